# Optimizing an MI355X kernel written in HIP

```python
import jax, jax.numpy as jnp
from jax import lax
import numpy as np

D_MODEL = 1024
BATCH = 16
SEQ = 256
DEPTH = 4
DEC_BATCH = 4
DEC_SEQ = 1024
PAST_LEN = 512

GRID_W = 64
HEAD_DIM = 64
RET_HEADS = 4
RET_DK = 64
RET_DV = 64
RET_W = RET_HEADS * RET_DV
RET_CHUNK = 128
GQA_HEADS = 6
GQA_KV_HEADS = 2
GQA_GROUP = GQA_HEADS // GQA_KV_HEADS
GQA_W = GQA_HEADS * HEAD_DIM
MLA_HEADS = 6
MLA_NOPE = 64
MLA_ROPE = 32
MLA_V = 64
MLA_Q_RANK = 256
MLA_KV_RANK = 128
MLA_W = MLA_HEADS * MLA_V
MIX_W = RET_W + GQA_W + MLA_W
Q_BLOCK = 128
ROPE_THETA = 10000.0
EPS = 1e-6
IN_SPLITS = (RET_W, RET_W, RET_W,
             GQA_HEADS * HEAD_DIM, GQA_KV_HEADS * HEAD_DIM, GQA_KV_HEADS * HEAD_DIM,
             MLA_Q_RANK, MLA_KV_RANK, MLA_ROPE,
             MIX_W)
IN_W = sum(IN_SPLITS)

kernel_name = 'hybrid_retention_gqa_mla_prefix_dit'

f32 = jnp.float32


def rms_norm(x, g=None):
    xf = x.astype(f32)
    y = xf * lax.rsqrt(jnp.mean(xf * xf, axis=-1, keepdims=True) + EPS)
    if g is not None:
        y = y * g.astype(f32)
    return y.astype(x.dtype)


def axial_rope(n_tok, dim):
    rows = n_tok // GRID_W
    row = jnp.repeat(jnp.arange(rows), GRID_W).astype(f32)
    col = (jnp.arange(n_tok) % GRID_W).astype(f32)
    half = dim // 2
    inv = ROPE_THETA ** (-jnp.arange(0, half, 2, dtype=f32) / half)
    ar = row[:, None] * inv[None, :]
    ac = col[:, None] * inv[None, :]
    ang = jnp.concatenate([ar, ar, ac, ac], axis=-1)
    return jnp.cos(ang), jnp.sin(ang)


def apply_rope(x, cos, sin):
    d = x.shape[-1]
    half = d // 2
    qd = half // 2
    xr, xc = x[..., :half], x[..., half:]
    rot = jnp.concatenate([-xr[..., qd:], xr[..., :qd], -xc[..., qd:], xc[..., :qd]], axis=-1)
    out = x.astype(f32) * cos[:, None, :] + rot.astype(f32) * sin[:, None, :]
    return out.astype(x.dtype)


def retention_chunkwise(q, k, v, log_g, s0):
    B, L, H, _ = q.shape
    dv = v.shape[-1]
    n = L // RET_CHUNK
    q, k, v = q.astype(f32), k.astype(f32), v.astype(f32)
    pos = jnp.arange(RET_CHUNK, dtype=f32)
    rel = pos[:, None] - pos[None, :]
    intra = jnp.where(rel >= 0, jnp.exp(jnp.maximum(rel, 0.0)[None] * log_g[:, None, None]), 0.0)
    q_dec = jnp.exp((pos + 1.0)[:, None] * log_g[None, :])
    k_dec = jnp.exp((RET_CHUNK - 1.0 - pos)[:, None] * log_g[None, :])
    c_dec = jnp.exp(RET_CHUNK * log_g)

    def to_chunks(a):
        return a.reshape(B, n, RET_CHUNK, H, a.shape[-1]).transpose(1, 0, 2, 3, 4)

    def step(s, inp):
        qi, ki, vi = inp
        a = jnp.einsum('bihd,bjhd->bhij', qi, ki) * intra
        o = (jnp.einsum('bhij,bjhe->bihe', a, vi)
             + jnp.einsum('bihd,bhde->bihe', qi, s) * q_dec[None, :, :, None])
        s = s * c_dec[None, :, None, None] + jnp.einsum('bjhd,bjhe->bhde', ki * k_dec[None, :, :, None], vi)
        return s, o

    s, o = lax.scan(step, s0.astype(f32), (to_chunks(q), to_chunks(k), to_chunks(v)))
    return o.transpose(1, 0, 2, 3, 4).reshape(B, L, H, dv), s


def bidir_retention(q, k, v, log_g, s0_f, s0_b):
    B, L = q.shape[:2]
    o_f, s_f = retention_chunkwise(q, k, v, log_g[0], s0_f)
    o_b, s_b = retention_chunkwise(jnp.flip(q, 1), jnp.flip(k, 1), jnp.flip(v, 1), log_g[1], s0_b)
    o = rms_norm(o_f + jnp.flip(o_b, 1))
    return o.reshape(B, L, RET_W).astype(v.dtype), jnp.stack([s_f, s_b], axis=1).astype(v.dtype)


def block_attention(q, k, v, scale):
    B, Lq, KH, G, dq = q.shape
    dv = v.shape[-1]
    nb = Lq // Q_BLOCK
    qb = q.reshape(B, nb, Q_BLOCK, KH, G, dq).transpose(1, 0, 2, 3, 4, 5)

    def one_block(qi):
        s = jnp.einsum('bqkgd,bskd->bkgqs', qi, k).astype(f32) * scale
        p = jax.nn.softmax(s, axis=-1).astype(v.dtype)
        return jnp.einsum('bkgqs,bskd->bqkgd', p, v)

    o = lax.map(one_block, qb)
    return o.transpose(1, 0, 2, 3, 4, 5).reshape(B, Lq, KH, G, dv)


def gqa_attend(q, k, v):
    B, L = q.shape[:2]
    qg = q.reshape(B, L, GQA_KV_HEADS, GQA_GROUP, HEAD_DIM)
    return block_attention(qg, k, v, HEAD_DIM ** -0.5).reshape(B, L, GQA_W)


def mla_queries(cq, p):
    B, L = cq.shape[:2]
    qf = (rms_norm(cq, p['mla_q_norm']) @ p['w_uq']).reshape(B, L, MLA_HEADS, MLA_NOPE + MLA_ROPE)
    return qf[..., :MLA_NOPE], qf[..., MLA_NOPE:]


def mla_attend(q_nope, q_pe, ckv, kpe, w_ukv):
    B, Lq = q_nope.shape[:2]
    Lk = ckv.shape[1]
    kv = (ckv @ w_ukv).reshape(B, Lk, MLA_HEADS, MLA_NOPE + MLA_V)
    k = jnp.concatenate([kv[..., :MLA_NOPE],
                         jnp.broadcast_to(kpe[:, :, None, :], (B, Lk, MLA_HEADS, MLA_ROPE))], axis=-1)
    v = kv[..., MLA_NOPE:]
    q = jnp.concatenate([q_nope, q_pe], axis=-1)[:, :, :, None, :]
    o = block_attention(q, k, v, (MLA_NOPE + MLA_ROPE) ** -0.5)
    return o.reshape(B, Lq, MLA_W)


def _pre(x, cond, p):
    mod = (jax.nn.silu(cond) @ p['w_ada'] + p['b_ada'])[:, None, :]
    shift, scale, gate = jnp.split(mod, 3, axis=-1)
    h = rms_norm(x, p['norm_g']) * (1 + scale) + shift
    idx = np.cumsum(IN_SPLITS)[:-1].tolist()
    parts = jnp.split(h @ p['w_in'], idx, axis=-1)
    return parts, gate


def _post(x, o_ret, o_gqa, o_mla, z_gate, g_res, w_out):
    y = jnp.concatenate([o_ret, o_gqa, o_mla], axis=-1) * jax.nn.silu(z_gate)
    return x + g_res * (y @ w_out)


def context_layer(x, c_ctx, p):
    B, L, _ = x.shape
    (rq, rk, rv, gq, gk, gv, cq, ckv, kpe, z_gate), g_res = _pre(x, c_ctx[None, :], p)
    q = rq.reshape(B, L, RET_HEADS, RET_DK)
    k = rk.reshape(B, L, RET_HEADS, RET_DK) * (RET_DK ** -0.5)
    v = rv.reshape(B, L, RET_HEADS, RET_DV)
    log_g = jax.nn.log_sigmoid(p['ret_decay_logit'].astype(f32))
    s0 = jnp.zeros((B, RET_HEADS, RET_DK, RET_DV), f32)
    o_ret, ret_state = bidir_retention(q, k, v, log_g, s0, s0)
    gq = rms_norm(gq.reshape(B, L, GQA_HEADS, HEAD_DIM), p['gqa_q_norm'])
    gk = rms_norm(gk.reshape(B, L, GQA_KV_HEADS, HEAD_DIM), p['gqa_k_norm'])
    gv = gv.reshape(B, L, GQA_KV_HEADS, HEAD_DIM)
    o_gqa = gqa_attend(gq, gk, gv)
    ckv = rms_norm(ckv, p['mla_kv_norm'])
    q_nope, q_pe = mla_queries(cq, p)
    o_mla = mla_attend(q_nope, q_pe, ckv, kpe, p['w_ukv'])
    x = _post(x, o_ret, o_gqa, o_mla, z_gate, g_res, p['w_out'])
    return x, (ret_state, gk, gv, ckv, kpe)


def latent_layer(x, c, p, cache, rope_hd, rope_mla):
    state, ck, cv, cckv, ckpe = cache
    B, L, _ = x.shape
    (rq, rk, rv, gq, gk, gv, cq, ckv, kpe, z_gate), g_res = _pre(x, c, p)
    cos, sin = rope_hd
    q = apply_rope(rq.reshape(B, L, RET_HEADS, RET_DK), cos, sin)
    k = apply_rope(rk.reshape(B, L, RET_HEADS, RET_DK), cos, sin) * (RET_DK ** -0.5)
    v = rv.reshape(B, L, RET_HEADS, RET_DV)
    log_g = jax.nn.log_sigmoid(p['ret_decay_logit'].astype(f32))
    o_ret, _ = bidir_retention(q, k, v, log_g, state[:, 0], state[:, 1])
    gq = apply_rope(rms_norm(gq.reshape(B, L, GQA_HEADS, HEAD_DIM), p['gqa_q_norm']), cos, sin)
    gk = apply_rope(rms_norm(gk.reshape(B, L, GQA_KV_HEADS, HEAD_DIM), p['gqa_k_norm']), cos, sin)
    gv = gv.reshape(B, L, GQA_KV_HEADS, HEAD_DIM)
    o_gqa = gqa_attend(gq, jnp.concatenate([ck, gk], axis=1), jnp.concatenate([cv, gv], axis=1))
    mcos, msin = rope_mla
    ckv = rms_norm(ckv, p['mla_kv_norm'])
    q_nope, q_pe = mla_queries(cq, p)
    q_pe = apply_rope(q_pe, mcos, msin)
    kpe = apply_rope(kpe[:, :, None, :], mcos, msin)[:, :, 0, :]
    o_mla = mla_attend(q_nope, q_pe, jnp.concatenate([cckv, ckv], axis=1),
                       jnp.concatenate([ckpe, kpe], axis=1), p['w_ukv'])
    return _post(x, o_ret, o_gqa, o_mla, z_gate, g_res, p['w_out'])


def setup_inputs(seed: int = 0) -> dict:
    key = jax.random.key(seed)
    ks = jax.random.split(key, 24)

    def nrm(k, shape, s=1.0):
        return jax.random.normal(k, shape, f32) * s

    expo = (5.0 + jnp.arange(RET_HEADS, dtype=f32))[None, None, :] \
        + jnp.array([0.0, 0.5], f32)[None, :, None] + nrm(ks[10], (DEPTH, 2, RET_HEADS), 0.1)
    one_minus = 2.0 ** (-expo)
    ret_decay_logit = jnp.log((1.0 - one_minus) / one_minus)
    return {
        'x_prompt': nrm(ks[0], (BATCH, SEQ, D_MODEL)),
        'x_sample': nrm(ks[1], (DEC_BATCH, DEC_SEQ, D_MODEL)),
        'state_ret': nrm(ks[2], (DEC_BATCH, DEPTH, 2, RET_HEADS, RET_DK, RET_DV)),
        'cache_gqa_k': nrm(ks[3], (DEC_BATCH, DEPTH, PAST_LEN, GQA_KV_HEADS, HEAD_DIM)),
        'cache_gqa_v': nrm(ks[4], (DEC_BATCH, DEPTH, PAST_LEN, GQA_KV_HEADS, HEAD_DIM)),
        'cache_mla_ckv': nrm(ks[5], (DEC_BATCH, DEPTH, PAST_LEN, MLA_KV_RANK)),
        'cache_mla_kpe': nrm(ks[6], (DEC_BATCH, DEPTH, PAST_LEN, MLA_ROPE)),
        'c': nrm(ks[7], (DEC_BATCH, D_MODEL)),
        'c_ctx': nrm(ks[8], (D_MODEL,)),
        'norm_g': 1.0 + nrm(ks[9], (DEPTH, D_MODEL), 0.02),
        'w_ada': nrm(ks[11], (DEPTH, D_MODEL, 3 * D_MODEL), 0.5 * D_MODEL ** -0.5),
        'b_ada': nrm(ks[12], (DEPTH, 3 * D_MODEL), 0.02),
        'w_in': nrm(ks[13], (DEPTH, D_MODEL, IN_W), D_MODEL ** -0.5),
        'ret_decay_logit': ret_decay_logit,
        'gqa_q_norm': 1.0 + nrm(ks[14], (DEPTH, HEAD_DIM), 0.02),
        'gqa_k_norm': 1.0 + nrm(ks[15], (DEPTH, HEAD_DIM), 0.02),
        'mla_q_norm': 1.0 + nrm(ks[16], (DEPTH, MLA_Q_RANK), 0.02),
        'mla_kv_norm': 1.0 + nrm(ks[17], (DEPTH, MLA_KV_RANK), 0.02),
        'w_uq': nrm(ks[18], (DEPTH, MLA_Q_RANK, MLA_HEADS * (MLA_NOPE + MLA_ROPE)), MLA_Q_RANK ** -0.5),
        'w_ukv': nrm(ks[19], (DEPTH, MLA_KV_RANK, MLA_HEADS * (MLA_NOPE + MLA_V)), MLA_KV_RANK ** -0.5),
        'w_out': nrm(ks[20], (DEPTH, MIX_W, D_MODEL), MIX_W ** -0.5),
        'final_norm': 1.0 + nrm(ks[21], (D_MODEL,), 0.02),
    }


def reference(x_prompt, x_sample, state_ret, cache_gqa_k, cache_gqa_v, cache_mla_ckv, cache_mla_kpe,
              c, c_ctx, norm_g, w_ada, b_ada, w_in, ret_decay_logit, gqa_q_norm, gqa_k_norm,
              mla_q_norm, mla_kv_norm, w_uq, w_ukv, w_out, final_norm):
    n_lat = x_sample.shape[1]
    rope_hd = axial_rope(n_lat, HEAD_DIM)
    rope_mla = axial_rope(n_lat, MLA_ROPE)
    xp, xs = x_prompt, x_sample
    st_l, gk_l, gv_l, ckv_l, kpe_l = [], [], [], [], []
    for l in range(DEPTH):
        p = dict(norm_g=norm_g[l], w_ada=w_ada[l], b_ada=b_ada[l], w_in=w_in[l],
                 ret_decay_logit=ret_decay_logit[l], gqa_q_norm=gqa_q_norm[l], gqa_k_norm=gqa_k_norm[l],
                 mla_q_norm=mla_q_norm[l], mla_kv_norm=mla_kv_norm[l], w_uq=w_uq[l], w_ukv=w_ukv[l],
                 w_out=w_out[l])
        xp, (st, gk, gv, ckv, kpe) = context_layer(xp, c_ctx, p)
        st_l.append(st)
        gk_l.append(gk)
        gv_l.append(gv)
        ckv_l.append(ckv)
        kpe_l.append(kpe)
        cache_l = (state_ret[:, l], cache_gqa_k[:, l], cache_gqa_v[:, l], cache_mla_ckv[:, l], cache_mla_kpe[:, l])
        xs = latent_layer(xs, c, p, cache_l, rope_hd, rope_mla)
    y_prompt = rms_norm(xp, final_norm)
    y_sample = rms_norm(xs, final_norm)
    new_state_ret = jnp.stack(st_l, axis=1)
    new_gqa_k = jnp.stack(gk_l, axis=1)
    new_gqa_v = jnp.stack(gv_l, axis=1)
    new_mla_ckv = jnp.stack(ckv_l, axis=1)
    new_mla_kpe = jnp.stack(kpe_l, axis=1)
    return (y_prompt, y_sample, new_state_ret, new_gqa_k, new_gqa_v, new_mla_ckv, new_mla_kpe)
```

```cpp
#include <hip/hip_runtime.h>
#include <stdint.h>
namespace nv {
constexpr float EPS = 1e-6f;
__device__ __forceinline__ float silu_f(float x) { return x / (1.f + expf(-x)); }
__device__ __forceinline__ float wsum(float v) {
#pragma unroll
    for (int o = 32; o > 0; o >>= 1) v += __shfl_xor(v, o);
    return v;
}
__device__ __forceinline__ float wmax(float v) {
#pragma unroll
    for (int o = 32; o > 0; o >>= 1) v = fmaxf(v, __shfl_xor(v, o));
    return v;
}
__device__ __forceinline__ float logsig(float x) { return -log1pf(expf(-x)); }

__global__ void __launch_bounds__(256) k_mods(const float* c, const float* c_ctx, const float* w_ada, const float* b_ada, float* mods) {
    int idx = blockIdx.x * 256 + threadIdx.x;
    if (idx >= 4 * 3072) return;
    int l = idx / 3072, j = idx % 3072;
    float acc[5] = {0.f, 0.f, 0.f, 0.f, 0.f};
    const float* w = w_ada + (size_t)l * 1024 * 3072 + j;
    for (int k = 0; k < 1024; ++k) {
        float wv = w[(size_t)k * 3072];
        acc[0] += silu_f(c_ctx[k]) * wv;
#pragma unroll
        for (int n = 1; n < 5; ++n) acc[n] += silu_f(c[(n - 1) * 1024 + k]) * wv;
    }
#pragma unroll
    for (int n = 0; n < 5; ++n) mods[(l * 5 + n) * 3072 + j] = acc[n] + b_ada[l * 3072 + j];
}

__global__ void __launch_bounds__(256) k_h(const float* x, float* nh, const float* g, const float* mods_l, int L, int is_lat) {
    int row = blockIdx.x * 4 + (threadIdx.x >> 6), lane = threadIdx.x & 63;
    const float* xr = x + (size_t)row * 1024;
    float ss = 0.f;
    for (int k = lane; k < 1024; k += 64) ss += xr[k] * xr[k];
    ss = wsum(ss);
    float rstd = rsqrtf(ss * (1.f / 1024.f) + EPS);
    int cond = is_lat ? 1 + row / L : 0;
    const float* md = mods_l + cond * 3072;
    for (int k = lane; k < 1024; k += 64) nh[(size_t)row * 1024 + k] = xr[k] * rstd * g[k] * (1.f + md[1024 + k]) + md[k];
}

__global__ void __launch_bounds__(256) k_gemm(const float* A, int lda, const float* B, int ldb, float* C, int ldc, int N, int K,
                       const float* gate_mods, int L, int is_lat) {
    int n = blockIdx.x * 256 + threadIdx.x, r0 = blockIdx.y * 8;
    if (n >= N) return;
    float acc[8];
#pragma unroll
    for (int i = 0; i < 8; ++i) acc[i] = 0.f;
    for (int k = 0; k < K; ++k) {
        float b = B[(size_t)k * ldb + n];
#pragma unroll
        for (int i = 0; i < 8; ++i) acc[i] += A[(size_t)(r0 + i) * lda + k] * b;
    }
#pragma unroll
    for (int i = 0; i < 8; ++i) {
        int r = r0 + i;
        if (gate_mods) {
            int cond = is_lat ? 1 + r / L : 0;
            float gt = gate_mods[cond * 3072 + 2048 + n];
            C[(size_t)r * ldc + n] += gt * acc[i];
        } else C[(size_t)r * ldc + n] = acc[i];
    }
}

__device__ __forceinline__ void rope64(float* p, int t) {
    float rw = (float)(t / 64), cl = (float)(t % 64);
    for (int i = 0; i < 16; ++i) {
        float inv = exp2f(-(float)i * (13.287712379549449f / 16.f));
        float a = rw * inv, c = cosf(a), s = sinf(a);
        float x0 = p[i], x1 = p[i + 16];
        p[i] = x0 * c - x1 * s; p[i + 16] = x1 * c + x0 * s;
        a = cl * inv; c = cosf(a); s = sinf(a);
        x0 = p[32 + i]; x1 = p[48 + i];
        p[32 + i] = x0 * c - x1 * s; p[48 + i] = x1 * c + x0 * s;
    }
}
__device__ __forceinline__ void rope32(float* p, int t) {
    float rw = (float)(t / 64), cl = (float)(t % 64);
    for (int i = 0; i < 8; ++i) {
        float inv = exp2f(-(float)i * (13.287712379549449f / 8.f));
        float a = rw * inv, c = cosf(a), s = sinf(a);
        float x0 = p[i], x1 = p[i + 8];
        p[i] = x0 * c - x1 * s; p[i + 8] = x1 * c + x0 * s;
        a = cl * inv; c = cosf(a); s = sinf(a);
        x0 = p[16 + i]; x1 = p[24 + i];
        p[16 + i] = x0 * c - x1 * s; p[24 + i] = x1 * c + x0 * s;
    }
}
__device__ __forceinline__ void rmsn(float* v, int n, const float* g) {
    float ss = 0.f;
    for (int i = 0; i < n; ++i) ss += v[i] * v[i];
    float r = rsqrtf(ss / (float)n + EPS);
    for (int i = 0; i < n; ++i) v[i] = v[i] * r * g[i];
}
__global__ void __launch_bounds__(256) k_post(float* np, int R, int L, int is_lat, int l, const float* gqn, const float* gkn, const float* mqn, const float* mkvn,
                       float* o_gk, float* o_gv, float* o_ckv, float* o_kpe) {
    int idx = blockIdx.x * 256 + threadIdx.x;
    if (idx >= R * 20) return;
    int row = idx / 20, it = idx % 20, b = row / L, t = row % L;
    float* p = np + (size_t)row * 2848;
    size_t orow = ((size_t)(b * 4 + l) * 256 + t);
    if (it < 6) { float* v = p + 768 + it * 64; rmsn(v, 64, gqn + l * 64); if (is_lat) rope64(v, t); }
    else if (it < 8) { int kh = it - 6; float* v = p + 1152 + kh * 64; rmsn(v, 64, gkn + l * 64);
        if (is_lat) rope64(v, t); else for (int i = 0; i < 64; ++i) o_gk[orow * 128 + kh * 64 + i] = v[i]; }
    else if (it == 8) { if (!is_lat) for (int i = 0; i < 128; ++i) o_gv[orow * 128 + i] = p[1280 + i]; }
    else if (it < 13) { float* v = p + (it - 9) * 64; if (is_lat) rope64(v, t); }
    else if (it < 17) { float* v = p + 256 + (it - 13) * 64; if (is_lat) rope64(v, t); for (int i = 0; i < 64; ++i) v[i] *= 0.125f; }
    else if (it == 17) { rmsn(p + 1408, 256, mqn + l * 256); }
    else if (it == 18) { float* v = p + 1664; rmsn(v, 128, mkvn + l * 128); if (!is_lat) for (int i = 0; i < 128; ++i) o_ckv[orow * 128 + i] = v[i]; }
    else { float* v = p + 1792; if (is_lat) rope32(v, t); else for (int i = 0; i < 32; ++i) o_kpe[orow * 32 + i] = v[i]; }
}
__global__ void __launch_bounds__(256) k_qpe_rope(float* nqm, int R, int L) {
    int idx = blockIdx.x * 256 + threadIdx.x;
    if (idx >= R * 6) return;
    int row = idx / 6, h = idx % 6;
    rope32(nqm + (size_t)row * 576 + h * 96 + 64, row % L);
}

template <int MODE>
__global__ void __launch_bounds__(256) k_attn(float* np, const float* nqm, const float* nkv, int L, int is_lat, int l,
                       const float* cgk, const float* cgv, const float* ckpe) {
    __shared__ float sc[4][1536];
    __shared__ float qs[4][96];
    int w = threadIdx.x >> 6, lane = threadIdx.x & 63;
    int gw = blockIdx.x * 4 + w, row = gw / 6, h = gw % 6, b = row / L;
    int nc = is_lat ? 512 : 0, nk = nc + L;
    constexpr int DQ = MODE == 0 ? 64 : 96;
    if (MODE == 0) qs[w][lane] = np[(size_t)row * 2848 + 768 + h * 64 + lane];
    else { qs[w][lane] = nqm[(size_t)row * 576 + h * 96 + lane]; if (lane < 32) qs[w][64 + lane] = nqm[(size_t)row * 576 + h * 96 + 64 + lane]; }
    __syncthreads();
    const float scale = MODE == 0 ? 0.125f : 0.10206207261596575f;
    float mx = -1e30f;
    for (int j = lane; j < nk; j += 64) {
        float s = 0.f;
        if (MODE == 0) {
            int kvh = h / 3;
            const float* kp = (j < nc) ? cgk + ((size_t)(b * 4 + l) * 512 + j) * 128 + kvh * 64 : np + (size_t)(b * L + j - nc) * 2848 + 1152 + kvh * 64;
            _Pragma("unroll 8") for (int i = 0; i < 64; ++i) s += qs[w][i] * kp[i];
        } else {
            size_t krow = is_lat ? (size_t)b * 1536 + j : (size_t)b * L + j;
            const float* kp = nkv + krow * 768 + h * 128;
            _Pragma("unroll 8") for (int i = 0; i < 64; ++i) s += qs[w][i] * kp[i];
            const float* pe = (j < nc) ? ckpe + ((size_t)(b * 4 + l) * 512 + j) * 32 : np + (size_t)(b * L + j - nc) * 2848 + 1792;
            _Pragma("unroll 8") for (int i = 0; i < 32; ++i) s += qs[w][64 + i] * pe[i];
        }
        s *= scale; sc[w][j] = s; mx = fmaxf(mx, s);
    }
    mx = wmax(mx);
    float sum = 0.f;
    for (int j = lane; j < nk; j += 64) { float p = expf(sc[w][j] - mx); sc[w][j] = p; sum += p; }
    sum = wsum(sum);
    __syncthreads();
    float o = 0.f;
    for (int j = 0; j < nk; ++j) {
        float v;
        if (MODE == 0) { int kvh = h / 3;
            v = (j < nc) ? cgv[((size_t)(b * 4 + l) * 512 + j) * 128 + kvh * 64 + lane] : np[(size_t)(b * L + j - nc) * 2848 + 1280 + kvh * 64 + lane]; }
        else { size_t krow = is_lat ? (size_t)b * 1536 + j : (size_t)b * L + j; v = nkv[krow * 768 + h * 128 + 64 + lane]; }
        o += sc[w][j] * v;
    }
    o /= sum;
    float* zp = np + (size_t)row * 2848 + 1824 + (MODE == 0 ? 256 : 640) + h * 64 + lane;
    *zp = o * silu_f(*zp);
}

__global__ void __launch_bounds__(256) k_ret(float* np, int L, int is_lat, int l, const float* decay, const float* state) {
    __shared__ float sc[4][1024];
    __shared__ float qs[4][64];
    int w = threadIdx.x >> 6, lane = threadIdx.x & 63;
    int gw = blockIdx.x * 4 + w, row = gw / 4, h = gw % 4, b = row / L, t = row % L;
    qs[w][lane] = np[(size_t)row * 2848 + h * 64 + lane];
    __syncthreads();
    float lgf = logsig(decay[(l * 2 + 0) * 4 + h]), lgb = logsig(decay[(l * 2 + 1) * 4 + h]);
    for (int m = lane; m < L; m += 64) {
        const float* kp = np + (size_t)(b * L + m) * 2848 + 256 + h * 64;
        float s = 0.f;
        _Pragma("unroll 8") for (int i = 0; i < 64; ++i) s += qs[w][i] * kp[i];
        float d = m < t ? expf((float)(t - m) * lgf) : (m > t ? expf((float)(m - t) * lgb) : 2.f);
        sc[w][m] = s * d;
    }
    __syncthreads();
    float o = 0.f;
    for (int m = 0; m < L; ++m) o += sc[w][m] * np[(size_t)(b * L + m) * 2848 + 512 + h * 64 + lane];
    if (is_lat) {
        const float* sf = state + ((size_t)((b * 4 + l) * 2 + 0) * 4 + h) * 4096;
        const float* sb = state + ((size_t)((b * 4 + l) * 2 + 1) * 4 + h) * 4096;
        float af = 0.f, ab = 0.f;
        _Pragma("unroll 4") for (int i = 0; i < 64; ++i) { af += qs[w][i] * sf[i * 64 + lane]; ab += qs[w][i] * sb[i * 64 + lane]; }
        o += expf((float)(t + 1) * lgf) * af + expf((float)(L - t) * lgb) * ab;
    }
    float ss = wsum(o * o);
    o *= rsqrtf(ss * (1.f / 64.f) + EPS);
    float* zp = np + (size_t)row * 2848 + 1824 + h * 64 + lane;
    *zp = o * silu_f(*zp);
}
__global__ void __launch_bounds__(256) k_state(const float* np, int l, const float* decay, float* o_state) {
    int idx = blockIdx.x * 256 + threadIdx.x;
    int dv = idx & 63, dk = (idx >> 6) & 63, h = (idx >> 12) & 3, dir = (idx >> 14) & 1, b = idx >> 15;
    float lg = logsig(decay[(l * 2 + dir) * 4 + h]);
    float acc = 0.f;
    for (int m = 0; m < 256; ++m) {
        const float* p = np + (size_t)(b * 256 + m) * 2848;
        float wgt = dir == 0 ? expf((float)(255 - m) * lg) : expf((float)m * lg);
        acc += wgt * p[256 + h * 64 + dk] * p[512 + h * 64 + dv];
    }
    o_state[((((size_t)(b * 4 + l) * 2 + dir) * 4 + h) * 64 + dk) * 64 + dv] = acc;
}
__global__ void __launch_bounds__(256) k_final(float* x, const float* fn) {
    int row = blockIdx.x * 4 + (threadIdx.x >> 6), lane = threadIdx.x & 63;
    float* xr = x + (size_t)row * 1024;
    float ss = 0.f;
    for (int k = lane; k < 1024; k += 64) ss += xr[k] * xr[k];
    ss = wsum(ss);
    float rstd = rsqrtf(ss * (1.f / 1024.f) + EPS);
    for (int k = lane; k < 1024; k += 64) xr[k] = xr[k] * rstd * fn[k];
}

struct In {
    const float *x_prompt, *x_sample, *state_ret, *cgk, *cgv, *cckv, *ckpe, *c, *c_ctx, *norm_g, *w_ada, *b_ada, *w_in, *decay,
        *gqn, *gkn, *mqn, *mkvn, *w_uq, *w_ukv, *w_out, *final_norm;
};
constexpr size_t NV_MODS = 0, NV_NH = 65536, NV_NP = NV_NH + 4096ull * 1024, NV_NQM = NV_NP + 4096ull * 2848, NV_NKV = NV_NQM + 4096ull * 576,
                 NV_END = NV_NKV + 6144ull * 768;

static void run_stream(const In& I, float* nvws, float* xbuf, float* dout, int is_lat, int l0, int l1, bool do_mods, bool do_final, hipStream_t s) {
    float* mods = nvws + NV_MODS; float* nh = nvws + NV_NH; float* np = nvws + NV_NP; float* nqm = nvws + NV_NQM; float* nkv = nvws + NV_NKV;
    const int R = 4096, L = is_lat ? 1024 : 256;
    float* o_state = dout + 8388608; float* o_gk = dout + 10485760; float* o_gv = dout + 12582912; float* o_ckv = dout + 14680064; float* o_kpe = dout + 16777216;
    if (do_mods) k_mods<<<48, 256, 0, s>>>(I.c, I.c_ctx, I.w_ada, I.b_ada, mods);
    for (int l = l0; l < l1; ++l) {
        const float* mods_l = mods + l * 5 * 3072;
        k_h<<<R / 4, 256, 0, s>>>(xbuf, nh, I.norm_g + l * 1024, mods_l, L, is_lat);
        k_gemm<<<dim3(12, R / 8), 256, 0, s>>>(nh, 1024, I.w_in + (size_t)l * 1024 * 2848, 2848, np, 2848, 2848, 1024, nullptr, L, is_lat);
        k_post<<<(R * 20 + 255) / 256, 256, 0, s>>>(np, R, L, is_lat, l, I.gqn, I.gkn, I.mqn, I.mkvn, o_gk, o_gv, o_ckv, o_kpe);
        k_gemm<<<dim3(3, R / 8), 256, 0, s>>>(np + 1408, 2848, I.w_uq + (size_t)l * 256 * 576, 576, nqm, 576, 576, 256, nullptr, L, is_lat);
        if (is_lat) {
            k_qpe_rope<<<(R * 6 + 255) / 256, 256, 0, s>>>(nqm, R, L);
            for (int b = 0; b < 4; ++b) {
                k_gemm<<<dim3(3, 512 / 8), 256, 0, s>>>(I.cckv + (size_t)(b * 4 + l) * 512 * 128, 128, I.w_ukv + (size_t)l * 128 * 768, 768, nkv + (size_t)b * 1536 * 768, 768, 768, 128, nullptr, L, is_lat);
                k_gemm<<<dim3(3, 1024 / 8), 256, 0, s>>>(np + (size_t)b * 1024 * 2848 + 1664, 2848, I.w_ukv + (size_t)l * 128 * 768, 768, nkv + ((size_t)b * 1536 + 512) * 768, 768, 768, 128, nullptr, L, is_lat);
            }
        } else {
            k_gemm<<<dim3(3, R / 8), 256, 0, s>>>(np + 1664, 2848, I.w_ukv + (size_t)l * 128 * 768, 768, nkv, 768, 768, 128, nullptr, L, is_lat);
            k_state<<<16 * 2 * 4 * 64 * 64 / 256, 256, 0, s>>>(np, l, I.decay, o_state);
        }
        k_attn<0><<<R * 6 / 4, 256, 0, s>>>(np, nqm, nkv, L, is_lat, l, I.cgk, I.cgv, I.ckpe);
        k_attn<1><<<R * 6 / 4, 256, 0, s>>>(np, nqm, nkv, L, is_lat, l, I.cgk, I.cgv, I.ckpe);
        k_ret<<<R * 4 / 4, 256, 0, s>>>(np, L, is_lat, l, I.decay, I.state_ret);
        k_gemm<<<dim3(4, R / 8), 256, 0, s>>>(np + 1824, 2848, I.w_out + (size_t)l * 1024 * 1024, 1024, xbuf, 1024, 1024, 1024, mods_l, L, is_lat);
    }
    if (do_final) k_final<<<R / 4, 256, 0, s>>>(xbuf, I.final_norm);
}
}

extern "C" void kernel_launch(void* const* d_in, const int* in_sizes, int n_in, void* d_out, int out_size, void* d_ws, size_t ws_size, hipStream_t stream) {
    nv::In I;
    const float** ip = (const float**)&I;
    for (int i = 0; i < 22; ++i) ip[i] = (const float*)d_in[i];
    float* out = (float*)d_out;
    float* nvws = (float*)d_ws;
    (void)hipMemcpyAsync(out, I.x_prompt, 4194304ull * 4, hipMemcpyDeviceToDevice, stream);
    (void)hipMemcpyAsync(out + 4194304, I.x_sample, 4194304ull * 4, hipMemcpyDeviceToDevice, stream);
    nv::run_stream(I, nvws, out, out, 0, 0, 4, true, true, stream);
    nv::run_stream(I, nvws, out + 4194304, out, 1, 0, 4, false, true, stream);
}
```

```cpp
#include <hip/hip_runtime.h>
#include <stdint.h>
namespace mk {
#define LAS __attribute__((address_space(3)))
typedef unsigned short bf16_t;
typedef short bf16x8 __attribute__((ext_vector_type(8)));
typedef short s16x4 __attribute__((ext_vector_type(4)));
typedef float f32x16 __attribute__((ext_vector_type(16)));
typedef float f32x4 __attribute__((ext_vector_type(4)));
typedef float f32x2 __attribute__((ext_vector_type(2)));
typedef unsigned u32x4 __attribute__((ext_vector_type(4)));
typedef unsigned u32x2 __attribute__((ext_vector_type(2)));
typedef __bf16 bf16x2_t __attribute__((ext_vector_type(2)));

constexpr float EPS = 1e-6f;
constexpr float LOG2E = 1.4426950408889634f;
constexpr float QSC_GQA = 0.125f * LOG2E;
constexpr float QSC_MLA = 0.10206207261596575f * LOG2E;

__device__ __forceinline__ unsigned pk2(float lo, float hi) { f32x2 v = {lo, hi}; bf16x2_t b = __builtin_convertvector(v, bf16x2_t); return __builtin_bit_cast(unsigned, b); }
__device__ __forceinline__ float bf2f(unsigned short u) { return __uint_as_float((unsigned)u << 16); }
__device__ __forceinline__ float bflo(unsigned u) { return __uint_as_float(u << 16); }
__device__ __forceinline__ float bfhi(unsigned u) { return __uint_as_float(u & 0xffff0000u); }
__device__ __forceinline__ float silu_f(float x) { return x * __builtin_amdgcn_rcpf(1.f + __builtin_amdgcn_exp2f(-x * LOG2E)); }
__device__ __forceinline__ float wsum(float v) {
#pragma unroll
    for (int o = 32; o > 0; o >>= 1) v += __shfl_xor(v, o);
    return v;
}

constexpr size_t MiB = 1u << 20;
constexpr size_t WS_CTL = 0, CTL_ZERO_BYTES = 1 * MiB;
constexpr size_t WS_MODS = 256 * 1024;
constexpr size_t WS_BIAS = 1 * MiB;
constexpr size_t WS_GS = 1 * MiB + 256 * 1024;
constexpr size_t WS_ROPE64 = 1 * MiB + 512 * 1024;
constexpr size_t WS_ROPE32 = 1 * MiB + 768 * 1024;
constexpr size_t WS_SSQ = 2 * MiB;
constexpr size_t WS_CQSSQ = 2 * MiB + 512 * 1024;
constexpr size_t WS_S0T = 3 * MiB;
constexpr size_t WS_CGK = 4 * MiB, WS_CGV = 6 * MiB, WS_CCKV = 8 * MiB, WS_CKPE = 10 * MiB;
constexpr size_t WS_WIN = 11 * MiB;
constexpr size_t WS_WOUT = 34 * MiB;
constexpr size_t WS_WUQ = 42 * MiB;
constexpr size_t WS_WUKV = 43 * MiB + 256 * 1024;
constexpr size_t WS_XG = 44 * MiB;
constexpr size_t WS_KVM = 44 * MiB;
constexpr size_t WS_KVMC = 56 * MiB;
constexpr size_t WS_RQ = 60 * MiB, WS_RK = 64 * MiB, WS_RV = 68 * MiB;
constexpr size_t WS_GQ = 72 * MiB;
constexpr size_t WS_GK = 78 * MiB, WS_GV = 80 * MiB;
constexpr size_t WS_CQG = 82 * MiB;
constexpr size_t WS_CKVN = 86 * MiB;
constexpr size_t WS_KPEB = 88 * MiB;
constexpr size_t WS_ZS = 89 * MiB;
constexpr size_t WS_QM = 105 * MiB;
constexpr size_t WS_Y = 114 * MiB;
constexpr size_t WS_XSDBG = 130 * MiB;
constexpr size_t WS_OPT_END = 162 * MiB;
constexpr int CW_QUEUE = 1024;
constexpr int CW_BAR = 4096;

constexpr size_t O_STATE = 8388608, O_GK = 10485760, O_GV = 12582912, O_CKV = 14680064, O_KPE = 16777216;

constexpr int LDS_EX = 65536;
constexpr int LDS_SCAL = 66560;
constexpr int LDS_MISC = 67072;
constexpr int LDS_BYTES = 67584;

struct Params { const float* in[22]; float* out; unsigned char* ws; float* xs; int ph_lo, ph_hi; };
enum { I_XP = 0, I_XS, I_STATE, I_CGK, I_CGV, I_CCKV, I_CKPE, I_C, I_CCTX, I_NORMG, I_WADA, I_BADA, I_WIN, I_DECAY, I_GQN, I_GKN, I_MQN, I_MKVN, I_WUQ, I_WUKV, I_WOUT, I_FNORM };

#define XB_TMO      128
#define XB_XCNT(j)  (256  + 64 * (j))
#define XB_XSUB(j)  (1280 + 64 * (j))
#define XB_XGEN(j)  (2304 + 64 * (j))
#define XB_TOP      3328
#define XB_TOPGEN   3392
#define XB_SPIN_CAP (1u << 20)
__device__ __forceinline__ unsigned xb_ld(unsigned* p) { return __hip_atomic_load(p, __ATOMIC_RELAXED, __HIP_MEMORY_SCOPE_AGENT); }
__device__ __forceinline__ unsigned xb_add(unsigned* p, unsigned v) { return __hip_atomic_fetch_add(p, v, __ATOMIC_RELAXED, __HIP_MEMORY_SCOPE_AGENT); }
__device__ __forceinline__ unsigned xb_xcc_id() { return (unsigned)__builtin_amdgcn_s_getreg((3 << 11) | 20) & 0xFu; }
#define XB_SPIN(cond, bar) do { unsigned _sp = 0; while (cond) { __builtin_amdgcn_s_sleep(1); \
    if ((++_sp & 255u) == 0u) { if (xb_ld(&(bar)[XB_TMO])) break; if (_sp > XB_SPIN_CAP) { atomicAdd(&(bar)[XB_TMO], 1u); break; } } } } while (0)
struct XcdBarrier { unsigned* bar; unsigned x; volatile LAS unsigned* st; };
__device__ __forceinline__ XcdBarrier xcd_barrier_post(unsigned* bar, volatile LAS unsigned* st) {
    XcdBarrier b; b.bar = bar; b.x = xb_xcc_id(); b.st = st;
    if (threadIdx.x == 0) (void)xb_add(&bar[XB_XCNT(b.x)], 1u);
    return b;
}
__device__ __forceinline__ void xcd_barrier_complete(unsigned* bar, unsigned x, unsigned& nloc, unsigned& nx) {
    const unsigned G = gridDim.x * gridDim.y * gridDim.z;
    unsigned sum, cnt, mine, sp = 0u;
    for (;;) {
        sum = 0u; cnt = 0u; mine = 0u;
#pragma unroll
        for (unsigned j = 0; j < 16; ++j) { const unsigned c = xb_ld(&bar[XB_XCNT(j)]); sum += c; cnt += (c > 0u) ? 1u : 0u; mine = (j == x) ? c : mine; }
        if (sum == G) break;
        __builtin_amdgcn_s_sleep(1);
        if ((++sp & 255u) == 0u) { if (xb_ld(&bar[XB_TMO])) break; if (sp > XB_SPIN_CAP) { atomicAdd(&bar[XB_TMO], 1u); break; } }
    }
    nloc = mine > 0u ? mine : 1u; nx = cnt > 0u ? cnt : 1u;
}
__device__ __forceinline__ void xcd_barrier(const XcdBarrier& b) {
    asm volatile("s_waitcnt vmcnt(0)" ::: "memory");
    __syncthreads();
    if (threadIdx.x == 0) {
        unsigned* bar = b.bar;
        __builtin_amdgcn_s_waitcnt(0);
        unsigned nloc = b.st[0], nx = b.st[1];
        if (nloc == 0u) { xcd_barrier_complete(bar, b.x, nloc, nx); b.st[0] = nloc; b.st[1] = nx; }
        const unsigned old = xb_add(&bar[XB_XSUB(b.x)], 1u);
        const unsigned gen = old / nloc;
        if (old + 1u == (gen + 1u) * nloc) {
            __builtin_amdgcn_fence(__ATOMIC_RELEASE, "agent");
            asm volatile("s_waitcnt vmcnt(0)" ::: "memory");
            const unsigned og = xb_add(&bar[XB_TOP], 1u);
            const unsigned tg = og / nx;
            if (og + 1u == (tg + 1u) * nx) xb_add(&bar[XB_TOPGEN], 1u);
            else XB_SPIN(xb_ld(&bar[XB_TOPGEN]) == tg, bar);
            __builtin_amdgcn_fence(__ATOMIC_ACQUIRE, "agent");
            xb_add(&bar[XB_XGEN(b.x)], 1u);
            asm volatile("s_waitcnt vmcnt(0)" ::: "memory");
        } else {
            XB_SPIN(xb_ld(&bar[XB_XGEN(b.x)]) == gen, bar);
            __builtin_amdgcn_fence(__ATOMIC_ACQUIRE, "agent");
            asm volatile("s_waitcnt vmcnt(0)" ::: "memory");
        }
    }
    __syncthreads();
}

struct Frame {
    LAS unsigned char* lds;
    int tid, lane, w, h, lq;
    unsigned char* ws;
};
#define GLDS16(gsrc, ldsdst) __builtin_amdgcn_global_load_lds((const unsigned*)(gsrc), (LAS unsigned*)(ldsdst), 16, 0, 0)
#define MFMA32(a, b, c) __builtin_amdgcn_mfma_f32_32x32x16_bf16((a), (b), (c), 0, 0, 0)

__device__ __forceinline__ void gemm_core(const Frame& F, const bf16_t* __restrict__ W, int ldw, const bf16_t* __restrict__ X, int ldx, int K, f32x16 (&acc)[2][2]) {
    const int lane = F.lane, w = F.w;
    const int nkt = K >> 6;
    int offW[4], offX[4];
#pragma unroll
    for (int g = 0; g < 4; ++g) {
        const int row = 32 * w + 8 * g + (lane >> 3);
        const int c = (lane & 7) ^ ((row >> 1) & 7);
        offW[g] = row * ldw + c * 8; offX[g] = row * ldx + c * 8;
    }
    LAS unsigned char* const dW = F.lds + (32 * w) * 128;
    LAS unsigned char* const dX = F.lds + 16384 + (32 * w) * 128;
#define GC_ISSUE(kt, st) do { _Pragma("unroll") for (int g = 0; g < 4; ++g) { \
        GLDS16(W + offW[g] + (kt) * 64, dW + (st) * 32768 + g * 1024); GLDS16(X + offX[g] + (kt) * 64, dX + (st) * 32768 + g * 1024); } } while (0)
    const int wn = w & 1, wm = w >> 1, h = F.h, lq = F.lq;
    const int sw = (lane >> 1) & 7;
    int so[4];
#pragma unroll
    for (int s = 0; s < 4; ++s) so[s] = ((2 * s + h) ^ sw) << 4;
    const int bn0 = (64 * wn + lq) * 128, bm0 = 16384 + (64 * wm + lq) * 128;
#pragma unroll
    for (int a = 0; a < 2; ++a)
#pragma unroll
        for (int b = 0; b < 2; ++b)
#pragma unroll
            for (int r = 0; r < 16; ++r) acc[a][b][r] = 0.f;
    GC_ISSUE(0, 0);
    asm volatile("s_waitcnt vmcnt(0)" ::: "memory");
    __syncthreads();
    for (int kt = 0; kt < nkt; ++kt) {
        const int st = kt & 1;
        if (kt + 1 < nkt) GC_ISSUE(kt + 1, st ^ 1);
        LAS unsigned char* const base = F.lds + st * 32768;
#pragma unroll
        for (int s = 0; s < 4; ++s) {
            const bf16x8 a0 = *(const LAS bf16x8*)(base + bn0 + so[s]);
            const bf16x8 a1 = *(const LAS bf16x8*)(base + bn0 + 4096 + so[s]);
            const bf16x8 b0 = *(const LAS bf16x8*)(base + bm0 + so[s]);
            const bf16x8 b1 = *(const LAS bf16x8*)(base + bm0 + 4096 + so[s]);
            acc[0][0] = MFMA32(a0, b0, acc[0][0]);
            acc[0][1] = MFMA32(a0, b1, acc[0][1]);
            acc[1][0] = MFMA32(a1, b0, acc[1][0]);
            acc[1][1] = MFMA32(a1, b1, acc[1][1]);
        }
        asm volatile("s_waitcnt vmcnt(0)" ::: "memory");
        __syncthreads();
    }
#undef GC_ISSUE
}
__device__ __forceinline__ int crow(int r, int h) { return (r & 3) + 8 * (r >> 2) + 4 * h; }

__device__ __forceinline__ void rope64_regs(float (&v)[2][16], const f32x2* tab, int h) {
#pragma unroll
    for (int nt = 0; nt < 2; ++nt)
#pragma unroll
        for (int g = 0; g < 2; ++g) {
            const f32x4* tp = (const f32x4*)(tab + nt * 16 + 8 * g + 4 * h);
            const f32x4 t0 = tp[0], t1 = tp[1];
            const float cs[4] = {t0[0], t0[2], t1[0], t1[2]}, sn[4] = {t0[1], t0[3], t1[1], t1[3]};
#pragma unroll
            for (int i = 0; i < 4; ++i) {
                const int r = 4 * g + i;
                const float x0 = v[nt][r], x1 = v[nt][r + 8];
                v[nt][r] = x0 * cs[i] - x1 * sn[i];
                v[nt][r + 8] = x1 * cs[i] + x0 * sn[i];
            }
        }
}
__device__ __forceinline__ void rope32_regs(float (&x)[16], const f32x2* tab, int h) {
#pragma unroll
    for (int g = 0; g < 2; ++g) {
        const f32x4* tp = (const f32x4*)(tab + 8 * g + 4 * h);
        const f32x4 t0 = tp[0], t1 = tp[1];
        const float cs[4] = {t0[0], t0[2], t1[0], t1[2]}, sn[4] = {t0[1], t0[3], t1[1], t1[3]};
#pragma unroll
        for (int i = 0; i < 4; ++i) {
            const int r = 8 * g + i;
            const float x0 = x[r], x1 = x[r + 4];
            x[r] = x0 * cs[i] - x1 * sn[i];
            x[r + 4] = x1 * cs[i] + x0 * sn[i];
        }
    }
}
__device__ __forceinline__ float ssq64(const float (&v)[2][16]) {
    float s = 0.f;
#pragma unroll
    for (int nt = 0; nt < 2; ++nt)
#pragma unroll
        for (int r = 0; r < 16; ++r) s += v[nt][r] * v[nt][r];
    s += __shfl_xor(s, 32);
    return s;
}
__device__ __forceinline__ void mulvec64(float (&v)[2][16], const float* gv, int h) {
#pragma unroll
    for (int nt = 0; nt < 2; ++nt)
#pragma unroll
        for (int g = 0; g < 4; ++g) {
            const f32x4 q = *(const f32x4*)(gv + 32 * nt + 8 * g + 4 * h);
#pragma unroll
            for (int i = 0; i < 4; ++i) v[nt][4 * g + i] *= q[i];
        }
}
__device__ __forceinline__ void store_bf16_64(bf16_t* dst, const float (&v)[2][16], float sc, int h) {
#pragma unroll
    for (int nt = 0; nt < 2; ++nt)
#pragma unroll
        for (int g = 0; g < 4; ++g) {
            u32x2 o; o.x = pk2(v[nt][4 * g] * sc, v[nt][4 * g + 1] * sc); o.y = pk2(v[nt][4 * g + 2] * sc, v[nt][4 * g + 3] * sc);
            *(u32x2*)(dst + 32 * nt + 8 * g + 4 * h) = o;
        }
}
__device__ __forceinline__ void store_f32_64(float* dst, const float (&v)[2][16], int h) {
#pragma unroll
    for (int nt = 0; nt < 2; ++nt)
#pragma unroll
        for (int g = 0; g < 4; ++g) {
            f32x4 o = {v[nt][4 * g], v[nt][4 * g + 1], v[nt][4 * g + 2], v[nt][4 * g + 3]};
            *(f32x4*)(dst + 32 * nt + 8 * g + 4 * h) = o;
        }
}

__device__ __forceinline__ void epi_gemm1(const Frame& F, const Params& p, f32x16 (&acc)[2][2], int tn, int tm, int l) {
    int h = F.h, lq = F.lq; const int wn = F.w & 1, wm = F.w >> 1;
    asm volatile("" : "+v"(h), "+v"(lq));
    unsigned char* ws = F.ws;
    const bool lat = tm >= 32;
    const int b = lat ? ((tm - 32) >> 3) : (tm >> 1);
    const int cond = lat ? 1 + b : 0;
    const int nb = tn * 128 + wn * 64;
    const float* bias = (const float*)(ws + WS_BIAS) + (size_t)(l * 5 + cond) * 2944 + nb;
    const float* ssqp = (const float*)(ws + WS_SSQ);
    float* outp = p.out;
    float ckv_ss[2];
#pragma unroll
    for (int mt = 0; mt < 2; ++mt) {
        __builtin_amdgcn_sched_barrier(0);
        const int tok = tm * 128 + wm * 64 + mt * 32 + lq;
        const int t = lat ? ((tok - 4096) & 1023) : (tok & 255);
        float ss = 0.f;
        { const f32x4* sp = (const f32x4*)(ssqp + (size_t)tok * 16);
#pragma unroll
          for (int i = 0; i < 4; ++i) { const f32x4 q = sp[i]; ss += (q[0] + q[1]) + (q[2] + q[3]); } }
        const float rstd = rsqrtf(ss * (1.f / 1024.f) + EPS);
        float v[2][16];
#pragma unroll
        for (int nt = 0; nt < 2; ++nt)
#pragma unroll
            for (int g = 0; g < 4; ++g) {
                const f32x4 bq = *(const f32x4*)(bias + 32 * nt + 8 * g + 4 * h);
#pragma unroll
                for (int i = 0; i < 4; ++i) v[nt][4 * g + i] = acc[nt][mt][4 * g + i] * rstd + bq[i];
            }
        __builtin_amdgcn_sched_barrier(0);
        const f32x2* r64 = (const f32x2*)(ws + WS_ROPE64) + (size_t)t * 32;
        const size_t orow = (size_t)(b * 4 + l) * 256 + t;
        if (tn < 2) {
            if (lat) rope64_regs(v, r64, h);
            store_bf16_64((bf16_t*)(ws + WS_RQ) + (size_t)tok * 256 + nb, v, 1.f, h);
        } else if (tn < 4) {
            if (lat) rope64_regs(v, r64, h);
            store_bf16_64((bf16_t*)(ws + WS_RK) + (size_t)tok * 256 + (nb - 256), v, 0.125f, h);
        } else if (tn < 6) {
            store_bf16_64((bf16_t*)(ws + WS_RV) + (size_t)tok * 256 + (nb - 512), v, 1.f, h);
        } else if (tn < 9) {
            const float r = rsqrtf(ssq64(v) * (1.f / 64.f) + EPS);
#pragma unroll
            for (int nt = 0; nt < 2; ++nt)
#pragma unroll
                for (int i = 0; i < 16; ++i) v[nt][i] *= r;
            mulvec64(v, p.in[I_GQN] + l * 64, h);
            if (lat) rope64_regs(v, r64, h);
            store_bf16_64((bf16_t*)(ws + WS_GQ) + (size_t)tok * 384 + (nb - 768), v, QSC_GQA, h);
        } else if (tn == 9) {
            const float r = rsqrtf(ssq64(v) * (1.f / 64.f) + EPS);
#pragma unroll
            for (int nt = 0; nt < 2; ++nt)
#pragma unroll
                for (int i = 0; i < 16; ++i) v[nt][i] *= r;
            mulvec64(v, p.in[I_GKN] + l * 64, h);
            if (lat) rope64_regs(v, r64, h); else store_f32_64(outp + O_GK + orow * 128 + (nb - 1152), v, h);
            store_bf16_64((bf16_t*)(ws + WS_GK) + (size_t)tok * 128 + (nb - 1152), v, 1.f, h);
        } else if (tn == 10) {
            if (!lat) store_f32_64(outp + O_GV + orow * 128 + (nb - 1280), v, h);
            store_bf16_64((bf16_t*)(ws + WS_GV) + (size_t)tok * 128 + (nb - 1280), v, 1.f, h);
        } else if (tn < 13) {
            const float s = ssq64(v);
            if (h == 0) ((float*)(ws + WS_CQSSQ))[(size_t)tok * 4 + ((nb - 1408) >> 6)] = s;
            mulvec64(v, p.in[I_MQN] + l * 256 + (nb - 1408), h);
            store_bf16_64((bf16_t*)(ws + WS_CQG) + (size_t)tok * 256 + (nb - 1408), v, 1.f, h);
        } else if (tn == 13) {
            ckv_ss[mt] = ssq64(v);
            if (h == 0) ((LAS float*)(F.lds + LDS_EX))[(wm * 2 + wn) * 64 + mt * 32 + lq] = ckv_ss[mt];
        } else if (tn < 22) {
#pragma unroll
            for (int nt = 0; nt < 2; ++nt)
#pragma unroll
                for (int i = 0; i < 16; ++i) v[nt][i] = silu_f(v[nt][i]);
            store_bf16_64((bf16_t*)(ws + WS_ZS) + (size_t)tok * 1024 + (nb - 1792), v, 1.f, h);
        } else {
            if (wn == 0) {
                if (lat) rope32_regs(v[0], (const f32x2*)(ws + WS_ROPE32) + (size_t)t * 16, h);
#pragma unroll
                for (int g = 0; g < 4; ++g) {
                    if (!lat) { f32x4 o = {v[0][4 * g], v[0][4 * g + 1], v[0][4 * g + 2], v[0][4 * g + 3]}; *(f32x4*)(outp + O_KPE + orow * 32 + 8 * g + 4 * h) = o; }
                    u32x2 o2; o2.x = pk2(v[0][4 * g], v[0][4 * g + 1]); o2.y = pk2(v[0][4 * g + 2], v[0][4 * g + 3]);
                    *(u32x2*)((bf16_t*)(ws + WS_KPEB) + (size_t)tok * 32 + 8 * g + 4 * h) = o2;
                }
            }
        }
    }
    if (tn == 13) {
        __syncthreads();
#pragma unroll
        for (int mt = 0; mt < 2; ++mt) {
            const int tok = tm * 128 + wm * 64 + mt * 32 + lq;
            const int t = lat ? ((tok - 4096) & 1023) : (tok & 255);
            float ss = 0.f;
            { const f32x4* sp = (const f32x4*)(ssqp + (size_t)tok * 16);
#pragma unroll
              for (int i = 0; i < 4; ++i) { const f32x4 q = sp[i]; ss += (q[0] + q[1]) + (q[2] + q[3]); } }
            const float rstd = rsqrtf(ss * (1.f / 1024.f) + EPS);
            float v[2][16];
#pragma unroll
            for (int nt = 0; nt < 2; ++nt)
#pragma unroll
                for (int g = 0; g < 4; ++g) {
                    const f32x4 bq = *(const f32x4*)(bias + 32 * nt + 8 * g + 4 * h);
#pragma unroll
                    for (int i = 0; i < 4; ++i) v[nt][4 * g + i] = acc[nt][mt][4 * g + i] * rstd + bq[i];
                }
            const float tot = ckv_ss[mt] + ((const LAS float*)(F.lds + LDS_EX))[(wm * 2 + (wn ^ 1)) * 64 + mt * 32 + lq];
            const float r = rsqrtf(tot * (1.f / 128.f) + EPS);
#pragma unroll
            for (int nt = 0; nt < 2; ++nt)
#pragma unroll
                for (int i = 0; i < 16; ++i) v[nt][i] *= r;
            mulvec64(v, p.in[I_MKVN] + l * 128 + wn * 64, h);
            const size_t orow = (size_t)(b * 4 + l) * 256 + t;
            if (!lat) store_f32_64(outp + O_CKV + orow * 128 + wn * 64, v, h);
            store_bf16_64((bf16_t*)(ws + WS_CKVN) + (size_t)tok * 128 + wn * 64, v, 1.f, h);
        }
        __syncthreads();
    }
}

__device__ __forceinline__ void epi_qm(const Frame& F, f32x16 (&acc)[2][2], int tn, int tm) {
    int h = F.h, lq = F.lq; const int wn = F.w & 1, wm = F.w >> 1;
    asm volatile("" : "+v"(h), "+v"(lq));
    unsigned char* ws = F.ws;
    const bool lat = tm >= 32;
    const int nb = tn * 128 + wn * 64;
#pragma unroll
    for (int mt = 0; mt < 2; ++mt) {
        const int tok = tm * 128 + wm * 64 + mt * 32 + lq;
        const int t = lat ? ((tok - 4096) & 1023) : (tok & 255);
        const f32x4 q4 = *(const f32x4*)((const float*)(ws + WS_CQSSQ) + (size_t)tok * 4);
        const float rstd = rsqrtf(((q4[0] + q4[1]) + (q4[2] + q4[3])) * (1.f / 256.f) + EPS);
#pragma unroll
        for (int nt = 0; nt < 2; ++nt) {
            const int n0 = nb + 32 * nt;
            if (n0 < 576) {
                float x[16];
#pragma unroll
                for (int i = 0; i < 16; ++i) x[i] = acc[nt][mt][i] * rstd;
                const int T = n0 >> 5;
                if (lat && (T % 3) == 2) rope32_regs(x, (const f32x2*)(ws + WS_ROPE32) + (size_t)t * 16, h);
                bf16_t* dst = (bf16_t*)(ws + WS_QM) + (size_t)tok * 576 + n0;
#pragma unroll
                for (int g = 0; g < 4; ++g) {
                    u32x2 o; o.x = pk2(x[4 * g] * QSC_MLA, x[4 * g + 1] * QSC_MLA); o.y = pk2(x[4 * g + 2] * QSC_MLA, x[4 * g + 3] * QSC_MLA);
                    *(u32x2*)(dst + 8 * g + 4 * h) = o;
                }
            }
        }
    }
}
__device__ __forceinline__ void epi_plain(const Frame& F, f32x16 (&acc)[2][2], bf16_t* D, int ldd, int row0, int n0) {
    int h = F.h, lq = F.lq; const int wn = F.w & 1, wm = F.w >> 1;
    asm volatile("" : "+v"(h), "+v"(lq));
#pragma unroll
    for (int mt = 0; mt < 2; ++mt) {
        const int row = row0 + wm * 64 + mt * 32 + lq;
        float v[2][16];
#pragma unroll
        for (int nt = 0; nt < 2; ++nt)
#pragma unroll
            for (int i = 0; i < 16; ++i) v[nt][i] = acc[nt][mt][i];
        store_bf16_64(D + (size_t)row * ldd + n0 + wn * 64, v, 1.f, h);
    }
}

__device__ __forceinline__ void epi_gemm2(const Frame& F, const Params& p, f32x16 (&acc)[2][2], int tn, int tm, int l) {
    int h = F.h, lq = F.lq; const int wn = F.w & 1, wm = F.w >> 1;
    asm volatile("" : "+v"(h), "+v"(lq));
    unsigned char* ws = F.ws;
    const bool lat = tm >= 32;
    const int b = lat ? ((tm - 32) >> 3) : (tm >> 1);
    const int cond = lat ? 1 + b : 0;
    const int nb = tn * 128 + wn * 64;
    const float* gate = (const float*)(ws + WS_MODS) + (size_t)(l * 5 + cond) * 3072 + 2048 + nb;
    const float* gs = (const float*)(ws + WS_GS) + (size_t)((l < 3 ? l + 1 : 3) * 5 + cond) * 1024 + nb;
#pragma unroll
    for (int mt = 0; mt < 2; ++mt) {
        const int tok = tm * 128 + wm * 64 + mt * 32 + lq;
        const float* xold = (l == 0) ? (lat ? p.in[I_XS] + (size_t)(tok - 4096) * 1024 : p.in[I_XP] + (size_t)tok * 1024) : p.xs + (size_t)tok * 1024;
        float* xnew = p.xs + (size_t)tok * 1024 + nb;
        xold += nb;
        float v[2][16];
        float ss = 0.f;
#pragma unroll
        for (int nt = 0; nt < 2; ++nt)
#pragma unroll
            for (int g = 0; g < 4; ++g) {
                const int o = 32 * nt + 8 * g + 4 * h;
                const f32x4 xo = *(const f32x4*)(xold + o), gt = *(const f32x4*)(gate + o);
                f32x4 xn;
#pragma unroll
                for (int i = 0; i < 4; ++i) { xn[i] = xo[i] + gt[i] * acc[nt][mt][4 * g + i]; ss += xn[i] * xn[i]; v[nt][4 * g + i] = xn[i]; }
                *(f32x4*)(xnew + o) = xn;
            }
        ss += __shfl_xor(ss, 32);
        if (h == 0) ((float*)(ws + WS_SSQ))[(size_t)tok * 16 + tn * 2 + wn] = ss;
        if (l < 3) {
            mulvec64(v, gs, h);
            store_bf16_64((bf16_t*)(ws + WS_XG) + (size_t)tok * 1024 + nb, v, 1.f, h);
        }
    }
}
constexpr int AT_STG = 20480, AT_PE = 8192, AT_V = 12288, AT_OLD = 68;
struct AttnUnit {
    int mode;
    int nt0, nt1;
    const bf16_t *q; int q_ld;
    const bf16_t *k0, *k1; int k_ld0, k_ld1;
    const bf16_t *pe0, *pe1;
    const bf16_t *v0, *v1; int v_ld0, v_ld1;
    int tok0;
    int ycol;
    int qpos0, L;
    float lf, lb;
    const bf16_t *s0f, *s0b;
    float* st_out;
};
__device__ __forceinline__ s16x4 tr16(LAS const unsigned char* p) {
    typedef short v4i16_t __attribute__((ext_vector_type(4)));
    return __builtin_bit_cast(s16x4, __builtin_amdgcn_ds_read_tr16_b64_v4i16((LAS v4i16_t*)p));
}

template <int MODE>
__device__ __forceinline__ void attn_unit(const Frame& F, const Params& p, const AttnUnit& U) {
    constexpr int NQS = MODE == 1 ? 6 : 4;
    const int lane = F.lane, w = F.w, h = F.h, lq = F.lq;
    LAS unsigned char* lds = F.lds;
    const int k_ld = U.k_ld1, v_ld = U.v_ld1;
    int koff[2];
#pragma unroll
    for (int g = 0; g < 2; ++g) {
        const int row = 16 * w + 8 * g + (lane >> 3), c = (lane & 7) ^ ((row >> 1) & 7);
        koff[g] = row * k_ld + c * 8;
    }
    const int poff = (16 * w + (lane >> 2)) * 32 + ((lane & 3) ^ ((lane >> 4) & 3)) * 8;
    int voff[2], vdst[2];
#pragma unroll
    for (int i = 0; i < 2; ++i) {
        const int ii = 2 * w + i, dblk = ii >> 2, kg = ii & 3, row = 16 * kg + (lane >> 2);
        voff[i] = row * v_ld + dblk * 32 + (lane & 3) * 8;
        vdst[i] = AT_V + dblk * 4096 + kg * 1024;
    }
    const int nt0 = U.nt0, ntot = U.nt0 + U.nt1;
#define AT_ISSUE(t, st) do { const int _t = (t); LAS unsigned char* _b = lds + (st) * AT_STG; \
        const bool _s0 = _t < nt0; const int _u = _s0 ? _t : _t - nt0; \
        const bf16_t* _kb = (_s0 ? U.k0 : U.k1) + (size_t)_u * 64 * k_ld; const bf16_t* _vb = (_s0 ? U.v0 : U.v1) + (size_t)_u * 64 * v_ld; \
        _Pragma("unroll") for (int g = 0; g < 2; ++g) GLDS16(_kb + koff[g], _b + (16 * w + 8 * g) * 128); \
        if (MODE == 1) { const bf16_t* _pb = (_s0 ? U.pe0 : U.pe1) + (size_t)_u * 64 * 32; GLDS16(_pb + poff, _b + AT_PE + 16 * w * 64); } \
        _Pragma("unroll") for (int i = 0; i < 2; ++i) GLDS16(_vb + voff[i], _b + vdst[i]); } while (0)
    AT_ISSUE(0, 0);
    bf16x8 qr[NQS];
    if (MODE == 3) {
        const int dk = 32 * (w & 1) + lq;
#pragma unroll
        for (int s = 0; s < 4; ++s)
#pragma unroll
            for (int j = 0; j < 8; ++j) qr[s][j] = (16 * s + 8 * h + j == dk) ? (short)0x3F80 : (short)0;
    } else {
        const bf16_t* qp = U.q + (size_t)(32 * w + lq) * U.q_ld + 8 * h;
#pragma unroll
        for (int s = 0; s < NQS; ++s) qr[s] = *(const bf16x8*)(qp + 16 * s);
    }
    f32x16 o[2];
#pragma unroll
    for (int d = 0; d < 2; ++d)
#pragma unroll
        for (int r = 0; r < 16; ++r) o[d][r] = 0.f;
    float m_run = -1e30f, l_run = 0.f;
    const int qpos = U.qpos0 + 32 * w + lq;
    const int sdir = w >> 1;
    LAS float* scal = (LAS float*)(lds + LDS_SCAL) + w * 32;
    const int kfo = lq * 128, sw = (lane >> 1) & 7, pfo = AT_PE + lq * 64, psw = (lane >> 2) & 3;
    const int vfo = AT_V + (4 * h + ((lane & 15) >> 2)) * 64 + ((lane >> 4) & 1) * 32 + (lane & 3) * 8;
    for (int t = 0; t < ntot; ++t) {
        asm volatile("s_waitcnt vmcnt(0)" ::: "memory");
        __syncthreads();
        const int st = t & 1;
        if (t + 1 < ntot) AT_ISSUE(t + 1, st ^ 1);
        LAS const unsigned char* base = lds + st * AT_STG;
        f32x16 p0, p1;
#pragma unroll
        for (int r = 0; r < 16; ++r) { p0[r] = 0.f; p1[r] = 0.f; }
#pragma unroll
        for (int s = 0; s < 4; ++s) {
            const int so = ((2 * s + h) ^ sw) << 4;
            const bf16x8 ka = *(const LAS bf16x8*)(base + kfo + so);
            const bf16x8 kb = *(const LAS bf16x8*)(base + kfo + 4096 + so);
            p0 = MFMA32(ka, qr[s], p0);
            p1 = MFMA32(kb, qr[s], p1);
        }
        if (MODE == 1) {
#pragma unroll
            for (int s = 0; s < 2; ++s) {
                const int so = ((2 * s + h) ^ psw) << 4;
                const bf16x8 ka = *(const LAS bf16x8*)(base + pfo + so);
                const bf16x8 kb = *(const LAS bf16x8*)(base + pfo + 2048 + so);
                p0 = MFMA32(ka, qr[4 + s], p0);
                p1 = MFMA32(kb, qr[4 + s], p1);
            }
        }
        __builtin_amdgcn_sched_barrier(0);
        if (MODE <= 1) {
            float tm = p0[0];
#pragma unroll
            for (int r = 1; r < 16; ++r) tm = fmaxf(tm, p0[r]);
#pragma unroll
            for (int r = 0; r < 16; ++r) tm = fmaxf(tm, p1[r]);
            tm = fmaxf(tm, __shfl_xor(tm, 32));
            if (__any(tm > m_run + 6.0f)) {
                const float mn = fmaxf(m_run, tm);
                const float alpha = __builtin_amdgcn_exp2f(m_run - mn);
                m_run = mn; l_run *= alpha;
                if (h == 0) scal[lq] = alpha;
                asm volatile("s_waitcnt lgkmcnt(0)" ::: "memory");
#pragma unroll
                for (int g = 0; g < 4; ++g) {
                    const f32x4 a4 = *(const LAS f32x4*)(scal + 8 * g + 4 * h);
#pragma unroll
                    for (int i = 0; i < 4; ++i) { o[0][4 * g + i] *= a4[i]; o[1][4 * g + i] *= a4[i]; }
                }
            }
            float ls = 0.f;
#pragma unroll
            for (int r = 0; r < 16; ++r) { p0[r] = __builtin_amdgcn_exp2f(p0[r] - m_run); p1[r] = __builtin_amdgcn_exp2f(p1[r] - m_run); ls += p0[r] + p1[r]; }
            l_run += ls;
        } else if (MODE == 2) {
            const float dq = (float)(qpos - 64 * t - 4 * h);
#pragma unroll
            for (int r = 0; r < 16; ++r) {
                const float d0 = dq - (float)((r & 3) + 8 * (r >> 2)), d1 = d0 - 32.f;
                const float w0 = __builtin_amdgcn_exp2f(fabsf(d0) * (d0 > 0.f ? U.lf : U.lb));
                const float w1 = __builtin_amdgcn_exp2f(fabsf(d1) * (d1 > 0.f ? U.lf : U.lb));
                p0[r] *= (d0 == 0.f ? 2.f : w0);
                p1[r] *= (d1 == 0.f ? 2.f : w1);
            }
        } else {
            const float mb = (float)(64 * t + 4 * h);
#pragma unroll
            for (int r = 0; r < 16; ++r) {
                const float m0 = mb + (float)((r & 3) + 8 * (r >> 2)), m1 = m0 + 32.f;
                const float e0 = sdir ? m0 * U.lb : (255.f - m0) * U.lf, e1 = sdir ? m1 * U.lb : (255.f - m1) * U.lf;
                p0[r] *= __builtin_amdgcn_exp2f(e0);
                p1[r] *= __builtin_amdgcn_exp2f(e1);
            }
        }
        __builtin_amdgcn_sched_barrier(0);
        bf16x8 pa[4];
        { u32x4 a;
          a.x = pk2(p0[0], p0[1]); a.y = pk2(p0[2], p0[3]); a.z = pk2(p0[4], p0[5]); a.w = pk2(p0[6], p0[7]); pa[0] = __builtin_bit_cast(bf16x8, a);
          a.x = pk2(p0[8], p0[9]); a.y = pk2(p0[10], p0[11]); a.z = pk2(p0[12], p0[13]); a.w = pk2(p0[14], p0[15]); pa[1] = __builtin_bit_cast(bf16x8, a);
          a.x = pk2(p1[0], p1[1]); a.y = pk2(p1[2], p1[3]); a.z = pk2(p1[4], p1[5]); a.w = pk2(p1[6], p1[7]); pa[2] = __builtin_bit_cast(bf16x8, a);
          a.x = pk2(p1[8], p1[9]); a.y = pk2(p1[10], p1[11]); a.z = pk2(p1[12], p1[13]); a.w = pk2(p1[14], p1[15]); pa[3] = __builtin_bit_cast(bf16x8, a); }
#pragma unroll
        for (int d = 0; d < 2; ++d)
#pragma unroll
            for (int ks = 0; ks < 4; ++ks) {
                const s16x4 lo = tr16(base + vfo + d * 4096 + ks * 1024), hi = tr16(base + vfo + d * 4096 + ks * 1024 + 512);
                const bf16x8 vb = {lo[0], lo[1], lo[2], lo[3], hi[0], hi[1], hi[2], hi[3]};
                o[d] = MFMA32(pa[ks], vb, o[d]);
            }
    }
#undef AT_ISSUE
    int lq2 = lq, h2 = h, lane2 = lane; asm volatile("" : "+v"(lq2), "+v"(h2), "+v"(lane2));
    if (MODE == 2 && U.s0f != nullptr) {
        const float ff = __builtin_amdgcn_exp2f((float)(qpos + 1) * U.lf), fb = __builtin_amdgcn_exp2f((float)(U.L - qpos) * U.lb);
#pragma unroll
        for (int s = 0; s < 4; ++s) {
            const u32x4 qu = __builtin_bit_cast(u32x4, qr[s]);
            u32x4 af, ab;
#pragma unroll
            for (int i = 0; i < 4; ++i) { const float lo = bflo(qu[i]), hi = bfhi(qu[i]); af[i] = pk2(lo * ff, hi * ff); ab[i] = pk2(lo * fb, hi * fb); }
#pragma unroll
            for (int d = 0; d < 2; ++d) {
                const bf16x8 sf = *(const bf16x8*)(U.s0f + (size_t)(32 * d + lq2) * 64 + 16 * s + 8 * h2);
                const bf16x8 sb = *(const bf16x8*)(U.s0b + (size_t)(32 * d + lq2) * 64 + 16 * s + 8 * h2);
                o[d] = MFMA32(__builtin_bit_cast(bf16x8, af), sf, o[d]);
                o[d] = MFMA32(__builtin_bit_cast(bf16x8, ab), sb, o[d]);
            }
        }
    }
    if (MODE == 3) {
        float* dst = U.st_out + (size_t)sdir * 4 * 4096 + (size_t)(32 * (w & 1)) * 64;
#pragma unroll
        for (int d = 0; d < 2; ++d)
#pragma unroll
            for (int r = 0; r < 16; ++r) dst[(size_t)((r & 3) + 8 * (r >> 2) + 4 * h2) * 64 + 32 * d + lq2] = o[d][r];
        __syncthreads();
        return;
    }
    if (MODE <= 1) {
        l_run += __shfl_xor(l_run, 32);
        if (h2 == 0) scal[lq2] = 1.f / l_run;
    }
    __syncthreads();
    LAS float* ost = (LAS float*)lds + w * (32 * AT_OLD);
#pragma unroll
    for (int d = 0; d < 2; ++d)
#pragma unroll
        for (int r = 0; r < 16; ++r) ost[((r & 3) + 8 * (r >> 2) + 4 * h2) * AT_OLD + 32 * d + lq2] = o[d][r];
    asm volatile("s_waitcnt lgkmcnt(0)" ::: "memory");
    __builtin_amdgcn_wave_barrier();
    const bf16_t* zs = (const bf16_t*)(F.ws + WS_ZS);
    bf16_t* yb = (bf16_t*)(F.ws + WS_Y);
#pragma unroll
    for (int it = 0; it < 4; ++it) {
        const int row = it * 8 + (lane2 >> 3), c8 = (lane2 & 7) * 8;
        const f32x4 x0 = *(const LAS f32x4*)(ost + row * AT_OLD + c8), x1 = *(const LAS f32x4*)(ost + row * AT_OLD + c8 + 4);
        float sc;
        if (MODE <= 1) sc = scal[row];
        else {
            float ss = (x0[0] * x0[0] + x0[1] * x0[1]) + (x0[2] * x0[2] + x0[3] * x0[3]) + (x1[0] * x1[0] + x1[1] * x1[1]) + (x1[2] * x1[2] + x1[3] * x1[3]);
            ss += __shfl_xor(ss, 1); ss += __shfl_xor(ss, 2); ss += __shfl_xor(ss, 4);
            sc = rsqrtf(ss * (1.f / 64.f) + EPS);
        }
        const size_t off = (size_t)(U.tok0 + 32 * w + row) * 1024 + U.ycol + c8;
        const u32x4 z = *(const u32x4*)(zs + off);
        u32x4 y;
        y.x = pk2(x0[0] * sc * bflo(z.x), x0[1] * sc * bfhi(z.x));
        y.y = pk2(x0[2] * sc * bflo(z.y), x0[3] * sc * bfhi(z.y));
        y.z = pk2(x1[0] * sc * bflo(z.z), x1[1] * sc * bfhi(z.z));
        y.w = pk2(x1[2] * sc * bflo(z.w), x1[3] * sc * bfhi(z.w));
        *(u32x4*)(yb + off) = y;
    }
    __syncthreads();
}

__device__ __forceinline__ void attn_dispatch(const Frame& F, const Params& p, int u, int l) {
    unsigned char* ws = F.ws;
    AttnUnit U;
    U.nt0 = 0; U.nt1 = 0; U.q = nullptr; U.q_ld = 0; U.k0 = U.k1 = nullptr; U.k_ld0 = U.k_ld1 = 0; U.pe0 = U.pe1 = nullptr; U.v0 = U.v1 = nullptr; U.v_ld0 = U.v_ld1 = 0;
    U.tok0 = 0; U.ycol = 0; U.qpos0 = 0; U.L = 0; U.lf = U.lb = 0.f; U.s0f = U.s0b = nullptr; U.st_out = nullptr; U.mode = 0;
    const bf16_t* GQ = (const bf16_t*)(ws + WS_GQ); const bf16_t* GK = (const bf16_t*)(ws + WS_GK); const bf16_t* GV = (const bf16_t*)(ws + WS_GV);
    const bf16_t* QM = (const bf16_t*)(ws + WS_QM); const bf16_t* KVM = (const bf16_t*)(ws + WS_KVM); const bf16_t* KVMC = (const bf16_t*)(ws + WS_KVMC);
    const bf16_t* KPEB = (const bf16_t*)(ws + WS_KPEB); const bf16_t* CKPE = (const bf16_t*)(ws + WS_CKPE);
    const bf16_t* CGK = (const bf16_t*)(ws + WS_CGK); const bf16_t* CGV = (const bf16_t*)(ws + WS_CGV);
    const bf16_t* RQ = (const bf16_t*)(ws + WS_RQ); const bf16_t* RK = (const bf16_t*)(ws + WS_RK); const bf16_t* RV = (const bf16_t*)(ws + WS_RV);
    const float* decay = p.in[I_DECAY] + l * 8;
    if (u < 192 || (u >= 512 && u < 704)) {
        const bool lat = u < 192; const int uu = lat ? u : u - 512;
        const int b = lat ? uu / 48 : uu / 12, hh = lat ? (uu >> 3) % 6 : (uu >> 1) % 6, qb = lat ? (uu & 7) : (uu & 1);
        const int seq0 = lat ? 4096 + b * 1024 : b * 256;
        U.mode = 1; U.tok0 = seq0 + qb * 128; U.q = QM + (size_t)U.tok0 * 576 + hh * 96; U.q_ld = 576; U.ycol = 640 + hh * 64;
        U.nt1 = lat ? 16 : 4; U.k1 = KVM + (size_t)seq0 * 768 + hh * 128; U.k_ld1 = 768; U.v1 = U.k1 + 64; U.v_ld1 = 768; U.pe1 = KPEB + (size_t)seq0 * 32;
        U.k0 = U.k1; U.v0 = U.v1; U.pe0 = U.pe1; U.k_ld0 = 768; U.v_ld0 = 768;
        if (lat) { U.nt0 = 8; U.k0 = KVMC + (size_t)(b * 512) * 768 + hh * 128; U.v0 = U.k0 + 64; U.pe0 = CKPE + (size_t)((b * 4 + l) * 512) * 32; }
        attn_unit<1>(F, p, U);
    } else if (u < 384 || (u >= 704 && u < 896)) {
        const bool lat = u < 384; const int uu = lat ? u - 192 : u - 704;
        const int b = lat ? uu / 48 : uu / 12, hh = lat ? (uu >> 3) % 6 : (uu >> 1) % 6, qb = lat ? (uu & 7) : (uu & 1), kvh = hh / 3;
        const int seq0 = lat ? 4096 + b * 1024 : b * 256;
        U.mode = 0; U.tok0 = seq0 + qb * 128; U.q = GQ + (size_t)U.tok0 * 384 + hh * 64; U.q_ld = 384; U.ycol = 256 + hh * 64;
        U.nt1 = lat ? 16 : 4; U.k1 = GK + (size_t)seq0 * 128 + kvh * 64; U.k_ld1 = 128; U.v1 = GV + (size_t)seq0 * 128 + kvh * 64; U.v_ld1 = 128;
        U.k0 = U.k1; U.v0 = U.v1; U.k_ld0 = 128; U.v_ld0 = 128;
        if (lat) { U.nt0 = 8; U.k0 = CGK + (size_t)((b * 4 + l) * 512) * 128 + kvh * 64; U.v0 = CGV + (size_t)((b * 4 + l) * 512) * 128 + kvh * 64; }
        attn_unit<0>(F, p, U);
    } else if (u < 512 || (u >= 896 && u < 1024)) {
        const bool lat = u < 512; const int uu = lat ? u - 384 : u - 896;
        const int b = lat ? uu / 32 : uu / 8, hh = lat ? (uu >> 3) & 3 : (uu >> 1) & 3, qb = lat ? (uu & 7) : (uu & 1);
        const int seq0 = lat ? 4096 + b * 1024 : b * 256;
        U.mode = 2; U.tok0 = seq0 + qb * 128; U.q = RQ + (size_t)U.tok0 * 256 + hh * 64; U.q_ld = 256; U.ycol = hh * 64;
        U.nt1 = lat ? 16 : 4; U.k1 = RK + (size_t)seq0 * 256 + hh * 64; U.k_ld1 = 256; U.v1 = RV + (size_t)seq0 * 256 + hh * 64; U.v_ld1 = 256;
        U.k0 = U.k1; U.v0 = U.v1; U.k_ld0 = 256; U.v_ld0 = 256;
        U.qpos0 = qb * 128; U.L = lat ? 1024 : 256;
        U.lf = -log1pf(__expf(-decay[hh])) * LOG2E; U.lb = -log1pf(__expf(-decay[4 + hh])) * LOG2E;
        if (lat) { const bf16_t* S0T = (const bf16_t*)(ws + WS_S0T); U.s0f = S0T + (size_t)(((b * 4 + l) * 2 + 0) * 4 + hh) * 4096; U.s0b = S0T + (size_t)(((b * 4 + l) * 2 + 1) * 4 + hh) * 4096; }
        attn_unit<2>(F, p, U);
    } else {
        const int uu = u - 1024, b = uu >> 2, hh = uu & 3, seq0 = b * 256;
        U.mode = 3; U.nt1 = 4; U.k1 = RK + (size_t)seq0 * 256 + hh * 64; U.k_ld1 = 256; U.v1 = RV + (size_t)seq0 * 256 + hh * 64; U.v_ld1 = 256;
        U.k0 = U.k1; U.v0 = U.v1; U.k_ld0 = 256; U.v_ld0 = 256;
        U.lf = -log1pf(__expf(-decay[hh])) * LOG2E; U.lb = -log1pf(__expf(-decay[4 + hh])) * LOG2E;
        U.st_out = p.out + O_STATE + (size_t)(((b * 4 + l) * 2 + 0) * 4 + hh) * 4096;
        attn_unit<3>(F, p, U);
    }
}
constexpr int N_ATTN_UNITS = 1088;
__device__ __forceinline__ void p0_transpose_item(const float* W, int K, int Nsrc, int src_n0, bf16_t* WT, int dest_row0, int k0, LAS float* scr, int lane) {
    if (src_n0 >= 0) {
#pragma unroll 8
        for (int i = 0; i < 32; ++i) { const int kk = 2 * i + (lane >> 5); scr[kk * 33 + (lane & 31)] = W[(size_t)(k0 + kk) * Nsrc + src_n0 + (lane & 31)]; }
    } else {
#pragma unroll 8
        for (int i = 0; i < 32; ++i) { const int kk = 2 * i + (lane >> 5); scr[kk * 33 + (lane & 31)] = 0.f; }
    }
    asm volatile("s_waitcnt lgkmcnt(0)" ::: "memory");
    __builtin_amdgcn_wave_barrier();
    const int c = lane & 7;
#pragma unroll
    for (int j = 0; j < 4; ++j) {
        const int n = (lane >> 3) + 8 * j; const LAS float* s = scr + (8 * c) * 33 + n;
        u32x4 o; o.x = pk2(s[0 * 33], s[1 * 33]); o.y = pk2(s[2 * 33], s[3 * 33]); o.z = pk2(s[4 * 33], s[5 * 33]); o.w = pk2(s[6 * 33], s[7 * 33]);
        *(u32x4*)(WT + (size_t)(dest_row0 + n) * K + k0 + 8 * c) = o;
    }
    asm volatile("s_waitcnt lgkmcnt(0)" ::: "memory");
    __builtin_amdgcn_wave_barrier();
}
__device__ __forceinline__ void cast8(const float* src, bf16_t* dst, size_t e) {
    const f32x4 a = *(const f32x4*)(src + e), b = *(const f32x4*)(src + e + 4);
    u32x4 o; o.x = pk2(a[0], a[1]); o.y = pk2(a[2], a[3]); o.z = pk2(b[0], b[1]); o.w = pk2(b[2], b[3]);
    *(u32x4*)(dst + e) = o;
}
constexpr int P0_MODS = 384, P0_TWIN = 4 * 16 * 92, P0_TWOUT = 4 * 16 * 32, P0_TWUQ = 4 * 4 * 20, P0_TWUKV = 4 * 2 * 24;
constexpr int P0_CAST_G = 2048, P0_CAST_KPE = 512, P0_S0T = 512, P0_R64 = 512, P0_R32 = 256;
constexpr int P0_TOTAL = P0_MODS + P0_TWIN + P0_TWOUT + P0_TWUQ + P0_TWUKV + 3 * P0_CAST_G + P0_CAST_KPE + P0_S0T + P0_R64 + P0_R32;
__device__ __forceinline__ void phase0(const Frame& F, const Params& p) {
    unsigned char* ws = F.ws; const int lane = F.lane;
    LAS float* scr = (LAS float*)F.lds + F.w * (64 * 33);
    const int gw = blockIdx.x * 4 + F.w, ngw = gridDim.x * 4;
    for (int it0 = gw; it0 < P0_TOTAL; it0 += ngw) {
        int it = it0;
        if (it < P0_MODS) {
            const int l = it / 96, cg = (it % 96) >> 3, ks = it & 7;
            const int j = cg * 256 + lane * 4;
            const float* wp = p.in[I_WADA] + ((size_t)l * 1024 + ks * 128) * 3072 + j;
            const float* c = p.in[I_C]; const float* cc = p.in[I_CCTX];
            f32x4 acc[5];
#pragma unroll
            for (int n = 0; n < 5; ++n) acc[n] = (f32x4){0.f, 0.f, 0.f, 0.f};
#pragma unroll 4
            for (int k = 0; k < 128; ++k) {
                const f32x4 wv = *(const f32x4*)(wp + (size_t)k * 3072);
                const int kk = ks * 128 + k;
                acc[0] += wv * silu_f(cc[kk]);
#pragma unroll
                for (int n = 1; n < 5; ++n) acc[n] += wv * silu_f(c[(n - 1) * 1024 + kk]);
            }
            float* mods = (float*)(ws + WS_MODS);
#pragma unroll
            for (int n = 0; n < 5; ++n) {
                if (ks == 0) acc[n] += *(const f32x4*)(p.in[I_BADA] + l * 3072 + j);
#pragma unroll
                for (int e = 0; e < 4; ++e) atomicAdd(mods + (size_t)(l * 5 + n) * 3072 + j + e, acc[n][e]);
            }
            continue;
        }
        it -= P0_MODS;
        if (it < P0_TWIN) {
            const int l = it / (16 * 92), r = it % (16 * 92), kb = r / 92, nb = r % 92, n0 = nb * 32;
            const int src = n0 < 1792 ? n0 : (n0 < 2816 ? n0 + 32 : (n0 < 2848 ? n0 - 2816 + 1792 : -1));
            p0_transpose_item(p.in[I_WIN] + (size_t)l * 1024 * 2848, 1024, 2848, src, (bf16_t*)(ws + WS_WIN) + (size_t)l * 2944 * 1024, n0, kb * 64, scr, lane);
            continue;
        }
        it -= P0_TWIN;
        if (it < P0_TWOUT) {
            const int l = it / 512, r = it % 512, kb = r >> 5, nb = r & 31;
            p0_transpose_item(p.in[I_WOUT] + (size_t)l * 1024 * 1024, 1024, 1024, nb * 32, (bf16_t*)(ws + WS_WOUT) + (size_t)l * 1024 * 1024, nb * 32, kb * 64, scr, lane);
            continue;
        }
        it -= P0_TWOUT;
        if (it < P0_TWUQ) {
            const int l = it / 80, r = it % 80, kb = r / 20, nb = r % 20;
            p0_transpose_item(p.in[I_WUQ] + (size_t)l * 256 * 576, 256, 576, nb < 18 ? nb * 32 : -1, (bf16_t*)(ws + WS_WUQ) + (size_t)l * 640 * 256, nb * 32, kb * 64, scr, lane);
            continue;
        }
        it -= P0_TWUQ;
        if (it < P0_TWUKV) {
            const int l = it / 48, r = it % 48, kb = r / 24, nb = r % 24;
            p0_transpose_item(p.in[I_WUKV] + (size_t)l * 128 * 768, 128, 768, nb * 32, (bf16_t*)(ws + WS_WUKV) + (size_t)l * 768 * 128, nb * 32, kb * 64, scr, lane);
            continue;
        }
        it -= P0_TWUKV;
        if (it < 3 * P0_CAST_G) {
            const int which = it / P0_CAST_G, r = it % P0_CAST_G;
            const float* src = which == 0 ? p.in[I_CGK] : (which == 1 ? p.in[I_CGV] : p.in[I_CCKV]);
            bf16_t* dst = (bf16_t*)(ws + (which == 0 ? WS_CGK : (which == 1 ? WS_CGV : WS_CCKV)));
            cast8(src, dst, (size_t)r * 512 + lane * 8);
            continue;
        }
        it -= 3 * P0_CAST_G;
        if (it < P0_CAST_KPE) { cast8(p.in[I_CKPE], (bf16_t*)(ws + WS_CKPE), (size_t)it * 512 + lane * 8); continue; }
        it -= P0_CAST_KPE;
        if (it < P0_S0T) {
            const int mat = it >> 2, qd = it & 3, dv = qd * 16 + (lane >> 2), dk0 = (lane & 3) * 16;
            const float* s = p.in[I_STATE] + (size_t)mat * 4096 + dv;
            float x[16];
#pragma unroll
            for (int i = 0; i < 16; ++i) x[i] = s[(dk0 + i) * 64];
            u32x4 o0, o1;
            o0.x = pk2(x[0], x[1]); o0.y = pk2(x[2], x[3]); o0.z = pk2(x[4], x[5]); o0.w = pk2(x[6], x[7]);
            o1.x = pk2(x[8], x[9]); o1.y = pk2(x[10], x[11]); o1.z = pk2(x[12], x[13]); o1.w = pk2(x[14], x[15]);
            bf16_t* d = (bf16_t*)(ws + WS_S0T) + (size_t)mat * 4096 + dv * 64 + dk0;
            *(u32x4*)d = o0; *(u32x4*)(d + 8) = o1;
            continue;
        }
        it -= P0_S0T;
        if (it < P0_R64) {
            const int e = it * 64 + lane, t = e >> 5, j = e & 31, i = j & 15;
            const float pos = (float)(j < 16 ? (t >> 6) : (t & 63));
            const float a = pos * exp2f(-(float)i * (13.287712379549449f / 16.f));
            ((f32x2*)(ws + WS_ROPE64))[e] = (f32x2){cosf(a), sinf(a)};
            continue;
        }
        it -= P0_R64;
        {
            const int e = it * 64 + lane, t = e >> 4, j = e & 15, i = j & 7;
            const float pos = (float)(j < 8 ? (t >> 6) : (t & 63));
            const float a = pos * exp2f(-(float)i * (13.287712379549449f / 8.f));
            ((f32x2*)(ws + WS_ROPE32))[e] = (f32x2){cosf(a), sinf(a)};
        }
    }
}
constexpr int P1_GS = 80, P1_BIAS = 4 * 2944, P1_X = 8192, P1_TOTAL = P1_GS + P1_BIAS + P1_X;
__device__ __forceinline__ void xg_row(const Frame& F, const float* xrow, const float* g, const float* mods_c, bf16_t* xg_row_out, float* ssq_row, bool write_xg) {
    const int lane = F.lane;
    float ss = 0.f;
#pragma unroll
    for (int j = 0; j < 4; ++j) {
        const int k = j * 256 + lane * 4;
        const f32x4 x = *(const f32x4*)(xrow + k);
        ss += (x[0] * x[0] + x[1] * x[1]) + (x[2] * x[2] + x[3] * x[3]);
        if (write_xg) {
            const f32x4 gg = *(const f32x4*)(g + k), sc = *(const f32x4*)(mods_c + 1024 + k);
            u32x2 o; o.x = pk2(x[0] * gg[0] * (1.f + sc[0]), x[1] * gg[1] * (1.f + sc[1])); o.y = pk2(x[2] * gg[2] * (1.f + sc[2]), x[3] * gg[3] * (1.f + sc[3]));
            *(u32x2*)(xg_row_out + k) = o;
        }
    }
    ss = wsum(ss);
    if (lane < 16) ssq_row[lane] = lane == 0 ? ss : 0.f;
}
__device__ __forceinline__ void phase1(const Frame& F, const Params& p) {
    unsigned char* ws = F.ws; const int lane = F.lane;
    const int gw = blockIdx.x * 4 + F.w, ngw = gridDim.x * 4;
    const float* mods = (const float*)(ws + WS_MODS);
    for (int it0 = gw; it0 < P1_TOTAL; it0 += ngw) {
        int it = it0;
        if (it < P1_GS) {
            const int e = it * 256 + lane * 4, lc = e >> 10, k = e & 1023, l = lc / 5;
            const f32x4 g = *(const f32x4*)(p.in[I_NORMG] + l * 1024 + k), sc = *(const f32x4*)(mods + (size_t)lc * 3072 + 1024 + k);
            *(f32x4*)((float*)(ws + WS_GS) + e) = g * (sc + 1.f);
            continue;
        }
        it -= P1_GS;
        if (it < P1_BIAS) {
            const int l = it / 2944, n = it % 2944;
            const bf16_t* wr = (const bf16_t*)(ws + WS_WIN) + ((size_t)l * 2944 + n) * 1024 + lane * 16;
            const u32x4 w0 = *(const u32x4*)wr, w1 = *(const u32x4*)(wr + 8);
            float wv[16];
#pragma unroll
            for (int i = 0; i < 4; ++i) { wv[2 * i] = bflo(w0[i]); wv[2 * i + 1] = bfhi(w0[i]); wv[8 + 2 * i] = bflo(w1[i]); wv[8 + 2 * i + 1] = bfhi(w1[i]); }
#pragma unroll
            for (int c = 0; c < 5; ++c) {
                const float* sh = mods + (size_t)(l * 5 + c) * 3072 + lane * 16;
                float d = 0.f;
#pragma unroll
                for (int i = 0; i < 4; ++i) { const f32x4 s4 = *(const f32x4*)(sh + 4 * i); d += (s4[0] * wv[4 * i] + s4[1] * wv[4 * i + 1]) + (s4[2] * wv[4 * i + 2] + s4[3] * wv[4 * i + 3]); }
                d = wsum(d);
                if (lane == 0) ((float*)(ws + WS_BIAS))[(size_t)(l * 5 + c) * 2944 + n] = d;
            }
            continue;
        }
        it -= P1_BIAS;
        {
            const int tok = it; const bool lat = tok >= 4096;
            const float* xr = lat ? p.in[I_XS] + (size_t)(tok - 4096) * 1024 : p.in[I_XP] + (size_t)tok * 1024;
            const int cond = lat ? 1 + ((tok - 4096) >> 10) : 0;
            xg_row(F, xr, p.in[I_NORMG], mods + (size_t)cond * 3072, (bf16_t*)(ws + WS_XG) + (size_t)tok * 1024, (float*)(ws + WS_SSQ) + (size_t)tok * 16, true);
        }
    }
}
__device__ __forceinline__ void phase_final(const Frame& F, const Params& p) {
    const int lane = F.lane;
    const int gw = blockIdx.x * 4 + F.w, ngw = gridDim.x * 4;
    for (int tok = gw; tok < 8192; tok += ngw) {
        float ss = 0.f;
        if (lane < 16) ss = ((const float*)(F.ws + WS_SSQ))[(size_t)tok * 16 + lane];
        ss = wsum(ss);
        const float rstd = rsqrtf(ss * (1.f / 1024.f) + EPS);
        const float* xr = p.xs + (size_t)tok * 1024; float* orow = p.out + (size_t)tok * 1024;
#pragma unroll
        for (int j = 0; j < 4; ++j) {
            const int k = j * 256 + lane * 4;
            const f32x4 x = *(const f32x4*)(xr + k), fn = *(const f32x4*)(p.in[I_FNORM] + k);
            *(f32x4*)(orow + k) = x * fn * rstd;
        }
    }
}

#ifndef MK_EN
#define MK_EN 0xff
#endif
#define EN(x) ((MK_EN >> (x)) & 1)
constexpr int PH_TOTAL = 19;
__global__ void __launch_bounds__(256, 2) mega(Params p) {
    extern __shared__ __attribute__((aligned(16))) unsigned char lds_raw[];
    Frame F;
    F.lds = (LAS unsigned char*)lds_raw;
    F.tid = threadIdx.x; F.lane = F.tid & 63; F.w = __builtin_amdgcn_readfirstlane(F.tid >> 6); F.h = F.lane >> 5; F.lq = F.lane & 31;
    F.ws = p.ws;
    volatile LAS unsigned* MISC = (volatile LAS unsigned*)(F.lds + LDS_MISC);
    if (F.tid < 64) MISC[F.tid] = 0u;
    __syncthreads();
    unsigned* ctl = (unsigned*)(p.ws + WS_CTL);
    XcdBarrier bar; bar.bar = ctl + CW_BAR; bar.x = 0; bar.st = nullptr;
    const bool multi = p.ph_hi - p.ph_lo > 1;
    if (multi) bar = xcd_barrier_post(ctl + CW_BAR, MISC + 8);
    const int G = gridDim.x;
    const Frame F0 = F;
    for (int ph = p.ph_lo; ph < p.ph_hi; ++ph) {
        Frame F = F0;
        asm volatile("" : "+v"(F.tid), "+v"(F.lane), "+v"(F.h), "+v"(F.lq));
        asm volatile("" : "+s"(F.w), "+s"(F.ws));
        if (EN(0) && ph == 0) phase0(F, p);
        else if (EN(1) && ph == 1) phase1(F, p);
        else if (EN(2) && ph == 18) phase_final(F, p);
        else {
            const int l = (ph - 2) >> 2, sub = (ph - 2) & 3;
            if (EN(3) && sub == 0) {
                const bf16_t* Wt = (const bf16_t*)(F.ws + WS_WIN) + (size_t)l * 2944 * 1024;
                const bf16_t* X = (const bf16_t*)(F.ws + WS_XG);
                for (int j = blockIdx.x; j < 23 * 64; j += G) {
                    const int tn = j >> 6, tm = j & 63;
                    f32x16 acc[2][2];
                    gemm_core(F, Wt + (size_t)tn * 128 * 1024, 1024, X + (size_t)tm * 128 * 1024, 1024, 1024, acc);
                    epi_gemm1(F, p, acc, tn, tm, l);
                }
            } else if (EN(4) && sub == 1) {
                for (int j = blockIdx.x; j < 800; j += G) {
                    f32x16 acc[2][2];
                    if (j < 320) {
                        const int tn = j >> 6, tm = j & 63;
                        gemm_core(F, (const bf16_t*)(F.ws + WS_WUQ) + ((size_t)l * 640 + tn * 128) * 256, 256, (const bf16_t*)(F.ws + WS_CQG) + (size_t)tm * 128 * 256, 256, 256, acc);
                        epi_qm(F, acc, tn, tm);
                    } else if (j < 704) {
                        const int jj = j - 320, tn = jj >> 6, tm = jj & 63;
                        gemm_core(F, (const bf16_t*)(F.ws + WS_WUKV) + ((size_t)l * 768 + tn * 128) * 128, 128, (const bf16_t*)(F.ws + WS_CKVN) + (size_t)tm * 128 * 128, 128, 128, acc);
                        epi_plain(F, acc, (bf16_t*)(F.ws + WS_KVM), 768, tm * 128, tn * 128);
                    } else {
                        const int jj = j - 704, tn = jj >> 4, tc = jj & 15, b = tc >> 2, jt = tc & 3;
                        gemm_core(F, (const bf16_t*)(F.ws + WS_WUKV) + ((size_t)l * 768 + tn * 128) * 128, 128,
                                  (const bf16_t*)(F.ws + WS_CCKV) + ((size_t)(b * 4 + l) * 512 + jt * 128) * 128, 128, 128, acc);
                        epi_plain(F, acc, (bf16_t*)(F.ws + WS_KVMC), 768, b * 512 + jt * 128, tn * 128);
                    }
                }
            } else if (EN(5) && sub == 2) {
                for (;;) {
                    __syncthreads();
                    if (F.tid == 0) MISC[0] = atomicAdd(ctl + CW_QUEUE + 64 * l, 1u);
                    __syncthreads();
                    const int u = __builtin_amdgcn_readfirstlane((int)MISC[0]);
                    if (u >= N_ATTN_UNITS) break;
                    attn_dispatch(F, p, u, l);
                }
            } else if (EN(6)) {
                const bf16_t* Wt = (const bf16_t*)(F.ws + WS_WOUT) + (size_t)l * 1024 * 1024;
                const bf16_t* Yb = (const bf16_t*)(F.ws + WS_Y);
                for (int j = blockIdx.x; j < 8 * 64; j += G) {
                    const int tn = j >> 6, tm = j & 63;
                    f32x16 acc[2][2];
                    gemm_core(F, Wt + (size_t)tn * 128 * 1024, 1024, Yb + (size_t)tm * 128 * 1024, 1024, 1024, acc);
                    epi_gemm2(F, p, acc, tn, tm, l);
                }
            }
        }
        if (ph + 1 < p.ph_hi) xcd_barrier(bar);
    }
}
}

extern "C" void kernel_launch(void* const* d_in, const int* in_sizes, int n_in, void* d_out, int out_size, void* d_ws, size_t ws_size, hipStream_t stream) {
    static int grid = 0;
    if (!grid) {
        int dev = 0, cus = 0, per_cu = 0;
        (void)hipGetDevice(&dev);
        (void)hipDeviceGetAttribute(&cus, hipDeviceAttributeMultiprocessorCount, dev);
        (void)hipFuncSetAttribute((const void*)mk::mega, hipFuncAttributeMaxDynamicSharedMemorySize, mk::LDS_BYTES);
        (void)hipOccupancyMaxActiveBlocksPerMultiprocessor(&per_cu, (const void*)mk::mega, 256, mk::LDS_BYTES);
        if (per_cu > 2) per_cu = 2;
        if (per_cu < 1) per_cu = 1;
        if (cus < 1) cus = 256;
        grid = cus * per_cu;
    }
    unsigned char* ws = (unsigned char*)d_ws;
    (void)hipMemsetAsync(ws, 0, mk::CTL_ZERO_BYTES, stream);
    mk::Params P{};
    for (int i = 0; i < 22; ++i) P.in[i] = (const float*)d_in[i];
    P.out = (float*)d_out; P.ws = ws; P.xs = (float*)d_out;
    P.ph_lo = 0; P.ph_hi = mk::PH_TOTAL;
    void* args[] = {&P};
    (void)hipLaunchCooperativeKernel((const void*)mk::mega, dim3(grid), dim3(256), args, mk::LDS_BYTES, stream);
}
```

```cpp
#include <hip/hip_runtime.h>
#include <stdint.h>
namespace mk {
#define LAS __attribute__((address_space(3)))
typedef unsigned short bf16_t;
typedef short bf16x8 __attribute__((ext_vector_type(8)));
typedef short s16x4 __attribute__((ext_vector_type(4)));
typedef float f32x16 __attribute__((ext_vector_type(16)));
typedef float f32x4 __attribute__((ext_vector_type(4)));
typedef float f32x2 __attribute__((ext_vector_type(2)));
typedef unsigned u32x4 __attribute__((ext_vector_type(4)));
typedef unsigned u32x2 __attribute__((ext_vector_type(2)));
typedef __bf16 bf16x2_t __attribute__((ext_vector_type(2)));

constexpr float EPS = 1e-6f;
constexpr float LOG2E = 1.4426950408889634f;
constexpr float QSC_GQA = 0.125f * LOG2E;
constexpr float QSC_MLA = 0.10206207261596575f * LOG2E;

__device__ __forceinline__ unsigned pk2(float lo, float hi) { f32x2 v = {lo, hi}; bf16x2_t b = __builtin_convertvector(v, bf16x2_t); return __builtin_bit_cast(unsigned, b); }
__device__ __forceinline__ float bf2f(unsigned short u) { return __uint_as_float((unsigned)u << 16); }
__device__ __forceinline__ float bflo(unsigned u) { return __uint_as_float(u << 16); }
__device__ __forceinline__ float bfhi(unsigned u) { return __uint_as_float(u & 0xffff0000u); }
__device__ __forceinline__ float silu_f(float x) { return x * __builtin_amdgcn_rcpf(1.f + __builtin_amdgcn_exp2f(-x * LOG2E)); }
__device__ __forceinline__ float wsum(float v) {
#pragma unroll
    for (int o = 32; o > 0; o >>= 1) v += __shfl_xor(v, o);
    return v;
}

constexpr size_t MiB = 1u << 20;
constexpr size_t WS_CTL = 0, CTL_ZERO_BYTES = 1 * MiB;
constexpr size_t WS_MODS = 256 * 1024;
constexpr size_t WS_BIAS = 1 * MiB;
constexpr size_t WS_GS = 1 * MiB + 256 * 1024;
constexpr size_t WS_ROPE64 = 1 * MiB + 512 * 1024;
constexpr size_t WS_ROPE32 = 1 * MiB + 768 * 1024;
constexpr size_t WS_SSQ = 2 * MiB;
constexpr size_t WS_CQSSQ = 2 * MiB + 512 * 1024;
constexpr size_t WS_S0T = 3 * MiB;
constexpr size_t WS_CGK = 4 * MiB, WS_CGV = 6 * MiB, WS_CCKV = 8 * MiB, WS_CKPE = 10 * MiB;
constexpr size_t WS_WIN = 11 * MiB;
constexpr size_t WS_WOUT = 34 * MiB;
constexpr size_t WS_WUQ = 42 * MiB;
constexpr size_t WS_WUKV = 43 * MiB + 256 * 1024;
constexpr size_t WS_XG = 44 * MiB;
constexpr size_t WS_KVM = 44 * MiB;
constexpr size_t WS_KVMC = 56 * MiB;
constexpr size_t WS_RQ = 60 * MiB, WS_RK = 64 * MiB, WS_RV = 68 * MiB;
constexpr size_t WS_GQ = 72 * MiB;
constexpr size_t WS_GK = 78 * MiB, WS_GV = 80 * MiB;
constexpr size_t WS_CQG = 82 * MiB;
constexpr size_t WS_CKVN = 86 * MiB;
constexpr size_t WS_KPEB = 88 * MiB;
constexpr size_t WS_ZS = 89 * MiB;
constexpr size_t WS_QM = 105 * MiB;
constexpr size_t WS_Y = 114 * MiB;
constexpr size_t WS_XSDBG = 130 * MiB;
constexpr size_t WS_OPT_END = 162 * MiB;
constexpr int CW_QUEUE = 1024;
constexpr int CW_BAR = 4096;

constexpr size_t O_STATE = 8388608, O_GK = 10485760, O_GV = 12582912, O_CKV = 14680064, O_KPE = 16777216;

constexpr int LDS_EX = 65536;
constexpr int LDS_SCAL = 66560;
constexpr int LDS_MISC = 67072;
constexpr int LDS_BYTES = 67584;

struct Params { const float* in[22]; float* out; unsigned char* ws; float* xs; int ph_lo, ph_hi; };
enum { I_XP = 0, I_XS, I_STATE, I_CGK, I_CGV, I_CCKV, I_CKPE, I_C, I_CCTX, I_NORMG, I_WADA, I_BADA, I_WIN, I_DECAY, I_GQN, I_GKN, I_MQN, I_MKVN, I_WUQ, I_WUKV, I_WOUT, I_FNORM };

#define XB_TMO      128
#define XB_XCNT(j)  (256  + 64 * (j))
#define XB_XSUB(j)  (1280 + 64 * (j))
#define XB_XGEN(j)  (2304 + 64 * (j))
#define XB_TOP      3328
#define XB_TOPGEN   3392
#define XB_SPIN_CAP (1u << 20)
__device__ __forceinline__ unsigned xb_ld(unsigned* p) { return __hip_atomic_load(p, __ATOMIC_RELAXED, __HIP_MEMORY_SCOPE_AGENT); }
__device__ __forceinline__ unsigned xb_add(unsigned* p, unsigned v) { return __hip_atomic_fetch_add(p, v, __ATOMIC_RELAXED, __HIP_MEMORY_SCOPE_AGENT); }
__device__ __forceinline__ unsigned xb_xcc_id() { return (unsigned)__builtin_amdgcn_s_getreg((3 << 11) | 20) & 0xFu; }
#define XB_SPIN(cond, bar) do { unsigned _sp = 0; while (cond) { __builtin_amdgcn_s_sleep(1); \
    if ((++_sp & 255u) == 0u) { if (xb_ld(&(bar)[XB_TMO])) break; if (_sp > XB_SPIN_CAP) { atomicAdd(&(bar)[XB_TMO], 1u); break; } } } } while (0)
struct XcdBarrier { unsigned* bar; unsigned x; volatile LAS unsigned* st; };
__device__ __forceinline__ XcdBarrier xcd_barrier_post(unsigned* bar, volatile LAS unsigned* st) {
    XcdBarrier b; b.bar = bar; b.x = xb_xcc_id(); b.st = st;
    if (threadIdx.x == 0) (void)xb_add(&bar[XB_XCNT(b.x)], 1u);
    return b;
}
__device__ __forceinline__ void xcd_barrier_complete(unsigned* bar, unsigned x, unsigned& nloc, unsigned& nx) {
    const unsigned G = gridDim.x * gridDim.y * gridDim.z;
    unsigned sum, cnt, mine, sp = 0u;
    for (;;) {
        sum = 0u; cnt = 0u; mine = 0u;
#pragma unroll
        for (unsigned j = 0; j < 16; ++j) { const unsigned c = xb_ld(&bar[XB_XCNT(j)]); sum += c; cnt += (c > 0u) ? 1u : 0u; mine = (j == x) ? c : mine; }
        if (sum == G) break;
        __builtin_amdgcn_s_sleep(1);
        if ((++sp & 255u) == 0u) { if (xb_ld(&bar[XB_TMO])) break; if (sp > XB_SPIN_CAP) { atomicAdd(&bar[XB_TMO], 1u); break; } }
    }
    nloc = mine > 0u ? mine : 1u; nx = cnt > 0u ? cnt : 1u;
}
__device__ __forceinline__ void xcd_barrier(const XcdBarrier& b) {
    asm volatile("s_waitcnt vmcnt(0)" ::: "memory");
    __syncthreads();
    if (threadIdx.x == 0) {
        unsigned* bar = b.bar;
        __builtin_amdgcn_s_waitcnt(0);
        unsigned nloc = b.st[0], nx = b.st[1];
        if (nloc == 0u) { xcd_barrier_complete(bar, b.x, nloc, nx); b.st[0] = nloc; b.st[1] = nx; }
        const unsigned old = xb_add(&bar[XB_XSUB(b.x)], 1u);
        const unsigned gen = old / nloc;
        if (old + 1u == (gen + 1u) * nloc) {
            __builtin_amdgcn_fence(__ATOMIC_RELEASE, "agent");
            asm volatile("s_waitcnt vmcnt(0)" ::: "memory");
            const unsigned og = xb_add(&bar[XB_TOP], 1u);
            const unsigned tg = og / nx;
            if (og + 1u == (tg + 1u) * nx) xb_add(&bar[XB_TOPGEN], 1u);
            else XB_SPIN(xb_ld(&bar[XB_TOPGEN]) == tg, bar);
            __builtin_amdgcn_fence(__ATOMIC_ACQUIRE, "agent");
            xb_add(&bar[XB_XGEN(b.x)], 1u);
            asm volatile("s_waitcnt vmcnt(0)" ::: "memory");
        } else {
            XB_SPIN(xb_ld(&bar[XB_XGEN(b.x)]) == gen, bar);
            __builtin_amdgcn_fence(__ATOMIC_ACQUIRE, "agent");
            asm volatile("s_waitcnt vmcnt(0)" ::: "memory");
        }
    }
    __syncthreads();
}

struct Frame {
    LAS unsigned char* lds;
    int tid, lane, w, h, lq;
    unsigned char* ws;
};
#define GLDS16(gsrc, ldsdst) __builtin_amdgcn_global_load_lds((const unsigned*)(gsrc), (LAS unsigned*)(ldsdst), 16, 0, 0)
#define MFMA32(a, b, c) __builtin_amdgcn_mfma_f32_32x32x16_bf16((a), (b), (c), 0, 0, 0)

__device__ __forceinline__ void gemm_core(const Frame& F, const bf16_t* __restrict__ W, int ldw, const bf16_t* __restrict__ X, int ldx, int K, f32x16 (&acc)[2][2]) {
    const int lane = F.lane, w = F.w;
    const int nkt = K >> 6;
    int offW[4], offX[4];
#pragma unroll
    for (int g = 0; g < 4; ++g) {
        const int row = 32 * w + 8 * g + (lane >> 3);
        const int c = (lane & 7) ^ ((row >> 1) & 7);
        offW[g] = row * ldw + c * 8; offX[g] = row * ldx + c * 8;
    }
    LAS unsigned char* const dW = F.lds + (32 * w) * 128;
    LAS unsigned char* const dX = F.lds + 16384 + (32 * w) * 128;
#define GC_ISSUE(kt, st) do { _Pragma("unroll") for (int g = 0; g < 4; ++g) { \
        GLDS16(W + offW[g] + (kt) * 64, dW + (st) * 32768 + g * 1024); GLDS16(X + offX[g] + (kt) * 64, dX + (st) * 32768 + g * 1024); } } while (0)
    const int wn = w & 1, wm = w >> 1, h = F.h, lq = F.lq;
    const int sw = (lane >> 1) & 7;
    int so[4];
#pragma unroll
    for (int s = 0; s < 4; ++s) so[s] = ((2 * s + h) ^ sw) << 4;
    const int bn0 = (64 * wn + lq) * 128, bm0 = 16384 + (64 * wm + lq) * 128;
#pragma unroll
    for (int a = 0; a < 2; ++a)
#pragma unroll
        for (int b = 0; b < 2; ++b)
#pragma unroll
            for (int r = 0; r < 16; ++r) acc[a][b][r] = 0.f;
    __syncthreads();
    GC_ISSUE(0, 0);
    asm volatile("s_waitcnt vmcnt(0)" ::: "memory");
    __syncthreads();
    for (int kt = 0; kt < nkt; ++kt) {
        const int st = kt & 1;
        if (kt + 1 < nkt) GC_ISSUE(kt + 1, st ^ 1);
        LAS unsigned char* const base = F.lds + st * 32768;
#pragma unroll
        for (int s = 0; s < 4; ++s) {
            const bf16x8 a0 = *(const LAS bf16x8*)(base + bn0 + so[s]);
            const bf16x8 a1 = *(const LAS bf16x8*)(base + bn0 + 4096 + so[s]);
            const bf16x8 b0 = *(const LAS bf16x8*)(base + bm0 + so[s]);
            const bf16x8 b1 = *(const LAS bf16x8*)(base + bm0 + 4096 + so[s]);
            acc[0][0] = MFMA32(a0, b0, acc[0][0]);
            acc[0][1] = MFMA32(a0, b1, acc[0][1]);
            acc[1][0] = MFMA32(a1, b0, acc[1][0]);
            acc[1][1] = MFMA32(a1, b1, acc[1][1]);
        }
        asm volatile("s_waitcnt vmcnt(0)" ::: "memory");
        __syncthreads();
    }
#undef GC_ISSUE
}
__device__ __forceinline__ int crow(int r, int h) { return (r & 3) + 8 * (r >> 2) + 4 * h; }

__device__ __forceinline__ void rope64_regs(float (&v)[2][16], const f32x2* tab, int h) {
#pragma unroll
    for (int nt = 0; nt < 2; ++nt)
#pragma unroll
        for (int g = 0; g < 2; ++g) {
            const f32x4* tp = (const f32x4*)(tab + nt * 16 + 8 * g + 4 * h);
            const f32x4 t0 = tp[0], t1 = tp[1];
            const float cs[4] = {t0[0], t0[2], t1[0], t1[2]}, sn[4] = {t0[1], t0[3], t1[1], t1[3]};
#pragma unroll
            for (int i = 0; i < 4; ++i) {
                const int r = 4 * g + i;
                const float x0 = v[nt][r], x1 = v[nt][r + 8];
                v[nt][r] = x0 * cs[i] - x1 * sn[i];
                v[nt][r + 8] = x1 * cs[i] + x0 * sn[i];
            }
        }
}
__device__ __forceinline__ void rope32_regs(float (&x)[16], const f32x2* tab, int h) {
#pragma unroll
    for (int g = 0; g < 2; ++g) {
        const f32x4* tp = (const f32x4*)(tab + 8 * g + 4 * h);
        const f32x4 t0 = tp[0], t1 = tp[1];
        const float cs[4] = {t0[0], t0[2], t1[0], t1[2]}, sn[4] = {t0[1], t0[3], t1[1], t1[3]};
#pragma unroll
        for (int i = 0; i < 4; ++i) {
            const int r = 8 * g + i;
            const float x0 = x[r], x1 = x[r + 4];
            x[r] = x0 * cs[i] - x1 * sn[i];
            x[r + 4] = x1 * cs[i] + x0 * sn[i];
        }
    }
}
__device__ __forceinline__ float ssq64(const float (&v)[2][16]) {
    float s = 0.f;
#pragma unroll
    for (int nt = 0; nt < 2; ++nt)
#pragma unroll
        for (int r = 0; r < 16; ++r) s += v[nt][r] * v[nt][r];
    s += __shfl_xor(s, 32);
    return s;
}
__device__ __forceinline__ void mulvec64(float (&v)[2][16], const float* gv, int h) {
#pragma unroll
    for (int nt = 0; nt < 2; ++nt)
#pragma unroll
        for (int g = 0; g < 4; ++g) {
            const f32x4 q = *(const f32x4*)(gv + 32 * nt + 8 * g + 4 * h);
#pragma unroll
            for (int i = 0; i < 4; ++i) v[nt][4 * g + i] *= q[i];
        }
}
constexpr int OST_LD = 68, OST_BYTES = 32 * OST_LD * 4;
__device__ __forceinline__ void stage_write(LAS float* st, const float (&v)[2][16], int h, int lq) {
    asm volatile("s_waitcnt lgkmcnt(0)" ::: "memory");
    __builtin_amdgcn_wave_barrier();
#pragma unroll
    for (int nt = 0; nt < 2; ++nt)
#pragma unroll
        for (int g = 0; g < 4; ++g) {
            f32x4 o = {v[nt][4 * g], v[nt][4 * g + 1], v[nt][4 * g + 2], v[nt][4 * g + 3]};
            *(LAS f32x4*)(st + lq * OST_LD + 32 * nt + 8 * g + 4 * h) = o;
        }
    asm volatile("s_waitcnt lgkmcnt(0)" ::: "memory");
    __builtin_amdgcn_wave_barrier();
}
__device__ __forceinline__ void stage_store_bf16(const LAS float* st, bf16_t* dst, int ld, float sc, int lane) {
#pragma unroll 1
    for (int it = 0; it < 4; ++it) {
        const int row = it * 8 + (lane >> 3), c8 = (lane & 7) * 8;
        const f32x4 x0 = *(const LAS f32x4*)(st + row * OST_LD + c8), x1 = *(const LAS f32x4*)(st + row * OST_LD + c8 + 4);
        u32x4 o; o.x = pk2(x0[0] * sc, x0[1] * sc); o.y = pk2(x0[2] * sc, x0[3] * sc); o.z = pk2(x1[0] * sc, x1[1] * sc); o.w = pk2(x1[2] * sc, x1[3] * sc);
        *(u32x4*)(dst + (size_t)row * ld + c8) = o;
    }
}
__device__ __forceinline__ void stage_store_f32(const LAS float* st, float* dst, int ld, int lane) {
#pragma unroll 1
    for (int it = 0; it < 8; ++it) {
        const int row = it * 4 + (lane >> 4), c = (lane & 15) * 4;
        *(f32x4*)(dst + (size_t)row * ld + c) = *(const LAS f32x4*)(st + row * OST_LD + c);
    }
}
__device__ __forceinline__ void stage_store_bf16_32(const LAS float* st, bf16_t* dst, int ld, int lane) {
#pragma unroll 1
    for (int it = 0; it < 2; ++it) {
        const int row = it * 16 + (lane >> 2), c8 = (lane & 3) * 8;
        const f32x4 x0 = *(const LAS f32x4*)(st + row * OST_LD + c8), x1 = *(const LAS f32x4*)(st + row * OST_LD + c8 + 4);
        u32x4 o; o.x = pk2(x0[0], x0[1]); o.y = pk2(x0[2], x0[3]); o.z = pk2(x1[0], x1[1]); o.w = pk2(x1[2], x1[3]);
        *(u32x4*)(dst + (size_t)row * ld + c8) = o;
    }
}
__device__ __forceinline__ void stage_store_f32_32(const LAS float* st, float* dst, int ld, int lane) {
#pragma unroll 1
    for (int it = 0; it < 4; ++it) {
        const int row = it * 8 + (lane >> 3), c = (lane & 7) * 4;
        *(f32x4*)(dst + (size_t)row * ld + c) = *(const LAS f32x4*)(st + row * OST_LD + c);
    }
}

__device__ __forceinline__ void gemm1_rstd(const Frame& F, int tm, float (&rstd2)[2]) {
    const float* ssqp = (const float*)(F.ws + WS_SSQ);
#pragma unroll
    for (int mt = 0; mt < 2; ++mt) {
        const int tok = tm * 128 + (F.w >> 1) * 64 + mt * 32 + F.lq;
        const f32x4* sp = (const f32x4*)(ssqp + (size_t)tok * 16);
        float ss = 0.f;
#pragma unroll
        for (int i = 0; i < 4; ++i) { const f32x4 q = sp[i]; ss += (q[0] + q[1]) + (q[2] + q[3]); }
        rstd2[mt] = rsqrtf(ss * (1.f / 1024.f) + EPS);
    }
}
__device__ __forceinline__ void epi_gemm1(const Frame& F, const Params& p, f32x16 (&acc)[2][2], int tn, int tm, int l, const float (&rstd2)[2]) {
    int h = F.h, lq = F.lq, lane = F.lane; const int wn = F.w & 1, wm = F.w >> 1;
    asm volatile("" : "+v"(h), "+v"(lq), "+v"(lane));
    unsigned char* ws = F.ws;
    LAS float* st = (LAS float*)(F.lds + F.w * OST_BYTES);
    const bool lat = tm >= 32;
    const int b = lat ? ((tm - 32) >> 3) : (tm >> 1);
    const int cond = lat ? 1 + b : 0;
    const int nb = tn * 128 + wn * 64;
    const float* bias = (const float*)(ws + WS_BIAS) + (size_t)(l * 5 + cond) * 2944 + nb;
    float* outp = p.out;
    float ckv_ss[2];
#pragma unroll
    for (int mt = 0; mt < 2; ++mt) {
        const int tok0 = tm * 128 + wm * 64 + mt * 32, tok = tok0 + lq;
        const int t0 = lat ? ((tok0 - 4096) & 1023) : (tok0 & 255), t = t0 + lq;
        const float rstd = rstd2[mt];
        float v[2][16];
#pragma unroll
        for (int nt = 0; nt < 2; ++nt)
#pragma unroll
            for (int g = 0; g < 4; ++g) {
                const f32x4 bq = *(const f32x4*)(bias + 32 * nt + 8 * g + 4 * h);
#pragma unroll
                for (int i = 0; i < 4; ++i) v[nt][4 * g + i] = acc[nt][mt][4 * g + i] * rstd + bq[i];
            }
        const f32x2* r64 = (const f32x2*)(ws + WS_ROPE64) + (size_t)t * 32;
        const size_t orow0 = (size_t)(b * 4 + l) * 256 + t0;
        if (tn < 2) {
            if (lat) rope64_regs(v, r64, h);
            stage_write(st, v, h, lq);
            stage_store_bf16(st, (bf16_t*)(ws + WS_RQ) + (size_t)tok0 * 256 + nb, 256, 1.f, lane);
        } else if (tn < 4) {
            if (lat) rope64_regs(v, r64, h);
            stage_write(st, v, h, lq);
            stage_store_bf16(st, (bf16_t*)(ws + WS_RK) + (size_t)tok0 * 256 + (nb - 256), 256, 0.125f, lane);
        } else if (tn < 6) {
            stage_write(st, v, h, lq);
            stage_store_bf16(st, (bf16_t*)(ws + WS_RV) + (size_t)tok0 * 256 + (nb - 512), 256, 1.f, lane);
        } else if (tn < 9) {
            const float r = rsqrtf(ssq64(v) * (1.f / 64.f) + EPS);
#pragma unroll
            for (int nt = 0; nt < 2; ++nt)
#pragma unroll
                for (int i = 0; i < 16; ++i) v[nt][i] *= r;
            mulvec64(v, p.in[I_GQN] + l * 64, h);
            if (lat) rope64_regs(v, r64, h);
            stage_write(st, v, h, lq);
            stage_store_bf16(st, (bf16_t*)(ws + WS_GQ) + (size_t)tok0 * 384 + (nb - 768), 384, QSC_GQA, lane);
        } else if (tn == 9) {
            const float r = rsqrtf(ssq64(v) * (1.f / 64.f) + EPS);
#pragma unroll
            for (int nt = 0; nt < 2; ++nt)
#pragma unroll
                for (int i = 0; i < 16; ++i) v[nt][i] *= r;
            mulvec64(v, p.in[I_GKN] + l * 64, h);
            if (lat) rope64_regs(v, r64, h);
            stage_write(st, v, h, lq);
            if (!lat) stage_store_f32(st, outp + O_GK + orow0 * 128 + (nb - 1152), 128, lane);
            stage_store_bf16(st, (bf16_t*)(ws + WS_GK) + (size_t)tok0 * 128 + (nb - 1152), 128, 1.f, lane);
        } else if (tn == 10) {
            stage_write(st, v, h, lq);
            if (!lat) stage_store_f32(st, outp + O_GV + orow0 * 128 + (nb - 1280), 128, lane);
            stage_store_bf16(st, (bf16_t*)(ws + WS_GV) + (size_t)tok0 * 128 + (nb - 1280), 128, 1.f, lane);
        } else if (tn < 13) {
            const float s2 = ssq64(v);
            if (h == 0) ((float*)(ws + WS_CQSSQ))[(size_t)tok * 4 + ((nb - 1408) >> 6)] = s2;
            mulvec64(v, p.in[I_MQN] + l * 256 + (nb - 1408), h);
            stage_write(st, v, h, lq);
            stage_store_bf16(st, (bf16_t*)(ws + WS_CQG) + (size_t)tok0 * 256 + (nb - 1408), 256, 1.f, lane);
        } else if (tn == 13) {
            ckv_ss[mt] = ssq64(v);
            if (h == 0) ((LAS float*)(F.lds + LDS_EX))[(wm * 2 + wn) * 64 + mt * 32 + lq] = ckv_ss[mt];
        } else if (tn < 22) {
#pragma unroll
            for (int nt = 0; nt < 2; ++nt)
#pragma unroll
                for (int i = 0; i < 16; ++i) v[nt][i] = silu_f(v[nt][i]);
            stage_write(st, v, h, lq);
            stage_store_bf16(st, (bf16_t*)(ws + WS_ZS) + (size_t)tok0 * 1024 + (nb - 1792), 1024, 1.f, lane);
        } else {
            if (wn == 0) {
                if (lat) rope32_regs(v[0], (const f32x2*)(ws + WS_ROPE32) + (size_t)t * 16, h);
                stage_write(st, v, h, lq);
                if (!lat) stage_store_f32_32(st, outp + O_KPE + orow0 * 32, 32, lane);
                stage_store_bf16_32(st, (bf16_t*)(ws + WS_KPEB) + (size_t)tok0 * 32, 32, lane);
            }
        }
    }
    if (tn == 13) {
        __syncthreads();
#pragma unroll
        for (int mt = 0; mt < 2; ++mt) {
            const int tok0 = tm * 128 + wm * 64 + mt * 32, tok = tok0 + lq;
            const int t0 = lat ? ((tok0 - 4096) & 1023) : (tok0 & 255);
            const float rstd = rstd2[mt];
            float v[2][16];
#pragma unroll
            for (int nt = 0; nt < 2; ++nt)
#pragma unroll
                for (int g = 0; g < 4; ++g) {
                    const f32x4 bq = *(const f32x4*)(bias + 32 * nt + 8 * g + 4 * h);
#pragma unroll
                    for (int i = 0; i < 4; ++i) v[nt][4 * g + i] = acc[nt][mt][4 * g + i] * rstd + bq[i];
                }
            const float tot = ckv_ss[mt] + ((const LAS float*)(F.lds + LDS_EX))[(wm * 2 + (wn ^ 1)) * 64 + mt * 32 + lq];
            const float r = rsqrtf(tot * (1.f / 128.f) + EPS);
#pragma unroll
            for (int nt = 0; nt < 2; ++nt)
#pragma unroll
                for (int i = 0; i < 16; ++i) v[nt][i] *= r;
            mulvec64(v, p.in[I_MKVN] + l * 128 + wn * 64, h);
            const size_t orow0 = (size_t)(b * 4 + l) * 256 + t0;
            stage_write(st, v, h, lq);
            if (!lat) stage_store_f32(st, outp + O_CKV + orow0 * 128 + wn * 64, 128, lane);
            stage_store_bf16(st, (bf16_t*)(ws + WS_CKVN) + (size_t)tok0 * 128 + wn * 64, 128, 1.f, lane);
        }
        __syncthreads();
    }
}

__device__ __forceinline__ void epi_qm(const Frame& F, f32x16 (&acc)[2][2], int tn, int tm) {
    int h = F.h, lq = F.lq, lane = F.lane; const int wn = F.w & 1, wm = F.w >> 1;
    asm volatile("" : "+v"(h), "+v"(lq), "+v"(lane));
    unsigned char* ws = F.ws;
    LAS float* st = (LAS float*)(F.lds + F.w * OST_BYTES);
    const bool lat = tm >= 32;
    const int nb = tn * 128 + wn * 64;
    if (nb >= 576) return;
#pragma unroll
    for (int mt = 0; mt < 2; ++mt) {
        const int tok0 = tm * 128 + wm * 64 + mt * 32, tok = tok0 + lq;
        const int t = lat ? ((tok - 4096) & 1023) : (tok & 255);
        const f32x4 q4 = *(const f32x4*)((const float*)(ws + WS_CQSSQ) + (size_t)tok * 4);
        const float rstd = rsqrtf(((q4[0] + q4[1]) + (q4[2] + q4[3])) * (1.f / 256.f) + EPS);
        float v[2][16];
#pragma unroll
        for (int nt = 0; nt < 2; ++nt) {
#pragma unroll
            for (int i = 0; i < 16; ++i) v[nt][i] = acc[nt][mt][i] * rstd;
            const int T = (nb + 32 * nt) >> 5;
            if (lat && (T % 3) == 2) rope32_regs(v[nt], (const f32x2*)(ws + WS_ROPE32) + (size_t)t * 16, h);
        }
        stage_write(st, v, h, lq);
        stage_store_bf16(st, (bf16_t*)(ws + WS_QM) + (size_t)tok0 * 576 + nb, 576, QSC_MLA, lane);
    }
}
__device__ __forceinline__ void epi_plain(const Frame& F, f32x16 (&acc)[2][2], bf16_t* D, int ldd, int row0, int n0) {
    int h = F.h, lq = F.lq, lane = F.lane; const int wn = F.w & 1, wm = F.w >> 1;
    asm volatile("" : "+v"(h), "+v"(lq), "+v"(lane));
    LAS float* st = (LAS float*)(F.lds + F.w * OST_BYTES);
#pragma unroll
    for (int mt = 0; mt < 2; ++mt) {
        const int r0 = row0 + wm * 64 + mt * 32;
        float v[2][16];
#pragma unroll
        for (int nt = 0; nt < 2; ++nt)
#pragma unroll
            for (int i = 0; i < 16; ++i) v[nt][i] = acc[nt][mt][i];
        stage_write(st, v, h, lq);
        stage_store_bf16(st, D + (size_t)r0 * ldd + n0 + wn * 64, ldd, 1.f, lane);
    }
}

__device__ __forceinline__ void epi_gemm2(const Frame& F, const Params& p, f32x16 (&acc)[2][2], int tn, int tm, int l) {
    int h = F.h, lq = F.lq, lane = F.lane; const int wn = F.w & 1, wm = F.w >> 1;
    asm volatile("" : "+v"(h), "+v"(lq), "+v"(lane));
    unsigned char* ws = F.ws;
    LAS float* st = (LAS float*)(F.lds + F.w * OST_BYTES);
    const bool lat = tm >= 32;
    const int b = lat ? ((tm - 32) >> 3) : (tm >> 1);
    const int cond = lat ? 1 + b : 0;
    const int nb = tn * 128 + wn * 64;
    const int c = (lane & 15) * 4;
    const f32x4 gt = *(const f32x4*)((const float*)(ws + WS_MODS) + (size_t)(l * 5 + cond) * 3072 + 2048 + nb + c);
    const f32x4 gs = *(const f32x4*)((const float*)(ws + WS_GS) + (size_t)((l < 3 ? l + 1 : 3) * 5 + cond) * 1024 + nb + c);
#pragma unroll
    for (int mt = 0; mt < 2; ++mt) {
        const int tok0 = tm * 128 + wm * 64 + mt * 32;
        float v[2][16];
#pragma unroll
        for (int nt = 0; nt < 2; ++nt)
#pragma unroll
            for (int i = 0; i < 16; ++i) v[nt][i] = acc[nt][mt][i];
        stage_write(st, v, h, lq);
        const float* xold0 = (l == 0) ? (lat ? p.in[I_XS] + (size_t)(tok0 - 4096) * 1024 : p.in[I_XP] + (size_t)tok0 * 1024) : p.xs + (size_t)tok0 * 1024;
#pragma unroll
        for (int it = 0; it < 8; ++it) {
            const int row = it * 4 + (lane >> 4);
            const f32x4 a = *(const LAS f32x4*)(st + row * OST_LD + c);
            const f32x4 xo = *(const f32x4*)(xold0 + (size_t)row * 1024 + nb + c);
            const f32x4 xn = xo + gt * a;
            *(f32x4*)(p.xs + (size_t)(tok0 + row) * 1024 + nb + c) = xn;
            float ss = (xn[0] * xn[0] + xn[1] * xn[1]) + (xn[2] * xn[2] + xn[3] * xn[3]);
            ss += __shfl_xor(ss, 1); ss += __shfl_xor(ss, 2); ss += __shfl_xor(ss, 4); ss += __shfl_xor(ss, 8);
            if ((lane & 15) == 0) ((float*)(ws + WS_SSQ))[(size_t)(tok0 + row) * 16 + tn * 2 + wn] = ss;
            if (l < 3) {
                u32x2 o; o.x = pk2(xn[0] * gs[0], xn[1] * gs[1]); o.y = pk2(xn[2] * gs[2], xn[3] * gs[3]);
                *(u32x2*)((bf16_t*)(ws + WS_XG) + (size_t)(tok0 + row) * 1024 + nb + c) = o;
            }
        }
    }
}
constexpr int AT_STG = 20480, AT_PE = 8192, AT_V = 12288, AT_OLD = 68;
struct AttnUnit {
    int mode;
    int nt0, nt1;
    const bf16_t *q; int q_ld;
    const bf16_t *k0, *k1; int k_ld0, k_ld1;
    const bf16_t *pe0, *pe1;
    const bf16_t *v0, *v1; int v_ld0, v_ld1;
    int tok0;
    int ycol;
    int qpos0, L;
    float lf, lb;
    const bf16_t *s0f, *s0b;
    float* st_out;
};
__device__ __forceinline__ s16x4 tr16(LAS const unsigned char* p) {
    typedef short v4i16_t __attribute__((ext_vector_type(4)));
    return __builtin_bit_cast(s16x4, __builtin_amdgcn_ds_read_tr16_b64_v4i16((LAS v4i16_t*)p));
}

template <int MODE>
__device__ __forceinline__ void attn_unit(const Frame& F, const Params& p, const AttnUnit& U) {
    constexpr int NQS = MODE == 1 ? 6 : 4;
    const int lane = F.lane, w = F.w, h = F.h, lq = F.lq;
    LAS unsigned char* lds = F.lds;
    const int k_ld = U.k_ld1, v_ld = U.v_ld1;
    int koff[2];
#pragma unroll
    for (int g = 0; g < 2; ++g) {
        const int row = 16 * w + 8 * g + (lane >> 3), c = (lane & 7) ^ ((row >> 1) & 7);
        koff[g] = row * k_ld + c * 8;
    }
    const int poff = (16 * w + (lane >> 2)) * 32 + ((lane & 3) ^ ((lane >> 4) & 3)) * 8;
    int voff[2], vdst[2];
#pragma unroll
    for (int i = 0; i < 2; ++i) {
        const int ii = 2 * w + i, dblk = ii >> 2, kg = ii & 3, row = 16 * kg + (lane >> 2);
        voff[i] = row * v_ld + dblk * 32 + (lane & 3) * 8;
        vdst[i] = AT_V + dblk * 4096 + kg * 1024;
    }
    const int nt0 = U.nt0, ntot = U.nt0 + U.nt1;
#define AT_ISSUE(t, st) do { const int _t = (t); LAS unsigned char* _b = lds + (st) * AT_STG; \
        const bool _s0 = _t < nt0; const int _u = _s0 ? _t : _t - nt0; \
        const bf16_t* _kb = (_s0 ? U.k0 : U.k1) + (size_t)_u * 64 * k_ld; const bf16_t* _vb = (_s0 ? U.v0 : U.v1) + (size_t)_u * 64 * v_ld; \
        _Pragma("unroll") for (int g = 0; g < 2; ++g) GLDS16(_kb + koff[g], _b + (16 * w + 8 * g) * 128); \
        if (MODE == 1) { const bf16_t* _pb = (_s0 ? U.pe0 : U.pe1) + (size_t)_u * 64 * 32; GLDS16(_pb + poff, _b + AT_PE + 16 * w * 64); } \
        _Pragma("unroll") for (int i = 0; i < 2; ++i) GLDS16(_vb + voff[i], _b + vdst[i]); } while (0)
    AT_ISSUE(0, 0);
    bf16x8 qr[NQS];
    if (MODE == 3) {
        const int dk = 32 * (w & 1) + lq;
#pragma unroll
        for (int s = 0; s < 4; ++s)
#pragma unroll
            for (int j = 0; j < 8; ++j) qr[s][j] = (16 * s + 8 * h + j == dk) ? (short)0x3F80 : (short)0;
    } else {
        const bf16_t* qp = U.q + (size_t)(32 * w + lq) * U.q_ld + 8 * h;
#pragma unroll
        for (int s = 0; s < NQS; ++s) qr[s] = *(const bf16x8*)(qp + 16 * s);
    }
    f32x16 o[2];
#pragma unroll
    for (int d = 0; d < 2; ++d)
#pragma unroll
        for (int r = 0; r < 16; ++r) o[d][r] = 0.f;
    float m_run = -1e30f, l_run = 0.f;
    const int qpos = U.qpos0 + 32 * w + lq;
    const int sdir = w >> 1;
    LAS float* scal = (LAS float*)(lds + LDS_SCAL) + w * 32;
    const int kfo = lq * 128, sw = (lane >> 1) & 7, pfo = AT_PE + lq * 64, psw = (lane >> 2) & 3;
    const int vfo = AT_V + (4 * h + ((lane & 15) >> 2)) * 64 + ((lane >> 4) & 1) * 32 + (lane & 3) * 8;
    for (int t = 0; t < ntot; ++t) {
        asm volatile("s_waitcnt vmcnt(0)" ::: "memory");
        __syncthreads();
        const int st = t & 1;
        if (t + 1 < ntot) AT_ISSUE(t + 1, st ^ 1);
        LAS const unsigned char* base = lds + st * AT_STG;
        f32x16 p0, p1;
#pragma unroll
        for (int r = 0; r < 16; ++r) { p0[r] = 0.f; p1[r] = 0.f; }
#pragma unroll
        for (int s = 0; s < 4; ++s) {
            const int so = ((2 * s + h) ^ sw) << 4;
            const bf16x8 ka = *(const LAS bf16x8*)(base + kfo + so);
            const bf16x8 kb = *(const LAS bf16x8*)(base + kfo + 4096 + so);
            p0 = MFMA32(ka, qr[s], p0);
            p1 = MFMA32(kb, qr[s], p1);
        }
        if (MODE == 1) {
#pragma unroll
            for (int s = 0; s < 2; ++s) {
                const int so = ((2 * s + h) ^ psw) << 4;
                const bf16x8 ka = *(const LAS bf16x8*)(base + pfo + so);
                const bf16x8 kb = *(const LAS bf16x8*)(base + pfo + 2048 + so);
                p0 = MFMA32(ka, qr[4 + s], p0);
                p1 = MFMA32(kb, qr[4 + s], p1);
            }
        }
        __builtin_amdgcn_sched_barrier(0);
        if (MODE <= 1) {
            float tm = p0[0];
#pragma unroll
            for (int r = 1; r < 16; ++r) tm = fmaxf(tm, p0[r]);
#pragma unroll
            for (int r = 0; r < 16; ++r) tm = fmaxf(tm, p1[r]);
            tm = fmaxf(tm, __shfl_xor(tm, 32));
            if (__any(tm > m_run + 6.0f)) {
                const float mn = fmaxf(m_run, tm);
                const float alpha = __builtin_amdgcn_exp2f(m_run - mn);
                m_run = mn; l_run *= alpha;
                if (h == 0) scal[lq] = alpha;
                asm volatile("s_waitcnt lgkmcnt(0)" ::: "memory");
#pragma unroll
                for (int g = 0; g < 4; ++g) {
                    const f32x4 a4 = *(const LAS f32x4*)(scal + 8 * g + 4 * h);
#pragma unroll
                    for (int i = 0; i < 4; ++i) { o[0][4 * g + i] *= a4[i]; o[1][4 * g + i] *= a4[i]; }
                }
            }
            float ls = 0.f;
#pragma unroll
            for (int r = 0; r < 16; ++r) { p0[r] = __builtin_amdgcn_exp2f(p0[r] - m_run); p1[r] = __builtin_amdgcn_exp2f(p1[r] - m_run); ls += p0[r] + p1[r]; }
            l_run += ls;
        } else if (MODE == 2) {
            const float dq = (float)(qpos - 64 * t - 4 * h);
#pragma unroll
            for (int r = 0; r < 16; ++r) {
                const float d0 = dq - (float)((r & 3) + 8 * (r >> 2)), d1 = d0 - 32.f;
                const float w0 = __builtin_amdgcn_exp2f(fabsf(d0) * (d0 > 0.f ? U.lf : U.lb));
                const float w1 = __builtin_amdgcn_exp2f(fabsf(d1) * (d1 > 0.f ? U.lf : U.lb));
                p0[r] *= (d0 == 0.f ? 2.f : w0);
                p1[r] *= (d1 == 0.f ? 2.f : w1);
            }
        } else {
            const float mb = (float)(64 * t + 4 * h);
#pragma unroll
            for (int r = 0; r < 16; ++r) {
                const float m0 = mb + (float)((r & 3) + 8 * (r >> 2)), m1 = m0 + 32.f;
                const float e0 = sdir ? m0 * U.lb : (255.f - m0) * U.lf, e1 = sdir ? m1 * U.lb : (255.f - m1) * U.lf;
                p0[r] *= __builtin_amdgcn_exp2f(e0);
                p1[r] *= __builtin_amdgcn_exp2f(e1);
            }
        }
        __builtin_amdgcn_sched_barrier(0);
        bf16x8 pa[4];
        { u32x4 a;
          a.x = pk2(p0[0], p0[1]); a.y = pk2(p0[2], p0[3]); a.z = pk2(p0[4], p0[5]); a.w = pk2(p0[6], p0[7]); pa[0] = __builtin_bit_cast(bf16x8, a);
          a.x = pk2(p0[8], p0[9]); a.y = pk2(p0[10], p0[11]); a.z = pk2(p0[12], p0[13]); a.w = pk2(p0[14], p0[15]); pa[1] = __builtin_bit_cast(bf16x8, a);
          a.x = pk2(p1[0], p1[1]); a.y = pk2(p1[2], p1[3]); a.z = pk2(p1[4], p1[5]); a.w = pk2(p1[6], p1[7]); pa[2] = __builtin_bit_cast(bf16x8, a);
          a.x = pk2(p1[8], p1[9]); a.y = pk2(p1[10], p1[11]); a.z = pk2(p1[12], p1[13]); a.w = pk2(p1[14], p1[15]); pa[3] = __builtin_bit_cast(bf16x8, a); }
#pragma unroll
        for (int d = 0; d < 2; ++d)
#pragma unroll
            for (int ks = 0; ks < 4; ++ks) {
                const s16x4 lo = tr16(base + vfo + d * 4096 + ks * 1024), hi = tr16(base + vfo + d * 4096 + ks * 1024 + 512);
                const bf16x8 vb = {lo[0], lo[1], lo[2], lo[3], hi[0], hi[1], hi[2], hi[3]};
                o[d] = MFMA32(pa[ks], vb, o[d]);
            }
    }
#undef AT_ISSUE
    int lq2 = lq, h2 = h, lane2 = lane; asm volatile("" : "+v"(lq2), "+v"(h2), "+v"(lane2));
    if (MODE == 2 && U.s0f != nullptr) {
        const float ff = __builtin_amdgcn_exp2f((float)(qpos + 1) * U.lf), fb = __builtin_amdgcn_exp2f((float)(U.L - qpos) * U.lb);
#pragma unroll
        for (int s = 0; s < 4; ++s) {
            const u32x4 qu = __builtin_bit_cast(u32x4, qr[s]);
            u32x4 af, ab;
#pragma unroll
            for (int i = 0; i < 4; ++i) { const float lo = bflo(qu[i]), hi = bfhi(qu[i]); af[i] = pk2(lo * ff, hi * ff); ab[i] = pk2(lo * fb, hi * fb); }
#pragma unroll
            for (int d = 0; d < 2; ++d) {
                const bf16x8 sf = *(const bf16x8*)(U.s0f + (size_t)(32 * d + lq2) * 64 + 16 * s + 8 * h2);
                const bf16x8 sb = *(const bf16x8*)(U.s0b + (size_t)(32 * d + lq2) * 64 + 16 * s + 8 * h2);
                o[d] = MFMA32(__builtin_bit_cast(bf16x8, af), sf, o[d]);
                o[d] = MFMA32(__builtin_bit_cast(bf16x8, ab), sb, o[d]);
            }
        }
    }
    if (MODE == 3) {
        float* dst = U.st_out + (size_t)sdir * 4 * 4096 + (size_t)(32 * (w & 1)) * 64;
#pragma unroll
        for (int d = 0; d < 2; ++d)
#pragma unroll
            for (int r = 0; r < 16; ++r) dst[(size_t)((r & 3) + 8 * (r >> 2) + 4 * h2) * 64 + 32 * d + lq2] = o[d][r];
        __syncthreads();
        return;
    }
    if (MODE <= 1) {
        l_run += __shfl_xor(l_run, 32);
        if (h2 == 0) scal[lq2] = 1.f / l_run;
    }
    __syncthreads();
    LAS float* ost = (LAS float*)lds + w * (32 * AT_OLD);
#pragma unroll
    for (int d = 0; d < 2; ++d)
#pragma unroll
        for (int r = 0; r < 16; ++r) ost[((r & 3) + 8 * (r >> 2) + 4 * h2) * AT_OLD + 32 * d + lq2] = o[d][r];
    asm volatile("s_waitcnt lgkmcnt(0)" ::: "memory");
    __builtin_amdgcn_wave_barrier();
    const bf16_t* zs = (const bf16_t*)(F.ws + WS_ZS);
    bf16_t* yb = (bf16_t*)(F.ws + WS_Y);
#pragma unroll
    for (int it = 0; it < 4; ++it) {
        const int row = it * 8 + (lane2 >> 3), c8 = (lane2 & 7) * 8;
        const f32x4 x0 = *(const LAS f32x4*)(ost + row * AT_OLD + c8), x1 = *(const LAS f32x4*)(ost + row * AT_OLD + c8 + 4);
        float sc;
        if (MODE <= 1) sc = scal[row];
        else {
            float ss = (x0[0] * x0[0] + x0[1] * x0[1]) + (x0[2] * x0[2] + x0[3] * x0[3]) + (x1[0] * x1[0] + x1[1] * x1[1]) + (x1[2] * x1[2] + x1[3] * x1[3]);
            ss += __shfl_xor(ss, 1); ss += __shfl_xor(ss, 2); ss += __shfl_xor(ss, 4);
            sc = rsqrtf(ss * (1.f / 64.f) + EPS);
        }
        const size_t off = (size_t)(U.tok0 + 32 * w + row) * 1024 + U.ycol + c8;
        const u32x4 z = *(const u32x4*)(zs + off);
        u32x4 y;
        y.x = pk2(x0[0] * sc * bflo(z.x), x0[1] * sc * bfhi(z.x));
        y.y = pk2(x0[2] * sc * bflo(z.y), x0[3] * sc * bfhi(z.y));
        y.z = pk2(x1[0] * sc * bflo(z.z), x1[1] * sc * bfhi(z.z));
        y.w = pk2(x1[2] * sc * bflo(z.w), x1[3] * sc * bfhi(z.w));
        *(u32x4*)(yb + off) = y;
    }
    __syncthreads();
}

__device__ __forceinline__ void attn_dispatch(const Frame& F, const Params& p, int u, int l) {
    unsigned char* ws = F.ws;
    AttnUnit U;
    U.nt0 = 0; U.nt1 = 0; U.q = nullptr; U.q_ld = 0; U.k0 = U.k1 = nullptr; U.k_ld0 = U.k_ld1 = 0; U.pe0 = U.pe1 = nullptr; U.v0 = U.v1 = nullptr; U.v_ld0 = U.v_ld1 = 0;
    U.tok0 = 0; U.ycol = 0; U.qpos0 = 0; U.L = 0; U.lf = U.lb = 0.f; U.s0f = U.s0b = nullptr; U.st_out = nullptr; U.mode = 0;
    const bf16_t* GQ = (const bf16_t*)(ws + WS_GQ); const bf16_t* GK = (const bf16_t*)(ws + WS_GK); const bf16_t* GV = (const bf16_t*)(ws + WS_GV);
    const bf16_t* QM = (const bf16_t*)(ws + WS_QM); const bf16_t* KVM = (const bf16_t*)(ws + WS_KVM); const bf16_t* KVMC = (const bf16_t*)(ws + WS_KVMC);
    const bf16_t* KPEB = (const bf16_t*)(ws + WS_KPEB); const bf16_t* CKPE = (const bf16_t*)(ws + WS_CKPE);
    const bf16_t* CGK = (const bf16_t*)(ws + WS_CGK); const bf16_t* CGV = (const bf16_t*)(ws + WS_CGV);
    const bf16_t* RQ = (const bf16_t*)(ws + WS_RQ); const bf16_t* RK = (const bf16_t*)(ws + WS_RK); const bf16_t* RV = (const bf16_t*)(ws + WS_RV);
    const float* decay = p.in[I_DECAY] + l * 8;
    if (u < 192 || (u >= 512 && u < 704)) {
        const bool lat = u < 192; const int uu = lat ? u : u - 512;
        const int b = lat ? uu / 48 : uu / 12, hh = lat ? (uu >> 3) % 6 : (uu >> 1) % 6, qb = lat ? (uu & 7) : (uu & 1);
        const int seq0 = lat ? 4096 + b * 1024 : b * 256;
        U.mode = 1; U.tok0 = seq0 + qb * 128; U.q = QM + (size_t)U.tok0 * 576 + hh * 96; U.q_ld = 576; U.ycol = 640 + hh * 64;
        U.nt1 = lat ? 16 : 4; U.k1 = KVM + (size_t)seq0 * 768 + hh * 128; U.k_ld1 = 768; U.v1 = U.k1 + 64; U.v_ld1 = 768; U.pe1 = KPEB + (size_t)seq0 * 32;
        U.k0 = U.k1; U.v0 = U.v1; U.pe0 = U.pe1; U.k_ld0 = 768; U.v_ld0 = 768;
        if (lat) { U.nt0 = 8; U.k0 = KVMC + (size_t)(b * 512) * 768 + hh * 128; U.v0 = U.k0 + 64; U.pe0 = CKPE + (size_t)((b * 4 + l) * 512) * 32; }
        attn_unit<1>(F, p, U);
    } else if (u < 384 || (u >= 704 && u < 896)) {
        const bool lat = u < 384; const int uu = lat ? u - 192 : u - 704;
        const int b = lat ? uu / 48 : uu / 12, hh = lat ? (uu >> 3) % 6 : (uu >> 1) % 6, qb = lat ? (uu & 7) : (uu & 1), kvh = hh / 3;
        const int seq0 = lat ? 4096 + b * 1024 : b * 256;
        U.mode = 0; U.tok0 = seq0 + qb * 128; U.q = GQ + (size_t)U.tok0 * 384 + hh * 64; U.q_ld = 384; U.ycol = 256 + hh * 64;
        U.nt1 = lat ? 16 : 4; U.k1 = GK + (size_t)seq0 * 128 + kvh * 64; U.k_ld1 = 128; U.v1 = GV + (size_t)seq0 * 128 + kvh * 64; U.v_ld1 = 128;
        U.k0 = U.k1; U.v0 = U.v1; U.k_ld0 = 128; U.v_ld0 = 128;
        if (lat) { U.nt0 = 8; U.k0 = CGK + (size_t)((b * 4 + l) * 512) * 128 + kvh * 64; U.v0 = CGV + (size_t)((b * 4 + l) * 512) * 128 + kvh * 64; }
        attn_unit<0>(F, p, U);
    } else if (u < 512 || (u >= 896 && u < 1024)) {
        const bool lat = u < 512; const int uu = lat ? u - 384 : u - 896;
        const int b = lat ? uu / 32 : uu / 8, hh = lat ? (uu >> 3) & 3 : (uu >> 1) & 3, qb = lat ? (uu & 7) : (uu & 1);
        const int seq0 = lat ? 4096 + b * 1024 : b * 256;
        U.mode = 2; U.tok0 = seq0 + qb * 128; U.q = RQ + (size_t)U.tok0 * 256 + hh * 64; U.q_ld = 256; U.ycol = hh * 64;
        U.nt1 = lat ? 16 : 4; U.k1 = RK + (size_t)seq0 * 256 + hh * 64; U.k_ld1 = 256; U.v1 = RV + (size_t)seq0 * 256 + hh * 64; U.v_ld1 = 256;
        U.k0 = U.k1; U.v0 = U.v1; U.k_ld0 = 256; U.v_ld0 = 256;
        U.qpos0 = qb * 128; U.L = lat ? 1024 : 256;
        U.lf = -log1pf(__expf(-decay[hh])) * LOG2E; U.lb = -log1pf(__expf(-decay[4 + hh])) * LOG2E;
        if (lat) { const bf16_t* S0T = (const bf16_t*)(ws + WS_S0T); U.s0f = S0T + (size_t)(((b * 4 + l) * 2 + 0) * 4 + hh) * 4096; U.s0b = S0T + (size_t)(((b * 4 + l) * 2 + 1) * 4 + hh) * 4096; }
        attn_unit<2>(F, p, U);
    } else {
        const int uu = u - 1024, b = uu >> 2, hh = uu & 3, seq0 = b * 256;
        U.mode = 3; U.nt1 = 4; U.k1 = RK + (size_t)seq0 * 256 + hh * 64; U.k_ld1 = 256; U.v1 = RV + (size_t)seq0 * 256 + hh * 64; U.v_ld1 = 256;
        U.k0 = U.k1; U.v0 = U.v1; U.k_ld0 = 256; U.v_ld0 = 256;
        U.lf = -log1pf(__expf(-decay[hh])) * LOG2E; U.lb = -log1pf(__expf(-decay[4 + hh])) * LOG2E;
        U.st_out = p.out + O_STATE + (size_t)(((b * 4 + l) * 2 + 0) * 4 + hh) * 4096;
        attn_unit<3>(F, p, U);
    }
}
constexpr int N_ATTN_UNITS = 1088;
__device__ __forceinline__ void p0_transpose_item(const float* W, int K, int Nsrc, int src_n0, bf16_t* WT, int dest_row0, int k0, LAS float* scr, int lane) {
    if (src_n0 >= 0) {
        float r[32];
        const float* wp = W + (size_t)(k0 + (lane >> 5)) * Nsrc + src_n0 + (lane & 31);
#pragma unroll
        for (int i = 0; i < 32; ++i) r[i] = wp[(size_t)(2 * i) * Nsrc];
#pragma unroll
        for (int i = 0; i < 32; ++i) scr[(2 * i + (lane >> 5)) * 33 + (lane & 31)] = r[i];
    } else {
#pragma unroll 8
        for (int i = 0; i < 32; ++i) { const int kk = 2 * i + (lane >> 5); scr[kk * 33 + (lane & 31)] = 0.f; }
    }
    asm volatile("s_waitcnt lgkmcnt(0)" ::: "memory");
    __builtin_amdgcn_wave_barrier();
    const int c = lane & 7;
#pragma unroll
    for (int j = 0; j < 4; ++j) {
        const int n = (lane >> 3) + 8 * j; const LAS float* s = scr + (8 * c) * 33 + n;
        u32x4 o; o.x = pk2(s[0 * 33], s[1 * 33]); o.y = pk2(s[2 * 33], s[3 * 33]); o.z = pk2(s[4 * 33], s[5 * 33]); o.w = pk2(s[6 * 33], s[7 * 33]);
        *(u32x4*)(WT + (size_t)(dest_row0 + n) * K + k0 + 8 * c) = o;
    }
    asm volatile("s_waitcnt lgkmcnt(0)" ::: "memory");
    __builtin_amdgcn_wave_barrier();
}
__device__ __forceinline__ void cast8(const float* src, bf16_t* dst, size_t e) {
    const f32x4 a = *(const f32x4*)(src + e), b = *(const f32x4*)(src + e + 4);
    u32x4 o; o.x = pk2(a[0], a[1]); o.y = pk2(a[2], a[3]); o.z = pk2(b[0], b[1]); o.w = pk2(b[2], b[3]);
    *(u32x4*)(dst + e) = o;
}
constexpr int P0_MODS = 1536, P0_TWIN = 4 * 16 * 92, P0_TWOUT = 4 * 16 * 32, P0_TWUQ = 4 * 4 * 20, P0_TWUKV = 4 * 2 * 24;
constexpr int P0_CAST_G = 512, P0_CAST_KPE = 128, P0_S0T = 512, P0_R64 = 512, P0_R32 = 256;
constexpr int P0_TOTAL = P0_MODS + P0_TWIN + P0_TWOUT + P0_TWUQ + P0_TWUKV + 3 * P0_CAST_G + P0_CAST_KPE + P0_S0T + P0_R64 + P0_R32;
__device__ __forceinline__ void phase0(const Frame& F, const Params& p, bool dup = false) {
    unsigned char* ws = F.ws + (dup ? 162 * MiB : 0); const int lane = F.lane;
    LAS float* scr = (LAS float*)F.lds + F.w * (64 * 33);
    const int gw = blockIdx.x * 4 + F.w, ngw = gridDim.x * 4;
    for (int it0 = gw; it0 < P0_TOTAL; it0 += ngw) {
        int it = it0;
        if (it < P0_MODS) {
            const int l = it / 384, cg = (it % 384) >> 5, ks = it & 31;
            const int j = cg * 256 + lane * 4;
            const float* wp = p.in[I_WADA] + ((size_t)l * 1024 + ks * 32) * 3072 + j;
            const float* c = p.in[I_C]; const float* cc = p.in[I_CCTX];
            f32x4 acc[5];
#pragma unroll
            for (int n = 0; n < 5; ++n) acc[n] = (f32x4){0.f, 0.f, 0.f, 0.f};
#pragma unroll
            for (int k0 = 0; k0 < 32; k0 += 16) {
                f32x4 wv[16];
#pragma unroll
                for (int k = 0; k < 16; ++k) wv[k] = *(const f32x4*)(wp + (size_t)(k0 + k) * 3072);
#pragma unroll
                for (int k = 0; k < 16; ++k) {
                    const int kk = ks * 32 + k0 + k;
                    acc[0] += wv[k] * silu_f(cc[kk]);
#pragma unroll
                    for (int n = 1; n < 5; ++n) acc[n] += wv[k] * silu_f(c[(n - 1) * 1024 + kk]);
                }
            }
            float* mods = (float*)(ws + WS_MODS);
#pragma unroll
            for (int n = 0; n < 5; ++n) {
                if (ks == 0) acc[n] += *(const f32x4*)(p.in[I_BADA] + l * 3072 + j);
#pragma unroll
                for (int e = 0; e < 4; ++e) atomicAdd(mods + (size_t)(l * 5 + n) * 3072 + j + e, acc[n][e]);
            }
            continue;
        }
        it -= P0_MODS;
        if (it < P0_TWIN) {
            const int l = it / (16 * 92), r = it % (16 * 92), kb = r / 92, nb = r % 92, n0 = nb * 32;
            const int src = n0 < 1792 ? n0 : (n0 < 2816 ? n0 + 32 : (n0 < 2848 ? n0 - 2816 + 1792 : -1));
            p0_transpose_item(p.in[I_WIN] + (size_t)l * 1024 * 2848, 1024, 2848, src, (bf16_t*)(ws + WS_WIN) + (size_t)l * 2944 * 1024, n0, kb * 64, scr, lane);
            continue;
        }
        it -= P0_TWIN;
        if (it < P0_TWOUT) {
            const int l = it / 512, r = it % 512, kb = r >> 5, nb = r & 31;
            p0_transpose_item(p.in[I_WOUT] + (size_t)l * 1024 * 1024, 1024, 1024, nb * 32, (bf16_t*)(ws + WS_WOUT) + (size_t)l * 1024 * 1024, nb * 32, kb * 64, scr, lane);
            continue;
        }
        it -= P0_TWOUT;
        if (it < P0_TWUQ) {
            const int l = it / 80, r = it % 80, kb = r / 20, nb = r % 20;
            p0_transpose_item(p.in[I_WUQ] + (size_t)l * 256 * 576, 256, 576, nb < 18 ? nb * 32 : -1, (bf16_t*)(ws + WS_WUQ) + (size_t)l * 640 * 256, nb * 32, kb * 64, scr, lane);
            continue;
        }
        it -= P0_TWUQ;
        if (it < P0_TWUKV) {
            const int l = it / 48, r = it % 48, kb = r / 24, nb = r % 24;
            p0_transpose_item(p.in[I_WUKV] + (size_t)l * 128 * 768, 128, 768, nb * 32, (bf16_t*)(ws + WS_WUKV) + (size_t)l * 768 * 128, nb * 32, kb * 64, scr, lane);
            continue;
        }
        it -= P0_TWUKV;
        if (it < 3 * P0_CAST_G) {
            const int which = it / P0_CAST_G, r = it % P0_CAST_G;
            const float* src = which == 0 ? p.in[I_CGK] : (which == 1 ? p.in[I_CGV] : p.in[I_CCKV]);
            bf16_t* dst = (bf16_t*)(ws + (which == 0 ? WS_CGK : (which == 1 ? WS_CGV : WS_CCKV)));
#pragma unroll
            for (int q = 0; q < 4; ++q) cast8(src, dst, (size_t)r * 2048 + q * 512 + lane * 8);
            continue;
        }
        it -= 3 * P0_CAST_G;
        if (it < P0_CAST_KPE) {
#pragma unroll
            for (int q = 0; q < 4; ++q) cast8(p.in[I_CKPE], (bf16_t*)(ws + WS_CKPE), (size_t)it * 2048 + q * 512 + lane * 8);
            continue; }
        it -= P0_CAST_KPE;
        if (it < P0_S0T) {
            const int mat = it >> 2, qd = it & 3, dv = qd * 16 + (lane >> 2), dk0 = (lane & 3) * 16;
            const float* s = p.in[I_STATE] + (size_t)mat * 4096 + dv;
            float x[16];
#pragma unroll
            for (int i = 0; i < 16; ++i) x[i] = s[(dk0 + i) * 64];
            u32x4 o0, o1;
            o0.x = pk2(x[0], x[1]); o0.y = pk2(x[2], x[3]); o0.z = pk2(x[4], x[5]); o0.w = pk2(x[6], x[7]);
            o1.x = pk2(x[8], x[9]); o1.y = pk2(x[10], x[11]); o1.z = pk2(x[12], x[13]); o1.w = pk2(x[14], x[15]);
            bf16_t* d = (bf16_t*)(ws + WS_S0T) + (size_t)mat * 4096 + dv * 64 + dk0;
            *(u32x4*)d = o0; *(u32x4*)(d + 8) = o1;
            continue;
        }
        it -= P0_S0T;
        if (it < P0_R64) {
            const int e = it * 64 + lane, t = e >> 5, j = e & 31, i = j & 15;
            const float pos = (float)(j < 16 ? (t >> 6) : (t & 63));
            const float a = pos * exp2f(-(float)i * (13.287712379549449f / 16.f));
            ((f32x2*)(ws + WS_ROPE64))[e] = (f32x2){cosf(a), sinf(a)};
            continue;
        }
        it -= P0_R64;
        {
            const int e = it * 64 + lane, t = e >> 4, j = e & 15, i = j & 7;
            const float pos = (float)(j < 8 ? (t >> 6) : (t & 63));
            const float a = pos * exp2f(-(float)i * (13.287712379549449f / 8.f));
            ((f32x2*)(ws + WS_ROPE32))[e] = (f32x2){cosf(a), sinf(a)};
        }
    }
}
constexpr int P1_GS = 80, P1_BIAS = 4 * 2944, P1_X = 8192, P1_TOTAL = P1_GS + P1_BIAS + P1_X;
__device__ __forceinline__ void xg_row(const Frame& F, const float* xrow, const float* g, const float* mods_c, bf16_t* xg_row_out, float* ssq_row, bool write_xg) {
    const int lane = F.lane;
    float ss = 0.f;
#pragma unroll
    for (int j = 0; j < 4; ++j) {
        const int k = j * 256 + lane * 4;
        const f32x4 x = *(const f32x4*)(xrow + k);
        ss += (x[0] * x[0] + x[1] * x[1]) + (x[2] * x[2] + x[3] * x[3]);
        if (write_xg) {
            const f32x4 gg = *(const f32x4*)(g + k), sc = *(const f32x4*)(mods_c + 1024 + k);
            u32x2 o; o.x = pk2(x[0] * gg[0] * (1.f + sc[0]), x[1] * gg[1] * (1.f + sc[1])); o.y = pk2(x[2] * gg[2] * (1.f + sc[2]), x[3] * gg[3] * (1.f + sc[3]));
            *(u32x2*)(xg_row_out + k) = o;
        }
    }
    ss = wsum(ss);
    if (lane < 16) ssq_row[lane] = lane == 0 ? ss : 0.f;
}
__device__ __forceinline__ void phase1(const Frame& F, const Params& p) {
    unsigned char* ws = F.ws; const int lane = F.lane;
    const int gw = blockIdx.x * 4 + F.w, ngw = gridDim.x * 4;
    const float* mods = (const float*)(ws + WS_MODS);
    for (int it0 = gw; it0 < P1_TOTAL; it0 += ngw) {
        int it = it0;
        if (it < P1_GS) {
            const int e = it * 256 + lane * 4, lc = e >> 10, k = e & 1023, l = lc / 5;
            const f32x4 g = *(const f32x4*)(p.in[I_NORMG] + l * 1024 + k), sc = *(const f32x4*)(mods + (size_t)lc * 3072 + 1024 + k);
            *(f32x4*)((float*)(ws + WS_GS) + e) = g * (sc + 1.f);
            continue;
        }
        it -= P1_GS;
        if (it < P1_BIAS) {
            const int l = it / 2944, n = it % 2944;
            const bf16_t* wr = (const bf16_t*)(ws + WS_WIN) + ((size_t)l * 2944 + n) * 1024 + lane * 16;
            const u32x4 w0 = *(const u32x4*)wr, w1 = *(const u32x4*)(wr + 8);
            float wv[16];
#pragma unroll
            for (int i = 0; i < 4; ++i) { wv[2 * i] = bflo(w0[i]); wv[2 * i + 1] = bfhi(w0[i]); wv[8 + 2 * i] = bflo(w1[i]); wv[8 + 2 * i + 1] = bfhi(w1[i]); }
#pragma unroll
            for (int c = 0; c < 5; ++c) {
                const float* sh = mods + (size_t)(l * 5 + c) * 3072 + lane * 16;
                float d = 0.f;
#pragma unroll
                for (int i = 0; i < 4; ++i) { const f32x4 s4 = *(const f32x4*)(sh + 4 * i); d += (s4[0] * wv[4 * i] + s4[1] * wv[4 * i + 1]) + (s4[2] * wv[4 * i + 2] + s4[3] * wv[4 * i + 3]); }
                d = wsum(d);
                if (lane == 0) ((float*)(ws + WS_BIAS))[(size_t)(l * 5 + c) * 2944 + n] = d;
            }
            continue;
        }
        it -= P1_BIAS;
        {
            const int tok = it; const bool lat = tok >= 4096;
            const float* xr = lat ? p.in[I_XS] + (size_t)(tok - 4096) * 1024 : p.in[I_XP] + (size_t)tok * 1024;
            const int cond = lat ? 1 + ((tok - 4096) >> 10) : 0;
            xg_row(F, xr, p.in[I_NORMG], mods + (size_t)cond * 3072, (bf16_t*)(ws + WS_XG) + (size_t)tok * 1024, (float*)(ws + WS_SSQ) + (size_t)tok * 16, true);
        }
    }
}
#ifndef MK_TIMING
#define MK_TIMING -1
#endif
constexpr int CW_TIME = 2048;
__device__ __forceinline__ void phase_final(const Frame& F, const Params& p) {
    const int lane = F.lane;
    float tf = 1.f;
    if (MK_TIMING >= 0) tf = __uint_as_float(__hip_atomic_load((unsigned*)(F.ws + WS_CTL) + CW_TIME, __ATOMIC_RELAXED, __HIP_MEMORY_SCOPE_AGENT));
    const int gw = blockIdx.x * 4 + F.w, ngw = gridDim.x * 4;
    for (int tok = gw; tok < 8192; tok += ngw) {
        float ss = 0.f;
        if (lane < 16) ss = ((const float*)(F.ws + WS_SSQ))[(size_t)tok * 16 + lane];
        ss = wsum(ss);
        const float rstd = rsqrtf(ss * (1.f / 1024.f) + EPS);
        const float* xr = p.xs + (size_t)tok * 1024; float* orow = p.out + (size_t)tok * 1024;
#pragma unroll
        for (int j = 0; j < 4; ++j) {
            const int k = j * 256 + lane * 4;
            const f32x4 x = *(const f32x4*)(xr + k), fn = *(const f32x4*)(p.in[I_FNORM] + k);
            *(f32x4*)(orow + k) = x * fn * (rstd * tf);
        }
    }
}

#ifndef MK_EN
#define MK_EN 0xff
#endif
#define EN(x) ((MK_EN >> (x)) & 1)
constexpr int PH_TOTAL = 19;
__global__ void __launch_bounds__(256, 2) mega(Params p) {
    extern __shared__ __attribute__((aligned(16))) unsigned char lds_raw[];
    Frame F;
    F.lds = (LAS unsigned char*)lds_raw;
    F.tid = threadIdx.x; F.lane = F.tid & 63; F.w = __builtin_amdgcn_readfirstlane(F.tid >> 6); F.h = F.lane >> 5; F.lq = F.lane & 31;
    F.ws = p.ws;
    volatile LAS unsigned* MISC = (volatile LAS unsigned*)(F.lds + LDS_MISC);
    if (F.tid < 64) MISC[F.tid] = 0u;
    __syncthreads();
    unsigned* ctl = (unsigned*)(p.ws + WS_CTL);
    XcdBarrier bar; bar.bar = ctl + CW_BAR; bar.x = 0; bar.st = nullptr;
    const bool multi = p.ph_hi - p.ph_lo > 1;
    if (multi) bar = xcd_barrier_post(ctl + CW_BAR, MISC + 8);
    const int G = gridDim.x;
    const Frame F0 = F;
    for (int ph = p.ph_lo; ph < p.ph_hi; ++ph) {
        Frame F = F0;
        asm volatile("" : "+v"(F.tid), "+v"(F.lane), "+v"(F.h), "+v"(F.lq));
        asm volatile("" : "+s"(F.w), "+s"(F.ws));
        if (MK_TIMING >= 0 && blockIdx.x == 0 && F.tid == 0) {
            const unsigned long long now = __builtin_amdgcn_s_memrealtime();
            const unsigned long long prev = ((unsigned long long)MISC[17] << 32) | MISC[16];
            if (ph > p.ph_lo) { const int q = ph - 1; const int grp = q < 2 ? q : 2 + ((q - 2) & 3); if (grp == MK_TIMING) MISC[18] += (unsigned)(now - prev); }
            MISC[16] = (unsigned)now; MISC[17] = (unsigned)(now >> 32);
        }
#ifndef MK_REPEAT
#define MK_REPEAT -1
#endif
        int nrep = 1;
        if (MK_REPEAT >= 1) { const int grp = ph < 2 ? ph : (ph == 18 ? 6 : 2 + ((ph - 2) & 3)); if (grp == MK_REPEAT) nrep = (grp == 5) ? (ph == 5 ? 5 : 1) : 2; }
        for (int rep = 0; rep < nrep; ++rep) {
        if (rep > 0) xcd_barrier(bar);
        Frame F = F0;
        asm volatile("" : "+v"(F.tid), "+v"(F.lane), "+v"(F.h), "+v"(F.lq));
        asm volatile("" : "+s"(F.w), "+s"(F.ws));
        if (EN(0) && ph == 0) {
#if defined(MK_DUP0)
            for (int d = 0; d < 2; ++d) { int dd = d; asm volatile("" : "+s"(dd)); if (dd) xcd_barrier(bar); phase0(F, p, dd != 0); }
#else
            phase0(F, p);
#endif
        }
        else if (EN(1) && ph == 1) phase1(F, p);
        else if (EN(2) && ph == 18) phase_final(F, p);
        else {
            const int l = (ph - 2) >> 2, sub = (ph - 2) & 3;
            if (EN(3) && sub == 0) {
                const bf16_t* Wt = (const bf16_t*)(F.ws + WS_WIN) + (size_t)l * 2944 * 1024;
                const bf16_t* X = (const bf16_t*)(F.ws + WS_XG);
                for (int j = blockIdx.x; j < 23 * 64; j += G) {
                    const int tn = j >> 6, tm = j & 63;
                    f32x16 acc[2][2];
                    float rstd2[2];
                    gemm1_rstd(F, tm, rstd2);
                    gemm_core(F, Wt + (size_t)tn * 128 * 1024, 1024, X + (size_t)tm * 128 * 1024, 1024, 1024, acc);
#if defined(MK_KLOOP2) && (MK_KLOOP2 & 1)
                    asm volatile("" : "+v"(acc[0][0]), "+v"(acc[0][1]), "+v"(acc[1][0]), "+v"(acc[1][1]));
                    gemm_core(F, Wt + (size_t)tn * 128 * 1024, 1024, X + (size_t)tm * 128 * 1024, 1024, 1024, acc);
#endif
                    epi_gemm1(F, p, acc, tn, tm, l, rstd2);
                }
            } else if (EN(4) && sub == 1) {
                for (int j = blockIdx.x; j < 800; j += G) {
                    f32x16 acc[2][2];
                    if (j < 320) {
                        const int tn = j >> 6, tm = j & 63;
                        gemm_core(F, (const bf16_t*)(F.ws + WS_WUQ) + ((size_t)l * 640 + tn * 128) * 256, 256, (const bf16_t*)(F.ws + WS_CQG) + (size_t)tm * 128 * 256, 256, 256, acc);
                        epi_qm(F, acc, tn, tm);
                    } else if (j < 704) {
                        const int jj = j - 320, tn = jj >> 6, tm = jj & 63;
                        gemm_core(F, (const bf16_t*)(F.ws + WS_WUKV) + ((size_t)l * 768 + tn * 128) * 128, 128, (const bf16_t*)(F.ws + WS_CKVN) + (size_t)tm * 128 * 128, 128, 128, acc);
                        epi_plain(F, acc, (bf16_t*)(F.ws + WS_KVM), 768, tm * 128, tn * 128);
                    } else {
                        const int jj = j - 704, tn = jj >> 4, tc = jj & 15, b = tc >> 2, jt = tc & 3;
                        gemm_core(F, (const bf16_t*)(F.ws + WS_WUKV) + ((size_t)l * 768 + tn * 128) * 128, 128,
                                  (const bf16_t*)(F.ws + WS_CCKV) + ((size_t)(b * 4 + l) * 512 + jt * 128) * 128, 128, 128, acc);
                        epi_plain(F, acc, (bf16_t*)(F.ws + WS_KVMC), 768, b * 512 + jt * 128, tn * 128);
                    }
                }
            } else if (EN(5) && sub == 2) {
                for (;;) {
                    __syncthreads();
                    if (F.tid == 0) MISC[0] = atomicAdd(ctl + CW_QUEUE + 64 * l + 32 * rep, 1u);
                    __syncthreads();
                    const int u = __builtin_amdgcn_readfirstlane((int)MISC[0]);
                    if (u >= N_ATTN_UNITS) break;
                    attn_dispatch(F, p, u, l);
                }
            } else if (EN(6)) {
                const bf16_t* Wt = (const bf16_t*)(F.ws + WS_WOUT) + (size_t)l * 1024 * 1024;
                const bf16_t* Yb = (const bf16_t*)(F.ws + WS_Y);
                for (int j = blockIdx.x; j < 8 * 64; j += G) {
                    const int tn = j >> 6, tm = j & 63;
                    f32x16 acc[2][2];
                    gemm_core(F, Wt + (size_t)tn * 128 * 1024, 1024, Yb + (size_t)tm * 128 * 1024, 1024, 1024, acc);
#if defined(MK_KLOOP2) && (MK_KLOOP2 & 2)
                    asm volatile("" : "+v"(acc[0][0]), "+v"(acc[0][1]), "+v"(acc[1][0]), "+v"(acc[1][1]));
                    gemm_core(F, Wt + (size_t)tn * 128 * 1024, 1024, Yb + (size_t)tm * 128 * 1024, 1024, 1024, acc);
#endif
                    epi_gemm2(F, p, acc, tn, tm, l);
                }
            }
        }
        }
        if (MK_TIMING >= 0 && ph == 17 && blockIdx.x == 0 && F.tid == 0) {
            const unsigned long long now = __builtin_amdgcn_s_memrealtime();
            const unsigned long long prev = ((unsigned long long)MISC[17] << 32) | MISC[16];
            unsigned a = MISC[18]; if (MK_TIMING == 5) a += (unsigned)(now - prev);
            __hip_atomic_store(ctl + CW_TIME, __float_as_uint(1.f + (float)a * 1e-5f), __ATOMIC_RELAXED, __HIP_MEMORY_SCOPE_AGENT);
        }
        if (ph + 1 < p.ph_hi) xcd_barrier(bar);
    }
}
}

extern "C" void kernel_launch(void* const* d_in, const int* in_sizes, int n_in, void* d_out, int out_size, void* d_ws, size_t ws_size, hipStream_t stream) {
    static int grid = 0;
    if (!grid) {
        int dev = 0, cus = 0, per_cu = 0;
        (void)hipGetDevice(&dev);
        (void)hipDeviceGetAttribute(&cus, hipDeviceAttributeMultiprocessorCount, dev);
        (void)hipFuncSetAttribute((const void*)mk::mega, hipFuncAttributeMaxDynamicSharedMemorySize, mk::LDS_BYTES);
        (void)hipOccupancyMaxActiveBlocksPerMultiprocessor(&per_cu, (const void*)mk::mega, 256, mk::LDS_BYTES);
        if (per_cu > 2) per_cu = 2;
        if (per_cu < 1) per_cu = 1;
        if (cus < 1) cus = 256;
        grid = cus * per_cu;
    }
    unsigned char* ws = (unsigned char*)d_ws;
    (void)hipMemsetAsync(ws, 0, mk::CTL_ZERO_BYTES, stream);
    mk::Params P{};
    for (int i = 0; i < 22; ++i) P.in[i] = (const float*)d_in[i];
    P.out = (float*)d_out; P.ws = ws; P.xs = (float*)d_out;
    P.ph_lo = 0; P.ph_hi = mk::PH_TOTAL;
    void* args[] = {&P};
    (void)hipLaunchCooperativeKernel((const void*)mk::mega, dim3(grid), dim3(256), args, mk::LDS_BYTES, stream);
}
```

```cpp
#include <hip/hip_runtime.h>
#include <stdint.h>
namespace mk {
#define LAS __attribute__((address_space(3)))
typedef unsigned short bf16_t;
typedef short bf16x8 __attribute__((ext_vector_type(8)));
typedef short s16x4 __attribute__((ext_vector_type(4)));
typedef float f32x16 __attribute__((ext_vector_type(16)));
typedef float f32x4 __attribute__((ext_vector_type(4)));
typedef float f32x2 __attribute__((ext_vector_type(2)));
typedef unsigned u32x4 __attribute__((ext_vector_type(4)));
typedef unsigned u32x2 __attribute__((ext_vector_type(2)));
typedef __bf16 bf16x2_t __attribute__((ext_vector_type(2)));

constexpr float EPS = 1e-6f;
constexpr float LOG2E = 1.4426950408889634f;
constexpr float QSC_GQA = 0.125f * LOG2E;
constexpr float QSC_MLA = 0.10206207261596575f * LOG2E;

__device__ __forceinline__ unsigned pk2(float lo, float hi) { f32x2 v = {lo, hi}; bf16x2_t b = __builtin_convertvector(v, bf16x2_t); return __builtin_bit_cast(unsigned, b); }
__device__ __forceinline__ float bf2f(unsigned short u) { return __uint_as_float((unsigned)u << 16); }
__device__ __forceinline__ float bflo(unsigned u) { return __uint_as_float(u << 16); }
__device__ __forceinline__ float bfhi(unsigned u) { return __uint_as_float(u & 0xffff0000u); }
__device__ __forceinline__ float silu_f(float x) { return x * __builtin_amdgcn_rcpf(1.f + __builtin_amdgcn_exp2f(-x * LOG2E)); }
__device__ __forceinline__ float wsum(float v) {
#pragma unroll
    for (int o = 32; o > 0; o >>= 1) v += __shfl_xor(v, o);
    return v;
}

constexpr size_t MiB = 1u << 20;
constexpr size_t WS_CTL = 0, CTL_ZERO_BYTES = 1 * MiB;
constexpr size_t WS_MODS = 256 * 1024;
constexpr size_t WS_BIAS = 1 * MiB;
constexpr size_t WS_GS = 1 * MiB + 256 * 1024;
constexpr size_t WS_ROPE64 = 1 * MiB + 512 * 1024;
constexpr size_t WS_ROPE32 = 1 * MiB + 768 * 1024;
constexpr size_t WS_SSQ = 2 * MiB;
constexpr size_t WS_CQSSQ = 2 * MiB + 512 * 1024;
constexpr size_t WS_S0T = 3 * MiB;
constexpr size_t WS_CGK = 4 * MiB, WS_CGV = 6 * MiB, WS_CCKV = 8 * MiB, WS_CKPE = 10 * MiB;
constexpr size_t WS_WIN = 11 * MiB;
constexpr size_t WS_WOUT = 34 * MiB;
constexpr size_t WS_WUQ = 42 * MiB;
constexpr size_t WS_WUKV = 43 * MiB + 256 * 1024;
constexpr size_t WS_XG = 44 * MiB;
constexpr size_t WS_KVM = 44 * MiB;
constexpr size_t WS_KVMC = 56 * MiB;
constexpr size_t WS_RQ = 60 * MiB, WS_RK = 64 * MiB, WS_RV = 68 * MiB;
constexpr size_t WS_GQ = 72 * MiB;
constexpr size_t WS_GK = 78 * MiB, WS_GV = 80 * MiB;
constexpr size_t WS_CQG = 82 * MiB;
constexpr size_t WS_CKVN = 86 * MiB;
constexpr size_t WS_KPEB = 88 * MiB;
constexpr size_t WS_ZS = 89 * MiB;
constexpr size_t WS_QM = 105 * MiB;
constexpr size_t WS_Y = 114 * MiB;
constexpr size_t WS_XSDBG = 130 * MiB;
constexpr size_t WS_OPT_END = 162 * MiB;
constexpr int CW_QUEUE = 1024;
constexpr int CW_BAR = 4096;

constexpr size_t O_STATE = 8388608, O_GK = 10485760, O_GV = 12582912, O_CKV = 14680064, O_KPE = 16777216;

constexpr int NWAVE = 8;
constexpr int GST = 49152;
constexpr int LDS_EX = 98304;
constexpr int LDS_SCAL = 100352;
constexpr int LDS_MISC = 101376;
constexpr int LDS_BYTES = 101632;

struct Params { const float* in[22]; float* out; unsigned char* ws; float* xs; int ph_lo, ph_hi; };
enum { I_XP = 0, I_XS, I_STATE, I_CGK, I_CGV, I_CCKV, I_CKPE, I_C, I_CCTX, I_NORMG, I_WADA, I_BADA, I_WIN, I_DECAY, I_GQN, I_GKN, I_MQN, I_MKVN, I_WUQ, I_WUKV, I_WOUT, I_FNORM };

#define XB_TMO      128
#define XB_XCNT(j)  (256  + 64 * (j))
#define XB_XSUB(j)  (1280 + 64 * (j))
#define XB_XGEN(j)  (2304 + 64 * (j))
#define XB_TOP      3328
#define XB_TOPGEN   3392
#define XB_SPIN_CAP (1u << 20)
__device__ __forceinline__ unsigned xb_ld(unsigned* p) { return __hip_atomic_load(p, __ATOMIC_RELAXED, __HIP_MEMORY_SCOPE_AGENT); }
__device__ __forceinline__ unsigned xb_add(unsigned* p, unsigned v) { return __hip_atomic_fetch_add(p, v, __ATOMIC_RELAXED, __HIP_MEMORY_SCOPE_AGENT); }
__device__ __forceinline__ unsigned xb_xcc_id() { return (unsigned)__builtin_amdgcn_s_getreg((3 << 11) | 20) & 0xFu; }
#define XB_SPIN(cond, bar) do { unsigned _sp = 0; while (cond) { __builtin_amdgcn_s_sleep(1); \
    if ((++_sp & 255u) == 0u) { if (xb_ld(&(bar)[XB_TMO])) break; if (_sp > XB_SPIN_CAP) { atomicAdd(&(bar)[XB_TMO], 1u); break; } } } } while (0)
struct XcdBarrier { unsigned* bar; unsigned x; volatile LAS unsigned* st; };
__device__ __forceinline__ XcdBarrier xcd_barrier_post(unsigned* bar, volatile LAS unsigned* st) {
    XcdBarrier b; b.bar = bar; b.x = xb_xcc_id(); b.st = st;
    if (threadIdx.x == 0) (void)xb_add(&bar[XB_XCNT(b.x)], 1u);
    return b;
}
__device__ __forceinline__ void xcd_barrier_complete(unsigned* bar, unsigned x, unsigned& nloc, unsigned& nx) {
    const unsigned G = gridDim.x * gridDim.y * gridDim.z;
    unsigned sum, cnt, mine, sp = 0u;
    for (;;) {
        sum = 0u; cnt = 0u; mine = 0u;
#pragma unroll
        for (unsigned j = 0; j < 16; ++j) { const unsigned c = xb_ld(&bar[XB_XCNT(j)]); sum += c; cnt += (c > 0u) ? 1u : 0u; mine = (j == x) ? c : mine; }
        if (sum == G) break;
        __builtin_amdgcn_s_sleep(1);
        if ((++sp & 255u) == 0u) { if (xb_ld(&bar[XB_TMO])) break; if (sp > XB_SPIN_CAP) { atomicAdd(&bar[XB_TMO], 1u); break; } }
    }
    nloc = mine > 0u ? mine : 1u; nx = cnt > 0u ? cnt : 1u;
}
__device__ __forceinline__ void xcd_barrier(const XcdBarrier& b) {
    asm volatile("s_waitcnt vmcnt(0)" ::: "memory");
    __syncthreads();
    if (threadIdx.x == 0) {
        unsigned* bar = b.bar;
        __builtin_amdgcn_s_waitcnt(0);
        unsigned nloc = b.st[0], nx = b.st[1];
        if (nloc == 0u) { xcd_barrier_complete(bar, b.x, nloc, nx); b.st[0] = nloc; b.st[1] = nx; }
        const unsigned old = xb_add(&bar[XB_XSUB(b.x)], 1u);
        const unsigned gen = old / nloc;
        if (old + 1u == (gen + 1u) * nloc) {
            __builtin_amdgcn_fence(__ATOMIC_RELEASE, "agent");
            asm volatile("s_waitcnt vmcnt(0)" ::: "memory");
            const unsigned og = xb_add(&bar[XB_TOP], 1u);
            const unsigned tg = og / nx;
            if (og + 1u == (tg + 1u) * nx) xb_add(&bar[XB_TOPGEN], 1u);
            else XB_SPIN(xb_ld(&bar[XB_TOPGEN]) == tg, bar);
            __builtin_amdgcn_fence(__ATOMIC_ACQUIRE, "agent");
            xb_add(&bar[XB_XGEN(b.x)], 1u);
            asm volatile("s_waitcnt vmcnt(0)" ::: "memory");
        } else {
            XB_SPIN(xb_ld(&bar[XB_XGEN(b.x)]) == gen, bar);
            __builtin_amdgcn_fence(__ATOMIC_ACQUIRE, "agent");
            asm volatile("s_waitcnt vmcnt(0)" ::: "memory");
        }
    }
    __syncthreads();
}

struct Frame {
    LAS unsigned char* lds;
    int tid, lane, w, h, lq;
    unsigned char* ws;
};
#define GLDS16(gsrc, ldsdst) __builtin_amdgcn_global_load_lds((const unsigned*)(gsrc), (LAS unsigned*)(ldsdst), 16, 0, 0)
#define MFMA32(a, b, c) __builtin_amdgcn_mfma_f32_32x32x16_bf16((a), (b), (c), 0, 0, 0)

__device__ __forceinline__ void gemm_core(const Frame& F, const bf16_t* __restrict__ W, int ldw, const bf16_t* __restrict__ X, int ldx, int K, f32x16 (&acc)[2][2]) {
    const int lane = F.lane, w = F.w;
    const int nkt = K >> 6;
    int offW[2], offX[4];
#pragma unroll
    for (int g = 0; g < 2; ++g) { const int row = 16 * w + 8 * g + (lane >> 3); offW[g] = row * ldw + ((lane & 7) ^ ((row >> 1) & 7)) * 8; }
#pragma unroll
    for (int g = 0; g < 4; ++g) { const int row = 32 * w + 8 * g + (lane >> 3); offX[g] = row * ldx + ((lane & 7) ^ ((row >> 1) & 7)) * 8; }
    LAS unsigned char* const dW = F.lds + (16 * w) * 128;
    LAS unsigned char* const dX = F.lds + 16384 + (32 * w) * 128;
#define GC_ISSUE(kt, st) do { _Pragma("unroll") for (int g = 0; g < 2; ++g) GLDS16(W + offW[g] + (kt) * 64, dW + (st) * GST + g * 1024); \
        _Pragma("unroll") for (int g = 0; g < 4; ++g) GLDS16(X + offX[g] + (kt) * 64, dX + (st) * GST + g * 1024); } while (0)
    const int wn = w & 1, wm = w >> 1, h = F.h, lq = F.lq;
    const int sw = (lane >> 1) & 7;
    int so[4];
#pragma unroll
    for (int s = 0; s < 4; ++s) so[s] = ((2 * s + h) ^ sw) << 4;
    const int bn0 = (64 * wn + lq) * 128, bm0 = 16384 + (64 * wm + lq) * 128;
#pragma unroll
    for (int a = 0; a < 2; ++a)
#pragma unroll
        for (int b = 0; b < 2; ++b)
#pragma unroll
            for (int r = 0; r < 16; ++r) acc[a][b][r] = 0.f;
    __syncthreads();
    GC_ISSUE(0, 0);
    asm volatile("s_waitcnt vmcnt(0)" ::: "memory");
    __syncthreads();
    for (int kt = 0; kt < nkt; ++kt) {
        const int st = kt & 1;
        if (kt + 1 < nkt) GC_ISSUE(kt + 1, st ^ 1);
        LAS unsigned char* const base = F.lds + st * GST;
        bf16x8 fa[2][2], fb[2][2];
        fa[0][0] = *(const LAS bf16x8*)(base + bn0 + so[0]); fa[0][1] = *(const LAS bf16x8*)(base + bn0 + 4096 + so[0]);
        fb[0][0] = *(const LAS bf16x8*)(base + bm0 + so[0]); fb[0][1] = *(const LAS bf16x8*)(base + bm0 + 4096 + so[0]);
#pragma unroll
        for (int s = 0; s < 4; ++s) {
            const int c = s & 1, n = c ^ 1;
            if (s < 3) {
                fa[n][0] = *(const LAS bf16x8*)(base + bn0 + so[s + 1]); fa[n][1] = *(const LAS bf16x8*)(base + bn0 + 4096 + so[s + 1]);
                fb[n][0] = *(const LAS bf16x8*)(base + bm0 + so[s + 1]); fb[n][1] = *(const LAS bf16x8*)(base + bm0 + 4096 + so[s + 1]);
            }
            acc[0][0] = MFMA32(fa[c][0], fb[c][0], acc[0][0]);
            acc[0][1] = MFMA32(fa[c][0], fb[c][1], acc[0][1]);
            acc[1][0] = MFMA32(fa[c][1], fb[c][0], acc[1][0]);
            acc[1][1] = MFMA32(fa[c][1], fb[c][1], acc[1][1]);
        }
        asm volatile("s_waitcnt vmcnt(0)" ::: "memory");
        __syncthreads();
    }
#undef GC_ISSUE
}
__device__ __forceinline__ int crow(int r, int h) { return (r & 3) + 8 * (r >> 2) + 4 * h; }

__device__ __forceinline__ void rope64_regs(float (&v)[2][16], const f32x2* tab, int h) {
#pragma unroll
    for (int nt = 0; nt < 2; ++nt)
#pragma unroll
        for (int g = 0; g < 2; ++g) {
            const f32x4* tp = (const f32x4*)(tab + nt * 16 + 8 * g + 4 * h);
            const f32x4 t0 = tp[0], t1 = tp[1];
            const float cs[4] = {t0[0], t0[2], t1[0], t1[2]}, sn[4] = {t0[1], t0[3], t1[1], t1[3]};
#pragma unroll
            for (int i = 0; i < 4; ++i) {
                const int r = 4 * g + i;
                const float x0 = v[nt][r], x1 = v[nt][r + 8];
                v[nt][r] = x0 * cs[i] - x1 * sn[i];
                v[nt][r + 8] = x1 * cs[i] + x0 * sn[i];
            }
        }
}
__device__ __forceinline__ void rope32_regs(float (&x)[16], const f32x2* tab, int h) {
#pragma unroll
    for (int g = 0; g < 2; ++g) {
        const f32x4* tp = (const f32x4*)(tab + 8 * g + 4 * h);
        const f32x4 t0 = tp[0], t1 = tp[1];
        const float cs[4] = {t0[0], t0[2], t1[0], t1[2]}, sn[4] = {t0[1], t0[3], t1[1], t1[3]};
#pragma unroll
        for (int i = 0; i < 4; ++i) {
            const int r = 8 * g + i;
            const float x0 = x[r], x1 = x[r + 4];
            x[r] = x0 * cs[i] - x1 * sn[i];
            x[r + 4] = x1 * cs[i] + x0 * sn[i];
        }
    }
}
__device__ __forceinline__ float ssq64(const float (&v)[2][16]) {
    float s = 0.f;
#pragma unroll
    for (int nt = 0; nt < 2; ++nt)
#pragma unroll
        for (int r = 0; r < 16; ++r) s += v[nt][r] * v[nt][r];
    s += __shfl_xor(s, 32);
    return s;
}
__device__ __forceinline__ void mulvec64(float (&v)[2][16], const float* gv, int h) {
#pragma unroll
    for (int nt = 0; nt < 2; ++nt)
#pragma unroll
        for (int g = 0; g < 4; ++g) {
            const f32x4 q = *(const f32x4*)(gv + 32 * nt + 8 * g + 4 * h);
#pragma unroll
            for (int i = 0; i < 4; ++i) v[nt][4 * g + i] *= q[i];
        }
}
constexpr int OST_LD = 68, OST_BYTES = 32 * OST_LD * 4;
__device__ __forceinline__ void stage_write(LAS float* st, const float (&v)[2][16], int h, int lq) {
    asm volatile("s_waitcnt lgkmcnt(0)" ::: "memory");
    __builtin_amdgcn_wave_barrier();
#pragma unroll
    for (int nt = 0; nt < 2; ++nt)
#pragma unroll
        for (int g = 0; g < 4; ++g) {
            f32x4 o = {v[nt][4 * g], v[nt][4 * g + 1], v[nt][4 * g + 2], v[nt][4 * g + 3]};
            *(LAS f32x4*)(st + lq * OST_LD + 32 * nt + 8 * g + 4 * h) = o;
        }
    asm volatile("s_waitcnt lgkmcnt(0)" ::: "memory");
    __builtin_amdgcn_wave_barrier();
}
__device__ __forceinline__ void stage_store_bf16(const LAS float* st, bf16_t* dst, int ld, float sc, int lane) {
#pragma unroll 1
    for (int it = 0; it < 4; ++it) {
        const int row = it * 8 + (lane >> 3), c8 = (lane & 7) * 8;
        const f32x4 x0 = *(const LAS f32x4*)(st + row * OST_LD + c8), x1 = *(const LAS f32x4*)(st + row * OST_LD + c8 + 4);
        u32x4 o; o.x = pk2(x0[0] * sc, x0[1] * sc); o.y = pk2(x0[2] * sc, x0[3] * sc); o.z = pk2(x1[0] * sc, x1[1] * sc); o.w = pk2(x1[2] * sc, x1[3] * sc);
        *(u32x4*)(dst + (size_t)row * ld + c8) = o;
    }
}
__device__ __forceinline__ void stage_store_f32(const LAS float* st, float* dst, int ld, int lane) {
#pragma unroll 1
    for (int it = 0; it < 8; ++it) {
        const int row = it * 4 + (lane >> 4), c = (lane & 15) * 4;
        *(f32x4*)(dst + (size_t)row * ld + c) = *(const LAS f32x4*)(st + row * OST_LD + c);
    }
}
__device__ __forceinline__ void stage_store_bf16_32(const LAS float* st, bf16_t* dst, int ld, int lane) {
#pragma unroll 1
    for (int it = 0; it < 2; ++it) {
        const int row = it * 16 + (lane >> 2), c8 = (lane & 3) * 8;
        const f32x4 x0 = *(const LAS f32x4*)(st + row * OST_LD + c8), x1 = *(const LAS f32x4*)(st + row * OST_LD + c8 + 4);
        u32x4 o; o.x = pk2(x0[0], x0[1]); o.y = pk2(x0[2], x0[3]); o.z = pk2(x1[0], x1[1]); o.w = pk2(x1[2], x1[3]);
        *(u32x4*)(dst + (size_t)row * ld + c8) = o;
    }
}
__device__ __forceinline__ void stage_store_f32_32(const LAS float* st, float* dst, int ld, int lane) {
#pragma unroll 1
    for (int it = 0; it < 4; ++it) {
        const int row = it * 8 + (lane >> 3), c = (lane & 7) * 4;
        *(f32x4*)(dst + (size_t)row * ld + c) = *(const LAS f32x4*)(st + row * OST_LD + c);
    }
}

__device__ __forceinline__ void gemm1_rstd(const Frame& F, int tm, float (&rstd2)[2]) {
    const float* ssqp = (const float*)(F.ws + WS_SSQ);
#pragma unroll
    for (int mt = 0; mt < 2; ++mt) {
        const int tok = tm * 256 + (F.w >> 1) * 64 + mt * 32 + F.lq;
        const f32x4* sp = (const f32x4*)(ssqp + (size_t)tok * 16);
        float ss = 0.f;
#pragma unroll
        for (int i = 0; i < 4; ++i) { const f32x4 q = sp[i]; ss += (q[0] + q[1]) + (q[2] + q[3]); }
        rstd2[mt] = rsqrtf(ss * (1.f / 1024.f) + EPS);
    }
}
__device__ __forceinline__ void epi_gemm1(const Frame& F, const Params& p, f32x16 (&acc)[2][2], int tn, int tm, int l, const float (&rstd2)[2]) {
    int h = F.h, lq = F.lq, lane = F.lane; const int wn = F.w & 1, wm = F.w >> 1;
    asm volatile("" : "+v"(h), "+v"(lq), "+v"(lane));
    unsigned char* ws = F.ws;
    LAS float* st = (LAS float*)(F.lds + F.w * OST_BYTES);
    const bool lat = tm >= 16;
    const int b = lat ? ((tm - 16) >> 2) : tm;
    const int cond = lat ? 1 + b : 0;
    const int nb = tn * 128 + wn * 64;
    const float* bias = (const float*)(ws + WS_BIAS) + (size_t)(l * 5 + cond) * 2944 + nb;
    float* outp = p.out;
    float ckv_ss[2];
#pragma unroll
    for (int mt = 0; mt < 2; ++mt) {
        const int tok0 = tm * 256 + wm * 64 + mt * 32, tok = tok0 + lq;
        const int t0 = lat ? ((tok0 - 4096) & 1023) : (tok0 & 255), t = t0 + lq;
        const float rstd = rstd2[mt];
        float v[2][16];
#pragma unroll
        for (int nt = 0; nt < 2; ++nt)
#pragma unroll
            for (int g = 0; g < 4; ++g) {
                const f32x4 bq = *(const f32x4*)(bias + 32 * nt + 8 * g + 4 * h);
#pragma unroll
                for (int i = 0; i < 4; ++i) v[nt][4 * g + i] = acc[nt][mt][4 * g + i] * rstd + bq[i];
            }
        const f32x2* r64 = (const f32x2*)(ws + WS_ROPE64) + (size_t)t * 32;
        const size_t orow0 = (size_t)(b * 4 + l) * 256 + t0;
        if (tn < 2) {
            if (lat) rope64_regs(v, r64, h);
            stage_write(st, v, h, lq);
            stage_store_bf16(st, (bf16_t*)(ws + WS_RQ) + (size_t)tok0 * 256 + nb, 256, 1.f, lane);
        } else if (tn < 4) {
            if (lat) rope64_regs(v, r64, h);
            stage_write(st, v, h, lq);
            stage_store_bf16(st, (bf16_t*)(ws + WS_RK) + (size_t)tok0 * 256 + (nb - 256), 256, 0.125f, lane);
        } else if (tn < 6) {
            stage_write(st, v, h, lq);
            stage_store_bf16(st, (bf16_t*)(ws + WS_RV) + (size_t)tok0 * 256 + (nb - 512), 256, 1.f, lane);
        } else if (tn < 9) {
            const float r = rsqrtf(ssq64(v) * (1.f / 64.f) + EPS);
#pragma unroll
            for (int nt = 0; nt < 2; ++nt)
#pragma unroll
                for (int i = 0; i < 16; ++i) v[nt][i] *= r;
            mulvec64(v, p.in[I_GQN] + l * 64, h);
            if (lat) rope64_regs(v, r64, h);
            stage_write(st, v, h, lq);
            stage_store_bf16(st, (bf16_t*)(ws + WS_GQ) + (size_t)tok0 * 384 + (nb - 768), 384, QSC_GQA, lane);
        } else if (tn == 9) {
            const float r = rsqrtf(ssq64(v) * (1.f / 64.f) + EPS);
#pragma unroll
            for (int nt = 0; nt < 2; ++nt)
#pragma unroll
                for (int i = 0; i < 16; ++i) v[nt][i] *= r;
            mulvec64(v, p.in[I_GKN] + l * 64, h);
            if (lat) rope64_regs(v, r64, h);
            stage_write(st, v, h, lq);
            if (!lat) stage_store_f32(st, outp + O_GK + orow0 * 128 + (nb - 1152), 128, lane);
            stage_store_bf16(st, (bf16_t*)(ws + WS_GK) + (size_t)tok0 * 128 + (nb - 1152), 128, 1.f, lane);
        } else if (tn == 10) {
            stage_write(st, v, h, lq);
            if (!lat) stage_store_f32(st, outp + O_GV + orow0 * 128 + (nb - 1280), 128, lane);
            stage_store_bf16(st, (bf16_t*)(ws + WS_GV) + (size_t)tok0 * 128 + (nb - 1280), 128, 1.f, lane);
        } else if (tn < 13) {
            const float s2 = ssq64(v);
            if (h == 0) ((float*)(ws + WS_CQSSQ))[(size_t)tok * 4 + ((nb - 1408) >> 6)] = s2;
            mulvec64(v, p.in[I_MQN] + l * 256 + (nb - 1408), h);
            stage_write(st, v, h, lq);
            stage_store_bf16(st, (bf16_t*)(ws + WS_CQG) + (size_t)tok0 * 256 + (nb - 1408), 256, 1.f, lane);
        } else if (tn == 13) {
            ckv_ss[mt] = ssq64(v);
            if (h == 0) ((LAS float*)(F.lds + LDS_EX))[(wm * 2 + wn) * 64 + mt * 32 + lq] = ckv_ss[mt];
        } else if (tn < 22) {
#pragma unroll
            for (int nt = 0; nt < 2; ++nt)
#pragma unroll
                for (int i = 0; i < 16; ++i) v[nt][i] = silu_f(v[nt][i]);
            stage_write(st, v, h, lq);
            stage_store_bf16(st, (bf16_t*)(ws + WS_ZS) + (size_t)tok0 * 1024 + (nb - 1792), 1024, 1.f, lane);
        } else {
            if (wn == 0) {
                if (lat) rope32_regs(v[0], (const f32x2*)(ws + WS_ROPE32) + (size_t)t * 16, h);
                stage_write(st, v, h, lq);
                if (!lat) stage_store_f32_32(st, outp + O_KPE + orow0 * 32, 32, lane);
                stage_store_bf16_32(st, (bf16_t*)(ws + WS_KPEB) + (size_t)tok0 * 32, 32, lane);
            }
        }
    }
    if (tn == 13) {
        __syncthreads();
#pragma unroll
        for (int mt = 0; mt < 2; ++mt) {
            const int tok0 = tm * 256 + wm * 64 + mt * 32, tok = tok0 + lq;
            const int t0 = lat ? ((tok0 - 4096) & 1023) : (tok0 & 255);
            const float rstd = rstd2[mt];
            float v[2][16];
#pragma unroll
            for (int nt = 0; nt < 2; ++nt)
#pragma unroll
                for (int g = 0; g < 4; ++g) {
                    const f32x4 bq = *(const f32x4*)(bias + 32 * nt + 8 * g + 4 * h);
#pragma unroll
                    for (int i = 0; i < 4; ++i) v[nt][4 * g + i] = acc[nt][mt][4 * g + i] * rstd + bq[i];
                }
            const float tot = ckv_ss[mt] + ((const LAS float*)(F.lds + LDS_EX))[(wm * 2 + (wn ^ 1)) * 64 + mt * 32 + lq];
            const float r = rsqrtf(tot * (1.f / 128.f) + EPS);
#pragma unroll
            for (int nt = 0; nt < 2; ++nt)
#pragma unroll
                for (int i = 0; i < 16; ++i) v[nt][i] *= r;
            mulvec64(v, p.in[I_MKVN] + l * 128 + wn * 64, h);
            const size_t orow0 = (size_t)(b * 4 + l) * 256 + t0;
            stage_write(st, v, h, lq);
            if (!lat) stage_store_f32(st, outp + O_CKV + orow0 * 128 + wn * 64, 128, lane);
            stage_store_bf16(st, (bf16_t*)(ws + WS_CKVN) + (size_t)tok0 * 128 + wn * 64, 128, 1.f, lane);
        }
        __syncthreads();
    }
}

__device__ __forceinline__ void epi_qm(const Frame& F, f32x16 (&acc)[2][2], int tn, int tm) {
    int h = F.h, lq = F.lq, lane = F.lane; const int wn = F.w & 1, wm = F.w >> 1;
    asm volatile("" : "+v"(h), "+v"(lq), "+v"(lane));
    unsigned char* ws = F.ws;
    LAS float* st = (LAS float*)(F.lds + F.w * OST_BYTES);
    const bool lat = tm >= 16;
    const int nb = tn * 128 + wn * 64;
    if (nb >= 576) return;
#pragma unroll
    for (int mt = 0; mt < 2; ++mt) {
        const int tok0 = tm * 256 + wm * 64 + mt * 32, tok = tok0 + lq;
        const int t = lat ? ((tok - 4096) & 1023) : (tok & 255);
        const f32x4 q4 = *(const f32x4*)((const float*)(ws + WS_CQSSQ) + (size_t)tok * 4);
        const float rstd = rsqrtf(((q4[0] + q4[1]) + (q4[2] + q4[3])) * (1.f / 256.f) + EPS);
        float v[2][16];
#pragma unroll
        for (int nt = 0; nt < 2; ++nt) {
#pragma unroll
            for (int i = 0; i < 16; ++i) v[nt][i] = acc[nt][mt][i] * rstd;
            const int T = (nb + 32 * nt) >> 5;
            if (lat && (T % 3) == 2) rope32_regs(v[nt], (const f32x2*)(ws + WS_ROPE32) + (size_t)t * 16, h);
        }
        stage_write(st, v, h, lq);
        stage_store_bf16(st, (bf16_t*)(ws + WS_QM) + (size_t)tok0 * 576 + nb, 576, QSC_MLA, lane);
    }
}
__device__ __forceinline__ void epi_plain(const Frame& F, f32x16 (&acc)[2][2], bf16_t* D, int ldd, int row0, int n0) {
    int h = F.h, lq = F.lq, lane = F.lane; const int wn = F.w & 1, wm = F.w >> 1;
    asm volatile("" : "+v"(h), "+v"(lq), "+v"(lane));
    LAS float* st = (LAS float*)(F.lds + F.w * OST_BYTES);
#pragma unroll
    for (int mt = 0; mt < 2; ++mt) {
        const int r0 = row0 + wm * 64 + mt * 32;
        float v[2][16];
#pragma unroll
        for (int nt = 0; nt < 2; ++nt)
#pragma unroll
            for (int i = 0; i < 16; ++i) v[nt][i] = acc[nt][mt][i];
        stage_write(st, v, h, lq);
        stage_store_bf16(st, D + (size_t)r0 * ldd + n0 + wn * 64, ldd, 1.f, lane);
    }
}

__device__ __forceinline__ void epi_gemm2(const Frame& F, const Params& p, f32x16 (&acc)[2][2], int tn, int tm, int l) {
    int h = F.h, lq = F.lq, lane = F.lane; const int wn = F.w & 1, wm = F.w >> 1;
    asm volatile("" : "+v"(h), "+v"(lq), "+v"(lane));
    unsigned char* ws = F.ws;
    LAS float* st = (LAS float*)(F.lds + F.w * OST_BYTES);
    const bool lat = tm >= 16;
    const int b = lat ? ((tm - 16) >> 2) : tm;
    const int cond = lat ? 1 + b : 0;
    const int nb = tn * 128 + wn * 64;
    const int c = (lane & 15) * 4;
    const f32x4 gt = *(const f32x4*)((const float*)(ws + WS_MODS) + (size_t)(l * 5 + cond) * 3072 + 2048 + nb + c);
    const f32x4 gs = *(const f32x4*)((const float*)(ws + WS_GS) + (size_t)((l < 3 ? l + 1 : 3) * 5 + cond) * 1024 + nb + c);
#pragma unroll
    for (int mt = 0; mt < 2; ++mt) {
        const int tok0 = tm * 256 + wm * 64 + mt * 32;
        float v[2][16];
#pragma unroll
        for (int nt = 0; nt < 2; ++nt)
#pragma unroll
            for (int i = 0; i < 16; ++i) v[nt][i] = acc[nt][mt][i];
        stage_write(st, v, h, lq);
        const float* xold0 = (l == 0) ? (lat ? p.in[I_XS] + (size_t)(tok0 - 4096) * 1024 : p.in[I_XP] + (size_t)tok0 * 1024) : p.xs + (size_t)tok0 * 1024;
        f32x4 xo8[8];
#pragma unroll
        for (int it = 0; it < 8; ++it) xo8[it] = *(const f32x4*)(xold0 + (size_t)(it * 4 + (lane >> 4)) * 1024 + nb + c);
#pragma unroll
        for (int it = 0; it < 8; ++it) {
            const int row = it * 4 + (lane >> 4);
            const f32x4 a = *(const LAS f32x4*)(st + row * OST_LD + c);
            const f32x4 xo = xo8[it];
            const f32x4 xn = xo + gt * a;
            *(f32x4*)(p.xs + (size_t)(tok0 + row) * 1024 + nb + c) = xn;
            float ss = (xn[0] * xn[0] + xn[1] * xn[1]) + (xn[2] * xn[2] + xn[3] * xn[3]);
            ss += __shfl_xor(ss, 1); ss += __shfl_xor(ss, 2); ss += __shfl_xor(ss, 4); ss += __shfl_xor(ss, 8);
            if ((lane & 15) == 0) ((float*)(ws + WS_SSQ))[(size_t)(tok0 + row) * 16 + tn * 2 + wn] = ss;
            if (l < 3) {
                u32x2 o; o.x = pk2(xn[0] * gs[0], xn[1] * gs[1]); o.y = pk2(xn[2] * gs[2], xn[3] * gs[3]);
                *(u32x2*)((bf16_t*)(ws + WS_XG) + (size_t)(tok0 + row) * 1024 + nb + c) = o;
            }
        }
    }
}
constexpr int AT_STG = 20480, AT_PE = 8192, AT_V = 12288, AT_OLD = 68;
struct AttnUnit {
    int mode;
    int nt0, nt1;
    const bf16_t *q; int q_ld;
    const bf16_t *k0, *k1; int k_ld0, k_ld1;
    const bf16_t *pe0, *pe1;
    const bf16_t *v0, *v1; int v_ld0, v_ld1;
    int tok0;
    int ycol;
    int qpos0, L;
    float lf, lb;
    const bf16_t *s0f, *s0b;
    float* st_out;
};
__device__ __forceinline__ s16x4 tr16(LAS const unsigned char* p) {
    typedef short v4i16_t __attribute__((ext_vector_type(4)));
    return __builtin_bit_cast(s16x4, __builtin_amdgcn_ds_read_tr16_b64_v4i16((LAS v4i16_t*)p));
}

template <int MODE>
__device__ __forceinline__ void attn_unit(const Frame& F, const Params& p, const AttnUnit& U) {
    constexpr int NQS = MODE == 1 ? 6 : 4;
    const int lane = F.lane, w = F.w, h = F.h, lq = F.lq;
    LAS unsigned char* lds = F.lds;
    const int k_ld = U.k_ld1, v_ld = U.v_ld1;
    const int krow = 8 * w + (lane >> 3);
    const int koff = krow * k_ld + ((lane & 7) ^ ((krow >> 1) & 7)) * 8;
    const int poff = (16 * (w & 3) + (lane >> 2)) * 32 + ((lane & 3) ^ ((lane >> 4) & 3)) * 8;
    const int vdblk = w >> 2, vkg = w & 3;
    const int voff = (16 * vkg + (lane >> 2)) * v_ld + vdblk * 32 + (lane & 3) * 8;
    const int vdst = AT_V + vdblk * 4096 + vkg * 1024;
    const int nt0 = U.nt0, ntot = U.nt0 + U.nt1;
#define AT_ISSUE(t, st) do { const int _t = (t); LAS unsigned char* _b = lds + (st) * AT_STG; \
        const bool _s0 = _t < nt0; const int _u = _s0 ? _t : _t - nt0; \
        const bf16_t* _kb = (_s0 ? U.k0 : U.k1) + (size_t)_u * 64 * k_ld; const bf16_t* _vb = (_s0 ? U.v0 : U.v1) + (size_t)_u * 64 * v_ld; \
        GLDS16(_kb + koff, _b + (8 * w) * 128); \
        if (MODE == 1) { const bf16_t* _pb = (_s0 ? U.pe0 : U.pe1) + (size_t)_u * 64 * 32; GLDS16(_pb + poff, _b + AT_PE + 16 * (w & 3) * 64); } \
        GLDS16(_vb + voff, _b + vdst); } while (0)
    AT_ISSUE(0, 0);
    if (ntot > 1) AT_ISSUE(1, 1);
    bf16x8 qr[NQS];
    if (MODE == 3) {
        const int dk = 32 * (w & 1) + lq;
#pragma unroll
        for (int s = 0; s < 4; ++s)
#pragma unroll
            for (int j = 0; j < 8; ++j) qr[s][j] = (16 * s + 8 * h + j == dk) ? (short)0x3F80 : (short)0;
    } else {
        const bf16_t* qp = U.q + (size_t)(32 * w + lq) * U.q_ld + 8 * h;
#pragma unroll
        for (int s = 0; s < NQS; ++s) qr[s] = *(const bf16x8*)(qp + 16 * s);
    }
    f32x16 o[2];
#pragma unroll
    for (int d = 0; d < 2; ++d)
#pragma unroll
        for (int r = 0; r < 16; ++r) o[d][r] = 0.f;
    float m_run = -1e30f, l_run = 0.f;
    const int qpos = U.qpos0 + 32 * w + lq;
    const int sdir = (w >> 1) & 1;
    LAS float* scal = (LAS float*)(lds + LDS_SCAL) + w * 32;
    const int kfo = lq * 128, sw = (lane >> 1) & 7, pfo = AT_PE + lq * 64, psw = (lane >> 2) & 3;
    const int vfo = AT_V + (4 * h + ((lane & 15) >> 2)) * 64 + ((lane >> 4) & 1) * 32 + (lane & 3) * 8;
    int st = 0;
    for (int t = 0; t < ntot; ++t) {
        if (t + 1 < ntot) { if (MODE == 1) asm volatile("s_waitcnt vmcnt(3)" ::: "memory"); else asm volatile("s_waitcnt vmcnt(2)" ::: "memory"); }
        else asm volatile("s_waitcnt vmcnt(0)" ::: "memory");
        __builtin_amdgcn_s_barrier();
        asm volatile("" ::: "memory");
        const int st2 = st == 0 ? 2 : st - 1;
        if (t + 2 < ntot) AT_ISSUE(t + 2, st2);
        LAS const unsigned char* base = lds + st * AT_STG;
        f32x16 p0, p1;
#pragma unroll
        for (int r = 0; r < 16; ++r) { p0[r] = 0.f; p1[r] = 0.f; }
#pragma unroll
        for (int s = 0; s < 4; ++s) {
            const int so = ((2 * s + h) ^ sw) << 4;
            const bf16x8 ka = *(const LAS bf16x8*)(base + kfo + so);
            const bf16x8 kb = *(const LAS bf16x8*)(base + kfo + 4096 + so);
            p0 = MFMA32(ka, qr[s], p0);
            p1 = MFMA32(kb, qr[s], p1);
        }
        if (MODE == 1) {
#pragma unroll
            for (int s = 0; s < 2; ++s) {
                const int so = ((2 * s + h) ^ psw) << 4;
                const bf16x8 ka = *(const LAS bf16x8*)(base + pfo + so);
                const bf16x8 kb = *(const LAS bf16x8*)(base + pfo + 2048 + so);
                p0 = MFMA32(ka, qr[4 + s], p0);
                p1 = MFMA32(kb, qr[4 + s], p1);
            }
        }
        __builtin_amdgcn_sched_barrier(0);
        if (MODE <= 1) {
            float tm = p0[0];
#pragma unroll
            for (int r = 1; r < 16; ++r) tm = fmaxf(tm, p0[r]);
#pragma unroll
            for (int r = 0; r < 16; ++r) tm = fmaxf(tm, p1[r]);
            tm = fmaxf(tm, __shfl_xor(tm, 32));
            if (__any(tm > m_run + 6.0f)) {
                const float mn = fmaxf(m_run, tm);
                const float alpha = __builtin_amdgcn_exp2f(m_run - mn);
                m_run = mn; l_run *= alpha;
                if (h == 0) scal[lq] = alpha;
                asm volatile("s_waitcnt lgkmcnt(0)" ::: "memory");
#pragma unroll
                for (int g = 0; g < 4; ++g) {
                    const f32x4 a4 = *(const LAS f32x4*)(scal + 8 * g + 4 * h);
#pragma unroll
                    for (int i = 0; i < 4; ++i) { o[0][4 * g + i] *= a4[i]; o[1][4 * g + i] *= a4[i]; }
                }
            }
            float ls = 0.f;
#pragma unroll
            for (int r = 0; r < 16; ++r) { p0[r] = __builtin_amdgcn_exp2f(p0[r] - m_run); p1[r] = __builtin_amdgcn_exp2f(p1[r] - m_run); ls += p0[r] + p1[r]; }
            l_run += ls;
        } else if (MODE == 2) {
            float dq = (float)(qpos - 64 * t - 4 * h);
            asm volatile("" : "+v"(dq));
#pragma unroll
            for (int r = 0; r < 16; ++r) {
                const float d0 = dq - (float)((r & 3) + 8 * (r >> 2)), d1 = d0 - 32.f;
                const float w0 = __builtin_amdgcn_exp2f(fabsf(d0) * (d0 > 0.f ? U.lf : U.lb));
                const float w1 = __builtin_amdgcn_exp2f(fabsf(d1) * (d1 > 0.f ? U.lf : U.lb));
                p0[r] *= (d0 == 0.f ? 2.f : w0);
                p1[r] *= (d1 == 0.f ? 2.f : w1);
            }
        } else {
            float mb = (float)(64 * t + 4 * h);
            asm volatile("" : "+v"(mb));
#pragma unroll
            for (int r = 0; r < 16; ++r) {
                const float m0 = mb + (float)((r & 3) + 8 * (r >> 2)), m1 = m0 + 32.f;
                const float e0 = sdir ? m0 * U.lb : (255.f - m0) * U.lf, e1 = sdir ? m1 * U.lb : (255.f - m1) * U.lf;
                p0[r] *= __builtin_amdgcn_exp2f(e0);
                p1[r] *= __builtin_amdgcn_exp2f(e1);
            }
        }
        __builtin_amdgcn_sched_barrier(0);
        bf16x8 pa[4];
        { u32x4 a;
          a.x = pk2(p0[0], p0[1]); a.y = pk2(p0[2], p0[3]); a.z = pk2(p0[4], p0[5]); a.w = pk2(p0[6], p0[7]); pa[0] = __builtin_bit_cast(bf16x8, a);
          a.x = pk2(p0[8], p0[9]); a.y = pk2(p0[10], p0[11]); a.z = pk2(p0[12], p0[13]); a.w = pk2(p0[14], p0[15]); pa[1] = __builtin_bit_cast(bf16x8, a);
          a.x = pk2(p1[0], p1[1]); a.y = pk2(p1[2], p1[3]); a.z = pk2(p1[4], p1[5]); a.w = pk2(p1[6], p1[7]); pa[2] = __builtin_bit_cast(bf16x8, a);
          a.x = pk2(p1[8], p1[9]); a.y = pk2(p1[10], p1[11]); a.z = pk2(p1[12], p1[13]); a.w = pk2(p1[14], p1[15]); pa[3] = __builtin_bit_cast(bf16x8, a); }
        const unsigned vaddr = (unsigned)(uintptr_t)(base + vfo);
#define TRR(dst, off) asm volatile("ds_read_b64_tr_b16 %0, %1 offset:%c2" : "=&v"(dst) : "v"(vaddr), "i"(off) : "memory")
#pragma unroll
        for (int dk = 0; dk < 4; ++dk) {
            const int d = dk >> 1, k0 = (dk & 1) * 2;
            s16x4 lo[2], hi[2];
#pragma unroll
            for (int ks = 0; ks < 2; ++ks) { TRR(lo[ks], d * 4096 + (k0 + ks) * 1024); TRR(hi[ks], d * 4096 + (k0 + ks) * 1024 + 512); }
            asm volatile("s_waitcnt lgkmcnt(0)" ::: "memory");
            __builtin_amdgcn_sched_barrier(0);
#pragma unroll
            for (int ks = 0; ks < 2; ++ks) {
                const bf16x8 vb = {lo[ks][0], lo[ks][1], lo[ks][2], lo[ks][3], hi[ks][0], hi[ks][1], hi[ks][2], hi[ks][3]};
                o[d] = MFMA32(pa[k0 + ks], vb, o[d]);
            }
        }
#undef TRR
        st = st == 2 ? 0 : st + 1;
    }
#undef AT_ISSUE
    int lq2 = lq, h2 = h, lane2 = lane; asm volatile("" : "+v"(lq2), "+v"(h2), "+v"(lane2));
    if (MODE == 2 && U.s0f != nullptr) {
        const float ff = __builtin_amdgcn_exp2f((float)(qpos + 1) * U.lf), fb = __builtin_amdgcn_exp2f((float)(U.L - qpos) * U.lb);
#pragma unroll
        for (int s = 0; s < 4; ++s) {
            const u32x4 qu = __builtin_bit_cast(u32x4, qr[s]);
            u32x4 af, ab;
#pragma unroll
            for (int i = 0; i < 4; ++i) { const float lo = bflo(qu[i]), hi = bfhi(qu[i]); af[i] = pk2(lo * ff, hi * ff); ab[i] = pk2(lo * fb, hi * fb); }
#pragma unroll
            for (int d = 0; d < 2; ++d) {
                const bf16x8 sf = *(const bf16x8*)(U.s0f + (size_t)(32 * d + lq2) * 64 + 16 * s + 8 * h2);
                const bf16x8 sb = *(const bf16x8*)(U.s0b + (size_t)(32 * d + lq2) * 64 + 16 * s + 8 * h2);
                o[d] = MFMA32(__builtin_bit_cast(bf16x8, af), sf, o[d]);
                o[d] = MFMA32(__builtin_bit_cast(bf16x8, ab), sb, o[d]);
            }
        }
    }
    if (MODE == 3) {
        float* dst = U.st_out + (size_t)sdir * 4 * 4096 + (size_t)(32 * (w & 1)) * 64;
        if (w < 4) {
#pragma unroll
        for (int d = 0; d < 2; ++d)
#pragma unroll
            for (int r = 0; r < 16; ++r) dst[(size_t)((r & 3) + 8 * (r >> 2) + 4 * h2) * 64 + 32 * d + lq2] = o[d][r];
        }
        __syncthreads();
        return;
    }
    if (MODE <= 1) {
        l_run += __shfl_xor(l_run, 32);
        if (h2 == 0) scal[lq2] = 1.f / l_run;
    }
    __syncthreads();
    LAS float* ost = (LAS float*)lds + w * (32 * AT_OLD);
#pragma unroll
    for (int d = 0; d < 2; ++d)
#pragma unroll
        for (int r = 0; r < 16; ++r) ost[((r & 3) + 8 * (r >> 2) + 4 * h2) * AT_OLD + 32 * d + lq2] = o[d][r];
    asm volatile("s_waitcnt lgkmcnt(0)" ::: "memory");
    __builtin_amdgcn_wave_barrier();
    const bf16_t* zs = (const bf16_t*)(F.ws + WS_ZS);
    bf16_t* yb = (bf16_t*)(F.ws + WS_Y);
#pragma unroll
    for (int it = 0; it < 4; ++it) {
        const int row = it * 8 + (lane2 >> 3), c8 = (lane2 & 7) * 8;
        const f32x4 x0 = *(const LAS f32x4*)(ost + row * AT_OLD + c8), x1 = *(const LAS f32x4*)(ost + row * AT_OLD + c8 + 4);
        float sc;
        if (MODE <= 1) sc = scal[row];
        else {
            float ss = (x0[0] * x0[0] + x0[1] * x0[1]) + (x0[2] * x0[2] + x0[3] * x0[3]) + (x1[0] * x1[0] + x1[1] * x1[1]) + (x1[2] * x1[2] + x1[3] * x1[3]);
            ss += __shfl_xor(ss, 1); ss += __shfl_xor(ss, 2); ss += __shfl_xor(ss, 4);
            sc = rsqrtf(ss * (1.f / 64.f) + EPS);
        }
        const size_t off = (size_t)(U.tok0 + 32 * w + row) * 1024 + U.ycol + c8;
        const u32x4 z = *(const u32x4*)(zs + off);
        u32x4 y;
        y.x = pk2(x0[0] * sc * bflo(z.x), x0[1] * sc * bfhi(z.x));
        y.y = pk2(x0[2] * sc * bflo(z.y), x0[3] * sc * bfhi(z.y));
        y.z = pk2(x1[0] * sc * bflo(z.z), x1[1] * sc * bfhi(z.z));
        y.w = pk2(x1[2] * sc * bflo(z.w), x1[3] * sc * bfhi(z.w));
        *(u32x4*)(yb + off) = y;
    }
    __syncthreads();
}

__device__ __forceinline__ void attn_dispatch(const Frame& F, const Params& p, int u, int l) {
    unsigned char* ws = F.ws;
    AttnUnit U;
    U.nt0 = 0; U.nt1 = 0; U.q = nullptr; U.q_ld = 0; U.k0 = U.k1 = nullptr; U.k_ld0 = U.k_ld1 = 0; U.pe0 = U.pe1 = nullptr; U.v0 = U.v1 = nullptr; U.v_ld0 = U.v_ld1 = 0;
    U.tok0 = 0; U.ycol = 0; U.qpos0 = 0; U.L = 0; U.lf = U.lb = 0.f; U.s0f = U.s0b = nullptr; U.st_out = nullptr; U.mode = 0;
    const bf16_t* GQ = (const bf16_t*)(ws + WS_GQ); const bf16_t* GK = (const bf16_t*)(ws + WS_GK); const bf16_t* GV = (const bf16_t*)(ws + WS_GV);
    const bf16_t* QM = (const bf16_t*)(ws + WS_QM); const bf16_t* KVM = (const bf16_t*)(ws + WS_KVM); const bf16_t* KVMC = (const bf16_t*)(ws + WS_KVMC);
    const bf16_t* KPEB = (const bf16_t*)(ws + WS_KPEB); const bf16_t* CKPE = (const bf16_t*)(ws + WS_CKPE);
    const bf16_t* CGK = (const bf16_t*)(ws + WS_CGK); const bf16_t* CGV = (const bf16_t*)(ws + WS_CGV);
    const bf16_t* RQ = (const bf16_t*)(ws + WS_RQ); const bf16_t* RK = (const bf16_t*)(ws + WS_RK); const bf16_t* RV = (const bf16_t*)(ws + WS_RV);
    const float* decay = p.in[I_DECAY] + l * 8;
    if (u < 96 || (u >= 256 && u < 352)) {
        const bool lat = u < 96; const int uu = lat ? u : u - 256;
        const int b = lat ? uu / 24 : uu / 6, hh = lat ? (uu >> 2) % 6 : uu % 6, qb = lat ? (uu & 3) : 0;
        const int seq0 = lat ? 4096 + b * 1024 : b * 256;
        U.mode = 1; U.tok0 = seq0 + qb * 256; U.q = QM + (size_t)U.tok0 * 576 + hh * 96; U.q_ld = 576; U.ycol = 640 + hh * 64;
        U.nt1 = lat ? 16 : 4; U.k1 = KVM + (size_t)seq0 * 768 + hh * 128; U.k_ld1 = 768; U.v1 = U.k1 + 64; U.v_ld1 = 768; U.pe1 = KPEB + (size_t)seq0 * 32;
        U.k0 = U.k1; U.v0 = U.v1; U.pe0 = U.pe1; U.k_ld0 = 768; U.v_ld0 = 768;
        if (lat) { U.nt0 = 8; U.k0 = KVMC + (size_t)(b * 512) * 768 + hh * 128; U.v0 = U.k0 + 64; U.pe0 = CKPE + (size_t)((b * 4 + l) * 512) * 32; }
        attn_unit<1>(F, p, U);
    } else if (u < 192 || (u >= 352 && u < 448)) {
        const bool lat = u < 192; const int uu = lat ? u - 96 : u - 352;
        const int b = lat ? uu / 24 : uu / 6, hh = lat ? (uu >> 2) % 6 : uu % 6, qb = lat ? (uu & 3) : 0, kvh = hh / 3;
        const int seq0 = lat ? 4096 + b * 1024 : b * 256;
        U.mode = 0; U.tok0 = seq0 + qb * 256; U.q = GQ + (size_t)U.tok0 * 384 + hh * 64; U.q_ld = 384; U.ycol = 256 + hh * 64;
        U.nt1 = lat ? 16 : 4; U.k1 = GK + (size_t)seq0 * 128 + kvh * 64; U.k_ld1 = 128; U.v1 = GV + (size_t)seq0 * 128 + kvh * 64; U.v_ld1 = 128;
        U.k0 = U.k1; U.v0 = U.v1; U.k_ld0 = 128; U.v_ld0 = 128;
        if (lat) { U.nt0 = 8; U.k0 = CGK + (size_t)((b * 4 + l) * 512) * 128 + kvh * 64; U.v0 = CGV + (size_t)((b * 4 + l) * 512) * 128 + kvh * 64; }
        attn_unit<0>(F, p, U);
    } else if (u < 256 || (u >= 448 && u < 512)) {
        const bool lat = u < 256; const int uu = lat ? u - 192 : u - 448;
        const int b = lat ? uu / 16 : uu / 4, hh = lat ? (uu >> 2) & 3 : uu & 3, qb = lat ? (uu & 3) : 0;
        const int seq0 = lat ? 4096 + b * 1024 : b * 256;
        U.mode = 2; U.tok0 = seq0 + qb * 256; U.q = RQ + (size_t)U.tok0 * 256 + hh * 64; U.q_ld = 256; U.ycol = hh * 64;
        U.nt1 = lat ? 16 : 4; U.k1 = RK + (size_t)seq0 * 256 + hh * 64; U.k_ld1 = 256; U.v1 = RV + (size_t)seq0 * 256 + hh * 64; U.v_ld1 = 256;
        U.k0 = U.k1; U.v0 = U.v1; U.k_ld0 = 256; U.v_ld0 = 256;
        U.qpos0 = qb * 256; U.L = lat ? 1024 : 256;
        U.lf = -log1pf(__expf(-decay[hh])) * LOG2E; U.lb = -log1pf(__expf(-decay[4 + hh])) * LOG2E;
        if (lat) { const bf16_t* S0T = (const bf16_t*)(ws + WS_S0T); U.s0f = S0T + (size_t)(((b * 4 + l) * 2 + 0) * 4 + hh) * 4096; U.s0b = S0T + (size_t)(((b * 4 + l) * 2 + 1) * 4 + hh) * 4096; }
        attn_unit<2>(F, p, U);
    } else {
        const int uu = u - 512, b = uu >> 2, hh = uu & 3, seq0 = b * 256;
        U.mode = 3; U.nt1 = 4; U.k1 = RK + (size_t)seq0 * 256 + hh * 64; U.k_ld1 = 256; U.v1 = RV + (size_t)seq0 * 256 + hh * 64; U.v_ld1 = 256;
        U.k0 = U.k1; U.v0 = U.v1; U.k_ld0 = 256; U.v_ld0 = 256;
        U.lf = -log1pf(__expf(-decay[hh])) * LOG2E; U.lb = -log1pf(__expf(-decay[4 + hh])) * LOG2E;
        U.st_out = p.out + O_STATE + (size_t)(((b * 4 + l) * 2 + 0) * 4 + hh) * 4096;
        attn_unit<3>(F, p, U);
    }
}
constexpr int N_ATTN_UNITS = 576;
__device__ __forceinline__ void p0_transpose_item(const float* W, int K, int Nsrc, int src_n0, bf16_t* WT, int dest_row0, int k0, LAS float* scr, int lane) {
    if (src_n0 >= 0) {
        float r[32];
        const float* wp = W + (size_t)(k0 + (lane >> 5)) * Nsrc + src_n0 + (lane & 31);
#pragma unroll
        for (int i = 0; i < 32; ++i) r[i] = wp[(size_t)(2 * i) * Nsrc];
#pragma unroll
        for (int i = 0; i < 32; ++i) scr[(2 * i + (lane >> 5)) * 33 + (lane & 31)] = r[i];
    } else {
#pragma unroll 8
        for (int i = 0; i < 32; ++i) { const int kk = 2 * i + (lane >> 5); scr[kk * 33 + (lane & 31)] = 0.f; }
    }
    asm volatile("s_waitcnt lgkmcnt(0)" ::: "memory");
    __builtin_amdgcn_wave_barrier();
    const int c = lane & 7;
#pragma unroll
    for (int j = 0; j < 4; ++j) {
        const int n = (lane >> 3) + 8 * j; const LAS float* s = scr + (8 * c) * 33 + n;
        u32x4 o; o.x = pk2(s[0 * 33], s[1 * 33]); o.y = pk2(s[2 * 33], s[3 * 33]); o.z = pk2(s[4 * 33], s[5 * 33]); o.w = pk2(s[6 * 33], s[7 * 33]);
        *(u32x4*)(WT + (size_t)(dest_row0 + n) * K + k0 + 8 * c) = o;
    }
    asm volatile("s_waitcnt lgkmcnt(0)" ::: "memory");
    __builtin_amdgcn_wave_barrier();
}
__device__ __forceinline__ void cast8(const float* src, bf16_t* dst, size_t e) {
    const f32x4 a = *(const f32x4*)(src + e), b = *(const f32x4*)(src + e + 4);
    u32x4 o; o.x = pk2(a[0], a[1]); o.y = pk2(a[2], a[3]); o.z = pk2(b[0], b[1]); o.w = pk2(b[2], b[3]);
    *(u32x4*)(dst + e) = o;
}
constexpr int P0_MODS = 1536, P0_TWIN = 4 * 16 * 92, P0_TWOUT = 4 * 16 * 32, P0_TWUQ = 4 * 4 * 20, P0_TWUKV = 4 * 2 * 24;
constexpr int P0_CAST_G = 512, P0_CAST_KPE = 128, P0_S0T = 512, P0_R64 = 512, P0_R32 = 256;
constexpr int P0_TOTAL = P0_MODS + P0_TWIN + P0_TWOUT + P0_TWUQ + P0_TWUKV + 3 * P0_CAST_G + P0_CAST_KPE + P0_S0T + P0_R64 + P0_R32;
__device__ __forceinline__ void phase0(const Frame& F, const Params& p, bool dup = false) {
    unsigned char* ws = F.ws + (dup ? 162 * MiB : 0); const int lane = F.lane;
    LAS float* scr = (LAS float*)F.lds + F.w * (64 * 33);
    const int gw = blockIdx.x * NWAVE + F.w, ngw = gridDim.x * NWAVE;
    for (int it0 = gw; it0 < P0_TOTAL; it0 += ngw) {
        int it = it0;
        if (it < P0_MODS) {
            const int l = it / 384, cg = (it % 384) >> 5, ks = it & 31;
            const int j = cg * 256 + lane * 4;
            const float* wp = p.in[I_WADA] + ((size_t)l * 1024 + ks * 32) * 3072 + j;
            const float* c = p.in[I_C]; const float* cc = p.in[I_CCTX];
            f32x4 acc[5];
#pragma unroll
            for (int n = 0; n < 5; ++n) acc[n] = (f32x4){0.f, 0.f, 0.f, 0.f};
#pragma unroll
            for (int k0 = 0; k0 < 32; k0 += 16) {
                f32x4 wv[16];
#pragma unroll
                for (int k = 0; k < 16; ++k) wv[k] = *(const f32x4*)(wp + (size_t)(k0 + k) * 3072);
#pragma unroll
                for (int k = 0; k < 16; ++k) {
                    const int kk = ks * 32 + k0 + k;
                    acc[0] += wv[k] * silu_f(cc[kk]);
#pragma unroll
                    for (int n = 1; n < 5; ++n) acc[n] += wv[k] * silu_f(c[(n - 1) * 1024 + kk]);
                }
            }
            float* mods = (float*)(ws + WS_MODS);
#pragma unroll
            for (int n = 0; n < 5; ++n) {
                if (ks == 0) acc[n] += *(const f32x4*)(p.in[I_BADA] + l * 3072 + j);
#pragma unroll
                for (int e = 0; e < 4; ++e) atomicAdd(mods + (size_t)(l * 5 + n) * 3072 + j + e, acc[n][e]);
            }
            continue;
        }
        it -= P0_MODS;
        if (it < P0_TWIN) {
            const int l = it / (16 * 92), r = it % (16 * 92), kb = r / 92, nb = r % 92, n0 = nb * 32;
            const int src = n0 < 1792 ? n0 : (n0 < 2816 ? n0 + 32 : (n0 < 2848 ? n0 - 2816 + 1792 : -1));
            p0_transpose_item(p.in[I_WIN] + (size_t)l * 1024 * 2848, 1024, 2848, src, (bf16_t*)(ws + WS_WIN) + (size_t)l * 2944 * 1024, n0, kb * 64, scr, lane);
            continue;
        }
        it -= P0_TWIN;
        if (it < P0_TWOUT) {
            const int l = it / 512, r = it % 512, kb = r >> 5, nb = r & 31;
            p0_transpose_item(p.in[I_WOUT] + (size_t)l * 1024 * 1024, 1024, 1024, nb * 32, (bf16_t*)(ws + WS_WOUT) + (size_t)l * 1024 * 1024, nb * 32, kb * 64, scr, lane);
            continue;
        }
        it -= P0_TWOUT;
        if (it < P0_TWUQ) {
            const int l = it / 80, r = it % 80, kb = r / 20, nb = r % 20;
            p0_transpose_item(p.in[I_WUQ] + (size_t)l * 256 * 576, 256, 576, nb < 18 ? nb * 32 : -1, (bf16_t*)(ws + WS_WUQ) + (size_t)l * 640 * 256, nb * 32, kb * 64, scr, lane);
            continue;
        }
        it -= P0_TWUQ;
        if (it < P0_TWUKV) {
            const int l = it / 48, r = it % 48, kb = r / 24, nb = r % 24;
            p0_transpose_item(p.in[I_WUKV] + (size_t)l * 128 * 768, 128, 768, nb * 32, (bf16_t*)(ws + WS_WUKV) + (size_t)l * 768 * 128, nb * 32, kb * 64, scr, lane);
            continue;
        }
        it -= P0_TWUKV;
        if (it < 3 * P0_CAST_G) {
            const int which = it / P0_CAST_G, r = it % P0_CAST_G;
            const float* src = which == 0 ? p.in[I_CGK] : (which == 1 ? p.in[I_CGV] : p.in[I_CCKV]);
            bf16_t* dst = (bf16_t*)(ws + (which == 0 ? WS_CGK : (which == 1 ? WS_CGV : WS_CCKV)));
#pragma unroll
            for (int q = 0; q < 4; ++q) cast8(src, dst, (size_t)r * 2048 + q * 512 + lane * 8);
            continue;
        }
        it -= 3 * P0_CAST_G;
        if (it < P0_CAST_KPE) {
#pragma unroll
            for (int q = 0; q < 4; ++q) cast8(p.in[I_CKPE], (bf16_t*)(ws + WS_CKPE), (size_t)it * 2048 + q * 512 + lane * 8);
            continue; }
        it -= P0_CAST_KPE;
        if (it < P0_S0T) {
            const int mat = it >> 2, qd = it & 3, dv = qd * 16 + (lane >> 2), dk0 = (lane & 3) * 16;
            const float* s = p.in[I_STATE] + (size_t)mat * 4096 + dv;
            float x[16];
#pragma unroll
            for (int i = 0; i < 16; ++i) x[i] = s[(dk0 + i) * 64];
            u32x4 o0, o1;
            o0.x = pk2(x[0], x[1]); o0.y = pk2(x[2], x[3]); o0.z = pk2(x[4], x[5]); o0.w = pk2(x[6], x[7]);
            o1.x = pk2(x[8], x[9]); o1.y = pk2(x[10], x[11]); o1.z = pk2(x[12], x[13]); o1.w = pk2(x[14], x[15]);
            bf16_t* d = (bf16_t*)(ws + WS_S0T) + (size_t)mat * 4096 + dv * 64 + dk0;
            *(u32x4*)d = o0; *(u32x4*)(d + 8) = o1;
            continue;
        }
        it -= P0_S0T;
        if (it < P0_R64) {
            const int e = it * 64 + lane, t = e >> 5, j = e & 31, i = j & 15;
            const float pos = (float)(j < 16 ? (t >> 6) : (t & 63));
            const float a = pos * exp2f(-(float)i * (13.287712379549449f / 16.f));
            ((f32x2*)(ws + WS_ROPE64))[e] = (f32x2){cosf(a), sinf(a)};
            continue;
        }
        it -= P0_R64;
        {
            const int e = it * 64 + lane, t = e >> 4, j = e & 15, i = j & 7;
            const float pos = (float)(j < 8 ? (t >> 6) : (t & 63));
            const float a = pos * exp2f(-(float)i * (13.287712379549449f / 8.f));
            ((f32x2*)(ws + WS_ROPE32))[e] = (f32x2){cosf(a), sinf(a)};
        }
    }
}
constexpr int P1_GS = 80, P1_BIAS = 4 * 2944, P1_X = 8192, P1_TOTAL = P1_GS + P1_BIAS + P1_X;
__device__ __forceinline__ void xg_row(const Frame& F, const float* xrow, const float* g, const float* mods_c, bf16_t* xg_row_out, float* ssq_row, bool write_xg) {
    const int lane = F.lane;
    float ss = 0.f;
#pragma unroll
    for (int j = 0; j < 4; ++j) {
        const int k = j * 256 + lane * 4;
        const f32x4 x = *(const f32x4*)(xrow + k);
        ss += (x[0] * x[0] + x[1] * x[1]) + (x[2] * x[2] + x[3] * x[3]);
        if (write_xg) {
            const f32x4 gg = *(const f32x4*)(g + k), sc = *(const f32x4*)(mods_c + 1024 + k);
            u32x2 o; o.x = pk2(x[0] * gg[0] * (1.f + sc[0]), x[1] * gg[1] * (1.f + sc[1])); o.y = pk2(x[2] * gg[2] * (1.f + sc[2]), x[3] * gg[3] * (1.f + sc[3]));
            *(u32x2*)(xg_row_out + k) = o;
        }
    }
    ss = wsum(ss);
    if (lane < 16) ssq_row[lane] = lane == 0 ? ss : 0.f;
}
__device__ __forceinline__ void phase1(const Frame& F, const Params& p) {
    unsigned char* ws = F.ws; const int lane = F.lane;
    const int gw = blockIdx.x * NWAVE + F.w, ngw = gridDim.x * NWAVE;
    const float* mods = (const float*)(ws + WS_MODS);
    for (int it0 = gw; it0 < P1_TOTAL; it0 += ngw) {
        int it = it0;
        if (it < P1_GS) {
            const int e = it * 256 + lane * 4, lc = e >> 10, k = e & 1023, l = lc / 5;
            const f32x4 g = *(const f32x4*)(p.in[I_NORMG] + l * 1024 + k), sc = *(const f32x4*)(mods + (size_t)lc * 3072 + 1024 + k);
            *(f32x4*)((float*)(ws + WS_GS) + e) = g * (sc + 1.f);
            continue;
        }
        it -= P1_GS;
        if (it < P1_BIAS) {
            const int l = it / 2944, n = it % 2944;
            const bf16_t* wr = (const bf16_t*)(ws + WS_WIN) + ((size_t)l * 2944 + n) * 1024 + lane * 16;
            const u32x4 w0 = *(const u32x4*)wr, w1 = *(const u32x4*)(wr + 8);
            float wv[16];
#pragma unroll
            for (int i = 0; i < 4; ++i) { wv[2 * i] = bflo(w0[i]); wv[2 * i + 1] = bfhi(w0[i]); wv[8 + 2 * i] = bflo(w1[i]); wv[8 + 2 * i + 1] = bfhi(w1[i]); }
#pragma unroll
            for (int c = 0; c < 5; ++c) {
                const float* sh = mods + (size_t)(l * 5 + c) * 3072 + lane * 16;
                float d = 0.f;
#pragma unroll
                for (int i = 0; i < 4; ++i) { const f32x4 s4 = *(const f32x4*)(sh + 4 * i); d += (s4[0] * wv[4 * i] + s4[1] * wv[4 * i + 1]) + (s4[2] * wv[4 * i + 2] + s4[3] * wv[4 * i + 3]); }
                d = wsum(d);
                if (lane == 0) ((float*)(ws + WS_BIAS))[(size_t)(l * 5 + c) * 2944 + n] = d;
            }
            continue;
        }
        it -= P1_BIAS;
        {
            const int tok = it; const bool lat = tok >= 4096;
            const float* xr = lat ? p.in[I_XS] + (size_t)(tok - 4096) * 1024 : p.in[I_XP] + (size_t)tok * 1024;
            const int cond = lat ? 1 + ((tok - 4096) >> 10) : 0;
            xg_row(F, xr, p.in[I_NORMG], mods + (size_t)cond * 3072, (bf16_t*)(ws + WS_XG) + (size_t)tok * 1024, (float*)(ws + WS_SSQ) + (size_t)tok * 16, true);
        }
    }
}
#ifndef MK_TIMING
#define MK_TIMING -1
#endif
constexpr int CW_TIME = 2048;
__device__ __forceinline__ void phase_final(const Frame& F, const Params& p) {
    const int lane = F.lane;
    float tf = 1.f;
    if (MK_TIMING >= 0) tf = __uint_as_float(__hip_atomic_load((unsigned*)(F.ws + WS_CTL) + CW_TIME, __ATOMIC_RELAXED, __HIP_MEMORY_SCOPE_AGENT));
    const int gw = blockIdx.x * NWAVE + F.w, ngw = gridDim.x * NWAVE;
    for (int tok = gw; tok < 8192; tok += ngw) {
        float ss = 0.f;
        if (lane < 16) ss = ((const float*)(F.ws + WS_SSQ))[(size_t)tok * 16 + lane];
        ss = wsum(ss);
        const float rstd = rsqrtf(ss * (1.f / 1024.f) + EPS);
        const float* xr = p.xs + (size_t)tok * 1024; float* orow = p.out + (size_t)tok * 1024;
#pragma unroll
        for (int j = 0; j < 4; ++j) {
            const int k = j * 256 + lane * 4;
            const f32x4 x = *(const f32x4*)(xr + k), fn = *(const f32x4*)(p.in[I_FNORM] + k);
            *(f32x4*)(orow + k) = x * fn * (rstd * tf);
        }
    }
}

#ifndef MK_EN
#define MK_EN 0xff
#endif
#define EN(x) ((MK_EN >> (x)) & 1)
constexpr int PH_TOTAL = 19;
__global__ void __launch_bounds__(512, 2) mega(Params p) {
    extern __shared__ __attribute__((aligned(16))) unsigned char lds_raw[];
    Frame F;
    F.lds = (LAS unsigned char*)lds_raw;
    F.tid = threadIdx.x; F.lane = F.tid & 63; F.w = __builtin_amdgcn_readfirstlane(F.tid >> 6); F.h = F.lane >> 5; F.lq = F.lane & 31;
    F.ws = p.ws;
    volatile LAS unsigned* MISC = (volatile LAS unsigned*)(F.lds + LDS_MISC);
    if (F.tid < 64) MISC[F.tid] = 0u;
    __syncthreads();
    unsigned* ctl = (unsigned*)(p.ws + WS_CTL);
    XcdBarrier bar; bar.bar = ctl + CW_BAR; bar.x = 0; bar.st = nullptr;
    const bool multi = p.ph_hi - p.ph_lo > 1;
    if (multi) bar = xcd_barrier_post(ctl + CW_BAR, MISC + 8);
    const int G = gridDim.x;
    const Frame F0 = F;
    for (int ph = p.ph_lo; ph < p.ph_hi; ++ph) {
        Frame F = F0;
        asm volatile("" : "+v"(F.lane));
        F.tid = threadIdx.x; F.h = F.lane >> 5; F.lq = F.lane & 31;
        asm volatile("" : "+s"(F.w), "+s"(F.ws));
        if (MK_TIMING >= 0 && blockIdx.x == 0 && F.tid == 0) {
            const unsigned long long now = __builtin_amdgcn_s_memrealtime();
            const unsigned long long prev = ((unsigned long long)MISC[17] << 32) | MISC[16];
            if (ph > p.ph_lo) { const int q = ph - 1; const int grp = q < 2 ? q : 2 + ((q - 2) & 3); if (grp == MK_TIMING) MISC[18] += (unsigned)(now - prev); }
            MISC[16] = (unsigned)now; MISC[17] = (unsigned)(now >> 32);
        }
#ifndef MK_REPEAT
#define MK_REPEAT -1
#endif
        int nrep = 1;
        if (MK_REPEAT >= 1) { const int grp = ph < 2 ? ph : (ph == 18 ? 6 : 2 + ((ph - 2) & 3)); if (grp == MK_REPEAT) nrep = (grp == 5) ? (ph == 5 ? 5 : 1) : 2; }
        for (int rep = 0; rep < nrep; ++rep) {
        if (rep > 0) xcd_barrier(bar);
        Frame F = F0;
        asm volatile("" : "+v"(F.lane));
        F.tid = threadIdx.x; F.h = F.lane >> 5; F.lq = F.lane & 31;
        asm volatile("" : "+s"(F.w), "+s"(F.ws));
        if (EN(0) && ph == 0) {
#if defined(MK_DUP0)
            for (int d = 0; d < 2; ++d) { int dd = d; asm volatile("" : "+s"(dd)); if (dd) xcd_barrier(bar); phase0(F, p, dd != 0); }
#else
            phase0(F, p);
#endif
        }
        else if (EN(1) && ph == 1) phase1(F, p);
        else if (EN(2) && ph == 18) phase_final(F, p);
        else {
            const int l = (ph - 2) >> 2, sub = (ph - 2) & 3;
            if (EN(3) && sub == 0) {
                const bf16_t* Wt = (const bf16_t*)(F.ws + WS_WIN) + (size_t)l * 2944 * 1024;
                const bf16_t* X = (const bf16_t*)(F.ws + WS_XG);
                for (int j = blockIdx.x; j < 23 * 32; j += G) {
                    const int tn = j >> 5, tm = j & 31;
                    f32x16 acc[2][2];
                    float rstd2[2];
                    gemm1_rstd(F, tm, rstd2);
                    gemm_core(F, Wt + (size_t)tn * 128 * 1024, 1024, X + (size_t)tm * 256 * 1024, 1024, 1024, acc);
#if defined(MK_KLOOP2) && (MK_KLOOP2 & 1)
                    asm volatile("" : "+v"(acc[0][0]), "+v"(acc[0][1]), "+v"(acc[1][0]), "+v"(acc[1][1]));
                    gemm_core(F, Wt + (size_t)tn * 128 * 1024, 1024, X + (size_t)tm * 256 * 1024, 1024, 1024, acc);
#endif
                    epi_gemm1(F, p, acc, tn, tm, l, rstd2);
                }
            } else if (EN(4) && sub == 1) {
                for (int j = blockIdx.x; j < 400; j += G) {
                    f32x16 acc[2][2];
                    if (j < 160) {
                        const int tn = j >> 5, tm = j & 31;
                        gemm_core(F, (const bf16_t*)(F.ws + WS_WUQ) + ((size_t)l * 640 + tn * 128) * 256, 256, (const bf16_t*)(F.ws + WS_CQG) + (size_t)tm * 256 * 256, 256, 256, acc);
                        epi_qm(F, acc, tn, tm);
                    } else if (j < 352) {
                        const int jj = j - 160, tn = jj >> 5, tm = jj & 31;
                        gemm_core(F, (const bf16_t*)(F.ws + WS_WUKV) + ((size_t)l * 768 + tn * 128) * 128, 128, (const bf16_t*)(F.ws + WS_CKVN) + (size_t)tm * 256 * 128, 128, 128, acc);
                        epi_plain(F, acc, (bf16_t*)(F.ws + WS_KVM), 768, tm * 256, tn * 128);
                    } else {
                        const int jj = j - 352, tn = jj >> 3, tc = jj & 7, b = tc >> 1, jt = tc & 1;
                        gemm_core(F, (const bf16_t*)(F.ws + WS_WUKV) + ((size_t)l * 768 + tn * 128) * 128, 128,
                                  (const bf16_t*)(F.ws + WS_CCKV) + ((size_t)(b * 4 + l) * 512 + jt * 256) * 128, 128, 128, acc);
                        epi_plain(F, acc, (bf16_t*)(F.ws + WS_KVMC), 768, b * 512 + jt * 256, tn * 128);
                    }
                }
            } else if (EN(5) && sub == 2) {
                for (;;) {
                    __syncthreads();
                    if (F.tid == 0) MISC[0] = atomicAdd(ctl + CW_QUEUE + 64 * l + 32 * rep, 1u);
                    __syncthreads();
                    const int u = __builtin_amdgcn_readfirstlane((int)MISC[0]);
                    if (u >= N_ATTN_UNITS) break;
                    attn_dispatch(F, p, u, l);
                }
            } else if (EN(6)) {
                const bf16_t* Wt = (const bf16_t*)(F.ws + WS_WOUT) + (size_t)l * 1024 * 1024;
                const bf16_t* Yb = (const bf16_t*)(F.ws + WS_Y);
                for (int j = blockIdx.x; j < 8 * 32; j += G) {
                    const int tn = j >> 5, tm = j & 31;
                    f32x16 acc[2][2];
                    gemm_core(F, Wt + (size_t)tn * 128 * 1024, 1024, Yb + (size_t)tm * 256 * 1024, 1024, 1024, acc);
#if defined(MK_KLOOP2) && (MK_KLOOP2 & 2)
                    asm volatile("" : "+v"(acc[0][0]), "+v"(acc[0][1]), "+v"(acc[1][0]), "+v"(acc[1][1]));
                    gemm_core(F, Wt + (size_t)tn * 128 * 1024, 1024, Yb + (size_t)tm * 256 * 1024, 1024, 1024, acc);
#endif
                    epi_gemm2(F, p, acc, tn, tm, l);
                }
            }
        }
        }
        if (MK_TIMING >= 0 && ph == 17 && blockIdx.x == 0 && F.tid == 0) {
            const unsigned long long now = __builtin_amdgcn_s_memrealtime();
            const unsigned long long prev = ((unsigned long long)MISC[17] << 32) | MISC[16];
            unsigned a = MISC[18]; if (MK_TIMING == 5) a += (unsigned)(now - prev);
            __hip_atomic_store(ctl + CW_TIME, __float_as_uint(1.f + (float)a * 1e-5f), __ATOMIC_RELAXED, __HIP_MEMORY_SCOPE_AGENT);
        }
        if (ph + 1 < p.ph_hi) xcd_barrier(bar);
    }
}
}

extern "C" void kernel_launch(void* const* d_in, const int* in_sizes, int n_in, void* d_out, int out_size, void* d_ws, size_t ws_size, hipStream_t stream) {
    static int grid = 0;
    if (!grid) {
        int dev = 0, cus = 0, per_cu = 0;
        (void)hipGetDevice(&dev);
        (void)hipDeviceGetAttribute(&cus, hipDeviceAttributeMultiprocessorCount, dev);
        (void)hipFuncSetAttribute((const void*)mk::mega, hipFuncAttributeMaxDynamicSharedMemorySize, mk::LDS_BYTES);
        (void)hipOccupancyMaxActiveBlocksPerMultiprocessor(&per_cu, (const void*)mk::mega, 512, mk::LDS_BYTES);
        if (per_cu > 1) per_cu = 1;
        if (per_cu < 1) per_cu = 1;
        if (cus < 1) cus = 256;
        grid = cus * per_cu;
    }
    unsigned char* ws = (unsigned char*)d_ws;
    (void)hipMemsetAsync(ws, 0, mk::CTL_ZERO_BYTES, stream);
    mk::Params P{};
    for (int i = 0; i < 22; ++i) P.in[i] = (const float*)d_in[i];
    P.out = (float*)d_out; P.ws = ws; P.xs = (float*)d_out;
    P.ph_lo = 0; P.ph_hi = mk::PH_TOTAL;
    void* args[] = {&P};
    (void)hipLaunchCooperativeKernel((const void*)mk::mega, dim3(grid), dim3(512), args, mk::LDS_BYTES, stream);
}
```

```cpp
#include <hip/hip_runtime.h>
#include <stdint.h>
namespace mk {
#define LAS __attribute__((address_space(3)))
typedef unsigned short bf16_t;
typedef short bf16x8 __attribute__((ext_vector_type(8)));
typedef short s16x4 __attribute__((ext_vector_type(4)));
typedef float f32x16 __attribute__((ext_vector_type(16)));
typedef float f32x4 __attribute__((ext_vector_type(4)));
typedef float f32x2 __attribute__((ext_vector_type(2)));
typedef unsigned u32x4 __attribute__((ext_vector_type(4)));
typedef unsigned u32x2 __attribute__((ext_vector_type(2)));
typedef __bf16 bf16x2_t __attribute__((ext_vector_type(2)));

constexpr float EPS = 1e-6f;
constexpr float LOG2E = 1.4426950408889634f;
constexpr float QSC_GQA = 0.125f * LOG2E;
constexpr float QSC_MLA = 0.10206207261596575f * LOG2E;

__device__ __forceinline__ unsigned pk2(float lo, float hi) { f32x2 v = {lo, hi}; bf16x2_t b = __builtin_convertvector(v, bf16x2_t); return __builtin_bit_cast(unsigned, b); }
__device__ __forceinline__ float bf2f(unsigned short u) { return __uint_as_float((unsigned)u << 16); }
__device__ __forceinline__ float bflo(unsigned u) { return __uint_as_float(u << 16); }
__device__ __forceinline__ float bfhi(unsigned u) { return __uint_as_float(u & 0xffff0000u); }
__device__ __forceinline__ float silu_f(float x) { return x * __builtin_amdgcn_rcpf(1.f + __builtin_amdgcn_exp2f(-x * LOG2E)); }
__device__ __forceinline__ float wsum(float v) {
#pragma unroll
    for (int o = 32; o > 0; o >>= 1) v += __shfl_xor(v, o);
    return v;
}

constexpr size_t MiB = 1u << 20;
constexpr size_t WS_CTL = 0, CTL_ZERO_BYTES = 1 * MiB;
constexpr size_t WS_MODS = 256 * 1024;
constexpr size_t WS_BIAS = 1 * MiB;
constexpr size_t WS_GS = 1 * MiB + 256 * 1024;
constexpr size_t WS_ROPE64 = 1 * MiB + 512 * 1024;
constexpr size_t WS_ROPE32 = 1 * MiB + 768 * 1024;
constexpr size_t WS_SSQ = 2 * MiB;
constexpr size_t WS_CQSSQ = 2 * MiB + 512 * 1024;
constexpr size_t WS_S0T = 3 * MiB;
constexpr size_t WS_CGK = 4 * MiB, WS_CGV = 6 * MiB, WS_CCKV = 8 * MiB, WS_CKPE = 10 * MiB;
constexpr size_t WS_WIN = 11 * MiB;
constexpr size_t WS_WOUT = 34 * MiB;
constexpr size_t WS_WUQ = 42 * MiB;
constexpr size_t WS_WUKV = 43 * MiB + 256 * 1024;
constexpr size_t WS_XG = 44 * MiB;
constexpr size_t WS_KVM = 44 * MiB;
constexpr size_t WS_KVMC = 56 * MiB;
constexpr size_t WS_RQ = 60 * MiB, WS_RK = 64 * MiB, WS_RV = 68 * MiB;
constexpr size_t WS_GQ = 72 * MiB;
constexpr size_t WS_GK = 78 * MiB, WS_GV = 80 * MiB;
constexpr size_t WS_CQG = 82 * MiB;
constexpr size_t WS_CKVN = 86 * MiB;
constexpr size_t WS_KPEB = 88 * MiB;
constexpr size_t WS_ZS = 89 * MiB;
constexpr size_t WS_QM = 105 * MiB;
constexpr size_t WS_Y = 114 * MiB;
constexpr size_t WS_XSDBG = 130 * MiB;
constexpr size_t WS_OPT_END = 162 * MiB;
constexpr int CW_QUEUE = 1024;
constexpr int CW_BAR = 4096;

constexpr size_t O_STATE = 8388608, O_GK = 10485760, O_GV = 12582912, O_CKV = 14680064, O_KPE = 16777216;

constexpr int NWAVE = 8;
constexpr int GST = 49152;
constexpr int LDS_OST = GST;
constexpr int LDS_EX = 120832;
constexpr int LDS_EXB = 122880;
constexpr int LDS_SCAL = 126976;
constexpr int LDS_MISC = 128000;
constexpr int LDS_BYTES = 128256;

struct Params { const float* in[22]; float* out; unsigned char* ws; float* xs; int ph_lo, ph_hi; };
enum { I_XP = 0, I_XS, I_STATE, I_CGK, I_CGV, I_CCKV, I_CKPE, I_C, I_CCTX, I_NORMG, I_WADA, I_BADA, I_WIN, I_DECAY, I_GQN, I_GKN, I_MQN, I_MKVN, I_WUQ, I_WUKV, I_WOUT, I_FNORM };

#define XB_TMO      128
#define XB_XCNT(j)  (256  + 64 * (j))
#define XB_XSUB(j)  (1280 + 64 * (j))
#define XB_XGEN(j)  (2304 + 64 * (j))
#define XB_TOP      3328
#define XB_TOPGEN   3392
#define XB_SPIN_CAP (1u << 20)
__device__ __forceinline__ unsigned xb_ld(unsigned* p) { return __hip_atomic_load(p, __ATOMIC_RELAXED, __HIP_MEMORY_SCOPE_AGENT); }
__device__ __forceinline__ unsigned xb_add(unsigned* p, unsigned v) { return __hip_atomic_fetch_add(p, v, __ATOMIC_RELAXED, __HIP_MEMORY_SCOPE_AGENT); }
__device__ __forceinline__ unsigned xb_xcc_id() { return (unsigned)__builtin_amdgcn_s_getreg((3 << 11) | 20) & 0xFu; }
#define XB_SPIN(cond, bar) do { unsigned _sp = 0; while (cond) { __builtin_amdgcn_s_sleep(1); \
    if ((++_sp & 255u) == 0u) { if (xb_ld(&(bar)[XB_TMO])) break; if (_sp > XB_SPIN_CAP) { atomicAdd(&(bar)[XB_TMO], 1u); break; } } } } while (0)
struct XcdBarrier { unsigned* bar; unsigned x; volatile LAS unsigned* st; };
__device__ __forceinline__ XcdBarrier xcd_barrier_post(unsigned* bar, volatile LAS unsigned* st) {
    XcdBarrier b; b.bar = bar; b.x = xb_xcc_id(); b.st = st;
    if (threadIdx.x == 0) (void)xb_add(&bar[XB_XCNT(b.x)], 1u);
    return b;
}
__device__ __forceinline__ void xcd_barrier_complete(unsigned* bar, unsigned x, unsigned& nloc, unsigned& nx) {
    const unsigned G = gridDim.x * gridDim.y * gridDim.z;
    unsigned sum, cnt, mine, sp = 0u;
    for (;;) {
        sum = 0u; cnt = 0u; mine = 0u;
#pragma unroll
        for (unsigned j = 0; j < 16; ++j) { const unsigned c = xb_ld(&bar[XB_XCNT(j)]); sum += c; cnt += (c > 0u) ? 1u : 0u; mine = (j == x) ? c : mine; }
        if (sum == G) break;
        __builtin_amdgcn_s_sleep(1);
        if ((++sp & 255u) == 0u) { if (xb_ld(&bar[XB_TMO])) break; if (sp > XB_SPIN_CAP) { atomicAdd(&bar[XB_TMO], 1u); break; } }
    }
    nloc = mine > 0u ? mine : 1u; nx = cnt > 0u ? cnt : 1u;
}
__device__ __forceinline__ void xcd_barrier(const XcdBarrier& b) {
    asm volatile("s_waitcnt vmcnt(0)" ::: "memory");
    __syncthreads();
    if (threadIdx.x == 0) {
        unsigned* bar = b.bar;
        __builtin_amdgcn_s_waitcnt(0);
        unsigned nloc = b.st[0], nx = b.st[1];
        if (nloc == 0u) { xcd_barrier_complete(bar, b.x, nloc, nx); b.st[0] = nloc; b.st[1] = nx; }
        const unsigned old = xb_add(&bar[XB_XSUB(b.x)], 1u);
        const unsigned gen = old / nloc;
        if (old + 1u == (gen + 1u) * nloc) {
            __builtin_amdgcn_fence(__ATOMIC_RELEASE, "agent");
            asm volatile("s_waitcnt vmcnt(0)" ::: "memory");
            const unsigned og = xb_add(&bar[XB_TOP], 1u);
            const unsigned tg = og / nx;
            if (og + 1u == (tg + 1u) * nx) xb_add(&bar[XB_TOPGEN], 1u);
            else XB_SPIN(xb_ld(&bar[XB_TOPGEN]) == tg, bar);
            __builtin_amdgcn_fence(__ATOMIC_ACQUIRE, "agent");
            xb_add(&bar[XB_XGEN(b.x)], 1u);
            asm volatile("s_waitcnt vmcnt(0)" ::: "memory");
        } else {
            XB_SPIN(xb_ld(&bar[XB_XGEN(b.x)]) == gen, bar);
            __builtin_amdgcn_fence(__ATOMIC_ACQUIRE, "agent");
            asm volatile("s_waitcnt vmcnt(0)" ::: "memory");
        }
    }
    __syncthreads();
}

struct Frame {
    LAS unsigned char* lds;
    int tid, lane, w, h, lq;
    unsigned char* ws;
};
#define GLDS16(gsrc, ldsdst) __builtin_amdgcn_global_load_lds((const unsigned*)(gsrc), (LAS unsigned*)(ldsdst), 16, 0, 0)
#define MFMA32(a, b, c) __builtin_amdgcn_mfma_f32_32x32x16_bf16((a), (b), (c), 0, 0, 0)

struct GemmOp { const bf16_t* W; const bf16_t* X; int ldw, ldx, K; };
__device__ __forceinline__ void gemm_issue0(const Frame& F, const GemmOp& g) {
    const int lane = F.lane, w = F.w;
#pragma unroll
    for (int q = 0; q < 2; ++q) { const int row = 16 * w + 8 * q + (lane >> 3); GLDS16(g.W + row * g.ldw + ((lane & 7) ^ ((row >> 1) & 7)) * 8, F.lds + (16 * w + 8 * q) * 128); }
#pragma unroll
    for (int q = 0; q < 4; ++q) { const int row = 32 * w + 8 * q + (lane >> 3); GLDS16(g.X + row * g.ldx + ((lane & 7) ^ ((row >> 1) & 7)) * 8, F.lds + 16384 + (32 * w + 8 * q) * 128); }
}
__device__ __forceinline__ void gemm_core(const Frame& F, const GemmOp& g, f32x16 (&acc)[2][2], bool issue_first, bool has_next, const GemmOp& gn) {
    const int lane = F.lane, w = F.w;
    const bf16_t* __restrict__ W = g.W; const bf16_t* __restrict__ X = g.X;
    const int nkt = g.K >> 6;
    int offW[2], offX[4];
#pragma unroll
    for (int q = 0; q < 2; ++q) { const int row = 16 * w + 8 * q + (lane >> 3); offW[q] = row * g.ldw + ((lane & 7) ^ ((row >> 1) & 7)) * 8; }
#pragma unroll
    for (int q = 0; q < 4; ++q) { const int row = 32 * w + 8 * q + (lane >> 3); offX[q] = row * g.ldx + ((lane & 7) ^ ((row >> 1) & 7)) * 8; }
    LAS unsigned char* const dW = F.lds + (16 * w) * 128;
    LAS unsigned char* const dX = F.lds + 16384 + (32 * w) * 128;
#define GC_ISSUE(kt, st) do { _Pragma("unroll") for (int q = 0; q < 2; ++q) GLDS16(W + offW[q] + (kt) * 64, dW + (st) * GST + q * 1024); \
        _Pragma("unroll") for (int q = 0; q < 4; ++q) GLDS16(X + offX[q] + (kt) * 64, dX + (st) * GST + q * 1024); } while (0)
    const int wn = w & 1, wm = w >> 1, h = F.h, lq = F.lq;
    const int sw = (lane >> 1) & 7;
    int so[4];
#pragma unroll
    for (int s = 0; s < 4; ++s) so[s] = ((2 * s + h) ^ sw) << 4;
    const int bn0 = (64 * wn + lq) * 128, bm0 = 16384 + (64 * wm + lq) * 128;
#pragma unroll
    for (int a = 0; a < 2; ++a)
#pragma unroll
        for (int b = 0; b < 2; ++b)
#pragma unroll
            for (int r = 0; r < 16; ++r) acc[a][b][r] = 0.f;
    if (issue_first) GC_ISSUE(0, 0);
    asm volatile("s_waitcnt vmcnt(0)" ::: "memory");
    __syncthreads();
    for (int kt = 0; kt < nkt; ++kt) {
        const int st = kt & 1;
        if (kt + 1 < nkt) GC_ISSUE(kt + 1, st ^ 1);
        LAS unsigned char* const base = F.lds + st * GST;
#pragma unroll
        for (int s = 0; s < 4; ++s) {
            const bf16x8 a0 = *(const LAS bf16x8*)(base + bn0 + so[s]);
            const bf16x8 a1 = *(const LAS bf16x8*)(base + bn0 + 4096 + so[s]);
            const bf16x8 b0 = *(const LAS bf16x8*)(base + bm0 + so[s]);
            const bf16x8 b1 = *(const LAS bf16x8*)(base + bm0 + 4096 + so[s]);
            acc[0][0] = MFMA32(a0, b0, acc[0][0]);
            acc[0][1] = MFMA32(a0, b1, acc[0][1]);
            acc[1][0] = MFMA32(a1, b0, acc[1][0]);
            acc[1][1] = MFMA32(a1, b1, acc[1][1]);
        }
        asm volatile("s_waitcnt vmcnt(0)" ::: "memory");
        __syncthreads();
    }
#undef GC_ISSUE
    if (has_next) gemm_issue0(F, gn);
}
__device__ __forceinline__ int crow(int r, int h) { return (r & 3) + 8 * (r >> 2) + 4 * h; }

__device__ __forceinline__ void rope64_regs(float (&v)[2][16], float rowp, float colp, int h) {
    constexpr float INVR16[16] = {1.591549431e-01f, 8.949940161e-02f, 5.032921210e-02f, 2.830219583e-02f, 1.591549431e-02f, 8.949940161e-03f, 5.032921210e-03f, 2.830219583e-03f, 1.591549431e-03f, 8.949940161e-04f, 5.032921210e-04f, 2.830219583e-04f, 1.591549431e-04f, 8.949940161e-05f, 5.032921210e-05f, 2.830219583e-05f};
#pragma unroll
    for (int nt = 0; nt < 2; ++nt) {
        const float pos = nt ? colp : rowp;
#pragma unroll
        for (int g = 0; g < 2; ++g)
#pragma unroll
            for (int i = 0; i < 4; ++i) {
                const float rev = pos * (h ? INVR16[8 * g + 4 + i] : INVR16[8 * g + i]);
                const float sn = __builtin_amdgcn_sinf(rev), cs = __builtin_amdgcn_cosf(rev);
                const int r = 4 * g + i;
                const float x0 = v[nt][r], x1 = v[nt][r + 8];
                v[nt][r] = x0 * cs - x1 * sn;
                v[nt][r + 8] = x1 * cs + x0 * sn;
            }
    }
}
__device__ __forceinline__ void rope32_regs(float (&x)[16], float rowp, float colp, int h) {
    constexpr float INVR8[8] = {1.591549431e-01f, 5.032921210e-02f, 1.591549431e-02f, 5.032921210e-03f, 1.591549431e-03f, 5.032921210e-04f, 1.591549431e-04f, 5.032921210e-05f};
#pragma unroll
    for (int g = 0; g < 2; ++g) {
        const float pos = g ? colp : rowp;
#pragma unroll
        for (int i = 0; i < 4; ++i) {
            const float rev = pos * (h ? INVR8[4 + i] : INVR8[i]);
            const float sn = __builtin_amdgcn_sinf(rev), cs = __builtin_amdgcn_cosf(rev);
            const int r = 8 * g + i;
            const float x0 = x[r], x1 = x[r + 4];
            x[r] = x0 * cs - x1 * sn;
            x[r + 4] = x1 * cs + x0 * sn;
        }
    }
}
__device__ __forceinline__ float ssq64(const float (&v)[2][16]) {
    float s = 0.f;
#pragma unroll
    for (int nt = 0; nt < 2; ++nt)
#pragma unroll
        for (int r = 0; r < 16; ++r) s += v[nt][r] * v[nt][r];
    s += __shfl_xor(s, 32);
    return s;
}
__device__ __forceinline__ void mulvec64(float (&v)[2][16], const LAS float* gv, int h) {
#pragma unroll
    for (int nt = 0; nt < 2; ++nt)
#pragma unroll
        for (int g = 0; g < 4; ++g) {
            const f32x4 q = *(const LAS f32x4*)(gv + 32 * nt + 8 * g + 4 * h);
#pragma unroll
            for (int i = 0; i < 4; ++i) v[nt][4 * g + i] *= q[i];
        }
}
constexpr int OST_LD = 68, OST_BYTES = 32 * OST_LD * 4;
__device__ __forceinline__ void stage_write(LAS float* st, const float (&v)[2][16], int h, int lq) {
    asm volatile("s_waitcnt lgkmcnt(0)" ::: "memory");
    __builtin_amdgcn_wave_barrier();
#pragma unroll
    for (int nt = 0; nt < 2; ++nt)
#pragma unroll
        for (int g = 0; g < 4; ++g) {
            f32x4 o = {v[nt][4 * g], v[nt][4 * g + 1], v[nt][4 * g + 2], v[nt][4 * g + 3]};
            *(LAS f32x4*)(st + lq * OST_LD + 32 * nt + 8 * g + 4 * h) = o;
        }
    asm volatile("s_waitcnt lgkmcnt(0)" ::: "memory");
    __builtin_amdgcn_wave_barrier();
}
__device__ __forceinline__ void stage_store_bf16(const LAS float* st, bf16_t* dst, int ld, float sc, int lane) {
#pragma unroll 1
    for (int it = 0; it < 4; ++it) {
        const int row = it * 8 + (lane >> 3), c8 = (lane & 7) * 8;
        const f32x4 x0 = *(const LAS f32x4*)(st + row * OST_LD + c8), x1 = *(const LAS f32x4*)(st + row * OST_LD + c8 + 4);
        u32x4 o; o.x = pk2(x0[0] * sc, x0[1] * sc); o.y = pk2(x0[2] * sc, x0[3] * sc); o.z = pk2(x1[0] * sc, x1[1] * sc); o.w = pk2(x1[2] * sc, x1[3] * sc);
        *(u32x4*)(dst + (size_t)row * ld + c8) = o;
    }
}
__device__ __forceinline__ void stage_store_f32(const LAS float* st, float* dst, int ld, int lane) {
#pragma unroll 1
    for (int it = 0; it < 8; ++it) {
        const int row = it * 4 + (lane >> 4), c = (lane & 15) * 4;
        *(f32x4*)(dst + (size_t)row * ld + c) = *(const LAS f32x4*)(st + row * OST_LD + c);
    }
}
__device__ __forceinline__ void stage_store_bf16_32(const LAS float* st, bf16_t* dst, int ld, int lane) {
#pragma unroll 1
    for (int it = 0; it < 2; ++it) {
        const int row = it * 16 + (lane >> 2), c8 = (lane & 3) * 8;
        const f32x4 x0 = *(const LAS f32x4*)(st + row * OST_LD + c8), x1 = *(const LAS f32x4*)(st + row * OST_LD + c8 + 4);
        u32x4 o; o.x = pk2(x0[0], x0[1]); o.y = pk2(x0[2], x0[3]); o.z = pk2(x1[0], x1[1]); o.w = pk2(x1[2], x1[3]);
        *(u32x4*)(dst + (size_t)row * ld + c8) = o;
    }
}
__device__ __forceinline__ void stage_store_f32_32(const LAS float* st, float* dst, int ld, int lane) {
#pragma unroll 1
    for (int it = 0; it < 4; ++it) {
        const int row = it * 8 + (lane >> 3), c = (lane & 7) * 4;
        *(f32x4*)(dst + (size_t)row * ld + c) = *(const LAS f32x4*)(st + row * OST_LD + c);
    }
}

struct Gemm1Pre { float rstd2[2]; float bias, gain; };
__device__ __forceinline__ void gemm1_pre(const Frame& F, const Params& p, int tn, int tm, int l, Gemm1Pre& P) {
    const float* ssqp = (const float*)(F.ws + WS_SSQ);
    const int wn = F.w & 1;
#pragma unroll
    for (int mt = 0; mt < 2; ++mt) {
        const int tok = tm * 256 + (F.w >> 1) * 64 + mt * 32 + F.lq;
        const f32x4* sp = (const f32x4*)(ssqp + (size_t)tok * 16);
        float ss = 0.f;
#pragma unroll
        for (int i = 0; i < 4; ++i) { const f32x4 q = sp[i]; ss += (q[0] + q[1]) + (q[2] + q[3]); }
        P.rstd2[mt] = rsqrtf(ss * (1.f / 1024.f) + EPS);
    }
    const bool lat = tm >= 16;
    const int cond = lat ? 1 + ((tm - 16) >> 2) : 0;
    const int nb = tn * 128 + wn * 64;
    P.bias = ((const float*)(F.ws + WS_BIAS))[(size_t)(l * 5 + cond) * 2944 + nb + F.lane];
    const float* gp = nullptr;
    if (tn >= 6 && tn < 9) gp = p.in[I_GQN] + l * 64;
    else if (tn == 9) gp = p.in[I_GKN] + l * 64;
    else if (tn == 11 || tn == 12) gp = p.in[I_MQN] + l * 256 + (nb - 1408);
    else if (tn == 13) gp = p.in[I_MKVN] + l * 128 + wn * 64;
    P.gain = gp ? gp[F.lane] : 1.f;
}
__device__ __forceinline__ void epi_gemm1(const Frame& F, const Params& p, f32x16 (&acc)[2][2], int tn, int tm, int l, const Gemm1Pre& P) {
    int h = F.h, lq = F.lq, lane = F.lane; const int wn = F.w & 1, wm = F.w >> 1;
    asm volatile("" : "+v"(h), "+v"(lq), "+v"(lane));
    unsigned char* ws = F.ws;
    LAS float* st = (LAS float*)(F.lds + LDS_OST + F.w * OST_BYTES);
    const bool lat = tm >= 16;
    const int b = lat ? ((tm - 16) >> 2) : tm;
    const int cond = lat ? 1 + b : 0;
    const int nb = tn * 128 + wn * 64;
    LAS float* exb = (LAS float*)(F.lds + LDS_EXB) + F.w * 128;
    exb[lane] = P.bias; exb[64 + lane] = P.gain;
    asm volatile("s_waitcnt lgkmcnt(0)" ::: "memory");
    __builtin_amdgcn_wave_barrier();
    const LAS float* bias = exb;
    (void)cond;
    float* outp = p.out;
    float ckv_ss[2];
#pragma unroll
    for (int mt = 0; mt < 2; ++mt) {
        const int tok0 = tm * 256 + wm * 64 + mt * 32, tok = tok0 + lq;
        const int t0 = lat ? ((tok0 - 4096) & 1023) : (tok0 & 255), t = t0 + lq;
        const float rstd = P.rstd2[mt];
        float v[2][16];
#pragma unroll
        for (int nt = 0; nt < 2; ++nt)
#pragma unroll
            for (int g = 0; g < 4; ++g) {
                const f32x4 bq = *(const LAS f32x4*)(bias + 32 * nt + 8 * g + 4 * h);
#pragma unroll
                for (int i = 0; i < 4; ++i) v[nt][4 * g + i] = acc[nt][mt][4 * g + i] * rstd + bq[i];
            }
        const float rowp = (float)(t >> 6), colp = (float)(t & 63);
        const size_t orow0 = (size_t)(b * 4 + l) * 256 + t0;
        if (tn < 2) {
            if (lat) rope64_regs(v, rowp, colp, h);
            stage_write(st, v, h, lq);
            stage_store_bf16(st, (bf16_t*)(ws + WS_RQ) + (size_t)tok0 * 256 + nb, 256, 1.f, lane);
        } else if (tn < 4) {
            if (lat) rope64_regs(v, rowp, colp, h);
            stage_write(st, v, h, lq);
            stage_store_bf16(st, (bf16_t*)(ws + WS_RK) + (size_t)tok0 * 256 + (nb - 256), 256, 0.125f, lane);
        } else if (tn < 6) {
            stage_write(st, v, h, lq);
            stage_store_bf16(st, (bf16_t*)(ws + WS_RV) + (size_t)tok0 * 256 + (nb - 512), 256, 1.f, lane);
        } else if (tn < 9) {
            const float r = rsqrtf(ssq64(v) * (1.f / 64.f) + EPS);
#pragma unroll
            for (int nt = 0; nt < 2; ++nt)
#pragma unroll
                for (int i = 0; i < 16; ++i) v[nt][i] *= r;
            mulvec64(v, exb + 64, h);
            if (lat) rope64_regs(v, rowp, colp, h);
            stage_write(st, v, h, lq);
            stage_store_bf16(st, (bf16_t*)(ws + WS_GQ) + (size_t)tok0 * 384 + (nb - 768), 384, QSC_GQA, lane);
        } else if (tn == 9) {
            const float r = rsqrtf(ssq64(v) * (1.f / 64.f) + EPS);
#pragma unroll
            for (int nt = 0; nt < 2; ++nt)
#pragma unroll
                for (int i = 0; i < 16; ++i) v[nt][i] *= r;
            mulvec64(v, exb + 64, h);
            if (lat) rope64_regs(v, rowp, colp, h);
            stage_write(st, v, h, lq);
            if (!lat) stage_store_f32(st, outp + O_GK + orow0 * 128 + (nb - 1152), 128, lane);
            stage_store_bf16(st, (bf16_t*)(ws + WS_GK) + (size_t)tok0 * 128 + (nb - 1152), 128, 1.f, lane);
        } else if (tn == 10) {
            stage_write(st, v, h, lq);
            if (!lat) stage_store_f32(st, outp + O_GV + orow0 * 128 + (nb - 1280), 128, lane);
            stage_store_bf16(st, (bf16_t*)(ws + WS_GV) + (size_t)tok0 * 128 + (nb - 1280), 128, 1.f, lane);
        } else if (tn < 13) {
            const float s2 = ssq64(v);
            if (h == 0) ((float*)(ws + WS_CQSSQ))[(size_t)tok * 4 + ((nb - 1408) >> 6)] = s2;
            mulvec64(v, exb + 64, h);
            stage_write(st, v, h, lq);
            stage_store_bf16(st, (bf16_t*)(ws + WS_CQG) + (size_t)tok0 * 256 + (nb - 1408), 256, 1.f, lane);
        } else if (tn == 13) {
            ckv_ss[mt] = ssq64(v);
            if (h == 0) ((LAS float*)(F.lds + LDS_EX))[(wm * 2 + wn) * 64 + mt * 32 + lq] = ckv_ss[mt];
        } else if (tn < 22) {
#pragma unroll
            for (int nt = 0; nt < 2; ++nt)
#pragma unroll
                for (int i = 0; i < 16; ++i) v[nt][i] = silu_f(v[nt][i]);
            stage_write(st, v, h, lq);
            stage_store_bf16(st, (bf16_t*)(ws + WS_ZS) + (size_t)tok0 * 1024 + (nb - 1792), 1024, 1.f, lane);
        } else {
            if (wn == 0) {
                if (lat) rope32_regs(v[0], rowp, colp, h);
                stage_write(st, v, h, lq);
                if (!lat) stage_store_f32_32(st, outp + O_KPE + orow0 * 32, 32, lane);
                stage_store_bf16_32(st, (bf16_t*)(ws + WS_KPEB) + (size_t)tok0 * 32, 32, lane);
            }
        }
    }
    if (tn == 13) {
        __syncthreads();
#pragma unroll
        for (int mt = 0; mt < 2; ++mt) {
            const int tok0 = tm * 256 + wm * 64 + mt * 32, tok = tok0 + lq;
            const int t0 = lat ? ((tok0 - 4096) & 1023) : (tok0 & 255);
            const float rstd = P.rstd2[mt];
            float v[2][16];
#pragma unroll
            for (int nt = 0; nt < 2; ++nt)
#pragma unroll
                for (int g = 0; g < 4; ++g) {
                    const f32x4 bq = *(const LAS f32x4*)(bias + 32 * nt + 8 * g + 4 * h);
#pragma unroll
                    for (int i = 0; i < 4; ++i) v[nt][4 * g + i] = acc[nt][mt][4 * g + i] * rstd + bq[i];
                }
            const float tot = ckv_ss[mt] + ((const LAS float*)(F.lds + LDS_EX))[(wm * 2 + (wn ^ 1)) * 64 + mt * 32 + lq];
            const float r = rsqrtf(tot * (1.f / 128.f) + EPS);
#pragma unroll
            for (int nt = 0; nt < 2; ++nt)
#pragma unroll
                for (int i = 0; i < 16; ++i) v[nt][i] *= r;
            mulvec64(v, exb + 64, h);
            const size_t orow0 = (size_t)(b * 4 + l) * 256 + t0;
            stage_write(st, v, h, lq);
            if (!lat) stage_store_f32(st, outp + O_CKV + orow0 * 128 + wn * 64, 128, lane);
            stage_store_bf16(st, (bf16_t*)(ws + WS_CKVN) + (size_t)tok0 * 128 + wn * 64, 128, 1.f, lane);
        }
        __syncthreads();
    }
}

__device__ __forceinline__ void qm_pre(const Frame& F, int tm, float (&rstd2)[2]) {
#pragma unroll
    for (int mt = 0; mt < 2; ++mt) {
        const int tok = tm * 256 + (F.w >> 1) * 64 + mt * 32 + F.lq;
        const f32x4 q4 = *(const f32x4*)((const float*)(F.ws + WS_CQSSQ) + (size_t)tok * 4);
        rstd2[mt] = rsqrtf(((q4[0] + q4[1]) + (q4[2] + q4[3])) * (1.f / 256.f) + EPS);
    }
}
__device__ __forceinline__ void epi_qm(const Frame& F, f32x16 (&acc)[2][2], int tn, int tm, const float (&rstd2)[2]) {
    int h = F.h, lq = F.lq, lane = F.lane; const int wn = F.w & 1, wm = F.w >> 1;
    asm volatile("" : "+v"(h), "+v"(lq), "+v"(lane));
    unsigned char* ws = F.ws;
    LAS float* st = (LAS float*)(F.lds + LDS_OST + F.w * OST_BYTES);
    const bool lat = tm >= 16;
    const int nb = tn * 128 + wn * 64;
    if (nb >= 576) return;
#pragma unroll
    for (int mt = 0; mt < 2; ++mt) {
        const int tok0 = tm * 256 + wm * 64 + mt * 32, tok = tok0 + lq;
        const int t = lat ? ((tok - 4096) & 1023) : (tok & 255);
        const float rstd = rstd2[mt];
        const float rowp = (float)(t >> 6), colp = (float)(t & 63);
        float v[2][16];
#pragma unroll
        for (int nt = 0; nt < 2; ++nt) {
#pragma unroll
            for (int i = 0; i < 16; ++i) v[nt][i] = acc[nt][mt][i] * rstd;
            const int T = (nb + 32 * nt) >> 5;
            if (lat && (T % 3) == 2) rope32_regs(v[nt], rowp, colp, h);
        }
        stage_write(st, v, h, lq);
        stage_store_bf16(st, (bf16_t*)(ws + WS_QM) + (size_t)tok0 * 576 + nb, 576, QSC_MLA, lane);
    }
}
__device__ __forceinline__ void epi_plain(const Frame& F, f32x16 (&acc)[2][2], bf16_t* D, int ldd, int row0, int n0) {
    int h = F.h, lq = F.lq, lane = F.lane; const int wn = F.w & 1, wm = F.w >> 1;
    asm volatile("" : "+v"(h), "+v"(lq), "+v"(lane));
    LAS float* st = (LAS float*)(F.lds + LDS_OST + F.w * OST_BYTES);
#pragma unroll
    for (int mt = 0; mt < 2; ++mt) {
        const int r0 = row0 + wm * 64 + mt * 32;
        float v[2][16];
#pragma unroll
        for (int nt = 0; nt < 2; ++nt)
#pragma unroll
            for (int i = 0; i < 16; ++i) v[nt][i] = acc[nt][mt][i];
        stage_write(st, v, h, lq);
        stage_store_bf16(st, D + (size_t)r0 * ldd + n0 + wn * 64, ldd, 1.f, lane);
    }
}

struct Gemm2Pre { f32x4 gt, gs; };
__device__ __forceinline__ void gemm2_pre(const Frame& F, int tn, int tm, int l, Gemm2Pre& P) {
    const bool lat = tm >= 16; const int cond = lat ? 1 + ((tm - 16) >> 2) : 0;
    const int nb = tn * 128 + (F.w & 1) * 64, c = (F.lane & 15) * 4;
    P.gt = *(const f32x4*)((const float*)(F.ws + WS_MODS) + (size_t)(l * 5 + cond) * 3072 + 2048 + nb + c);
    P.gs = *(const f32x4*)((const float*)(F.ws + WS_GS) + (size_t)((l < 3 ? l + 1 : 3) * 5 + cond) * 1024 + nb + c);
}
__device__ __forceinline__ void epi_gemm2(const Frame& F, const Params& p, f32x16 (&acc)[2][2], int tn, int tm, int l, const Gemm2Pre& P) {
    int h = F.h, lq = F.lq, lane = F.lane; const int wn = F.w & 1, wm = F.w >> 1;
    asm volatile("" : "+v"(h), "+v"(lq), "+v"(lane));
    unsigned char* ws = F.ws;
    LAS float* st = (LAS float*)(F.lds + LDS_OST + F.w * OST_BYTES);
    const bool lat = tm >= 16;
    const int b = lat ? ((tm - 16) >> 2) : tm;
    const int cond = lat ? 1 + b : 0;
    const int nb = tn * 128 + wn * 64;
    const int c = (lane & 15) * 4;
    const f32x4 gt = P.gt, gs = P.gs;
    (void)cond;
#pragma unroll
    for (int mt = 0; mt < 2; ++mt) {
        const int tok0 = tm * 256 + wm * 64 + mt * 32;
        float v[2][16];
#pragma unroll
        for (int nt = 0; nt < 2; ++nt)
#pragma unroll
            for (int i = 0; i < 16; ++i) v[nt][i] = acc[nt][mt][i];
        stage_write(st, v, h, lq);
        const float* xold0 = (l == 0) ? (lat ? p.in[I_XS] + (size_t)(tok0 - 4096) * 1024 : p.in[I_XP] + (size_t)tok0 * 1024) : p.xs + (size_t)tok0 * 1024;
        f32x4 xo8[8];
#pragma unroll
        for (int it = 0; it < 8; ++it) xo8[it] = *(const f32x4*)(xold0 + (size_t)(it * 4 + (lane >> 4)) * 1024 + nb + c);
#pragma unroll
        for (int it = 0; it < 8; ++it) {
            const int row = it * 4 + (lane >> 4);
            const f32x4 a = *(const LAS f32x4*)(st + row * OST_LD + c);
            const f32x4 xo = xo8[it];
            const f32x4 xn = xo + gt * a;
            *(f32x4*)(p.xs + (size_t)(tok0 + row) * 1024 + nb + c) = xn;
            float ss = (xn[0] * xn[0] + xn[1] * xn[1]) + (xn[2] * xn[2] + xn[3] * xn[3]);
            ss += __shfl_xor(ss, 1); ss += __shfl_xor(ss, 2); ss += __shfl_xor(ss, 4); ss += __shfl_xor(ss, 8);
            if ((lane & 15) == 0) ((float*)(ws + WS_SSQ))[(size_t)(tok0 + row) * 16 + tn * 2 + wn] = ss;
            if (l < 3) {
                u32x2 o; o.x = pk2(xn[0] * gs[0], xn[1] * gs[1]); o.y = pk2(xn[2] * gs[2], xn[3] * gs[3]);
                *(u32x2*)((bf16_t*)(ws + WS_XG) + (size_t)(tok0 + row) * 1024 + nb + c) = o;
            }
        }
    }
}
constexpr int AT_STG = 20480, AT_PE = 8192, AT_V = 12288, AT_OLD = 68;
struct AttnUnit {
    int mode;
    int nt0, nt1;
    const bf16_t *q; int q_ld;
    const bf16_t *k0, *k1; int k_ld0, k_ld1;
    const bf16_t *pe0, *pe1;
    const bf16_t *v0, *v1; int v_ld0, v_ld1;
    int tok0;
    int ycol;
    int qpos0, L;
    float lf, lb;
    const bf16_t *s0f, *s0b;
    float* st_out;
};
__device__ __forceinline__ s16x4 tr16(LAS const unsigned char* p) {
    typedef short v4i16_t __attribute__((ext_vector_type(4)));
    return __builtin_bit_cast(s16x4, __builtin_amdgcn_ds_read_tr16_b64_v4i16((LAS v4i16_t*)p));
}

template <int MODE>
__device__ __forceinline__ void attn_unit(const Frame& F, const Params& p, const AttnUnit& U) {
    constexpr int NQS = MODE == 1 ? 6 : 4;
    const int lane = F.lane, w = F.w, h = F.h, lq = F.lq;
    LAS unsigned char* lds = F.lds;
    const int k_ld = U.k_ld1, v_ld = U.v_ld1;
    const int krow = 8 * w + (lane >> 3);
    const int koff = krow * k_ld + ((lane & 7) ^ ((krow >> 1) & 7)) * 8;
    const int poff = (16 * (w & 3) + (lane >> 2)) * 32 + ((lane & 3) ^ ((lane >> 4) & 3)) * 8;
    const int vdblk = w >> 2, vkg = w & 3;
    const int voff = (16 * vkg + (lane >> 2)) * v_ld + vdblk * 32 + (lane & 3) * 8;
    const int vdst = AT_V + vdblk * 4096 + vkg * 1024;
    const int nt0 = U.nt0, ntot = U.nt0 + U.nt1;
    const unsigned ldsb = (unsigned)(uintptr_t)lds;
#define AT_DMA(gsrc, ldsoff) do { unsigned _keep; const unsigned _d = (unsigned)__builtin_amdgcn_readfirstlane((int)(ldsb + (unsigned)(ldsoff))); \
        asm volatile("s_mov_b32 %0, m0\n\ts_mov_b32 m0, %2\n\ts_nop 0\n\tglobal_load_lds_dwordx4 %1, off\n\ts_mov_b32 m0, %0" : "=&s"(_keep) : "v"(gsrc), "s"(_d) : "memory"); } while (0)
#define AT_ISSUE(t, st) do { const int _t = (t); const int _b = (st) * AT_STG; \
        const bool _s0 = _t < nt0; const int _u = _s0 ? _t : _t - nt0; \
        const bf16_t* _kb = (_s0 ? U.k0 : U.k1) + (size_t)_u * 64 * k_ld; const bf16_t* _vb = (_s0 ? U.v0 : U.v1) + (size_t)_u * 64 * v_ld; \
        AT_DMA(_kb + koff, _b + (8 * w) * 128); \
        if (MODE == 1) { const bf16_t* _pb = (_s0 ? U.pe0 : U.pe1) + (size_t)_u * 64 * 32; AT_DMA(_pb + poff, _b + AT_PE + 16 * (w & 3) * 64); } \
        AT_DMA(_vb + voff, _b + vdst); } while (0)
    AT_ISSUE(0, 0);
    if (ntot > 1) AT_ISSUE(1, 1);
    bf16x8 qr[NQS];
    if (MODE == 3) {
        const int dk = 32 * (w & 1) + lq;
#pragma unroll
        for (int s = 0; s < 4; ++s)
#pragma unroll
            for (int j = 0; j < 8; ++j) qr[s][j] = (16 * s + 8 * h + j == dk) ? (short)0x3F80 : (short)0;
    } else {
        const bf16_t* qp = U.q + (size_t)(32 * w + lq) * U.q_ld + 8 * h;
#pragma unroll
        for (int s = 0; s < NQS; ++s) qr[s] = *(const bf16x8*)(qp + 16 * s);
    }
    f32x16 o[2];
#pragma unroll
    for (int d = 0; d < 2; ++d)
#pragma unroll
        for (int r = 0; r < 16; ++r) o[d][r] = 0.f;
    float m_run = 0.f, l_run = 0.f;
    f32x16 negm;
#pragma unroll
    for (int r = 0; r < 16; ++r) negm[r] = 0.f;
    const int qpos = U.qpos0 + 32 * w + lq;
    const float st_slope = ((w >> 1) & 1) ? U.lb : -U.lf, st_off = ((w >> 1) & 1) ? 0.f : 255.f * U.lf;
    const int sdir = (w >> 1) & 1;
    LAS float* scal = (LAS float*)(lds + LDS_SCAL) + w * 32;
    LAS float* ctab = (LAS float*)(lds + LDS_EXB) + w * 128;
    float a_f = 0.f, a_b = 0.f;
    if (MODE == 2) {
        ctab[lane] = __builtin_amdgcn_exp2f((float)(63 - lane) * U.lf);
        ctab[64 + lane] = __builtin_amdgcn_exp2f((float)lane * U.lb);
        a_f = __builtin_amdgcn_exp2f((float)(32 * w + lq) * U.lf);
        a_b = __builtin_amdgcn_exp2f((float)(255 - 32 * w - lq) * U.lb);
        asm volatile("s_waitcnt lgkmcnt(0)" ::: "memory");
        __builtin_amdgcn_wave_barrier();
    }
    const int kfo = lq * 128, sw = (lane >> 1) & 7, pfo = AT_PE + lq * 64, psw = (lane >> 2) & 3;
    const int vfo = AT_V + (4 * h + ((lane & 15) >> 2)) * 64 + ((lane >> 4) & 1) * 32 + (lane & 3) * 8;
    int st = 0;
    for (int t = 0; t < ntot; ++t) {
        if (t + 1 < ntot) { if (MODE == 1) asm volatile("s_waitcnt vmcnt(3)" ::: "memory"); else asm volatile("s_waitcnt vmcnt(2)" ::: "memory"); }
        else asm volatile("s_waitcnt vmcnt(0)" ::: "memory");
        __builtin_amdgcn_s_barrier();
        asm volatile("" ::: "memory");
        const int st2 = st == 0 ? 2 : st - 1;
        if (t + 2 < ntot) AT_ISSUE(t + 2, st2);
        LAS const unsigned char* base = lds + st * AT_STG;
        bf16x8 kfa[NQS], kfb[NQS];
#pragma unroll
        for (int s = 0; s < 4; ++s) {
            const int so = ((2 * s + h) ^ sw) << 4;
            kfa[s] = *(const LAS bf16x8*)(base + kfo + so);
            kfb[s] = *(const LAS bf16x8*)(base + kfo + 4096 + so);
        }
        if (MODE == 1) {
#pragma unroll
            for (int s = 0; s < 2; ++s) {
                const int so = ((2 * s + h) ^ psw) << 4;
                kfa[4 + s] = *(const LAS bf16x8*)(base + pfo + so);
                kfb[4 + s] = *(const LAS bf16x8*)(base + pfo + 2048 + so);
            }
        }
        f32x16 p0, p1;
        if (MODE <= 1) { p0 = negm; p1 = negm; }
        else {
#pragma unroll
            for (int r = 0; r < 16; ++r) { p0[r] = 0.f; p1[r] = 0.f; }
        }
#pragma unroll
        for (int s = 0; s < NQS; ++s) { p0 = MFMA32(kfa[s], qr[s], p0); p1 = MFMA32(kfb[s], qr[s], p1); }
        s16x4 vlo[4], vhi[4];
#pragma unroll
        for (int ks = 0; ks < 4; ++ks) { vlo[ks] = tr16(base + vfo + ks * 1024); vhi[ks] = tr16(base + vfo + ks * 1024 + 512); }
        if (MODE <= 1) {
            float tm = p0[0];
#pragma unroll
            for (int r = 1; r < 16; ++r) tm = fmaxf(tm, p0[r]);
#pragma unroll
            for (int r = 0; r < 16; ++r) tm = fmaxf(tm, p1[r]);
            tm = fmaxf(tm, __shfl_xor(tm, 32));
            if (t == 0 || __any(tm > 6.0f)) {
                const float dl = t == 0 ? tm : fmaxf(tm, 0.f);
                m_run += dl;
#pragma unroll
                for (int r = 0; r < 16; ++r) { p0[r] -= dl; p1[r] -= dl; negm[r] = -m_run; }
                if (t > 0) {
                    const float alpha = __builtin_amdgcn_exp2f(-dl);
                    l_run *= alpha;
                    if (h == 0) scal[lq] = alpha;
                    asm volatile("s_waitcnt lgkmcnt(0)" ::: "memory");
#pragma unroll
                    for (int g = 0; g < 4; ++g) {
                        const f32x4 a4 = *(const LAS f32x4*)(scal + 8 * g + 4 * h);
#pragma unroll
                        for (int i = 0; i < 4; ++i) { o[0][4 * g + i] *= a4[i]; o[1][4 * g + i] *= a4[i]; }
                    }
                }
            }
            float ls = 0.f;
#pragma unroll
            for (int r = 0; r < 16; ++r) { p0[r] = __builtin_amdgcn_exp2f(p0[r]); p1[r] = __builtin_amdgcn_exp2f(p1[r]); ls += p0[r] + p1[r]; }
            l_run += ls;
        } else if (MODE == 2 && (64 * t + 63 < U.qpos0 || 64 * t > U.qpos0 + 255)) {
            const bool fwd = 64 * t + 63 < U.qpos0;
            const float A = fwd ? a_f * __builtin_amdgcn_exp2f((float)(U.qpos0 - 64 * t - 63) * U.lf) : a_b * __builtin_amdgcn_exp2f((float)(64 * t - U.qpos0 - 255) * U.lb);
            const LAS float* tb = ctab + (fwd ? 0 : 64) + 4 * h;
#pragma unroll
            for (int g = 0; g < 4; ++g) {
                const f32x4 c0 = *(const LAS f32x4*)(tb + 8 * g), c1 = *(const LAS f32x4*)(tb + 32 + 8 * g);
#pragma unroll
                for (int i = 0; i < 4; ++i) { p0[4 * g + i] *= c0[i] * A; p1[4 * g + i] *= c1[i] * A; }
            }
        } else if (MODE == 2) {
            float dq = (float)(qpos - 64 * t - 4 * h);
            asm volatile("" : "+v"(dq));
#pragma unroll
            for (int r = 0; r < 16; ++r) {
                const float d0 = dq - (float)((r & 3) + 8 * (r >> 2)), d1 = d0 - 32.f;
                const float w0 = __builtin_amdgcn_exp2f(fabsf(d0) * (d0 > 0.f ? U.lf : U.lb));
                const float w1 = __builtin_amdgcn_exp2f(fabsf(d1) * (d1 > 0.f ? U.lf : U.lb));
                p0[r] *= (d0 == 0.f ? 2.f : w0);
                p1[r] *= (d1 == 0.f ? 2.f : w1);
            }
        } else {
            float mb = (float)(64 * t + 4 * h);
            asm volatile("" : "+v"(mb));
#pragma unroll
            for (int r = 0; r < 16; ++r) {
                const float m0 = mb + (float)((r & 3) + 8 * (r >> 2)), m1 = m0 + 32.f;
                const float e0 = fmaf(m0, st_slope, st_off), e1 = fmaf(m1, st_slope, st_off);
                p0[r] *= __builtin_amdgcn_exp2f(e0);
                p1[r] *= __builtin_amdgcn_exp2f(e1);
            }
        }
        bf16x8 pa[4];
        { u32x4 a;
          a.x = pk2(p0[0], p0[1]); a.y = pk2(p0[2], p0[3]); a.z = pk2(p0[4], p0[5]); a.w = pk2(p0[6], p0[7]); pa[0] = __builtin_bit_cast(bf16x8, a);
          a.x = pk2(p0[8], p0[9]); a.y = pk2(p0[10], p0[11]); a.z = pk2(p0[12], p0[13]); a.w = pk2(p0[14], p0[15]); pa[1] = __builtin_bit_cast(bf16x8, a);
          a.x = pk2(p1[0], p1[1]); a.y = pk2(p1[2], p1[3]); a.z = pk2(p1[4], p1[5]); a.w = pk2(p1[6], p1[7]); pa[2] = __builtin_bit_cast(bf16x8, a);
          a.x = pk2(p1[8], p1[9]); a.y = pk2(p1[10], p1[11]); a.z = pk2(p1[12], p1[13]); a.w = pk2(p1[14], p1[15]); pa[3] = __builtin_bit_cast(bf16x8, a); }
#pragma unroll
        for (int ks = 0; ks < 4; ++ks) {
            const bf16x8 vb = __builtin_shufflevector(vlo[ks], vhi[ks], 0, 1, 2, 3, 4, 5, 6, 7);
            o[0] = MFMA32(pa[ks], vb, o[0]);
        }
#pragma unroll
        for (int ks = 0; ks < 4; ++ks) { vlo[ks] = tr16(base + vfo + 4096 + ks * 1024); vhi[ks] = tr16(base + vfo + 4096 + ks * 1024 + 512); }
#pragma unroll
        for (int ks = 0; ks < 4; ++ks) {
            const bf16x8 vb = __builtin_shufflevector(vlo[ks], vhi[ks], 0, 1, 2, 3, 4, 5, 6, 7);
            o[1] = MFMA32(pa[ks], vb, o[1]);
        }
        st = st == 2 ? 0 : st + 1;
    }
#undef AT_ISSUE
#undef AT_DMA
    int lq2 = lq, h2 = h, lane2 = lane; asm volatile("" : "+v"(lq2), "+v"(h2), "+v"(lane2));
    if (MODE == 2 && U.s0f != nullptr) {
        const float ff = __builtin_amdgcn_exp2f((float)(qpos + 1) * U.lf), fb = __builtin_amdgcn_exp2f((float)(U.L - qpos) * U.lb);
#pragma unroll
        for (int s = 0; s < 4; ++s) {
            const u32x4 qu = __builtin_bit_cast(u32x4, qr[s]);
            u32x4 af, ab;
#pragma unroll
            for (int i = 0; i < 4; ++i) { const float lo = bflo(qu[i]), hi = bfhi(qu[i]); af[i] = pk2(lo * ff, hi * ff); ab[i] = pk2(lo * fb, hi * fb); }
#pragma unroll
            for (int d = 0; d < 2; ++d) {
                const bf16x8 sf = *(const bf16x8*)(U.s0f + (size_t)(32 * d + lq2) * 64 + 16 * s + 8 * h2);
                const bf16x8 sb = *(const bf16x8*)(U.s0b + (size_t)(32 * d + lq2) * 64 + 16 * s + 8 * h2);
                o[d] = MFMA32(__builtin_bit_cast(bf16x8, af), sf, o[d]);
                o[d] = MFMA32(__builtin_bit_cast(bf16x8, ab), sb, o[d]);
            }
        }
    }
    if (MODE == 3) {
        float* dst = U.st_out + (size_t)sdir * 4 * 4096 + (size_t)(32 * (w & 1)) * 64;
        if (w < 4) {
#pragma unroll
        for (int d = 0; d < 2; ++d)
#pragma unroll
            for (int r = 0; r < 16; ++r) dst[(size_t)((r & 3) + 8 * (r >> 2) + 4 * h2) * 64 + 32 * d + lq2] = o[d][r];
        }
        __syncthreads();
        return;
    }
    if (MODE <= 1) {
        l_run += __shfl_xor(l_run, 32);
        if (h2 == 0) scal[lq2] = 1.f / l_run;
    }
    __syncthreads();
    LAS float* ost = (LAS float*)lds + w * (32 * AT_OLD);
#pragma unroll
    for (int d = 0; d < 2; ++d)
#pragma unroll
        for (int r = 0; r < 16; ++r) ost[((r & 3) + 8 * (r >> 2) + 4 * h2) * AT_OLD + 32 * d + lq2] = o[d][r];
    asm volatile("s_waitcnt lgkmcnt(0)" ::: "memory");
    __builtin_amdgcn_wave_barrier();
    const bf16_t* zs = (const bf16_t*)(F.ws + WS_ZS);
    bf16_t* yb = (bf16_t*)(F.ws + WS_Y);
#pragma unroll
    for (int it = 0; it < 4; ++it) {
        const int row = it * 8 + (lane2 >> 3), c8 = (lane2 & 7) * 8;
        const f32x4 x0 = *(const LAS f32x4*)(ost + row * AT_OLD + c8), x1 = *(const LAS f32x4*)(ost + row * AT_OLD + c8 + 4);
        float sc;
        if (MODE <= 1) sc = scal[row];
        else {
            float ss = (x0[0] * x0[0] + x0[1] * x0[1]) + (x0[2] * x0[2] + x0[3] * x0[3]) + (x1[0] * x1[0] + x1[1] * x1[1]) + (x1[2] * x1[2] + x1[3] * x1[3]);
            ss += __shfl_xor(ss, 1); ss += __shfl_xor(ss, 2); ss += __shfl_xor(ss, 4);
            sc = rsqrtf(ss * (1.f / 64.f) + EPS);
        }
        const size_t off = (size_t)(U.tok0 + 32 * w + row) * 1024 + U.ycol + c8;
        const u32x4 z = *(const u32x4*)(zs + off);
        u32x4 y;
        y.x = pk2(x0[0] * sc * bflo(z.x), x0[1] * sc * bfhi(z.x));
        y.y = pk2(x0[2] * sc * bflo(z.y), x0[3] * sc * bfhi(z.y));
        y.z = pk2(x1[0] * sc * bflo(z.z), x1[1] * sc * bfhi(z.z));
        y.w = pk2(x1[2] * sc * bflo(z.w), x1[3] * sc * bfhi(z.w));
        *(u32x4*)(yb + off) = y;
    }
    __syncthreads();
}

__device__ __forceinline__ void attn_dispatch(const Frame& F, const Params& p, int u, int l) {
    unsigned char* ws = F.ws;
    AttnUnit U;
    U.nt0 = 0; U.nt1 = 0; U.q = nullptr; U.q_ld = 0; U.k0 = U.k1 = nullptr; U.k_ld0 = U.k_ld1 = 0; U.pe0 = U.pe1 = nullptr; U.v0 = U.v1 = nullptr; U.v_ld0 = U.v_ld1 = 0;
    U.tok0 = 0; U.ycol = 0; U.qpos0 = 0; U.L = 0; U.lf = U.lb = 0.f; U.s0f = U.s0b = nullptr; U.st_out = nullptr; U.mode = 0;
    const bf16_t* GQ = (const bf16_t*)(ws + WS_GQ); const bf16_t* GK = (const bf16_t*)(ws + WS_GK); const bf16_t* GV = (const bf16_t*)(ws + WS_GV);
    const bf16_t* QM = (const bf16_t*)(ws + WS_QM); const bf16_t* KVM = (const bf16_t*)(ws + WS_KVM); const bf16_t* KVMC = (const bf16_t*)(ws + WS_KVMC);
    const bf16_t* KPEB = (const bf16_t*)(ws + WS_KPEB); const bf16_t* CKPE = (const bf16_t*)(ws + WS_CKPE);
    const bf16_t* CGK = (const bf16_t*)(ws + WS_CGK); const bf16_t* CGV = (const bf16_t*)(ws + WS_CGV);
    const bf16_t* RQ = (const bf16_t*)(ws + WS_RQ); const bf16_t* RK = (const bf16_t*)(ws + WS_RK); const bf16_t* RV = (const bf16_t*)(ws + WS_RV);
    const float* decay = p.in[I_DECAY] + l * 8;
    if (u < 96 || (u >= 256 && u < 352)) {
        const bool lat = u < 96; const int uu = lat ? u : u - 256;
        const int b = lat ? uu / 24 : uu / 6, hh = lat ? (uu >> 2) % 6 : uu % 6, qb = lat ? (uu & 3) : 0;
        const int seq0 = lat ? 4096 + b * 1024 : b * 256;
        U.mode = 1; U.tok0 = seq0 + qb * 256; U.q = QM + (size_t)U.tok0 * 576 + hh * 96; U.q_ld = 576; U.ycol = 640 + hh * 64;
        U.nt1 = lat ? 16 : 4; U.k1 = KVM + (size_t)seq0 * 768 + hh * 128; U.k_ld1 = 768; U.v1 = U.k1 + 64; U.v_ld1 = 768; U.pe1 = KPEB + (size_t)seq0 * 32;
        U.k0 = U.k1; U.v0 = U.v1; U.pe0 = U.pe1; U.k_ld0 = 768; U.v_ld0 = 768;
        if (lat) { U.nt0 = 8; U.k0 = KVMC + (size_t)(b * 512) * 768 + hh * 128; U.v0 = U.k0 + 64; U.pe0 = CKPE + (size_t)((b * 4 + l) * 512) * 32; }
        attn_unit<1>(F, p, U);
    } else if (u < 192 || (u >= 352 && u < 448)) {
        const bool lat = u < 192; const int uu = lat ? u - 96 : u - 352;
        const int b = lat ? uu / 24 : uu / 6, hh = lat ? (uu >> 2) % 6 : uu % 6, qb = lat ? (uu & 3) : 0, kvh = hh / 3;
        const int seq0 = lat ? 4096 + b * 1024 : b * 256;
        U.mode = 0; U.tok0 = seq0 + qb * 256; U.q = GQ + (size_t)U.tok0 * 384 + hh * 64; U.q_ld = 384; U.ycol = 256 + hh * 64;
        U.nt1 = lat ? 16 : 4; U.k1 = GK + (size_t)seq0 * 128 + kvh * 64; U.k_ld1 = 128; U.v1 = GV + (size_t)seq0 * 128 + kvh * 64; U.v_ld1 = 128;
        U.k0 = U.k1; U.v0 = U.v1; U.k_ld0 = 128; U.v_ld0 = 128;
        if (lat) { U.nt0 = 8; U.k0 = CGK + (size_t)((b * 4 + l) * 512) * 128 + kvh * 64; U.v0 = CGV + (size_t)((b * 4 + l) * 512) * 128 + kvh * 64; }
        attn_unit<0>(F, p, U);
    } else if (u < 256 || (u >= 448 && u < 512)) {
        const bool lat = u < 256; const int uu = lat ? u - 192 : u - 448;
        const int b = lat ? uu / 16 : uu / 4, hh = lat ? (uu >> 2) & 3 : uu & 3, qb = lat ? (uu & 3) : 0;
        const int seq0 = lat ? 4096 + b * 1024 : b * 256;
        U.mode = 2; U.tok0 = seq0 + qb * 256; U.q = RQ + (size_t)U.tok0 * 256 + hh * 64; U.q_ld = 256; U.ycol = hh * 64;
        U.nt1 = lat ? 16 : 4; U.k1 = RK + (size_t)seq0 * 256 + hh * 64; U.k_ld1 = 256; U.v1 = RV + (size_t)seq0 * 256 + hh * 64; U.v_ld1 = 256;
        U.k0 = U.k1; U.v0 = U.v1; U.k_ld0 = 256; U.v_ld0 = 256;
        U.qpos0 = qb * 256; U.L = lat ? 1024 : 256;
        U.lf = -log1pf(__expf(-decay[hh])) * LOG2E; U.lb = -log1pf(__expf(-decay[4 + hh])) * LOG2E;
        if (lat) { const bf16_t* S0T = (const bf16_t*)(ws + WS_S0T); U.s0f = S0T + (size_t)(((b * 4 + l) * 2 + 0) * 4 + hh) * 4096; U.s0b = S0T + (size_t)(((b * 4 + l) * 2 + 1) * 4 + hh) * 4096; }
        attn_unit<2>(F, p, U);
    } else {
        const int uu = u - 512, b = uu >> 2, hh = uu & 3, seq0 = b * 256;
        U.mode = 3; U.nt1 = 4; U.k1 = RK + (size_t)seq0 * 256 + hh * 64; U.k_ld1 = 256; U.v1 = RV + (size_t)seq0 * 256 + hh * 64; U.v_ld1 = 256;
        U.k0 = U.k1; U.v0 = U.v1; U.k_ld0 = 256; U.v_ld0 = 256;
        U.lf = -log1pf(__expf(-decay[hh])) * LOG2E; U.lb = -log1pf(__expf(-decay[4 + hh])) * LOG2E;
        U.st_out = p.out + O_STATE + (size_t)(((b * 4 + l) * 2 + 0) * 4 + hh) * 4096;
        attn_unit<3>(F, p, U);
    }
}
constexpr int N_ATTN_UNITS = 576;
struct TItem { const float* src; bf16_t* dst; int nsrc, K; int valid; };
constexpr int P0_TWIN = 4 * 16 * 92, P0_TWOUT = 4 * 16 * 32, P0_TWUQ = 4 * 4 * 20, P0_TWUKV = 4 * 2 * 24, P0_TR = P0_TWIN + P0_TWOUT + P0_TWUQ + P0_TWUKV;
__device__ __forceinline__ TItem p0_titem(const Params& p, unsigned char* ws, int it) {
    TItem t; t.valid = it < P0_TR; t.src = nullptr; t.dst = nullptr; t.nsrc = 0; t.K = 0;
    if (!t.valid) return t;
    if (it < P0_TWIN) {
        const int l = it / (16 * 92), r = it % (16 * 92), kb = r / 92, nb = r % 92, n0 = nb * 32;
        const int src = n0 < 1792 ? n0 : (n0 < 2816 ? n0 + 32 : (n0 < 2848 ? n0 - 2816 + 1792 : -1));
        t.nsrc = 2848; t.K = 1024;
        if (src >= 0) t.src = p.in[I_WIN] + (size_t)l * 1024 * 2848 + (size_t)(kb * 64) * 2848 + src;
        t.dst = (bf16_t*)(ws + WS_WIN) + ((size_t)l * 2944 + n0) * 1024 + kb * 64;
        return t;
    }
    it -= P0_TWIN;
    if (it < P0_TWOUT) {
        const int l = it / 512, r = it % 512, kb = r >> 5, nb = r & 31;
        t.nsrc = 1024; t.K = 1024; t.src = p.in[I_WOUT] + (size_t)l * 1024 * 1024 + (size_t)(kb * 64) * 1024 + nb * 32;
        t.dst = (bf16_t*)(ws + WS_WOUT) + ((size_t)l * 1024 + nb * 32) * 1024 + kb * 64;
        return t;
    }
    it -= P0_TWOUT;
    if (it < P0_TWUQ) {
        const int l = it / 80, r = it % 80, kb = r / 20, nb = r % 20;
        t.nsrc = 576; t.K = 256; if (nb < 18) t.src = p.in[I_WUQ] + (size_t)l * 256 * 576 + (size_t)(kb * 64) * 576 + nb * 32;
        t.dst = (bf16_t*)(ws + WS_WUQ) + ((size_t)l * 640 + nb * 32) * 256 + kb * 64;
        return t;
    }
    it -= P0_TWUQ;
    { const int l = it / 48, r = it % 48, kb = r / 24, nb = r % 24;
      t.nsrc = 768; t.K = 128; t.src = p.in[I_WUKV] + (size_t)l * 128 * 768 + (size_t)(kb * 64) * 768 + nb * 32;
      t.dst = (bf16_t*)(ws + WS_WUKV) + ((size_t)l * 768 + nb * 32) * 128 + kb * 64; }
    return t;
}
__device__ __forceinline__ void p0_tload(const TItem& t, float (&r)[32], int lane) {
    if (t.valid && t.src) {
        const float* wp = t.src + (size_t)(lane >> 5) * t.nsrc + (lane & 31);
#pragma unroll
        for (int i = 0; i < 32; ++i) r[i] = wp[(size_t)(2 * i) * t.nsrc];
    } else {
#pragma unroll
        for (int i = 0; i < 32; ++i) r[i] = 0.f;
    }
}
__device__ __forceinline__ void p0_tstore(const TItem& t, const float (&r)[32], LAS float* scr, int lane) {
    if (!t.valid) return;
#pragma unroll
    for (int i = 0; i < 32; ++i) scr[(2 * i + (lane >> 5)) * 33 + (lane & 31)] = r[i];
    asm volatile("s_waitcnt lgkmcnt(0)" ::: "memory");
    __builtin_amdgcn_wave_barrier();
    const int c = lane & 7;
#pragma unroll
    for (int j = 0; j < 4; ++j) {
        const int n = (lane >> 3) + 8 * j; const LAS float* s = scr + (8 * c) * 33 + n;
        u32x4 o; o.x = pk2(s[0 * 33], s[1 * 33]); o.y = pk2(s[2 * 33], s[3 * 33]); o.z = pk2(s[4 * 33], s[5 * 33]); o.w = pk2(s[6 * 33], s[7 * 33]);
        *(u32x4*)(t.dst + (size_t)n * t.K + 8 * c) = o;
    }
    asm volatile("s_waitcnt lgkmcnt(0)" ::: "memory");
    __builtin_amdgcn_wave_barrier();
}
__device__ __forceinline__ void cast8(const float* src, bf16_t* dst, size_t e) {
    const f32x4 a = *(const f32x4*)(src + e), b = *(const f32x4*)(src + e + 4);
    u32x4 o; o.x = pk2(a[0], a[1]); o.y = pk2(a[2], a[3]); o.z = pk2(b[0], b[1]); o.w = pk2(b[2], b[3]);
    *(u32x4*)(dst + e) = o;
}
constexpr int P0_MODS = 1536, P0_CAST_G = 512, P0_CAST_KPE = 128, P0_S0T = 512;
constexpr int P0_TOTAL = P0_MODS + 3 * P0_CAST_G + P0_CAST_KPE + P0_S0T;
__device__ __forceinline__ void phase0(const Frame& F, const Params& p, bool dup = false) {
    unsigned char* ws = F.ws + (dup ? 162 * MiB : 0); const int lane = F.lane;
    LAS float* scr = (LAS float*)F.lds + F.w * (64 * 33);
    const int gw = blockIdx.x * NWAVE + F.w, ngw = gridDim.x * NWAVE;
    for (int it = gw; it < P0_TR; it += 2 * ngw) {
        const TItem t0 = p0_titem(p, ws, it), t1 = p0_titem(p, ws, it + ngw);
        float r0[32], r1[32];
        p0_tload(t0, r0, lane); p0_tload(t1, r1, lane);
        p0_tstore(t0, r0, scr, lane); p0_tstore(t1, r1, scr, lane);
    }
    for (int it0 = (gw + ngw - 256) % ngw; it0 < P0_TOTAL; it0 += ngw) {
        int it = it0;
        if (it < P0_MODS) {
            const int l = it / 384, cg = (it % 384) >> 5, ks = it & 31;
            const int j = cg * 256 + lane * 4;
            const float* wp = p.in[I_WADA] + ((size_t)l * 1024 + ks * 32) * 3072 + j;
            const float* c = p.in[I_C]; const float* cc = p.in[I_CCTX];
            f32x4 acc[5];
#pragma unroll
            for (int n = 0; n < 5; ++n) acc[n] = (f32x4){0.f, 0.f, 0.f, 0.f};
#pragma unroll 1
            for (int k0 = 0; k0 < 32; k0 += 8) {
                f32x4 wv[8];
#pragma unroll
                for (int k = 0; k < 8; ++k) wv[k] = *(const f32x4*)(wp + (size_t)(k0 + k) * 3072);
                __builtin_amdgcn_sched_barrier(0);
#pragma unroll
                for (int k = 0; k < 8; ++k) {
                    const int kk = ks * 32 + k0 + k;
                    acc[0] += wv[k] * silu_f(cc[kk]);
#pragma unroll
                    for (int n = 1; n < 5; ++n) acc[n] += wv[k] * silu_f(c[(n - 1) * 1024 + kk]);
                }
            }
            float* mods = (float*)(ws + WS_MODS);
#pragma unroll
            for (int n = 0; n < 5; ++n) {
                if (ks == 0) acc[n] += *(const f32x4*)(p.in[I_BADA] + l * 3072 + j);
#pragma unroll
                for (int e = 0; e < 4; ++e) atomicAdd(mods + (size_t)(l * 5 + n) * 3072 + j + e, acc[n][e]);
            }
            continue;
        }
        it -= P0_MODS;
        if (it < 3 * P0_CAST_G) {
            const int which = it / P0_CAST_G, r = it % P0_CAST_G;
            const float* src = which == 0 ? p.in[I_CGK] : (which == 1 ? p.in[I_CGV] : p.in[I_CCKV]);
            bf16_t* dst = (bf16_t*)(ws + (which == 0 ? WS_CGK : (which == 1 ? WS_CGV : WS_CCKV)));
#pragma unroll
            for (int q = 0; q < 4; ++q) cast8(src, dst, (size_t)r * 2048 + q * 512 + lane * 8);
            continue;
        }
        it -= 3 * P0_CAST_G;
        if (it < P0_CAST_KPE) {
#pragma unroll
            for (int q = 0; q < 4; ++q) cast8(p.in[I_CKPE], (bf16_t*)(ws + WS_CKPE), (size_t)it * 2048 + q * 512 + lane * 8);
            continue; }
        it -= P0_CAST_KPE;
        {
            const int mat = it >> 2, qd = it & 3, dv = qd * 16 + (lane >> 2), dk0 = (lane & 3) * 16;
            const float* s = p.in[I_STATE] + (size_t)mat * 4096 + dv;
            float x[16];
#pragma unroll
            for (int i = 0; i < 16; ++i) x[i] = s[(dk0 + i) * 64];
            u32x4 o0, o1;
            o0.x = pk2(x[0], x[1]); o0.y = pk2(x[2], x[3]); o0.z = pk2(x[4], x[5]); o0.w = pk2(x[6], x[7]);
            o1.x = pk2(x[8], x[9]); o1.y = pk2(x[10], x[11]); o1.z = pk2(x[12], x[13]); o1.w = pk2(x[14], x[15]);
            bf16_t* d = (bf16_t*)(ws + WS_S0T) + (size_t)mat * 4096 + dv * 64 + dk0;
            *(u32x4*)d = o0; *(u32x4*)(d + 8) = o1;
        }
    }
}
constexpr int P1_GS = 80, P1_BIAS = 4 * 2944, P1_X = 8192, P1_TOTAL = P1_GS + P1_BIAS + P1_X;
__device__ __forceinline__ void xg_row(const Frame& F, const float* xrow, const float* g, const float* mods_c, bf16_t* xg_row_out, float* ssq_row, bool write_xg) {
    const int lane = F.lane;
    float ss = 0.f;
#pragma unroll
    for (int j = 0; j < 4; ++j) {
        const int k = j * 256 + lane * 4;
        const f32x4 x = *(const f32x4*)(xrow + k);
        ss += (x[0] * x[0] + x[1] * x[1]) + (x[2] * x[2] + x[3] * x[3]);
        if (write_xg) {
            const f32x4 gg = *(const f32x4*)(g + k), sc = *(const f32x4*)(mods_c + 1024 + k);
            u32x2 o; o.x = pk2(x[0] * gg[0] * (1.f + sc[0]), x[1] * gg[1] * (1.f + sc[1])); o.y = pk2(x[2] * gg[2] * (1.f + sc[2]), x[3] * gg[3] * (1.f + sc[3]));
            *(u32x2*)(xg_row_out + k) = o;
        }
    }
    ss = wsum(ss);
    if (lane < 16) ssq_row[lane] = lane == 0 ? ss : 0.f;
}
__device__ __forceinline__ void phase1(const Frame& F, const Params& p) {
    unsigned char* ws = F.ws; const int lane = F.lane;
    const int gw = blockIdx.x * NWAVE + F.w, ngw = gridDim.x * NWAVE;
    const float* mods = (const float*)(ws + WS_MODS);
    for (int it0 = gw; it0 < P1_TOTAL; it0 += ngw) {
        int it = it0;
        if (it < P1_GS) {
            const int e = it * 256 + lane * 4, lc = e >> 10, k = e & 1023, l = lc / 5;
            const f32x4 g = *(const f32x4*)(p.in[I_NORMG] + l * 1024 + k), sc = *(const f32x4*)(mods + (size_t)lc * 3072 + 1024 + k);
            *(f32x4*)((float*)(ws + WS_GS) + e) = g * (sc + 1.f);
            continue;
        }
        it -= P1_GS;
        if (it < P1_BIAS) {
            const int l = it / 2944, n = it % 2944;
            const bf16_t* wr = (const bf16_t*)(ws + WS_WIN) + ((size_t)l * 2944 + n) * 1024 + lane * 16;
            const u32x4 w0 = *(const u32x4*)wr, w1 = *(const u32x4*)(wr + 8);
            float wv[16];
#pragma unroll
            for (int i = 0; i < 4; ++i) { wv[2 * i] = bflo(w0[i]); wv[2 * i + 1] = bfhi(w0[i]); wv[8 + 2 * i] = bflo(w1[i]); wv[8 + 2 * i + 1] = bfhi(w1[i]); }
#pragma unroll
            for (int c = 0; c < 5; ++c) {
                const float* sh = mods + (size_t)(l * 5 + c) * 3072 + lane * 16;
                float d = 0.f;
#pragma unroll
                for (int i = 0; i < 4; ++i) { const f32x4 s4 = *(const f32x4*)(sh + 4 * i); d += (s4[0] * wv[4 * i] + s4[1] * wv[4 * i + 1]) + (s4[2] * wv[4 * i + 2] + s4[3] * wv[4 * i + 3]); }
                d = wsum(d);
                if (lane == 0) ((float*)(ws + WS_BIAS))[(size_t)(l * 5 + c) * 2944 + n] = d;
            }
            continue;
        }
        it -= P1_BIAS;
        {
            const int tok = it; const bool lat = tok >= 4096;
            const float* xr = lat ? p.in[I_XS] + (size_t)(tok - 4096) * 1024 : p.in[I_XP] + (size_t)tok * 1024;
            const int cond = lat ? 1 + ((tok - 4096) >> 10) : 0;
            xg_row(F, xr, p.in[I_NORMG], mods + (size_t)cond * 3072, (bf16_t*)(ws + WS_XG) + (size_t)tok * 1024, (float*)(ws + WS_SSQ) + (size_t)tok * 16, true);
        }
    }
}
#ifndef MK_TIMING
#define MK_TIMING -1
#endif
constexpr int CW_TIME = 2048;
__device__ __forceinline__ void phase_final(const Frame& F, const Params& p) {
    const int lane = F.lane;
    float tf = 1.f;
    if (MK_TIMING >= 0) tf = __uint_as_float(__hip_atomic_load((unsigned*)(F.ws + WS_CTL) + CW_TIME, __ATOMIC_RELAXED, __HIP_MEMORY_SCOPE_AGENT));
    const int gw = blockIdx.x * NWAVE + F.w, ngw = gridDim.x * NWAVE;
    for (int tok = gw; tok < 8192; tok += ngw) {
        float ss = 0.f;
        if (lane < 16) ss = ((const float*)(F.ws + WS_SSQ))[(size_t)tok * 16 + lane];
        ss = wsum(ss);
        const float rstd = rsqrtf(ss * (1.f / 1024.f) + EPS);
        const float* xr = p.xs + (size_t)tok * 1024; float* orow = p.out + (size_t)tok * 1024;
#pragma unroll
        for (int j = 0; j < 4; ++j) {
            const int k = j * 256 + lane * 4;
            const f32x4 x = *(const f32x4*)(xr + k), fn = *(const f32x4*)(p.in[I_FNORM] + k);
            *(f32x4*)(orow + k) = x * fn * (rstd * tf);
        }
    }
}

__device__ __forceinline__ GemmOp a2_op(const Frame& F, int l, int j) {
    GemmOp g;
    if (j < 160) { const int tn = j >> 5, tm = j & 31; g.W = (const bf16_t*)(F.ws + WS_WUQ) + ((size_t)l * 640 + tn * 128) * 256; g.X = (const bf16_t*)(F.ws + WS_CQG) + (size_t)tm * 256 * 256; g.ldw = 256; g.ldx = 256; g.K = 256; }
    else if (j < 352) { const int jj = j - 160, tn = jj >> 5, tm = jj & 31; g.W = (const bf16_t*)(F.ws + WS_WUKV) + ((size_t)l * 768 + tn * 128) * 128; g.X = (const bf16_t*)(F.ws + WS_CKVN) + (size_t)tm * 256 * 128; g.ldw = 128; g.ldx = 128; g.K = 128; }
    else { const int jj = j - 352, tn = jj >> 3, tc = jj & 7, b = tc >> 1, jt = tc & 1; g.W = (const bf16_t*)(F.ws + WS_WUKV) + ((size_t)l * 768 + tn * 128) * 128;
           g.X = (const bf16_t*)(F.ws + WS_CCKV) + ((size_t)(b * 4 + l) * 512 + jt * 256) * 128; g.ldw = 128; g.ldx = 128; g.K = 128; }
    return g;
}
#ifndef MK_EN
#define MK_EN 0xff
#endif
#define EN(x) ((MK_EN >> (x)) & 1)
constexpr int PH_TOTAL = 19;
__global__ void __launch_bounds__(512, 2) mega(Params p) {
    extern __shared__ __attribute__((aligned(16))) unsigned char lds_raw[];
    Frame F;
    F.lds = (LAS unsigned char*)lds_raw;
    F.tid = threadIdx.x; F.lane = F.tid & 63; F.w = __builtin_amdgcn_readfirstlane(F.tid >> 6); F.h = F.lane >> 5; F.lq = F.lane & 31;
    F.ws = p.ws;
    volatile LAS unsigned* MISC = (volatile LAS unsigned*)(F.lds + LDS_MISC);
    if (F.tid < 64) MISC[F.tid] = 0u;
    __syncthreads();
    unsigned* ctl = (unsigned*)(p.ws + WS_CTL);
    XcdBarrier bar; bar.bar = ctl + CW_BAR; bar.x = 0; bar.st = nullptr;
    const bool multi = p.ph_hi - p.ph_lo > 1;
    if (multi) bar = xcd_barrier_post(ctl + CW_BAR, MISC + 8);
    const int G = gridDim.x;
    const Frame F0 = F;
    for (int ph = p.ph_lo; ph < p.ph_hi; ++ph) {
        Frame F = F0;
        asm volatile("" : "+v"(F.lane));
        F.tid = threadIdx.x; F.h = F.lane >> 5; F.lq = F.lane & 31;
        asm volatile("" : "+s"(F.w), "+s"(F.ws));
        if (MK_TIMING >= 0 && blockIdx.x == 0 && F.tid == 0) {
            const unsigned long long now = __builtin_amdgcn_s_memrealtime();
            const unsigned long long prev = ((unsigned long long)MISC[17] << 32) | MISC[16];
            if (ph > p.ph_lo) { const int q = ph - 1; const int grp = q < 2 ? q : 2 + ((q - 2) & 3); if (grp == MK_TIMING) MISC[18] += (unsigned)(now - prev); }
            MISC[16] = (unsigned)now; MISC[17] = (unsigned)(now >> 32);
        }
#ifndef MK_REPEAT
#define MK_REPEAT -1
#endif
        int nrep = 1;
        if (MK_REPEAT >= 1) { const int grp = ph < 2 ? ph : (ph == 18 ? 6 : 2 + ((ph - 2) & 3)); if (grp == MK_REPEAT) nrep = (grp == 5) ? (ph == 5 ? 5 : 1) : 2; }
        for (int rep = 0; rep < nrep; ++rep) {
        if (rep > 0) xcd_barrier(bar);
        Frame F = F0;
        asm volatile("" : "+v"(F.lane));
        F.tid = threadIdx.x; F.h = F.lane >> 5; F.lq = F.lane & 31;
        asm volatile("" : "+s"(F.w), "+s"(F.ws));
        if (EN(0) && ph == 0) {
#if defined(MK_DUP0)
            for (int d = 0; d < 2; ++d) { int dd = d; asm volatile("" : "+s"(dd)); if (dd) xcd_barrier(bar); phase0(F, p, dd != 0); }
#else
            phase0(F, p);
#endif
        }
        else if (EN(1) && ph == 1) phase1(F, p);
        else if (EN(2) && ph == 18) phase_final(F, p);
        else {
            const int l = (ph - 2) >> 2, sub = (ph - 2) & 3;
            if (EN(3) && sub == 0) {
                const bf16_t* Wt = (const bf16_t*)(F.ws + WS_WIN) + (size_t)l * 2944 * 1024;
                const bf16_t* X = (const bf16_t*)(F.ws + WS_XG);
                bool first = true;
                for (int j = blockIdx.x; j < 23 * 32; j += G) {
                    const int tn = j >> 5, tm = j & 31;
                    const int jn = j + G; const bool hn = jn < 23 * 32;
                    GemmOp g; g.W = Wt + (size_t)tn * 128 * 1024; g.X = X + (size_t)tm * 256 * 1024; g.ldw = 1024; g.ldx = 1024; g.K = 1024;
                    GemmOp gn = g; if (hn) { gn.W = Wt + (size_t)(jn >> 5) * 128 * 1024; gn.X = X + (size_t)(jn & 31) * 256 * 1024; }
                    f32x16 acc[2][2];
                    Gemm1Pre P1;
                    gemm1_pre(F, p, tn, tm, l, P1);
                    gemm_core(F, g, acc, first, hn, gn); first = false;
                    epi_gemm1(F, p, acc, tn, tm, l, P1);
                }
            } else if (EN(4) && sub == 1) {
                bool first = true;
                for (int j = blockIdx.x; j < 400; j += G) {
                    const int jn = j + G; const bool hn = jn < 400;
                    const GemmOp g = a2_op(F, l, j); const GemmOp gn = a2_op(F, l, hn ? jn : j);
                    f32x16 acc[2][2];
                    float rstd2[2] = {0.f, 0.f};
                    if (j < 160) qm_pre(F, j & 31, rstd2);
                    gemm_core(F, g, acc, first, hn, gn); first = false;
                    if (j < 160) epi_qm(F, acc, j >> 5, j & 31, rstd2);
                    else if (j < 352) { const int jj = j - 160; epi_plain(F, acc, (bf16_t*)(F.ws + WS_KVM), 768, (jj & 31) * 256, (jj >> 5) * 128); }
                    else { const int jj = j - 352, tc = jj & 7; epi_plain(F, acc, (bf16_t*)(F.ws + WS_KVMC), 768, (tc >> 1) * 512 + (tc & 1) * 256, (jj >> 3) * 128); }
                }
            } else if (EN(5) && sub == 2) {
                for (;;) {
                    __syncthreads();
                    if (F.tid == 0) MISC[0] = atomicAdd(ctl + CW_QUEUE + 64 * l + 32 * rep, 1u);
                    __syncthreads();
                    const int u = __builtin_amdgcn_readfirstlane((int)MISC[0]);
                    if (u >= N_ATTN_UNITS) break;
                    attn_dispatch(F, p, u, l);
                }
            } else if (EN(6)) {
                const bf16_t* Wt = (const bf16_t*)(F.ws + WS_WOUT) + (size_t)l * 1024 * 1024;
                const bf16_t* Yb = (const bf16_t*)(F.ws + WS_Y);
                bool first = true;
                for (int j = blockIdx.x; j < 8 * 32; j += G) {
                    const int tn = j >> 5, tm = j & 31;
                    const int jn = j + G; const bool hn = jn < 8 * 32;
                    GemmOp g; g.W = Wt + (size_t)tn * 128 * 1024; g.X = Yb + (size_t)tm * 256 * 1024; g.ldw = 1024; g.ldx = 1024; g.K = 1024;
                    GemmOp gn = g; if (hn) { gn.W = Wt + (size_t)(jn >> 5) * 128 * 1024; gn.X = Yb + (size_t)(jn & 31) * 256 * 1024; }
                    f32x16 acc[2][2];
                    Gemm2Pre P2;
                    gemm2_pre(F, tn, tm, l, P2);
                    gemm_core(F, g, acc, first, hn, gn); first = false;
                    epi_gemm2(F, p, acc, tn, tm, l, P2);
                }
            }
        }
        }
        if (MK_TIMING >= 0 && ph == 17 && blockIdx.x == 0 && F.tid == 0) {
            const unsigned long long now = __builtin_amdgcn_s_memrealtime();
            const unsigned long long prev = ((unsigned long long)MISC[17] << 32) | MISC[16];
            unsigned a = MISC[18]; if (MK_TIMING == 5) a += (unsigned)(now - prev);
            __hip_atomic_store(ctl + CW_TIME, __float_as_uint(1.f + (float)a * 1e-5f), __ATOMIC_RELAXED, __HIP_MEMORY_SCOPE_AGENT);
        }
        if (ph + 1 < p.ph_hi) xcd_barrier(bar);
    }
}
}

extern "C" void kernel_launch(void* const* d_in, const int* in_sizes, int n_in, void* d_out, int out_size, void* d_ws, size_t ws_size, hipStream_t stream) {
    static int grid = 0;
    if (!grid) {
        int dev = 0, cus = 0, per_cu = 0;
        (void)hipGetDevice(&dev);
        (void)hipDeviceGetAttribute(&cus, hipDeviceAttributeMultiprocessorCount, dev);
        (void)hipFuncSetAttribute((const void*)mk::mega, hipFuncAttributeMaxDynamicSharedMemorySize, mk::LDS_BYTES);
        (void)hipOccupancyMaxActiveBlocksPerMultiprocessor(&per_cu, (const void*)mk::mega, 512, mk::LDS_BYTES);
        if (per_cu > 1) per_cu = 1;
        if (per_cu < 1) per_cu = 1;
        if (cus < 1) cus = 256;
        grid = cus * per_cu;
    }
    unsigned char* ws = (unsigned char*)d_ws;
    (void)hipMemsetAsync(ws, 0, mk::CTL_ZERO_BYTES, stream);
    mk::Params P{};
    for (int i = 0; i < 22; ++i) P.in[i] = (const float*)d_in[i];
    P.out = (float*)d_out; P.ws = ws; P.xs = (float*)d_out;
    P.ph_lo = 0; P.ph_hi = mk::PH_TOTAL;
    void* args[] = {&P};
    (void)hipLaunchCooperativeKernel((const void*)mk::mega, dim3(grid), dim3(512), args, mk::LDS_BYTES, stream);
}
```

```cpp
#include <hip/hip_runtime.h>
#include <stdint.h>
namespace mk {
#define LAS __attribute__((address_space(3)))
typedef unsigned short bf16_t;
typedef short bf16x8 __attribute__((ext_vector_type(8)));
typedef short s16x4 __attribute__((ext_vector_type(4)));
typedef float f32x16 __attribute__((ext_vector_type(16)));
typedef float f32x4 __attribute__((ext_vector_type(4)));
typedef float f32x2 __attribute__((ext_vector_type(2)));
typedef unsigned u32x4 __attribute__((ext_vector_type(4)));
typedef unsigned u32x2 __attribute__((ext_vector_type(2)));
typedef __bf16 bf16x2_t __attribute__((ext_vector_type(2)));

constexpr float EPS = 1e-6f;
constexpr float LOG2E = 1.4426950408889634f;
constexpr float QSC_GQA = 0.125f * LOG2E;
constexpr float QSC_MLA = 0.10206207261596575f * LOG2E;

__device__ __forceinline__ unsigned pk2(float lo, float hi) { f32x2 v = {lo, hi}; bf16x2_t b = __builtin_convertvector(v, bf16x2_t); return __builtin_bit_cast(unsigned, b); }
__device__ __forceinline__ float bf2f(unsigned short u) { return __uint_as_float((unsigned)u << 16); }
__device__ __forceinline__ float bflo(unsigned u) { return __uint_as_float(u << 16); }
__device__ __forceinline__ float bfhi(unsigned u) { return __uint_as_float(u & 0xffff0000u); }
__device__ __forceinline__ float silu_f(float x) { return x * __builtin_amdgcn_rcpf(1.f + __builtin_amdgcn_exp2f(-x * LOG2E)); }
__device__ __forceinline__ float wsum(float v) {
#pragma unroll
    for (int o = 32; o > 0; o >>= 1) v += __shfl_xor(v, o);
    return v;
}

constexpr size_t MiB = 1u << 20;
constexpr size_t WS_CTL = 0, CTL_ZERO_BYTES = 1 * MiB;
constexpr size_t WS_MODS = 256 * 1024;
constexpr size_t WS_BIAS = 1 * MiB;
constexpr size_t WS_GS = 1 * MiB + 256 * 1024;
constexpr size_t WS_ROPE64 = 1 * MiB + 512 * 1024;
constexpr size_t WS_ROPE32 = 1 * MiB + 768 * 1024;
constexpr size_t WS_SSQ = 2 * MiB;
constexpr size_t WS_CQSSQ = 2 * MiB + 512 * 1024;
constexpr size_t WS_S0T = 3 * MiB;
constexpr size_t WS_CGK = 4 * MiB, WS_CGV = 6 * MiB, WS_CCKV = 8 * MiB, WS_CKPE = 10 * MiB;
constexpr size_t WS_WIN = 11 * MiB;
constexpr size_t WS_WOUT = 34 * MiB;
constexpr size_t WS_WUQ = 42 * MiB;
constexpr size_t WS_WUKV = 43 * MiB + 256 * 1024;
constexpr size_t WS_XG = 44 * MiB;
constexpr size_t WS_KVM = 130 * MiB;
constexpr size_t WS_KVMC = 142 * MiB;
constexpr size_t WS_RQ = 60 * MiB, WS_RK = 64 * MiB, WS_RV = 68 * MiB;
constexpr size_t WS_GQ = 72 * MiB;
constexpr size_t WS_GK = 78 * MiB, WS_GV = 80 * MiB;
constexpr size_t WS_CQG = 82 * MiB;
constexpr size_t WS_CKVN = 86 * MiB;
constexpr size_t WS_KPEB = 88 * MiB;
constexpr size_t WS_ZS = 89 * MiB;
constexpr size_t WS_QM = 105 * MiB;
constexpr size_t WS_Y = 114 * MiB;
constexpr size_t WS_XSDBG = 130 * MiB;
constexpr size_t WS_XB = 146 * MiB;
constexpr size_t WS_OPT_END = 162 * MiB;
constexpr int CW_QUEUE = 1024;
constexpr int CW_FLAG = 2048;
constexpr int CW_BAR = 4096;

constexpr size_t O_STATE = 8388608, O_GK = 10485760, O_GV = 12582912, O_CKV = 14680064, O_KPE = 16777216;

constexpr int NWAVE = 8;
constexpr int GST = 49152;
constexpr int GST2 = 65536;
constexpr int LDS_OST = GST2;
constexpr int LDS_EX = 135168;
constexpr int LDS_EXB = 137216;
constexpr int LDS_SCAL = 141312;
constexpr int LDS_MISC = 142336;
constexpr int LDS_BYTES = 142592;

struct Params { const float* in[22]; float* out; unsigned char* ws; float* xs; int ph_lo, ph_hi; };
enum { I_XP = 0, I_XS, I_STATE, I_CGK, I_CGV, I_CCKV, I_CKPE, I_C, I_CCTX, I_NORMG, I_WADA, I_BADA, I_WIN, I_DECAY, I_GQN, I_GKN, I_MQN, I_MKVN, I_WUQ, I_WUKV, I_WOUT, I_FNORM };

#define XB_TMO      128
#define XB_XCNT(j)  (256  + 64 * (j))
#define XB_XSUB(j)  (1280 + 64 * (j))
#define XB_XGEN(j)  (2304 + 64 * (j))
#define XB_TOP      3328
#define XB_TOPGEN   3392
#define XB_SPIN_CAP (1u << 20)
__device__ __forceinline__ unsigned xb_ld(unsigned* p) { return __hip_atomic_load(p, __ATOMIC_RELAXED, __HIP_MEMORY_SCOPE_AGENT); }
__device__ __forceinline__ unsigned xb_add(unsigned* p, unsigned v) { return __hip_atomic_fetch_add(p, v, __ATOMIC_RELAXED, __HIP_MEMORY_SCOPE_AGENT); }
__device__ __forceinline__ unsigned xb_xcc_id() { return (unsigned)__builtin_amdgcn_s_getreg((3 << 11) | 20) & 0xFu; }
#define XB_SPIN(cond, bar) do { unsigned _sp = 0; while (cond) { __builtin_amdgcn_s_sleep(1); \
    if ((++_sp & 255u) == 0u) { if (xb_ld(&(bar)[XB_TMO])) break; if (_sp > XB_SPIN_CAP) { atomicAdd(&(bar)[XB_TMO], 1u); break; } } } } while (0)
struct XcdBarrier { unsigned* bar; unsigned x; volatile LAS unsigned* st; int w; };
__device__ __forceinline__ XcdBarrier xcd_barrier_post(unsigned* bar, volatile LAS unsigned* st) {
    XcdBarrier b; b.bar = bar; b.x = xb_xcc_id(); b.st = st; b.w = 0;
    if (threadIdx.x == 0) (void)xb_add(&bar[XB_XCNT(b.x)], 1u);
    return b;
}
__device__ __forceinline__ void xcd_barrier_complete(unsigned* bar, unsigned x, unsigned& nloc, unsigned& nx) {
    const unsigned G = gridDim.x * gridDim.y * gridDim.z;
    unsigned sum, cnt, mine, sp = 0u;
    for (;;) {
        sum = 0u; cnt = 0u; mine = 0u;
#pragma unroll
        for (unsigned j = 0; j < 16; ++j) { const unsigned c = xb_ld(&bar[XB_XCNT(j)]); sum += c; cnt += (c > 0u) ? 1u : 0u; mine = (j == x) ? c : mine; }
        if (sum == G) break;
        __builtin_amdgcn_s_sleep(1);
        if ((++sp & 255u) == 0u) { if (xb_ld(&bar[XB_TMO])) break; if (sp > XB_SPIN_CAP) { atomicAdd(&bar[XB_TMO], 1u); break; } }
    }
    nloc = mine > 0u ? mine : 1u; nx = cnt > 0u ? cnt : 1u;
}
__device__ __forceinline__ void xcd_barrier(const XcdBarrier& b) {
    asm volatile("s_waitcnt vmcnt(0)" ::: "memory");
    __syncthreads();
    if (b.w == 0 && __builtin_amdgcn_mbcnt_hi(~0u, __builtin_amdgcn_mbcnt_lo(~0u, 0u)) == 0u) {
        unsigned* bar = b.bar;
        __builtin_amdgcn_s_waitcnt(0);
        unsigned nloc = b.st[0], nx = b.st[1];
        if (nloc == 0u) { xcd_barrier_complete(bar, b.x, nloc, nx); b.st[0] = nloc; b.st[1] = nx; }
        const unsigned old = xb_add(&bar[XB_XSUB(b.x)], 1u);
        const unsigned gen = old / nloc;
        if (old + 1u == (gen + 1u) * nloc) {
            __builtin_amdgcn_fence(__ATOMIC_RELEASE, "agent");
            asm volatile("s_waitcnt vmcnt(0)" ::: "memory");
            const unsigned og = xb_add(&bar[XB_TOP], 1u);
            const unsigned tg = og / nx;
            if (og + 1u == (tg + 1u) * nx) xb_add(&bar[XB_TOPGEN], 1u);
            else XB_SPIN(xb_ld(&bar[XB_TOPGEN]) == tg, bar);
            __builtin_amdgcn_fence(__ATOMIC_ACQUIRE, "agent");
            xb_add(&bar[XB_XGEN(b.x)], 1u);
            asm volatile("s_waitcnt vmcnt(0)" ::: "memory");
        } else {
            XB_SPIN(xb_ld(&bar[XB_XGEN(b.x)]) == gen, bar);
            __builtin_amdgcn_fence(__ATOMIC_ACQUIRE, "agent");
            asm volatile("s_waitcnt vmcnt(0)" ::: "memory");
        }
    }
    __syncthreads();
}

typedef const float* cfp_t;
typedef const __attribute__((address_space(4))) cfp_t* karg_t;
struct Frame {
    LAS unsigned char* lds;
    int tid, lane, w, h, lq;
    unsigned char* ws;
    karg_t karg;
};
__device__ __forceinline__ const float* pin(const Frame& F, int i) { return F.karg[i]; }
#define GLDS16(gsrc, ldsdst) __builtin_amdgcn_global_load_lds((const unsigned*)(gsrc), (LAS unsigned*)(ldsdst), 16, 0, 0)
#define ST16_WT(ptr, val) asm volatile("global_store_dwordx4 %0, %1, off sc1\n\ts_nop 1" :: "v"(ptr), "v"(val) : "memory")
#define MFMA32(a, b, c) __builtin_amdgcn_mfma_f32_32x32x16_bf16((a), (b), (c), 0, 0, 0)

struct GemmOp { const bf16_t* W; const bf16_t* X; int ldw, ldx, K; };
__device__ __forceinline__ void gemm_issue0(const Frame& F, const GemmOp& g) {
    const int lane = F.lane, w = F.w;
#pragma unroll
    for (int q = 0; q < 2; ++q) { const int row = 16 * w + 8 * q + (lane >> 3); GLDS16(g.W + row * g.ldw + ((lane & 7) ^ ((row >> 1) & 7)) * 8, F.lds + (16 * w + 8 * q) * 128); }
#pragma unroll
    for (int q = 0; q < 4; ++q) { const int row = 32 * w + 8 * q + (lane >> 3); GLDS16(g.X + row * g.ldx + ((lane & 7) ^ ((row >> 1) & 7)) * 8, F.lds + 16384 + (32 * w + 8 * q) * 128); }
}
typedef f32x4 GemmAcc[4][4];
__device__ __forceinline__ void gemm_core(const Frame& F, const GemmOp& g, GemmAcc& acc, bool issue_first, bool has_next, const GemmOp& gn) {
    const int lane = F.lane, w = F.w;
    const bf16_t* __restrict__ W = g.W; const bf16_t* __restrict__ X = g.X;
    const int nkt = g.K >> 6;
    int offW[2], offX[4];
#pragma unroll
    for (int q = 0; q < 2; ++q) { const int row = 16 * w + 8 * q + (lane >> 3); offW[q] = row * g.ldw + ((lane & 7) ^ ((row >> 1) & 7)) * 8; }
#pragma unroll
    for (int q = 0; q < 4; ++q) { const int row = 32 * w + 8 * q + (lane >> 3); offX[q] = row * g.ldx + ((lane & 7) ^ ((row >> 1) & 7)) * 8; }
    LAS unsigned char* const dW = F.lds + (16 * w) * 128;
    LAS unsigned char* const dX = F.lds + 16384 + (32 * w) * 128;
#define GC_ISSUE(kt, st) do { _Pragma("unroll") for (int q = 0; q < 2; ++q) GLDS16(W + offW[q] + (kt) * 64, dW + (st) * GST + q * 1024); \
        _Pragma("unroll") for (int q = 0; q < 4; ++q) GLDS16(X + offX[q] + (kt) * 64, dX + (st) * GST + q * 1024); } while (0)
    const int wn = w & 1, wm = w >> 1, c15 = lane & 15, g4 = lane >> 4;
    const int sw = (c15 >> 1) & 7;
    int so[2];
#pragma unroll
    for (int s = 0; s < 2; ++s) so[s] = ((4 * s + g4) ^ sw) << 4;
    const int bn0 = (64 * wn + c15) * 128, bm0 = 16384 + (64 * wm + c15) * 128;
#pragma unroll
    for (int a = 0; a < 4; ++a)
#pragma unroll
        for (int b = 0; b < 4; ++b) acc[a][b] = (f32x4){0.f, 0.f, 0.f, 0.f};
    if (issue_first) GC_ISSUE(0, 0);
    asm volatile("s_waitcnt vmcnt(0)" ::: "memory");
    __syncthreads();
    for (int kt = 0; kt < nkt; ++kt) {
        const int st = kt & 1;
        if (kt + 1 < nkt) GC_ISSUE(kt + 1, st ^ 1);
        LAS unsigned char* const base = F.lds + st * GST;
#pragma unroll
        for (int s = 0; s < 2; ++s) {
            bf16x8 fa[4], fb[4];
#pragma unroll
            for (int q = 0; q < 4; ++q) { fa[q] = *(const LAS bf16x8*)(base + bn0 + q * 2048 + so[s]); fb[q] = *(const LAS bf16x8*)(base + bm0 + q * 2048 + so[s]); }
#pragma unroll
            for (int a = 0; a < 4; ++a)
#pragma unroll
                for (int b = 0; b < 4; ++b) acc[a][b] = __builtin_amdgcn_mfma_f32_16x16x32_bf16(fa[a], fb[b], acc[a][b], 0, 0, 0);
        }
        asm volatile("s_waitcnt vmcnt(0)" ::: "memory");
        __syncthreads();
    }
#undef GC_ISSUE
    if (has_next) gemm_issue0(F, gn);
}

typedef f32x4 GemmAcc8[4][8];
__device__ __forceinline__ void gemm256_issue0(const Frame& F, const bf16_t* W, const bf16_t* X) {
    int lane = F.lane; const int w = F.w;
    asm volatile("" : "+v"(lane));
#pragma unroll
    for (int q = 0; q < 4; ++q) {
        const int row = 32 * w + 8 * q + (lane >> 3), off = row * 1024 + ((lane & 7) ^ ((row >> 1) & 7)) * 8;
        GLDS16(W + off, F.lds + (32 * w + 8 * q) * 128);
        GLDS16(X + off, F.lds + 32768 + (32 * w + 8 * q) * 128);
    }
}
__device__ __forceinline__ void gemm_core256(const Frame& F, const bf16_t* __restrict__ W, const bf16_t* __restrict__ X, GemmAcc8& acc, bool issue_first, bool has_next, const bf16_t* Wn, const bf16_t* Xn) {
    int lane = F.lane; const int w = F.w;
    asm volatile("" : "+v"(lane));
    int off[4];
#pragma unroll
    for (int q = 0; q < 4; ++q) { const int row = 32 * w + 8 * q + (lane >> 3); off[q] = row * 1024 + ((lane & 7) ^ ((row >> 1) & 7)) * 8; }
    LAS unsigned char* const dW = F.lds + (32 * w) * 128;
    LAS unsigned char* const dX = F.lds + 32768 + (32 * w) * 128;
#define GC2_ISSUE(kt, st) do { _Pragma("unroll") for (int q = 0; q < 4; ++q) { GLDS16(W + off[q] + (kt) * 64, dW + (st) * GST2 + q * 1024); GLDS16(X + off[q] + (kt) * 64, dX + (st) * GST2 + q * 1024); } } while (0)
    const int wn4 = w & 3, wm2 = w >> 2, c15 = lane & 15, g4 = lane >> 4;
    const int sw = (c15 >> 1) & 7;
    int so[2];
#pragma unroll
    for (int s = 0; s < 2; ++s) so[s] = ((4 * s + g4) ^ sw) << 4;
    const int bn0 = (64 * wn4 + c15) * 128, bm0 = 32768 + (128 * wm2 + c15) * 128;
#pragma unroll
    for (int a = 0; a < 4; ++a)
#pragma unroll
        for (int b = 0; b < 8; ++b) acc[a][b] = (f32x4){0.f, 0.f, 0.f, 0.f};
    if (issue_first) GC2_ISSUE(0, 0);
    asm volatile("s_waitcnt vmcnt(0)" ::: "memory");
    __syncthreads();
    for (int kt = 0; kt < 16; ++kt) {
        const int st = kt & 1;
        if (kt + 1 < 16) GC2_ISSUE(kt + 1, st ^ 1);
        LAS unsigned char* const base = F.lds + st * GST2;
#pragma unroll
        for (int s = 0; s < 2; ++s) {
            bf16x8 fa[4];
#pragma unroll
            for (int q = 0; q < 4; ++q) fa[q] = *(const LAS bf16x8*)(base + bn0 + q * 2048 + so[s]);
#pragma unroll
            for (int hb = 0; hb < 2; ++hb) {
                bf16x8 fb[4];
#pragma unroll
                for (int q = 0; q < 4; ++q) fb[q] = *(const LAS bf16x8*)(base + bm0 + (4 * hb + q) * 2048 + so[s]);
#pragma unroll
                for (int a = 0; a < 4; ++a)
#pragma unroll
                    for (int b = 0; b < 4; ++b) acc[a][4 * hb + b] = __builtin_amdgcn_mfma_f32_16x16x32_bf16(fa[a], fb[b], acc[a][4 * hb + b], 0, 0, 0);
            }
        }
        asm volatile("s_waitcnt vmcnt(0)" ::: "memory");
        __syncthreads();
    }
#undef GC2_ISSUE
    if (has_next) gemm256_issue0(F, Wn, Xn);
}

__device__ __forceinline__ void rope64_16(float (&v)[4][4], float rowp, float colp, int g4) {
#pragma unroll
    for (int i = 0; i < 4; ++i) {
        const float fr = __builtin_amdgcn_exp2f((float)(4 * g4 + i) * -0.8304820237218406f) * 0.15915494309189535f;
#pragma unroll
        for (int c = 0; c < 2; ++c) {
            const float rev = (c ? colp : rowp) * fr;
            const float sn = __builtin_amdgcn_sinf(rev), cs = __builtin_amdgcn_cosf(rev);
            const float x0 = v[2 * c][i], x1 = v[2 * c + 1][i];
            v[2 * c][i] = x0 * cs - x1 * sn;
            v[2 * c + 1][i] = x1 * cs + x0 * sn;
        }
    }
}
__device__ __forceinline__ void rope32_16(float (&a)[4], float (&b)[4], float rowp, float colp, int g4) {
    const bool hi = g4 >= 2;
#pragma unroll
    for (int i = 0; i < 4; ++i) {
        const float fr = __builtin_amdgcn_exp2f((float)(4 * (g4 & 1) + i) * -1.6609640474436813f) * 0.15915494309189535f;
        {
            const float rev = rowp * fr;
            const float sn = __builtin_amdgcn_sinf(rev), cs = __builtin_amdgcn_cosf(rev);
            const float own = a[i], oth = __shfl_xor(own, 32);
            a[i] = own * cs + oth * (hi ? sn : -sn);
        }
        {
            const float rev = colp * fr;
            const float sn = __builtin_amdgcn_sinf(rev), cs = __builtin_amdgcn_cosf(rev);
            const float own = b[i], oth = __shfl_xor(own, 32);
            b[i] = own * cs + oth * (hi ? sn : -sn);
        }
    }
}
__device__ __forceinline__ float ssq64(const float (&v)[4][4]) {
    float s = 0.f;
#pragma unroll
    for (int nt = 0; nt < 4; ++nt)
#pragma unroll
        for (int i = 0; i < 4; ++i) s += v[nt][i] * v[nt][i];
    s += __shfl_xor(s, 16);
    s += __shfl_xor(s, 32);
    return s;
}
__device__ __forceinline__ void mulvec64(float (&v)[4][4], const LAS float* gv, int g4) {
#pragma unroll
    for (int nt = 0; nt < 4; ++nt) {
        const f32x4 q = *(const LAS f32x4*)(gv + 16 * nt + 4 * g4);
#pragma unroll
        for (int i = 0; i < 4; ++i) v[nt][i] *= q[i];
    }
}
constexpr int OST_LD = 68, OST_BYTES = 32 * OST_LD * 4;
__device__ __forceinline__ void stage_write16(LAS float* st, const float (&v)[4][4], int mh, int c15, int g4) {
    asm volatile("s_waitcnt lgkmcnt(0)" ::: "memory");
    __builtin_amdgcn_wave_barrier();
#pragma unroll
    for (int nt = 0; nt < 4; ++nt) {
        f32x4 o = {v[nt][0], v[nt][1], v[nt][2], v[nt][3]};
        *(LAS f32x4*)(st + (16 * mh + c15) * OST_LD + 16 * nt + 4 * g4) = o;
    }
    asm volatile("s_waitcnt lgkmcnt(0)" ::: "memory");
    __builtin_amdgcn_wave_barrier();
}
__device__ __forceinline__ void stage_write16a(LAS float* st, const f32x4 (&a)[4][4], int mt, int c15, int g4) {
    asm volatile("s_waitcnt lgkmcnt(0)" ::: "memory");
    __builtin_amdgcn_wave_barrier();
#pragma unroll
    for (int nt = 0; nt < 4; ++nt) *(LAS f32x4*)(st + (16 * (mt & 1) + c15) * OST_LD + 16 * nt + 4 * g4) = a[nt][mt];
    asm volatile("s_waitcnt lgkmcnt(0)" ::: "memory");
    __builtin_amdgcn_wave_barrier();
}
__device__ __forceinline__ void stage_store_bf16(const LAS float* st, bf16_t* dst, int ld, float sc, int lane) {
#pragma unroll 1
    for (int it = 0; it < 4; ++it) {
        const int row = it * 8 + (lane >> 3), c8 = (lane & 7) * 8;
        const f32x4 x0 = *(const LAS f32x4*)(st + row * OST_LD + c8), x1 = *(const LAS f32x4*)(st + row * OST_LD + c8 + 4);
        u32x4 o; o.x = pk2(x0[0] * sc, x0[1] * sc); o.y = pk2(x0[2] * sc, x0[3] * sc); o.z = pk2(x1[0] * sc, x1[1] * sc); o.w = pk2(x1[2] * sc, x1[3] * sc);
        ST16_WT(dst + (size_t)row * ld + c8, o);
    }
}
__device__ __forceinline__ void stage_store_bf16_sc1(const LAS float* st, bf16_t* dst, int ld, int lane) {
#pragma unroll 1
    for (int it = 0; it < 4; ++it) {
        const int row = it * 8 + (lane >> 3), c8 = (lane & 7) * 8;
        const f32x4 x0 = *(const LAS f32x4*)(st + row * OST_LD + c8), x1 = *(const LAS f32x4*)(st + row * OST_LD + c8 + 4);
        u32x4 o; o.x = pk2(x0[0], x0[1]); o.y = pk2(x0[2], x0[3]); o.z = pk2(x1[0], x1[1]); o.w = pk2(x1[2], x1[3]);
        bf16_t* ptr = dst + (size_t)row * ld + c8;
        asm volatile("global_store_dwordx4 %0, %1, off sc1\n\ts_nop 1" :: "v"(ptr), "v"(o) : "memory");
    }
}
__device__ __forceinline__ void stage_store_f32(const LAS float* st, float* dst, int ld, int lane) {
#pragma unroll 1
    for (int it = 0; it < 8; ++it) {
        const int row = it * 4 + (lane >> 4), c = (lane & 15) * 4;
        { const f32x4 o = *(const LAS f32x4*)(st + row * OST_LD + c); ST16_WT(dst + (size_t)row * ld + c, o); }
    }
}
__device__ __forceinline__ void stage_store_bf16_32(const LAS float* st, bf16_t* dst, int ld, int lane) {
#pragma unroll 1
    for (int it = 0; it < 2; ++it) {
        const int row = it * 16 + (lane >> 2), c8 = (lane & 3) * 8;
        const f32x4 x0 = *(const LAS f32x4*)(st + row * OST_LD + c8), x1 = *(const LAS f32x4*)(st + row * OST_LD + c8 + 4);
        u32x4 o; o.x = pk2(x0[0], x0[1]); o.y = pk2(x0[2], x0[3]); o.z = pk2(x1[0], x1[1]); o.w = pk2(x1[2], x1[3]);
        ST16_WT(dst + (size_t)row * ld + c8, o);
    }
}
__device__ __forceinline__ void stage_store_f32_32(const LAS float* st, float* dst, int ld, int lane) {
#pragma unroll 1
    for (int it = 0; it < 4; ++it) {
        const int row = it * 8 + (lane >> 3), c = (lane & 7) * 4;
        { const f32x4 o = *(const LAS f32x4*)(st + row * OST_LD + c); ST16_WT(dst + (size_t)row * ld + c, o); }
    }
}

struct Gemm1Pre { float rstd[2]; float bias, gain; };
__device__ __forceinline__ void gemm1_pre(const Frame& F, const Params& p, int tn, int wn, int tm, int l, Gemm1Pre& P) {
    const float* ssqp = (const float*)(F.ws + WS_SSQ);
#pragma unroll
    for (int jj = 0; jj < 2; ++jj) {
        const int tok = tm * 256 + (F.w >> 2) * 128 + 64 * jj + F.lane;
        const f32x4* sp = (const f32x4*)(ssqp + (size_t)tok * 16);
        float ss = 0.f;
#pragma unroll
        for (int i = 0; i < 4; ++i) { const f32x4 q = sp[i]; ss += (q[0] + q[1]) + (q[2] + q[3]); }
        P.rstd[jj] = rsqrtf(ss * (1.f / 1024.f) + EPS);
    }
    const bool lat = tm >= 16;
    const int cond = lat ? 1 + ((tm - 16) >> 2) : 0;
    const int nb = tn * 128 + wn * 64;
    P.bias = (tn < 23) ? ((const float*)(F.ws + WS_BIAS))[(size_t)(l * 5 + cond) * 2944 + nb + F.lane] : 0.f;
    const float* gp = nullptr;
    if (tn >= 6 && tn < 9) gp = pin(F, I_GQN) + l * 64;
    else if (tn == 9) gp = pin(F, I_GKN) + l * 64;
    else if (tn == 11 || tn == 12) gp = pin(F, I_MQN) + l * 256 + (nb - 1408);
    else if (tn == 13) gp = pin(F, I_MKVN) + l * 128 + wn * 64;
    P.gain = gp ? gp[F.lane] : 1.f;
}
__device__ __forceinline__ void epi_gemm1(const Frame& F, const Params& p, GemmAcc8& acc, int tn, int wn, int tm, int l, const Gemm1Pre& P, bool ckv_tile) {
    int lane = F.lane; const int wm = F.w >> 2;
    asm volatile("" : "+v"(lane));
    const int c15 = lane & 15, g4 = lane >> 4;
    unsigned char* ws = F.ws;
    LAS float* st = (LAS float*)(F.lds + LDS_OST + F.w * OST_BYTES);
    const bool lat = tm >= 16;
    const int b = lat ? ((tm - 16) >> 2) : tm;
    const int nb = tn * 128 + wn * 64;
    LAS float* exb = (LAS float*)(F.lds + LDS_EXB) + F.w * 128;
    exb[lane] = P.bias; exb[64 + lane] = P.gain;
    asm volatile("s_waitcnt lgkmcnt(0)" ::: "memory");
    __builtin_amdgcn_wave_barrier();
    const LAS float* bias = exb;
    float* outp = p.out;
    float ckv_ss[8];
    if (tn < 23) {
#pragma unroll
    for (int mt = 0; mt < 8; ++mt) {
        const int mh = mt & 1;
        const int tok0 = tm * 256 + wm * 128 + (mt >> 1) * 32;
        const int tokb = tok0 + 16 * mh, tok = tokb + c15;
        const int t0 = lat ? ((tok0 - 4096) & 1023) : (tok0 & 255), t = t0 + 16 * mh + c15;
        const float rstd = __shfl(P.rstd[mt >> 2], 16 * (mt & 3) + c15);
        float v[4][4];
#pragma unroll
        for (int nt = 0; nt < 4; ++nt) {
            const f32x4 bq = *(const LAS f32x4*)(bias + 16 * nt + 4 * g4);
#pragma unroll
            for (int i = 0; i < 4; ++i) v[nt][i] = acc[nt][mt][i] * rstd + bq[i];
        }
        const float rowp = (float)(t >> 6), colp = (float)(t & 63);
        const size_t orow0 = (size_t)(b * 4 + l) * 256 + t0;
        if (tn < 2) {
            if (lat) rope64_16(v, rowp, colp, g4);
            stage_write16(st, v, mh, c15, g4);
            if (mh) stage_store_bf16(st, (bf16_t*)(ws + WS_RQ) + (size_t)tok0 * 256 + nb, 256, 1.f, lane);
        } else if (tn < 4) {
            if (lat) rope64_16(v, rowp, colp, g4);
            stage_write16(st, v, mh, c15, g4);
            if (mh) stage_store_bf16(st, (bf16_t*)(ws + WS_RK) + (size_t)tok0 * 256 + (nb - 256), 256, 0.125f, lane);
        } else if (tn < 6) {
            stage_write16(st, v, mh, c15, g4);
            if (mh) stage_store_bf16(st, (bf16_t*)(ws + WS_RV) + (size_t)tok0 * 256 + (nb - 512), 256, 1.f, lane);
        } else if (tn < 9) {
            const float r = rsqrtf(ssq64(v) * (1.f / 64.f) + EPS);
#pragma unroll
            for (int nt = 0; nt < 4; ++nt)
#pragma unroll
                for (int i = 0; i < 4; ++i) v[nt][i] *= r;
            mulvec64(v, exb + 64, g4);
            if (lat) rope64_16(v, rowp, colp, g4);
            stage_write16(st, v, mh, c15, g4);
            if (mh) stage_store_bf16(st, (bf16_t*)(ws + WS_GQ) + (size_t)tok0 * 384 + (nb - 768), 384, QSC_GQA, lane);
        } else if (tn == 9) {
            const float r = rsqrtf(ssq64(v) * (1.f / 64.f) + EPS);
#pragma unroll
            for (int nt = 0; nt < 4; ++nt)
#pragma unroll
                for (int i = 0; i < 4; ++i) v[nt][i] *= r;
            mulvec64(v, exb + 64, g4);
            if (lat) rope64_16(v, rowp, colp, g4);
            stage_write16(st, v, mh, c15, g4);
            if (mh) {
                if (!lat) stage_store_f32(st, outp + O_GK + orow0 * 128 + (nb - 1152), 128, lane);
                stage_store_bf16(st, (bf16_t*)(ws + WS_GK) + (size_t)tok0 * 128 + (nb - 1152), 128, 1.f, lane);
            }
        } else if (tn == 10) {
            stage_write16(st, v, mh, c15, g4);
            if (mh) {
                if (!lat) stage_store_f32(st, outp + O_GV + orow0 * 128 + (nb - 1280), 128, lane);
                stage_store_bf16(st, (bf16_t*)(ws + WS_GV) + (size_t)tok0 * 128 + (nb - 1280), 128, 1.f, lane);
            }
        } else if (tn < 13) {
            const float s2 = ssq64(v);
            if (g4 == 0) __hip_atomic_store((__attribute__((address_space(1))) float*)((float*)(ws + WS_CQSSQ) + (size_t)tok * 4 + ((nb - 1408) >> 6)), s2, __ATOMIC_RELAXED, __HIP_MEMORY_SCOPE_AGENT);
            mulvec64(v, exb + 64, g4);
            stage_write16(st, v, mh, c15, g4);
            if (mh) stage_store_bf16_sc1(st, (bf16_t*)(ws + WS_CQG) + (size_t)tok0 * 256 + (nb - 1408), 256, lane);
        } else if (tn == 13) {
            ckv_ss[mt] = ssq64(v);
            if (g4 == 0) ((LAS float*)(F.lds + LDS_EX))[(wm * 2 + wn) * 128 + mt * 16 + c15] = ckv_ss[mt];
        } else if (tn < 22) {
#pragma unroll
            for (int nt = 0; nt < 4; ++nt)
#pragma unroll
                for (int i = 0; i < 4; ++i) v[nt][i] = silu_f(v[nt][i]);
            stage_write16(st, v, mh, c15, g4);
            if (mh) stage_store_bf16(st, (bf16_t*)(ws + WS_ZS) + (size_t)tok0 * 1024 + (nb - 1792), 1024, 1.f, lane);
        } else {
            if (wn == 0) {
                if (lat) rope32_16(v[0], v[1], rowp, colp, g4);
                stage_write16(st, v, mh, c15, g4);
                if (mh) {
                    if (!lat) stage_store_f32_32(st, outp + O_KPE + orow0 * 32, 32, lane);
                    stage_store_bf16_32(st, (bf16_t*)(ws + WS_KPEB) + (size_t)tok0 * 32, 32, lane);
                }
            }
        }
    }
    }
    if (ckv_tile) {
        __syncthreads();
        if (tn == 13) {
#pragma unroll
        for (int mt = 0; mt < 8; ++mt) {
            const int mh = mt & 1;
            const int tok0 = tm * 256 + wm * 128 + (mt >> 1) * 32;
            const int t0 = lat ? ((tok0 - 4096) & 1023) : (tok0 & 255);
            const float rstd = __shfl(P.rstd[mt >> 2], 16 * (mt & 3) + c15);
            float v[4][4];
#pragma unroll
            for (int nt = 0; nt < 4; ++nt) {
                const f32x4 bq = *(const LAS f32x4*)(bias + 16 * nt + 4 * g4);
#pragma unroll
                for (int i = 0; i < 4; ++i) v[nt][i] = acc[nt][mt][i] * rstd + bq[i];
            }
            const float tot = ckv_ss[mt] + ((const LAS float*)(F.lds + LDS_EX))[(wm * 2 + (wn ^ 1)) * 128 + mt * 16 + c15];
            const float r = rsqrtf(tot * (1.f / 128.f) + EPS);
#pragma unroll
            for (int nt = 0; nt < 4; ++nt)
#pragma unroll
                for (int i = 0; i < 4; ++i) v[nt][i] *= r;
            mulvec64(v, exb + 64, g4);
            const size_t orow0 = (size_t)(b * 4 + l) * 256 + t0;
            stage_write16(st, v, mh, c15, g4);
            if (mh) {
                if (!lat) stage_store_f32(st, outp + O_CKV + orow0 * 128 + wn * 64, 128, lane);
                stage_store_bf16_sc1(st, (bf16_t*)(ws + WS_CKVN) + (size_t)tok0 * 128 + wn * 64, 128, lane);
            }
        }
        }
        __syncthreads();
    }
}

__device__ __forceinline__ void qm_pre(const Frame& F, int tm, float& rstd) {
    const int tok = tm * 256 + (F.w >> 1) * 64 + F.lane;
    const f32x4 q4 = *(const f32x4*)((const float*)(F.ws + WS_CQSSQ) + (size_t)tok * 4);
    rstd = rsqrtf(((q4[0] + q4[1]) + (q4[2] + q4[3])) * (1.f / 256.f) + EPS);
}
__device__ __forceinline__ void epi_qm(const Frame& F, GemmAcc& acc, int tn, int tm, float rstdl) {
    int lane = F.lane; const int wn = F.w & 1, wm = F.w >> 1;
    asm volatile("" : "+v"(lane));
    const int c15 = lane & 15, g4 = lane >> 4;
    unsigned char* ws = F.ws;
    LAS float* st = (LAS float*)(F.lds + LDS_OST + F.w * OST_BYTES);
    const bool lat = tm >= 16;
    const int nb = tn * 128 + wn * 64;
    if (nb >= 576) return;
#pragma unroll
    for (int mt = 0; mt < 4; ++mt) {
        const int mh = mt & 1;
        const int tok0 = tm * 256 + wm * 64 + (mt >> 1) * 32, tok = tok0 + 16 * mh + c15;
        const int t = lat ? ((tok - 4096) & 1023) : (tok & 255);
        const float rstd = __shfl(rstdl, 16 * mt + c15);
        const float rowp = (float)(t >> 6), colp = (float)(t & 63);
        float v[4][4];
#pragma unroll
        for (int nt = 0; nt < 4; ++nt)
#pragma unroll
            for (int i = 0; i < 4; ++i) v[nt][i] = acc[nt][mt][i] * rstd;
#pragma unroll
        for (int q = 0; q < 2; ++q) {
            const int T = (nb + 32 * q) >> 5;
            if (lat && (T % 3) == 2) rope32_16(v[2 * q], v[2 * q + 1], rowp, colp, g4);
        }
        stage_write16(st, v, mh, c15, g4);
        if (mh) stage_store_bf16(st, (bf16_t*)(ws + WS_QM) + (size_t)tok0 * 576 + nb, 576, QSC_MLA, lane);
    }
}
__device__ __forceinline__ void epi_plain(const Frame& F, GemmAcc& acc, bf16_t* D, int ldd, int row0, int n0) {
    int lane = F.lane; const int wn = F.w & 1, wm = F.w >> 1;
    asm volatile("" : "+v"(lane));
    const int c15 = lane & 15, g4 = lane >> 4;
    LAS float* st = (LAS float*)(F.lds + LDS_OST + F.w * OST_BYTES);
#pragma unroll
    for (int mt = 0; mt < 4; ++mt) {
        const int r0 = row0 + wm * 64 + (mt >> 1) * 32;
        stage_write16a(st, acc, mt, c15, g4);
        if (mt & 1) stage_store_bf16(st, D + (size_t)r0 * ldd + n0 + wn * 64, ldd, 1.f, lane);
    }
}

struct Gemm2Pre { f32x4 gt0, gt1, gs0, gs1; };
__device__ __forceinline__ void gemm2_pre(const Frame& F, int tn, int tm, int l, Gemm2Pre& P) {
    const bool lat = tm >= 16; const int cond = lat ? 1 + ((tm - 16) >> 2) : 0;
    const int nb = tn * 128 + (F.w & 1) * 64, c8 = (F.lane & 7) * 8;
    const float* gtp = (const float*)(F.ws + WS_MODS) + (size_t)(l * 5 + cond) * 3072 + 2048 + nb + c8;
    const float* gsp = (const float*)(F.ws + WS_GS) + (size_t)((l < 3 ? l + 1 : 3) * 5 + cond) * 1024 + nb + c8;
    P.gt0 = *(const f32x4*)gtp; P.gt1 = *(const f32x4*)(gtp + 4);
    P.gs0 = *(const f32x4*)gsp; P.gs1 = *(const f32x4*)(gsp + 4);
}
__device__ __forceinline__ void epi_gemm2(const Frame& F, const Params& p, GemmAcc& acc, int tn, int tm, int l, const Gemm2Pre& P) {
    int lane = F.lane; const int wn = F.w & 1, wm = F.w >> 1;
    asm volatile("" : "+v"(lane));
    const int c15 = lane & 15, g4 = lane >> 4;
    unsigned char* ws = F.ws;
    LAS float* st = (LAS float*)(F.lds + LDS_OST + F.w * OST_BYTES);
    const bool lat = tm >= 16;
    const int nb = tn * 128 + wn * 64;
    const int c8 = (lane & 7) * 8, r8 = lane >> 3;
#pragma unroll
    for (int mt = 0; mt < 2; ++mt) {
        const int tok0 = tm * 256 + wm * 64 + mt * 32;
        stage_write16a(st, acc, 2 * mt, c15, g4);
        stage_write16a(st, acc, 2 * mt + 1, c15, g4);
        bf16_t* xb0 = (bf16_t*)(ws + WS_XB) + (size_t)tok0 * 1024 + nb + c8;
        f32x4 xo8[8];
        if (l == 0) {
            const float* xold0 = lat ? pin(F, I_XS) + (size_t)(tok0 - 4096) * 1024 : pin(F, I_XP) + (size_t)tok0 * 1024;
#pragma unroll
            for (int it = 0; it < 4; ++it) {
                const float* xp = xold0 + (size_t)(it * 8 + r8) * 1024 + nb + c8;
                xo8[2 * it] = *(const f32x4*)xp; xo8[2 * it + 1] = *(const f32x4*)(xp + 4);
            }
        } else {
#pragma unroll
            for (int it = 0; it < 4; ++it) {
                const u32x4 q = *(const u32x4*)(xb0 + (size_t)(it * 8 + r8) * 1024);
                xo8[2 * it] = (f32x4){bflo(q.x), bfhi(q.x), bflo(q.y), bfhi(q.y)}; xo8[2 * it + 1] = (f32x4){bflo(q.z), bfhi(q.z), bflo(q.w), bfhi(q.w)};
            }
        }
#pragma unroll
        for (int it = 0; it < 4; ++it) {
            const int row = it * 8 + r8;
            const f32x4 a0 = *(const LAS f32x4*)(st + row * OST_LD + c8), a1 = *(const LAS f32x4*)(st + row * OST_LD + c8 + 4);
            const f32x4 xn0 = xo8[2 * it] + P.gt0 * a0, xn1 = xo8[2 * it + 1] + P.gt1 * a1;
            {
                u32x4 o; o.x = pk2(xn0[0], xn0[1]); o.y = pk2(xn0[2], xn0[3]); o.z = pk2(xn1[0], xn1[1]); o.w = pk2(xn1[2], xn1[3]);
                *(u32x4*)(xb0 + (size_t)row * 1024) = o;
            }
            float ss = ((xn0[0] * xn0[0] + xn0[1] * xn0[1]) + (xn0[2] * xn0[2] + xn0[3] * xn0[3])) + ((xn1[0] * xn1[0] + xn1[1] * xn1[1]) + (xn1[2] * xn1[2] + xn1[3] * xn1[3]));
            ss += __shfl_xor(ss, 1); ss += __shfl_xor(ss, 2); ss += __shfl_xor(ss, 4);
            if ((lane & 7) == 0) ((float*)(ws + WS_SSQ))[(size_t)(tok0 + row) * 16 + tn * 2 + wn] = ss;
            if (l < 3) {
                u32x4 o; o.x = pk2(xn0[0] * P.gs0[0], xn0[1] * P.gs0[1]); o.y = pk2(xn0[2] * P.gs0[2], xn0[3] * P.gs0[3]);
                o.z = pk2(xn1[0] * P.gs1[0], xn1[1] * P.gs1[1]); o.w = pk2(xn1[2] * P.gs1[2], xn1[3] * P.gs1[3]);
                *(u32x4*)((bf16_t*)(ws + WS_XG) + (size_t)(tok0 + row) * 1024 + nb + c8) = o;
            }
        }
    }
}
constexpr int AT_STG = 20480, AT_PE = 8192, AT_V = 12288, AT_OLD = 68;
struct AttnUnit {
    int mode;
    int nt0, nt1;
    const bf16_t *q; int q_ld;
    const bf16_t *k0, *k1; int k_ld0, k_ld1;
    const bf16_t *pe0, *pe1;
    const bf16_t *v0, *v1; int v_ld0, v_ld1;
    int tok0;
    int ycol;
    int qpos0, L;
    float lf, lb;
    const bf16_t *s0f, *s0b;
    float* st_out;
};
__device__ __forceinline__ s16x4 tr16(LAS const unsigned char* p) {
    typedef short v4i16_t __attribute__((ext_vector_type(4)));
    return __builtin_bit_cast(s16x4, __builtin_amdgcn_ds_read_tr16_b64_v4i16((LAS v4i16_t*)p));
}

template <int MODE>
__device__ __forceinline__ void attn_unit(const Frame& F, const Params& p, const AttnUnit& U) {
    constexpr int NQS = MODE == 1 ? 6 : 4;
    const int lane = F.lane, w = F.w, h = F.h, lq = F.lq;
    LAS unsigned char* lds = F.lds;
    const int k_ld = U.k_ld1, v_ld = U.v_ld1;
    const int krow = 8 * w + (lane >> 3);
    const int koff = krow * k_ld + ((lane & 7) ^ ((krow >> 1) & 7)) * 8;
    const int poff = (16 * (w & 3) + (lane >> 2)) * 32 + ((lane & 3) ^ ((lane >> 4) & 3)) * 8;
    const int vdblk = w >> 2, vkg = w & 3;
    const int voff = (16 * vkg + (lane >> 2)) * v_ld + vdblk * 32 + (lane & 3) * 8;
    const int vdst = AT_V + vdblk * 4096 + vkg * 1024;
    const int nt0 = U.nt0, ntot = U.nt0 + U.nt1;
    const unsigned ldsb = (unsigned)(uintptr_t)lds;
#define AT_DMA(gsrc, ldsoff) do { unsigned _keep; const unsigned _d = (unsigned)__builtin_amdgcn_readfirstlane((int)(ldsb + (unsigned)(ldsoff))); \
        asm volatile("s_mov_b32 %0, m0\n\ts_mov_b32 m0, %2\n\ts_nop 0\n\tglobal_load_lds_dwordx4 %1, off\n\ts_mov_b32 m0, %0" : "=&s"(_keep) : "v"(gsrc), "s"(_d) : "memory"); } while (0)
#define AT_ISSUE(t, st) do { const int _t = (t); const int _b = (st) * AT_STG; \
        const bool _s0 = _t < nt0; const int _u = _s0 ? _t : _t - nt0; \
        const bf16_t* _kb = (_s0 ? U.k0 : U.k1) + (size_t)_u * 64 * k_ld; const bf16_t* _vb = (_s0 ? U.v0 : U.v1) + (size_t)_u * 64 * v_ld; \
        AT_DMA(_kb + koff, _b + (8 * w) * 128); \
        if (MODE == 1) { const bf16_t* _pb = (_s0 ? U.pe0 : U.pe1) + (size_t)_u * 64 * 32; AT_DMA(_pb + poff, _b + AT_PE + 16 * (w & 3) * 64); } \
        AT_DMA(_vb + voff, _b + vdst); } while (0)
    AT_ISSUE(0, 0);
    if (ntot > 1) AT_ISSUE(1, 1);
    bf16x8 qr[NQS];
    if (MODE == 3) {
        const int dk = 32 * (w & 1) + lq;
#pragma unroll
        for (int s = 0; s < 4; ++s)
#pragma unroll
            for (int j = 0; j < 8; ++j) qr[s][j] = (16 * s + 8 * h + j == dk) ? (short)0x3F80 : (short)0;
    } else {
        const bf16_t* qp = U.q + (size_t)(32 * w + lq) * U.q_ld + 8 * h;
#pragma unroll
        for (int s = 0; s < NQS; ++s) qr[s] = *(const bf16x8*)(qp + 16 * s);
    }
    f32x16 o[2];
#pragma unroll
    for (int d = 0; d < 2; ++d)
#pragma unroll
        for (int r = 0; r < 16; ++r) o[d][r] = 0.f;
    float m_run = 0.f, l_run = 0.f;
    f32x16 negm;
#pragma unroll
    for (int r = 0; r < 16; ++r) negm[r] = 0.f;
    const int qpos = U.qpos0 + 32 * w + lq;
    const float st_slope = ((w >> 1) & 1) ? U.lb : -U.lf, st_off = ((w >> 1) & 1) ? 0.f : 255.f * U.lf;
    const int sdir = (w >> 1) & 1;
    LAS float* scal = (LAS float*)(lds + LDS_SCAL) + w * 32;
    LAS float* ctab = (LAS float*)(lds + LDS_EXB) + w * 128;
    float a_f = 0.f, a_b = 0.f;
    if (MODE == 2) {
        ctab[lane] = __builtin_amdgcn_exp2f((float)(63 - lane) * U.lf);
        ctab[64 + lane] = __builtin_amdgcn_exp2f((float)lane * U.lb);
        a_f = __builtin_amdgcn_exp2f((float)(32 * w + lq) * U.lf);
        a_b = __builtin_amdgcn_exp2f((float)(255 - 32 * w - lq) * U.lb);
        asm volatile("s_waitcnt lgkmcnt(0)" ::: "memory");
        __builtin_amdgcn_wave_barrier();
    }
    const int kfo = lq * 128, sw = (lane >> 1) & 7, pfo = AT_PE + lq * 64, psw = (lane >> 2) & 3;
    const int vfo = AT_V + (4 * h + ((lane & 15) >> 2)) * 64 + ((lane >> 4) & 1) * 32 + (lane & 3) * 8;
    int st = 0;
    for (int t = 0; t < ntot; ++t) {
        if (t + 1 < ntot) { if (MODE == 1) asm volatile("s_waitcnt vmcnt(3)" ::: "memory"); else asm volatile("s_waitcnt vmcnt(2)" ::: "memory"); }
        else asm volatile("s_waitcnt vmcnt(0)" ::: "memory");
        __builtin_amdgcn_s_barrier();
        asm volatile("" ::: "memory");
        const int st2 = st == 0 ? 2 : st - 1;
        if (t + 2 < ntot) AT_ISSUE(t + 2, st2);
        LAS const unsigned char* base = lds + st * AT_STG;
        bf16x8 kfa[NQS], kfb[NQS];
#pragma unroll
        for (int s = 0; s < 4; ++s) {
            const int so = ((2 * s + h) ^ sw) << 4;
            kfa[s] = *(const LAS bf16x8*)(base + kfo + so);
            kfb[s] = *(const LAS bf16x8*)(base + kfo + 4096 + so);
        }
        if (MODE == 1) {
#pragma unroll
            for (int s = 0; s < 2; ++s) {
                const int so = ((2 * s + h) ^ psw) << 4;
                kfa[4 + s] = *(const LAS bf16x8*)(base + pfo + so);
                kfb[4 + s] = *(const LAS bf16x8*)(base + pfo + 2048 + so);
            }
        }
        f32x16 p0, p1;
        if (MODE <= 1) { p0 = negm; p1 = negm; }
        else {
#pragma unroll
            for (int r = 0; r < 16; ++r) { p0[r] = 0.f; p1[r] = 0.f; }
        }
#pragma unroll
        for (int s = 0; s < NQS; ++s) { p0 = MFMA32(kfa[s], qr[s], p0); p1 = MFMA32(kfb[s], qr[s], p1); }
        s16x4 vlo[4], vhi[4];
#pragma unroll
        for (int ks = 0; ks < 4; ++ks) { vlo[ks] = tr16(base + vfo + ks * 1024); vhi[ks] = tr16(base + vfo + ks * 1024 + 512); }
        if (MODE <= 1) {
            float tm = p0[0];
#pragma unroll
            for (int r = 1; r < 16; ++r) tm = fmaxf(tm, p0[r]);
#pragma unroll
            for (int r = 0; r < 16; ++r) tm = fmaxf(tm, p1[r]);
            tm = fmaxf(tm, __shfl_xor(tm, 32));
            if (t == 0 || __any(tm > 6.0f)) {
                const float dl = t == 0 ? tm : fmaxf(tm, 0.f);
                m_run += dl;
#pragma unroll
                for (int r = 0; r < 16; ++r) { p0[r] -= dl; p1[r] -= dl; negm[r] = -m_run; }
                if (t > 0) {
                    const float alpha = __builtin_amdgcn_exp2f(-dl);
                    l_run *= alpha;
                    if (h == 0) scal[lq] = alpha;
                    asm volatile("s_waitcnt lgkmcnt(0)" ::: "memory");
#pragma unroll
                    for (int g = 0; g < 4; ++g) {
                        const f32x4 a4 = *(const LAS f32x4*)(scal + 8 * g + 4 * h);
#pragma unroll
                        for (int i = 0; i < 4; ++i) { o[0][4 * g + i] *= a4[i]; o[1][4 * g + i] *= a4[i]; }
                    }
                }
            }
            float ls = 0.f;
#pragma unroll
            for (int r = 0; r < 16; ++r) { p0[r] = __builtin_amdgcn_exp2f(p0[r]); p1[r] = __builtin_amdgcn_exp2f(p1[r]); ls += p0[r] + p1[r]; }
            l_run += ls;
        } else if (MODE == 2 && (64 * t + 63 < U.qpos0 || 64 * t > U.qpos0 + 255)) {
            const bool fwd = 64 * t + 63 < U.qpos0;
            const float A = fwd ? a_f * __builtin_amdgcn_exp2f((float)(U.qpos0 - 64 * t - 63) * U.lf) : a_b * __builtin_amdgcn_exp2f((float)(64 * t - U.qpos0 - 255) * U.lb);
            const LAS float* tb = ctab + (fwd ? 0 : 64) + 4 * h;
#pragma unroll
            for (int g = 0; g < 4; ++g) {
                const f32x4 c0 = *(const LAS f32x4*)(tb + 8 * g), c1 = *(const LAS f32x4*)(tb + 32 + 8 * g);
#pragma unroll
                for (int i = 0; i < 4; ++i) { p0[4 * g + i] *= c0[i] * A; p1[4 * g + i] *= c1[i] * A; }
            }
        } else if (MODE == 2) {
            float dq = (float)(qpos - 64 * t - 4 * h);
            asm volatile("" : "+v"(dq));
#pragma unroll
            for (int r = 0; r < 16; ++r) {
                const float d0 = dq - (float)((r & 3) + 8 * (r >> 2)), d1 = d0 - 32.f;
                const float w0 = __builtin_amdgcn_exp2f(fabsf(d0) * (d0 > 0.f ? U.lf : U.lb));
                const float w1 = __builtin_amdgcn_exp2f(fabsf(d1) * (d1 > 0.f ? U.lf : U.lb));
                p0[r] *= (d0 == 0.f ? 2.f : w0);
                p1[r] *= (d1 == 0.f ? 2.f : w1);
            }
        } else {
            float mb = (float)(64 * t + 4 * h);
            asm volatile("" : "+v"(mb));
#pragma unroll
            for (int r = 0; r < 16; ++r) {
                const float m0 = mb + (float)((r & 3) + 8 * (r >> 2)), m1 = m0 + 32.f;
                const float e0 = fmaf(m0, st_slope, st_off), e1 = fmaf(m1, st_slope, st_off);
                p0[r] *= __builtin_amdgcn_exp2f(e0);
                p1[r] *= __builtin_amdgcn_exp2f(e1);
            }
        }
        bf16x8 pa[4];
        { u32x4 a;
          a.x = pk2(p0[0], p0[1]); a.y = pk2(p0[2], p0[3]); a.z = pk2(p0[4], p0[5]); a.w = pk2(p0[6], p0[7]); pa[0] = __builtin_bit_cast(bf16x8, a);
          a.x = pk2(p0[8], p0[9]); a.y = pk2(p0[10], p0[11]); a.z = pk2(p0[12], p0[13]); a.w = pk2(p0[14], p0[15]); pa[1] = __builtin_bit_cast(bf16x8, a);
          a.x = pk2(p1[0], p1[1]); a.y = pk2(p1[2], p1[3]); a.z = pk2(p1[4], p1[5]); a.w = pk2(p1[6], p1[7]); pa[2] = __builtin_bit_cast(bf16x8, a);
          a.x = pk2(p1[8], p1[9]); a.y = pk2(p1[10], p1[11]); a.z = pk2(p1[12], p1[13]); a.w = pk2(p1[14], p1[15]); pa[3] = __builtin_bit_cast(bf16x8, a); }
#pragma unroll
        for (int ks = 0; ks < 4; ++ks) {
            const bf16x8 vb = __builtin_shufflevector(vlo[ks], vhi[ks], 0, 1, 2, 3, 4, 5, 6, 7);
            o[0] = MFMA32(pa[ks], vb, o[0]);
        }
#pragma unroll
        for (int ks = 0; ks < 4; ++ks) { vlo[ks] = tr16(base + vfo + 4096 + ks * 1024); vhi[ks] = tr16(base + vfo + 4096 + ks * 1024 + 512); }
#pragma unroll
        for (int ks = 0; ks < 4; ++ks) {
            const bf16x8 vb = __builtin_shufflevector(vlo[ks], vhi[ks], 0, 1, 2, 3, 4, 5, 6, 7);
            o[1] = MFMA32(pa[ks], vb, o[1]);
        }
        st = st == 2 ? 0 : st + 1;
    }
#undef AT_ISSUE
#undef AT_DMA
    int lq2 = lq, h2 = h, lane2 = lane; asm volatile("" : "+v"(lq2), "+v"(h2), "+v"(lane2));
    if (MODE == 2 && U.s0f != nullptr) {
        const float ff = __builtin_amdgcn_exp2f((float)(qpos + 1) * U.lf), fb = __builtin_amdgcn_exp2f((float)(U.L - qpos) * U.lb);
#pragma unroll
        for (int s = 0; s < 4; ++s) {
            const u32x4 qu = __builtin_bit_cast(u32x4, qr[s]);
            u32x4 af, ab;
#pragma unroll
            for (int i = 0; i < 4; ++i) { const float lo = bflo(qu[i]), hi = bfhi(qu[i]); af[i] = pk2(lo * ff, hi * ff); ab[i] = pk2(lo * fb, hi * fb); }
#pragma unroll
            for (int d = 0; d < 2; ++d) {
                const bf16x8 sf = *(const bf16x8*)(U.s0f + (size_t)(32 * d + lq2) * 64 + 16 * s + 8 * h2);
                const bf16x8 sb = *(const bf16x8*)(U.s0b + (size_t)(32 * d + lq2) * 64 + 16 * s + 8 * h2);
                o[d] = MFMA32(__builtin_bit_cast(bf16x8, af), sf, o[d]);
                o[d] = MFMA32(__builtin_bit_cast(bf16x8, ab), sb, o[d]);
            }
        }
    }
    if (MODE == 3) {
        float* dst = U.st_out + (size_t)sdir * 4 * 4096 + (size_t)(32 * (w & 1)) * 64;
        if (w < 4) {
#pragma unroll
        for (int d = 0; d < 2; ++d)
#pragma unroll
            for (int r = 0; r < 16; ++r) dst[(size_t)((r & 3) + 8 * (r >> 2) + 4 * h2) * 64 + 32 * d + lq2] = o[d][r];
        }
        __syncthreads();
        return;
    }
    if (MODE <= 1) {
        l_run += __shfl_xor(l_run, 32);
        if (h2 == 0) scal[lq2] = 1.f / l_run;
    }
    __syncthreads();
    LAS float* ost = (LAS float*)lds + w * (32 * AT_OLD);
#pragma unroll
    for (int d = 0; d < 2; ++d)
#pragma unroll
        for (int r = 0; r < 16; ++r) ost[((r & 3) + 8 * (r >> 2) + 4 * h2) * AT_OLD + 32 * d + lq2] = o[d][r];
    asm volatile("s_waitcnt lgkmcnt(0)" ::: "memory");
    __builtin_amdgcn_wave_barrier();
    const bf16_t* zs = (const bf16_t*)(F.ws + WS_ZS);
    bf16_t* yb = (bf16_t*)(F.ws + WS_Y);
#pragma unroll
    for (int it = 0; it < 4; ++it) {
        const int row = it * 8 + (lane2 >> 3), c8 = (lane2 & 7) * 8;
        const f32x4 x0 = *(const LAS f32x4*)(ost + row * AT_OLD + c8), x1 = *(const LAS f32x4*)(ost + row * AT_OLD + c8 + 4);
        float sc;
        if (MODE <= 1) sc = scal[row];
        else {
            float ss = (x0[0] * x0[0] + x0[1] * x0[1]) + (x0[2] * x0[2] + x0[3] * x0[3]) + (x1[0] * x1[0] + x1[1] * x1[1]) + (x1[2] * x1[2] + x1[3] * x1[3]);
            ss += __shfl_xor(ss, 1); ss += __shfl_xor(ss, 2); ss += __shfl_xor(ss, 4);
            sc = rsqrtf(ss * (1.f / 64.f) + EPS);
        }
        const size_t off = (size_t)(U.tok0 + 32 * w + row) * 1024 + U.ycol + c8;
        const u32x4 z = *(const u32x4*)(zs + off);
        u32x4 y;
        y.x = pk2(x0[0] * sc * bflo(z.x), x0[1] * sc * bfhi(z.x));
        y.y = pk2(x0[2] * sc * bflo(z.y), x0[3] * sc * bfhi(z.y));
        y.z = pk2(x1[0] * sc * bflo(z.z), x1[1] * sc * bfhi(z.z));
        y.w = pk2(x1[2] * sc * bflo(z.w), x1[3] * sc * bfhi(z.w));
        ST16_WT(yb + off, y);
    }
    __syncthreads();
}

__device__ __forceinline__ void attn_dispatch(const Frame& F, const Params& p, int u, int l) {
    unsigned char* ws = F.ws;
    AttnUnit U;
    U.nt0 = 0; U.nt1 = 0; U.q = nullptr; U.q_ld = 0; U.k0 = U.k1 = nullptr; U.k_ld0 = U.k_ld1 = 0; U.pe0 = U.pe1 = nullptr; U.v0 = U.v1 = nullptr; U.v_ld0 = U.v_ld1 = 0;
    U.tok0 = 0; U.ycol = 0; U.qpos0 = 0; U.L = 0; U.lf = U.lb = 0.f; U.s0f = U.s0b = nullptr; U.st_out = nullptr; U.mode = 0;
    const bf16_t* GQ = (const bf16_t*)(ws + WS_GQ); const bf16_t* GK = (const bf16_t*)(ws + WS_GK); const bf16_t* GV = (const bf16_t*)(ws + WS_GV);
    const bf16_t* QM = (const bf16_t*)(ws + WS_QM); const bf16_t* KVM = (const bf16_t*)(ws + WS_KVM); const bf16_t* KVMC = (const bf16_t*)(ws + WS_KVMC);
    const bf16_t* KPEB = (const bf16_t*)(ws + WS_KPEB); const bf16_t* CKPE = (const bf16_t*)(ws + WS_CKPE);
    const bf16_t* CGK = (const bf16_t*)(ws + WS_CGK); const bf16_t* CGV = (const bf16_t*)(ws + WS_CGV);
    const bf16_t* RQ = (const bf16_t*)(ws + WS_RQ); const bf16_t* RK = (const bf16_t*)(ws + WS_RK); const bf16_t* RV = (const bf16_t*)(ws + WS_RV);
    const float* decay = pin(F, I_DECAY) + l * 8;
    if (u < 96 || (u >= 256 && u < 352)) {
        const bool lat = u < 96; const int uu = lat ? u : u - 256;
        const int b = lat ? uu / 24 : uu / 6, hh = lat ? (uu >> 2) % 6 : uu % 6, qb = lat ? (uu & 3) : 0;
        const int seq0 = lat ? 4096 + b * 1024 : b * 256;
        U.mode = 1; U.tok0 = seq0 + qb * 256; U.q = QM + (size_t)U.tok0 * 576 + hh * 96; U.q_ld = 576; U.ycol = 640 + hh * 64;
        U.nt1 = lat ? 16 : 4; U.k1 = KVM + (size_t)seq0 * 768 + hh * 128; U.k_ld1 = 768; U.v1 = U.k1 + 64; U.v_ld1 = 768; U.pe1 = KPEB + (size_t)seq0 * 32;
        U.k0 = U.k1; U.v0 = U.v1; U.pe0 = U.pe1; U.k_ld0 = 768; U.v_ld0 = 768;
        if (lat) { U.nt0 = 8; U.k0 = KVMC + (size_t)(b * 512) * 768 + hh * 128; U.v0 = U.k0 + 64; U.pe0 = CKPE + (size_t)((b * 4 + l) * 512) * 32; }
        attn_unit<1>(F, p, U);
    } else if (u < 192 || (u >= 352 && u < 448)) {
        const bool lat = u < 192; const int uu = lat ? u - 96 : u - 352;
        const int b = lat ? uu / 24 : uu / 6, hh = lat ? (uu >> 2) % 6 : uu % 6, qb = lat ? (uu & 3) : 0, kvh = hh / 3;
        const int seq0 = lat ? 4096 + b * 1024 : b * 256;
        U.mode = 0; U.tok0 = seq0 + qb * 256; U.q = GQ + (size_t)U.tok0 * 384 + hh * 64; U.q_ld = 384; U.ycol = 256 + hh * 64;
        U.nt1 = lat ? 16 : 4; U.k1 = GK + (size_t)seq0 * 128 + kvh * 64; U.k_ld1 = 128; U.v1 = GV + (size_t)seq0 * 128 + kvh * 64; U.v_ld1 = 128;
        U.k0 = U.k1; U.v0 = U.v1; U.k_ld0 = 128; U.v_ld0 = 128;
        if (lat) { U.nt0 = 8; U.k0 = CGK + (size_t)((b * 4 + l) * 512) * 128 + kvh * 64; U.v0 = CGV + (size_t)((b * 4 + l) * 512) * 128 + kvh * 64; }
        attn_unit<0>(F, p, U);
    } else if (u < 256 || (u >= 448 && u < 512)) {
        const bool lat = u < 256; const int uu = lat ? u - 192 : u - 448;
        const int b = lat ? uu / 16 : uu / 4, hh = lat ? (uu >> 2) & 3 : uu & 3, qb = lat ? (uu & 3) : 0;
        const int seq0 = lat ? 4096 + b * 1024 : b * 256;
        U.mode = 2; U.tok0 = seq0 + qb * 256; U.q = RQ + (size_t)U.tok0 * 256 + hh * 64; U.q_ld = 256; U.ycol = hh * 64;
        U.nt1 = lat ? 16 : 4; U.k1 = RK + (size_t)seq0 * 256 + hh * 64; U.k_ld1 = 256; U.v1 = RV + (size_t)seq0 * 256 + hh * 64; U.v_ld1 = 256;
        U.k0 = U.k1; U.v0 = U.v1; U.k_ld0 = 256; U.v_ld0 = 256;
        U.qpos0 = qb * 256; U.L = lat ? 1024 : 256;
        U.lf = -log1pf(__expf(-decay[hh])) * LOG2E; U.lb = -log1pf(__expf(-decay[4 + hh])) * LOG2E;
        if (lat) { const bf16_t* S0T = (const bf16_t*)(ws + WS_S0T); U.s0f = S0T + (size_t)(((b * 4 + l) * 2 + 0) * 4 + hh) * 4096; U.s0b = S0T + (size_t)(((b * 4 + l) * 2 + 1) * 4 + hh) * 4096; }
        attn_unit<2>(F, p, U);
    } else {
        const int uu = u - 512, b = uu >> 2, hh = uu & 3, seq0 = b * 256;
        U.mode = 3; U.nt1 = 4; U.k1 = RK + (size_t)seq0 * 256 + hh * 64; U.k_ld1 = 256; U.v1 = RV + (size_t)seq0 * 256 + hh * 64; U.v_ld1 = 256;
        U.k0 = U.k1; U.v0 = U.v1; U.k_ld0 = 256; U.v_ld0 = 256;
        U.lf = -log1pf(__expf(-decay[hh])) * LOG2E; U.lb = -log1pf(__expf(-decay[4 + hh])) * LOG2E;
        U.st_out = p.out + O_STATE + (size_t)(((b * 4 + l) * 2 + 0) * 4 + hh) * 4096;
        attn_unit<3>(F, p, U);
    }
}
constexpr int N_ATTN_UNITS = 576;
struct TItem { const float* src; bf16_t* dst; int nsrc, K; int valid; };
constexpr int P0_TWIN = 4 * 16 * 92, P0_TWOUT = 4 * 16 * 32, P0_TWUQ = 4 * 4 * 20, P0_TWUKV = 4 * 2 * 24, P0_TR = P0_TWIN + P0_TWOUT + P0_TWUQ + P0_TWUKV;
__device__ __forceinline__ TItem p0_titem(const Frame& F, unsigned char* ws, int it) {
    TItem t; t.valid = it < P0_TR; t.src = nullptr; t.dst = nullptr; t.nsrc = 0; t.K = 0;
    if (!t.valid) return t;
    if (it < P0_TWIN) {
        const int l = it / (16 * 92), r = it % (16 * 92), kb = r / 92, nb = r % 92, n0 = nb * 32;
        const int src = n0 < 1792 ? n0 : (n0 < 2816 ? n0 + 32 : (n0 < 2848 ? n0 - 2816 + 1792 : -1));
        t.nsrc = 2848; t.K = 1024;
        if (src >= 0) t.src = pin(F, I_WIN) + (size_t)l * 1024 * 2848 + (size_t)(kb * 64) * 2848 + src;
        t.dst = (bf16_t*)(ws + WS_WIN) + ((size_t)l * 2944 + n0) * 1024 + kb * 64;
        return t;
    }
    it -= P0_TWIN;
    if (it < P0_TWOUT) {
        const int l = it / 512, r = it % 512, kb = r >> 5, nb = r & 31;
        t.nsrc = 1024; t.K = 1024; t.src = pin(F, I_WOUT) + (size_t)l * 1024 * 1024 + (size_t)(kb * 64) * 1024 + nb * 32;
        t.dst = (bf16_t*)(ws + WS_WOUT) + ((size_t)l * 1024 + nb * 32) * 1024 + kb * 64;
        return t;
    }
    it -= P0_TWOUT;
    if (it < P0_TWUQ) {
        const int l = it / 80, r = it % 80, kb = r / 20, nb = r % 20;
        t.nsrc = 576; t.K = 256; if (nb < 18) t.src = pin(F, I_WUQ) + (size_t)l * 256 * 576 + (size_t)(kb * 64) * 576 + nb * 32;
        t.dst = (bf16_t*)(ws + WS_WUQ) + ((size_t)l * 640 + nb * 32) * 256 + kb * 64;
        return t;
    }
    it -= P0_TWUQ;
    { const int l = it / 48, r = it % 48, kb = r / 24, nb = r % 24;
      t.nsrc = 768; t.K = 128; t.src = pin(F, I_WUKV) + (size_t)l * 128 * 768 + (size_t)(kb * 64) * 768 + nb * 32;
      t.dst = (bf16_t*)(ws + WS_WUKV) + ((size_t)l * 768 + nb * 32) * 128 + kb * 64; }
    return t;
}
__device__ __forceinline__ void p0_tload(const TItem& t, float (&r)[32], int lane) {
    if (t.valid && t.src) {
        const float* wp = t.src + (size_t)(lane >> 5) * t.nsrc + (lane & 31);
#pragma unroll
        for (int i = 0; i < 32; ++i) r[i] = wp[(size_t)(2 * i) * t.nsrc];
    } else {
#pragma unroll
        for (int i = 0; i < 32; ++i) r[i] = 0.f;
    }
}
__device__ __forceinline__ void p0_tstore(const TItem& t, const float (&r)[32], LAS float* scr, int lane) {
    if (!t.valid) return;
#pragma unroll
    for (int i = 0; i < 32; ++i) scr[(2 * i + (lane >> 5)) * 33 + (lane & 31)] = r[i];
    asm volatile("s_waitcnt lgkmcnt(0)" ::: "memory");
    __builtin_amdgcn_wave_barrier();
    const int c = lane & 7;
#pragma unroll
    for (int j = 0; j < 4; ++j) {
        const int n = (lane >> 3) + 8 * j; const LAS float* s = scr + (8 * c) * 33 + n;
        u32x4 o; o.x = pk2(s[0 * 33], s[1 * 33]); o.y = pk2(s[2 * 33], s[3 * 33]); o.z = pk2(s[4 * 33], s[5 * 33]); o.w = pk2(s[6 * 33], s[7 * 33]);
        ST16_WT(t.dst + (size_t)n * t.K + 8 * c, o);
    }
    asm volatile("s_waitcnt lgkmcnt(0)" ::: "memory");
    __builtin_amdgcn_wave_barrier();
}
__device__ __forceinline__ void cast8(const float* src, bf16_t* dst, size_t e) {
    const f32x4 a = *(const f32x4*)(src + e), b = *(const f32x4*)(src + e + 4);
    u32x4 o; o.x = pk2(a[0], a[1]); o.y = pk2(a[2], a[3]); o.z = pk2(b[0], b[1]); o.w = pk2(b[2], b[3]);
    ST16_WT(dst + e, o);
}
constexpr int P0_MODS = 1536, P0_CAST_G = 512, P0_CAST_KPE = 128, P0_S0T = 512;
constexpr int P0_TOTAL = P0_MODS + 3 * P0_CAST_G + P0_CAST_KPE + P0_S0T;
__device__ __forceinline__ void phase0(const Frame& F, const Params& p, bool dup = false) {
    unsigned char* ws = F.ws + (dup ? 162 * MiB : 0); const int lane = F.lane;
    LAS float* scr = (LAS float*)F.lds + F.w * (64 * 33);
    const int gw = blockIdx.x * NWAVE + F.w, ngw = gridDim.x * NWAVE;
#ifndef MK_DUP0
#define MK_DUP0_ 0
#else
#define MK_DUP0_ MK_DUP0
#endif
    if (!(dup && MK_DUP0_ == 2))
    for (int it = gw; it < P0_TR; it += 2 * ngw) {
        const TItem t0 = p0_titem(F, ws, it), t1 = p0_titem(F, ws, it + ngw);
        float r0[32], r1[32];
        p0_tload(t0, r0, lane); p0_tload(t1, r1, lane);
        p0_tstore(t0, r0, scr, lane); p0_tstore(t1, r1, scr, lane);
    }
    if (!(dup && MK_DUP0_ == 1))
    for (int it0 = (gw + ngw - 256) % ngw; it0 < P0_TOTAL; it0 += ngw) {
        int it = it0;
        if (it < P0_MODS) {
            const int l = it / 384, cg = (it % 384) >> 5, ks = it & 31;
            const int j = cg * 256 + lane * 4;
            const float* wp = pin(F, I_WADA) + ((size_t)l * 1024 + ks * 32) * 3072 + j;
            const float* c = pin(F, I_C); const float* cc = pin(F, I_CCTX);
            float sv[3];
#pragma unroll
            for (int q = 0; q < 3; ++q) {
                const int idx = q * 64 + lane, n = idx >> 5, k = idx & 31;
                float x = 0.f;
                if (idx < 160) x = (n == 0) ? cc[ks * 32 + k] : c[(n - 1) * 1024 + ks * 32 + k];
                sv[q] = silu_f(x);
            }
            f32x4 acc[5];
#pragma unroll
            for (int n = 0; n < 5; ++n) acc[n] = (f32x4){0.f, 0.f, 0.f, 0.f};
#pragma unroll 1
            for (int k0 = 0; k0 < 32; k0 += 16) {
                f32x4 wv[16];
#pragma unroll
                for (int k = 0; k < 16; ++k) wv[k] = *(const f32x4*)(wp + (size_t)(k0 + k) * 3072);
                __builtin_amdgcn_sched_barrier(0);
#pragma unroll
                for (int k = 0; k < 16; ++k)
#pragma unroll
                    for (int n = 0; n < 5; ++n) {
                        const float s = __int_as_float(__builtin_amdgcn_readlane(__float_as_int(sv[n >> 1]), 32 * (n & 1) + k0 + k));
                        acc[n] += wv[k] * s;
                    }
            }
            LAS f32x4* red = (LAS f32x4*)(F.lds + 69632);
#pragma unroll
            for (int n = 0; n < 5; ++n) red[(F.w * 5 + n) * 64 + lane] = acc[n];
            __syncthreads();
            if (F.tid < 320) {
                const int n = F.tid >> 6;
                f32x4 s = red[n * 64 + lane];
#pragma unroll
                for (int ww = 1; ww < 8; ++ww) s += red[(ww * 5 + n) * 64 + lane];
                if ((ks >> 3) == 0) s += *(const f32x4*)(pin(F, I_BADA) + l * 3072 + j);
                float* mods = (float*)(ws + WS_MODS) + (size_t)(l * 5 + n) * 3072 + j;
#pragma unroll
                for (int e = 0; e < 4; ++e) atomicAdd(mods + e, s[e]);
            }
            __syncthreads();
            continue;
        }
        it -= P0_MODS;
        if (it < 3 * P0_CAST_G) {
            const int which = it / P0_CAST_G, r = it % P0_CAST_G;
            const float* src = which == 0 ? pin(F, I_CGK) : (which == 1 ? pin(F, I_CGV) : pin(F, I_CCKV));
            bf16_t* dst = (bf16_t*)(ws + (which == 0 ? WS_CGK : (which == 1 ? WS_CGV : WS_CCKV)));
#pragma unroll
            for (int q = 0; q < 4; ++q) cast8(src, dst, (size_t)r * 2048 + q * 512 + lane * 8);
            continue;
        }
        it -= 3 * P0_CAST_G;
        if (it < P0_CAST_KPE) {
#pragma unroll
            for (int q = 0; q < 4; ++q) cast8(pin(F, I_CKPE), (bf16_t*)(ws + WS_CKPE), (size_t)it * 2048 + q * 512 + lane * 8);
            continue; }
        it -= P0_CAST_KPE;
        {
            const int mat = it >> 2, qd = it & 3, dv = qd * 16 + (lane >> 2), dk0 = (lane & 3) * 16;
            const float* s = pin(F, I_STATE) + (size_t)mat * 4096 + dv;
            float x[16];
#pragma unroll
            for (int i = 0; i < 16; ++i) x[i] = s[(dk0 + i) * 64];
            u32x4 o0, o1;
            o0.x = pk2(x[0], x[1]); o0.y = pk2(x[2], x[3]); o0.z = pk2(x[4], x[5]); o0.w = pk2(x[6], x[7]);
            o1.x = pk2(x[8], x[9]); o1.y = pk2(x[10], x[11]); o1.z = pk2(x[12], x[13]); o1.w = pk2(x[14], x[15]);
            bf16_t* d = (bf16_t*)(ws + WS_S0T) + (size_t)mat * 4096 + dv * 64 + dk0;
            ST16_WT(d, o0); ST16_WT(d + 8, o1);
        }
    }
}
constexpr int P1_GS = 80, P1_BIAS = 4 * 368, P1_X = 8192, P1_TOTAL = P1_GS + P1_BIAS + P1_X;
__device__ __forceinline__ void xg_row(const Frame& F, const float* xrow, const float* g, const float* mods_c, bf16_t* xg_row_out, float* ssq_row, bool write_xg) {
    const int lane = F.lane;
    float ss = 0.f;
#pragma unroll
    for (int j = 0; j < 2; ++j) {
        const int k = j * 512 + lane * 8;
        const f32x4 x0 = *(const f32x4*)(xrow + k), x1 = *(const f32x4*)(xrow + k + 4);
        ss += ((x0[0] * x0[0] + x0[1] * x0[1]) + (x0[2] * x0[2] + x0[3] * x0[3])) + ((x1[0] * x1[0] + x1[1] * x1[1]) + (x1[2] * x1[2] + x1[3] * x1[3]));
        if (write_xg) {
            const f32x4 g0 = *(const f32x4*)(g + k), g1 = *(const f32x4*)(g + k + 4), s0 = *(const f32x4*)(mods_c + 1024 + k), s1 = *(const f32x4*)(mods_c + 1024 + k + 4);
            u32x4 o; o.x = pk2(x0[0] * g0[0] * (1.f + s0[0]), x0[1] * g0[1] * (1.f + s0[1])); o.y = pk2(x0[2] * g0[2] * (1.f + s0[2]), x0[3] * g0[3] * (1.f + s0[3]));
            o.z = pk2(x1[0] * g1[0] * (1.f + s1[0]), x1[1] * g1[1] * (1.f + s1[1])); o.w = pk2(x1[2] * g1[2] * (1.f + s1[2]), x1[3] * g1[3] * (1.f + s1[3]));
            ST16_WT(xg_row_out + k, o);
        }
    }
    ss = wsum(ss);
    if (lane < 16) ssq_row[lane] = lane == 0 ? ss : 0.f;
}
__device__ __forceinline__ void phase1(const Frame& F, const Params& p) {
    unsigned char* ws = F.ws; const int lane = F.lane;
    const int gw = blockIdx.x * NWAVE + F.w, ngw = gridDim.x * NWAVE;
    const float* mods = (const float*)(ws + WS_MODS);
    for (int it0 = gw; it0 < P1_TOTAL; it0 += ngw) {
        int it = it0;
        if (it < P1_GS) {
            const int e = it * 256 + lane * 4, lc = e >> 10, k = e & 1023, l = lc / 5;
            const f32x4 g = *(const f32x4*)(pin(F, I_NORMG) + l * 1024 + k), sc = *(const f32x4*)(mods + (size_t)lc * 3072 + 1024 + k);
            *(f32x4*)((float*)(ws + WS_GS) + e) = g * (sc + 1.f);
            continue;
        }
        it -= P1_GS;
        if (it < P1_BIAS) {
            const int l = it / 368, n0 = (it % 368) * 8;
            f32x4 sh[5][4];
#pragma unroll
            for (int c = 0; c < 5; ++c) {
                const float* shp = mods + (size_t)(l * 5 + c) * 3072 + lane * 16;
#pragma unroll
                for (int i = 0; i < 4; ++i) sh[c][i] = *(const f32x4*)(shp + 4 * i);
            }
            const bf16_t* wr0 = (const bf16_t*)(ws + WS_WIN) + ((size_t)l * 2944 + n0) * 1024 + lane * 16;
            u32x4 w0[8], w1[8];
#pragma unroll
            for (int r = 0; r < 8; ++r) { w0[r] = *(const u32x4*)(wr0 + (size_t)r * 1024); w1[r] = *(const u32x4*)(wr0 + (size_t)r * 1024 + 8); }
#pragma unroll
            for (int r = 0; r < 8; ++r) {
                float wv[16];
#pragma unroll
                for (int i = 0; i < 4; ++i) { wv[2 * i] = bflo(w0[r][i]); wv[2 * i + 1] = bfhi(w0[r][i]); wv[8 + 2 * i] = bflo(w1[r][i]); wv[8 + 2 * i + 1] = bfhi(w1[r][i]); }
#pragma unroll
                for (int c = 0; c < 5; ++c) {
                    float d = 0.f;
#pragma unroll
                    for (int i = 0; i < 4; ++i) { const f32x4 s4 = sh[c][i]; d += (s4[0] * wv[4 * i] + s4[1] * wv[4 * i + 1]) + (s4[2] * wv[4 * i + 2] + s4[3] * wv[4 * i + 3]); }
                    d = wsum(d);
                    if (lane == 0) ((float*)(ws + WS_BIAS))[(size_t)(l * 5 + c) * 2944 + n0 + r] = d;
                }
            }
            continue;
        }
        it -= P1_BIAS;
        {
            const int tok = it; const bool lat = tok >= 4096;
            const float* xr = lat ? pin(F, I_XS) + (size_t)(tok - 4096) * 1024 : pin(F, I_XP) + (size_t)tok * 1024;
            const int cond = lat ? 1 + ((tok - 4096) >> 10) : 0;
            xg_row(F, xr, pin(F, I_NORMG), mods + (size_t)cond * 3072, (bf16_t*)(ws + WS_XG) + (size_t)tok * 1024, (float*)(ws + WS_SSQ) + (size_t)tok * 16, true);
        }
    }
}
#ifndef MK_TIMING
#define MK_TIMING -1
#endif
constexpr int CW_TIME = 2048;
__device__ __forceinline__ void phase_final(const Frame& F, const Params& p) {
    const int lane = F.lane;
    float tf = 1.f;
    if (MK_TIMING >= 0) tf = __uint_as_float(__hip_atomic_load((unsigned*)(F.ws + WS_CTL) + CW_TIME, __ATOMIC_RELAXED, __HIP_MEMORY_SCOPE_AGENT));
    const int gw = blockIdx.x * NWAVE + F.w, ngw = gridDim.x * NWAVE;
    for (int tok = gw; tok < 8192; tok += ngw) {
        float ss = 0.f;
        if (lane < 16) ss = ((const float*)(F.ws + WS_SSQ))[(size_t)tok * 16 + lane];
        ss = wsum(ss);
        const float rstd = rsqrtf(ss * (1.f / 1024.f) + EPS);
        const bf16_t* xr = (const bf16_t*)(F.ws + WS_XB) + (size_t)tok * 1024; float* orow = p.out + (size_t)tok * 1024;
#pragma unroll
        for (int j = 0; j < 4; ++j) {
            const int k = j * 256 + lane * 4;
            const u32x2 xq = *(const u32x2*)(xr + k);
            const f32x4 x = {bflo(xq.x), bfhi(xq.x), bflo(xq.y), bfhi(xq.y)}, fn = *(const f32x4*)(pin(F, I_FNORM) + k);
            { const f32x4 o = x * fn * (rstd * tf); ST16_WT(orow + k, o); }
        }
    }
}

__device__ __forceinline__ GemmOp a2_op(const Frame& F, int l, int j) {
    GemmOp g;
    if (j < 160) { const int tn = j >> 5, tm = j & 31; g.W = (const bf16_t*)(F.ws + WS_WUQ) + ((size_t)l * 640 + tn * 128) * 256; g.X = (const bf16_t*)(F.ws + WS_CQG) + (size_t)tm * 256 * 256; g.ldw = 256; g.ldx = 256; g.K = 256; }
    else if (j < 352) { const int jj = j - 160, tn = jj >> 5, tm = jj & 31; g.W = (const bf16_t*)(F.ws + WS_WUKV) + ((size_t)l * 768 + tn * 128) * 128; g.X = (const bf16_t*)(F.ws + WS_CKVN) + (size_t)tm * 256 * 128; g.ldw = 128; g.ldx = 128; g.K = 128; }
    else { const int jj = j - 352, tn = jj >> 3, tc = jj & 7, b = tc >> 1, jt = tc & 1; g.W = (const bf16_t*)(F.ws + WS_WUKV) + ((size_t)l * 768 + tn * 128) * 128;
           g.X = (const bf16_t*)(F.ws + WS_CCKV) + ((size_t)(b * 4 + l) * 512 + jt * 256) * 128; g.ldw = 128; g.ldx = 128; g.K = 128; }
    return g;
}
__device__ __forceinline__ int a2_item(int vb, int i) {
    const int c = (vb >> 5) - 4, tmw = vb & 31;
    if (i == 3) return 352 + 32 + tmw;
    if (c == 0) return i * 32 + tmw;
    if (c == 1) return i < 2 ? (3 + i) * 32 + tmw : 160 + tmw;
    if (c == 2) return 160 + (1 + i) * 32 + tmw;
    return i < 2 ? 160 + (4 + i) * 32 + tmw : 352 + tmw;
}
#ifndef MK_EN
#define MK_EN 0xff
#endif
#define EN(x) ((MK_EN >> (x)) & 1)
constexpr int PH_TOTAL = 19;
__global__ void __launch_bounds__(512, 2) mega(Params p) {
    extern __shared__ __attribute__((aligned(16))) unsigned char lds_raw[];
    Frame F;
    F.lds = (LAS unsigned char*)lds_raw;
    F.tid = threadIdx.x; F.lane = F.tid & 63; F.w = __builtin_amdgcn_readfirstlane(F.tid >> 6); F.h = F.lane >> 5; F.lq = F.lane & 31;
    F.ws = p.ws;
    F.karg = (karg_t)__builtin_amdgcn_kernarg_segment_ptr();
    volatile LAS unsigned* MISC = (volatile LAS unsigned*)(F.lds + LDS_MISC);
    if (F.tid < 64) MISC[F.tid] = 0u;
    __syncthreads();
    unsigned* ctl = (unsigned*)(p.ws + WS_CTL);
    XcdBarrier bar; bar.bar = ctl + CW_BAR; bar.x = 0; bar.st = nullptr;
    const bool multi = p.ph_hi - p.ph_lo > 1;
    if (multi) bar = xcd_barrier_post(ctl + CW_BAR, MISC + 8);
    bar.w = F.w;
    const int G = gridDim.x;
    const Frame F0 = F;
    for (int ph = p.ph_lo; ph < p.ph_hi; ++ph) {
        if (ph >= 2 && ph < 18 && ((ph - 2) & 3) == 1) continue;
        Frame F = F0;
        F.lane = (int)__builtin_amdgcn_mbcnt_hi(~0u, __builtin_amdgcn_mbcnt_lo(~0u, 0u));
        asm volatile("" : "+v"(F.lane));
        F.tid = (F.w << 6) | F.lane; F.h = F.lane >> 5; F.lq = F.lane & 31;
        asm volatile("" : "+s"(F.w), "+s"(F.ws), "+s"(F.karg));
        if (MK_TIMING >= 0 && blockIdx.x == 0 && F.tid == 0) {
            const unsigned long long now = __builtin_amdgcn_s_memrealtime();
            const unsigned long long prev = ((unsigned long long)MISC[17] << 32) | MISC[16];
            if (ph > p.ph_lo) { const int q = ph - 1; const int grp = q < 2 ? q : 2 + ((q - 2) & 3); if (grp == MK_TIMING) MISC[18] += (unsigned)(now - prev); }
            MISC[16] = (unsigned)now; MISC[17] = (unsigned)(now >> 32);
        }
#ifndef MK_REPEAT
#define MK_REPEAT -1
#endif
        int nrep = 1;
        if (MK_REPEAT >= 1) { const int grp = ph < 2 ? ph : (ph == 18 ? 6 : 2 + ((ph - 2) & 3)); if (grp == MK_REPEAT) nrep = (grp == 5) ? (ph == 5 ? 5 : 1) : 2; }
        for (int rep = 0; rep < nrep; ++rep) {
        if (rep > 0) xcd_barrier(bar);
        Frame F = F0;
        F.lane = (int)__builtin_amdgcn_mbcnt_hi(~0u, __builtin_amdgcn_mbcnt_lo(~0u, 0u));
        asm volatile("" : "+v"(F.lane));
        F.tid = (F.w << 6) | F.lane; F.h = F.lane >> 5; F.lq = F.lane & 31;
        asm volatile("" : "+s"(F.w), "+s"(F.ws), "+s"(F.karg));
        if (EN(0) && ph == 0) {
#if defined(MK_DUP0)
            for (int d = 0; d < 2; ++d) { int dd = d; asm volatile("" : "+s"(dd)); if (dd) xcd_barrier(bar); phase0(F, p, dd != 0); }
#else
            phase0(F, p);
#endif
        }
        else if (EN(1) && ph == 1) phase1(F, p);
        else if (EN(2) && ph == 18) phase_final(F, p);
        else {
            const int l = (ph - 2) >> 2, sub = (ph - 2) & 3;
            if (EN(3) && sub == 0) {
                const bf16_t* Wt = (const bf16_t*)(F.ws + WS_WIN) + (size_t)l * 2944 * 1024;
                const bf16_t* X = (const bf16_t*)(F.ws + WS_XG);
                unsigned* flags = ctl + CW_FLAG + l * 512;
                bool first = true;
                for (int j = blockIdx.x; j < 12 * 32; j += G) {
                    const int tn2 = j >> 5, tm = j & 31;
                    const int jn = j + G; const bool hn = jn < 12 * 32;
                    const int tn = 2 * tn2 + ((F.w & 3) >> 1), wn = F.w & 1;
                    GemmAcc8 acc;
                    Gemm1Pre P1;
                    gemm1_pre(F, p, tn, wn, tm, l, P1);
                    gemm_core256(F, Wt + (size_t)tn2 * 256 * 1024, X + (size_t)tm * 256 * 1024, acc, first, hn, Wt + (size_t)(jn >> 5) * 256 * 1024, X + (size_t)(jn & 31) * 256 * 1024); first = false;
                    epi_gemm1(F, p, acc, tn, wn, tm, l, P1, tn2 == 6);
                    if (tn2 == 5 || tn2 == 6) {
                        asm volatile("s_waitcnt vmcnt(0)" ::: "memory");
                        __syncthreads();
                        if (F.tid == 0) (void)xb_add(flags + tm * 16, 1u);
                    }
                }
                for (int vb = blockIdx.x; vb < 256; vb += G) {
                    if (vb < 128) continue;
                    const int c = (vb >> 5) - 4, tmw = vb & 31;
                    const int nit = (c == 2 && tmw < 16) ? 4 : 3;
                    if (F.tid == 0) {
                        unsigned* f = flags + tmw * 16;
                        XB_SPIN(xb_ld(f) < 2u, ctl + CW_BAR);
                        __builtin_amdgcn_fence(__ATOMIC_ACQUIRE, "agent");
                        asm volatile("s_waitcnt vmcnt(0)" ::: "memory");
                    }
                    __syncthreads();
                    for (int i = 0; i < nit; ++i) {
                        const bool hn = i + 1 < nit;
                        const int j = a2_item(vb, i), jn = a2_item(vb, hn ? i + 1 : i);
                        const GemmOp g = a2_op(F, l, j); const GemmOp gn = a2_op(F, l, jn);
                        GemmAcc acc;
                        float rstdq = 0.f;
                        if (j < 160) qm_pre(F, tmw, rstdq);
                        gemm_core(F, g, acc, i == 0, hn, gn);
                        if (j < 160) epi_qm(F, acc, j >> 5, tmw, rstdq);
                        else if (j < 352) { const int jj = j - 160; epi_plain(F, acc, (bf16_t*)(F.ws + WS_KVM), 768, tmw * 256, (jj >> 5) * 128); }
                        else { const int jj = j - 352, tc = jj & 7; epi_plain(F, acc, (bf16_t*)(F.ws + WS_KVMC), 768, (tc >> 1) * 512 + (tc & 1) * 256, (jj >> 3) * 128); }
                    }
                }
            } else if (EN(5) && sub == 2) {
                for (;;) {
                    __syncthreads();
                    if (F.tid == 0) MISC[0] = atomicAdd(ctl + CW_QUEUE + 64 * l + 32 * rep, 1u);
                    __syncthreads();
                    const int u = __builtin_amdgcn_readfirstlane((int)MISC[0]);
                    if (u >= N_ATTN_UNITS) break;
                    attn_dispatch(F, p, u, l);
                }
            } else if (EN(6)) {
                const bf16_t* Wt = (const bf16_t*)(F.ws + WS_WOUT) + (size_t)l * 1024 * 1024;
                const bf16_t* Yb = (const bf16_t*)(F.ws + WS_Y);
                bool first = true;
                for (int j = blockIdx.x; j < 8 * 32; j += G) {
                    const int tn = j >> 5, tm = j & 31;
                    const int jn = j + G; const bool hn = jn < 8 * 32;
                    GemmOp g; g.W = Wt + (size_t)tn * 128 * 1024; g.X = Yb + (size_t)tm * 256 * 1024; g.ldw = 1024; g.ldx = 1024; g.K = 1024;
                    GemmOp gn = g; if (hn) { gn.W = Wt + (size_t)(jn >> 5) * 128 * 1024; gn.X = Yb + (size_t)(jn & 31) * 256 * 1024; }
                    GemmAcc acc;
                    Gemm2Pre P2;
                    gemm2_pre(F, tn, tm, l, P2);
                    gemm_core(F, g, acc, first, hn, gn); first = false;
                    epi_gemm2(F, p, acc, tn, tm, l, P2);
                }
            }
        }
        }
        if (MK_TIMING >= 0 && ph == 17 && blockIdx.x == 0 && F.tid == 0) {
            const unsigned long long now = __builtin_amdgcn_s_memrealtime();
            const unsigned long long prev = ((unsigned long long)MISC[17] << 32) | MISC[16];
            unsigned a = MISC[18]; if (MK_TIMING == 5) a += (unsigned)(now - prev);
            __hip_atomic_store(ctl + CW_TIME, __float_as_uint(1.f + (float)a * 1e-5f), __ATOMIC_RELAXED, __HIP_MEMORY_SCOPE_AGENT);
        }
        if (ph + 1 < p.ph_hi) xcd_barrier(bar);
    }
}
}

extern "C" void kernel_launch(void* const* d_in, const int* in_sizes, int n_in, void* d_out, int out_size, void* d_ws, size_t ws_size, hipStream_t stream) {
    static int grid = 0;
    if (!grid) {
        int dev = 0, cus = 0, per_cu = 0;
        (void)hipGetDevice(&dev);
        (void)hipDeviceGetAttribute(&cus, hipDeviceAttributeMultiprocessorCount, dev);
        (void)hipFuncSetAttribute((const void*)mk::mega, hipFuncAttributeMaxDynamicSharedMemorySize, mk::LDS_BYTES);
        (void)hipOccupancyMaxActiveBlocksPerMultiprocessor(&per_cu, (const void*)mk::mega, 512, mk::LDS_BYTES);
        if (per_cu > 1) per_cu = 1;
        if (per_cu < 1) per_cu = 1;
        if (cus < 1) cus = 256;
        grid = cus * per_cu;
    }
    unsigned char* ws = (unsigned char*)d_ws;
    (void)hipMemsetAsync(ws, 0, mk::CTL_ZERO_BYTES, stream);
    mk::Params P{};
    for (int i = 0; i < 22; ++i) P.in[i] = (const float*)d_in[i];
    P.out = (float*)d_out; P.ws = ws; P.xs = (float*)d_out;
    P.ph_lo = 0; P.ph_hi = mk::PH_TOTAL;
    void* args[] = {&P};
    (void)hipLaunchCooperativeKernel((const void*)mk::mega, dim3(grid), dim3(512), args, mk::LDS_BYTES, stream);
}
```

```cpp
#include <hip/hip_runtime.h>
#include <stdint.h>
namespace mk {
#define LAS __attribute__((address_space(3)))
typedef unsigned short bf16_t;
typedef short bf16x8 __attribute__((ext_vector_type(8)));
typedef short s16x4 __attribute__((ext_vector_type(4)));
typedef float f32x16 __attribute__((ext_vector_type(16)));
typedef float f32x4 __attribute__((ext_vector_type(4)));
typedef float f32x2 __attribute__((ext_vector_type(2)));
typedef unsigned u32x4 __attribute__((ext_vector_type(4)));
typedef unsigned u32x2 __attribute__((ext_vector_type(2)));
typedef __bf16 bf16x2_t __attribute__((ext_vector_type(2)));

constexpr float EPS = 1e-6f;
constexpr float LOG2E = 1.4426950408889634f;
constexpr float QSC_GQA = 0.125f * LOG2E;
constexpr float QSC_MLA = 0.10206207261596575f * LOG2E;

__device__ __forceinline__ unsigned pk2(float lo, float hi) { f32x2 v = {lo, hi}; bf16x2_t b = __builtin_convertvector(v, bf16x2_t); return __builtin_bit_cast(unsigned, b); }
__device__ __forceinline__ float bf2f(unsigned short u) { return __uint_as_float((unsigned)u << 16); }
__device__ __forceinline__ float bflo(unsigned u) { return __uint_as_float(u << 16); }
__device__ __forceinline__ float bfhi(unsigned u) { return __uint_as_float(u & 0xffff0000u); }
__device__ __forceinline__ float silu_f(float x) { return x * __builtin_amdgcn_rcpf(1.f + __builtin_amdgcn_exp2f(-x * LOG2E)); }
__device__ __forceinline__ float wsum(float v) {
#pragma unroll
    for (int o = 32; o > 0; o >>= 1) v += __shfl_xor(v, o);
    return v;
}

constexpr size_t MiB = 1u << 20;
constexpr size_t WS_CTL = 0, CTL_ZERO_BYTES = 1 * MiB;
constexpr size_t WS_MODS = 256 * 1024;
constexpr size_t WS_BIAS = 1 * MiB;
constexpr size_t WS_GS = 1 * MiB + 256 * 1024;
constexpr size_t WS_ROPE64 = 1 * MiB + 512 * 1024;
constexpr size_t WS_ROPE32 = 1 * MiB + 768 * 1024;
constexpr size_t WS_SSQ = 2 * MiB;
constexpr size_t WS_CQSSQ = 2 * MiB + 512 * 1024;
constexpr size_t WS_S0T = 3 * MiB;
constexpr size_t WS_CGK = 4 * MiB, WS_CGV = 6 * MiB, WS_CCKV = 8 * MiB, WS_CKPE = 10 * MiB;
constexpr size_t WS_WIN = 11 * MiB;
constexpr size_t WS_WOUT = 34 * MiB;
constexpr size_t WS_WUQ = 42 * MiB;
constexpr size_t WS_WUKV = 43 * MiB + 256 * 1024;
constexpr size_t WS_XG = 44 * MiB;
constexpr size_t WS_KVM = 130 * MiB;
constexpr size_t WS_KVMC = 142 * MiB;
constexpr size_t WS_RQ = 60 * MiB, WS_RK = 64 * MiB, WS_RV = 68 * MiB;
constexpr size_t WS_GQ = 72 * MiB;
constexpr size_t WS_GK = 78 * MiB, WS_GV = 80 * MiB;
constexpr size_t WS_CQG = 82 * MiB;
constexpr size_t WS_CKVN = 86 * MiB;
constexpr size_t WS_KPEB = 88 * MiB;
constexpr size_t WS_ZS = 89 * MiB;
constexpr size_t WS_QM = 105 * MiB;
constexpr size_t WS_Y = 114 * MiB;
constexpr size_t WS_XSDBG = 130 * MiB;
constexpr size_t WS_XB = 146 * MiB;
constexpr size_t WS_OPT_END = 162 * MiB;
constexpr int CW_QUEUE = 1024;
constexpr int CW_FLAG = 2048;
constexpr int CW_YRDY = 1536;
constexpr int CW_BAR = 4096;

constexpr size_t O_STATE = 8388608, O_GK = 10485760, O_GV = 12582912, O_CKV = 14680064, O_KPE = 16777216;

constexpr int NWAVE = 8;
constexpr int GST = 49152;
constexpr int GST2 = 65536;
constexpr int LDS_OST = GST2;
constexpr int LDS_EX = 135168;
constexpr int LDS_EXB = 137216;
constexpr int LDS_SCAL = 141312;
constexpr int LDS_MISC = 142336;
constexpr int LDS_BYTES = 142592;

struct Params { const float* in[22]; float* out; unsigned char* ws; float* xs; int ph_lo, ph_hi; };
enum { I_XP = 0, I_XS, I_STATE, I_CGK, I_CGV, I_CCKV, I_CKPE, I_C, I_CCTX, I_NORMG, I_WADA, I_BADA, I_WIN, I_DECAY, I_GQN, I_GKN, I_MQN, I_MKVN, I_WUQ, I_WUKV, I_WOUT, I_FNORM };

#define XB_TMO      128
#define XB_XCNT(j)  (256  + 64 * (j))
#define XB_XSUB(j)  (1280 + 64 * (j))
#define XB_XGEN(j)  (2304 + 64 * (j))
#define XB_TOP      3328
#define XB_TOPGEN   3392
#define XB_SPIN_CAP (1u << 20)
__device__ __forceinline__ unsigned xb_ld(unsigned* p) { return __hip_atomic_load(p, __ATOMIC_RELAXED, __HIP_MEMORY_SCOPE_AGENT); }
__device__ __forceinline__ unsigned xb_add(unsigned* p, unsigned v) { return __hip_atomic_fetch_add(p, v, __ATOMIC_RELAXED, __HIP_MEMORY_SCOPE_AGENT); }
__device__ __forceinline__ unsigned xb_xcc_id() { return (unsigned)__builtin_amdgcn_s_getreg((3 << 11) | 20) & 0xFu; }
#define XB_SPIN(cond, bar) do { unsigned _sp = 0; while (cond) { __builtin_amdgcn_s_sleep(1); \
    if ((++_sp & 255u) == 0u) { if (xb_ld(&(bar)[XB_TMO])) break; if (_sp > XB_SPIN_CAP) { atomicAdd(&(bar)[XB_TMO], 1u); break; } } } } while (0)
struct XcdBarrier { unsigned* bar; unsigned x; volatile LAS unsigned* st; int w; };
__device__ __forceinline__ XcdBarrier xcd_barrier_post(unsigned* bar, volatile LAS unsigned* st) {
    XcdBarrier b; b.bar = bar; b.x = xb_xcc_id(); b.st = st; b.w = 0;
    if (threadIdx.x == 0) (void)xb_add(&bar[XB_XCNT(b.x)], 1u);
    return b;
}
__device__ __forceinline__ void xcd_barrier_complete(unsigned* bar, unsigned x, unsigned& nloc, unsigned& nx) {
    const unsigned G = gridDim.x * gridDim.y * gridDim.z;
    unsigned sum, cnt, mine, sp = 0u;
    for (;;) {
        sum = 0u; cnt = 0u; mine = 0u;
#pragma unroll
        for (unsigned j = 0; j < 16; ++j) { const unsigned c = xb_ld(&bar[XB_XCNT(j)]); sum += c; cnt += (c > 0u) ? 1u : 0u; mine = (j == x) ? c : mine; }
        if (sum == G) break;
        __builtin_amdgcn_s_sleep(1);
        if ((++sp & 255u) == 0u) { if (xb_ld(&bar[XB_TMO])) break; if (sp > XB_SPIN_CAP) { atomicAdd(&bar[XB_TMO], 1u); break; } }
    }
    nloc = mine > 0u ? mine : 1u; nx = cnt > 0u ? cnt : 1u;
}
__device__ __forceinline__ void xcd_barrier(const XcdBarrier& b) {
    asm volatile("s_waitcnt vmcnt(0)" ::: "memory");
    __syncthreads();
    if (b.w == 0 && __builtin_amdgcn_mbcnt_hi(~0u, __builtin_amdgcn_mbcnt_lo(~0u, 0u)) == 0u) {
        unsigned* bar = b.bar;
        __builtin_amdgcn_s_waitcnt(0);
        unsigned nloc = b.st[0], nx = b.st[1];
        if (nloc == 0u) { xcd_barrier_complete(bar, b.x, nloc, nx); b.st[0] = nloc; b.st[1] = nx; }
        const unsigned old = xb_add(&bar[XB_XSUB(b.x)], 1u);
        const unsigned gen = old / nloc;
        if (old + 1u == (gen + 1u) * nloc) {
            __builtin_amdgcn_fence(__ATOMIC_RELEASE, "agent");
            asm volatile("s_waitcnt vmcnt(0)" ::: "memory");
            const unsigned og = xb_add(&bar[XB_TOP], 1u);
            const unsigned tg = og / nx;
            if (og + 1u == (tg + 1u) * nx) xb_add(&bar[XB_TOPGEN], 1u);
            else XB_SPIN(xb_ld(&bar[XB_TOPGEN]) == tg, bar);
            xb_add(&bar[XB_XGEN(b.x)], 1u);
            __builtin_amdgcn_fence(__ATOMIC_ACQUIRE, "agent");
            asm volatile("s_waitcnt vmcnt(0)" ::: "memory");
        } else {
            XB_SPIN(xb_ld(&bar[XB_XGEN(b.x)]) == gen, bar);
            __builtin_amdgcn_fence(__ATOMIC_ACQUIRE, "agent");
            asm volatile("s_waitcnt vmcnt(0)" ::: "memory");
        }
    }
    __syncthreads();
}

typedef const float* cfp_t;
typedef const __attribute__((address_space(4))) cfp_t* karg_t;
struct Frame {
    LAS unsigned char* lds;
    int tid, lane, w, h, lq;
    unsigned char* ws;
    karg_t karg;
};
__device__ __forceinline__ const float* pin(const Frame& F, int i) { return F.karg[i]; }
#define GLDS16(gsrc, ldsdst) __builtin_amdgcn_global_load_lds((const unsigned*)(gsrc), (LAS unsigned*)(ldsdst), 16, 0, 0)
#define ST16_WT(ptr, val) asm volatile("global_store_dwordx4 %0, %1, off sc1\n\ts_nop 1" :: "v"(ptr), "v"(val) : "memory")
#define MFMA32(a, b, c) __builtin_amdgcn_mfma_f32_32x32x16_bf16((a), (b), (c), 0, 0, 0)

struct GemmOp { const bf16_t* W; const bf16_t* X; int ldw, ldx, K; };
__device__ __forceinline__ void gemm_issue0(const Frame& F, const GemmOp& g) {
    const int lane = F.lane, w = F.w;
#pragma unroll
    for (int q = 0; q < 2; ++q) { const int row = 16 * w + 8 * q + (lane >> 3); GLDS16(g.W + row * g.ldw + ((lane & 7) ^ ((row >> 1) & 7)) * 8, F.lds + (16 * w + 8 * q) * 128); }
#pragma unroll
    for (int q = 0; q < 4; ++q) { const int row = 32 * w + 8 * q + (lane >> 3); GLDS16(g.X + row * g.ldx + ((lane & 7) ^ ((row >> 1) & 7)) * 8, F.lds + 16384 + (32 * w + 8 * q) * 128); }
}
typedef f32x4 GemmAcc[4][4];
__device__ __forceinline__ void gemm_core(const Frame& F, const GemmOp& g, GemmAcc& acc, bool issue_first, bool has_next, const GemmOp& gn) {
    const int lane = F.lane, w = F.w;
    const bf16_t* __restrict__ W = g.W; const bf16_t* __restrict__ X = g.X;
    const int nkt = g.K >> 6;
    int offW[2], offX[4];
#pragma unroll
    for (int q = 0; q < 2; ++q) { const int row = 16 * w + 8 * q + (lane >> 3); offW[q] = row * g.ldw + ((lane & 7) ^ ((row >> 1) & 7)) * 8; }
#pragma unroll
    for (int q = 0; q < 4; ++q) { const int row = 32 * w + 8 * q + (lane >> 3); offX[q] = row * g.ldx + ((lane & 7) ^ ((row >> 1) & 7)) * 8; }
    LAS unsigned char* const dW = F.lds + (16 * w) * 128;
    LAS unsigned char* const dX = F.lds + 16384 + (32 * w) * 128;
#define GC_ISSUE(kt, st) do { _Pragma("unroll") for (int q = 0; q < 2; ++q) GLDS16(W + offW[q] + (kt) * 64, dW + (st) * GST + q * 1024); \
        _Pragma("unroll") for (int q = 0; q < 4; ++q) GLDS16(X + offX[q] + (kt) * 64, dX + (st) * GST + q * 1024); } while (0)
    const int wn = w & 1, wm = w >> 1, c15 = lane & 15, g4 = lane >> 4;
    const int sw = (c15 >> 1) & 7;
    int so[2];
#pragma unroll
    for (int s = 0; s < 2; ++s) so[s] = ((4 * s + g4) ^ sw) << 4;
    const int bn0 = (64 * wn + c15) * 128, bm0 = 16384 + (64 * wm + c15) * 128;
#pragma unroll
    for (int a = 0; a < 4; ++a)
#pragma unroll
        for (int b = 0; b < 4; ++b) acc[a][b] = (f32x4){0.f, 0.f, 0.f, 0.f};
    if (issue_first) GC_ISSUE(0, 0);
    asm volatile("s_waitcnt vmcnt(0)" ::: "memory");
    __syncthreads();
    for (int kt = 0; kt < nkt; ++kt) {
        const int st = kt & 1;
        if (kt + 1 < nkt) GC_ISSUE(kt + 1, st ^ 1);
        LAS unsigned char* const base = F.lds + st * GST;
#pragma unroll
        for (int s = 0; s < 2; ++s) {
            bf16x8 fa[4], fb[4];
#pragma unroll
            for (int q = 0; q < 4; ++q) { fa[q] = *(const LAS bf16x8*)(base + bn0 + q * 2048 + so[s]); fb[q] = *(const LAS bf16x8*)(base + bm0 + q * 2048 + so[s]); }
#pragma unroll
            for (int a = 0; a < 4; ++a)
#pragma unroll
                for (int b = 0; b < 4; ++b) acc[a][b] = __builtin_amdgcn_mfma_f32_16x16x32_bf16(fa[a], fb[b], acc[a][b], 0, 0, 0);
        }
        asm volatile("s_waitcnt vmcnt(0)" ::: "memory");
        __syncthreads();
    }
#undef GC_ISSUE
    if (has_next) gemm_issue0(F, gn);
}

typedef f32x4 GemmAcc8[4][8];
__device__ __forceinline__ void gemm256_issue0(const Frame& F, const bf16_t* W, const bf16_t* X) {
    int lane = F.lane; const int w = F.w;
    asm volatile("" : "+v"(lane));
#pragma unroll
    for (int q = 0; q < 4; ++q) {
        const int row = 32 * w + 8 * q + (lane >> 3), off = row * 1024 + ((lane & 7) ^ ((row >> 1) & 7)) * 8;
        GLDS16(W + off, F.lds + (32 * w + 8 * q) * 128);
        GLDS16(X + off, F.lds + 32768 + (32 * w + 8 * q) * 128);
    }
}
__device__ __forceinline__ void gemm_core256(const Frame& F, const bf16_t* __restrict__ W, const bf16_t* __restrict__ X, GemmAcc8& acc, bool issue_first, bool has_next, const bf16_t* Wn, const bf16_t* Xn) {
    int lane = F.lane; const int w = F.w;
    asm volatile("" : "+v"(lane));
    int off[4];
#pragma unroll
    for (int q = 0; q < 4; ++q) { const int row = 32 * w + 8 * q + (lane >> 3); off[q] = row * 1024 + ((lane & 7) ^ ((row >> 1) & 7)) * 8; }
    LAS unsigned char* const dW = F.lds + (32 * w) * 128;
    LAS unsigned char* const dX = F.lds + 32768 + (32 * w) * 128;
#define GC2_ISSUE(kt, st) do { _Pragma("unroll") for (int q = 0; q < 4; ++q) { GLDS16(W + off[q] + (kt) * 64, dW + (st) * GST2 + q * 1024); GLDS16(X + off[q] + (kt) * 64, dX + (st) * GST2 + q * 1024); } } while (0)
    const int wn4 = w & 3, wm2 = w >> 2, c15 = lane & 15, g4 = lane >> 4;
    const int sw = (c15 >> 1) & 7;
    int so[2];
#pragma unroll
    for (int s = 0; s < 2; ++s) so[s] = ((4 * s + g4) ^ sw) << 4;
    const int bn0 = (64 * wn4 + c15) * 128, bm0 = 32768 + (128 * wm2 + c15) * 128;
#pragma unroll
    for (int a = 0; a < 4; ++a)
#pragma unroll
        for (int b = 0; b < 8; ++b) acc[a][b] = (f32x4){0.f, 0.f, 0.f, 0.f};
    if (issue_first) GC2_ISSUE(0, 0);
    asm volatile("s_waitcnt vmcnt(0)" ::: "memory");
    __syncthreads();
    for (int kt = 0; kt < 16; ++kt) {
        const int st = kt & 1;
        if (kt + 1 < 16) GC2_ISSUE(kt + 1, st ^ 1);
        LAS unsigned char* const base = F.lds + st * GST2;
#pragma unroll
        for (int s = 0; s < 2; ++s) {
            bf16x8 fa[4];
#pragma unroll
            for (int q = 0; q < 4; ++q) fa[q] = *(const LAS bf16x8*)(base + bn0 + q * 2048 + so[s]);
#pragma unroll
            for (int hb = 0; hb < 2; ++hb) {
                bf16x8 fb[4];
#pragma unroll
                for (int q = 0; q < 4; ++q) fb[q] = *(const LAS bf16x8*)(base + bm0 + (4 * hb + q) * 2048 + so[s]);
#pragma unroll
                for (int a = 0; a < 4; ++a)
#pragma unroll
                    for (int b = 0; b < 4; ++b) acc[a][4 * hb + b] = __builtin_amdgcn_mfma_f32_16x16x32_bf16(fa[a], fb[b], acc[a][4 * hb + b], 0, 0, 0);
            }
        }
        asm volatile("s_waitcnt vmcnt(0)" ::: "memory");
        __syncthreads();
    }
#undef GC2_ISSUE
    if (has_next) gemm256_issue0(F, Wn, Xn);
}

__device__ __forceinline__ void rope64_16(float (&v)[4][4], float rowp, float colp, int g4) {
#pragma unroll
    for (int i = 0; i < 4; ++i) {
        const float fr = __builtin_amdgcn_exp2f((float)(4 * g4 + i) * -0.8304820237218406f) * 0.15915494309189535f;
#pragma unroll
        for (int c = 0; c < 2; ++c) {
            const float rev = (c ? colp : rowp) * fr;
            const float sn = __builtin_amdgcn_sinf(rev), cs = __builtin_amdgcn_cosf(rev);
            const float x0 = v[2 * c][i], x1 = v[2 * c + 1][i];
            v[2 * c][i] = x0 * cs - x1 * sn;
            v[2 * c + 1][i] = x1 * cs + x0 * sn;
        }
    }
}
__device__ __forceinline__ void rope32_16(float (&a)[4], float (&b)[4], float rowp, float colp, int g4) {
    const bool hi = g4 >= 2;
#pragma unroll
    for (int i = 0; i < 4; ++i) {
        const float fr = __builtin_amdgcn_exp2f((float)(4 * (g4 & 1) + i) * -1.6609640474436813f) * 0.15915494309189535f;
        {
            const float rev = rowp * fr;
            const float sn = __builtin_amdgcn_sinf(rev), cs = __builtin_amdgcn_cosf(rev);
            const float own = a[i], oth = __shfl_xor(own, 32);
            a[i] = own * cs + oth * (hi ? sn : -sn);
        }
        {
            const float rev = colp * fr;
            const float sn = __builtin_amdgcn_sinf(rev), cs = __builtin_amdgcn_cosf(rev);
            const float own = b[i], oth = __shfl_xor(own, 32);
            b[i] = own * cs + oth * (hi ? sn : -sn);
        }
    }
}
__device__ __forceinline__ float ssq64(const float (&v)[4][4]) {
    float s = 0.f;
#pragma unroll
    for (int nt = 0; nt < 4; ++nt)
#pragma unroll
        for (int i = 0; i < 4; ++i) s += v[nt][i] * v[nt][i];
    s += __shfl_xor(s, 16);
    s += __shfl_xor(s, 32);
    return s;
}
__device__ __forceinline__ void mulvec64(float (&v)[4][4], const LAS float* gv, int g4) {
#pragma unroll
    for (int nt = 0; nt < 4; ++nt) {
        const f32x4 q = *(const LAS f32x4*)(gv + 16 * nt + 4 * g4);
#pragma unroll
        for (int i = 0; i < 4; ++i) v[nt][i] *= q[i];
    }
}
constexpr int OST_LD = 68, OST_BYTES = 32 * OST_LD * 4;
__device__ __forceinline__ void stage_write16(LAS float* st, const float (&v)[4][4], int mh, int c15, int g4) {
    asm volatile("s_waitcnt lgkmcnt(0)" ::: "memory");
    __builtin_amdgcn_wave_barrier();
#pragma unroll
    for (int nt = 0; nt < 4; ++nt) {
        f32x4 o = {v[nt][0], v[nt][1], v[nt][2], v[nt][3]};
        *(LAS f32x4*)(st + (16 * mh + c15) * OST_LD + 16 * nt + 4 * g4) = o;
    }
    asm volatile("s_waitcnt lgkmcnt(0)" ::: "memory");
    __builtin_amdgcn_wave_barrier();
}
__device__ __forceinline__ void stage_write16a(LAS float* st, const f32x4 (&a)[4][4], int mt, int c15, int g4) {
    asm volatile("s_waitcnt lgkmcnt(0)" ::: "memory");
    __builtin_amdgcn_wave_barrier();
#pragma unroll
    for (int nt = 0; nt < 4; ++nt) *(LAS f32x4*)(st + (16 * (mt & 1) + c15) * OST_LD + 16 * nt + 4 * g4) = a[nt][mt];
    asm volatile("s_waitcnt lgkmcnt(0)" ::: "memory");
    __builtin_amdgcn_wave_barrier();
}
__device__ __forceinline__ void stage_store_bf16(const LAS float* st, bf16_t* dst, int ld, float sc, int lane) {
#pragma unroll 1
    for (int it = 0; it < 4; ++it) {
        const int row = it * 8 + (lane >> 3), c8 = (lane & 7) * 8;
        const f32x4 x0 = *(const LAS f32x4*)(st + row * OST_LD + c8), x1 = *(const LAS f32x4*)(st + row * OST_LD + c8 + 4);
        u32x4 o; o.x = pk2(x0[0] * sc, x0[1] * sc); o.y = pk2(x0[2] * sc, x0[3] * sc); o.z = pk2(x1[0] * sc, x1[1] * sc); o.w = pk2(x1[2] * sc, x1[3] * sc);
        ST16_WT(dst + (size_t)row * ld + c8, o);
    }
}
__device__ __forceinline__ void stage_store_bf16_sc1(const LAS float* st, bf16_t* dst, int ld, int lane) {
#pragma unroll 1
    for (int it = 0; it < 4; ++it) {
        const int row = it * 8 + (lane >> 3), c8 = (lane & 7) * 8;
        const f32x4 x0 = *(const LAS f32x4*)(st + row * OST_LD + c8), x1 = *(const LAS f32x4*)(st + row * OST_LD + c8 + 4);
        u32x4 o; o.x = pk2(x0[0], x0[1]); o.y = pk2(x0[2], x0[3]); o.z = pk2(x1[0], x1[1]); o.w = pk2(x1[2], x1[3]);
        bf16_t* ptr = dst + (size_t)row * ld + c8;
        asm volatile("global_store_dwordx4 %0, %1, off sc1\n\ts_nop 1" :: "v"(ptr), "v"(o) : "memory");
    }
}
__device__ __forceinline__ void stage_store_f32(const LAS float* st, float* dst, int ld, int lane) {
#pragma unroll 1
    for (int it = 0; it < 8; ++it) {
        const int row = it * 4 + (lane >> 4), c = (lane & 15) * 4;
        { const f32x4 o = *(const LAS f32x4*)(st + row * OST_LD + c); ST16_WT(dst + (size_t)row * ld + c, o); }
    }
}
__device__ __forceinline__ void stage_store_bf16_32(const LAS float* st, bf16_t* dst, int ld, int lane) {
#pragma unroll 1
    for (int it = 0; it < 2; ++it) {
        const int row = it * 16 + (lane >> 2), c8 = (lane & 3) * 8;
        const f32x4 x0 = *(const LAS f32x4*)(st + row * OST_LD + c8), x1 = *(const LAS f32x4*)(st + row * OST_LD + c8 + 4);
        u32x4 o; o.x = pk2(x0[0], x0[1]); o.y = pk2(x0[2], x0[3]); o.z = pk2(x1[0], x1[1]); o.w = pk2(x1[2], x1[3]);
        ST16_WT(dst + (size_t)row * ld + c8, o);
    }
}
__device__ __forceinline__ void stage_store_f32_32(const LAS float* st, float* dst, int ld, int lane) {
#pragma unroll 1
    for (int it = 0; it < 4; ++it) {
        const int row = it * 8 + (lane >> 3), c = (lane & 7) * 4;
        { const f32x4 o = *(const LAS f32x4*)(st + row * OST_LD + c); ST16_WT(dst + (size_t)row * ld + c, o); }
    }
}

struct Gemm1Pre { float rstd[2]; float bias, gain; };
__device__ __forceinline__ void gemm1_pre(const Frame& F, const Params& p, int tn, int wn, int tm, int l, Gemm1Pre& P) {
    const float* ssqp = (const float*)(F.ws + WS_SSQ);
#pragma unroll
    for (int jj = 0; jj < 2; ++jj) {
        const int tok = tm * 256 + (F.w >> 2) * 128 + 64 * jj + F.lane;
        const f32x4* sp = (const f32x4*)(ssqp + (size_t)tok * 16);
        float ss = 0.f;
#pragma unroll
        for (int i = 0; i < 4; ++i) { const f32x4 q = sp[i]; ss += (q[0] + q[1]) + (q[2] + q[3]); }
        P.rstd[jj] = rsqrtf(ss * (1.f / 1024.f) + EPS);
    }
    const bool lat = tm >= 16;
    const int cond = lat ? 1 + ((tm - 16) >> 2) : 0;
    const int nb = tn * 128 + wn * 64;
    P.bias = (tn < 23) ? ((const float*)(F.ws + WS_BIAS))[(size_t)(l * 5 + cond) * 2944 + nb + F.lane] : 0.f;
    const float* gp = nullptr;
    if (tn >= 6 && tn < 9) gp = pin(F, I_GQN) + l * 64;
    else if (tn == 9) gp = pin(F, I_GKN) + l * 64;
    else if (tn == 11 || tn == 12) gp = pin(F, I_MQN) + l * 256 + (nb - 1408);
    else if (tn == 13) gp = pin(F, I_MKVN) + l * 128 + wn * 64;
    P.gain = gp ? gp[F.lane] : 1.f;
}
__device__ __forceinline__ void epi_gemm1(const Frame& F, const Params& p, GemmAcc8& acc, int tn, int wn, int tm, int l, const Gemm1Pre& P, bool ckv_tile) {
    int lane = F.lane; const int wm = F.w >> 2;
    asm volatile("" : "+v"(lane));
    const int c15 = lane & 15, g4 = lane >> 4;
    unsigned char* ws = F.ws;
    LAS float* st = (LAS float*)(F.lds + LDS_OST + F.w * OST_BYTES);
    const bool lat = tm >= 16;
    const int b = lat ? ((tm - 16) >> 2) : tm;
    const int nb = tn * 128 + wn * 64;
    LAS float* exb = (LAS float*)(F.lds + LDS_EXB) + F.w * 128;
    exb[lane] = P.bias; exb[64 + lane] = P.gain;
    asm volatile("s_waitcnt lgkmcnt(0)" ::: "memory");
    __builtin_amdgcn_wave_barrier();
    const LAS float* bias = exb;
    float* outp = p.out;
    float ckv_ss[8];
    if (tn < 23) {
#pragma unroll
    for (int mt = 0; mt < 8; ++mt) {
        const int mh = mt & 1;
        const int tok0 = tm * 256 + wm * 128 + (mt >> 1) * 32;
        const int tokb = tok0 + 16 * mh, tok = tokb + c15;
        const int t0 = lat ? ((tok0 - 4096) & 1023) : (tok0 & 255), t = t0 + 16 * mh + c15;
        const float rstd = __shfl(P.rstd[mt >> 2], 16 * (mt & 3) + c15);
        float v[4][4];
#pragma unroll
        for (int nt = 0; nt < 4; ++nt) {
            const f32x4 bq = *(const LAS f32x4*)(bias + 16 * nt + 4 * g4);
#pragma unroll
            for (int i = 0; i < 4; ++i) v[nt][i] = acc[nt][mt][i] * rstd + bq[i];
        }
        const float rowp = (float)(t >> 6), colp = (float)(t & 63);
        const size_t orow0 = (size_t)(b * 4 + l) * 256 + t0;
        if (tn < 2) {
            if (lat) rope64_16(v, rowp, colp, g4);
            stage_write16(st, v, mh, c15, g4);
            if (mh) stage_store_bf16(st, (bf16_t*)(ws + WS_RQ) + (size_t)tok0 * 256 + nb, 256, 1.f, lane);
        } else if (tn < 4) {
            if (lat) rope64_16(v, rowp, colp, g4);
            stage_write16(st, v, mh, c15, g4);
            if (mh) stage_store_bf16(st, (bf16_t*)(ws + WS_RK) + (size_t)tok0 * 256 + (nb - 256), 256, 0.125f, lane);
        } else if (tn < 6) {
            stage_write16(st, v, mh, c15, g4);
            if (mh) stage_store_bf16(st, (bf16_t*)(ws + WS_RV) + (size_t)tok0 * 256 + (nb - 512), 256, 1.f, lane);
        } else if (tn < 9) {
            const float r = rsqrtf(ssq64(v) * (1.f / 64.f) + EPS);
#pragma unroll
            for (int nt = 0; nt < 4; ++nt)
#pragma unroll
                for (int i = 0; i < 4; ++i) v[nt][i] *= r;
            mulvec64(v, exb + 64, g4);
            if (lat) rope64_16(v, rowp, colp, g4);
            stage_write16(st, v, mh, c15, g4);
            if (mh) stage_store_bf16(st, (bf16_t*)(ws + WS_GQ) + (size_t)tok0 * 384 + (nb - 768), 384, QSC_GQA, lane);
        } else if (tn == 9) {
            const float r = rsqrtf(ssq64(v) * (1.f / 64.f) + EPS);
#pragma unroll
            for (int nt = 0; nt < 4; ++nt)
#pragma unroll
                for (int i = 0; i < 4; ++i) v[nt][i] *= r;
            mulvec64(v, exb + 64, g4);
            if (lat) rope64_16(v, rowp, colp, g4);
            stage_write16(st, v, mh, c15, g4);
            if (mh) {
                if (!lat) stage_store_f32(st, outp + O_GK + orow0 * 128 + (nb - 1152), 128, lane);
                stage_store_bf16(st, (bf16_t*)(ws + WS_GK) + (size_t)tok0 * 128 + (nb - 1152), 128, 1.f, lane);
            }
        } else if (tn == 10) {
            stage_write16(st, v, mh, c15, g4);
            if (mh) {
                if (!lat) stage_store_f32(st, outp + O_GV + orow0 * 128 + (nb - 1280), 128, lane);
                stage_store_bf16(st, (bf16_t*)(ws + WS_GV) + (size_t)tok0 * 128 + (nb - 1280), 128, 1.f, lane);
            }
        } else if (tn < 13) {
            const float s2 = ssq64(v);
            if (g4 == 0) __hip_atomic_store((__attribute__((address_space(1))) float*)((float*)(ws + WS_CQSSQ) + (size_t)tok * 4 + ((nb - 1408) >> 6)), s2, __ATOMIC_RELAXED, __HIP_MEMORY_SCOPE_AGENT);
            mulvec64(v, exb + 64, g4);
            stage_write16(st, v, mh, c15, g4);
            if (mh) stage_store_bf16_sc1(st, (bf16_t*)(ws + WS_CQG) + (size_t)tok0 * 256 + (nb - 1408), 256, lane);
        } else if (tn == 13) {
            ckv_ss[mt] = ssq64(v);
            if (g4 == 0) ((LAS float*)(F.lds + LDS_EX))[(wm * 2 + wn) * 128 + mt * 16 + c15] = ckv_ss[mt];
        } else if (tn < 22) {
#pragma unroll
            for (int nt = 0; nt < 4; ++nt)
#pragma unroll
                for (int i = 0; i < 4; ++i) v[nt][i] = silu_f(v[nt][i]);
            stage_write16(st, v, mh, c15, g4);
            if (mh) stage_store_bf16(st, (bf16_t*)(ws + WS_ZS) + (size_t)tok0 * 1024 + (nb - 1792), 1024, 1.f, lane);
        } else {
            if (wn == 0) {
                if (lat) rope32_16(v[0], v[1], rowp, colp, g4);
                stage_write16(st, v, mh, c15, g4);
                if (mh) {
                    if (!lat) stage_store_f32_32(st, outp + O_KPE + orow0 * 32, 32, lane);
                    stage_store_bf16_32(st, (bf16_t*)(ws + WS_KPEB) + (size_t)tok0 * 32, 32, lane);
                }
            }
        }
    }
    }
    if (ckv_tile) {
        __syncthreads();
        if (tn == 13) {
#pragma unroll
        for (int mt = 0; mt < 8; ++mt) {
            const int mh = mt & 1;
            const int tok0 = tm * 256 + wm * 128 + (mt >> 1) * 32;
            const int t0 = lat ? ((tok0 - 4096) & 1023) : (tok0 & 255);
            const float rstd = __shfl(P.rstd[mt >> 2], 16 * (mt & 3) + c15);
            float v[4][4];
#pragma unroll
            for (int nt = 0; nt < 4; ++nt) {
                const f32x4 bq = *(const LAS f32x4*)(bias + 16 * nt + 4 * g4);
#pragma unroll
                for (int i = 0; i < 4; ++i) v[nt][i] = acc[nt][mt][i] * rstd + bq[i];
            }
            const float tot = ckv_ss[mt] + ((const LAS float*)(F.lds + LDS_EX))[(wm * 2 + (wn ^ 1)) * 128 + mt * 16 + c15];
            const float r = rsqrtf(tot * (1.f / 128.f) + EPS);
#pragma unroll
            for (int nt = 0; nt < 4; ++nt)
#pragma unroll
                for (int i = 0; i < 4; ++i) v[nt][i] *= r;
            mulvec64(v, exb + 64, g4);
            const size_t orow0 = (size_t)(b * 4 + l) * 256 + t0;
            stage_write16(st, v, mh, c15, g4);
            if (mh) {
                if (!lat) stage_store_f32(st, outp + O_CKV + orow0 * 128 + wn * 64, 128, lane);
                stage_store_bf16_sc1(st, (bf16_t*)(ws + WS_CKVN) + (size_t)tok0 * 128 + wn * 64, 128, lane);
            }
        }
        }
        __syncthreads();
    }
}

__device__ __forceinline__ void qm_pre(const Frame& F, int tm, float& rstd) {
    const int tok = tm * 256 + (F.w >> 1) * 64 + F.lane;
    const f32x4 q4 = *(const f32x4*)((const float*)(F.ws + WS_CQSSQ) + (size_t)tok * 4);
    rstd = rsqrtf(((q4[0] + q4[1]) + (q4[2] + q4[3])) * (1.f / 256.f) + EPS);
}
__device__ __forceinline__ void epi_qm(const Frame& F, GemmAcc& acc, int tn, int tm, float rstdl) {
    int lane = F.lane; const int wn = F.w & 1, wm = F.w >> 1;
    asm volatile("" : "+v"(lane));
    const int c15 = lane & 15, g4 = lane >> 4;
    unsigned char* ws = F.ws;
    LAS float* st = (LAS float*)(F.lds + LDS_OST + F.w * OST_BYTES);
    const bool lat = tm >= 16;
    const int nb = tn * 128 + wn * 64;
    if (nb >= 576) return;
#pragma unroll
    for (int mt = 0; mt < 4; ++mt) {
        const int mh = mt & 1;
        const int tok0 = tm * 256 + wm * 64 + (mt >> 1) * 32, tok = tok0 + 16 * mh + c15;
        const int t = lat ? ((tok - 4096) & 1023) : (tok & 255);
        const float rstd = __shfl(rstdl, 16 * mt + c15);
        const float rowp = (float)(t >> 6), colp = (float)(t & 63);
        float v[4][4];
#pragma unroll
        for (int nt = 0; nt < 4; ++nt)
#pragma unroll
            for (int i = 0; i < 4; ++i) v[nt][i] = acc[nt][mt][i] * rstd;
#pragma unroll
        for (int q = 0; q < 2; ++q) {
            const int T = (nb + 32 * q) >> 5;
            if (lat && (T % 3) == 2) rope32_16(v[2 * q], v[2 * q + 1], rowp, colp, g4);
        }
        stage_write16(st, v, mh, c15, g4);
        if (mh) stage_store_bf16(st, (bf16_t*)(ws + WS_QM) + (size_t)tok0 * 576 + nb, 576, QSC_MLA, lane);
    }
}
__device__ __forceinline__ void epi_plain(const Frame& F, GemmAcc& acc, bf16_t* D, int ldd, int row0, int n0) {
    int lane = F.lane; const int wn = F.w & 1, wm = F.w >> 1;
    asm volatile("" : "+v"(lane));
    const int c15 = lane & 15, g4 = lane >> 4;
    LAS float* st = (LAS float*)(F.lds + LDS_OST + F.w * OST_BYTES);
#pragma unroll
    for (int mt = 0; mt < 4; ++mt) {
        const int r0 = row0 + wm * 64 + (mt >> 1) * 32;
        stage_write16a(st, acc, mt, c15, g4);
        if (mt & 1) stage_store_bf16(st, D + (size_t)r0 * ldd + n0 + wn * 64, ldd, 1.f, lane);
    }
}

struct Gemm2Pre { f32x4 gt0, gt1, gs0, gs1; };
__device__ __forceinline__ void gemm2_pre(const Frame& F, int tn, int tm, int l, Gemm2Pre& P) {
    const bool lat = tm >= 16; const int cond = lat ? 1 + ((tm - 16) >> 2) : 0;
    const int nb = tn * 128 + (F.w & 1) * 64, c8 = (F.lane & 7) * 8;
    const float* gtp = (const float*)(F.ws + WS_MODS) + (size_t)(l * 5 + cond) * 3072 + 2048 + nb + c8;
    const float* gsp = (const float*)(F.ws + WS_GS) + (size_t)((l < 3 ? l + 1 : 3) * 5 + cond) * 1024 + nb + c8;
    P.gt0 = *(const f32x4*)gtp; P.gt1 = *(const f32x4*)(gtp + 4);
    P.gs0 = *(const f32x4*)gsp; P.gs1 = *(const f32x4*)(gsp + 4);
}
__device__ __forceinline__ void epi_gemm2(const Frame& F, const Params& p, GemmAcc& acc, int tn, int tm, int l, const Gemm2Pre& P) {
    int lane = F.lane; const int wn = F.w & 1, wm = F.w >> 1;
    asm volatile("" : "+v"(lane));
    const int c15 = lane & 15, g4 = lane >> 4;
    unsigned char* ws = F.ws;
    LAS float* st = (LAS float*)(F.lds + LDS_OST + F.w * OST_BYTES);
    const bool lat = tm >= 16;
    const int nb = tn * 128 + wn * 64;
    const int c8 = (lane & 7) * 8, r8 = lane >> 3;
#pragma unroll
    for (int mt = 0; mt < 2; ++mt) {
        const int tok0 = tm * 256 + wm * 64 + mt * 32;
        stage_write16a(st, acc, 2 * mt, c15, g4);
        stage_write16a(st, acc, 2 * mt + 1, c15, g4);
        bf16_t* xb0 = (bf16_t*)(ws + WS_XB) + (size_t)tok0 * 1024 + nb + c8;
        f32x4 xo8[8];
        if (l == 0) {
            const float* xold0 = lat ? pin(F, I_XS) + (size_t)(tok0 - 4096) * 1024 : pin(F, I_XP) + (size_t)tok0 * 1024;
#pragma unroll
            for (int it = 0; it < 4; ++it) {
                const float* xp = xold0 + (size_t)(it * 8 + r8) * 1024 + nb + c8;
                xo8[2 * it] = *(const f32x4*)xp; xo8[2 * it + 1] = *(const f32x4*)(xp + 4);
            }
        } else {
#pragma unroll
            for (int it = 0; it < 4; ++it) {
                const u32x4 q = *(const u32x4*)(xb0 + (size_t)(it * 8 + r8) * 1024);
                xo8[2 * it] = (f32x4){bflo(q.x), bfhi(q.x), bflo(q.y), bfhi(q.y)}; xo8[2 * it + 1] = (f32x4){bflo(q.z), bfhi(q.z), bflo(q.w), bfhi(q.w)};
            }
        }
#pragma unroll
        for (int it = 0; it < 4; ++it) {
            const int row = it * 8 + r8;
            const f32x4 a0 = *(const LAS f32x4*)(st + row * OST_LD + c8), a1 = *(const LAS f32x4*)(st + row * OST_LD + c8 + 4);
            const f32x4 xn0 = xo8[2 * it] + P.gt0 * a0, xn1 = xo8[2 * it + 1] + P.gt1 * a1;
            {
                u32x4 o; o.x = pk2(xn0[0], xn0[1]); o.y = pk2(xn0[2], xn0[3]); o.z = pk2(xn1[0], xn1[1]); o.w = pk2(xn1[2], xn1[3]);
                *(u32x4*)(xb0 + (size_t)row * 1024) = o;
            }
            float ss = ((xn0[0] * xn0[0] + xn0[1] * xn0[1]) + (xn0[2] * xn0[2] + xn0[3] * xn0[3])) + ((xn1[0] * xn1[0] + xn1[1] * xn1[1]) + (xn1[2] * xn1[2] + xn1[3] * xn1[3]));
            ss += __shfl_xor(ss, 1); ss += __shfl_xor(ss, 2); ss += __shfl_xor(ss, 4);
            if ((lane & 7) == 0) ((float*)(ws + WS_SSQ))[(size_t)(tok0 + row) * 16 + tn * 2 + wn] = ss;
            if (l < 3) {
                u32x4 o; o.x = pk2(xn0[0] * P.gs0[0], xn0[1] * P.gs0[1]); o.y = pk2(xn0[2] * P.gs0[2], xn0[3] * P.gs0[3]);
                o.z = pk2(xn1[0] * P.gs1[0], xn1[1] * P.gs1[1]); o.w = pk2(xn1[2] * P.gs1[2], xn1[3] * P.gs1[3]);
                *(u32x4*)((bf16_t*)(ws + WS_XG) + (size_t)(tok0 + row) * 1024 + nb + c8) = o;
            }
        }
    }
}
constexpr int AT_STG = 20480, AT_PE = 8192, AT_V = 12288, AT_OLD = 68;
struct AttnUnit {
    int mode;
    int nt0, nt1;
    const bf16_t *q; int q_ld;
    const bf16_t *k0, *k1; int k_ld0, k_ld1;
    const bf16_t *pe0, *pe1;
    const bf16_t *v0, *v1; int v_ld0, v_ld1;
    int tok0;
    int ycol;
    int qpos0, L;
    float lf, lb;
    const bf16_t *s0f, *s0b;
    unsigned* yflag;
    float* st_out;
};
__device__ __forceinline__ s16x4 tr16(LAS const unsigned char* p) {
    typedef short v4i16_t __attribute__((ext_vector_type(4)));
    return __builtin_bit_cast(s16x4, __builtin_amdgcn_ds_read_tr16_b64_v4i16((LAS v4i16_t*)p));
}

template <int MODE>
__device__ __forceinline__ void attn_unit(const Frame& F, const Params& p, const AttnUnit& U) {
    constexpr int NQS = MODE == 1 ? 6 : 4;
    const int lane = F.lane, w = F.w, h = F.h, lq = F.lq;
    LAS unsigned char* lds = F.lds;
    const int k_ld = U.k_ld1, v_ld = U.v_ld1;
    const int krow = 8 * w + (lane >> 3);
    const int koff = krow * k_ld + ((lane & 7) ^ ((krow >> 1) & 7)) * 8;
    const int poff = (16 * (w & 3) + (lane >> 2)) * 32 + ((lane & 3) ^ ((lane >> 4) & 3)) * 8;
    const int vdblk = w >> 2, vkg = w & 3;
    const int voff = (16 * vkg + (lane >> 2)) * v_ld + vdblk * 32 + (lane & 3) * 8;
    const int vdst = AT_V + vdblk * 4096 + vkg * 1024;
    const int nt0 = U.nt0, ntot = U.nt0 + U.nt1;
    const unsigned ldsb = (unsigned)(uintptr_t)lds;
#define AT_DMA(gsrc, ldsoff) do { unsigned _keep; const unsigned _d = (unsigned)__builtin_amdgcn_readfirstlane((int)(ldsb + (unsigned)(ldsoff))); \
        asm volatile("s_mov_b32 %0, m0\n\ts_mov_b32 m0, %2\n\ts_nop 0\n\tglobal_load_lds_dwordx4 %1, off\n\ts_mov_b32 m0, %0" : "=&s"(_keep) : "v"(gsrc), "s"(_d) : "memory"); } while (0)
#define AT_ISSUE(t, st) do { const int _t = (t); const int _b = (st) * AT_STG; \
        const bool _s0 = _t < nt0; const int _u = _s0 ? _t : _t - nt0; \
        const bf16_t* _kb = (_s0 ? U.k0 : U.k1) + (size_t)_u * 64 * k_ld; const bf16_t* _vb = (_s0 ? U.v0 : U.v1) + (size_t)_u * 64 * v_ld; \
        AT_DMA(_kb + koff, _b + (8 * w) * 128); \
        if (MODE == 1) { const bf16_t* _pb = (_s0 ? U.pe0 : U.pe1) + (size_t)_u * 64 * 32; AT_DMA(_pb + poff, _b + AT_PE + 16 * (w & 3) * 64); } \
        AT_DMA(_vb + voff, _b + vdst); } while (0)
    AT_ISSUE(0, 0);
    if (ntot > 1) AT_ISSUE(1, 1);
    bf16x8 qr[NQS];
    if (MODE == 3) {
        const int dk = 32 * (w & 1) + lq;
#pragma unroll
        for (int s = 0; s < 4; ++s)
#pragma unroll
            for (int j = 0; j < 8; ++j) qr[s][j] = (16 * s + 8 * h + j == dk) ? (short)0x3F80 : (short)0;
    } else {
        const bf16_t* qp = U.q + (size_t)(32 * w + lq) * U.q_ld + 8 * h;
#pragma unroll
        for (int s = 0; s < NQS; ++s) qr[s] = *(const bf16x8*)(qp + 16 * s);
    }
    f32x16 o[2];
#pragma unroll
    for (int d = 0; d < 2; ++d)
#pragma unroll
        for (int r = 0; r < 16; ++r) o[d][r] = 0.f;
    float m_run = 0.f, l_run = 0.f;
    f32x16 negm;
#pragma unroll
    for (int r = 0; r < 16; ++r) negm[r] = 0.f;
    const int qpos = U.qpos0 + 32 * w + lq;
    const float st_slope = ((w >> 1) & 1) ? U.lb : -U.lf, st_off = ((w >> 1) & 1) ? 0.f : 255.f * U.lf;
    const int sdir = (w >> 1) & 1;
    LAS float* scal = (LAS float*)(lds + LDS_SCAL) + w * 32;
    LAS float* ctab = (LAS float*)(lds + LDS_EXB) + w * 128;
    float a_f = 0.f, a_b = 0.f;
    if (MODE == 2) {
        ctab[lane] = __builtin_amdgcn_exp2f((float)(63 - lane) * U.lf);
        ctab[64 + lane] = __builtin_amdgcn_exp2f((float)lane * U.lb);
        a_f = __builtin_amdgcn_exp2f((float)(32 * w + lq) * U.lf);
        a_b = __builtin_amdgcn_exp2f((float)(255 - 32 * w - lq) * U.lb);
        asm volatile("s_waitcnt lgkmcnt(0)" ::: "memory");
        __builtin_amdgcn_wave_barrier();
    }
    const int kfo = lq * 128, sw = (lane >> 1) & 7, pfo = AT_PE + lq * 64, psw = (lane >> 2) & 3;
    const int vfo = AT_V + (4 * h + ((lane & 15) >> 2)) * 64 + ((lane >> 4) & 1) * 32 + (lane & 3) * 8;
    int st = 0;
    for (int t = 0; t < ntot; ++t) {
        if (t + 1 < ntot) { if (MODE == 1) asm volatile("s_waitcnt vmcnt(3)" ::: "memory"); else asm volatile("s_waitcnt vmcnt(2)" ::: "memory"); }
        else asm volatile("s_waitcnt vmcnt(0)" ::: "memory");
        __builtin_amdgcn_s_barrier();
        asm volatile("" ::: "memory");
        const int st2 = st == 0 ? 2 : st - 1;
        if (t + 2 < ntot) AT_ISSUE(t + 2, st2);
        LAS const unsigned char* base = lds + st * AT_STG;
        bf16x8 kfa[NQS], kfb[NQS];
#pragma unroll
        for (int s = 0; s < 4; ++s) {
            const int so = ((2 * s + h) ^ sw) << 4;
            kfa[s] = *(const LAS bf16x8*)(base + kfo + so);
            kfb[s] = *(const LAS bf16x8*)(base + kfo + 4096 + so);
        }
        if (MODE == 1) {
#pragma unroll
            for (int s = 0; s < 2; ++s) {
                const int so = ((2 * s + h) ^ psw) << 4;
                kfa[4 + s] = *(const LAS bf16x8*)(base + pfo + so);
                kfb[4 + s] = *(const LAS bf16x8*)(base + pfo + 2048 + so);
            }
        }
        f32x16 p0, p1;
        if (MODE <= 1) { p0 = negm; p1 = negm; }
        else {
#pragma unroll
            for (int r = 0; r < 16; ++r) { p0[r] = 0.f; p1[r] = 0.f; }
        }
#pragma unroll
        for (int s = 0; s < NQS; ++s) { p0 = MFMA32(kfa[s], qr[s], p0); p1 = MFMA32(kfb[s], qr[s], p1); }
        s16x4 vlo[4], vhi[4];
#pragma unroll
        for (int ks = 0; ks < 4; ++ks) { vlo[ks] = tr16(base + vfo + ks * 1024); vhi[ks] = tr16(base + vfo + ks * 1024 + 512); }
        if (MODE <= 1) {
            float tm = p0[0];
#pragma unroll
            for (int r = 1; r < 16; ++r) tm = fmaxf(tm, p0[r]);
#pragma unroll
            for (int r = 0; r < 16; ++r) tm = fmaxf(tm, p1[r]);
            tm = fmaxf(tm, __shfl_xor(tm, 32));
            if (t == 0 || __any(tm > 6.0f)) {
                const float dl = t == 0 ? tm : fmaxf(tm, 0.f);
                m_run += dl;
#pragma unroll
                for (int r = 0; r < 16; ++r) { p0[r] -= dl; p1[r] -= dl; negm[r] = -m_run; }
                if (t > 0) {
                    const float alpha = __builtin_amdgcn_exp2f(-dl);
                    l_run *= alpha;
                    if (h == 0) scal[lq] = alpha;
                    asm volatile("s_waitcnt lgkmcnt(0)" ::: "memory");
#pragma unroll
                    for (int g = 0; g < 4; ++g) {
                        const f32x4 a4 = *(const LAS f32x4*)(scal + 8 * g + 4 * h);
#pragma unroll
                        for (int i = 0; i < 4; ++i) { o[0][4 * g + i] *= a4[i]; o[1][4 * g + i] *= a4[i]; }
                    }
                }
            }
            float ls = 0.f;
#pragma unroll
            for (int r = 0; r < 16; ++r) { p0[r] = __builtin_amdgcn_exp2f(p0[r]); p1[r] = __builtin_amdgcn_exp2f(p1[r]); ls += p0[r] + p1[r]; }
            l_run += ls;
        } else if (MODE == 2 && (64 * t + 63 < U.qpos0 || 64 * t > U.qpos0 + 255)) {
            const bool fwd = 64 * t + 63 < U.qpos0;
            const float A = fwd ? a_f * __builtin_amdgcn_exp2f((float)(U.qpos0 - 64 * t - 63) * U.lf) : a_b * __builtin_amdgcn_exp2f((float)(64 * t - U.qpos0 - 255) * U.lb);
            const LAS float* tb = ctab + (fwd ? 0 : 64) + 4 * h;
#pragma unroll
            for (int g = 0; g < 4; ++g) {
                const f32x4 c0 = *(const LAS f32x4*)(tb + 8 * g), c1 = *(const LAS f32x4*)(tb + 32 + 8 * g);
#pragma unroll
                for (int i = 0; i < 4; ++i) { p0[4 * g + i] *= c0[i] * A; p1[4 * g + i] *= c1[i] * A; }
            }
        } else if (MODE == 2) {
            float dq = (float)(qpos - 64 * t - 4 * h);
            asm volatile("" : "+v"(dq));
#pragma unroll
            for (int r = 0; r < 16; ++r) {
                const float d0 = dq - (float)((r & 3) + 8 * (r >> 2)), d1 = d0 - 32.f;
                const float w0 = __builtin_amdgcn_exp2f(fabsf(d0) * (d0 > 0.f ? U.lf : U.lb));
                const float w1 = __builtin_amdgcn_exp2f(fabsf(d1) * (d1 > 0.f ? U.lf : U.lb));
                p0[r] *= (d0 == 0.f ? 2.f : w0);
                p1[r] *= (d1 == 0.f ? 2.f : w1);
            }
        } else {
            float mb = (float)(64 * t + 4 * h);
            asm volatile("" : "+v"(mb));
#pragma unroll
            for (int r = 0; r < 16; ++r) {
                const float m0 = mb + (float)((r & 3) + 8 * (r >> 2)), m1 = m0 + 32.f;
                const float e0 = fmaf(m0, st_slope, st_off), e1 = fmaf(m1, st_slope, st_off);
                p0[r] *= __builtin_amdgcn_exp2f(e0);
                p1[r] *= __builtin_amdgcn_exp2f(e1);
            }
        }
        bf16x8 pa[4];
        { u32x4 a;
          a.x = pk2(p0[0], p0[1]); a.y = pk2(p0[2], p0[3]); a.z = pk2(p0[4], p0[5]); a.w = pk2(p0[6], p0[7]); pa[0] = __builtin_bit_cast(bf16x8, a);
          a.x = pk2(p0[8], p0[9]); a.y = pk2(p0[10], p0[11]); a.z = pk2(p0[12], p0[13]); a.w = pk2(p0[14], p0[15]); pa[1] = __builtin_bit_cast(bf16x8, a);
          a.x = pk2(p1[0], p1[1]); a.y = pk2(p1[2], p1[3]); a.z = pk2(p1[4], p1[5]); a.w = pk2(p1[6], p1[7]); pa[2] = __builtin_bit_cast(bf16x8, a);
          a.x = pk2(p1[8], p1[9]); a.y = pk2(p1[10], p1[11]); a.z = pk2(p1[12], p1[13]); a.w = pk2(p1[14], p1[15]); pa[3] = __builtin_bit_cast(bf16x8, a); }
#pragma unroll
        for (int ks = 0; ks < 4; ++ks) {
            const bf16x8 vb = __builtin_shufflevector(vlo[ks], vhi[ks], 0, 1, 2, 3, 4, 5, 6, 7);
            o[0] = MFMA32(pa[ks], vb, o[0]);
        }
#pragma unroll
        for (int ks = 0; ks < 4; ++ks) { vlo[ks] = tr16(base + vfo + 4096 + ks * 1024); vhi[ks] = tr16(base + vfo + 4096 + ks * 1024 + 512); }
#pragma unroll
        for (int ks = 0; ks < 4; ++ks) {
            const bf16x8 vb = __builtin_shufflevector(vlo[ks], vhi[ks], 0, 1, 2, 3, 4, 5, 6, 7);
            o[1] = MFMA32(pa[ks], vb, o[1]);
        }
        st = st == 2 ? 0 : st + 1;
    }
#undef AT_ISSUE
#undef AT_DMA
    int lq2 = lq, h2 = h, lane2 = lane; asm volatile("" : "+v"(lq2), "+v"(h2), "+v"(lane2));
    if (MODE == 2 && U.s0f != nullptr) {
        const float ff = __builtin_amdgcn_exp2f((float)(qpos + 1) * U.lf), fb = __builtin_amdgcn_exp2f((float)(U.L - qpos) * U.lb);
#pragma unroll
        for (int s = 0; s < 4; ++s) {
            const u32x4 qu = __builtin_bit_cast(u32x4, qr[s]);
            u32x4 af, ab;
#pragma unroll
            for (int i = 0; i < 4; ++i) { const float lo = bflo(qu[i]), hi = bfhi(qu[i]); af[i] = pk2(lo * ff, hi * ff); ab[i] = pk2(lo * fb, hi * fb); }
#pragma unroll
            for (int d = 0; d < 2; ++d) {
                const bf16x8 sf = *(const bf16x8*)(U.s0f + (size_t)(32 * d + lq2) * 64 + 16 * s + 8 * h2);
                const bf16x8 sb = *(const bf16x8*)(U.s0b + (size_t)(32 * d + lq2) * 64 + 16 * s + 8 * h2);
                o[d] = MFMA32(__builtin_bit_cast(bf16x8, af), sf, o[d]);
                o[d] = MFMA32(__builtin_bit_cast(bf16x8, ab), sb, o[d]);
            }
        }
    }
    if (MODE == 3) {
        float* dst = U.st_out + (size_t)sdir * 4 * 4096 + (size_t)(32 * (w & 1)) * 64;
        if (w < 4) {
#pragma unroll
        for (int d = 0; d < 2; ++d)
#pragma unroll
            for (int r = 0; r < 16; ++r) dst[(size_t)((r & 3) + 8 * (r >> 2) + 4 * h2) * 64 + 32 * d + lq2] = o[d][r];
        }
        __syncthreads();
        return;
    }
    if (MODE <= 1) {
        l_run += __shfl_xor(l_run, 32);
        if (h2 == 0) scal[lq2] = 1.f / l_run;
    }
    __syncthreads();
    LAS float* ost = (LAS float*)lds + w * (32 * AT_OLD);
#pragma unroll
    for (int d = 0; d < 2; ++d)
#pragma unroll
        for (int r = 0; r < 16; ++r) ost[((r & 3) + 8 * (r >> 2) + 4 * h2) * AT_OLD + 32 * d + lq2] = o[d][r];
    asm volatile("s_waitcnt lgkmcnt(0)" ::: "memory");
    __builtin_amdgcn_wave_barrier();
    const bf16_t* zs = (const bf16_t*)(F.ws + WS_ZS);
    bf16_t* yb = (bf16_t*)(F.ws + WS_Y);
#pragma unroll
    for (int it = 0; it < 4; ++it) {
        const int row = it * 8 + (lane2 >> 3), c8 = (lane2 & 7) * 8;
        const f32x4 x0 = *(const LAS f32x4*)(ost + row * AT_OLD + c8), x1 = *(const LAS f32x4*)(ost + row * AT_OLD + c8 + 4);
        float sc;
        if (MODE <= 1) sc = scal[row];
        else {
            float ss = (x0[0] * x0[0] + x0[1] * x0[1]) + (x0[2] * x0[2] + x0[3] * x0[3]) + (x1[0] * x1[0] + x1[1] * x1[1]) + (x1[2] * x1[2] + x1[3] * x1[3]);
            ss += __shfl_xor(ss, 1); ss += __shfl_xor(ss, 2); ss += __shfl_xor(ss, 4);
            sc = rsqrtf(ss * (1.f / 64.f) + EPS);
        }
        const size_t off = (size_t)(U.tok0 + 32 * w + row) * 1024 + U.ycol + c8;
        const u32x4 z = *(const u32x4*)(zs + off);
        u32x4 y;
        y.x = pk2(x0[0] * sc * bflo(z.x), x0[1] * sc * bfhi(z.x));
        y.y = pk2(x0[2] * sc * bflo(z.y), x0[3] * sc * bfhi(z.y));
        y.z = pk2(x1[0] * sc * bflo(z.z), x1[1] * sc * bfhi(z.z));
        y.w = pk2(x1[2] * sc * bflo(z.w), x1[3] * sc * bfhi(z.w));
        ST16_WT(yb + off, y);
    }
    asm volatile("s_waitcnt vmcnt(0)" ::: "memory");
    __syncthreads();
    if (F.tid == 0) (void)xb_add(U.yflag, 1u);
}

__device__ __forceinline__ void attn_dispatch(const Frame& F, const Params& p, int u, int l) {
    unsigned char* ws = F.ws;
    AttnUnit U;
    U.nt0 = 0; U.nt1 = 0; U.q = nullptr; U.q_ld = 0; U.k0 = U.k1 = nullptr; U.k_ld0 = U.k_ld1 = 0; U.pe0 = U.pe1 = nullptr; U.v0 = U.v1 = nullptr; U.v_ld0 = U.v_ld1 = 0;
    U.tok0 = 0; U.ycol = 0; U.qpos0 = 0; U.L = 0; U.lf = U.lb = 0.f; U.s0f = U.s0b = nullptr; U.st_out = nullptr; U.mode = 0; U.yflag = nullptr;
    const bf16_t* GQ = (const bf16_t*)(ws + WS_GQ); const bf16_t* GK = (const bf16_t*)(ws + WS_GK); const bf16_t* GV = (const bf16_t*)(ws + WS_GV);
    const bf16_t* QM = (const bf16_t*)(ws + WS_QM); const bf16_t* KVM = (const bf16_t*)(ws + WS_KVM); const bf16_t* KVMC = (const bf16_t*)(ws + WS_KVMC);
    const bf16_t* KPEB = (const bf16_t*)(ws + WS_KPEB); const bf16_t* CKPE = (const bf16_t*)(ws + WS_CKPE);
    const bf16_t* CGK = (const bf16_t*)(ws + WS_CGK); const bf16_t* CGV = (const bf16_t*)(ws + WS_CGV);
    const bf16_t* RQ = (const bf16_t*)(ws + WS_RQ); const bf16_t* RK = (const bf16_t*)(ws + WS_RK); const bf16_t* RV = (const bf16_t*)(ws + WS_RV);
    const float* decay = pin(F, I_DECAY) + l * 8;
    if (u < 96 || (u >= 256 && u < 352)) {
        const bool lat = u < 96; const int uu = lat ? u : u - 256;
        const int b = lat ? uu / 24 : uu / 6, hh = lat ? (uu >> 2) % 6 : uu % 6, qb = lat ? (uu & 3) : 0;
        const int seq0 = lat ? 4096 + b * 1024 : b * 256;
        U.mode = 1; U.tok0 = seq0 + qb * 256; U.q = QM + (size_t)U.tok0 * 576 + hh * 96; U.q_ld = 576; U.ycol = 640 + hh * 64;
        U.nt1 = lat ? 16 : 4; U.k1 = KVM + (size_t)seq0 * 768 + hh * 128; U.k_ld1 = 768; U.v1 = U.k1 + 64; U.v_ld1 = 768; U.pe1 = KPEB + (size_t)seq0 * 32;
        U.k0 = U.k1; U.v0 = U.v1; U.pe0 = U.pe1; U.k_ld0 = 768; U.v_ld0 = 768;
        if (lat) { U.nt0 = 8; U.k0 = KVMC + (size_t)(b * 512) * 768 + hh * 128; U.v0 = U.k0 + 64; U.pe0 = CKPE + (size_t)((b * 4 + l) * 512) * 32; }
        U.yflag = (unsigned*)(ws + WS_CTL) + CW_YRDY + (l * 32 + (U.tok0 >> 8)) * 4;
        attn_unit<1>(F, p, U);
    } else if (u < 192 || (u >= 352 && u < 448)) {
        const bool lat = u < 192; const int uu = lat ? u - 96 : u - 352;
        const int b = lat ? uu / 24 : uu / 6, hh = lat ? (uu >> 2) % 6 : uu % 6, qb = lat ? (uu & 3) : 0, kvh = hh / 3;
        const int seq0 = lat ? 4096 + b * 1024 : b * 256;
        U.mode = 0; U.tok0 = seq0 + qb * 256; U.q = GQ + (size_t)U.tok0 * 384 + hh * 64; U.q_ld = 384; U.ycol = 256 + hh * 64;
        U.nt1 = lat ? 16 : 4; U.k1 = GK + (size_t)seq0 * 128 + kvh * 64; U.k_ld1 = 128; U.v1 = GV + (size_t)seq0 * 128 + kvh * 64; U.v_ld1 = 128;
        U.k0 = U.k1; U.v0 = U.v1; U.k_ld0 = 128; U.v_ld0 = 128;
        if (lat) { U.nt0 = 8; U.k0 = CGK + (size_t)((b * 4 + l) * 512) * 128 + kvh * 64; U.v0 = CGV + (size_t)((b * 4 + l) * 512) * 128 + kvh * 64; }
        U.yflag = (unsigned*)(ws + WS_CTL) + CW_YRDY + (l * 32 + (U.tok0 >> 8)) * 4;
        attn_unit<0>(F, p, U);
    } else if (u < 256 || (u >= 448 && u < 512)) {
        const bool lat = u < 256; const int uu = lat ? u - 192 : u - 448;
        const int b = lat ? uu / 16 : uu / 4, hh = lat ? (uu >> 2) & 3 : uu & 3, qb = lat ? (uu & 3) : 0;
        const int seq0 = lat ? 4096 + b * 1024 : b * 256;
        U.mode = 2; U.tok0 = seq0 + qb * 256; U.q = RQ + (size_t)U.tok0 * 256 + hh * 64; U.q_ld = 256; U.ycol = hh * 64;
        U.nt1 = lat ? 16 : 4; U.k1 = RK + (size_t)seq0 * 256 + hh * 64; U.k_ld1 = 256; U.v1 = RV + (size_t)seq0 * 256 + hh * 64; U.v_ld1 = 256;
        U.k0 = U.k1; U.v0 = U.v1; U.k_ld0 = 256; U.v_ld0 = 256;
        U.qpos0 = qb * 256; U.L = lat ? 1024 : 256;
        U.lf = -log1pf(__expf(-decay[hh])) * LOG2E; U.lb = -log1pf(__expf(-decay[4 + hh])) * LOG2E;
        if (lat) { const bf16_t* S0T = (const bf16_t*)(ws + WS_S0T); U.s0f = S0T + (size_t)(((b * 4 + l) * 2 + 0) * 4 + hh) * 4096; U.s0b = S0T + (size_t)(((b * 4 + l) * 2 + 1) * 4 + hh) * 4096; }
        U.yflag = (unsigned*)(ws + WS_CTL) + CW_YRDY + (l * 32 + (U.tok0 >> 8)) * 4;
        attn_unit<2>(F, p, U);
    } else {
        const int uu = u - 512, b = uu >> 2, hh = uu & 3, seq0 = b * 256;
        U.mode = 3; U.nt1 = 4; U.k1 = RK + (size_t)seq0 * 256 + hh * 64; U.k_ld1 = 256; U.v1 = RV + (size_t)seq0 * 256 + hh * 64; U.v_ld1 = 256;
        U.k0 = U.k1; U.v0 = U.v1; U.k_ld0 = 256; U.v_ld0 = 256;
        U.lf = -log1pf(__expf(-decay[hh])) * LOG2E; U.lb = -log1pf(__expf(-decay[4 + hh])) * LOG2E;
        U.st_out = p.out + O_STATE + (size_t)(((b * 4 + l) * 2 + 0) * 4 + hh) * 4096;
        attn_unit<3>(F, p, U);
    }
}
constexpr int N_ATTN_UNITS = 576;
struct TItem { const float* src; bf16_t* dst; int nsrc, K; int valid; };
constexpr int P0_TWIN = 4 * 16 * 92, P0_TWOUT = 4 * 16 * 32, P0_TWUQ = 4 * 4 * 20, P0_TWUKV = 4 * 2 * 24, P0_TR = P0_TWIN + P0_TWOUT + P0_TWUQ + P0_TWUKV;
__device__ __forceinline__ TItem p0_titem(const Frame& F, unsigned char* ws, int it) {
    TItem t; t.valid = it < P0_TR; t.src = nullptr; t.dst = nullptr; t.nsrc = 0; t.K = 0;
    if (!t.valid) return t;
    if (it < P0_TWIN) {
        const int l = it / (16 * 92), r = it % (16 * 92), kb = r / 92, nb = r % 92, n0 = nb * 32;
        const int src = n0 < 1792 ? n0 : (n0 < 2816 ? n0 + 32 : (n0 < 2848 ? n0 - 2816 + 1792 : -1));
        t.nsrc = 2848; t.K = 1024;
        if (src >= 0) t.src = pin(F, I_WIN) + (size_t)l * 1024 * 2848 + (size_t)(kb * 64) * 2848 + src;
        t.dst = (bf16_t*)(ws + WS_WIN) + ((size_t)l * 2944 + n0) * 1024 + kb * 64;
        return t;
    }
    it -= P0_TWIN;
    if (it < P0_TWOUT) {
        const int l = it / 512, r = it % 512, kb = r >> 5, nb = r & 31;
        t.nsrc = 1024; t.K = 1024; t.src = pin(F, I_WOUT) + (size_t)l * 1024 * 1024 + (size_t)(kb * 64) * 1024 + nb * 32;
        t.dst = (bf16_t*)(ws + WS_WOUT) + ((size_t)l * 1024 + nb * 32) * 1024 + kb * 64;
        return t;
    }
    it -= P0_TWOUT;
    if (it < P0_TWUQ) {
        const int l = it / 80, r = it % 80, kb = r / 20, nb = r % 20;
        t.nsrc = 576; t.K = 256; if (nb < 18) t.src = pin(F, I_WUQ) + (size_t)l * 256 * 576 + (size_t)(kb * 64) * 576 + nb * 32;
        t.dst = (bf16_t*)(ws + WS_WUQ) + ((size_t)l * 640 + nb * 32) * 256 + kb * 64;
        return t;
    }
    it -= P0_TWUQ;
    { const int l = it / 48, r = it % 48, kb = r / 24, nb = r % 24;
      t.nsrc = 768; t.K = 128; t.src = pin(F, I_WUKV) + (size_t)l * 128 * 768 + (size_t)(kb * 64) * 768 + nb * 32;
      t.dst = (bf16_t*)(ws + WS_WUKV) + ((size_t)l * 768 + nb * 32) * 128 + kb * 64; }
    return t;
}
__device__ __forceinline__ void p0_tload(const TItem& t, float (&r)[32], int lane) {
    if (t.valid && t.src) {
        const float* wp = t.src + (size_t)(lane >> 5) * t.nsrc + (lane & 31);
#pragma unroll
        for (int i = 0; i < 32; ++i) r[i] = wp[(size_t)(2 * i) * t.nsrc];
    } else {
#pragma unroll
        for (int i = 0; i < 32; ++i) r[i] = 0.f;
    }
}
__device__ __forceinline__ void p0_tstore(const TItem& t, const float (&r)[32], LAS float* scr, int lane) {
    if (!t.valid) return;
#pragma unroll
    for (int i = 0; i < 32; ++i) scr[(2 * i + (lane >> 5)) * 33 + (lane & 31)] = r[i];
    asm volatile("s_waitcnt lgkmcnt(0)" ::: "memory");
    __builtin_amdgcn_wave_barrier();
    const int c = lane & 7;
#pragma unroll
    for (int j = 0; j < 4; ++j) {
        const int n = (lane >> 3) + 8 * j; const LAS float* s = scr + (8 * c) * 33 + n;
        u32x4 o; o.x = pk2(s[0 * 33], s[1 * 33]); o.y = pk2(s[2 * 33], s[3 * 33]); o.z = pk2(s[4 * 33], s[5 * 33]); o.w = pk2(s[6 * 33], s[7 * 33]);
        ST16_WT(t.dst + (size_t)n * t.K + 8 * c, o);
    }
    asm volatile("s_waitcnt lgkmcnt(0)" ::: "memory");
    __builtin_amdgcn_wave_barrier();
}
__device__ __forceinline__ void cast8(const float* src, bf16_t* dst, size_t e) {
    const f32x4 a = *(const f32x4*)(src + e), b = *(const f32x4*)(src + e + 4);
    u32x4 o; o.x = pk2(a[0], a[1]); o.y = pk2(a[2], a[3]); o.z = pk2(b[0], b[1]); o.w = pk2(b[2], b[3]);
    ST16_WT(dst + e, o);
}
constexpr int P0_MODS = 1536, P0_CAST_G = 512, P0_CAST_KPE = 128, P0_S0T = 512;
constexpr int P0_TOTAL = P0_MODS + 3 * P0_CAST_G + P0_CAST_KPE + P0_S0T;
__device__ __forceinline__ void phase0(const Frame& F, const Params& p, bool dup = false) {
    unsigned char* ws = F.ws + (dup ? 162 * MiB : 0); const int lane = F.lane;
    LAS float* scr = (LAS float*)F.lds + F.w * (64 * 33);
    const int gw = blockIdx.x * NWAVE + F.w, ngw = gridDim.x * NWAVE;
#ifndef MK_DUP0
#define MK_DUP0_ 0
#else
#define MK_DUP0_ MK_DUP0
#endif
    if (!(dup && MK_DUP0_ == 2))
    for (int it = gw; it < P0_TR; it += 2 * ngw) {
        const TItem t0 = p0_titem(F, ws, it), t1 = p0_titem(F, ws, it + ngw);
        float r0[32], r1[32];
        p0_tload(t0, r0, lane); p0_tload(t1, r1, lane);
        p0_tstore(t0, r0, scr, lane); p0_tstore(t1, r1, scr, lane);
    }
    if (!(dup && MK_DUP0_ == 1))
    for (int it0 = (gw + ngw - 256) % ngw; it0 < P0_TOTAL; it0 += ngw) {
        int it = it0;
        if (it < P0_MODS) {
            const int l = it / 384, cg = (it % 384) >> 5, ks = it & 31;
            const int j = cg * 256 + lane * 4;
            const float* wp = pin(F, I_WADA) + ((size_t)l * 1024 + ks * 32) * 3072 + j;
            const float* c = pin(F, I_C); const float* cc = pin(F, I_CCTX);
            float sv[3];
#pragma unroll
            for (int q = 0; q < 3; ++q) {
                const int idx = q * 64 + lane, n = idx >> 5, k = idx & 31;
                float x = 0.f;
                if (idx < 160) x = (n == 0) ? cc[ks * 32 + k] : c[(n - 1) * 1024 + ks * 32 + k];
                sv[q] = silu_f(x);
            }
            f32x4 acc[5];
#pragma unroll
            for (int n = 0; n < 5; ++n) acc[n] = (f32x4){0.f, 0.f, 0.f, 0.f};
#pragma unroll 1
            for (int k0 = 0; k0 < 32; k0 += 16) {
                f32x4 wv[16];
#pragma unroll
                for (int k = 0; k < 16; ++k) wv[k] = *(const f32x4*)(wp + (size_t)(k0 + k) * 3072);
                __builtin_amdgcn_sched_barrier(0);
#pragma unroll
                for (int k = 0; k < 16; ++k)
#pragma unroll
                    for (int n = 0; n < 5; ++n) {
                        const float s = __int_as_float(__builtin_amdgcn_readlane(__float_as_int(sv[n >> 1]), 32 * (n & 1) + k0 + k));
                        acc[n] += wv[k] * s;
                    }
            }
            LAS f32x4* red = (LAS f32x4*)(F.lds + 69632);
#pragma unroll
            for (int n = 0; n < 5; ++n) red[(F.w * 5 + n) * 64 + lane] = acc[n];
            __syncthreads();
            if (F.tid < 320) {
                const int n = F.tid >> 6;
                f32x4 s = red[n * 64 + lane];
#pragma unroll
                for (int ww = 1; ww < 8; ++ww) s += red[(ww * 5 + n) * 64 + lane];
                if ((ks >> 3) == 0) s += *(const f32x4*)(pin(F, I_BADA) + l * 3072 + j);
                float* mods = (float*)(ws + WS_MODS) + (size_t)(l * 5 + n) * 3072 + j;
#pragma unroll
                for (int e = 0; e < 4; ++e) atomicAdd(mods + e, s[e]);
            }
            __syncthreads();
            continue;
        }
        it -= P0_MODS;
        if (it < 3 * P0_CAST_G) {
            const int which = it / P0_CAST_G, r = it % P0_CAST_G;
            const float* src = which == 0 ? pin(F, I_CGK) : (which == 1 ? pin(F, I_CGV) : pin(F, I_CCKV));
            bf16_t* dst = (bf16_t*)(ws + (which == 0 ? WS_CGK : (which == 1 ? WS_CGV : WS_CCKV)));
#pragma unroll
            for (int q = 0; q < 4; ++q) cast8(src, dst, (size_t)r * 2048 + q * 512 + lane * 8);
            continue;
        }
        it -= 3 * P0_CAST_G;
        if (it < P0_CAST_KPE) {
#pragma unroll
            for (int q = 0; q < 4; ++q) cast8(pin(F, I_CKPE), (bf16_t*)(ws + WS_CKPE), (size_t)it * 2048 + q * 512 + lane * 8);
            continue; }
        it -= P0_CAST_KPE;
        {
            const int mat = it >> 2, qd = it & 3, dv = qd * 16 + (lane >> 2), dk0 = (lane & 3) * 16;
            const float* s = pin(F, I_STATE) + (size_t)mat * 4096 + dv;
            float x[16];
#pragma unroll
            for (int i = 0; i < 16; ++i) x[i] = s[(dk0 + i) * 64];
            u32x4 o0, o1;
            o0.x = pk2(x[0], x[1]); o0.y = pk2(x[2], x[3]); o0.z = pk2(x[4], x[5]); o0.w = pk2(x[6], x[7]);
            o1.x = pk2(x[8], x[9]); o1.y = pk2(x[10], x[11]); o1.z = pk2(x[12], x[13]); o1.w = pk2(x[14], x[15]);
            bf16_t* d = (bf16_t*)(ws + WS_S0T) + (size_t)mat * 4096 + dv * 64 + dk0;
            ST16_WT(d, o0); ST16_WT(d + 8, o1);
        }
    }
}
constexpr int P1_GS = 80, P1_BIAS = 4 * 368, P1_X = 8192, P1_TOTAL = P1_GS + P1_BIAS + P1_X;
__device__ __forceinline__ void xg_row(const Frame& F, const float* xrow, const float* g, const float* mods_c, bf16_t* xg_row_out, float* ssq_row, bool write_xg) {
    const int lane = F.lane;
    float ss = 0.f;
#pragma unroll
    for (int j = 0; j < 2; ++j) {
        const int k = j * 512 + lane * 8;
        const f32x4 x0 = *(const f32x4*)(xrow + k), x1 = *(const f32x4*)(xrow + k + 4);
        ss += ((x0[0] * x0[0] + x0[1] * x0[1]) + (x0[2] * x0[2] + x0[3] * x0[3])) + ((x1[0] * x1[0] + x1[1] * x1[1]) + (x1[2] * x1[2] + x1[3] * x1[3]));
        if (write_xg) {
            const f32x4 g0 = *(const f32x4*)(g + k), g1 = *(const f32x4*)(g + k + 4), s0 = *(const f32x4*)(mods_c + 1024 + k), s1 = *(const f32x4*)(mods_c + 1024 + k + 4);
            u32x4 o; o.x = pk2(x0[0] * g0[0] * (1.f + s0[0]), x0[1] * g0[1] * (1.f + s0[1])); o.y = pk2(x0[2] * g0[2] * (1.f + s0[2]), x0[3] * g0[3] * (1.f + s0[3]));
            o.z = pk2(x1[0] * g1[0] * (1.f + s1[0]), x1[1] * g1[1] * (1.f + s1[1])); o.w = pk2(x1[2] * g1[2] * (1.f + s1[2]), x1[3] * g1[3] * (1.f + s1[3]));
            ST16_WT(xg_row_out + k, o);
        }
    }
    ss = wsum(ss);
    if (lane < 16) ssq_row[lane] = lane == 0 ? ss : 0.f;
}
__device__ __forceinline__ void phase1(const Frame& F, const Params& p) {
    unsigned char* ws = F.ws; const int lane = F.lane;
    const int gw = blockIdx.x * NWAVE + F.w, ngw = gridDim.x * NWAVE;
    const float* mods = (const float*)(ws + WS_MODS);
    for (int it0 = gw; it0 < P1_TOTAL; it0 += ngw) {
        int it = it0;
        if (it < P1_GS) {
            const int e = it * 256 + lane * 4, lc = e >> 10, k = e & 1023, l = lc / 5;
            const f32x4 g = *(const f32x4*)(pin(F, I_NORMG) + l * 1024 + k), sc = *(const f32x4*)(mods + (size_t)lc * 3072 + 1024 + k);
            *(f32x4*)((float*)(ws + WS_GS) + e) = g * (sc + 1.f);
            continue;
        }
        it -= P1_GS;
        if (it < P1_BIAS) {
            const int l = it / 368, n0 = (it % 368) * 8;
            f32x4 sh[5][4];
#pragma unroll
            for (int c = 0; c < 5; ++c) {
                const float* shp = mods + (size_t)(l * 5 + c) * 3072 + lane * 16;
#pragma unroll
                for (int i = 0; i < 4; ++i) sh[c][i] = *(const f32x4*)(shp + 4 * i);
            }
            const bf16_t* wr0 = (const bf16_t*)(ws + WS_WIN) + ((size_t)l * 2944 + n0) * 1024 + lane * 16;
            u32x4 w0[8], w1[8];
#pragma unroll
            for (int r = 0; r < 8; ++r) { w0[r] = *(const u32x4*)(wr0 + (size_t)r * 1024); w1[r] = *(const u32x4*)(wr0 + (size_t)r * 1024 + 8); }
#pragma unroll
            for (int r = 0; r < 8; ++r) {
                float wv[16];
#pragma unroll
                for (int i = 0; i < 4; ++i) { wv[2 * i] = bflo(w0[r][i]); wv[2 * i + 1] = bfhi(w0[r][i]); wv[8 + 2 * i] = bflo(w1[r][i]); wv[8 + 2 * i + 1] = bfhi(w1[r][i]); }
#pragma unroll
                for (int c = 0; c < 5; ++c) {
                    float d = 0.f;
#pragma unroll
                    for (int i = 0; i < 4; ++i) { const f32x4 s4 = sh[c][i]; d += (s4[0] * wv[4 * i] + s4[1] * wv[4 * i + 1]) + (s4[2] * wv[4 * i + 2] + s4[3] * wv[4 * i + 3]); }
                    d = wsum(d);
                    if (lane == 0) ((float*)(ws + WS_BIAS))[(size_t)(l * 5 + c) * 2944 + n0 + r] = d;
                }
            }
            continue;
        }
        it -= P1_BIAS;
        {
            const int tok = it; const bool lat = tok >= 4096;
            const float* xr = lat ? pin(F, I_XS) + (size_t)(tok - 4096) * 1024 : pin(F, I_XP) + (size_t)tok * 1024;
            const int cond = lat ? 1 + ((tok - 4096) >> 10) : 0;
            xg_row(F, xr, pin(F, I_NORMG), mods + (size_t)cond * 3072, (bf16_t*)(ws + WS_XG) + (size_t)tok * 1024, (float*)(ws + WS_SSQ) + (size_t)tok * 16, true);
        }
    }
}
#ifndef MK_TIMING
#define MK_TIMING -1
#endif
constexpr int CW_TIME = 2048;
__device__ __forceinline__ void phase_final(const Frame& F, const Params& p) {
    const int lane = F.lane;
    float tf = 1.f;
    if (MK_TIMING >= 0) tf = __uint_as_float(__hip_atomic_load((unsigned*)(F.ws + WS_CTL) + CW_TIME, __ATOMIC_RELAXED, __HIP_MEMORY_SCOPE_AGENT));
    const int gw = blockIdx.x * NWAVE + F.w, ngw = gridDim.x * NWAVE;
    for (int tok = gw; tok < 8192; tok += ngw) {
        float ss = 0.f;
        if (lane < 16) ss = ((const float*)(F.ws + WS_SSQ))[(size_t)tok * 16 + lane];
        ss = wsum(ss);
        const float rstd = rsqrtf(ss * (1.f / 1024.f) + EPS);
        const bf16_t* xr = (const bf16_t*)(F.ws + WS_XB) + (size_t)tok * 1024; float* orow = p.out + (size_t)tok * 1024;
#pragma unroll
        for (int j = 0; j < 4; ++j) {
            const int k = j * 256 + lane * 4;
            const u32x2 xq = *(const u32x2*)(xr + k);
            const f32x4 x = {bflo(xq.x), bfhi(xq.x), bflo(xq.y), bfhi(xq.y)}, fn = *(const f32x4*)(pin(F, I_FNORM) + k);
            { const f32x4 o = x * fn * (rstd * tf); ST16_WT(orow + k, o); }
        }
    }
}

__device__ __forceinline__ GemmOp a2_op(const Frame& F, int l, int j) {
    GemmOp g;
    if (j < 160) { const int tn = j >> 5, tm = j & 31; g.W = (const bf16_t*)(F.ws + WS_WUQ) + ((size_t)l * 640 + tn * 128) * 256; g.X = (const bf16_t*)(F.ws + WS_CQG) + (size_t)tm * 256 * 256; g.ldw = 256; g.ldx = 256; g.K = 256; }
    else if (j < 352) { const int jj = j - 160, tn = jj >> 5, tm = jj & 31; g.W = (const bf16_t*)(F.ws + WS_WUKV) + ((size_t)l * 768 + tn * 128) * 128; g.X = (const bf16_t*)(F.ws + WS_CKVN) + (size_t)tm * 256 * 128; g.ldw = 128; g.ldx = 128; g.K = 128; }
    else { const int jj = j - 352, tn = jj >> 3, tc = jj & 7, b = tc >> 1, jt = tc & 1; g.W = (const bf16_t*)(F.ws + WS_WUKV) + ((size_t)l * 768 + tn * 128) * 128;
           g.X = (const bf16_t*)(F.ws + WS_CCKV) + ((size_t)(b * 4 + l) * 512 + jt * 256) * 128; g.ldw = 128; g.ldx = 128; g.K = 128; }
    return g;
}
__device__ __forceinline__ int a2_item(int vb, int i) {
    const int c = (vb >> 5) - 4, tmw = vb & 31;
    if (i == 3) return 352 + 32 + tmw;
    if (c == 0) return i * 32 + tmw;
    if (c == 1) return i < 2 ? (3 + i) * 32 + tmw : 160 + tmw;
    if (c == 2) return 160 + (1 + i) * 32 + tmw;
    return i < 2 ? 160 + (4 + i) * 32 + tmw : 352 + tmw;
}
#ifndef MK_EN
#define MK_EN 0xff
#endif
#define EN(x) ((MK_EN >> (x)) & 1)
constexpr int PH_TOTAL = 19;
__global__ void __launch_bounds__(512, 2) mega(Params p) {
    extern __shared__ __attribute__((aligned(16))) unsigned char lds_raw[];
    Frame F;
    F.lds = (LAS unsigned char*)lds_raw;
    F.tid = threadIdx.x; F.lane = F.tid & 63; F.w = __builtin_amdgcn_readfirstlane(F.tid >> 6); F.h = F.lane >> 5; F.lq = F.lane & 31;
    F.ws = p.ws;
    F.karg = (karg_t)__builtin_amdgcn_kernarg_segment_ptr();
    volatile LAS unsigned* MISC = (volatile LAS unsigned*)(F.lds + LDS_MISC);
    if (F.tid < 64) MISC[F.tid] = 0u;
    __syncthreads();
    unsigned* ctl = (unsigned*)(p.ws + WS_CTL);
    XcdBarrier bar; bar.bar = ctl + CW_BAR; bar.x = 0; bar.st = nullptr;
    const bool multi = p.ph_hi - p.ph_lo > 1;
    if (multi) bar = xcd_barrier_post(ctl + CW_BAR, MISC + 8);
    bar.w = F.w;
    const int G = gridDim.x;
    const Frame F0 = F;
    for (int ph = p.ph_lo; ph < p.ph_hi; ++ph) {
        if (ph >= 2 && ph < 18 && ((ph - 2) & 3) == 1) continue;
        Frame F = F0;
        F.lane = (int)__builtin_amdgcn_mbcnt_hi(~0u, __builtin_amdgcn_mbcnt_lo(~0u, 0u));
        asm volatile("" : "+v"(F.lane));
        F.tid = (F.w << 6) | F.lane; F.h = F.lane >> 5; F.lq = F.lane & 31;
        asm volatile("" : "+s"(F.w), "+s"(F.ws), "+s"(F.karg));
        if (MK_TIMING >= 0 && blockIdx.x == 0 && F.tid == 0) {
            const unsigned long long now = __builtin_amdgcn_s_memrealtime();
            const unsigned long long prev = ((unsigned long long)MISC[17] << 32) | MISC[16];
            if (ph > p.ph_lo) { const int q = ph - 1; const int grp = q < 2 ? q : 2 + ((q - 2) & 3); if (grp == MK_TIMING) MISC[18] += (unsigned)(now - prev); }
            MISC[16] = (unsigned)now; MISC[17] = (unsigned)(now >> 32);
        }
#ifndef MK_REPEAT
#define MK_REPEAT -1
#endif
        int nrep = 1;
        if (MK_REPEAT >= 1) { const int grp = ph < 2 ? ph : (ph == 18 ? 6 : 2 + ((ph - 2) & 3)); if (grp == MK_REPEAT) nrep = (grp == 5) ? (ph == 5 ? 5 : 1) : 2; }
        for (int rep = 0; rep < nrep; ++rep) {
        if (rep > 0) xcd_barrier(bar);
        Frame F = F0;
        F.lane = (int)__builtin_amdgcn_mbcnt_hi(~0u, __builtin_amdgcn_mbcnt_lo(~0u, 0u));
        asm volatile("" : "+v"(F.lane));
        F.tid = (F.w << 6) | F.lane; F.h = F.lane >> 5; F.lq = F.lane & 31;
        asm volatile("" : "+s"(F.w), "+s"(F.ws), "+s"(F.karg));
        if (EN(0) && ph == 0) {
#if defined(MK_DUP0)
            for (int d = 0; d < 2; ++d) { int dd = d; asm volatile("" : "+s"(dd)); if (dd) xcd_barrier(bar); phase0(F, p, dd != 0); }
#else
            phase0(F, p);
#endif
        }
        else if (EN(1) && ph == 1) phase1(F, p);
        else if (EN(2) && ph == 18) phase_final(F, p);
        else {
            const int l = (ph - 2) >> 2, sub = (ph - 2) & 3;
            if (EN(3) && sub == 0) {
                const bf16_t* Wt = (const bf16_t*)(F.ws + WS_WIN) + (size_t)l * 2944 * 1024;
                const bf16_t* X = (const bf16_t*)(F.ws + WS_XG);
                unsigned* flags = ctl + CW_FLAG + l * 512;
                bool first = true;
                for (int j = blockIdx.x; j < 12 * 32; j += G) {
                    const int tn2 = j >> 5, tm = j & 31;
                    const int jn = j + G; const bool hn = jn < 12 * 32;
                    const int tn = 2 * tn2 + ((F.w & 3) >> 1), wn = F.w & 1;
                    GemmAcc8 acc;
                    Gemm1Pre P1;
                    gemm1_pre(F, p, tn, wn, tm, l, P1);
                    gemm_core256(F, Wt + (size_t)tn2 * 256 * 1024, X + (size_t)tm * 256 * 1024, acc, first, hn, Wt + (size_t)(jn >> 5) * 256 * 1024, X + (size_t)(jn & 31) * 256 * 1024); first = false;
                    epi_gemm1(F, p, acc, tn, wn, tm, l, P1, tn2 == 6);
                    if (tn2 == 5 || tn2 == 6) {
                        asm volatile("s_waitcnt vmcnt(0)" ::: "memory");
                        __syncthreads();
                        if (F.tid == 0) (void)xb_add(flags + tm * 16, 1u);
                    }
                }
                for (int vb = blockIdx.x; vb < 256; vb += G) {
                    if (vb < 128) continue;
                    const int c = (vb >> 5) - 4, tmw = vb & 31;
                    const int nit = (c == 2 && tmw < 16) ? 4 : 3;
                    if (F.tid == 0) {
                        unsigned* f = flags + tmw * 16;
                        XB_SPIN(xb_ld(f) < 2u, ctl + CW_BAR);
                        __builtin_amdgcn_fence(__ATOMIC_ACQUIRE, "agent");
                        asm volatile("s_waitcnt vmcnt(0)" ::: "memory");
                    }
                    __syncthreads();
                    for (int i = 0; i < nit; ++i) {
                        const bool hn = i + 1 < nit;
                        const int j = a2_item(vb, i), jn = a2_item(vb, hn ? i + 1 : i);
                        const GemmOp g = a2_op(F, l, j); const GemmOp gn = a2_op(F, l, jn);
                        GemmAcc acc;
                        float rstdq = 0.f;
                        if (j < 160) qm_pre(F, tmw, rstdq);
                        gemm_core(F, g, acc, i == 0, hn, gn);
                        if (j < 160) epi_qm(F, acc, j >> 5, tmw, rstdq);
                        else if (j < 352) { const int jj = j - 160; epi_plain(F, acc, (bf16_t*)(F.ws + WS_KVM), 768, tmw * 256, (jj >> 5) * 128); }
                        else { const int jj = j - 352, tc = jj & 7; epi_plain(F, acc, (bf16_t*)(F.ws + WS_KVMC), 768, (tc >> 1) * 512 + (tc & 1) * 256, (jj >> 3) * 128); }
                    }
                }
            } else if (EN(5) && sub == 2) {
                for (;;) {
                    __syncthreads();
                    if (F.tid == 0) MISC[0] = atomicAdd(ctl + CW_QUEUE + 64 * l + 32 * rep, 1u);
                    __syncthreads();
                    const int u = __builtin_amdgcn_readfirstlane((int)MISC[0]);
                    if (u >= N_ATTN_UNITS) break;
                    attn_dispatch(F, p, u, l);
                }
            } else if (EN(6)) {
                const bf16_t* Wt = (const bf16_t*)(F.ws + WS_WOUT) + (size_t)l * 1024 * 1024;
                const bf16_t* Yb = (const bf16_t*)(F.ws + WS_Y);
                for (int j = blockIdx.x; j < 8 * 32; j += G) {
                    const int tn = j >> 5, tm = j & 31;
                    GemmOp g; g.W = Wt + (size_t)tn * 128 * 1024; g.X = Yb + (size_t)tm * 256 * 1024; g.ldw = 1024; g.ldx = 1024; g.K = 1024;
                    GemmAcc acc;
                    Gemm2Pre P2;
                    gemm2_pre(F, tn, tm, l, P2);
                    if (F.tid == 0) {
                        unsigned* f = ctl + CW_YRDY + (l * 32 + tm) * 4;
                        XB_SPIN(xb_ld(f) < 16u, ctl + CW_BAR);
                        __builtin_amdgcn_fence(__ATOMIC_ACQUIRE, "agent");
                        asm volatile("s_waitcnt vmcnt(0)" ::: "memory");
                    }
                    __syncthreads();
                    gemm_core(F, g, acc, true, false, g);
                    epi_gemm2(F, p, acc, tn, tm, l, P2);
                }
            }
        }
        }
        if (MK_TIMING >= 0 && ph == 17 && blockIdx.x == 0 && F.tid == 0) {
            const unsigned long long now = __builtin_amdgcn_s_memrealtime();
            const unsigned long long prev = ((unsigned long long)MISC[17] << 32) | MISC[16];
            unsigned a = MISC[18]; if (MK_TIMING == 5) a += (unsigned)(now - prev);
            __hip_atomic_store(ctl + CW_TIME, __float_as_uint(1.f + (float)a * 1e-5f), __ATOMIC_RELAXED, __HIP_MEMORY_SCOPE_AGENT);
        }
        if (ph + 1 < p.ph_hi && !(ph >= 2 && ph < 18 && ((ph - 2) & 3) == 2)) xcd_barrier(bar);
    }
}
}

extern "C" void kernel_launch(void* const* d_in, const int* in_sizes, int n_in, void* d_out, int out_size, void* d_ws, size_t ws_size, hipStream_t stream) {
    static int grid = 0;
    if (!grid) {
        int dev = 0, cus = 0, per_cu = 0;
        (void)hipGetDevice(&dev);
        (void)hipDeviceGetAttribute(&cus, hipDeviceAttributeMultiprocessorCount, dev);
        (void)hipFuncSetAttribute((const void*)mk::mega, hipFuncAttributeMaxDynamicSharedMemorySize, mk::LDS_BYTES);
        (void)hipOccupancyMaxActiveBlocksPerMultiprocessor(&per_cu, (const void*)mk::mega, 512, mk::LDS_BYTES);
        if (per_cu > 1) per_cu = 1;
        if (per_cu < 1) per_cu = 1;
        if (cus < 1) cus = 256;
        grid = cus * per_cu;
    }
    unsigned char* ws = (unsigned char*)d_ws;
    (void)hipMemsetAsync(ws, 0, mk::CTL_ZERO_BYTES, stream);
    mk::Params P{};
    for (int i = 0; i < 22; ++i) P.in[i] = (const float*)d_in[i];
    P.out = (float*)d_out; P.ws = ws; P.xs = (float*)d_out;
    P.ph_lo = 0; P.ph_hi = mk::PH_TOTAL;
    void* args[] = {&P};
    (void)hipLaunchCooperativeKernel((const void*)mk::mega, dim3(grid), dim3(512), args, mk::LDS_BYTES, stream);
}
```

```cpp
#include <hip/hip_runtime.h>
#include <stdint.h>
namespace mk {
#define LAS __attribute__((address_space(3)))
typedef unsigned short bf16_t;
typedef short bf16x8 __attribute__((ext_vector_type(8)));
typedef short s16x4 __attribute__((ext_vector_type(4)));
typedef float f32x16 __attribute__((ext_vector_type(16)));
typedef float f32x4 __attribute__((ext_vector_type(4)));
typedef float f32x2 __attribute__((ext_vector_type(2)));
typedef unsigned u32x4 __attribute__((ext_vector_type(4)));
typedef unsigned u32x2 __attribute__((ext_vector_type(2)));
typedef __bf16 bf16x2_t __attribute__((ext_vector_type(2)));

constexpr float EPS = 1e-6f;
constexpr float LOG2E = 1.4426950408889634f;
constexpr float QSC_GQA = 0.125f * LOG2E;
constexpr float QSC_MLA = 0.10206207261596575f * LOG2E;

__device__ __forceinline__ unsigned pk2(float lo, float hi) { f32x2 v = {lo, hi}; bf16x2_t b = __builtin_convertvector(v, bf16x2_t); return __builtin_bit_cast(unsigned, b); }
__device__ __forceinline__ float bf2f(unsigned short u) { return __uint_as_float((unsigned)u << 16); }
__device__ __forceinline__ float bflo(unsigned u) { return __uint_as_float(u << 16); }
__device__ __forceinline__ float bfhi(unsigned u) { return __uint_as_float(u & 0xffff0000u); }
__device__ __forceinline__ float silu_f(float x) { return x * __builtin_amdgcn_rcpf(1.f + __builtin_amdgcn_exp2f(-x * LOG2E)); }
__device__ __forceinline__ float wsum(float v) {
#pragma unroll
    for (int o = 32; o > 0; o >>= 1) v += __shfl_xor(v, o);
    return v;
}

constexpr size_t MiB = 1u << 20;
constexpr size_t WS_CTL = 0, CTL_ZERO_BYTES = 1 * MiB;
constexpr size_t WS_MODS = 256 * 1024;
constexpr size_t WS_BIAS = 1 * MiB;
constexpr size_t WS_GS = 1 * MiB + 256 * 1024;
constexpr size_t WS_ROPE64 = 1 * MiB + 512 * 1024;
constexpr size_t WS_ROPE32 = 1 * MiB + 768 * 1024;
constexpr size_t WS_SSQ = 2 * MiB;
constexpr size_t WS_CQSSQ = 2 * MiB + 512 * 1024;
constexpr size_t WS_S0T = 3 * MiB;
constexpr size_t WS_CGK = 4 * MiB, WS_CGV = 6 * MiB, WS_CCKV = 8 * MiB, WS_CKPE = 10 * MiB;
constexpr size_t WS_WIN = 11 * MiB;
constexpr size_t WS_WOUT = 34 * MiB;
constexpr size_t WS_WUQ = 42 * MiB;
constexpr size_t WS_WUKV = 43 * MiB + 256 * 1024;
constexpr size_t WS_XG = 44 * MiB;
constexpr size_t WS_KVM = 130 * MiB;
constexpr size_t WS_KVMC = 142 * MiB;
constexpr size_t WS_RQ = 60 * MiB, WS_RK = 64 * MiB, WS_RV = 68 * MiB;
constexpr size_t WS_GQ = 72 * MiB;
constexpr size_t WS_GK = 78 * MiB, WS_GV = 80 * MiB;
constexpr size_t WS_CQG = 82 * MiB;
constexpr size_t WS_CKVN = 86 * MiB;
constexpr size_t WS_KPEB = 88 * MiB;
constexpr size_t WS_ZS = 89 * MiB;
constexpr size_t WS_QM = 105 * MiB;
constexpr size_t WS_Y = 114 * MiB;
constexpr size_t WS_XSDBG = 130 * MiB;
constexpr size_t WS_XB = 146 * MiB;
constexpr size_t WS_OPT_END = 162 * MiB;
constexpr int CW_QUEUE = 1024;
constexpr int CW_FLAG = 2048;
constexpr int CW_YRDY = 1536;
constexpr int CW_XRDY = 1280;
constexpr int CW_RA = 8192;
constexpr int CW_FULL = 8704;
constexpr int CW_ZC = 9216;
constexpr int CW_KC = 9728;
constexpr int CW_BAR = 4096;

constexpr size_t O_STATE = 8388608, O_GK = 10485760, O_GV = 12582912, O_CKV = 14680064, O_KPE = 16777216;

constexpr int NWAVE = 8;
constexpr int GST = 49152;
constexpr int GST2 = 65536;
constexpr int LDS_OST = GST2;
constexpr int LDS_EX = 135168;
constexpr int LDS_EXB = 137216;
constexpr int LDS_SCAL = 141312;
constexpr int LDS_MISC = 142336;
constexpr int LDS_BYTES = 142592;

struct Params { const float* in[22]; float* out; unsigned char* ws; float* xs; int ph_lo, ph_hi; };
enum { I_XP = 0, I_XS, I_STATE, I_CGK, I_CGV, I_CCKV, I_CKPE, I_C, I_CCTX, I_NORMG, I_WADA, I_BADA, I_WIN, I_DECAY, I_GQN, I_GKN, I_MQN, I_MKVN, I_WUQ, I_WUKV, I_WOUT, I_FNORM };

#define XB_TMO      128
#define XB_XCNT(j)  (256  + 64 * (j))
#define XB_XSUB(j)  (1280 + 64 * (j))
#define XB_XGEN(j)  (2304 + 64 * (j))
#define XB_TOP      3328
#define XB_TOPGEN   3392
#define XB_SPIN_CAP (1u << 20)
__device__ __forceinline__ unsigned xb_ld(unsigned* p) { return __hip_atomic_load(p, __ATOMIC_RELAXED, __HIP_MEMORY_SCOPE_AGENT); }
__device__ __forceinline__ unsigned xb_add(unsigned* p, unsigned v) { return __hip_atomic_fetch_add(p, v, __ATOMIC_RELAXED, __HIP_MEMORY_SCOPE_AGENT); }
__device__ __forceinline__ unsigned xb_xcc_id() { return (unsigned)__builtin_amdgcn_s_getreg((3 << 11) | 20) & 0xFu; }
#define XB_SPIN(cond, bar) do { unsigned _sp = 0; while (cond) { __builtin_amdgcn_s_sleep(1); \
    if ((++_sp & 255u) == 0u) { if (xb_ld(&(bar)[XB_TMO])) break; if (_sp > XB_SPIN_CAP) { atomicAdd(&(bar)[XB_TMO], 1u); break; } } } } while (0)
struct XcdBarrier { unsigned* bar; unsigned x; volatile LAS unsigned* st; int w; };
__device__ __forceinline__ XcdBarrier xcd_barrier_post(unsigned* bar, volatile LAS unsigned* st) {
    XcdBarrier b; b.bar = bar; b.x = xb_xcc_id(); b.st = st; b.w = 0;
    if (threadIdx.x == 0) (void)xb_add(&bar[XB_XCNT(b.x)], 1u);
    return b;
}
__device__ __forceinline__ void xcd_barrier_complete(unsigned* bar, unsigned x, unsigned& nloc, unsigned& nx) {
    const unsigned G = gridDim.x * gridDim.y * gridDim.z;
    unsigned sum, cnt, mine, sp = 0u;
    for (;;) {
        sum = 0u; cnt = 0u; mine = 0u;
#pragma unroll
        for (unsigned j = 0; j < 16; ++j) { const unsigned c = xb_ld(&bar[XB_XCNT(j)]); sum += c; cnt += (c > 0u) ? 1u : 0u; mine = (j == x) ? c : mine; }
        if (sum == G) break;
        __builtin_amdgcn_s_sleep(1);
        if ((++sp & 255u) == 0u) { if (xb_ld(&bar[XB_TMO])) break; if (sp > XB_SPIN_CAP) { atomicAdd(&bar[XB_TMO], 1u); break; } }
    }
    nloc = mine > 0u ? mine : 1u; nx = cnt > 0u ? cnt : 1u;
}
__device__ __forceinline__ void xcd_barrier(const XcdBarrier& b) {
    asm volatile("s_waitcnt vmcnt(0)" ::: "memory");
    __syncthreads();
    if (b.w == 0 && __builtin_amdgcn_mbcnt_hi(~0u, __builtin_amdgcn_mbcnt_lo(~0u, 0u)) == 0u) {
        unsigned* bar = b.bar;
        __builtin_amdgcn_s_waitcnt(0);
        unsigned nloc = b.st[0], nx = b.st[1];
        if (nloc == 0u) { xcd_barrier_complete(bar, b.x, nloc, nx); b.st[0] = nloc; b.st[1] = nx; }
        const unsigned old = xb_add(&bar[XB_XSUB(b.x)], 1u);
        const unsigned gen = old / nloc;
        if (old + 1u == (gen + 1u) * nloc) {
            __builtin_amdgcn_fence(__ATOMIC_RELEASE, "agent");
            asm volatile("s_waitcnt vmcnt(0)" ::: "memory");
            const unsigned og = xb_add(&bar[XB_TOP], 1u);
            const unsigned tg = og / nx;
            if (og + 1u == (tg + 1u) * nx) xb_add(&bar[XB_TOPGEN], 1u);
            else XB_SPIN(xb_ld(&bar[XB_TOPGEN]) == tg, bar);
            xb_add(&bar[XB_XGEN(b.x)], 1u);
            __builtin_amdgcn_fence(__ATOMIC_ACQUIRE, "agent");
            asm volatile("s_waitcnt vmcnt(0)" ::: "memory");
        } else {
            XB_SPIN(xb_ld(&bar[XB_XGEN(b.x)]) == gen, bar);
            __builtin_amdgcn_fence(__ATOMIC_ACQUIRE, "agent");
            asm volatile("s_waitcnt vmcnt(0)" ::: "memory");
        }
    }
    __syncthreads();
}

typedef const float* cfp_t;
typedef const __attribute__((address_space(4))) cfp_t* karg_t;
struct Frame {
    LAS unsigned char* lds;
    int tid, lane, w, h, lq;
    unsigned char* ws;
    karg_t karg;
};
__device__ __forceinline__ const float* pin(const Frame& F, int i) { return F.karg[i]; }
#define GLDS16(gsrc, ldsdst) __builtin_amdgcn_global_load_lds((const unsigned*)(gsrc), (LAS unsigned*)(ldsdst), 16, 0, 0)
#define ST16_WT(ptr, val) asm volatile("global_store_dwordx4 %0, %1, off sc1\n\ts_nop 1" :: "v"(ptr), "v"(val) : "memory")
#define MFMA32(a, b, c) __builtin_amdgcn_mfma_f32_32x32x16_bf16((a), (b), (c), 0, 0, 0)

struct GemmOp { const bf16_t* W; const bf16_t* X; int ldw, ldx, K; };
__device__ __forceinline__ void gemm_issue0(const Frame& F, const GemmOp& g) {
    const int lane = F.lane, w = F.w;
#pragma unroll
    for (int q = 0; q < 2; ++q) { const int row = 16 * w + 8 * q + (lane >> 3); GLDS16(g.W + row * g.ldw + ((lane & 7) ^ ((row >> 1) & 7)) * 8, F.lds + (16 * w + 8 * q) * 128); }
#pragma unroll
    for (int q = 0; q < 4; ++q) { const int row = 32 * w + 8 * q + (lane >> 3); GLDS16(g.X + row * g.ldx + ((lane & 7) ^ ((row >> 1) & 7)) * 8, F.lds + 16384 + (32 * w + 8 * q) * 128); }
}
typedef f32x4 GemmAcc[4][4];
__device__ __forceinline__ void gemm_core(const Frame& F, const GemmOp& g, GemmAcc& acc, bool issue_first, bool has_next, const GemmOp& gn) {
    const int lane = F.lane, w = F.w;
    const bf16_t* __restrict__ W = g.W; const bf16_t* __restrict__ X = g.X;
    const int nkt = g.K >> 6;
    int offW[2], offX[4];
#pragma unroll
    for (int q = 0; q < 2; ++q) { const int row = 16 * w + 8 * q + (lane >> 3); offW[q] = row * g.ldw + ((lane & 7) ^ ((row >> 1) & 7)) * 8; }
#pragma unroll
    for (int q = 0; q < 4; ++q) { const int row = 32 * w + 8 * q + (lane >> 3); offX[q] = row * g.ldx + ((lane & 7) ^ ((row >> 1) & 7)) * 8; }
    LAS unsigned char* const dW = F.lds + (16 * w) * 128;
    LAS unsigned char* const dX = F.lds + 16384 + (32 * w) * 128;
#define GC_ISSUE(kt, st) do { _Pragma("unroll") for (int q = 0; q < 2; ++q) GLDS16(W + offW[q] + (kt) * 64, dW + (st) * GST + q * 1024); \
        _Pragma("unroll") for (int q = 0; q < 4; ++q) GLDS16(X + offX[q] + (kt) * 64, dX + (st) * GST + q * 1024); } while (0)
    const int wn = w & 1, wm = w >> 1, c15 = lane & 15, g4 = lane >> 4;
    const int sw = (c15 >> 1) & 7;
    int so[2];
#pragma unroll
    for (int s = 0; s < 2; ++s) so[s] = ((4 * s + g4) ^ sw) << 4;
    const int bn0 = (64 * wn + c15) * 128, bm0 = 16384 + (64 * wm + c15) * 128;
#pragma unroll
    for (int a = 0; a < 4; ++a)
#pragma unroll
        for (int b = 0; b < 4; ++b) acc[a][b] = (f32x4){0.f, 0.f, 0.f, 0.f};
    if (issue_first) GC_ISSUE(0, 0);
    asm volatile("s_waitcnt vmcnt(0)" ::: "memory");
    __syncthreads();
    for (int kt = 0; kt < nkt; ++kt) {
        const int st = kt & 1;
        if (kt + 1 < nkt) GC_ISSUE(kt + 1, st ^ 1);
        LAS unsigned char* const base = F.lds + st * GST;
#pragma unroll
        for (int s = 0; s < 2; ++s) {
            bf16x8 fa[4], fb[4];
#pragma unroll
            for (int q = 0; q < 4; ++q) { fa[q] = *(const LAS bf16x8*)(base + bn0 + q * 2048 + so[s]); fb[q] = *(const LAS bf16x8*)(base + bm0 + q * 2048 + so[s]); }
#pragma unroll
            for (int a = 0; a < 4; ++a)
#pragma unroll
                for (int b = 0; b < 4; ++b) acc[a][b] = __builtin_amdgcn_mfma_f32_16x16x32_bf16(fa[a], fb[b], acc[a][b], 0, 0, 0);
        }
        asm volatile("s_waitcnt vmcnt(0)" ::: "memory");
        __syncthreads();
    }
#undef GC_ISSUE
    if (has_next) gemm_issue0(F, gn);
}

typedef f32x4 GemmAcc8[4][8];
__device__ __forceinline__ void gemm256_issue0(const Frame& F, const bf16_t* W, const bf16_t* X) {
    int lane = F.lane; const int w = F.w;
    asm volatile("" : "+v"(lane));
#pragma unroll
    for (int q = 0; q < 4; ++q) {
        const int row = 32 * w + 8 * q + (lane >> 3), off = row * 1024 + ((lane & 7) ^ ((row >> 1) & 7)) * 8;
        GLDS16(W + off, F.lds + (32 * w + 8 * q) * 128);
        GLDS16(X + off, F.lds + 32768 + (32 * w + 8 * q) * 128);
    }
}
__device__ __forceinline__ void gemm_core256(const Frame& F, const bf16_t* __restrict__ W, const bf16_t* __restrict__ X, GemmAcc8& acc, bool issue_first, bool has_next, const bf16_t* Wn, const bf16_t* Xn) {
    int lane = F.lane; const int w = F.w;
    asm volatile("" : "+v"(lane));
    int off[4];
#pragma unroll
    for (int q = 0; q < 4; ++q) { const int row = 32 * w + 8 * q + (lane >> 3); off[q] = row * 1024 + ((lane & 7) ^ ((row >> 1) & 7)) * 8; }
    LAS unsigned char* const dW = F.lds + (32 * w) * 128;
    LAS unsigned char* const dX = F.lds + 32768 + (32 * w) * 128;
#define GC2_ISSUE(kt, st) do { _Pragma("unroll") for (int q = 0; q < 4; ++q) { GLDS16(W + off[q] + (kt) * 64, dW + (st) * GST2 + q * 1024); GLDS16(X + off[q] + (kt) * 64, dX + (st) * GST2 + q * 1024); } } while (0)
    const int wn4 = w & 3, wm2 = w >> 2, c15 = lane & 15, g4 = lane >> 4;
    const int sw = (c15 >> 1) & 7;
    int so[2];
#pragma unroll
    for (int s = 0; s < 2; ++s) so[s] = ((4 * s + g4) ^ sw) << 4;
    const int bn0 = (64 * wn4 + c15) * 128, bm0 = 32768 + (128 * wm2 + c15) * 128;
#pragma unroll
    for (int a = 0; a < 4; ++a)
#pragma unroll
        for (int b = 0; b < 8; ++b) acc[a][b] = (f32x4){0.f, 0.f, 0.f, 0.f};
    if (issue_first) GC2_ISSUE(0, 0);
    asm volatile("s_waitcnt vmcnt(0)" ::: "memory");
    __syncthreads();
    for (int kt = 0; kt < 16; ++kt) {
        const int st = kt & 1;
        if (kt + 1 < 16) GC2_ISSUE(kt + 1, st ^ 1);
        LAS unsigned char* const base = F.lds + st * GST2;
#pragma unroll
        for (int s = 0; s < 2; ++s) {
            bf16x8 fa[4];
#pragma unroll
            for (int q = 0; q < 4; ++q) fa[q] = *(const LAS bf16x8*)(base + bn0 + q * 2048 + so[s]);
#pragma unroll
            for (int hb = 0; hb < 2; ++hb) {
                bf16x8 fb[4];
#pragma unroll
                for (int q = 0; q < 4; ++q) fb[q] = *(const LAS bf16x8*)(base + bm0 + (4 * hb + q) * 2048 + so[s]);
#pragma unroll
                for (int a = 0; a < 4; ++a)
#pragma unroll
                    for (int b = 0; b < 4; ++b) acc[a][4 * hb + b] = __builtin_amdgcn_mfma_f32_16x16x32_bf16(fa[a], fb[b], acc[a][4 * hb + b], 0, 0, 0);
            }
        }
        asm volatile("s_waitcnt vmcnt(0)" ::: "memory");
        __syncthreads();
    }
#undef GC2_ISSUE
    if (has_next) gemm256_issue0(F, Wn, Xn);
}

__device__ __forceinline__ void rope64_16(float (&v)[4][4], float rowp, float colp, int g4) {
#pragma unroll
    for (int i = 0; i < 4; ++i) {
        const float fr = __builtin_amdgcn_exp2f((float)(4 * g4 + i) * -0.8304820237218406f) * 0.15915494309189535f;
#pragma unroll
        for (int c = 0; c < 2; ++c) {
            const float rev = (c ? colp : rowp) * fr;
            const float sn = __builtin_amdgcn_sinf(rev), cs = __builtin_amdgcn_cosf(rev);
            const float x0 = v[2 * c][i], x1 = v[2 * c + 1][i];
            v[2 * c][i] = x0 * cs - x1 * sn;
            v[2 * c + 1][i] = x1 * cs + x0 * sn;
        }
    }
}
__device__ __forceinline__ void rope32_16(float (&a)[4], float (&b)[4], float rowp, float colp, int g4) {
    const bool hi = g4 >= 2;
#pragma unroll
    for (int i = 0; i < 4; ++i) {
        const float fr = __builtin_amdgcn_exp2f((float)(4 * (g4 & 1) + i) * -1.6609640474436813f) * 0.15915494309189535f;
        {
            const float rev = rowp * fr;
            const float sn = __builtin_amdgcn_sinf(rev), cs = __builtin_amdgcn_cosf(rev);
            const float own = a[i], oth = __shfl_xor(own, 32);
            a[i] = own * cs + oth * (hi ? sn : -sn);
        }
        {
            const float rev = colp * fr;
            const float sn = __builtin_amdgcn_sinf(rev), cs = __builtin_amdgcn_cosf(rev);
            const float own = b[i], oth = __shfl_xor(own, 32);
            b[i] = own * cs + oth * (hi ? sn : -sn);
        }
    }
}
__device__ __forceinline__ float ssq64(const float (&v)[4][4]) {
    float s = 0.f;
#pragma unroll
    for (int nt = 0; nt < 4; ++nt)
#pragma unroll
        for (int i = 0; i < 4; ++i) s += v[nt][i] * v[nt][i];
    s += __shfl_xor(s, 16);
    s += __shfl_xor(s, 32);
    return s;
}
__device__ __forceinline__ void mulvec64(float (&v)[4][4], const LAS float* gv, int g4) {
#pragma unroll
    for (int nt = 0; nt < 4; ++nt) {
        const f32x4 q = *(const LAS f32x4*)(gv + 16 * nt + 4 * g4);
#pragma unroll
        for (int i = 0; i < 4; ++i) v[nt][i] *= q[i];
    }
}
constexpr int OST_LD = 68, OST_BYTES = 32 * OST_LD * 4;
__device__ __forceinline__ void stage_write16(LAS float* st, const float (&v)[4][4], int mh, int c15, int g4) {
    asm volatile("s_waitcnt lgkmcnt(0)" ::: "memory");
    __builtin_amdgcn_wave_barrier();
#pragma unroll
    for (int nt = 0; nt < 4; ++nt) {
        f32x4 o = {v[nt][0], v[nt][1], v[nt][2], v[nt][3]};
        *(LAS f32x4*)(st + (16 * mh + c15) * OST_LD + 16 * nt + 4 * g4) = o;
    }
    asm volatile("s_waitcnt lgkmcnt(0)" ::: "memory");
    __builtin_amdgcn_wave_barrier();
}
__device__ __forceinline__ void stage_write16a(LAS float* st, const f32x4 (&a)[4][4], int mt, int c15, int g4) {
    asm volatile("s_waitcnt lgkmcnt(0)" ::: "memory");
    __builtin_amdgcn_wave_barrier();
#pragma unroll
    for (int nt = 0; nt < 4; ++nt) *(LAS f32x4*)(st + (16 * (mt & 1) + c15) * OST_LD + 16 * nt + 4 * g4) = a[nt][mt];
    asm volatile("s_waitcnt lgkmcnt(0)" ::: "memory");
    __builtin_amdgcn_wave_barrier();
}
__device__ __forceinline__ void stage_store_bf16(const LAS float* st, bf16_t* dst, int ld, float sc, int lane) {
#pragma unroll 1
    for (int it = 0; it < 4; ++it) {
        const int row = it * 8 + (lane >> 3), c8 = (lane & 7) * 8;
        const f32x4 x0 = *(const LAS f32x4*)(st + row * OST_LD + c8), x1 = *(const LAS f32x4*)(st + row * OST_LD + c8 + 4);
        u32x4 o; o.x = pk2(x0[0] * sc, x0[1] * sc); o.y = pk2(x0[2] * sc, x0[3] * sc); o.z = pk2(x1[0] * sc, x1[1] * sc); o.w = pk2(x1[2] * sc, x1[3] * sc);
        ST16_WT(dst + (size_t)row * ld + c8, o);
    }
}
__device__ __forceinline__ void stage_store_bf16_sc1(const LAS float* st, bf16_t* dst, int ld, int lane) {
#pragma unroll 1
    for (int it = 0; it < 4; ++it) {
        const int row = it * 8 + (lane >> 3), c8 = (lane & 7) * 8;
        const f32x4 x0 = *(const LAS f32x4*)(st + row * OST_LD + c8), x1 = *(const LAS f32x4*)(st + row * OST_LD + c8 + 4);
        u32x4 o; o.x = pk2(x0[0], x0[1]); o.y = pk2(x0[2], x0[3]); o.z = pk2(x1[0], x1[1]); o.w = pk2(x1[2], x1[3]);
        bf16_t* ptr = dst + (size_t)row * ld + c8;
        asm volatile("global_store_dwordx4 %0, %1, off sc1\n\ts_nop 1" :: "v"(ptr), "v"(o) : "memory");
    }
}
__device__ __forceinline__ void stage_store_f32(const LAS float* st, float* dst, int ld, int lane) {
#pragma unroll 1
    for (int it = 0; it < 8; ++it) {
        const int row = it * 4 + (lane >> 4), c = (lane & 15) * 4;
        { const f32x4 o = *(const LAS f32x4*)(st + row * OST_LD + c); ST16_WT(dst + (size_t)row * ld + c, o); }
    }
}
__device__ __forceinline__ void stage_store_bf16_32(const LAS float* st, bf16_t* dst, int ld, int lane) {
#pragma unroll 1
    for (int it = 0; it < 2; ++it) {
        const int row = it * 16 + (lane >> 2), c8 = (lane & 3) * 8;
        const f32x4 x0 = *(const LAS f32x4*)(st + row * OST_LD + c8), x1 = *(const LAS f32x4*)(st + row * OST_LD + c8 + 4);
        u32x4 o; o.x = pk2(x0[0], x0[1]); o.y = pk2(x0[2], x0[3]); o.z = pk2(x1[0], x1[1]); o.w = pk2(x1[2], x1[3]);
        ST16_WT(dst + (size_t)row * ld + c8, o);
    }
}
__device__ __forceinline__ void stage_store_f32_32(const LAS float* st, float* dst, int ld, int lane) {
#pragma unroll 1
    for (int it = 0; it < 4; ++it) {
        const int row = it * 8 + (lane >> 3), c = (lane & 7) * 4;
        { const f32x4 o = *(const LAS f32x4*)(st + row * OST_LD + c); ST16_WT(dst + (size_t)row * ld + c, o); }
    }
}

struct Gemm1Pre { float rstd[2]; float bias, gain; };
__device__ __forceinline__ void gemm1_pre(const Frame& F, const Params& p, int tn, int wn, int tm, int l, Gemm1Pre& P) {
    const float* ssqp = (const float*)(F.ws + WS_SSQ);
#pragma unroll
    for (int jj = 0; jj < 2; ++jj) {
        const int tok = tm * 256 + (F.w >> 2) * 128 + 64 * jj + F.lane;
        const f32x4* sp = (const f32x4*)(ssqp + (size_t)tok * 16);
        float ss = 0.f;
#pragma unroll
        for (int i = 0; i < 4; ++i) { const f32x4 q = sp[i]; ss += (q[0] + q[1]) + (q[2] + q[3]); }
        P.rstd[jj] = rsqrtf(ss * (1.f / 1024.f) + EPS);
    }
    const bool lat = tm >= 16;
    const int cond = lat ? 1 + ((tm - 16) >> 2) : 0;
    const int nb = tn * 128 + wn * 64;
    P.bias = (tn < 23) ? ((const float*)(F.ws + WS_BIAS))[(size_t)(l * 5 + cond) * 2944 + nb + F.lane] : 0.f;
    const float* gp = nullptr;
    if (tn >= 6 && tn < 9) gp = pin(F, I_GQN) + l * 64;
    else if (tn == 9) gp = pin(F, I_GKN) + l * 64;
    else if (tn == 11 || tn == 12) gp = pin(F, I_MQN) + l * 256 + (nb - 1408);
    else if (tn == 13) gp = pin(F, I_MKVN) + l * 128 + wn * 64;
    P.gain = gp ? gp[F.lane] : 1.f;
}
__device__ __forceinline__ void epi_gemm1(const Frame& F, const Params& p, GemmAcc8& acc, int tn, int wn, int tm, int l, const Gemm1Pre& P, bool ckv_tile) {
    int lane = F.lane; const int wm = F.w >> 2;
    asm volatile("" : "+v"(lane));
    const int c15 = lane & 15, g4 = lane >> 4;
    unsigned char* ws = F.ws;
    asm volatile("" : "+s"(ws));
    LAS float* st = (LAS float*)(F.lds + LDS_OST + F.w * OST_BYTES);
    const bool lat = tm >= 16;
    const int b = lat ? ((tm - 16) >> 2) : tm;
    const int nb = tn * 128 + wn * 64;
    LAS float* exb = (LAS float*)(F.lds + LDS_EXB) + F.w * 128;
    exb[lane] = P.bias; exb[64 + lane] = P.gain;
    asm volatile("s_waitcnt lgkmcnt(0)" ::: "memory");
    __builtin_amdgcn_wave_barrier();
    const LAS float* bias = exb;
    float* outp = p.out;
    asm volatile("" : "+s"(outp));
    float ckv_ss[8];
    if (tn < 23) {
#pragma unroll
    for (int mt = 0; mt < 8; ++mt) {
        const int mh = mt & 1;
        const int tok0 = tm * 256 + wm * 128 + (mt >> 1) * 32;
        const int tokb = tok0 + 16 * mh, tok = tokb + c15;
        const int t0 = lat ? ((tok0 - 4096) & 1023) : (tok0 & 255), t = t0 + 16 * mh + c15;
        const float rstd = __shfl(P.rstd[mt >> 2], 16 * (mt & 3) + c15);
        float v[4][4];
#pragma unroll
        for (int nt = 0; nt < 4; ++nt) {
            const f32x4 bq = *(const LAS f32x4*)(bias + 16 * nt + 4 * g4);
#pragma unroll
            for (int i = 0; i < 4; ++i) v[nt][i] = acc[nt][mt][i] * rstd + bq[i];
        }
        const float rowp = (float)(t >> 6), colp = (float)(t & 63);
        const size_t orow0 = (size_t)(b * 4 + l) * 256 + t0;
        if (tn < 2) {
            if (lat) rope64_16(v, rowp, colp, g4);
            stage_write16(st, v, mh, c15, g4);
            if (mh) stage_store_bf16(st, (bf16_t*)(ws + WS_RQ) + (size_t)tok0 * 256 + nb, 256, 1.f, lane);
        } else if (tn < 4) {
            if (lat) rope64_16(v, rowp, colp, g4);
            stage_write16(st, v, mh, c15, g4);
            if (mh) stage_store_bf16(st, (bf16_t*)(ws + WS_RK) + (size_t)tok0 * 256 + (nb - 256), 256, 0.125f, lane);
        } else if (tn < 6) {
            stage_write16(st, v, mh, c15, g4);
            if (mh) stage_store_bf16(st, (bf16_t*)(ws + WS_RV) + (size_t)tok0 * 256 + (nb - 512), 256, 1.f, lane);
        } else if (tn < 9) {
            const float r = rsqrtf(ssq64(v) * (1.f / 64.f) + EPS);
#pragma unroll
            for (int nt = 0; nt < 4; ++nt)
#pragma unroll
                for (int i = 0; i < 4; ++i) v[nt][i] *= r;
            mulvec64(v, exb + 64, g4);
            if (lat) rope64_16(v, rowp, colp, g4);
            stage_write16(st, v, mh, c15, g4);
            if (mh) stage_store_bf16(st, (bf16_t*)(ws + WS_GQ) + (size_t)tok0 * 384 + (nb - 768), 384, QSC_GQA, lane);
        } else if (tn == 9) {
            const float r = rsqrtf(ssq64(v) * (1.f / 64.f) + EPS);
#pragma unroll
            for (int nt = 0; nt < 4; ++nt)
#pragma unroll
                for (int i = 0; i < 4; ++i) v[nt][i] *= r;
            mulvec64(v, exb + 64, g4);
            if (lat) rope64_16(v, rowp, colp, g4);
            stage_write16(st, v, mh, c15, g4);
            if (mh) {
                if (!lat) stage_store_f32(st, outp + O_GK + orow0 * 128 + (nb - 1152), 128, lane);
                stage_store_bf16(st, (bf16_t*)(ws + WS_GK) + (size_t)tok0 * 128 + (nb - 1152), 128, 1.f, lane);
            }
        } else if (tn == 10) {
            stage_write16(st, v, mh, c15, g4);
            if (mh) {
                if (!lat) stage_store_f32(st, outp + O_GV + orow0 * 128 + (nb - 1280), 128, lane);
                stage_store_bf16(st, (bf16_t*)(ws + WS_GV) + (size_t)tok0 * 128 + (nb - 1280), 128, 1.f, lane);
            }
        } else if (tn < 13) {
            const float s2 = ssq64(v);
            if (g4 == 0) __hip_atomic_store((__attribute__((address_space(1))) float*)((float*)(ws + WS_CQSSQ) + (size_t)tok * 4 + ((nb - 1408) >> 6)), s2, __ATOMIC_RELAXED, __HIP_MEMORY_SCOPE_AGENT);
            mulvec64(v, exb + 64, g4);
            stage_write16(st, v, mh, c15, g4);
            if (mh) stage_store_bf16_sc1(st, (bf16_t*)(ws + WS_CQG) + (size_t)tok0 * 256 + (nb - 1408), 256, lane);
        } else if (tn == 13) {
            ckv_ss[mt] = ssq64(v);
            if (g4 == 0) ((LAS float*)(F.lds + LDS_EX))[(wm * 2 + wn) * 128 + mt * 16 + c15] = ckv_ss[mt];
        } else if (tn < 22) {
#pragma unroll
            for (int nt = 0; nt < 4; ++nt)
#pragma unroll
                for (int i = 0; i < 4; ++i) v[nt][i] = silu_f(v[nt][i]);
            stage_write16(st, v, mh, c15, g4);
            if (mh) stage_store_bf16(st, (bf16_t*)(ws + WS_ZS) + (size_t)tok0 * 1024 + (nb - 1792), 1024, 1.f, lane);
        } else {
            if (wn == 0) {
                if (lat) rope32_16(v[0], v[1], rowp, colp, g4);
                stage_write16(st, v, mh, c15, g4);
                if (mh) {
                    if (!lat) stage_store_f32_32(st, outp + O_KPE + orow0 * 32, 32, lane);
                    stage_store_bf16_32(st, (bf16_t*)(ws + WS_KPEB) + (size_t)tok0 * 32, 32, lane);
                }
            }
        }
    }
    }
    if (ckv_tile) {
        __syncthreads();
        if (tn == 13) {
#pragma unroll
        for (int mt = 0; mt < 8; ++mt) {
            const int mh = mt & 1;
            const int tok0 = tm * 256 + wm * 128 + (mt >> 1) * 32;
            const int t0 = lat ? ((tok0 - 4096) & 1023) : (tok0 & 255);
            const float rstd = __shfl(P.rstd[mt >> 2], 16 * (mt & 3) + c15);
            float v[4][4];
#pragma unroll
            for (int nt = 0; nt < 4; ++nt) {
                const f32x4 bq = *(const LAS f32x4*)(bias + 16 * nt + 4 * g4);
#pragma unroll
                for (int i = 0; i < 4; ++i) v[nt][i] = acc[nt][mt][i] * rstd + bq[i];
            }
            const float tot = ckv_ss[mt] + ((const LAS float*)(F.lds + LDS_EX))[(wm * 2 + (wn ^ 1)) * 128 + mt * 16 + c15];
            const float r = rsqrtf(tot * (1.f / 128.f) + EPS);
#pragma unroll
            for (int nt = 0; nt < 4; ++nt)
#pragma unroll
                for (int i = 0; i < 4; ++i) v[nt][i] *= r;
            mulvec64(v, exb + 64, g4);
            const size_t orow0 = (size_t)(b * 4 + l) * 256 + t0;
            stage_write16(st, v, mh, c15, g4);
            if (mh) {
                if (!lat) stage_store_f32(st, outp + O_CKV + orow0 * 128 + wn * 64, 128, lane);
                stage_store_bf16_sc1(st, (bf16_t*)(ws + WS_CKVN) + (size_t)tok0 * 128 + wn * 64, 128, lane);
            }
        }
        }
        __syncthreads();
    }
}

__device__ __forceinline__ void qm_pre(const Frame& F, int tm, float& rstd) {
    const int tok = tm * 256 + (F.w >> 1) * 64 + F.lane;
    const f32x4 q4 = *(const f32x4*)((const float*)(F.ws + WS_CQSSQ) + (size_t)tok * 4);
    rstd = rsqrtf(((q4[0] + q4[1]) + (q4[2] + q4[3])) * (1.f / 256.f) + EPS);
}
__device__ __forceinline__ void epi_qm(const Frame& F, GemmAcc& acc, int tn, int tm, float rstdl) {
    int lane = F.lane; const int wn = F.w & 1, wm = F.w >> 1;
    asm volatile("" : "+v"(lane));
    const int c15 = lane & 15, g4 = lane >> 4;
    unsigned char* ws = F.ws;
    LAS float* st = (LAS float*)(F.lds + LDS_OST + F.w * OST_BYTES);
    const bool lat = tm >= 16;
    const int nb = tn * 128 + wn * 64;
    if (nb >= 576) return;
#pragma unroll
    for (int mt = 0; mt < 4; ++mt) {
        const int mh = mt & 1;
        const int tok0 = tm * 256 + wm * 64 + (mt >> 1) * 32, tok = tok0 + 16 * mh + c15;
        const int t = lat ? ((tok - 4096) & 1023) : (tok & 255);
        const float rstd = __shfl(rstdl, 16 * mt + c15);
        const float rowp = (float)(t >> 6), colp = (float)(t & 63);
        float v[4][4];
#pragma unroll
        for (int nt = 0; nt < 4; ++nt)
#pragma unroll
            for (int i = 0; i < 4; ++i) v[nt][i] = acc[nt][mt][i] * rstd;
#pragma unroll
        for (int q = 0; q < 2; ++q) {
            const int T = (nb + 32 * q) >> 5;
            if (lat && (T % 3) == 2) rope32_16(v[2 * q], v[2 * q + 1], rowp, colp, g4);
        }
        stage_write16(st, v, mh, c15, g4);
        if (mh) stage_store_bf16(st, (bf16_t*)(ws + WS_QM) + (size_t)tok0 * 576 + nb, 576, QSC_MLA, lane);
    }
}
__device__ __forceinline__ void epi_plain(const Frame& F, GemmAcc& acc, bf16_t* D, int ldd, int row0, int n0) {
    int lane = F.lane; const int wn = F.w & 1, wm = F.w >> 1;
    asm volatile("" : "+v"(lane));
    const int c15 = lane & 15, g4 = lane >> 4;
    LAS float* st = (LAS float*)(F.lds + LDS_OST + F.w * OST_BYTES);
#pragma unroll
    for (int mt = 0; mt < 4; ++mt) {
        const int r0 = row0 + wm * 64 + (mt >> 1) * 32;
        stage_write16a(st, acc, mt, c15, g4);
        if (mt & 1) stage_store_bf16(st, D + (size_t)r0 * ldd + n0 + wn * 64, ldd, 1.f, lane);
    }
}

struct Gemm2Pre { f32x4 gt0, gt1, gs0, gs1; };
__device__ __forceinline__ void gemm2_pre(const Frame& F, int tn, int tm, int l, Gemm2Pre& P) {
    const bool lat = tm >= 16; const int cond = lat ? 1 + ((tm - 16) >> 2) : 0;
    const int nb = tn * 128 + (F.w & 1) * 64, c8 = (F.lane & 7) * 8;
    const float* gtp = (const float*)(F.ws + WS_MODS) + (size_t)(l * 5 + cond) * 3072 + 2048 + nb + c8;
    const float* gsp = (const float*)(F.ws + WS_GS) + (size_t)((l < 3 ? l + 1 : 3) * 5 + cond) * 1024 + nb + c8;
    P.gt0 = *(const f32x4*)gtp; P.gt1 = *(const f32x4*)(gtp + 4);
    P.gs0 = *(const f32x4*)gsp; P.gs1 = *(const f32x4*)(gsp + 4);
}
__device__ __forceinline__ void epi_gemm2(const Frame& F, const Params& p, GemmAcc& acc, int tn, int tm, int l, const Gemm2Pre& P, bool last) {
    int lane = F.lane; const int wn = F.w & 1, wm = F.w >> 1;
    asm volatile("" : "+v"(lane));
    const int c15 = lane & 15, g4 = lane >> 4;
    unsigned char* ws = F.ws;
    LAS float* st = (LAS float*)(F.lds + LDS_OST + F.w * OST_BYTES);
    const bool lat = tm >= 16;
    const int nb = tn * 128 + wn * 64;
    const int c8 = (lane & 7) * 8, r8 = lane >> 3;
#pragma unroll
    for (int mt = 0; mt < 2; ++mt) {
        const int tok0 = tm * 256 + wm * 64 + mt * 32;
        stage_write16a(st, acc, 2 * mt, c15, g4);
        stage_write16a(st, acc, 2 * mt + 1, c15, g4);
        bf16_t* xb0 = (bf16_t*)(ws + WS_XB) + (size_t)tok0 * 1024 + nb + c8;
        f32x4 xo8[8];
        if (l == 0) {
            const float* xold0 = lat ? pin(F, I_XS) + (size_t)(tok0 - 4096) * 1024 : pin(F, I_XP) + (size_t)tok0 * 1024;
#pragma unroll
            for (int it = 0; it < 4; ++it) {
                const float* xp = xold0 + (size_t)(it * 8 + r8) * 1024 + nb + c8;
                xo8[2 * it] = *(const f32x4*)xp; xo8[2 * it + 1] = *(const f32x4*)(xp + 4);
            }
        } else {
#pragma unroll
            for (int it = 0; it < 4; ++it) {
                const u32x4 q = *(const u32x4*)(xb0 + (size_t)(it * 8 + r8) * 1024);
                xo8[2 * it] = (f32x4){bflo(q.x), bfhi(q.x), bflo(q.y), bfhi(q.y)}; xo8[2 * it + 1] = (f32x4){bflo(q.z), bfhi(q.z), bflo(q.w), bfhi(q.w)};
            }
        }
#pragma unroll
        for (int it = 0; it < 4; ++it) {
            const int row = it * 8 + r8;
            const f32x4 a0 = *(const LAS f32x4*)(st + row * OST_LD + c8), a1 = *(const LAS f32x4*)(st + row * OST_LD + c8 + 4);
            const f32x4 xn0 = xo8[2 * it] + P.gt0 * a0, xn1 = xo8[2 * it + 1] + P.gt1 * a1;
            {
                u32x4 o; o.x = pk2(xn0[0], xn0[1]); o.y = pk2(xn0[2], xn0[3]); o.z = pk2(xn1[0], xn1[1]); o.w = pk2(xn1[2], xn1[3]);
                if (last) ST16_WT(xb0 + (size_t)row * 1024, o); else *(u32x4*)(xb0 + (size_t)row * 1024) = o;
            }
            float ss = ((xn0[0] * xn0[0] + xn0[1] * xn0[1]) + (xn0[2] * xn0[2] + xn0[3] * xn0[3])) + ((xn1[0] * xn1[0] + xn1[1] * xn1[1]) + (xn1[2] * xn1[2] + xn1[3] * xn1[3]));
            ss += __shfl_xor(ss, 1); ss += __shfl_xor(ss, 2); ss += __shfl_xor(ss, 4);
            if ((lane & 7) == 0) {
                float* sq = (float*)(ws + WS_SSQ) + (size_t)(tok0 + row) * 16 + tn * 2 + wn;
                if (last) __hip_atomic_store((__attribute__((address_space(1))) float*)sq, ss, __ATOMIC_RELAXED, __HIP_MEMORY_SCOPE_AGENT);
                else *sq = ss;
            }
            if (l < 3) {
                u32x4 o; o.x = pk2(xn0[0] * P.gs0[0], xn0[1] * P.gs0[1]); o.y = pk2(xn0[2] * P.gs0[2], xn0[3] * P.gs0[3]);
                o.z = pk2(xn1[0] * P.gs1[0], xn1[1] * P.gs1[1]); o.w = pk2(xn1[2] * P.gs1[2], xn1[3] * P.gs1[3]);
                *(u32x4*)((bf16_t*)(ws + WS_XG) + (size_t)(tok0 + row) * 1024 + nb + c8) = o;
            }
        }
    }
}
constexpr int AT_STG = 20480, AT_PE = 8192, AT_V = 12288, AT_OLD = 68;
struct AttnUnit {
    int mode;
    int nt0, nt1;
    const bf16_t *q; int q_ld;
    const bf16_t *k0, *k1; int k_ld0, k_ld1;
    const bf16_t *pe0, *pe1;
    const bf16_t *v0, *v1; int v_ld0, v_ld1;
    int tok0;
    int ycol;
    int qpos0, L;
    float lf, lb;
    const bf16_t *s0f, *s0b;
    unsigned* zflag;
    unsigned* yflag;
    float* st_out;
};
__device__ __forceinline__ s16x4 tr16(LAS const unsigned char* p) {
    typedef short v4i16_t __attribute__((ext_vector_type(4)));
    return __builtin_bit_cast(s16x4, __builtin_amdgcn_ds_read_tr16_b64_v4i16((LAS v4i16_t*)p));
}

template <int MODE>
__device__ __forceinline__ void attn_unit(const Frame& F, const Params& p, const AttnUnit& U) {
    constexpr int NQS = MODE == 1 ? 6 : 4;
    const int lane = F.lane, w = F.w, h = F.h, lq = F.lq;
    LAS unsigned char* lds = F.lds;
    const int k_ld = U.k_ld1, v_ld = U.v_ld1;
    const int krow = 8 * w + (lane >> 3);
    const int koff = krow * k_ld + ((lane & 7) ^ ((krow >> 1) & 7)) * 8;
    const int poff = (16 * (w & 3) + (lane >> 2)) * 32 + ((lane & 3) ^ ((lane >> 4) & 3)) * 8;
    const int vdblk = w >> 2, vkg = w & 3;
    const int voff = (16 * vkg + (lane >> 2)) * v_ld + vdblk * 32 + (lane & 3) * 8;
    const int vdst = AT_V + vdblk * 4096 + vkg * 1024;
    const int nt0 = U.nt0, ntot = U.nt0 + U.nt1;
    const unsigned ldsb = (unsigned)(uintptr_t)lds;
#define AT_DMA(gsrc, ldsoff) do { unsigned _keep; const unsigned _d = (unsigned)__builtin_amdgcn_readfirstlane((int)(ldsb + (unsigned)(ldsoff))); \
        asm volatile("s_mov_b32 %0, m0\n\ts_mov_b32 m0, %2\n\ts_nop 0\n\tglobal_load_lds_dwordx4 %1, off\n\ts_mov_b32 m0, %0" : "=&s"(_keep) : "v"(gsrc), "s"(_d) : "memory"); } while (0)
#define AT_ISSUE(t, st) do { const int _t = (t); const int _b = (st) * AT_STG; \
        const bool _s0 = _t < nt0; const int _u = _s0 ? _t : _t - nt0; \
        const bf16_t* _kb = (_s0 ? U.k0 : U.k1) + (size_t)_u * 64 * k_ld; const bf16_t* _vb = (_s0 ? U.v0 : U.v1) + (size_t)_u * 64 * v_ld; \
        AT_DMA(_kb + koff, _b + (8 * w) * 128); \
        if (MODE == 1) { const bf16_t* _pb = (_s0 ? U.pe0 : U.pe1) + (size_t)_u * 64 * 32; AT_DMA(_pb + poff, _b + AT_PE + 16 * (w & 3) * 64); } \
        AT_DMA(_vb + voff, _b + vdst); } while (0)
    AT_ISSUE(0, 0);
    if (ntot > 1) AT_ISSUE(1, 1);
    bf16x8 qr[NQS];
    if (MODE == 3) {
        const int dk = 32 * (w & 1) + lq;
#pragma unroll
        for (int s = 0; s < 4; ++s)
#pragma unroll
            for (int j = 0; j < 8; ++j) qr[s][j] = (16 * s + 8 * h + j == dk) ? (short)0x3F80 : (short)0;
    } else {
        const bf16_t* qp = U.q + (size_t)(32 * w + lq) * U.q_ld + 8 * h;
#pragma unroll
        for (int s = 0; s < NQS; ++s) qr[s] = *(const bf16x8*)(qp + 16 * s);
    }
    f32x16 o[2];
#pragma unroll
    for (int d = 0; d < 2; ++d)
#pragma unroll
        for (int r = 0; r < 16; ++r) o[d][r] = 0.f;
    float m_run = 0.f, l_run = 0.f;
    f32x16 negm;
#pragma unroll
    for (int r = 0; r < 16; ++r) negm[r] = 0.f;
    const int qpos = U.qpos0 + 32 * w + lq;
    const float st_slope = ((w >> 1) & 1) ? U.lb : -U.lf, st_off = ((w >> 1) & 1) ? 0.f : 255.f * U.lf;
    const int sdir = (w >> 1) & 1;
    LAS float* scal = (LAS float*)(lds + LDS_SCAL) + w * 32;
    LAS float* ctab = (LAS float*)(lds + LDS_EXB) + w * 128;
    float a_f = 0.f, a_b = 0.f;
    if (MODE == 2) {
        ctab[lane] = __builtin_amdgcn_exp2f((float)(63 - lane) * U.lf);
        ctab[64 + lane] = __builtin_amdgcn_exp2f((float)lane * U.lb);
        a_f = __builtin_amdgcn_exp2f((float)(32 * w + lq) * U.lf);
        a_b = __builtin_amdgcn_exp2f((float)(255 - 32 * w - lq) * U.lb);
        asm volatile("s_waitcnt lgkmcnt(0)" ::: "memory");
        __builtin_amdgcn_wave_barrier();
    }
    const int kfo = lq * 128, sw = (lane >> 1) & 7, pfo = AT_PE + lq * 64, psw = (lane >> 2) & 3;
    const int vfo = AT_V + (4 * h + ((lane & 15) >> 2)) * 64 + ((lane >> 4) & 1) * 32 + (lane & 3) * 8;
    int st = 0;
    for (int t = 0; t < ntot; ++t) {
        if (t + 1 < ntot) { if (MODE == 1) asm volatile("s_waitcnt vmcnt(3)" ::: "memory"); else asm volatile("s_waitcnt vmcnt(2)" ::: "memory"); }
        else asm volatile("s_waitcnt vmcnt(0)" ::: "memory");
        __builtin_amdgcn_s_barrier();
        asm volatile("" ::: "memory");
        const int st2 = st == 0 ? 2 : st - 1;
        if (t + 2 < ntot) AT_ISSUE(t + 2, st2);
        LAS const unsigned char* base = lds + st * AT_STG;
        bf16x8 kfa[NQS], kfb[NQS];
#pragma unroll
        for (int s = 0; s < 4; ++s) {
            const int so = ((2 * s + h) ^ sw) << 4;
            kfa[s] = *(const LAS bf16x8*)(base + kfo + so);
            kfb[s] = *(const LAS bf16x8*)(base + kfo + 4096 + so);
        }
        if (MODE == 1) {
#pragma unroll
            for (int s = 0; s < 2; ++s) {
                const int so = ((2 * s + h) ^ psw) << 4;
                kfa[4 + s] = *(const LAS bf16x8*)(base + pfo + so);
                kfb[4 + s] = *(const LAS bf16x8*)(base + pfo + 2048 + so);
            }
        }
        f32x16 p0, p1;
        if (MODE <= 1) { p0 = negm; p1 = negm; }
        else {
#pragma unroll
            for (int r = 0; r < 16; ++r) { p0[r] = 0.f; p1[r] = 0.f; }
        }
#pragma unroll
        for (int s = 0; s < NQS; ++s) { p0 = MFMA32(kfa[s], qr[s], p0); p1 = MFMA32(kfb[s], qr[s], p1); }
        s16x4 vlo[4], vhi[4];
#pragma unroll
        for (int ks = 0; ks < 4; ++ks) { vlo[ks] = tr16(base + vfo + ks * 1024); vhi[ks] = tr16(base + vfo + ks * 1024 + 512); }
        if (MODE <= 1) {
            float tm = p0[0];
#pragma unroll
            for (int r = 1; r < 16; ++r) tm = fmaxf(tm, p0[r]);
#pragma unroll
            for (int r = 0; r < 16; ++r) tm = fmaxf(tm, p1[r]);
            tm = fmaxf(tm, __shfl_xor(tm, 32));
            if (t == 0 || __any(tm > 6.0f)) {
                const float dl = t == 0 ? tm : fmaxf(tm, 0.f);
                m_run += dl;
#pragma unroll
                for (int r = 0; r < 16; ++r) { p0[r] -= dl; p1[r] -= dl; negm[r] = -m_run; }
                if (t > 0) {
                    const float alpha = __builtin_amdgcn_exp2f(-dl);
                    l_run *= alpha;
                    if (h == 0) scal[lq] = alpha;
                    asm volatile("s_waitcnt lgkmcnt(0)" ::: "memory");
#pragma unroll
                    for (int g = 0; g < 4; ++g) {
                        const f32x4 a4 = *(const LAS f32x4*)(scal + 8 * g + 4 * h);
#pragma unroll
                        for (int i = 0; i < 4; ++i) { o[0][4 * g + i] *= a4[i]; o[1][4 * g + i] *= a4[i]; }
                    }
                }
            }
            float ls = 0.f;
#pragma unroll
            for (int r = 0; r < 16; ++r) { p0[r] = __builtin_amdgcn_exp2f(p0[r]); p1[r] = __builtin_amdgcn_exp2f(p1[r]); ls += p0[r] + p1[r]; }
            l_run += ls;
        } else if (MODE == 2 && (64 * t + 63 < U.qpos0 || 64 * t > U.qpos0 + 255)) {
            const bool fwd = 64 * t + 63 < U.qpos0;
            const float A = fwd ? a_f * __builtin_amdgcn_exp2f((float)(U.qpos0 - 64 * t - 63) * U.lf) : a_b * __builtin_amdgcn_exp2f((float)(64 * t - U.qpos0 - 255) * U.lb);
            const LAS float* tb = ctab + (fwd ? 0 : 64) + 4 * h;
#pragma unroll
            for (int g = 0; g < 4; ++g) {
                const f32x4 c0 = *(const LAS f32x4*)(tb + 8 * g), c1 = *(const LAS f32x4*)(tb + 32 + 8 * g);
#pragma unroll
                for (int i = 0; i < 4; ++i) { p0[4 * g + i] *= c0[i] * A; p1[4 * g + i] *= c1[i] * A; }
            }
        } else if (MODE == 2) {
            float dq = (float)(qpos - 64 * t - 4 * h);
            asm volatile("" : "+v"(dq));
#pragma unroll
            for (int r = 0; r < 16; ++r) {
                const float d0 = dq - (float)((r & 3) + 8 * (r >> 2)), d1 = d0 - 32.f;
                const float w0 = __builtin_amdgcn_exp2f(fabsf(d0) * (d0 > 0.f ? U.lf : U.lb));
                const float w1 = __builtin_amdgcn_exp2f(fabsf(d1) * (d1 > 0.f ? U.lf : U.lb));
                p0[r] *= (d0 == 0.f ? 2.f : w0);
                p1[r] *= (d1 == 0.f ? 2.f : w1);
            }
        } else {
            float mb = (float)(64 * t + 4 * h);
            asm volatile("" : "+v"(mb));
#pragma unroll
            for (int r = 0; r < 16; ++r) {
                const float m0 = mb + (float)((r & 3) + 8 * (r >> 2)), m1 = m0 + 32.f;
                const float e0 = fmaf(m0, st_slope, st_off), e1 = fmaf(m1, st_slope, st_off);
                p0[r] *= __builtin_amdgcn_exp2f(e0);
                p1[r] *= __builtin_amdgcn_exp2f(e1);
            }
        }
        bf16x8 pa[4];
        { u32x4 a;
          a.x = pk2(p0[0], p0[1]); a.y = pk2(p0[2], p0[3]); a.z = pk2(p0[4], p0[5]); a.w = pk2(p0[6], p0[7]); pa[0] = __builtin_bit_cast(bf16x8, a);
          a.x = pk2(p0[8], p0[9]); a.y = pk2(p0[10], p0[11]); a.z = pk2(p0[12], p0[13]); a.w = pk2(p0[14], p0[15]); pa[1] = __builtin_bit_cast(bf16x8, a);
          a.x = pk2(p1[0], p1[1]); a.y = pk2(p1[2], p1[3]); a.z = pk2(p1[4], p1[5]); a.w = pk2(p1[6], p1[7]); pa[2] = __builtin_bit_cast(bf16x8, a);
          a.x = pk2(p1[8], p1[9]); a.y = pk2(p1[10], p1[11]); a.z = pk2(p1[12], p1[13]); a.w = pk2(p1[14], p1[15]); pa[3] = __builtin_bit_cast(bf16x8, a); }
#pragma unroll
        for (int ks = 0; ks < 4; ++ks) {
            const bf16x8 vb = __builtin_shufflevector(vlo[ks], vhi[ks], 0, 1, 2, 3, 4, 5, 6, 7);
            o[0] = MFMA32(pa[ks], vb, o[0]);
        }
#pragma unroll
        for (int ks = 0; ks < 4; ++ks) { vlo[ks] = tr16(base + vfo + 4096 + ks * 1024); vhi[ks] = tr16(base + vfo + 4096 + ks * 1024 + 512); }
#pragma unroll
        for (int ks = 0; ks < 4; ++ks) {
            const bf16x8 vb = __builtin_shufflevector(vlo[ks], vhi[ks], 0, 1, 2, 3, 4, 5, 6, 7);
            o[1] = MFMA32(pa[ks], vb, o[1]);
        }
        st = st == 2 ? 0 : st + 1;
    }
#undef AT_ISSUE
#undef AT_DMA
    int lq2 = lq, h2 = h, lane2 = lane; asm volatile("" : "+v"(lq2), "+v"(h2), "+v"(lane2));
    if (MODE == 2 && U.s0f != nullptr) {
        const float ff = __builtin_amdgcn_exp2f((float)(qpos + 1) * U.lf), fb = __builtin_amdgcn_exp2f((float)(U.L - qpos) * U.lb);
#pragma unroll
        for (int s = 0; s < 4; ++s) {
            const u32x4 qu = __builtin_bit_cast(u32x4, qr[s]);
            u32x4 af, ab;
#pragma unroll
            for (int i = 0; i < 4; ++i) { const float lo = bflo(qu[i]), hi = bfhi(qu[i]); af[i] = pk2(lo * ff, hi * ff); ab[i] = pk2(lo * fb, hi * fb); }
#pragma unroll
            for (int d = 0; d < 2; ++d) {
                const bf16x8 sf = *(const bf16x8*)(U.s0f + (size_t)(32 * d + lq2) * 64 + 16 * s + 8 * h2);
                const bf16x8 sb = *(const bf16x8*)(U.s0b + (size_t)(32 * d + lq2) * 64 + 16 * s + 8 * h2);
                o[d] = MFMA32(__builtin_bit_cast(bf16x8, af), sf, o[d]);
                o[d] = MFMA32(__builtin_bit_cast(bf16x8, ab), sb, o[d]);
            }
        }
    }
    if (MODE == 3) {
        float* dst = U.st_out + (size_t)sdir * 4 * 4096 + (size_t)(32 * (w & 1)) * 64;
        if (w < 4) {
#pragma unroll
        for (int d = 0; d < 2; ++d)
#pragma unroll
            for (int r = 0; r < 16; ++r) dst[(size_t)((r & 3) + 8 * (r >> 2) + 4 * h2) * 64 + 32 * d + lq2] = o[d][r];
        }
        __syncthreads();
        return;
    }
    if (MODE <= 1) {
        l_run += __shfl_xor(l_run, 32);
        if (h2 == 0) scal[lq2] = 1.f / l_run;
    }
    if (U.zflag != nullptr && F.tid == 0) {
        unsigned* bar0 = (unsigned*)(F.ws + WS_CTL) + CW_BAR;
        XB_SPIN(xb_ld(U.zflag) < 4u, bar0);
    }
    __syncthreads();
    LAS float* ost = (LAS float*)lds + w * (32 * AT_OLD);
#pragma unroll
    for (int d = 0; d < 2; ++d)
#pragma unroll
        for (int r = 0; r < 16; ++r) ost[((r & 3) + 8 * (r >> 2) + 4 * h2) * AT_OLD + 32 * d + lq2] = o[d][r];
    asm volatile("s_waitcnt lgkmcnt(0)" ::: "memory");
    __builtin_amdgcn_wave_barrier();
    const bf16_t* zs = (const bf16_t*)(F.ws + WS_ZS);
    bf16_t* yb = (bf16_t*)(F.ws + WS_Y);
#pragma unroll
    for (int it = 0; it < 4; ++it) {
        const int row = it * 8 + (lane2 >> 3), c8 = (lane2 & 7) * 8;
        const f32x4 x0 = *(const LAS f32x4*)(ost + row * AT_OLD + c8), x1 = *(const LAS f32x4*)(ost + row * AT_OLD + c8 + 4);
        float sc;
        if (MODE <= 1) sc = scal[row];
        else {
            float ss = (x0[0] * x0[0] + x0[1] * x0[1]) + (x0[2] * x0[2] + x0[3] * x0[3]) + (x1[0] * x1[0] + x1[1] * x1[1]) + (x1[2] * x1[2] + x1[3] * x1[3]);
            ss += __shfl_xor(ss, 1); ss += __shfl_xor(ss, 2); ss += __shfl_xor(ss, 4);
            sc = rsqrtf(ss * (1.f / 64.f) + EPS);
        }
        const size_t off = (size_t)(U.tok0 + 32 * w + row) * 1024 + U.ycol + c8;
        const u32x4 z = *(const u32x4*)(zs + off);
        u32x4 y;
        y.x = pk2(x0[0] * sc * bflo(z.x), x0[1] * sc * bfhi(z.x));
        y.y = pk2(x0[2] * sc * bflo(z.y), x0[3] * sc * bfhi(z.y));
        y.z = pk2(x1[0] * sc * bflo(z.z), x1[1] * sc * bfhi(z.z));
        y.w = pk2(x1[2] * sc * bflo(z.w), x1[3] * sc * bfhi(z.w));
        ST16_WT(yb + off, y);
    }
    asm volatile("s_waitcnt vmcnt(0)" ::: "memory");
    __syncthreads();
    if (F.tid == 0) (void)xb_add(U.yflag, 1u);
}

__device__ __forceinline__ void dep_wait(const Frame& F, unsigned* c, int n, unsigned target) {
    if (F.tid == 0) {
        unsigned* bar0 = (unsigned*)(F.ws + WS_CTL) + CW_BAR;
        for (int i = 0; i < n; ++i) { XB_SPIN(xb_ld(c + 4 * i) < target, bar0); }
    }
}
__device__ __forceinline__ void attn_dispatch(const Frame& F, const Params& p, int u, int l) {
    unsigned char* ws = F.ws;
    AttnUnit U;
    U.nt0 = 0; U.nt1 = 0; U.q = nullptr; U.q_ld = 0; U.k0 = U.k1 = nullptr; U.k_ld0 = U.k_ld1 = 0; U.pe0 = U.pe1 = nullptr; U.v0 = U.v1 = nullptr; U.v_ld0 = U.v_ld1 = 0;
    U.tok0 = 0; U.ycol = 0; U.qpos0 = 0; U.L = 0; U.lf = U.lb = 0.f; U.s0f = U.s0b = nullptr; U.st_out = nullptr; U.mode = 0; U.yflag = nullptr; U.zflag = nullptr;
    const bf16_t* GQ = (const bf16_t*)(ws + WS_GQ); const bf16_t* GK = (const bf16_t*)(ws + WS_GK); const bf16_t* GV = (const bf16_t*)(ws + WS_GV);
    const bf16_t* QM = (const bf16_t*)(ws + WS_QM); const bf16_t* KVM = (const bf16_t*)(ws + WS_KVM); const bf16_t* KVMC = (const bf16_t*)(ws + WS_KVMC);
    const bf16_t* KPEB = (const bf16_t*)(ws + WS_KPEB); const bf16_t* CKPE = (const bf16_t*)(ws + WS_CKPE);
    const bf16_t* CGK = (const bf16_t*)(ws + WS_CGK); const bf16_t* CGV = (const bf16_t*)(ws + WS_CGV);
    const bf16_t* RQ = (const bf16_t*)(ws + WS_RQ); const bf16_t* RK = (const bf16_t*)(ws + WS_RK); const bf16_t* RV = (const bf16_t*)(ws + WS_RV);
    const float* decay = pin(F, I_DECAY) + l * 8;
    if (u < 96 || (u >= 256 && u < 352)) {
        const bool lat = u < 96; const int uu = lat ? u : u - 256;
        const int b = lat ? uu / 24 : uu / 6, hh = lat ? (uu >> 2) % 6 : uu % 6, qb = lat ? (uu & 3) : 0;
        const int seq0 = lat ? 4096 + b * 1024 : b * 256;
        U.mode = 1; U.tok0 = seq0 + qb * 256; U.q = QM + (size_t)U.tok0 * 576 + hh * 96; U.q_ld = 576; U.ycol = 640 + hh * 64;
        U.nt1 = lat ? 16 : 4; U.k1 = KVM + (size_t)seq0 * 768 + hh * 128; U.k_ld1 = 768; U.v1 = U.k1 + 64; U.v_ld1 = 768; U.pe1 = KPEB + (size_t)seq0 * 32;
        U.k0 = U.k1; U.v0 = U.v1; U.pe0 = U.pe1; U.k_ld0 = 768; U.v_ld0 = 768;
        if (lat) { U.nt0 = 8; U.k0 = KVMC + (size_t)(b * 512) * 768 + hh * 128; U.v0 = U.k0 + 64; U.pe0 = CKPE + (size_t)((b * 4 + l) * 512) * 32; }
        U.yflag = (unsigned*)(ws + WS_CTL) + CW_YRDY + (l * 32 + (U.tok0 >> 8)) * 4;
        { unsigned* c = (unsigned*)(ws + WS_CTL);
          dep_wait(F, c + CW_FULL + (l * 32 + (seq0 >> 8)) * 4, lat ? 4 : 1, 23u);
          if (lat) dep_wait(F, c + CW_KC + (l * 4 + b) * 4, 1, 12u); }
        __syncthreads();
        attn_unit<1>(F, p, U);
    } else if (u < 192 || (u >= 352 && u < 448)) {
        const bool lat = u < 192; const int uu = lat ? u - 96 : u - 352;
        const int b = lat ? uu / 24 : uu / 6, hh = lat ? (uu >> 2) % 6 : uu % 6, qb = lat ? (uu & 3) : 0, kvh = hh / 3;
        const int seq0 = lat ? 4096 + b * 1024 : b * 256;
        U.mode = 0; U.tok0 = seq0 + qb * 256; U.q = GQ + (size_t)U.tok0 * 384 + hh * 64; U.q_ld = 384; U.ycol = 256 + hh * 64;
        U.nt1 = lat ? 16 : 4; U.k1 = GK + (size_t)seq0 * 128 + kvh * 64; U.k_ld1 = 128; U.v1 = GV + (size_t)seq0 * 128 + kvh * 64; U.v_ld1 = 128;
        U.k0 = U.k1; U.v0 = U.v1; U.k_ld0 = 128; U.v_ld0 = 128;
        if (lat) { U.nt0 = 8; U.k0 = CGK + (size_t)((b * 4 + l) * 512) * 128 + kvh * 64; U.v0 = CGV + (size_t)((b * 4 + l) * 512) * 128 + kvh * 64; }
        U.yflag = (unsigned*)(ws + WS_CTL) + CW_YRDY + (l * 32 + (U.tok0 >> 8)) * 4;
        { unsigned* c = (unsigned*)(ws + WS_CTL);
          dep_wait(F, c + CW_RA + (l * 32 + (seq0 >> 8)) * 4, lat ? 4 : 1, 8u);
          U.zflag = c + CW_ZC + (l * 32 + (U.tok0 >> 8)) * 4; }
        __syncthreads();
        attn_unit<0>(F, p, U);
    } else if (u < 256 || (u >= 448 && u < 512)) {
        const bool lat = u < 256; const int uu = lat ? u - 192 : u - 448;
        const int b = lat ? uu / 16 : uu / 4, hh = lat ? (uu >> 2) & 3 : uu & 3, qb = lat ? (uu & 3) : 0;
        const int seq0 = lat ? 4096 + b * 1024 : b * 256;
        U.mode = 2; U.tok0 = seq0 + qb * 256; U.q = RQ + (size_t)U.tok0 * 256 + hh * 64; U.q_ld = 256; U.ycol = hh * 64;
        U.nt1 = lat ? 16 : 4; U.k1 = RK + (size_t)seq0 * 256 + hh * 64; U.k_ld1 = 256; U.v1 = RV + (size_t)seq0 * 256 + hh * 64; U.v_ld1 = 256;
        U.k0 = U.k1; U.v0 = U.v1; U.k_ld0 = 256; U.v_ld0 = 256;
        U.qpos0 = qb * 256; U.L = lat ? 1024 : 256;
        U.lf = -log1pf(__expf(-decay[hh])) * LOG2E; U.lb = -log1pf(__expf(-decay[4 + hh])) * LOG2E;
        if (lat) { const bf16_t* S0T = (const bf16_t*)(ws + WS_S0T); U.s0f = S0T + (size_t)(((b * 4 + l) * 2 + 0) * 4 + hh) * 4096; U.s0b = S0T + (size_t)(((b * 4 + l) * 2 + 1) * 4 + hh) * 4096; }
        U.yflag = (unsigned*)(ws + WS_CTL) + CW_YRDY + (l * 32 + (U.tok0 >> 8)) * 4;
        { unsigned* c = (unsigned*)(ws + WS_CTL);
          dep_wait(F, c + CW_RA + (l * 32 + (seq0 >> 8)) * 4, lat ? 4 : 1, 8u);
          U.zflag = c + CW_ZC + (l * 32 + (U.tok0 >> 8)) * 4; }
        __syncthreads();
        attn_unit<2>(F, p, U);
    } else {
        const int uu = u - 512, b = uu >> 2, hh = uu & 3, seq0 = b * 256;
        U.mode = 3; U.nt1 = 4; U.k1 = RK + (size_t)seq0 * 256 + hh * 64; U.k_ld1 = 256; U.v1 = RV + (size_t)seq0 * 256 + hh * 64; U.v_ld1 = 256;
        U.k0 = U.k1; U.v0 = U.v1; U.k_ld0 = 256; U.v_ld0 = 256;
        U.lf = -log1pf(__expf(-decay[hh])) * LOG2E; U.lb = -log1pf(__expf(-decay[4 + hh])) * LOG2E;
        U.st_out = p.out + O_STATE + (size_t)(((b * 4 + l) * 2 + 0) * 4 + hh) * 4096;
        dep_wait(F, (unsigned*)(ws + WS_CTL) + CW_RA + (l * 32 + b) * 4, 1, 8u);
        __syncthreads();
        attn_unit<3>(F, p, U);
    }
}
constexpr int N_ATTN_UNITS = 576;
struct TItem { const float* src; bf16_t* dst; int nsrc, K; int valid; };
constexpr int P0_TWIN = 4 * 16 * 92, P0_TWOUT = 4 * 16 * 32, P0_TWUQ = 4 * 4 * 20, P0_TWUKV = 4 * 2 * 24, P0_TR = P0_TWIN + P0_TWOUT + P0_TWUQ + P0_TWUKV;
__device__ __forceinline__ TItem p0_titem(const Frame& F, unsigned char* ws, int it) {
    TItem t; t.valid = it < P0_TR; t.src = nullptr; t.dst = nullptr; t.nsrc = 0; t.K = 0;
    if (!t.valid) return t;
    if (it < P0_TWIN) {
        const int l = it / (16 * 92), r = it % (16 * 92), kb = r / 92, nb = r % 92, n0 = nb * 32;
        const int src = n0 < 1792 ? n0 : (n0 < 2816 ? n0 + 32 : (n0 < 2848 ? n0 - 2816 + 1792 : -1));
        t.nsrc = 2848; t.K = 1024;
        if (src >= 0) t.src = pin(F, I_WIN) + (size_t)l * 1024 * 2848 + (size_t)(kb * 64) * 2848 + src;
        t.dst = (bf16_t*)(ws + WS_WIN) + ((size_t)l * 2944 + n0) * 1024 + kb * 64;
        return t;
    }
    it -= P0_TWIN;
    if (it < P0_TWOUT) {
        const int l = it / 512, r = it % 512, kb = r >> 5, nb = r & 31;
        t.nsrc = 1024; t.K = 1024; t.src = pin(F, I_WOUT) + (size_t)l * 1024 * 1024 + (size_t)(kb * 64) * 1024 + nb * 32;
        t.dst = (bf16_t*)(ws + WS_WOUT) + ((size_t)l * 1024 + nb * 32) * 1024 + kb * 64;
        return t;
    }
    it -= P0_TWOUT;
    if (it < P0_TWUQ) {
        const int l = it / 80, r = it % 80, kb = r / 20, nb = r % 20;
        t.nsrc = 576; t.K = 256; if (nb < 18) t.src = pin(F, I_WUQ) + (size_t)l * 256 * 576 + (size_t)(kb * 64) * 576 + nb * 32;
        t.dst = (bf16_t*)(ws + WS_WUQ) + ((size_t)l * 640 + nb * 32) * 256 + kb * 64;
        return t;
    }
    it -= P0_TWUQ;
    { const int l = it / 48, r = it % 48, kb = r / 24, nb = r % 24;
      t.nsrc = 768; t.K = 128; t.src = pin(F, I_WUKV) + (size_t)l * 128 * 768 + (size_t)(kb * 64) * 768 + nb * 32;
      t.dst = (bf16_t*)(ws + WS_WUKV) + ((size_t)l * 768 + nb * 32) * 128 + kb * 64; }
    return t;
}
__device__ __forceinline__ void p0_tload(const TItem& t, float (&r)[32], int lane) {
    if (t.valid && t.src) {
        const float* wp = t.src + (size_t)(lane >> 5) * t.nsrc + (lane & 31);
#pragma unroll
        for (int i = 0; i < 32; ++i) r[i] = wp[(size_t)(2 * i) * t.nsrc];
    } else {
#pragma unroll
        for (int i = 0; i < 32; ++i) r[i] = 0.f;
    }
}
__device__ __forceinline__ void p0_tstore(const TItem& t, const float (&r)[32], LAS float* scr, int lane) {
    if (!t.valid) return;
#pragma unroll
    for (int i = 0; i < 32; ++i) scr[(2 * i + (lane >> 5)) * 33 + (lane & 31)] = r[i];
    asm volatile("s_waitcnt lgkmcnt(0)" ::: "memory");
    __builtin_amdgcn_wave_barrier();
    const int c = lane & 7;
#pragma unroll
    for (int j = 0; j < 4; ++j) {
        const int n = (lane >> 3) + 8 * j; const LAS float* s = scr + (8 * c) * 33 + n;
        u32x4 o; o.x = pk2(s[0 * 33], s[1 * 33]); o.y = pk2(s[2 * 33], s[3 * 33]); o.z = pk2(s[4 * 33], s[5 * 33]); o.w = pk2(s[6 * 33], s[7 * 33]);
        ST16_WT(t.dst + (size_t)n * t.K + 8 * c, o);
    }
    asm volatile("s_waitcnt lgkmcnt(0)" ::: "memory");
    __builtin_amdgcn_wave_barrier();
}
__device__ __forceinline__ void cast8(const float* src, bf16_t* dst, size_t e) {
    const f32x4 a = *(const f32x4*)(src + e), b = *(const f32x4*)(src + e + 4);
    u32x4 o; o.x = pk2(a[0], a[1]); o.y = pk2(a[2], a[3]); o.z = pk2(b[0], b[1]); o.w = pk2(b[2], b[3]);
    ST16_WT(dst + e, o);
}
constexpr int P0_MODS = 1536, P0_CAST_G = 512, P0_CAST_KPE = 128, P0_S0T = 512;
constexpr int P0_TOTAL = P0_MODS + 3 * P0_CAST_G + P0_CAST_KPE + P0_S0T;
__device__ __forceinline__ void phase0(const Frame& F, const Params& p, bool dup = false) {
    unsigned char* ws = F.ws + (dup ? 162 * MiB : 0); const int lane = F.lane;
    LAS float* scr = (LAS float*)F.lds + F.w * (64 * 33);
    const int gw = blockIdx.x * NWAVE + F.w, ngw = gridDim.x * NWAVE;
#ifndef MK_DUP0
#define MK_DUP0_ 0
#else
#define MK_DUP0_ MK_DUP0
#endif
    if (!(dup && MK_DUP0_ == 2))
    for (int it = gw; it < P0_TR; it += 2 * ngw) {
        const TItem t0 = p0_titem(F, ws, it), t1 = p0_titem(F, ws, it + ngw);
        float r0[32], r1[32];
        p0_tload(t0, r0, lane); p0_tload(t1, r1, lane);
        p0_tstore(t0, r0, scr, lane); p0_tstore(t1, r1, scr, lane);
    }
    if (!(dup && MK_DUP0_ == 1))
    for (int it0 = (gw + ngw - 256) % ngw; it0 < P0_TOTAL; it0 += ngw) {
        int it = it0;
        if (it < P0_MODS) {
            const int l = it / 384, cg = (it % 384) >> 5, ks = it & 31;
            const int j = cg * 256 + lane * 4;
            const float* wp = pin(F, I_WADA) + ((size_t)l * 1024 + ks * 32) * 3072 + j;
            const float* c = pin(F, I_C); const float* cc = pin(F, I_CCTX);
            float sv[3];
#pragma unroll
            for (int q = 0; q < 3; ++q) {
                const int idx = q * 64 + lane, n = idx >> 5, k = idx & 31;
                float x = 0.f;
                if (idx < 160) x = (n == 0) ? cc[ks * 32 + k] : c[(n - 1) * 1024 + ks * 32 + k];
                sv[q] = silu_f(x);
            }
            f32x4 acc[5];
#pragma unroll
            for (int n = 0; n < 5; ++n) acc[n] = (f32x4){0.f, 0.f, 0.f, 0.f};
#pragma unroll 1
            for (int k0 = 0; k0 < 32; k0 += 16) {
                f32x4 wv[16];
#pragma unroll
                for (int k = 0; k < 16; ++k) wv[k] = *(const f32x4*)(wp + (size_t)(k0 + k) * 3072);
                __builtin_amdgcn_sched_barrier(0);
#pragma unroll
                for (int k = 0; k < 16; ++k)
#pragma unroll
                    for (int n = 0; n < 5; ++n) {
                        const float s = __int_as_float(__builtin_amdgcn_readlane(__float_as_int(sv[n >> 1]), 32 * (n & 1) + k0 + k));
                        acc[n] += wv[k] * s;
                    }
            }
            LAS f32x4* red = (LAS f32x4*)(F.lds + 69632);
#pragma unroll
            for (int n = 0; n < 5; ++n) red[(F.w * 5 + n) * 64 + lane] = acc[n];
            __syncthreads();
            if (F.tid < 320) {
                const int n = F.tid >> 6;
                f32x4 s = red[n * 64 + lane];
#pragma unroll
                for (int ww = 1; ww < 8; ++ww) s += red[(ww * 5 + n) * 64 + lane];
                if ((ks >> 3) == 0) s += *(const f32x4*)(pin(F, I_BADA) + l * 3072 + j);
                float* mods = (float*)(ws + WS_MODS) + (size_t)(l * 5 + n) * 3072 + j;
#pragma unroll
                for (int e = 0; e < 4; ++e) atomicAdd(mods + e, s[e]);
            }
            __syncthreads();
            continue;
        }
        it -= P0_MODS;
        if (it < 3 * P0_CAST_G) {
            const int which = it / P0_CAST_G, r = it % P0_CAST_G;
            const float* src = which == 0 ? pin(F, I_CGK) : (which == 1 ? pin(F, I_CGV) : pin(F, I_CCKV));
            bf16_t* dst = (bf16_t*)(ws + (which == 0 ? WS_CGK : (which == 1 ? WS_CGV : WS_CCKV)));
#pragma unroll
            for (int q = 0; q < 4; ++q) cast8(src, dst, (size_t)r * 2048 + q * 512 + lane * 8);
            continue;
        }
        it -= 3 * P0_CAST_G;
        if (it < P0_CAST_KPE) {
#pragma unroll
            for (int q = 0; q < 4; ++q) cast8(pin(F, I_CKPE), (bf16_t*)(ws + WS_CKPE), (size_t)it * 2048 + q * 512 + lane * 8);
            continue; }
        it -= P0_CAST_KPE;
        {
            const int mat = it >> 2, qd = it & 3, dv = qd * 16 + (lane >> 2), dk0 = (lane & 3) * 16;
            const float* s = pin(F, I_STATE) + (size_t)mat * 4096 + dv;
            float x[16];
#pragma unroll
            for (int i = 0; i < 16; ++i) x[i] = s[(dk0 + i) * 64];
            u32x4 o0, o1;
            o0.x = pk2(x[0], x[1]); o0.y = pk2(x[2], x[3]); o0.z = pk2(x[4], x[5]); o0.w = pk2(x[6], x[7]);
            o1.x = pk2(x[8], x[9]); o1.y = pk2(x[10], x[11]); o1.z = pk2(x[12], x[13]); o1.w = pk2(x[14], x[15]);
            bf16_t* d = (bf16_t*)(ws + WS_S0T) + (size_t)mat * 4096 + dv * 64 + dk0;
            ST16_WT(d, o0); ST16_WT(d + 8, o1);
        }
    }
}
constexpr int P1_GS = 80, P1_BIAS = 4 * 368, P1_X = 8192, P1_TOTAL = P1_GS + P1_BIAS + P1_X;
__device__ __forceinline__ void xg_row(const Frame& F, const float* xrow, const float* g, const float* mods_c, bf16_t* xg_row_out, float* ssq_row, bool write_xg) {
    const int lane = F.lane;
    float ss = 0.f;
#pragma unroll
    for (int j = 0; j < 2; ++j) {
        const int k = j * 512 + lane * 8;
        const f32x4 x0 = *(const f32x4*)(xrow + k), x1 = *(const f32x4*)(xrow + k + 4);
        ss += ((x0[0] * x0[0] + x0[1] * x0[1]) + (x0[2] * x0[2] + x0[3] * x0[3])) + ((x1[0] * x1[0] + x1[1] * x1[1]) + (x1[2] * x1[2] + x1[3] * x1[3]));
        if (write_xg) {
            const f32x4 g0 = *(const f32x4*)(g + k), g1 = *(const f32x4*)(g + k + 4), s0 = *(const f32x4*)(mods_c + 1024 + k), s1 = *(const f32x4*)(mods_c + 1024 + k + 4);
            u32x4 o; o.x = pk2(x0[0] * g0[0] * (1.f + s0[0]), x0[1] * g0[1] * (1.f + s0[1])); o.y = pk2(x0[2] * g0[2] * (1.f + s0[2]), x0[3] * g0[3] * (1.f + s0[3]));
            o.z = pk2(x1[0] * g1[0] * (1.f + s1[0]), x1[1] * g1[1] * (1.f + s1[1])); o.w = pk2(x1[2] * g1[2] * (1.f + s1[2]), x1[3] * g1[3] * (1.f + s1[3]));
            ST16_WT(xg_row_out + k, o);
        }
    }
    ss = wsum(ss);
    if (lane < 16) ssq_row[lane] = lane == 0 ? ss : 0.f;
}
__device__ __forceinline__ void phase1(const Frame& F, const Params& p) {
    unsigned char* ws = F.ws; const int lane = F.lane;
    const int gw = blockIdx.x * NWAVE + F.w, ngw = gridDim.x * NWAVE;
    const float* mods = (const float*)(ws + WS_MODS);
    for (int it0 = gw; it0 < P1_TOTAL; it0 += ngw) {
        int it = it0;
        if (it < P1_GS) {
            const int e = it * 256 + lane * 4, lc = e >> 10, k = e & 1023, l = lc / 5;
            const f32x4 g = *(const f32x4*)(pin(F, I_NORMG) + l * 1024 + k), sc = *(const f32x4*)(mods + (size_t)lc * 3072 + 1024 + k);
            *(f32x4*)((float*)(ws + WS_GS) + e) = g * (sc + 1.f);
            continue;
        }
        it -= P1_GS;
        if (it < P1_BIAS) {
            const int l = it / 368, n0 = (it % 368) * 8;
            f32x4 sh[5][4];
#pragma unroll
            for (int c = 0; c < 5; ++c) {
                const float* shp = mods + (size_t)(l * 5 + c) * 3072 + lane * 16;
#pragma unroll
                for (int i = 0; i < 4; ++i) sh[c][i] = *(const f32x4*)(shp + 4 * i);
            }
            const bf16_t* wr0 = (const bf16_t*)(ws + WS_WIN) + ((size_t)l * 2944 + n0) * 1024 + lane * 16;
            u32x4 w0[8], w1[8];
#pragma unroll
            for (int r = 0; r < 8; ++r) { w0[r] = *(const u32x4*)(wr0 + (size_t)r * 1024); w1[r] = *(const u32x4*)(wr0 + (size_t)r * 1024 + 8); }
#pragma unroll
            for (int r = 0; r < 8; ++r) {
                float wv[16];
#pragma unroll
                for (int i = 0; i < 4; ++i) { wv[2 * i] = bflo(w0[r][i]); wv[2 * i + 1] = bfhi(w0[r][i]); wv[8 + 2 * i] = bflo(w1[r][i]); wv[8 + 2 * i + 1] = bfhi(w1[r][i]); }
#pragma unroll
                for (int c = 0; c < 5; ++c) {
                    float d = 0.f;
#pragma unroll
                    for (int i = 0; i < 4; ++i) { const f32x4 s4 = sh[c][i]; d += (s4[0] * wv[4 * i] + s4[1] * wv[4 * i + 1]) + (s4[2] * wv[4 * i + 2] + s4[3] * wv[4 * i + 3]); }
                    d = wsum(d);
                    if (lane == 0) ((float*)(ws + WS_BIAS))[(size_t)(l * 5 + c) * 2944 + n0 + r] = d;
                }
            }
            continue;
        }
        it -= P1_BIAS;
        {
            const int tok = it; const bool lat = tok >= 4096;
            const float* xr = lat ? pin(F, I_XS) + (size_t)(tok - 4096) * 1024 : pin(F, I_XP) + (size_t)tok * 1024;
            const int cond = lat ? 1 + ((tok - 4096) >> 10) : 0;
            xg_row(F, xr, pin(F, I_NORMG), mods + (size_t)cond * 3072, (bf16_t*)(ws + WS_XG) + (size_t)tok * 1024, (float*)(ws + WS_SSQ) + (size_t)tok * 16, true);
        }
    }
}
#ifndef MK_TIMING
#define MK_TIMING -1
#endif
constexpr int CW_TIME = 2048;
__device__ __forceinline__ void phase_final(const Frame& F, const Params& p) {
    const int lane = F.lane;
    float tf = 1.f;
    if (MK_TIMING >= 0) tf = __uint_as_float(__hip_atomic_load((unsigned*)(F.ws + WS_CTL) + CW_TIME, __ATOMIC_RELAXED, __HIP_MEMORY_SCOPE_AGENT));
    unsigned* ctl = (unsigned*)(F.ws + WS_CTL);
    for (int vb = blockIdx.x; vb < 256; vb += gridDim.x) {
        const int tm = vb & 31, part = vb >> 5;
        if (F.tid == 0) {
            XB_SPIN(xb_ld(ctl + CW_XRDY + tm * 4) < 8u, ctl + CW_BAR);
            __builtin_amdgcn_fence(__ATOMIC_ACQUIRE, "agent");
            asm volatile("s_waitcnt vmcnt(0)" ::: "memory");
        }
        __syncthreads();
#pragma unroll 1
        for (int i = 0; i < 4; ++i) {
            const int tok = tm * 256 + part * 32 + F.w * 4 + i;
            float ss = 0.f;
            if (lane < 16) ss = ((const float*)(F.ws + WS_SSQ))[(size_t)tok * 16 + lane];
            ss = wsum(ss);
            const float rstd = rsqrtf(ss * (1.f / 1024.f) + EPS);
            const bf16_t* xr = (const bf16_t*)(F.ws + WS_XB) + (size_t)tok * 1024; float* orow = p.out + (size_t)tok * 1024;
#pragma unroll
            for (int j = 0; j < 4; ++j) {
                const int k = j * 256 + lane * 4;
                const u32x2 xq = *(const u32x2*)(xr + k);
                const f32x4 x = {bflo(xq.x), bfhi(xq.x), bflo(xq.y), bfhi(xq.y)}, fn = *(const f32x4*)(pin(F, I_FNORM) + k);
                { const f32x4 o = x * fn * (rstd * tf); ST16_WT(orow + k, o); }
            }
        }
    }
}

__device__ __forceinline__ GemmOp a2_op(const Frame& F, int l, int j) {
    GemmOp g;
    if (j < 160) { const int tn = j >> 5, tm = j & 31; g.W = (const bf16_t*)(F.ws + WS_WUQ) + ((size_t)l * 640 + tn * 128) * 256; g.X = (const bf16_t*)(F.ws + WS_CQG) + (size_t)tm * 256 * 256; g.ldw = 256; g.ldx = 256; g.K = 256; }
    else if (j < 352) { const int jj = j - 160, tn = jj >> 5, tm = jj & 31; g.W = (const bf16_t*)(F.ws + WS_WUKV) + ((size_t)l * 768 + tn * 128) * 128; g.X = (const bf16_t*)(F.ws + WS_CKVN) + (size_t)tm * 256 * 128; g.ldw = 128; g.ldx = 128; g.K = 128; }
    else { const int jj = j - 352, tn = jj >> 3, tc = jj & 7, b = tc >> 1, jt = tc & 1; g.W = (const bf16_t*)(F.ws + WS_WUKV) + ((size_t)l * 768 + tn * 128) * 128;
           g.X = (const bf16_t*)(F.ws + WS_CCKV) + ((size_t)(b * 4 + l) * 512 + jt * 256) * 128; g.ldw = 128; g.ldx = 128; g.K = 128; }
    return g;
}
__device__ __forceinline__ int a2_item(int vb, int i) {
    const int c = (vb >> 5) - 4, tmw = vb & 31;
    if (i == 3) return 352 + 32 + tmw;
    if (c == 0) return i * 32 + tmw;
    if (c == 1) return i < 2 ? (3 + i) * 32 + tmw : 160 + tmw;
    if (c == 2) return 160 + (1 + i) * 32 + tmw;
    return i < 2 ? 160 + (4 + i) * 32 + tmw : 352 + tmw;
}
#ifndef MK_EN
#define MK_EN 0xff
#endif
#define EN(x) ((MK_EN >> (x)) & 1)
constexpr int PH_TOTAL = 19;
__global__ void __launch_bounds__(512, 2) mega(Params p) {
    extern __shared__ __attribute__((aligned(16))) unsigned char lds_raw[];
    Frame F;
    F.lds = (LAS unsigned char*)lds_raw;
    F.tid = threadIdx.x; F.lane = F.tid & 63; F.w = __builtin_amdgcn_readfirstlane(F.tid >> 6); F.h = F.lane >> 5; F.lq = F.lane & 31;
    F.ws = p.ws;
    F.karg = (karg_t)__builtin_amdgcn_kernarg_segment_ptr();
    volatile LAS unsigned* MISC = (volatile LAS unsigned*)(F.lds + LDS_MISC);
    if (F.tid < 64) MISC[F.tid] = 0u;
    __syncthreads();
    unsigned* ctl = (unsigned*)(p.ws + WS_CTL);
    XcdBarrier bar; bar.bar = ctl + CW_BAR; bar.x = 0; bar.st = nullptr;
    const bool multi = p.ph_hi - p.ph_lo > 1;
    if (multi) bar = xcd_barrier_post(ctl + CW_BAR, MISC + 8);
    bar.w = F.w;
    const int G = gridDim.x;
    const Frame F0 = F;
    for (int ph = p.ph_lo; ph < p.ph_hi; ++ph) {
        if (ph >= 2 && ph < 18 && ((ph - 2) & 3) == 1) continue;
        Frame F = F0;
        F.lane = (int)__builtin_amdgcn_mbcnt_hi(~0u, __builtin_amdgcn_mbcnt_lo(~0u, 0u));
        asm volatile("" : "+v"(F.lane));
        F.tid = (F.w << 6) | F.lane; F.h = F.lane >> 5; F.lq = F.lane & 31;
        asm volatile("" : "+s"(F.w), "+s"(F.ws), "+s"(F.karg));
        if (MK_TIMING >= 0 && blockIdx.x == 0 && F.tid == 0) {
            const unsigned long long now = __builtin_amdgcn_s_memrealtime();
            const unsigned long long prev = ((unsigned long long)MISC[17] << 32) | MISC[16];
            if (ph > p.ph_lo) { const int q = ph - 1; const int grp = q < 2 ? q : 2 + ((q - 2) & 3); if (grp == MK_TIMING) MISC[18] += (unsigned)(now - prev); }
            MISC[16] = (unsigned)now; MISC[17] = (unsigned)(now >> 32);
        }
#ifndef MK_REPEAT
#define MK_REPEAT -1
#endif
        int nrep = 1;
        if (MK_REPEAT >= 1) { const int grp = ph < 2 ? ph : (ph == 18 ? 6 : 2 + ((ph - 2) & 3)); if (grp == MK_REPEAT) nrep = (grp == 5) ? (ph == 5 ? 5 : 1) : 2; }
        for (int rep = 0; rep < nrep; ++rep) {
        if (rep > 0) xcd_barrier(bar);
        Frame F = F0;
        F.lane = (int)__builtin_amdgcn_mbcnt_hi(~0u, __builtin_amdgcn_mbcnt_lo(~0u, 0u));
        asm volatile("" : "+v"(F.lane));
        F.tid = (F.w << 6) | F.lane; F.h = F.lane >> 5; F.lq = F.lane & 31;
        asm volatile("" : "+s"(F.w), "+s"(F.ws), "+s"(F.karg));
        if (EN(0) && ph == 0) {
#if defined(MK_DUP0)
            for (int d = 0; d < 2; ++d) { int dd = d; asm volatile("" : "+s"(dd)); if (dd) xcd_barrier(bar); phase0(F, p, dd != 0); }
#else
            phase0(F, p);
#endif
        }
        else if (EN(1) && ph == 1) phase1(F, p);
        else if (EN(2) && ph == 18) phase_final(F, p);
        else {
            const int l = (ph - 2) >> 2, sub = (ph - 2) & 3;
            int bid = blockIdx.x; asm volatile("" : "+s"(bid));
            if (EN(3) && sub == 0) {
                const bf16_t* Wt = (const bf16_t*)(F.ws + WS_WIN) + (size_t)l * 2944 * 1024;
                const bf16_t* X = (const bf16_t*)(F.ws + WS_XG);
                unsigned* flags = ctl + CW_FLAG + l * 512;
                bool first = true;
                for (int j = bid; j < 12 * 32; j += G) {
                    const int tn2 = j >> 5, tm = j & 31;
                    const int jn = j + G; const bool hn = jn < 12 * 32;
                    const int tn = 2 * tn2 + ((F.w & 3) >> 1), wn = F.w & 1;
                    GemmAcc8 acc;
                    Gemm1Pre P1;
                    gemm1_pre(F, p, tn, wn, tm, l, P1);
                    gemm_core256(F, Wt + (size_t)tn2 * 256 * 1024, X + (size_t)tm * 256 * 1024, acc, first, hn, Wt + (size_t)(jn >> 5) * 256 * 1024, X + (size_t)(jn & 31) * 256 * 1024); first = false;
                    epi_gemm1(F, p, acc, tn, wn, tm, l, P1, tn2 == 6);
                    {
                        asm volatile("s_waitcnt vmcnt(0)" ::: "memory");
                        __syncthreads();
                        if (F.tid == 0) {
                            if (tn2 == 5 || tn2 == 6) (void)xb_add(flags + tm * 16, 1u);
                            if (tn2 < 8) (void)xb_add(ctl + CW_RA + (l * 32 + tm) * 4, 1u);
                            if (tn2 >= 7 && tn2 < 11) (void)xb_add(ctl + CW_ZC + (l * 32 + tm) * 4, 1u);
                            (void)xb_add(ctl + CW_FULL + (l * 32 + tm) * 4, 1u);
                        }
                    }
                }
                for (int vb = bid; vb < 256; vb += G) {
                    if (vb < 128) continue;
                    const int c = (vb >> 5) - 4, tmw = vb & 31;
                    const int nit = (c == 2 && tmw < 16) ? 4 : 3;
                    if (F.tid == 0) {
                        unsigned* f = flags + tmw * 16;
                        XB_SPIN(xb_ld(f) < 2u, ctl + CW_BAR);
                        __builtin_amdgcn_fence(__ATOMIC_ACQUIRE, "agent");
                        asm volatile("s_waitcnt vmcnt(0)" ::: "memory");
                    }
                    __syncthreads();
                    for (int i = 0; i < nit; ++i) {
                        const bool hn = i + 1 < nit;
                        const int j = a2_item(vb, i), jn = a2_item(vb, hn ? i + 1 : i);
                        const GemmOp g = a2_op(F, l, j); const GemmOp gn = a2_op(F, l, jn);
                        GemmAcc acc;
                        float rstdq = 0.f;
                        if (j < 160) qm_pre(F, tmw, rstdq);
                        gemm_core(F, g, acc, i == 0, hn, gn);
                        if (j < 160) epi_qm(F, acc, j >> 5, tmw, rstdq);
                        else if (j < 352) { const int jj = j - 160; epi_plain(F, acc, (bf16_t*)(F.ws + WS_KVM), 768, tmw * 256, (jj >> 5) * 128); }
                        else { const int jj = j - 352, tc = jj & 7; epi_plain(F, acc, (bf16_t*)(F.ws + WS_KVMC), 768, (tc >> 1) * 512 + (tc & 1) * 256, (jj >> 3) * 128); }
                        asm volatile("s_waitcnt vmcnt(0)" ::: "memory");
                        __syncthreads();
                        if (F.tid == 0) {
                            if (j < 352) (void)xb_add(ctl + CW_FULL + (l * 32 + tmw) * 4, 1u);
                            else (void)xb_add(ctl + CW_KC + (l * 4 + (((j - 352) & 7) >> 1)) * 4, 1u);
                        }
                    }
                }
            } else if (EN(5) && sub == 2) {
                for (;;) {
                    __syncthreads();
                    if (F.tid == 0) MISC[0] = atomicAdd(ctl + CW_QUEUE + 64 * l + 32 * rep, 1u);
                    __syncthreads();
                    const int uq = __builtin_amdgcn_readfirstlane((int)MISC[0]);
                    if (uq >= N_ATTN_UNITS) break;
                    const int u = uq < 160 ? uq + 96 : (uq < 256 ? uq - 160 : (uq < 480 ? uq + 96 : uq - 224));
                    attn_dispatch(F, p, u, l);
                }
            } else if (EN(6)) {
                const bf16_t* Wt = (const bf16_t*)(F.ws + WS_WOUT) + (size_t)l * 1024 * 1024;
                const bf16_t* Yb = (const bf16_t*)(F.ws + WS_Y);
                for (int j = bid; j < 8 * 32; j += G) {
                    const int tn = j >> 5, tm = j & 31;
                    GemmOp g; g.W = Wt + (size_t)tn * 128 * 1024; g.X = Yb + (size_t)tm * 256 * 1024; g.ldw = 1024; g.ldx = 1024; g.K = 1024;
                    GemmAcc acc;
                    Gemm2Pre P2;
                    gemm2_pre(F, tn, tm, l, P2);
                    if (F.tid == 0) {
                        unsigned* f = ctl + CW_YRDY + (l * 32 + tm) * 4;
                        XB_SPIN(xb_ld(f) < 16u, ctl + CW_BAR);
                        __builtin_amdgcn_fence(__ATOMIC_ACQUIRE, "agent");
                        asm volatile("s_waitcnt vmcnt(0)" ::: "memory");
                    }
                    __syncthreads();
                    gemm_core(F, g, acc, true, false, g);
                    epi_gemm2(F, p, acc, tn, tm, l, P2, l == 3);
                    if (l == 3) {
                        asm volatile("s_waitcnt vmcnt(0)" ::: "memory");
                        __syncthreads();
                        if (F.tid == 0) (void)xb_add(ctl + CW_XRDY + tm * 4, 1u);
                    }
                }
            }
        }
        }
        if (MK_TIMING >= 0 && ph == 17 && blockIdx.x == 0 && F.tid == 0) {
            const unsigned long long now = __builtin_amdgcn_s_memrealtime();
            const unsigned long long prev = ((unsigned long long)MISC[17] << 32) | MISC[16];
            unsigned a = MISC[18]; if (MK_TIMING == 5) a += (unsigned)(now - prev);
            __hip_atomic_store(ctl + CW_TIME, __float_as_uint(1.f + (float)a * 1e-5f), __ATOMIC_RELAXED, __HIP_MEMORY_SCOPE_AGENT);
        }
        if (ph + 1 < p.ph_hi && !(ph >= 2 && ph < 18 && ((ph - 2) & 3) != 3) && ph != 17) xcd_barrier(bar);
    }
}
}

extern "C" void kernel_launch(void* const* d_in, const int* in_sizes, int n_in, void* d_out, int out_size, void* d_ws, size_t ws_size, hipStream_t stream) {
    static int grid = 0;
    if (!grid) {
        int dev = 0, cus = 0, per_cu = 0;
        (void)hipGetDevice(&dev);
        (void)hipDeviceGetAttribute(&cus, hipDeviceAttributeMultiprocessorCount, dev);
        (void)hipFuncSetAttribute((const void*)mk::mega, hipFuncAttributeMaxDynamicSharedMemorySize, mk::LDS_BYTES);
        (void)hipOccupancyMaxActiveBlocksPerMultiprocessor(&per_cu, (const void*)mk::mega, 512, mk::LDS_BYTES);
        if (per_cu > 1) per_cu = 1;
        if (per_cu < 1) per_cu = 1;
        if (cus < 1) cus = 256;
        grid = cus * per_cu;
    }
    unsigned char* ws = (unsigned char*)d_ws;
    (void)hipMemsetAsync(ws, 0, mk::CTL_ZERO_BYTES, stream);
    mk::Params P{};
    for (int i = 0; i < 22; ++i) P.in[i] = (const float*)d_in[i];
    P.out = (float*)d_out; P.ws = ws; P.xs = (float*)d_out;
    P.ph_lo = 0; P.ph_hi = mk::PH_TOTAL;
    void* args[] = {&P};
    (void)hipLaunchCooperativeKernel((const void*)mk::mega, dim3(grid), dim3(512), args, mk::LDS_BYTES, stream);
}
```

```cpp
#include <hip/hip_runtime.h>
#include <stdint.h>
namespace mk {
#define LAS __attribute__((address_space(3)))
typedef unsigned short bf16_t;
typedef short bf16x8 __attribute__((ext_vector_type(8)));
typedef short s16x4 __attribute__((ext_vector_type(4)));
typedef float f32x16 __attribute__((ext_vector_type(16)));
typedef float f32x4 __attribute__((ext_vector_type(4)));
typedef float f32x2 __attribute__((ext_vector_type(2)));
typedef unsigned u32x4 __attribute__((ext_vector_type(4)));
typedef unsigned u32x2 __attribute__((ext_vector_type(2)));
typedef __bf16 bf16x2_t __attribute__((ext_vector_type(2)));

constexpr float EPS = 1e-6f;
constexpr float LOG2E = 1.4426950408889634f;
constexpr float QSC_GQA = 0.125f * LOG2E;
constexpr float QSC_MLA = 0.10206207261596575f * LOG2E;

__device__ __forceinline__ unsigned pk2(float lo, float hi) { f32x2 v = {lo, hi}; bf16x2_t b = __builtin_convertvector(v, bf16x2_t); return __builtin_bit_cast(unsigned, b); }
__device__ __forceinline__ float bf2f(unsigned short u) { return __uint_as_float((unsigned)u << 16); }
__device__ __forceinline__ float bflo(unsigned u) { return __uint_as_float(u << 16); }
__device__ __forceinline__ float bfhi(unsigned u) { return __uint_as_float(u & 0xffff0000u); }
__device__ __forceinline__ float silu_f(float x) { return x * __builtin_amdgcn_rcpf(1.f + __builtin_amdgcn_exp2f(-x * LOG2E)); }
__device__ __forceinline__ float wsum(float v) {
#pragma unroll
    for (int o = 32; o > 0; o >>= 1) v += __shfl_xor(v, o);
    return v;
}

constexpr size_t MiB = 1u << 20;
constexpr size_t WS_CTL = 0, CTL_ZERO_BYTES = 1 * MiB;
constexpr size_t WS_MODS = 256 * 1024;
constexpr size_t WS_BIAS = 1 * MiB;
constexpr size_t WS_GS = 1 * MiB + 256 * 1024;
constexpr size_t WS_ROPE64 = 1 * MiB + 512 * 1024;
constexpr size_t WS_ROPE32 = 1 * MiB + 768 * 1024;
constexpr size_t WS_SSQ = 2 * MiB;
constexpr size_t WS_CQSSQ = 2 * MiB + 512 * 1024;
constexpr size_t WS_S0T = 3 * MiB;
constexpr size_t WS_CGK = 4 * MiB, WS_CGV = 6 * MiB, WS_CCKV = 8 * MiB, WS_CKPE = 10 * MiB;
constexpr size_t WS_WIN = 11 * MiB;
constexpr size_t WS_WOUT = 34 * MiB;
constexpr size_t WS_WUQ = 42 * MiB;
constexpr size_t WS_WUKV = 43 * MiB + 256 * 1024;
constexpr size_t WS_XG = 44 * MiB;
constexpr size_t WS_KVM = 130 * MiB;
constexpr size_t WS_KVMC = 142 * MiB;
constexpr size_t WS_RQ = 60 * MiB, WS_RK = 64 * MiB, WS_RV = 68 * MiB;
constexpr size_t WS_GQ = 72 * MiB;
constexpr size_t WS_GK = 78 * MiB, WS_GV = 80 * MiB;
constexpr size_t WS_CQG = 82 * MiB;
constexpr size_t WS_CKVN = 86 * MiB;
constexpr size_t WS_KPEB = 88 * MiB;
constexpr size_t WS_ZS = 89 * MiB;
constexpr size_t WS_QM = 105 * MiB;
constexpr size_t WS_Y = 114 * MiB;
constexpr size_t WS_XSDBG = 130 * MiB;
constexpr size_t WS_XB = 146 * MiB;
constexpr size_t WS_OPT_END = 162 * MiB;
constexpr int CW_QUEUE = 1024;
constexpr int CW_FLAG = 2048;
constexpr int CW_YRDY = 1536;
constexpr int CW_XRDY = 1280;
constexpr int CW_RA = 8192;
constexpr int CW_FULL = 8704;
constexpr int CW_ZC = 9216;
constexpr int CW_KC = 9728;
constexpr int CW_XGR = 9856;
constexpr int CW_SD = 10368;
constexpr int CW_BAR = 4096;

constexpr size_t O_STATE = 8388608, O_GK = 10485760, O_GV = 12582912, O_CKV = 14680064, O_KPE = 16777216;

constexpr int NWAVE = 8;
constexpr int GST = 49152;
constexpr int GST2 = 65536;
constexpr int LDS_OST = GST2;
constexpr int LDS_EX = 135168;
constexpr int LDS_EXB = 137216;
constexpr int LDS_SCAL = 141312;
constexpr int LDS_MISC = 142336;
constexpr int LDS_BYTES = 142592;

struct Params { const float* in[22]; float* out; unsigned char* ws; float* xs; int ph_lo, ph_hi; };
enum { I_XP = 0, I_XS, I_STATE, I_CGK, I_CGV, I_CCKV, I_CKPE, I_C, I_CCTX, I_NORMG, I_WADA, I_BADA, I_WIN, I_DECAY, I_GQN, I_GKN, I_MQN, I_MKVN, I_WUQ, I_WUKV, I_WOUT, I_FNORM };

#define XB_TMO      128
#define XB_XCNT(j)  (256  + 64 * (j))
#define XB_XSUB(j)  (1280 + 64 * (j))
#define XB_XGEN(j)  (2304 + 64 * (j))
#define XB_TOP      3328
#define XB_TOPGEN   3392
#define XB_SPIN_CAP (1u << 20)
__device__ __forceinline__ unsigned xb_ld(unsigned* p) { return __hip_atomic_load(p, __ATOMIC_RELAXED, __HIP_MEMORY_SCOPE_AGENT); }
__device__ __forceinline__ unsigned xb_add(unsigned* p, unsigned v) { return __hip_atomic_fetch_add(p, v, __ATOMIC_RELAXED, __HIP_MEMORY_SCOPE_AGENT); }
__device__ __forceinline__ unsigned xb_xcc_id() { return (unsigned)__builtin_amdgcn_s_getreg((3 << 11) | 20) & 0xFu; }
#define XB_SPIN(cond, bar) do { unsigned _sp = 0; while (cond) { __builtin_amdgcn_s_sleep(1); \
    if ((++_sp & 255u) == 0u) { if (xb_ld(&(bar)[XB_TMO])) break; if (_sp > XB_SPIN_CAP) { atomicAdd(&(bar)[XB_TMO], 1u); break; } } } } while (0)
struct XcdBarrier { unsigned* bar; unsigned x; volatile LAS unsigned* st; int w; };
__device__ __forceinline__ XcdBarrier xcd_barrier_post(unsigned* bar, volatile LAS unsigned* st) {
    XcdBarrier b; b.bar = bar; b.x = xb_xcc_id(); b.st = st; b.w = 0;
    if (threadIdx.x == 0) (void)xb_add(&bar[XB_XCNT(b.x)], 1u);
    return b;
}
__device__ __forceinline__ void xcd_barrier_complete(unsigned* bar, unsigned x, unsigned& nloc, unsigned& nx) {
    const unsigned G = gridDim.x * gridDim.y * gridDim.z;
    unsigned sum, cnt, mine, sp = 0u;
    for (;;) {
        sum = 0u; cnt = 0u; mine = 0u;
#pragma unroll
        for (unsigned j = 0; j < 16; ++j) { const unsigned c = xb_ld(&bar[XB_XCNT(j)]); sum += c; cnt += (c > 0u) ? 1u : 0u; mine = (j == x) ? c : mine; }
        if (sum == G) break;
        __builtin_amdgcn_s_sleep(1);
        if ((++sp & 255u) == 0u) { if (xb_ld(&bar[XB_TMO])) break; if (sp > XB_SPIN_CAP) { atomicAdd(&bar[XB_TMO], 1u); break; } }
    }
    nloc = mine > 0u ? mine : 1u; nx = cnt > 0u ? cnt : 1u;
}
__device__ __forceinline__ void xcd_barrier(const XcdBarrier& b) {
    asm volatile("s_waitcnt vmcnt(0)" ::: "memory");
    __syncthreads();
    if (b.w == 0 && __builtin_amdgcn_mbcnt_hi(~0u, __builtin_amdgcn_mbcnt_lo(~0u, 0u)) == 0u) {
        unsigned* bar = b.bar;
        __builtin_amdgcn_s_waitcnt(0);
        unsigned nloc = b.st[0], nx = b.st[1];
        if (nloc == 0u) { xcd_barrier_complete(bar, b.x, nloc, nx); b.st[0] = nloc; b.st[1] = nx; }
        const unsigned old = xb_add(&bar[XB_XSUB(b.x)], 1u);
        const unsigned gen = old / nloc;
        if (old + 1u == (gen + 1u) * nloc) {
            __builtin_amdgcn_fence(__ATOMIC_RELEASE, "agent");
            asm volatile("s_waitcnt vmcnt(0)" ::: "memory");
            const unsigned og = xb_add(&bar[XB_TOP], 1u);
            const unsigned tg = og / nx;
            if (og + 1u == (tg + 1u) * nx) xb_add(&bar[XB_TOPGEN], 1u);
            else XB_SPIN(xb_ld(&bar[XB_TOPGEN]) == tg, bar);
            xb_add(&bar[XB_XGEN(b.x)], 1u);
            __builtin_amdgcn_fence(__ATOMIC_ACQUIRE, "agent");
            asm volatile("s_waitcnt vmcnt(0)" ::: "memory");
        } else {
            XB_SPIN(xb_ld(&bar[XB_XGEN(b.x)]) == gen, bar);
            __builtin_amdgcn_fence(__ATOMIC_ACQUIRE, "agent");
            asm volatile("s_waitcnt vmcnt(0)" ::: "memory");
        }
    }
    __syncthreads();
}

typedef const float* cfp_t;
typedef const __attribute__((address_space(4))) cfp_t* karg_t;
struct Frame {
    LAS unsigned char* lds;
    int tid, lane, w, h, lq;
    unsigned char* ws;
    karg_t karg;
};
__device__ __forceinline__ const float* pin(const Frame& F, int i) { return F.karg[i]; }
#define GLDS16(gsrc, ldsdst) __builtin_amdgcn_global_load_lds((const unsigned*)(gsrc), (LAS unsigned*)(ldsdst), 16, 0, 0)
#define ST16_WT(ptr, val) asm volatile("global_store_dwordx4 %0, %1, off sc1\n\ts_nop 1" :: "v"(ptr), "v"(val) : "memory")
#define MFMA32(a, b, c) __builtin_amdgcn_mfma_f32_32x32x16_bf16((a), (b), (c), 0, 0, 0)

struct GemmOp { const bf16_t* W; const bf16_t* X; int ldw, ldx, K; };
__device__ __forceinline__ void gemm_issue0(const Frame& F, const GemmOp& g) {
    const int lane = F.lane, w = F.w;
#pragma unroll
    for (int q = 0; q < 2; ++q) { const int row = 16 * w + 8 * q + (lane >> 3); GLDS16(g.W + row * g.ldw + ((lane & 7) ^ ((row >> 1) & 7)) * 8, F.lds + (16 * w + 8 * q) * 128); }
#pragma unroll
    for (int q = 0; q < 4; ++q) { const int row = 32 * w + 8 * q + (lane >> 3); GLDS16(g.X + row * g.ldx + ((lane & 7) ^ ((row >> 1) & 7)) * 8, F.lds + 16384 + (32 * w + 8 * q) * 128); }
}
typedef f32x4 GemmAcc[4][4];
__device__ __forceinline__ void gemm_core(const Frame& F, const GemmOp& g, GemmAcc& acc, bool issue_first, bool has_next, const GemmOp& gn) {
    const int lane = F.lane, w = F.w;
    const bf16_t* __restrict__ W = g.W; const bf16_t* __restrict__ X = g.X;
    const int nkt = g.K >> 6;
    int offW[2], offX[4];
#pragma unroll
    for (int q = 0; q < 2; ++q) { const int row = 16 * w + 8 * q + (lane >> 3); offW[q] = row * g.ldw + ((lane & 7) ^ ((row >> 1) & 7)) * 8; }
#pragma unroll
    for (int q = 0; q < 4; ++q) { const int row = 32 * w + 8 * q + (lane >> 3); offX[q] = row * g.ldx + ((lane & 7) ^ ((row >> 1) & 7)) * 8; }
    LAS unsigned char* const dW = F.lds + (16 * w) * 128;
    LAS unsigned char* const dX = F.lds + 16384 + (32 * w) * 128;
#define GC_ISSUE(kt, st) do { _Pragma("unroll") for (int q = 0; q < 2; ++q) GLDS16(W + offW[q] + (kt) * 64, dW + (st) * GST + q * 1024); \
        _Pragma("unroll") for (int q = 0; q < 4; ++q) GLDS16(X + offX[q] + (kt) * 64, dX + (st) * GST + q * 1024); } while (0)
    const int wn = w & 1, wm = w >> 1, c15 = lane & 15, g4 = lane >> 4;
    const int sw = (c15 >> 1) & 7;
    int so[2];
#pragma unroll
    for (int s = 0; s < 2; ++s) so[s] = ((4 * s + g4) ^ sw) << 4;
    const int bn0 = (64 * wn + c15) * 128, bm0 = 16384 + (64 * wm + c15) * 128;
#pragma unroll
    for (int a = 0; a < 4; ++a)
#pragma unroll
        for (int b = 0; b < 4; ++b) acc[a][b] = (f32x4){0.f, 0.f, 0.f, 0.f};
    if (issue_first) GC_ISSUE(0, 0);
    asm volatile("s_waitcnt vmcnt(0)" ::: "memory");
    __syncthreads();
    for (int kt = 0; kt < nkt; ++kt) {
        const int st = kt & 1;
        if (kt + 1 < nkt) GC_ISSUE(kt + 1, st ^ 1);
        LAS unsigned char* const base = F.lds + st * GST;
#pragma unroll
        for (int s = 0; s < 2; ++s) {
            bf16x8 fa[4], fb[4];
#pragma unroll
            for (int q = 0; q < 4; ++q) { fa[q] = *(const LAS bf16x8*)(base + bn0 + q * 2048 + so[s]); fb[q] = *(const LAS bf16x8*)(base + bm0 + q * 2048 + so[s]); }
#pragma unroll
            for (int a = 0; a < 4; ++a)
#pragma unroll
                for (int b = 0; b < 4; ++b) acc[a][b] = __builtin_amdgcn_mfma_f32_16x16x32_bf16(fa[a], fb[b], acc[a][b], 0, 0, 0);
        }
        asm volatile("s_waitcnt vmcnt(0)" ::: "memory");
        __syncthreads();
    }
#undef GC_ISSUE
    if (has_next) gemm_issue0(F, gn);
}

typedef f32x4 GemmAcc8[4][8];
__device__ __forceinline__ void gemm256_issue0(const Frame& F, const bf16_t* W, const bf16_t* X) {
    int lane = F.lane; const int w = F.w;
    asm volatile("" : "+v"(lane));
#pragma unroll
    for (int q = 0; q < 4; ++q) {
        const int row = 32 * w + 8 * q + (lane >> 3), off = row * 1024 + ((lane & 7) ^ ((row >> 1) & 7)) * 8;
        GLDS16(W + off, F.lds + (32 * w + 8 * q) * 128);
        GLDS16(X + off, F.lds + 32768 + (32 * w + 8 * q) * 128);
    }
}
__device__ __forceinline__ void gemm_core256(const Frame& F, const bf16_t* __restrict__ W, const bf16_t* __restrict__ X, GemmAcc8& acc, bool issue_first, bool has_next, const bf16_t* Wn, const bf16_t* Xn) {
    int lane = F.lane; const int w = F.w;
    asm volatile("" : "+v"(lane));
    int off[4];
#pragma unroll
    for (int q = 0; q < 4; ++q) { const int row = 32 * w + 8 * q + (lane >> 3); off[q] = row * 1024 + ((lane & 7) ^ ((row >> 1) & 7)) * 8; }
    LAS unsigned char* const dW = F.lds + (32 * w) * 128;
    LAS unsigned char* const dX = F.lds + 32768 + (32 * w) * 128;
#define GC2_ISSUE(kt, st) do { _Pragma("unroll") for (int q = 0; q < 4; ++q) { GLDS16(W + off[q] + (kt) * 64, dW + (st) * GST2 + q * 1024); GLDS16(X + off[q] + (kt) * 64, dX + (st) * GST2 + q * 1024); } } while (0)
    const int wn4 = w & 3, wm2 = w >> 2, c15 = lane & 15, g4 = lane >> 4;
    const int sw = (c15 >> 1) & 7;
    int so[2];
#pragma unroll
    for (int s = 0; s < 2; ++s) so[s] = ((4 * s + g4) ^ sw) << 4;
    const int bn0 = (64 * wn4 + c15) * 128, bm0 = 32768 + (128 * wm2 + c15) * 128;
#pragma unroll
    for (int a = 0; a < 4; ++a)
#pragma unroll
        for (int b = 0; b < 8; ++b) acc[a][b] = (f32x4){0.f, 0.f, 0.f, 0.f};
    if (issue_first) GC2_ISSUE(0, 0);
    asm volatile("s_waitcnt vmcnt(0)" ::: "memory");
    __syncthreads();
    for (int kt = 0; kt < 16; ++kt) {
        const int st = kt & 1;
        if (kt + 1 < 16) GC2_ISSUE(kt + 1, st ^ 1);
        LAS unsigned char* const base = F.lds + st * GST2;
#pragma unroll
        for (int s = 0; s < 2; ++s) {
            bf16x8 fa[4];
#pragma unroll
            for (int q = 0; q < 4; ++q) fa[q] = *(const LAS bf16x8*)(base + bn0 + q * 2048 + so[s]);
#pragma unroll
            for (int hb = 0; hb < 2; ++hb) {
                bf16x8 fb[4];
#pragma unroll
                for (int q = 0; q < 4; ++q) fb[q] = *(const LAS bf16x8*)(base + bm0 + (4 * hb + q) * 2048 + so[s]);
#pragma unroll
                for (int a = 0; a < 4; ++a)
#pragma unroll
                    for (int b = 0; b < 4; ++b) acc[a][4 * hb + b] = __builtin_amdgcn_mfma_f32_16x16x32_bf16(fa[a], fb[b], acc[a][4 * hb + b], 0, 0, 0);
            }
        }
        asm volatile("s_waitcnt vmcnt(0)" ::: "memory");
        __syncthreads();
    }
#undef GC2_ISSUE
    if (has_next) gemm256_issue0(F, Wn, Xn);
}

__device__ __forceinline__ void rope64_16(float (&v)[4][4], float rowp, float colp, int g4) {
#pragma unroll
    for (int i = 0; i < 4; ++i) {
        const float fr = __builtin_amdgcn_exp2f((float)(4 * g4 + i) * -0.8304820237218406f) * 0.15915494309189535f;
#pragma unroll
        for (int c = 0; c < 2; ++c) {
            const float rev = (c ? colp : rowp) * fr;
            const float sn = __builtin_amdgcn_sinf(rev), cs = __builtin_amdgcn_cosf(rev);
            const float x0 = v[2 * c][i], x1 = v[2 * c + 1][i];
            v[2 * c][i] = x0 * cs - x1 * sn;
            v[2 * c + 1][i] = x1 * cs + x0 * sn;
        }
    }
}
__device__ __forceinline__ void rope32_16(float (&a)[4], float (&b)[4], float rowp, float colp, int g4) {
    const bool hi = g4 >= 2;
#pragma unroll
    for (int i = 0; i < 4; ++i) {
        const float fr = __builtin_amdgcn_exp2f((float)(4 * (g4 & 1) + i) * -1.6609640474436813f) * 0.15915494309189535f;
        {
            const float rev = rowp * fr;
            const float sn = __builtin_amdgcn_sinf(rev), cs = __builtin_amdgcn_cosf(rev);
            const float own = a[i], oth = __shfl_xor(own, 32);
            a[i] = own * cs + oth * (hi ? sn : -sn);
        }
        {
            const float rev = colp * fr;
            const float sn = __builtin_amdgcn_sinf(rev), cs = __builtin_amdgcn_cosf(rev);
            const float own = b[i], oth = __shfl_xor(own, 32);
            b[i] = own * cs + oth * (hi ? sn : -sn);
        }
    }
}
__device__ __forceinline__ float ssq64(const float (&v)[4][4]) {
    float s = 0.f;
#pragma unroll
    for (int nt = 0; nt < 4; ++nt)
#pragma unroll
        for (int i = 0; i < 4; ++i) s += v[nt][i] * v[nt][i];
    s += __shfl_xor(s, 16);
    s += __shfl_xor(s, 32);
    return s;
}
__device__ __forceinline__ void mulvec64(float (&v)[4][4], const LAS float* gv, int g4) {
#pragma unroll
    for (int nt = 0; nt < 4; ++nt) {
        const f32x4 q = *(const LAS f32x4*)(gv + 16 * nt + 4 * g4);
#pragma unroll
        for (int i = 0; i < 4; ++i) v[nt][i] *= q[i];
    }
}
constexpr int OST_LD = 68, OST_BYTES = 32 * OST_LD * 4;
__device__ __forceinline__ void stage_write16(LAS float* st, const float (&v)[4][4], int mh, int c15, int g4) {
    asm volatile("s_waitcnt lgkmcnt(0)" ::: "memory");
    __builtin_amdgcn_wave_barrier();
#pragma unroll
    for (int nt = 0; nt < 4; ++nt) {
        f32x4 o = {v[nt][0], v[nt][1], v[nt][2], v[nt][3]};
        *(LAS f32x4*)(st + (16 * mh + c15) * OST_LD + 16 * nt + 4 * g4) = o;
    }
    asm volatile("s_waitcnt lgkmcnt(0)" ::: "memory");
    __builtin_amdgcn_wave_barrier();
}
__device__ __forceinline__ void stage_write16a(LAS float* st, const f32x4 (&a)[4][4], int mt, int c15, int g4) {
    asm volatile("s_waitcnt lgkmcnt(0)" ::: "memory");
    __builtin_amdgcn_wave_barrier();
#pragma unroll
    for (int nt = 0; nt < 4; ++nt) *(LAS f32x4*)(st + (16 * (mt & 1) + c15) * OST_LD + 16 * nt + 4 * g4) = a[nt][mt];
    asm volatile("s_waitcnt lgkmcnt(0)" ::: "memory");
    __builtin_amdgcn_wave_barrier();
}
__device__ __forceinline__ void stage_store_bf16(const LAS float* st, bf16_t* dst, int ld, float sc, int lane) {
#pragma unroll 1
    for (int it = 0; it < 4; ++it) {
        const int row = it * 8 + (lane >> 3), c8 = (lane & 7) * 8;
        const f32x4 x0 = *(const LAS f32x4*)(st + row * OST_LD + c8), x1 = *(const LAS f32x4*)(st + row * OST_LD + c8 + 4);
        u32x4 o; o.x = pk2(x0[0] * sc, x0[1] * sc); o.y = pk2(x0[2] * sc, x0[3] * sc); o.z = pk2(x1[0] * sc, x1[1] * sc); o.w = pk2(x1[2] * sc, x1[3] * sc);
        ST16_WT(dst + (size_t)row * ld + c8, o);
    }
}
__device__ __forceinline__ void stage_store_bf16_sc1(const LAS float* st, bf16_t* dst, int ld, int lane) {
#pragma unroll 1
    for (int it = 0; it < 4; ++it) {
        const int row = it * 8 + (lane >> 3), c8 = (lane & 7) * 8;
        const f32x4 x0 = *(const LAS f32x4*)(st + row * OST_LD + c8), x1 = *(const LAS f32x4*)(st + row * OST_LD + c8 + 4);
        u32x4 o; o.x = pk2(x0[0], x0[1]); o.y = pk2(x0[2], x0[3]); o.z = pk2(x1[0], x1[1]); o.w = pk2(x1[2], x1[3]);
        bf16_t* ptr = dst + (size_t)row * ld + c8;
        asm volatile("global_store_dwordx4 %0, %1, off sc1\n\ts_nop 1" :: "v"(ptr), "v"(o) : "memory");
    }
}
__device__ __forceinline__ void stage_store_f32(const LAS float* st, float* dst, int ld, int lane) {
#pragma unroll 1
    for (int it = 0; it < 8; ++it) {
        const int row = it * 4 + (lane >> 4), c = (lane & 15) * 4;
        { const f32x4 o = *(const LAS f32x4*)(st + row * OST_LD + c); ST16_WT(dst + (size_t)row * ld + c, o); }
    }
}
__device__ __forceinline__ void stage_store_bf16_32(const LAS float* st, bf16_t* dst, int ld, int lane) {
#pragma unroll 1
    for (int it = 0; it < 2; ++it) {
        const int row = it * 16 + (lane >> 2), c8 = (lane & 3) * 8;
        const f32x4 x0 = *(const LAS f32x4*)(st + row * OST_LD + c8), x1 = *(const LAS f32x4*)(st + row * OST_LD + c8 + 4);
        u32x4 o; o.x = pk2(x0[0], x0[1]); o.y = pk2(x0[2], x0[3]); o.z = pk2(x1[0], x1[1]); o.w = pk2(x1[2], x1[3]);
        ST16_WT(dst + (size_t)row * ld + c8, o);
    }
}
__device__ __forceinline__ void stage_store_f32_32(const LAS float* st, float* dst, int ld, int lane) {
#pragma unroll 1
    for (int it = 0; it < 4; ++it) {
        const int row = it * 8 + (lane >> 3), c = (lane & 7) * 4;
        { const f32x4 o = *(const LAS f32x4*)(st + row * OST_LD + c); ST16_WT(dst + (size_t)row * ld + c, o); }
    }
}

struct Gemm1Pre { float rstd[2]; float bias, gain; };
__device__ __forceinline__ void gemm1_pre(const Frame& F, const Params& p, int tn, int wn, int tm, int l, Gemm1Pre& P) {
    const float* ssqp = (const float*)(F.ws + WS_SSQ);
#pragma unroll
    for (int jj = 0; jj < 2; ++jj) {
        const int tok = tm * 256 + (F.w >> 2) * 128 + 64 * jj + F.lane;
        const f32x4* sp = (const f32x4*)(ssqp + (size_t)tok * 16);
        float ss = 0.f;
#pragma unroll
        for (int i = 0; i < 4; ++i) { const f32x4 q = sp[i]; ss += (q[0] + q[1]) + (q[2] + q[3]); }
        P.rstd[jj] = rsqrtf(ss * (1.f / 1024.f) + EPS);
    }
    const bool lat = tm >= 16;
    const int cond = lat ? 1 + ((tm - 16) >> 2) : 0;
    const int nb = tn * 128 + wn * 64;
    P.bias = (tn < 23) ? ((const float*)(F.ws + WS_BIAS))[(size_t)(l * 5 + cond) * 2944 + nb + F.lane] : 0.f;
    const float* gp = nullptr;
    if (tn >= 6 && tn < 9) gp = pin(F, I_GQN) + l * 64;
    else if (tn == 9) gp = pin(F, I_GKN) + l * 64;
    else if (tn == 11 || tn == 12) gp = pin(F, I_MQN) + l * 256 + (nb - 1408);
    else if (tn == 13) gp = pin(F, I_MKVN) + l * 128 + wn * 64;
    P.gain = gp ? gp[F.lane] : 1.f;
}
__device__ __forceinline__ void epi_gemm1(const Frame& F, const Params& p, GemmAcc8& acc, int tn, int wn, int tm, int l, const Gemm1Pre& P, bool ckv_tile) {
    int lane = F.lane; const int wm = F.w >> 2;
    asm volatile("" : "+v"(lane));
    const int c15 = lane & 15, g4 = lane >> 4;
    unsigned char* ws = F.ws;
    asm volatile("" : "+s"(ws));
    LAS float* st = (LAS float*)(F.lds + LDS_OST + F.w * OST_BYTES);
    const bool lat = tm >= 16;
    const int b = lat ? ((tm - 16) >> 2) : tm;
    const int nb = tn * 128 + wn * 64;
    LAS float* exb = (LAS float*)(F.lds + LDS_EXB) + F.w * 128;
    exb[lane] = P.bias; exb[64 + lane] = P.gain;
    asm volatile("s_waitcnt lgkmcnt(0)" ::: "memory");
    __builtin_amdgcn_wave_barrier();
    const LAS float* bias = exb;
    float* outp = p.out;
    asm volatile("" : "+s"(outp));
    float ckv_ss[8];
    if (tn < 23) {
#pragma unroll
    for (int mt = 0; mt < 8; ++mt) {
        const int mh = mt & 1;
        const int tok0 = tm * 256 + wm * 128 + (mt >> 1) * 32;
        const int tokb = tok0 + 16 * mh, tok = tokb + c15;
        const int t0 = lat ? ((tok0 - 4096) & 1023) : (tok0 & 255), t = t0 + 16 * mh + c15;
        const float rstd = __shfl(P.rstd[mt >> 2], 16 * (mt & 3) + c15);
        float v[4][4];
#pragma unroll
        for (int nt = 0; nt < 4; ++nt) {
            const f32x4 bq = *(const LAS f32x4*)(bias + 16 * nt + 4 * g4);
#pragma unroll
            for (int i = 0; i < 4; ++i) v[nt][i] = acc[nt][mt][i] * rstd + bq[i];
        }
        const float rowp = (float)(t >> 6), colp = (float)(t & 63);
        const size_t orow0 = (size_t)(b * 4 + l) * 256 + t0;
        if (tn < 2) {
            if (lat) rope64_16(v, rowp, colp, g4);
            stage_write16(st, v, mh, c15, g4);
            if (mh) stage_store_bf16(st, (bf16_t*)(ws + WS_RQ) + (size_t)tok0 * 256 + nb, 256, 1.f, lane);
        } else if (tn < 4) {
            if (lat) rope64_16(v, rowp, colp, g4);
            stage_write16(st, v, mh, c15, g4);
            if (mh) stage_store_bf16(st, (bf16_t*)(ws + WS_RK) + (size_t)tok0 * 256 + (nb - 256), 256, 0.125f, lane);
        } else if (tn < 6) {
            stage_write16(st, v, mh, c15, g4);
            if (mh) stage_store_bf16(st, (bf16_t*)(ws + WS_RV) + (size_t)tok0 * 256 + (nb - 512), 256, 1.f, lane);
        } else if (tn < 9) {
            const float r = rsqrtf(ssq64(v) * (1.f / 64.f) + EPS);
#pragma unroll
            for (int nt = 0; nt < 4; ++nt)
#pragma unroll
                for (int i = 0; i < 4; ++i) v[nt][i] *= r;
            mulvec64(v, exb + 64, g4);
            if (lat) rope64_16(v, rowp, colp, g4);
            stage_write16(st, v, mh, c15, g4);
            if (mh) stage_store_bf16(st, (bf16_t*)(ws + WS_GQ) + (size_t)tok0 * 384 + (nb - 768), 384, QSC_GQA, lane);
        } else if (tn == 9) {
            const float r = rsqrtf(ssq64(v) * (1.f / 64.f) + EPS);
#pragma unroll
            for (int nt = 0; nt < 4; ++nt)
#pragma unroll
                for (int i = 0; i < 4; ++i) v[nt][i] *= r;
            mulvec64(v, exb + 64, g4);
            if (lat) rope64_16(v, rowp, colp, g4);
            stage_write16(st, v, mh, c15, g4);
            if (mh) {
                if (!lat) stage_store_f32(st, outp + O_GK + orow0 * 128 + (nb - 1152), 128, lane);
                stage_store_bf16(st, (bf16_t*)(ws + WS_GK) + (size_t)tok0 * 128 + (nb - 1152), 128, 1.f, lane);
            }
        } else if (tn == 10) {
            stage_write16(st, v, mh, c15, g4);
            if (mh) {
                if (!lat) stage_store_f32(st, outp + O_GV + orow0 * 128 + (nb - 1280), 128, lane);
                stage_store_bf16(st, (bf16_t*)(ws + WS_GV) + (size_t)tok0 * 128 + (nb - 1280), 128, 1.f, lane);
            }
        } else if (tn < 13) {
            const float s2 = ssq64(v);
            if (g4 == 0) __hip_atomic_store((__attribute__((address_space(1))) float*)((float*)(ws + WS_CQSSQ) + (size_t)tok * 4 + ((nb - 1408) >> 6)), s2, __ATOMIC_RELAXED, __HIP_MEMORY_SCOPE_AGENT);
            mulvec64(v, exb + 64, g4);
            stage_write16(st, v, mh, c15, g4);
            if (mh) stage_store_bf16_sc1(st, (bf16_t*)(ws + WS_CQG) + (size_t)tok0 * 256 + (nb - 1408), 256, lane);
        } else if (tn == 13) {
            ckv_ss[mt] = ssq64(v);
            if (g4 == 0) ((LAS float*)(F.lds + LDS_EX))[(wm * 2 + wn) * 128 + mt * 16 + c15] = ckv_ss[mt];
        } else if (tn < 22) {
#pragma unroll
            for (int nt = 0; nt < 4; ++nt)
#pragma unroll
                for (int i = 0; i < 4; ++i) v[nt][i] = silu_f(v[nt][i]);
            stage_write16(st, v, mh, c15, g4);
            if (mh) stage_store_bf16(st, (bf16_t*)(ws + WS_ZS) + (size_t)tok0 * 1024 + (nb - 1792), 1024, 1.f, lane);
        } else {
            if (wn == 0) {
                if (lat) rope32_16(v[0], v[1], rowp, colp, g4);
                stage_write16(st, v, mh, c15, g4);
                if (mh) {
                    if (!lat) stage_store_f32_32(st, outp + O_KPE + orow0 * 32, 32, lane);
                    stage_store_bf16_32(st, (bf16_t*)(ws + WS_KPEB) + (size_t)tok0 * 32, 32, lane);
                }
            }
        }
    }
    }
    if (ckv_tile) {
        __syncthreads();
        if (tn == 13) {
#pragma unroll
        for (int mt = 0; mt < 8; ++mt) {
            const int mh = mt & 1;
            const int tok0 = tm * 256 + wm * 128 + (mt >> 1) * 32;
            const int t0 = lat ? ((tok0 - 4096) & 1023) : (tok0 & 255);
            const float rstd = __shfl(P.rstd[mt >> 2], 16 * (mt & 3) + c15);
            float v[4][4];
#pragma unroll
            for (int nt = 0; nt < 4; ++nt) {
                const f32x4 bq = *(const LAS f32x4*)(bias + 16 * nt + 4 * g4);
#pragma unroll
                for (int i = 0; i < 4; ++i) v[nt][i] = acc[nt][mt][i] * rstd + bq[i];
            }
            const float tot = ckv_ss[mt] + ((const LAS float*)(F.lds + LDS_EX))[(wm * 2 + (wn ^ 1)) * 128 + mt * 16 + c15];
            const float r = rsqrtf(tot * (1.f / 128.f) + EPS);
#pragma unroll
            for (int nt = 0; nt < 4; ++nt)
#pragma unroll
                for (int i = 0; i < 4; ++i) v[nt][i] *= r;
            mulvec64(v, exb + 64, g4);
            const size_t orow0 = (size_t)(b * 4 + l) * 256 + t0;
            stage_write16(st, v, mh, c15, g4);
            if (mh) {
                if (!lat) stage_store_f32(st, outp + O_CKV + orow0 * 128 + wn * 64, 128, lane);
                stage_store_bf16_sc1(st, (bf16_t*)(ws + WS_CKVN) + (size_t)tok0 * 128 + wn * 64, 128, lane);
            }
        }
        }
        __syncthreads();
    }
}

__device__ __forceinline__ void qm_pre(const Frame& F, int tm, float& rstd) {
    const int tok = tm * 256 + (F.w >> 1) * 64 + F.lane;
    const f32x4 q4 = *(const f32x4*)((const float*)(F.ws + WS_CQSSQ) + (size_t)tok * 4);
    rstd = rsqrtf(((q4[0] + q4[1]) + (q4[2] + q4[3])) * (1.f / 256.f) + EPS);
}
__device__ __forceinline__ void epi_qm(const Frame& F, GemmAcc& acc, int tn, int tm, float rstdl) {
    int lane = F.lane; const int wn = F.w & 1, wm = F.w >> 1;
    asm volatile("" : "+v"(lane));
    const int c15 = lane & 15, g4 = lane >> 4;
    unsigned char* ws = F.ws;
    LAS float* st = (LAS float*)(F.lds + LDS_OST + F.w * OST_BYTES);
    const bool lat = tm >= 16;
    const int nb = tn * 128 + wn * 64;
    if (nb >= 576) return;
#pragma unroll
    for (int mt = 0; mt < 4; ++mt) {
        const int mh = mt & 1;
        const int tok0 = tm * 256 + wm * 64 + (mt >> 1) * 32, tok = tok0 + 16 * mh + c15;
        const int t = lat ? ((tok - 4096) & 1023) : (tok & 255);
        const float rstd = __shfl(rstdl, 16 * mt + c15);
        const float rowp = (float)(t >> 6), colp = (float)(t & 63);
        float v[4][4];
#pragma unroll
        for (int nt = 0; nt < 4; ++nt)
#pragma unroll
            for (int i = 0; i < 4; ++i) v[nt][i] = acc[nt][mt][i] * rstd;
#pragma unroll
        for (int q = 0; q < 2; ++q) {
            const int T = (nb + 32 * q) >> 5;
            if (lat && (T % 3) == 2) rope32_16(v[2 * q], v[2 * q + 1], rowp, colp, g4);
        }
        stage_write16(st, v, mh, c15, g4);
        if (mh) stage_store_bf16(st, (bf16_t*)(ws + WS_QM) + (size_t)tok0 * 576 + nb, 576, QSC_MLA, lane);
    }
}
__device__ __forceinline__ void epi_plain(const Frame& F, GemmAcc& acc, bf16_t* D, int ldd, int row0, int n0) {
    int lane = F.lane; const int wn = F.w & 1, wm = F.w >> 1;
    asm volatile("" : "+v"(lane));
    const int c15 = lane & 15, g4 = lane >> 4;
    LAS float* st = (LAS float*)(F.lds + LDS_OST + F.w * OST_BYTES);
#pragma unroll
    for (int mt = 0; mt < 4; ++mt) {
        const int r0 = row0 + wm * 64 + (mt >> 1) * 32;
        stage_write16a(st, acc, mt, c15, g4);
        if (mt & 1) stage_store_bf16(st, D + (size_t)r0 * ldd + n0 + wn * 64, ldd, 1.f, lane);
    }
}

struct Gemm2Pre { f32x4 gt0, gt1, gs0, gs1; };
__device__ __forceinline__ void gemm2_pre(const Frame& F, int tn, int tm, int l, Gemm2Pre& P) {
    const bool lat = tm >= 16; const int cond = lat ? 1 + ((tm - 16) >> 2) : 0;
    const int nb = tn * 128 + (F.w & 1) * 64, c8 = (F.lane & 7) * 8;
    const float* gtp = (const float*)(F.ws + WS_MODS) + (size_t)(l * 5 + cond) * 3072 + 2048 + nb + c8;
    const float* gsp = (const float*)(F.ws + WS_GS) + (size_t)((l < 3 ? l + 1 : 3) * 5 + cond) * 1024 + nb + c8;
    P.gt0 = *(const f32x4*)gtp; P.gt1 = *(const f32x4*)(gtp + 4);
    P.gs0 = *(const f32x4*)gsp; P.gs1 = *(const f32x4*)(gsp + 4);
}
__device__ __forceinline__ void epi_gemm2(const Frame& F, const Params& p, GemmAcc& acc, int tn, int tm, int l, const Gemm2Pre& P, bool last) {
    int lane = F.lane; const int wn = F.w & 1, wm = F.w >> 1;
    asm volatile("" : "+v"(lane));
    const int c15 = lane & 15, g4 = lane >> 4;
    unsigned char* ws = F.ws;
    LAS float* st = (LAS float*)(F.lds + LDS_OST + F.w * OST_BYTES);
    const bool lat = tm >= 16;
    const int nb = tn * 128 + wn * 64;
    const int c8 = (lane & 7) * 8, r8 = lane >> 3;
#pragma unroll
    for (int mt = 0; mt < 2; ++mt) {
        const int tok0 = tm * 256 + wm * 64 + mt * 32;
        stage_write16a(st, acc, 2 * mt, c15, g4);
        stage_write16a(st, acc, 2 * mt + 1, c15, g4);
        bf16_t* xb0 = (bf16_t*)(ws + WS_XB) + (size_t)tok0 * 1024 + nb + c8;
        f32x4 xo8[8];
        if (l == 0) {
            const float* xold0 = lat ? pin(F, I_XS) + (size_t)(tok0 - 4096) * 1024 : pin(F, I_XP) + (size_t)tok0 * 1024;
#pragma unroll
            for (int it = 0; it < 4; ++it) {
                const float* xp = xold0 + (size_t)(it * 8 + r8) * 1024 + nb + c8;
                xo8[2 * it] = *(const f32x4*)xp; xo8[2 * it + 1] = *(const f32x4*)(xp + 4);
            }
        } else {
#pragma unroll
            for (int it = 0; it < 4; ++it) {
                const u32x4 q = *(const u32x4*)(xb0 + (size_t)(it * 8 + r8) * 1024);
                xo8[2 * it] = (f32x4){bflo(q.x), bfhi(q.x), bflo(q.y), bfhi(q.y)}; xo8[2 * it + 1] = (f32x4){bflo(q.z), bfhi(q.z), bflo(q.w), bfhi(q.w)};
            }
        }
#pragma unroll
        for (int it = 0; it < 4; ++it) {
            const int row = it * 8 + r8;
            const f32x4 a0 = *(const LAS f32x4*)(st + row * OST_LD + c8), a1 = *(const LAS f32x4*)(st + row * OST_LD + c8 + 4);
            const f32x4 xn0 = xo8[2 * it] + P.gt0 * a0, xn1 = xo8[2 * it + 1] + P.gt1 * a1;
            {
                u32x4 o; o.x = pk2(xn0[0], xn0[1]); o.y = pk2(xn0[2], xn0[3]); o.z = pk2(xn1[0], xn1[1]); o.w = pk2(xn1[2], xn1[3]);
                if (last) ST16_WT(xb0 + (size_t)row * 1024, o); else *(u32x4*)(xb0 + (size_t)row * 1024) = o;
            }
            float ss = ((xn0[0] * xn0[0] + xn0[1] * xn0[1]) + (xn0[2] * xn0[2] + xn0[3] * xn0[3])) + ((xn1[0] * xn1[0] + xn1[1] * xn1[1]) + (xn1[2] * xn1[2] + xn1[3] * xn1[3]));
            ss += __shfl_xor(ss, 1); ss += __shfl_xor(ss, 2); ss += __shfl_xor(ss, 4);
            if ((lane & 7) == 0) {
                float* sq = (float*)(ws + WS_SSQ) + (size_t)(tok0 + row) * 16 + tn * 2 + wn;
                __hip_atomic_store((__attribute__((address_space(1))) float*)sq, ss, __ATOMIC_RELAXED, __HIP_MEMORY_SCOPE_AGENT);
            }
            if (l < 3) {
                u32x4 o; o.x = pk2(xn0[0] * P.gs0[0], xn0[1] * P.gs0[1]); o.y = pk2(xn0[2] * P.gs0[2], xn0[3] * P.gs0[3]);
                o.z = pk2(xn1[0] * P.gs1[0], xn1[1] * P.gs1[1]); o.w = pk2(xn1[2] * P.gs1[2], xn1[3] * P.gs1[3]);
                ST16_WT((bf16_t*)(ws + WS_XG) + (size_t)(tok0 + row) * 1024 + nb + c8, o);
            }
        }
    }
}
constexpr int AT_STG = 20480, AT_PE = 8192, AT_V = 12288, AT_OLD = 68;
struct AttnUnit {
    int mode;
    int nt0, nt1;
    const bf16_t *q; int q_ld;
    const bf16_t *k0, *k1; int k_ld0, k_ld1;
    const bf16_t *pe0, *pe1;
    const bf16_t *v0, *v1; int v_ld0, v_ld1;
    int tok0;
    int ycol;
    int qpos0, L;
    float lf, lb;
    const bf16_t *s0f, *s0b;
    unsigned* zflag;
    unsigned* yflag;
    float* st_out;
};
__device__ __forceinline__ s16x4 tr16(LAS const unsigned char* p) {
    typedef short v4i16_t __attribute__((ext_vector_type(4)));
    return __builtin_bit_cast(s16x4, __builtin_amdgcn_ds_read_tr16_b64_v4i16((LAS v4i16_t*)p));
}

template <int MODE>
__device__ __forceinline__ void attn_unit(const Frame& F, const Params& p, const AttnUnit& U) {
    constexpr int NQS = MODE == 1 ? 6 : 4;
    const int lane = F.lane, w = F.w, h = F.h, lq = F.lq;
    LAS unsigned char* lds = F.lds;
    const int k_ld = U.k_ld1, v_ld = U.v_ld1;
    const int krow = 8 * w + (lane >> 3);
    const int koff = krow * k_ld + ((lane & 7) ^ ((krow >> 1) & 7)) * 8;
    const int poff = (16 * (w & 3) + (lane >> 2)) * 32 + ((lane & 3) ^ ((lane >> 4) & 3)) * 8;
    const int vdblk = w >> 2, vkg = w & 3;
    const int voff = (16 * vkg + (lane >> 2)) * v_ld + vdblk * 32 + (lane & 3) * 8;
    const int vdst = AT_V + vdblk * 4096 + vkg * 1024;
    const int nt0 = U.nt0, ntot = U.nt0 + U.nt1;
    const unsigned ldsb = (unsigned)(uintptr_t)lds;
#define AT_DMA(gsrc, ldsoff) do { unsigned _keep; const unsigned _d = (unsigned)__builtin_amdgcn_readfirstlane((int)(ldsb + (unsigned)(ldsoff))); \
        asm volatile("s_mov_b32 %0, m0\n\ts_mov_b32 m0, %2\n\ts_nop 0\n\tglobal_load_lds_dwordx4 %1, off\n\ts_mov_b32 m0, %0" : "=&s"(_keep) : "v"(gsrc), "s"(_d) : "memory"); } while (0)
#define AT_ISSUE(t, st) do { const int _t = (t); const int _b = (st) * AT_STG; \
        const bool _s0 = _t < nt0; const int _u = _s0 ? _t : _t - nt0; \
        const bf16_t* _kb = (_s0 ? U.k0 : U.k1) + (size_t)_u * 64 * k_ld; const bf16_t* _vb = (_s0 ? U.v0 : U.v1) + (size_t)_u * 64 * v_ld; \
        AT_DMA(_kb + koff, _b + (8 * w) * 128); \
        if (MODE == 1) { const bf16_t* _pb = (_s0 ? U.pe0 : U.pe1) + (size_t)_u * 64 * 32; AT_DMA(_pb + poff, _b + AT_PE + 16 * (w & 3) * 64); } \
        AT_DMA(_vb + voff, _b + vdst); } while (0)
    AT_ISSUE(0, 0);
    if (ntot > 1) AT_ISSUE(1, 1);
    bf16x8 qr[NQS];
    if (MODE == 3) {
        const int dk = 32 * (w & 1) + lq;
#pragma unroll
        for (int s = 0; s < 4; ++s)
#pragma unroll
            for (int j = 0; j < 8; ++j) qr[s][j] = (16 * s + 8 * h + j == dk) ? (short)0x3F80 : (short)0;
    } else {
        const bf16_t* qp = U.q + (size_t)(32 * w + lq) * U.q_ld + 8 * h;
#pragma unroll
        for (int s = 0; s < NQS; ++s) qr[s] = *(const bf16x8*)(qp + 16 * s);
    }
    f32x16 o[2];
#pragma unroll
    for (int d = 0; d < 2; ++d)
#pragma unroll
        for (int r = 0; r < 16; ++r) o[d][r] = 0.f;
    float m_run = 0.f, l_run = 0.f;
    f32x16 negm;
#pragma unroll
    for (int r = 0; r < 16; ++r) negm[r] = 0.f;
    const int qpos = U.qpos0 + 32 * w + lq;
    const float st_slope = ((w >> 1) & 1) ? U.lb : -U.lf, st_off = ((w >> 1) & 1) ? 0.f : 255.f * U.lf;
    const int sdir = (w >> 1) & 1;
    LAS float* scal = (LAS float*)(lds + LDS_SCAL) + w * 32;
    LAS float* ctab = (LAS float*)(lds + LDS_EXB) + w * 128;
    float a_f = 0.f, a_b = 0.f;
    if (MODE == 2) {
        ctab[lane] = __builtin_amdgcn_exp2f((float)(63 - lane) * U.lf);
        ctab[64 + lane] = __builtin_amdgcn_exp2f((float)lane * U.lb);
        a_f = __builtin_amdgcn_exp2f((float)(32 * w + lq) * U.lf);
        a_b = __builtin_amdgcn_exp2f((float)(255 - 32 * w - lq) * U.lb);
        asm volatile("s_waitcnt lgkmcnt(0)" ::: "memory");
        __builtin_amdgcn_wave_barrier();
    }
    const int kfo = lq * 128, sw = (lane >> 1) & 7, pfo = AT_PE + lq * 64, psw = (lane >> 2) & 3;
    const int vfo = AT_V + (4 * h + ((lane & 15) >> 2)) * 64 + ((lane >> 4) & 1) * 32 + (lane & 3) * 8;
    int st = 0;
    for (int t = 0; t < ntot; ++t) {
        if (t + 1 < ntot) { if (MODE == 1) asm volatile("s_waitcnt vmcnt(3)" ::: "memory"); else asm volatile("s_waitcnt vmcnt(2)" ::: "memory"); }
        else asm volatile("s_waitcnt vmcnt(0)" ::: "memory");
        __builtin_amdgcn_s_barrier();
        asm volatile("" ::: "memory");
        const int st2 = st == 0 ? 2 : st - 1;
        if (t + 2 < ntot) AT_ISSUE(t + 2, st2);
        LAS const unsigned char* base = lds + st * AT_STG;
        bf16x8 kfa[NQS], kfb[NQS];
#pragma unroll
        for (int s = 0; s < 4; ++s) {
            const int so = ((2 * s + h) ^ sw) << 4;
            kfa[s] = *(const LAS bf16x8*)(base + kfo + so);
            kfb[s] = *(const LAS bf16x8*)(base + kfo + 4096 + so);
        }
        if (MODE == 1) {
#pragma unroll
            for (int s = 0; s < 2; ++s) {
                const int so = ((2 * s + h) ^ psw) << 4;
                kfa[4 + s] = *(const LAS bf16x8*)(base + pfo + so);
                kfb[4 + s] = *(const LAS bf16x8*)(base + pfo + 2048 + so);
            }
        }
        f32x16 p0, p1;
        if (MODE <= 1) { p0 = negm; p1 = negm; }
        else {
#pragma unroll
            for (int r = 0; r < 16; ++r) { p0[r] = 0.f; p1[r] = 0.f; }
        }
#pragma unroll
        for (int s = 0; s < NQS; ++s) { p0 = MFMA32(kfa[s], qr[s], p0); p1 = MFMA32(kfb[s], qr[s], p1); }
        s16x4 vlo[4], vhi[4];
#pragma unroll
        for (int ks = 0; ks < 4; ++ks) { vlo[ks] = tr16(base + vfo + ks * 1024); vhi[ks] = tr16(base + vfo + ks * 1024 + 512); }
        if (MODE <= 1) {
            float tm = p0[0];
#pragma unroll
            for (int r = 1; r < 16; ++r) tm = fmaxf(tm, p0[r]);
#pragma unroll
            for (int r = 0; r < 16; ++r) tm = fmaxf(tm, p1[r]);
            tm = fmaxf(tm, __shfl_xor(tm, 32));
            if (t == 0 || __any(tm > 6.0f)) {
                const float dl = t == 0 ? tm : fmaxf(tm, 0.f);
                m_run += dl;
#pragma unroll
                for (int r = 0; r < 16; ++r) { p0[r] -= dl; p1[r] -= dl; negm[r] = -m_run; }
                if (t > 0) {
                    const float alpha = __builtin_amdgcn_exp2f(-dl);
                    l_run *= alpha;
                    if (h == 0) scal[lq] = alpha;
                    asm volatile("s_waitcnt lgkmcnt(0)" ::: "memory");
#pragma unroll
                    for (int g = 0; g < 4; ++g) {
                        const f32x4 a4 = *(const LAS f32x4*)(scal + 8 * g + 4 * h);
#pragma unroll
                        for (int i = 0; i < 4; ++i) { o[0][4 * g + i] *= a4[i]; o[1][4 * g + i] *= a4[i]; }
                    }
                }
            }
            float ls = 0.f;
#pragma unroll
            for (int r = 0; r < 16; ++r) { p0[r] = __builtin_amdgcn_exp2f(p0[r]); p1[r] = __builtin_amdgcn_exp2f(p1[r]); ls += p0[r] + p1[r]; }
            l_run += ls;
        } else if (MODE == 2 && (64 * t + 63 < U.qpos0 || 64 * t > U.qpos0 + 255)) {
            const bool fwd = 64 * t + 63 < U.qpos0;
            const float A = fwd ? a_f * __builtin_amdgcn_exp2f((float)(U.qpos0 - 64 * t - 63) * U.lf) : a_b * __builtin_amdgcn_exp2f((float)(64 * t - U.qpos0 - 255) * U.lb);
            const LAS float* tb = ctab + (fwd ? 0 : 64) + 4 * h;
#pragma unroll
            for (int g = 0; g < 4; ++g) {
                const f32x4 c0 = *(const LAS f32x4*)(tb + 8 * g), c1 = *(const LAS f32x4*)(tb + 32 + 8 * g);
#pragma unroll
                for (int i = 0; i < 4; ++i) { p0[4 * g + i] *= c0[i] * A; p1[4 * g + i] *= c1[i] * A; }
            }
        } else if (MODE == 2) {
            float dq = (float)(qpos - 64 * t - 4 * h);
            asm volatile("" : "+v"(dq));
#pragma unroll
            for (int r = 0; r < 16; ++r) {
                const float d0 = dq - (float)((r & 3) + 8 * (r >> 2)), d1 = d0 - 32.f;
                const float w0 = __builtin_amdgcn_exp2f(fabsf(d0) * (d0 > 0.f ? U.lf : U.lb));
                const float w1 = __builtin_amdgcn_exp2f(fabsf(d1) * (d1 > 0.f ? U.lf : U.lb));
                p0[r] *= (d0 == 0.f ? 2.f : w0);
                p1[r] *= (d1 == 0.f ? 2.f : w1);
            }
        } else {
            float mb = (float)(64 * t + 4 * h);
            asm volatile("" : "+v"(mb));
#pragma unroll
            for (int r = 0; r < 16; ++r) {
                const float m0 = mb + (float)((r & 3) + 8 * (r >> 2)), m1 = m0 + 32.f;
                const float e0 = fmaf(m0, st_slope, st_off), e1 = fmaf(m1, st_slope, st_off);
                p0[r] *= __builtin_amdgcn_exp2f(e0);
                p1[r] *= __builtin_amdgcn_exp2f(e1);
            }
        }
        bf16x8 pa[4];
        { u32x4 a;
          a.x = pk2(p0[0], p0[1]); a.y = pk2(p0[2], p0[3]); a.z = pk2(p0[4], p0[5]); a.w = pk2(p0[6], p0[7]); pa[0] = __builtin_bit_cast(bf16x8, a);
          a.x = pk2(p0[8], p0[9]); a.y = pk2(p0[10], p0[11]); a.z = pk2(p0[12], p0[13]); a.w = pk2(p0[14], p0[15]); pa[1] = __builtin_bit_cast(bf16x8, a);
          a.x = pk2(p1[0], p1[1]); a.y = pk2(p1[2], p1[3]); a.z = pk2(p1[4], p1[5]); a.w = pk2(p1[6], p1[7]); pa[2] = __builtin_bit_cast(bf16x8, a);
          a.x = pk2(p1[8], p1[9]); a.y = pk2(p1[10], p1[11]); a.z = pk2(p1[12], p1[13]); a.w = pk2(p1[14], p1[15]); pa[3] = __builtin_bit_cast(bf16x8, a); }
#pragma unroll
        for (int ks = 0; ks < 4; ++ks) {
            const bf16x8 vb = __builtin_shufflevector(vlo[ks], vhi[ks], 0, 1, 2, 3, 4, 5, 6, 7);
            o[0] = MFMA32(pa[ks], vb, o[0]);
        }
#pragma unroll
        for (int ks = 0; ks < 4; ++ks) { vlo[ks] = tr16(base + vfo + 4096 + ks * 1024); vhi[ks] = tr16(base + vfo + 4096 + ks * 1024 + 512); }
#pragma unroll
        for (int ks = 0; ks < 4; ++ks) {
            const bf16x8 vb = __builtin_shufflevector(vlo[ks], vhi[ks], 0, 1, 2, 3, 4, 5, 6, 7);
            o[1] = MFMA32(pa[ks], vb, o[1]);
        }
        st = st == 2 ? 0 : st + 1;
    }
#undef AT_ISSUE
#undef AT_DMA
    int lq2 = lq, h2 = h, lane2 = lane; asm volatile("" : "+v"(lq2), "+v"(h2), "+v"(lane2));
    if (MODE == 2 && U.s0f != nullptr) {
        const float ff = __builtin_amdgcn_exp2f((float)(qpos + 1) * U.lf), fb = __builtin_amdgcn_exp2f((float)(U.L - qpos) * U.lb);
#pragma unroll
        for (int s = 0; s < 4; ++s) {
            const u32x4 qu = __builtin_bit_cast(u32x4, qr[s]);
            u32x4 af, ab;
#pragma unroll
            for (int i = 0; i < 4; ++i) { const float lo = bflo(qu[i]), hi = bfhi(qu[i]); af[i] = pk2(lo * ff, hi * ff); ab[i] = pk2(lo * fb, hi * fb); }
#pragma unroll
            for (int d = 0; d < 2; ++d) {
                const bf16x8 sf = *(const bf16x8*)(U.s0f + (size_t)(32 * d + lq2) * 64 + 16 * s + 8 * h2);
                const bf16x8 sb = *(const bf16x8*)(U.s0b + (size_t)(32 * d + lq2) * 64 + 16 * s + 8 * h2);
                o[d] = MFMA32(__builtin_bit_cast(bf16x8, af), sf, o[d]);
                o[d] = MFMA32(__builtin_bit_cast(bf16x8, ab), sb, o[d]);
            }
        }
    }
    if (MODE == 3) {
        float* dst = U.st_out + (size_t)sdir * 4 * 4096 + (size_t)(32 * (w & 1)) * 64;
        if (w < 4) {
#pragma unroll
        for (int d = 0; d < 2; ++d)
#pragma unroll
            for (int r = 0; r < 16; ++r) dst[(size_t)((r & 3) + 8 * (r >> 2) + 4 * h2) * 64 + 32 * d + lq2] = o[d][r];
        }
        __syncthreads();
        if (F.tid == 0 && U.yflag != nullptr) (void)xb_add(U.yflag, 1u);
        return;
    }
    if (MODE <= 1) {
        l_run += __shfl_xor(l_run, 32);
        if (h2 == 0) scal[lq2] = 1.f / l_run;
    }
    if (U.zflag != nullptr && F.tid == 0) {
        unsigned* bar0 = (unsigned*)(F.ws + WS_CTL) + CW_BAR;
        XB_SPIN(xb_ld(U.zflag) < 4u, bar0);
    }
    __syncthreads();
    LAS float* ost = (LAS float*)lds + w * (32 * AT_OLD);
#pragma unroll
    for (int d = 0; d < 2; ++d)
#pragma unroll
        for (int r = 0; r < 16; ++r) ost[((r & 3) + 8 * (r >> 2) + 4 * h2) * AT_OLD + 32 * d + lq2] = o[d][r];
    asm volatile("s_waitcnt lgkmcnt(0)" ::: "memory");
    __builtin_amdgcn_wave_barrier();
    const bf16_t* zs = (const bf16_t*)(F.ws + WS_ZS);
    bf16_t* yb = (bf16_t*)(F.ws + WS_Y);
#pragma unroll
    for (int it = 0; it < 4; ++it) {
        const int row = it * 8 + (lane2 >> 3), c8 = (lane2 & 7) * 8;
        const f32x4 x0 = *(const LAS f32x4*)(ost + row * AT_OLD + c8), x1 = *(const LAS f32x4*)(ost + row * AT_OLD + c8 + 4);
        float sc;
        if (MODE <= 1) sc = scal[row];
        else {
            float ss = (x0[0] * x0[0] + x0[1] * x0[1]) + (x0[2] * x0[2] + x0[3] * x0[3]) + (x1[0] * x1[0] + x1[1] * x1[1]) + (x1[2] * x1[2] + x1[3] * x1[3]);
            ss += __shfl_xor(ss, 1); ss += __shfl_xor(ss, 2); ss += __shfl_xor(ss, 4);
            sc = rsqrtf(ss * (1.f / 64.f) + EPS);
        }
        const size_t off = (size_t)(U.tok0 + 32 * w + row) * 1024 + U.ycol + c8;
        const u32x4 z = *(const u32x4*)(zs + off);
        u32x4 y;
        y.x = pk2(x0[0] * sc * bflo(z.x), x0[1] * sc * bfhi(z.x));
        y.y = pk2(x0[2] * sc * bflo(z.y), x0[3] * sc * bfhi(z.y));
        y.z = pk2(x1[0] * sc * bflo(z.z), x1[1] * sc * bfhi(z.z));
        y.w = pk2(x1[2] * sc * bflo(z.w), x1[3] * sc * bfhi(z.w));
        ST16_WT(yb + off, y);
    }
    asm volatile("s_waitcnt vmcnt(0)" ::: "memory");
    __syncthreads();
    if (F.tid == 0) (void)xb_add(U.yflag, 1u);
}

__device__ __forceinline__ void dep_wait(const Frame& F, unsigned* c, int n, unsigned target) {
    if (F.tid == 0) {
        unsigned* bar0 = (unsigned*)(F.ws + WS_CTL) + CW_BAR;
        for (int i = 0; i < n; ++i) { XB_SPIN(xb_ld(c + 4 * i) < target, bar0); }
    }
}
__device__ __forceinline__ void attn_dispatch(const Frame& F, const Params& p, int u, int l) {
    unsigned char* ws = F.ws;
    AttnUnit U;
    U.nt0 = 0; U.nt1 = 0; U.q = nullptr; U.q_ld = 0; U.k0 = U.k1 = nullptr; U.k_ld0 = U.k_ld1 = 0; U.pe0 = U.pe1 = nullptr; U.v0 = U.v1 = nullptr; U.v_ld0 = U.v_ld1 = 0;
    U.tok0 = 0; U.ycol = 0; U.qpos0 = 0; U.L = 0; U.lf = U.lb = 0.f; U.s0f = U.s0b = nullptr; U.st_out = nullptr; U.mode = 0; U.yflag = nullptr; U.zflag = nullptr;
    const bf16_t* GQ = (const bf16_t*)(ws + WS_GQ); const bf16_t* GK = (const bf16_t*)(ws + WS_GK); const bf16_t* GV = (const bf16_t*)(ws + WS_GV);
    const bf16_t* QM = (const bf16_t*)(ws + WS_QM); const bf16_t* KVM = (const bf16_t*)(ws + WS_KVM); const bf16_t* KVMC = (const bf16_t*)(ws + WS_KVMC);
    const bf16_t* KPEB = (const bf16_t*)(ws + WS_KPEB); const bf16_t* CKPE = (const bf16_t*)(ws + WS_CKPE);
    const bf16_t* CGK = (const bf16_t*)(ws + WS_CGK); const bf16_t* CGV = (const bf16_t*)(ws + WS_CGV);
    const bf16_t* RQ = (const bf16_t*)(ws + WS_RQ); const bf16_t* RK = (const bf16_t*)(ws + WS_RK); const bf16_t* RV = (const bf16_t*)(ws + WS_RV);
    const float* decay = pin(F, I_DECAY) + l * 8;
    if (u < 96 || (u >= 256 && u < 352)) {
        const bool lat = u < 96; const int uu = lat ? u : u - 256;
        const int b = lat ? uu / 24 : uu / 6, hh = lat ? (uu >> 2) % 6 : uu % 6, qb = lat ? (uu & 3) : 0;
        const int seq0 = lat ? 4096 + b * 1024 : b * 256;
        U.mode = 1; U.tok0 = seq0 + qb * 256; U.q = QM + (size_t)U.tok0 * 576 + hh * 96; U.q_ld = 576; U.ycol = 640 + hh * 64;
        U.nt1 = lat ? 16 : 4; U.k1 = KVM + (size_t)seq0 * 768 + hh * 128; U.k_ld1 = 768; U.v1 = U.k1 + 64; U.v_ld1 = 768; U.pe1 = KPEB + (size_t)seq0 * 32;
        U.k0 = U.k1; U.v0 = U.v1; U.pe0 = U.pe1; U.k_ld0 = 768; U.v_ld0 = 768;
        if (lat) { U.nt0 = 8; U.k0 = KVMC + (size_t)(b * 512) * 768 + hh * 128; U.v0 = U.k0 + 64; U.pe0 = CKPE + (size_t)((b * 4 + l) * 512) * 32; }
        U.yflag = (unsigned*)(ws + WS_CTL) + CW_YRDY + (l * 32 + (U.tok0 >> 8)) * 4;
        { unsigned* c = (unsigned*)(ws + WS_CTL);
          dep_wait(F, c + CW_FULL + (l * 32 + (seq0 >> 8)) * 4, lat ? 4 : 1, 23u);
          if (lat) dep_wait(F, c + CW_KC + (l * 4 + b) * 4, 1, 12u); }
        __syncthreads();
        attn_unit<1>(F, p, U);
    } else if (u < 192 || (u >= 352 && u < 448)) {
        const bool lat = u < 192; const int uu = lat ? u - 96 : u - 352;
        const int b = lat ? uu / 24 : uu / 6, hh = lat ? (uu >> 2) % 6 : uu % 6, qb = lat ? (uu & 3) : 0, kvh = hh / 3;
        const int seq0 = lat ? 4096 + b * 1024 : b * 256;
        U.mode = 0; U.tok0 = seq0 + qb * 256; U.q = GQ + (size_t)U.tok0 * 384 + hh * 64; U.q_ld = 384; U.ycol = 256 + hh * 64;
        U.nt1 = lat ? 16 : 4; U.k1 = GK + (size_t)seq0 * 128 + kvh * 64; U.k_ld1 = 128; U.v1 = GV + (size_t)seq0 * 128 + kvh * 64; U.v_ld1 = 128;
        U.k0 = U.k1; U.v0 = U.v1; U.k_ld0 = 128; U.v_ld0 = 128;
        if (lat) { U.nt0 = 8; U.k0 = CGK + (size_t)((b * 4 + l) * 512) * 128 + kvh * 64; U.v0 = CGV + (size_t)((b * 4 + l) * 512) * 128 + kvh * 64; }
        U.yflag = (unsigned*)(ws + WS_CTL) + CW_YRDY + (l * 32 + (U.tok0 >> 8)) * 4;
        { unsigned* c = (unsigned*)(ws + WS_CTL);
          dep_wait(F, c + CW_RA + (l * 32 + (seq0 >> 8)) * 4, lat ? 4 : 1, 8u);
          U.zflag = c + CW_ZC + (l * 32 + (U.tok0 >> 8)) * 4; }
        __syncthreads();
        attn_unit<0>(F, p, U);
    } else if (u < 256 || (u >= 448 && u < 512)) {
        const bool lat = u < 256; const int uu = lat ? u - 192 : u - 448;
        const int b = lat ? uu / 16 : uu / 4, hh = lat ? (uu >> 2) & 3 : uu & 3, qb = lat ? (uu & 3) : 0;
        const int seq0 = lat ? 4096 + b * 1024 : b * 256;
        U.mode = 2; U.tok0 = seq0 + qb * 256; U.q = RQ + (size_t)U.tok0 * 256 + hh * 64; U.q_ld = 256; U.ycol = hh * 64;
        U.nt1 = lat ? 16 : 4; U.k1 = RK + (size_t)seq0 * 256 + hh * 64; U.k_ld1 = 256; U.v1 = RV + (size_t)seq0 * 256 + hh * 64; U.v_ld1 = 256;
        U.k0 = U.k1; U.v0 = U.v1; U.k_ld0 = 256; U.v_ld0 = 256;
        U.qpos0 = qb * 256; U.L = lat ? 1024 : 256;
        U.lf = -log1pf(__expf(-decay[hh])) * LOG2E; U.lb = -log1pf(__expf(-decay[4 + hh])) * LOG2E;
        if (lat) { const bf16_t* S0T = (const bf16_t*)(ws + WS_S0T); U.s0f = S0T + (size_t)(((b * 4 + l) * 2 + 0) * 4 + hh) * 4096; U.s0b = S0T + (size_t)(((b * 4 + l) * 2 + 1) * 4 + hh) * 4096; }
        U.yflag = (unsigned*)(ws + WS_CTL) + CW_YRDY + (l * 32 + (U.tok0 >> 8)) * 4;
        { unsigned* c = (unsigned*)(ws + WS_CTL);
          dep_wait(F, c + CW_RA + (l * 32 + (seq0 >> 8)) * 4, lat ? 4 : 1, 8u);
          U.zflag = c + CW_ZC + (l * 32 + (U.tok0 >> 8)) * 4; }
        __syncthreads();
        attn_unit<2>(F, p, U);
    } else {
        const int uu = u - 512, b = uu >> 2, hh = uu & 3, seq0 = b * 256;
        U.mode = 3; U.nt1 = 4; U.k1 = RK + (size_t)seq0 * 256 + hh * 64; U.k_ld1 = 256; U.v1 = RV + (size_t)seq0 * 256 + hh * 64; U.v_ld1 = 256;
        U.k0 = U.k1; U.v0 = U.v1; U.k_ld0 = 256; U.v_ld0 = 256;
        U.lf = -log1pf(__expf(-decay[hh])) * LOG2E; U.lb = -log1pf(__expf(-decay[4 + hh])) * LOG2E;
        U.st_out = p.out + O_STATE + (size_t)(((b * 4 + l) * 2 + 0) * 4 + hh) * 4096;
        dep_wait(F, (unsigned*)(ws + WS_CTL) + CW_RA + (l * 32 + b) * 4, 1, 8u);
        U.yflag = (unsigned*)(ws + WS_CTL) + CW_SD + (l * 16 + b) * 4;
        __syncthreads();
        attn_unit<3>(F, p, U);
    }
}
constexpr int N_ATTN_UNITS = 576;
struct TItem { const float* src; bf16_t* dst; int nsrc, K; int valid; };
constexpr int P0_TWIN = 4 * 16 * 92, P0_TWOUT = 4 * 16 * 32, P0_TWUQ = 4 * 4 * 20, P0_TWUKV = 4 * 2 * 24, P0_TR = P0_TWIN + P0_TWOUT + P0_TWUQ + P0_TWUKV;
__device__ __forceinline__ TItem p0_titem(const Frame& F, unsigned char* ws, int it) {
    TItem t; t.valid = it < P0_TR; t.src = nullptr; t.dst = nullptr; t.nsrc = 0; t.K = 0;
    if (!t.valid) return t;
    if (it < P0_TWIN) {
        const int l = it / (16 * 92), r = it % (16 * 92), kb = r / 92, nb = r % 92, n0 = nb * 32;
        const int src = n0 < 1792 ? n0 : (n0 < 2816 ? n0 + 32 : (n0 < 2848 ? n0 - 2816 + 1792 : -1));
        t.nsrc = 2848; t.K = 1024;
        if (src >= 0) t.src = pin(F, I_WIN) + (size_t)l * 1024 * 2848 + (size_t)(kb * 64) * 2848 + src;
        t.dst = (bf16_t*)(ws + WS_WIN) + ((size_t)l * 2944 + n0) * 1024 + kb * 64;
        return t;
    }
    it -= P0_TWIN;
    if (it < P0_TWOUT) {
        const int l = it / 512, r = it % 512, kb = r >> 5, nb = r & 31;
        t.nsrc = 1024; t.K = 1024; t.src = pin(F, I_WOUT) + (size_t)l * 1024 * 1024 + (size_t)(kb * 64) * 1024 + nb * 32;
        t.dst = (bf16_t*)(ws + WS_WOUT) + ((size_t)l * 1024 + nb * 32) * 1024 + kb * 64;
        return t;
    }
    it -= P0_TWOUT;
    if (it < P0_TWUQ) {
        const int l = it / 80, r = it % 80, kb = r / 20, nb = r % 20;
        t.nsrc = 576; t.K = 256; if (nb < 18) t.src = pin(F, I_WUQ) + (size_t)l * 256 * 576 + (size_t)(kb * 64) * 576 + nb * 32;
        t.dst = (bf16_t*)(ws + WS_WUQ) + ((size_t)l * 640 + nb * 32) * 256 + kb * 64;
        return t;
    }
    it -= P0_TWUQ;
    { const int l = it / 48, r = it % 48, kb = r / 24, nb = r % 24;
      t.nsrc = 768; t.K = 128; t.src = pin(F, I_WUKV) + (size_t)l * 128 * 768 + (size_t)(kb * 64) * 768 + nb * 32;
      t.dst = (bf16_t*)(ws + WS_WUKV) + ((size_t)l * 768 + nb * 32) * 128 + kb * 64; }
    return t;
}
__device__ __forceinline__ void p0_tload(const TItem& t, float (&r)[32], int lane) {
    if (t.valid && t.src) {
        const float* wp = t.src + (size_t)(lane >> 5) * t.nsrc + (lane & 31);
#pragma unroll
        for (int i = 0; i < 32; ++i) r[i] = wp[(size_t)(2 * i) * t.nsrc];
    } else {
#pragma unroll
        for (int i = 0; i < 32; ++i) r[i] = 0.f;
    }
}
__device__ __forceinline__ void p0_tstore(const TItem& t, const float (&r)[32], LAS float* scr, int lane) {
    if (!t.valid) return;
#pragma unroll
    for (int i = 0; i < 32; ++i) scr[(2 * i + (lane >> 5)) * 33 + (lane & 31)] = r[i];
    asm volatile("s_waitcnt lgkmcnt(0)" ::: "memory");
    __builtin_amdgcn_wave_barrier();
    const int c = lane & 7;
#pragma unroll
    for (int j = 0; j < 4; ++j) {
        const int n = (lane >> 3) + 8 * j; const LAS float* s = scr + (8 * c) * 33 + n;
        u32x4 o; o.x = pk2(s[0 * 33], s[1 * 33]); o.y = pk2(s[2 * 33], s[3 * 33]); o.z = pk2(s[4 * 33], s[5 * 33]); o.w = pk2(s[6 * 33], s[7 * 33]);
        ST16_WT(t.dst + (size_t)n * t.K + 8 * c, o);
    }
    asm volatile("s_waitcnt lgkmcnt(0)" ::: "memory");
    __builtin_amdgcn_wave_barrier();
}
__device__ __forceinline__ void cast8(const float* src, bf16_t* dst, size_t e) {
    const f32x4 a = *(const f32x4*)(src + e), b = *(const f32x4*)(src + e + 4);
    u32x4 o; o.x = pk2(a[0], a[1]); o.y = pk2(a[2], a[3]); o.z = pk2(b[0], b[1]); o.w = pk2(b[2], b[3]);
    ST16_WT(dst + e, o);
}
constexpr int P0_MODS = 1536, P0_CAST_G = 512, P0_CAST_KPE = 128, P0_S0T = 512;
constexpr int P0_TOTAL = P0_MODS + 3 * P0_CAST_G + P0_CAST_KPE + P0_S0T;
__device__ __forceinline__ void phase0(const Frame& F, const Params& p, bool dup = false) {
    unsigned char* ws = F.ws + (dup ? 162 * MiB : 0); const int lane = F.lane;
    LAS float* scr = (LAS float*)F.lds + F.w * (64 * 33);
    const int gw = blockIdx.x * NWAVE + F.w, ngw = gridDim.x * NWAVE;
#ifndef MK_DUP0
#define MK_DUP0_ 0
#else
#define MK_DUP0_ MK_DUP0
#endif
    if (!(dup && MK_DUP0_ == 2))
    for (int it = gw; it < P0_TR; it += 2 * ngw) {
        const TItem t0 = p0_titem(F, ws, it), t1 = p0_titem(F, ws, it + ngw);
        float r0[32], r1[32];
        p0_tload(t0, r0, lane); p0_tload(t1, r1, lane);
        p0_tstore(t0, r0, scr, lane); p0_tstore(t1, r1, scr, lane);
    }
    if (!(dup && MK_DUP0_ == 1))
    for (int it0 = (gw + ngw - 256) % ngw; it0 < P0_TOTAL; it0 += ngw) {
        int it = it0;
        if (it < P0_MODS) {
            const int l = it / 384, cg = (it % 384) >> 5, ks = it & 31;
            const int j = cg * 256 + lane * 4;
            const float* wp = pin(F, I_WADA) + ((size_t)l * 1024 + ks * 32) * 3072 + j;
            const float* c = pin(F, I_C); const float* cc = pin(F, I_CCTX);
            float sv[3];
#pragma unroll
            for (int q = 0; q < 3; ++q) {
                const int idx = q * 64 + lane, n = idx >> 5, k = idx & 31;
                float x = 0.f;
                if (idx < 160) x = (n == 0) ? cc[ks * 32 + k] : c[(n - 1) * 1024 + ks * 32 + k];
                sv[q] = silu_f(x);
            }
            f32x4 acc[5];
#pragma unroll
            for (int n = 0; n < 5; ++n) acc[n] = (f32x4){0.f, 0.f, 0.f, 0.f};
#pragma unroll 1
            for (int k0 = 0; k0 < 32; k0 += 16) {
                f32x4 wv[16];
#pragma unroll
                for (int k = 0; k < 16; ++k) wv[k] = *(const f32x4*)(wp + (size_t)(k0 + k) * 3072);
                __builtin_amdgcn_sched_barrier(0);
#pragma unroll
                for (int k = 0; k < 16; ++k)
#pragma unroll
                    for (int n = 0; n < 5; ++n) {
                        const float s = __int_as_float(__builtin_amdgcn_readlane(__float_as_int(sv[n >> 1]), 32 * (n & 1) + k0 + k));
                        acc[n] += wv[k] * s;
                    }
            }
            LAS f32x4* red = (LAS f32x4*)(F.lds + 69632);
#pragma unroll
            for (int n = 0; n < 5; ++n) red[(F.w * 5 + n) * 64 + lane] = acc[n];
            __syncthreads();
            if (F.tid < 320) {
                const int n = F.tid >> 6;
                f32x4 s = red[n * 64 + lane];
#pragma unroll
                for (int ww = 1; ww < 8; ++ww) s += red[(ww * 5 + n) * 64 + lane];
                if ((ks >> 3) == 0) s += *(const f32x4*)(pin(F, I_BADA) + l * 3072 + j);
                float* mods = (float*)(ws + WS_MODS) + (size_t)(l * 5 + n) * 3072 + j;
#pragma unroll
                for (int e = 0; e < 4; ++e) atomicAdd(mods + e, s[e]);
            }
            __syncthreads();
            continue;
        }
        it -= P0_MODS;
        if (it < 3 * P0_CAST_G) {
            const int which = it / P0_CAST_G, r = it % P0_CAST_G;
            const float* src = which == 0 ? pin(F, I_CGK) : (which == 1 ? pin(F, I_CGV) : pin(F, I_CCKV));
            bf16_t* dst = (bf16_t*)(ws + (which == 0 ? WS_CGK : (which == 1 ? WS_CGV : WS_CCKV)));
#pragma unroll
            for (int q = 0; q < 4; ++q) cast8(src, dst, (size_t)r * 2048 + q * 512 + lane * 8);
            continue;
        }
        it -= 3 * P0_CAST_G;
        if (it < P0_CAST_KPE) {
#pragma unroll
            for (int q = 0; q < 4; ++q) cast8(pin(F, I_CKPE), (bf16_t*)(ws + WS_CKPE), (size_t)it * 2048 + q * 512 + lane * 8);
            continue; }
        it -= P0_CAST_KPE;
        {
            const int mat = it >> 2, qd = it & 3, dv = qd * 16 + (lane >> 2), dk0 = (lane & 3) * 16;
            const float* s = pin(F, I_STATE) + (size_t)mat * 4096 + dv;
            float x[16];
#pragma unroll
            for (int i = 0; i < 16; ++i) x[i] = s[(dk0 + i) * 64];
            u32x4 o0, o1;
            o0.x = pk2(x[0], x[1]); o0.y = pk2(x[2], x[3]); o0.z = pk2(x[4], x[5]); o0.w = pk2(x[6], x[7]);
            o1.x = pk2(x[8], x[9]); o1.y = pk2(x[10], x[11]); o1.z = pk2(x[12], x[13]); o1.w = pk2(x[14], x[15]);
            bf16_t* d = (bf16_t*)(ws + WS_S0T) + (size_t)mat * 4096 + dv * 64 + dk0;
            ST16_WT(d, o0); ST16_WT(d + 8, o1);
        }
    }
}
constexpr int P1_GS = 80, P1_BIAS = 4 * 368, P1_X = 8192, P1_TOTAL = P1_GS + P1_BIAS + P1_X;
__device__ __forceinline__ void xg_row(const Frame& F, const float* xrow, const float* g, const float* mods_c, bf16_t* xg_row_out, float* ssq_row, bool write_xg) {
    const int lane = F.lane;
    float ss = 0.f;
#pragma unroll
    for (int j = 0; j < 2; ++j) {
        const int k = j * 512 + lane * 8;
        const f32x4 x0 = *(const f32x4*)(xrow + k), x1 = *(const f32x4*)(xrow + k + 4);
        ss += ((x0[0] * x0[0] + x0[1] * x0[1]) + (x0[2] * x0[2] + x0[3] * x0[3])) + ((x1[0] * x1[0] + x1[1] * x1[1]) + (x1[2] * x1[2] + x1[3] * x1[3]));
        if (write_xg) {
            const f32x4 g0 = *(const f32x4*)(g + k), g1 = *(const f32x4*)(g + k + 4), s0 = *(const f32x4*)(mods_c + 1024 + k), s1 = *(const f32x4*)(mods_c + 1024 + k + 4);
            u32x4 o; o.x = pk2(x0[0] * g0[0] * (1.f + s0[0]), x0[1] * g0[1] * (1.f + s0[1])); o.y = pk2(x0[2] * g0[2] * (1.f + s0[2]), x0[3] * g0[3] * (1.f + s0[3]));
            o.z = pk2(x1[0] * g1[0] * (1.f + s1[0]), x1[1] * g1[1] * (1.f + s1[1])); o.w = pk2(x1[2] * g1[2] * (1.f + s1[2]), x1[3] * g1[3] * (1.f + s1[3]));
            ST16_WT(xg_row_out + k, o);
        }
    }
    ss = wsum(ss);
    if (lane < 16) ssq_row[lane] = lane == 0 ? ss : 0.f;
}
__device__ __forceinline__ void phase1(const Frame& F, const Params& p) {
    unsigned char* ws = F.ws; const int lane = F.lane;
    const int gw = blockIdx.x * NWAVE + F.w, ngw = gridDim.x * NWAVE;
    const float* mods = (const float*)(ws + WS_MODS);
    for (int it0 = gw; it0 < P1_TOTAL; it0 += ngw) {
        int it = it0;
        if (it < P1_GS) {
            const int e = it * 256 + lane * 4, lc = e >> 10, k = e & 1023, l = lc / 5;
            const f32x4 g = *(const f32x4*)(pin(F, I_NORMG) + l * 1024 + k), sc = *(const f32x4*)(mods + (size_t)lc * 3072 + 1024 + k);
            *(f32x4*)((float*)(ws + WS_GS) + e) = g * (sc + 1.f);
            continue;
        }
        it -= P1_GS;
        if (it < P1_BIAS) {
            const int l = it / 368, n0 = (it % 368) * 8;
            f32x4 sh[5][4];
#pragma unroll
            for (int c = 0; c < 5; ++c) {
                const float* shp = mods + (size_t)(l * 5 + c) * 3072 + lane * 16;
#pragma unroll
                for (int i = 0; i < 4; ++i) sh[c][i] = *(const f32x4*)(shp + 4 * i);
            }
            const bf16_t* wr0 = (const bf16_t*)(ws + WS_WIN) + ((size_t)l * 2944 + n0) * 1024 + lane * 16;
            u32x4 w0[8], w1[8];
#pragma unroll
            for (int r = 0; r < 8; ++r) { w0[r] = *(const u32x4*)(wr0 + (size_t)r * 1024); w1[r] = *(const u32x4*)(wr0 + (size_t)r * 1024 + 8); }
#pragma unroll
            for (int r = 0; r < 8; ++r) {
                float wv[16];
#pragma unroll
                for (int i = 0; i < 4; ++i) { wv[2 * i] = bflo(w0[r][i]); wv[2 * i + 1] = bfhi(w0[r][i]); wv[8 + 2 * i] = bflo(w1[r][i]); wv[8 + 2 * i + 1] = bfhi(w1[r][i]); }
#pragma unroll
                for (int c = 0; c < 5; ++c) {
                    float d = 0.f;
#pragma unroll
                    for (int i = 0; i < 4; ++i) { const f32x4 s4 = sh[c][i]; d += (s4[0] * wv[4 * i] + s4[1] * wv[4 * i + 1]) + (s4[2] * wv[4 * i + 2] + s4[3] * wv[4 * i + 3]); }
                    d = wsum(d);
                    if (lane == 0) ((float*)(ws + WS_BIAS))[(size_t)(l * 5 + c) * 2944 + n0 + r] = d;
                }
            }
            continue;
        }
        it -= P1_BIAS;
        {
            const int tok = it; const bool lat = tok >= 4096;
            const float* xr = lat ? pin(F, I_XS) + (size_t)(tok - 4096) * 1024 : pin(F, I_XP) + (size_t)tok * 1024;
            const int cond = lat ? 1 + ((tok - 4096) >> 10) : 0;
            xg_row(F, xr, pin(F, I_NORMG), mods + (size_t)cond * 3072, (bf16_t*)(ws + WS_XG) + (size_t)tok * 1024, (float*)(ws + WS_SSQ) + (size_t)tok * 16, true);
        }
    }
}
#ifndef MK_TIMING
#define MK_TIMING -1
#endif
constexpr int CW_TIME = 2048;
__device__ __forceinline__ void phase_final(const Frame& F, const Params& p) {
    const int lane = F.lane;
    float tf = 1.f;
    if (MK_TIMING >= 0) tf = __uint_as_float(__hip_atomic_load((unsigned*)(F.ws + WS_CTL) + CW_TIME, __ATOMIC_RELAXED, __HIP_MEMORY_SCOPE_AGENT));
    unsigned* ctl = (unsigned*)(F.ws + WS_CTL);
    for (int vb = blockIdx.x; vb < 256; vb += gridDim.x) {
        const int tm = vb & 31, part = vb >> 5;
        if (F.tid == 0) {
            XB_SPIN(xb_ld(ctl + CW_XRDY + tm * 4) < 8u, ctl + CW_BAR);
            __builtin_amdgcn_fence(__ATOMIC_ACQUIRE, "agent");
            asm volatile("s_waitcnt vmcnt(0)" ::: "memory");
        }
        __syncthreads();
#pragma unroll 1
        for (int i = 0; i < 4; ++i) {
            const int tok = tm * 256 + part * 32 + F.w * 4 + i;
            float ss = 0.f;
            if (lane < 16) ss = ((const float*)(F.ws + WS_SSQ))[(size_t)tok * 16 + lane];
            ss = wsum(ss);
            const float rstd = rsqrtf(ss * (1.f / 1024.f) + EPS);
            const bf16_t* xr = (const bf16_t*)(F.ws + WS_XB) + (size_t)tok * 1024; float* orow = p.out + (size_t)tok * 1024;
#pragma unroll
            for (int j = 0; j < 4; ++j) {
                const int k = j * 256 + lane * 4;
                const u32x2 xq = *(const u32x2*)(xr + k);
                const f32x4 x = {bflo(xq.x), bfhi(xq.x), bflo(xq.y), bfhi(xq.y)}, fn = *(const f32x4*)(pin(F, I_FNORM) + k);
                { const f32x4 o = x * fn * (rstd * tf); ST16_WT(orow + k, o); }
            }
        }
    }
}

__device__ __forceinline__ GemmOp a2_op(const Frame& F, int l, int j) {
    GemmOp g;
    if (j < 160) { const int tn = j >> 5, tm = j & 31; g.W = (const bf16_t*)(F.ws + WS_WUQ) + ((size_t)l * 640 + tn * 128) * 256; g.X = (const bf16_t*)(F.ws + WS_CQG) + (size_t)tm * 256 * 256; g.ldw = 256; g.ldx = 256; g.K = 256; }
    else if (j < 352) { const int jj = j - 160, tn = jj >> 5, tm = jj & 31; g.W = (const bf16_t*)(F.ws + WS_WUKV) + ((size_t)l * 768 + tn * 128) * 128; g.X = (const bf16_t*)(F.ws + WS_CKVN) + (size_t)tm * 256 * 128; g.ldw = 128; g.ldx = 128; g.K = 128; }
    else { const int jj = j - 352, tn = jj >> 3, tc = jj & 7, b = tc >> 1, jt = tc & 1; g.W = (const bf16_t*)(F.ws + WS_WUKV) + ((size_t)l * 768 + tn * 128) * 128;
           g.X = (const bf16_t*)(F.ws + WS_CCKV) + ((size_t)(b * 4 + l) * 512 + jt * 256) * 128; g.ldw = 128; g.ldx = 128; g.K = 128; }
    return g;
}
__device__ __forceinline__ int a2_item(int vb, int i) {
    const int c = (vb >> 5) - 4, tmw = vb & 31;
    if (i == 3) return 352 + 32 + tmw;
    if (c == 0) return i * 32 + tmw;
    if (c == 1) return i < 2 ? (3 + i) * 32 + tmw : 160 + tmw;
    if (c == 2) return 160 + (1 + i) * 32 + tmw;
    return i < 2 ? 160 + (4 + i) * 32 + tmw : 352 + tmw;
}
#ifndef MK_EN
#define MK_EN 0xff
#endif
#define EN(x) ((MK_EN >> (x)) & 1)
constexpr int PH_TOTAL = 19;
__global__ void __launch_bounds__(512, 2) mega(Params p) {
    extern __shared__ __attribute__((aligned(16))) unsigned char lds_raw[];
    Frame F;
    F.lds = (LAS unsigned char*)lds_raw;
    F.tid = threadIdx.x; F.lane = F.tid & 63; F.w = __builtin_amdgcn_readfirstlane(F.tid >> 6); F.h = F.lane >> 5; F.lq = F.lane & 31;
    F.ws = p.ws;
    F.karg = (karg_t)__builtin_amdgcn_kernarg_segment_ptr();
    volatile LAS unsigned* MISC = (volatile LAS unsigned*)(F.lds + LDS_MISC);
    if (F.tid < 64) MISC[F.tid] = 0u;
    __syncthreads();
    unsigned* ctl = (unsigned*)(p.ws + WS_CTL);
    XcdBarrier bar; bar.bar = ctl + CW_BAR; bar.x = 0; bar.st = nullptr;
    const bool multi = p.ph_hi - p.ph_lo > 1;
    if (multi) bar = xcd_barrier_post(ctl + CW_BAR, MISC + 8);
    bar.w = F.w;
    const int G = gridDim.x;
    const Frame F0 = F;
    for (int ph = p.ph_lo; ph < p.ph_hi; ++ph) {
        if (ph >= 2 && ph < 18 && ((ph - 2) & 3) == 1) continue;
        Frame F = F0;
        F.lane = (int)__builtin_amdgcn_mbcnt_hi(~0u, __builtin_amdgcn_mbcnt_lo(~0u, 0u));
        asm volatile("" : "+v"(F.lane));
        F.tid = (F.w << 6) | F.lane; F.h = F.lane >> 5; F.lq = F.lane & 31;
        asm volatile("" : "+s"(F.w), "+s"(F.ws), "+s"(F.karg));
        if (MK_TIMING >= 0 && blockIdx.x == 0 && F.tid == 0) {
            const unsigned long long now = __builtin_amdgcn_s_memrealtime();
            const unsigned long long prev = ((unsigned long long)MISC[17] << 32) | MISC[16];
            if (ph > p.ph_lo) { const int q = ph - 1; const int grp = q < 2 ? q : 2 + ((q - 2) & 3); if (grp == MK_TIMING) MISC[18] += (unsigned)(now - prev); }
            MISC[16] = (unsigned)now; MISC[17] = (unsigned)(now >> 32);
        }
#ifndef MK_REPEAT
#define MK_REPEAT -1
#endif
        int nrep = 1;
        if (MK_REPEAT >= 1) { const int grp = ph < 2 ? ph : (ph == 18 ? 6 : 2 + ((ph - 2) & 3)); if (grp == MK_REPEAT) nrep = (grp == 5) ? (ph == 5 ? 5 : 1) : 2; }
        for (int rep = 0; rep < nrep; ++rep) {
        if (rep > 0) xcd_barrier(bar);
        Frame F = F0;
        F.lane = (int)__builtin_amdgcn_mbcnt_hi(~0u, __builtin_amdgcn_mbcnt_lo(~0u, 0u));
        asm volatile("" : "+v"(F.lane));
        F.tid = (F.w << 6) | F.lane; F.h = F.lane >> 5; F.lq = F.lane & 31;
        asm volatile("" : "+s"(F.w), "+s"(F.ws), "+s"(F.karg));
        if (EN(0) && ph == 0) {
#if defined(MK_DUP0)
            for (int d = 0; d < 2; ++d) { int dd = d; asm volatile("" : "+s"(dd)); if (dd) xcd_barrier(bar); phase0(F, p, dd != 0); }
#else
            phase0(F, p);
#endif
        }
        else if (EN(1) && ph == 1) phase1(F, p);
        else if (EN(2) && ph == 18) phase_final(F, p);
        else {
            const int l = (ph - 2) >> 2, sub = (ph - 2) & 3;
            int bid = blockIdx.x; asm volatile("" : "+s"(bid));
            if (EN(3) && sub == 0) {
                const bf16_t* Wt = (const bf16_t*)(F.ws + WS_WIN) + (size_t)l * 2944 * 1024;
                const bf16_t* X = (const bf16_t*)(F.ws + WS_XG);
                unsigned* flags = ctl + CW_FLAG + l * 512;
                bool first = true;
                int waited_tm = -1;
                for (int j = bid; j < 12 * 32; j += G) {
                    const int tn2 = j >> 5, tm = j & 31;
                    const int jn = j + G; const bool hn = jn < 12 * 32 && (jn & 31) == tm;
                    if (l > 0 && tm != waited_tm) {
                        waited_tm = tm;
                        if (F.tid == 0) {
                            XB_SPIN(xb_ld(ctl + CW_XGR + ((l - 1) * 32 + tm) * 4) < 8u, ctl + CW_BAR);
                            if (tm >= 16) { unsigned* y = ctl + CW_YRDY + ((l - 1) * 32 + (tm & ~3)) * 4; for (int i = 0; i < 4; ++i) { XB_SPIN(xb_ld(y + 4 * i) < 16u, ctl + CW_BAR); } }
                            else { XB_SPIN(xb_ld(ctl + CW_SD + ((l - 1) * 16 + tm) * 4) < 4u, ctl + CW_BAR); }
                            __builtin_amdgcn_fence(__ATOMIC_ACQUIRE, "agent");
                            asm volatile("s_waitcnt vmcnt(0)" ::: "memory");
                        }
                        __syncthreads();
                        first = true;
                    }
                    const int tn = 2 * tn2 + ((F.w & 3) >> 1), wn = F.w & 1;
                    GemmAcc8 acc;
                    Gemm1Pre P1;
                    gemm1_pre(F, p, tn, wn, tm, l, P1);
                    gemm_core256(F, Wt + (size_t)tn2 * 256 * 1024, X + (size_t)tm * 256 * 1024, acc, first, hn, Wt + (size_t)(jn >> 5) * 256 * 1024, X + (size_t)(jn & 31) * 256 * 1024); first = false;
                    epi_gemm1(F, p, acc, tn, wn, tm, l, P1, tn2 == 6);
                    {
                        asm volatile("s_waitcnt vmcnt(0)" ::: "memory");
                        __syncthreads();
                        if (F.tid == 0) {
                            if (tn2 == 5 || tn2 == 6) (void)xb_add(flags + tm * 16, 1u);
                            if (tn2 < 8) (void)xb_add(ctl + CW_RA + (l * 32 + tm) * 4, 1u);
                            if (tn2 >= 7 && tn2 < 11) (void)xb_add(ctl + CW_ZC + (l * 32 + tm) * 4, 1u);
                            (void)xb_add(ctl + CW_FULL + (l * 32 + tm) * 4, 1u);
                        }
                    }
                }
                for (int vb = bid; vb < 256; vb += G) {
                    if (vb < 128) continue;
                    const int c = (vb >> 5) - 4, tmw = vb & 31;
                    const int nit = (c == 2 && tmw < 16) ? 4 : 3;
                    if (F.tid == 0) {
                        if (l > 0 && tmw != waited_tm) {
                            if (tmw >= 16) { unsigned* y = ctl + CW_YRDY + ((l - 1) * 32 + (tmw & ~3)) * 4; for (int i = 0; i < 4; ++i) { XB_SPIN(xb_ld(y + 4 * i) < 16u, ctl + CW_BAR); } }
                            else { XB_SPIN(xb_ld(ctl + CW_YRDY + ((l - 1) * 32 + tmw) * 4) < 16u, ctl + CW_BAR); XB_SPIN(xb_ld(ctl + CW_SD + ((l - 1) * 16 + tmw) * 4) < 4u, ctl + CW_BAR); }
                        }
                        unsigned* f = flags + tmw * 16;
                        XB_SPIN(xb_ld(f) < 2u, ctl + CW_BAR);
                        __builtin_amdgcn_fence(__ATOMIC_ACQUIRE, "agent");
                        asm volatile("s_waitcnt vmcnt(0)" ::: "memory");
                    }
                    __syncthreads();
                    for (int i = 0; i < nit; ++i) {
                        const bool hn = i + 1 < nit;
                        const int j = a2_item(vb, i), jn = a2_item(vb, hn ? i + 1 : i);
                        const GemmOp g = a2_op(F, l, j); const GemmOp gn = a2_op(F, l, jn);
                        GemmAcc acc;
                        float rstdq = 0.f;
                        if (j < 160) qm_pre(F, tmw, rstdq);
                        gemm_core(F, g, acc, i == 0, hn, gn);
                        if (j < 160) epi_qm(F, acc, j >> 5, tmw, rstdq);
                        else if (j < 352) { const int jj = j - 160; epi_plain(F, acc, (bf16_t*)(F.ws + WS_KVM), 768, tmw * 256, (jj >> 5) * 128); }
                        else {
                            const int jj = j - 352, tc = jj & 7;
                            if (l > 0) {
                                if (F.tid == 0) { unsigned* y = ctl + CW_YRDY + ((l - 1) * 32 + 16 + 4 * (tc >> 1)) * 4; for (int q = 0; q < 4; ++q) { XB_SPIN(xb_ld(y + 4 * q) < 16u, ctl + CW_BAR); } }
                                __syncthreads();
                            }
                            epi_plain(F, acc, (bf16_t*)(F.ws + WS_KVMC), 768, (tc >> 1) * 512 + (tc & 1) * 256, (jj >> 3) * 128);
                        }
                        asm volatile("s_waitcnt vmcnt(0)" ::: "memory");
                        __syncthreads();
                        if (F.tid == 0) {
                            if (j < 352) (void)xb_add(ctl + CW_FULL + (l * 32 + tmw) * 4, 1u);
                            else (void)xb_add(ctl + CW_KC + (l * 4 + (((j - 352) & 7) >> 1)) * 4, 1u);
                        }
                    }
                }
            } else if (EN(5) && sub == 2) {
                for (;;) {
                    __syncthreads();
                    if (F.tid == 0) MISC[0] = atomicAdd(ctl + CW_QUEUE + 64 * l + 32 * rep, 1u);
                    __syncthreads();
                    const int uq = __builtin_amdgcn_readfirstlane((int)MISC[0]);
                    if (uq >= N_ATTN_UNITS) break;
                    const int u = uq < 160 ? uq + 96 : (uq < 256 ? uq - 160 : (uq < 480 ? uq + 96 : uq - 224));
                    attn_dispatch(F, p, u, l);
                }
            } else if (EN(6)) {
                const bf16_t* Wt = (const bf16_t*)(F.ws + WS_WOUT) + (size_t)l * 1024 * 1024;
                const bf16_t* Yb = (const bf16_t*)(F.ws + WS_Y);
                for (int j = bid; j < 8 * 32; j += G) {
                    const int tn = j >> 5, tm = j & 31;
                    GemmOp g; g.W = Wt + (size_t)tn * 128 * 1024; g.X = Yb + (size_t)tm * 256 * 1024; g.ldw = 1024; g.ldx = 1024; g.K = 1024;
                    GemmAcc acc;
                    Gemm2Pre P2;
                    gemm2_pre(F, tn, tm, l, P2);
                    if (F.tid == 0) {
                        unsigned* f = ctl + CW_YRDY + (l * 32 + tm) * 4;
                        XB_SPIN(xb_ld(f) < 16u, ctl + CW_BAR);
                        __builtin_amdgcn_fence(__ATOMIC_ACQUIRE, "agent");
                        asm volatile("s_waitcnt vmcnt(0)" ::: "memory");
                    }
                    __syncthreads();
                    gemm_core(F, g, acc, true, false, g);
                    epi_gemm2(F, p, acc, tn, tm, l, P2, l == 3);
                    {
                        asm volatile("s_waitcnt vmcnt(0)" ::: "memory");
                        __syncthreads();
                        if (F.tid == 0) (void)xb_add(l == 3 ? ctl + CW_XRDY + tm * 4 : ctl + CW_XGR + (l * 32 + tm) * 4, 1u);
                    }
                }
            }
        }
        }
        if (MK_TIMING >= 0 && ph == 17 && blockIdx.x == 0 && F.tid == 0) {
            const unsigned long long now = __builtin_amdgcn_s_memrealtime();
            const unsigned long long prev = ((unsigned long long)MISC[17] << 32) | MISC[16];
            unsigned a = MISC[18]; if (MK_TIMING == 5) a += (unsigned)(now - prev);
            __hip_atomic_store(ctl + CW_TIME, __float_as_uint(1.f + (float)a * 1e-5f), __ATOMIC_RELAXED, __HIP_MEMORY_SCOPE_AGENT);
        }
        if (ph + 1 < p.ph_hi && ph < 2) xcd_barrier(bar);
    }
}
}

extern "C" void kernel_launch(void* const* d_in, const int* in_sizes, int n_in, void* d_out, int out_size, void* d_ws, size_t ws_size, hipStream_t stream) {
    static int grid = 0;
    if (!grid) {
        int dev = 0, cus = 0, per_cu = 0;
        (void)hipGetDevice(&dev);
        (void)hipDeviceGetAttribute(&cus, hipDeviceAttributeMultiprocessorCount, dev);
        (void)hipFuncSetAttribute((const void*)mk::mega, hipFuncAttributeMaxDynamicSharedMemorySize, mk::LDS_BYTES);
        (void)hipOccupancyMaxActiveBlocksPerMultiprocessor(&per_cu, (const void*)mk::mega, 512, mk::LDS_BYTES);
        if (per_cu > 1) per_cu = 1;
        if (per_cu < 1) per_cu = 1;
        if (cus < 1) cus = 256;
        grid = cus * per_cu;
    }
    unsigned char* ws = (unsigned char*)d_ws;
    (void)hipMemsetAsync(ws, 0, mk::CTL_ZERO_BYTES, stream);
    mk::Params P{};
    for (int i = 0; i < 22; ++i) P.in[i] = (const float*)d_in[i];
    P.out = (float*)d_out; P.ws = ws; P.xs = (float*)d_out;
    P.ph_lo = 0; P.ph_hi = mk::PH_TOTAL;
    void* args[] = {&P};
    (void)hipLaunchCooperativeKernel((const void*)mk::mega, dim3(grid), dim3(512), args, mk::LDS_BYTES, stream);
}
```

```cpp
#include <hip/hip_runtime.h>
#include <stdint.h>
namespace mk {
#define LAS __attribute__((address_space(3)))
typedef unsigned short bf16_t;
typedef short bf16x8 __attribute__((ext_vector_type(8)));
typedef short s16x4 __attribute__((ext_vector_type(4)));
typedef float f32x16 __attribute__((ext_vector_type(16)));
typedef float f32x4 __attribute__((ext_vector_type(4)));
typedef float f32x2 __attribute__((ext_vector_type(2)));
typedef unsigned u32x4 __attribute__((ext_vector_type(4)));
typedef unsigned u32x2 __attribute__((ext_vector_type(2)));
typedef __bf16 bf16x2_t __attribute__((ext_vector_type(2)));

constexpr float EPS = 1e-6f;
constexpr float LOG2E = 1.4426950408889634f;
constexpr float QSC_GQA = 0.125f * LOG2E;
constexpr float QSC_MLA = 0.10206207261596575f * LOG2E;

__device__ __forceinline__ unsigned pk2(float lo, float hi) { f32x2 v = {lo, hi}; bf16x2_t b = __builtin_convertvector(v, bf16x2_t); return __builtin_bit_cast(unsigned, b); }
__device__ __forceinline__ float bf2f(unsigned short u) { return __uint_as_float((unsigned)u << 16); }
__device__ __forceinline__ float bflo(unsigned u) { return __uint_as_float(u << 16); }
__device__ __forceinline__ float bfhi(unsigned u) { return __uint_as_float(u & 0xffff0000u); }
__device__ __forceinline__ float silu_f(float x) { return x * __builtin_amdgcn_rcpf(1.f + __builtin_amdgcn_exp2f(-x * LOG2E)); }
__device__ __forceinline__ float wsum(float v) {
#pragma unroll
    for (int o = 32; o > 0; o >>= 1) v += __shfl_xor(v, o);
    return v;
}

constexpr size_t MiB = 1u << 20;
constexpr size_t WS_CTL = 0, CTL_ZERO_BYTES = 1 * MiB;
constexpr size_t WS_MODS = 256 * 1024;
constexpr size_t WS_BIAS = 1 * MiB;
constexpr size_t WS_GS = 1 * MiB + 256 * 1024;
constexpr size_t WS_ROPE64 = 1 * MiB + 512 * 1024;
constexpr size_t WS_ROPE32 = 1 * MiB + 768 * 1024;
constexpr size_t WS_SSQ = 2 * MiB;
constexpr size_t WS_CQSSQ = 2 * MiB + 512 * 1024;
constexpr size_t WS_S0T = 3 * MiB;
constexpr size_t WS_CGK = 4 * MiB, WS_CGV = 6 * MiB, WS_CCKV = 8 * MiB, WS_CKPE = 10 * MiB;
constexpr size_t WS_WIN = 11 * MiB;
constexpr size_t WS_WOUT = 34 * MiB;
constexpr size_t WS_WUQ = 42 * MiB;
constexpr size_t WS_WUKV = 43 * MiB + 256 * 1024;
constexpr size_t WS_XG = 44 * MiB;
constexpr size_t WS_KVM = 130 * MiB;
constexpr size_t WS_KVMC = 142 * MiB;
constexpr size_t WS_RQ = 60 * MiB, WS_RK = 64 * MiB, WS_RV = 68 * MiB;
constexpr size_t WS_GQ = 72 * MiB;
constexpr size_t WS_GK = 78 * MiB, WS_GV = 80 * MiB;
constexpr size_t WS_CQG = 82 * MiB;
constexpr size_t WS_CKVN = 86 * MiB;
constexpr size_t WS_KPEB = 88 * MiB;
constexpr size_t WS_ZS = 89 * MiB;
constexpr size_t WS_QM = 105 * MiB;
constexpr size_t WS_Y = 114 * MiB;
constexpr size_t WS_XSDBG = 130 * MiB;
constexpr size_t WS_XB = 146 * MiB;
constexpr size_t WS_OPT_END = 162 * MiB;
constexpr int CW_QUEUE = 1024;
constexpr int CW_FLAG = 2048;
constexpr int CW_YRDY = 1536;
constexpr int CW_XRDY = 1280;
constexpr int CW_RA = 8192;
constexpr int CW_FULL = 8704;
constexpr int CW_ZC = 9216;
constexpr int CW_KC = 9728;
constexpr int CW_XGR = 9856;
constexpr int CW_SD = 10368;
constexpr int CW_P1X = 10656;
constexpr int CW_P1B0 = 10784;
constexpr int CW_P1DONE = 10788;
constexpr int CW_BAR = 4096;

constexpr size_t O_STATE = 8388608, O_GK = 10485760, O_GV = 12582912, O_CKV = 14680064, O_KPE = 16777216;

constexpr int NWAVE = 8;
constexpr int GST = 49152;
constexpr int GST2 = 65536;
constexpr int LDS_OST = GST2;
constexpr int LDS_EX = 135168;
constexpr int LDS_EXB = 137216;
constexpr int LDS_SCAL = 141312;
constexpr int LDS_MISC = 142336;
constexpr int LDS_BYTES = 142592;

struct Params { const float* in[22]; float* out; unsigned char* ws; float* xs; int ph_lo, ph_hi; };
enum { I_XP = 0, I_XS, I_STATE, I_CGK, I_CGV, I_CCKV, I_CKPE, I_C, I_CCTX, I_NORMG, I_WADA, I_BADA, I_WIN, I_DECAY, I_GQN, I_GKN, I_MQN, I_MKVN, I_WUQ, I_WUKV, I_WOUT, I_FNORM };

#define XB_TMO      128
#define XB_XCNT(j)  (256  + 64 * (j))
#define XB_XSUB(j)  (1280 + 64 * (j))
#define XB_XGEN(j)  (2304 + 64 * (j))
#define XB_TOP      3328
#define XB_TOPGEN   3392
#define XB_SPIN_CAP (1u << 20)
__device__ __forceinline__ unsigned xb_ld(unsigned* p) { return __hip_atomic_load(p, __ATOMIC_RELAXED, __HIP_MEMORY_SCOPE_AGENT); }
__device__ __forceinline__ unsigned xb_add(unsigned* p, unsigned v) { return __hip_atomic_fetch_add(p, v, __ATOMIC_RELAXED, __HIP_MEMORY_SCOPE_AGENT); }
__device__ __forceinline__ unsigned xb_xcc_id() { return (unsigned)__builtin_amdgcn_s_getreg((3 << 11) | 20) & 0xFu; }
#define XB_SPIN(cond, bar) do { unsigned _sp = 0; while (cond) { __builtin_amdgcn_s_sleep(1); \
    if ((++_sp & 255u) == 0u) { if (xb_ld(&(bar)[XB_TMO])) break; if (_sp > XB_SPIN_CAP) { atomicAdd(&(bar)[XB_TMO], 1u); break; } } } } while (0)
struct XcdBarrier { unsigned* bar; unsigned x; volatile LAS unsigned* st; int w; };
__device__ __forceinline__ XcdBarrier xcd_barrier_post(unsigned* bar, volatile LAS unsigned* st) {
    XcdBarrier b; b.bar = bar; b.x = xb_xcc_id(); b.st = st; b.w = 0;
    if (threadIdx.x == 0) (void)xb_add(&bar[XB_XCNT(b.x)], 1u);
    return b;
}
__device__ __forceinline__ void xcd_barrier_complete(unsigned* bar, unsigned x, unsigned& nloc, unsigned& nx) {
    const unsigned G = gridDim.x * gridDim.y * gridDim.z;
    unsigned sum, cnt, mine, sp = 0u;
    for (;;) {
        sum = 0u; cnt = 0u; mine = 0u;
#pragma unroll
        for (unsigned j = 0; j < 16; ++j) { const unsigned c = xb_ld(&bar[XB_XCNT(j)]); sum += c; cnt += (c > 0u) ? 1u : 0u; mine = (j == x) ? c : mine; }
        if (sum == G) break;
        __builtin_amdgcn_s_sleep(1);
        if ((++sp & 255u) == 0u) { if (xb_ld(&bar[XB_TMO])) break; if (sp > XB_SPIN_CAP) { atomicAdd(&bar[XB_TMO], 1u); break; } }
    }
    nloc = mine > 0u ? mine : 1u; nx = cnt > 0u ? cnt : 1u;
}
__device__ __forceinline__ void xcd_barrier(const XcdBarrier& b) {
    asm volatile("s_waitcnt vmcnt(0)" ::: "memory");
    __syncthreads();
    if (b.w == 0 && __builtin_amdgcn_mbcnt_hi(~0u, __builtin_amdgcn_mbcnt_lo(~0u, 0u)) == 0u) {
        unsigned* bar = b.bar;
        __builtin_amdgcn_s_waitcnt(0);
        unsigned nloc = b.st[0], nx = b.st[1];
        if (nloc == 0u) { xcd_barrier_complete(bar, b.x, nloc, nx); b.st[0] = nloc; b.st[1] = nx; }
        const unsigned old = xb_add(&bar[XB_XSUB(b.x)], 1u);
        const unsigned gen = old / nloc;
        if (old + 1u == (gen + 1u) * nloc) {
            __builtin_amdgcn_fence(__ATOMIC_RELEASE, "agent");
            asm volatile("s_waitcnt vmcnt(0)" ::: "memory");
            const unsigned og = xb_add(&bar[XB_TOP], 1u);
            const unsigned tg = og / nx;
            if (og + 1u == (tg + 1u) * nx) xb_add(&bar[XB_TOPGEN], 1u);
            else XB_SPIN(xb_ld(&bar[XB_TOPGEN]) == tg, bar);
            xb_add(&bar[XB_XGEN(b.x)], 1u);
            __builtin_amdgcn_fence(__ATOMIC_ACQUIRE, "agent");
            asm volatile("s_waitcnt vmcnt(0)" ::: "memory");
        } else {
            XB_SPIN(xb_ld(&bar[XB_XGEN(b.x)]) == gen, bar);
            __builtin_amdgcn_fence(__ATOMIC_ACQUIRE, "agent");
            asm volatile("s_waitcnt vmcnt(0)" ::: "memory");
        }
    }
    __syncthreads();
}

typedef const float* cfp_t;
typedef const __attribute__((address_space(4))) cfp_t* karg_t;
struct Frame {
    LAS unsigned char* lds;
    int tid, lane, w, h, lq;
    unsigned char* ws;
    karg_t karg;
};
__device__ __forceinline__ const float* pin(const Frame& F, int i) { return F.karg[i]; }
__device__ __forceinline__ bool is_t0(const Frame& F) { return F.w == 0 && __builtin_amdgcn_mbcnt_hi(~0u, __builtin_amdgcn_mbcnt_lo(~0u, 0u)) == 0u; }
#define GLDS16(gsrc, ldsdst) __builtin_amdgcn_global_load_lds((const unsigned*)(gsrc), (LAS unsigned*)(ldsdst), 16, 0, 0)
#define ST16_WT(ptr, val) asm volatile("global_store_dwordx4 %0, %1, off sc1\n\ts_nop 1" :: "v"(ptr), "v"(val) : "memory")
#define MFMA32(a, b, c) __builtin_amdgcn_mfma_f32_32x32x16_bf16((a), (b), (c), 0, 0, 0)

struct GemmOp { const bf16_t* W; const bf16_t* X; int ldw, ldx, K; };
__device__ __forceinline__ void gemm_issue0(const Frame& F, const GemmOp& g) {
    const int lane = F.lane, w = F.w;
#pragma unroll
    for (int q = 0; q < 2; ++q) { const int row = 16 * w + 8 * q + (lane >> 3); GLDS16(g.W + row * g.ldw + ((lane & 7) ^ ((row >> 1) & 7)) * 8, F.lds + (16 * w + 8 * q) * 128); }
#pragma unroll
    for (int q = 0; q < 4; ++q) { const int row = 32 * w + 8 * q + (lane >> 3); GLDS16(g.X + row * g.ldx + ((lane & 7) ^ ((row >> 1) & 7)) * 8, F.lds + 16384 + (32 * w + 8 * q) * 128); }
}
typedef f32x4 GemmAcc[4][4];
__device__ __forceinline__ void gemm_core(const Frame& F, const GemmOp& g, GemmAcc& acc, bool issue_first, bool has_next, const GemmOp& gn) {
    const int lane = F.lane, w = F.w;
    const bf16_t* __restrict__ W = g.W; const bf16_t* __restrict__ X = g.X;
    const int nkt = g.K >> 6;
    int offW[2], offX[4];
#pragma unroll
    for (int q = 0; q < 2; ++q) { const int row = 16 * w + 8 * q + (lane >> 3); offW[q] = row * g.ldw + ((lane & 7) ^ ((row >> 1) & 7)) * 8; }
#pragma unroll
    for (int q = 0; q < 4; ++q) { const int row = 32 * w + 8 * q + (lane >> 3); offX[q] = row * g.ldx + ((lane & 7) ^ ((row >> 1) & 7)) * 8; }
    LAS unsigned char* const dW = F.lds + (16 * w) * 128;
    LAS unsigned char* const dX = F.lds + 16384 + (32 * w) * 128;
#define GC_ISSUE(kt, st) do { _Pragma("unroll") for (int q = 0; q < 2; ++q) GLDS16(W + offW[q] + (kt) * 64, dW + (st) * GST + q * 1024); \
        _Pragma("unroll") for (int q = 0; q < 4; ++q) GLDS16(X + offX[q] + (kt) * 64, dX + (st) * GST + q * 1024); } while (0)
    const int wn = w & 1, wm = w >> 1, c15 = lane & 15, g4 = lane >> 4;
    const int sw = (c15 >> 1) & 7;
    int so[2];
#pragma unroll
    for (int s = 0; s < 2; ++s) so[s] = ((4 * s + g4) ^ sw) << 4;
    const int bn0 = (64 * wn + c15) * 128, bm0 = 16384 + (64 * wm + c15) * 128;
#pragma unroll
    for (int a = 0; a < 4; ++a)
#pragma unroll
        for (int b = 0; b < 4; ++b) acc[a][b] = (f32x4){0.f, 0.f, 0.f, 0.f};
    if (issue_first) GC_ISSUE(0, 0);
    asm volatile("s_waitcnt vmcnt(0)" ::: "memory");
    __syncthreads();
    for (int kt = 0; kt < nkt; ++kt) {
        const int st = kt & 1;
        if (kt + 1 < nkt) GC_ISSUE(kt + 1, st ^ 1);
        LAS unsigned char* const base = F.lds + st * GST;
#pragma unroll
        for (int s = 0; s < 2; ++s) {
            bf16x8 fa[4], fb[4];
#pragma unroll
            for (int q = 0; q < 4; ++q) { fa[q] = *(const LAS bf16x8*)(base + bn0 + q * 2048 + so[s]); fb[q] = *(const LAS bf16x8*)(base + bm0 + q * 2048 + so[s]); }
#pragma unroll
            for (int a = 0; a < 4; ++a)
#pragma unroll
                for (int b = 0; b < 4; ++b) acc[a][b] = __builtin_amdgcn_mfma_f32_16x16x32_bf16(fa[a], fb[b], acc[a][b], 0, 0, 0);
        }
        asm volatile("s_waitcnt vmcnt(0)" ::: "memory");
        __syncthreads();
    }
#undef GC_ISSUE
    if (has_next) gemm_issue0(F, gn);
}

typedef f32x4 GemmAcc8[4][8];
__device__ __forceinline__ void gemm256_issue0(const Frame& F, const bf16_t* W, const bf16_t* X) {
    int lane = F.lane; const int w = F.w;
    asm volatile("" : "+v"(lane));
#pragma unroll
    for (int q = 0; q < 4; ++q) {
        const int row = 32 * w + 8 * q + (lane >> 3), off = row * 1024 + ((lane & 7) ^ ((row >> 1) & 7)) * 8;
        GLDS16(W + off, F.lds + (32 * w + 8 * q) * 128);
        GLDS16(X + off, F.lds + 32768 + (32 * w + 8 * q) * 128);
    }
}
__device__ __forceinline__ void gemm_core256(const Frame& F, const bf16_t* __restrict__ W, const bf16_t* __restrict__ X, GemmAcc8& acc, bool issue_first, bool has_next, const bf16_t* Wn, const bf16_t* Xn) {
    int lane = F.lane; const int w = F.w;
    asm volatile("" : "+v"(lane));
    int off[4];
#pragma unroll
    for (int q = 0; q < 4; ++q) { const int row = 32 * w + 8 * q + (lane >> 3); off[q] = row * 1024 + ((lane & 7) ^ ((row >> 1) & 7)) * 8; }
    LAS unsigned char* const dW = F.lds + (32 * w) * 128;
    LAS unsigned char* const dX = F.lds + 32768 + (32 * w) * 128;
#define GC2_ISSUE(kt, st) do { _Pragma("unroll") for (int q = 0; q < 4; ++q) { GLDS16(W + off[q] + (kt) * 64, dW + (st) * GST2 + q * 1024); GLDS16(X + off[q] + (kt) * 64, dX + (st) * GST2 + q * 1024); } } while (0)
    const int wn4 = w & 3, wm2 = w >> 2, c15 = lane & 15, g4 = lane >> 4;
    const int sw = (c15 >> 1) & 7;
    int so[2];
#pragma unroll
    for (int s = 0; s < 2; ++s) so[s] = ((4 * s + g4) ^ sw) << 4;
    const int bn0 = (64 * wn4 + c15) * 128, bm0 = 32768 + (128 * wm2 + c15) * 128;
#pragma unroll
    for (int a = 0; a < 4; ++a)
#pragma unroll
        for (int b = 0; b < 8; ++b) acc[a][b] = (f32x4){0.f, 0.f, 0.f, 0.f};
    if (issue_first) GC2_ISSUE(0, 0);
    asm volatile("s_waitcnt vmcnt(0)" ::: "memory");
    __syncthreads();
    for (int kt = 0; kt < 16; ++kt) {
        const int st = kt & 1;
        if (kt + 1 < 16) GC2_ISSUE(kt + 1, st ^ 1);
        LAS unsigned char* const base = F.lds + st * GST2;
#pragma unroll
        for (int s = 0; s < 2; ++s) {
            bf16x8 fa[4];
#pragma unroll
            for (int q = 0; q < 4; ++q) fa[q] = *(const LAS bf16x8*)(base + bn0 + q * 2048 + so[s]);
#pragma unroll
            for (int hb = 0; hb < 2; ++hb) {
                bf16x8 fb[4];
#pragma unroll
                for (int q = 0; q < 4; ++q) fb[q] = *(const LAS bf16x8*)(base + bm0 + (4 * hb + q) * 2048 + so[s]);
#pragma unroll
                for (int a = 0; a < 4; ++a)
#pragma unroll
                    for (int b = 0; b < 4; ++b) acc[a][4 * hb + b] = __builtin_amdgcn_mfma_f32_16x16x32_bf16(fa[a], fb[b], acc[a][4 * hb + b], 0, 0, 0);
            }
        }
        asm volatile("s_waitcnt vmcnt(0)" ::: "memory");
        __syncthreads();
    }
#undef GC2_ISSUE
    if (has_next) gemm256_issue0(F, Wn, Xn);
}

__device__ __forceinline__ void rope64_16(float (&v)[4][4], float rowp, float colp, int g4) {
#pragma unroll
    for (int i = 0; i < 4; ++i) {
        const float fr = __builtin_amdgcn_exp2f((float)(4 * g4 + i) * -0.8304820237218406f) * 0.15915494309189535f;
#pragma unroll
        for (int c = 0; c < 2; ++c) {
            const float rev = (c ? colp : rowp) * fr;
            const float sn = __builtin_amdgcn_sinf(rev), cs = __builtin_amdgcn_cosf(rev);
            const float x0 = v[2 * c][i], x1 = v[2 * c + 1][i];
            v[2 * c][i] = x0 * cs - x1 * sn;
            v[2 * c + 1][i] = x1 * cs + x0 * sn;
        }
    }
}
__device__ __forceinline__ void rope32_16(float (&a)[4], float (&b)[4], float rowp, float colp, int g4) {
    const bool hi = g4 >= 2;
#pragma unroll
    for (int i = 0; i < 4; ++i) {
        const float fr = __builtin_amdgcn_exp2f((float)(4 * (g4 & 1) + i) * -1.6609640474436813f) * 0.15915494309189535f;
        {
            const float rev = rowp * fr;
            const float sn = __builtin_amdgcn_sinf(rev), cs = __builtin_amdgcn_cosf(rev);
            const float own = a[i], oth = __shfl_xor(own, 32);
            a[i] = own * cs + oth * (hi ? sn : -sn);
        }
        {
            const float rev = colp * fr;
            const float sn = __builtin_amdgcn_sinf(rev), cs = __builtin_amdgcn_cosf(rev);
            const float own = b[i], oth = __shfl_xor(own, 32);
            b[i] = own * cs + oth * (hi ? sn : -sn);
        }
    }
}
__device__ __forceinline__ float ssq64(const float (&v)[4][4]) {
    float s = 0.f;
#pragma unroll
    for (int nt = 0; nt < 4; ++nt)
#pragma unroll
        for (int i = 0; i < 4; ++i) s += v[nt][i] * v[nt][i];
    s += __shfl_xor(s, 16);
    s += __shfl_xor(s, 32);
    return s;
}
__device__ __forceinline__ void mulvec64(float (&v)[4][4], const LAS float* gv, int g4) {
#pragma unroll
    for (int nt = 0; nt < 4; ++nt) {
        const f32x4 q = *(const LAS f32x4*)(gv + 16 * nt + 4 * g4);
#pragma unroll
        for (int i = 0; i < 4; ++i) v[nt][i] *= q[i];
    }
}
constexpr int OST_LD = 68, OST_BYTES = 32 * OST_LD * 4;
__device__ __forceinline__ void stage_write16(LAS float* st, const float (&v)[4][4], int mh, int c15, int g4) {
    asm volatile("s_waitcnt lgkmcnt(0)" ::: "memory");
    __builtin_amdgcn_wave_barrier();
#pragma unroll
    for (int nt = 0; nt < 4; ++nt) {
        f32x4 o = {v[nt][0], v[nt][1], v[nt][2], v[nt][3]};
        *(LAS f32x4*)(st + (16 * mh + c15) * OST_LD + 16 * nt + 4 * g4) = o;
    }
    asm volatile("s_waitcnt lgkmcnt(0)" ::: "memory");
    __builtin_amdgcn_wave_barrier();
}
__device__ __forceinline__ void stage_write16a(LAS float* st, const f32x4 (&a)[4][4], int mt, int c15, int g4) {
    asm volatile("s_waitcnt lgkmcnt(0)" ::: "memory");
    __builtin_amdgcn_wave_barrier();
#pragma unroll
    for (int nt = 0; nt < 4; ++nt) *(LAS f32x4*)(st + (16 * (mt & 1) + c15) * OST_LD + 16 * nt + 4 * g4) = a[nt][mt];
    asm volatile("s_waitcnt lgkmcnt(0)" ::: "memory");
    __builtin_amdgcn_wave_barrier();
}
__device__ __forceinline__ void stage_store_bf16(const LAS float* st, bf16_t* dst, int ld, float sc, int lane) {
#pragma unroll 1
    for (int it = 0; it < 4; ++it) {
        const int row = it * 8 + (lane >> 3), c8 = (lane & 7) * 8;
        const f32x4 x0 = *(const LAS f32x4*)(st + row * OST_LD + c8), x1 = *(const LAS f32x4*)(st + row * OST_LD + c8 + 4);
        u32x4 o; o.x = pk2(x0[0] * sc, x0[1] * sc); o.y = pk2(x0[2] * sc, x0[3] * sc); o.z = pk2(x1[0] * sc, x1[1] * sc); o.w = pk2(x1[2] * sc, x1[3] * sc);
        ST16_WT(dst + (size_t)row * ld + c8, o);
    }
}
__device__ __forceinline__ void stage_store_bf16_sc1(const LAS float* st, bf16_t* dst, int ld, int lane) {
#pragma unroll 1
    for (int it = 0; it < 4; ++it) {
        const int row = it * 8 + (lane >> 3), c8 = (lane & 7) * 8;
        const f32x4 x0 = *(const LAS f32x4*)(st + row * OST_LD + c8), x1 = *(const LAS f32x4*)(st + row * OST_LD + c8 + 4);
        u32x4 o; o.x = pk2(x0[0], x0[1]); o.y = pk2(x0[2], x0[3]); o.z = pk2(x1[0], x1[1]); o.w = pk2(x1[2], x1[3]);
        bf16_t* ptr = dst + (size_t)row * ld + c8;
        asm volatile("global_store_dwordx4 %0, %1, off sc1\n\ts_nop 1" :: "v"(ptr), "v"(o) : "memory");
    }
}
__device__ __forceinline__ void stage_store_f32(const LAS float* st, float* dst, int ld, int lane) {
#pragma unroll 1
    for (int it = 0; it < 8; ++it) {
        const int row = it * 4 + (lane >> 4), c = (lane & 15) * 4;
        { const f32x4 o = *(const LAS f32x4*)(st + row * OST_LD + c); ST16_WT(dst + (size_t)row * ld + c, o); }
    }
}
__device__ __forceinline__ void stage_store_bf16_32(const LAS float* st, bf16_t* dst, int ld, int lane) {
#pragma unroll 1
    for (int it = 0; it < 2; ++it) {
        const int row = it * 16 + (lane >> 2), c8 = (lane & 3) * 8;
        const f32x4 x0 = *(const LAS f32x4*)(st + row * OST_LD + c8), x1 = *(const LAS f32x4*)(st + row * OST_LD + c8 + 4);
        u32x4 o; o.x = pk2(x0[0], x0[1]); o.y = pk2(x0[2], x0[3]); o.z = pk2(x1[0], x1[1]); o.w = pk2(x1[2], x1[3]);
        ST16_WT(dst + (size_t)row * ld + c8, o);
    }
}
__device__ __forceinline__ void stage_store_f32_32(const LAS float* st, float* dst, int ld, int lane) {
#pragma unroll 1
    for (int it = 0; it < 4; ++it) {
        const int row = it * 8 + (lane >> 3), c = (lane & 7) * 4;
        { const f32x4 o = *(const LAS f32x4*)(st + row * OST_LD + c); ST16_WT(dst + (size_t)row * ld + c, o); }
    }
}

struct Gemm1Pre { float rstd[2]; float bias, gain; };
__device__ __forceinline__ void gemm1_pre(const Frame& F, const Params& p, int tn, int wn, int tm, int l, Gemm1Pre& P) {
    const float* ssqp = (const float*)(F.ws + WS_SSQ);
#pragma unroll
    for (int jj = 0; jj < 2; ++jj) {
        const int tok = tm * 256 + (F.w >> 2) * 128 + 64 * jj + F.lane;
        const f32x4* sp = (const f32x4*)(ssqp + (size_t)tok * 16);
        float ss = 0.f;
#pragma unroll
        for (int i = 0; i < 4; ++i) { const f32x4 q = sp[i]; ss += (q[0] + q[1]) + (q[2] + q[3]); }
        P.rstd[jj] = rsqrtf(ss * (1.f / 1024.f) + EPS);
    }
    const bool lat = tm >= 16;
    const int cond = lat ? 1 + ((tm - 16) >> 2) : 0;
    const int nb = tn * 128 + wn * 64;
    P.bias = (tn < 23) ? ((const float*)(F.ws + WS_BIAS))[(size_t)(l * 5 + cond) * 2944 + nb + F.lane] : 0.f;
    const float* gp = nullptr;
    if (tn >= 6 && tn < 9) gp = pin(F, I_GQN) + l * 64;
    else if (tn == 9) gp = pin(F, I_GKN) + l * 64;
    else if (tn == 11 || tn == 12) gp = pin(F, I_MQN) + l * 256 + (nb - 1408);
    else if (tn == 13) gp = pin(F, I_MKVN) + l * 128 + wn * 64;
    P.gain = gp ? gp[F.lane] : 1.f;
}
__device__ __forceinline__ void epi_gemm1(const Frame& F, const Params& p, GemmAcc8& acc, int tn, int wn, int tm, int l, const Gemm1Pre& P, bool ckv_tile) {
    int lane = F.lane; const int wm = F.w >> 2;
    asm volatile("" : "+v"(lane));
    const int c15 = lane & 15, g4 = lane >> 4;
    unsigned char* ws = F.ws;
    asm volatile("" : "+s"(ws));
    LAS float* st = (LAS float*)(F.lds + LDS_OST + F.w * OST_BYTES);
    const bool lat = tm >= 16;
    const int b = lat ? ((tm - 16) >> 2) : tm;
    const int nb = tn * 128 + wn * 64;
    LAS float* exb = (LAS float*)(F.lds + LDS_EXB) + F.w * 128;
    exb[lane] = P.bias; exb[64 + lane] = P.gain;
    asm volatile("s_waitcnt lgkmcnt(0)" ::: "memory");
    __builtin_amdgcn_wave_barrier();
    const LAS float* bias = exb;
    float* outp = p.out;
    asm volatile("" : "+s"(outp));
    float ckv_ss[8];
    if (tn < 23) {
#pragma unroll
    for (int mt = 0; mt < 8; ++mt) {
        const int mh = mt & 1;
        const int tok0 = tm * 256 + wm * 128 + (mt >> 1) * 32;
        const int tokb = tok0 + 16 * mh, tok = tokb + c15;
        const int t0 = lat ? ((tok0 - 4096) & 1023) : (tok0 & 255), t = t0 + 16 * mh + c15;
        const float rstd = __shfl(P.rstd[mt >> 2], 16 * (mt & 3) + c15);
        float v[4][4];
#pragma unroll
        for (int nt = 0; nt < 4; ++nt) {
            const f32x4 bq = *(const LAS f32x4*)(bias + 16 * nt + 4 * g4);
#pragma unroll
            for (int i = 0; i < 4; ++i) v[nt][i] = acc[nt][mt][i] * rstd + bq[i];
        }
        const float rowp = (float)(t >> 6), colp = (float)(t & 63);
        const size_t orow0 = (size_t)(b * 4 + l) * 256 + t0;
        if (tn < 2) {
            if (lat) rope64_16(v, rowp, colp, g4);
            stage_write16(st, v, mh, c15, g4);
            if (mh) stage_store_bf16(st, (bf16_t*)(ws + WS_RQ) + (size_t)tok0 * 256 + nb, 256, 1.f, lane);
        } else if (tn < 4) {
            if (lat) rope64_16(v, rowp, colp, g4);
            stage_write16(st, v, mh, c15, g4);
            if (mh) stage_store_bf16(st, (bf16_t*)(ws + WS_RK) + (size_t)tok0 * 256 + (nb - 256), 256, 0.125f, lane);
        } else if (tn < 6) {
            stage_write16(st, v, mh, c15, g4);
            if (mh) stage_store_bf16(st, (bf16_t*)(ws + WS_RV) + (size_t)tok0 * 256 + (nb - 512), 256, 1.f, lane);
        } else if (tn < 9) {
            const float r = rsqrtf(ssq64(v) * (1.f / 64.f) + EPS);
#pragma unroll
            for (int nt = 0; nt < 4; ++nt)
#pragma unroll
                for (int i = 0; i < 4; ++i) v[nt][i] *= r;
            mulvec64(v, exb + 64, g4);
            if (lat) rope64_16(v, rowp, colp, g4);
            stage_write16(st, v, mh, c15, g4);
            if (mh) stage_store_bf16(st, (bf16_t*)(ws + WS_GQ) + (size_t)tok0 * 384 + (nb - 768), 384, QSC_GQA, lane);
        } else if (tn == 9) {
            const float r = rsqrtf(ssq64(v) * (1.f / 64.f) + EPS);
#pragma unroll
            for (int nt = 0; nt < 4; ++nt)
#pragma unroll
                for (int i = 0; i < 4; ++i) v[nt][i] *= r;
            mulvec64(v, exb + 64, g4);
            if (lat) rope64_16(v, rowp, colp, g4);
            stage_write16(st, v, mh, c15, g4);
            if (mh) {
                if (!lat) stage_store_f32(st, outp + O_GK + orow0 * 128 + (nb - 1152), 128, lane);
                stage_store_bf16(st, (bf16_t*)(ws + WS_GK) + (size_t)tok0 * 128 + (nb - 1152), 128, 1.f, lane);
            }
        } else if (tn == 10) {
            stage_write16(st, v, mh, c15, g4);
            if (mh) {
                if (!lat) stage_store_f32(st, outp + O_GV + orow0 * 128 + (nb - 1280), 128, lane);
                stage_store_bf16(st, (bf16_t*)(ws + WS_GV) + (size_t)tok0 * 128 + (nb - 1280), 128, 1.f, lane);
            }
        } else if (tn < 13) {
            const float s2 = ssq64(v);
            if (g4 == 0) __hip_atomic_store((__attribute__((address_space(1))) float*)((float*)(ws + WS_CQSSQ) + (size_t)tok * 4 + ((nb - 1408) >> 6)), s2, __ATOMIC_RELAXED, __HIP_MEMORY_SCOPE_AGENT);
            mulvec64(v, exb + 64, g4);
            stage_write16(st, v, mh, c15, g4);
            if (mh) stage_store_bf16_sc1(st, (bf16_t*)(ws + WS_CQG) + (size_t)tok0 * 256 + (nb - 1408), 256, lane);
        } else if (tn == 13) {
            ckv_ss[mt] = ssq64(v);
            if (g4 == 0) ((LAS float*)(F.lds + LDS_EX))[(wm * 2 + wn) * 128 + mt * 16 + c15] = ckv_ss[mt];
        } else if (tn < 22) {
#pragma unroll
            for (int nt = 0; nt < 4; ++nt)
#pragma unroll
                for (int i = 0; i < 4; ++i) v[nt][i] = silu_f(v[nt][i]);
            stage_write16(st, v, mh, c15, g4);
            if (mh) stage_store_bf16(st, (bf16_t*)(ws + WS_ZS) + (size_t)tok0 * 1024 + (nb - 1792), 1024, 1.f, lane);
        } else {
            if (wn == 0) {
                if (lat) rope32_16(v[0], v[1], rowp, colp, g4);
                stage_write16(st, v, mh, c15, g4);
                if (mh) {
                    if (!lat) stage_store_f32_32(st, outp + O_KPE + orow0 * 32, 32, lane);
                    stage_store_bf16_32(st, (bf16_t*)(ws + WS_KPEB) + (size_t)tok0 * 32, 32, lane);
                }
            }
        }
    }
    }
    if (ckv_tile) {
        __syncthreads();
        if (tn == 13) {
#pragma unroll
        for (int mt = 0; mt < 8; ++mt) {
            const int mh = mt & 1;
            const int tok0 = tm * 256 + wm * 128 + (mt >> 1) * 32;
            const int t0 = lat ? ((tok0 - 4096) & 1023) : (tok0 & 255);
            const float rstd = __shfl(P.rstd[mt >> 2], 16 * (mt & 3) + c15);
            float v[4][4];
#pragma unroll
            for (int nt = 0; nt < 4; ++nt) {
                const f32x4 bq = *(const LAS f32x4*)(bias + 16 * nt + 4 * g4);
#pragma unroll
                for (int i = 0; i < 4; ++i) v[nt][i] = acc[nt][mt][i] * rstd + bq[i];
            }
            const float tot = ckv_ss[mt] + ((const LAS float*)(F.lds + LDS_EX))[(wm * 2 + (wn ^ 1)) * 128 + mt * 16 + c15];
            const float r = rsqrtf(tot * (1.f / 128.f) + EPS);
#pragma unroll
            for (int nt = 0; nt < 4; ++nt)
#pragma unroll
                for (int i = 0; i < 4; ++i) v[nt][i] *= r;
            mulvec64(v, exb + 64, g4);
            const size_t orow0 = (size_t)(b * 4 + l) * 256 + t0;
            stage_write16(st, v, mh, c15, g4);
            if (mh) {
                if (!lat) stage_store_f32(st, outp + O_CKV + orow0 * 128 + wn * 64, 128, lane);
                stage_store_bf16_sc1(st, (bf16_t*)(ws + WS_CKVN) + (size_t)tok0 * 128 + wn * 64, 128, lane);
            }
        }
        }
        __syncthreads();
    }
}

__device__ __forceinline__ void qm_pre(const Frame& F, int tm, float& rstd) {
    const int tok = tm * 256 + (F.w >> 1) * 64 + F.lane;
    const f32x4 q4 = *(const f32x4*)((const float*)(F.ws + WS_CQSSQ) + (size_t)tok * 4);
    rstd = rsqrtf(((q4[0] + q4[1]) + (q4[2] + q4[3])) * (1.f / 256.f) + EPS);
}
__device__ __forceinline__ void epi_qm(const Frame& F, GemmAcc& acc, int tn, int tm, float rstdl) {
    int lane = F.lane; const int wn = F.w & 1, wm = F.w >> 1;
    asm volatile("" : "+v"(lane));
    const int c15 = lane & 15, g4 = lane >> 4;
    unsigned char* ws = F.ws;
    LAS float* st = (LAS float*)(F.lds + LDS_OST + F.w * OST_BYTES);
    const bool lat = tm >= 16;
    const int nb = tn * 128 + wn * 64;
    if (nb >= 576) return;
#pragma unroll
    for (int mt = 0; mt < 4; ++mt) {
        const int mh = mt & 1;
        const int tok0 = tm * 256 + wm * 64 + (mt >> 1) * 32, tok = tok0 + 16 * mh + c15;
        const int t = lat ? ((tok - 4096) & 1023) : (tok & 255);
        const float rstd = __shfl(rstdl, 16 * mt + c15);
        const float rowp = (float)(t >> 6), colp = (float)(t & 63);
        float v[4][4];
#pragma unroll
        for (int nt = 0; nt < 4; ++nt)
#pragma unroll
            for (int i = 0; i < 4; ++i) v[nt][i] = acc[nt][mt][i] * rstd;
#pragma unroll
        for (int q = 0; q < 2; ++q) {
            const int T = (nb + 32 * q) >> 5;
            if (lat && (T % 3) == 2) rope32_16(v[2 * q], v[2 * q + 1], rowp, colp, g4);
        }
        stage_write16(st, v, mh, c15, g4);
        if (mh) stage_store_bf16(st, (bf16_t*)(ws + WS_QM) + (size_t)tok0 * 576 + nb, 576, QSC_MLA, lane);
    }
}
__device__ __forceinline__ void epi_plain(const Frame& F, GemmAcc& acc, bf16_t* D, int ldd, int row0, int n0) {
    int lane = F.lane; const int wn = F.w & 1, wm = F.w >> 1;
    asm volatile("" : "+v"(lane));
    const int c15 = lane & 15, g4 = lane >> 4;
    LAS float* st = (LAS float*)(F.lds + LDS_OST + F.w * OST_BYTES);
#pragma unroll
    for (int mt = 0; mt < 4; ++mt) {
        const int r0 = row0 + wm * 64 + (mt >> 1) * 32;
        stage_write16a(st, acc, mt, c15, g4);
        if (mt & 1) stage_store_bf16(st, D + (size_t)r0 * ldd + n0 + wn * 64, ldd, 1.f, lane);
    }
}

struct Gemm2Pre { f32x4 gt0, gt1, gs0, gs1; };
__device__ __forceinline__ void gemm2_pre(const Frame& F, int tn, int tm, int l, Gemm2Pre& P) {
    const bool lat = tm >= 16; const int cond = lat ? 1 + ((tm - 16) >> 2) : 0;
    const int nb = tn * 128 + (F.w & 1) * 64, c8 = (F.lane & 7) * 8;
    const float* gtp = (const float*)(F.ws + WS_MODS) + (size_t)(l * 5 + cond) * 3072 + 2048 + nb + c8;
    const float* gsp = (const float*)(F.ws + WS_GS) + (size_t)((l < 3 ? l + 1 : 3) * 5 + cond) * 1024 + nb + c8;
    P.gt0 = *(const f32x4*)gtp; P.gt1 = *(const f32x4*)(gtp + 4);
    P.gs0 = *(const f32x4*)gsp; P.gs1 = *(const f32x4*)(gsp + 4);
}
__device__ __forceinline__ void epi_gemm2(const Frame& F, const Params& p, GemmAcc& acc, int tn, int tm, int l, const Gemm2Pre& P, bool last) {
    int lane = F.lane; const int wn = F.w & 1, wm = F.w >> 1;
    asm volatile("" : "+v"(lane));
    const int c15 = lane & 15, g4 = lane >> 4;
    unsigned char* ws = F.ws;
    LAS float* st = (LAS float*)(F.lds + LDS_OST + F.w * OST_BYTES);
    const bool lat = tm >= 16;
    const int nb = tn * 128 + wn * 64;
    const int c8 = (lane & 7) * 8, r8 = lane >> 3;
#pragma unroll
    for (int mt = 0; mt < 2; ++mt) {
        const int tok0 = tm * 256 + wm * 64 + mt * 32;
        stage_write16a(st, acc, 2 * mt, c15, g4);
        stage_write16a(st, acc, 2 * mt + 1, c15, g4);
        bf16_t* xb0 = (bf16_t*)(ws + WS_XB) + (size_t)tok0 * 1024 + nb + c8;
        f32x4 xo8[8];
        if (l == 0) {
            const float* xold0 = lat ? pin(F, I_XS) + (size_t)(tok0 - 4096) * 1024 : pin(F, I_XP) + (size_t)tok0 * 1024;
#pragma unroll
            for (int it = 0; it < 4; ++it) {
                const float* xp = xold0 + (size_t)(it * 8 + r8) * 1024 + nb + c8;
                xo8[2 * it] = *(const f32x4*)xp; xo8[2 * it + 1] = *(const f32x4*)(xp + 4);
            }
        } else {
#pragma unroll
            for (int it = 0; it < 4; ++it) {
                const u32x4 q = *(const u32x4*)(xb0 + (size_t)(it * 8 + r8) * 1024);
                xo8[2 * it] = (f32x4){bflo(q.x), bfhi(q.x), bflo(q.y), bfhi(q.y)}; xo8[2 * it + 1] = (f32x4){bflo(q.z), bfhi(q.z), bflo(q.w), bfhi(q.w)};
            }
        }
#pragma unroll
        for (int it = 0; it < 4; ++it) {
            const int row = it * 8 + r8;
            const f32x4 a0 = *(const LAS f32x4*)(st + row * OST_LD + c8), a1 = *(const LAS f32x4*)(st + row * OST_LD + c8 + 4);
            const f32x4 xn0 = xo8[2 * it] + P.gt0 * a0, xn1 = xo8[2 * it + 1] + P.gt1 * a1;
            {
                u32x4 o; o.x = pk2(xn0[0], xn0[1]); o.y = pk2(xn0[2], xn0[3]); o.z = pk2(xn1[0], xn1[1]); o.w = pk2(xn1[2], xn1[3]);
                if (last) ST16_WT(xb0 + (size_t)row * 1024, o); else *(u32x4*)(xb0 + (size_t)row * 1024) = o;
            }
            float ss = ((xn0[0] * xn0[0] + xn0[1] * xn0[1]) + (xn0[2] * xn0[2] + xn0[3] * xn0[3])) + ((xn1[0] * xn1[0] + xn1[1] * xn1[1]) + (xn1[2] * xn1[2] + xn1[3] * xn1[3]));
            ss += __shfl_xor(ss, 1); ss += __shfl_xor(ss, 2); ss += __shfl_xor(ss, 4);
            if ((lane & 7) == 0) {
                float* sq = (float*)(ws + WS_SSQ) + (size_t)(tok0 + row) * 16 + tn * 2 + wn;
                __hip_atomic_store((__attribute__((address_space(1))) float*)sq, ss, __ATOMIC_RELAXED, __HIP_MEMORY_SCOPE_AGENT);
            }
            if (l < 3) {
                u32x4 o; o.x = pk2(xn0[0] * P.gs0[0], xn0[1] * P.gs0[1]); o.y = pk2(xn0[2] * P.gs0[2], xn0[3] * P.gs0[3]);
                o.z = pk2(xn1[0] * P.gs1[0], xn1[1] * P.gs1[1]); o.w = pk2(xn1[2] * P.gs1[2], xn1[3] * P.gs1[3]);
                ST16_WT((bf16_t*)(ws + WS_XG) + (size_t)(tok0 + row) * 1024 + nb + c8, o);
            }
        }
    }
}
constexpr int AT_STG = 20480, AT_PE = 8192, AT_V = 12288, AT_OLD = 68;
struct AttnUnit {
    int mode;
    int nt0, nt1;
    const bf16_t *q; int q_ld;
    const bf16_t *k0, *k1; int k_ld0, k_ld1;
    const bf16_t *pe0, *pe1;
    const bf16_t *v0, *v1; int v_ld0, v_ld1;
    int tok0;
    int ycol;
    int qpos0, L;
    float lf, lb;
    const bf16_t *s0f, *s0b;
    unsigned* zflag;
    unsigned* yflag;
    float* st_out;
};
__device__ __forceinline__ s16x4 tr16(LAS const unsigned char* p) {
    typedef short v4i16_t __attribute__((ext_vector_type(4)));
    return __builtin_bit_cast(s16x4, __builtin_amdgcn_ds_read_tr16_b64_v4i16((LAS v4i16_t*)p));
}

template <int MODE>
__device__ __forceinline__ void attn_unit(const Frame& F, const Params& p, const AttnUnit& U) {
    constexpr int NQS = MODE == 1 ? 6 : 4;
    const int lane = F.lane, w = F.w, h = F.h, lq = F.lq;
    LAS unsigned char* lds = F.lds;
    const int k_ld = U.k_ld1, v_ld = U.v_ld1;
    const int krow = 8 * w + (lane >> 3);
    const int koff = krow * k_ld + ((lane & 7) ^ ((krow >> 1) & 7)) * 8;
    const int poff = (16 * (w & 3) + (lane >> 2)) * 32 + ((lane & 3) ^ ((lane >> 4) & 3)) * 8;
    const int vdblk = w >> 2, vkg = w & 3;
    const int voff = (16 * vkg + (lane >> 2)) * v_ld + vdblk * 32 + (lane & 3) * 8;
    const int vdst = AT_V + vdblk * 4096 + vkg * 1024;
    const int nt0 = U.nt0, ntot = U.nt0 + U.nt1;
    const unsigned ldsb = (unsigned)(uintptr_t)lds;
#define AT_DMA(gsrc, ldsoff) do { unsigned _keep; const unsigned _d = (unsigned)__builtin_amdgcn_readfirstlane((int)(ldsb + (unsigned)(ldsoff))); \
        asm volatile("s_mov_b32 %0, m0\n\ts_mov_b32 m0, %2\n\ts_nop 0\n\tglobal_load_lds_dwordx4 %1, off\n\ts_mov_b32 m0, %0" : "=&s"(_keep) : "v"(gsrc), "s"(_d) : "memory"); } while (0)
#define AT_ISSUE(t, st) do { const int _t = (t); const int _b = (st) * AT_STG; \
        const bool _s0 = _t < nt0; const int _u = _s0 ? _t : _t - nt0; \
        const bf16_t* _kb = (_s0 ? U.k0 : U.k1) + (size_t)_u * 64 * k_ld; const bf16_t* _vb = (_s0 ? U.v0 : U.v1) + (size_t)_u * 64 * v_ld; \
        AT_DMA(_kb + koff, _b + (8 * w) * 128); \
        if (MODE == 1) { const bf16_t* _pb = (_s0 ? U.pe0 : U.pe1) + (size_t)_u * 64 * 32; AT_DMA(_pb + poff, _b + AT_PE + 16 * (w & 3) * 64); } \
        AT_DMA(_vb + voff, _b + vdst); } while (0)
    AT_ISSUE(0, 0);
    if (ntot > 1) AT_ISSUE(1, 1);
    bf16x8 qr[NQS];
    if (MODE == 3) {
        const int dk = 32 * (w & 1) + lq;
#pragma unroll
        for (int s = 0; s < 4; ++s)
#pragma unroll
            for (int j = 0; j < 8; ++j) qr[s][j] = (16 * s + 8 * h + j == dk) ? (short)0x3F80 : (short)0;
    } else {
        const bf16_t* qp = U.q + (size_t)(32 * w + lq) * U.q_ld + 8 * h;
#pragma unroll
        for (int s = 0; s < NQS; ++s) qr[s] = *(const bf16x8*)(qp + 16 * s);
    }
    f32x16 o[2];
#pragma unroll
    for (int d = 0; d < 2; ++d)
#pragma unroll
        for (int r = 0; r < 16; ++r) o[d][r] = 0.f;
    float m_run = 0.f, l_run = 0.f;
    f32x16 negm;
#pragma unroll
    for (int r = 0; r < 16; ++r) negm[r] = 0.f;
    const int qpos = U.qpos0 + 32 * w + lq;
    const float st_slope = ((w >> 1) & 1) ? U.lb : -U.lf, st_off = ((w >> 1) & 1) ? 0.f : 255.f * U.lf;
    const int sdir = (w >> 1) & 1;
    LAS float* scal = (LAS float*)(lds + LDS_SCAL) + w * 32;
    LAS float* ctab = (LAS float*)(lds + LDS_EXB) + w * 128;
    float a_f = 0.f, a_b = 0.f;
    if (MODE == 2) {
        ctab[lane] = __builtin_amdgcn_exp2f((float)(63 - lane) * U.lf);
        ctab[64 + lane] = __builtin_amdgcn_exp2f((float)lane * U.lb);
        a_f = __builtin_amdgcn_exp2f((float)(32 * w + lq) * U.lf);
        a_b = __builtin_amdgcn_exp2f((float)(255 - 32 * w - lq) * U.lb);
        asm volatile("s_waitcnt lgkmcnt(0)" ::: "memory");
        __builtin_amdgcn_wave_barrier();
    }
    const int kfo = lq * 128, sw = (lane >> 1) & 7, pfo = AT_PE + lq * 64, psw = (lane >> 2) & 3;
    const int vfo = AT_V + (4 * h + ((lane & 15) >> 2)) * 64 + ((lane >> 4) & 1) * 32 + (lane & 3) * 8;
    int st = 0;
    for (int t = 0; t < ntot; ++t) {
        if (t + 1 < ntot) { if (MODE == 1) asm volatile("s_waitcnt vmcnt(3)" ::: "memory"); else asm volatile("s_waitcnt vmcnt(2)" ::: "memory"); }
        else asm volatile("s_waitcnt vmcnt(0)" ::: "memory");
        __builtin_amdgcn_s_barrier();
        asm volatile("" ::: "memory");
        const int st2 = st == 0 ? 2 : st - 1;
        if (t + 2 < ntot) AT_ISSUE(t + 2, st2);
        LAS const unsigned char* base = lds + st * AT_STG;
        bf16x8 kfa[NQS], kfb[NQS];
#pragma unroll
        for (int s = 0; s < 4; ++s) {
            const int so = ((2 * s + h) ^ sw) << 4;
            kfa[s] = *(const LAS bf16x8*)(base + kfo + so);
            kfb[s] = *(const LAS bf16x8*)(base + kfo + 4096 + so);
        }
        if (MODE == 1) {
#pragma unroll
            for (int s = 0; s < 2; ++s) {
                const int so = ((2 * s + h) ^ psw) << 4;
                kfa[4 + s] = *(const LAS bf16x8*)(base + pfo + so);
                kfb[4 + s] = *(const LAS bf16x8*)(base + pfo + 2048 + so);
            }
        }
        f32x16 p0, p1;
        if (MODE <= 1) { p0 = negm; p1 = negm; }
        else {
#pragma unroll
            for (int r = 0; r < 16; ++r) { p0[r] = 0.f; p1[r] = 0.f; }
        }
#pragma unroll
        for (int s = 0; s < NQS; ++s) { p0 = MFMA32(kfa[s], qr[s], p0); p1 = MFMA32(kfb[s], qr[s], p1); }
        s16x4 vlo[4], vhi[4];
#pragma unroll
        for (int ks = 0; ks < 4; ++ks) { vlo[ks] = tr16(base + vfo + ks * 1024); vhi[ks] = tr16(base + vfo + ks * 1024 + 512); }
        if (MODE <= 1) {
            float tm = p0[0];
#pragma unroll
            for (int r = 1; r < 16; ++r) tm = fmaxf(tm, p0[r]);
#pragma unroll
            for (int r = 0; r < 16; ++r) tm = fmaxf(tm, p1[r]);
            tm = fmaxf(tm, __shfl_xor(tm, 32));
            if (t == 0 || __any(tm > 6.0f)) {
                const float dl = t == 0 ? tm : fmaxf(tm, 0.f);
                m_run += dl;
#pragma unroll
                for (int r = 0; r < 16; ++r) { p0[r] -= dl; p1[r] -= dl; negm[r] = -m_run; }
                if (t > 0) {
                    const float alpha = __builtin_amdgcn_exp2f(-dl);
                    l_run *= alpha;
                    if (h == 0) scal[lq] = alpha;
                    asm volatile("s_waitcnt lgkmcnt(0)" ::: "memory");
#pragma unroll
                    for (int g = 0; g < 4; ++g) {
                        const f32x4 a4 = *(const LAS f32x4*)(scal + 8 * g + 4 * h);
#pragma unroll
                        for (int i = 0; i < 4; ++i) { o[0][4 * g + i] *= a4[i]; o[1][4 * g + i] *= a4[i]; }
                    }
                }
            }
            float ls = 0.f;
#pragma unroll
            for (int r = 0; r < 16; ++r) { p0[r] = __builtin_amdgcn_exp2f(p0[r]); p1[r] = __builtin_amdgcn_exp2f(p1[r]); ls += p0[r] + p1[r]; }
            l_run += ls;
        } else if (MODE == 2 && (64 * t + 63 < U.qpos0 || 64 * t > U.qpos0 + 255)) {
            const bool fwd = 64 * t + 63 < U.qpos0;
            const float A = fwd ? a_f * __builtin_amdgcn_exp2f((float)(U.qpos0 - 64 * t - 63) * U.lf) : a_b * __builtin_amdgcn_exp2f((float)(64 * t - U.qpos0 - 255) * U.lb);
            const LAS float* tb = ctab + (fwd ? 0 : 64) + 4 * h;
#pragma unroll
            for (int g = 0; g < 4; ++g) {
                const f32x4 c0 = *(const LAS f32x4*)(tb + 8 * g), c1 = *(const LAS f32x4*)(tb + 32 + 8 * g);
#pragma unroll
                for (int i = 0; i < 4; ++i) { p0[4 * g + i] *= c0[i] * A; p1[4 * g + i] *= c1[i] * A; }
            }
        } else if (MODE == 2) {
            float dq = (float)(qpos - 64 * t - 4 * h);
            asm volatile("" : "+v"(dq));
#pragma unroll
            for (int r = 0; r < 16; ++r) {
                const float d0 = dq - (float)((r & 3) + 8 * (r >> 2)), d1 = d0 - 32.f;
                const float w0 = __builtin_amdgcn_exp2f(fabsf(d0) * (d0 > 0.f ? U.lf : U.lb));
                const float w1 = __builtin_amdgcn_exp2f(fabsf(d1) * (d1 > 0.f ? U.lf : U.lb));
                p0[r] *= (d0 == 0.f ? 2.f : w0);
                p1[r] *= (d1 == 0.f ? 2.f : w1);
            }
        } else {
            float mb = (float)(64 * t + 4 * h);
            asm volatile("" : "+v"(mb));
#pragma unroll
            for (int r = 0; r < 16; ++r) {
                const float m0 = mb + (float)((r & 3) + 8 * (r >> 2)), m1 = m0 + 32.f;
                const float e0 = fmaf(m0, st_slope, st_off), e1 = fmaf(m1, st_slope, st_off);
                p0[r] *= __builtin_amdgcn_exp2f(e0);
                p1[r] *= __builtin_amdgcn_exp2f(e1);
            }
        }
        bf16x8 pa[4];
        { u32x4 a;
          a.x = pk2(p0[0], p0[1]); a.y = pk2(p0[2], p0[3]); a.z = pk2(p0[4], p0[5]); a.w = pk2(p0[6], p0[7]); pa[0] = __builtin_bit_cast(bf16x8, a);
          a.x = pk2(p0[8], p0[9]); a.y = pk2(p0[10], p0[11]); a.z = pk2(p0[12], p0[13]); a.w = pk2(p0[14], p0[15]); pa[1] = __builtin_bit_cast(bf16x8, a);
          a.x = pk2(p1[0], p1[1]); a.y = pk2(p1[2], p1[3]); a.z = pk2(p1[4], p1[5]); a.w = pk2(p1[6], p1[7]); pa[2] = __builtin_bit_cast(bf16x8, a);
          a.x = pk2(p1[8], p1[9]); a.y = pk2(p1[10], p1[11]); a.z = pk2(p1[12], p1[13]); a.w = pk2(p1[14], p1[15]); pa[3] = __builtin_bit_cast(bf16x8, a); }
#pragma unroll
        for (int ks = 0; ks < 4; ++ks) {
            const bf16x8 vb = __builtin_shufflevector(vlo[ks], vhi[ks], 0, 1, 2, 3, 4, 5, 6, 7);
            o[0] = MFMA32(pa[ks], vb, o[0]);
        }
#pragma unroll
        for (int ks = 0; ks < 4; ++ks) { vlo[ks] = tr16(base + vfo + 4096 + ks * 1024); vhi[ks] = tr16(base + vfo + 4096 + ks * 1024 + 512); }
#pragma unroll
        for (int ks = 0; ks < 4; ++ks) {
            const bf16x8 vb = __builtin_shufflevector(vlo[ks], vhi[ks], 0, 1, 2, 3, 4, 5, 6, 7);
            o[1] = MFMA32(pa[ks], vb, o[1]);
        }
        st = st == 2 ? 0 : st + 1;
    }
#undef AT_ISSUE
#undef AT_DMA
    int lq2 = lq, h2 = h, lane2 = lane; asm volatile("" : "+v"(lq2), "+v"(h2), "+v"(lane2));
    if (MODE == 2 && U.s0f != nullptr) {
        const float ff = __builtin_amdgcn_exp2f((float)(qpos + 1) * U.lf), fb = __builtin_amdgcn_exp2f((float)(U.L - qpos) * U.lb);
#pragma unroll
        for (int s = 0; s < 4; ++s) {
            const u32x4 qu = __builtin_bit_cast(u32x4, qr[s]);
            u32x4 af, ab;
#pragma unroll
            for (int i = 0; i < 4; ++i) { const float lo = bflo(qu[i]), hi = bfhi(qu[i]); af[i] = pk2(lo * ff, hi * ff); ab[i] = pk2(lo * fb, hi * fb); }
#pragma unroll
            for (int d = 0; d < 2; ++d) {
                const bf16x8 sf = *(const bf16x8*)(U.s0f + (size_t)(32 * d + lq2) * 64 + 16 * s + 8 * h2);
                const bf16x8 sb = *(const bf16x8*)(U.s0b + (size_t)(32 * d + lq2) * 64 + 16 * s + 8 * h2);
                o[d] = MFMA32(__builtin_bit_cast(bf16x8, af), sf, o[d]);
                o[d] = MFMA32(__builtin_bit_cast(bf16x8, ab), sb, o[d]);
            }
        }
    }
    if (MODE == 3) {
        float* dst = U.st_out + (size_t)sdir * 4 * 4096 + (size_t)(32 * (w & 1)) * 64;
        if (w < 4) {
#pragma unroll
        for (int d = 0; d < 2; ++d)
#pragma unroll
            for (int r = 0; r < 16; ++r) dst[(size_t)((r & 3) + 8 * (r >> 2) + 4 * h2) * 64 + 32 * d + lq2] = o[d][r];
        }
        __syncthreads();
        if (F.tid == 0 && U.yflag != nullptr) (void)xb_add(U.yflag, 1u);
        return;
    }
    if (MODE <= 1) {
        l_run += __shfl_xor(l_run, 32);
        if (h2 == 0) scal[lq2] = 1.f / l_run;
    }
    if (U.zflag != nullptr && F.tid == 0) {
        unsigned* bar0 = (unsigned*)(F.ws + WS_CTL) + CW_BAR;
        XB_SPIN(xb_ld(U.zflag) < 4u, bar0);
    }
    __syncthreads();
    LAS float* ost = (LAS float*)lds + w * (32 * AT_OLD);
#pragma unroll
    for (int d = 0; d < 2; ++d)
#pragma unroll
        for (int r = 0; r < 16; ++r) ost[((r & 3) + 8 * (r >> 2) + 4 * h2) * AT_OLD + 32 * d + lq2] = o[d][r];
    asm volatile("s_waitcnt lgkmcnt(0)" ::: "memory");
    __builtin_amdgcn_wave_barrier();
    const bf16_t* zs = (const bf16_t*)(F.ws + WS_ZS);
    bf16_t* yb = (bf16_t*)(F.ws + WS_Y);
#pragma unroll
    for (int it = 0; it < 4; ++it) {
        const int row = it * 8 + (lane2 >> 3), c8 = (lane2 & 7) * 8;
        const f32x4 x0 = *(const LAS f32x4*)(ost + row * AT_OLD + c8), x1 = *(const LAS f32x4*)(ost + row * AT_OLD + c8 + 4);
        float sc;
        if (MODE <= 1) sc = scal[row];
        else {
            float ss = (x0[0] * x0[0] + x0[1] * x0[1]) + (x0[2] * x0[2] + x0[3] * x0[3]) + (x1[0] * x1[0] + x1[1] * x1[1]) + (x1[2] * x1[2] + x1[3] * x1[3]);
            ss += __shfl_xor(ss, 1); ss += __shfl_xor(ss, 2); ss += __shfl_xor(ss, 4);
            sc = rsqrtf(ss * (1.f / 64.f) + EPS);
        }
        const size_t off = (size_t)(U.tok0 + 32 * w + row) * 1024 + U.ycol + c8;
        const u32x4 z = *(const u32x4*)(zs + off);
        u32x4 y;
        y.x = pk2(x0[0] * sc * bflo(z.x), x0[1] * sc * bfhi(z.x));
        y.y = pk2(x0[2] * sc * bflo(z.y), x0[3] * sc * bfhi(z.y));
        y.z = pk2(x1[0] * sc * bflo(z.z), x1[1] * sc * bfhi(z.z));
        y.w = pk2(x1[2] * sc * bflo(z.w), x1[3] * sc * bfhi(z.w));
        ST16_WT(yb + off, y);
    }
    asm volatile("s_waitcnt vmcnt(0)" ::: "memory");
    __syncthreads();
    if (F.tid == 0) (void)xb_add(U.yflag, 1u);
}

__device__ __forceinline__ void dep_wait(const Frame& F, unsigned* c, int n, unsigned target) {
    if (F.tid == 0) {
        unsigned* bar0 = (unsigned*)(F.ws + WS_CTL) + CW_BAR;
        for (int i = 0; i < n; ++i) { XB_SPIN(xb_ld(c + 4 * i) < target, bar0); }
    }
}
__device__ __forceinline__ void attn_dispatch(const Frame& F, const Params& p, int u, int l) {
    unsigned char* ws = F.ws;
    AttnUnit U;
    U.nt0 = 0; U.nt1 = 0; U.q = nullptr; U.q_ld = 0; U.k0 = U.k1 = nullptr; U.k_ld0 = U.k_ld1 = 0; U.pe0 = U.pe1 = nullptr; U.v0 = U.v1 = nullptr; U.v_ld0 = U.v_ld1 = 0;
    U.tok0 = 0; U.ycol = 0; U.qpos0 = 0; U.L = 0; U.lf = U.lb = 0.f; U.s0f = U.s0b = nullptr; U.st_out = nullptr; U.mode = 0; U.yflag = nullptr; U.zflag = nullptr;
    const bf16_t* GQ = (const bf16_t*)(ws + WS_GQ); const bf16_t* GK = (const bf16_t*)(ws + WS_GK); const bf16_t* GV = (const bf16_t*)(ws + WS_GV);
    const bf16_t* QM = (const bf16_t*)(ws + WS_QM); const bf16_t* KVM = (const bf16_t*)(ws + WS_KVM); const bf16_t* KVMC = (const bf16_t*)(ws + WS_KVMC);
    const bf16_t* KPEB = (const bf16_t*)(ws + WS_KPEB); const bf16_t* CKPE = (const bf16_t*)(ws + WS_CKPE);
    const bf16_t* CGK = (const bf16_t*)(ws + WS_CGK); const bf16_t* CGV = (const bf16_t*)(ws + WS_CGV);
    const bf16_t* RQ = (const bf16_t*)(ws + WS_RQ); const bf16_t* RK = (const bf16_t*)(ws + WS_RK); const bf16_t* RV = (const bf16_t*)(ws + WS_RV);
    const float* decay = pin(F, I_DECAY) + l * 8;
    if (u < 96 || (u >= 256 && u < 352)) {
        const bool lat = u < 96; const int uu = lat ? u : u - 256;
        const int b = lat ? uu / 24 : uu / 6, hh = lat ? (uu >> 2) % 6 : uu % 6, qb = lat ? (uu & 3) : 0;
        const int seq0 = lat ? 4096 + b * 1024 : b * 256;
        U.mode = 1; U.tok0 = seq0 + qb * 256; U.q = QM + (size_t)U.tok0 * 576 + hh * 96; U.q_ld = 576; U.ycol = 640 + hh * 64;
        U.nt1 = lat ? 16 : 4; U.k1 = KVM + (size_t)seq0 * 768 + hh * 128; U.k_ld1 = 768; U.v1 = U.k1 + 64; U.v_ld1 = 768; U.pe1 = KPEB + (size_t)seq0 * 32;
        U.k0 = U.k1; U.v0 = U.v1; U.pe0 = U.pe1; U.k_ld0 = 768; U.v_ld0 = 768;
        if (lat) { U.nt0 = 8; U.k0 = KVMC + (size_t)(b * 512) * 768 + hh * 128; U.v0 = U.k0 + 64; U.pe0 = CKPE + (size_t)((b * 4 + l) * 512) * 32; }
        U.yflag = (unsigned*)(ws + WS_CTL) + CW_YRDY + (l * 32 + (U.tok0 >> 8)) * 4;
        { unsigned* c = (unsigned*)(ws + WS_CTL);
          dep_wait(F, c + CW_FULL + (l * 32 + (seq0 >> 8)) * 4, lat ? 4 : 1, 23u);
          if (lat) dep_wait(F, c + CW_KC + (l * 4 + b) * 4, 1, 12u); }
        __syncthreads();
        attn_unit<1>(F, p, U);
    } else if (u < 192 || (u >= 352 && u < 448)) {
        const bool lat = u < 192; const int uu = lat ? u - 96 : u - 352;
        const int b = lat ? uu / 24 : uu / 6, hh = lat ? (uu >> 2) % 6 : uu % 6, qb = lat ? (uu & 3) : 0, kvh = hh / 3;
        const int seq0 = lat ? 4096 + b * 1024 : b * 256;
        U.mode = 0; U.tok0 = seq0 + qb * 256; U.q = GQ + (size_t)U.tok0 * 384 + hh * 64; U.q_ld = 384; U.ycol = 256 + hh * 64;
        U.nt1 = lat ? 16 : 4; U.k1 = GK + (size_t)seq0 * 128 + kvh * 64; U.k_ld1 = 128; U.v1 = GV + (size_t)seq0 * 128 + kvh * 64; U.v_ld1 = 128;
        U.k0 = U.k1; U.v0 = U.v1; U.k_ld0 = 128; U.v_ld0 = 128;
        if (lat) { U.nt0 = 8; U.k0 = CGK + (size_t)((b * 4 + l) * 512) * 128 + kvh * 64; U.v0 = CGV + (size_t)((b * 4 + l) * 512) * 128 + kvh * 64; }
        U.yflag = (unsigned*)(ws + WS_CTL) + CW_YRDY + (l * 32 + (U.tok0 >> 8)) * 4;
        { unsigned* c = (unsigned*)(ws + WS_CTL);
          dep_wait(F, c + CW_RA + (l * 32 + (seq0 >> 8)) * 4, lat ? 4 : 1, 8u);
          U.zflag = c + CW_ZC + (l * 32 + (U.tok0 >> 8)) * 4; }
        __syncthreads();
        attn_unit<0>(F, p, U);
    } else if (u < 256 || (u >= 448 && u < 512)) {
        const bool lat = u < 256; const int uu = lat ? u - 192 : u - 448;
        const int b = lat ? uu / 16 : uu / 4, hh = lat ? (uu >> 2) & 3 : uu & 3, qb = lat ? (uu & 3) : 0;
        const int seq0 = lat ? 4096 + b * 1024 : b * 256;
        U.mode = 2; U.tok0 = seq0 + qb * 256; U.q = RQ + (size_t)U.tok0 * 256 + hh * 64; U.q_ld = 256; U.ycol = hh * 64;
        U.nt1 = lat ? 16 : 4; U.k1 = RK + (size_t)seq0 * 256 + hh * 64; U.k_ld1 = 256; U.v1 = RV + (size_t)seq0 * 256 + hh * 64; U.v_ld1 = 256;
        U.k0 = U.k1; U.v0 = U.v1; U.k_ld0 = 256; U.v_ld0 = 256;
        U.qpos0 = qb * 256; U.L = lat ? 1024 : 256;
        U.lf = -log1pf(__expf(-decay[hh])) * LOG2E; U.lb = -log1pf(__expf(-decay[4 + hh])) * LOG2E;
        if (lat) { const bf16_t* S0T = (const bf16_t*)(ws + WS_S0T); U.s0f = S0T + (size_t)(((b * 4 + l) * 2 + 0) * 4 + hh) * 4096; U.s0b = S0T + (size_t)(((b * 4 + l) * 2 + 1) * 4 + hh) * 4096; }
        U.yflag = (unsigned*)(ws + WS_CTL) + CW_YRDY + (l * 32 + (U.tok0 >> 8)) * 4;
        { unsigned* c = (unsigned*)(ws + WS_CTL);
          dep_wait(F, c + CW_RA + (l * 32 + (seq0 >> 8)) * 4, lat ? 4 : 1, 8u);
          U.zflag = c + CW_ZC + (l * 32 + (U.tok0 >> 8)) * 4; }
        __syncthreads();
        attn_unit<2>(F, p, U);
    } else {
        const int uu = u - 512, b = uu >> 2, hh = uu & 3, seq0 = b * 256;
        U.mode = 3; U.nt1 = 4; U.k1 = RK + (size_t)seq0 * 256 + hh * 64; U.k_ld1 = 256; U.v1 = RV + (size_t)seq0 * 256 + hh * 64; U.v_ld1 = 256;
        U.k0 = U.k1; U.v0 = U.v1; U.k_ld0 = 256; U.v_ld0 = 256;
        U.lf = -log1pf(__expf(-decay[hh])) * LOG2E; U.lb = -log1pf(__expf(-decay[4 + hh])) * LOG2E;
        U.st_out = p.out + O_STATE + (size_t)(((b * 4 + l) * 2 + 0) * 4 + hh) * 4096;
        dep_wait(F, (unsigned*)(ws + WS_CTL) + CW_RA + (l * 32 + b) * 4, 1, 8u);
        U.yflag = (unsigned*)(ws + WS_CTL) + CW_SD + (l * 16 + b) * 4;
        __syncthreads();
        attn_unit<3>(F, p, U);
    }
}
constexpr int N_ATTN_UNITS = 576;
struct TItem { const float* src; bf16_t* dst; int nsrc, K; int valid; };
constexpr int P0_TWIN = 4 * 16 * 92, P0_TWOUT = 4 * 16 * 32, P0_TWUQ = 4 * 4 * 20, P0_TWUKV = 4 * 2 * 24, P0_TR = P0_TWIN + P0_TWOUT + P0_TWUQ + P0_TWUKV;
__device__ __forceinline__ TItem p0_titem(const Frame& F, unsigned char* ws, int it) {
    TItem t; t.valid = it < P0_TR; t.src = nullptr; t.dst = nullptr; t.nsrc = 0; t.K = 0;
    if (!t.valid) return t;
    if (it < P0_TWIN) {
        const int l = it / (16 * 92), r = it % (16 * 92), kb = r / 92, nb = r % 92, n0 = nb * 32;
        const int src = n0 < 1792 ? n0 : (n0 < 2816 ? n0 + 32 : (n0 < 2848 ? n0 - 2816 + 1792 : -1));
        t.nsrc = 2848; t.K = 1024;
        if (src >= 0) t.src = pin(F, I_WIN) + (size_t)l * 1024 * 2848 + (size_t)(kb * 64) * 2848 + src;
        t.dst = (bf16_t*)(ws + WS_WIN) + ((size_t)l * 2944 + n0) * 1024 + kb * 64;
        return t;
    }
    it -= P0_TWIN;
    if (it < P0_TWOUT) {
        const int l = it / 512, r = it % 512, kb = r >> 5, nb = r & 31;
        t.nsrc = 1024; t.K = 1024; t.src = pin(F, I_WOUT) + (size_t)l * 1024 * 1024 + (size_t)(kb * 64) * 1024 + nb * 32;
        t.dst = (bf16_t*)(ws + WS_WOUT) + ((size_t)l * 1024 + nb * 32) * 1024 + kb * 64;
        return t;
    }
    it -= P0_TWOUT;
    if (it < P0_TWUQ) {
        const int l = it / 80, r = it % 80, kb = r / 20, nb = r % 20;
        t.nsrc = 576; t.K = 256; if (nb < 18) t.src = pin(F, I_WUQ) + (size_t)l * 256 * 576 + (size_t)(kb * 64) * 576 + nb * 32;
        t.dst = (bf16_t*)(ws + WS_WUQ) + ((size_t)l * 640 + nb * 32) * 256 + kb * 64;
        return t;
    }
    it -= P0_TWUQ;
    { const int l = it / 48, r = it % 48, kb = r / 24, nb = r % 24;
      t.nsrc = 768; t.K = 128; t.src = pin(F, I_WUKV) + (size_t)l * 128 * 768 + (size_t)(kb * 64) * 768 + nb * 32;
      t.dst = (bf16_t*)(ws + WS_WUKV) + ((size_t)l * 768 + nb * 32) * 128 + kb * 64; }
    return t;
}
__device__ __forceinline__ void p0_tload(const TItem& t, float (&r)[32], int lane) {
    if (t.valid && t.src) {
        const float* wp = t.src + (size_t)(lane >> 5) * t.nsrc + (lane & 31);
#pragma unroll
        for (int i = 0; i < 32; ++i) r[i] = wp[(size_t)(2 * i) * t.nsrc];
    } else {
#pragma unroll
        for (int i = 0; i < 32; ++i) r[i] = 0.f;
    }
}
__device__ __forceinline__ void p0_tstore(const TItem& t, const float (&r)[32], LAS float* scr, int lane) {
    if (!t.valid) return;
#pragma unroll
    for (int i = 0; i < 32; ++i) scr[(2 * i + (lane >> 5)) * 33 + (lane & 31)] = r[i];
    asm volatile("s_waitcnt lgkmcnt(0)" ::: "memory");
    __builtin_amdgcn_wave_barrier();
    const int c = lane & 7;
#pragma unroll
    for (int j = 0; j < 4; ++j) {
        const int n = (lane >> 3) + 8 * j; const LAS float* s = scr + (8 * c) * 33 + n;
        u32x4 o; o.x = pk2(s[0 * 33], s[1 * 33]); o.y = pk2(s[2 * 33], s[3 * 33]); o.z = pk2(s[4 * 33], s[5 * 33]); o.w = pk2(s[6 * 33], s[7 * 33]);
        ST16_WT(t.dst + (size_t)n * t.K + 8 * c, o);
    }
    asm volatile("s_waitcnt lgkmcnt(0)" ::: "memory");
    __builtin_amdgcn_wave_barrier();
}
__device__ __forceinline__ void cast8(const float* src, bf16_t* dst, size_t e) {
    const f32x4 a = *(const f32x4*)(src + e), b = *(const f32x4*)(src + e + 4);
    u32x4 o; o.x = pk2(a[0], a[1]); o.y = pk2(a[2], a[3]); o.z = pk2(b[0], b[1]); o.w = pk2(b[2], b[3]);
    ST16_WT(dst + e, o);
}
constexpr int P0_MODS = 1536, P0_CAST_G = 512, P0_CAST_KPE = 128, P0_S0T = 512;
constexpr int P0_TOTAL = P0_MODS + 3 * P0_CAST_G + P0_CAST_KPE + P0_S0T;
__device__ __forceinline__ void phase0(const Frame& F, const Params& p, bool dup = false) {
    unsigned char* ws = F.ws + (dup ? 162 * MiB : 0); const int lane = F.lane;
    LAS float* scr = (LAS float*)F.lds + F.w * (64 * 33);
    const int gw = blockIdx.x * NWAVE + F.w, ngw = gridDim.x * NWAVE;
#ifndef MK_DUP0
#define MK_DUP0_ 0
#else
#define MK_DUP0_ MK_DUP0
#endif
    if (!(dup && MK_DUP0_ == 2))
    for (int it = gw; it < P0_TR; it += 2 * ngw) {
        const TItem t0 = p0_titem(F, ws, it), t1 = p0_titem(F, ws, it + ngw);
        float r0[32], r1[32];
        p0_tload(t0, r0, lane); p0_tload(t1, r1, lane);
        p0_tstore(t0, r0, scr, lane); p0_tstore(t1, r1, scr, lane);
    }
    if (!(dup && MK_DUP0_ == 1))
    for (int it0 = (gw + ngw - 256) % ngw; it0 < P0_TOTAL; it0 += ngw) {
        int it = it0;
        if (it < P0_MODS) {
            const int l = it / 384, cg = (it % 384) >> 5, ks = it & 31;
            const int j = cg * 256 + lane * 4;
            const float* wp = pin(F, I_WADA) + ((size_t)l * 1024 + ks * 32) * 3072 + j;
            const float* c = pin(F, I_C); const float* cc = pin(F, I_CCTX);
            float sv[3];
#pragma unroll
            for (int q = 0; q < 3; ++q) {
                const int idx = q * 64 + lane, n = idx >> 5, k = idx & 31;
                float x = 0.f;
                if (idx < 160) x = (n == 0) ? cc[ks * 32 + k] : c[(n - 1) * 1024 + ks * 32 + k];
                sv[q] = silu_f(x);
            }
            f32x4 acc[5];
#pragma unroll
            for (int n = 0; n < 5; ++n) acc[n] = (f32x4){0.f, 0.f, 0.f, 0.f};
#pragma unroll 1
            for (int k0 = 0; k0 < 32; k0 += 16) {
                f32x4 wv[16];
#pragma unroll
                for (int k = 0; k < 16; ++k) wv[k] = *(const f32x4*)(wp + (size_t)(k0 + k) * 3072);
                __builtin_amdgcn_sched_barrier(0);
#pragma unroll
                for (int k = 0; k < 16; ++k)
#pragma unroll
                    for (int n = 0; n < 5; ++n) {
                        const float s = __int_as_float(__builtin_amdgcn_readlane(__float_as_int(sv[n >> 1]), 32 * (n & 1) + k0 + k));
                        acc[n] += wv[k] * s;
                    }
            }
            LAS f32x4* red = (LAS f32x4*)(F.lds + 69632);
#pragma unroll
            for (int n = 0; n < 5; ++n) red[(F.w * 5 + n) * 64 + lane] = acc[n];
            __syncthreads();
            if (F.tid < 320) {
                const int n = F.tid >> 6;
                f32x4 s = red[n * 64 + lane];
#pragma unroll
                for (int ww = 1; ww < 8; ++ww) s += red[(ww * 5 + n) * 64 + lane];
                if ((ks >> 3) == 0) s += *(const f32x4*)(pin(F, I_BADA) + l * 3072 + j);
                float* mods = (float*)(ws + WS_MODS) + (size_t)(l * 5 + n) * 3072 + j;
#pragma unroll
                for (int e = 0; e < 4; ++e) atomicAdd(mods + e, s[e]);
            }
            __syncthreads();
            continue;
        }
        it -= P0_MODS;
        if (it < 3 * P0_CAST_G) {
            const int which = it / P0_CAST_G, r = it % P0_CAST_G;
            const float* src = which == 0 ? pin(F, I_CGK) : (which == 1 ? pin(F, I_CGV) : pin(F, I_CCKV));
            bf16_t* dst = (bf16_t*)(ws + (which == 0 ? WS_CGK : (which == 1 ? WS_CGV : WS_CCKV)));
#pragma unroll
            for (int q = 0; q < 4; ++q) cast8(src, dst, (size_t)r * 2048 + q * 512 + lane * 8);
            continue;
        }
        it -= 3 * P0_CAST_G;
        if (it < P0_CAST_KPE) {
#pragma unroll
            for (int q = 0; q < 4; ++q) cast8(pin(F, I_CKPE), (bf16_t*)(ws + WS_CKPE), (size_t)it * 2048 + q * 512 + lane * 8);
            continue; }
        it -= P0_CAST_KPE;
        {
            const int mat = it >> 2, qd = it & 3, dv = qd * 16 + (lane >> 2), dk0 = (lane & 3) * 16;
            const float* s = pin(F, I_STATE) + (size_t)mat * 4096 + dv;
            float x[16];
#pragma unroll
            for (int i = 0; i < 16; ++i) x[i] = s[(dk0 + i) * 64];
            u32x4 o0, o1;
            o0.x = pk2(x[0], x[1]); o0.y = pk2(x[2], x[3]); o0.z = pk2(x[4], x[5]); o0.w = pk2(x[6], x[7]);
            o1.x = pk2(x[8], x[9]); o1.y = pk2(x[10], x[11]); o1.z = pk2(x[12], x[13]); o1.w = pk2(x[14], x[15]);
            bf16_t* d = (bf16_t*)(ws + WS_S0T) + (size_t)mat * 4096 + dv * 64 + dk0;
            ST16_WT(d, o0); ST16_WT(d + 8, o1);
        }
    }
}
constexpr int P1_GS = 80, P1_BIAS = 4 * 368, P1_X = 8192, P1_TOTAL = P1_GS + P1_BIAS + P1_X;
__device__ __forceinline__ void xg_row(const Frame& F, const float* xrow, const float* g, const float* mods_c, bf16_t* xg_row_out, float* ssq_row, bool write_xg) {
    const int lane = F.lane;
    float ss = 0.f;
#pragma unroll
    for (int j = 0; j < 2; ++j) {
        const int k = j * 512 + lane * 8;
        const f32x4 x0 = *(const f32x4*)(xrow + k), x1 = *(const f32x4*)(xrow + k + 4);
        ss += ((x0[0] * x0[0] + x0[1] * x0[1]) + (x0[2] * x0[2] + x0[3] * x0[3])) + ((x1[0] * x1[0] + x1[1] * x1[1]) + (x1[2] * x1[2] + x1[3] * x1[3]));
        if (write_xg) {
            const f32x4 g0 = *(const f32x4*)(g + k), g1 = *(const f32x4*)(g + k + 4), s0 = *(const f32x4*)(mods_c + 1024 + k), s1 = *(const f32x4*)(mods_c + 1024 + k + 4);
            u32x4 o; o.x = pk2(x0[0] * g0[0] * (1.f + s0[0]), x0[1] * g0[1] * (1.f + s0[1])); o.y = pk2(x0[2] * g0[2] * (1.f + s0[2]), x0[3] * g0[3] * (1.f + s0[3]));
            o.z = pk2(x1[0] * g1[0] * (1.f + s1[0]), x1[1] * g1[1] * (1.f + s1[1])); o.w = pk2(x1[2] * g1[2] * (1.f + s1[2]), x1[3] * g1[3] * (1.f + s1[3]));
            ST16_WT(xg_row_out + k, o);
        }
    }
    ss = wsum(ss);
    if (lane < 16) ssq_row[lane] = lane == 0 ? ss : 0.f;
}
__device__ __forceinline__ void phase1(const Frame& F, const Params& p) {
    unsigned char* ws = F.ws; const int lane = F.lane;
    unsigned* ctl = (unsigned*)(ws + WS_CTL);
    const int gw = blockIdx.x * NWAVE + F.w, ngw = gridDim.x * NWAVE;
    const float* mods = (const float*)(ws + WS_MODS);
    for (int it0 = gw; it0 < P1_GS + P1_BIAS; it0 += ngw) {
        int it = it0;
        if (it < P1_GS) {
            const int e = it * 256 + lane * 4, lc = e >> 10, k = e & 1023, l = lc / 5;
            const f32x4 g = *(const f32x4*)(pin(F, I_NORMG) + l * 1024 + k), sc = *(const f32x4*)(mods + (size_t)lc * 3072 + 1024 + k);
            { const f32x4 o = g * (sc + 1.f); ST16_WT((float*)(ws + WS_GS) + e, o); }
            continue;
        }
        it -= P1_GS;
        {
            const int l = it / 368, n0 = (it % 368) * 8;
            f32x4 sh[5][4];
#pragma unroll
            for (int c = 0; c < 5; ++c) {
                const float* shp = mods + (size_t)(l * 5 + c) * 3072 + lane * 16;
#pragma unroll
                for (int i = 0; i < 4; ++i) sh[c][i] = *(const f32x4*)(shp + 4 * i);
            }
            const bf16_t* wr0 = (const bf16_t*)(ws + WS_WIN) + ((size_t)l * 2944 + n0) * 1024 + lane * 16;
            u32x4 w0[8], w1[8];
#pragma unroll
            for (int r = 0; r < 8; ++r) { w0[r] = *(const u32x4*)(wr0 + (size_t)r * 1024); w1[r] = *(const u32x4*)(wr0 + (size_t)r * 1024 + 8); }
#pragma unroll
            for (int r = 0; r < 8; ++r) {
                float wv[16];
#pragma unroll
                for (int i = 0; i < 4; ++i) { wv[2 * i] = bflo(w0[r][i]); wv[2 * i + 1] = bfhi(w0[r][i]); wv[8 + 2 * i] = bflo(w1[r][i]); wv[8 + 2 * i + 1] = bfhi(w1[r][i]); }
#pragma unroll
                for (int c = 0; c < 5; ++c) {
                    float d = 0.f;
#pragma unroll
                    for (int i = 0; i < 4; ++i) { const f32x4 s4 = sh[c][i]; d += (s4[0] * wv[4 * i] + s4[1] * wv[4 * i + 1]) + (s4[2] * wv[4 * i + 2] + s4[3] * wv[4 * i + 3]); }
                    d = wsum(d);
                    if (lane == 0) __hip_atomic_store((__attribute__((address_space(1))) float*)((float*)(ws + WS_BIAS) + (size_t)(l * 5 + c) * 2944 + n0 + r), d, __ATOMIC_RELAXED, __HIP_MEMORY_SCOPE_AGENT);
                }
            }
            if (l == 0) {
                asm volatile("s_waitcnt vmcnt(0)" ::: "memory");
                if (lane == 0) (void)xb_add(ctl + CW_P1B0, 1u);
            }
        }
    }
    for (int vb = blockIdx.x; vb < 256; vb += gridDim.x) {
        const int tm = vb & 31, part = vb >> 5;
        const bool lat = tm >= 16;
        const int cond = lat ? 1 + ((tm - 16) >> 2) : 0;
        const float* g = pin(F, I_NORMG); const float* sc = mods + (size_t)cond * 3072 + 1024;
#pragma unroll 1
        for (int i = 0; i < 4; i += 2) {
            const int tok = tm * 256 + part * 32 + F.w * 4 + i;
            const float* xa = lat ? pin(F, I_XS) + (size_t)(tok - 4096) * 1024 : pin(F, I_XP) + (size_t)tok * 1024;
            const float* xb = xa + 1024;
            bf16_t* oa = (bf16_t*)(ws + WS_XG) + (size_t)tok * 1024;
            float ssa = 0.f, ssb = 0.f;
#pragma unroll
            for (int j = 0; j < 2; ++j) {
                const int k = j * 512 + lane * 8;
                const f32x4 a0 = *(const f32x4*)(xa + k), a1 = *(const f32x4*)(xa + k + 4), b0 = *(const f32x4*)(xb + k), b1 = *(const f32x4*)(xb + k + 4);
                const f32x4 g0 = *(const f32x4*)(g + k), g1 = *(const f32x4*)(g + k + 4), s0 = *(const f32x4*)(sc + k), s1 = *(const f32x4*)(sc + k + 4);
                const f32x4 m0 = g0 * (s0 + 1.f), m1 = g1 * (s1 + 1.f);
                ssa += ((a0[0] * a0[0] + a0[1] * a0[1]) + (a0[2] * a0[2] + a0[3] * a0[3])) + ((a1[0] * a1[0] + a1[1] * a1[1]) + (a1[2] * a1[2] + a1[3] * a1[3]));
                ssb += ((b0[0] * b0[0] + b0[1] * b0[1]) + (b0[2] * b0[2] + b0[3] * b0[3])) + ((b1[0] * b1[0] + b1[1] * b1[1]) + (b1[2] * b1[2] + b1[3] * b1[3]));
                u32x4 o; o.x = pk2(a0[0] * m0[0], a0[1] * m0[1]); o.y = pk2(a0[2] * m0[2], a0[3] * m0[3]); o.z = pk2(a1[0] * m1[0], a1[1] * m1[1]); o.w = pk2(a1[2] * m1[2], a1[3] * m1[3]);
                ST16_WT(oa + k, o);
                o.x = pk2(b0[0] * m0[0], b0[1] * m0[1]); o.y = pk2(b0[2] * m0[2], b0[3] * m0[3]); o.z = pk2(b1[0] * m1[0], b1[1] * m1[1]); o.w = pk2(b1[2] * m1[2], b1[3] * m1[3]);
                ST16_WT(oa + 1024 + k, o);
            }
            ssa = wsum(ssa); ssb = wsum(ssb);
            if (lane < 32) {
                const float v = (lane & 15) == 0 ? (lane < 16 ? ssa : ssb) : 0.f;
                __hip_atomic_store((__attribute__((address_space(1))) float*)((float*)(ws + WS_SSQ) + (size_t)(tok + (lane >> 4)) * 16 + (lane & 15)), v, __ATOMIC_RELAXED, __HIP_MEMORY_SCOPE_AGENT);
            }
        }
        asm volatile("s_waitcnt vmcnt(0)" ::: "memory");
        __syncthreads();
        if (is_t0(F)) (void)xb_add(ctl + CW_P1X + tm * 4, 1u);
    }
    asm volatile("s_waitcnt vmcnt(0)" ::: "memory");
    __syncthreads();
    if (is_t0(F)) (void)xb_add(ctl + CW_P1DONE, 1u);
}
#ifndef MK_TIMING
#define MK_TIMING -1
#endif
constexpr int CW_TIME = 2048;
__device__ __forceinline__ void phase_final(const Frame& F, const Params& p) {
    const int lane = F.lane;
    float tf = 1.f;
    if (MK_TIMING >= 0) tf = __uint_as_float(__hip_atomic_load((unsigned*)(F.ws + WS_CTL) + CW_TIME, __ATOMIC_RELAXED, __HIP_MEMORY_SCOPE_AGENT));
    unsigned* ctl = (unsigned*)(F.ws + WS_CTL);
    for (int vb = blockIdx.x; vb < 256; vb += gridDim.x) {
        const int tm = vb & 31, part = vb >> 5;
        if (F.tid == 0) {
            XB_SPIN(xb_ld(ctl + CW_XRDY + tm * 4) < 8u, ctl + CW_BAR);
            __builtin_amdgcn_fence(__ATOMIC_ACQUIRE, "agent");
            asm volatile("s_waitcnt vmcnt(0)" ::: "memory");
        }
        __syncthreads();
#pragma unroll 1
        for (int i = 0; i < 4; ++i) {
            const int tok = tm * 256 + part * 32 + F.w * 4 + i;
            float ss = 0.f;
            if (lane < 16) ss = ((const float*)(F.ws + WS_SSQ))[(size_t)tok * 16 + lane];
            ss = wsum(ss);
            const float rstd = rsqrtf(ss * (1.f / 1024.f) + EPS);
            const bf16_t* xr = (const bf16_t*)(F.ws + WS_XB) + (size_t)tok * 1024; float* orow = p.out + (size_t)tok * 1024;
#pragma unroll
            for (int j = 0; j < 4; ++j) {
                const int k = j * 256 + lane * 4;
                const u32x2 xq = *(const u32x2*)(xr + k);
                const f32x4 x = {bflo(xq.x), bfhi(xq.x), bflo(xq.y), bfhi(xq.y)}, fn = *(const f32x4*)(pin(F, I_FNORM) + k);
                { const f32x4 o = x * fn * (rstd * tf); ST16_WT(orow + k, o); }
            }
        }
    }
}

__device__ __forceinline__ GemmOp a2_op(const Frame& F, int l, int j) {
    GemmOp g;
    if (j < 160) { const int tn = j >> 5, tm = j & 31; g.W = (const bf16_t*)(F.ws + WS_WUQ) + ((size_t)l * 640 + tn * 128) * 256; g.X = (const bf16_t*)(F.ws + WS_CQG) + (size_t)tm * 256 * 256; g.ldw = 256; g.ldx = 256; g.K = 256; }
    else if (j < 352) { const int jj = j - 160, tn = jj >> 5, tm = jj & 31; g.W = (const bf16_t*)(F.ws + WS_WUKV) + ((size_t)l * 768 + tn * 128) * 128; g.X = (const bf16_t*)(F.ws + WS_CKVN) + (size_t)tm * 256 * 128; g.ldw = 128; g.ldx = 128; g.K = 128; }
    else { const int jj = j - 352, tn = jj >> 3, tc = jj & 7, b = tc >> 1, jt = tc & 1; g.W = (const bf16_t*)(F.ws + WS_WUKV) + ((size_t)l * 768 + tn * 128) * 128;
           g.X = (const bf16_t*)(F.ws + WS_CCKV) + ((size_t)(b * 4 + l) * 512 + jt * 256) * 128; g.ldw = 128; g.ldx = 128; g.K = 128; }
    return g;
}
__device__ __forceinline__ int a2_item(int vb, int i) {
    const int c = (vb >> 5) - 4, tmw = vb & 31;
    if (i == 3) return 352 + 32 + tmw;
    if (c == 0) return i * 32 + tmw;
    if (c == 1) return i < 2 ? (3 + i) * 32 + tmw : 160 + tmw;
    if (c == 2) return 160 + (1 + i) * 32 + tmw;
    return i < 2 ? 160 + (4 + i) * 32 + tmw : 352 + tmw;
}
#ifndef MK_EN
#define MK_EN 0xff
#endif
#define EN(x) ((MK_EN >> (x)) & 1)
constexpr int PH_TOTAL = 19;
__global__ void __launch_bounds__(512, 2) mega(Params p) {
    extern __shared__ __attribute__((aligned(16))) unsigned char lds_raw[];
    Frame F;
    F.lds = (LAS unsigned char*)lds_raw;
    F.tid = threadIdx.x; F.lane = F.tid & 63; F.w = __builtin_amdgcn_readfirstlane(F.tid >> 6); F.h = F.lane >> 5; F.lq = F.lane & 31;
    F.ws = p.ws;
    F.karg = (karg_t)__builtin_amdgcn_kernarg_segment_ptr();
    volatile LAS unsigned* MISC = (volatile LAS unsigned*)(F.lds + LDS_MISC);
    if (F.tid < 64) MISC[F.tid] = 0u;
    __syncthreads();
    unsigned* ctl = (unsigned*)(p.ws + WS_CTL);
    XcdBarrier bar; bar.bar = ctl + CW_BAR; bar.x = 0; bar.st = nullptr;
    const bool multi = p.ph_hi - p.ph_lo > 1;
    if (multi) bar = xcd_barrier_post(ctl + CW_BAR, MISC + 8);
    bar.w = F.w;
    const int G = gridDim.x;
    const Frame F0 = F;
    for (int ph = p.ph_lo; ph < p.ph_hi; ++ph) {
        if (ph >= 2 && ph < 18 && ((ph - 2) & 3) == 1) continue;
        Frame F = F0;
        F.lane = (int)__builtin_amdgcn_mbcnt_hi(~0u, __builtin_amdgcn_mbcnt_lo(~0u, 0u));
        asm volatile("" : "+v"(F.lane));
        F.tid = (F.w << 6) | F.lane; F.h = F.lane >> 5; F.lq = F.lane & 31;
        asm volatile("" : "+s"(F.w), "+s"(F.ws), "+s"(F.karg));
        if (MK_TIMING >= 0 && blockIdx.x == 0 && F.tid == 0) {
            const unsigned long long now = __builtin_amdgcn_s_memrealtime();
            const unsigned long long prev = ((unsigned long long)MISC[17] << 32) | MISC[16];
            if (ph > p.ph_lo) { const int q = ph - 1; const int grp = q < 2 ? q : 2 + ((q - 2) & 3); if (grp == MK_TIMING) MISC[18] += (unsigned)(now - prev); }
            MISC[16] = (unsigned)now; MISC[17] = (unsigned)(now >> 32);
        }
#ifndef MK_REPEAT
#define MK_REPEAT -1
#endif
        int nrep = 1;
        if (MK_REPEAT >= 1) { const int grp = ph < 2 ? ph : (ph == 18 ? 6 : 2 + ((ph - 2) & 3)); if (grp == MK_REPEAT) nrep = (grp == 5) ? (ph == 5 ? 5 : 1) : 2; }
        for (int rep = 0; rep < nrep; ++rep) {
        if (rep > 0) xcd_barrier(bar);
        Frame F = F0;
        F.lane = (int)__builtin_amdgcn_mbcnt_hi(~0u, __builtin_amdgcn_mbcnt_lo(~0u, 0u));
        asm volatile("" : "+v"(F.lane));
        F.tid = (F.w << 6) | F.lane; F.h = F.lane >> 5; F.lq = F.lane & 31;
        asm volatile("" : "+s"(F.w), "+s"(F.ws), "+s"(F.karg));
        if (EN(0) && ph == 0) {
#if defined(MK_DUP0)
            for (int d = 0; d < 2; ++d) { int dd = d; asm volatile("" : "+s"(dd)); if (dd) xcd_barrier(bar); phase0(F, p, dd != 0); }
#else
            phase0(F, p);
#endif
        }
        else if (EN(1) && ph == 1) phase1(F, p);
        else if (EN(2) && ph == 18) phase_final(F, p);
        else {
            const int l = (ph - 2) >> 2, sub = (ph - 2) & 3;
            int bid = blockIdx.x; asm volatile("" : "+s"(bid));
            if (EN(3) && sub == 0) {
                const bf16_t* Wt = (const bf16_t*)(F.ws + WS_WIN) + (size_t)l * 2944 * 1024;
                const bf16_t* X = (const bf16_t*)(F.ws + WS_XG);
                unsigned* flags = ctl + CW_FLAG + l * 512;
                bool first = true;
                int waited_tm = -1;
                for (int j = bid; j < 12 * 32; j += G) {
                    const int tn2 = j >> 5, tm = j & 31;
                    const int jn = j + G; const bool hn = jn < 12 * 32 && (jn & 31) == tm;
                    if (l == 0 && tm != waited_tm) {
                        waited_tm = tm;
                        if (F.tid == 0) {
                            XB_SPIN(xb_ld(ctl + CW_P1X + tm * 4) < 8u, ctl + CW_BAR);
                            XB_SPIN(xb_ld(ctl + CW_P1B0) < 368u, ctl + CW_BAR);
                            __builtin_amdgcn_fence(__ATOMIC_ACQUIRE, "agent");
                            asm volatile("s_waitcnt vmcnt(0)" ::: "memory");
                        }
                        __syncthreads();
                        first = true;
                    }
                    if (l > 0 && tm != waited_tm) {
                        waited_tm = tm;
                        if (F.tid == 0) {
                            XB_SPIN(xb_ld(ctl + CW_P1DONE) < (unsigned)G, ctl + CW_BAR);
                            XB_SPIN(xb_ld(ctl + CW_XGR + ((l - 1) * 32 + tm) * 4) < 8u, ctl + CW_BAR);
                            if (tm >= 16) { unsigned* y = ctl + CW_YRDY + ((l - 1) * 32 + (tm & ~3)) * 4; for (int i = 0; i < 4; ++i) { XB_SPIN(xb_ld(y + 4 * i) < 16u, ctl + CW_BAR); } }
                            else { XB_SPIN(xb_ld(ctl + CW_SD + ((l - 1) * 16 + tm) * 4) < 4u, ctl + CW_BAR); }
                            __builtin_amdgcn_fence(__ATOMIC_ACQUIRE, "agent");
                            asm volatile("s_waitcnt vmcnt(0)" ::: "memory");
                        }
                        __syncthreads();
                        first = true;
                    }
                    const int tn = 2 * tn2 + ((F.w & 3) >> 1), wn = F.w & 1;
                    GemmAcc8 acc;
                    Gemm1Pre P1;
                    gemm1_pre(F, p, tn, wn, tm, l, P1);
                    gemm_core256(F, Wt + (size_t)tn2 * 256 * 1024, X + (size_t)tm * 256 * 1024, acc, first, hn, Wt + (size_t)(jn >> 5) * 256 * 1024, X + (size_t)(jn & 31) * 256 * 1024); first = false;
                    epi_gemm1(F, p, acc, tn, wn, tm, l, P1, tn2 == 6);
                    {
                        asm volatile("s_waitcnt vmcnt(0)" ::: "memory");
                        __syncthreads();
                        if (F.tid == 0) {
                            if (tn2 == 5 || tn2 == 6) (void)xb_add(flags + tm * 16, 1u);
                            if (tn2 < 8) (void)xb_add(ctl + CW_RA + (l * 32 + tm) * 4, 1u);
                            if (tn2 >= 7 && tn2 < 11) (void)xb_add(ctl + CW_ZC + (l * 32 + tm) * 4, 1u);
                            (void)xb_add(ctl + CW_FULL + (l * 32 + tm) * 4, 1u);
                        }
                    }
                }
                for (int vb = bid; vb < 256; vb += G) {
                    if (vb < 128) continue;
                    const int c = (vb >> 5) - 4, tmw = vb & 31;
                    const int nit = (c == 2 && tmw < 16) ? 4 : 3;
                    if (F.tid == 0) {
                        if (l > 0 && tmw != waited_tm) {
                            if (tmw >= 16) { unsigned* y = ctl + CW_YRDY + ((l - 1) * 32 + (tmw & ~3)) * 4; for (int i = 0; i < 4; ++i) { XB_SPIN(xb_ld(y + 4 * i) < 16u, ctl + CW_BAR); } }
                            else { XB_SPIN(xb_ld(ctl + CW_YRDY + ((l - 1) * 32 + tmw) * 4) < 16u, ctl + CW_BAR); XB_SPIN(xb_ld(ctl + CW_SD + ((l - 1) * 16 + tmw) * 4) < 4u, ctl + CW_BAR); }
                        }
                        unsigned* f = flags + tmw * 16;
                        XB_SPIN(xb_ld(f) < 2u, ctl + CW_BAR);
                        __builtin_amdgcn_fence(__ATOMIC_ACQUIRE, "agent");
                        asm volatile("s_waitcnt vmcnt(0)" ::: "memory");
                    }
                    __syncthreads();
                    for (int i = 0; i < nit; ++i) {
                        const bool hn = i + 1 < nit;
                        const int j = a2_item(vb, i), jn = a2_item(vb, hn ? i + 1 : i);
                        const GemmOp g = a2_op(F, l, j); const GemmOp gn = a2_op(F, l, jn);
                        GemmAcc acc;
                        float rstdq = 0.f;
                        if (j < 160) qm_pre(F, tmw, rstdq);
                        gemm_core(F, g, acc, i == 0, hn, gn);
                        if (j < 160) epi_qm(F, acc, j >> 5, tmw, rstdq);
                        else if (j < 352) { const int jj = j - 160; epi_plain(F, acc, (bf16_t*)(F.ws + WS_KVM), 768, tmw * 256, (jj >> 5) * 128); }
                        else {
                            const int jj = j - 352, tc = jj & 7;
                            if (l > 0) {
                                if (F.tid == 0) { unsigned* y = ctl + CW_YRDY + ((l - 1) * 32 + 16 + 4 * (tc >> 1)) * 4; for (int q = 0; q < 4; ++q) { XB_SPIN(xb_ld(y + 4 * q) < 16u, ctl + CW_BAR); } }
                                __syncthreads();
                            }
                            epi_plain(F, acc, (bf16_t*)(F.ws + WS_KVMC), 768, (tc >> 1) * 512 + (tc & 1) * 256, (jj >> 3) * 128);
                        }
                        asm volatile("s_waitcnt vmcnt(0)" ::: "memory");
                        __syncthreads();
                        if (F.tid == 0) {
                            if (j < 352) (void)xb_add(ctl + CW_FULL + (l * 32 + tmw) * 4, 1u);
                            else (void)xb_add(ctl + CW_KC + (l * 4 + (((j - 352) & 7) >> 1)) * 4, 1u);
                        }
                    }
                }
            } else if (EN(5) && sub == 2) {
                for (;;) {
                    __syncthreads();
                    if (F.tid == 0) MISC[0] = atomicAdd(ctl + CW_QUEUE + 64 * l + 32 * rep, 1u);
                    __syncthreads();
                    const int uq = __builtin_amdgcn_readfirstlane((int)MISC[0]);
                    if (uq >= N_ATTN_UNITS) break;
                    const int u = uq < 160 ? uq + 96 : (uq < 256 ? uq - 160 : (uq < 480 ? uq + 96 : uq - 224));
                    attn_dispatch(F, p, u, l);
                }
            } else if (EN(6)) {
                const bf16_t* Wt = (const bf16_t*)(F.ws + WS_WOUT) + (size_t)l * 1024 * 1024;
                const bf16_t* Yb = (const bf16_t*)(F.ws + WS_Y);
                for (int j = bid; j < 8 * 32; j += G) {
                    const int tn = j >> 5, tm = j & 31;
                    GemmOp g; g.W = Wt + (size_t)tn * 128 * 1024; g.X = Yb + (size_t)tm * 256 * 1024; g.ldw = 1024; g.ldx = 1024; g.K = 1024;
                    GemmAcc acc;
                    Gemm2Pre P2;
                    if (F.tid == 0) {
                        unsigned* f = ctl + CW_YRDY + (l * 32 + tm) * 4;
                        XB_SPIN(xb_ld(f) < 16u, ctl + CW_BAR);
                        if (l == 0) { XB_SPIN(xb_ld(ctl + CW_P1DONE) < (unsigned)G, ctl + CW_BAR); }
                        __builtin_amdgcn_fence(__ATOMIC_ACQUIRE, "agent");
                        asm volatile("s_waitcnt vmcnt(0)" ::: "memory");
                    }
                    __syncthreads();
                    gemm2_pre(F, tn, tm, l, P2);
                    gemm_core(F, g, acc, true, false, g);
                    epi_gemm2(F, p, acc, tn, tm, l, P2, l == 3);
                    {
                        asm volatile("s_waitcnt vmcnt(0)" ::: "memory");
                        __syncthreads();
                        if (F.tid == 0) (void)xb_add(l == 3 ? ctl + CW_XRDY + tm * 4 : ctl + CW_XGR + (l * 32 + tm) * 4, 1u);
                    }
                }
            }
        }
        }
        if (MK_TIMING >= 0 && ph == 17 && blockIdx.x == 0 && F.tid == 0) {
            const unsigned long long now = __builtin_amdgcn_s_memrealtime();
            const unsigned long long prev = ((unsigned long long)MISC[17] << 32) | MISC[16];
            unsigned a = MISC[18]; if (MK_TIMING == 5) a += (unsigned)(now - prev);
            __hip_atomic_store(ctl + CW_TIME, __float_as_uint(1.f + (float)a * 1e-5f), __ATOMIC_RELAXED, __HIP_MEMORY_SCOPE_AGENT);
        }
        if (ph + 1 < p.ph_hi && ph < 1) xcd_barrier(bar);
    }
}
}

extern "C" void kernel_launch(void* const* d_in, const int* in_sizes, int n_in, void* d_out, int out_size, void* d_ws, size_t ws_size, hipStream_t stream) {
    static int grid = 0;
    if (!grid) {
        int dev = 0, cus = 0, per_cu = 0;
        (void)hipGetDevice(&dev);
        (void)hipDeviceGetAttribute(&cus, hipDeviceAttributeMultiprocessorCount, dev);
        (void)hipFuncSetAttribute((const void*)mk::mega, hipFuncAttributeMaxDynamicSharedMemorySize, mk::LDS_BYTES);
        (void)hipOccupancyMaxActiveBlocksPerMultiprocessor(&per_cu, (const void*)mk::mega, 512, mk::LDS_BYTES);
        if (per_cu > 1) per_cu = 1;
        if (per_cu < 1) per_cu = 1;
        if (cus < 1) cus = 256;
        grid = cus * per_cu;
    }
    unsigned char* ws = (unsigned char*)d_ws;
    (void)hipMemsetAsync(ws, 0, mk::CTL_ZERO_BYTES, stream);
    mk::Params P{};
    for (int i = 0; i < 22; ++i) P.in[i] = (const float*)d_in[i];
    P.out = (float*)d_out; P.ws = ws; P.xs = (float*)d_out;
    P.ph_lo = 0; P.ph_hi = mk::PH_TOTAL;
    void* args[] = {&P};
    (void)hipLaunchCooperativeKernel((const void*)mk::mega, dim3(grid), dim3(512), args, mk::LDS_BYTES, stream);
}
```

```cpp
#include <hip/hip_runtime.h>
#include <stdint.h>
namespace mk {
#define LAS __attribute__((address_space(3)))
typedef unsigned short bf16_t;
typedef short bf16x8 __attribute__((ext_vector_type(8)));
typedef short s16x4 __attribute__((ext_vector_type(4)));
typedef float f32x16 __attribute__((ext_vector_type(16)));
typedef float f32x4 __attribute__((ext_vector_type(4)));
typedef float f32x2 __attribute__((ext_vector_type(2)));
typedef unsigned u32x4 __attribute__((ext_vector_type(4)));
typedef unsigned u32x2 __attribute__((ext_vector_type(2)));
typedef __bf16 bf16x2_t __attribute__((ext_vector_type(2)));

constexpr float EPS = 1e-6f;
constexpr float LOG2E = 1.4426950408889634f;
constexpr float QSC_GQA = 0.125f * LOG2E;
constexpr float QSC_MLA = 0.10206207261596575f * LOG2E;

__device__ __forceinline__ unsigned pk2(float lo, float hi) { f32x2 v = {lo, hi}; bf16x2_t b = __builtin_convertvector(v, bf16x2_t); return __builtin_bit_cast(unsigned, b); }
__device__ __forceinline__ float bf2f(unsigned short u) { return __uint_as_float((unsigned)u << 16); }
__device__ __forceinline__ float bflo(unsigned u) { return __uint_as_float(u << 16); }
__device__ __forceinline__ float bfhi(unsigned u) { return __uint_as_float(u & 0xffff0000u); }
__device__ __forceinline__ float silu_f(float x) { return x * __builtin_amdgcn_rcpf(1.f + __builtin_amdgcn_exp2f(-x * LOG2E)); }
__device__ __forceinline__ float wsum(float v) {
#pragma unroll
    for (int o = 32; o > 0; o >>= 1) v += __shfl_xor(v, o);
    return v;
}

constexpr size_t MiB = 1u << 20;
constexpr size_t WS_CTL = 0, CTL_ZERO_BYTES = 1 * MiB;
constexpr size_t WS_MODS = 256 * 1024;
constexpr size_t WS_BIAS = 1 * MiB;
constexpr size_t WS_GS = 1 * MiB + 256 * 1024;
constexpr size_t WS_ROPE64 = 1 * MiB + 512 * 1024;
constexpr size_t WS_ROPE32 = 1 * MiB + 768 * 1024;
constexpr size_t WS_SSQ = 2 * MiB;
constexpr size_t WS_CQSSQ = 2 * MiB + 512 * 1024;
constexpr size_t WS_S0T = 3 * MiB;
constexpr size_t WS_CGK = 4 * MiB, WS_CGV = 6 * MiB, WS_CCKV = 8 * MiB, WS_CKPE = 10 * MiB;
constexpr size_t WS_WIN = 11 * MiB;
constexpr size_t WS_WOUT = 34 * MiB;
constexpr size_t WS_WUQ = 42 * MiB;
constexpr size_t WS_WUKV = 43 * MiB + 256 * 1024;
constexpr size_t WS_XG = 44 * MiB;
constexpr size_t WS_KVM = 130 * MiB;
constexpr size_t WS_KVMC = 142 * MiB;
constexpr size_t WS_RQ = 60 * MiB, WS_RK = 64 * MiB, WS_RV = 68 * MiB;
constexpr size_t WS_GQ = 72 * MiB;
constexpr size_t WS_GK = 78 * MiB, WS_GV = 80 * MiB;
constexpr size_t WS_CQG = 82 * MiB;
constexpr size_t WS_CKVN = 86 * MiB;
constexpr size_t WS_KPEB = 88 * MiB;
constexpr size_t WS_ZS = 89 * MiB;
constexpr size_t WS_QM = 105 * MiB;
constexpr size_t WS_Y = 114 * MiB;
constexpr size_t WS_XSDBG = 130 * MiB;
constexpr size_t WS_XB = 146 * MiB;
constexpr size_t WS_OPT_END = 162 * MiB;
constexpr int CW_QUEUE = 1024;
constexpr int CW_FLAG = 2048;
constexpr int CW_YRDY = 1536;
constexpr int CW_XRDY = 1280;
constexpr int CW_RA = 8192;
constexpr int CW_FULL = 8704;
constexpr int CW_ZC = 9216;
constexpr int CW_KC = 9728;
constexpr int CW_XGR = 9856;
constexpr int CW_SD = 10368;
constexpr int CW_P1X = 10656;
constexpr int CW_P1B0 = 10784;
constexpr int CW_P1DONE = 10788;
constexpr int CW_BAR = 4096;

constexpr size_t O_STATE = 8388608, O_GK = 10485760, O_GV = 12582912, O_CKV = 14680064, O_KPE = 16777216;

constexpr int NWAVE = 8;
constexpr int GST = 49152;
constexpr int GST2 = 65536;
constexpr int LDS_OST = GST2;
constexpr int LDS_EX = 135168;
constexpr int LDS_EXB = 137216;
constexpr int LDS_SCAL = 141312;
constexpr int LDS_MISC = 142336;
constexpr int LDS_BYTES = 142592;

struct Params { const float* in[22]; float* out; unsigned char* ws; float* xs; int ph_lo, ph_hi; };
enum { I_XP = 0, I_XS, I_STATE, I_CGK, I_CGV, I_CCKV, I_CKPE, I_C, I_CCTX, I_NORMG, I_WADA, I_BADA, I_WIN, I_DECAY, I_GQN, I_GKN, I_MQN, I_MKVN, I_WUQ, I_WUKV, I_WOUT, I_FNORM };

#define XB_TMO      128
#define XB_XCNT(j)  (256  + 64 * (j))
#define XB_XSUB(j)  (1280 + 64 * (j))
#define XB_XGEN(j)  (2304 + 64 * (j))
#define XB_TOP      3328
#define XB_TOPGEN   3392
#define XB_SPIN_CAP (1u << 20)
__device__ __forceinline__ unsigned xb_ld(unsigned* p) { return __hip_atomic_load(p, __ATOMIC_RELAXED, __HIP_MEMORY_SCOPE_AGENT); }
__device__ __forceinline__ unsigned xb_add(unsigned* p, unsigned v) { return __hip_atomic_fetch_add(p, v, __ATOMIC_RELAXED, __HIP_MEMORY_SCOPE_AGENT); }
__device__ __forceinline__ unsigned xb_xcc_id() { return (unsigned)__builtin_amdgcn_s_getreg((3 << 11) | 20) & 0xFu; }
#define XB_SPIN(cond, bar) do { unsigned _sp = 0; while (cond) { __builtin_amdgcn_s_sleep(1); \
    if ((++_sp & 255u) == 0u) { if (xb_ld(&(bar)[XB_TMO])) break; if (_sp > XB_SPIN_CAP) { atomicAdd(&(bar)[XB_TMO], 1u); break; } } } } while (0)
__device__ __forceinline__ int lane_id() { int ln = (int)__builtin_amdgcn_mbcnt_hi(~0u, __builtin_amdgcn_mbcnt_lo(~0u, 0u)); asm volatile("" : "+v"(ln)); return ln; }
__device__ __forceinline__ void poll_lanes(unsigned* ptr, unsigned target, bool active, unsigned* bar0) {
    unsigned sp = 0u;
    for (;;) {
        unsigned v = target;
        if (active) v = xb_ld(ptr);
        if (!__any(v < target)) break;
        __builtin_amdgcn_s_sleep(1);
        if ((++sp & 255u) == 0u) { if (xb_ld(&bar0[XB_TMO])) break; if (sp > XB_SPIN_CAP) { atomicAdd(&bar0[XB_TMO], 1u); break; } }
    }
}
struct XcdBarrier { unsigned* bar; unsigned x; volatile LAS unsigned* st; int w; };
__device__ __forceinline__ XcdBarrier xcd_barrier_post(unsigned* bar, volatile LAS unsigned* st) {
    XcdBarrier b; b.bar = bar; b.x = xb_xcc_id(); b.st = st; b.w = 0;
    if (threadIdx.x == 0) (void)xb_add(&bar[XB_XCNT(b.x)], 1u);
    return b;
}
__device__ __forceinline__ void xcd_barrier_complete(unsigned* bar, unsigned x, unsigned& nloc, unsigned& nx) {
    const unsigned G = gridDim.x * gridDim.y * gridDim.z;
    unsigned sum, cnt, mine, sp = 0u;
    for (;;) {
        sum = 0u; cnt = 0u; mine = 0u;
#pragma unroll
        for (unsigned j = 0; j < 16; ++j) { const unsigned c = xb_ld(&bar[XB_XCNT(j)]); sum += c; cnt += (c > 0u) ? 1u : 0u; mine = (j == x) ? c : mine; }
        if (sum == G) break;
        __builtin_amdgcn_s_sleep(1);
        if ((++sp & 255u) == 0u) { if (xb_ld(&bar[XB_TMO])) break; if (sp > XB_SPIN_CAP) { atomicAdd(&bar[XB_TMO], 1u); break; } }
    }
    nloc = mine > 0u ? mine : 1u; nx = cnt > 0u ? cnt : 1u;
}
__device__ __forceinline__ void xcd_barrier(const XcdBarrier& b) {
    asm volatile("s_waitcnt vmcnt(0)" ::: "memory");
    __syncthreads();
    if (b.w == 0 && __builtin_amdgcn_mbcnt_hi(~0u, __builtin_amdgcn_mbcnt_lo(~0u, 0u)) == 0u) {
        unsigned* bar = b.bar;
        __builtin_amdgcn_s_waitcnt(0);
        unsigned nloc = b.st[0], nx = b.st[1];
        if (nloc == 0u) { xcd_barrier_complete(bar, b.x, nloc, nx); b.st[0] = nloc; b.st[1] = nx; }
        const unsigned old = xb_add(&bar[XB_XSUB(b.x)], 1u);
        const unsigned gen = old / nloc;
        if (old + 1u == (gen + 1u) * nloc) {
            __builtin_amdgcn_fence(__ATOMIC_RELEASE, "agent");
            asm volatile("s_waitcnt vmcnt(0)" ::: "memory");
            const unsigned og = xb_add(&bar[XB_TOP], 1u);
            const unsigned tg = og / nx;
            if (og + 1u == (tg + 1u) * nx) xb_add(&bar[XB_TOPGEN], 1u);
            else XB_SPIN(xb_ld(&bar[XB_TOPGEN]) == tg, bar);
            xb_add(&bar[XB_XGEN(b.x)], 1u);
            __builtin_amdgcn_fence(__ATOMIC_ACQUIRE, "agent");
            asm volatile("s_waitcnt vmcnt(0)" ::: "memory");
        } else {
            XB_SPIN(xb_ld(&bar[XB_XGEN(b.x)]) == gen, bar);
            __builtin_amdgcn_fence(__ATOMIC_ACQUIRE, "agent");
            asm volatile("s_waitcnt vmcnt(0)" ::: "memory");
        }
    }
    __syncthreads();
}

typedef const float* cfp_t;
typedef const __attribute__((address_space(4))) cfp_t* karg_t;
struct Frame {
    LAS unsigned char* lds;
    int tid, lane, w, h, lq;
    unsigned char* ws;
    karg_t karg;
};
__device__ __forceinline__ const float* pin(const Frame& F, int i) { return F.karg[i]; }
__device__ __forceinline__ bool is_t0(const Frame& F) { return F.w == 0 && __builtin_amdgcn_mbcnt_hi(~0u, __builtin_amdgcn_mbcnt_lo(~0u, 0u)) == 0u; }
#define GLDS16(gsrc, ldsdst) __builtin_amdgcn_global_load_lds((const unsigned*)(gsrc), (LAS unsigned*)(ldsdst), 16, 0, 0)
#define ST16_WT(ptr, val) asm volatile("global_store_dwordx4 %0, %1, off sc1\n\ts_nop 1" :: "v"(ptr), "v"(val) : "memory")
#define MFMA32(a, b, c) __builtin_amdgcn_mfma_f32_32x32x16_bf16((a), (b), (c), 0, 0, 0)

struct GemmOp { const bf16_t* W; const bf16_t* X; int ldw, ldx, K; };
__device__ __forceinline__ void gemm_issue0(const Frame& F, const GemmOp& g) {
    const int lane = F.lane, w = F.w;
#pragma unroll
    for (int q = 0; q < 2; ++q) { const int row = 16 * w + 8 * q + (lane >> 3); GLDS16(g.W + row * g.ldw + ((lane & 7) ^ ((row >> 1) & 7)) * 8, F.lds + (16 * w + 8 * q) * 128); }
#pragma unroll
    for (int q = 0; q < 4; ++q) { const int row = 32 * w + 8 * q + (lane >> 3); GLDS16(g.X + row * g.ldx + ((lane & 7) ^ ((row >> 1) & 7)) * 8, F.lds + 16384 + (32 * w + 8 * q) * 128); }
}
typedef f32x4 GemmAcc[4][4];
__device__ __forceinline__ void gemm_core(const Frame& F, const GemmOp& g, GemmAcc& acc, bool issue_first, bool has_next, const GemmOp& gn) {
    const int lane = F.lane, w = F.w;
    const bf16_t* __restrict__ W = g.W; const bf16_t* __restrict__ X = g.X;
    const int nkt = g.K >> 6;
    int offW[2], offX[4];
#pragma unroll
    for (int q = 0; q < 2; ++q) { const int row = 16 * w + 8 * q + (lane >> 3); offW[q] = row * g.ldw + ((lane & 7) ^ ((row >> 1) & 7)) * 8; }
#pragma unroll
    for (int q = 0; q < 4; ++q) { const int row = 32 * w + 8 * q + (lane >> 3); offX[q] = row * g.ldx + ((lane & 7) ^ ((row >> 1) & 7)) * 8; }
    LAS unsigned char* const dW = F.lds + (16 * w) * 128;
    LAS unsigned char* const dX = F.lds + 16384 + (32 * w) * 128;
#define GC_ISSUE(kt, st) do { _Pragma("unroll") for (int q = 0; q < 2; ++q) GLDS16(W + offW[q] + (kt) * 64, dW + (st) * GST + q * 1024); \
        _Pragma("unroll") for (int q = 0; q < 4; ++q) GLDS16(X + offX[q] + (kt) * 64, dX + (st) * GST + q * 1024); } while (0)
    const int wn = w & 1, wm = w >> 1, c15 = lane & 15, g4 = lane >> 4;
    const int sw = (c15 >> 1) & 7;
    int so[2];
#pragma unroll
    for (int s = 0; s < 2; ++s) so[s] = ((4 * s + g4) ^ sw) << 4;
    const int bn0 = (64 * wn + c15) * 128, bm0 = 16384 + (64 * wm + c15) * 128;
#pragma unroll
    for (int a = 0; a < 4; ++a)
#pragma unroll
        for (int b = 0; b < 4; ++b) acc[a][b] = (f32x4){0.f, 0.f, 0.f, 0.f};
    if (issue_first) GC_ISSUE(0, 0);
    asm volatile("s_waitcnt vmcnt(0)" ::: "memory");
    __syncthreads();
    for (int kt = 0; kt < nkt; ++kt) {
        const int st = kt & 1;
        if (kt + 1 < nkt) GC_ISSUE(kt + 1, st ^ 1);
        LAS unsigned char* const base = F.lds + st * GST;
#pragma unroll
        for (int s = 0; s < 2; ++s) {
            bf16x8 fa[4], fb[4];
#pragma unroll
            for (int q = 0; q < 4; ++q) { fa[q] = *(const LAS bf16x8*)(base + bn0 + q * 2048 + so[s]); fb[q] = *(const LAS bf16x8*)(base + bm0 + q * 2048 + so[s]); }
#pragma unroll
            for (int a = 0; a < 4; ++a)
#pragma unroll
                for (int b = 0; b < 4; ++b) acc[a][b] = __builtin_amdgcn_mfma_f32_16x16x32_bf16(fa[a], fb[b], acc[a][b], 0, 0, 0);
        }
        asm volatile("s_waitcnt vmcnt(0)" ::: "memory");
        __syncthreads();
    }
#undef GC_ISSUE
    if (has_next) gemm_issue0(F, gn);
}

typedef f32x4 GemmAcc8[4][8];
__device__ __forceinline__ void gemm256_issue0(const Frame& F, const bf16_t* W, const bf16_t* X) {
    int lane = F.lane; const int w = F.w;
    asm volatile("" : "+v"(lane));
#pragma unroll
    for (int q = 0; q < 4; ++q) {
        const int row = 32 * w + 8 * q + (lane >> 3), off = row * 1024 + ((lane & 7) ^ ((row >> 1) & 7)) * 8;
        GLDS16(W + off, F.lds + (32 * w + 8 * q) * 128);
        GLDS16(X + off, F.lds + 32768 + (32 * w + 8 * q) * 128);
    }
}
__device__ __forceinline__ void gemm_core256(const Frame& F, const bf16_t* __restrict__ W, const bf16_t* __restrict__ X, GemmAcc8& acc, bool issue_first, bool has_next, const bf16_t* Wn, const bf16_t* Xn) {
    int lane = F.lane; const int w = F.w;
    asm volatile("" : "+v"(lane));
    int off[4];
#pragma unroll
    for (int q = 0; q < 4; ++q) { const int row = 32 * w + 8 * q + (lane >> 3); off[q] = row * 1024 + ((lane & 7) ^ ((row >> 1) & 7)) * 8; }
    LAS unsigned char* const dW = F.lds + (32 * w) * 128;
    LAS unsigned char* const dX = F.lds + 32768 + (32 * w) * 128;
#define GC2_ISSUE(kt, st) do { _Pragma("unroll") for (int q = 0; q < 4; ++q) { GLDS16(W + off[q] + (kt) * 64, dW + (st) * GST2 + q * 1024); GLDS16(X + off[q] + (kt) * 64, dX + (st) * GST2 + q * 1024); } } while (0)
    const int wn4 = w & 3, wm2 = w >> 2, c15 = lane & 15, g4 = lane >> 4;
    const int sw = (c15 >> 1) & 7;
    int so[2];
#pragma unroll
    for (int s = 0; s < 2; ++s) so[s] = ((4 * s + g4) ^ sw) << 4;
    const int bn0 = (64 * wn4 + c15) * 128, bm0 = 32768 + (128 * wm2 + c15) * 128;
#pragma unroll
    for (int a = 0; a < 4; ++a)
#pragma unroll
        for (int b = 0; b < 8; ++b) acc[a][b] = (f32x4){0.f, 0.f, 0.f, 0.f};
    if (issue_first) GC2_ISSUE(0, 0);
    asm volatile("s_waitcnt vmcnt(0)" ::: "memory");
    __syncthreads();
    for (int kt = 0; kt < 16; ++kt) {
        const int st = kt & 1;
        if (kt + 1 < 16) GC2_ISSUE(kt + 1, st ^ 1);
        LAS unsigned char* const base = F.lds + st * GST2;
#pragma unroll
        for (int s = 0; s < 2; ++s) {
            bf16x8 fa[4];
#pragma unroll
            for (int q = 0; q < 4; ++q) fa[q] = *(const LAS bf16x8*)(base + bn0 + q * 2048 + so[s]);
#pragma unroll
            for (int hb = 0; hb < 2; ++hb) {
                bf16x8 fb[4];
#pragma unroll
                for (int q = 0; q < 4; ++q) fb[q] = *(const LAS bf16x8*)(base + bm0 + (4 * hb + q) * 2048 + so[s]);
#pragma unroll
                for (int a = 0; a < 4; ++a)
#pragma unroll
                    for (int b = 0; b < 4; ++b) acc[a][4 * hb + b] = __builtin_amdgcn_mfma_f32_16x16x32_bf16(fa[a], fb[b], acc[a][4 * hb + b], 0, 0, 0);
            }
        }
        asm volatile("s_waitcnt vmcnt(0)" ::: "memory");
        __syncthreads();
    }
#undef GC2_ISSUE
    if (has_next) gemm256_issue0(F, Wn, Xn);
}

__device__ __forceinline__ void rope64_16(float (&v)[4][4], float rowp, float colp, int g4) {
#pragma unroll
    for (int i = 0; i < 4; ++i) {
        const float fr = __builtin_amdgcn_exp2f((float)(4 * g4 + i) * -0.8304820237218406f) * 0.15915494309189535f;
#pragma unroll
        for (int c = 0; c < 2; ++c) {
            const float rev = (c ? colp : rowp) * fr;
            const float sn = __builtin_amdgcn_sinf(rev), cs = __builtin_amdgcn_cosf(rev);
            const float x0 = v[2 * c][i], x1 = v[2 * c + 1][i];
            v[2 * c][i] = x0 * cs - x1 * sn;
            v[2 * c + 1][i] = x1 * cs + x0 * sn;
        }
    }
}
__device__ __forceinline__ void rope32_16(float (&a)[4], float (&b)[4], float rowp, float colp, int g4) {
    const bool hi = g4 >= 2;
#pragma unroll
    for (int i = 0; i < 4; ++i) {
        const float fr = __builtin_amdgcn_exp2f((float)(4 * (g4 & 1) + i) * -1.6609640474436813f) * 0.15915494309189535f;
        {
            const float rev = rowp * fr;
            const float sn = __builtin_amdgcn_sinf(rev), cs = __builtin_amdgcn_cosf(rev);
            const float own = a[i], oth = __shfl_xor(own, 32);
            a[i] = own * cs + oth * (hi ? sn : -sn);
        }
        {
            const float rev = colp * fr;
            const float sn = __builtin_amdgcn_sinf(rev), cs = __builtin_amdgcn_cosf(rev);
            const float own = b[i], oth = __shfl_xor(own, 32);
            b[i] = own * cs + oth * (hi ? sn : -sn);
        }
    }
}
__device__ __forceinline__ float ssq64(const float (&v)[4][4]) {
    float s = 0.f;
#pragma unroll
    for (int nt = 0; nt < 4; ++nt)
#pragma unroll
        for (int i = 0; i < 4; ++i) s += v[nt][i] * v[nt][i];
    s += __shfl_xor(s, 16);
    s += __shfl_xor(s, 32);
    return s;
}
__device__ __forceinline__ void mulvec64(float (&v)[4][4], const LAS float* gv, int g4) {
#pragma unroll
    for (int nt = 0; nt < 4; ++nt) {
        const f32x4 q = *(const LAS f32x4*)(gv + 16 * nt + 4 * g4);
#pragma unroll
        for (int i = 0; i < 4; ++i) v[nt][i] *= q[i];
    }
}
constexpr int OST_LD = 68, OST_BYTES = 32 * OST_LD * 4;
__device__ __forceinline__ void stage_write16(LAS float* st, const float (&v)[4][4], int mh, int c15, int g4) {
    asm volatile("s_waitcnt lgkmcnt(0)" ::: "memory");
    __builtin_amdgcn_wave_barrier();
#pragma unroll
    for (int nt = 0; nt < 4; ++nt) {
        f32x4 o = {v[nt][0], v[nt][1], v[nt][2], v[nt][3]};
        *(LAS f32x4*)(st + (16 * mh + c15) * OST_LD + 16 * nt + 4 * g4) = o;
    }
    asm volatile("s_waitcnt lgkmcnt(0)" ::: "memory");
    __builtin_amdgcn_wave_barrier();
}
__device__ __forceinline__ void stage_write16a(LAS float* st, const f32x4 (&a)[4][4], int mt, int c15, int g4) {
    asm volatile("s_waitcnt lgkmcnt(0)" ::: "memory");
    __builtin_amdgcn_wave_barrier();
#pragma unroll
    for (int nt = 0; nt < 4; ++nt) *(LAS f32x4*)(st + (16 * (mt & 1) + c15) * OST_LD + 16 * nt + 4 * g4) = a[nt][mt];
    asm volatile("s_waitcnt lgkmcnt(0)" ::: "memory");
    __builtin_amdgcn_wave_barrier();
}
__device__ __forceinline__ void stage_store_bf16(const LAS float* st, bf16_t* dst, int ld, float sc, int lane) {
#pragma unroll 1
    for (int it = 0; it < 4; ++it) {
        const int row = it * 8 + (lane >> 3), c8 = (lane & 7) * 8;
        const f32x4 x0 = *(const LAS f32x4*)(st + row * OST_LD + c8), x1 = *(const LAS f32x4*)(st + row * OST_LD + c8 + 4);
        u32x4 o; o.x = pk2(x0[0] * sc, x0[1] * sc); o.y = pk2(x0[2] * sc, x0[3] * sc); o.z = pk2(x1[0] * sc, x1[1] * sc); o.w = pk2(x1[2] * sc, x1[3] * sc);
        ST16_WT(dst + (size_t)row * ld + c8, o);
    }
}
__device__ __forceinline__ void stage_store_bf16_sc1(const LAS float* st, bf16_t* dst, int ld, int lane) {
#pragma unroll 1
    for (int it = 0; it < 4; ++it) {
        const int row = it * 8 + (lane >> 3), c8 = (lane & 7) * 8;
        const f32x4 x0 = *(const LAS f32x4*)(st + row * OST_LD + c8), x1 = *(const LAS f32x4*)(st + row * OST_LD + c8 + 4);
        u32x4 o; o.x = pk2(x0[0], x0[1]); o.y = pk2(x0[2], x0[3]); o.z = pk2(x1[0], x1[1]); o.w = pk2(x1[2], x1[3]);
        bf16_t* ptr = dst + (size_t)row * ld + c8;
        asm volatile("global_store_dwordx4 %0, %1, off sc1\n\ts_nop 1" :: "v"(ptr), "v"(o) : "memory");
    }
}
__device__ __forceinline__ void stage_store_f32(const LAS float* st, float* dst, int ld, int lane) {
#pragma unroll 1
    for (int it = 0; it < 8; ++it) {
        const int row = it * 4 + (lane >> 4), c = (lane & 15) * 4;
        { const f32x4 o = *(const LAS f32x4*)(st + row * OST_LD + c); ST16_WT(dst + (size_t)row * ld + c, o); }
    }
}
__device__ __forceinline__ void stage_store_bf16_32(const LAS float* st, bf16_t* dst, int ld, int lane) {
#pragma unroll 1
    for (int it = 0; it < 2; ++it) {
        const int row = it * 16 + (lane >> 2), c8 = (lane & 3) * 8;
        const f32x4 x0 = *(const LAS f32x4*)(st + row * OST_LD + c8), x1 = *(const LAS f32x4*)(st + row * OST_LD + c8 + 4);
        u32x4 o; o.x = pk2(x0[0], x0[1]); o.y = pk2(x0[2], x0[3]); o.z = pk2(x1[0], x1[1]); o.w = pk2(x1[2], x1[3]);
        ST16_WT(dst + (size_t)row * ld + c8, o);
    }
}
__device__ __forceinline__ void stage_store_f32_32(const LAS float* st, float* dst, int ld, int lane) {
#pragma unroll 1
    for (int it = 0; it < 4; ++it) {
        const int row = it * 8 + (lane >> 3), c = (lane & 7) * 4;
        { const f32x4 o = *(const LAS f32x4*)(st + row * OST_LD + c); ST16_WT(dst + (size_t)row * ld + c, o); }
    }
}

struct Gemm1Pre { float rstd[2]; float bias, gain; };
__device__ __forceinline__ void gemm1_pre(const Frame& F, const Params& p, int tn, int wn, int tm, int l, Gemm1Pre& P) {
    const float* ssqp = (const float*)(F.ws + WS_SSQ);
#pragma unroll
    for (int jj = 0; jj < 2; ++jj) {
        const int tok = tm * 256 + (F.w >> 2) * 128 + 64 * jj + F.lane;
        const f32x4* sp = (const f32x4*)(ssqp + (size_t)tok * 16);
        float ss = 0.f;
#pragma unroll
        for (int i = 0; i < 4; ++i) { const f32x4 q = sp[i]; ss += (q[0] + q[1]) + (q[2] + q[3]); }
        P.rstd[jj] = rsqrtf(ss * (1.f / 1024.f) + EPS);
    }
    const bool lat = tm >= 16;
    const int cond = lat ? 1 + ((tm - 16) >> 2) : 0;
    const int nb = tn * 128 + wn * 64;
    P.bias = (tn < 23) ? ((const float*)(F.ws + WS_BIAS))[(size_t)(l * 5 + cond) * 2944 + nb + F.lane] : 0.f;
    const float* gp = nullptr;
    if (tn >= 6 && tn < 9) gp = pin(F, I_GQN) + l * 64;
    else if (tn == 9) gp = pin(F, I_GKN) + l * 64;
    else if (tn == 11 || tn == 12) gp = pin(F, I_MQN) + l * 256 + (nb - 1408);
    else if (tn == 13) gp = pin(F, I_MKVN) + l * 128 + wn * 64;
    P.gain = gp ? gp[F.lane] : 1.f;
}
__device__ __forceinline__ void epi_gemm1(const Frame& F, const Params& p, GemmAcc8& acc, int tn, int wn, int tm, int l, const Gemm1Pre& P, bool ckv_tile) {
    int lane = F.lane; const int wm = F.w >> 2;
    asm volatile("" : "+v"(lane));
    const int c15 = lane & 15, g4 = lane >> 4;
    unsigned char* ws = F.ws;
    asm volatile("" : "+s"(ws));
    LAS float* st = (LAS float*)(F.lds + LDS_OST + F.w * OST_BYTES);
    const bool lat = tm >= 16;
    const int b = lat ? ((tm - 16) >> 2) : tm;
    const int nb = tn * 128 + wn * 64;
    LAS float* exb = (LAS float*)(F.lds + LDS_EXB) + F.w * 128;
    exb[lane] = P.bias; exb[64 + lane] = P.gain;
    asm volatile("s_waitcnt lgkmcnt(0)" ::: "memory");
    __builtin_amdgcn_wave_barrier();
    const LAS float* bias = exb;
    float* outp = p.out;
    asm volatile("" : "+s"(outp));
    float ckv_ss[8];
    if (tn < 23) {
#pragma unroll
    for (int mt = 0; mt < 8; ++mt) {
        const int mh = mt & 1;
        const int tok0 = tm * 256 + wm * 128 + (mt >> 1) * 32;
        const int tokb = tok0 + 16 * mh, tok = tokb + c15;
        const int t0 = lat ? ((tok0 - 4096) & 1023) : (tok0 & 255), t = t0 + 16 * mh + c15;
        const float rstd = __shfl(P.rstd[mt >> 2], 16 * (mt & 3) + c15);
        float v[4][4];
#pragma unroll
        for (int nt = 0; nt < 4; ++nt) {
            const f32x4 bq = *(const LAS f32x4*)(bias + 16 * nt + 4 * g4);
#pragma unroll
            for (int i = 0; i < 4; ++i) v[nt][i] = acc[nt][mt][i] * rstd + bq[i];
        }
        const float rowp = (float)(t >> 6), colp = (float)(t & 63);
        const size_t orow0 = (size_t)(b * 4 + l) * 256 + t0;
        if (tn < 2) {
            if (lat) rope64_16(v, rowp, colp, g4);
            stage_write16(st, v, mh, c15, g4);
            if (mh) stage_store_bf16(st, (bf16_t*)(ws + WS_RQ) + (size_t)tok0 * 256 + nb, 256, 1.f, lane);
        } else if (tn < 4) {
            if (lat) rope64_16(v, rowp, colp, g4);
            stage_write16(st, v, mh, c15, g4);
            if (mh) stage_store_bf16(st, (bf16_t*)(ws + WS_RK) + (size_t)tok0 * 256 + (nb - 256), 256, 0.125f, lane);
        } else if (tn < 6) {
            stage_write16(st, v, mh, c15, g4);
            if (mh) stage_store_bf16(st, (bf16_t*)(ws + WS_RV) + (size_t)tok0 * 256 + (nb - 512), 256, 1.f, lane);
        } else if (tn < 9) {
            const float r = rsqrtf(ssq64(v) * (1.f / 64.f) + EPS);
#pragma unroll
            for (int nt = 0; nt < 4; ++nt)
#pragma unroll
                for (int i = 0; i < 4; ++i) v[nt][i] *= r;
            mulvec64(v, exb + 64, g4);
            if (lat) rope64_16(v, rowp, colp, g4);
            stage_write16(st, v, mh, c15, g4);
            if (mh) stage_store_bf16(st, (bf16_t*)(ws + WS_GQ) + (size_t)tok0 * 384 + (nb - 768), 384, QSC_GQA, lane);
        } else if (tn == 9) {
            const float r = rsqrtf(ssq64(v) * (1.f / 64.f) + EPS);
#pragma unroll
            for (int nt = 0; nt < 4; ++nt)
#pragma unroll
                for (int i = 0; i < 4; ++i) v[nt][i] *= r;
            mulvec64(v, exb + 64, g4);
            if (lat) rope64_16(v, rowp, colp, g4);
            stage_write16(st, v, mh, c15, g4);
            if (mh) {
                if (!lat) stage_store_f32(st, outp + O_GK + orow0 * 128 + (nb - 1152), 128, lane);
                stage_store_bf16(st, (bf16_t*)(ws + WS_GK) + (size_t)tok0 * 128 + (nb - 1152), 128, 1.f, lane);
            }
        } else if (tn == 10) {
            stage_write16(st, v, mh, c15, g4);
            if (mh) {
                if (!lat) stage_store_f32(st, outp + O_GV + orow0 * 128 + (nb - 1280), 128, lane);
                stage_store_bf16(st, (bf16_t*)(ws + WS_GV) + (size_t)tok0 * 128 + (nb - 1280), 128, 1.f, lane);
            }
        } else if (tn < 13) {
            const float s2 = ssq64(v);
            if (g4 == 0) __hip_atomic_store((__attribute__((address_space(1))) float*)((float*)(ws + WS_CQSSQ) + (size_t)tok * 4 + ((nb - 1408) >> 6)), s2, __ATOMIC_RELAXED, __HIP_MEMORY_SCOPE_AGENT);
            mulvec64(v, exb + 64, g4);
            stage_write16(st, v, mh, c15, g4);
            if (mh) stage_store_bf16_sc1(st, (bf16_t*)(ws + WS_CQG) + (size_t)tok0 * 256 + (nb - 1408), 256, lane);
        } else if (tn == 13) {
            ckv_ss[mt] = ssq64(v);
            if (g4 == 0) ((LAS float*)(F.lds + LDS_EX))[(wm * 2 + wn) * 128 + mt * 16 + c15] = ckv_ss[mt];
        } else if (tn < 22) {
#pragma unroll
            for (int nt = 0; nt < 4; ++nt)
#pragma unroll
                for (int i = 0; i < 4; ++i) v[nt][i] = silu_f(v[nt][i]);
            stage_write16(st, v, mh, c15, g4);
            if (mh) stage_store_bf16(st, (bf16_t*)(ws + WS_ZS) + (size_t)tok0 * 1024 + (nb - 1792), 1024, 1.f, lane);
        } else {
            if (wn == 0) {
                if (lat) rope32_16(v[0], v[1], rowp, colp, g4);
                stage_write16(st, v, mh, c15, g4);
                if (mh) {
                    if (!lat) stage_store_f32_32(st, outp + O_KPE + orow0 * 32, 32, lane);
                    stage_store_bf16_32(st, (bf16_t*)(ws + WS_KPEB) + (size_t)tok0 * 32, 32, lane);
                }
            }
        }
    }
    }
    if (ckv_tile) {
        __syncthreads();
        if (tn == 13) {
#pragma unroll
        for (int mt = 0; mt < 8; ++mt) {
            const int mh = mt & 1;
            const int tok0 = tm * 256 + wm * 128 + (mt >> 1) * 32;
            const int t0 = lat ? ((tok0 - 4096) & 1023) : (tok0 & 255);
            const float rstd = __shfl(P.rstd[mt >> 2], 16 * (mt & 3) + c15);
            float v[4][4];
#pragma unroll
            for (int nt = 0; nt < 4; ++nt) {
                const f32x4 bq = *(const LAS f32x4*)(bias + 16 * nt + 4 * g4);
#pragma unroll
                for (int i = 0; i < 4; ++i) v[nt][i] = acc[nt][mt][i] * rstd + bq[i];
            }
            const float tot = ckv_ss[mt] + ((const LAS float*)(F.lds + LDS_EX))[(wm * 2 + (wn ^ 1)) * 128 + mt * 16 + c15];
            const float r = rsqrtf(tot * (1.f / 128.f) + EPS);
#pragma unroll
            for (int nt = 0; nt < 4; ++nt)
#pragma unroll
                for (int i = 0; i < 4; ++i) v[nt][i] *= r;
            mulvec64(v, exb + 64, g4);
            const size_t orow0 = (size_t)(b * 4 + l) * 256 + t0;
            stage_write16(st, v, mh, c15, g4);
            if (mh) {
                if (!lat) stage_store_f32(st, outp + O_CKV + orow0 * 128 + wn * 64, 128, lane);
                stage_store_bf16_sc1(st, (bf16_t*)(ws + WS_CKVN) + (size_t)tok0 * 128 + wn * 64, 128, lane);
            }
        }
        }
        __syncthreads();
    }
}

__device__ __forceinline__ void qm_pre(const Frame& F, int tm, float& rstd) {
    const int tok = tm * 256 + (F.w >> 1) * 64 + F.lane;
    const f32x4 q4 = *(const f32x4*)((const float*)(F.ws + WS_CQSSQ) + (size_t)tok * 4);
    rstd = rsqrtf(((q4[0] + q4[1]) + (q4[2] + q4[3])) * (1.f / 256.f) + EPS);
}
__device__ __forceinline__ void epi_qm(const Frame& F, GemmAcc& acc, int tn, int tm, float rstdl) {
    int lane = F.lane; const int wn = F.w & 1, wm = F.w >> 1;
    asm volatile("" : "+v"(lane));
    const int c15 = lane & 15, g4 = lane >> 4;
    unsigned char* ws = F.ws;
    LAS float* st = (LAS float*)(F.lds + LDS_OST + F.w * OST_BYTES);
    const bool lat = tm >= 16;
    const int nb = tn * 128 + wn * 64;
    if (nb >= 576) return;
#pragma unroll
    for (int mt = 0; mt < 4; ++mt) {
        const int mh = mt & 1;
        const int tok0 = tm * 256 + wm * 64 + (mt >> 1) * 32, tok = tok0 + 16 * mh + c15;
        const int t = lat ? ((tok - 4096) & 1023) : (tok & 255);
        const float rstd = __shfl(rstdl, 16 * mt + c15);
        const float rowp = (float)(t >> 6), colp = (float)(t & 63);
        float v[4][4];
#pragma unroll
        for (int nt = 0; nt < 4; ++nt)
#pragma unroll
            for (int i = 0; i < 4; ++i) v[nt][i] = acc[nt][mt][i] * rstd;
#pragma unroll
        for (int q = 0; q < 2; ++q) {
            const int T = (nb + 32 * q) >> 5;
            if (lat && (T % 3) == 2) rope32_16(v[2 * q], v[2 * q + 1], rowp, colp, g4);
        }
        stage_write16(st, v, mh, c15, g4);
        if (mh) stage_store_bf16(st, (bf16_t*)(ws + WS_QM) + (size_t)tok0 * 576 + nb, 576, QSC_MLA, lane);
    }
}
__device__ __forceinline__ void epi_plain(const Frame& F, GemmAcc& acc, bf16_t* D, int ldd, int row0, int n0) {
    int lane = F.lane; const int wn = F.w & 1, wm = F.w >> 1;
    asm volatile("" : "+v"(lane));
    const int c15 = lane & 15, g4 = lane >> 4;
    LAS float* st = (LAS float*)(F.lds + LDS_OST + F.w * OST_BYTES);
#pragma unroll
    for (int mt = 0; mt < 4; ++mt) {
        const int r0 = row0 + wm * 64 + (mt >> 1) * 32;
        stage_write16a(st, acc, mt, c15, g4);
        if (mt & 1) stage_store_bf16(st, D + (size_t)r0 * ldd + n0 + wn * 64, ldd, 1.f, lane);
    }
}

struct Gemm2Pre { f32x4 gt0, gt1, gs0, gs1; };
__device__ __forceinline__ void gemm2_pre(const Frame& F, int tn, int tm, int l, Gemm2Pre& P) {
    const bool lat = tm >= 16; const int cond = lat ? 1 + ((tm - 16) >> 2) : 0;
    const int nb = tn * 128 + (F.w & 1) * 64, c8 = (F.lane & 7) * 8;
    const float* gtp = (const float*)(F.ws + WS_MODS) + (size_t)(l * 5 + cond) * 3072 + 2048 + nb + c8;
    const float* gsp = (const float*)(F.ws + WS_GS) + (size_t)((l < 3 ? l + 1 : 3) * 5 + cond) * 1024 + nb + c8;
    P.gt0 = *(const f32x4*)gtp; P.gt1 = *(const f32x4*)(gtp + 4);
    P.gs0 = *(const f32x4*)gsp; P.gs1 = *(const f32x4*)(gsp + 4);
}
__device__ __forceinline__ void epi_gemm2(const Frame& F, const Params& p, GemmAcc& acc, int tn, int tm, int l, const Gemm2Pre& P, bool last) {
    int lane = F.lane; const int wn = F.w & 1, wm = F.w >> 1;
    asm volatile("" : "+v"(lane));
    const int c15 = lane & 15, g4 = lane >> 4;
    unsigned char* ws = F.ws;
    LAS float* st = (LAS float*)(F.lds + LDS_OST + F.w * OST_BYTES);
    const bool lat = tm >= 16;
    const int nb = tn * 128 + wn * 64;
    const int c8 = (lane & 7) * 8, r8 = lane >> 3;
#pragma unroll
    for (int mt = 0; mt < 2; ++mt) {
        const int tok0 = tm * 256 + wm * 64 + mt * 32;
        stage_write16a(st, acc, 2 * mt, c15, g4);
        stage_write16a(st, acc, 2 * mt + 1, c15, g4);
        bf16_t* xb0 = (bf16_t*)(ws + WS_XB) + (size_t)tok0 * 1024 + nb + c8;
        f32x4 xo8[8];
        if (l == 0) {
            const float* xold0 = lat ? pin(F, I_XS) + (size_t)(tok0 - 4096) * 1024 : pin(F, I_XP) + (size_t)tok0 * 1024;
#pragma unroll
            for (int it = 0; it < 4; ++it) {
                const float* xp = xold0 + (size_t)(it * 8 + r8) * 1024 + nb + c8;
                xo8[2 * it] = *(const f32x4*)xp; xo8[2 * it + 1] = *(const f32x4*)(xp + 4);
            }
        } else {
#pragma unroll
            for (int it = 0; it < 4; ++it) {
                const u32x4 q = *(const u32x4*)(xb0 + (size_t)(it * 8 + r8) * 1024);
                xo8[2 * it] = (f32x4){bflo(q.x), bfhi(q.x), bflo(q.y), bfhi(q.y)}; xo8[2 * it + 1] = (f32x4){bflo(q.z), bfhi(q.z), bflo(q.w), bfhi(q.w)};
            }
        }
#pragma unroll
        for (int it = 0; it < 4; ++it) {
            const int row = it * 8 + r8;
            const f32x4 a0 = *(const LAS f32x4*)(st + row * OST_LD + c8), a1 = *(const LAS f32x4*)(st + row * OST_LD + c8 + 4);
            const f32x4 xn0 = xo8[2 * it] + P.gt0 * a0, xn1 = xo8[2 * it + 1] + P.gt1 * a1;
            {
                u32x4 o; o.x = pk2(xn0[0], xn0[1]); o.y = pk2(xn0[2], xn0[3]); o.z = pk2(xn1[0], xn1[1]); o.w = pk2(xn1[2], xn1[3]);
                if (last) ST16_WT(xb0 + (size_t)row * 1024, o); else *(u32x4*)(xb0 + (size_t)row * 1024) = o;
            }
            float ss = ((xn0[0] * xn0[0] + xn0[1] * xn0[1]) + (xn0[2] * xn0[2] + xn0[3] * xn0[3])) + ((xn1[0] * xn1[0] + xn1[1] * xn1[1]) + (xn1[2] * xn1[2] + xn1[3] * xn1[3]));
            ss += __shfl_xor(ss, 1); ss += __shfl_xor(ss, 2); ss += __shfl_xor(ss, 4);
            if ((lane & 7) == 0) {
                float* sq = (float*)(ws + WS_SSQ) + (size_t)(tok0 + row) * 16 + tn * 2 + wn;
                __hip_atomic_store((__attribute__((address_space(1))) float*)sq, ss, __ATOMIC_RELAXED, __HIP_MEMORY_SCOPE_AGENT);
            }
            if (l < 3) {
                u32x4 o; o.x = pk2(xn0[0] * P.gs0[0], xn0[1] * P.gs0[1]); o.y = pk2(xn0[2] * P.gs0[2], xn0[3] * P.gs0[3]);
                o.z = pk2(xn1[0] * P.gs1[0], xn1[1] * P.gs1[1]); o.w = pk2(xn1[2] * P.gs1[2], xn1[3] * P.gs1[3]);
                ST16_WT((bf16_t*)(ws + WS_XG) + (size_t)(tok0 + row) * 1024 + nb + c8, o);
            }
        }
    }
}
constexpr int AT_STG = 20480, AT_PE = 8192, AT_V = 12288, AT_OLD = 68;
struct AttnUnit {
    int mode;
    int nt0, nt1;
    const bf16_t *q; int q_ld;
    const bf16_t *k0, *k1; int k_ld0, k_ld1;
    const bf16_t *pe0, *pe1;
    const bf16_t *v0, *v1; int v_ld0, v_ld1;
    int tok0;
    int ycol;
    int qpos0, L;
    float lf, lb;
    const bf16_t *s0f, *s0b;
    unsigned* zflag;
    unsigned* yflag;
    float* st_out;
};
__device__ __forceinline__ s16x4 tr16(LAS const unsigned char* p) {
    typedef short v4i16_t __attribute__((ext_vector_type(4)));
    return __builtin_bit_cast(s16x4, __builtin_amdgcn_ds_read_tr16_b64_v4i16((LAS v4i16_t*)p));
}

template <int MODE>
__device__ __forceinline__ void attn_unit(const Frame& F, const Params& p, const AttnUnit& U) {
    constexpr int NQS = MODE == 1 ? 6 : 4;
    int lane = F.lane; const int w = F.w;
    asm volatile("" : "+v"(lane));
    const int h = lane >> 5, lq = lane & 31;
    LAS unsigned char* lds = F.lds;
    const int k_ld = U.k_ld1, v_ld = U.v_ld1;
    const int krow = 8 * w + (lane >> 3);
    const int koff = krow * k_ld + ((lane & 7) ^ ((krow >> 1) & 7)) * 8;
    const int poff = (16 * (w & 3) + (lane >> 2)) * 32 + ((lane & 3) ^ ((lane >> 4) & 3)) * 8;
    const int vdblk = w >> 2, vkg = w & 3;
    const int voff = (16 * vkg + (lane >> 2)) * v_ld + vdblk * 32 + (lane & 3) * 8;
    const int vdst = AT_V + vdblk * 4096 + vkg * 1024;
    const int nt0 = U.nt0, ntot = U.nt0 + U.nt1;
    const unsigned ldsb = (unsigned)(uintptr_t)lds;
#define AT_DMA(gsrc, ldsoff) do { unsigned _keep; const unsigned _d = (unsigned)__builtin_amdgcn_readfirstlane((int)(ldsb + (unsigned)(ldsoff))); \
        asm volatile("s_mov_b32 %0, m0\n\ts_mov_b32 m0, %2\n\ts_nop 0\n\tglobal_load_lds_dwordx4 %1, off\n\ts_mov_b32 m0, %0" : "=&s"(_keep) : "v"(gsrc), "s"(_d) : "memory"); } while (0)
#define AT_ISSUE(t, st) do { const int _t = (t); const int _b = (st) * AT_STG; \
        const bool _s0 = _t < nt0; const int _u = _s0 ? _t : _t - nt0; \
        const bf16_t* _kb = (_s0 ? U.k0 : U.k1) + (size_t)_u * 64 * k_ld; const bf16_t* _vb = (_s0 ? U.v0 : U.v1) + (size_t)_u * 64 * v_ld; \
        AT_DMA(_kb + koff, _b + (8 * w) * 128); \
        if (MODE == 1) { const bf16_t* _pb = (_s0 ? U.pe0 : U.pe1) + (size_t)_u * 64 * 32; AT_DMA(_pb + poff, _b + AT_PE + 16 * (w & 3) * 64); } \
        AT_DMA(_vb + voff, _b + vdst); } while (0)
    AT_ISSUE(0, 0);
    if (ntot > 1) AT_ISSUE(1, 1);
    bf16x8 qr[NQS];
    if (MODE == 3) {
        const int dk = 32 * (w & 1) + lq;
#pragma unroll
        for (int s = 0; s < 4; ++s)
#pragma unroll
            for (int j = 0; j < 8; ++j) qr[s][j] = (16 * s + 8 * h + j == dk) ? (short)0x3F80 : (short)0;
    } else {
        const bf16_t* qp = U.q + (size_t)(32 * w + lq) * U.q_ld + 8 * h;
#pragma unroll
        for (int s = 0; s < NQS; ++s) qr[s] = *(const bf16x8*)(qp + 16 * s);
    }
    f32x16 o[2];
#pragma unroll
    for (int d = 0; d < 2; ++d)
#pragma unroll
        for (int r = 0; r < 16; ++r) o[d][r] = 0.f;
    float m_run = 0.f, l_run = 0.f;
    f32x16 negm;
#pragma unroll
    for (int r = 0; r < 16; ++r) negm[r] = 0.f;
    const int qpos = U.qpos0 + 32 * w + lq;
    const float st_slope = ((w >> 1) & 1) ? U.lb : -U.lf, st_off = ((w >> 1) & 1) ? 0.f : 255.f * U.lf;
    const int sdir = (w >> 1) & 1;
    LAS float* scal = (LAS float*)(lds + LDS_SCAL) + w * 32;
    LAS float* ctab = (LAS float*)(lds + LDS_EXB) + w * 128;
    float a_f = 0.f, a_b = 0.f;
    if (MODE == 2) {
        ctab[lane] = __builtin_amdgcn_exp2f((float)(63 - lane) * U.lf);
        ctab[64 + lane] = __builtin_amdgcn_exp2f((float)lane * U.lb);
        a_f = __builtin_amdgcn_exp2f((float)(32 * w + lq) * U.lf);
        a_b = __builtin_amdgcn_exp2f((float)(255 - 32 * w - lq) * U.lb);
        asm volatile("s_waitcnt lgkmcnt(0)" ::: "memory");
        __builtin_amdgcn_wave_barrier();
    }
    const int kfo = lq * 128, sw = (lane >> 1) & 7, pfo = AT_PE + lq * 64, psw = (lane >> 2) & 3;
    const int vfo = AT_V + (4 * h + ((lane & 15) >> 2)) * 64 + ((lane >> 4) & 1) * 32 + (lane & 3) * 8;
    int st = 0;
    for (int t = 0; t < ntot; ++t) {
        if (t + 1 < ntot) { if (MODE == 1) asm volatile("s_waitcnt vmcnt(3)" ::: "memory"); else asm volatile("s_waitcnt vmcnt(2)" ::: "memory"); }
        else asm volatile("s_waitcnt vmcnt(0)" ::: "memory");
        __builtin_amdgcn_s_barrier();
        asm volatile("" ::: "memory");
        const int st2 = st == 0 ? 2 : st - 1;
        if (t + 2 < ntot) AT_ISSUE(t + 2, st2);
        LAS const unsigned char* base = lds + st * AT_STG;
        bf16x8 kfa[NQS], kfb[NQS];
#pragma unroll
        for (int s = 0; s < 4; ++s) {
            const int so = ((2 * s + h) ^ sw) << 4;
            kfa[s] = *(const LAS bf16x8*)(base + kfo + so);
            kfb[s] = *(const LAS bf16x8*)(base + kfo + 4096 + so);
        }
        if (MODE == 1) {
#pragma unroll
            for (int s = 0; s < 2; ++s) {
                const int so = ((2 * s + h) ^ psw) << 4;
                kfa[4 + s] = *(const LAS bf16x8*)(base + pfo + so);
                kfb[4 + s] = *(const LAS bf16x8*)(base + pfo + 2048 + so);
            }
        }
        f32x16 p0, p1;
        if (MODE <= 1) { p0 = negm; p1 = negm; }
        else {
#pragma unroll
            for (int r = 0; r < 16; ++r) { p0[r] = 0.f; p1[r] = 0.f; }
        }
#pragma unroll
        for (int s = 0; s < NQS; ++s) { p0 = MFMA32(kfa[s], qr[s], p0); p1 = MFMA32(kfb[s], qr[s], p1); }
        s16x4 vlo[4], vhi[4];
#pragma unroll
        for (int ks = 0; ks < 4; ++ks) { vlo[ks] = tr16(base + vfo + ks * 1024); vhi[ks] = tr16(base + vfo + ks * 1024 + 512); }
        if (MODE <= 1) {
            float tm = p0[0];
#pragma unroll
            for (int r = 1; r < 16; ++r) tm = fmaxf(tm, p0[r]);
#pragma unroll
            for (int r = 0; r < 16; ++r) tm = fmaxf(tm, p1[r]);
            tm = fmaxf(tm, __shfl_xor(tm, 32));
            if (t == 0 || __any(tm > 6.0f)) {
                const float dl = t == 0 ? tm : fmaxf(tm, 0.f);
                m_run += dl;
#pragma unroll
                for (int r = 0; r < 16; ++r) { p0[r] -= dl; p1[r] -= dl; negm[r] = -m_run; }
                if (t > 0) {
                    const float alpha = __builtin_amdgcn_exp2f(-dl);
                    l_run *= alpha;
                    if (h == 0) scal[lq] = alpha;
                    asm volatile("s_waitcnt lgkmcnt(0)" ::: "memory");
#pragma unroll
                    for (int g = 0; g < 4; ++g) {
                        const f32x4 a4 = *(const LAS f32x4*)(scal + 8 * g + 4 * h);
#pragma unroll
                        for (int i = 0; i < 4; ++i) { o[0][4 * g + i] *= a4[i]; o[1][4 * g + i] *= a4[i]; }
                    }
                }
            }
            float ls = 0.f;
#pragma unroll
            for (int r = 0; r < 16; ++r) { p0[r] = __builtin_amdgcn_exp2f(p0[r]); p1[r] = __builtin_amdgcn_exp2f(p1[r]); ls += p0[r] + p1[r]; }
            l_run += ls;
        } else if (MODE == 2 && (64 * t + 63 < U.qpos0 || 64 * t > U.qpos0 + 255)) {
            const bool fwd = 64 * t + 63 < U.qpos0;
            const float A = fwd ? a_f * __builtin_amdgcn_exp2f((float)(U.qpos0 - 64 * t - 63) * U.lf) : a_b * __builtin_amdgcn_exp2f((float)(64 * t - U.qpos0 - 255) * U.lb);
            const LAS float* tb = ctab + (fwd ? 0 : 64) + 4 * h;
#pragma unroll
            for (int g = 0; g < 4; ++g) {
                const f32x4 c0 = *(const LAS f32x4*)(tb + 8 * g), c1 = *(const LAS f32x4*)(tb + 32 + 8 * g);
#pragma unroll
                for (int i = 0; i < 4; ++i) { p0[4 * g + i] *= c0[i] * A; p1[4 * g + i] *= c1[i] * A; }
            }
        } else if (MODE == 2) {
            float dq = (float)(qpos - 64 * t - 4 * h);
            asm volatile("" : "+v"(dq));
#pragma unroll
            for (int r = 0; r < 16; ++r) {
                const float d0 = dq - (float)((r & 3) + 8 * (r >> 2)), d1 = d0 - 32.f;
                const float w0 = __builtin_amdgcn_exp2f(fabsf(d0) * (d0 > 0.f ? U.lf : U.lb));
                const float w1 = __builtin_amdgcn_exp2f(fabsf(d1) * (d1 > 0.f ? U.lf : U.lb));
                p0[r] *= (d0 == 0.f ? 2.f : w0);
                p1[r] *= (d1 == 0.f ? 2.f : w1);
            }
        } else {
            float mb = (float)(64 * t + 4 * h);
            asm volatile("" : "+v"(mb));
#pragma unroll
            for (int r = 0; r < 16; ++r) {
                const float m0 = mb + (float)((r & 3) + 8 * (r >> 2)), m1 = m0 + 32.f;
                const float e0 = fmaf(m0, st_slope, st_off), e1 = fmaf(m1, st_slope, st_off);
                p0[r] *= __builtin_amdgcn_exp2f(e0);
                p1[r] *= __builtin_amdgcn_exp2f(e1);
            }
        }
        bf16x8 pa[4];
        { u32x4 a;
          a.x = pk2(p0[0], p0[1]); a.y = pk2(p0[2], p0[3]); a.z = pk2(p0[4], p0[5]); a.w = pk2(p0[6], p0[7]); pa[0] = __builtin_bit_cast(bf16x8, a);
          a.x = pk2(p0[8], p0[9]); a.y = pk2(p0[10], p0[11]); a.z = pk2(p0[12], p0[13]); a.w = pk2(p0[14], p0[15]); pa[1] = __builtin_bit_cast(bf16x8, a);
          a.x = pk2(p1[0], p1[1]); a.y = pk2(p1[2], p1[3]); a.z = pk2(p1[4], p1[5]); a.w = pk2(p1[6], p1[7]); pa[2] = __builtin_bit_cast(bf16x8, a);
          a.x = pk2(p1[8], p1[9]); a.y = pk2(p1[10], p1[11]); a.z = pk2(p1[12], p1[13]); a.w = pk2(p1[14], p1[15]); pa[3] = __builtin_bit_cast(bf16x8, a); }
#pragma unroll
        for (int ks = 0; ks < 4; ++ks) {
            const bf16x8 vb = __builtin_shufflevector(vlo[ks], vhi[ks], 0, 1, 2, 3, 4, 5, 6, 7);
            o[0] = MFMA32(pa[ks], vb, o[0]);
        }
#pragma unroll
        for (int ks = 0; ks < 4; ++ks) { vlo[ks] = tr16(base + vfo + 4096 + ks * 1024); vhi[ks] = tr16(base + vfo + 4096 + ks * 1024 + 512); }
#pragma unroll
        for (int ks = 0; ks < 4; ++ks) {
            const bf16x8 vb = __builtin_shufflevector(vlo[ks], vhi[ks], 0, 1, 2, 3, 4, 5, 6, 7);
            o[1] = MFMA32(pa[ks], vb, o[1]);
        }
        st = st == 2 ? 0 : st + 1;
    }
#undef AT_ISSUE
#undef AT_DMA
    int lq2 = lq, h2 = h, lane2 = lane; asm volatile("" : "+v"(lq2), "+v"(h2), "+v"(lane2));
    if (MODE == 2 && U.s0f != nullptr) {
        const float ff = __builtin_amdgcn_exp2f((float)(qpos + 1) * U.lf), fb = __builtin_amdgcn_exp2f((float)(U.L - qpos) * U.lb);
#pragma unroll
        for (int s = 0; s < 4; ++s) {
            const u32x4 qu = __builtin_bit_cast(u32x4, qr[s]);
            u32x4 af, ab;
#pragma unroll
            for (int i = 0; i < 4; ++i) { const float lo = bflo(qu[i]), hi = bfhi(qu[i]); af[i] = pk2(lo * ff, hi * ff); ab[i] = pk2(lo * fb, hi * fb); }
#pragma unroll
            for (int d = 0; d < 2; ++d) {
                const bf16x8 sf = *(const bf16x8*)(U.s0f + (size_t)(32 * d + lq2) * 64 + 16 * s + 8 * h2);
                const bf16x8 sb = *(const bf16x8*)(U.s0b + (size_t)(32 * d + lq2) * 64 + 16 * s + 8 * h2);
                o[d] = MFMA32(__builtin_bit_cast(bf16x8, af), sf, o[d]);
                o[d] = MFMA32(__builtin_bit_cast(bf16x8, ab), sb, o[d]);
            }
        }
    }
    if (MODE == 3) {
        float* dst = U.st_out + (size_t)sdir * 4 * 4096 + (size_t)(32 * (w & 1)) * 64;
        if (w < 4) {
#pragma unroll
        for (int d = 0; d < 2; ++d)
#pragma unroll
            for (int r = 0; r < 16; ++r) dst[(size_t)((r & 3) + 8 * (r >> 2) + 4 * h2) * 64 + 32 * d + lq2] = o[d][r];
        }
        __syncthreads();
        if (F.tid == 0 && U.yflag != nullptr) (void)xb_add(U.yflag, 1u);
        return;
    }
    if (MODE <= 1) {
        l_run += __shfl_xor(l_run, 32);
        if (h2 == 0) scal[lq2] = 1.f / l_run;
    }
    if (U.zflag != nullptr && F.tid == 0) {
        unsigned* bar0 = (unsigned*)(F.ws + WS_CTL) + CW_BAR;
        XB_SPIN(xb_ld(U.zflag) < 4u, bar0);
    }
    __syncthreads();
    LAS float* ost = (LAS float*)lds + w * (32 * AT_OLD);
#pragma unroll
    for (int d = 0; d < 2; ++d)
#pragma unroll
        for (int r = 0; r < 16; ++r) ost[((r & 3) + 8 * (r >> 2) + 4 * h2) * AT_OLD + 32 * d + lq2] = o[d][r];
    asm volatile("s_waitcnt lgkmcnt(0)" ::: "memory");
    __builtin_amdgcn_wave_barrier();
    const bf16_t* zs = (const bf16_t*)(F.ws + WS_ZS);
    bf16_t* yb = (bf16_t*)(F.ws + WS_Y);
#pragma unroll
    for (int it = 0; it < 4; ++it) {
        const int row = it * 8 + (lane2 >> 3), c8 = (lane2 & 7) * 8;
        const f32x4 x0 = *(const LAS f32x4*)(ost + row * AT_OLD + c8), x1 = *(const LAS f32x4*)(ost + row * AT_OLD + c8 + 4);
        float sc;
        if (MODE <= 1) sc = scal[row];
        else {
            float ss = (x0[0] * x0[0] + x0[1] * x0[1]) + (x0[2] * x0[2] + x0[3] * x0[3]) + (x1[0] * x1[0] + x1[1] * x1[1]) + (x1[2] * x1[2] + x1[3] * x1[3]);
            ss += __shfl_xor(ss, 1); ss += __shfl_xor(ss, 2); ss += __shfl_xor(ss, 4);
            sc = rsqrtf(ss * (1.f / 64.f) + EPS);
        }
        const size_t off = (size_t)(U.tok0 + 32 * w + row) * 1024 + U.ycol + c8;
        const u32x4 z = *(const u32x4*)(zs + off);
        u32x4 y;
        y.x = pk2(x0[0] * sc * bflo(z.x), x0[1] * sc * bfhi(z.x));
        y.y = pk2(x0[2] * sc * bflo(z.y), x0[3] * sc * bfhi(z.y));
        y.z = pk2(x1[0] * sc * bflo(z.z), x1[1] * sc * bfhi(z.z));
        y.w = pk2(x1[2] * sc * bflo(z.w), x1[3] * sc * bfhi(z.w));
        ST16_WT(yb + off, y);
    }
    asm volatile("s_waitcnt vmcnt(0)" ::: "memory");
    __syncthreads();
    if (F.tid == 0) (void)xb_add(U.yflag, 1u);
}

__device__ __forceinline__ void dep_wait(const Frame& F, unsigned* c, int n, unsigned target, unsigned* c2 = nullptr, unsigned target2 = 0u) {
    if (F.w == 0) {
        const int ln = lane_id();
        unsigned* ptr = c + 4 * ln; unsigned tgt = target;
        if (c2 != nullptr && ln == n) { ptr = c2; tgt = target2; }
        poll_lanes(ptr, tgt, ln < n + (c2 != nullptr ? 1 : 0), (unsigned*)(F.ws + WS_CTL) + CW_BAR);
    }
}
__device__ __forceinline__ void attn_dispatch(const Frame& F, const Params& p, int u, int l) {
    unsigned char* ws = F.ws;
    AttnUnit U;
    U.nt0 = 0; U.nt1 = 0; U.q = nullptr; U.q_ld = 0; U.k0 = U.k1 = nullptr; U.k_ld0 = U.k_ld1 = 0; U.pe0 = U.pe1 = nullptr; U.v0 = U.v1 = nullptr; U.v_ld0 = U.v_ld1 = 0;
    U.tok0 = 0; U.ycol = 0; U.qpos0 = 0; U.L = 0; U.lf = U.lb = 0.f; U.s0f = U.s0b = nullptr; U.st_out = nullptr; U.mode = 0; U.yflag = nullptr; U.zflag = nullptr;
    const bf16_t* GQ = (const bf16_t*)(ws + WS_GQ); const bf16_t* GK = (const bf16_t*)(ws + WS_GK); const bf16_t* GV = (const bf16_t*)(ws + WS_GV);
    const bf16_t* QM = (const bf16_t*)(ws + WS_QM); const bf16_t* KVM = (const bf16_t*)(ws + WS_KVM); const bf16_t* KVMC = (const bf16_t*)(ws + WS_KVMC);
    const bf16_t* KPEB = (const bf16_t*)(ws + WS_KPEB); const bf16_t* CKPE = (const bf16_t*)(ws + WS_CKPE);
    const bf16_t* CGK = (const bf16_t*)(ws + WS_CGK); const bf16_t* CGV = (const bf16_t*)(ws + WS_CGV);
    const bf16_t* RQ = (const bf16_t*)(ws + WS_RQ); const bf16_t* RK = (const bf16_t*)(ws + WS_RK); const bf16_t* RV = (const bf16_t*)(ws + WS_RV);
    const float* decay = pin(F, I_DECAY) + l * 8;
    if (u < 96 || (u >= 256 && u < 352)) {
        const bool lat = u < 96; const int uu = lat ? u : u - 256;
        const int b = lat ? uu / 24 : uu / 6, hh = lat ? (uu >> 2) % 6 : uu % 6, qb = lat ? (uu & 3) : 0;
        const int seq0 = lat ? 4096 + b * 1024 : b * 256;
        U.mode = 1; U.tok0 = seq0 + qb * 256; U.q = QM + (size_t)U.tok0 * 576 + hh * 96; U.q_ld = 576; U.ycol = 640 + hh * 64;
        U.nt1 = lat ? 16 : 4; U.k1 = KVM + (size_t)seq0 * 768 + hh * 128; U.k_ld1 = 768; U.v1 = U.k1 + 64; U.v_ld1 = 768; U.pe1 = KPEB + (size_t)seq0 * 32;
        U.k0 = U.k1; U.v0 = U.v1; U.pe0 = U.pe1; U.k_ld0 = 768; U.v_ld0 = 768;
        if (lat) { U.nt0 = 8; U.k0 = KVMC + (size_t)(b * 512) * 768 + hh * 128; U.v0 = U.k0 + 64; U.pe0 = CKPE + (size_t)((b * 4 + l) * 512) * 32; }
        U.yflag = (unsigned*)(ws + WS_CTL) + CW_YRDY + (l * 32 + (U.tok0 >> 8)) * 4;
        { unsigned* c = (unsigned*)(ws + WS_CTL);
          dep_wait(F, c + CW_FULL + (l * 32 + (seq0 >> 8)) * 4, lat ? 4 : 1, 23u, lat ? c + CW_KC + (l * 4 + b) * 4 : nullptr, 12u); }
        __syncthreads();
        attn_unit<1>(F, p, U);
    } else if (u < 192 || (u >= 352 && u < 448)) {
        const bool lat = u < 192; const int uu = lat ? u - 96 : u - 352;
        const int b = lat ? uu / 24 : uu / 6, hh = lat ? (uu >> 2) % 6 : uu % 6, qb = lat ? (uu & 3) : 0, kvh = hh / 3;
        const int seq0 = lat ? 4096 + b * 1024 : b * 256;
        U.mode = 0; U.tok0 = seq0 + qb * 256; U.q = GQ + (size_t)U.tok0 * 384 + hh * 64; U.q_ld = 384; U.ycol = 256 + hh * 64;
        U.nt1 = lat ? 16 : 4; U.k1 = GK + (size_t)seq0 * 128 + kvh * 64; U.k_ld1 = 128; U.v1 = GV + (size_t)seq0 * 128 + kvh * 64; U.v_ld1 = 128;
        U.k0 = U.k1; U.v0 = U.v1; U.k_ld0 = 128; U.v_ld0 = 128;
        if (lat) { U.nt0 = 8; U.k0 = CGK + (size_t)((b * 4 + l) * 512) * 128 + kvh * 64; U.v0 = CGV + (size_t)((b * 4 + l) * 512) * 128 + kvh * 64; }
        U.yflag = (unsigned*)(ws + WS_CTL) + CW_YRDY + (l * 32 + (U.tok0 >> 8)) * 4;
        { unsigned* c = (unsigned*)(ws + WS_CTL);
          dep_wait(F, c + CW_RA + (l * 32 + (seq0 >> 8)) * 4, lat ? 4 : 1, 8u);
          U.zflag = c + CW_ZC + (l * 32 + (U.tok0 >> 8)) * 4; }
        __syncthreads();
        attn_unit<0>(F, p, U);
    } else if (u < 256 || (u >= 448 && u < 512)) {
        const bool lat = u < 256; const int uu = lat ? u - 192 : u - 448;
        const int b = lat ? uu / 16 : uu / 4, hh = lat ? (uu >> 2) & 3 : uu & 3, qb = lat ? (uu & 3) : 0;
        const int seq0 = lat ? 4096 + b * 1024 : b * 256;
        U.mode = 2; U.tok0 = seq0 + qb * 256; U.q = RQ + (size_t)U.tok0 * 256 + hh * 64; U.q_ld = 256; U.ycol = hh * 64;
        U.nt1 = lat ? 16 : 4; U.k1 = RK + (size_t)seq0 * 256 + hh * 64; U.k_ld1 = 256; U.v1 = RV + (size_t)seq0 * 256 + hh * 64; U.v_ld1 = 256;
        U.k0 = U.k1; U.v0 = U.v1; U.k_ld0 = 256; U.v_ld0 = 256;
        U.qpos0 = qb * 256; U.L = lat ? 1024 : 256;
        U.lf = -log1pf(__expf(-decay[hh])) * LOG2E; U.lb = -log1pf(__expf(-decay[4 + hh])) * LOG2E;
        if (lat) { const bf16_t* S0T = (const bf16_t*)(ws + WS_S0T); U.s0f = S0T + (size_t)(((b * 4 + l) * 2 + 0) * 4 + hh) * 4096; U.s0b = S0T + (size_t)(((b * 4 + l) * 2 + 1) * 4 + hh) * 4096; }
        U.yflag = (unsigned*)(ws + WS_CTL) + CW_YRDY + (l * 32 + (U.tok0 >> 8)) * 4;
        { unsigned* c = (unsigned*)(ws + WS_CTL);
          dep_wait(F, c + CW_RA + (l * 32 + (seq0 >> 8)) * 4, lat ? 4 : 1, 8u);
          U.zflag = c + CW_ZC + (l * 32 + (U.tok0 >> 8)) * 4; }
        __syncthreads();
        attn_unit<2>(F, p, U);
    } else {
        const int uu = u - 512, b = uu >> 2, hh = uu & 3, seq0 = b * 256;
        U.mode = 3; U.nt1 = 4; U.k1 = RK + (size_t)seq0 * 256 + hh * 64; U.k_ld1 = 256; U.v1 = RV + (size_t)seq0 * 256 + hh * 64; U.v_ld1 = 256;
        U.k0 = U.k1; U.v0 = U.v1; U.k_ld0 = 256; U.v_ld0 = 256;
        U.lf = -log1pf(__expf(-decay[hh])) * LOG2E; U.lb = -log1pf(__expf(-decay[4 + hh])) * LOG2E;
        U.st_out = p.out + O_STATE + (size_t)(((b * 4 + l) * 2 + 0) * 4 + hh) * 4096;
        dep_wait(F, (unsigned*)(ws + WS_CTL) + CW_RA + (l * 32 + b) * 4, 1, 8u);
        U.yflag = (unsigned*)(ws + WS_CTL) + CW_SD + (l * 16 + b) * 4;
        __syncthreads();
        attn_unit<3>(F, p, U);
    }
}
constexpr int N_ATTN_UNITS = 576;
struct TItem { const float* src; bf16_t* dst; int nsrc, K; int valid; };
constexpr int P0_TWIN = 4 * 16 * 92, P0_TWOUT = 4 * 16 * 32, P0_TWUQ = 4 * 4 * 20, P0_TWUKV = 4 * 2 * 24, P0_TR = P0_TWIN + P0_TWOUT + P0_TWUQ + P0_TWUKV;
__device__ __forceinline__ TItem p0_titem(const Frame& F, unsigned char* ws, int it) {
    TItem t; t.valid = it < P0_TR; t.src = nullptr; t.dst = nullptr; t.nsrc = 0; t.K = 0;
    if (!t.valid) return t;
    if (it < P0_TWIN) {
        const int l = it / (16 * 92), r = it % (16 * 92), kb = r / 92, nb = r % 92, n0 = nb * 32;
        const int src = n0 < 1792 ? n0 : (n0 < 2816 ? n0 + 32 : (n0 < 2848 ? n0 - 2816 + 1792 : -1));
        t.nsrc = 2848; t.K = 1024;
        if (src >= 0) t.src = pin(F, I_WIN) + (size_t)l * 1024 * 2848 + (size_t)(kb * 64) * 2848 + src;
        t.dst = (bf16_t*)(ws + WS_WIN) + ((size_t)l * 2944 + n0) * 1024 + kb * 64;
        return t;
    }
    it -= P0_TWIN;
    if (it < P0_TWOUT) {
        const int l = it / 512, r = it % 512, kb = r >> 5, nb = r & 31;
        t.nsrc = 1024; t.K = 1024; t.src = pin(F, I_WOUT) + (size_t)l * 1024 * 1024 + (size_t)(kb * 64) * 1024 + nb * 32;
        t.dst = (bf16_t*)(ws + WS_WOUT) + ((size_t)l * 1024 + nb * 32) * 1024 + kb * 64;
        return t;
    }
    it -= P0_TWOUT;
    if (it < P0_TWUQ) {
        const int l = it / 80, r = it % 80, kb = r / 20, nb = r % 20;
        t.nsrc = 576; t.K = 256; if (nb < 18) t.src = pin(F, I_WUQ) + (size_t)l * 256 * 576 + (size_t)(kb * 64) * 576 + nb * 32;
        t.dst = (bf16_t*)(ws + WS_WUQ) + ((size_t)l * 640 + nb * 32) * 256 + kb * 64;
        return t;
    }
    it -= P0_TWUQ;
    { const int l = it / 48, r = it % 48, kb = r / 24, nb = r % 24;
      t.nsrc = 768; t.K = 128; t.src = pin(F, I_WUKV) + (size_t)l * 128 * 768 + (size_t)(kb * 64) * 768 + nb * 32;
      t.dst = (bf16_t*)(ws + WS_WUKV) + ((size_t)l * 768 + nb * 32) * 128 + kb * 64; }
    return t;
}
__device__ __forceinline__ void p0_tload(const TItem& t, float (&r)[32], int lane) {
    if (t.valid && t.src) {
        const float* wp = t.src + (size_t)(lane >> 5) * t.nsrc + (lane & 31);
#pragma unroll
        for (int i = 0; i < 32; ++i) r[i] = wp[(size_t)(2 * i) * t.nsrc];
    } else {
#pragma unroll
        for (int i = 0; i < 32; ++i) r[i] = 0.f;
    }
}
__device__ __forceinline__ void p0_tstore(const TItem& t, const float (&r)[32], LAS float* scr, int lane) {
    if (!t.valid) return;
#pragma unroll
    for (int i = 0; i < 32; ++i) scr[(2 * i + (lane >> 5)) * 33 + (lane & 31)] = r[i];
    asm volatile("s_waitcnt lgkmcnt(0)" ::: "memory");
    __builtin_amdgcn_wave_barrier();
    const int c = lane & 7;
#pragma unroll
    for (int j = 0; j < 4; ++j) {
        const int n = (lane >> 3) + 8 * j; const LAS float* s = scr + (8 * c) * 33 + n;
        u32x4 o; o.x = pk2(s[0 * 33], s[1 * 33]); o.y = pk2(s[2 * 33], s[3 * 33]); o.z = pk2(s[4 * 33], s[5 * 33]); o.w = pk2(s[6 * 33], s[7 * 33]);
        ST16_WT(t.dst + (size_t)n * t.K + 8 * c, o);
    }
    asm volatile("s_waitcnt lgkmcnt(0)" ::: "memory");
    __builtin_amdgcn_wave_barrier();
}
__device__ __forceinline__ void cast8(const float* src, bf16_t* dst, size_t e) {
    const f32x4 a = *(const f32x4*)(src + e), b = *(const f32x4*)(src + e + 4);
    u32x4 o; o.x = pk2(a[0], a[1]); o.y = pk2(a[2], a[3]); o.z = pk2(b[0], b[1]); o.w = pk2(b[2], b[3]);
    ST16_WT(dst + e, o);
}
constexpr int P0_MODS = 1536, P0_CAST_G = 512, P0_CAST_KPE = 128, P0_S0T = 512;
constexpr int P0_TOTAL = P0_MODS + 3 * P0_CAST_G + P0_CAST_KPE + P0_S0T;
__device__ __forceinline__ void phase0(const Frame& F, const Params& p, bool dup = false) {
    unsigned char* ws = F.ws + (dup ? 162 * MiB : 0); const int lane = F.lane;
    LAS float* scr = (LAS float*)F.lds + F.w * (64 * 33);
    const int gw = blockIdx.x * NWAVE + F.w, ngw = gridDim.x * NWAVE;
#ifndef MK_DUP0
#define MK_DUP0_ 0
#else
#define MK_DUP0_ MK_DUP0
#endif
    if (!(dup && MK_DUP0_ == 2))
    for (int it = gw; it < P0_TR; it += 2 * ngw) {
        const TItem t0 = p0_titem(F, ws, it), t1 = p0_titem(F, ws, it + ngw);
        float r0[32], r1[32];
        p0_tload(t0, r0, lane); p0_tload(t1, r1, lane);
        p0_tstore(t0, r0, scr, lane); p0_tstore(t1, r1, scr, lane);
    }
    if (!(dup && MK_DUP0_ == 1))
    for (int it0 = (gw + ngw - 256) % ngw; it0 < P0_TOTAL; it0 += ngw) {
        int it = it0;
        if (it < P0_MODS) {
            const int l = it / 384, cg = (it % 384) >> 5, ks = it & 31;
            const int j = cg * 256 + lane * 4;
            const float* wp = pin(F, I_WADA) + ((size_t)l * 1024 + ks * 32) * 3072 + j;
            const float* c = pin(F, I_C); const float* cc = pin(F, I_CCTX);
            float sv[3];
#pragma unroll
            for (int q = 0; q < 3; ++q) {
                const int idx = q * 64 + lane, n = idx >> 5, k = idx & 31;
                float x = 0.f;
                if (idx < 160) x = (n == 0) ? cc[ks * 32 + k] : c[(n - 1) * 1024 + ks * 32 + k];
                sv[q] = silu_f(x);
            }
            f32x4 acc[5];
#pragma unroll
            for (int n = 0; n < 5; ++n) acc[n] = (f32x4){0.f, 0.f, 0.f, 0.f};
#pragma unroll 1
            for (int k0 = 0; k0 < 32; k0 += 16) {
                f32x4 wv[16];
#pragma unroll
                for (int k = 0; k < 16; ++k) wv[k] = *(const f32x4*)(wp + (size_t)(k0 + k) * 3072);
                __builtin_amdgcn_sched_barrier(0);
#pragma unroll
                for (int k = 0; k < 16; ++k)
#pragma unroll
                    for (int n = 0; n < 5; ++n) {
                        const float s = __int_as_float(__builtin_amdgcn_readlane(__float_as_int(sv[n >> 1]), 32 * (n & 1) + k0 + k));
                        acc[n] += wv[k] * s;
                    }
            }
            LAS f32x4* red = (LAS f32x4*)(F.lds + 69632);
#pragma unroll
            for (int n = 0; n < 5; ++n) red[(F.w * 5 + n) * 64 + lane] = acc[n];
            __syncthreads();
            if (F.tid < 320) {
                const int n = F.tid >> 6;
                f32x4 s = red[n * 64 + lane];
#pragma unroll
                for (int ww = 1; ww < 8; ++ww) s += red[(ww * 5 + n) * 64 + lane];
                if ((ks >> 3) == 0) s += *(const f32x4*)(pin(F, I_BADA) + l * 3072 + j);
                float* mods = (float*)(ws + WS_MODS) + (size_t)(l * 5 + n) * 3072 + j;
#pragma unroll
                for (int e = 0; e < 4; ++e) atomicAdd(mods + e, s[e]);
            }
            __syncthreads();
            continue;
        }
        it -= P0_MODS;
        if (it < 3 * P0_CAST_G) {
            const int which = it / P0_CAST_G, r = it % P0_CAST_G;
            const float* src = which == 0 ? pin(F, I_CGK) : (which == 1 ? pin(F, I_CGV) : pin(F, I_CCKV));
            bf16_t* dst = (bf16_t*)(ws + (which == 0 ? WS_CGK : (which == 1 ? WS_CGV : WS_CCKV)));
#pragma unroll
            for (int q = 0; q < 4; ++q) cast8(src, dst, (size_t)r * 2048 + q * 512 + lane * 8);
            continue;
        }
        it -= 3 * P0_CAST_G;
        if (it < P0_CAST_KPE) {
#pragma unroll
            for (int q = 0; q < 4; ++q) cast8(pin(F, I_CKPE), (bf16_t*)(ws + WS_CKPE), (size_t)it * 2048 + q * 512 + lane * 8);
            continue; }
        it -= P0_CAST_KPE;
        {
            const int mat = it >> 2, qd = it & 3, dv = qd * 16 + (lane >> 2), dk0 = (lane & 3) * 16;
            const float* s = pin(F, I_STATE) + (size_t)mat * 4096 + dv;
            float x[16];
#pragma unroll
            for (int i = 0; i < 16; ++i) x[i] = s[(dk0 + i) * 64];
            u32x4 o0, o1;
            o0.x = pk2(x[0], x[1]); o0.y = pk2(x[2], x[3]); o0.z = pk2(x[4], x[5]); o0.w = pk2(x[6], x[7]);
            o1.x = pk2(x[8], x[9]); o1.y = pk2(x[10], x[11]); o1.z = pk2(x[12], x[13]); o1.w = pk2(x[14], x[15]);
            bf16_t* d = (bf16_t*)(ws + WS_S0T) + (size_t)mat * 4096 + dv * 64 + dk0;
            ST16_WT(d, o0); ST16_WT(d + 8, o1);
        }
    }
}
constexpr int P1_GS = 80, P1_BIAS = 4 * 368, P1_X = 8192, P1_TOTAL = P1_GS + P1_BIAS + P1_X;
__device__ __forceinline__ void xg_row(const Frame& F, const float* xrow, const float* g, const float* mods_c, bf16_t* xg_row_out, float* ssq_row, bool write_xg) {
    const int lane = F.lane;
    float ss = 0.f;
#pragma unroll
    for (int j = 0; j < 2; ++j) {
        const int k = j * 512 + lane * 8;
        const f32x4 x0 = *(const f32x4*)(xrow + k), x1 = *(const f32x4*)(xrow + k + 4);
        ss += ((x0[0] * x0[0] + x0[1] * x0[1]) + (x0[2] * x0[2] + x0[3] * x0[3])) + ((x1[0] * x1[0] + x1[1] * x1[1]) + (x1[2] * x1[2] + x1[3] * x1[3]));
        if (write_xg) {
            const f32x4 g0 = *(const f32x4*)(g + k), g1 = *(const f32x4*)(g + k + 4), s0 = *(const f32x4*)(mods_c + 1024 + k), s1 = *(const f32x4*)(mods_c + 1024 + k + 4);
            u32x4 o; o.x = pk2(x0[0] * g0[0] * (1.f + s0[0]), x0[1] * g0[1] * (1.f + s0[1])); o.y = pk2(x0[2] * g0[2] * (1.f + s0[2]), x0[3] * g0[3] * (1.f + s0[3]));
            o.z = pk2(x1[0] * g1[0] * (1.f + s1[0]), x1[1] * g1[1] * (1.f + s1[1])); o.w = pk2(x1[2] * g1[2] * (1.f + s1[2]), x1[3] * g1[3] * (1.f + s1[3]));
            ST16_WT(xg_row_out + k, o);
        }
    }
    ss = wsum(ss);
    if (lane < 16) ssq_row[lane] = lane == 0 ? ss : 0.f;
}
__device__ __forceinline__ void phase1(const Frame& F, const Params& p) {
    unsigned char* ws = F.ws; const int lane = F.lane;
    unsigned* ctl = (unsigned*)(ws + WS_CTL);
    const int gw = blockIdx.x * NWAVE + F.w, ngw = gridDim.x * NWAVE;
    const float* mods = (const float*)(ws + WS_MODS);
    for (int it0 = gw; it0 < P1_GS + P1_BIAS; it0 += ngw) {
        int it = it0;
        if (it < P1_GS) {
            const int e = it * 256 + lane * 4, lc = e >> 10, k = e & 1023, l = lc / 5;
            const f32x4 g = *(const f32x4*)(pin(F, I_NORMG) + l * 1024 + k), sc = *(const f32x4*)(mods + (size_t)lc * 3072 + 1024 + k);
            { const f32x4 o = g * (sc + 1.f); ST16_WT((float*)(ws + WS_GS) + e, o); }
            continue;
        }
        it -= P1_GS;
        {
            const int l = it / 368, n0 = (it % 368) * 8;
            f32x4 sh[5][4];
#pragma unroll
            for (int c = 0; c < 5; ++c) {
                const float* shp = mods + (size_t)(l * 5 + c) * 3072 + lane * 16;
#pragma unroll
                for (int i = 0; i < 4; ++i) sh[c][i] = *(const f32x4*)(shp + 4 * i);
            }
            const bf16_t* wr0 = (const bf16_t*)(ws + WS_WIN) + ((size_t)l * 2944 + n0) * 1024 + lane * 16;
            u32x4 w0[8], w1[8];
#pragma unroll
            for (int r = 0; r < 8; ++r) { w0[r] = *(const u32x4*)(wr0 + (size_t)r * 1024); w1[r] = *(const u32x4*)(wr0 + (size_t)r * 1024 + 8); }
#pragma unroll
            for (int r = 0; r < 8; ++r) {
                float wv[16];
#pragma unroll
                for (int i = 0; i < 4; ++i) { wv[2 * i] = bflo(w0[r][i]); wv[2 * i + 1] = bfhi(w0[r][i]); wv[8 + 2 * i] = bflo(w1[r][i]); wv[8 + 2 * i + 1] = bfhi(w1[r][i]); }
#pragma unroll
                for (int c = 0; c < 5; ++c) {
                    float d = 0.f;
#pragma unroll
                    for (int i = 0; i < 4; ++i) { const f32x4 s4 = sh[c][i]; d += (s4[0] * wv[4 * i] + s4[1] * wv[4 * i + 1]) + (s4[2] * wv[4 * i + 2] + s4[3] * wv[4 * i + 3]); }
                    d = wsum(d);
                    if (lane == 0) __hip_atomic_store((__attribute__((address_space(1))) float*)((float*)(ws + WS_BIAS) + (size_t)(l * 5 + c) * 2944 + n0 + r), d, __ATOMIC_RELAXED, __HIP_MEMORY_SCOPE_AGENT);
                }
            }
            if (l == 0) {
                asm volatile("s_waitcnt vmcnt(0)" ::: "memory");
                if (lane == 0) (void)xb_add(ctl + CW_P1B0, 1u);
            }
        }
    }
    for (int vb = blockIdx.x; vb < 256; vb += gridDim.x) {
        const int tm = vb & 31, part = vb >> 5;
        const bool lat = tm >= 16;
        const int cond = lat ? 1 + ((tm - 16) >> 2) : 0;
        const float* g = pin(F, I_NORMG); const float* sc = mods + (size_t)cond * 3072 + 1024;
#pragma unroll 1
        for (int i = 0; i < 4; i += 2) {
            const int tok = tm * 256 + part * 32 + F.w * 4 + i;
            const float* xa = lat ? pin(F, I_XS) + (size_t)(tok - 4096) * 1024 : pin(F, I_XP) + (size_t)tok * 1024;
            const float* xb = xa + 1024;
            bf16_t* oa = (bf16_t*)(ws + WS_XG) + (size_t)tok * 1024;
            float ssa = 0.f, ssb = 0.f;
#pragma unroll
            for (int j = 0; j < 2; ++j) {
                const int k = j * 512 + lane * 8;
                const f32x4 a0 = *(const f32x4*)(xa + k), a1 = *(const f32x4*)(xa + k + 4), b0 = *(const f32x4*)(xb + k), b1 = *(const f32x4*)(xb + k + 4);
                const f32x4 g0 = *(const f32x4*)(g + k), g1 = *(const f32x4*)(g + k + 4), s0 = *(const f32x4*)(sc + k), s1 = *(const f32x4*)(sc + k + 4);
                const f32x4 m0 = g0 * (s0 + 1.f), m1 = g1 * (s1 + 1.f);
                ssa += ((a0[0] * a0[0] + a0[1] * a0[1]) + (a0[2] * a0[2] + a0[3] * a0[3])) + ((a1[0] * a1[0] + a1[1] * a1[1]) + (a1[2] * a1[2] + a1[3] * a1[3]));
                ssb += ((b0[0] * b0[0] + b0[1] * b0[1]) + (b0[2] * b0[2] + b0[3] * b0[3])) + ((b1[0] * b1[0] + b1[1] * b1[1]) + (b1[2] * b1[2] + b1[3] * b1[3]));
                u32x4 o; o.x = pk2(a0[0] * m0[0], a0[1] * m0[1]); o.y = pk2(a0[2] * m0[2], a0[3] * m0[3]); o.z = pk2(a1[0] * m1[0], a1[1] * m1[1]); o.w = pk2(a1[2] * m1[2], a1[3] * m1[3]);
                ST16_WT(oa + k, o);
                o.x = pk2(b0[0] * m0[0], b0[1] * m0[1]); o.y = pk2(b0[2] * m0[2], b0[3] * m0[3]); o.z = pk2(b1[0] * m1[0], b1[1] * m1[1]); o.w = pk2(b1[2] * m1[2], b1[3] * m1[3]);
                ST16_WT(oa + 1024 + k, o);
            }
            ssa = wsum(ssa); ssb = wsum(ssb);
            if (lane < 32) {
                const float v = (lane & 15) == 0 ? (lane < 16 ? ssa : ssb) : 0.f;
                __hip_atomic_store((__attribute__((address_space(1))) float*)((float*)(ws + WS_SSQ) + (size_t)(tok + (lane >> 4)) * 16 + (lane & 15)), v, __ATOMIC_RELAXED, __HIP_MEMORY_SCOPE_AGENT);
            }
        }
        asm volatile("s_waitcnt vmcnt(0)" ::: "memory");
        __syncthreads();
        if (is_t0(F)) (void)xb_add(ctl + CW_P1X + tm * 4, 1u);
    }
    asm volatile("s_waitcnt vmcnt(0)" ::: "memory");
    __syncthreads();
    if (is_t0(F)) (void)xb_add(ctl + CW_P1DONE, 1u);
}
#ifndef MK_TIMING
#define MK_TIMING -1
#endif
constexpr int CW_TIME = 2048;
__device__ __forceinline__ void phase_final(const Frame& F, const Params& p) {
    const int lane = F.lane;
    float tf = 1.f;
    if (MK_TIMING >= 0) tf = __uint_as_float(__hip_atomic_load((unsigned*)(F.ws + WS_CTL) + CW_TIME, __ATOMIC_RELAXED, __HIP_MEMORY_SCOPE_AGENT));
    unsigned* ctl = (unsigned*)(F.ws + WS_CTL);
    for (int vb = blockIdx.x; vb < 256; vb += gridDim.x) {
        const int tm = vb & 31, part = vb >> 5;
        if (F.tid == 0) {
            XB_SPIN(xb_ld(ctl + CW_XRDY + tm * 4) < 8u, ctl + CW_BAR);
            __builtin_amdgcn_fence(__ATOMIC_ACQUIRE, "agent");
            asm volatile("s_waitcnt vmcnt(0)" ::: "memory");
        }
        __syncthreads();
#pragma unroll 1
        for (int i = 0; i < 4; ++i) {
            const int tok = tm * 256 + part * 32 + F.w * 4 + i;
            float ss = 0.f;
            if (lane < 16) ss = ((const float*)(F.ws + WS_SSQ))[(size_t)tok * 16 + lane];
            ss = wsum(ss);
            const float rstd = rsqrtf(ss * (1.f / 1024.f) + EPS);
            const bf16_t* xr = (const bf16_t*)(F.ws + WS_XB) + (size_t)tok * 1024; float* orow = p.out + (size_t)tok * 1024;
#pragma unroll
            for (int j = 0; j < 4; ++j) {
                const int k = j * 256 + lane * 4;
                const u32x2 xq = *(const u32x2*)(xr + k);
                const f32x4 x = {bflo(xq.x), bfhi(xq.x), bflo(xq.y), bfhi(xq.y)}, fn = *(const f32x4*)(pin(F, I_FNORM) + k);
                { const f32x4 o = x * fn * (rstd * tf); ST16_WT(orow + k, o); }
            }
        }
    }
}

__device__ __forceinline__ GemmOp a2_op(const Frame& F, int l, int j) {
    GemmOp g;
    if (j < 160) { const int tn = j >> 5, tm = j & 31; g.W = (const bf16_t*)(F.ws + WS_WUQ) + ((size_t)l * 640 + tn * 128) * 256; g.X = (const bf16_t*)(F.ws + WS_CQG) + (size_t)tm * 256 * 256; g.ldw = 256; g.ldx = 256; g.K = 256; }
    else if (j < 352) { const int jj = j - 160, tn = jj >> 5, tm = jj & 31; g.W = (const bf16_t*)(F.ws + WS_WUKV) + ((size_t)l * 768 + tn * 128) * 128; g.X = (const bf16_t*)(F.ws + WS_CKVN) + (size_t)tm * 256 * 128; g.ldw = 128; g.ldx = 128; g.K = 128; }
    else { const int jj = j - 352, tn = jj >> 3, tc = jj & 7, b = tc >> 1, jt = tc & 1; g.W = (const bf16_t*)(F.ws + WS_WUKV) + ((size_t)l * 768 + tn * 128) * 128;
           g.X = (const bf16_t*)(F.ws + WS_CCKV) + ((size_t)(b * 4 + l) * 512 + jt * 256) * 128; g.ldw = 128; g.ldx = 128; g.K = 128; }
    return g;
}
__device__ __forceinline__ int a2_item(int vb, int i) {
    const int c = (vb >> 5) - 4, tmw = vb & 31;
    if (i == 3) return 352 + 32 + tmw;
    if (c == 0) return i * 32 + tmw;
    if (c == 1) return i < 2 ? (3 + i) * 32 + tmw : 160 + tmw;
    if (c == 2) return 160 + (1 + i) * 32 + tmw;
    return i < 2 ? 160 + (4 + i) * 32 + tmw : 352 + tmw;
}
#ifndef MK_EN
#define MK_EN 0xff
#endif
#define EN(x) ((MK_EN >> (x)) & 1)
constexpr int PH_TOTAL = 19;
__global__ void __launch_bounds__(512, 2) mega(Params p) {
    extern __shared__ __attribute__((aligned(16))) unsigned char lds_raw[];
    Frame F;
    F.lds = (LAS unsigned char*)lds_raw;
    F.tid = threadIdx.x; F.lane = F.tid & 63; F.w = __builtin_amdgcn_readfirstlane(F.tid >> 6); F.h = F.lane >> 5; F.lq = F.lane & 31;
    F.ws = p.ws;
    F.karg = (karg_t)__builtin_amdgcn_kernarg_segment_ptr();
    volatile LAS unsigned* MISC = (volatile LAS unsigned*)(F.lds + LDS_MISC);
    if (F.tid < 64) MISC[F.tid] = 0u;
    __syncthreads();
    unsigned* ctl = (unsigned*)(p.ws + WS_CTL);
    XcdBarrier bar; bar.bar = ctl + CW_BAR; bar.x = 0; bar.st = nullptr;
    const bool multi = p.ph_hi - p.ph_lo > 1;
    if (multi) bar = xcd_barrier_post(ctl + CW_BAR, MISC + 8);
    bar.w = F.w;
    const int G = gridDim.x;
    const Frame F0 = F;
    for (int ph = p.ph_lo; ph < p.ph_hi; ++ph) {
        if (ph >= 2 && ph < 18 && ((ph - 2) & 3) == 1) continue;
        Frame F = F0;
        F.lane = (int)__builtin_amdgcn_mbcnt_hi(~0u, __builtin_amdgcn_mbcnt_lo(~0u, 0u));
        asm volatile("" : "+v"(F.lane));
        F.tid = (F.w << 6) | F.lane; F.h = F.lane >> 5; F.lq = F.lane & 31;
        asm volatile("" : "+s"(F.w), "+s"(F.ws), "+s"(F.karg));
        if (MK_TIMING >= 0 && blockIdx.x == 0 && F.tid == 0) {
            const unsigned long long now = __builtin_amdgcn_s_memrealtime();
            const unsigned long long prev = ((unsigned long long)MISC[17] << 32) | MISC[16];
            if (ph > p.ph_lo) { const int q = ph - 1; const int grp = q < 2 ? q : 2 + ((q - 2) & 3); if (grp == MK_TIMING) MISC[18] += (unsigned)(now - prev); }
            MISC[16] = (unsigned)now; MISC[17] = (unsigned)(now >> 32);
        }
#ifndef MK_REPEAT
#define MK_REPEAT -1
#endif
        int nrep = 1;
        if (MK_REPEAT >= 1) { const int grp = ph < 2 ? ph : (ph == 18 ? 6 : 2 + ((ph - 2) & 3)); if (grp == MK_REPEAT) nrep = (grp == 5) ? (ph == 5 ? 5 : 1) : 2; }
        for (int rep = 0; rep < nrep; ++rep) {
        if (rep > 0) xcd_barrier(bar);
        Frame F = F0;
        F.lane = (int)__builtin_amdgcn_mbcnt_hi(~0u, __builtin_amdgcn_mbcnt_lo(~0u, 0u));
        asm volatile("" : "+v"(F.lane));
        F.tid = (F.w << 6) | F.lane; F.h = F.lane >> 5; F.lq = F.lane & 31;
        asm volatile("" : "+s"(F.w), "+s"(F.ws), "+s"(F.karg));
        if (EN(0) && ph == 0) {
#if defined(MK_DUP0)
            for (int d = 0; d < 2; ++d) { int dd = d; asm volatile("" : "+s"(dd)); if (dd) xcd_barrier(bar); phase0(F, p, dd != 0); }
#else
            phase0(F, p);
#endif
        }
        else if (EN(1) && ph == 1) phase1(F, p);
        else if (EN(2) && ph == 18) phase_final(F, p);
        else {
            const int l = (ph - 2) >> 2, sub = (ph - 2) & 3;
            int bid = blockIdx.x; asm volatile("" : "+s"(bid));
            if (EN(3) && sub == 0) {
                const bf16_t* Wt = (const bf16_t*)(F.ws + WS_WIN) + (size_t)l * 2944 * 1024;
                const bf16_t* X = (const bf16_t*)(F.ws + WS_XG);
                unsigned* flags = ctl + CW_FLAG + l * 512;
                bool first = true;
                int waited_tm = -1;
                for (int j = bid; j < 12 * 32; j += G) {
                    const int tn2 = j >> 5, tm = j & 31;
                    const int jn = j + G; const bool hn = jn < 12 * 32 && (jn & 31) == tm;
                    if (l == 0 && tm != waited_tm) {
                        waited_tm = tm;
                        if (F.tid == 0) {
                            XB_SPIN(xb_ld(ctl + CW_P1X + tm * 4) < 8u, ctl + CW_BAR);
                            XB_SPIN(xb_ld(ctl + CW_P1B0) < 368u, ctl + CW_BAR);
                            __builtin_amdgcn_fence(__ATOMIC_ACQUIRE, "agent");
                            asm volatile("s_waitcnt vmcnt(0)" ::: "memory");
                        }
                        __syncthreads();
                        first = true;
                    }
                    if (l > 0 && tm != waited_tm) {
                        waited_tm = tm;
                        if (F.w == 0) {
                            const int ln = lane_id();
                            unsigned* ptr = ctl + CW_P1DONE; unsigned tgt = (unsigned)G;
                            if (ln == 1) { ptr = ctl + CW_XGR + ((l - 1) * 32 + tm) * 4; tgt = 8u; }
                            if (ln >= 2) {
                                if (tm >= 16) { ptr = ctl + CW_YRDY + ((l - 1) * 32 + (tm & ~3) + ((ln - 2) & 3)) * 4; tgt = 16u; }
                                else { ptr = ctl + CW_SD + ((l - 1) * 16 + tm) * 4; tgt = 4u; }
                            }
                            poll_lanes(ptr, tgt, ln < (tm >= 16 ? 6 : 3), ctl + CW_BAR);
                            __builtin_amdgcn_fence(__ATOMIC_ACQUIRE, "agent");
                            asm volatile("s_waitcnt vmcnt(0)" ::: "memory");
                        }
                        __syncthreads();
                        first = true;
                    }
                    const int tn = 2 * tn2 + ((F.w & 3) >> 1), wn = F.w & 1;
                    GemmAcc8 acc;
                    Gemm1Pre P1;
                    gemm1_pre(F, p, tn, wn, tm, l, P1);
                    gemm_core256(F, Wt + (size_t)tn2 * 256 * 1024, X + (size_t)tm * 256 * 1024, acc, first, hn, Wt + (size_t)(jn >> 5) * 256 * 1024, X + (size_t)(jn & 31) * 256 * 1024); first = false;
                    epi_gemm1(F, p, acc, tn, wn, tm, l, P1, tn2 == 6);
                    {
                        asm volatile("s_waitcnt vmcnt(0)" ::: "memory");
                        __syncthreads();
                        if (F.tid == 0) {
                            if (tn2 == 5 || tn2 == 6) (void)xb_add(flags + tm * 16, 1u);
                            if (tn2 < 8) (void)xb_add(ctl + CW_RA + (l * 32 + tm) * 4, 1u);
                            if (tn2 >= 7 && tn2 < 11) (void)xb_add(ctl + CW_ZC + (l * 32 + tm) * 4, 1u);
                            (void)xb_add(ctl + CW_FULL + (l * 32 + tm) * 4, 1u);
                        }
                    }
                }
                for (int vb = bid; vb < 256; vb += G) {
                    if (vb < 128) continue;
                    const int c = (vb >> 5) - 4, tmw = vb & 31;
                    const int nit = (c == 2 && tmw < 16) ? 4 : 3;
                    if (F.tid == 0) {
                        if (l > 0 && tmw != waited_tm) {
                            if (tmw >= 16) { unsigned* y = ctl + CW_YRDY + ((l - 1) * 32 + (tmw & ~3)) * 4; for (int i = 0; i < 4; ++i) { XB_SPIN(xb_ld(y + 4 * i) < 16u, ctl + CW_BAR); } }
                            else { XB_SPIN(xb_ld(ctl + CW_YRDY + ((l - 1) * 32 + tmw) * 4) < 16u, ctl + CW_BAR); XB_SPIN(xb_ld(ctl + CW_SD + ((l - 1) * 16 + tmw) * 4) < 4u, ctl + CW_BAR); }
                        }
                        unsigned* f = flags + tmw * 16;
                        XB_SPIN(xb_ld(f) < 2u, ctl + CW_BAR);
                        __builtin_amdgcn_fence(__ATOMIC_ACQUIRE, "agent");
                        asm volatile("s_waitcnt vmcnt(0)" ::: "memory");
                    }
                    __syncthreads();
                    for (int i = 0; i < nit; ++i) {
                        const bool hn = i + 1 < nit;
                        const int j = a2_item(vb, i), jn = a2_item(vb, hn ? i + 1 : i);
                        const GemmOp g = a2_op(F, l, j); const GemmOp gn = a2_op(F, l, jn);
                        GemmAcc acc;
                        float rstdq = 0.f;
                        if (j < 160) qm_pre(F, tmw, rstdq);
                        gemm_core(F, g, acc, i == 0, hn, gn);
                        if (j < 160) epi_qm(F, acc, j >> 5, tmw, rstdq);
                        else if (j < 352) { const int jj = j - 160; epi_plain(F, acc, (bf16_t*)(F.ws + WS_KVM), 768, tmw * 256, (jj >> 5) * 128); }
                        else {
                            const int jj = j - 352, tc = jj & 7;
                            if (l > 0) {
                                if (F.tid == 0) { unsigned* y = ctl + CW_YRDY + ((l - 1) * 32 + 16 + 4 * (tc >> 1)) * 4; for (int q = 0; q < 4; ++q) { XB_SPIN(xb_ld(y + 4 * q) < 16u, ctl + CW_BAR); } }
                                __syncthreads();
                            }
                            epi_plain(F, acc, (bf16_t*)(F.ws + WS_KVMC), 768, (tc >> 1) * 512 + (tc & 1) * 256, (jj >> 3) * 128);
                        }
                        asm volatile("s_waitcnt vmcnt(0)" ::: "memory");
                        __syncthreads();
                        if (F.tid == 0) {
                            if (j < 352) (void)xb_add(ctl + CW_FULL + (l * 32 + tmw) * 4, 1u);
                            else (void)xb_add(ctl + CW_KC + (l * 4 + (((j - 352) & 7) >> 1)) * 4, 1u);
                        }
                    }
                }
            } else if (EN(5) && sub == 2) {
                for (;;) {
                    __syncthreads();
                    if (F.tid == 0) MISC[0] = atomicAdd(ctl + CW_QUEUE + 64 * l + 32 * rep, 1u);
                    __syncthreads();
                    const int uq = __builtin_amdgcn_readfirstlane((int)MISC[0]);
                    if (uq >= N_ATTN_UNITS) break;
                    const int u = uq < 160 ? uq + 96 : (uq < 256 ? uq - 160 : (uq < 480 ? uq + 96 : uq - 224));
                    attn_dispatch(F, p, u, l);
                }
            } else if (EN(6)) {
                const bf16_t* Wt = (const bf16_t*)(F.ws + WS_WOUT) + (size_t)l * 1024 * 1024;
                const bf16_t* Yb = (const bf16_t*)(F.ws + WS_Y);
                for (int j = bid; j < 8 * 32; j += G) {
                    const int tn = j >> 5, tm = j & 31;
                    GemmOp g; g.W = Wt + (size_t)tn * 128 * 1024; g.X = Yb + (size_t)tm * 256 * 1024; g.ldw = 1024; g.ldx = 1024; g.K = 1024;
                    GemmAcc acc;
                    Gemm2Pre P2;
                    if (F.tid == 0) {
                        unsigned* f = ctl + CW_YRDY + (l * 32 + tm) * 4;
                        XB_SPIN(xb_ld(f) < 16u, ctl + CW_BAR);
                        if (l == 0) { XB_SPIN(xb_ld(ctl + CW_P1DONE) < (unsigned)G, ctl + CW_BAR); }
                        __builtin_amdgcn_fence(__ATOMIC_ACQUIRE, "agent");
                        asm volatile("s_waitcnt vmcnt(0)" ::: "memory");
                    }
                    __syncthreads();
                    gemm2_pre(F, tn, tm, l, P2);
                    gemm_core(F, g, acc, true, false, g);
                    epi_gemm2(F, p, acc, tn, tm, l, P2, l == 3);
                    {
                        asm volatile("s_waitcnt vmcnt(0)" ::: "memory");
                        __syncthreads();
                        if (F.tid == 0) (void)xb_add(l == 3 ? ctl + CW_XRDY + tm * 4 : ctl + CW_XGR + (l * 32 + tm) * 4, 1u);
                    }
                }
            }
        }
        }
        if (MK_TIMING >= 0 && ph == 17 && blockIdx.x == 0 && F.tid == 0) {
            const unsigned long long now = __builtin_amdgcn_s_memrealtime();
            const unsigned long long prev = ((unsigned long long)MISC[17] << 32) | MISC[16];
            unsigned a = MISC[18]; if (MK_TIMING == 5) a += (unsigned)(now - prev);
            __hip_atomic_store(ctl + CW_TIME, __float_as_uint(1.f + (float)a * 1e-5f), __ATOMIC_RELAXED, __HIP_MEMORY_SCOPE_AGENT);
        }
        if (ph + 1 < p.ph_hi && ph < 1) xcd_barrier(bar);
    }
}
}

extern "C" void kernel_launch(void* const* d_in, const int* in_sizes, int n_in, void* d_out, int out_size, void* d_ws, size_t ws_size, hipStream_t stream) {
    static int grid = 0;
    if (!grid) {
        int dev = 0, cus = 0, per_cu = 0;
        (void)hipGetDevice(&dev);
        (void)hipDeviceGetAttribute(&cus, hipDeviceAttributeMultiprocessorCount, dev);
        (void)hipFuncSetAttribute((const void*)mk::mega, hipFuncAttributeMaxDynamicSharedMemorySize, mk::LDS_BYTES);
        (void)hipOccupancyMaxActiveBlocksPerMultiprocessor(&per_cu, (const void*)mk::mega, 512, mk::LDS_BYTES);
        if (per_cu > 1) per_cu = 1;
        if (per_cu < 1) per_cu = 1;
        if (cus < 1) cus = 256;
        grid = cus * per_cu;
    }
    unsigned char* ws = (unsigned char*)d_ws;
    (void)hipMemsetAsync(ws, 0, mk::CTL_ZERO_BYTES, stream);
    mk::Params P{};
    for (int i = 0; i < 22; ++i) P.in[i] = (const float*)d_in[i];
    P.out = (float*)d_out; P.ws = ws; P.xs = (float*)d_out;
    P.ph_lo = 0; P.ph_hi = mk::PH_TOTAL;
    void* args[] = {&P};
    (void)hipLaunchCooperativeKernel((const void*)mk::mega, dim3(grid), dim3(512), args, mk::LDS_BYTES, stream);
}
```

```cpp
#include <hip/hip_runtime.h>
#include <stdint.h>
namespace mk {
#define LAS __attribute__((address_space(3)))
typedef unsigned short bf16_t;
typedef short bf16x8 __attribute__((ext_vector_type(8)));
typedef short s16x4 __attribute__((ext_vector_type(4)));
typedef float f32x16 __attribute__((ext_vector_type(16)));
typedef float f32x4 __attribute__((ext_vector_type(4)));
typedef float f32x2 __attribute__((ext_vector_type(2)));
typedef unsigned u32x4 __attribute__((ext_vector_type(4)));
typedef unsigned u32x2 __attribute__((ext_vector_type(2)));
typedef __bf16 bf16x2_t __attribute__((ext_vector_type(2)));

constexpr float EPS = 1e-6f;
constexpr float LOG2E = 1.4426950408889634f;
constexpr float QSC_GQA = 0.125f * LOG2E;
constexpr float QSC_MLA = 0.10206207261596575f * LOG2E;

__device__ __forceinline__ unsigned pk2(float lo, float hi) { f32x2 v = {lo, hi}; bf16x2_t b = __builtin_convertvector(v, bf16x2_t); return __builtin_bit_cast(unsigned, b); }
__device__ __forceinline__ float bf2f(unsigned short u) { return __uint_as_float((unsigned)u << 16); }
__device__ __forceinline__ float bflo(unsigned u) { return __uint_as_float(u << 16); }
__device__ __forceinline__ float bfhi(unsigned u) { return __uint_as_float(u & 0xffff0000u); }
__device__ __forceinline__ float silu_f(float x) { return x * __builtin_amdgcn_rcpf(1.f + __builtin_amdgcn_exp2f(-x * LOG2E)); }
__device__ __forceinline__ float wsum(float v) {
#pragma unroll
    for (int o = 32; o > 0; o >>= 1) v += __shfl_xor(v, o);
    return v;
}

constexpr size_t MiB = 1u << 20;
constexpr size_t WS_CTL = 0, CTL_ZERO_BYTES = 1 * MiB;
constexpr size_t WS_MODS = 256 * 1024;
constexpr size_t WS_BIAS = 1 * MiB;
constexpr size_t WS_GS = 1 * MiB + 256 * 1024;
constexpr size_t WS_ROPE64 = 1 * MiB + 512 * 1024;
constexpr size_t WS_ROPE32 = 1 * MiB + 768 * 1024;
constexpr size_t WS_SSQ = 2 * MiB;
constexpr size_t WS_CQSSQ = 2 * MiB + 512 * 1024;
constexpr size_t WS_S0T = 3 * MiB;
constexpr size_t WS_CGK = 4 * MiB, WS_CGV = 6 * MiB, WS_CCKV = 8 * MiB, WS_CKPE = 10 * MiB;
constexpr size_t WS_WIN = 11 * MiB;
constexpr size_t WS_WOUT = 34 * MiB;
constexpr size_t WS_WUQ = 42 * MiB;
constexpr size_t WS_WUKV = 43 * MiB + 256 * 1024;
constexpr size_t WS_XG = 44 * MiB;
constexpr size_t WS_KVM = 130 * MiB;
constexpr size_t WS_KVMC = 142 * MiB;
constexpr size_t WS_RQ = 60 * MiB, WS_RK = 64 * MiB, WS_RV = 68 * MiB;
constexpr size_t WS_GQ = 72 * MiB;
constexpr size_t WS_GK = 78 * MiB, WS_GV = 80 * MiB;
constexpr size_t WS_CQG = 82 * MiB;
constexpr size_t WS_CKVN = 86 * MiB;
constexpr size_t WS_KPEB = 88 * MiB;
constexpr size_t WS_ZS = 89 * MiB;
constexpr size_t WS_QM = 105 * MiB;
constexpr size_t WS_Y = 114 * MiB;
constexpr size_t WS_XSDBG = 130 * MiB;
constexpr size_t WS_XB = 146 * MiB;
constexpr size_t WS_OPT_END = 162 * MiB;
constexpr int CW_QUEUE = 1024;
constexpr int CW_FLAG = 2048;
constexpr int CW_YRDY = 1536;
constexpr int CW_XRDY = 1280;
constexpr int CW_RA = 8192;
constexpr int CW_FULL = 8704;
constexpr int CW_ZC = 9216;
constexpr int CW_KC = 9728;
constexpr int CW_XGR = 9856;
constexpr int CW_SD = 10368;
constexpr int CW_P1X = 10656;
constexpr int CW_P1B0 = 10784;
constexpr int CW_P1DONE = 10788;
constexpr int CW_BAR = 4096;

constexpr size_t O_STATE = 8388608, O_GK = 10485760, O_GV = 12582912, O_CKV = 14680064, O_KPE = 16777216;

constexpr int NWAVE = 8;
constexpr int GST = 49152;
constexpr int GST2 = 65536;
constexpr int LDS_OST = GST2;
constexpr int LDS_EX = 135168;
constexpr int LDS_EXB = 137216;
constexpr int LDS_SCAL = 141312;
constexpr int LDS_MISC = 142336;
constexpr int LDS_BYTES = 142592;

struct Params { const float* in[22]; float* out; unsigned char* ws; float* xs; int ph_lo, ph_hi; };
enum { I_XP = 0, I_XS, I_STATE, I_CGK, I_CGV, I_CCKV, I_CKPE, I_C, I_CCTX, I_NORMG, I_WADA, I_BADA, I_WIN, I_DECAY, I_GQN, I_GKN, I_MQN, I_MKVN, I_WUQ, I_WUKV, I_WOUT, I_FNORM };

#define XB_TMO      128
#define XB_XCNT(j)  (256  + 64 * (j))
#define XB_XSUB(j)  (1280 + 64 * (j))
#define XB_XGEN(j)  (2304 + 64 * (j))
#define XB_TOP      3328
#define XB_TOPGEN   3392
#define XB_SPIN_CAP (1u << 20)
__device__ __forceinline__ unsigned xb_ld(unsigned* p) { return __hip_atomic_load(p, __ATOMIC_RELAXED, __HIP_MEMORY_SCOPE_AGENT); }
__device__ __forceinline__ unsigned xb_add(unsigned* p, unsigned v) { return __hip_atomic_fetch_add(p, v, __ATOMIC_RELAXED, __HIP_MEMORY_SCOPE_AGENT); }
__device__ __forceinline__ unsigned xb_xcc_id() { return (unsigned)__builtin_amdgcn_s_getreg((3 << 11) | 20) & 0xFu; }
#define XB_SPIN(cond, bar) do { unsigned _sp = 0; while (cond) { __builtin_amdgcn_s_sleep(1); \
    if ((++_sp & 255u) == 0u) { if (xb_ld(&(bar)[XB_TMO])) break; if (_sp > XB_SPIN_CAP) { atomicAdd(&(bar)[XB_TMO], 1u); break; } } } } while (0)
__device__ __forceinline__ int lane_id() { int ln = (int)__builtin_amdgcn_mbcnt_hi(~0u, __builtin_amdgcn_mbcnt_lo(~0u, 0u)); asm volatile("" : "+v"(ln)); return ln; }
__device__ __forceinline__ void poll_lanes(unsigned* ptr, unsigned target, bool active, unsigned* bar0) {
    unsigned sp = 0u;
    for (;;) {
        unsigned v = target;
        if (active) v = xb_ld(ptr);
        if (!__any(v < target)) break;
        __builtin_amdgcn_s_sleep(1);
        if ((++sp & 255u) == 0u) { if (xb_ld(&bar0[XB_TMO])) break; if (sp > XB_SPIN_CAP) { atomicAdd(&bar0[XB_TMO], 1u); break; } }
    }
}
struct XcdBarrier { unsigned* bar; unsigned x; volatile LAS unsigned* st; int w; };
__device__ __forceinline__ XcdBarrier xcd_barrier_post(unsigned* bar, volatile LAS unsigned* st) {
    XcdBarrier b; b.bar = bar; b.x = xb_xcc_id(); b.st = st; b.w = 0;
    if (threadIdx.x == 0) (void)xb_add(&bar[XB_XCNT(b.x)], 1u);
    return b;
}
__device__ __forceinline__ void xcd_barrier_complete(unsigned* bar, unsigned x, unsigned& nloc, unsigned& nx) {
    const unsigned G = gridDim.x * gridDim.y * gridDim.z;
    unsigned sum, cnt, mine, sp = 0u;
    for (;;) {
        sum = 0u; cnt = 0u; mine = 0u;
#pragma unroll
        for (unsigned j = 0; j < 16; ++j) { const unsigned c = xb_ld(&bar[XB_XCNT(j)]); sum += c; cnt += (c > 0u) ? 1u : 0u; mine = (j == x) ? c : mine; }
        if (sum == G) break;
        __builtin_amdgcn_s_sleep(1);
        if ((++sp & 255u) == 0u) { if (xb_ld(&bar[XB_TMO])) break; if (sp > XB_SPIN_CAP) { atomicAdd(&bar[XB_TMO], 1u); break; } }
    }
    nloc = mine > 0u ? mine : 1u; nx = cnt > 0u ? cnt : 1u;
}
__device__ __forceinline__ void xcd_barrier(const XcdBarrier& b) {
    asm volatile("s_waitcnt vmcnt(0)" ::: "memory");
    __syncthreads();
    if (b.w == 0 && __builtin_amdgcn_mbcnt_hi(~0u, __builtin_amdgcn_mbcnt_lo(~0u, 0u)) == 0u) {
        unsigned* bar = b.bar;
        __builtin_amdgcn_s_waitcnt(0);
        unsigned nloc = b.st[0], nx = b.st[1];
        if (nloc == 0u) { xcd_barrier_complete(bar, b.x, nloc, nx); b.st[0] = nloc; b.st[1] = nx; }
        const unsigned old = xb_add(&bar[XB_XSUB(b.x)], 1u);
        const unsigned gen = old / nloc;
        if (old + 1u == (gen + 1u) * nloc) {
            __builtin_amdgcn_fence(__ATOMIC_RELEASE, "agent");
            asm volatile("s_waitcnt vmcnt(0)" ::: "memory");
            const unsigned og = xb_add(&bar[XB_TOP], 1u);
            const unsigned tg = og / nx;
            if (og + 1u == (tg + 1u) * nx) xb_add(&bar[XB_TOPGEN], 1u);
            else XB_SPIN(xb_ld(&bar[XB_TOPGEN]) == tg, bar);
            xb_add(&bar[XB_XGEN(b.x)], 1u);
            __builtin_amdgcn_fence(__ATOMIC_ACQUIRE, "agent");
            asm volatile("s_waitcnt vmcnt(0)" ::: "memory");
        } else {
            XB_SPIN(xb_ld(&bar[XB_XGEN(b.x)]) == gen, bar);
            __builtin_amdgcn_fence(__ATOMIC_ACQUIRE, "agent");
            asm volatile("s_waitcnt vmcnt(0)" ::: "memory");
        }
    }
    __syncthreads();
}

typedef const float* cfp_t;
typedef const __attribute__((address_space(4))) cfp_t* karg_t;
struct Frame {
    LAS unsigned char* lds;
    int tid, lane, w, h, lq;
    unsigned char* ws;
    karg_t karg;
};
__device__ __forceinline__ const float* pin(const Frame& F, int i) { return F.karg[i]; }
__device__ __forceinline__ bool is_t0(const Frame& F) { return F.w == 0 && __builtin_amdgcn_mbcnt_hi(~0u, __builtin_amdgcn_mbcnt_lo(~0u, 0u)) == 0u; }
#define GLDS16(gsrc, ldsdst) __builtin_amdgcn_global_load_lds((const unsigned*)(gsrc), (LAS unsigned*)(ldsdst), 16, 0, 0)
#define ST16_WT(ptr, val) asm volatile("global_store_dwordx4 %0, %1, off sc1\n\ts_nop 1" :: "v"(ptr), "v"(val) : "memory")
#define MFMA32(a, b, c) __builtin_amdgcn_mfma_f32_32x32x16_bf16((a), (b), (c), 0, 0, 0)

struct GemmOp { const bf16_t* W; const bf16_t* X; int ldw, ldx, K; };
__device__ __forceinline__ void gemm_issue0(const Frame& F, const GemmOp& g) {
    const int lane = F.lane, w = F.w;
#pragma unroll
    for (int q = 0; q < 2; ++q) { const int row = 16 * w + 8 * q + (lane >> 3); GLDS16(g.W + row * g.ldw + ((lane & 7) ^ ((row >> 1) & 7)) * 8, F.lds + (16 * w + 8 * q) * 128); }
#pragma unroll
    for (int q = 0; q < 4; ++q) { const int row = 32 * w + 8 * q + (lane >> 3); GLDS16(g.X + row * g.ldx + ((lane & 7) ^ ((row >> 1) & 7)) * 8, F.lds + 16384 + (32 * w + 8 * q) * 128); }
}
typedef f32x4 GemmAcc[4][4];
__device__ __forceinline__ void gemm_core(const Frame& F, const GemmOp& g, GemmAcc& acc, bool issue_first, bool has_next, const GemmOp& gn) {
    const int lane = F.lane, w = F.w;
    const bf16_t* __restrict__ W = g.W; const bf16_t* __restrict__ X = g.X;
    const int nkt = g.K >> 6;
    int offW[2], offX[4];
#pragma unroll
    for (int q = 0; q < 2; ++q) { const int row = 16 * w + 8 * q + (lane >> 3); offW[q] = row * g.ldw + ((lane & 7) ^ ((row >> 1) & 7)) * 8; }
#pragma unroll
    for (int q = 0; q < 4; ++q) { const int row = 32 * w + 8 * q + (lane >> 3); offX[q] = row * g.ldx + ((lane & 7) ^ ((row >> 1) & 7)) * 8; }
    LAS unsigned char* const dW = F.lds + (16 * w) * 128;
    LAS unsigned char* const dX = F.lds + 16384 + (32 * w) * 128;
#define GC_ISSUE(kt, st) do { _Pragma("unroll") for (int q = 0; q < 2; ++q) GLDS16(W + offW[q] + (kt) * 64, dW + (st) * GST + q * 1024); \
        _Pragma("unroll") for (int q = 0; q < 4; ++q) GLDS16(X + offX[q] + (kt) * 64, dX + (st) * GST + q * 1024); } while (0)
    const int wn = w & 1, wm = w >> 1, c15 = lane & 15, g4 = lane >> 4;
    const int sw = (c15 >> 1) & 7;
    int so[2];
#pragma unroll
    for (int s = 0; s < 2; ++s) so[s] = ((4 * s + g4) ^ sw) << 4;
    const int bn0 = (64 * wn + c15) * 128, bm0 = 16384 + (64 * wm + c15) * 128;
#pragma unroll
    for (int a = 0; a < 4; ++a)
#pragma unroll
        for (int b = 0; b < 4; ++b) acc[a][b] = (f32x4){0.f, 0.f, 0.f, 0.f};
    if (issue_first) GC_ISSUE(0, 0);
    asm volatile("s_waitcnt vmcnt(0)" ::: "memory");
    __syncthreads();
    for (int kt = 0; kt < nkt; ++kt) {
        const int st = kt & 1;
        if (kt + 1 < nkt) GC_ISSUE(kt + 1, st ^ 1);
        LAS unsigned char* const base = F.lds + st * GST;
#pragma unroll
        for (int s = 0; s < 2; ++s) {
            bf16x8 fa[4], fb[4];
#pragma unroll
            for (int q = 0; q < 4; ++q) { fa[q] = *(const LAS bf16x8*)(base + bn0 + q * 2048 + so[s]); fb[q] = *(const LAS bf16x8*)(base + bm0 + q * 2048 + so[s]); }
#pragma unroll
            for (int a = 0; a < 4; ++a)
#pragma unroll
                for (int b = 0; b < 4; ++b) acc[a][b] = __builtin_amdgcn_mfma_f32_16x16x32_bf16(fa[a], fb[b], acc[a][b], 0, 0, 0);
        }
        asm volatile("s_waitcnt vmcnt(0)" ::: "memory");
        __syncthreads();
    }
#undef GC_ISSUE
    if (has_next) gemm_issue0(F, gn);
}

typedef f32x4 GemmAcc8[4][8];
__device__ __forceinline__ void gemm256_issue0(const Frame& F, const bf16_t* W, const bf16_t* X) {
    int lane = F.lane; const int w = F.w;
    asm volatile("" : "+v"(lane));
#pragma unroll
    for (int q = 0; q < 4; ++q) {
        const int row = 32 * w + 8 * q + (lane >> 3), off = row * 1024 + ((lane & 7) ^ ((row >> 1) & 7)) * 8;
        GLDS16(W + off, F.lds + (32 * w + 8 * q) * 128);
        GLDS16(X + off, F.lds + 32768 + (32 * w + 8 * q) * 128);
    }
}
__device__ __forceinline__ void gemm_core256(const Frame& F, const bf16_t* __restrict__ W, const bf16_t* __restrict__ X, GemmAcc8& acc, bool issue_first, bool has_next, const bf16_t* Wn, const bf16_t* Xn) {
    int lane = F.lane; const int w = F.w;
    asm volatile("" : "+v"(lane));
    int off[4];
#pragma unroll
    for (int q = 0; q < 4; ++q) { const int row = 32 * w + 8 * q + (lane >> 3); off[q] = row * 1024 + ((lane & 7) ^ ((row >> 1) & 7)) * 8; }
    LAS unsigned char* const dW = F.lds + (32 * w) * 128;
    LAS unsigned char* const dX = F.lds + 32768 + (32 * w) * 128;
#define GC2_ISSUE(kt, st) do { _Pragma("unroll") for (int q = 0; q < 4; ++q) { GLDS16(W + off[q] + (kt) * 64, dW + (st) * GST2 + q * 1024); GLDS16(X + off[q] + (kt) * 64, dX + (st) * GST2 + q * 1024); } } while (0)
    const int wn4 = w & 3, wm2 = w >> 2, c15 = lane & 15, g4 = lane >> 4;
    const int sw = (c15 >> 1) & 7;
    int so[2];
#pragma unroll
    for (int s = 0; s < 2; ++s) so[s] = ((4 * s + g4) ^ sw) << 4;
    const int bn0 = (64 * wn4 + c15) * 128, bm0 = 32768 + (128 * wm2 + c15) * 128;
#pragma unroll
    for (int a = 0; a < 4; ++a)
#pragma unroll
        for (int b = 0; b < 8; ++b) acc[a][b] = (f32x4){0.f, 0.f, 0.f, 0.f};
    if (issue_first) GC2_ISSUE(0, 0);
    asm volatile("s_waitcnt vmcnt(0)" ::: "memory");
    __syncthreads();
    for (int kt = 0; kt < 16; ++kt) {
        const int st = kt & 1;
        if (kt + 1 < 16) GC2_ISSUE(kt + 1, st ^ 1);
        LAS unsigned char* const base = F.lds + st * GST2;
#pragma unroll
        for (int s = 0; s < 2; ++s) {
            bf16x8 fa[4];
#pragma unroll
            for (int q = 0; q < 4; ++q) fa[q] = *(const LAS bf16x8*)(base + bn0 + q * 2048 + so[s]);
#pragma unroll
            for (int hb = 0; hb < 2; ++hb) {
                bf16x8 fb[4];
#pragma unroll
                for (int q = 0; q < 4; ++q) fb[q] = *(const LAS bf16x8*)(base + bm0 + (4 * hb + q) * 2048 + so[s]);
#pragma unroll
                for (int a = 0; a < 4; ++a)
#pragma unroll
                    for (int b = 0; b < 4; ++b) acc[a][4 * hb + b] = __builtin_amdgcn_mfma_f32_16x16x32_bf16(fa[a], fb[b], acc[a][4 * hb + b], 0, 0, 0);
            }
        }
        asm volatile("s_waitcnt vmcnt(0)" ::: "memory");
        __syncthreads();
    }
#undef GC2_ISSUE
    if (has_next) gemm256_issue0(F, Wn, Xn);
}

__device__ __forceinline__ void rope64_16(float (&v)[4][4], float rowp, float colp, int g4) {
#pragma unroll
    for (int i = 0; i < 4; ++i) {
        const float fr = __builtin_amdgcn_exp2f((float)(4 * g4 + i) * -0.8304820237218406f) * 0.15915494309189535f;
#pragma unroll
        for (int c = 0; c < 2; ++c) {
            const float rev = (c ? colp : rowp) * fr;
            const float sn = __builtin_amdgcn_sinf(rev), cs = __builtin_amdgcn_cosf(rev);
            const float x0 = v[2 * c][i], x1 = v[2 * c + 1][i];
            v[2 * c][i] = x0 * cs - x1 * sn;
            v[2 * c + 1][i] = x1 * cs + x0 * sn;
        }
    }
}
__device__ __forceinline__ void rope32_16(float (&a)[4], float (&b)[4], float rowp, float colp, int g4) {
    const bool hi = g4 >= 2;
#pragma unroll
    for (int i = 0; i < 4; ++i) {
        const float fr = __builtin_amdgcn_exp2f((float)(4 * (g4 & 1) + i) * -1.6609640474436813f) * 0.15915494309189535f;
        {
            const float rev = rowp * fr;
            const float sn = __builtin_amdgcn_sinf(rev), cs = __builtin_amdgcn_cosf(rev);
            const float own = a[i], oth = __shfl_xor(own, 32);
            a[i] = own * cs + oth * (hi ? sn : -sn);
        }
        {
            const float rev = colp * fr;
            const float sn = __builtin_amdgcn_sinf(rev), cs = __builtin_amdgcn_cosf(rev);
            const float own = b[i], oth = __shfl_xor(own, 32);
            b[i] = own * cs + oth * (hi ? sn : -sn);
        }
    }
}
__device__ __forceinline__ float ssq64(const float (&v)[4][4]) {
    float s = 0.f;
#pragma unroll
    for (int nt = 0; nt < 4; ++nt)
#pragma unroll
        for (int i = 0; i < 4; ++i) s += v[nt][i] * v[nt][i];
    s += __shfl_xor(s, 16);
    s += __shfl_xor(s, 32);
    return s;
}
__device__ __forceinline__ void mulvec64(float (&v)[4][4], const LAS float* gv, int g4) {
#pragma unroll
    for (int nt = 0; nt < 4; ++nt) {
        const f32x4 q = *(const LAS f32x4*)(gv + 16 * nt + 4 * g4);
#pragma unroll
        for (int i = 0; i < 4; ++i) v[nt][i] *= q[i];
    }
}
constexpr int OST_LD = 68, OST_BYTES = 32 * OST_LD * 4;
__device__ __forceinline__ void stage_write16(LAS float* st, const float (&v)[4][4], int mh, int c15, int g4) {
    asm volatile("s_waitcnt lgkmcnt(0)" ::: "memory");
    __builtin_amdgcn_wave_barrier();
#pragma unroll
    for (int nt = 0; nt < 4; ++nt) {
        f32x4 o = {v[nt][0], v[nt][1], v[nt][2], v[nt][3]};
        *(LAS f32x4*)(st + (16 * mh + c15) * OST_LD + 16 * nt + 4 * g4) = o;
    }
    asm volatile("s_waitcnt lgkmcnt(0)" ::: "memory");
    __builtin_amdgcn_wave_barrier();
}
__device__ __forceinline__ void stage_write16a(LAS float* st, const f32x4 (&a)[4][4], int mt, int c15, int g4) {
    asm volatile("s_waitcnt lgkmcnt(0)" ::: "memory");
    __builtin_amdgcn_wave_barrier();
#pragma unroll
    for (int nt = 0; nt < 4; ++nt) *(LAS f32x4*)(st + (16 * (mt & 1) + c15) * OST_LD + 16 * nt + 4 * g4) = a[nt][mt];
    asm volatile("s_waitcnt lgkmcnt(0)" ::: "memory");
    __builtin_amdgcn_wave_barrier();
}
__device__ __forceinline__ void stage_store_bf16(const LAS float* st, bf16_t* dst, int ld, float sc, int lane) {
#pragma unroll 1
    for (int it = 0; it < 4; ++it) {
        const int row = it * 8 + (lane >> 3), c8 = (lane & 7) * 8;
        const f32x4 x0 = *(const LAS f32x4*)(st + row * OST_LD + c8), x1 = *(const LAS f32x4*)(st + row * OST_LD + c8 + 4);
        u32x4 o; o.x = pk2(x0[0] * sc, x0[1] * sc); o.y = pk2(x0[2] * sc, x0[3] * sc); o.z = pk2(x1[0] * sc, x1[1] * sc); o.w = pk2(x1[2] * sc, x1[3] * sc);
        ST16_WT(dst + (size_t)row * ld + c8, o);
    }
}
__device__ __forceinline__ void stage_store_bf16_sc1(const LAS float* st, bf16_t* dst, int ld, int lane) {
#pragma unroll 1
    for (int it = 0; it < 4; ++it) {
        const int row = it * 8 + (lane >> 3), c8 = (lane & 7) * 8;
        const f32x4 x0 = *(const LAS f32x4*)(st + row * OST_LD + c8), x1 = *(const LAS f32x4*)(st + row * OST_LD + c8 + 4);
        u32x4 o; o.x = pk2(x0[0], x0[1]); o.y = pk2(x0[2], x0[3]); o.z = pk2(x1[0], x1[1]); o.w = pk2(x1[2], x1[3]);
        bf16_t* ptr = dst + (size_t)row * ld + c8;
        asm volatile("global_store_dwordx4 %0, %1, off sc1\n\ts_nop 1" :: "v"(ptr), "v"(o) : "memory");
    }
}
__device__ __forceinline__ void stage_store_f32(const LAS float* st, float* dst, int ld, int lane) {
#pragma unroll 1
    for (int it = 0; it < 8; ++it) {
        const int row = it * 4 + (lane >> 4), c = (lane & 15) * 4;
        { const f32x4 o = *(const LAS f32x4*)(st + row * OST_LD + c); ST16_WT(dst + (size_t)row * ld + c, o); }
    }
}
__device__ __forceinline__ void stage_store_bf16_32(const LAS float* st, bf16_t* dst, int ld, int lane) {
#pragma unroll 1
    for (int it = 0; it < 2; ++it) {
        const int row = it * 16 + (lane >> 2), c8 = (lane & 3) * 8;
        const f32x4 x0 = *(const LAS f32x4*)(st + row * OST_LD + c8), x1 = *(const LAS f32x4*)(st + row * OST_LD + c8 + 4);
        u32x4 o; o.x = pk2(x0[0], x0[1]); o.y = pk2(x0[2], x0[3]); o.z = pk2(x1[0], x1[1]); o.w = pk2(x1[2], x1[3]);
        ST16_WT(dst + (size_t)row * ld + c8, o);
    }
}
__device__ __forceinline__ void stage_store_f32_32(const LAS float* st, float* dst, int ld, int lane) {
#pragma unroll 1
    for (int it = 0; it < 4; ++it) {
        const int row = it * 8 + (lane >> 3), c = (lane & 7) * 4;
        { const f32x4 o = *(const LAS f32x4*)(st + row * OST_LD + c); ST16_WT(dst + (size_t)row * ld + c, o); }
    }
}

struct Gemm1Pre { float rstd[2]; float bias, gain; };
__device__ __forceinline__ void gemm1_pre(const Frame& F, const Params& p, int tn, int wn, int tm, int l, Gemm1Pre& P) {
    const float* ssqp = (const float*)(F.ws + WS_SSQ);
#pragma unroll
    for (int jj = 0; jj < 2; ++jj) {
        const int tok = tm * 256 + (F.w >> 2) * 128 + 64 * jj + F.lane;
        const f32x4* sp = (const f32x4*)(ssqp + (size_t)tok * 16);
        float ss = 0.f;
#pragma unroll
        for (int i = 0; i < 4; ++i) { const f32x4 q = sp[i]; ss += (q[0] + q[1]) + (q[2] + q[3]); }
        P.rstd[jj] = rsqrtf(ss * (1.f / 1024.f) + EPS);
    }
    const bool lat = tm >= 16;
    const int cond = lat ? 1 + ((tm - 16) >> 2) : 0;
    const int nb = tn * 128 + wn * 64;
    P.bias = (tn < 23) ? ((const float*)(F.ws + WS_BIAS))[(size_t)(l * 5 + cond) * 2944 + nb + F.lane] : 0.f;
    const float* gp = nullptr;
    if (tn >= 6 && tn < 9) gp = pin(F, I_GQN) + l * 64;
    else if (tn == 9) gp = pin(F, I_GKN) + l * 64;
    else if (tn == 11 || tn == 12) gp = pin(F, I_MQN) + l * 256 + (nb - 1408);
    else if (tn == 13) gp = pin(F, I_MKVN) + l * 128 + wn * 64;
    P.gain = gp ? gp[F.lane] : 1.f;
}
__device__ __forceinline__ void epi_gemm1(const Frame& F, const Params& p, GemmAcc8& acc, int tn, int wn, int tm, int l, const Gemm1Pre& P, bool ckv_tile) {
    int lane = F.lane; const int wm = F.w >> 2;
    asm volatile("" : "+v"(lane));
    const int c15 = lane & 15, g4 = lane >> 4;
    unsigned char* ws = F.ws;
    asm volatile("" : "+s"(ws));
    LAS float* st = (LAS float*)(F.lds + LDS_OST + F.w * OST_BYTES);
    const bool lat = tm >= 16;
    const int b = lat ? ((tm - 16) >> 2) : tm;
    const int nb = tn * 128 + wn * 64;
    LAS float* exb = (LAS float*)(F.lds + LDS_EXB) + F.w * 128;
    exb[lane] = P.bias; exb[64 + lane] = P.gain;
    asm volatile("s_waitcnt lgkmcnt(0)" ::: "memory");
    __builtin_amdgcn_wave_barrier();
    const LAS float* bias = exb;
    float* outp = p.out;
    asm volatile("" : "+s"(outp));
    float ckv_ss[8];
    if (tn < 23) {
#pragma unroll
    for (int mt = 0; mt < 8; ++mt) {
        const int mh = mt & 1;
        const int tok0 = tm * 256 + wm * 128 + (mt >> 1) * 32;
        const int tokb = tok0 + 16 * mh, tok = tokb + c15;
        const int t0 = lat ? ((tok0 - 4096) & 1023) : (tok0 & 255), t = t0 + 16 * mh + c15;
        const float rstd = __shfl(P.rstd[mt >> 2], 16 * (mt & 3) + c15);
        float v[4][4];
#pragma unroll
        for (int nt = 0; nt < 4; ++nt) {
            const f32x4 bq = *(const LAS f32x4*)(bias + 16 * nt + 4 * g4);
#pragma unroll
            for (int i = 0; i < 4; ++i) v[nt][i] = acc[nt][mt][i] * rstd + bq[i];
        }
        const float rowp = (float)(t >> 6), colp = (float)(t & 63);
        const size_t orow0 = (size_t)(b * 4 + l) * 256 + t0;
        if (tn < 2) {
            if (lat) rope64_16(v, rowp, colp, g4);
            stage_write16(st, v, mh, c15, g4);
            if (mh) stage_store_bf16(st, (bf16_t*)(ws + WS_RQ) + (size_t)tok0 * 256 + nb, 256, 1.f, lane);
        } else if (tn < 4) {
            if (lat) rope64_16(v, rowp, colp, g4);
            stage_write16(st, v, mh, c15, g4);
            if (mh) stage_store_bf16(st, (bf16_t*)(ws + WS_RK) + (size_t)tok0 * 256 + (nb - 256), 256, 0.125f, lane);
        } else if (tn < 6) {
            stage_write16(st, v, mh, c15, g4);
            if (mh) stage_store_bf16(st, (bf16_t*)(ws + WS_RV) + (size_t)tok0 * 256 + (nb - 512), 256, 1.f, lane);
        } else if (tn < 9) {
            const float r = rsqrtf(ssq64(v) * (1.f / 64.f) + EPS);
#pragma unroll
            for (int nt = 0; nt < 4; ++nt)
#pragma unroll
                for (int i = 0; i < 4; ++i) v[nt][i] *= r;
            mulvec64(v, exb + 64, g4);
            if (lat) rope64_16(v, rowp, colp, g4);
            stage_write16(st, v, mh, c15, g4);
            if (mh) stage_store_bf16(st, (bf16_t*)(ws + WS_GQ) + (size_t)tok0 * 384 + (nb - 768), 384, QSC_GQA, lane);
        } else if (tn == 9) {
            const float r = rsqrtf(ssq64(v) * (1.f / 64.f) + EPS);
#pragma unroll
            for (int nt = 0; nt < 4; ++nt)
#pragma unroll
                for (int i = 0; i < 4; ++i) v[nt][i] *= r;
            mulvec64(v, exb + 64, g4);
            if (lat) rope64_16(v, rowp, colp, g4);
            stage_write16(st, v, mh, c15, g4);
            if (mh) {
                if (!lat) stage_store_f32(st, outp + O_GK + orow0 * 128 + (nb - 1152), 128, lane);
                stage_store_bf16(st, (bf16_t*)(ws + WS_GK) + (size_t)tok0 * 128 + (nb - 1152), 128, 1.f, lane);
            }
        } else if (tn == 10) {
            stage_write16(st, v, mh, c15, g4);
            if (mh) {
                if (!lat) stage_store_f32(st, outp + O_GV + orow0 * 128 + (nb - 1280), 128, lane);
                stage_store_bf16(st, (bf16_t*)(ws + WS_GV) + (size_t)tok0 * 128 + (nb - 1280), 128, 1.f, lane);
            }
        } else if (tn < 13) {
            const float s2 = ssq64(v);
            if (g4 == 0) __hip_atomic_store((__attribute__((address_space(1))) float*)((float*)(ws + WS_CQSSQ) + (size_t)tok * 4 + ((nb - 1408) >> 6)), s2, __ATOMIC_RELAXED, __HIP_MEMORY_SCOPE_AGENT);
            mulvec64(v, exb + 64, g4);
            stage_write16(st, v, mh, c15, g4);
            if (mh) stage_store_bf16_sc1(st, (bf16_t*)(ws + WS_CQG) + (size_t)tok0 * 256 + (nb - 1408), 256, lane);
        } else if (tn == 13) {
            ckv_ss[mt] = ssq64(v);
            if (g4 == 0) ((LAS float*)(F.lds + LDS_EX))[(wm * 2 + wn) * 128 + mt * 16 + c15] = ckv_ss[mt];
        } else if (tn < 22) {
#pragma unroll
            for (int nt = 0; nt < 4; ++nt)
#pragma unroll
                for (int i = 0; i < 4; ++i) v[nt][i] = silu_f(v[nt][i]);
            stage_write16(st, v, mh, c15, g4);
            if (mh) stage_store_bf16(st, (bf16_t*)(ws + WS_ZS) + (size_t)tok0 * 1024 + (nb - 1792), 1024, 1.f, lane);
        } else {
            if (wn == 0) {
                if (lat) rope32_16(v[0], v[1], rowp, colp, g4);
                stage_write16(st, v, mh, c15, g4);
                if (mh) {
                    if (!lat) stage_store_f32_32(st, outp + O_KPE + orow0 * 32, 32, lane);
                    stage_store_bf16_32(st, (bf16_t*)(ws + WS_KPEB) + (size_t)tok0 * 32, 32, lane);
                }
            }
        }
    }
    }
    if (ckv_tile) {
        __syncthreads();
        if (tn == 13) {
#pragma unroll
        for (int mt = 0; mt < 8; ++mt) {
            const int mh = mt & 1;
            const int tok0 = tm * 256 + wm * 128 + (mt >> 1) * 32;
            const int t0 = lat ? ((tok0 - 4096) & 1023) : (tok0 & 255);
            const float rstd = __shfl(P.rstd[mt >> 2], 16 * (mt & 3) + c15);
            float v[4][4];
#pragma unroll
            for (int nt = 0; nt < 4; ++nt) {
                const f32x4 bq = *(const LAS f32x4*)(bias + 16 * nt + 4 * g4);
#pragma unroll
                for (int i = 0; i < 4; ++i) v[nt][i] = acc[nt][mt][i] * rstd + bq[i];
            }
            const float tot = ckv_ss[mt] + ((const LAS float*)(F.lds + LDS_EX))[(wm * 2 + (wn ^ 1)) * 128 + mt * 16 + c15];
            const float r = rsqrtf(tot * (1.f / 128.f) + EPS);
#pragma unroll
            for (int nt = 0; nt < 4; ++nt)
#pragma unroll
                for (int i = 0; i < 4; ++i) v[nt][i] *= r;
            mulvec64(v, exb + 64, g4);
            const size_t orow0 = (size_t)(b * 4 + l) * 256 + t0;
            stage_write16(st, v, mh, c15, g4);
            if (mh) {
                if (!lat) stage_store_f32(st, outp + O_CKV + orow0 * 128 + wn * 64, 128, lane);
                stage_store_bf16_sc1(st, (bf16_t*)(ws + WS_CKVN) + (size_t)tok0 * 128 + wn * 64, 128, lane);
            }
        }
        }
        __syncthreads();
    }
}

__device__ __forceinline__ void qm_pre(const Frame& F, int tm, float& rstd) {
    const int tok = tm * 256 + (F.w >> 1) * 64 + F.lane;
    const f32x4 q4 = *(const f32x4*)((const float*)(F.ws + WS_CQSSQ) + (size_t)tok * 4);
    rstd = rsqrtf(((q4[0] + q4[1]) + (q4[2] + q4[3])) * (1.f / 256.f) + EPS);
}
__device__ __forceinline__ void epi_qm(const Frame& F, GemmAcc& acc, int tn, int tm, float rstdl) {
    int lane = F.lane; const int wn = F.w & 1, wm = F.w >> 1;
    asm volatile("" : "+v"(lane));
    const int c15 = lane & 15, g4 = lane >> 4;
    unsigned char* ws = F.ws;
    LAS float* st = (LAS float*)(F.lds + LDS_OST + F.w * OST_BYTES);
    const bool lat = tm >= 16;
    const int nb = tn * 128 + wn * 64;
    if (nb >= 576) return;
#pragma unroll
    for (int mt = 0; mt < 4; ++mt) {
        const int mh = mt & 1;
        const int tok0 = tm * 256 + wm * 64 + (mt >> 1) * 32, tok = tok0 + 16 * mh + c15;
        const int t = lat ? ((tok - 4096) & 1023) : (tok & 255);
        const float rstd = __shfl(rstdl, 16 * mt + c15);
        const float rowp = (float)(t >> 6), colp = (float)(t & 63);
        float v[4][4];
#pragma unroll
        for (int nt = 0; nt < 4; ++nt)
#pragma unroll
            for (int i = 0; i < 4; ++i) v[nt][i] = acc[nt][mt][i] * rstd;
#pragma unroll
        for (int q = 0; q < 2; ++q) {
            const int T = (nb + 32 * q) >> 5;
            if (lat && (T % 3) == 2) rope32_16(v[2 * q], v[2 * q + 1], rowp, colp, g4);
        }
        stage_write16(st, v, mh, c15, g4);
        if (mh) stage_store_bf16(st, (bf16_t*)(ws + WS_QM) + (size_t)tok0 * 576 + nb, 576, QSC_MLA, lane);
    }
}
__device__ __forceinline__ void epi_plain(const Frame& F, GemmAcc& acc, bf16_t* D, int ldd, int row0, int n0) {
    int lane = F.lane; const int wn = F.w & 1, wm = F.w >> 1;
    asm volatile("" : "+v"(lane));
    const int c15 = lane & 15, g4 = lane >> 4;
    LAS float* st = (LAS float*)(F.lds + LDS_OST + F.w * OST_BYTES);
#pragma unroll
    for (int mt = 0; mt < 4; ++mt) {
        const int r0 = row0 + wm * 64 + (mt >> 1) * 32;
        stage_write16a(st, acc, mt, c15, g4);
        if (mt & 1) stage_store_bf16(st, D + (size_t)r0 * ldd + n0 + wn * 64, ldd, 1.f, lane);
    }
}

struct Gemm2Pre { f32x4 gt0, gt1, gs0, gs1; };
__device__ __forceinline__ void gemm2_pre(const Frame& F, int tn, int tm, int l, Gemm2Pre& P) {
    const bool lat = tm >= 16; const int cond = lat ? 1 + ((tm - 16) >> 2) : 0;
    const int nb = tn * 128 + (F.w & 1) * 64, c8 = (F.lane & 7) * 8;
    const float* gtp = (const float*)(F.ws + WS_MODS) + (size_t)(l * 5 + cond) * 3072 + 2048 + nb + c8;
    const float* gsp = (const float*)(F.ws + WS_GS) + (size_t)((l < 3 ? l + 1 : 3) * 5 + cond) * 1024 + nb + c8;
    P.gt0 = *(const f32x4*)gtp; P.gt1 = *(const f32x4*)(gtp + 4);
    P.gs0 = *(const f32x4*)gsp; P.gs1 = *(const f32x4*)(gsp + 4);
}
__device__ __forceinline__ void epi_gemm2(const Frame& F, const Params& p, GemmAcc& acc, int tn, int tm, int l, const Gemm2Pre& P, bool last) {
    int lane = F.lane; const int wn = F.w & 1, wm = F.w >> 1;
    asm volatile("" : "+v"(lane));
    const int c15 = lane & 15, g4 = lane >> 4;
    unsigned char* ws = F.ws;
    LAS float* st = (LAS float*)(F.lds + LDS_OST + F.w * OST_BYTES);
    const bool lat = tm >= 16;
    const int nb = tn * 128 + wn * 64;
    const int c8 = (lane & 7) * 8, r8 = lane >> 3;
#pragma unroll
    for (int mt = 0; mt < 2; ++mt) {
        const int tok0 = tm * 256 + wm * 64 + mt * 32;
        stage_write16a(st, acc, 2 * mt, c15, g4);
        stage_write16a(st, acc, 2 * mt + 1, c15, g4);
        bf16_t* xb0 = (bf16_t*)(ws + WS_XB) + (size_t)tok0 * 1024 + nb + c8;
        f32x4 xo8[8];
        if (l == 0) {
            const float* xold0 = lat ? pin(F, I_XS) + (size_t)(tok0 - 4096) * 1024 : pin(F, I_XP) + (size_t)tok0 * 1024;
#pragma unroll
            for (int it = 0; it < 4; ++it) {
                const float* xp = xold0 + (size_t)(it * 8 + r8) * 1024 + nb + c8;
                xo8[2 * it] = *(const f32x4*)xp; xo8[2 * it + 1] = *(const f32x4*)(xp + 4);
            }
        } else {
#pragma unroll
            for (int it = 0; it < 4; ++it) {
                const u32x4 q = *(const u32x4*)(xb0 + (size_t)(it * 8 + r8) * 1024);
                xo8[2 * it] = (f32x4){bflo(q.x), bfhi(q.x), bflo(q.y), bfhi(q.y)}; xo8[2 * it + 1] = (f32x4){bflo(q.z), bfhi(q.z), bflo(q.w), bfhi(q.w)};
            }
        }
#pragma unroll
        for (int it = 0; it < 4; ++it) {
            const int row = it * 8 + r8;
            const f32x4 a0 = *(const LAS f32x4*)(st + row * OST_LD + c8), a1 = *(const LAS f32x4*)(st + row * OST_LD + c8 + 4);
            const f32x4 xn0 = xo8[2 * it] + P.gt0 * a0, xn1 = xo8[2 * it + 1] + P.gt1 * a1;
            {
                u32x4 o; o.x = pk2(xn0[0], xn0[1]); o.y = pk2(xn0[2], xn0[3]); o.z = pk2(xn1[0], xn1[1]); o.w = pk2(xn1[2], xn1[3]);
                if (last) ST16_WT(xb0 + (size_t)row * 1024, o); else *(u32x4*)(xb0 + (size_t)row * 1024) = o;
            }
            float ss = ((xn0[0] * xn0[0] + xn0[1] * xn0[1]) + (xn0[2] * xn0[2] + xn0[3] * xn0[3])) + ((xn1[0] * xn1[0] + xn1[1] * xn1[1]) + (xn1[2] * xn1[2] + xn1[3] * xn1[3]));
            ss += __shfl_xor(ss, 1); ss += __shfl_xor(ss, 2); ss += __shfl_xor(ss, 4);
            if ((lane & 7) == 0) {
                float* sq = (float*)(ws + WS_SSQ) + (size_t)(tok0 + row) * 16 + tn * 2 + wn;
                __hip_atomic_store((__attribute__((address_space(1))) float*)sq, ss, __ATOMIC_RELAXED, __HIP_MEMORY_SCOPE_AGENT);
            }
            if (l < 3) {
                u32x4 o; o.x = pk2(xn0[0] * P.gs0[0], xn0[1] * P.gs0[1]); o.y = pk2(xn0[2] * P.gs0[2], xn0[3] * P.gs0[3]);
                o.z = pk2(xn1[0] * P.gs1[0], xn1[1] * P.gs1[1]); o.w = pk2(xn1[2] * P.gs1[2], xn1[3] * P.gs1[3]);
                ST16_WT((bf16_t*)(ws + WS_XG) + (size_t)(tok0 + row) * 1024 + nb + c8, o);
            }
        }
    }
}
constexpr int AT_STG = 20480, AT_PE = 8192, AT_V = 12288, AT_OLD = 68;
struct AttnUnit {
    int mode;
    int nt0, nt1;
    const bf16_t *q; int q_ld;
    const bf16_t *k0, *k1; int k_ld0, k_ld1;
    const bf16_t *pe0, *pe1;
    const bf16_t *v0, *v1; int v_ld0, v_ld1;
    int tok0;
    int ycol;
    int qpos0, L;
    float lf, lb;
    const bf16_t *s0f, *s0b;
    unsigned* zflag;
    unsigned* yflag;
    float* st_out;
};
__device__ __forceinline__ s16x4 tr16(LAS const unsigned char* p) {
    typedef short v4i16_t __attribute__((ext_vector_type(4)));
    return __builtin_bit_cast(s16x4, __builtin_amdgcn_ds_read_tr16_b64_v4i16((LAS v4i16_t*)p));
}

template <int MODE>
__device__ __forceinline__ void attn_unit(const Frame& F, const Params& p, const AttnUnit& U) {
    constexpr int NQS = MODE == 1 ? 6 : 4;
    int lane = F.lane; const int w = F.w;
    asm volatile("" : "+v"(lane));
    const int h = lane >> 5, lq = lane & 31;
    LAS unsigned char* lds = F.lds;
    const int k_ld = U.k_ld1, v_ld = U.v_ld1;
    const int krow = 8 * w + (lane >> 3);
    const int koff = krow * k_ld + ((lane & 7) ^ ((krow >> 1) & 7)) * 8;
    const int poff = (16 * (w & 3) + (lane >> 2)) * 32 + ((lane & 3) ^ ((lane >> 4) & 3)) * 8;
    const int vdblk = w >> 2, vkg = w & 3;
    const int voff = (16 * vkg + (lane >> 2)) * v_ld + vdblk * 32 + (lane & 3) * 8;
    const int vdst = AT_V + vdblk * 4096 + vkg * 1024;
    const int nt0 = U.nt0, ntot = U.nt0 + U.nt1;
    const unsigned ldsb = (unsigned)(uintptr_t)lds;
#define AT_DMA(gsrc, ldsoff) do { unsigned _keep; const unsigned _d = (unsigned)__builtin_amdgcn_readfirstlane((int)(ldsb + (unsigned)(ldsoff))); \
        asm volatile("s_mov_b32 %0, m0\n\ts_mov_b32 m0, %2\n\ts_nop 0\n\tglobal_load_lds_dwordx4 %1, off\n\ts_mov_b32 m0, %0" : "=&s"(_keep) : "v"(gsrc), "s"(_d) : "memory"); } while (0)
#define AT_ISSUE(t, st) do { const int _t = (t); const int _b = (st) * AT_STG; \
        const bool _s0 = _t < nt0; const int _u = _s0 ? _t : _t - nt0; \
        const bf16_t* _kb = (_s0 ? U.k0 : U.k1) + (size_t)_u * 64 * k_ld; const bf16_t* _vb = (_s0 ? U.v0 : U.v1) + (size_t)_u * 64 * v_ld; \
        AT_DMA(_kb + koff, _b + (8 * w) * 128); \
        if (MODE == 1) { const bf16_t* _pb = (_s0 ? U.pe0 : U.pe1) + (size_t)_u * 64 * 32; AT_DMA(_pb + poff, _b + AT_PE + 16 * (w & 3) * 64); } \
        AT_DMA(_vb + voff, _b + vdst); } while (0)
    AT_ISSUE(0, 0);
    if (ntot > 1) AT_ISSUE(1, 1);
    bf16x8 qr[NQS];
    if (MODE == 3) {
        const int dk = 32 * (w & 1) + lq;
#pragma unroll
        for (int s = 0; s < 4; ++s)
#pragma unroll
            for (int j = 0; j < 8; ++j) qr[s][j] = (16 * s + 8 * h + j == dk) ? (short)0x3F80 : (short)0;
    } else {
        const bf16_t* qp = U.q + (size_t)(32 * w + lq) * U.q_ld + 8 * h;
#pragma unroll
        for (int s = 0; s < NQS; ++s) qr[s] = *(const bf16x8*)(qp + 16 * s);
    }
    f32x16 o[2];
#pragma unroll
    for (int d = 0; d < 2; ++d)
#pragma unroll
        for (int r = 0; r < 16; ++r) o[d][r] = 0.f;
    float m_run = 0.f, l_run = 0.f;
    f32x16 negm;
#pragma unroll
    for (int r = 0; r < 16; ++r) negm[r] = 0.f;
    const int qpos = U.qpos0 + 32 * w + lq;
    const float st_slope = ((w >> 1) & 1) ? U.lb : -U.lf, st_off = ((w >> 1) & 1) ? 0.f : 255.f * U.lf;
    const int sdir = (w >> 1) & 1;
    LAS float* scal = (LAS float*)(lds + LDS_SCAL) + w * 32;
    LAS float* ctab = (LAS float*)(lds + LDS_EXB) + w * 128;
    float a_f = 0.f, a_b = 0.f;
    if (MODE == 2) {
        ctab[lane] = __builtin_amdgcn_exp2f((float)(63 - lane) * U.lf);
        ctab[64 + lane] = __builtin_amdgcn_exp2f((float)lane * U.lb);
        a_f = __builtin_amdgcn_exp2f((float)(32 * w + lq) * U.lf);
        a_b = __builtin_amdgcn_exp2f((float)(255 - 32 * w - lq) * U.lb);
        asm volatile("s_waitcnt lgkmcnt(0)" ::: "memory");
        __builtin_amdgcn_wave_barrier();
    }
    const int kfo = lq * 128, sw = (lane >> 1) & 7, pfo = AT_PE + lq * 64, psw = (lane >> 2) & 3;
    const int vfo = AT_V + (4 * h + ((lane & 15) >> 2)) * 64 + ((lane >> 4) & 1) * 32 + (lane & 3) * 8;
    int st = 0;
    for (int t = 0; t < ntot; ++t) {
        if (t + 1 < ntot) { if (MODE == 1) asm volatile("s_waitcnt vmcnt(3)" ::: "memory"); else asm volatile("s_waitcnt vmcnt(2)" ::: "memory"); }
        else asm volatile("s_waitcnt vmcnt(0)" ::: "memory");
        __builtin_amdgcn_s_barrier();
        asm volatile("" ::: "memory");
        const int st2 = st == 0 ? 2 : st - 1;
        if (t + 2 < ntot) AT_ISSUE(t + 2, st2);
        LAS const unsigned char* base = lds + st * AT_STG;
        bf16x8 kfa[NQS], kfb[NQS];
#pragma unroll
        for (int s = 0; s < 4; ++s) {
            const int so = ((2 * s + h) ^ sw) << 4;
            kfa[s] = *(const LAS bf16x8*)(base + kfo + so);
            kfb[s] = *(const LAS bf16x8*)(base + kfo + 4096 + so);
        }
        if (MODE == 1) {
#pragma unroll
            for (int s = 0; s < 2; ++s) {
                const int so = ((2 * s + h) ^ psw) << 4;
                kfa[4 + s] = *(const LAS bf16x8*)(base + pfo + so);
                kfb[4 + s] = *(const LAS bf16x8*)(base + pfo + 2048 + so);
            }
        }
        f32x16 p0, p1;
        if (MODE <= 1) { p0 = negm; p1 = negm; }
        else {
#pragma unroll
            for (int r = 0; r < 16; ++r) { p0[r] = 0.f; p1[r] = 0.f; }
        }
#pragma unroll
        for (int s = 0; s < NQS; ++s) { p0 = MFMA32(kfa[s], qr[s], p0); p1 = MFMA32(kfb[s], qr[s], p1); }
        s16x4 vlo[4], vhi[4];
#pragma unroll
        for (int ks = 0; ks < 4; ++ks) { vlo[ks] = tr16(base + vfo + ks * 1024); vhi[ks] = tr16(base + vfo + ks * 1024 + 512); }
        if (MODE <= 1) {
            float tm = p0[0];
#pragma unroll
            for (int r = 1; r < 16; ++r) tm = fmaxf(tm, p0[r]);
#pragma unroll
            for (int r = 0; r < 16; ++r) tm = fmaxf(tm, p1[r]);
            tm = fmaxf(tm, __shfl_xor(tm, 32));
            if (t == 0 || __any(tm > 6.0f)) {
                const float dl = t == 0 ? tm : fmaxf(tm, 0.f);
                m_run += dl;
#pragma unroll
                for (int r = 0; r < 16; ++r) { p0[r] -= dl; p1[r] -= dl; negm[r] = -m_run; }
                if (t > 0) {
                    const float alpha = __builtin_amdgcn_exp2f(-dl);
                    l_run *= alpha;
                    if (h == 0) scal[lq] = alpha;
                    asm volatile("s_waitcnt lgkmcnt(0)" ::: "memory");
#pragma unroll
                    for (int g = 0; g < 4; ++g) {
                        const f32x4 a4 = *(const LAS f32x4*)(scal + 8 * g + 4 * h);
#pragma unroll
                        for (int i = 0; i < 4; ++i) { o[0][4 * g + i] *= a4[i]; o[1][4 * g + i] *= a4[i]; }
                    }
                }
            }
            float ls = 0.f;
#pragma unroll
            for (int r = 0; r < 16; ++r) { p0[r] = __builtin_amdgcn_exp2f(p0[r]); p1[r] = __builtin_amdgcn_exp2f(p1[r]); ls += p0[r] + p1[r]; }
            l_run += ls;
        } else if (MODE == 2 && (64 * t + 63 < U.qpos0 || 64 * t > U.qpos0 + 255)) {
            const bool fwd = 64 * t + 63 < U.qpos0;
            const float A = fwd ? a_f * __builtin_amdgcn_exp2f((float)(U.qpos0 - 64 * t - 63) * U.lf) : a_b * __builtin_amdgcn_exp2f((float)(64 * t - U.qpos0 - 255) * U.lb);
            const LAS float* tb = ctab + (fwd ? 0 : 64) + 4 * h;
#pragma unroll
            for (int g = 0; g < 4; ++g) {
                const f32x4 c0 = *(const LAS f32x4*)(tb + 8 * g), c1 = *(const LAS f32x4*)(tb + 32 + 8 * g);
#pragma unroll
                for (int i = 0; i < 4; ++i) { p0[4 * g + i] *= c0[i] * A; p1[4 * g + i] *= c1[i] * A; }
            }
        } else if (MODE == 2) {
            float dq = (float)(qpos - 64 * t - 4 * h);
            asm volatile("" : "+v"(dq));
#pragma unroll
            for (int r = 0; r < 16; ++r) {
                const float d0 = dq - (float)((r & 3) + 8 * (r >> 2)), d1 = d0 - 32.f;
                const float w0 = __builtin_amdgcn_exp2f(fabsf(d0) * (d0 > 0.f ? U.lf : U.lb));
                const float w1 = __builtin_amdgcn_exp2f(fabsf(d1) * (d1 > 0.f ? U.lf : U.lb));
                p0[r] *= (d0 == 0.f ? 2.f : w0);
                p1[r] *= (d1 == 0.f ? 2.f : w1);
            }
        } else {
            float mb = (float)(64 * t + 4 * h);
            asm volatile("" : "+v"(mb));
#pragma unroll
            for (int r = 0; r < 16; ++r) {
                const float m0 = mb + (float)((r & 3) + 8 * (r >> 2)), m1 = m0 + 32.f;
                const float e0 = fmaf(m0, st_slope, st_off), e1 = fmaf(m1, st_slope, st_off);
                p0[r] *= __builtin_amdgcn_exp2f(e0);
                p1[r] *= __builtin_amdgcn_exp2f(e1);
            }
        }
        bf16x8 pa[4];
        { u32x4 a;
          a.x = pk2(p0[0], p0[1]); a.y = pk2(p0[2], p0[3]); a.z = pk2(p0[4], p0[5]); a.w = pk2(p0[6], p0[7]); pa[0] = __builtin_bit_cast(bf16x8, a);
          a.x = pk2(p0[8], p0[9]); a.y = pk2(p0[10], p0[11]); a.z = pk2(p0[12], p0[13]); a.w = pk2(p0[14], p0[15]); pa[1] = __builtin_bit_cast(bf16x8, a);
          a.x = pk2(p1[0], p1[1]); a.y = pk2(p1[2], p1[3]); a.z = pk2(p1[4], p1[5]); a.w = pk2(p1[6], p1[7]); pa[2] = __builtin_bit_cast(bf16x8, a);
          a.x = pk2(p1[8], p1[9]); a.y = pk2(p1[10], p1[11]); a.z = pk2(p1[12], p1[13]); a.w = pk2(p1[14], p1[15]); pa[3] = __builtin_bit_cast(bf16x8, a); }
#pragma unroll
        for (int ks = 0; ks < 4; ++ks) {
            const bf16x8 vb = __builtin_shufflevector(vlo[ks], vhi[ks], 0, 1, 2, 3, 4, 5, 6, 7);
            o[0] = MFMA32(pa[ks], vb, o[0]);
        }
#pragma unroll
        for (int ks = 0; ks < 4; ++ks) { vlo[ks] = tr16(base + vfo + 4096 + ks * 1024); vhi[ks] = tr16(base + vfo + 4096 + ks * 1024 + 512); }
#pragma unroll
        for (int ks = 0; ks < 4; ++ks) {
            const bf16x8 vb = __builtin_shufflevector(vlo[ks], vhi[ks], 0, 1, 2, 3, 4, 5, 6, 7);
            o[1] = MFMA32(pa[ks], vb, o[1]);
        }
        st = st == 2 ? 0 : st + 1;
    }
#undef AT_ISSUE
#undef AT_DMA
    int lq2 = lq, h2 = h, lane2 = lane; asm volatile("" : "+v"(lq2), "+v"(h2), "+v"(lane2));
    if (MODE == 2 && U.s0f != nullptr) {
        const float ff = __builtin_amdgcn_exp2f((float)(qpos + 1) * U.lf), fb = __builtin_amdgcn_exp2f((float)(U.L - qpos) * U.lb);
#pragma unroll
        for (int s = 0; s < 4; ++s) {
            const u32x4 qu = __builtin_bit_cast(u32x4, qr[s]);
            u32x4 af, ab;
#pragma unroll
            for (int i = 0; i < 4; ++i) { const float lo = bflo(qu[i]), hi = bfhi(qu[i]); af[i] = pk2(lo * ff, hi * ff); ab[i] = pk2(lo * fb, hi * fb); }
#pragma unroll
            for (int d = 0; d < 2; ++d) {
                const bf16x8 sf = *(const bf16x8*)(U.s0f + (size_t)(32 * d + lq2) * 64 + 16 * s + 8 * h2);
                const bf16x8 sb = *(const bf16x8*)(U.s0b + (size_t)(32 * d + lq2) * 64 + 16 * s + 8 * h2);
                o[d] = MFMA32(__builtin_bit_cast(bf16x8, af), sf, o[d]);
                o[d] = MFMA32(__builtin_bit_cast(bf16x8, ab), sb, o[d]);
            }
        }
    }
    if (MODE == 3) {
        float* dst = U.st_out + (size_t)sdir * 4 * 4096 + (size_t)(32 * (w & 1)) * 64;
        if (w < 4) {
#pragma unroll
        for (int d = 0; d < 2; ++d)
#pragma unroll
            for (int r = 0; r < 16; ++r) dst[(size_t)((r & 3) + 8 * (r >> 2) + 4 * h2) * 64 + 32 * d + lq2] = o[d][r];
        }
        __syncthreads();
        if (F.tid == 0 && U.yflag != nullptr) (void)xb_add(U.yflag, 1u);
        return;
    }
    if (MODE <= 1) {
        l_run += __shfl_xor(l_run, 32);
        if (h2 == 0) scal[lq2] = 1.f / l_run;
    }
    if (U.zflag != nullptr && F.tid == 0) {
        unsigned* bar0 = (unsigned*)(F.ws + WS_CTL) + CW_BAR;
        XB_SPIN(xb_ld(U.zflag) < 4u, bar0);
    }
    __syncthreads();
    LAS float* ost = (LAS float*)lds + w * (32 * AT_OLD);
#pragma unroll
    for (int d = 0; d < 2; ++d)
#pragma unroll
        for (int r = 0; r < 16; ++r) ost[((r & 3) + 8 * (r >> 2) + 4 * h2) * AT_OLD + 32 * d + lq2] = o[d][r];
    asm volatile("s_waitcnt lgkmcnt(0)" ::: "memory");
    __builtin_amdgcn_wave_barrier();
    const bf16_t* zs = (const bf16_t*)(F.ws + WS_ZS);
    bf16_t* yb = (bf16_t*)(F.ws + WS_Y);
#pragma unroll
    for (int it = 0; it < 4; ++it) {
        const int row = it * 8 + (lane2 >> 3), c8 = (lane2 & 7) * 8;
        const f32x4 x0 = *(const LAS f32x4*)(ost + row * AT_OLD + c8), x1 = *(const LAS f32x4*)(ost + row * AT_OLD + c8 + 4);
        float sc;
        if (MODE <= 1) sc = scal[row];
        else {
            float ss = (x0[0] * x0[0] + x0[1] * x0[1]) + (x0[2] * x0[2] + x0[3] * x0[3]) + (x1[0] * x1[0] + x1[1] * x1[1]) + (x1[2] * x1[2] + x1[3] * x1[3]);
            ss += __shfl_xor(ss, 1); ss += __shfl_xor(ss, 2); ss += __shfl_xor(ss, 4);
            sc = rsqrtf(ss * (1.f / 64.f) + EPS);
        }
        const size_t off = (size_t)(U.tok0 + 32 * w + row) * 1024 + U.ycol + c8;
        const u32x4 z = *(const u32x4*)(zs + off);
        u32x4 y;
        y.x = pk2(x0[0] * sc * bflo(z.x), x0[1] * sc * bfhi(z.x));
        y.y = pk2(x0[2] * sc * bflo(z.y), x0[3] * sc * bfhi(z.y));
        y.z = pk2(x1[0] * sc * bflo(z.z), x1[1] * sc * bfhi(z.z));
        y.w = pk2(x1[2] * sc * bflo(z.w), x1[3] * sc * bfhi(z.w));
        ST16_WT(yb + off, y);
    }
    asm volatile("s_waitcnt vmcnt(0)" ::: "memory");
    __syncthreads();
    if (F.tid == 0) (void)xb_add(U.yflag, 1u);
}

__device__ __forceinline__ void dep_wait(const Frame& F, unsigned* c, int n, unsigned target, unsigned* c2 = nullptr, unsigned target2 = 0u) {
    if (F.w == 0) {
        const int ln = lane_id();
        unsigned* ptr = c + 4 * ln; unsigned tgt = target;
        if (c2 != nullptr && ln == n) { ptr = c2; tgt = target2; }
        poll_lanes(ptr, tgt, ln < n + (c2 != nullptr ? 1 : 0), (unsigned*)(F.ws + WS_CTL) + CW_BAR);
    }
}
__device__ __forceinline__ void attn_dispatch(const Frame& F, const Params& p, int u, int l) {
    unsigned char* ws = F.ws;
    AttnUnit U;
    U.nt0 = 0; U.nt1 = 0; U.q = nullptr; U.q_ld = 0; U.k0 = U.k1 = nullptr; U.k_ld0 = U.k_ld1 = 0; U.pe0 = U.pe1 = nullptr; U.v0 = U.v1 = nullptr; U.v_ld0 = U.v_ld1 = 0;
    U.tok0 = 0; U.ycol = 0; U.qpos0 = 0; U.L = 0; U.lf = U.lb = 0.f; U.s0f = U.s0b = nullptr; U.st_out = nullptr; U.mode = 0; U.yflag = nullptr; U.zflag = nullptr;
    const bf16_t* GQ = (const bf16_t*)(ws + WS_GQ); const bf16_t* GK = (const bf16_t*)(ws + WS_GK); const bf16_t* GV = (const bf16_t*)(ws + WS_GV);
    const bf16_t* QM = (const bf16_t*)(ws + WS_QM); const bf16_t* KVM = (const bf16_t*)(ws + WS_KVM); const bf16_t* KVMC = (const bf16_t*)(ws + WS_KVMC);
    const bf16_t* KPEB = (const bf16_t*)(ws + WS_KPEB); const bf16_t* CKPE = (const bf16_t*)(ws + WS_CKPE);
    const bf16_t* CGK = (const bf16_t*)(ws + WS_CGK); const bf16_t* CGV = (const bf16_t*)(ws + WS_CGV);
    const bf16_t* RQ = (const bf16_t*)(ws + WS_RQ); const bf16_t* RK = (const bf16_t*)(ws + WS_RK); const bf16_t* RV = (const bf16_t*)(ws + WS_RV);
    const float* decay = pin(F, I_DECAY) + l * 8;
    if (u < 96 || (u >= 256 && u < 352)) {
        const bool lat = u < 96; const int uu = lat ? u : u - 256;
        const int b = lat ? uu / 24 : uu / 6, hh = lat ? (uu >> 2) % 6 : uu % 6, qb = lat ? (uu & 3) : 0;
        const int seq0 = lat ? 4096 + b * 1024 : b * 256;
        U.mode = 1; U.tok0 = seq0 + qb * 256; U.q = QM + (size_t)U.tok0 * 576 + hh * 96; U.q_ld = 576; U.ycol = 640 + hh * 64;
        U.nt1 = lat ? 16 : 4; U.k1 = KVM + (size_t)seq0 * 768 + hh * 128; U.k_ld1 = 768; U.v1 = U.k1 + 64; U.v_ld1 = 768; U.pe1 = KPEB + (size_t)seq0 * 32;
        U.k0 = U.k1; U.v0 = U.v1; U.pe0 = U.pe1; U.k_ld0 = 768; U.v_ld0 = 768;
        if (lat) { U.nt0 = 8; U.k0 = KVMC + (size_t)(b * 512) * 768 + hh * 128; U.v0 = U.k0 + 64; U.pe0 = CKPE + (size_t)((b * 4 + l) * 512) * 32; }
        U.yflag = (unsigned*)(ws + WS_CTL) + CW_YRDY + (l * 32 + (U.tok0 >> 8)) * 4;
        { unsigned* c = (unsigned*)(ws + WS_CTL);
          dep_wait(F, c + CW_FULL + (l * 32 + (seq0 >> 8)) * 4, lat ? 4 : 1, 23u, lat ? c + CW_KC + (l * 4 + b) * 4 : nullptr, 12u); }
        __syncthreads();
        attn_unit<1>(F, p, U);
    } else if (u < 192 || (u >= 352 && u < 448)) {
        const bool lat = u < 192; const int uu = lat ? u - 96 : u - 352;
        const int b = lat ? uu / 24 : uu / 6, hh = lat ? (uu >> 2) % 6 : uu % 6, qb = lat ? (uu & 3) : 0, kvh = hh / 3;
        const int seq0 = lat ? 4096 + b * 1024 : b * 256;
        U.mode = 0; U.tok0 = seq0 + qb * 256; U.q = GQ + (size_t)U.tok0 * 384 + hh * 64; U.q_ld = 384; U.ycol = 256 + hh * 64;
        U.nt1 = lat ? 16 : 4; U.k1 = GK + (size_t)seq0 * 128 + kvh * 64; U.k_ld1 = 128; U.v1 = GV + (size_t)seq0 * 128 + kvh * 64; U.v_ld1 = 128;
        U.k0 = U.k1; U.v0 = U.v1; U.k_ld0 = 128; U.v_ld0 = 128;
        if (lat) { U.nt0 = 8; U.k0 = CGK + (size_t)((b * 4 + l) * 512) * 128 + kvh * 64; U.v0 = CGV + (size_t)((b * 4 + l) * 512) * 128 + kvh * 64; }
        U.yflag = (unsigned*)(ws + WS_CTL) + CW_YRDY + (l * 32 + (U.tok0 >> 8)) * 4;
        { unsigned* c = (unsigned*)(ws + WS_CTL);
          dep_wait(F, c + CW_RA + (l * 32 + (seq0 >> 8)) * 4, lat ? 4 : 1, 8u);
          U.zflag = c + CW_ZC + (l * 32 + (U.tok0 >> 8)) * 4; }
        __syncthreads();
        attn_unit<0>(F, p, U);
    } else if (u < 256 || (u >= 448 && u < 512)) {
        const bool lat = u < 256; const int uu = lat ? u - 192 : u - 448;
        const int b = lat ? uu / 16 : uu / 4, hh = lat ? (uu >> 2) & 3 : uu & 3, qb = lat ? (uu & 3) : 0;
        const int seq0 = lat ? 4096 + b * 1024 : b * 256;
        U.mode = 2; U.tok0 = seq0 + qb * 256; U.q = RQ + (size_t)U.tok0 * 256 + hh * 64; U.q_ld = 256; U.ycol = hh * 64;
        U.nt1 = lat ? 16 : 4; U.k1 = RK + (size_t)seq0 * 256 + hh * 64; U.k_ld1 = 256; U.v1 = RV + (size_t)seq0 * 256 + hh * 64; U.v_ld1 = 256;
        U.k0 = U.k1; U.v0 = U.v1; U.k_ld0 = 256; U.v_ld0 = 256;
        U.qpos0 = qb * 256; U.L = lat ? 1024 : 256;
        U.lf = -log1pf(__expf(-decay[hh])) * LOG2E; U.lb = -log1pf(__expf(-decay[4 + hh])) * LOG2E;
        if (lat) { const bf16_t* S0T = (const bf16_t*)(ws + WS_S0T); U.s0f = S0T + (size_t)(((b * 4 + l) * 2 + 0) * 4 + hh) * 4096; U.s0b = S0T + (size_t)(((b * 4 + l) * 2 + 1) * 4 + hh) * 4096; }
        U.yflag = (unsigned*)(ws + WS_CTL) + CW_YRDY + (l * 32 + (U.tok0 >> 8)) * 4;
        { unsigned* c = (unsigned*)(ws + WS_CTL);
          dep_wait(F, c + CW_RA + (l * 32 + (seq0 >> 8)) * 4, lat ? 4 : 1, 8u);
          U.zflag = c + CW_ZC + (l * 32 + (U.tok0 >> 8)) * 4; }
        __syncthreads();
        attn_unit<2>(F, p, U);
    } else {
        const int uu = u - 512, b = uu >> 2, hh = uu & 3, seq0 = b * 256;
        U.mode = 3; U.nt1 = 4; U.k1 = RK + (size_t)seq0 * 256 + hh * 64; U.k_ld1 = 256; U.v1 = RV + (size_t)seq0 * 256 + hh * 64; U.v_ld1 = 256;
        U.k0 = U.k1; U.v0 = U.v1; U.k_ld0 = 256; U.v_ld0 = 256;
        U.lf = -log1pf(__expf(-decay[hh])) * LOG2E; U.lb = -log1pf(__expf(-decay[4 + hh])) * LOG2E;
        U.st_out = p.out + O_STATE + (size_t)(((b * 4 + l) * 2 + 0) * 4 + hh) * 4096;
        dep_wait(F, (unsigned*)(ws + WS_CTL) + CW_RA + (l * 32 + b) * 4, 1, 8u);
        U.yflag = (unsigned*)(ws + WS_CTL) + CW_SD + (l * 16 + b) * 4;
        __syncthreads();
        attn_unit<3>(F, p, U);
    }
}
constexpr int N_ATTN_UNITS = 576;
struct TItem { const float* src; bf16_t* dst; int nsrc, K; int valid; };
constexpr int P0_TWIN = 4 * 16 * 92, P0_TWOUT = 4 * 16 * 32, P0_TWUQ = 4 * 4 * 20, P0_TWUKV = 4 * 2 * 24, P0_TR = P0_TWIN + P0_TWOUT + P0_TWUQ + P0_TWUKV;
__device__ __forceinline__ TItem p0_titem(const Frame& F, unsigned char* ws, int it) {
    TItem t; t.valid = it < P0_TR; t.src = nullptr; t.dst = nullptr; t.nsrc = 0; t.K = 0;
    if (!t.valid) return t;
    if (it < P0_TWIN) {
        const int l = it / (16 * 92), r = it % (16 * 92), kb = r / 92, nb = r % 92, n0 = nb * 32;
        const int src = n0 < 1792 ? n0 : (n0 < 2816 ? n0 + 32 : (n0 < 2848 ? n0 - 2816 + 1792 : -1));
        t.nsrc = 2848; t.K = 1024;
        if (src >= 0) t.src = pin(F, I_WIN) + (size_t)l * 1024 * 2848 + (size_t)(kb * 64) * 2848 + src;
        t.dst = (bf16_t*)(ws + WS_WIN) + ((size_t)l * 2944 + n0) * 1024 + kb * 64;
        return t;
    }
    it -= P0_TWIN;
    if (it < P0_TWOUT) {
        const int l = it / 512, r = it % 512, kb = r >> 5, nb = r & 31;
        t.nsrc = 1024; t.K = 1024; t.src = pin(F, I_WOUT) + (size_t)l * 1024 * 1024 + (size_t)(kb * 64) * 1024 + nb * 32;
        t.dst = (bf16_t*)(ws + WS_WOUT) + ((size_t)l * 1024 + nb * 32) * 1024 + kb * 64;
        return t;
    }
    it -= P0_TWOUT;
    if (it < P0_TWUQ) {
        const int l = it / 80, r = it % 80, kb = r / 20, nb = r % 20;
        t.nsrc = 576; t.K = 256; if (nb < 18) t.src = pin(F, I_WUQ) + (size_t)l * 256 * 576 + (size_t)(kb * 64) * 576 + nb * 32;
        t.dst = (bf16_t*)(ws + WS_WUQ) + ((size_t)l * 640 + nb * 32) * 256 + kb * 64;
        return t;
    }
    it -= P0_TWUQ;
    { const int l = it / 48, r = it % 48, kb = r / 24, nb = r % 24;
      t.nsrc = 768; t.K = 128; t.src = pin(F, I_WUKV) + (size_t)l * 128 * 768 + (size_t)(kb * 64) * 768 + nb * 32;
      t.dst = (bf16_t*)(ws + WS_WUKV) + ((size_t)l * 768 + nb * 32) * 128 + kb * 64; }
    return t;
}
__device__ __forceinline__ void p0_tload(const TItem& t, float (&r)[32], int lane) {
    if (t.valid && t.src) {
        const float* wp = t.src + (size_t)(lane >> 5) * t.nsrc + (lane & 31);
#pragma unroll
        for (int i = 0; i < 32; ++i) r[i] = wp[(size_t)(2 * i) * t.nsrc];
    } else {
#pragma unroll
        for (int i = 0; i < 32; ++i) r[i] = 0.f;
    }
}
__device__ __forceinline__ void p0_tstore(const TItem& t, const float (&r)[32], LAS float* scr, int lane) {
    if (!t.valid) return;
#pragma unroll
    for (int i = 0; i < 32; ++i) scr[(2 * i + (lane >> 5)) * 33 + (lane & 31)] = r[i];
    asm volatile("s_waitcnt lgkmcnt(0)" ::: "memory");
    __builtin_amdgcn_wave_barrier();
    const int c = lane & 7;
#pragma unroll
    for (int j = 0; j < 4; ++j) {
        const int n = (lane >> 3) + 8 * j; const LAS float* s = scr + (8 * c) * 33 + n;
        u32x4 o; o.x = pk2(s[0 * 33], s[1 * 33]); o.y = pk2(s[2 * 33], s[3 * 33]); o.z = pk2(s[4 * 33], s[5 * 33]); o.w = pk2(s[6 * 33], s[7 * 33]);
        ST16_WT(t.dst + (size_t)n * t.K + 8 * c, o);
    }
    asm volatile("s_waitcnt lgkmcnt(0)" ::: "memory");
    __builtin_amdgcn_wave_barrier();
}
__device__ __forceinline__ void cast8(const float* src, bf16_t* dst, size_t e) {
    const f32x4 a = *(const f32x4*)(src + e), b = *(const f32x4*)(src + e + 4);
    u32x4 o; o.x = pk2(a[0], a[1]); o.y = pk2(a[2], a[3]); o.z = pk2(b[0], b[1]); o.w = pk2(b[2], b[3]);
    ST16_WT(dst + e, o);
}
constexpr int P0_MODS = 1536, P0_CAST_G = 512, P0_CAST_KPE = 128, P0_S0T = 512;
constexpr int P0_TOTAL = P0_MODS + 3 * P0_CAST_G + P0_CAST_KPE + P0_S0T;
__device__ __forceinline__ void phase0(const Frame& F, const Params& p, bool dup = false) {
    unsigned char* ws = F.ws + (dup ? 162 * MiB : 0); const int lane = F.lane;
    LAS float* scr = (LAS float*)F.lds + F.w * (64 * 33);
    const int gw = blockIdx.x * NWAVE + F.w, ngw = gridDim.x * NWAVE;
#ifndef MK_DUP0
#define MK_DUP0_ 0
#else
#define MK_DUP0_ MK_DUP0
#endif
    if (!(dup && MK_DUP0_ == 2))
    for (int it = gw; it < P0_TR; it += 2 * ngw) {
        const TItem t0 = p0_titem(F, ws, it), t1 = p0_titem(F, ws, it + ngw);
        float r0[32], r1[32];
        p0_tload(t0, r0, lane); p0_tload(t1, r1, lane);
        p0_tstore(t0, r0, scr, lane); p0_tstore(t1, r1, scr, lane);
    }
    if (!(dup && MK_DUP0_ == 1))
    for (int it0 = (gw + ngw - 256) % ngw; it0 < P0_TOTAL; it0 += ngw) {
        int it = it0;
        if (it < P0_MODS) {
            const int l = it / 384, cg = (it % 384) >> 5, ks = it & 31;
            const int j = cg * 256 + lane * 4;
            const float* wp = pin(F, I_WADA) + ((size_t)l * 1024 + ks * 32) * 3072 + j;
            const float* c = pin(F, I_C); const float* cc = pin(F, I_CCTX);
            float sv[3];
#pragma unroll
            for (int q = 0; q < 3; ++q) {
                const int idx = q * 64 + lane, n = idx >> 5, k = idx & 31;
                float x = 0.f;
                if (idx < 160) x = (n == 0) ? cc[ks * 32 + k] : c[(n - 1) * 1024 + ks * 32 + k];
                sv[q] = silu_f(x);
            }
            f32x4 acc[5];
#pragma unroll
            for (int n = 0; n < 5; ++n) acc[n] = (f32x4){0.f, 0.f, 0.f, 0.f};
#pragma unroll 1
            for (int k0 = 0; k0 < 32; k0 += 16) {
                f32x4 wv[16];
#pragma unroll
                for (int k = 0; k < 16; ++k) wv[k] = *(const f32x4*)(wp + (size_t)(k0 + k) * 3072);
                __builtin_amdgcn_sched_barrier(0);
#pragma unroll
                for (int k = 0; k < 16; ++k)
#pragma unroll
                    for (int n = 0; n < 5; ++n) {
                        const float s = __int_as_float(__builtin_amdgcn_readlane(__float_as_int(sv[n >> 1]), 32 * (n & 1) + k0 + k));
                        acc[n] += wv[k] * s;
                    }
            }
            LAS f32x4* red = (LAS f32x4*)(F.lds + 69632);
#pragma unroll
            for (int n = 0; n < 5; ++n) red[(F.w * 5 + n) * 64 + lane] = acc[n];
            __syncthreads();
            if (F.tid < 320) {
                const int n = F.tid >> 6;
                f32x4 s = red[n * 64 + lane];
#pragma unroll
                for (int ww = 1; ww < 8; ++ww) s += red[(ww * 5 + n) * 64 + lane];
                if ((ks >> 3) == 0) s += *(const f32x4*)(pin(F, I_BADA) + l * 3072 + j);
                float* mods = (float*)(ws + WS_MODS) + (size_t)(l * 5 + n) * 3072 + j;
#pragma unroll
                for (int e = 0; e < 4; ++e) atomicAdd(mods + e, s[e]);
            }
            __syncthreads();
            continue;
        }
        it -= P0_MODS;
        if (it < 3 * P0_CAST_G) {
            const int which = it / P0_CAST_G, r = it % P0_CAST_G;
            const float* src = which == 0 ? pin(F, I_CGK) : (which == 1 ? pin(F, I_CGV) : pin(F, I_CCKV));
            bf16_t* dst = (bf16_t*)(ws + (which == 0 ? WS_CGK : (which == 1 ? WS_CGV : WS_CCKV)));
#pragma unroll
            for (int q = 0; q < 4; ++q) cast8(src, dst, (size_t)r * 2048 + q * 512 + lane * 8);
            continue;
        }
        it -= 3 * P0_CAST_G;
        if (it < P0_CAST_KPE) {
#pragma unroll
            for (int q = 0; q < 4; ++q) cast8(pin(F, I_CKPE), (bf16_t*)(ws + WS_CKPE), (size_t)it * 2048 + q * 512 + lane * 8);
            continue; }
        it -= P0_CAST_KPE;
        {
            const int mat = it >> 2, qd = it & 3, dv = qd * 16 + (lane >> 2), dk0 = (lane & 3) * 16;
            const float* s = pin(F, I_STATE) + (size_t)mat * 4096 + dv;
            float x[16];
#pragma unroll
            for (int i = 0; i < 16; ++i) x[i] = s[(dk0 + i) * 64];
            u32x4 o0, o1;
            o0.x = pk2(x[0], x[1]); o0.y = pk2(x[2], x[3]); o0.z = pk2(x[4], x[5]); o0.w = pk2(x[6], x[7]);
            o1.x = pk2(x[8], x[9]); o1.y = pk2(x[10], x[11]); o1.z = pk2(x[12], x[13]); o1.w = pk2(x[14], x[15]);
            bf16_t* d = (bf16_t*)(ws + WS_S0T) + (size_t)mat * 4096 + dv * 64 + dk0;
            ST16_WT(d, o0); ST16_WT(d + 8, o1);
        }
    }
}
constexpr int P1_GS = 80, P1_BIAS = 4 * 368, P1_X = 8192, P1_TOTAL = P1_GS + P1_BIAS + P1_X;
__device__ __forceinline__ void xg_row(const Frame& F, const float* xrow, const float* g, const float* mods_c, bf16_t* xg_row_out, float* ssq_row, bool write_xg) {
    const int lane = F.lane;
    float ss = 0.f;
#pragma unroll
    for (int j = 0; j < 2; ++j) {
        const int k = j * 512 + lane * 8;
        const f32x4 x0 = *(const f32x4*)(xrow + k), x1 = *(const f32x4*)(xrow + k + 4);
        ss += ((x0[0] * x0[0] + x0[1] * x0[1]) + (x0[2] * x0[2] + x0[3] * x0[3])) + ((x1[0] * x1[0] + x1[1] * x1[1]) + (x1[2] * x1[2] + x1[3] * x1[3]));
        if (write_xg) {
            const f32x4 g0 = *(const f32x4*)(g + k), g1 = *(const f32x4*)(g + k + 4), s0 = *(const f32x4*)(mods_c + 1024 + k), s1 = *(const f32x4*)(mods_c + 1024 + k + 4);
            u32x4 o; o.x = pk2(x0[0] * g0[0] * (1.f + s0[0]), x0[1] * g0[1] * (1.f + s0[1])); o.y = pk2(x0[2] * g0[2] * (1.f + s0[2]), x0[3] * g0[3] * (1.f + s0[3]));
            o.z = pk2(x1[0] * g1[0] * (1.f + s1[0]), x1[1] * g1[1] * (1.f + s1[1])); o.w = pk2(x1[2] * g1[2] * (1.f + s1[2]), x1[3] * g1[3] * (1.f + s1[3]));
            ST16_WT(xg_row_out + k, o);
        }
    }
    ss = wsum(ss);
    if (lane < 16) ssq_row[lane] = lane == 0 ? ss : 0.f;
}
__device__ __forceinline__ void phase1(const Frame& F, const Params& p) {
    unsigned char* ws = F.ws; const int lane = F.lane;
    unsigned* ctl = (unsigned*)(ws + WS_CTL);
    const int gw = blockIdx.x * NWAVE + F.w, ngw = gridDim.x * NWAVE;
    const float* mods = (const float*)(ws + WS_MODS);
    for (int it0 = gw; it0 < P1_GS + P1_BIAS; it0 += ngw) {
        int it = it0;
        if (it < P1_GS) {
            const int e = it * 256 + lane * 4, lc = e >> 10, k = e & 1023, l = lc / 5;
            const f32x4 g = *(const f32x4*)(pin(F, I_NORMG) + l * 1024 + k), sc = *(const f32x4*)(mods + (size_t)lc * 3072 + 1024 + k);
            { const f32x4 o = g * (sc + 1.f); ST16_WT((float*)(ws + WS_GS) + e, o); }
            continue;
        }
        it -= P1_GS;
        {
            const int l = it / 368, n0 = (it % 368) * 8;
            f32x4 sh[5][4];
#pragma unroll
            for (int c = 0; c < 5; ++c) {
                const float* shp = mods + (size_t)(l * 5 + c) * 3072 + lane * 16;
#pragma unroll
                for (int i = 0; i < 4; ++i) sh[c][i] = *(const f32x4*)(shp + 4 * i);
            }
            const bf16_t* wr0 = (const bf16_t*)(ws + WS_WIN) + ((size_t)l * 2944 + n0) * 1024 + lane * 16;
            u32x4 w0[8], w1[8];
#pragma unroll
            for (int r = 0; r < 8; ++r) { w0[r] = *(const u32x4*)(wr0 + (size_t)r * 1024); w1[r] = *(const u32x4*)(wr0 + (size_t)r * 1024 + 8); }
#pragma unroll
            for (int r = 0; r < 8; ++r) {
                float wv[16];
#pragma unroll
                for (int i = 0; i < 4; ++i) { wv[2 * i] = bflo(w0[r][i]); wv[2 * i + 1] = bfhi(w0[r][i]); wv[8 + 2 * i] = bflo(w1[r][i]); wv[8 + 2 * i + 1] = bfhi(w1[r][i]); }
#pragma unroll
                for (int c = 0; c < 5; ++c) {
                    float d = 0.f;
#pragma unroll
                    for (int i = 0; i < 4; ++i) { const f32x4 s4 = sh[c][i]; d += (s4[0] * wv[4 * i] + s4[1] * wv[4 * i + 1]) + (s4[2] * wv[4 * i + 2] + s4[3] * wv[4 * i + 3]); }
                    d = wsum(d);
                    if (lane == 0) __hip_atomic_store((__attribute__((address_space(1))) float*)((float*)(ws + WS_BIAS) + (size_t)(l * 5 + c) * 2944 + n0 + r), d, __ATOMIC_RELAXED, __HIP_MEMORY_SCOPE_AGENT);
                }
            }
            if (l == 0) {
                asm volatile("s_waitcnt vmcnt(0)" ::: "memory");
                if (lane == 0) (void)xb_add(ctl + CW_P1B0, 1u);
            }
        }
    }
    for (int vb = blockIdx.x; vb < 256; vb += gridDim.x) {
        const int tm = vb & 31, part = vb >> 5;
        const bool lat = tm >= 16;
        const int cond = lat ? 1 + ((tm - 16) >> 2) : 0;
        const float* g = pin(F, I_NORMG); const float* sc = mods + (size_t)cond * 3072 + 1024;
#pragma unroll 1
        for (int i = 0; i < 4; i += 2) {
            const int tok = tm * 256 + part * 32 + F.w * 4 + i;
            const float* xa = lat ? pin(F, I_XS) + (size_t)(tok - 4096) * 1024 : pin(F, I_XP) + (size_t)tok * 1024;
            const float* xb = xa + 1024;
            bf16_t* oa = (bf16_t*)(ws + WS_XG) + (size_t)tok * 1024;
            float ssa = 0.f, ssb = 0.f;
#pragma unroll
            for (int j = 0; j < 2; ++j) {
                const int k = j * 512 + lane * 8;
                const f32x4 a0 = *(const f32x4*)(xa + k), a1 = *(const f32x4*)(xa + k + 4), b0 = *(const f32x4*)(xb + k), b1 = *(const f32x4*)(xb + k + 4);
                const f32x4 g0 = *(const f32x4*)(g + k), g1 = *(const f32x4*)(g + k + 4), s0 = *(const f32x4*)(sc + k), s1 = *(const f32x4*)(sc + k + 4);
                const f32x4 m0 = g0 * (s0 + 1.f), m1 = g1 * (s1 + 1.f);
                ssa += ((a0[0] * a0[0] + a0[1] * a0[1]) + (a0[2] * a0[2] + a0[3] * a0[3])) + ((a1[0] * a1[0] + a1[1] * a1[1]) + (a1[2] * a1[2] + a1[3] * a1[3]));
                ssb += ((b0[0] * b0[0] + b0[1] * b0[1]) + (b0[2] * b0[2] + b0[3] * b0[3])) + ((b1[0] * b1[0] + b1[1] * b1[1]) + (b1[2] * b1[2] + b1[3] * b1[3]));
                u32x4 o; o.x = pk2(a0[0] * m0[0], a0[1] * m0[1]); o.y = pk2(a0[2] * m0[2], a0[3] * m0[3]); o.z = pk2(a1[0] * m1[0], a1[1] * m1[1]); o.w = pk2(a1[2] * m1[2], a1[3] * m1[3]);
                ST16_WT(oa + k, o);
                o.x = pk2(b0[0] * m0[0], b0[1] * m0[1]); o.y = pk2(b0[2] * m0[2], b0[3] * m0[3]); o.z = pk2(b1[0] * m1[0], b1[1] * m1[1]); o.w = pk2(b1[2] * m1[2], b1[3] * m1[3]);
                ST16_WT(oa + 1024 + k, o);
            }
            ssa = wsum(ssa); ssb = wsum(ssb);
            if (lane < 32) {
                const float v = (lane & 15) == 0 ? (lane < 16 ? ssa : ssb) : 0.f;
                __hip_atomic_store((__attribute__((address_space(1))) float*)((float*)(ws + WS_SSQ) + (size_t)(tok + (lane >> 4)) * 16 + (lane & 15)), v, __ATOMIC_RELAXED, __HIP_MEMORY_SCOPE_AGENT);
            }
        }
        asm volatile("s_waitcnt vmcnt(0)" ::: "memory");
        __syncthreads();
        if (is_t0(F)) (void)xb_add(ctl + CW_P1X + tm * 4, 1u);
    }
    asm volatile("s_waitcnt vmcnt(0)" ::: "memory");
    __syncthreads();
    if (is_t0(F)) (void)xb_add(ctl + CW_P1DONE, 1u);
}
#ifndef MK_TIMING
#define MK_TIMING -1
#endif
constexpr int CW_TIME = 2048;
__device__ __forceinline__ void phase_final(const Frame& F, const Params& p) {
    const int lane = F.lane;
    float tf = 1.f;
    if (MK_TIMING >= 0) tf = __uint_as_float(__hip_atomic_load((unsigned*)(F.ws + WS_CTL) + CW_TIME, __ATOMIC_RELAXED, __HIP_MEMORY_SCOPE_AGENT));
    unsigned* ctl = (unsigned*)(F.ws + WS_CTL);
    for (int vb = blockIdx.x; vb < 256; vb += gridDim.x) {
        const int tm = vb & 31, part = vb >> 5;
        if (F.tid == 0) {
            XB_SPIN(xb_ld(ctl + CW_XRDY + tm * 4) < 8u, ctl + CW_BAR);
            __builtin_amdgcn_fence(__ATOMIC_ACQUIRE, "agent");
            asm volatile("s_waitcnt vmcnt(0)" ::: "memory");
        }
        __syncthreads();
#pragma unroll 1
        for (int i = 0; i < 4; ++i) {
            const int tok = tm * 256 + part * 32 + F.w * 4 + i;
            float ss = 0.f;
            if (lane < 16) ss = ((const float*)(F.ws + WS_SSQ))[(size_t)tok * 16 + lane];
            ss = wsum(ss);
            const float rstd = rsqrtf(ss * (1.f / 1024.f) + EPS);
            const bf16_t* xr = (const bf16_t*)(F.ws + WS_XB) + (size_t)tok * 1024; float* orow = p.out + (size_t)tok * 1024;
#pragma unroll
            for (int j = 0; j < 4; ++j) {
                const int k = j * 256 + lane * 4;
                const u32x2 xq = *(const u32x2*)(xr + k);
                const f32x4 x = {bflo(xq.x), bfhi(xq.x), bflo(xq.y), bfhi(xq.y)}, fn = *(const f32x4*)(pin(F, I_FNORM) + k);
                { const f32x4 o = x * fn * (rstd * tf); ST16_WT(orow + k, o); }
            }
        }
    }
}

__device__ __forceinline__ GemmOp a2_op(const Frame& F, int l, int j) {
    GemmOp g;
    if (j < 160) { const int tn = j >> 5, tm = j & 31; g.W = (const bf16_t*)(F.ws + WS_WUQ) + ((size_t)l * 640 + tn * 128) * 256; g.X = (const bf16_t*)(F.ws + WS_CQG) + (size_t)tm * 256 * 256; g.ldw = 256; g.ldx = 256; g.K = 256; }
    else if (j < 352) { const int jj = j - 160, tn = jj >> 5, tm = jj & 31; g.W = (const bf16_t*)(F.ws + WS_WUKV) + ((size_t)l * 768 + tn * 128) * 128; g.X = (const bf16_t*)(F.ws + WS_CKVN) + (size_t)tm * 256 * 128; g.ldw = 128; g.ldx = 128; g.K = 128; }
    else { const int jj = j - 352, tn = jj >> 3, tc = jj & 7, b = tc >> 1, jt = tc & 1; g.W = (const bf16_t*)(F.ws + WS_WUKV) + ((size_t)l * 768 + tn * 128) * 128;
           g.X = (const bf16_t*)(F.ws + WS_CCKV) + ((size_t)(b * 4 + l) * 512 + jt * 256) * 128; g.ldw = 128; g.ldx = 128; g.K = 128; }
    return g;
}
__device__ __forceinline__ int a2_item(int vb, int i) {
    const int c = (vb >> 5) - 4, tmw = vb & 31;
    if (i == 3) return 352 + 32 + tmw;
    if (c == 0) return i * 32 + tmw;
    if (c == 1) return i < 2 ? (3 + i) * 32 + tmw : 160 + tmw;
    if (c == 2) return 160 + (1 + i) * 32 + tmw;
    return i < 2 ? 160 + (4 + i) * 32 + tmw : 352 + tmw;
}
#ifndef MK_EN
#define MK_EN 0xff
#endif
#define EN(x) ((MK_EN >> (x)) & 1)
constexpr int PH_TOTAL = 19;
__global__ void __launch_bounds__(512, 2) mega(Params p) {
    extern __shared__ __attribute__((aligned(16))) unsigned char lds_raw[];
    Frame F;
    F.lds = (LAS unsigned char*)lds_raw;
    F.tid = threadIdx.x; F.lane = F.tid & 63; F.w = __builtin_amdgcn_readfirstlane(F.tid >> 6); F.h = F.lane >> 5; F.lq = F.lane & 31;
    F.ws = p.ws;
    F.karg = (karg_t)__builtin_amdgcn_kernarg_segment_ptr();
    volatile LAS unsigned* MISC = (volatile LAS unsigned*)(F.lds + LDS_MISC);
    if (F.tid < 64) MISC[F.tid] = 0u;
    __syncthreads();
    unsigned* ctl = (unsigned*)(p.ws + WS_CTL);
    XcdBarrier bar; bar.bar = ctl + CW_BAR; bar.x = 0; bar.st = nullptr;
    const bool multi = p.ph_hi - p.ph_lo > 1;
    if (multi) bar = xcd_barrier_post(ctl + CW_BAR, MISC + 8);
    bar.w = F.w;
    const int G = gridDim.x;
    const Frame F0 = F;
    for (int ph = p.ph_lo; ph < p.ph_hi; ++ph) {
        if (ph >= 2 && ph < 18 && ((ph - 2) & 3) == 1) continue;
        Frame F = F0;
        F.lane = (int)__builtin_amdgcn_mbcnt_hi(~0u, __builtin_amdgcn_mbcnt_lo(~0u, 0u));
        asm volatile("" : "+v"(F.lane));
        F.tid = (F.w << 6) | F.lane; F.h = F.lane >> 5; F.lq = F.lane & 31;
        asm volatile("" : "+s"(F.w), "+s"(F.ws), "+s"(F.karg));
        if (MK_TIMING >= 0 && blockIdx.x == 0 && F.tid == 0) {
            const unsigned long long now = __builtin_amdgcn_s_memrealtime();
            const unsigned long long prev = ((unsigned long long)MISC[17] << 32) | MISC[16];
            if (ph > p.ph_lo) { const int q = ph - 1; const int grp = q < 2 ? q : 2 + ((q - 2) & 3); if (grp == MK_TIMING) MISC[18] += (unsigned)(now - prev); }
            MISC[16] = (unsigned)now; MISC[17] = (unsigned)(now >> 32);
        }
#ifndef MK_REPEAT
#define MK_REPEAT -1
#endif
        int nrep = 1;
        if (MK_REPEAT >= 1) { const int grp = ph < 2 ? ph : (ph == 18 ? 6 : 2 + ((ph - 2) & 3)); if (grp == MK_REPEAT) nrep = (grp == 5) ? (ph == 5 ? 5 : 1) : 2; }
        for (int rep = 0; rep < nrep; ++rep) {
        if (rep > 0) xcd_barrier(bar);
        Frame F = F0;
        F.lane = (int)__builtin_amdgcn_mbcnt_hi(~0u, __builtin_amdgcn_mbcnt_lo(~0u, 0u));
        asm volatile("" : "+v"(F.lane));
        F.tid = (F.w << 6) | F.lane; F.h = F.lane >> 5; F.lq = F.lane & 31;
        asm volatile("" : "+s"(F.w), "+s"(F.ws), "+s"(F.karg));
        if (EN(0) && ph == 0) {
#if defined(MK_DUP0)
            for (int d = 0; d < 2; ++d) { int dd = d; asm volatile("" : "+s"(dd)); if (dd) xcd_barrier(bar); phase0(F, p, dd != 0); }
#else
            phase0(F, p);
#endif
        }
        else if (EN(1) && ph == 1) phase1(F, p);
        else if (EN(2) && ph == 18) phase_final(F, p);
        else {
            const int l = (ph - 2) >> 2, sub = (ph - 2) & 3;
            int bid = blockIdx.x; asm volatile("" : "+s"(bid));
            if (EN(3) && sub == 0) {
                const bf16_t* Wt = (const bf16_t*)(F.ws + WS_WIN) + (size_t)l * 2944 * 1024;
                const bf16_t* X = (const bf16_t*)(F.ws + WS_XG);
                unsigned* flags = ctl + CW_FLAG + l * 512;
                bool first = true;
                int waited_tm = -1;
                for (int j = bid; j < 12 * 32; j += G) {
                    const int tn2 = j >> 5, tm = j & 31;
                    const int jn = j + G; const bool hn = jn < 12 * 32 && (jn & 31) == tm;
                    if (l == 0 && tm != waited_tm) {
                        waited_tm = tm;
                        if (F.tid == 0) {
                            XB_SPIN(xb_ld(ctl + CW_P1X + tm * 4) < 8u, ctl + CW_BAR);
                            XB_SPIN(xb_ld(ctl + CW_P1B0) < 368u, ctl + CW_BAR);
                            __builtin_amdgcn_fence(__ATOMIC_ACQUIRE, "agent");
                            asm volatile("s_waitcnt vmcnt(0)" ::: "memory");
                        }
                        __syncthreads();
                        first = true;
                    }
                    if (l > 0 && tm != waited_tm) {
                        waited_tm = tm;
                        if (F.w == 0) {
                            const int ln = lane_id();
                            unsigned* ptr = ctl + CW_P1DONE; unsigned tgt = (unsigned)G;
                            if (ln == 1) { ptr = ctl + CW_XGR + ((l - 1) * 32 + tm) * 4; tgt = 8u; }
                            if (ln >= 2) {
                                if (tm >= 16) { ptr = ctl + CW_YRDY + ((l - 1) * 32 + (tm & ~3) + ((ln - 2) & 3)) * 4; tgt = 16u; }
                                else { ptr = ctl + CW_SD + ((l - 1) * 16 + tm) * 4; tgt = 4u; }
                            }
                            poll_lanes(ptr, tgt, ln < (tm >= 16 ? 6 : 3), ctl + CW_BAR);
                            __builtin_amdgcn_fence(__ATOMIC_ACQUIRE, "agent");
                            asm volatile("s_waitcnt vmcnt(0)" ::: "memory");
                        }
                        __syncthreads();
                        first = true;
                    }
                    const int tn = 2 * tn2 + ((F.w & 3) >> 1), wn = F.w & 1;
                    GemmAcc8 acc;
                    Gemm1Pre P1;
                    gemm1_pre(F, p, tn, wn, tm, l, P1);
                    gemm_core256(F, Wt + (size_t)tn2 * 256 * 1024, X + (size_t)tm * 256 * 1024, acc, first, hn, Wt + (size_t)(jn >> 5) * 256 * 1024, X + (size_t)(jn & 31) * 256 * 1024); first = false;
                    epi_gemm1(F, p, acc, tn, wn, tm, l, P1, tn2 == 6);
                    {
                        asm volatile("s_waitcnt vmcnt(0)" ::: "memory");
                        __syncthreads();
                        if (F.tid == 0) {
                            if (tn2 == 5 || tn2 == 6) (void)xb_add(flags + tm * 16, 1u);
                            if (tn2 < 8) (void)xb_add(ctl + CW_RA + (l * 32 + tm) * 4, 1u);
                            if (tn2 >= 7 && tn2 < 11) (void)xb_add(ctl + CW_ZC + (l * 32 + tm) * 4, 1u);
                            (void)xb_add(ctl + CW_FULL + (l * 32 + tm) * 4, 1u);
                        }
                    }
                }
                for (int vb = bid; vb < 256; vb += G) {
                    if (vb < 128) continue;
                    const int c = (vb >> 5) - 4, tmw = vb & 31;
                    const int nit = (c == 2 && tmw < 16) ? 4 : 3;
                    if (F.tid == 0) {
                        if (l > 0 && tmw != waited_tm) {
                            if (tmw >= 16) { unsigned* y = ctl + CW_YRDY + ((l - 1) * 32 + (tmw & ~3)) * 4; for (int i = 0; i < 4; ++i) { XB_SPIN(xb_ld(y + 4 * i) < 16u, ctl + CW_BAR); } }
                            else { XB_SPIN(xb_ld(ctl + CW_YRDY + ((l - 1) * 32 + tmw) * 4) < 16u, ctl + CW_BAR); XB_SPIN(xb_ld(ctl + CW_SD + ((l - 1) * 16 + tmw) * 4) < 4u, ctl + CW_BAR); }
                        }
                        unsigned* f = flags + tmw * 16;
                        XB_SPIN(xb_ld(f) < 2u, ctl + CW_BAR);
                        __builtin_amdgcn_fence(__ATOMIC_ACQUIRE, "agent");
                        asm volatile("s_waitcnt vmcnt(0)" ::: "memory");
                    }
                    __syncthreads();
                    for (int i = 0; i < nit; ++i) {
                        const bool hn = i + 1 < nit;
                        const int j = a2_item(vb, i), jn = a2_item(vb, hn ? i + 1 : i);
                        const GemmOp g = a2_op(F, l, j); const GemmOp gn = a2_op(F, l, jn);
                        GemmAcc acc;
                        float rstdq = 0.f;
                        if (j < 160) qm_pre(F, tmw, rstdq);
                        gemm_core(F, g, acc, i == 0, hn, gn);
                        if (j < 160) epi_qm(F, acc, j >> 5, tmw, rstdq);
                        else if (j < 352) { const int jj = j - 160; epi_plain(F, acc, (bf16_t*)(F.ws + WS_KVM), 768, tmw * 256, (jj >> 5) * 128); }
                        else {
                            const int jj = j - 352, tc = jj & 7;
                            if (l > 0) {
                                if (F.w == 0) { const int ln = lane_id(); poll_lanes(ctl + CW_YRDY + ((l - 1) * 32 + 16 + 4 * (tc >> 1) + (ln & 3)) * 4, 16u, ln < 4, ctl + CW_BAR); }
                                __syncthreads();
                            }
                            epi_plain(F, acc, (bf16_t*)(F.ws + WS_KVMC), 768, (tc >> 1) * 512 + (tc & 1) * 256, (jj >> 3) * 128);
                        }
                        asm volatile("s_waitcnt vmcnt(0)" ::: "memory");
                        __syncthreads();
                        if (F.tid == 0) {
                            if (j < 352) (void)xb_add(ctl + CW_FULL + (l * 32 + tmw) * 4, 1u);
                            else (void)xb_add(ctl + CW_KC + (l * 4 + (((j - 352) & 7) >> 1)) * 4, 1u);
                        }
                    }
                }
            } else if (EN(5) && sub == 2) {
                for (;;) {
                    __syncthreads();
                    if (F.tid == 0) MISC[0] = atomicAdd(ctl + CW_QUEUE + 64 * l + 32 * rep, 1u);
                    __syncthreads();
                    const int uq = __builtin_amdgcn_readfirstlane((int)MISC[0]);
                    if (uq >= N_ATTN_UNITS) break;
                    const int u = uq < 160 ? uq + 96 : (uq < 256 ? uq - 160 : (uq < 480 ? uq + 96 : uq - 224));
                    attn_dispatch(F, p, u, l);
                }
            } else if (EN(6)) {
                const bf16_t* Wt = (const bf16_t*)(F.ws + WS_WOUT) + (size_t)l * 1024 * 1024;
                const bf16_t* Yb = (const bf16_t*)(F.ws + WS_Y);
                for (int j = bid; j < 8 * 32; j += G) {
                    const int tn = j >> 5, tm = j & 31;
                    GemmOp g; g.W = Wt + (size_t)tn * 128 * 1024; g.X = Yb + (size_t)tm * 256 * 1024; g.ldw = 1024; g.ldx = 1024; g.K = 1024;
                    GemmAcc acc;
                    Gemm2Pre P2;
                    if (F.tid == 0) {
                        unsigned* f = ctl + CW_YRDY + (l * 32 + tm) * 4;
                        XB_SPIN(xb_ld(f) < 16u, ctl + CW_BAR);
                        if (l == 0) { XB_SPIN(xb_ld(ctl + CW_P1DONE) < (unsigned)G, ctl + CW_BAR); }
                        __builtin_amdgcn_fence(__ATOMIC_ACQUIRE, "agent");
                        asm volatile("s_waitcnt vmcnt(0)" ::: "memory");
                    }
                    __syncthreads();
                    gemm2_pre(F, tn, tm, l, P2);
                    gemm_core(F, g, acc, true, false, g);
                    epi_gemm2(F, p, acc, tn, tm, l, P2, l == 3);
                    {
                        asm volatile("s_waitcnt vmcnt(0)" ::: "memory");
                        __syncthreads();
                        if (F.tid == 0) (void)xb_add(l == 3 ? ctl + CW_XRDY + tm * 4 : ctl + CW_XGR + (l * 32 + tm) * 4, 1u);
                    }
                }
            }
        }
        }
        if (MK_TIMING >= 0 && ph == 17 && blockIdx.x == 0 && F.tid == 0) {
            const unsigned long long now = __builtin_amdgcn_s_memrealtime();
            const unsigned long long prev = ((unsigned long long)MISC[17] << 32) | MISC[16];
            unsigned a = MISC[18]; if (MK_TIMING == 5) a += (unsigned)(now - prev);
            __hip_atomic_store(ctl + CW_TIME, __float_as_uint(1.f + (float)a * 1e-5f), __ATOMIC_RELAXED, __HIP_MEMORY_SCOPE_AGENT);
        }
        if (ph + 1 < p.ph_hi && ph < 1) xcd_barrier(bar);
    }
}
}

extern "C" void kernel_launch(void* const* d_in, const int* in_sizes, int n_in, void* d_out, int out_size, void* d_ws, size_t ws_size, hipStream_t stream) {
    static int grid = 0;
    if (!grid) {
        int dev = 0, cus = 0, per_cu = 0;
        (void)hipGetDevice(&dev);
        (void)hipDeviceGetAttribute(&cus, hipDeviceAttributeMultiprocessorCount, dev);
        (void)hipFuncSetAttribute((const void*)mk::mega, hipFuncAttributeMaxDynamicSharedMemorySize, mk::LDS_BYTES);
        (void)hipOccupancyMaxActiveBlocksPerMultiprocessor(&per_cu, (const void*)mk::mega, 512, mk::LDS_BYTES);
        if (per_cu > 1) per_cu = 1;
        if (per_cu < 1) per_cu = 1;
        if (cus < 1) cus = 256;
        grid = cus * per_cu;
    }
    unsigned char* ws = (unsigned char*)d_ws;
    (void)hipMemsetAsync(ws, 0, mk::CTL_ZERO_BYTES, stream);
    mk::Params P{};
    for (int i = 0; i < 22; ++i) P.in[i] = (const float*)d_in[i];
    P.out = (float*)d_out; P.ws = ws; P.xs = (float*)d_out;
    P.ph_lo = 0; P.ph_hi = mk::PH_TOTAL;
    void* args[] = {&P};
    (void)hipLaunchCooperativeKernel((const void*)mk::mega, dim3(grid), dim3(512), args, mk::LDS_BYTES, stream);
}
```

```cpp
#include <hip/hip_runtime.h>
#include <stdint.h>
namespace mk {
#define LAS __attribute__((address_space(3)))
typedef unsigned short bf16_t;
typedef short bf16x8 __attribute__((ext_vector_type(8)));
typedef short s16x4 __attribute__((ext_vector_type(4)));
typedef float f32x16 __attribute__((ext_vector_type(16)));
typedef float f32x4 __attribute__((ext_vector_type(4)));
typedef float f32x2 __attribute__((ext_vector_type(2)));
typedef unsigned u32x4 __attribute__((ext_vector_type(4)));
typedef unsigned u32x2 __attribute__((ext_vector_type(2)));
typedef __bf16 bf16x2_t __attribute__((ext_vector_type(2)));

constexpr float EPS = 1e-6f;
constexpr float LOG2E = 1.4426950408889634f;
constexpr float QSC_GQA = 0.125f * LOG2E;
constexpr float QSC_MLA = 0.10206207261596575f * LOG2E;

__device__ __forceinline__ unsigned pk2(float lo, float hi) { f32x2 v = {lo, hi}; bf16x2_t b = __builtin_convertvector(v, bf16x2_t); return __builtin_bit_cast(unsigned, b); }
__device__ __forceinline__ float bf2f(unsigned short u) { return __uint_as_float((unsigned)u << 16); }
__device__ __forceinline__ float bflo(unsigned u) { return __uint_as_float(u << 16); }
__device__ __forceinline__ float bfhi(unsigned u) { return __uint_as_float(u & 0xffff0000u); }
__device__ __forceinline__ float silu_f(float x) { return x * __builtin_amdgcn_rcpf(1.f + __builtin_amdgcn_exp2f(-x * LOG2E)); }
__device__ __forceinline__ float wsum(float v) {
#pragma unroll
    for (int o = 32; o > 0; o >>= 1) v += __shfl_xor(v, o);
    return v;
}

constexpr size_t MiB = 1u << 20;
constexpr size_t WS_CTL = 0, CTL_ZERO_BYTES = 1 * MiB;
constexpr size_t WS_MODS = 256 * 1024;
constexpr size_t WS_BIAS = 1 * MiB;
constexpr size_t WS_GS = 1 * MiB + 256 * 1024;
constexpr size_t WS_ROPE64 = 1 * MiB + 512 * 1024;
constexpr size_t WS_ROPE32 = 1 * MiB + 768 * 1024;
constexpr size_t WS_SSQ = 2 * MiB;
constexpr size_t WS_CQSSQ = 2 * MiB + 512 * 1024;
constexpr size_t WS_S0T = 3 * MiB;
constexpr size_t WS_CGK = 4 * MiB, WS_CGV = 6 * MiB, WS_CCKV = 8 * MiB, WS_CKPE = 10 * MiB;
constexpr size_t WS_WIN = 11 * MiB;
constexpr size_t WS_WOUT = 34 * MiB;
constexpr size_t WS_WUQ = 42 * MiB;
constexpr size_t WS_WUKV = 43 * MiB + 256 * 1024;
constexpr size_t WS_XG = 44 * MiB;
constexpr size_t WS_KVM = 130 * MiB;
constexpr size_t WS_KVMC = 142 * MiB;
constexpr size_t WS_RQ = 60 * MiB, WS_RK = 64 * MiB, WS_RV = 68 * MiB;
constexpr size_t WS_GQ = 72 * MiB;
constexpr size_t WS_GK = 78 * MiB, WS_GV = 80 * MiB;
constexpr size_t WS_CQG = 82 * MiB;
constexpr size_t WS_CKVN = 86 * MiB;
constexpr size_t WS_KPEB = 88 * MiB;
constexpr size_t WS_ZS = 89 * MiB;
constexpr size_t WS_QM = 105 * MiB;
constexpr size_t WS_Y = 114 * MiB;
constexpr size_t WS_XSDBG = 130 * MiB;
constexpr size_t WS_XB = 146 * MiB;
constexpr size_t WS_OPT_END = 162 * MiB;
constexpr int CW_QUEUE = 1024;
constexpr int CW_FLAG = 2048;
constexpr int CW_YRDY = 1536;
constexpr int CW_XRDY = 1280;
constexpr int CW_RA = 8192;
constexpr int CW_FULL = 8704;
constexpr int CW_ZC = 9216;
constexpr int CW_KC = 9728;
constexpr int CW_XGR = 9856;
constexpr int CW_SD = 10368;
constexpr int CW_P1X = 10656;
constexpr int CW_P1B0 = 10784;
constexpr int CW_P1DONE = 10788;
constexpr int CW_BAR = 4096;

constexpr size_t O_STATE = 8388608, O_GK = 10485760, O_GV = 12582912, O_CKV = 14680064, O_KPE = 16777216;

constexpr int NWAVE = 8;
constexpr int GST = 49152;
constexpr int GST2 = 65536;
constexpr int LDS_OST = GST2;
constexpr int LDS_EX = 135168;
constexpr int LDS_EXB = 137216;
constexpr int LDS_SCAL = 141312;
constexpr int LDS_MISC = 142336;
constexpr int LDS_BYTES = 142592;

struct Params { const float* in[22]; float* out; unsigned char* ws; float* xs; int ph_lo, ph_hi; };
enum { I_XP = 0, I_XS, I_STATE, I_CGK, I_CGV, I_CCKV, I_CKPE, I_C, I_CCTX, I_NORMG, I_WADA, I_BADA, I_WIN, I_DECAY, I_GQN, I_GKN, I_MQN, I_MKVN, I_WUQ, I_WUKV, I_WOUT, I_FNORM };

#define XB_TMO      128
#define XB_XCNT(j)  (256  + 64 * (j))
#define XB_XSUB(j)  (1280 + 64 * (j))
#define XB_XGEN(j)  (2304 + 64 * (j))
#define XB_TOP      3328
#define XB_TOPGEN   3392
#define XB_SPIN_CAP (1u << 20)
__device__ __forceinline__ unsigned xb_ld(unsigned* p) { return __hip_atomic_load(p, __ATOMIC_RELAXED, __HIP_MEMORY_SCOPE_AGENT); }
__device__ __forceinline__ unsigned xb_add(unsigned* p, unsigned v) { return __hip_atomic_fetch_add(p, v, __ATOMIC_RELAXED, __HIP_MEMORY_SCOPE_AGENT); }
__device__ __forceinline__ unsigned xb_xcc_id() { return (unsigned)__builtin_amdgcn_s_getreg((3 << 11) | 20) & 0xFu; }
#define XB_SPIN(cond, bar) do { unsigned _sp = 0; while (cond) { __builtin_amdgcn_s_sleep(1); \
    if ((++_sp & 255u) == 0u) { if (xb_ld(&(bar)[XB_TMO])) break; if (_sp > XB_SPIN_CAP) { atomicAdd(&(bar)[XB_TMO], 1u); break; } } } } while (0)
__device__ __forceinline__ int lane_id() { int ln = (int)__builtin_amdgcn_mbcnt_hi(~0u, __builtin_amdgcn_mbcnt_lo(~0u, 0u)); asm volatile("" : "+v"(ln)); return ln; }
__device__ __forceinline__ void poll_lanes(unsigned* ptr, unsigned target, bool active, unsigned* bar0) {
    unsigned sp = 0u;
    for (;;) {
        unsigned v = target;
        if (active) v = xb_ld(ptr);
        if (!__any(v < target)) break;
        __builtin_amdgcn_s_sleep(1);
        if ((++sp & 255u) == 0u) { if (xb_ld(&bar0[XB_TMO])) break; if (sp > XB_SPIN_CAP) { atomicAdd(&bar0[XB_TMO], 1u); break; } }
    }
}
struct XcdBarrier { unsigned* bar; unsigned x; volatile LAS unsigned* st; int w; };
__device__ __forceinline__ XcdBarrier xcd_barrier_post(unsigned* bar, volatile LAS unsigned* st) {
    XcdBarrier b; b.bar = bar; b.x = xb_xcc_id(); b.st = st; b.w = 0;
    if (threadIdx.x == 0) (void)xb_add(&bar[XB_XCNT(b.x)], 1u);
    return b;
}
__device__ __forceinline__ void xcd_barrier_complete(unsigned* bar, unsigned x, unsigned& nloc, unsigned& nx) {
    const unsigned G = gridDim.x * gridDim.y * gridDim.z;
    unsigned sum, cnt, mine, sp = 0u;
    for (;;) {
        sum = 0u; cnt = 0u; mine = 0u;
#pragma unroll
        for (unsigned j = 0; j < 16; ++j) { const unsigned c = xb_ld(&bar[XB_XCNT(j)]); sum += c; cnt += (c > 0u) ? 1u : 0u; mine = (j == x) ? c : mine; }
        if (sum == G) break;
        __builtin_amdgcn_s_sleep(1);
        if ((++sp & 255u) == 0u) { if (xb_ld(&bar[XB_TMO])) break; if (sp > XB_SPIN_CAP) { atomicAdd(&bar[XB_TMO], 1u); break; } }
    }
    nloc = mine > 0u ? mine : 1u; nx = cnt > 0u ? cnt : 1u;
}
__device__ __forceinline__ void xcd_barrier(const XcdBarrier& b) {
    asm volatile("s_waitcnt vmcnt(0)" ::: "memory");
    __syncthreads();
    if (b.w == 0 && __builtin_amdgcn_mbcnt_hi(~0u, __builtin_amdgcn_mbcnt_lo(~0u, 0u)) == 0u) {
        unsigned* bar = b.bar;
        __builtin_amdgcn_s_waitcnt(0);
        unsigned nloc = b.st[0], nx = b.st[1];
        if (nloc == 0u) { xcd_barrier_complete(bar, b.x, nloc, nx); b.st[0] = nloc; b.st[1] = nx; }
        const unsigned old = xb_add(&bar[XB_XSUB(b.x)], 1u);
        const unsigned gen = old / nloc;
        if (old + 1u == (gen + 1u) * nloc) {
            __builtin_amdgcn_fence(__ATOMIC_RELEASE, "agent");
            asm volatile("s_waitcnt vmcnt(0)" ::: "memory");
            const unsigned og = xb_add(&bar[XB_TOP], 1u);
            const unsigned tg = og / nx;
            if (og + 1u == (tg + 1u) * nx) xb_add(&bar[XB_TOPGEN], 1u);
            else XB_SPIN(xb_ld(&bar[XB_TOPGEN]) == tg, bar);
            xb_add(&bar[XB_XGEN(b.x)], 1u);
            __builtin_amdgcn_fence(__ATOMIC_ACQUIRE, "agent");
            asm volatile("s_waitcnt vmcnt(0)" ::: "memory");
        } else {
            XB_SPIN(xb_ld(&bar[XB_XGEN(b.x)]) == gen, bar);
            __builtin_amdgcn_fence(__ATOMIC_ACQUIRE, "agent");
            asm volatile("s_waitcnt vmcnt(0)" ::: "memory");
        }
    }
    __syncthreads();
}

typedef const float* cfp_t;
typedef const __attribute__((address_space(4))) cfp_t* karg_t;
struct Frame {
    LAS unsigned char* lds;
    int tid, lane, w, h, lq;
    unsigned char* ws;
    karg_t karg;
};
__device__ __forceinline__ const float* pin(const Frame& F, int i) { return F.karg[i]; }
__device__ __forceinline__ bool is_t0(const Frame& F) { return F.w == 0 && __builtin_amdgcn_mbcnt_hi(~0u, __builtin_amdgcn_mbcnt_lo(~0u, 0u)) == 0u; }
#define GLDS16(gsrc, ldsdst) __builtin_amdgcn_global_load_lds((const unsigned*)(gsrc), (LAS unsigned*)(ldsdst), 16, 0, 0)
#define ST16_WT(ptr, val) asm volatile("global_store_dwordx4 %0, %1, off sc1\n\ts_nop 1" :: "v"(ptr), "v"(val) : "memory")
#define MFMA32(a, b, c) __builtin_amdgcn_mfma_f32_32x32x16_bf16((a), (b), (c), 0, 0, 0)

struct GemmOp { const bf16_t* W; const bf16_t* X; int ldw, ldx, K; };
__device__ __forceinline__ void gemm_issue0(const Frame& F, const GemmOp& g) {
    const int lane = F.lane, w = F.w;
#pragma unroll
    for (int q = 0; q < 2; ++q) { const int row = 16 * w + 8 * q + (lane >> 3); GLDS16(g.W + row * g.ldw + ((lane & 7) ^ ((row >> 1) & 7)) * 8, F.lds + (16 * w + 8 * q) * 128); }
#pragma unroll
    for (int q = 0; q < 4; ++q) { const int row = 32 * w + 8 * q + (lane >> 3); GLDS16(g.X + row * g.ldx + ((lane & 7) ^ ((row >> 1) & 7)) * 8, F.lds + 16384 + (32 * w + 8 * q) * 128); }
}
typedef f32x4 GemmAcc[4][4];
__device__ __forceinline__ void gemm_core(const Frame& F, const GemmOp& g, GemmAcc& acc, bool issue_first, bool has_next, const GemmOp& gn) {
    const int lane = F.lane, w = F.w;
    const bf16_t* __restrict__ W = g.W; const bf16_t* __restrict__ X = g.X;
    const int nkt = g.K >> 6;
    int offW[2], offX[4];
#pragma unroll
    for (int q = 0; q < 2; ++q) { const int row = 16 * w + 8 * q + (lane >> 3); offW[q] = row * g.ldw + ((lane & 7) ^ ((row >> 1) & 7)) * 8; }
#pragma unroll
    for (int q = 0; q < 4; ++q) { const int row = 32 * w + 8 * q + (lane >> 3); offX[q] = row * g.ldx + ((lane & 7) ^ ((row >> 1) & 7)) * 8; }
    LAS unsigned char* const dW = F.lds + (16 * w) * 128;
    LAS unsigned char* const dX = F.lds + 16384 + (32 * w) * 128;
#define GC_ISSUE(kt, st) do { _Pragma("unroll") for (int q = 0; q < 2; ++q) GLDS16(W + offW[q] + (kt) * 64, dW + (st) * GST + q * 1024); \
        _Pragma("unroll") for (int q = 0; q < 4; ++q) GLDS16(X + offX[q] + (kt) * 64, dX + (st) * GST + q * 1024); } while (0)
    const int wn = w & 1, wm = w >> 1, c15 = lane & 15, g4 = lane >> 4;
    const int sw = (c15 >> 1) & 7;
    int so[2];
#pragma unroll
    for (int s = 0; s < 2; ++s) so[s] = ((4 * s + g4) ^ sw) << 4;
    const int bn0 = (64 * wn + c15) * 128, bm0 = 16384 + (64 * wm + c15) * 128;
#pragma unroll
    for (int a = 0; a < 4; ++a)
#pragma unroll
        for (int b = 0; b < 4; ++b) acc[a][b] = (f32x4){0.f, 0.f, 0.f, 0.f};
    if (issue_first) GC_ISSUE(0, 0);
    asm volatile("s_waitcnt vmcnt(0)" ::: "memory");
    __syncthreads();
    for (int kt = 0; kt < nkt; ++kt) {
        const int st = kt & 1;
        if (kt + 1 < nkt) GC_ISSUE(kt + 1, st ^ 1);
        LAS unsigned char* const base = F.lds + st * GST;
#pragma unroll
        for (int s = 0; s < 2; ++s) {
            bf16x8 fa[4], fb[4];
#pragma unroll
            for (int q = 0; q < 4; ++q) { fa[q] = *(const LAS bf16x8*)(base + bn0 + q * 2048 + so[s]); fb[q] = *(const LAS bf16x8*)(base + bm0 + q * 2048 + so[s]); }
#pragma unroll
            for (int a = 0; a < 4; ++a)
#pragma unroll
                for (int b = 0; b < 4; ++b) acc[a][b] = __builtin_amdgcn_mfma_f32_16x16x32_bf16(fa[a], fb[b], acc[a][b], 0, 0, 0);
        }
        asm volatile("s_waitcnt vmcnt(0)" ::: "memory");
        __syncthreads();
    }
#undef GC_ISSUE
    if (has_next) gemm_issue0(F, gn);
}

typedef f32x4 GemmAcc8[4][8];
__device__ __forceinline__ void gemm256_issue0(const Frame& F, const bf16_t* W, const bf16_t* X) {
    int lane = F.lane; const int w = F.w;
    asm volatile("" : "+v"(lane));
#pragma unroll
    for (int q = 0; q < 4; ++q) {
        const int row = 32 * w + 8 * q + (lane >> 3), off = row * 1024 + ((lane & 7) ^ ((row >> 1) & 7)) * 8;
        GLDS16(W + off, F.lds + (32 * w + 8 * q) * 128);
        GLDS16(X + off, F.lds + 32768 + (32 * w + 8 * q) * 128);
    }
}
__device__ __forceinline__ void gemm_core256(const Frame& F, const bf16_t* __restrict__ W, const bf16_t* __restrict__ X, GemmAcc8& acc, bool issue_first, bool has_next, const bf16_t* Wn, const bf16_t* Xn) {
    int lane = F.lane; const int w = F.w;
    asm volatile("" : "+v"(lane));
    int off[4];
#pragma unroll
    for (int q = 0; q < 4; ++q) { const int row = 32 * w + 8 * q + (lane >> 3); off[q] = row * 1024 + ((lane & 7) ^ ((row >> 1) & 7)) * 8; }
    LAS unsigned char* const dW = F.lds + (32 * w) * 128;
    LAS unsigned char* const dX = F.lds + 32768 + (32 * w) * 128;
#define GC2_ISSUE(kt, st) do { _Pragma("unroll") for (int q = 0; q < 4; ++q) { GLDS16(W + off[q] + (kt) * 64, dW + (st) * GST2 + q * 1024); GLDS16(X + off[q] + (kt) * 64, dX + (st) * GST2 + q * 1024); } } while (0)
    const int wn4 = w & 3, wm2 = w >> 2, c15 = lane & 15, g4 = lane >> 4;
    const int sw = (c15 >> 1) & 7;
    int so[2];
#pragma unroll
    for (int s = 0; s < 2; ++s) so[s] = ((4 * s + g4) ^ sw) << 4;
    const int bn0 = (64 * wn4 + c15) * 128, bm0 = 32768 + (128 * wm2 + c15) * 128;
#pragma unroll
    for (int a = 0; a < 4; ++a)
#pragma unroll
        for (int b = 0; b < 8; ++b) acc[a][b] = (f32x4){0.f, 0.f, 0.f, 0.f};
    if (issue_first) GC2_ISSUE(0, 0);
    asm volatile("s_waitcnt vmcnt(0)" ::: "memory");
    __syncthreads();
    for (int kt = 0; kt < 16; ++kt) {
        const int st = kt & 1;
        if (kt + 1 < 16) GC2_ISSUE(kt + 1, st ^ 1);
        LAS unsigned char* const base = F.lds + st * GST2;
#pragma unroll
        for (int s = 0; s < 2; ++s) {
            bf16x8 fa[4];
#pragma unroll
            for (int q = 0; q < 4; ++q) fa[q] = *(const LAS bf16x8*)(base + bn0 + q * 2048 + so[s]);
#pragma unroll
            for (int hb = 0; hb < 2; ++hb) {
                bf16x8 fb[4];
#pragma unroll
                for (int q = 0; q < 4; ++q) fb[q] = *(const LAS bf16x8*)(base + bm0 + (4 * hb + q) * 2048 + so[s]);
#pragma unroll
                for (int a = 0; a < 4; ++a)
#pragma unroll
                    for (int b = 0; b < 4; ++b) acc[a][4 * hb + b] = __builtin_amdgcn_mfma_f32_16x16x32_bf16(fa[a], fb[b], acc[a][4 * hb + b], 0, 0, 0);
            }
        }
        asm volatile("s_waitcnt vmcnt(0)" ::: "memory");
        __syncthreads();
    }
#undef GC2_ISSUE
    if (has_next) gemm256_issue0(F, Wn, Xn);
}
typedef f32x4 GemmAcc2[2][8];
__device__ __forceinline__ void gemm_core256n(const Frame& F, const bf16_t* __restrict__ W, const bf16_t* __restrict__ X, GemmAcc2& acc, bool issue_first) {
    int lane = F.lane; const int w = F.w;
    asm volatile("" : "+v"(lane));
    int off[4];
#pragma unroll
    for (int q = 0; q < 4; ++q) { const int row = 32 * w + 8 * q + (lane >> 3); off[q] = row * 1024 + ((lane & 7) ^ ((row >> 1) & 7)) * 8; }
    LAS unsigned char* const dW = F.lds + (32 * w) * 128;
    LAS unsigned char* const dX = F.lds + 32768 + (32 * w) * 128;
#define GC2_ISSUE(kt, st) do { _Pragma("unroll") for (int q = 0; q < 4; ++q) { if (w == 0) GLDS16(W + off[q] + (kt) * 64, dW + (st) * GST2 + q * 1024); GLDS16(X + off[q] + (kt) * 64, dX + (st) * GST2 + q * 1024); } } while (0)
    const int wn4 = w & 3, wm2 = w >> 2, c15 = lane & 15, g4 = lane >> 4;
    const int sw = (c15 >> 1) & 7;
    int so[2];
#pragma unroll
    for (int s = 0; s < 2; ++s) so[s] = ((4 * s + g4) ^ sw) << 4;
    const int bn0 = (64 * wn4 + c15) * 128, bm0 = 32768 + (128 * wm2 + c15) * 128;
#pragma unroll
    for (int a = 0; a < 2; ++a)
#pragma unroll
        for (int b = 0; b < 8; ++b) acc[a][b] = (f32x4){0.f, 0.f, 0.f, 0.f};
    if (issue_first) GC2_ISSUE(0, 0);
    asm volatile("s_waitcnt vmcnt(0)" ::: "memory");
    __syncthreads();
    for (int kt = 0; kt < 16; ++kt) {
        const int st = kt & 1;
        if (kt + 1 < 16) GC2_ISSUE(kt + 1, st ^ 1);
        LAS unsigned char* const base = F.lds + st * GST2;
        if (wn4 == 0) {
#pragma unroll
        for (int s = 0; s < 2; ++s) {
            bf16x8 fa[2];
#pragma unroll
            for (int q = 0; q < 2; ++q) fa[q] = *(const LAS bf16x8*)(base + bn0 + q * 2048 + so[s]);
#pragma unroll
            for (int hb = 0; hb < 2; ++hb) {
                bf16x8 fb[4];
#pragma unroll
                for (int q = 0; q < 4; ++q) fb[q] = *(const LAS bf16x8*)(base + bm0 + (4 * hb + q) * 2048 + so[s]);
#pragma unroll
                for (int a = 0; a < 2; ++a)
#pragma unroll
                    for (int b = 0; b < 4; ++b) acc[a][4 * hb + b] = __builtin_amdgcn_mfma_f32_16x16x32_bf16(fa[a], fb[b], acc[a][4 * hb + b], 0, 0, 0);
            }
        }
        }
        asm volatile("s_waitcnt vmcnt(0)" ::: "memory");
        __syncthreads();
    }
#undef GC2_ISSUE
}

__device__ __forceinline__ void rope64_16(float (&v)[4][4], float rowp, float colp, int g4) {
#pragma unroll
    for (int i = 0; i < 4; ++i) {
        const float fr = __builtin_amdgcn_exp2f((float)(4 * g4 + i) * -0.8304820237218406f) * 0.15915494309189535f;
#pragma unroll
        for (int c = 0; c < 2; ++c) {
            const float rev = (c ? colp : rowp) * fr;
            const float sn = __builtin_amdgcn_sinf(rev), cs = __builtin_amdgcn_cosf(rev);
            const float x0 = v[2 * c][i], x1 = v[2 * c + 1][i];
            v[2 * c][i] = x0 * cs - x1 * sn;
            v[2 * c + 1][i] = x1 * cs + x0 * sn;
        }
    }
}
__device__ __forceinline__ void rope32_16(float (&a)[4], float (&b)[4], float rowp, float colp, int g4) {
    const bool hi = g4 >= 2;
#pragma unroll
    for (int i = 0; i < 4; ++i) {
        const float fr = __builtin_amdgcn_exp2f((float)(4 * (g4 & 1) + i) * -1.6609640474436813f) * 0.15915494309189535f;
        {
            const float rev = rowp * fr;
            const float sn = __builtin_amdgcn_sinf(rev), cs = __builtin_amdgcn_cosf(rev);
            const float own = a[i], oth = __shfl_xor(own, 32);
            a[i] = own * cs + oth * (hi ? sn : -sn);
        }
        {
            const float rev = colp * fr;
            const float sn = __builtin_amdgcn_sinf(rev), cs = __builtin_amdgcn_cosf(rev);
            const float own = b[i], oth = __shfl_xor(own, 32);
            b[i] = own * cs + oth * (hi ? sn : -sn);
        }
    }
}
__device__ __forceinline__ float ssq64(const float (&v)[4][4]) {
    float s = 0.f;
#pragma unroll
    for (int nt = 0; nt < 4; ++nt)
#pragma unroll
        for (int i = 0; i < 4; ++i) s += v[nt][i] * v[nt][i];
    s += __shfl_xor(s, 16);
    s += __shfl_xor(s, 32);
    return s;
}
__device__ __forceinline__ void mulvec64(float (&v)[4][4], const LAS float* gv, int g4) {
#pragma unroll
    for (int nt = 0; nt < 4; ++nt) {
        const f32x4 q = *(const LAS f32x4*)(gv + 16 * nt + 4 * g4);
#pragma unroll
        for (int i = 0; i < 4; ++i) v[nt][i] *= q[i];
    }
}
constexpr int OST_LD = 68, OST_BYTES = 32 * OST_LD * 4;
__device__ __forceinline__ void stage_write16(LAS float* st, const float (&v)[4][4], int mh, int c15, int g4) {
    asm volatile("s_waitcnt lgkmcnt(0)" ::: "memory");
    __builtin_amdgcn_wave_barrier();
#pragma unroll
    for (int nt = 0; nt < 4; ++nt) {
        f32x4 o = {v[nt][0], v[nt][1], v[nt][2], v[nt][3]};
        *(LAS f32x4*)(st + (16 * mh + c15) * OST_LD + 16 * nt + 4 * g4) = o;
    }
    asm volatile("s_waitcnt lgkmcnt(0)" ::: "memory");
    __builtin_amdgcn_wave_barrier();
}
__device__ __forceinline__ void stage_write16a(LAS float* st, const f32x4 (&a)[4][4], int mt, int c15, int g4) {
    asm volatile("s_waitcnt lgkmcnt(0)" ::: "memory");
    __builtin_amdgcn_wave_barrier();
#pragma unroll
    for (int nt = 0; nt < 4; ++nt) *(LAS f32x4*)(st + (16 * (mt & 1) + c15) * OST_LD + 16 * nt + 4 * g4) = a[nt][mt];
    asm volatile("s_waitcnt lgkmcnt(0)" ::: "memory");
    __builtin_amdgcn_wave_barrier();
}
__device__ __forceinline__ void stage_store_bf16(const LAS float* st, bf16_t* dst, int ld, float sc, int lane) {
#pragma unroll 1
    for (int it = 0; it < 4; ++it) {
        const int row = it * 8 + (lane >> 3), c8 = (lane & 7) * 8;
        const f32x4 x0 = *(const LAS f32x4*)(st + row * OST_LD + c8), x1 = *(const LAS f32x4*)(st + row * OST_LD + c8 + 4);
        u32x4 o; o.x = pk2(x0[0] * sc, x0[1] * sc); o.y = pk2(x0[2] * sc, x0[3] * sc); o.z = pk2(x1[0] * sc, x1[1] * sc); o.w = pk2(x1[2] * sc, x1[3] * sc);
        ST16_WT(dst + (size_t)row * ld + c8, o);
    }
}
__device__ __forceinline__ void stage_store_bf16_sc1(const LAS float* st, bf16_t* dst, int ld, int lane) {
#pragma unroll 1
    for (int it = 0; it < 4; ++it) {
        const int row = it * 8 + (lane >> 3), c8 = (lane & 7) * 8;
        const f32x4 x0 = *(const LAS f32x4*)(st + row * OST_LD + c8), x1 = *(const LAS f32x4*)(st + row * OST_LD + c8 + 4);
        u32x4 o; o.x = pk2(x0[0], x0[1]); o.y = pk2(x0[2], x0[3]); o.z = pk2(x1[0], x1[1]); o.w = pk2(x1[2], x1[3]);
        bf16_t* ptr = dst + (size_t)row * ld + c8;
        asm volatile("global_store_dwordx4 %0, %1, off sc1\n\ts_nop 1" :: "v"(ptr), "v"(o) : "memory");
    }
}
__device__ __forceinline__ void stage_store_f32(const LAS float* st, float* dst, int ld, int lane) {
#pragma unroll 1
    for (int it = 0; it < 8; ++it) {
        const int row = it * 4 + (lane >> 4), c = (lane & 15) * 4;
        { const f32x4 o = *(const LAS f32x4*)(st + row * OST_LD + c); ST16_WT(dst + (size_t)row * ld + c, o); }
    }
}
__device__ __forceinline__ void stage_store_bf16_32(const LAS float* st, bf16_t* dst, int ld, int lane) {
#pragma unroll 1
    for (int it = 0; it < 2; ++it) {
        const int row = it * 16 + (lane >> 2), c8 = (lane & 3) * 8;
        const f32x4 x0 = *(const LAS f32x4*)(st + row * OST_LD + c8), x1 = *(const LAS f32x4*)(st + row * OST_LD + c8 + 4);
        u32x4 o; o.x = pk2(x0[0], x0[1]); o.y = pk2(x0[2], x0[3]); o.z = pk2(x1[0], x1[1]); o.w = pk2(x1[2], x1[3]);
        ST16_WT(dst + (size_t)row * ld + c8, o);
    }
}
__device__ __forceinline__ void stage_store_f32_32(const LAS float* st, float* dst, int ld, int lane) {
#pragma unroll 1
    for (int it = 0; it < 4; ++it) {
        const int row = it * 8 + (lane >> 3), c = (lane & 7) * 4;
        { const f32x4 o = *(const LAS f32x4*)(st + row * OST_LD + c); ST16_WT(dst + (size_t)row * ld + c, o); }
    }
}

struct Gemm1Pre { float rstd[2]; float bias, gain; };
__device__ __forceinline__ void gemm1_pre(const Frame& F, const Params& p, int tn, int wn, int tm, int l, Gemm1Pre& P) {
    const float* ssqp = (const float*)(F.ws + WS_SSQ);
#pragma unroll
    for (int jj = 0; jj < 2; ++jj) {
        const int tok = tm * 256 + (F.w >> 2) * 128 + 64 * jj + F.lane;
        const f32x4* sp = (const f32x4*)(ssqp + (size_t)tok * 16);
        float ss = 0.f;
#pragma unroll
        for (int i = 0; i < 4; ++i) { const f32x4 q = sp[i]; ss += (q[0] + q[1]) + (q[2] + q[3]); }
        P.rstd[jj] = rsqrtf(ss * (1.f / 1024.f) + EPS);
    }
    const bool lat = tm >= 16;
    const int cond = lat ? 1 + ((tm - 16) >> 2) : 0;
    const int nb = tn * 128 + wn * 64;
    P.bias = (tn < 23) ? ((const float*)(F.ws + WS_BIAS))[(size_t)(l * 5 + cond) * 2944 + nb + F.lane] : 0.f;
    const float* gp = nullptr;
    if (tn >= 6 && tn < 9) gp = pin(F, I_GQN) + l * 64;
    else if (tn == 9) gp = pin(F, I_GKN) + l * 64;
    else if (tn == 11 || tn == 12) gp = pin(F, I_MQN) + l * 256 + (nb - 1408);
    else if (tn == 13) gp = pin(F, I_MKVN) + l * 128 + wn * 64;
    P.gain = gp ? gp[F.lane] : 1.f;
}
__device__ __forceinline__ void epi_gemm1(const Frame& F, const Params& p, GemmAcc8& acc, int tn, int wn, int tm, int l, const Gemm1Pre& P, bool ckv_tile) {
    int lane = F.lane; const int wm = F.w >> 2;
    asm volatile("" : "+v"(lane));
    const int c15 = lane & 15, g4 = lane >> 4;
    unsigned char* ws = F.ws;
    asm volatile("" : "+s"(ws));
    LAS float* st = (LAS float*)(F.lds + LDS_OST + F.w * OST_BYTES);
    const bool lat = tm >= 16;
    const int b = lat ? ((tm - 16) >> 2) : tm;
    const int nb = tn * 128 + wn * 64;
    LAS float* exb = (LAS float*)(F.lds + LDS_EXB) + F.w * 128;
    exb[lane] = P.bias; exb[64 + lane] = P.gain;
    asm volatile("s_waitcnt lgkmcnt(0)" ::: "memory");
    __builtin_amdgcn_wave_barrier();
    const LAS float* bias = exb;
    float* outp = p.out;
    asm volatile("" : "+s"(outp));
    float ckv_ss[8];
    if (tn < 23) {
#pragma unroll
    for (int mt = 0; mt < 8; ++mt) {
        const int mh = mt & 1;
        const int tok0 = tm * 256 + wm * 128 + (mt >> 1) * 32;
        const int tokb = tok0 + 16 * mh, tok = tokb + c15;
        const int t0 = lat ? ((tok0 - 4096) & 1023) : (tok0 & 255), t = t0 + 16 * mh + c15;
        const float rstd = __shfl(P.rstd[mt >> 2], 16 * (mt & 3) + c15);
        float v[4][4];
#pragma unroll
        for (int nt = 0; nt < 4; ++nt) {
            const f32x4 bq = *(const LAS f32x4*)(bias + 16 * nt + 4 * g4);
#pragma unroll
            for (int i = 0; i < 4; ++i) v[nt][i] = acc[nt][mt][i] * rstd + bq[i];
        }
        const float rowp = (float)(t >> 6), colp = (float)(t & 63);
        const size_t orow0 = (size_t)(b * 4 + l) * 256 + t0;
        if (tn < 2) {
            if (lat) rope64_16(v, rowp, colp, g4);
            stage_write16(st, v, mh, c15, g4);
            if (mh) stage_store_bf16(st, (bf16_t*)(ws + WS_RQ) + (size_t)tok0 * 256 + nb, 256, 1.f, lane);
        } else if (tn < 4) {
            if (lat) rope64_16(v, rowp, colp, g4);
            stage_write16(st, v, mh, c15, g4);
            if (mh) stage_store_bf16(st, (bf16_t*)(ws + WS_RK) + (size_t)tok0 * 256 + (nb - 256), 256, 0.125f, lane);
        } else if (tn < 6) {
            stage_write16(st, v, mh, c15, g4);
            if (mh) stage_store_bf16(st, (bf16_t*)(ws + WS_RV) + (size_t)tok0 * 256 + (nb - 512), 256, 1.f, lane);
        } else if (tn < 9) {
            const float r = rsqrtf(ssq64(v) * (1.f / 64.f) + EPS);
#pragma unroll
            for (int nt = 0; nt < 4; ++nt)
#pragma unroll
                for (int i = 0; i < 4; ++i) v[nt][i] *= r;
            mulvec64(v, exb + 64, g4);
            if (lat) rope64_16(v, rowp, colp, g4);
            stage_write16(st, v, mh, c15, g4);
            if (mh) stage_store_bf16(st, (bf16_t*)(ws + WS_GQ) + (size_t)tok0 * 384 + (nb - 768), 384, QSC_GQA, lane);
        } else if (tn == 9) {
            const float r = rsqrtf(ssq64(v) * (1.f / 64.f) + EPS);
#pragma unroll
            for (int nt = 0; nt < 4; ++nt)
#pragma unroll
                for (int i = 0; i < 4; ++i) v[nt][i] *= r;
            mulvec64(v, exb + 64, g4);
            if (lat) rope64_16(v, rowp, colp, g4);
            stage_write16(st, v, mh, c15, g4);
            if (mh) {
                if (!lat) stage_store_f32(st, outp + O_GK + orow0 * 128 + (nb - 1152), 128, lane);
                stage_store_bf16(st, (bf16_t*)(ws + WS_GK) + (size_t)tok0 * 128 + (nb - 1152), 128, 1.f, lane);
            }
        } else if (tn == 10) {
            stage_write16(st, v, mh, c15, g4);
            if (mh) {
                if (!lat) stage_store_f32(st, outp + O_GV + orow0 * 128 + (nb - 1280), 128, lane);
                stage_store_bf16(st, (bf16_t*)(ws + WS_GV) + (size_t)tok0 * 128 + (nb - 1280), 128, 1.f, lane);
            }
        } else if (tn < 13) {
            const float s2 = ssq64(v);
            if (g4 == 0) __hip_atomic_store((__attribute__((address_space(1))) float*)((float*)(ws + WS_CQSSQ) + (size_t)tok * 4 + ((nb - 1408) >> 6)), s2, __ATOMIC_RELAXED, __HIP_MEMORY_SCOPE_AGENT);
            mulvec64(v, exb + 64, g4);
            stage_write16(st, v, mh, c15, g4);
            if (mh) stage_store_bf16_sc1(st, (bf16_t*)(ws + WS_CQG) + (size_t)tok0 * 256 + (nb - 1408), 256, lane);
        } else if (tn == 13) {
            ckv_ss[mt] = ssq64(v);
            if (g4 == 0) ((LAS float*)(F.lds + LDS_EX))[(wm * 2 + wn) * 128 + mt * 16 + c15] = ckv_ss[mt];
        } else if (tn < 22) {
#pragma unroll
            for (int nt = 0; nt < 4; ++nt)
#pragma unroll
                for (int i = 0; i < 4; ++i) v[nt][i] = silu_f(v[nt][i]);
            stage_write16(st, v, mh, c15, g4);
            if (mh) stage_store_bf16(st, (bf16_t*)(ws + WS_ZS) + (size_t)tok0 * 1024 + (nb - 1792), 1024, 1.f, lane);
        } else {
            if (wn == 0) {
                if (lat) rope32_16(v[0], v[1], rowp, colp, g4);
                stage_write16(st, v, mh, c15, g4);
                if (mh) {
                    if (!lat) stage_store_f32_32(st, outp + O_KPE + orow0 * 32, 32, lane);
                    stage_store_bf16_32(st, (bf16_t*)(ws + WS_KPEB) + (size_t)tok0 * 32, 32, lane);
                }
            }
        }
    }
    }
    if (ckv_tile) {
        __syncthreads();
        if (tn == 13) {
#pragma unroll
        for (int mt = 0; mt < 8; ++mt) {
            const int mh = mt & 1;
            const int tok0 = tm * 256 + wm * 128 + (mt >> 1) * 32;
            const int t0 = lat ? ((tok0 - 4096) & 1023) : (tok0 & 255);
            const float rstd = __shfl(P.rstd[mt >> 2], 16 * (mt & 3) + c15);
            float v[4][4];
#pragma unroll
            for (int nt = 0; nt < 4; ++nt) {
                const f32x4 bq = *(const LAS f32x4*)(bias + 16 * nt + 4 * g4);
#pragma unroll
                for (int i = 0; i < 4; ++i) v[nt][i] = acc[nt][mt][i] * rstd + bq[i];
            }
            const float tot = ckv_ss[mt] + ((const LAS float*)(F.lds + LDS_EX))[(wm * 2 + (wn ^ 1)) * 128 + mt * 16 + c15];
            const float r = rsqrtf(tot * (1.f / 128.f) + EPS);
#pragma unroll
            for (int nt = 0; nt < 4; ++nt)
#pragma unroll
                for (int i = 0; i < 4; ++i) v[nt][i] *= r;
            mulvec64(v, exb + 64, g4);
            const size_t orow0 = (size_t)(b * 4 + l) * 256 + t0;
            stage_write16(st, v, mh, c15, g4);
            if (mh) {
                if (!lat) stage_store_f32(st, outp + O_CKV + orow0 * 128 + wn * 64, 128, lane);
                stage_store_bf16_sc1(st, (bf16_t*)(ws + WS_CKVN) + (size_t)tok0 * 128 + wn * 64, 128, lane);
            }
        }
        }
        __syncthreads();
    }
}

__device__ __forceinline__ void qm_pre(const Frame& F, int tm, float& rstd) {
    const int tok = tm * 256 + (F.w >> 1) * 64 + F.lane;
    const f32x4 q4 = *(const f32x4*)((const float*)(F.ws + WS_CQSSQ) + (size_t)tok * 4);
    rstd = rsqrtf(((q4[0] + q4[1]) + (q4[2] + q4[3])) * (1.f / 256.f) + EPS);
}
__device__ __forceinline__ void epi_qm(const Frame& F, GemmAcc& acc, int tn, int tm, float rstdl) {
    int lane = F.lane; const int wn = F.w & 1, wm = F.w >> 1;
    asm volatile("" : "+v"(lane));
    const int c15 = lane & 15, g4 = lane >> 4;
    unsigned char* ws = F.ws;
    LAS float* st = (LAS float*)(F.lds + LDS_OST + F.w * OST_BYTES);
    const bool lat = tm >= 16;
    const int nb = tn * 128 + wn * 64;
    if (nb >= 576) return;
#pragma unroll
    for (int mt = 0; mt < 4; ++mt) {
        const int mh = mt & 1;
        const int tok0 = tm * 256 + wm * 64 + (mt >> 1) * 32, tok = tok0 + 16 * mh + c15;
        const int t = lat ? ((tok - 4096) & 1023) : (tok & 255);
        const float rstd = __shfl(rstdl, 16 * mt + c15);
        const float rowp = (float)(t >> 6), colp = (float)(t & 63);
        float v[4][4];
#pragma unroll
        for (int nt = 0; nt < 4; ++nt)
#pragma unroll
            for (int i = 0; i < 4; ++i) v[nt][i] = acc[nt][mt][i] * rstd;
#pragma unroll
        for (int q = 0; q < 2; ++q) {
            const int T = (nb + 32 * q) >> 5;
            if (lat && (T % 3) == 2) rope32_16(v[2 * q], v[2 * q + 1], rowp, colp, g4);
        }
        stage_write16(st, v, mh, c15, g4);
        if (mh) stage_store_bf16(st, (bf16_t*)(ws + WS_QM) + (size_t)tok0 * 576 + nb, 576, QSC_MLA, lane);
    }
}
__device__ __forceinline__ void epi_plain(const Frame& F, GemmAcc& acc, bf16_t* D, int ldd, int row0, int n0) {
    int lane = F.lane; const int wn = F.w & 1, wm = F.w >> 1;
    asm volatile("" : "+v"(lane));
    const int c15 = lane & 15, g4 = lane >> 4;
    LAS float* st = (LAS float*)(F.lds + LDS_OST + F.w * OST_BYTES);
#pragma unroll
    for (int mt = 0; mt < 4; ++mt) {
        const int r0 = row0 + wm * 64 + (mt >> 1) * 32;
        stage_write16a(st, acc, mt, c15, g4);
        if (mt & 1) stage_store_bf16(st, D + (size_t)r0 * ldd + n0 + wn * 64, ldd, 1.f, lane);
    }
}

struct Gemm2Pre { f32x4 gt0, gt1, gs0, gs1; };
__device__ __forceinline__ void gemm2_pre(const Frame& F, int tn, int tm, int l, Gemm2Pre& P) {
    const bool lat = tm >= 16; const int cond = lat ? 1 + ((tm - 16) >> 2) : 0;
    const int nb = tn * 128 + (F.w & 1) * 64, c8 = (F.lane & 7) * 8;
    const float* gtp = (const float*)(F.ws + WS_MODS) + (size_t)(l * 5 + cond) * 3072 + 2048 + nb + c8;
    const float* gsp = (const float*)(F.ws + WS_GS) + (size_t)((l < 3 ? l + 1 : 3) * 5 + cond) * 1024 + nb + c8;
    P.gt0 = *(const f32x4*)gtp; P.gt1 = *(const f32x4*)(gtp + 4);
    P.gs0 = *(const f32x4*)gsp; P.gs1 = *(const f32x4*)(gsp + 4);
}
__device__ __forceinline__ void epi_gemm2(const Frame& F, const Params& p, GemmAcc& acc, int tn, int tm, int l, const Gemm2Pre& P, bool last) {
    int lane = F.lane; const int wn = F.w & 1, wm = F.w >> 1;
    asm volatile("" : "+v"(lane));
    const int c15 = lane & 15, g4 = lane >> 4;
    unsigned char* ws = F.ws;
    LAS float* st = (LAS float*)(F.lds + LDS_OST + F.w * OST_BYTES);
    const bool lat = tm >= 16;
    const int nb = tn * 128 + wn * 64;
    const int c8 = (lane & 7) * 8, r8 = lane >> 3;
#pragma unroll
    for (int mt = 0; mt < 2; ++mt) {
        const int tok0 = tm * 256 + wm * 64 + mt * 32;
        stage_write16a(st, acc, 2 * mt, c15, g4);
        stage_write16a(st, acc, 2 * mt + 1, c15, g4);
        bf16_t* xb0 = (bf16_t*)(ws + WS_XB) + (size_t)tok0 * 1024 + nb + c8;
        f32x4 xo8[8];
        if (l == 0) {
            const float* xold0 = lat ? pin(F, I_XS) + (size_t)(tok0 - 4096) * 1024 : pin(F, I_XP) + (size_t)tok0 * 1024;
#pragma unroll
            for (int it = 0; it < 4; ++it) {
                const float* xp = xold0 + (size_t)(it * 8 + r8) * 1024 + nb + c8;
                xo8[2 * it] = *(const f32x4*)xp; xo8[2 * it + 1] = *(const f32x4*)(xp + 4);
            }
        } else {
#pragma unroll
            for (int it = 0; it < 4; ++it) {
                const u32x4 q = *(const u32x4*)(xb0 + (size_t)(it * 8 + r8) * 1024);
                xo8[2 * it] = (f32x4){bflo(q.x), bfhi(q.x), bflo(q.y), bfhi(q.y)}; xo8[2 * it + 1] = (f32x4){bflo(q.z), bfhi(q.z), bflo(q.w), bfhi(q.w)};
            }
        }
#pragma unroll
        for (int it = 0; it < 4; ++it) {
            const int row = it * 8 + r8;
            const f32x4 a0 = *(const LAS f32x4*)(st + row * OST_LD + c8), a1 = *(const LAS f32x4*)(st + row * OST_LD + c8 + 4);
            const f32x4 xn0 = xo8[2 * it] + P.gt0 * a0, xn1 = xo8[2 * it + 1] + P.gt1 * a1;
            {
                u32x4 o; o.x = pk2(xn0[0], xn0[1]); o.y = pk2(xn0[2], xn0[3]); o.z = pk2(xn1[0], xn1[1]); o.w = pk2(xn1[2], xn1[3]);
                if (last) ST16_WT(xb0 + (size_t)row * 1024, o); else *(u32x4*)(xb0 + (size_t)row * 1024) = o;
            }
            float ss = ((xn0[0] * xn0[0] + xn0[1] * xn0[1]) + (xn0[2] * xn0[2] + xn0[3] * xn0[3])) + ((xn1[0] * xn1[0] + xn1[1] * xn1[1]) + (xn1[2] * xn1[2] + xn1[3] * xn1[3]));
            ss += __shfl_xor(ss, 1); ss += __shfl_xor(ss, 2); ss += __shfl_xor(ss, 4);
            if ((lane & 7) == 0) {
                float* sq = (float*)(ws + WS_SSQ) + (size_t)(tok0 + row) * 16 + tn * 2 + wn;
                __hip_atomic_store((__attribute__((address_space(1))) float*)sq, ss, __ATOMIC_RELAXED, __HIP_MEMORY_SCOPE_AGENT);
            }
            if (l < 3) {
                u32x4 o; o.x = pk2(xn0[0] * P.gs0[0], xn0[1] * P.gs0[1]); o.y = pk2(xn0[2] * P.gs0[2], xn0[3] * P.gs0[3]);
                o.z = pk2(xn1[0] * P.gs1[0], xn1[1] * P.gs1[1]); o.w = pk2(xn1[2] * P.gs1[2], xn1[3] * P.gs1[3]);
                ST16_WT((bf16_t*)(ws + WS_XG) + (size_t)(tok0 + row) * 1024 + nb + c8, o);
            }
        }
    }
}

__device__ __forceinline__ void epi_kpe(const Frame& F, const Params& p, GemmAcc2& acc, int tm, int l, const Gemm1Pre& P) {
    int lane = F.lane; const int wm = F.w >> 2;
    asm volatile("" : "+v"(lane));
    const int c15 = lane & 15, g4 = lane >> 4;
    unsigned char* ws = F.ws;
    asm volatile("" : "+s"(ws));
    float* outp = p.out;
    asm volatile("" : "+s"(outp));
    LAS float* st = (LAS float*)(F.lds + LDS_OST + F.w * OST_BYTES);
    const bool lat = tm >= 16;
    const int b = lat ? ((tm - 16) >> 2) : tm;
    LAS float* exb = (LAS float*)(F.lds + LDS_EXB) + F.w * 128;
    exb[lane] = P.bias;
    asm volatile("s_waitcnt lgkmcnt(0)" ::: "memory");
    __builtin_amdgcn_wave_barrier();
#pragma unroll
    for (int mt = 0; mt < 8; ++mt) {
        const int mh = mt & 1;
        const int tok0 = tm * 256 + wm * 128 + (mt >> 1) * 32;
        const int t0 = lat ? ((tok0 - 4096) & 1023) : (tok0 & 255), t = t0 + 16 * mh + c15;
        const float rstd = __shfl(P.rstd[mt >> 2], 16 * (mt & 3) + c15);
        float v[4][4];
#pragma unroll
        for (int nt = 0; nt < 2; ++nt) {
            const f32x4 bq = *(const LAS f32x4*)(exb + 16 * nt + 4 * g4);
#pragma unroll
            for (int i = 0; i < 4; ++i) { v[nt][i] = acc[nt][mt][i] * rstd + bq[i]; v[2 + nt][i] = 0.f; }
        }
        const float rowp = (float)(t >> 6), colp = (float)(t & 63);
        const size_t orow0 = (size_t)(b * 4 + l) * 256 + t0;
        if (lat) rope32_16(v[0], v[1], rowp, colp, g4);
        stage_write16(st, v, mh, c15, g4);
        if (mh) {
            if (!lat) stage_store_f32_32(st, outp + O_KPE + orow0 * 32, 32, lane);
            stage_store_bf16_32(st, (bf16_t*)(ws + WS_KPEB) + (size_t)tok0 * 32, 32, lane);
        }
    }
}
constexpr int AT_STG = 20480, AT_PE = 8192, AT_V = 12288, AT_OLD = 68;
struct AttnUnit {
    int mode;
    int nt0, nt1;
    const bf16_t *q; int q_ld;
    const bf16_t *k0, *k1; int k_ld0, k_ld1;
    const bf16_t *pe0, *pe1;
    const bf16_t *v0, *v1; int v_ld0, v_ld1;
    int tok0;
    int ycol;
    int qpos0, L;
    float lf, lb;
    const bf16_t *s0f, *s0b;
    unsigned* zflag;
    unsigned* yflag;
    float* st_out;
};
__device__ __forceinline__ s16x4 tr16(LAS const unsigned char* p) {
    typedef short v4i16_t __attribute__((ext_vector_type(4)));
    return __builtin_bit_cast(s16x4, __builtin_amdgcn_ds_read_tr16_b64_v4i16((LAS v4i16_t*)p));
}

template <int MODE>
__device__ __forceinline__ void attn_unit(const Frame& F, const Params& p, const AttnUnit& U) {
    constexpr int NQS = MODE == 1 ? 6 : 4;
    int lane = F.lane; const int w = F.w;
    asm volatile("" : "+v"(lane));
    const int h = lane >> 5, lq = lane & 31;
    LAS unsigned char* lds = F.lds;
    const int k_ld = U.k_ld1, v_ld = U.v_ld1;
    const int krow = 8 * w + (lane >> 3);
    const int koff = krow * k_ld + ((lane & 7) ^ ((krow >> 1) & 7)) * 8;
    const int poff = (16 * (w & 3) + (lane >> 2)) * 32 + ((lane & 3) ^ ((lane >> 4) & 3)) * 8;
    const int vdblk = w >> 2, vkg = w & 3;
    const int voff = (16 * vkg + (lane >> 2)) * v_ld + vdblk * 32 + (lane & 3) * 8;
    const int vdst = AT_V + vdblk * 4096 + vkg * 1024;
    const int nt0 = U.nt0, ntot = U.nt0 + U.nt1;
    const unsigned ldsb = (unsigned)(uintptr_t)lds;
#define AT_DMA(gsrc, ldsoff) do { unsigned _keep; const unsigned _d = (unsigned)__builtin_amdgcn_readfirstlane((int)(ldsb + (unsigned)(ldsoff))); \
        asm volatile("s_mov_b32 %0, m0\n\ts_mov_b32 m0, %2\n\ts_nop 0\n\tglobal_load_lds_dwordx4 %1, off\n\ts_mov_b32 m0, %0" : "=&s"(_keep) : "v"(gsrc), "s"(_d) : "memory"); } while (0)
#define AT_ISSUE(t, st) do { const int _t = (t); const int _b = (st) * AT_STG; \
        const bool _s0 = _t < nt0; const int _u = _s0 ? _t : _t - nt0; \
        const bf16_t* _kb = (_s0 ? U.k0 : U.k1) + (size_t)_u * 64 * k_ld; const bf16_t* _vb = (_s0 ? U.v0 : U.v1) + (size_t)_u * 64 * v_ld; \
        AT_DMA(_kb + koff, _b + (8 * w) * 128); \
        if (MODE == 1) { const bf16_t* _pb = (_s0 ? U.pe0 : U.pe1) + (size_t)_u * 64 * 32; AT_DMA(_pb + poff, _b + AT_PE + 16 * (w & 3) * 64); } \
        AT_DMA(_vb + voff, _b + vdst); } while (0)
    AT_ISSUE(0, 0);
    if (ntot > 1) AT_ISSUE(1, 1);
    bf16x8 qr[NQS];
    if (MODE == 3) {
        const int dk = 32 * (w & 1) + lq;
#pragma unroll
        for (int s = 0; s < 4; ++s)
#pragma unroll
            for (int j = 0; j < 8; ++j) qr[s][j] = (16 * s + 8 * h + j == dk) ? (short)0x3F80 : (short)0;
    } else {
        const bf16_t* qp = U.q + (size_t)(32 * w + lq) * U.q_ld + 8 * h;
#pragma unroll
        for (int s = 0; s < NQS; ++s) qr[s] = *(const bf16x8*)(qp + 16 * s);
    }
    f32x16 o[2];
#pragma unroll
    for (int d = 0; d < 2; ++d)
#pragma unroll
        for (int r = 0; r < 16; ++r) o[d][r] = 0.f;
    float m_run = 0.f, l_run = 0.f;
    f32x16 negm;
#pragma unroll
    for (int r = 0; r < 16; ++r) negm[r] = 0.f;
    const int qpos = U.qpos0 + 32 * w + lq;
    const float st_slope = ((w >> 1) & 1) ? U.lb : -U.lf, st_off = ((w >> 1) & 1) ? 0.f : 255.f * U.lf;
    const int sdir = (w >> 1) & 1;
    LAS float* scal = (LAS float*)(lds + LDS_SCAL) + w * 32;
    LAS float* ctab = (LAS float*)(lds + LDS_EXB) + w * 128;
    float a_f = 0.f, a_b = 0.f;
    if (MODE == 2) {
        ctab[lane] = __builtin_amdgcn_exp2f((float)(63 - lane) * U.lf);
        ctab[64 + lane] = __builtin_amdgcn_exp2f((float)lane * U.lb);
        a_f = __builtin_amdgcn_exp2f((float)(32 * w + lq) * U.lf);
        a_b = __builtin_amdgcn_exp2f((float)(255 - 32 * w - lq) * U.lb);
        asm volatile("s_waitcnt lgkmcnt(0)" ::: "memory");
        __builtin_amdgcn_wave_barrier();
    }
    const int kfo = lq * 128, sw = (lane >> 1) & 7, pfo = AT_PE + lq * 64, psw = (lane >> 2) & 3;
    const int vfo = AT_V + (4 * h + ((lane & 15) >> 2)) * 64 + ((lane >> 4) & 1) * 32 + (lane & 3) * 8;
    int st = 0;
    for (int t = 0; t < ntot; ++t) {
        if (t + 1 < ntot) { if (MODE == 1) asm volatile("s_waitcnt vmcnt(3)" ::: "memory"); else asm volatile("s_waitcnt vmcnt(2)" ::: "memory"); }
        else asm volatile("s_waitcnt vmcnt(0)" ::: "memory");
        __builtin_amdgcn_s_barrier();
        asm volatile("" ::: "memory");
        const int st2 = st == 0 ? 2 : st - 1;
        if (t + 2 < ntot) AT_ISSUE(t + 2, st2);
        LAS const unsigned char* base = lds + st * AT_STG;
        bf16x8 kfa[NQS], kfb[NQS];
#pragma unroll
        for (int s = 0; s < 4; ++s) {
            const int so = ((2 * s + h) ^ sw) << 4;
            kfa[s] = *(const LAS bf16x8*)(base + kfo + so);
            kfb[s] = *(const LAS bf16x8*)(base + kfo + 4096 + so);
        }
        if (MODE == 1) {
#pragma unroll
            for (int s = 0; s < 2; ++s) {
                const int so = ((2 * s + h) ^ psw) << 4;
                kfa[4 + s] = *(const LAS bf16x8*)(base + pfo + so);
                kfb[4 + s] = *(const LAS bf16x8*)(base + pfo + 2048 + so);
            }
        }
        f32x16 p0, p1;
        if (MODE <= 1) { p0 = negm; p1 = negm; }
        else {
#pragma unroll
            for (int r = 0; r < 16; ++r) { p0[r] = 0.f; p1[r] = 0.f; }
        }
#pragma unroll
        for (int s = 0; s < NQS; ++s) { p0 = MFMA32(kfa[s], qr[s], p0); p1 = MFMA32(kfb[s], qr[s], p1); }
        s16x4 vlo[4], vhi[4];
#pragma unroll
        for (int ks = 0; ks < 4; ++ks) { vlo[ks] = tr16(base + vfo + ks * 1024); vhi[ks] = tr16(base + vfo + ks * 1024 + 512); }
        if (MODE <= 1) {
            float tm = p0[0];
#pragma unroll
            for (int r = 1; r < 16; ++r) tm = fmaxf(tm, p0[r]);
#pragma unroll
            for (int r = 0; r < 16; ++r) tm = fmaxf(tm, p1[r]);
            tm = fmaxf(tm, __shfl_xor(tm, 32));
            if (t == 0 || __any(tm > 6.0f)) {
                const float dl = t == 0 ? tm : fmaxf(tm, 0.f);
                m_run += dl;
#pragma unroll
                for (int r = 0; r < 16; ++r) { p0[r] -= dl; p1[r] -= dl; negm[r] = -m_run; }
                if (t > 0) {
                    const float alpha = __builtin_amdgcn_exp2f(-dl);
                    l_run *= alpha;
                    if (h == 0) scal[lq] = alpha;
                    asm volatile("s_waitcnt lgkmcnt(0)" ::: "memory");
#pragma unroll
                    for (int g = 0; g < 4; ++g) {
                        const f32x4 a4 = *(const LAS f32x4*)(scal + 8 * g + 4 * h);
#pragma unroll
                        for (int i = 0; i < 4; ++i) { o[0][4 * g + i] *= a4[i]; o[1][4 * g + i] *= a4[i]; }
                    }
                }
            }
            float ls = 0.f;
#pragma unroll
            for (int r = 0; r < 16; ++r) { p0[r] = __builtin_amdgcn_exp2f(p0[r]); p1[r] = __builtin_amdgcn_exp2f(p1[r]); ls += p0[r] + p1[r]; }
            l_run += ls;
        } else if (MODE == 2 && (64 * t + 63 < U.qpos0 || 64 * t > U.qpos0 + 255)) {
            const bool fwd = 64 * t + 63 < U.qpos0;
            const float A = fwd ? a_f * __builtin_amdgcn_exp2f((float)(U.qpos0 - 64 * t - 63) * U.lf) : a_b * __builtin_amdgcn_exp2f((float)(64 * t - U.qpos0 - 255) * U.lb);
            const LAS float* tb = ctab + (fwd ? 0 : 64) + 4 * h;
#pragma unroll
            for (int g = 0; g < 4; ++g) {
                const f32x4 c0 = *(const LAS f32x4*)(tb + 8 * g), c1 = *(const LAS f32x4*)(tb + 32 + 8 * g);
#pragma unroll
                for (int i = 0; i < 4; ++i) { p0[4 * g + i] *= c0[i] * A; p1[4 * g + i] *= c1[i] * A; }
            }
        } else if (MODE == 2) {
            float dq = (float)(qpos - 64 * t - 4 * h);
            asm volatile("" : "+v"(dq));
#pragma unroll
            for (int r = 0; r < 16; ++r) {
                const float d0 = dq - (float)((r & 3) + 8 * (r >> 2)), d1 = d0 - 32.f;
                const float w0 = __builtin_amdgcn_exp2f(fabsf(d0) * (d0 > 0.f ? U.lf : U.lb));
                const float w1 = __builtin_amdgcn_exp2f(fabsf(d1) * (d1 > 0.f ? U.lf : U.lb));
                p0[r] *= (d0 == 0.f ? 2.f : w0);
                p1[r] *= (d1 == 0.f ? 2.f : w1);
            }
        } else {
            float mb = (float)(64 * t + 4 * h);
            asm volatile("" : "+v"(mb));
#pragma unroll
            for (int r = 0; r < 16; ++r) {
                const float m0 = mb + (float)((r & 3) + 8 * (r >> 2)), m1 = m0 + 32.f;
                const float e0 = fmaf(m0, st_slope, st_off), e1 = fmaf(m1, st_slope, st_off);
                p0[r] *= __builtin_amdgcn_exp2f(e0);
                p1[r] *= __builtin_amdgcn_exp2f(e1);
            }
        }
        bf16x8 pa[4];
        { u32x4 a;
          a.x = pk2(p0[0], p0[1]); a.y = pk2(p0[2], p0[3]); a.z = pk2(p0[4], p0[5]); a.w = pk2(p0[6], p0[7]); pa[0] = __builtin_bit_cast(bf16x8, a);
          a.x = pk2(p0[8], p0[9]); a.y = pk2(p0[10], p0[11]); a.z = pk2(p0[12], p0[13]); a.w = pk2(p0[14], p0[15]); pa[1] = __builtin_bit_cast(bf16x8, a);
          a.x = pk2(p1[0], p1[1]); a.y = pk2(p1[2], p1[3]); a.z = pk2(p1[4], p1[5]); a.w = pk2(p1[6], p1[7]); pa[2] = __builtin_bit_cast(bf16x8, a);
          a.x = pk2(p1[8], p1[9]); a.y = pk2(p1[10], p1[11]); a.z = pk2(p1[12], p1[13]); a.w = pk2(p1[14], p1[15]); pa[3] = __builtin_bit_cast(bf16x8, a); }
#pragma unroll
        for (int ks = 0; ks < 4; ++ks) {
            const bf16x8 vb = __builtin_shufflevector(vlo[ks], vhi[ks], 0, 1, 2, 3, 4, 5, 6, 7);
            o[0] = MFMA32(pa[ks], vb, o[0]);
        }
#pragma unroll
        for (int ks = 0; ks < 4; ++ks) { vlo[ks] = tr16(base + vfo + 4096 + ks * 1024); vhi[ks] = tr16(base + vfo + 4096 + ks * 1024 + 512); }
#pragma unroll
        for (int ks = 0; ks < 4; ++ks) {
            const bf16x8 vb = __builtin_shufflevector(vlo[ks], vhi[ks], 0, 1, 2, 3, 4, 5, 6, 7);
            o[1] = MFMA32(pa[ks], vb, o[1]);
        }
        st = st == 2 ? 0 : st + 1;
    }
#undef AT_ISSUE
#undef AT_DMA
    int lq2 = lq, h2 = h, lane2 = lane; asm volatile("" : "+v"(lq2), "+v"(h2), "+v"(lane2));
    if (MODE == 2 && U.s0f != nullptr) {
        const float ff = __builtin_amdgcn_exp2f((float)(qpos + 1) * U.lf), fb = __builtin_amdgcn_exp2f((float)(U.L - qpos) * U.lb);
#pragma unroll
        for (int s = 0; s < 4; ++s) {
            const u32x4 qu = __builtin_bit_cast(u32x4, qr[s]);
            u32x4 af, ab;
#pragma unroll
            for (int i = 0; i < 4; ++i) { const float lo = bflo(qu[i]), hi = bfhi(qu[i]); af[i] = pk2(lo * ff, hi * ff); ab[i] = pk2(lo * fb, hi * fb); }
#pragma unroll
            for (int d = 0; d < 2; ++d) {
                const bf16x8 sf = *(const bf16x8*)(U.s0f + (size_t)(32 * d + lq2) * 64 + 16 * s + 8 * h2);
                const bf16x8 sb = *(const bf16x8*)(U.s0b + (size_t)(32 * d + lq2) * 64 + 16 * s + 8 * h2);
                o[d] = MFMA32(__builtin_bit_cast(bf16x8, af), sf, o[d]);
                o[d] = MFMA32(__builtin_bit_cast(bf16x8, ab), sb, o[d]);
            }
        }
    }
    if (MODE == 3) {
        float* dst = U.st_out + (size_t)sdir * 4 * 4096 + (size_t)(32 * (w & 1)) * 64;
        if (w < 4) {
#pragma unroll
        for (int d = 0; d < 2; ++d)
#pragma unroll
            for (int r = 0; r < 16; ++r) dst[(size_t)((r & 3) + 8 * (r >> 2) + 4 * h2) * 64 + 32 * d + lq2] = o[d][r];
        }
        __syncthreads();
        if (F.tid == 0 && U.yflag != nullptr) (void)xb_add(U.yflag, 1u);
        return;
    }
    if (MODE <= 1) {
        l_run += __shfl_xor(l_run, 32);
        if (h2 == 0) scal[lq2] = 1.f / l_run;
    }
    if (U.zflag != nullptr && F.tid == 0) {
        unsigned* bar0 = (unsigned*)(F.ws + WS_CTL) + CW_BAR;
        XB_SPIN(xb_ld(U.zflag) < 4u, bar0);
    }
    __syncthreads();
    LAS float* ost = (LAS float*)lds + w * (32 * AT_OLD);
#pragma unroll
    for (int d = 0; d < 2; ++d)
#pragma unroll
        for (int r = 0; r < 16; ++r) ost[((r & 3) + 8 * (r >> 2) + 4 * h2) * AT_OLD + 32 * d + lq2] = o[d][r];
    asm volatile("s_waitcnt lgkmcnt(0)" ::: "memory");
    __builtin_amdgcn_wave_barrier();
    const bf16_t* zs = (const bf16_t*)(F.ws + WS_ZS);
    bf16_t* yb = (bf16_t*)(F.ws + WS_Y);
#pragma unroll
    for (int it = 0; it < 4; ++it) {
        const int row = it * 8 + (lane2 >> 3), c8 = (lane2 & 7) * 8;
        const f32x4 x0 = *(const LAS f32x4*)(ost + row * AT_OLD + c8), x1 = *(const LAS f32x4*)(ost + row * AT_OLD + c8 + 4);
        float sc;
        if (MODE <= 1) sc = scal[row];
        else {
            float ss = (x0[0] * x0[0] + x0[1] * x0[1]) + (x0[2] * x0[2] + x0[3] * x0[3]) + (x1[0] * x1[0] + x1[1] * x1[1]) + (x1[2] * x1[2] + x1[3] * x1[3]);
            ss += __shfl_xor(ss, 1); ss += __shfl_xor(ss, 2); ss += __shfl_xor(ss, 4);
            sc = rsqrtf(ss * (1.f / 64.f) + EPS);
        }
        const size_t off = (size_t)(U.tok0 + 32 * w + row) * 1024 + U.ycol + c8;
        const u32x4 z = *(const u32x4*)(zs + off);
        u32x4 y;
        y.x = pk2(x0[0] * sc * bflo(z.x), x0[1] * sc * bfhi(z.x));
        y.y = pk2(x0[2] * sc * bflo(z.y), x0[3] * sc * bfhi(z.y));
        y.z = pk2(x1[0] * sc * bflo(z.z), x1[1] * sc * bfhi(z.z));
        y.w = pk2(x1[2] * sc * bflo(z.w), x1[3] * sc * bfhi(z.w));
        ST16_WT(yb + off, y);
    }
    asm volatile("s_waitcnt vmcnt(0)" ::: "memory");
    __syncthreads();
    if (F.tid == 0) (void)xb_add(U.yflag, 1u);
}

__device__ __forceinline__ void dep_wait(const Frame& F, unsigned* c, int n, unsigned target, unsigned* c2 = nullptr, unsigned target2 = 0u) {
    if (F.w == 0) {
        const int ln = lane_id();
        unsigned* ptr = c + 4 * ln; unsigned tgt = target;
        if (c2 != nullptr && ln == n) { ptr = c2; tgt = target2; }
        poll_lanes(ptr, tgt, ln < n + (c2 != nullptr ? 1 : 0), (unsigned*)(F.ws + WS_CTL) + CW_BAR);
    }
}
__device__ __forceinline__ void attn_dispatch(const Frame& F, const Params& p, int u, int l) {
    unsigned char* ws = F.ws;
    AttnUnit U;
    U.nt0 = 0; U.nt1 = 0; U.q = nullptr; U.q_ld = 0; U.k0 = U.k1 = nullptr; U.k_ld0 = U.k_ld1 = 0; U.pe0 = U.pe1 = nullptr; U.v0 = U.v1 = nullptr; U.v_ld0 = U.v_ld1 = 0;
    U.tok0 = 0; U.ycol = 0; U.qpos0 = 0; U.L = 0; U.lf = U.lb = 0.f; U.s0f = U.s0b = nullptr; U.st_out = nullptr; U.mode = 0; U.yflag = nullptr; U.zflag = nullptr;
    const bf16_t* GQ = (const bf16_t*)(ws + WS_GQ); const bf16_t* GK = (const bf16_t*)(ws + WS_GK); const bf16_t* GV = (const bf16_t*)(ws + WS_GV);
    const bf16_t* QM = (const bf16_t*)(ws + WS_QM); const bf16_t* KVM = (const bf16_t*)(ws + WS_KVM); const bf16_t* KVMC = (const bf16_t*)(ws + WS_KVMC);
    const bf16_t* KPEB = (const bf16_t*)(ws + WS_KPEB); const bf16_t* CKPE = (const bf16_t*)(ws + WS_CKPE);
    const bf16_t* CGK = (const bf16_t*)(ws + WS_CGK); const bf16_t* CGV = (const bf16_t*)(ws + WS_CGV);
    const bf16_t* RQ = (const bf16_t*)(ws + WS_RQ); const bf16_t* RK = (const bf16_t*)(ws + WS_RK); const bf16_t* RV = (const bf16_t*)(ws + WS_RV);
    const float* decay = pin(F, I_DECAY) + l * 8;
    if (u < 96 || (u >= 256 && u < 352)) {
        const bool lat = u < 96; const int uu = lat ? u : u - 256;
        const int b = lat ? uu / 24 : uu / 6, hh = lat ? (uu >> 2) % 6 : uu % 6, qb = lat ? (uu & 3) : 0;
        const int seq0 = lat ? 4096 + b * 1024 : b * 256;
        U.mode = 1; U.tok0 = seq0 + qb * 256; U.q = QM + (size_t)U.tok0 * 576 + hh * 96; U.q_ld = 576; U.ycol = 640 + hh * 64;
        U.nt1 = lat ? 16 : 4; U.k1 = KVM + (size_t)seq0 * 768 + hh * 128; U.k_ld1 = 768; U.v1 = U.k1 + 64; U.v_ld1 = 768; U.pe1 = KPEB + (size_t)seq0 * 32;
        U.k0 = U.k1; U.v0 = U.v1; U.pe0 = U.pe1; U.k_ld0 = 768; U.v_ld0 = 768;
        if (lat) { U.nt0 = 8; U.k0 = KVMC + (size_t)(b * 512) * 768 + hh * 128; U.v0 = U.k0 + 64; U.pe0 = CKPE + (size_t)((b * 4 + l) * 512) * 32; }
        U.yflag = (unsigned*)(ws + WS_CTL) + CW_YRDY + (l * 32 + (U.tok0 >> 8)) * 4;
        { unsigned* c = (unsigned*)(ws + WS_CTL);
          dep_wait(F, c + CW_FULL + (l * 32 + (seq0 >> 8)) * 4, lat ? 4 : 1, 23u, lat ? c + CW_KC + (l * 4 + b) * 4 : nullptr, 12u); }
        __syncthreads();
        attn_unit<1>(F, p, U);
    } else if (u < 192 || (u >= 352 && u < 448)) {
        const bool lat = u < 192; const int uu = lat ? u - 96 : u - 352;
        const int b = lat ? uu / 24 : uu / 6, hh = lat ? (uu >> 2) % 6 : uu % 6, qb = lat ? (uu & 3) : 0, kvh = hh / 3;
        const int seq0 = lat ? 4096 + b * 1024 : b * 256;
        U.mode = 0; U.tok0 = seq0 + qb * 256; U.q = GQ + (size_t)U.tok0 * 384 + hh * 64; U.q_ld = 384; U.ycol = 256 + hh * 64;
        U.nt1 = lat ? 16 : 4; U.k1 = GK + (size_t)seq0 * 128 + kvh * 64; U.k_ld1 = 128; U.v1 = GV + (size_t)seq0 * 128 + kvh * 64; U.v_ld1 = 128;
        U.k0 = U.k1; U.v0 = U.v1; U.k_ld0 = 128; U.v_ld0 = 128;
        if (lat) { U.nt0 = 8; U.k0 = CGK + (size_t)((b * 4 + l) * 512) * 128 + kvh * 64; U.v0 = CGV + (size_t)((b * 4 + l) * 512) * 128 + kvh * 64; }
        U.yflag = (unsigned*)(ws + WS_CTL) + CW_YRDY + (l * 32 + (U.tok0 >> 8)) * 4;
        { unsigned* c = (unsigned*)(ws + WS_CTL);
          dep_wait(F, c + CW_RA + (l * 32 + (seq0 >> 8)) * 4, lat ? 4 : 1, 8u);
          U.zflag = c + CW_ZC + (l * 32 + (U.tok0 >> 8)) * 4; }
        __syncthreads();
        attn_unit<0>(F, p, U);
    } else if (u < 256 || (u >= 448 && u < 512)) {
        const bool lat = u < 256; const int uu = lat ? u - 192 : u - 448;
        const int b = lat ? uu / 16 : uu / 4, hh = lat ? (uu >> 2) & 3 : uu & 3, qb = lat ? (uu & 3) : 0;
        const int seq0 = lat ? 4096 + b * 1024 : b * 256;
        U.mode = 2; U.tok0 = seq0 + qb * 256; U.q = RQ + (size_t)U.tok0 * 256 + hh * 64; U.q_ld = 256; U.ycol = hh * 64;
        U.nt1 = lat ? 16 : 4; U.k1 = RK + (size_t)seq0 * 256 + hh * 64; U.k_ld1 = 256; U.v1 = RV + (size_t)seq0 * 256 + hh * 64; U.v_ld1 = 256;
        U.k0 = U.k1; U.v0 = U.v1; U.k_ld0 = 256; U.v_ld0 = 256;
        U.qpos0 = qb * 256; U.L = lat ? 1024 : 256;
        U.lf = -log1pf(__expf(-decay[hh])) * LOG2E; U.lb = -log1pf(__expf(-decay[4 + hh])) * LOG2E;
        if (lat) { const bf16_t* S0T = (const bf16_t*)(ws + WS_S0T); U.s0f = S0T + (size_t)(((b * 4 + l) * 2 + 0) * 4 + hh) * 4096; U.s0b = S0T + (size_t)(((b * 4 + l) * 2 + 1) * 4 + hh) * 4096; }
        U.yflag = (unsigned*)(ws + WS_CTL) + CW_YRDY + (l * 32 + (U.tok0 >> 8)) * 4;
        { unsigned* c = (unsigned*)(ws + WS_CTL);
          dep_wait(F, c + CW_RA + (l * 32 + (seq0 >> 8)) * 4, lat ? 4 : 1, 8u);
          U.zflag = c + CW_ZC + (l * 32 + (U.tok0 >> 8)) * 4; }
        __syncthreads();
        attn_unit<2>(F, p, U);
    } else {
        const int uu = u - 512, b = uu >> 2, hh = uu & 3, seq0 = b * 256;
        U.mode = 3; U.nt1 = 4; U.k1 = RK + (size_t)seq0 * 256 + hh * 64; U.k_ld1 = 256; U.v1 = RV + (size_t)seq0 * 256 + hh * 64; U.v_ld1 = 256;
        U.k0 = U.k1; U.v0 = U.v1; U.k_ld0 = 256; U.v_ld0 = 256;
        U.lf = -log1pf(__expf(-decay[hh])) * LOG2E; U.lb = -log1pf(__expf(-decay[4 + hh])) * LOG2E;
        U.st_out = p.out + O_STATE + (size_t)(((b * 4 + l) * 2 + 0) * 4 + hh) * 4096;
        dep_wait(F, (unsigned*)(ws + WS_CTL) + CW_RA + (l * 32 + b) * 4, 1, 8u);
        U.yflag = (unsigned*)(ws + WS_CTL) + CW_SD + (l * 16 + b) * 4;
        __syncthreads();
        attn_unit<3>(F, p, U);
    }
}
constexpr int N_ATTN_UNITS = 576;
struct TItem { const float* src; bf16_t* dst; int nsrc, K; int valid; };
constexpr int P0_TWIN = 4 * 16 * 92, P0_TWOUT = 4 * 16 * 32, P0_TWUQ = 4 * 4 * 20, P0_TWUKV = 4 * 2 * 24, P0_TR = P0_TWIN + P0_TWOUT + P0_TWUQ + P0_TWUKV;
__device__ __forceinline__ TItem p0_titem(const Frame& F, unsigned char* ws, int it) {
    TItem t; t.valid = it < P0_TR; t.src = nullptr; t.dst = nullptr; t.nsrc = 0; t.K = 0;
    if (!t.valid) return t;
    if (it < P0_TWIN) {
        const int l = it / (16 * 92), r = it % (16 * 92), kb = r / 92, nb = r % 92, n0 = nb * 32;
        const int src = n0 < 1792 ? n0 : (n0 < 2816 ? n0 + 32 : (n0 < 2848 ? n0 - 2816 + 1792 : -1));
        t.nsrc = 2848; t.K = 1024;
        if (src >= 0) t.src = pin(F, I_WIN) + (size_t)l * 1024 * 2848 + (size_t)(kb * 64) * 2848 + src;
        t.dst = (bf16_t*)(ws + WS_WIN) + ((size_t)l * 2944 + n0) * 1024 + kb * 64;
        return t;
    }
    it -= P0_TWIN;
    if (it < P0_TWOUT) {
        const int l = it / 512, r = it % 512, kb = r >> 5, nb = r & 31;
        t.nsrc = 1024; t.K = 1024; t.src = pin(F, I_WOUT) + (size_t)l * 1024 * 1024 + (size_t)(kb * 64) * 1024 + nb * 32;
        t.dst = (bf16_t*)(ws + WS_WOUT) + ((size_t)l * 1024 + nb * 32) * 1024 + kb * 64;
        return t;
    }
    it -= P0_TWOUT;
    if (it < P0_TWUQ) {
        const int l = it / 80, r = it % 80, kb = r / 20, nb = r % 20;
        t.nsrc = 576; t.K = 256; if (nb < 18) t.src = pin(F, I_WUQ) + (size_t)l * 256 * 576 + (size_t)(kb * 64) * 576 + nb * 32;
        t.dst = (bf16_t*)(ws + WS_WUQ) + ((size_t)l * 640 + nb * 32) * 256 + kb * 64;
        return t;
    }
    it -= P0_TWUQ;
    { const int l = it / 48, r = it % 48, kb = r / 24, nb = r % 24;
      t.nsrc = 768; t.K = 128; t.src = pin(F, I_WUKV) + (size_t)l * 128 * 768 + (size_t)(kb * 64) * 768 + nb * 32;
      t.dst = (bf16_t*)(ws + WS_WUKV) + ((size_t)l * 768 + nb * 32) * 128 + kb * 64; }
    return t;
}
__device__ __forceinline__ void p0_tload(const TItem& t, float (&r)[32], int lane) {
    if (t.valid && t.src) {
        const float* wp = t.src + (size_t)(lane >> 5) * t.nsrc + (lane & 31);
#pragma unroll
        for (int i = 0; i < 32; ++i) r[i] = wp[(size_t)(2 * i) * t.nsrc];
    } else {
#pragma unroll
        for (int i = 0; i < 32; ++i) r[i] = 0.f;
    }
}
__device__ __forceinline__ void p0_tstore(const TItem& t, const float (&r)[32], LAS float* scr, int lane) {
    if (!t.valid) return;
#pragma unroll
    for (int i = 0; i < 32; ++i) scr[(2 * i + (lane >> 5)) * 33 + (lane & 31)] = r[i];
    asm volatile("s_waitcnt lgkmcnt(0)" ::: "memory");
    __builtin_amdgcn_wave_barrier();
    const int c = lane & 7;
#pragma unroll
    for (int j = 0; j < 4; ++j) {
        const int n = (lane >> 3) + 8 * j; const LAS float* s = scr + (8 * c) * 33 + n;
        u32x4 o; o.x = pk2(s[0 * 33], s[1 * 33]); o.y = pk2(s[2 * 33], s[3 * 33]); o.z = pk2(s[4 * 33], s[5 * 33]); o.w = pk2(s[6 * 33], s[7 * 33]);
        ST16_WT(t.dst + (size_t)n * t.K + 8 * c, o);
    }
    asm volatile("s_waitcnt lgkmcnt(0)" ::: "memory");
    __builtin_amdgcn_wave_barrier();
}
__device__ __forceinline__ void cast8(const float* src, bf16_t* dst, size_t e) {
    const f32x4 a = *(const f32x4*)(src + e), b = *(const f32x4*)(src + e + 4);
    u32x4 o; o.x = pk2(a[0], a[1]); o.y = pk2(a[2], a[3]); o.z = pk2(b[0], b[1]); o.w = pk2(b[2], b[3]);
    ST16_WT(dst + e, o);
}
constexpr int P0_MODS = 1536, P0_CAST_G = 512, P0_CAST_KPE = 128, P0_S0T = 512;
constexpr int P0_TOTAL = P0_MODS + 3 * P0_CAST_G + P0_CAST_KPE + P0_S0T;
__device__ __forceinline__ void phase0(const Frame& F, const Params& p, bool dup = false) {
    unsigned char* ws = F.ws + (dup ? 162 * MiB : 0); const int lane = F.lane;
    LAS float* scr = (LAS float*)F.lds + F.w * (64 * 33);
    const int gw = blockIdx.x * NWAVE + F.w, ngw = gridDim.x * NWAVE;
#ifndef MK_DUP0
#define MK_DUP0_ 0
#else
#define MK_DUP0_ MK_DUP0
#endif
    if (!(dup && MK_DUP0_ == 2))
    for (int it = gw; it < P0_TR; it += 2 * ngw) {
        const TItem t0 = p0_titem(F, ws, it), t1 = p0_titem(F, ws, it + ngw);
        float r0[32], r1[32];
        p0_tload(t0, r0, lane); p0_tload(t1, r1, lane);
        p0_tstore(t0, r0, scr, lane); p0_tstore(t1, r1, scr, lane);
    }
    if (!(dup && MK_DUP0_ == 1))
    for (int it0 = (gw + ngw - 256) % ngw; it0 < P0_TOTAL; it0 += ngw) {
        int it = it0;
        if (it < P0_MODS) {
            const int l = it / 384, cg = (it % 384) >> 5, ks = it & 31;
            const int j = cg * 256 + lane * 4;
            const float* wp = pin(F, I_WADA) + ((size_t)l * 1024 + ks * 32) * 3072 + j;
            const float* c = pin(F, I_C); const float* cc = pin(F, I_CCTX);
            float sv[3];
#pragma unroll
            for (int q = 0; q < 3; ++q) {
                const int idx = q * 64 + lane, n = idx >> 5, k = idx & 31;
                float x = 0.f;
                if (idx < 160) x = (n == 0) ? cc[ks * 32 + k] : c[(n - 1) * 1024 + ks * 32 + k];
                sv[q] = silu_f(x);
            }
            f32x4 acc[5];
#pragma unroll
            for (int n = 0; n < 5; ++n) acc[n] = (f32x4){0.f, 0.f, 0.f, 0.f};
#pragma unroll 1
            for (int k0 = 0; k0 < 32; k0 += 16) {
                f32x4 wv[16];
#pragma unroll
                for (int k = 0; k < 16; ++k) wv[k] = *(const f32x4*)(wp + (size_t)(k0 + k) * 3072);
                __builtin_amdgcn_sched_barrier(0);
#pragma unroll
                for (int k = 0; k < 16; ++k)
#pragma unroll
                    for (int n = 0; n < 5; ++n) {
                        const float s = __int_as_float(__builtin_amdgcn_readlane(__float_as_int(sv[n >> 1]), 32 * (n & 1) + k0 + k));
                        acc[n] += wv[k] * s;
                    }
            }
            LAS f32x4* red = (LAS f32x4*)(F.lds + 69632);
#pragma unroll
            for (int n = 0; n < 5; ++n) red[(F.w * 5 + n) * 64 + lane] = acc[n];
            __syncthreads();
            if (F.tid < 320) {
                const int n = F.tid >> 6;
                f32x4 s = red[n * 64 + lane];
#pragma unroll
                for (int ww = 1; ww < 8; ++ww) s += red[(ww * 5 + n) * 64 + lane];
                if ((ks >> 3) == 0) s += *(const f32x4*)(pin(F, I_BADA) + l * 3072 + j);
                float* mods = (float*)(ws + WS_MODS) + (size_t)(l * 5 + n) * 3072 + j;
#pragma unroll
                for (int e = 0; e < 4; ++e) atomicAdd(mods + e, s[e]);
            }
            __syncthreads();
            continue;
        }
        it -= P0_MODS;
        if (it < 3 * P0_CAST_G) {
            const int which = it / P0_CAST_G, r = it % P0_CAST_G;
            const float* src = which == 0 ? pin(F, I_CGK) : (which == 1 ? pin(F, I_CGV) : pin(F, I_CCKV));
            bf16_t* dst = (bf16_t*)(ws + (which == 0 ? WS_CGK : (which == 1 ? WS_CGV : WS_CCKV)));
#pragma unroll
            for (int q = 0; q < 4; ++q) cast8(src, dst, (size_t)r * 2048 + q * 512 + lane * 8);
            continue;
        }
        it -= 3 * P0_CAST_G;
        if (it < P0_CAST_KPE) {
#pragma unroll
            for (int q = 0; q < 4; ++q) cast8(pin(F, I_CKPE), (bf16_t*)(ws + WS_CKPE), (size_t)it * 2048 + q * 512 + lane * 8);
            continue; }
        it -= P0_CAST_KPE;
        {
            const int mat = it >> 2, qd = it & 3, dv = qd * 16 + (lane >> 2), dk0 = (lane & 3) * 16;
            const float* s = pin(F, I_STATE) + (size_t)mat * 4096 + dv;
            float x[16];
#pragma unroll
            for (int i = 0; i < 16; ++i) x[i] = s[(dk0 + i) * 64];
            u32x4 o0, o1;
            o0.x = pk2(x[0], x[1]); o0.y = pk2(x[2], x[3]); o0.z = pk2(x[4], x[5]); o0.w = pk2(x[6], x[7]);
            o1.x = pk2(x[8], x[9]); o1.y = pk2(x[10], x[11]); o1.z = pk2(x[12], x[13]); o1.w = pk2(x[14], x[15]);
            bf16_t* d = (bf16_t*)(ws + WS_S0T) + (size_t)mat * 4096 + dv * 64 + dk0;
            ST16_WT(d, o0); ST16_WT(d + 8, o1);
        }
    }
}
constexpr int P1_GS = 80, P1_BIAS = 4 * 368, P1_X = 8192, P1_TOTAL = P1_GS + P1_BIAS + P1_X;
__device__ __forceinline__ void xg_row(const Frame& F, const float* xrow, const float* g, const float* mods_c, bf16_t* xg_row_out, float* ssq_row, bool write_xg) {
    const int lane = F.lane;
    float ss = 0.f;
#pragma unroll
    for (int j = 0; j < 2; ++j) {
        const int k = j * 512 + lane * 8;
        const f32x4 x0 = *(const f32x4*)(xrow + k), x1 = *(const f32x4*)(xrow + k + 4);
        ss += ((x0[0] * x0[0] + x0[1] * x0[1]) + (x0[2] * x0[2] + x0[3] * x0[3])) + ((x1[0] * x1[0] + x1[1] * x1[1]) + (x1[2] * x1[2] + x1[3] * x1[3]));
        if (write_xg) {
            const f32x4 g0 = *(const f32x4*)(g + k), g1 = *(const f32x4*)(g + k + 4), s0 = *(const f32x4*)(mods_c + 1024 + k), s1 = *(const f32x4*)(mods_c + 1024 + k + 4);
            u32x4 o; o.x = pk2(x0[0] * g0[0] * (1.f + s0[0]), x0[1] * g0[1] * (1.f + s0[1])); o.y = pk2(x0[2] * g0[2] * (1.f + s0[2]), x0[3] * g0[3] * (1.f + s0[3]));
            o.z = pk2(x1[0] * g1[0] * (1.f + s1[0]), x1[1] * g1[1] * (1.f + s1[1])); o.w = pk2(x1[2] * g1[2] * (1.f + s1[2]), x1[3] * g1[3] * (1.f + s1[3]));
            ST16_WT(xg_row_out + k, o);
        }
    }
    ss = wsum(ss);
    if (lane < 16) ssq_row[lane] = lane == 0 ? ss : 0.f;
}
__device__ __forceinline__ void phase1(const Frame& F, const Params& p) {
    unsigned char* ws = F.ws; const int lane = F.lane;
    unsigned* ctl = (unsigned*)(ws + WS_CTL);
    const int gw = blockIdx.x * NWAVE + F.w, ngw = gridDim.x * NWAVE;
    const float* mods = (const float*)(ws + WS_MODS);
    for (int it0 = gw; it0 < P1_GS + P1_BIAS; it0 += ngw) {
        int it = it0;
        if (it < P1_GS) {
            const int e = it * 256 + lane * 4, lc = e >> 10, k = e & 1023, l = lc / 5;
            const f32x4 g = *(const f32x4*)(pin(F, I_NORMG) + l * 1024 + k), sc = *(const f32x4*)(mods + (size_t)lc * 3072 + 1024 + k);
            { const f32x4 o = g * (sc + 1.f); ST16_WT((float*)(ws + WS_GS) + e, o); }
            continue;
        }
        it -= P1_GS;
        {
            const int l = it / 368, n0 = (it % 368) * 8;
            f32x4 sh[5][4];
#pragma unroll
            for (int c = 0; c < 5; ++c) {
                const float* shp = mods + (size_t)(l * 5 + c) * 3072 + lane * 16;
#pragma unroll
                for (int i = 0; i < 4; ++i) sh[c][i] = *(const f32x4*)(shp + 4 * i);
            }
            const bf16_t* wr0 = (const bf16_t*)(ws + WS_WIN) + ((size_t)l * 2944 + n0) * 1024 + lane * 16;
            u32x4 w0[8], w1[8];
#pragma unroll
            for (int r = 0; r < 8; ++r) { w0[r] = *(const u32x4*)(wr0 + (size_t)r * 1024); w1[r] = *(const u32x4*)(wr0 + (size_t)r * 1024 + 8); }
#pragma unroll
            for (int r = 0; r < 8; ++r) {
                float wv[16];
#pragma unroll
                for (int i = 0; i < 4; ++i) { wv[2 * i] = bflo(w0[r][i]); wv[2 * i + 1] = bfhi(w0[r][i]); wv[8 + 2 * i] = bflo(w1[r][i]); wv[8 + 2 * i + 1] = bfhi(w1[r][i]); }
#pragma unroll
                for (int c = 0; c < 5; ++c) {
                    float d = 0.f;
#pragma unroll
                    for (int i = 0; i < 4; ++i) { const f32x4 s4 = sh[c][i]; d += (s4[0] * wv[4 * i] + s4[1] * wv[4 * i + 1]) + (s4[2] * wv[4 * i + 2] + s4[3] * wv[4 * i + 3]); }
                    d = wsum(d);
                    if (lane == 0) __hip_atomic_store((__attribute__((address_space(1))) float*)((float*)(ws + WS_BIAS) + (size_t)(l * 5 + c) * 2944 + n0 + r), d, __ATOMIC_RELAXED, __HIP_MEMORY_SCOPE_AGENT);
                }
            }
            if (l == 0) {
                asm volatile("s_waitcnt vmcnt(0)" ::: "memory");
                if (lane == 0) (void)xb_add(ctl + CW_P1B0, 1u);
            }
        }
    }
    for (int vb = blockIdx.x; vb < 256; vb += gridDim.x) {
        const int tm = vb & 31, part = vb >> 5;
        const bool lat = tm >= 16;
        const int cond = lat ? 1 + ((tm - 16) >> 2) : 0;
        const float* g = pin(F, I_NORMG); const float* sc = mods + (size_t)cond * 3072 + 1024;
#pragma unroll 1
        for (int i = 0; i < 4; i += 2) {
            const int tok = tm * 256 + part * 32 + F.w * 4 + i;
            const float* xa = lat ? pin(F, I_XS) + (size_t)(tok - 4096) * 1024 : pin(F, I_XP) + (size_t)tok * 1024;
            const float* xb = xa + 1024;
            bf16_t* oa = (bf16_t*)(ws + WS_XG) + (size_t)tok * 1024;
            float ssa = 0.f, ssb = 0.f;
#pragma unroll
            for (int j = 0; j < 2; ++j) {
                const int k = j * 512 + lane * 8;
                const f32x4 a0 = *(const f32x4*)(xa + k), a1 = *(const f32x4*)(xa + k + 4), b0 = *(const f32x4*)(xb + k), b1 = *(const f32x4*)(xb + k + 4);
                const f32x4 g0 = *(const f32x4*)(g + k), g1 = *(const f32x4*)(g + k + 4), s0 = *(const f32x4*)(sc + k), s1 = *(const f32x4*)(sc + k + 4);
                const f32x4 m0 = g0 * (s0 + 1.f), m1 = g1 * (s1 + 1.f);
                ssa += ((a0[0] * a0[0] + a0[1] * a0[1]) + (a0[2] * a0[2] + a0[3] * a0[3])) + ((a1[0] * a1[0] + a1[1] * a1[1]) + (a1[2] * a1[2] + a1[3] * a1[3]));
                ssb += ((b0[0] * b0[0] + b0[1] * b0[1]) + (b0[2] * b0[2] + b0[3] * b0[3])) + ((b1[0] * b1[0] + b1[1] * b1[1]) + (b1[2] * b1[2] + b1[3] * b1[3]));
                u32x4 o; o.x = pk2(a0[0] * m0[0], a0[1] * m0[1]); o.y = pk2(a0[2] * m0[2], a0[3] * m0[3]); o.z = pk2(a1[0] * m1[0], a1[1] * m1[1]); o.w = pk2(a1[2] * m1[2], a1[3] * m1[3]);
                ST16_WT(oa + k, o);
                o.x = pk2(b0[0] * m0[0], b0[1] * m0[1]); o.y = pk2(b0[2] * m0[2], b0[3] * m0[3]); o.z = pk2(b1[0] * m1[0], b1[1] * m1[1]); o.w = pk2(b1[2] * m1[2], b1[3] * m1[3]);
                ST16_WT(oa + 1024 + k, o);
            }
            ssa = wsum(ssa); ssb = wsum(ssb);
            if (lane < 32) {
                const float v = (lane & 15) == 0 ? (lane < 16 ? ssa : ssb) : 0.f;
                __hip_atomic_store((__attribute__((address_space(1))) float*)((float*)(ws + WS_SSQ) + (size_t)(tok + (lane >> 4)) * 16 + (lane & 15)), v, __ATOMIC_RELAXED, __HIP_MEMORY_SCOPE_AGENT);
            }
        }
        asm volatile("s_waitcnt vmcnt(0)" ::: "memory");
        __syncthreads();
        if (is_t0(F)) (void)xb_add(ctl + CW_P1X + tm * 4, 1u);
    }
    asm volatile("s_waitcnt vmcnt(0)" ::: "memory");
    __syncthreads();
    if (is_t0(F)) (void)xb_add(ctl + CW_P1DONE, 1u);
}
#ifndef MK_TIMING
#define MK_TIMING -1
#endif
constexpr int CW_TIME = 2048;
__device__ __forceinline__ void phase_final(const Frame& F, const Params& p) {
    const int lane = F.lane;
    float tf = 1.f;
    if (MK_TIMING >= 0) tf = __uint_as_float(__hip_atomic_load((unsigned*)(F.ws + WS_CTL) + CW_TIME, __ATOMIC_RELAXED, __HIP_MEMORY_SCOPE_AGENT));
    unsigned* ctl = (unsigned*)(F.ws + WS_CTL);
    for (int vb = blockIdx.x; vb < 256; vb += gridDim.x) {
        const int tm = vb & 31, part = vb >> 5;
        if (F.tid == 0) {
            XB_SPIN(xb_ld(ctl + CW_XRDY + tm * 4) < 8u, ctl + CW_BAR);
            __builtin_amdgcn_fence(__ATOMIC_ACQUIRE, "agent");
            asm volatile("s_waitcnt vmcnt(0)" ::: "memory");
        }
        __syncthreads();
#pragma unroll 1
        for (int i = 0; i < 4; ++i) {
            const int tok = tm * 256 + part * 32 + F.w * 4 + i;
            float ss = 0.f;
            if (lane < 16) ss = ((const float*)(F.ws + WS_SSQ))[(size_t)tok * 16 + lane];
            ss = wsum(ss);
            const float rstd = rsqrtf(ss * (1.f / 1024.f) + EPS);
            const bf16_t* xr = (const bf16_t*)(F.ws + WS_XB) + (size_t)tok * 1024; float* orow = p.out + (size_t)tok * 1024;
#pragma unroll
            for (int j = 0; j < 4; ++j) {
                const int k = j * 256 + lane * 4;
                const u32x2 xq = *(const u32x2*)(xr + k);
                const f32x4 x = {bflo(xq.x), bfhi(xq.x), bflo(xq.y), bfhi(xq.y)}, fn = *(const f32x4*)(pin(F, I_FNORM) + k);
                { const f32x4 o = x * fn * (rstd * tf); ST16_WT(orow + k, o); }
            }
        }
    }
}

__device__ __forceinline__ GemmOp a2_op(const Frame& F, int l, int j) {
    GemmOp g;
    if (j < 160) { const int tn = j >> 5, tm = j & 31; g.W = (const bf16_t*)(F.ws + WS_WUQ) + ((size_t)l * 640 + tn * 128) * 256; g.X = (const bf16_t*)(F.ws + WS_CQG) + (size_t)tm * 256 * 256; g.ldw = 256; g.ldx = 256; g.K = 256; }
    else if (j < 352) { const int jj = j - 160, tn = jj >> 5, tm = jj & 31; g.W = (const bf16_t*)(F.ws + WS_WUKV) + ((size_t)l * 768 + tn * 128) * 128; g.X = (const bf16_t*)(F.ws + WS_CKVN) + (size_t)tm * 256 * 128; g.ldw = 128; g.ldx = 128; g.K = 128; }
    else { const int jj = j - 352, tn = jj >> 3, tc = jj & 7, b = tc >> 1, jt = tc & 1; g.W = (const bf16_t*)(F.ws + WS_WUKV) + ((size_t)l * 768 + tn * 128) * 128;
           g.X = (const bf16_t*)(F.ws + WS_CCKV) + ((size_t)(b * 4 + l) * 512 + jt * 256) * 128; g.ldw = 128; g.ldx = 128; g.K = 128; }
    return g;
}
__device__ __forceinline__ int a2_item(int vb, int i) {
    const int c = (vb >> 5) - 4, tmw = vb & 31;
    if (i == 3) return 352 + 32 + tmw;
    if (c == 0) return i * 32 + tmw;
    if (c == 1) return i < 2 ? (3 + i) * 32 + tmw : 160 + tmw;
    if (c == 2) return 160 + (1 + i) * 32 + tmw;
    return i < 2 ? 160 + (4 + i) * 32 + tmw : 352 + tmw;
}
#ifndef MK_EN
#define MK_EN 0xff
#endif
#define EN(x) ((MK_EN >> (x)) & 1)
constexpr int PH_TOTAL = 19;
__global__ void __launch_bounds__(512, 2) mega(Params p) {
    extern __shared__ __attribute__((aligned(16))) unsigned char lds_raw[];
    Frame F;
    F.lds = (LAS unsigned char*)lds_raw;
    F.tid = threadIdx.x; F.lane = F.tid & 63; F.w = __builtin_amdgcn_readfirstlane(F.tid >> 6); F.h = F.lane >> 5; F.lq = F.lane & 31;
    F.ws = p.ws;
    F.karg = (karg_t)__builtin_amdgcn_kernarg_segment_ptr();
    volatile LAS unsigned* MISC = (volatile LAS unsigned*)(F.lds + LDS_MISC);
    if (F.tid < 64) MISC[F.tid] = 0u;
    __syncthreads();
    unsigned* ctl = (unsigned*)(p.ws + WS_CTL);
    XcdBarrier bar; bar.bar = ctl + CW_BAR; bar.x = 0; bar.st = nullptr;
    const bool multi = p.ph_hi - p.ph_lo > 1;
    if (multi) bar = xcd_barrier_post(ctl + CW_BAR, MISC + 8);
    bar.w = F.w;
    const int G = gridDim.x;
    const Frame F0 = F;
    for (int ph = p.ph_lo; ph < p.ph_hi; ++ph) {
        if (ph >= 2 && ph < 18 && ((ph - 2) & 3) == 1) continue;
        Frame F = F0;
        F.lane = (int)__builtin_amdgcn_mbcnt_hi(~0u, __builtin_amdgcn_mbcnt_lo(~0u, 0u));
        asm volatile("" : "+v"(F.lane));
        F.tid = (F.w << 6) | F.lane; F.h = F.lane >> 5; F.lq = F.lane & 31;
        asm volatile("" : "+s"(F.w), "+s"(F.ws), "+s"(F.karg));
        if (MK_TIMING >= 0 && blockIdx.x == 0 && F.tid == 0) {
            const unsigned long long now = __builtin_amdgcn_s_memrealtime();
            const unsigned long long prev = ((unsigned long long)MISC[17] << 32) | MISC[16];
            if (ph > p.ph_lo) { const int q = ph - 1; const int grp = q < 2 ? q : 2 + ((q - 2) & 3); if (grp == MK_TIMING) MISC[18] += (unsigned)(now - prev); }
            MISC[16] = (unsigned)now; MISC[17] = (unsigned)(now >> 32);
        }
#ifndef MK_REPEAT
#define MK_REPEAT -1
#endif
        int nrep = 1;
        if (MK_REPEAT >= 1) { const int grp = ph < 2 ? ph : (ph == 18 ? 6 : 2 + ((ph - 2) & 3)); if (grp == MK_REPEAT) nrep = (grp == 5) ? (ph == 5 ? 5 : 1) : 2; }
        for (int rep = 0; rep < nrep; ++rep) {
        if (rep > 0) xcd_barrier(bar);
        Frame F = F0;
        F.lane = (int)__builtin_amdgcn_mbcnt_hi(~0u, __builtin_amdgcn_mbcnt_lo(~0u, 0u));
        asm volatile("" : "+v"(F.lane));
        F.tid = (F.w << 6) | F.lane; F.h = F.lane >> 5; F.lq = F.lane & 31;
        asm volatile("" : "+s"(F.w), "+s"(F.ws), "+s"(F.karg));
        if (EN(0) && ph == 0) {
#if defined(MK_DUP0)
            for (int d = 0; d < 2; ++d) { int dd = d; asm volatile("" : "+s"(dd)); if (dd) xcd_barrier(bar); phase0(F, p, dd != 0); }
#else
            phase0(F, p);
#endif
        }
        else if (EN(1) && ph == 1) phase1(F, p);
        else if (EN(2) && ph == 18) phase_final(F, p);
        else {
            const int l = (ph - 2) >> 2, sub = (ph - 2) & 3;
            int bid = blockIdx.x; asm volatile("" : "+s"(bid));
            if (EN(3) && sub == 0) {
                const bf16_t* Wt = (const bf16_t*)(F.ws + WS_WIN) + (size_t)l * 2944 * 1024;
                const bf16_t* X = (const bf16_t*)(F.ws + WS_XG);
                unsigned* flags = ctl + CW_FLAG + l * 512;
                bool first = true;
                int waited_tm = -1;
                for (int j = bid; j < 12 * 32; j += G) {
                    const int tn2 = j >> 5, tm = j & 31;
                    const int jn = j + G; const bool hn = jn < 12 * 32 && (jn & 31) == tm;
                    if (l == 0 && tm != waited_tm) {
                        waited_tm = tm;
                        if (F.tid == 0) {
                            XB_SPIN(xb_ld(ctl + CW_P1X + tm * 4) < 8u, ctl + CW_BAR);
                            XB_SPIN(xb_ld(ctl + CW_P1B0) < 368u, ctl + CW_BAR);
                            __builtin_amdgcn_fence(__ATOMIC_ACQUIRE, "agent");
                            asm volatile("s_waitcnt vmcnt(0)" ::: "memory");
                        }
                        __syncthreads();
                        first = true;
                    }
                    if (l > 0 && tm != waited_tm) {
                        waited_tm = tm;
                        if (F.w == 0) {
                            const int ln = lane_id();
                            unsigned* ptr = ctl + CW_P1DONE; unsigned tgt = (unsigned)G;
                            if (ln == 1) { ptr = ctl + CW_XGR + ((l - 1) * 32 + tm) * 4; tgt = 8u; }
                            if (ln >= 2) {
                                if (tm >= 16) { ptr = ctl + CW_YRDY + ((l - 1) * 32 + (tm & ~3) + ((ln - 2) & 3)) * 4; tgt = 16u; }
                                else { ptr = ctl + CW_SD + ((l - 1) * 16 + tm) * 4; tgt = 4u; }
                            }
                            poll_lanes(ptr, tgt, ln < (tm >= 16 ? 6 : 3), ctl + CW_BAR);
                            __builtin_amdgcn_fence(__ATOMIC_ACQUIRE, "agent");
                            asm volatile("s_waitcnt vmcnt(0)" ::: "memory");
                        }
                        __syncthreads();
                        first = true;
                    }
                    const int tn = 2 * tn2 + ((F.w & 3) >> 1), wn = F.w & 1;
                    if (tn2 == 11) {
                        GemmAcc2 accn;
                        Gemm1Pre P1;
                        const bool mine = (F.w & 3) == 0;
                        if (mine) gemm1_pre(F, p, 22, 0, tm, l, P1); else { P1.rstd[0] = P1.rstd[1] = 0.f; P1.bias = 0.f; P1.gain = 1.f; }
                        gemm_core256n(F, Wt + (size_t)tn2 * 256 * 1024, X + (size_t)tm * 256 * 1024, accn, first); first = true;
                        if (mine) epi_kpe(F, p, accn, tm, l, P1);
                    } else {
                    GemmAcc8 acc;
                    Gemm1Pre P1;
                    gemm1_pre(F, p, tn, wn, tm, l, P1);
                    gemm_core256(F, Wt + (size_t)tn2 * 256 * 1024, X + (size_t)tm * 256 * 1024, acc, first, hn, Wt + (size_t)(jn >> 5) * 256 * 1024, X + (size_t)(jn & 31) * 256 * 1024); first = false;
                    epi_gemm1(F, p, acc, tn, wn, tm, l, P1, tn2 == 6);
                    }
                    {
                        asm volatile("s_waitcnt vmcnt(0)" ::: "memory");
                        __syncthreads();
                        if (F.tid == 0) {
                            if (tn2 == 5 || tn2 == 6) (void)xb_add(flags + tm * 16, 1u);
                            if (tn2 < 8) (void)xb_add(ctl + CW_RA + (l * 32 + tm) * 4, 1u);
                            if (tn2 >= 7 && tn2 < 11) (void)xb_add(ctl + CW_ZC + (l * 32 + tm) * 4, 1u);
                            (void)xb_add(ctl + CW_FULL + (l * 32 + tm) * 4, 1u);
                        }
                    }
                }
                for (int vb = bid; vb < 256; vb += G) {
                    if (vb < 128) continue;
                    const int c = (vb >> 5) - 4, tmw = vb & 31;
                    const int nit = (c == 2 && tmw < 16) ? 4 : 3;
                    if (F.tid == 0) {
                        if (l > 0 && tmw != waited_tm) {
                            if (tmw >= 16) { unsigned* y = ctl + CW_YRDY + ((l - 1) * 32 + (tmw & ~3)) * 4; for (int i = 0; i < 4; ++i) { XB_SPIN(xb_ld(y + 4 * i) < 16u, ctl + CW_BAR); } }
                            else { XB_SPIN(xb_ld(ctl + CW_YRDY + ((l - 1) * 32 + tmw) * 4) < 16u, ctl + CW_BAR); XB_SPIN(xb_ld(ctl + CW_SD + ((l - 1) * 16 + tmw) * 4) < 4u, ctl + CW_BAR); }
                        }
                        unsigned* f = flags + tmw * 16;
                        XB_SPIN(xb_ld(f) < 2u, ctl + CW_BAR);
                        __builtin_amdgcn_fence(__ATOMIC_ACQUIRE, "agent");
                        asm volatile("s_waitcnt vmcnt(0)" ::: "memory");
                    }
                    __syncthreads();
                    for (int i = 0; i < nit; ++i) {
                        const bool hn = i + 1 < nit;
                        const int j = a2_item(vb, i), jn = a2_item(vb, hn ? i + 1 : i);
                        const GemmOp g = a2_op(F, l, j); const GemmOp gn = a2_op(F, l, jn);
                        GemmAcc acc;
                        float rstdq = 0.f;
                        if (j < 160) qm_pre(F, tmw, rstdq);
                        gemm_core(F, g, acc, i == 0, hn, gn);
                        if (j < 160) epi_qm(F, acc, j >> 5, tmw, rstdq);
                        else if (j < 352) { const int jj = j - 160; epi_plain(F, acc, (bf16_t*)(F.ws + WS_KVM), 768, tmw * 256, (jj >> 5) * 128); }
                        else {
                            const int jj = j - 352, tc = jj & 7;
                            if (l > 0) {
                                if (F.w == 0) { const int ln = lane_id(); poll_lanes(ctl + CW_YRDY + ((l - 1) * 32 + 16 + 4 * (tc >> 1) + (ln & 3)) * 4, 16u, ln < 4, ctl + CW_BAR); }
                                __syncthreads();
                            }
                            epi_plain(F, acc, (bf16_t*)(F.ws + WS_KVMC), 768, (tc >> 1) * 512 + (tc & 1) * 256, (jj >> 3) * 128);
                        }
                        asm volatile("s_waitcnt vmcnt(0)" ::: "memory");
                        __syncthreads();
                        if (F.tid == 0) {
                            if (j < 352) (void)xb_add(ctl + CW_FULL + (l * 32 + tmw) * 4, 1u);
                            else (void)xb_add(ctl + CW_KC + (l * 4 + (((j - 352) & 7) >> 1)) * 4, 1u);
                        }
                    }
                }
            } else if (EN(5) && sub == 2) {
                for (;;) {
                    __syncthreads();
                    if (F.tid == 0) MISC[0] = atomicAdd(ctl + CW_QUEUE + 64 * l + 32 * rep, 1u);
                    __syncthreads();
                    const int uq = __builtin_amdgcn_readfirstlane((int)MISC[0]);
                    if (uq >= N_ATTN_UNITS) break;
                    const int u = uq < 160 ? uq + 96 : (uq < 256 ? uq - 160 : (uq < 480 ? uq + 96 : uq - 224));
                    attn_dispatch(F, p, u, l);
                }
            } else if (EN(6)) {
                const bf16_t* Wt = (const bf16_t*)(F.ws + WS_WOUT) + (size_t)l * 1024 * 1024;
                const bf16_t* Yb = (const bf16_t*)(F.ws + WS_Y);
                for (int j = bid; j < 8 * 32; j += G) {
                    const int tn = j >> 5, tm = j & 31;
                    GemmOp g; g.W = Wt + (size_t)tn * 128 * 1024; g.X = Yb + (size_t)tm * 256 * 1024; g.ldw = 1024; g.ldx = 1024; g.K = 1024;
                    GemmAcc acc;
                    Gemm2Pre P2;
                    if (F.tid == 0) {
                        unsigned* f = ctl + CW_YRDY + (l * 32 + tm) * 4;
                        XB_SPIN(xb_ld(f) < 16u, ctl + CW_BAR);
                        if (l == 0) { XB_SPIN(xb_ld(ctl + CW_P1DONE) < (unsigned)G, ctl + CW_BAR); }
                        __builtin_amdgcn_fence(__ATOMIC_ACQUIRE, "agent");
                        asm volatile("s_waitcnt vmcnt(0)" ::: "memory");
                    }
                    __syncthreads();
                    gemm2_pre(F, tn, tm, l, P2);
                    gemm_core(F, g, acc, true, false, g);
                    epi_gemm2(F, p, acc, tn, tm, l, P2, l == 3);
                    {
                        asm volatile("s_waitcnt vmcnt(0)" ::: "memory");
                        __syncthreads();
                        if (F.tid == 0) (void)xb_add(l == 3 ? ctl + CW_XRDY + tm * 4 : ctl + CW_XGR + (l * 32 + tm) * 4, 1u);
                    }
                }
            }
        }
        }
        if (MK_TIMING >= 0 && ph == 17 && blockIdx.x == 0 && F.tid == 0) {
            const unsigned long long now = __builtin_amdgcn_s_memrealtime();
            const unsigned long long prev = ((unsigned long long)MISC[17] << 32) | MISC[16];
            unsigned a = MISC[18]; if (MK_TIMING == 5) a += (unsigned)(now - prev);
            __hip_atomic_store(ctl + CW_TIME, __float_as_uint(1.f + (float)a * 1e-5f), __ATOMIC_RELAXED, __HIP_MEMORY_SCOPE_AGENT);
        }
        if (ph + 1 < p.ph_hi && ph < 1) xcd_barrier(bar);
    }
}
}

extern "C" void kernel_launch(void* const* d_in, const int* in_sizes, int n_in, void* d_out, int out_size, void* d_ws, size_t ws_size, hipStream_t stream) {
    static int grid = 0;
    if (!grid) {
        int dev = 0, cus = 0, per_cu = 0;
        (void)hipGetDevice(&dev);
        (void)hipDeviceGetAttribute(&cus, hipDeviceAttributeMultiprocessorCount, dev);
        (void)hipFuncSetAttribute((const void*)mk::mega, hipFuncAttributeMaxDynamicSharedMemorySize, mk::LDS_BYTES);
        (void)hipOccupancyMaxActiveBlocksPerMultiprocessor(&per_cu, (const void*)mk::mega, 512, mk::LDS_BYTES);
        if (per_cu > 1) per_cu = 1;
        if (per_cu < 1) per_cu = 1;
        if (cus < 1) cus = 256;
        grid = cus * per_cu;
    }
    unsigned char* ws = (unsigned char*)d_ws;
    (void)hipMemsetAsync(ws, 0, mk::CTL_ZERO_BYTES, stream);
    mk::Params P{};
    for (int i = 0; i < 22; ++i) P.in[i] = (const float*)d_in[i];
    P.out = (float*)d_out; P.ws = ws; P.xs = (float*)d_out;
    P.ph_lo = 0; P.ph_hi = mk::PH_TOTAL;
    void* args[] = {&P};
    (void)hipLaunchCooperativeKernel((const void*)mk::mega, dim3(grid), dim3(512), args, mk::LDS_BYTES, stream);
}
```

```cpp
#include <hip/hip_runtime.h>
#include <stdint.h>
namespace mk {
#define LAS __attribute__((address_space(3)))
typedef unsigned short bf16_t;
typedef short bf16x8 __attribute__((ext_vector_type(8)));
typedef short s16x4 __attribute__((ext_vector_type(4)));
typedef float f32x16 __attribute__((ext_vector_type(16)));
typedef float f32x4 __attribute__((ext_vector_type(4)));
typedef float f32x2 __attribute__((ext_vector_type(2)));
typedef unsigned u32x4 __attribute__((ext_vector_type(4)));
typedef unsigned u32x2 __attribute__((ext_vector_type(2)));
typedef __bf16 bf16x2_t __attribute__((ext_vector_type(2)));

constexpr float EPS = 1e-6f;
constexpr float LOG2E = 1.4426950408889634f;
constexpr float QSC_GQA = 0.125f * LOG2E;
constexpr float QSC_MLA = 0.10206207261596575f * LOG2E;

__device__ __forceinline__ unsigned pk2(float lo, float hi) { f32x2 v = {lo, hi}; bf16x2_t b = __builtin_convertvector(v, bf16x2_t); return __builtin_bit_cast(unsigned, b); }
__device__ __forceinline__ float bf2f(unsigned short u) { return __uint_as_float((unsigned)u << 16); }
__device__ __forceinline__ float bflo(unsigned u) { return __uint_as_float(u << 16); }
__device__ __forceinline__ float bfhi(unsigned u) { return __uint_as_float(u & 0xffff0000u); }
__device__ __forceinline__ float silu_f(float x) { return x * __builtin_amdgcn_rcpf(1.f + __builtin_amdgcn_exp2f(-x * LOG2E)); }
__device__ __forceinline__ float wsum(float v) {
#pragma unroll
    for (int o = 32; o > 0; o >>= 1) v += __shfl_xor(v, o);
    return v;
}

constexpr size_t MiB = 1u << 20;
constexpr size_t WS_CTL = 0, CTL_ZERO_BYTES = 1 * MiB;
constexpr size_t WS_MODS = 256 * 1024;
constexpr size_t WS_BIAS = 1 * MiB;
constexpr size_t WS_GS = 1 * MiB + 256 * 1024;
constexpr size_t WS_ROPE64 = 1 * MiB + 512 * 1024;
constexpr size_t WS_ROPE32 = 1 * MiB + 768 * 1024;
constexpr size_t WS_SSQ = 2 * MiB;
constexpr size_t WS_CQSSQ = 2 * MiB + 512 * 1024;
constexpr size_t WS_S0T = 3 * MiB;
constexpr size_t WS_CGK = 4 * MiB, WS_CGV = 6 * MiB, WS_CCKV = 8 * MiB, WS_CKPE = 10 * MiB;
constexpr size_t WS_WIN = 11 * MiB;
constexpr size_t WS_WOUT = 34 * MiB;
constexpr size_t WS_WUQ = 42 * MiB;
constexpr size_t WS_WUKV = 43 * MiB + 256 * 1024;
constexpr size_t WS_XG = 44 * MiB;
constexpr size_t WS_KVM = 130 * MiB;
constexpr size_t WS_KVMC = 142 * MiB;
constexpr size_t WS_RQ = 60 * MiB, WS_RK = 64 * MiB, WS_RV = 68 * MiB;
constexpr size_t WS_GQ = 72 * MiB;
constexpr size_t WS_GK = 78 * MiB, WS_GV = 80 * MiB;
constexpr size_t WS_CQG = 82 * MiB;
constexpr size_t WS_CKVN = 86 * MiB;
constexpr size_t WS_KPEB = 88 * MiB;
constexpr size_t WS_ZS = 89 * MiB;
constexpr size_t WS_QM = 105 * MiB;
constexpr size_t WS_Y = 114 * MiB;
constexpr size_t WS_XSDBG = 130 * MiB;
constexpr size_t WS_XB = 146 * MiB;
constexpr size_t WS_OPT_END = 162 * MiB;
constexpr int CW_QUEUE = 1024;
constexpr int CW_FLAG = 2048;
constexpr int CW_YRDY = 1536;
constexpr int CW_XRDY = 1280;
constexpr int CW_RA = 8192;
constexpr int CW_FULL = 8704;
constexpr int CW_ZC = 9216;
constexpr int CW_KC = 9728;
constexpr int CW_XGR = 9856;
constexpr int CW_SD = 10368;
constexpr int CW_P1X = 10656;
constexpr int CW_P1B0 = 10784;
constexpr int CW_P1DONE = 10788;
constexpr int CW_BAR = 4096;

constexpr size_t O_STATE = 8388608, O_GK = 10485760, O_GV = 12582912, O_CKV = 14680064, O_KPE = 16777216;

constexpr int NWAVE = 8;
constexpr int GST = 49152;
constexpr int GST2 = 65536;
constexpr int LDS_OST = GST2;
constexpr int LDS_EX = 135168;
constexpr int LDS_EXB = 137216;
constexpr int LDS_SCAL = 141312;
constexpr int LDS_MISC = 142336;
constexpr int LDS_BYTES = 142592;

struct Params { const float* in[22]; float* out; unsigned char* ws; float* xs; int ph_lo, ph_hi; };
enum { I_XP = 0, I_XS, I_STATE, I_CGK, I_CGV, I_CCKV, I_CKPE, I_C, I_CCTX, I_NORMG, I_WADA, I_BADA, I_WIN, I_DECAY, I_GQN, I_GKN, I_MQN, I_MKVN, I_WUQ, I_WUKV, I_WOUT, I_FNORM };

#define XB_TMO      128
#define XB_XCNT(j)  (256  + 64 * (j))
#define XB_XSUB(j)  (1280 + 64 * (j))
#define XB_XGEN(j)  (2304 + 64 * (j))
#define XB_TOP      3328
#define XB_TOPGEN   3392
#define XB_SPIN_CAP (1u << 20)
__device__ __forceinline__ unsigned xb_ld(unsigned* p) { return __hip_atomic_load(p, __ATOMIC_RELAXED, __HIP_MEMORY_SCOPE_AGENT); }
__device__ __forceinline__ unsigned xb_add(unsigned* p, unsigned v) { return __hip_atomic_fetch_add(p, v, __ATOMIC_RELAXED, __HIP_MEMORY_SCOPE_AGENT); }
__device__ __forceinline__ unsigned xb_xcc_id() { return (unsigned)__builtin_amdgcn_s_getreg((3 << 11) | 20) & 0xFu; }
#define XB_SPIN(cond, bar) do { unsigned _sp = 0; while (cond) { __builtin_amdgcn_s_sleep(1); \
    if ((++_sp & 255u) == 0u) { if (xb_ld(&(bar)[XB_TMO])) break; if (_sp > XB_SPIN_CAP) { atomicAdd(&(bar)[XB_TMO], 1u); break; } } } } while (0)
__device__ __forceinline__ int lane_id() { int ln = (int)__builtin_amdgcn_mbcnt_hi(~0u, __builtin_amdgcn_mbcnt_lo(~0u, 0u)); asm volatile("" : "+v"(ln)); return ln; }
__device__ __forceinline__ void poll_lanes(unsigned* ptr, unsigned target, bool active, unsigned* bar0) {
    unsigned sp = 0u;
    for (;;) {
        unsigned v = target;
        if (active) v = xb_ld(ptr);
        if (!__any(v < target)) break;
        __builtin_amdgcn_s_sleep(1);
        if ((++sp & 255u) == 0u) { if (xb_ld(&bar0[XB_TMO])) break; if (sp > XB_SPIN_CAP) { atomicAdd(&bar0[XB_TMO], 1u); break; } }
    }
}
struct XcdBarrier { unsigned* bar; unsigned x; volatile LAS unsigned* st; int w; };
__device__ __forceinline__ XcdBarrier xcd_barrier_post(unsigned* bar, volatile LAS unsigned* st) {
    XcdBarrier b; b.bar = bar; b.x = xb_xcc_id(); b.st = st; b.w = 0;
    if (threadIdx.x == 0) (void)xb_add(&bar[XB_XCNT(b.x)], 1u);
    return b;
}
__device__ __forceinline__ void xcd_barrier_complete(unsigned* bar, unsigned x, unsigned& nloc, unsigned& nx) {
    const unsigned G = gridDim.x * gridDim.y * gridDim.z;
    unsigned sum, cnt, mine, sp = 0u;
    for (;;) {
        sum = 0u; cnt = 0u; mine = 0u;
#pragma unroll
        for (unsigned j = 0; j < 16; ++j) { const unsigned c = xb_ld(&bar[XB_XCNT(j)]); sum += c; cnt += (c > 0u) ? 1u : 0u; mine = (j == x) ? c : mine; }
        if (sum == G) break;
        __builtin_amdgcn_s_sleep(1);
        if ((++sp & 255u) == 0u) { if (xb_ld(&bar[XB_TMO])) break; if (sp > XB_SPIN_CAP) { atomicAdd(&bar[XB_TMO], 1u); break; } }
    }
    nloc = mine > 0u ? mine : 1u; nx = cnt > 0u ? cnt : 1u;
}
__device__ __forceinline__ void xcd_barrier(const XcdBarrier& b) {
    asm volatile("s_waitcnt vmcnt(0)" ::: "memory");
    __syncthreads();
    if (b.w == 0 && __builtin_amdgcn_mbcnt_hi(~0u, __builtin_amdgcn_mbcnt_lo(~0u, 0u)) == 0u) {
        unsigned* bar = b.bar;
        __builtin_amdgcn_s_waitcnt(0);
        unsigned nloc = b.st[0], nx = b.st[1];
        if (nloc == 0u) { xcd_barrier_complete(bar, b.x, nloc, nx); b.st[0] = nloc; b.st[1] = nx; }
        const unsigned old = xb_add(&bar[XB_XSUB(b.x)], 1u);
        const unsigned gen = old / nloc;
        if (old + 1u == (gen + 1u) * nloc) {
            __builtin_amdgcn_fence(__ATOMIC_RELEASE, "agent");
            asm volatile("s_waitcnt vmcnt(0)" ::: "memory");
            const unsigned og = xb_add(&bar[XB_TOP], 1u);
            const unsigned tg = og / nx;
            if (og + 1u == (tg + 1u) * nx) xb_add(&bar[XB_TOPGEN], 1u);
            else XB_SPIN(xb_ld(&bar[XB_TOPGEN]) == tg, bar);
            xb_add(&bar[XB_XGEN(b.x)], 1u);
            __builtin_amdgcn_fence(__ATOMIC_ACQUIRE, "agent");
            asm volatile("s_waitcnt vmcnt(0)" ::: "memory");
        } else {
            XB_SPIN(xb_ld(&bar[XB_XGEN(b.x)]) == gen, bar);
            __builtin_amdgcn_fence(__ATOMIC_ACQUIRE, "agent");
            asm volatile("s_waitcnt vmcnt(0)" ::: "memory");
        }
    }
    __syncthreads();
}

typedef const float* cfp_t;
typedef const __attribute__((address_space(4))) cfp_t* karg_t;
struct Frame {
    LAS unsigned char* lds;
    int tid, lane, w, h, lq;
    unsigned char* ws;
    karg_t karg;
};
__device__ __forceinline__ const float* pin(const Frame& F, int i) { return F.karg[i]; }
__device__ __forceinline__ bool is_t0(const Frame& F) { return F.w == 0 && __builtin_amdgcn_mbcnt_hi(~0u, __builtin_amdgcn_mbcnt_lo(~0u, 0u)) == 0u; }
#define GLDS16(gsrc, ldsdst) __builtin_amdgcn_global_load_lds((const unsigned*)(gsrc), (LAS unsigned*)(ldsdst), 16, 0, 0)
#define ST16_WT(ptr, val) asm volatile("global_store_dwordx4 %0, %1, off sc1\n\ts_nop 1" :: "v"(ptr), "v"(val) : "memory")
#define MFMA32(a, b, c) __builtin_amdgcn_mfma_f32_32x32x16_bf16((a), (b), (c), 0, 0, 0)

struct GemmOp { const bf16_t* W; const bf16_t* X; int ldw, ldx, K; };
__device__ __forceinline__ void gemm_issue0(const Frame& F, const GemmOp& g) {
    const int lane = F.lane, w = F.w;
#pragma unroll
    for (int q = 0; q < 2; ++q) { const int row = 16 * w + 8 * q + (lane >> 3); GLDS16(g.W + row * g.ldw + ((lane & 7) ^ ((row >> 1) & 7)) * 8, F.lds + (16 * w + 8 * q) * 128); }
#pragma unroll
    for (int q = 0; q < 4; ++q) { const int row = 32 * w + 8 * q + (lane >> 3); GLDS16(g.X + row * g.ldx + ((lane & 7) ^ ((row >> 1) & 7)) * 8, F.lds + 16384 + (32 * w + 8 * q) * 128); }
}
typedef f32x4 GemmAcc[4][4];
__device__ __forceinline__ void gemm_core(const Frame& F, const GemmOp& g, GemmAcc& acc, bool issue_first, bool has_next, const GemmOp& gn) {
    const int lane = F.lane, w = F.w;
    const bf16_t* __restrict__ W = g.W; const bf16_t* __restrict__ X = g.X;
    const int nkt = g.K >> 6;
    int offW[2], offX[4];
#pragma unroll
    for (int q = 0; q < 2; ++q) { const int row = 16 * w + 8 * q + (lane >> 3); offW[q] = row * g.ldw + ((lane & 7) ^ ((row >> 1) & 7)) * 8; }
#pragma unroll
    for (int q = 0; q < 4; ++q) { const int row = 32 * w + 8 * q + (lane >> 3); offX[q] = row * g.ldx + ((lane & 7) ^ ((row >> 1) & 7)) * 8; }
    LAS unsigned char* const dW = F.lds + (16 * w) * 128;
    LAS unsigned char* const dX = F.lds + 16384 + (32 * w) * 128;
#define GC_ISSUE(kt, st) do { _Pragma("unroll") for (int q = 0; q < 2; ++q) GLDS16(W + offW[q] + (kt) * 64, dW + (st) * GST + q * 1024); \
        _Pragma("unroll") for (int q = 0; q < 4; ++q) GLDS16(X + offX[q] + (kt) * 64, dX + (st) * GST + q * 1024); } while (0)
    const int wn = w & 1, wm = w >> 1, c15 = lane & 15, g4 = lane >> 4;
    const int sw = (c15 >> 1) & 7;
    int so[2];
#pragma unroll
    for (int s = 0; s < 2; ++s) so[s] = ((4 * s + g4) ^ sw) << 4;
    const int bn0 = (64 * wn + c15) * 128, bm0 = 16384 + (64 * wm + c15) * 128;
#pragma unroll
    for (int a = 0; a < 4; ++a)
#pragma unroll
        for (int b = 0; b < 4; ++b) acc[a][b] = (f32x4){0.f, 0.f, 0.f, 0.f};
    if (issue_first) GC_ISSUE(0, 0);
    asm volatile("s_waitcnt vmcnt(0)" ::: "memory");
    __syncthreads();
    for (int kt = 0; kt < nkt; ++kt) {
        const int st = kt & 1;
        if (kt + 1 < nkt) GC_ISSUE(kt + 1, st ^ 1);
        LAS unsigned char* const base = F.lds + st * GST;
#pragma unroll
        for (int s = 0; s < 2; ++s) {
            bf16x8 fa[4], fb[4];
#pragma unroll
            for (int q = 0; q < 4; ++q) { fa[q] = *(const LAS bf16x8*)(base + bn0 + q * 2048 + so[s]); fb[q] = *(const LAS bf16x8*)(base + bm0 + q * 2048 + so[s]); }
#pragma unroll
            for (int a = 0; a < 4; ++a)
#pragma unroll
                for (int b = 0; b < 4; ++b) acc[a][b] = __builtin_amdgcn_mfma_f32_16x16x32_bf16(fa[a], fb[b], acc[a][b], 0, 0, 0);
        }
        asm volatile("s_waitcnt vmcnt(0)" ::: "memory");
        __syncthreads();
    }
#undef GC_ISSUE
    if (has_next) gemm_issue0(F, gn);
}

typedef f32x4 GemmAcc8[4][8];
__device__ __forceinline__ void gemm256_issue0(const Frame& F, const bf16_t* W, const bf16_t* X) {
    int lane = F.lane; const int w = F.w;
    asm volatile("" : "+v"(lane));
#pragma unroll
    for (int q = 0; q < 4; ++q) {
        const int row = 32 * w + 8 * q + (lane >> 3), off = row * 1024 + ((lane & 7) ^ ((row >> 1) & 7)) * 8;
        GLDS16(W + off, F.lds + (32 * w + 8 * q) * 128);
        GLDS16(X + off, F.lds + 32768 + (32 * w + 8 * q) * 128);
    }
}
__device__ __forceinline__ void gemm_core256(const Frame& F, const bf16_t* __restrict__ W, const bf16_t* __restrict__ X, GemmAcc8& acc, bool issue_first, bool has_next, const bf16_t* Wn, const bf16_t* Xn) {
    int lane = F.lane; const int w = F.w;
    asm volatile("" : "+v"(lane));
    int off[4];
#pragma unroll
    for (int q = 0; q < 4; ++q) { const int row = 32 * w + 8 * q + (lane >> 3); off[q] = row * 1024 + ((lane & 7) ^ ((row >> 1) & 7)) * 8; }
    LAS unsigned char* const dW = F.lds + (32 * w) * 128;
    LAS unsigned char* const dX = F.lds + 32768 + (32 * w) * 128;
#define GC2_ISSUE(kt, st) do { _Pragma("unroll") for (int q = 0; q < 4; ++q) { GLDS16(W + off[q] + (kt) * 64, dW + (st) * GST2 + q * 1024); GLDS16(X + off[q] + (kt) * 64, dX + (st) * GST2 + q * 1024); } } while (0)
    const int wn4 = w & 3, wm2 = w >> 2, c15 = lane & 15, g4 = lane >> 4;
    const int sw = (c15 >> 1) & 7;
    int so[2];
#pragma unroll
    for (int s = 0; s < 2; ++s) so[s] = ((4 * s + g4) ^ sw) << 4;
    const int bn0 = (64 * wn4 + c15) * 128, bm0 = 32768 + (128 * wm2 + c15) * 128;
#pragma unroll
    for (int a = 0; a < 4; ++a)
#pragma unroll
        for (int b = 0; b < 8; ++b) acc[a][b] = (f32x4){0.f, 0.f, 0.f, 0.f};
    if (issue_first) GC2_ISSUE(0, 0);
    asm volatile("s_waitcnt vmcnt(0)" ::: "memory");
    __syncthreads();
    for (int kt = 0; kt < 16; ++kt) {
        const int st = kt & 1;
        if (kt + 1 < 16) GC2_ISSUE(kt + 1, st ^ 1);
        LAS unsigned char* const base = F.lds + st * GST2;
#pragma unroll
        for (int s = 0; s < 2; ++s) {
            bf16x8 fa[4];
#pragma unroll
            for (int q = 0; q < 4; ++q) fa[q] = *(const LAS bf16x8*)(base + bn0 + q * 2048 + so[s]);
#pragma unroll
            for (int hb = 0; hb < 2; ++hb) {
                bf16x8 fb[4];
#pragma unroll
                for (int q = 0; q < 4; ++q) fb[q] = *(const LAS bf16x8*)(base + bm0 + (4 * hb + q) * 2048 + so[s]);
#pragma unroll
                for (int a = 0; a < 4; ++a)
#pragma unroll
                    for (int b = 0; b < 4; ++b) acc[a][4 * hb + b] = __builtin_amdgcn_mfma_f32_16x16x32_bf16(fa[a], fb[b], acc[a][4 * hb + b], 0, 0, 0);
            }
        }
        asm volatile("s_waitcnt vmcnt(0)" ::: "memory");
        __syncthreads();
    }
#undef GC2_ISSUE
    if (has_next) gemm256_issue0(F, Wn, Xn);
}
typedef f32x4 GemmAcc2[2][8];
__device__ __forceinline__ void gemm_core256n(const Frame& F, const bf16_t* __restrict__ W, const bf16_t* __restrict__ X, GemmAcc2& acc, bool issue_first) {
    int lane = F.lane; const int w = F.w;
    asm volatile("" : "+v"(lane));
    int off[4];
#pragma unroll
    for (int q = 0; q < 4; ++q) { const int row = 32 * w + 8 * q + (lane >> 3); off[q] = row * 1024 + ((lane & 7) ^ ((row >> 1) & 7)) * 8; }
    LAS unsigned char* const dW = F.lds + (32 * w) * 128;
    LAS unsigned char* const dX = F.lds + 32768 + (32 * w) * 128;
#define GC2_ISSUE(kt, st) do { _Pragma("unroll") for (int q = 0; q < 4; ++q) { if (w == 0) GLDS16(W + off[q] + (kt) * 64, dW + (st) * GST2 + q * 1024); GLDS16(X + off[q] + (kt) * 64, dX + (st) * GST2 + q * 1024); } } while (0)
    const int wn4 = w & 3, wm2 = w >> 2, c15 = lane & 15, g4 = lane >> 4;
    const int sw = (c15 >> 1) & 7;
    int so[2];
#pragma unroll
    for (int s = 0; s < 2; ++s) so[s] = ((4 * s + g4) ^ sw) << 4;
    const int bn0 = (64 * wn4 + c15) * 128, bm0 = 32768 + (128 * wm2 + c15) * 128;
#pragma unroll
    for (int a = 0; a < 2; ++a)
#pragma unroll
        for (int b = 0; b < 8; ++b) acc[a][b] = (f32x4){0.f, 0.f, 0.f, 0.f};
    if (issue_first) GC2_ISSUE(0, 0);
    asm volatile("s_waitcnt vmcnt(0)" ::: "memory");
    __syncthreads();
    for (int kt = 0; kt < 16; ++kt) {
        const int st = kt & 1;
        if (kt + 1 < 16) GC2_ISSUE(kt + 1, st ^ 1);
        LAS unsigned char* const base = F.lds + st * GST2;
        if (wn4 == 0) {
#pragma unroll
        for (int s = 0; s < 2; ++s) {
            bf16x8 fa[2];
#pragma unroll
            for (int q = 0; q < 2; ++q) fa[q] = *(const LAS bf16x8*)(base + bn0 + q * 2048 + so[s]);
#pragma unroll
            for (int hb = 0; hb < 2; ++hb) {
                bf16x8 fb[4];
#pragma unroll
                for (int q = 0; q < 4; ++q) fb[q] = *(const LAS bf16x8*)(base + bm0 + (4 * hb + q) * 2048 + so[s]);
#pragma unroll
                for (int a = 0; a < 2; ++a)
#pragma unroll
                    for (int b = 0; b < 4; ++b) acc[a][4 * hb + b] = __builtin_amdgcn_mfma_f32_16x16x32_bf16(fa[a], fb[b], acc[a][4 * hb + b], 0, 0, 0);
            }
        }
        }
        asm volatile("s_waitcnt vmcnt(0)" ::: "memory");
        __syncthreads();
    }
#undef GC2_ISSUE
}

__device__ __forceinline__ void rope64_16(float (&v)[4][4], float rowp, float colp, int g4) {
#pragma unroll
    for (int i = 0; i < 4; ++i) {
        const float fr = __builtin_amdgcn_exp2f((float)(4 * g4 + i) * -0.8304820237218406f) * 0.15915494309189535f;
#pragma unroll
        for (int c = 0; c < 2; ++c) {
            const float rev = (c ? colp : rowp) * fr;
            const float sn = __builtin_amdgcn_sinf(rev), cs = __builtin_amdgcn_cosf(rev);
            const float x0 = v[2 * c][i], x1 = v[2 * c + 1][i];
            v[2 * c][i] = x0 * cs - x1 * sn;
            v[2 * c + 1][i] = x1 * cs + x0 * sn;
        }
    }
}
__device__ __forceinline__ void rope32_16(float (&a)[4], float (&b)[4], float rowp, float colp, int g4) {
    const bool hi = g4 >= 2;
#pragma unroll
    for (int i = 0; i < 4; ++i) {
        const float fr = __builtin_amdgcn_exp2f((float)(4 * (g4 & 1) + i) * -1.6609640474436813f) * 0.15915494309189535f;
        {
            const float rev = rowp * fr;
            const float sn = __builtin_amdgcn_sinf(rev), cs = __builtin_amdgcn_cosf(rev);
            const float own = a[i], oth = __shfl_xor(own, 32);
            a[i] = own * cs + oth * (hi ? sn : -sn);
        }
        {
            const float rev = colp * fr;
            const float sn = __builtin_amdgcn_sinf(rev), cs = __builtin_amdgcn_cosf(rev);
            const float own = b[i], oth = __shfl_xor(own, 32);
            b[i] = own * cs + oth * (hi ? sn : -sn);
        }
    }
}
__device__ __forceinline__ float ssq64(const float (&v)[4][4]) {
    float s = 0.f;
#pragma unroll
    for (int nt = 0; nt < 4; ++nt)
#pragma unroll
        for (int i = 0; i < 4; ++i) s += v[nt][i] * v[nt][i];
    s += __shfl_xor(s, 16);
    s += __shfl_xor(s, 32);
    return s;
}
__device__ __forceinline__ void mulvec64(float (&v)[4][4], const LAS float* gv, int g4) {
#pragma unroll
    for (int nt = 0; nt < 4; ++nt) {
        const f32x4 q = *(const LAS f32x4*)(gv + 16 * nt + 4 * g4);
#pragma unroll
        for (int i = 0; i < 4; ++i) v[nt][i] *= q[i];
    }
}
constexpr int OST_LD = 68, OST_BYTES = 32 * OST_LD * 4;
__device__ __forceinline__ void stage_write16(LAS float* st, const float (&v)[4][4], int mh, int c15, int g4) {
    asm volatile("s_waitcnt lgkmcnt(0)" ::: "memory");
    __builtin_amdgcn_wave_barrier();
#pragma unroll
    for (int nt = 0; nt < 4; ++nt) {
        f32x4 o = {v[nt][0], v[nt][1], v[nt][2], v[nt][3]};
        *(LAS f32x4*)(st + (16 * mh + c15) * OST_LD + 16 * nt + 4 * g4) = o;
    }
    asm volatile("s_waitcnt lgkmcnt(0)" ::: "memory");
    __builtin_amdgcn_wave_barrier();
}
__device__ __forceinline__ void stage_write16a(LAS float* st, const f32x4 (&a)[4][4], int mt, int c15, int g4) {
    asm volatile("s_waitcnt lgkmcnt(0)" ::: "memory");
    __builtin_amdgcn_wave_barrier();
#pragma unroll
    for (int nt = 0; nt < 4; ++nt) *(LAS f32x4*)(st + (16 * (mt & 1) + c15) * OST_LD + 16 * nt + 4 * g4) = a[nt][mt];
    asm volatile("s_waitcnt lgkmcnt(0)" ::: "memory");
    __builtin_amdgcn_wave_barrier();
}
__device__ __forceinline__ void stage_store_bf16(const LAS float* st, bf16_t* dst, int ld, float sc, int lane) {
#pragma unroll 1
    for (int it = 0; it < 4; ++it) {
        const int row = it * 8 + (lane >> 3), c8 = (lane & 7) * 8;
        const f32x4 x0 = *(const LAS f32x4*)(st + row * OST_LD + c8), x1 = *(const LAS f32x4*)(st + row * OST_LD + c8 + 4);
        u32x4 o; o.x = pk2(x0[0] * sc, x0[1] * sc); o.y = pk2(x0[2] * sc, x0[3] * sc); o.z = pk2(x1[0] * sc, x1[1] * sc); o.w = pk2(x1[2] * sc, x1[3] * sc);
        ST16_WT(dst + (size_t)row * ld + c8, o);
    }
}
__device__ __forceinline__ void stage_store_bf16_sc1(const LAS float* st, bf16_t* dst, int ld, int lane) {
#pragma unroll 1
    for (int it = 0; it < 4; ++it) {
        const int row = it * 8 + (lane >> 3), c8 = (lane & 7) * 8;
        const f32x4 x0 = *(const LAS f32x4*)(st + row * OST_LD + c8), x1 = *(const LAS f32x4*)(st + row * OST_LD + c8 + 4);
        u32x4 o; o.x = pk2(x0[0], x0[1]); o.y = pk2(x0[2], x0[3]); o.z = pk2(x1[0], x1[1]); o.w = pk2(x1[2], x1[3]);
        bf16_t* ptr = dst + (size_t)row * ld + c8;
        asm volatile("global_store_dwordx4 %0, %1, off sc1\n\ts_nop 1" :: "v"(ptr), "v"(o) : "memory");
    }
}
__device__ __forceinline__ void stage_store_f32(const LAS float* st, float* dst, int ld, int lane) {
#pragma unroll 1
    for (int it = 0; it < 8; ++it) {
        const int row = it * 4 + (lane >> 4), c = (lane & 15) * 4;
        { const f32x4 o = *(const LAS f32x4*)(st + row * OST_LD + c); ST16_WT(dst + (size_t)row * ld + c, o); }
    }
}
__device__ __forceinline__ void stage_store_bf16_32(const LAS float* st, bf16_t* dst, int ld, int lane) {
#pragma unroll 1
    for (int it = 0; it < 2; ++it) {
        const int row = it * 16 + (lane >> 2), c8 = (lane & 3) * 8;
        const f32x4 x0 = *(const LAS f32x4*)(st + row * OST_LD + c8), x1 = *(const LAS f32x4*)(st + row * OST_LD + c8 + 4);
        u32x4 o; o.x = pk2(x0[0], x0[1]); o.y = pk2(x0[2], x0[3]); o.z = pk2(x1[0], x1[1]); o.w = pk2(x1[2], x1[3]);
        ST16_WT(dst + (size_t)row * ld + c8, o);
    }
}
__device__ __forceinline__ void stage_store_f32_32(const LAS float* st, float* dst, int ld, int lane) {
#pragma unroll 1
    for (int it = 0; it < 4; ++it) {
        const int row = it * 8 + (lane >> 3), c = (lane & 7) * 4;
        { const f32x4 o = *(const LAS f32x4*)(st + row * OST_LD + c); ST16_WT(dst + (size_t)row * ld + c, o); }
    }
}

struct Gemm1Pre { float rstd[2]; float bias, gain; };
__device__ __forceinline__ void gemm1_pre(const Frame& F, const Params& p, int tn, int wn, int tm, int l, Gemm1Pre& P) {
    const float* ssqp = (const float*)(F.ws + WS_SSQ);
#pragma unroll
    for (int jj = 0; jj < 2; ++jj) {
        const int tok = tm * 256 + (F.w >> 2) * 128 + 64 * jj + F.lane;
        const f32x4* sp = (const f32x4*)(ssqp + (size_t)tok * 16);
        float ss = 0.f;
#pragma unroll
        for (int i = 0; i < 4; ++i) { const f32x4 q = sp[i]; ss += (q[0] + q[1]) + (q[2] + q[3]); }
        P.rstd[jj] = rsqrtf(ss * (1.f / 1024.f) + EPS);
    }
    const bool lat = tm >= 16;
    const int cond = lat ? 1 + ((tm - 16) >> 2) : 0;
    const int nb = tn * 128 + wn * 64;
    P.bias = (tn < 23) ? ((const float*)(F.ws + WS_BIAS))[(size_t)(l * 5 + cond) * 2944 + nb + F.lane] : 0.f;
    const float* gp = nullptr;
    if (tn >= 6 && tn < 9) gp = pin(F, I_GQN) + l * 64;
    else if (tn == 9) gp = pin(F, I_GKN) + l * 64;
    else if (tn == 11 || tn == 12) gp = pin(F, I_MQN) + l * 256 + (nb - 1408);
    else if (tn == 13) gp = pin(F, I_MKVN) + l * 128 + wn * 64;
    P.gain = gp ? gp[F.lane] : 1.f;
}
__device__ __forceinline__ void epi_gemm1(const Frame& F, const Params& p, GemmAcc8& acc, int tn, int wn, int tm, int l, const Gemm1Pre& P, bool ckv_tile) {
    int lane = F.lane; const int wm = F.w >> 2;
    asm volatile("" : "+v"(lane));
    const int c15 = lane & 15, g4 = lane >> 4;
    unsigned char* ws = F.ws;
    asm volatile("" : "+s"(ws));
    LAS float* st = (LAS float*)(F.lds + LDS_OST + F.w * OST_BYTES);
    const bool lat = tm >= 16;
    const int b = lat ? ((tm - 16) >> 2) : tm;
    const int nb = tn * 128 + wn * 64;
    LAS float* exb = (LAS float*)(F.lds + LDS_EXB) + F.w * 128;
    exb[lane] = P.bias; exb[64 + lane] = P.gain;
    asm volatile("s_waitcnt lgkmcnt(0)" ::: "memory");
    __builtin_amdgcn_wave_barrier();
    const LAS float* bias = exb;
    float* outp = p.out;
    asm volatile("" : "+s"(outp));
    float ckv_ss[8];
    if (tn < 23) {
#pragma unroll
    for (int mt = 0; mt < 8; ++mt) {
        const int mh = mt & 1;
        const int tok0 = tm * 256 + wm * 128 + (mt >> 1) * 32;
        const int tokb = tok0 + 16 * mh, tok = tokb + c15;
        const int t0 = lat ? ((tok0 - 4096) & 1023) : (tok0 & 255), t = t0 + 16 * mh + c15;
        const float rstd = __shfl(P.rstd[mt >> 2], 16 * (mt & 3) + c15);
        float v[4][4];
#pragma unroll
        for (int nt = 0; nt < 4; ++nt) {
            const f32x4 bq = *(const LAS f32x4*)(bias + 16 * nt + 4 * g4);
#pragma unroll
            for (int i = 0; i < 4; ++i) v[nt][i] = acc[nt][mt][i] * rstd + bq[i];
        }
        const float rowp = (float)(t >> 6), colp = (float)(t & 63);
        const size_t orow0 = (size_t)(b * 4 + l) * 256 + t0;
        if (tn < 2) {
            if (lat) rope64_16(v, rowp, colp, g4);
            stage_write16(st, v, mh, c15, g4);
            if (mh) stage_store_bf16(st, (bf16_t*)(ws + WS_RQ) + (size_t)tok0 * 256 + nb, 256, 1.f, lane);
        } else if (tn < 4) {
            if (lat) rope64_16(v, rowp, colp, g4);
            stage_write16(st, v, mh, c15, g4);
            if (mh) stage_store_bf16(st, (bf16_t*)(ws + WS_RK) + (size_t)tok0 * 256 + (nb - 256), 256, 0.125f, lane);
        } else if (tn < 6) {
            stage_write16(st, v, mh, c15, g4);
            if (mh) stage_store_bf16(st, (bf16_t*)(ws + WS_RV) + (size_t)tok0 * 256 + (nb - 512), 256, 1.f, lane);
        } else if (tn < 9) {
            const float r = rsqrtf(ssq64(v) * (1.f / 64.f) + EPS);
#pragma unroll
            for (int nt = 0; nt < 4; ++nt)
#pragma unroll
                for (int i = 0; i < 4; ++i) v[nt][i] *= r;
            mulvec64(v, exb + 64, g4);
            if (lat) rope64_16(v, rowp, colp, g4);
            stage_write16(st, v, mh, c15, g4);
            if (mh) stage_store_bf16(st, (bf16_t*)(ws + WS_GQ) + (size_t)tok0 * 384 + (nb - 768), 384, QSC_GQA, lane);
        } else if (tn == 9) {
            const float r = rsqrtf(ssq64(v) * (1.f / 64.f) + EPS);
#pragma unroll
            for (int nt = 0; nt < 4; ++nt)
#pragma unroll
                for (int i = 0; i < 4; ++i) v[nt][i] *= r;
            mulvec64(v, exb + 64, g4);
            if (lat) rope64_16(v, rowp, colp, g4);
            stage_write16(st, v, mh, c15, g4);
            if (mh) {
                if (!lat) stage_store_f32(st, outp + O_GK + orow0 * 128 + (nb - 1152), 128, lane);
                stage_store_bf16(st, (bf16_t*)(ws + WS_GK) + (size_t)tok0 * 128 + (nb - 1152), 128, 1.f, lane);
            }
        } else if (tn == 10) {
            stage_write16(st, v, mh, c15, g4);
            if (mh) {
                if (!lat) stage_store_f32(st, outp + O_GV + orow0 * 128 + (nb - 1280), 128, lane);
                stage_store_bf16(st, (bf16_t*)(ws + WS_GV) + (size_t)tok0 * 128 + (nb - 1280), 128, 1.f, lane);
            }
        } else if (tn < 13) {
            const float s2 = ssq64(v);
            if (g4 == 0) __hip_atomic_store((__attribute__((address_space(1))) float*)((float*)(ws + WS_CQSSQ) + (size_t)tok * 4 + ((nb - 1408) >> 6)), s2, __ATOMIC_RELAXED, __HIP_MEMORY_SCOPE_AGENT);
            mulvec64(v, exb + 64, g4);
            stage_write16(st, v, mh, c15, g4);
            if (mh) stage_store_bf16_sc1(st, (bf16_t*)(ws + WS_CQG) + (size_t)tok0 * 256 + (nb - 1408), 256, lane);
        } else if (tn == 13) {
            ckv_ss[mt] = ssq64(v);
            if (g4 == 0) ((LAS float*)(F.lds + LDS_EX))[(wm * 2 + wn) * 128 + mt * 16 + c15] = ckv_ss[mt];
        } else if (tn < 22) {
#pragma unroll
            for (int nt = 0; nt < 4; ++nt)
#pragma unroll
                for (int i = 0; i < 4; ++i) v[nt][i] = silu_f(v[nt][i]);
            stage_write16(st, v, mh, c15, g4);
            if (mh) stage_store_bf16(st, (bf16_t*)(ws + WS_ZS) + (size_t)tok0 * 1024 + (nb - 1792), 1024, 1.f, lane);
        } else {
            if (wn == 0) {
                if (lat) rope32_16(v[0], v[1], rowp, colp, g4);
                stage_write16(st, v, mh, c15, g4);
                if (mh) {
                    if (!lat) stage_store_f32_32(st, outp + O_KPE + orow0 * 32, 32, lane);
                    stage_store_bf16_32(st, (bf16_t*)(ws + WS_KPEB) + (size_t)tok0 * 32, 32, lane);
                }
            }
        }
    }
    }
    if (ckv_tile) {
        __syncthreads();
        if (tn == 13) {
#pragma unroll
        for (int mt = 0; mt < 8; ++mt) {
            const int mh = mt & 1;
            const int tok0 = tm * 256 + wm * 128 + (mt >> 1) * 32;
            const int t0 = lat ? ((tok0 - 4096) & 1023) : (tok0 & 255);
            const float rstd = __shfl(P.rstd[mt >> 2], 16 * (mt & 3) + c15);
            float v[4][4];
#pragma unroll
            for (int nt = 0; nt < 4; ++nt) {
                const f32x4 bq = *(const LAS f32x4*)(bias + 16 * nt + 4 * g4);
#pragma unroll
                for (int i = 0; i < 4; ++i) v[nt][i] = acc[nt][mt][i] * rstd + bq[i];
            }
            const float tot = ckv_ss[mt] + ((const LAS float*)(F.lds + LDS_EX))[(wm * 2 + (wn ^ 1)) * 128 + mt * 16 + c15];
            const float r = rsqrtf(tot * (1.f / 128.f) + EPS);
#pragma unroll
            for (int nt = 0; nt < 4; ++nt)
#pragma unroll
                for (int i = 0; i < 4; ++i) v[nt][i] *= r;
            mulvec64(v, exb + 64, g4);
            const size_t orow0 = (size_t)(b * 4 + l) * 256 + t0;
            stage_write16(st, v, mh, c15, g4);
            if (mh) {
                if (!lat) stage_store_f32(st, outp + O_CKV + orow0 * 128 + wn * 64, 128, lane);
                stage_store_bf16_sc1(st, (bf16_t*)(ws + WS_CKVN) + (size_t)tok0 * 128 + wn * 64, 128, lane);
            }
        }
        }
        __syncthreads();
    }
}

__device__ __forceinline__ void qm_pre(const Frame& F, int tm, float& rstd) {
    const int tok = tm * 256 + (F.w >> 1) * 64 + F.lane;
    const f32x4 q4 = *(const f32x4*)((const float*)(F.ws + WS_CQSSQ) + (size_t)tok * 4);
    rstd = rsqrtf(((q4[0] + q4[1]) + (q4[2] + q4[3])) * (1.f / 256.f) + EPS);
}
__device__ __forceinline__ void epi_qm(const Frame& F, GemmAcc& acc, int tn, int tm, float rstdl) {
    int lane = F.lane; const int wn = F.w & 1, wm = F.w >> 1;
    asm volatile("" : "+v"(lane));
    const int c15 = lane & 15, g4 = lane >> 4;
    unsigned char* ws = F.ws;
    LAS float* st = (LAS float*)(F.lds + LDS_OST + F.w * OST_BYTES);
    const bool lat = tm >= 16;
    const int nb = tn * 128 + wn * 64;
    if (nb >= 576) return;
#pragma unroll
    for (int mt = 0; mt < 4; ++mt) {
        const int mh = mt & 1;
        const int tok0 = tm * 256 + wm * 64 + (mt >> 1) * 32, tok = tok0 + 16 * mh + c15;
        const int t = lat ? ((tok - 4096) & 1023) : (tok & 255);
        const float rstd = __shfl(rstdl, 16 * mt + c15);
        const float rowp = (float)(t >> 6), colp = (float)(t & 63);
        float v[4][4];
#pragma unroll
        for (int nt = 0; nt < 4; ++nt)
#pragma unroll
            for (int i = 0; i < 4; ++i) v[nt][i] = acc[nt][mt][i] * rstd;
#pragma unroll
        for (int q = 0; q < 2; ++q) {
            const int T = (nb + 32 * q) >> 5;
            if (lat && (T % 3) == 2) rope32_16(v[2 * q], v[2 * q + 1], rowp, colp, g4);
        }
        stage_write16(st, v, mh, c15, g4);
        if (mh) stage_store_bf16(st, (bf16_t*)(ws + WS_QM) + (size_t)tok0 * 576 + nb, 576, QSC_MLA, lane);
    }
}
__device__ __forceinline__ void epi_plain(const Frame& F, GemmAcc& acc, bf16_t* D, int ldd, int row0, int n0) {
    int lane = F.lane; const int wn = F.w & 1, wm = F.w >> 1;
    asm volatile("" : "+v"(lane));
    const int c15 = lane & 15, g4 = lane >> 4;
    LAS float* st = (LAS float*)(F.lds + LDS_OST + F.w * OST_BYTES);
#pragma unroll
    for (int mt = 0; mt < 4; ++mt) {
        const int r0 = row0 + wm * 64 + (mt >> 1) * 32;
        stage_write16a(st, acc, mt, c15, g4);
        if (mt & 1) stage_store_bf16(st, D + (size_t)r0 * ldd + n0 + wn * 64, ldd, 1.f, lane);
    }
}

struct Gemm2Pre { f32x4 gt0, gt1, gs0, gs1; };
__device__ __forceinline__ void gemm2_pre(const Frame& F, int tn, int tm, int l, Gemm2Pre& P) {
    const bool lat = tm >= 16; const int cond = lat ? 1 + ((tm - 16) >> 2) : 0;
    const int nb = tn * 128 + (F.w & 1) * 64, c8 = (F.lane & 7) * 8;
    const float* gtp = (const float*)(F.ws + WS_MODS) + (size_t)(l * 5 + cond) * 3072 + 2048 + nb + c8;
    const float* gsp = (const float*)(F.ws + WS_GS) + (size_t)((l < 3 ? l + 1 : 3) * 5 + cond) * 1024 + nb + c8;
    P.gt0 = *(const f32x4*)gtp; P.gt1 = *(const f32x4*)(gtp + 4);
    P.gs0 = *(const f32x4*)gsp; P.gs1 = *(const f32x4*)(gsp + 4);
}
__device__ __forceinline__ void epi_gemm2(const Frame& F, const Params& p, GemmAcc& acc, int tn, int tm, int l, const Gemm2Pre& P, bool last) {
    int lane = F.lane; const int wn = F.w & 1, wm = F.w >> 1;
    asm volatile("" : "+v"(lane));
    const int c15 = lane & 15, g4 = lane >> 4;
    unsigned char* ws = F.ws;
    LAS float* st = (LAS float*)(F.lds + LDS_OST + F.w * OST_BYTES);
    const bool lat = tm >= 16;
    const int nb = tn * 128 + wn * 64;
    const int c8 = (lane & 7) * 8, r8 = lane >> 3;
#pragma unroll
    for (int mt = 0; mt < 2; ++mt) {
        const int tok0 = tm * 256 + wm * 64 + mt * 32;
        stage_write16a(st, acc, 2 * mt, c15, g4);
        stage_write16a(st, acc, 2 * mt + 1, c15, g4);
        bf16_t* xb0 = (bf16_t*)(ws + WS_XB) + (size_t)tok0 * 1024 + nb + c8;
        f32x4 xo8[8];
        if (l == 0) {
            const float* xold0 = lat ? pin(F, I_XS) + (size_t)(tok0 - 4096) * 1024 : pin(F, I_XP) + (size_t)tok0 * 1024;
#pragma unroll
            for (int it = 0; it < 4; ++it) {
                const float* xp = xold0 + (size_t)(it * 8 + r8) * 1024 + nb + c8;
                xo8[2 * it] = *(const f32x4*)xp; xo8[2 * it + 1] = *(const f32x4*)(xp + 4);
            }
        } else {
#pragma unroll
            for (int it = 0; it < 4; ++it) {
                const u32x4 q = *(const u32x4*)(xb0 + (size_t)(it * 8 + r8) * 1024);
                xo8[2 * it] = (f32x4){bflo(q.x), bfhi(q.x), bflo(q.y), bfhi(q.y)}; xo8[2 * it + 1] = (f32x4){bflo(q.z), bfhi(q.z), bflo(q.w), bfhi(q.w)};
            }
        }
#pragma unroll
        for (int it = 0; it < 4; ++it) {
            const int row = it * 8 + r8;
            const f32x4 a0 = *(const LAS f32x4*)(st + row * OST_LD + c8), a1 = *(const LAS f32x4*)(st + row * OST_LD + c8 + 4);
            const f32x4 xn0 = xo8[2 * it] + P.gt0 * a0, xn1 = xo8[2 * it + 1] + P.gt1 * a1;
            {
                u32x4 o; o.x = pk2(xn0[0], xn0[1]); o.y = pk2(xn0[2], xn0[3]); o.z = pk2(xn1[0], xn1[1]); o.w = pk2(xn1[2], xn1[3]);
                if (last) ST16_WT(xb0 + (size_t)row * 1024, o); else *(u32x4*)(xb0 + (size_t)row * 1024) = o;
            }
            float ss = ((xn0[0] * xn0[0] + xn0[1] * xn0[1]) + (xn0[2] * xn0[2] + xn0[3] * xn0[3])) + ((xn1[0] * xn1[0] + xn1[1] * xn1[1]) + (xn1[2] * xn1[2] + xn1[3] * xn1[3]));
            ss += __shfl_xor(ss, 1); ss += __shfl_xor(ss, 2); ss += __shfl_xor(ss, 4);
            if ((lane & 7) == 0) {
                float* sq = (float*)(ws + WS_SSQ) + (size_t)(tok0 + row) * 16 + tn * 2 + wn;
                __hip_atomic_store((__attribute__((address_space(1))) float*)sq, ss, __ATOMIC_RELAXED, __HIP_MEMORY_SCOPE_AGENT);
            }
            if (l < 3) {
                u32x4 o; o.x = pk2(xn0[0] * P.gs0[0], xn0[1] * P.gs0[1]); o.y = pk2(xn0[2] * P.gs0[2], xn0[3] * P.gs0[3]);
                o.z = pk2(xn1[0] * P.gs1[0], xn1[1] * P.gs1[1]); o.w = pk2(xn1[2] * P.gs1[2], xn1[3] * P.gs1[3]);
                ST16_WT((bf16_t*)(ws + WS_XG) + (size_t)(tok0 + row) * 1024 + nb + c8, o);
            }
        }
    }
}

__device__ __forceinline__ void epi_kpe(const Frame& F, const Params& p, GemmAcc2& acc, int tm, int l, const Gemm1Pre& P) {
    int lane = F.lane; const int wm = F.w >> 2;
    asm volatile("" : "+v"(lane));
    const int c15 = lane & 15, g4 = lane >> 4;
    unsigned char* ws = F.ws;
    asm volatile("" : "+s"(ws));
    float* outp = p.out;
    asm volatile("" : "+s"(outp));
    LAS float* st = (LAS float*)(F.lds + LDS_OST + F.w * OST_BYTES);
    const bool lat = tm >= 16;
    const int b = lat ? ((tm - 16) >> 2) : tm;
    LAS float* exb = (LAS float*)(F.lds + LDS_EXB) + F.w * 128;
    exb[lane] = P.bias;
    asm volatile("s_waitcnt lgkmcnt(0)" ::: "memory");
    __builtin_amdgcn_wave_barrier();
#pragma unroll
    for (int mt = 0; mt < 8; ++mt) {
        const int mh = mt & 1;
        const int tok0 = tm * 256 + wm * 128 + (mt >> 1) * 32;
        const int t0 = lat ? ((tok0 - 4096) & 1023) : (tok0 & 255), t = t0 + 16 * mh + c15;
        const float rstd = __shfl(P.rstd[mt >> 2], 16 * (mt & 3) + c15);
        float v[4][4];
#pragma unroll
        for (int nt = 0; nt < 2; ++nt) {
            const f32x4 bq = *(const LAS f32x4*)(exb + 16 * nt + 4 * g4);
#pragma unroll
            for (int i = 0; i < 4; ++i) { v[nt][i] = acc[nt][mt][i] * rstd + bq[i]; v[2 + nt][i] = 0.f; }
        }
        const float rowp = (float)(t >> 6), colp = (float)(t & 63);
        const size_t orow0 = (size_t)(b * 4 + l) * 256 + t0;
        if (lat) rope32_16(v[0], v[1], rowp, colp, g4);
        stage_write16(st, v, mh, c15, g4);
        if (mh) {
            if (!lat) stage_store_f32_32(st, outp + O_KPE + orow0 * 32, 32, lane);
            stage_store_bf16_32(st, (bf16_t*)(ws + WS_KPEB) + (size_t)tok0 * 32, 32, lane);
        }
    }
}
constexpr int AT_STG = 20480, AT_PE = 8192, AT_V = 12288, AT_OLD = 68;
struct AttnUnit {
    int mode;
    int nt0, nt1;
    const bf16_t *q; int q_ld;
    const bf16_t *k0, *k1; int k_ld0, k_ld1;
    const bf16_t *pe0, *pe1;
    const bf16_t *v0, *v1; int v_ld0, v_ld1;
    int tok0;
    int ycol;
    int qpos0, L;
    float lf, lb;
    const bf16_t *s0f, *s0b;
    unsigned* zflag;
    unsigned* yflag;
    float* st_out;
};
__device__ __forceinline__ s16x4 tr16(LAS const unsigned char* p) {
    typedef short v4i16_t __attribute__((ext_vector_type(4)));
    return __builtin_bit_cast(s16x4, __builtin_amdgcn_ds_read_tr16_b64_v4i16((LAS v4i16_t*)p));
}

template <int MODE>
__device__ __forceinline__ void attn_unit(const Frame& F, const Params& p, const AttnUnit& U) {
    constexpr int NQS = MODE == 1 ? 6 : 4;
    int lane = F.lane; const int w = F.w;
    asm volatile("" : "+v"(lane));
    const int h = lane >> 5, lq = lane & 31;
    LAS unsigned char* lds = F.lds;
    const int k_ld = U.k_ld1, v_ld = U.v_ld1;
    const int krow = 8 * w + (lane >> 3);
    const int koff = krow * k_ld + ((lane & 7) ^ ((krow >> 1) & 7)) * 8;
    const int poff = (16 * (w & 3) + (lane >> 2)) * 32 + ((lane & 3) ^ ((lane >> 4) & 3)) * 8;
    const int vdblk = w >> 2, vkg = w & 3;
    const int voff = (16 * vkg + (lane >> 2)) * v_ld + vdblk * 32 + (lane & 3) * 8;
    const int vdst = AT_V + vdblk * 4096 + vkg * 1024;
    const int nt0 = U.nt0, ntot = U.nt0 + U.nt1;
    const unsigned ldsb = (unsigned)(uintptr_t)lds;
#define AT_DMA(gsrc, ldsoff) do { unsigned _keep; const unsigned _d = (unsigned)__builtin_amdgcn_readfirstlane((int)(ldsb + (unsigned)(ldsoff))); \
        asm volatile("s_mov_b32 %0, m0\n\ts_mov_b32 m0, %2\n\ts_nop 0\n\tglobal_load_lds_dwordx4 %1, off\n\ts_mov_b32 m0, %0" : "=&s"(_keep) : "v"(gsrc), "s"(_d) : "memory"); } while (0)
#define AT_ISSUE(t, st) do { const int _t = (t); const int _b = (st) * AT_STG; \
        const bool _s0 = _t < nt0; const int _u = _s0 ? _t : _t - nt0; \
        const bf16_t* _kb = (_s0 ? U.k0 : U.k1) + (size_t)_u * 64 * k_ld; const bf16_t* _vb = (_s0 ? U.v0 : U.v1) + (size_t)_u * 64 * v_ld; \
        AT_DMA(_kb + koff, _b + (8 * w) * 128); \
        if (MODE == 1) { const bf16_t* _pb = (_s0 ? U.pe0 : U.pe1) + (size_t)_u * 64 * 32; AT_DMA(_pb + poff, _b + AT_PE + 16 * (w & 3) * 64); } \
        AT_DMA(_vb + voff, _b + vdst); } while (0)
    AT_ISSUE(0, 0);
    if (ntot > 1) AT_ISSUE(1, 1);
    bf16x8 qr[NQS];
    if (MODE == 3) {
        const int dk = 32 * (w & 1) + lq;
#pragma unroll
        for (int s = 0; s < 4; ++s)
#pragma unroll
            for (int j = 0; j < 8; ++j) qr[s][j] = (16 * s + 8 * h + j == dk) ? (short)0x3F80 : (short)0;
    } else {
        const bf16_t* qp = U.q + (size_t)(32 * w + lq) * U.q_ld + 8 * h;
#pragma unroll
        for (int s = 0; s < NQS; ++s) qr[s] = *(const bf16x8*)(qp + 16 * s);
    }
    f32x16 o[2];
#pragma unroll
    for (int d = 0; d < 2; ++d)
#pragma unroll
        for (int r = 0; r < 16; ++r) o[d][r] = 0.f;
    float m_run = 0.f, l_run = 0.f;
    f32x16 negm;
#pragma unroll
    for (int r = 0; r < 16; ++r) negm[r] = 0.f;
    const int qpos = U.qpos0 + 32 * w + lq;
    const float st_slope = ((w >> 1) & 1) ? U.lb : -U.lf, st_off = ((w >> 1) & 1) ? 0.f : 255.f * U.lf;
    const int sdir = (w >> 1) & 1;
    LAS float* scal = (LAS float*)(lds + LDS_SCAL) + w * 32;
    LAS float* ctab = (LAS float*)(lds + LDS_EXB) + w * 128;
    float a_f = 0.f, a_b = 0.f;
    if (MODE == 2) {
        ctab[lane] = __builtin_amdgcn_exp2f((float)(63 - lane) * U.lf);
        ctab[64 + lane] = __builtin_amdgcn_exp2f((float)lane * U.lb);
        a_f = __builtin_amdgcn_exp2f((float)(32 * w + lq) * U.lf);
        a_b = __builtin_amdgcn_exp2f((float)(255 - 32 * w - lq) * U.lb);
        asm volatile("s_waitcnt lgkmcnt(0)" ::: "memory");
        __builtin_amdgcn_wave_barrier();
    }
    const int kfo = lq * 128, sw = (lane >> 1) & 7, pfo = AT_PE + lq * 64, psw = (lane >> 2) & 3;
    const int vfo = AT_V + (4 * h + ((lane & 15) >> 2)) * 64 + ((lane >> 4) & 1) * 32 + (lane & 3) * 8;
    int st = 0;
    for (int t = 0; t < ntot; ++t) {
        if (t + 1 < ntot) { if (MODE == 1) asm volatile("s_waitcnt vmcnt(3)" ::: "memory"); else asm volatile("s_waitcnt vmcnt(2)" ::: "memory"); }
        else asm volatile("s_waitcnt vmcnt(0)" ::: "memory");
        __builtin_amdgcn_s_barrier();
        asm volatile("" ::: "memory");
        const int st2 = st == 0 ? 2 : st - 1;
        if (t + 2 < ntot) AT_ISSUE(t + 2, st2);
        LAS const unsigned char* base = lds + st * AT_STG;
        bf16x8 kfa[NQS], kfb[NQS];
#pragma unroll
        for (int s = 0; s < 4; ++s) {
            const int so = ((2 * s + h) ^ sw) << 4;
            kfa[s] = *(const LAS bf16x8*)(base + kfo + so);
            kfb[s] = *(const LAS bf16x8*)(base + kfo + 4096 + so);
        }
        if (MODE == 1) {
#pragma unroll
            for (int s = 0; s < 2; ++s) {
                const int so = ((2 * s + h) ^ psw) << 4;
                kfa[4 + s] = *(const LAS bf16x8*)(base + pfo + so);
                kfb[4 + s] = *(const LAS bf16x8*)(base + pfo + 2048 + so);
            }
        }
        f32x16 p0, p1;
        if (MODE <= 1) { p0 = negm; p1 = negm; }
        else {
#pragma unroll
            for (int r = 0; r < 16; ++r) { p0[r] = 0.f; p1[r] = 0.f; }
        }
#pragma unroll
        for (int s = 0; s < NQS; ++s) { p0 = MFMA32(kfa[s], qr[s], p0); p1 = MFMA32(kfb[s], qr[s], p1); }
        s16x4 vlo[4], vhi[4];
#pragma unroll
        for (int ks = 0; ks < 4; ++ks) { vlo[ks] = tr16(base + vfo + ks * 1024); vhi[ks] = tr16(base + vfo + ks * 1024 + 512); }
        if (MODE <= 1) {
            float tm = p0[0];
#pragma unroll
            for (int r = 1; r < 16; ++r) tm = fmaxf(tm, p0[r]);
#pragma unroll
            for (int r = 0; r < 16; ++r) tm = fmaxf(tm, p1[r]);
            tm = fmaxf(tm, __shfl_xor(tm, 32));
            if (t == 0 || __any(tm > 6.0f)) {
                const float dl = t == 0 ? tm : fmaxf(tm, 0.f);
                m_run += dl;
#pragma unroll
                for (int r = 0; r < 16; ++r) { p0[r] -= dl; p1[r] -= dl; negm[r] = -m_run; }
                if (t > 0) {
                    const float alpha = __builtin_amdgcn_exp2f(-dl);
                    l_run *= alpha;
                    if (h == 0) scal[lq] = alpha;
                    asm volatile("s_waitcnt lgkmcnt(0)" ::: "memory");
#pragma unroll
                    for (int g = 0; g < 4; ++g) {
                        const f32x4 a4 = *(const LAS f32x4*)(scal + 8 * g + 4 * h);
#pragma unroll
                        for (int i = 0; i < 4; ++i) { o[0][4 * g + i] *= a4[i]; o[1][4 * g + i] *= a4[i]; }
                    }
                }
            }
            float ls = 0.f;
#pragma unroll
            for (int r = 0; r < 16; ++r) { p0[r] = __builtin_amdgcn_exp2f(p0[r]); p1[r] = __builtin_amdgcn_exp2f(p1[r]); ls += p0[r] + p1[r]; }
            l_run += ls;
        } else if (MODE == 2 && (64 * t + 63 < U.qpos0 || 64 * t > U.qpos0 + 255)) {
            const bool fwd = 64 * t + 63 < U.qpos0;
            const float A = fwd ? a_f * __builtin_amdgcn_exp2f((float)(U.qpos0 - 64 * t - 63) * U.lf) : a_b * __builtin_amdgcn_exp2f((float)(64 * t - U.qpos0 - 255) * U.lb);
            const LAS float* tb = ctab + (fwd ? 0 : 64) + 4 * h;
#pragma unroll
            for (int g = 0; g < 4; ++g) {
                const f32x4 c0 = *(const LAS f32x4*)(tb + 8 * g), c1 = *(const LAS f32x4*)(tb + 32 + 8 * g);
#pragma unroll
                for (int i = 0; i < 4; ++i) { p0[4 * g + i] *= c0[i] * A; p1[4 * g + i] *= c1[i] * A; }
            }
        } else if (MODE == 2) {
            float dq = (float)(qpos - 64 * t - 4 * h);
            asm volatile("" : "+v"(dq));
#pragma unroll
            for (int r = 0; r < 16; ++r) {
                const float d0 = dq - (float)((r & 3) + 8 * (r >> 2)), d1 = d0 - 32.f;
                const float w0 = __builtin_amdgcn_exp2f(fabsf(d0) * (d0 > 0.f ? U.lf : U.lb));
                const float w1 = __builtin_amdgcn_exp2f(fabsf(d1) * (d1 > 0.f ? U.lf : U.lb));
                p0[r] *= (d0 == 0.f ? 2.f : w0);
                p1[r] *= (d1 == 0.f ? 2.f : w1);
            }
        } else {
            float mb = (float)(64 * t + 4 * h);
            asm volatile("" : "+v"(mb));
#pragma unroll
            for (int r = 0; r < 16; ++r) {
                const float m0 = mb + (float)((r & 3) + 8 * (r >> 2)), m1 = m0 + 32.f;
                const float e0 = fmaf(m0, st_slope, st_off), e1 = fmaf(m1, st_slope, st_off);
                p0[r] *= __builtin_amdgcn_exp2f(e0);
                p1[r] *= __builtin_amdgcn_exp2f(e1);
            }
        }
        bf16x8 pa[4];
        { u32x4 a;
          a.x = pk2(p0[0], p0[1]); a.y = pk2(p0[2], p0[3]); a.z = pk2(p0[4], p0[5]); a.w = pk2(p0[6], p0[7]); pa[0] = __builtin_bit_cast(bf16x8, a);
          a.x = pk2(p0[8], p0[9]); a.y = pk2(p0[10], p0[11]); a.z = pk2(p0[12], p0[13]); a.w = pk2(p0[14], p0[15]); pa[1] = __builtin_bit_cast(bf16x8, a);
          a.x = pk2(p1[0], p1[1]); a.y = pk2(p1[2], p1[3]); a.z = pk2(p1[4], p1[5]); a.w = pk2(p1[6], p1[7]); pa[2] = __builtin_bit_cast(bf16x8, a);
          a.x = pk2(p1[8], p1[9]); a.y = pk2(p1[10], p1[11]); a.z = pk2(p1[12], p1[13]); a.w = pk2(p1[14], p1[15]); pa[3] = __builtin_bit_cast(bf16x8, a); }
#pragma unroll
        for (int ks = 0; ks < 4; ++ks) {
            const bf16x8 vb = __builtin_shufflevector(vlo[ks], vhi[ks], 0, 1, 2, 3, 4, 5, 6, 7);
            o[0] = MFMA32(pa[ks], vb, o[0]);
        }
#pragma unroll
        for (int ks = 0; ks < 4; ++ks) { vlo[ks] = tr16(base + vfo + 4096 + ks * 1024); vhi[ks] = tr16(base + vfo + 4096 + ks * 1024 + 512); }
#pragma unroll
        for (int ks = 0; ks < 4; ++ks) {
            const bf16x8 vb = __builtin_shufflevector(vlo[ks], vhi[ks], 0, 1, 2, 3, 4, 5, 6, 7);
            o[1] = MFMA32(pa[ks], vb, o[1]);
        }
        st = st == 2 ? 0 : st + 1;
    }
#undef AT_ISSUE
#undef AT_DMA
    int lq2 = lq, h2 = h, lane2 = lane; asm volatile("" : "+v"(lq2), "+v"(h2), "+v"(lane2));
    if (MODE == 2 && U.s0f != nullptr) {
        const float ff = __builtin_amdgcn_exp2f((float)(qpos + 1) * U.lf), fb = __builtin_amdgcn_exp2f((float)(U.L - qpos) * U.lb);
#pragma unroll
        for (int s = 0; s < 4; ++s) {
            const u32x4 qu = __builtin_bit_cast(u32x4, qr[s]);
            u32x4 af, ab;
#pragma unroll
            for (int i = 0; i < 4; ++i) { const float lo = bflo(qu[i]), hi = bfhi(qu[i]); af[i] = pk2(lo * ff, hi * ff); ab[i] = pk2(lo * fb, hi * fb); }
#pragma unroll
            for (int d = 0; d < 2; ++d) {
                const bf16x8 sf = *(const bf16x8*)(U.s0f + (size_t)(32 * d + lq2) * 64 + 16 * s + 8 * h2);
                const bf16x8 sb = *(const bf16x8*)(U.s0b + (size_t)(32 * d + lq2) * 64 + 16 * s + 8 * h2);
                o[d] = MFMA32(__builtin_bit_cast(bf16x8, af), sf, o[d]);
                o[d] = MFMA32(__builtin_bit_cast(bf16x8, ab), sb, o[d]);
            }
        }
    }
    if (MODE == 3) {
        float* dst = U.st_out + (size_t)sdir * 4 * 4096 + (size_t)(32 * (w & 1)) * 64;
        if (w < 4) {
#pragma unroll
        for (int d = 0; d < 2; ++d)
#pragma unroll
            for (int r = 0; r < 16; ++r) dst[(size_t)((r & 3) + 8 * (r >> 2) + 4 * h2) * 64 + 32 * d + lq2] = o[d][r];
        }
        __syncthreads();
        if (F.tid == 0 && U.yflag != nullptr) (void)xb_add(U.yflag, 1u);
        return;
    }
    if (MODE <= 1) {
        l_run += __shfl_xor(l_run, 32);
        if (h2 == 0) scal[lq2] = 1.f / l_run;
    }
    if (U.zflag != nullptr && F.tid == 0) {
        unsigned* bar0 = (unsigned*)(F.ws + WS_CTL) + CW_BAR;
        XB_SPIN(xb_ld(U.zflag) < 4u, bar0);
    }
    __syncthreads();
    LAS float* ost = (LAS float*)lds + w * (32 * AT_OLD);
#pragma unroll
    for (int d = 0; d < 2; ++d)
#pragma unroll
        for (int r = 0; r < 16; ++r) ost[((r & 3) + 8 * (r >> 2) + 4 * h2) * AT_OLD + 32 * d + lq2] = o[d][r];
    asm volatile("s_waitcnt lgkmcnt(0)" ::: "memory");
    __builtin_amdgcn_wave_barrier();
    const bf16_t* zs = (const bf16_t*)(F.ws + WS_ZS);
    bf16_t* yb = (bf16_t*)(F.ws + WS_Y);
#pragma unroll
    for (int it = 0; it < 4; ++it) {
        const int row = it * 8 + (lane2 >> 3), c8 = (lane2 & 7) * 8;
        const f32x4 x0 = *(const LAS f32x4*)(ost + row * AT_OLD + c8), x1 = *(const LAS f32x4*)(ost + row * AT_OLD + c8 + 4);
        float sc;
        if (MODE <= 1) sc = scal[row];
        else {
            float ss = (x0[0] * x0[0] + x0[1] * x0[1]) + (x0[2] * x0[2] + x0[3] * x0[3]) + (x1[0] * x1[0] + x1[1] * x1[1]) + (x1[2] * x1[2] + x1[3] * x1[3]);
            ss += __shfl_xor(ss, 1); ss += __shfl_xor(ss, 2); ss += __shfl_xor(ss, 4);
            sc = rsqrtf(ss * (1.f / 64.f) + EPS);
        }
        const size_t off = (size_t)(U.tok0 + 32 * w + row) * 1024 + U.ycol + c8;
        const u32x4 z = *(const u32x4*)(zs + off);
        u32x4 y;
        y.x = pk2(x0[0] * sc * bflo(z.x), x0[1] * sc * bfhi(z.x));
        y.y = pk2(x0[2] * sc * bflo(z.y), x0[3] * sc * bfhi(z.y));
        y.z = pk2(x1[0] * sc * bflo(z.z), x1[1] * sc * bfhi(z.z));
        y.w = pk2(x1[2] * sc * bflo(z.w), x1[3] * sc * bfhi(z.w));
        ST16_WT(yb + off, y);
    }
    asm volatile("s_waitcnt vmcnt(0)" ::: "memory");
    __syncthreads();
    if (F.tid == 0) (void)xb_add(U.yflag, 1u);
}

__device__ __forceinline__ void dep_wait(const Frame& F, unsigned* c, int n, unsigned target, unsigned* c2 = nullptr, unsigned target2 = 0u) {
    if (F.w == 0) {
        const int ln = lane_id();
        unsigned* ptr = c + 4 * ln; unsigned tgt = target;
        if (c2 != nullptr && ln == n) { ptr = c2; tgt = target2; }
        poll_lanes(ptr, tgt, ln < n + (c2 != nullptr ? 1 : 0), (unsigned*)(F.ws + WS_CTL) + CW_BAR);
    }
}
__device__ __forceinline__ void attn_dispatch(const Frame& F, const Params& p, int u, int l) {
    unsigned char* ws = F.ws;
    AttnUnit U;
    U.nt0 = 0; U.nt1 = 0; U.q = nullptr; U.q_ld = 0; U.k0 = U.k1 = nullptr; U.k_ld0 = U.k_ld1 = 0; U.pe0 = U.pe1 = nullptr; U.v0 = U.v1 = nullptr; U.v_ld0 = U.v_ld1 = 0;
    U.tok0 = 0; U.ycol = 0; U.qpos0 = 0; U.L = 0; U.lf = U.lb = 0.f; U.s0f = U.s0b = nullptr; U.st_out = nullptr; U.mode = 0; U.yflag = nullptr; U.zflag = nullptr;
    const bf16_t* GQ = (const bf16_t*)(ws + WS_GQ); const bf16_t* GK = (const bf16_t*)(ws + WS_GK); const bf16_t* GV = (const bf16_t*)(ws + WS_GV);
    const bf16_t* QM = (const bf16_t*)(ws + WS_QM); const bf16_t* KVM = (const bf16_t*)(ws + WS_KVM); const bf16_t* KVMC = (const bf16_t*)(ws + WS_KVMC);
    const bf16_t* KPEB = (const bf16_t*)(ws + WS_KPEB); const bf16_t* CKPE = (const bf16_t*)(ws + WS_CKPE);
    const bf16_t* CGK = (const bf16_t*)(ws + WS_CGK); const bf16_t* CGV = (const bf16_t*)(ws + WS_CGV);
    const bf16_t* RQ = (const bf16_t*)(ws + WS_RQ); const bf16_t* RK = (const bf16_t*)(ws + WS_RK); const bf16_t* RV = (const bf16_t*)(ws + WS_RV);
    const float* decay = pin(F, I_DECAY) + l * 8;
    if (u < 96 || (u >= 256 && u < 352)) {
        const bool lat = u < 96; const int uu = lat ? u : u - 256;
        const int b = lat ? uu / 24 : uu / 6, hh = lat ? (uu >> 2) % 6 : uu % 6, qb = lat ? (uu & 3) : 0;
        const int seq0 = lat ? 4096 + b * 1024 : b * 256;
        U.mode = 1; U.tok0 = seq0 + qb * 256; U.q = QM + (size_t)U.tok0 * 576 + hh * 96; U.q_ld = 576; U.ycol = 640 + hh * 64;
        U.nt1 = lat ? 16 : 4; U.k1 = KVM + (size_t)seq0 * 768 + hh * 128; U.k_ld1 = 768; U.v1 = U.k1 + 64; U.v_ld1 = 768; U.pe1 = KPEB + (size_t)seq0 * 32;
        U.k0 = U.k1; U.v0 = U.v1; U.pe0 = U.pe1; U.k_ld0 = 768; U.v_ld0 = 768;
        if (lat) { U.nt0 = 8; U.k0 = KVMC + (size_t)(b * 512) * 768 + hh * 128; U.v0 = U.k0 + 64; U.pe0 = CKPE + (size_t)((b * 4 + l) * 512) * 32; }
        U.yflag = (unsigned*)(ws + WS_CTL) + CW_YRDY + (l * 32 + (U.tok0 >> 8)) * 4;
        { unsigned* c = (unsigned*)(ws + WS_CTL);
          dep_wait(F, c + CW_FULL + (l * 32 + (seq0 >> 8)) * 4, lat ? 4 : 1, 23u, lat ? c + CW_KC + (l * 4 + b) * 4 : nullptr, 12u); }
        __syncthreads();
        attn_unit<1>(F, p, U);
    } else if (u < 192 || (u >= 352 && u < 448)) {
        const bool lat = u < 192; const int uu = lat ? u - 96 : u - 352;
        const int b = lat ? uu / 24 : uu / 6, hh = lat ? (uu >> 2) % 6 : uu % 6, qb = lat ? (uu & 3) : 0, kvh = hh / 3;
        const int seq0 = lat ? 4096 + b * 1024 : b * 256;
        U.mode = 0; U.tok0 = seq0 + qb * 256; U.q = GQ + (size_t)U.tok0 * 384 + hh * 64; U.q_ld = 384; U.ycol = 256 + hh * 64;
        U.nt1 = lat ? 16 : 4; U.k1 = GK + (size_t)seq0 * 128 + kvh * 64; U.k_ld1 = 128; U.v1 = GV + (size_t)seq0 * 128 + kvh * 64; U.v_ld1 = 128;
        U.k0 = U.k1; U.v0 = U.v1; U.k_ld0 = 128; U.v_ld0 = 128;
        if (lat) { U.nt0 = 8; U.k0 = CGK + (size_t)((b * 4 + l) * 512) * 128 + kvh * 64; U.v0 = CGV + (size_t)((b * 4 + l) * 512) * 128 + kvh * 64; }
        U.yflag = (unsigned*)(ws + WS_CTL) + CW_YRDY + (l * 32 + (U.tok0 >> 8)) * 4;
        { unsigned* c = (unsigned*)(ws + WS_CTL);
          dep_wait(F, c + CW_RA + (l * 32 + (seq0 >> 8)) * 4, lat ? 4 : 1, 8u);
          U.zflag = c + CW_ZC + (l * 32 + (U.tok0 >> 8)) * 4; }
        __syncthreads();
        attn_unit<0>(F, p, U);
    } else if (u < 256 || (u >= 448 && u < 512)) {
        const bool lat = u < 256; const int uu = lat ? u - 192 : u - 448;
        const int b = lat ? uu / 16 : uu / 4, hh = lat ? (uu >> 2) & 3 : uu & 3, qb = lat ? (uu & 3) : 0;
        const int seq0 = lat ? 4096 + b * 1024 : b * 256;
        U.mode = 2; U.tok0 = seq0 + qb * 256; U.q = RQ + (size_t)U.tok0 * 256 + hh * 64; U.q_ld = 256; U.ycol = hh * 64;
        U.nt1 = lat ? 16 : 4; U.k1 = RK + (size_t)seq0 * 256 + hh * 64; U.k_ld1 = 256; U.v1 = RV + (size_t)seq0 * 256 + hh * 64; U.v_ld1 = 256;
        U.k0 = U.k1; U.v0 = U.v1; U.k_ld0 = 256; U.v_ld0 = 256;
        U.qpos0 = qb * 256; U.L = lat ? 1024 : 256;
        U.lf = -log1pf(__expf(-decay[hh])) * LOG2E; U.lb = -log1pf(__expf(-decay[4 + hh])) * LOG2E;
        if (lat) { const bf16_t* S0T = (const bf16_t*)(ws + WS_S0T); U.s0f = S0T + (size_t)(((b * 4 + l) * 2 + 0) * 4 + hh) * 4096; U.s0b = S0T + (size_t)(((b * 4 + l) * 2 + 1) * 4 + hh) * 4096; }
        U.yflag = (unsigned*)(ws + WS_CTL) + CW_YRDY + (l * 32 + (U.tok0 >> 8)) * 4;
        { unsigned* c = (unsigned*)(ws + WS_CTL);
          dep_wait(F, c + CW_RA + (l * 32 + (seq0 >> 8)) * 4, lat ? 4 : 1, 8u);
          U.zflag = c + CW_ZC + (l * 32 + (U.tok0 >> 8)) * 4; }
        __syncthreads();
        attn_unit<2>(F, p, U);
    } else {
        const int uu = u - 512, b = uu >> 2, hh = uu & 3, seq0 = b * 256;
        U.mode = 3; U.nt1 = 4; U.k1 = RK + (size_t)seq0 * 256 + hh * 64; U.k_ld1 = 256; U.v1 = RV + (size_t)seq0 * 256 + hh * 64; U.v_ld1 = 256;
        U.k0 = U.k1; U.v0 = U.v1; U.k_ld0 = 256; U.v_ld0 = 256;
        U.lf = -log1pf(__expf(-decay[hh])) * LOG2E; U.lb = -log1pf(__expf(-decay[4 + hh])) * LOG2E;
        U.st_out = p.out + O_STATE + (size_t)(((b * 4 + l) * 2 + 0) * 4 + hh) * 4096;
        dep_wait(F, (unsigned*)(ws + WS_CTL) + CW_RA + (l * 32 + b) * 4, 1, 8u);
        U.yflag = (unsigned*)(ws + WS_CTL) + CW_SD + (l * 16 + b) * 4;
        __syncthreads();
        attn_unit<3>(F, p, U);
    }
}
constexpr int N_ATTN_UNITS = 576;
struct TItem { const float* src; bf16_t* dst; int nsrc, K; int valid; };
constexpr int P0_TWIN = 4 * 16 * 92, P0_TWOUT = 4 * 16 * 32, P0_TWUQ = 4 * 4 * 20, P0_TWUKV = 4 * 2 * 24, P0_TR = P0_TWIN + P0_TWOUT + P0_TWUQ + P0_TWUKV;
__device__ __forceinline__ TItem p0_titem(const Frame& F, unsigned char* ws, int it) {
    TItem t; t.valid = it < P0_TR; t.src = nullptr; t.dst = nullptr; t.nsrc = 0; t.K = 0;
    if (!t.valid) return t;
    if (it < P0_TWIN) {
        const int l = it / (16 * 92), r = it % (16 * 92), kb = r / 92, nb = r % 92, n0 = nb * 32;
        const int src = n0 < 1792 ? n0 : (n0 < 2816 ? n0 + 32 : (n0 < 2848 ? n0 - 2816 + 1792 : -1));
        t.nsrc = 2848; t.K = 1024;
        if (src >= 0) t.src = pin(F, I_WIN) + (size_t)l * 1024 * 2848 + (size_t)(kb * 64) * 2848 + src;
        t.dst = (bf16_t*)(ws + WS_WIN) + ((size_t)l * 2944 + n0) * 1024 + kb * 64;
        return t;
    }
    it -= P0_TWIN;
    if (it < P0_TWOUT) {
        const int l = it / 512, r = it % 512, kb = r >> 5, nb = r & 31;
        t.nsrc = 1024; t.K = 1024; t.src = pin(F, I_WOUT) + (size_t)l * 1024 * 1024 + (size_t)(kb * 64) * 1024 + nb * 32;
        t.dst = (bf16_t*)(ws + WS_WOUT) + ((size_t)l * 1024 + nb * 32) * 1024 + kb * 64;
        return t;
    }
    it -= P0_TWOUT;
    if (it < P0_TWUQ) {
        const int l = it / 80, r = it % 80, kb = r / 20, nb = r % 20;
        t.nsrc = 576; t.K = 256; if (nb < 18) t.src = pin(F, I_WUQ) + (size_t)l * 256 * 576 + (size_t)(kb * 64) * 576 + nb * 32;
        t.dst = (bf16_t*)(ws + WS_WUQ) + ((size_t)l * 640 + nb * 32) * 256 + kb * 64;
        return t;
    }
    it -= P0_TWUQ;
    { const int l = it / 48, r = it % 48, kb = r / 24, nb = r % 24;
      t.nsrc = 768; t.K = 128; t.src = pin(F, I_WUKV) + (size_t)l * 128 * 768 + (size_t)(kb * 64) * 768 + nb * 32;
      t.dst = (bf16_t*)(ws + WS_WUKV) + ((size_t)l * 768 + nb * 32) * 128 + kb * 64; }
    return t;
}
__device__ __forceinline__ void p0_tload(const TItem& t, float (&r)[32], int lane) {
    if (t.valid && t.src) {
        const float* wp = t.src + (size_t)(lane >> 5) * t.nsrc + (lane & 31);
#pragma unroll
        for (int i = 0; i < 32; ++i) r[i] = __builtin_nontemporal_load(wp + (size_t)(2 * i) * t.nsrc);
    } else {
#pragma unroll
        for (int i = 0; i < 32; ++i) r[i] = 0.f;
    }
}
__device__ __forceinline__ void p0_tstore(const TItem& t, const float (&r)[32], LAS float* scr, int lane) {
    if (!t.valid) return;
#pragma unroll
    for (int i = 0; i < 32; ++i) scr[(2 * i + (lane >> 5)) * 33 + (lane & 31)] = r[i];
    asm volatile("s_waitcnt lgkmcnt(0)" ::: "memory");
    __builtin_amdgcn_wave_barrier();
    const int c = lane & 7;
#pragma unroll
    for (int j = 0; j < 4; ++j) {
        const int n = (lane >> 3) + 8 * j; const LAS float* s = scr + (8 * c) * 33 + n;
        u32x4 o; o.x = pk2(s[0 * 33], s[1 * 33]); o.y = pk2(s[2 * 33], s[3 * 33]); o.z = pk2(s[4 * 33], s[5 * 33]); o.w = pk2(s[6 * 33], s[7 * 33]);
        ST16_WT(t.dst + (size_t)n * t.K + 8 * c, o);
    }
    asm volatile("s_waitcnt lgkmcnt(0)" ::: "memory");
    __builtin_amdgcn_wave_barrier();
}
__device__ __forceinline__ void cast8(const float* src, bf16_t* dst, size_t e) {
    const f32x4 a = *(const f32x4*)(src + e), b = *(const f32x4*)(src + e + 4);
    u32x4 o; o.x = pk2(a[0], a[1]); o.y = pk2(a[2], a[3]); o.z = pk2(b[0], b[1]); o.w = pk2(b[2], b[3]);
    ST16_WT(dst + e, o);
}
constexpr int P0_MODS = 1536, P0_CAST_G = 512, P0_CAST_KPE = 128, P0_S0T = 512;
constexpr int P0_TOTAL = P0_MODS + 3 * P0_CAST_G + P0_CAST_KPE + P0_S0T;
__device__ __forceinline__ void phase0(const Frame& F, const Params& p, bool dup = false) {
    unsigned char* ws = F.ws + (dup ? 162 * MiB : 0); const int lane = F.lane;
    LAS float* scr = (LAS float*)F.lds + F.w * (64 * 33);
    const int gw = blockIdx.x * NWAVE + F.w, ngw = gridDim.x * NWAVE;
#ifndef MK_DUP0
#define MK_DUP0_ 0
#else
#define MK_DUP0_ MK_DUP0
#endif
    if (!(dup && MK_DUP0_ == 2))
    for (int it = gw; it < P0_TR; it += 2 * ngw) {
        const TItem t0 = p0_titem(F, ws, it), t1 = p0_titem(F, ws, it + ngw);
        float r0[32], r1[32];
        p0_tload(t0, r0, lane); p0_tload(t1, r1, lane);
        p0_tstore(t0, r0, scr, lane); p0_tstore(t1, r1, scr, lane);
    }
    if (!(dup && MK_DUP0_ == 1))
    for (int it0 = (gw + ngw - 256) % ngw; it0 < P0_TOTAL; it0 += ngw) {
        int it = it0;
        if (it < P0_MODS) {
            const int l = it / 384, cg = (it % 384) >> 5, ks = it & 31;
            const int j = cg * 256 + lane * 4;
            const float* wp = pin(F, I_WADA) + ((size_t)l * 1024 + ks * 32) * 3072 + j;
            const float* c = pin(F, I_C); const float* cc = pin(F, I_CCTX);
            float sv[3];
#pragma unroll
            for (int q = 0; q < 3; ++q) {
                const int idx = q * 64 + lane, n = idx >> 5, k = idx & 31;
                float x = 0.f;
                if (idx < 160) x = (n == 0) ? cc[ks * 32 + k] : c[(n - 1) * 1024 + ks * 32 + k];
                sv[q] = silu_f(x);
            }
            f32x4 acc[5];
#pragma unroll
            for (int n = 0; n < 5; ++n) acc[n] = (f32x4){0.f, 0.f, 0.f, 0.f};
#pragma unroll 1
            for (int k0 = 0; k0 < 32; k0 += 16) {
                f32x4 wv[16];
#pragma unroll
                for (int k = 0; k < 16; ++k) wv[k] = __builtin_nontemporal_load((const f32x4*)(wp + (size_t)(k0 + k) * 3072));
                __builtin_amdgcn_sched_barrier(0);
#pragma unroll
                for (int k = 0; k < 16; ++k)
#pragma unroll
                    for (int n = 0; n < 5; ++n) {
                        const float s = __int_as_float(__builtin_amdgcn_readlane(__float_as_int(sv[n >> 1]), 32 * (n & 1) + k0 + k));
                        acc[n] += wv[k] * s;
                    }
            }
            LAS f32x4* red = (LAS f32x4*)(F.lds + 69632);
#pragma unroll
            for (int n = 0; n < 5; ++n) red[(F.w * 5 + n) * 64 + lane] = acc[n];
            __syncthreads();
            if (F.tid < 320) {
                const int n = F.tid >> 6;
                f32x4 s = red[n * 64 + lane];
#pragma unroll
                for (int ww = 1; ww < 8; ++ww) s += red[(ww * 5 + n) * 64 + lane];
                if ((ks >> 3) == 0) s += *(const f32x4*)(pin(F, I_BADA) + l * 3072 + j);
                float* mods = (float*)(ws + WS_MODS) + (size_t)(l * 5 + n) * 3072 + j;
#pragma unroll
                for (int e = 0; e < 4; ++e) atomicAdd(mods + e, s[e]);
            }
            __syncthreads();
            continue;
        }
        it -= P0_MODS;
        if (it < 3 * P0_CAST_G) {
            const int which = it / P0_CAST_G, r = it % P0_CAST_G;
            const float* src = which == 0 ? pin(F, I_CGK) : (which == 1 ? pin(F, I_CGV) : pin(F, I_CCKV));
            bf16_t* dst = (bf16_t*)(ws + (which == 0 ? WS_CGK : (which == 1 ? WS_CGV : WS_CCKV)));
#pragma unroll
            for (int q = 0; q < 4; ++q) cast8(src, dst, (size_t)r * 2048 + q * 512 + lane * 8);
            continue;
        }
        it -= 3 * P0_CAST_G;
        if (it < P0_CAST_KPE) {
#pragma unroll
            for (int q = 0; q < 4; ++q) cast8(pin(F, I_CKPE), (bf16_t*)(ws + WS_CKPE), (size_t)it * 2048 + q * 512 + lane * 8);
            continue; }
        it -= P0_CAST_KPE;
        {
            const int mat = it >> 2, qd = it & 3, dv = qd * 16 + (lane >> 2), dk0 = (lane & 3) * 16;
            const float* s = pin(F, I_STATE) + (size_t)mat * 4096 + dv;
            float x[16];
#pragma unroll
            for (int i = 0; i < 16; ++i) x[i] = s[(dk0 + i) * 64];
            u32x4 o0, o1;
            o0.x = pk2(x[0], x[1]); o0.y = pk2(x[2], x[3]); o0.z = pk2(x[4], x[5]); o0.w = pk2(x[6], x[7]);
            o1.x = pk2(x[8], x[9]); o1.y = pk2(x[10], x[11]); o1.z = pk2(x[12], x[13]); o1.w = pk2(x[14], x[15]);
            bf16_t* d = (bf16_t*)(ws + WS_S0T) + (size_t)mat * 4096 + dv * 64 + dk0;
            ST16_WT(d, o0); ST16_WT(d + 8, o1);
        }
    }
}
constexpr int P1_GS = 80, P1_BIAS = 4 * 368, P1_X = 8192, P1_TOTAL = P1_GS + P1_BIAS + P1_X;
__device__ __forceinline__ void xg_row(const Frame& F, const float* xrow, const float* g, const float* mods_c, bf16_t* xg_row_out, float* ssq_row, bool write_xg) {
    const int lane = F.lane;
    float ss = 0.f;
#pragma unroll
    for (int j = 0; j < 2; ++j) {
        const int k = j * 512 + lane * 8;
        const f32x4 x0 = *(const f32x4*)(xrow + k), x1 = *(const f32x4*)(xrow + k + 4);
        ss += ((x0[0] * x0[0] + x0[1] * x0[1]) + (x0[2] * x0[2] + x0[3] * x0[3])) + ((x1[0] * x1[0] + x1[1] * x1[1]) + (x1[2] * x1[2] + x1[3] * x1[3]));
        if (write_xg) {
            const f32x4 g0 = *(const f32x4*)(g + k), g1 = *(const f32x4*)(g + k + 4), s0 = *(const f32x4*)(mods_c + 1024 + k), s1 = *(const f32x4*)(mods_c + 1024 + k + 4);
            u32x4 o; o.x = pk2(x0[0] * g0[0] * (1.f + s0[0]), x0[1] * g0[1] * (1.f + s0[1])); o.y = pk2(x0[2] * g0[2] * (1.f + s0[2]), x0[3] * g0[3] * (1.f + s0[3]));
            o.z = pk2(x1[0] * g1[0] * (1.f + s1[0]), x1[1] * g1[1] * (1.f + s1[1])); o.w = pk2(x1[2] * g1[2] * (1.f + s1[2]), x1[3] * g1[3] * (1.f + s1[3]));
            ST16_WT(xg_row_out + k, o);
        }
    }
    ss = wsum(ss);
    if (lane < 16) ssq_row[lane] = lane == 0 ? ss : 0.f;
}
__device__ __forceinline__ void phase1(const Frame& F, const Params& p) {
    unsigned char* ws = F.ws; const int lane = F.lane;
    unsigned* ctl = (unsigned*)(ws + WS_CTL);
    const int gw = blockIdx.x * NWAVE + F.w, ngw = gridDim.x * NWAVE;
    const float* mods = (const float*)(ws + WS_MODS);
    for (int it0 = gw; it0 < P1_GS + P1_BIAS; it0 += ngw) {
        int it = it0;
        if (it < P1_GS) {
            const int e = it * 256 + lane * 4, lc = e >> 10, k = e & 1023, l = lc / 5;
            const f32x4 g = *(const f32x4*)(pin(F, I_NORMG) + l * 1024 + k), sc = *(const f32x4*)(mods + (size_t)lc * 3072 + 1024 + k);
            { const f32x4 o = g * (sc + 1.f); ST16_WT((float*)(ws + WS_GS) + e, o); }
            continue;
        }
        it -= P1_GS;
        {
            const int l = it / 368, n0 = (it % 368) * 8;
            f32x4 sh[5][4];
#pragma unroll
            for (int c = 0; c < 5; ++c) {
                const float* shp = mods + (size_t)(l * 5 + c) * 3072 + lane * 16;
#pragma unroll
                for (int i = 0; i < 4; ++i) sh[c][i] = *(const f32x4*)(shp + 4 * i);
            }
            const bf16_t* wr0 = (const bf16_t*)(ws + WS_WIN) + ((size_t)l * 2944 + n0) * 1024 + lane * 16;
            u32x4 w0[8], w1[8];
#pragma unroll
            for (int r = 0; r < 8; ++r) { w0[r] = *(const u32x4*)(wr0 + (size_t)r * 1024); w1[r] = *(const u32x4*)(wr0 + (size_t)r * 1024 + 8); }
#pragma unroll
            for (int r = 0; r < 8; ++r) {
                float wv[16];
#pragma unroll
                for (int i = 0; i < 4; ++i) { wv[2 * i] = bflo(w0[r][i]); wv[2 * i + 1] = bfhi(w0[r][i]); wv[8 + 2 * i] = bflo(w1[r][i]); wv[8 + 2 * i + 1] = bfhi(w1[r][i]); }
#pragma unroll
                for (int c = 0; c < 5; ++c) {
                    float d = 0.f;
#pragma unroll
                    for (int i = 0; i < 4; ++i) { const f32x4 s4 = sh[c][i]; d += (s4[0] * wv[4 * i] + s4[1] * wv[4 * i + 1]) + (s4[2] * wv[4 * i + 2] + s4[3] * wv[4 * i + 3]); }
                    d = wsum(d);
                    if (lane == 0) __hip_atomic_store((__attribute__((address_space(1))) float*)((float*)(ws + WS_BIAS) + (size_t)(l * 5 + c) * 2944 + n0 + r), d, __ATOMIC_RELAXED, __HIP_MEMORY_SCOPE_AGENT);
                }
            }
            if (l == 0) {
                asm volatile("s_waitcnt vmcnt(0)" ::: "memory");
                if (lane == 0) (void)xb_add(ctl + CW_P1B0, 1u);
            }
        }
    }
    for (int vb = blockIdx.x; vb < 256; vb += gridDim.x) {
        const int tm = vb & 31, part = vb >> 5;
        const bool lat = tm >= 16;
        const int cond = lat ? 1 + ((tm - 16) >> 2) : 0;
        const float* g = pin(F, I_NORMG); const float* sc = mods + (size_t)cond * 3072 + 1024;
#pragma unroll 1
        for (int i = 0; i < 4; i += 2) {
            const int tok = tm * 256 + part * 32 + F.w * 4 + i;
            const float* xa = lat ? pin(F, I_XS) + (size_t)(tok - 4096) * 1024 : pin(F, I_XP) + (size_t)tok * 1024;
            const float* xb = xa + 1024;
            bf16_t* oa = (bf16_t*)(ws + WS_XG) + (size_t)tok * 1024;
            float ssa = 0.f, ssb = 0.f;
#pragma unroll
            for (int j = 0; j < 2; ++j) {
                const int k = j * 512 + lane * 8;
                const f32x4 a0 = *(const f32x4*)(xa + k), a1 = *(const f32x4*)(xa + k + 4), b0 = *(const f32x4*)(xb + k), b1 = *(const f32x4*)(xb + k + 4);
                const f32x4 g0 = *(const f32x4*)(g + k), g1 = *(const f32x4*)(g + k + 4), s0 = *(const f32x4*)(sc + k), s1 = *(const f32x4*)(sc + k + 4);
                const f32x4 m0 = g0 * (s0 + 1.f), m1 = g1 * (s1 + 1.f);
                ssa += ((a0[0] * a0[0] + a0[1] * a0[1]) + (a0[2] * a0[2] + a0[3] * a0[3])) + ((a1[0] * a1[0] + a1[1] * a1[1]) + (a1[2] * a1[2] + a1[3] * a1[3]));
                ssb += ((b0[0] * b0[0] + b0[1] * b0[1]) + (b0[2] * b0[2] + b0[3] * b0[3])) + ((b1[0] * b1[0] + b1[1] * b1[1]) + (b1[2] * b1[2] + b1[3] * b1[3]));
                u32x4 o; o.x = pk2(a0[0] * m0[0], a0[1] * m0[1]); o.y = pk2(a0[2] * m0[2], a0[3] * m0[3]); o.z = pk2(a1[0] * m1[0], a1[1] * m1[1]); o.w = pk2(a1[2] * m1[2], a1[3] * m1[3]);
                ST16_WT(oa + k, o);
                o.x = pk2(b0[0] * m0[0], b0[1] * m0[1]); o.y = pk2(b0[2] * m0[2], b0[3] * m0[3]); o.z = pk2(b1[0] * m1[0], b1[1] * m1[1]); o.w = pk2(b1[2] * m1[2], b1[3] * m1[3]);
                ST16_WT(oa + 1024 + k, o);
            }
            ssa = wsum(ssa); ssb = wsum(ssb);
            if (lane < 32) {
                const float v = (lane & 15) == 0 ? (lane < 16 ? ssa : ssb) : 0.f;
                __hip_atomic_store((__attribute__((address_space(1))) float*)((float*)(ws + WS_SSQ) + (size_t)(tok + (lane >> 4)) * 16 + (lane & 15)), v, __ATOMIC_RELAXED, __HIP_MEMORY_SCOPE_AGENT);
            }
        }
        asm volatile("s_waitcnt vmcnt(0)" ::: "memory");
        __syncthreads();
        if (is_t0(F)) (void)xb_add(ctl + CW_P1X + tm * 4, 1u);
    }
    asm volatile("s_waitcnt vmcnt(0)" ::: "memory");
    __syncthreads();
    if (is_t0(F)) (void)xb_add(ctl + CW_P1DONE, 1u);
}
#ifndef MK_TIMING
#define MK_TIMING -1
#endif
constexpr int CW_TIME = 2048;
__device__ __forceinline__ void phase_final(const Frame& F, const Params& p) {
    const int lane = F.lane;
    float tf = 1.f;
    if (MK_TIMING >= 0) tf = __uint_as_float(__hip_atomic_load((unsigned*)(F.ws + WS_CTL) + CW_TIME, __ATOMIC_RELAXED, __HIP_MEMORY_SCOPE_AGENT));
    unsigned* ctl = (unsigned*)(F.ws + WS_CTL);
    for (int vb = blockIdx.x; vb < 256; vb += gridDim.x) {
        const int tm = vb & 31, part = vb >> 5;
        if (F.tid == 0) {
            XB_SPIN(xb_ld(ctl + CW_XRDY + tm * 4) < 8u, ctl + CW_BAR);
            __builtin_amdgcn_fence(__ATOMIC_ACQUIRE, "agent");
            asm volatile("s_waitcnt vmcnt(0)" ::: "memory");
        }
        __syncthreads();
#pragma unroll 1
        for (int i = 0; i < 4; ++i) {
            const int tok = tm * 256 + part * 32 + F.w * 4 + i;
            float ss = 0.f;
            if (lane < 16) ss = ((const float*)(F.ws + WS_SSQ))[(size_t)tok * 16 + lane];
            ss = wsum(ss);
            const float rstd = rsqrtf(ss * (1.f / 1024.f) + EPS);
            const bf16_t* xr = (const bf16_t*)(F.ws + WS_XB) + (size_t)tok * 1024; float* orow = p.out + (size_t)tok * 1024;
#pragma unroll
            for (int j = 0; j < 4; ++j) {
                const int k = j * 256 + lane * 4;
                const u32x2 xq = *(const u32x2*)(xr + k);
                const f32x4 x = {bflo(xq.x), bfhi(xq.x), bflo(xq.y), bfhi(xq.y)}, fn = *(const f32x4*)(pin(F, I_FNORM) + k);
                { const f32x4 o = x * fn * (rstd * tf); ST16_WT(orow + k, o); }
            }
        }
    }
}

__device__ __forceinline__ GemmOp a2_op(const Frame& F, int l, int j) {
    GemmOp g;
    if (j < 160) { const int tn = j >> 5, tm = j & 31; g.W = (const bf16_t*)(F.ws + WS_WUQ) + ((size_t)l * 640 + tn * 128) * 256; g.X = (const bf16_t*)(F.ws + WS_CQG) + (size_t)tm * 256 * 256; g.ldw = 256; g.ldx = 256; g.K = 256; }
    else if (j < 352) { const int jj = j - 160, tn = jj >> 5, tm = jj & 31; g.W = (const bf16_t*)(F.ws + WS_WUKV) + ((size_t)l * 768 + tn * 128) * 128; g.X = (const bf16_t*)(F.ws + WS_CKVN) + (size_t)tm * 256 * 128; g.ldw = 128; g.ldx = 128; g.K = 128; }
    else { const int jj = j - 352, tn = jj >> 3, tc = jj & 7, b = tc >> 1, jt = tc & 1; g.W = (const bf16_t*)(F.ws + WS_WUKV) + ((size_t)l * 768 + tn * 128) * 128;
           g.X = (const bf16_t*)(F.ws + WS_CCKV) + ((size_t)(b * 4 + l) * 512 + jt * 256) * 128; g.ldw = 128; g.ldx = 128; g.K = 128; }
    return g;
}
__device__ __forceinline__ int a2_item(int vb, int i) {
    const int c = (vb >> 5) - 4, tmw = vb & 31;
    if (i == 3) return 352 + 32 + tmw;
    if (c == 0) return i * 32 + tmw;
    if (c == 1) return i < 2 ? (3 + i) * 32 + tmw : 160 + tmw;
    if (c == 2) return 160 + (1 + i) * 32 + tmw;
    return i < 2 ? 160 + (4 + i) * 32 + tmw : 352 + tmw;
}
#ifndef MK_EN
#define MK_EN 0xff
#endif
#define EN(x) ((MK_EN >> (x)) & 1)
constexpr int PH_TOTAL = 19;
__global__ void __launch_bounds__(512, 2) mega(Params p) {
    extern __shared__ __attribute__((aligned(16))) unsigned char lds_raw[];
    Frame F;
    F.lds = (LAS unsigned char*)lds_raw;
    F.tid = threadIdx.x; F.lane = F.tid & 63; F.w = __builtin_amdgcn_readfirstlane(F.tid >> 6); F.h = F.lane >> 5; F.lq = F.lane & 31;
    F.ws = p.ws;
    F.karg = (karg_t)__builtin_amdgcn_kernarg_segment_ptr();
    volatile LAS unsigned* MISC = (volatile LAS unsigned*)(F.lds + LDS_MISC);
    if (F.tid < 64) MISC[F.tid] = 0u;
    __syncthreads();
    unsigned* ctl = (unsigned*)(p.ws + WS_CTL);
    XcdBarrier bar; bar.bar = ctl + CW_BAR; bar.x = 0; bar.st = nullptr;
    const bool multi = p.ph_hi - p.ph_lo > 1;
    if (multi) bar = xcd_barrier_post(ctl + CW_BAR, MISC + 8);
    bar.w = F.w;
    const int G = gridDim.x;
    const Frame F0 = F;
    for (int ph = p.ph_lo; ph < p.ph_hi; ++ph) {
        if (ph >= 2 && ph < 18 && ((ph - 2) & 3) == 1) continue;
        Frame F = F0;
        F.lane = (int)__builtin_amdgcn_mbcnt_hi(~0u, __builtin_amdgcn_mbcnt_lo(~0u, 0u));
        asm volatile("" : "+v"(F.lane));
        F.tid = (F.w << 6) | F.lane; F.h = F.lane >> 5; F.lq = F.lane & 31;
        asm volatile("" : "+s"(F.w), "+s"(F.ws), "+s"(F.karg));
        if (MK_TIMING >= 0 && blockIdx.x == 0 && F.tid == 0) {
            const unsigned long long now = __builtin_amdgcn_s_memrealtime();
            const unsigned long long prev = ((unsigned long long)MISC[17] << 32) | MISC[16];
            if (ph > p.ph_lo) { const int q = ph - 1; const int grp = q < 2 ? q : 2 + ((q - 2) & 3); if (grp == MK_TIMING) MISC[18] += (unsigned)(now - prev); }
            MISC[16] = (unsigned)now; MISC[17] = (unsigned)(now >> 32);
        }
#ifndef MK_REPEAT
#define MK_REPEAT -1
#endif
        int nrep = 1;
        if (MK_REPEAT >= 1) { const int grp = ph < 2 ? ph : (ph == 18 ? 6 : 2 + ((ph - 2) & 3)); if (grp == MK_REPEAT) nrep = (grp == 5) ? (ph == 5 ? 5 : 1) : 2; }
        for (int rep = 0; rep < nrep; ++rep) {
        if (rep > 0) xcd_barrier(bar);
        Frame F = F0;
        F.lane = (int)__builtin_amdgcn_mbcnt_hi(~0u, __builtin_amdgcn_mbcnt_lo(~0u, 0u));
        asm volatile("" : "+v"(F.lane));
        F.tid = (F.w << 6) | F.lane; F.h = F.lane >> 5; F.lq = F.lane & 31;
        asm volatile("" : "+s"(F.w), "+s"(F.ws), "+s"(F.karg));
        if (EN(0) && ph == 0) {
#if defined(MK_DUP0)
            for (int d = 0; d < 2; ++d) { int dd = d; asm volatile("" : "+s"(dd)); if (dd) xcd_barrier(bar); phase0(F, p, dd != 0); }
#else
            phase0(F, p);
#endif
        }
        else if (EN(1) && ph == 1) phase1(F, p);
        else if (EN(2) && ph == 18) phase_final(F, p);
        else {
            const int l = (ph - 2) >> 2, sub = (ph - 2) & 3;
            int bid = blockIdx.x; asm volatile("" : "+s"(bid));
            if (EN(3) && sub == 0) {
                const bf16_t* Wt = (const bf16_t*)(F.ws + WS_WIN) + (size_t)l * 2944 * 1024;
                const bf16_t* X = (const bf16_t*)(F.ws + WS_XG);
                unsigned* flags = ctl + CW_FLAG + l * 512;
                bool first = true;
                int waited_tm = -1;
                for (int j = bid; j < 12 * 32; j += G) {
                    const int tn2 = j >> 5, tm = j & 31;
                    const int jn = j + G; const bool hn = jn < 12 * 32 && (jn & 31) == tm;
                    if (l == 0 && tm != waited_tm) {
                        waited_tm = tm;
                        if (F.tid == 0) {
                            XB_SPIN(xb_ld(ctl + CW_P1X + tm * 4) < 8u, ctl + CW_BAR);
                            XB_SPIN(xb_ld(ctl + CW_P1B0) < 368u, ctl + CW_BAR);
                            __builtin_amdgcn_fence(__ATOMIC_ACQUIRE, "agent");
                            asm volatile("s_waitcnt vmcnt(0)" ::: "memory");
                        }
                        __syncthreads();
                        first = true;
                    }
                    if (l > 0 && tm != waited_tm) {
                        waited_tm = tm;
                        if (F.w == 0) {
                            const int ln = lane_id();
                            unsigned* ptr = ctl + CW_P1DONE; unsigned tgt = (unsigned)G;
                            if (ln == 1) { ptr = ctl + CW_XGR + ((l - 1) * 32 + tm) * 4; tgt = 8u; }
                            if (ln >= 2) {
                                if (tm >= 16) { ptr = ctl + CW_YRDY + ((l - 1) * 32 + (tm & ~3) + ((ln - 2) & 3)) * 4; tgt = 16u; }
                                else { ptr = ctl + CW_SD + ((l - 1) * 16 + tm) * 4; tgt = 4u; }
                            }
                            poll_lanes(ptr, tgt, ln < (tm >= 16 ? 6 : 3), ctl + CW_BAR);
                            __builtin_amdgcn_fence(__ATOMIC_ACQUIRE, "agent");
                            asm volatile("s_waitcnt vmcnt(0)" ::: "memory");
                        }
                        __syncthreads();
                        first = true;
                    }
                    const int tn = 2 * tn2 + ((F.w & 3) >> 1), wn = F.w & 1;
                    if (tn2 == 11) {
                        GemmAcc2 accn;
                        Gemm1Pre P1;
                        const bool mine = (F.w & 3) == 0;
                        if (mine) gemm1_pre(F, p, 22, 0, tm, l, P1); else { P1.rstd[0] = P1.rstd[1] = 0.f; P1.bias = 0.f; P1.gain = 1.f; }
                        gemm_core256n(F, Wt + (size_t)tn2 * 256 * 1024, X + (size_t)tm * 256 * 1024, accn, first); first = true;
                        if (mine) epi_kpe(F, p, accn, tm, l, P1);
                    } else {
                    GemmAcc8 acc;
                    Gemm1Pre P1;
                    gemm1_pre(F, p, tn, wn, tm, l, P1);
                    gemm_core256(F, Wt + (size_t)tn2 * 256 * 1024, X + (size_t)tm * 256 * 1024, acc, first, hn, Wt + (size_t)(jn >> 5) * 256 * 1024, X + (size_t)(jn & 31) * 256 * 1024); first = false;
                    epi_gemm1(F, p, acc, tn, wn, tm, l, P1, tn2 == 6);
                    }
                    {
                        asm volatile("s_waitcnt vmcnt(0)" ::: "memory");
                        __syncthreads();
                        if (F.tid == 0) {
                            if (tn2 == 5 || tn2 == 6) (void)xb_add(flags + tm * 16, 1u);
                            if (tn2 < 8) (void)xb_add(ctl + CW_RA + (l * 32 + tm) * 4, 1u);
                            if (tn2 >= 7 && tn2 < 11) (void)xb_add(ctl + CW_ZC + (l * 32 + tm) * 4, 1u);
                            (void)xb_add(ctl + CW_FULL + (l * 32 + tm) * 4, 1u);
                        }
                    }
                }
                for (int vb = bid; vb < 256; vb += G) {
                    if (vb < 128) continue;
                    const int c = (vb >> 5) - 4, tmw = vb & 31;
                    const int nit = (c == 2 && tmw < 16) ? 4 : 3;
                    if (F.tid == 0) {
                        if (l > 0 && tmw != waited_tm) {
                            if (tmw >= 16) { unsigned* y = ctl + CW_YRDY + ((l - 1) * 32 + (tmw & ~3)) * 4; for (int i = 0; i < 4; ++i) { XB_SPIN(xb_ld(y + 4 * i) < 16u, ctl + CW_BAR); } }
                            else { XB_SPIN(xb_ld(ctl + CW_YRDY + ((l - 1) * 32 + tmw) * 4) < 16u, ctl + CW_BAR); XB_SPIN(xb_ld(ctl + CW_SD + ((l - 1) * 16 + tmw) * 4) < 4u, ctl + CW_BAR); }
                        }
                        unsigned* f = flags + tmw * 16;
                        XB_SPIN(xb_ld(f) < 2u, ctl + CW_BAR);
                        __builtin_amdgcn_fence(__ATOMIC_ACQUIRE, "agent");
                        asm volatile("s_waitcnt vmcnt(0)" ::: "memory");
                    }
                    __syncthreads();
                    for (int i = 0; i < nit; ++i) {
                        const bool hn = i + 1 < nit;
                        const int j = a2_item(vb, i), jn = a2_item(vb, hn ? i + 1 : i);
                        const GemmOp g = a2_op(F, l, j); const GemmOp gn = a2_op(F, l, jn);
                        GemmAcc acc;
                        float rstdq = 0.f;
                        if (j < 160) qm_pre(F, tmw, rstdq);
                        gemm_core(F, g, acc, i == 0, hn, gn);
                        if (j < 160) epi_qm(F, acc, j >> 5, tmw, rstdq);
                        else if (j < 352) { const int jj = j - 160; epi_plain(F, acc, (bf16_t*)(F.ws + WS_KVM), 768, tmw * 256, (jj >> 5) * 128); }
                        else {
                            const int jj = j - 352, tc = jj & 7;
                            if (l > 0) {
                                if (F.w == 0) { const int ln = lane_id(); poll_lanes(ctl + CW_YRDY + ((l - 1) * 32 + 16 + 4 * (tc >> 1) + (ln & 3)) * 4, 16u, ln < 4, ctl + CW_BAR); }
                                __syncthreads();
                            }
                            epi_plain(F, acc, (bf16_t*)(F.ws + WS_KVMC), 768, (tc >> 1) * 512 + (tc & 1) * 256, (jj >> 3) * 128);
                        }
                        asm volatile("s_waitcnt vmcnt(0)" ::: "memory");
                        __syncthreads();
                        if (F.tid == 0) {
                            if (j < 352) (void)xb_add(ctl + CW_FULL + (l * 32 + tmw) * 4, 1u);
                            else (void)xb_add(ctl + CW_KC + (l * 4 + (((j - 352) & 7) >> 1)) * 4, 1u);
                        }
                    }
                }
            } else if (EN(5) && sub == 2) {
                for (;;) {
                    __syncthreads();
                    if (F.tid == 0) MISC[0] = atomicAdd(ctl + CW_QUEUE + 64 * l + 32 * rep, 1u);
                    __syncthreads();
                    const int uq = __builtin_amdgcn_readfirstlane((int)MISC[0]);
                    if (uq >= N_ATTN_UNITS) break;
                    const int u = uq < 160 ? uq + 96 : (uq < 256 ? uq - 160 : (uq < 480 ? uq + 96 : uq - 224));
                    attn_dispatch(F, p, u, l);
                }
            } else if (EN(6)) {
                const bf16_t* Wt = (const bf16_t*)(F.ws + WS_WOUT) + (size_t)l * 1024 * 1024;
                const bf16_t* Yb = (const bf16_t*)(F.ws + WS_Y);
                for (int j = bid; j < 8 * 32; j += G) {
                    const int tn = j >> 5, tm = j & 31;
                    GemmOp g; g.W = Wt + (size_t)tn * 128 * 1024; g.X = Yb + (size_t)tm * 256 * 1024; g.ldw = 1024; g.ldx = 1024; g.K = 1024;
                    GemmAcc acc;
                    Gemm2Pre P2;
                    if (F.tid == 0) {
                        unsigned* f = ctl + CW_YRDY + (l * 32 + tm) * 4;
                        XB_SPIN(xb_ld(f) < 16u, ctl + CW_BAR);
                        if (l == 0) { XB_SPIN(xb_ld(ctl + CW_P1DONE) < (unsigned)G, ctl + CW_BAR); }
                        __builtin_amdgcn_fence(__ATOMIC_ACQUIRE, "agent");
                        asm volatile("s_waitcnt vmcnt(0)" ::: "memory");
                    }
                    __syncthreads();
                    gemm2_pre(F, tn, tm, l, P2);
                    gemm_core(F, g, acc, true, false, g);
                    epi_gemm2(F, p, acc, tn, tm, l, P2, l == 3);
                    {
                        asm volatile("s_waitcnt vmcnt(0)" ::: "memory");
                        __syncthreads();
                        if (F.tid == 0) (void)xb_add(l == 3 ? ctl + CW_XRDY + tm * 4 : ctl + CW_XGR + (l * 32 + tm) * 4, 1u);
                    }
                }
            }
        }
        }
        if (MK_TIMING >= 0 && ph == 17 && blockIdx.x == 0 && F.tid == 0) {
            const unsigned long long now = __builtin_amdgcn_s_memrealtime();
            const unsigned long long prev = ((unsigned long long)MISC[17] << 32) | MISC[16];
            unsigned a = MISC[18]; if (MK_TIMING == 5) a += (unsigned)(now - prev);
            __hip_atomic_store(ctl + CW_TIME, __float_as_uint(1.f + (float)a * 1e-5f), __ATOMIC_RELAXED, __HIP_MEMORY_SCOPE_AGENT);
        }
        if (ph + 1 < p.ph_hi && ph < 1) xcd_barrier(bar);
    }
}
}

extern "C" void kernel_launch(void* const* d_in, const int* in_sizes, int n_in, void* d_out, int out_size, void* d_ws, size_t ws_size, hipStream_t stream) {
    static int grid = 0;
    if (!grid) {
        int dev = 0, cus = 0, per_cu = 0;
        (void)hipGetDevice(&dev);
        (void)hipDeviceGetAttribute(&cus, hipDeviceAttributeMultiprocessorCount, dev);
        (void)hipFuncSetAttribute((const void*)mk::mega, hipFuncAttributeMaxDynamicSharedMemorySize, mk::LDS_BYTES);
        (void)hipOccupancyMaxActiveBlocksPerMultiprocessor(&per_cu, (const void*)mk::mega, 512, mk::LDS_BYTES);
        if (per_cu > 1) per_cu = 1;
        if (per_cu < 1) per_cu = 1;
        if (cus < 1) cus = 256;
        grid = cus * per_cu;
    }
    unsigned char* ws = (unsigned char*)d_ws;
    (void)hipMemsetAsync(ws, 0, mk::CTL_ZERO_BYTES, stream);
    mk::Params P{};
    for (int i = 0; i < 22; ++i) P.in[i] = (const float*)d_in[i];
    P.out = (float*)d_out; P.ws = ws; P.xs = (float*)d_out;
    P.ph_lo = 0; P.ph_hi = mk::PH_TOTAL;
    void* args[] = {&P};
    (void)hipLaunchCooperativeKernel((const void*)mk::mega, dim3(grid), dim3(512), args, mk::LDS_BYTES, stream);
}
```

```cpp
#include <hip/hip_runtime.h>
#include <stdint.h>
namespace mk {
#define LAS __attribute__((address_space(3)))
typedef unsigned short bf16_t;
typedef short bf16x8 __attribute__((ext_vector_type(8)));
typedef short s16x4 __attribute__((ext_vector_type(4)));
typedef float f32x16 __attribute__((ext_vector_type(16)));
typedef float f32x4 __attribute__((ext_vector_type(4)));
typedef float f32x2 __attribute__((ext_vector_type(2)));
typedef unsigned u32x4 __attribute__((ext_vector_type(4)));
typedef unsigned u32x2 __attribute__((ext_vector_type(2)));
typedef __bf16 bf16x2_t __attribute__((ext_vector_type(2)));

constexpr float EPS = 1e-6f;
constexpr float LOG2E = 1.4426950408889634f;
constexpr float QSC_GQA = 0.125f * LOG2E;
constexpr float QSC_MLA = 0.10206207261596575f * LOG2E;

__device__ __forceinline__ unsigned pk2(float lo, float hi) { f32x2 v = {lo, hi}; bf16x2_t b = __builtin_convertvector(v, bf16x2_t); return __builtin_bit_cast(unsigned, b); }
__device__ __forceinline__ float bf2f(unsigned short u) { return __uint_as_float((unsigned)u << 16); }
__device__ __forceinline__ float bflo(unsigned u) { return __uint_as_float(u << 16); }
__device__ __forceinline__ float bfhi(unsigned u) { return __uint_as_float(u & 0xffff0000u); }
__device__ __forceinline__ float silu_f(float x) { return x * __builtin_amdgcn_rcpf(1.f + __builtin_amdgcn_exp2f(-x * LOG2E)); }
__device__ __forceinline__ float wsum(float v) {
#pragma unroll
    for (int o = 32; o > 0; o >>= 1) v += __shfl_xor(v, o);
    return v;
}

constexpr size_t MiB = 1u << 20;
constexpr size_t WS_CTL = 0, CTL_ZERO_BYTES = 1 * MiB;
constexpr size_t WS_MODS = 256 * 1024;
constexpr size_t WS_BIAS = 1 * MiB;
constexpr size_t WS_GS = 1 * MiB + 256 * 1024;
constexpr size_t WS_ROPE64 = 1 * MiB + 512 * 1024;
constexpr size_t WS_ROPE32 = 1 * MiB + 768 * 1024;
constexpr size_t WS_SSQ = 2 * MiB;
constexpr size_t WS_CQSSQ = 2 * MiB + 512 * 1024;
constexpr size_t WS_S0T = 3 * MiB;
constexpr size_t WS_CGK = 4 * MiB, WS_CGV = 6 * MiB, WS_CCKV = 8 * MiB, WS_CKPE = 10 * MiB;
constexpr size_t WS_WIN = 11 * MiB;
constexpr size_t WS_WOUT = 34 * MiB;
constexpr size_t WS_WUQ = 42 * MiB;
constexpr size_t WS_WUKV = 43 * MiB + 256 * 1024;
constexpr size_t WS_XG = 44 * MiB;
constexpr size_t WS_KVM = 130 * MiB;
constexpr size_t WS_KVMC = 142 * MiB;
constexpr size_t WS_RQ = 60 * MiB, WS_RK = 64 * MiB, WS_RV = 68 * MiB;
constexpr size_t WS_GQ = 72 * MiB;
constexpr size_t WS_GK = 78 * MiB, WS_GV = 80 * MiB;
constexpr size_t WS_CQG = 82 * MiB;
constexpr size_t WS_CKVN = 86 * MiB;
constexpr size_t WS_KPEB = 88 * MiB;
constexpr size_t WS_ZS = 89 * MiB;
constexpr size_t WS_QM = 105 * MiB;
constexpr size_t WS_Y = 114 * MiB;
constexpr size_t WS_XSDBG = 130 * MiB;
constexpr size_t WS_XB = 146 * MiB;
constexpr size_t WS_OPT_END = 162 * MiB;
constexpr int CW_QUEUE = 1024;
constexpr int CW_FLAG = 2048;
constexpr int CW_YRDY = 1536;
constexpr int CW_XRDY = 1280;
constexpr int CW_RA = 8192;
constexpr int CW_FULL = 8704;
constexpr int CW_ZC = 9216;
constexpr int CW_KC = 9728;
constexpr int CW_XGR = 9856;
constexpr int CW_SD = 10368;
constexpr int CW_P1X = 10656;
constexpr int CW_P1B0 = 10784;
constexpr int CW_P1DONE = 10788;
constexpr int CW_BAR = 4096;

constexpr size_t O_STATE = 8388608, O_GK = 10485760, O_GV = 12582912, O_CKV = 14680064, O_KPE = 16777216;

constexpr int NWAVE = 8;
constexpr int GST = 49152;
constexpr int GST2 = 65536;
constexpr int LDS_OST = GST2;
constexpr int LDS_EX = 135168;
constexpr int LDS_EXB = 137216;
constexpr int LDS_SCAL = 141312;
constexpr int LDS_MISC = 142336;
constexpr int LDS_BYTES = 142592;

struct Params { const float* in[22]; float* out; unsigned char* ws; float* xs; int ph_lo, ph_hi; };
enum { I_XP = 0, I_XS, I_STATE, I_CGK, I_CGV, I_CCKV, I_CKPE, I_C, I_CCTX, I_NORMG, I_WADA, I_BADA, I_WIN, I_DECAY, I_GQN, I_GKN, I_MQN, I_MKVN, I_WUQ, I_WUKV, I_WOUT, I_FNORM };

#define XB_TMO      128
#define XB_XCNT(j)  (256  + 64 * (j))
#define XB_XSUB(j)  (1280 + 64 * (j))
#define XB_XGEN(j)  (2304 + 64 * (j))
#define XB_TOP      3328
#define XB_TOPGEN   3392
#define XB_SPIN_CAP (1u << 20)
__device__ __forceinline__ unsigned xb_ld(unsigned* p) { return __hip_atomic_load(p, __ATOMIC_RELAXED, __HIP_MEMORY_SCOPE_AGENT); }
__device__ __forceinline__ unsigned xb_add(unsigned* p, unsigned v) { return __hip_atomic_fetch_add(p, v, __ATOMIC_RELAXED, __HIP_MEMORY_SCOPE_AGENT); }
__device__ __forceinline__ unsigned xb_xcc_id() { return (unsigned)__builtin_amdgcn_s_getreg((3 << 11) | 20) & 0xFu; }
#define XB_SPIN(cond, bar) do { unsigned _sp = 0; while (cond) { __builtin_amdgcn_s_sleep(1); \
    if ((++_sp & 255u) == 0u) { if (xb_ld(&(bar)[XB_TMO])) break; if (_sp > XB_SPIN_CAP) { atomicAdd(&(bar)[XB_TMO], 1u); break; } } } } while (0)
__device__ __forceinline__ int lane_id() { int ln = (int)__builtin_amdgcn_mbcnt_hi(~0u, __builtin_amdgcn_mbcnt_lo(~0u, 0u)); asm volatile("" : "+v"(ln)); return ln; }
__device__ __forceinline__ void poll_lanes(unsigned* ptr, unsigned target, bool active, unsigned* bar0) {
    unsigned sp = 0u;
    for (;;) {
        unsigned v = target;
        if (active) v = xb_ld(ptr);
        if (!__any(v < target)) break;
        __builtin_amdgcn_s_sleep(1);
        if ((++sp & 255u) == 0u) { if (xb_ld(&bar0[XB_TMO])) break; if (sp > XB_SPIN_CAP) { atomicAdd(&bar0[XB_TMO], 1u); break; } }
    }
}
struct XcdBarrier { unsigned* bar; unsigned x; volatile LAS unsigned* st; int w; };
__device__ __forceinline__ XcdBarrier xcd_barrier_post(unsigned* bar, volatile LAS unsigned* st) {
    XcdBarrier b; b.bar = bar; b.x = xb_xcc_id(); b.st = st; b.w = 0;
    if (threadIdx.x == 0) (void)xb_add(&bar[XB_XCNT(b.x)], 1u);
    return b;
}
__device__ __forceinline__ void xcd_barrier_complete(unsigned* bar, unsigned x, unsigned& nloc, unsigned& nx) {
    const unsigned G = gridDim.x * gridDim.y * gridDim.z;
    unsigned sum, cnt, mine, sp = 0u;
    for (;;) {
        sum = 0u; cnt = 0u; mine = 0u;
#pragma unroll
        for (unsigned j = 0; j < 16; ++j) { const unsigned c = xb_ld(&bar[XB_XCNT(j)]); sum += c; cnt += (c > 0u) ? 1u : 0u; mine = (j == x) ? c : mine; }
        if (sum == G) break;
        __builtin_amdgcn_s_sleep(1);
        if ((++sp & 255u) == 0u) { if (xb_ld(&bar[XB_TMO])) break; if (sp > XB_SPIN_CAP) { atomicAdd(&bar[XB_TMO], 1u); break; } }
    }
    nloc = mine > 0u ? mine : 1u; nx = cnt > 0u ? cnt : 1u;
}
__device__ __forceinline__ void xcd_barrier(const XcdBarrier& b) {
    asm volatile("s_waitcnt vmcnt(0)" ::: "memory");
    __syncthreads();
    if (b.w == 0 && __builtin_amdgcn_mbcnt_hi(~0u, __builtin_amdgcn_mbcnt_lo(~0u, 0u)) == 0u) {
        unsigned* bar = b.bar;
        __builtin_amdgcn_s_waitcnt(0);
        unsigned nloc = b.st[0], nx = b.st[1];
        if (nloc == 0u) { xcd_barrier_complete(bar, b.x, nloc, nx); b.st[0] = nloc; b.st[1] = nx; }
        const unsigned old = xb_add(&bar[XB_XSUB(b.x)], 1u);
        const unsigned gen = old / nloc;
        if (old + 1u == (gen + 1u) * nloc) {
            __builtin_amdgcn_fence(__ATOMIC_RELEASE, "agent");
            asm volatile("s_waitcnt vmcnt(0)" ::: "memory");
            const unsigned og = xb_add(&bar[XB_TOP], 1u);
            const unsigned tg = og / nx;
            if (og + 1u == (tg + 1u) * nx) xb_add(&bar[XB_TOPGEN], 1u);
            else XB_SPIN(xb_ld(&bar[XB_TOPGEN]) == tg, bar);
            xb_add(&bar[XB_XGEN(b.x)], 1u);
            __builtin_amdgcn_fence(__ATOMIC_ACQUIRE, "agent");
            asm volatile("s_waitcnt vmcnt(0)" ::: "memory");
        } else {
            XB_SPIN(xb_ld(&bar[XB_XGEN(b.x)]) == gen, bar);
            __builtin_amdgcn_fence(__ATOMIC_ACQUIRE, "agent");
            asm volatile("s_waitcnt vmcnt(0)" ::: "memory");
        }
    }
    __syncthreads();
}

typedef const float* cfp_t;
typedef const __attribute__((address_space(4))) cfp_t* karg_t;
struct Frame {
    LAS unsigned char* lds;
    int tid, lane, w, h, lq;
    unsigned char* ws;
    karg_t karg;
};
__device__ __forceinline__ const float* pin(const Frame& F, int i) { return F.karg[i]; }
__device__ __forceinline__ bool is_t0(const Frame& F) { return F.w == 0 && __builtin_amdgcn_mbcnt_hi(~0u, __builtin_amdgcn_mbcnt_lo(~0u, 0u)) == 0u; }
#define GLDS16(gsrc, ldsdst) __builtin_amdgcn_global_load_lds((const unsigned*)(gsrc), (LAS unsigned*)(ldsdst), 16, 0, 0)
#define ST16_WT(ptr, val) asm volatile("global_store_dwordx4 %0, %1, off sc1\n\ts_nop 1" :: "v"(ptr), "v"(val) : "memory")
#define MFMA32(a, b, c) __builtin_amdgcn_mfma_f32_32x32x16_bf16((a), (b), (c), 0, 0, 0)

struct GemmOp { const bf16_t* W; const bf16_t* X; int ldw, ldx, K; };
__device__ __forceinline__ void gemm_issue0(const Frame& F, const GemmOp& g) {
    const int lane = F.lane, w = F.w;
#pragma unroll
    for (int q = 0; q < 2; ++q) { const int row = 16 * w + 8 * q + (lane >> 3); GLDS16(g.W + row * g.ldw + ((lane & 7) ^ ((row >> 1) & 7)) * 8, F.lds + (16 * w + 8 * q) * 128); }
#pragma unroll
    for (int q = 0; q < 4; ++q) { const int row = 32 * w + 8 * q + (lane >> 3); GLDS16(g.X + row * g.ldx + ((lane & 7) ^ ((row >> 1) & 7)) * 8, F.lds + 16384 + (32 * w + 8 * q) * 128); }
}
typedef f32x4 GemmAcc[4][4];
__device__ __forceinline__ void gemm_core(const Frame& F, const GemmOp& g, GemmAcc& acc, bool issue_first, bool has_next, const GemmOp& gn) {
    const int lane = F.lane, w = F.w;
    const bf16_t* __restrict__ W = g.W; const bf16_t* __restrict__ X = g.X;
    const int nkt = g.K >> 6;
    int offW[2], offX[4];
#pragma unroll
    for (int q = 0; q < 2; ++q) { const int row = 16 * w + 8 * q + (lane >> 3); offW[q] = row * g.ldw + ((lane & 7) ^ ((row >> 1) & 7)) * 8; }
#pragma unroll
    for (int q = 0; q < 4; ++q) { const int row = 32 * w + 8 * q + (lane >> 3); offX[q] = row * g.ldx + ((lane & 7) ^ ((row >> 1) & 7)) * 8; }
    LAS unsigned char* const dW = F.lds + (16 * w) * 128;
    LAS unsigned char* const dX = F.lds + 16384 + (32 * w) * 128;
#define GC_ISSUE(kt, st) do { _Pragma("unroll") for (int q = 0; q < 2; ++q) GLDS16(W + offW[q] + (kt) * 64, dW + (st) * GST + q * 1024); \
        _Pragma("unroll") for (int q = 0; q < 4; ++q) GLDS16(X + offX[q] + (kt) * 64, dX + (st) * GST + q * 1024); } while (0)
    const int wn = w & 1, wm = w >> 1, c15 = lane & 15, g4 = lane >> 4;
    const int sw = (c15 >> 1) & 7;
    int so[2];
#pragma unroll
    for (int s = 0; s < 2; ++s) so[s] = ((4 * s + g4) ^ sw) << 4;
    const int bn0 = (64 * wn + c15) * 128, bm0 = 16384 + (64 * wm + c15) * 128;
#pragma unroll
    for (int a = 0; a < 4; ++a)
#pragma unroll
        for (int b = 0; b < 4; ++b) acc[a][b] = (f32x4){0.f, 0.f, 0.f, 0.f};
    if (issue_first) GC_ISSUE(0, 0);
    asm volatile("s_waitcnt vmcnt(0)" ::: "memory");
    __syncthreads();
    for (int kt = 0; kt < nkt; ++kt) {
        const int st = kt & 1;
        if (kt + 1 < nkt) GC_ISSUE(kt + 1, st ^ 1);
        LAS unsigned char* const base = F.lds + st * GST;
#pragma unroll
        for (int s = 0; s < 2; ++s) {
            bf16x8 fa[4], fb[4];
#pragma unroll
            for (int q = 0; q < 4; ++q) { fa[q] = *(const LAS bf16x8*)(base + bn0 + q * 2048 + so[s]); fb[q] = *(const LAS bf16x8*)(base + bm0 + q * 2048 + so[s]); }
#pragma unroll
            for (int a = 0; a < 4; ++a)
#pragma unroll
                for (int b = 0; b < 4; ++b) acc[a][b] = __builtin_amdgcn_mfma_f32_16x16x32_bf16(fa[a], fb[b], acc[a][b], 0, 0, 0);
        }
        asm volatile("s_waitcnt vmcnt(0)" ::: "memory");
        __syncthreads();
    }
#undef GC_ISSUE
    if (has_next) gemm_issue0(F, gn);
}

typedef f32x4 GemmAcc8[4][8];
__device__ __forceinline__ void gemm256_issue0(const Frame& F, const bf16_t* W, const bf16_t* X) {
    int lane = F.lane; const int w = F.w;
    asm volatile("" : "+v"(lane));
#pragma unroll
    for (int q = 0; q < 4; ++q) {
        const int row = 32 * w + 8 * q + (lane >> 3), off = row * 1024 + ((lane & 7) ^ ((row >> 1) & 7)) * 8;
        GLDS16(W + off, F.lds + (32 * w + 8 * q) * 128);
        GLDS16(X + off, F.lds + 32768 + (32 * w + 8 * q) * 128);
    }
}
__device__ __forceinline__ void gemm_core256(const Frame& F, const bf16_t* __restrict__ W, const bf16_t* __restrict__ X, GemmAcc8& acc, bool issue_first, bool has_next, const bf16_t* Wn, const bf16_t* Xn) {
    int lane = F.lane; const int w = F.w;
    asm volatile("" : "+v"(lane));
    int off[4];
#pragma unroll
    for (int q = 0; q < 4; ++q) { const int row = 32 * w + 8 * q + (lane >> 3); off[q] = row * 1024 + ((lane & 7) ^ ((row >> 1) & 7)) * 8; }
    LAS unsigned char* const dW = F.lds + (32 * w) * 128;
    LAS unsigned char* const dX = F.lds + 32768 + (32 * w) * 128;
#define GC2_ISSUE(kt, st) do { _Pragma("unroll") for (int q = 0; q < 4; ++q) { GLDS16(W + off[q] + (kt) * 64, dW + (st) * GST2 + q * 1024); GLDS16(X + off[q] + (kt) * 64, dX + (st) * GST2 + q * 1024); } } while (0)
    const int wn4 = w & 3, wm2 = w >> 2, c15 = lane & 15, g4 = lane >> 4;
    const int sw = (c15 >> 1) & 7;
    int so[2];
#pragma unroll
    for (int s = 0; s < 2; ++s) so[s] = ((4 * s + g4) ^ sw) << 4;
    const int bn0 = (64 * wn4 + c15) * 128, bm0 = 32768 + (128 * wm2 + c15) * 128;
#pragma unroll
    for (int a = 0; a < 4; ++a)
#pragma unroll
        for (int b = 0; b < 8; ++b) acc[a][b] = (f32x4){0.f, 0.f, 0.f, 0.f};
    if (issue_first) GC2_ISSUE(0, 0);
    asm volatile("s_waitcnt vmcnt(0)" ::: "memory");
    __syncthreads();
    for (int kt = 0; kt < 16; ++kt) {
        const int st = kt & 1;
        if (kt + 1 < 16) GC2_ISSUE(kt + 1, st ^ 1);
        LAS unsigned char* const base = F.lds + st * GST2;
#pragma unroll
        for (int s = 0; s < 2; ++s) {
            bf16x8 fa[4];
#pragma unroll
            for (int q = 0; q < 4; ++q) fa[q] = *(const LAS bf16x8*)(base + bn0 + q * 2048 + so[s]);
#pragma unroll
            for (int hb = 0; hb < 2; ++hb) {
                bf16x8 fb[4];
#pragma unroll
                for (int q = 0; q < 4; ++q) fb[q] = *(const LAS bf16x8*)(base + bm0 + (4 * hb + q) * 2048 + so[s]);
#pragma unroll
                for (int a = 0; a < 4; ++a)
#pragma unroll
                    for (int b = 0; b < 4; ++b) acc[a][4 * hb + b] = __builtin_amdgcn_mfma_f32_16x16x32_bf16(fa[a], fb[b], acc[a][4 * hb + b], 0, 0, 0);
            }
        }
        asm volatile("s_waitcnt vmcnt(0)" ::: "memory");
        __syncthreads();
    }
#undef GC2_ISSUE
    if (has_next) gemm256_issue0(F, Wn, Xn);
}
typedef f32x4 GemmAcc2[2][8];
__device__ __forceinline__ void gemm_core256n(const Frame& F, const bf16_t* __restrict__ W, const bf16_t* __restrict__ X, GemmAcc2& acc, bool issue_first) {
    int lane = F.lane; const int w = F.w;
    asm volatile("" : "+v"(lane));
    int off[4];
#pragma unroll
    for (int q = 0; q < 4; ++q) { const int row = 32 * w + 8 * q + (lane >> 3); off[q] = row * 1024 + ((lane & 7) ^ ((row >> 1) & 7)) * 8; }
    LAS unsigned char* const dW = F.lds + (32 * w) * 128;
    LAS unsigned char* const dX = F.lds + 32768 + (32 * w) * 128;
#define GC2_ISSUE(kt, st) do { _Pragma("unroll") for (int q = 0; q < 4; ++q) { if (w == 0) GLDS16(W + off[q] + (kt) * 64, dW + (st) * GST2 + q * 1024); GLDS16(X + off[q] + (kt) * 64, dX + (st) * GST2 + q * 1024); } } while (0)
    const int wn4 = w & 3, wm2 = w >> 2, c15 = lane & 15, g4 = lane >> 4;
    const int sw = (c15 >> 1) & 7;
    int so[2];
#pragma unroll
    for (int s = 0; s < 2; ++s) so[s] = ((4 * s + g4) ^ sw) << 4;
    const int bn0 = (64 * wn4 + c15) * 128, bm0 = 32768 + (128 * wm2 + c15) * 128;
#pragma unroll
    for (int a = 0; a < 2; ++a)
#pragma unroll
        for (int b = 0; b < 8; ++b) acc[a][b] = (f32x4){0.f, 0.f, 0.f, 0.f};
    if (issue_first) GC2_ISSUE(0, 0);
    asm volatile("s_waitcnt vmcnt(0)" ::: "memory");
    __syncthreads();
    for (int kt = 0; kt < 16; ++kt) {
        const int st = kt & 1;
        if (kt + 1 < 16) GC2_ISSUE(kt + 1, st ^ 1);
        LAS unsigned char* const base = F.lds + st * GST2;
        if (wn4 == 0) {
#pragma unroll
        for (int s = 0; s < 2; ++s) {
            bf16x8 fa[2];
#pragma unroll
            for (int q = 0; q < 2; ++q) fa[q] = *(const LAS bf16x8*)(base + bn0 + q * 2048 + so[s]);
#pragma unroll
            for (int hb = 0; hb < 2; ++hb) {
                bf16x8 fb[4];
#pragma unroll
                for (int q = 0; q < 4; ++q) fb[q] = *(const LAS bf16x8*)(base + bm0 + (4 * hb + q) * 2048 + so[s]);
#pragma unroll
                for (int a = 0; a < 2; ++a)
#pragma unroll
                    for (int b = 0; b < 4; ++b) acc[a][4 * hb + b] = __builtin_amdgcn_mfma_f32_16x16x32_bf16(fa[a], fb[b], acc[a][4 * hb + b], 0, 0, 0);
            }
        }
        }
        asm volatile("s_waitcnt vmcnt(0)" ::: "memory");
        __syncthreads();
    }
#undef GC2_ISSUE
}

__device__ __forceinline__ void rope64_16(float (&v)[4][4], float rowp, float colp, int g4) {
#pragma unroll
    for (int i = 0; i < 4; ++i) {
        const float fr = __builtin_amdgcn_exp2f((float)(4 * g4 + i) * -0.8304820237218406f) * 0.15915494309189535f;
#pragma unroll
        for (int c = 0; c < 2; ++c) {
            const float rev = (c ? colp : rowp) * fr;
            const float sn = __builtin_amdgcn_sinf(rev), cs = __builtin_amdgcn_cosf(rev);
            const float x0 = v[2 * c][i], x1 = v[2 * c + 1][i];
            v[2 * c][i] = x0 * cs - x1 * sn;
            v[2 * c + 1][i] = x1 * cs + x0 * sn;
        }
    }
}
__device__ __forceinline__ void rope32_16(float (&a)[4], float (&b)[4], float rowp, float colp, int g4) {
    const bool hi = g4 >= 2;
#pragma unroll
    for (int i = 0; i < 4; ++i) {
        const float fr = __builtin_amdgcn_exp2f((float)(4 * (g4 & 1) + i) * -1.6609640474436813f) * 0.15915494309189535f;
        {
            const float rev = rowp * fr;
            const float sn = __builtin_amdgcn_sinf(rev), cs = __builtin_amdgcn_cosf(rev);
            const float own = a[i], oth = __shfl_xor(own, 32);
            a[i] = own * cs + oth * (hi ? sn : -sn);
        }
        {
            const float rev = colp * fr;
            const float sn = __builtin_amdgcn_sinf(rev), cs = __builtin_amdgcn_cosf(rev);
            const float own = b[i], oth = __shfl_xor(own, 32);
            b[i] = own * cs + oth * (hi ? sn : -sn);
        }
    }
}
__device__ __forceinline__ float ssq64(const float (&v)[4][4]) {
    float s = 0.f;
#pragma unroll
    for (int nt = 0; nt < 4; ++nt)
#pragma unroll
        for (int i = 0; i < 4; ++i) s += v[nt][i] * v[nt][i];
    s += __shfl_xor(s, 16);
    s += __shfl_xor(s, 32);
    return s;
}
__device__ __forceinline__ void mulvec64(float (&v)[4][4], const LAS float* gv, int g4) {
#pragma unroll
    for (int nt = 0; nt < 4; ++nt) {
        const f32x4 q = *(const LAS f32x4*)(gv + 16 * nt + 4 * g4);
#pragma unroll
        for (int i = 0; i < 4; ++i) v[nt][i] *= q[i];
    }
}
constexpr int OST_LD = 68, OST_BYTES = 32 * OST_LD * 4;
__device__ __forceinline__ void stage_write16(LAS float* st, const float (&v)[4][4], int mh, int c15, int g4) {
    asm volatile("s_waitcnt lgkmcnt(0)" ::: "memory");
    __builtin_amdgcn_wave_barrier();
#pragma unroll
    for (int nt = 0; nt < 4; ++nt) {
        f32x4 o = {v[nt][0], v[nt][1], v[nt][2], v[nt][3]};
        *(LAS f32x4*)(st + (16 * mh + c15) * OST_LD + 16 * nt + 4 * g4) = o;
    }
    asm volatile("s_waitcnt lgkmcnt(0)" ::: "memory");
    __builtin_amdgcn_wave_barrier();
}
__device__ __forceinline__ void stage_write16a(LAS float* st, const f32x4 (&a)[4][4], int mt, int c15, int g4) {
    asm volatile("s_waitcnt lgkmcnt(0)" ::: "memory");
    __builtin_amdgcn_wave_barrier();
#pragma unroll
    for (int nt = 0; nt < 4; ++nt) *(LAS f32x4*)(st + (16 * (mt & 1) + c15) * OST_LD + 16 * nt + 4 * g4) = a[nt][mt];
    asm volatile("s_waitcnt lgkmcnt(0)" ::: "memory");
    __builtin_amdgcn_wave_barrier();
}
__device__ __forceinline__ void stage_store_bf16(const LAS float* st, bf16_t* dst, int ld, float sc, int lane) {
#pragma unroll 1
    for (int it = 0; it < 4; ++it) {
        const int row = it * 8 + (lane >> 3), c8 = (lane & 7) * 8;
        const f32x4 x0 = *(const LAS f32x4*)(st + row * OST_LD + c8), x1 = *(const LAS f32x4*)(st + row * OST_LD + c8 + 4);
        u32x4 o; o.x = pk2(x0[0] * sc, x0[1] * sc); o.y = pk2(x0[2] * sc, x0[3] * sc); o.z = pk2(x1[0] * sc, x1[1] * sc); o.w = pk2(x1[2] * sc, x1[3] * sc);
        ST16_WT(dst + (size_t)row * ld + c8, o);
    }
}
__device__ __forceinline__ void stage_store_bf16_sc1(const LAS float* st, bf16_t* dst, int ld, int lane) {
#pragma unroll 1
    for (int it = 0; it < 4; ++it) {
        const int row = it * 8 + (lane >> 3), c8 = (lane & 7) * 8;
        const f32x4 x0 = *(const LAS f32x4*)(st + row * OST_LD + c8), x1 = *(const LAS f32x4*)(st + row * OST_LD + c8 + 4);
        u32x4 o; o.x = pk2(x0[0], x0[1]); o.y = pk2(x0[2], x0[3]); o.z = pk2(x1[0], x1[1]); o.w = pk2(x1[2], x1[3]);
        bf16_t* ptr = dst + (size_t)row * ld + c8;
        asm volatile("global_store_dwordx4 %0, %1, off sc1\n\ts_nop 1" :: "v"(ptr), "v"(o) : "memory");
    }
}
__device__ __forceinline__ void stage_store_f32(const LAS float* st, float* dst, int ld, int lane) {
#pragma unroll 1
    for (int it = 0; it < 8; ++it) {
        const int row = it * 4 + (lane >> 4), c = (lane & 15) * 4;
        { const f32x4 o = *(const LAS f32x4*)(st + row * OST_LD + c); ST16_WT(dst + (size_t)row * ld + c, o); }
    }
}
__device__ __forceinline__ void stage_store_bf16_32(const LAS float* st, bf16_t* dst, int ld, int lane) {
#pragma unroll 1
    for (int it = 0; it < 2; ++it) {
        const int row = it * 16 + (lane >> 2), c8 = (lane & 3) * 8;
        const f32x4 x0 = *(const LAS f32x4*)(st + row * OST_LD + c8), x1 = *(const LAS f32x4*)(st + row * OST_LD + c8 + 4);
        u32x4 o; o.x = pk2(x0[0], x0[1]); o.y = pk2(x0[2], x0[3]); o.z = pk2(x1[0], x1[1]); o.w = pk2(x1[2], x1[3]);
        ST16_WT(dst + (size_t)row * ld + c8, o);
    }
}
__device__ __forceinline__ void stage_store_f32_32(const LAS float* st, float* dst, int ld, int lane) {
#pragma unroll 1
    for (int it = 0; it < 4; ++it) {
        const int row = it * 8 + (lane >> 3), c = (lane & 7) * 4;
        { const f32x4 o = *(const LAS f32x4*)(st + row * OST_LD + c); ST16_WT(dst + (size_t)row * ld + c, o); }
    }
}

struct Gemm1Pre { float rstd[2]; float bias, gain; };
__device__ __forceinline__ void gemm1_pre(const Frame& F, const Params& p, int tn, int wn, int tm, int l, Gemm1Pre& P) {
    const float* ssqp = (const float*)(F.ws + WS_SSQ);
#pragma unroll
    for (int jj = 0; jj < 2; ++jj) {
        const int tok = tm * 256 + (F.w >> 2) * 128 + 64 * jj + F.lane;
        const f32x4* sp = (const f32x4*)(ssqp + (size_t)tok * 16);
        float ss = 0.f;
#pragma unroll
        for (int i = 0; i < 4; ++i) { const f32x4 q = sp[i]; ss += (q[0] + q[1]) + (q[2] + q[3]); }
        P.rstd[jj] = rsqrtf(ss * (1.f / 1024.f) + EPS);
    }
    const bool lat = tm >= 16;
    const int cond = lat ? 1 + ((tm - 16) >> 2) : 0;
    const int nb = tn * 128 + wn * 64;
    P.bias = (tn < 23) ? ((const float*)(F.ws + WS_BIAS))[(size_t)(l * 5 + cond) * 2944 + nb + F.lane] : 0.f;
    const float* gp = nullptr;
    if (tn >= 6 && tn < 9) gp = pin(F, I_GQN) + l * 64;
    else if (tn == 9) gp = pin(F, I_GKN) + l * 64;
    else if (tn == 11 || tn == 12) gp = pin(F, I_MQN) + l * 256 + (nb - 1408);
    else if (tn == 13) gp = pin(F, I_MKVN) + l * 128 + wn * 64;
    P.gain = gp ? gp[F.lane] : 1.f;
}
__device__ __forceinline__ void epi_gemm1(const Frame& F, const Params& p, GemmAcc8& acc, int tn, int wn, int tm, int l, const Gemm1Pre& P, bool ckv_tile) {
    int lane = F.lane; const int wm = F.w >> 2;
    asm volatile("" : "+v"(lane));
    const int c15 = lane & 15, g4 = lane >> 4;
    unsigned char* ws = F.ws;
    asm volatile("" : "+s"(ws));
    LAS float* st = (LAS float*)(F.lds + LDS_OST + F.w * OST_BYTES);
    const bool lat = tm >= 16;
    const int b = lat ? ((tm - 16) >> 2) : tm;
    const int nb = tn * 128 + wn * 64;
    LAS float* exb = (LAS float*)(F.lds + LDS_EXB) + F.w * 128;
    exb[lane] = P.bias; exb[64 + lane] = P.gain;
    asm volatile("s_waitcnt lgkmcnt(0)" ::: "memory");
    __builtin_amdgcn_wave_barrier();
    const LAS float* bias = exb;
    float* outp = p.out;
    asm volatile("" : "+s"(outp));
    float ckv_ss[8];
    if (tn < 23) {
#pragma unroll
    for (int mt = 0; mt < 8; ++mt) {
        const int mh = mt & 1;
        const int tok0 = tm * 256 + wm * 128 + (mt >> 1) * 32;
        const int tokb = tok0 + 16 * mh, tok = tokb + c15;
        const int t0 = lat ? ((tok0 - 4096) & 1023) : (tok0 & 255), t = t0 + 16 * mh + c15;
        const float rstd = __shfl(P.rstd[mt >> 2], 16 * (mt & 3) + c15);
        float v[4][4];
#pragma unroll
        for (int nt = 0; nt < 4; ++nt) {
            const f32x4 bq = *(const LAS f32x4*)(bias + 16 * nt + 4 * g4);
#pragma unroll
            for (int i = 0; i < 4; ++i) v[nt][i] = acc[nt][mt][i] * rstd + bq[i];
        }
        const float rowp = (float)(t >> 6), colp = (float)(t & 63);
        const size_t orow0 = (size_t)(b * 4 + l) * 256 + t0;
        if (tn < 2) {
            if (lat) rope64_16(v, rowp, colp, g4);
            stage_write16(st, v, mh, c15, g4);
            if (mh) stage_store_bf16(st, (bf16_t*)(ws + WS_RQ) + (size_t)tok0 * 256 + nb, 256, 1.f, lane);
        } else if (tn < 4) {
            if (lat) rope64_16(v, rowp, colp, g4);
            stage_write16(st, v, mh, c15, g4);
            if (mh) stage_store_bf16(st, (bf16_t*)(ws + WS_RK) + (size_t)tok0 * 256 + (nb - 256), 256, 0.125f, lane);
        } else if (tn < 6) {
            stage_write16(st, v, mh, c15, g4);
            if (mh) stage_store_bf16(st, (bf16_t*)(ws + WS_RV) + (size_t)tok0 * 256 + (nb - 512), 256, 1.f, lane);
        } else if (tn < 9) {
            const float r = rsqrtf(ssq64(v) * (1.f / 64.f) + EPS);
#pragma unroll
            for (int nt = 0; nt < 4; ++nt)
#pragma unroll
                for (int i = 0; i < 4; ++i) v[nt][i] *= r;
            mulvec64(v, exb + 64, g4);
            if (lat) rope64_16(v, rowp, colp, g4);
            stage_write16(st, v, mh, c15, g4);
            if (mh) stage_store_bf16(st, (bf16_t*)(ws + WS_GQ) + (size_t)tok0 * 384 + (nb - 768), 384, QSC_GQA, lane);
        } else if (tn == 9) {
            const float r = rsqrtf(ssq64(v) * (1.f / 64.f) + EPS);
#pragma unroll
            for (int nt = 0; nt < 4; ++nt)
#pragma unroll
                for (int i = 0; i < 4; ++i) v[nt][i] *= r;
            mulvec64(v, exb + 64, g4);
            if (lat) rope64_16(v, rowp, colp, g4);
            stage_write16(st, v, mh, c15, g4);
            if (mh) {
                if (!lat) stage_store_f32(st, outp + O_GK + orow0 * 128 + (nb - 1152), 128, lane);
                stage_store_bf16(st, (bf16_t*)(ws + WS_GK) + (size_t)tok0 * 128 + (nb - 1152), 128, 1.f, lane);
            }
        } else if (tn == 10) {
            stage_write16(st, v, mh, c15, g4);
            if (mh) {
                if (!lat) stage_store_f32(st, outp + O_GV + orow0 * 128 + (nb - 1280), 128, lane);
                stage_store_bf16(st, (bf16_t*)(ws + WS_GV) + (size_t)tok0 * 128 + (nb - 1280), 128, 1.f, lane);
            }
        } else if (tn < 13) {
            const float s2 = ssq64(v);
            if (g4 == 0) __hip_atomic_store((__attribute__((address_space(1))) float*)((float*)(ws + WS_CQSSQ) + (size_t)tok * 4 + ((nb - 1408) >> 6)), s2, __ATOMIC_RELAXED, __HIP_MEMORY_SCOPE_AGENT);
            mulvec64(v, exb + 64, g4);
            stage_write16(st, v, mh, c15, g4);
            if (mh) stage_store_bf16_sc1(st, (bf16_t*)(ws + WS_CQG) + (size_t)tok0 * 256 + (nb - 1408), 256, lane);
        } else if (tn == 13) {
            ckv_ss[mt] = ssq64(v);
            if (g4 == 0) ((LAS float*)(F.lds + LDS_EX))[(wm * 2 + wn) * 128 + mt * 16 + c15] = ckv_ss[mt];
        } else if (tn < 22) {
#pragma unroll
            for (int nt = 0; nt < 4; ++nt)
#pragma unroll
                for (int i = 0; i < 4; ++i) v[nt][i] = silu_f(v[nt][i]);
            stage_write16(st, v, mh, c15, g4);
            if (mh) stage_store_bf16(st, (bf16_t*)(ws + WS_ZS) + (size_t)tok0 * 1024 + (nb - 1792), 1024, 1.f, lane);
        } else {
            if (wn == 0) {
                if (lat) rope32_16(v[0], v[1], rowp, colp, g4);
                stage_write16(st, v, mh, c15, g4);
                if (mh) {
                    if (!lat) stage_store_f32_32(st, outp + O_KPE + orow0 * 32, 32, lane);
                    stage_store_bf16_32(st, (bf16_t*)(ws + WS_KPEB) + (size_t)tok0 * 32, 32, lane);
                }
            }
        }
    }
    }
    if (ckv_tile) {
        __syncthreads();
        if (tn == 13) {
#pragma unroll
        for (int mt = 0; mt < 8; ++mt) {
            const int mh = mt & 1;
            const int tok0 = tm * 256 + wm * 128 + (mt >> 1) * 32;
            const int t0 = lat ? ((tok0 - 4096) & 1023) : (tok0 & 255);
            const float rstd = __shfl(P.rstd[mt >> 2], 16 * (mt & 3) + c15);
            float v[4][4];
#pragma unroll
            for (int nt = 0; nt < 4; ++nt) {
                const f32x4 bq = *(const LAS f32x4*)(bias + 16 * nt + 4 * g4);
#pragma unroll
                for (int i = 0; i < 4; ++i) v[nt][i] = acc[nt][mt][i] * rstd + bq[i];
            }
            const float tot = ckv_ss[mt] + ((const LAS float*)(F.lds + LDS_EX))[(wm * 2 + (wn ^ 1)) * 128 + mt * 16 + c15];
            const float r = rsqrtf(tot * (1.f / 128.f) + EPS);
#pragma unroll
            for (int nt = 0; nt < 4; ++nt)
#pragma unroll
                for (int i = 0; i < 4; ++i) v[nt][i] *= r;
            mulvec64(v, exb + 64, g4);
            const size_t orow0 = (size_t)(b * 4 + l) * 256 + t0;
            stage_write16(st, v, mh, c15, g4);
            if (mh) {
                if (!lat) stage_store_f32(st, outp + O_CKV + orow0 * 128 + wn * 64, 128, lane);
                stage_store_bf16_sc1(st, (bf16_t*)(ws + WS_CKVN) + (size_t)tok0 * 128 + wn * 64, 128, lane);
            }
        }
        }
        __syncthreads();
    }
}

__device__ __forceinline__ void qm_pre(const Frame& F, int tm, float& rstd) {
    const int tok = tm * 256 + (F.w >> 1) * 64 + F.lane;
    const f32x4 q4 = *(const f32x4*)((const float*)(F.ws + WS_CQSSQ) + (size_t)tok * 4);
    rstd = rsqrtf(((q4[0] + q4[1]) + (q4[2] + q4[3])) * (1.f / 256.f) + EPS);
}
__device__ __forceinline__ void epi_qm(const Frame& F, GemmAcc& acc, int tn, int tm, float rstdl) {
    int lane = F.lane; const int wn = F.w & 1, wm = F.w >> 1;
    asm volatile("" : "+v"(lane));
    const int c15 = lane & 15, g4 = lane >> 4;
    unsigned char* ws = F.ws;
    LAS float* st = (LAS float*)(F.lds + LDS_OST + F.w * OST_BYTES);
    const bool lat = tm >= 16;
    const int nb = tn * 128 + wn * 64;
    if (nb >= 576) return;
#pragma unroll
    for (int mt = 0; mt < 4; ++mt) {
        const int mh = mt & 1;
        const int tok0 = tm * 256 + wm * 64 + (mt >> 1) * 32, tok = tok0 + 16 * mh + c15;
        const int t = lat ? ((tok - 4096) & 1023) : (tok & 255);
        const float rstd = __shfl(rstdl, 16 * mt + c15);
        const float rowp = (float)(t >> 6), colp = (float)(t & 63);
        float v[4][4];
#pragma unroll
        for (int nt = 0; nt < 4; ++nt)
#pragma unroll
            for (int i = 0; i < 4; ++i) v[nt][i] = acc[nt][mt][i] * rstd;
#pragma unroll
        for (int q = 0; q < 2; ++q) {
            const int T = (nb + 32 * q) >> 5;
            if (lat && (T % 3) == 2) rope32_16(v[2 * q], v[2 * q + 1], rowp, colp, g4);
        }
        stage_write16(st, v, mh, c15, g4);
        if (mh) stage_store_bf16(st, (bf16_t*)(ws + WS_QM) + (size_t)tok0 * 576 + nb, 576, QSC_MLA, lane);
    }
}
__device__ __forceinline__ void epi_plain(const Frame& F, GemmAcc& acc, bf16_t* D, int ldd, int row0, int n0) {
    int lane = F.lane; const int wn = F.w & 1, wm = F.w >> 1;
    asm volatile("" : "+v"(lane));
    const int c15 = lane & 15, g4 = lane >> 4;
    LAS float* st = (LAS float*)(F.lds + LDS_OST + F.w * OST_BYTES);
#pragma unroll
    for (int mt = 0; mt < 4; ++mt) {
        const int r0 = row0 + wm * 64 + (mt >> 1) * 32;
        stage_write16a(st, acc, mt, c15, g4);
        if (mt & 1) stage_store_bf16(st, D + (size_t)r0 * ldd + n0 + wn * 64, ldd, 1.f, lane);
    }
}

struct Gemm2Pre { f32x4 gt0, gt1, gs0, gs1; };
__device__ __forceinline__ void gemm2_pre(const Frame& F, int tn, int tm, int l, Gemm2Pre& P) {
    const bool lat = tm >= 16; const int cond = lat ? 1 + ((tm - 16) >> 2) : 0;
    const int nb = tn * 128 + (F.w & 1) * 64, c8 = (F.lane & 7) * 8;
    const float* gtp = (const float*)(F.ws + WS_MODS) + (size_t)(l * 5 + cond) * 3072 + 2048 + nb + c8;
    const float* gsp = (const float*)(F.ws + WS_GS) + (size_t)((l < 3 ? l + 1 : 3) * 5 + cond) * 1024 + nb + c8;
    P.gt0 = *(const f32x4*)gtp; P.gt1 = *(const f32x4*)(gtp + 4);
    P.gs0 = *(const f32x4*)gsp; P.gs1 = *(const f32x4*)(gsp + 4);
}
__device__ __forceinline__ void epi_gemm2(const Frame& F, const Params& p, GemmAcc& acc, int tn, int tm, int l, const Gemm2Pre& P, bool last) {
    int lane = F.lane; const int wn = F.w & 1, wm = F.w >> 1;
    asm volatile("" : "+v"(lane));
    const int c15 = lane & 15, g4 = lane >> 4;
    unsigned char* ws = F.ws;
    LAS float* st = (LAS float*)(F.lds + LDS_OST + F.w * OST_BYTES);
    const bool lat = tm >= 16;
    const int nb = tn * 128 + wn * 64;
    const int c8 = (lane & 7) * 8, r8 = lane >> 3;
#pragma unroll
    for (int mt = 0; mt < 2; ++mt) {
        const int tok0 = tm * 256 + wm * 64 + mt * 32;
        stage_write16a(st, acc, 2 * mt, c15, g4);
        stage_write16a(st, acc, 2 * mt + 1, c15, g4);
        bf16_t* xb0 = (bf16_t*)(ws + WS_XB) + (size_t)tok0 * 1024 + nb + c8;
        f32x4 xo8[8];
        if (l == 0) {
            const float* xold0 = lat ? pin(F, I_XS) + (size_t)(tok0 - 4096) * 1024 : pin(F, I_XP) + (size_t)tok0 * 1024;
#pragma unroll
            for (int it = 0; it < 4; ++it) {
                const float* xp = xold0 + (size_t)(it * 8 + r8) * 1024 + nb + c8;
                xo8[2 * it] = __builtin_nontemporal_load((const f32x4*)xp); xo8[2 * it + 1] = __builtin_nontemporal_load((const f32x4*)(xp + 4));
            }
        } else {
#pragma unroll
            for (int it = 0; it < 4; ++it) {
                const u32x4 q = *(const u32x4*)(xb0 + (size_t)(it * 8 + r8) * 1024);
                xo8[2 * it] = (f32x4){bflo(q.x), bfhi(q.x), bflo(q.y), bfhi(q.y)}; xo8[2 * it + 1] = (f32x4){bflo(q.z), bfhi(q.z), bflo(q.w), bfhi(q.w)};
            }
        }
#pragma unroll
        for (int it = 0; it < 4; ++it) {
            const int row = it * 8 + r8;
            const f32x4 a0 = *(const LAS f32x4*)(st + row * OST_LD + c8), a1 = *(const LAS f32x4*)(st + row * OST_LD + c8 + 4);
            const f32x4 xn0 = xo8[2 * it] + P.gt0 * a0, xn1 = xo8[2 * it + 1] + P.gt1 * a1;
            {
                u32x4 o; o.x = pk2(xn0[0], xn0[1]); o.y = pk2(xn0[2], xn0[3]); o.z = pk2(xn1[0], xn1[1]); o.w = pk2(xn1[2], xn1[3]);
                if (last) ST16_WT(xb0 + (size_t)row * 1024, o); else *(u32x4*)(xb0 + (size_t)row * 1024) = o;
            }
            float ss = ((xn0[0] * xn0[0] + xn0[1] * xn0[1]) + (xn0[2] * xn0[2] + xn0[3] * xn0[3])) + ((xn1[0] * xn1[0] + xn1[1] * xn1[1]) + (xn1[2] * xn1[2] + xn1[3] * xn1[3]));
            ss += __shfl_xor(ss, 1); ss += __shfl_xor(ss, 2); ss += __shfl_xor(ss, 4);
            if ((lane & 7) == 0) {
                float* sq = (float*)(ws + WS_SSQ) + (size_t)(tok0 + row) * 16 + tn * 2 + wn;
                __hip_atomic_store((__attribute__((address_space(1))) float*)sq, ss, __ATOMIC_RELAXED, __HIP_MEMORY_SCOPE_AGENT);
            }
            if (l < 3) {
                u32x4 o; o.x = pk2(xn0[0] * P.gs0[0], xn0[1] * P.gs0[1]); o.y = pk2(xn0[2] * P.gs0[2], xn0[3] * P.gs0[3]);
                o.z = pk2(xn1[0] * P.gs1[0], xn1[1] * P.gs1[1]); o.w = pk2(xn1[2] * P.gs1[2], xn1[3] * P.gs1[3]);
                ST16_WT((bf16_t*)(ws + WS_XG) + (size_t)(tok0 + row) * 1024 + nb + c8, o);
            }
        }
    }
}

__device__ __forceinline__ void epi_kpe(const Frame& F, const Params& p, GemmAcc2& acc, int tm, int l, const Gemm1Pre& P) {
    int lane = F.lane; const int wm = F.w >> 2;
    asm volatile("" : "+v"(lane));
    const int c15 = lane & 15, g4 = lane >> 4;
    unsigned char* ws = F.ws;
    asm volatile("" : "+s"(ws));
    float* outp = p.out;
    asm volatile("" : "+s"(outp));
    LAS float* st = (LAS float*)(F.lds + LDS_OST + F.w * OST_BYTES);
    const bool lat = tm >= 16;
    const int b = lat ? ((tm - 16) >> 2) : tm;
    LAS float* exb = (LAS float*)(F.lds + LDS_EXB) + F.w * 128;
    exb[lane] = P.bias;
    asm volatile("s_waitcnt lgkmcnt(0)" ::: "memory");
    __builtin_amdgcn_wave_barrier();
#pragma unroll
    for (int mt = 0; mt < 8; ++mt) {
        const int mh = mt & 1;
        const int tok0 = tm * 256 + wm * 128 + (mt >> 1) * 32;
        const int t0 = lat ? ((tok0 - 4096) & 1023) : (tok0 & 255), t = t0 + 16 * mh + c15;
        const float rstd = __shfl(P.rstd[mt >> 2], 16 * (mt & 3) + c15);
        float v[4][4];
#pragma unroll
        for (int nt = 0; nt < 2; ++nt) {
            const f32x4 bq = *(const LAS f32x4*)(exb + 16 * nt + 4 * g4);
#pragma unroll
            for (int i = 0; i < 4; ++i) { v[nt][i] = acc[nt][mt][i] * rstd + bq[i]; v[2 + nt][i] = 0.f; }
        }
        const float rowp = (float)(t >> 6), colp = (float)(t & 63);
        const size_t orow0 = (size_t)(b * 4 + l) * 256 + t0;
        if (lat) rope32_16(v[0], v[1], rowp, colp, g4);
        stage_write16(st, v, mh, c15, g4);
        if (mh) {
            if (!lat) stage_store_f32_32(st, outp + O_KPE + orow0 * 32, 32, lane);
            stage_store_bf16_32(st, (bf16_t*)(ws + WS_KPEB) + (size_t)tok0 * 32, 32, lane);
        }
    }
}
constexpr int AT_STG = 20480, AT_PE = 8192, AT_V = 12288, AT_OLD = 68;
struct AttnUnit {
    int mode;
    int nt0, nt1;
    const bf16_t *q; int q_ld;
    const bf16_t *k0, *k1; int k_ld0, k_ld1;
    const bf16_t *pe0, *pe1;
    const bf16_t *v0, *v1; int v_ld0, v_ld1;
    int tok0;
    int ycol;
    int qpos0, L;
    float lf, lb;
    const bf16_t *s0f, *s0b;
    unsigned* zflag;
    unsigned* yflag;
    float* st_out;
};
__device__ __forceinline__ s16x4 tr16(LAS const unsigned char* p) {
    typedef short v4i16_t __attribute__((ext_vector_type(4)));
    return __builtin_bit_cast(s16x4, __builtin_amdgcn_ds_read_tr16_b64_v4i16((LAS v4i16_t*)p));
}

template <int MODE>
__device__ __forceinline__ void attn_unit(const Frame& F, const Params& p, const AttnUnit& U) {
    constexpr int NQS = MODE == 1 ? 6 : 4;
    int lane = F.lane; const int w = F.w;
    asm volatile("" : "+v"(lane));
    const int h = lane >> 5, lq = lane & 31;
    LAS unsigned char* lds = F.lds;
    const int k_ld = U.k_ld1, v_ld = U.v_ld1;
    const int krow = 8 * w + (lane >> 3);
    const int koff = krow * k_ld + ((lane & 7) ^ ((krow >> 1) & 7)) * 8;
    const int poff = (16 * (w & 3) + (lane >> 2)) * 32 + ((lane & 3) ^ ((lane >> 4) & 3)) * 8;
    const int vdblk = w >> 2, vkg = w & 3;
    const int voff = (16 * vkg + (lane >> 2)) * v_ld + vdblk * 32 + (lane & 3) * 8;
    const int vdst = AT_V + vdblk * 4096 + vkg * 1024;
    const int nt0 = U.nt0, ntot = U.nt0 + U.nt1;
    const unsigned ldsb = (unsigned)(uintptr_t)lds;
#define AT_DMA(gsrc, ldsoff) do { unsigned _keep; const unsigned _d = (unsigned)__builtin_amdgcn_readfirstlane((int)(ldsb + (unsigned)(ldsoff))); \
        asm volatile("s_mov_b32 %0, m0\n\ts_mov_b32 m0, %2\n\ts_nop 0\n\tglobal_load_lds_dwordx4 %1, off\n\ts_mov_b32 m0, %0" : "=&s"(_keep) : "v"(gsrc), "s"(_d) : "memory"); } while (0)
#define AT_ISSUE(t, st) do { const int _t = (t); const int _b = (st) * AT_STG; \
        const bool _s0 = _t < nt0; const int _u = _s0 ? _t : _t - nt0; \
        const bf16_t* _kb = (_s0 ? U.k0 : U.k1) + (size_t)_u * 64 * k_ld; const bf16_t* _vb = (_s0 ? U.v0 : U.v1) + (size_t)_u * 64 * v_ld; \
        AT_DMA(_kb + koff, _b + (8 * w) * 128); \
        if (MODE == 1) { const bf16_t* _pb = (_s0 ? U.pe0 : U.pe1) + (size_t)_u * 64 * 32; AT_DMA(_pb + poff, _b + AT_PE + 16 * (w & 3) * 64); } \
        AT_DMA(_vb + voff, _b + vdst); } while (0)
    AT_ISSUE(0, 0);
    if (ntot > 1) AT_ISSUE(1, 1);
    bf16x8 qr[NQS];
    if (MODE == 3) {
        const int dk = 32 * (w & 1) + lq;
#pragma unroll
        for (int s = 0; s < 4; ++s)
#pragma unroll
            for (int j = 0; j < 8; ++j) qr[s][j] = (16 * s + 8 * h + j == dk) ? (short)0x3F80 : (short)0;
    } else {
        const bf16_t* qp = U.q + (size_t)(32 * w + lq) * U.q_ld + 8 * h;
#pragma unroll
        for (int s = 0; s < NQS; ++s) qr[s] = *(const bf16x8*)(qp + 16 * s);
    }
    f32x16 o[2];
#pragma unroll
    for (int d = 0; d < 2; ++d)
#pragma unroll
        for (int r = 0; r < 16; ++r) o[d][r] = 0.f;
    float m_run = 0.f, l_run = 0.f;
    f32x16 negm;
#pragma unroll
    for (int r = 0; r < 16; ++r) negm[r] = 0.f;
    const int qpos = U.qpos0 + 32 * w + lq;
    const float st_slope = ((w >> 1) & 1) ? U.lb : -U.lf, st_off = ((w >> 1) & 1) ? 0.f : 255.f * U.lf;
    const int sdir = (w >> 1) & 1;
    LAS float* scal = (LAS float*)(lds + LDS_SCAL) + w * 32;
    LAS float* ctab = (LAS float*)(lds + LDS_EXB) + w * 128;
    float a_f = 0.f, a_b = 0.f;
    if (MODE == 2) {
        ctab[lane] = __builtin_amdgcn_exp2f((float)(63 - lane) * U.lf);
        ctab[64 + lane] = __builtin_amdgcn_exp2f((float)lane * U.lb);
        a_f = __builtin_amdgcn_exp2f((float)(32 * w + lq) * U.lf);
        a_b = __builtin_amdgcn_exp2f((float)(255 - 32 * w - lq) * U.lb);
        asm volatile("s_waitcnt lgkmcnt(0)" ::: "memory");
        __builtin_amdgcn_wave_barrier();
    }
    const int kfo = lq * 128, sw = (lane >> 1) & 7, pfo = AT_PE + lq * 64, psw = (lane >> 2) & 3;
    const int vfo = AT_V + (4 * h + ((lane & 15) >> 2)) * 64 + ((lane >> 4) & 1) * 32 + (lane & 3) * 8;
    int st = 0;
    for (int t = 0; t < ntot; ++t) {
        if (t + 1 < ntot) { if (MODE == 1) asm volatile("s_waitcnt vmcnt(3)" ::: "memory"); else asm volatile("s_waitcnt vmcnt(2)" ::: "memory"); }
        else asm volatile("s_waitcnt vmcnt(0)" ::: "memory");
        __builtin_amdgcn_s_barrier();
        asm volatile("" ::: "memory");
        const int st2 = st == 0 ? 2 : st - 1;
        if (t + 2 < ntot) AT_ISSUE(t + 2, st2);
        LAS const unsigned char* base = lds + st * AT_STG;
        bf16x8 kfa[NQS], kfb[NQS];
#pragma unroll
        for (int s = 0; s < 4; ++s) {
            const int so = ((2 * s + h) ^ sw) << 4;
            kfa[s] = *(const LAS bf16x8*)(base + kfo + so);
            kfb[s] = *(const LAS bf16x8*)(base + kfo + 4096 + so);
        }
        if (MODE == 1) {
#pragma unroll
            for (int s = 0; s < 2; ++s) {
                const int so = ((2 * s + h) ^ psw) << 4;
                kfa[4 + s] = *(const LAS bf16x8*)(base + pfo + so);
                kfb[4 + s] = *(const LAS bf16x8*)(base + pfo + 2048 + so);
            }
        }
        f32x16 p0, p1;
        if (MODE <= 1) { p0 = negm; p1 = negm; }
        else {
#pragma unroll
            for (int r = 0; r < 16; ++r) { p0[r] = 0.f; p1[r] = 0.f; }
        }
#pragma unroll
        for (int s = 0; s < NQS; ++s) { p0 = MFMA32(kfa[s], qr[s], p0); p1 = MFMA32(kfb[s], qr[s], p1); }
        s16x4 vlo[4], vhi[4];
#pragma unroll
        for (int ks = 0; ks < 4; ++ks) { vlo[ks] = tr16(base + vfo + ks * 1024); vhi[ks] = tr16(base + vfo + ks * 1024 + 512); }
        if (MODE <= 1) {
            float tm = p0[0];
#pragma unroll
            for (int r = 1; r < 16; ++r) tm = fmaxf(tm, p0[r]);
#pragma unroll
            for (int r = 0; r < 16; ++r) tm = fmaxf(tm, p1[r]);
            tm = fmaxf(tm, __shfl_xor(tm, 32));
            if (t == 0 || __any(tm > 6.0f)) {
                const float dl = t == 0 ? tm : fmaxf(tm, 0.f);
                m_run += dl;
#pragma unroll
                for (int r = 0; r < 16; ++r) { p0[r] -= dl; p1[r] -= dl; negm[r] = -m_run; }
                if (t > 0) {
                    const float alpha = __builtin_amdgcn_exp2f(-dl);
                    l_run *= alpha;
                    if (h == 0) scal[lq] = alpha;
                    asm volatile("s_waitcnt lgkmcnt(0)" ::: "memory");
#pragma unroll
                    for (int g = 0; g < 4; ++g) {
                        const f32x4 a4 = *(const LAS f32x4*)(scal + 8 * g + 4 * h);
#pragma unroll
                        for (int i = 0; i < 4; ++i) { o[0][4 * g + i] *= a4[i]; o[1][4 * g + i] *= a4[i]; }
                    }
                }
            }
            float ls = 0.f;
#pragma unroll
            for (int r = 0; r < 16; ++r) { p0[r] = __builtin_amdgcn_exp2f(p0[r]); p1[r] = __builtin_amdgcn_exp2f(p1[r]); ls += p0[r] + p1[r]; }
            l_run += ls;
        } else if (MODE == 2 && (64 * t + 63 < U.qpos0 || 64 * t > U.qpos0 + 255)) {
            const bool fwd = 64 * t + 63 < U.qpos0;
            const float A = fwd ? a_f * __builtin_amdgcn_exp2f((float)(U.qpos0 - 64 * t - 63) * U.lf) : a_b * __builtin_amdgcn_exp2f((float)(64 * t - U.qpos0 - 255) * U.lb);
            const LAS float* tb = ctab + (fwd ? 0 : 64) + 4 * h;
#pragma unroll
            for (int g = 0; g < 4; ++g) {
                const f32x4 c0 = *(const LAS f32x4*)(tb + 8 * g), c1 = *(const LAS f32x4*)(tb + 32 + 8 * g);
#pragma unroll
                for (int i = 0; i < 4; ++i) { p0[4 * g + i] *= c0[i] * A; p1[4 * g + i] *= c1[i] * A; }
            }
        } else if (MODE == 2) {
            float dq = (float)(qpos - 64 * t - 4 * h);
            asm volatile("" : "+v"(dq));
#pragma unroll
            for (int r = 0; r < 16; ++r) {
                const float d0 = dq - (float)((r & 3) + 8 * (r >> 2)), d1 = d0 - 32.f;
                const float w0 = __builtin_amdgcn_exp2f(fabsf(d0) * (d0 > 0.f ? U.lf : U.lb));
                const float w1 = __builtin_amdgcn_exp2f(fabsf(d1) * (d1 > 0.f ? U.lf : U.lb));
                p0[r] *= (d0 == 0.f ? 2.f : w0);
                p1[r] *= (d1 == 0.f ? 2.f : w1);
            }
        } else {
            float mb = (float)(64 * t + 4 * h);
            asm volatile("" : "+v"(mb));
#pragma unroll
            for (int r = 0; r < 16; ++r) {
                const float m0 = mb + (float)((r & 3) + 8 * (r >> 2)), m1 = m0 + 32.f;
                const float e0 = fmaf(m0, st_slope, st_off), e1 = fmaf(m1, st_slope, st_off);
                p0[r] *= __builtin_amdgcn_exp2f(e0);
                p1[r] *= __builtin_amdgcn_exp2f(e1);
            }
        }
        bf16x8 pa[4];
        { u32x4 a;
          a.x = pk2(p0[0], p0[1]); a.y = pk2(p0[2], p0[3]); a.z = pk2(p0[4], p0[5]); a.w = pk2(p0[6], p0[7]); pa[0] = __builtin_bit_cast(bf16x8, a);
          a.x = pk2(p0[8], p0[9]); a.y = pk2(p0[10], p0[11]); a.z = pk2(p0[12], p0[13]); a.w = pk2(p0[14], p0[15]); pa[1] = __builtin_bit_cast(bf16x8, a);
          a.x = pk2(p1[0], p1[1]); a.y = pk2(p1[2], p1[3]); a.z = pk2(p1[4], p1[5]); a.w = pk2(p1[6], p1[7]); pa[2] = __builtin_bit_cast(bf16x8, a);
          a.x = pk2(p1[8], p1[9]); a.y = pk2(p1[10], p1[11]); a.z = pk2(p1[12], p1[13]); a.w = pk2(p1[14], p1[15]); pa[3] = __builtin_bit_cast(bf16x8, a); }
#pragma unroll
        for (int ks = 0; ks < 4; ++ks) {
            const bf16x8 vb = __builtin_shufflevector(vlo[ks], vhi[ks], 0, 1, 2, 3, 4, 5, 6, 7);
            o[0] = MFMA32(pa[ks], vb, o[0]);
        }
#pragma unroll
        for (int ks = 0; ks < 4; ++ks) { vlo[ks] = tr16(base + vfo + 4096 + ks * 1024); vhi[ks] = tr16(base + vfo + 4096 + ks * 1024 + 512); }
#pragma unroll
        for (int ks = 0; ks < 4; ++ks) {
            const bf16x8 vb = __builtin_shufflevector(vlo[ks], vhi[ks], 0, 1, 2, 3, 4, 5, 6, 7);
            o[1] = MFMA32(pa[ks], vb, o[1]);
        }
        st = st == 2 ? 0 : st + 1;
    }
#undef AT_ISSUE
#undef AT_DMA
    int lq2 = lq, h2 = h, lane2 = lane; asm volatile("" : "+v"(lq2), "+v"(h2), "+v"(lane2));
    if (MODE == 2 && U.s0f != nullptr) {
        const float ff = __builtin_amdgcn_exp2f((float)(qpos + 1) * U.lf), fb = __builtin_amdgcn_exp2f((float)(U.L - qpos) * U.lb);
#pragma unroll
        for (int s = 0; s < 4; ++s) {
            const u32x4 qu = __builtin_bit_cast(u32x4, qr[s]);
            u32x4 af, ab;
#pragma unroll
            for (int i = 0; i < 4; ++i) { const float lo = bflo(qu[i]), hi = bfhi(qu[i]); af[i] = pk2(lo * ff, hi * ff); ab[i] = pk2(lo * fb, hi * fb); }
#pragma unroll
            for (int d = 0; d < 2; ++d) {
                const bf16x8 sf = *(const bf16x8*)(U.s0f + (size_t)(32 * d + lq2) * 64 + 16 * s + 8 * h2);
                const bf16x8 sb = *(const bf16x8*)(U.s0b + (size_t)(32 * d + lq2) * 64 + 16 * s + 8 * h2);
                o[d] = MFMA32(__builtin_bit_cast(bf16x8, af), sf, o[d]);
                o[d] = MFMA32(__builtin_bit_cast(bf16x8, ab), sb, o[d]);
            }
        }
    }
    if (MODE == 3) {
        float* dst = U.st_out + (size_t)sdir * 4 * 4096 + (size_t)(32 * (w & 1)) * 64;
        if (w < 4) {
#pragma unroll
        for (int d = 0; d < 2; ++d)
#pragma unroll
            for (int r = 0; r < 16; ++r) dst[(size_t)((r & 3) + 8 * (r >> 2) + 4 * h2) * 64 + 32 * d + lq2] = o[d][r];
        }
        __syncthreads();
        if (F.tid == 0 && U.yflag != nullptr) (void)xb_add(U.yflag, 1u);
        return;
    }
    if (MODE <= 1) {
        l_run += __shfl_xor(l_run, 32);
        if (h2 == 0) scal[lq2] = 1.f / l_run;
    }
    if (U.zflag != nullptr && F.tid == 0) {
        unsigned* bar0 = (unsigned*)(F.ws + WS_CTL) + CW_BAR;
        XB_SPIN(xb_ld(U.zflag) < 4u, bar0);
    }
    __syncthreads();
    LAS float* ost = (LAS float*)lds + w * (32 * AT_OLD);
#pragma unroll
    for (int d = 0; d < 2; ++d)
#pragma unroll
        for (int r = 0; r < 16; ++r) ost[((r & 3) + 8 * (r >> 2) + 4 * h2) * AT_OLD + 32 * d + lq2] = o[d][r];
    asm volatile("s_waitcnt lgkmcnt(0)" ::: "memory");
    __builtin_amdgcn_wave_barrier();
    const bf16_t* zs = (const bf16_t*)(F.ws + WS_ZS);
    bf16_t* yb = (bf16_t*)(F.ws + WS_Y);
#pragma unroll
    for (int it = 0; it < 4; ++it) {
        const int row = it * 8 + (lane2 >> 3), c8 = (lane2 & 7) * 8;
        const f32x4 x0 = *(const LAS f32x4*)(ost + row * AT_OLD + c8), x1 = *(const LAS f32x4*)(ost + row * AT_OLD + c8 + 4);
        float sc;
        if (MODE <= 1) sc = scal[row];
        else {
            float ss = (x0[0] * x0[0] + x0[1] * x0[1]) + (x0[2] * x0[2] + x0[3] * x0[3]) + (x1[0] * x1[0] + x1[1] * x1[1]) + (x1[2] * x1[2] + x1[3] * x1[3]);
            ss += __shfl_xor(ss, 1); ss += __shfl_xor(ss, 2); ss += __shfl_xor(ss, 4);
            sc = rsqrtf(ss * (1.f / 64.f) + EPS);
        }
        const size_t off = (size_t)(U.tok0 + 32 * w + row) * 1024 + U.ycol + c8;
        const u32x4 z = *(const u32x4*)(zs + off);
        u32x4 y;
        y.x = pk2(x0[0] * sc * bflo(z.x), x0[1] * sc * bfhi(z.x));
        y.y = pk2(x0[2] * sc * bflo(z.y), x0[3] * sc * bfhi(z.y));
        y.z = pk2(x1[0] * sc * bflo(z.z), x1[1] * sc * bfhi(z.z));
        y.w = pk2(x1[2] * sc * bflo(z.w), x1[3] * sc * bfhi(z.w));
        ST16_WT(yb + off, y);
    }
    asm volatile("s_waitcnt vmcnt(0)" ::: "memory");
    __syncthreads();
    if (F.tid == 0) (void)xb_add(U.yflag, 1u);
}

__device__ __forceinline__ void dep_wait(const Frame& F, unsigned* c, int n, unsigned target, unsigned* c2 = nullptr, unsigned target2 = 0u) {
    if (F.w == 0) {
        const int ln = lane_id();
        unsigned* ptr = c + 4 * ln; unsigned tgt = target;
        if (c2 != nullptr && ln == n) { ptr = c2; tgt = target2; }
        poll_lanes(ptr, tgt, ln < n + (c2 != nullptr ? 1 : 0), (unsigned*)(F.ws + WS_CTL) + CW_BAR);
    }
}
__device__ __forceinline__ void attn_dispatch(const Frame& F, const Params& p, int u, int l) {
    unsigned char* ws = F.ws;
    AttnUnit U;
    U.nt0 = 0; U.nt1 = 0; U.q = nullptr; U.q_ld = 0; U.k0 = U.k1 = nullptr; U.k_ld0 = U.k_ld1 = 0; U.pe0 = U.pe1 = nullptr; U.v0 = U.v1 = nullptr; U.v_ld0 = U.v_ld1 = 0;
    U.tok0 = 0; U.ycol = 0; U.qpos0 = 0; U.L = 0; U.lf = U.lb = 0.f; U.s0f = U.s0b = nullptr; U.st_out = nullptr; U.mode = 0; U.yflag = nullptr; U.zflag = nullptr;
    const bf16_t* GQ = (const bf16_t*)(ws + WS_GQ); const bf16_t* GK = (const bf16_t*)(ws + WS_GK); const bf16_t* GV = (const bf16_t*)(ws + WS_GV);
    const bf16_t* QM = (const bf16_t*)(ws + WS_QM); const bf16_t* KVM = (const bf16_t*)(ws + WS_KVM); const bf16_t* KVMC = (const bf16_t*)(ws + WS_KVMC);
    const bf16_t* KPEB = (const bf16_t*)(ws + WS_KPEB); const bf16_t* CKPE = (const bf16_t*)(ws + WS_CKPE);
    const bf16_t* CGK = (const bf16_t*)(ws + WS_CGK); const bf16_t* CGV = (const bf16_t*)(ws + WS_CGV);
    const bf16_t* RQ = (const bf16_t*)(ws + WS_RQ); const bf16_t* RK = (const bf16_t*)(ws + WS_RK); const bf16_t* RV = (const bf16_t*)(ws + WS_RV);
    const float* decay = pin(F, I_DECAY) + l * 8;
    if (u < 96 || (u >= 256 && u < 352)) {
        const bool lat = u < 96; const int uu = lat ? u : u - 256;
        const int b = lat ? uu / 24 : uu / 6, hh = lat ? (uu >> 2) % 6 : uu % 6, qb = lat ? (uu & 3) : 0;
        const int seq0 = lat ? 4096 + b * 1024 : b * 256;
        U.mode = 1; U.tok0 = seq0 + qb * 256; U.q = QM + (size_t)U.tok0 * 576 + hh * 96; U.q_ld = 576; U.ycol = 640 + hh * 64;
        U.nt1 = lat ? 16 : 4; U.k1 = KVM + (size_t)seq0 * 768 + hh * 128; U.k_ld1 = 768; U.v1 = U.k1 + 64; U.v_ld1 = 768; U.pe1 = KPEB + (size_t)seq0 * 32;
        U.k0 = U.k1; U.v0 = U.v1; U.pe0 = U.pe1; U.k_ld0 = 768; U.v_ld0 = 768;
        if (lat) { U.nt0 = 8; U.k0 = KVMC + (size_t)(b * 512) * 768 + hh * 128; U.v0 = U.k0 + 64; U.pe0 = CKPE + (size_t)((b * 4 + l) * 512) * 32; }
        U.yflag = (unsigned*)(ws + WS_CTL) + CW_YRDY + (l * 32 + (U.tok0 >> 8)) * 4;
        { unsigned* c = (unsigned*)(ws + WS_CTL);
          dep_wait(F, c + CW_FULL + (l * 32 + (seq0 >> 8)) * 4, lat ? 4 : 1, 23u, lat ? c + CW_KC + (l * 4 + b) * 4 : nullptr, 12u); }
        __syncthreads();
        attn_unit<1>(F, p, U);
    } else if (u < 192 || (u >= 352 && u < 448)) {
        const bool lat = u < 192; const int uu = lat ? u - 96 : u - 352;
        const int b = lat ? uu / 24 : uu / 6, hh = lat ? (uu >> 2) % 6 : uu % 6, qb = lat ? (uu & 3) : 0, kvh = hh / 3;
        const int seq0 = lat ? 4096 + b * 1024 : b * 256;
        U.mode = 0; U.tok0 = seq0 + qb * 256; U.q = GQ + (size_t)U.tok0 * 384 + hh * 64; U.q_ld = 384; U.ycol = 256 + hh * 64;
        U.nt1 = lat ? 16 : 4; U.k1 = GK + (size_t)seq0 * 128 + kvh * 64; U.k_ld1 = 128; U.v1 = GV + (size_t)seq0 * 128 + kvh * 64; U.v_ld1 = 128;
        U.k0 = U.k1; U.v0 = U.v1; U.k_ld0 = 128; U.v_ld0 = 128;
        if (lat) { U.nt0 = 8; U.k0 = CGK + (size_t)((b * 4 + l) * 512) * 128 + kvh * 64; U.v0 = CGV + (size_t)((b * 4 + l) * 512) * 128 + kvh * 64; }
        U.yflag = (unsigned*)(ws + WS_CTL) + CW_YRDY + (l * 32 + (U.tok0 >> 8)) * 4;
        { unsigned* c = (unsigned*)(ws + WS_CTL);
          dep_wait(F, c + CW_RA + (l * 32 + (seq0 >> 8)) * 4, lat ? 4 : 1, 8u);
          U.zflag = c + CW_ZC + (l * 32 + (U.tok0 >> 8)) * 4; }
        __syncthreads();
        attn_unit<0>(F, p, U);
    } else if (u < 256 || (u >= 448 && u < 512)) {
        const bool lat = u < 256; const int uu = lat ? u - 192 : u - 448;
        const int b = lat ? uu / 16 : uu / 4, hh = lat ? (uu >> 2) & 3 : uu & 3, qb = lat ? (uu & 3) : 0;
        const int seq0 = lat ? 4096 + b * 1024 : b * 256;
        U.mode = 2; U.tok0 = seq0 + qb * 256; U.q = RQ + (size_t)U.tok0 * 256 + hh * 64; U.q_ld = 256; U.ycol = hh * 64;
        U.nt1 = lat ? 16 : 4; U.k1 = RK + (size_t)seq0 * 256 + hh * 64; U.k_ld1 = 256; U.v1 = RV + (size_t)seq0 * 256 + hh * 64; U.v_ld1 = 256;
        U.k0 = U.k1; U.v0 = U.v1; U.k_ld0 = 256; U.v_ld0 = 256;
        U.qpos0 = qb * 256; U.L = lat ? 1024 : 256;
        U.lf = -log1pf(__expf(-decay[hh])) * LOG2E; U.lb = -log1pf(__expf(-decay[4 + hh])) * LOG2E;
        if (lat) { const bf16_t* S0T = (const bf16_t*)(ws + WS_S0T); U.s0f = S0T + (size_t)(((b * 4 + l) * 2 + 0) * 4 + hh) * 4096; U.s0b = S0T + (size_t)(((b * 4 + l) * 2 + 1) * 4 + hh) * 4096; }
        U.yflag = (unsigned*)(ws + WS_CTL) + CW_YRDY + (l * 32 + (U.tok0 >> 8)) * 4;
        { unsigned* c = (unsigned*)(ws + WS_CTL);
          dep_wait(F, c + CW_RA + (l * 32 + (seq0 >> 8)) * 4, lat ? 4 : 1, 8u);
          U.zflag = c + CW_ZC + (l * 32 + (U.tok0 >> 8)) * 4; }
        __syncthreads();
        attn_unit<2>(F, p, U);
    } else {
        const int uu = u - 512, b = uu >> 2, hh = uu & 3, seq0 = b * 256;
        U.mode = 3; U.nt1 = 4; U.k1 = RK + (size_t)seq0 * 256 + hh * 64; U.k_ld1 = 256; U.v1 = RV + (size_t)seq0 * 256 + hh * 64; U.v_ld1 = 256;
        U.k0 = U.k1; U.v0 = U.v1; U.k_ld0 = 256; U.v_ld0 = 256;
        U.lf = -log1pf(__expf(-decay[hh])) * LOG2E; U.lb = -log1pf(__expf(-decay[4 + hh])) * LOG2E;
        U.st_out = p.out + O_STATE + (size_t)(((b * 4 + l) * 2 + 0) * 4 + hh) * 4096;
        dep_wait(F, (unsigned*)(ws + WS_CTL) + CW_RA + (l * 32 + b) * 4, 1, 8u);
        U.yflag = (unsigned*)(ws + WS_CTL) + CW_SD + (l * 16 + b) * 4;
        __syncthreads();
        attn_unit<3>(F, p, U);
    }
}
constexpr int N_ATTN_UNITS = 576;
struct TItem { const float* src; bf16_t* dst; int nsrc, K; int valid; };
constexpr int P0_TWIN = 4 * 16 * 92, P0_TWOUT = 4 * 16 * 32, P0_TWUQ = 4 * 4 * 20, P0_TWUKV = 4 * 2 * 24, P0_TR = P0_TWIN + P0_TWOUT + P0_TWUQ + P0_TWUKV;
__device__ __forceinline__ TItem p0_titem(const Frame& F, unsigned char* ws, int it) {
    TItem t; t.valid = it < P0_TR; t.src = nullptr; t.dst = nullptr; t.nsrc = 0; t.K = 0;
    if (!t.valid) return t;
    if (it < P0_TWIN) {
        const int l = it / (16 * 92), r = it % (16 * 92), kb = r / 92, nb = r % 92, n0 = nb * 32;
        const int src = n0 < 1792 ? n0 : (n0 < 2816 ? n0 + 32 : (n0 < 2848 ? n0 - 2816 + 1792 : -1));
        t.nsrc = 2848; t.K = 1024;
        if (src >= 0) t.src = pin(F, I_WIN) + (size_t)l * 1024 * 2848 + (size_t)(kb * 64) * 2848 + src;
        t.dst = (bf16_t*)(ws + WS_WIN) + ((size_t)l * 2944 + n0) * 1024 + kb * 64;
        return t;
    }
    it -= P0_TWIN;
    if (it < P0_TWOUT) {
        const int l = it / 512, r = it % 512, kb = r >> 5, nb = r & 31;
        t.nsrc = 1024; t.K = 1024; t.src = pin(F, I_WOUT) + (size_t)l * 1024 * 1024 + (size_t)(kb * 64) * 1024 + nb * 32;
        t.dst = (bf16_t*)(ws + WS_WOUT) + ((size_t)l * 1024 + nb * 32) * 1024 + kb * 64;
        return t;
    }
    it -= P0_TWOUT;
    if (it < P0_TWUQ) {
        const int l = it / 80, r = it % 80, kb = r / 20, nb = r % 20;
        t.nsrc = 576; t.K = 256; if (nb < 18) t.src = pin(F, I_WUQ) + (size_t)l * 256 * 576 + (size_t)(kb * 64) * 576 + nb * 32;
        t.dst = (bf16_t*)(ws + WS_WUQ) + ((size_t)l * 640 + nb * 32) * 256 + kb * 64;
        return t;
    }
    it -= P0_TWUQ;
    { const int l = it / 48, r = it % 48, kb = r / 24, nb = r % 24;
      t.nsrc = 768; t.K = 128; t.src = pin(F, I_WUKV) + (size_t)l * 128 * 768 + (size_t)(kb * 64) * 768 + nb * 32;
      t.dst = (bf16_t*)(ws + WS_WUKV) + ((size_t)l * 768 + nb * 32) * 128 + kb * 64; }
    return t;
}
__device__ __forceinline__ void p0_tload(const TItem& t, float (&r)[32], int lane) {
    if (t.valid && t.src) {
        const float* wp = t.src + (size_t)(lane >> 5) * t.nsrc + (lane & 31);
#pragma unroll
        for (int i = 0; i < 32; ++i) r[i] = __builtin_nontemporal_load(wp + (size_t)(2 * i) * t.nsrc);
    } else {
#pragma unroll
        for (int i = 0; i < 32; ++i) r[i] = 0.f;
    }
}
__device__ __forceinline__ void p0_tstore(const TItem& t, const float (&r)[32], LAS float* scr, int lane) {
    if (!t.valid) return;
#pragma unroll
    for (int i = 0; i < 32; ++i) scr[(2 * i + (lane >> 5)) * 33 + (lane & 31)] = r[i];
    asm volatile("s_waitcnt lgkmcnt(0)" ::: "memory");
    __builtin_amdgcn_wave_barrier();
    const int c = lane & 7;
#pragma unroll
    for (int j = 0; j < 4; ++j) {
        const int n = (lane >> 3) + 8 * j; const LAS float* s = scr + (8 * c) * 33 + n;
        u32x4 o; o.x = pk2(s[0 * 33], s[1 * 33]); o.y = pk2(s[2 * 33], s[3 * 33]); o.z = pk2(s[4 * 33], s[5 * 33]); o.w = pk2(s[6 * 33], s[7 * 33]);
        ST16_WT(t.dst + (size_t)n * t.K + 8 * c, o);
    }
    asm volatile("s_waitcnt lgkmcnt(0)" ::: "memory");
    __builtin_amdgcn_wave_barrier();
}
__device__ __forceinline__ void cast8(const float* src, bf16_t* dst, size_t e) {
    const f32x4 a = __builtin_nontemporal_load((const f32x4*)(src + e)), b = __builtin_nontemporal_load((const f32x4*)(src + e + 4));
    u32x4 o; o.x = pk2(a[0], a[1]); o.y = pk2(a[2], a[3]); o.z = pk2(b[0], b[1]); o.w = pk2(b[2], b[3]);
    ST16_WT(dst + e, o);
}
constexpr int P0_MODS = 1536, P0_CAST_G = 512, P0_CAST_KPE = 128, P0_S0T = 512;
constexpr int P0_TOTAL = P0_MODS + 3 * P0_CAST_G + P0_CAST_KPE + P0_S0T;
__device__ __forceinline__ void phase0(const Frame& F, const Params& p, bool dup = false) {
    unsigned char* ws = F.ws + (dup ? 162 * MiB : 0); const int lane = F.lane;
    LAS float* scr = (LAS float*)F.lds + F.w * (64 * 33);
    const int gw = blockIdx.x * NWAVE + F.w, ngw = gridDim.x * NWAVE;
#ifndef MK_DUP0
#define MK_DUP0_ 0
#else
#define MK_DUP0_ MK_DUP0
#endif
    if (!(dup && MK_DUP0_ == 2))
    for (int it = gw; it < P0_TR; it += 2 * ngw) {
        const TItem t0 = p0_titem(F, ws, it), t1 = p0_titem(F, ws, it + ngw);
        float r0[32], r1[32];
        p0_tload(t0, r0, lane); p0_tload(t1, r1, lane);
        p0_tstore(t0, r0, scr, lane); p0_tstore(t1, r1, scr, lane);
    }
    if (!(dup && MK_DUP0_ == 1))
    for (int it0 = (gw + ngw - 256) % ngw; it0 < P0_TOTAL; it0 += ngw) {
        int it = it0;
        if (it < P0_MODS) {
            const int l = it / 384, cg = (it % 384) >> 5, ks = it & 31;
            const int j = cg * 256 + lane * 4;
            const float* wp = pin(F, I_WADA) + ((size_t)l * 1024 + ks * 32) * 3072 + j;
            const float* c = pin(F, I_C); const float* cc = pin(F, I_CCTX);
            float sv[3];
#pragma unroll
            for (int q = 0; q < 3; ++q) {
                const int idx = q * 64 + lane, n = idx >> 5, k = idx & 31;
                float x = 0.f;
                if (idx < 160) x = (n == 0) ? cc[ks * 32 + k] : c[(n - 1) * 1024 + ks * 32 + k];
                sv[q] = silu_f(x);
            }
            f32x4 acc[5];
#pragma unroll
            for (int n = 0; n < 5; ++n) acc[n] = (f32x4){0.f, 0.f, 0.f, 0.f};
#pragma unroll 1
            for (int k0 = 0; k0 < 32; k0 += 16) {
                f32x4 wv[16];
#pragma unroll
                for (int k = 0; k < 16; ++k) wv[k] = __builtin_nontemporal_load((const f32x4*)(wp + (size_t)(k0 + k) * 3072));
                __builtin_amdgcn_sched_barrier(0);
#pragma unroll
                for (int k = 0; k < 16; ++k)
#pragma unroll
                    for (int n = 0; n < 5; ++n) {
                        const float s = __int_as_float(__builtin_amdgcn_readlane(__float_as_int(sv[n >> 1]), 32 * (n & 1) + k0 + k));
                        acc[n] += wv[k] * s;
                    }
            }
            LAS f32x4* red = (LAS f32x4*)(F.lds + 69632);
#pragma unroll
            for (int n = 0; n < 5; ++n) red[(F.w * 5 + n) * 64 + lane] = acc[n];
            __syncthreads();
            if (F.tid < 320) {
                const int n = F.tid >> 6;
                f32x4 s = red[n * 64 + lane];
#pragma unroll
                for (int ww = 1; ww < 8; ++ww) s += red[(ww * 5 + n) * 64 + lane];
                if ((ks >> 3) == 0) s += *(const f32x4*)(pin(F, I_BADA) + l * 3072 + j);
                float* mods = (float*)(ws + WS_MODS) + (size_t)(l * 5 + n) * 3072 + j;
#pragma unroll
                for (int e = 0; e < 4; ++e) atomicAdd(mods + e, s[e]);
            }
            __syncthreads();
            continue;
        }
        it -= P0_MODS;
        if (it < 3 * P0_CAST_G) {
            const int which = it / P0_CAST_G, r = it % P0_CAST_G;
            const float* src = which == 0 ? pin(F, I_CGK) : (which == 1 ? pin(F, I_CGV) : pin(F, I_CCKV));
            bf16_t* dst = (bf16_t*)(ws + (which == 0 ? WS_CGK : (which == 1 ? WS_CGV : WS_CCKV)));
#pragma unroll
            for (int q = 0; q < 4; ++q) cast8(src, dst, (size_t)r * 2048 + q * 512 + lane * 8);
            continue;
        }
        it -= 3 * P0_CAST_G;
        if (it < P0_CAST_KPE) {
#pragma unroll
            for (int q = 0; q < 4; ++q) cast8(pin(F, I_CKPE), (bf16_t*)(ws + WS_CKPE), (size_t)it * 2048 + q * 512 + lane * 8);
            continue; }
        it -= P0_CAST_KPE;
        {
            const int mat = it >> 2, qd = it & 3, dv = qd * 16 + (lane >> 2), dk0 = (lane & 3) * 16;
            const float* s = pin(F, I_STATE) + (size_t)mat * 4096 + dv;
            float x[16];
#pragma unroll
            for (int i = 0; i < 16; ++i) x[i] = __builtin_nontemporal_load(s + (dk0 + i) * 64);
            u32x4 o0, o1;
            o0.x = pk2(x[0], x[1]); o0.y = pk2(x[2], x[3]); o0.z = pk2(x[4], x[5]); o0.w = pk2(x[6], x[7]);
            o1.x = pk2(x[8], x[9]); o1.y = pk2(x[10], x[11]); o1.z = pk2(x[12], x[13]); o1.w = pk2(x[14], x[15]);
            bf16_t* d = (bf16_t*)(ws + WS_S0T) + (size_t)mat * 4096 + dv * 64 + dk0;
            ST16_WT(d, o0); ST16_WT(d + 8, o1);
        }
    }
}
constexpr int P1_GS = 80, P1_BIAS = 4 * 368, P1_X = 8192, P1_TOTAL = P1_GS + P1_BIAS + P1_X;
__device__ __forceinline__ void xg_row(const Frame& F, const float* xrow, const float* g, const float* mods_c, bf16_t* xg_row_out, float* ssq_row, bool write_xg) {
    const int lane = F.lane;
    float ss = 0.f;
#pragma unroll
    for (int j = 0; j < 2; ++j) {
        const int k = j * 512 + lane * 8;
        const f32x4 x0 = *(const f32x4*)(xrow + k), x1 = *(const f32x4*)(xrow + k + 4);
        ss += ((x0[0] * x0[0] + x0[1] * x0[1]) + (x0[2] * x0[2] + x0[3] * x0[3])) + ((x1[0] * x1[0] + x1[1] * x1[1]) + (x1[2] * x1[2] + x1[3] * x1[3]));
        if (write_xg) {
            const f32x4 g0 = *(const f32x4*)(g + k), g1 = *(const f32x4*)(g + k + 4), s0 = *(const f32x4*)(mods_c + 1024 + k), s1 = *(const f32x4*)(mods_c + 1024 + k + 4);
            u32x4 o; o.x = pk2(x0[0] * g0[0] * (1.f + s0[0]), x0[1] * g0[1] * (1.f + s0[1])); o.y = pk2(x0[2] * g0[2] * (1.f + s0[2]), x0[3] * g0[3] * (1.f + s0[3]));
            o.z = pk2(x1[0] * g1[0] * (1.f + s1[0]), x1[1] * g1[1] * (1.f + s1[1])); o.w = pk2(x1[2] * g1[2] * (1.f + s1[2]), x1[3] * g1[3] * (1.f + s1[3]));
            ST16_WT(xg_row_out + k, o);
        }
    }
    ss = wsum(ss);
    if (lane < 16) ssq_row[lane] = lane == 0 ? ss : 0.f;
}
__device__ __forceinline__ void phase1(const Frame& F, const Params& p) {
    unsigned char* ws = F.ws; const int lane = F.lane;
    unsigned* ctl = (unsigned*)(ws + WS_CTL);
    const int gw = blockIdx.x * NWAVE + F.w, ngw = gridDim.x * NWAVE;
    const float* mods = (const float*)(ws + WS_MODS);
    for (int it0 = gw; it0 < P1_GS + P1_BIAS; it0 += ngw) {
        int it = it0;
        if (it < P1_GS) {
            const int e = it * 256 + lane * 4, lc = e >> 10, k = e & 1023, l = lc / 5;
            const f32x4 g = *(const f32x4*)(pin(F, I_NORMG) + l * 1024 + k), sc = *(const f32x4*)(mods + (size_t)lc * 3072 + 1024 + k);
            { const f32x4 o = g * (sc + 1.f); ST16_WT((float*)(ws + WS_GS) + e, o); }
            continue;
        }
        it -= P1_GS;
        {
            const int l = it / 368, n0 = (it % 368) * 8;
            f32x4 sh[5][4];
#pragma unroll
            for (int c = 0; c < 5; ++c) {
                const float* shp = mods + (size_t)(l * 5 + c) * 3072 + lane * 16;
#pragma unroll
                for (int i = 0; i < 4; ++i) sh[c][i] = *(const f32x4*)(shp + 4 * i);
            }
            const bf16_t* wr0 = (const bf16_t*)(ws + WS_WIN) + ((size_t)l * 2944 + n0) * 1024 + lane * 16;
            u32x4 w0[8], w1[8];
#pragma unroll
            for (int r = 0; r < 8; ++r) { w0[r] = *(const u32x4*)(wr0 + (size_t)r * 1024); w1[r] = *(const u32x4*)(wr0 + (size_t)r * 1024 + 8); }
#pragma unroll
            for (int r = 0; r < 8; ++r) {
                float wv[16];
#pragma unroll
                for (int i = 0; i < 4; ++i) { wv[2 * i] = bflo(w0[r][i]); wv[2 * i + 1] = bfhi(w0[r][i]); wv[8 + 2 * i] = bflo(w1[r][i]); wv[8 + 2 * i + 1] = bfhi(w1[r][i]); }
#pragma unroll
                for (int c = 0; c < 5; ++c) {
                    float d = 0.f;
#pragma unroll
                    for (int i = 0; i < 4; ++i) { const f32x4 s4 = sh[c][i]; d += (s4[0] * wv[4 * i] + s4[1] * wv[4 * i + 1]) + (s4[2] * wv[4 * i + 2] + s4[3] * wv[4 * i + 3]); }
                    d = wsum(d);
                    if (lane == 0) __hip_atomic_store((__attribute__((address_space(1))) float*)((float*)(ws + WS_BIAS) + (size_t)(l * 5 + c) * 2944 + n0 + r), d, __ATOMIC_RELAXED, __HIP_MEMORY_SCOPE_AGENT);
                }
            }
            if (l == 0) {
                asm volatile("s_waitcnt vmcnt(0)" ::: "memory");
                if (lane == 0) (void)xb_add(ctl + CW_P1B0, 1u);
            }
        }
    }
    for (int vb = blockIdx.x; vb < 256; vb += gridDim.x) {
        const int tm = vb & 31, part = vb >> 5;
        const bool lat = tm >= 16;
        const int cond = lat ? 1 + ((tm - 16) >> 2) : 0;
        const float* g = pin(F, I_NORMG); const float* sc = mods + (size_t)cond * 3072 + 1024;
#pragma unroll 1
        for (int i = 0; i < 4; i += 2) {
            const int tok = tm * 256 + part * 32 + F.w * 4 + i;
            const float* xa = lat ? pin(F, I_XS) + (size_t)(tok - 4096) * 1024 : pin(F, I_XP) + (size_t)tok * 1024;
            const float* xb = xa + 1024;
            bf16_t* oa = (bf16_t*)(ws + WS_XG) + (size_t)tok * 1024;
            float ssa = 0.f, ssb = 0.f;
#pragma unroll
            for (int j = 0; j < 2; ++j) {
                const int k = j * 512 + lane * 8;
                const f32x4 a0 = *(const f32x4*)(xa + k), a1 = *(const f32x4*)(xa + k + 4), b0 = *(const f32x4*)(xb + k), b1 = *(const f32x4*)(xb + k + 4);
                const f32x4 g0 = *(const f32x4*)(g + k), g1 = *(const f32x4*)(g + k + 4), s0 = *(const f32x4*)(sc + k), s1 = *(const f32x4*)(sc + k + 4);
                const f32x4 m0 = g0 * (s0 + 1.f), m1 = g1 * (s1 + 1.f);
                ssa += ((a0[0] * a0[0] + a0[1] * a0[1]) + (a0[2] * a0[2] + a0[3] * a0[3])) + ((a1[0] * a1[0] + a1[1] * a1[1]) + (a1[2] * a1[2] + a1[3] * a1[3]));
                ssb += ((b0[0] * b0[0] + b0[1] * b0[1]) + (b0[2] * b0[2] + b0[3] * b0[3])) + ((b1[0] * b1[0] + b1[1] * b1[1]) + (b1[2] * b1[2] + b1[3] * b1[3]));
                u32x4 o; o.x = pk2(a0[0] * m0[0], a0[1] * m0[1]); o.y = pk2(a0[2] * m0[2], a0[3] * m0[3]); o.z = pk2(a1[0] * m1[0], a1[1] * m1[1]); o.w = pk2(a1[2] * m1[2], a1[3] * m1[3]);
                ST16_WT(oa + k, o);
                o.x = pk2(b0[0] * m0[0], b0[1] * m0[1]); o.y = pk2(b0[2] * m0[2], b0[3] * m0[3]); o.z = pk2(b1[0] * m1[0], b1[1] * m1[1]); o.w = pk2(b1[2] * m1[2], b1[3] * m1[3]);
                ST16_WT(oa + 1024 + k, o);
            }
            ssa = wsum(ssa); ssb = wsum(ssb);
            if (lane < 32) {
                const float v = (lane & 15) == 0 ? (lane < 16 ? ssa : ssb) : 0.f;
                __hip_atomic_store((__attribute__((address_space(1))) float*)((float*)(ws + WS_SSQ) + (size_t)(tok + (lane >> 4)) * 16 + (lane & 15)), v, __ATOMIC_RELAXED, __HIP_MEMORY_SCOPE_AGENT);
            }
        }
        asm volatile("s_waitcnt vmcnt(0)" ::: "memory");
        __syncthreads();
        if (is_t0(F)) (void)xb_add(ctl + CW_P1X + tm * 4, 1u);
    }
    asm volatile("s_waitcnt vmcnt(0)" ::: "memory");
    __syncthreads();
    if (is_t0(F)) (void)xb_add(ctl + CW_P1DONE, 1u);
}
#ifndef MK_TIMING
#define MK_TIMING -1
#endif
constexpr int CW_TIME = 2048;
__device__ __forceinline__ void phase_final(const Frame& F, const Params& p) {
    const int lane = F.lane;
    float tf = 1.f;
    if (MK_TIMING >= 0) tf = __uint_as_float(__hip_atomic_load((unsigned*)(F.ws + WS_CTL) + CW_TIME, __ATOMIC_RELAXED, __HIP_MEMORY_SCOPE_AGENT));
    unsigned* ctl = (unsigned*)(F.ws + WS_CTL);
    for (int vb = blockIdx.x; vb < 256; vb += gridDim.x) {
        const int tm = vb & 31, part = vb >> 5;
        if (F.tid == 0) {
            XB_SPIN(xb_ld(ctl + CW_XRDY + tm * 4) < 8u, ctl + CW_BAR);
            __builtin_amdgcn_fence(__ATOMIC_ACQUIRE, "agent");
            asm volatile("s_waitcnt vmcnt(0)" ::: "memory");
        }
        __syncthreads();
#pragma unroll 1
        for (int i = 0; i < 4; ++i) {
            const int tok = tm * 256 + part * 32 + F.w * 4 + i;
            float ss = 0.f;
            if (lane < 16) ss = ((const float*)(F.ws + WS_SSQ))[(size_t)tok * 16 + lane];
            ss = wsum(ss);
            const float rstd = rsqrtf(ss * (1.f / 1024.f) + EPS);
            const bf16_t* xr = (const bf16_t*)(F.ws + WS_XB) + (size_t)tok * 1024; float* orow = p.out + (size_t)tok * 1024;
#pragma unroll
            for (int j = 0; j < 4; ++j) {
                const int k = j * 256 + lane * 4;
                const u32x2 xq = *(const u32x2*)(xr + k);
                const f32x4 x = {bflo(xq.x), bfhi(xq.x), bflo(xq.y), bfhi(xq.y)}, fn = *(const f32x4*)(pin(F, I_FNORM) + k);
                { const f32x4 o = x * fn * (rstd * tf); ST16_WT(orow + k, o); }
            }
        }
    }
}

__device__ __forceinline__ GemmOp a2_op(const Frame& F, int l, int j) {
    GemmOp g;
    if (j < 160) { const int tn = j >> 5, tm = j & 31; g.W = (const bf16_t*)(F.ws + WS_WUQ) + ((size_t)l * 640 + tn * 128) * 256; g.X = (const bf16_t*)(F.ws + WS_CQG) + (size_t)tm * 256 * 256; g.ldw = 256; g.ldx = 256; g.K = 256; }
    else if (j < 352) { const int jj = j - 160, tn = jj >> 5, tm = jj & 31; g.W = (const bf16_t*)(F.ws + WS_WUKV) + ((size_t)l * 768 + tn * 128) * 128; g.X = (const bf16_t*)(F.ws + WS_CKVN) + (size_t)tm * 256 * 128; g.ldw = 128; g.ldx = 128; g.K = 128; }
    else { const int jj = j - 352, tn = jj >> 3, tc = jj & 7, b = tc >> 1, jt = tc & 1; g.W = (const bf16_t*)(F.ws + WS_WUKV) + ((size_t)l * 768 + tn * 128) * 128;
           g.X = (const bf16_t*)(F.ws + WS_CCKV) + ((size_t)(b * 4 + l) * 512 + jt * 256) * 128; g.ldw = 128; g.ldx = 128; g.K = 128; }
    return g;
}
__device__ __forceinline__ int a2_item(int vb, int i) {
    const int c = (vb >> 5) - 4, tmw = vb & 31;
    if (i == 3) return 352 + 32 + tmw;
    if (c == 0) return i * 32 + tmw;
    if (c == 1) return i < 2 ? (3 + i) * 32 + tmw : 160 + tmw;
    if (c == 2) return 160 + (1 + i) * 32 + tmw;
    return i < 2 ? 160 + (4 + i) * 32 + tmw : 352 + tmw;
}
#ifndef MK_EN
#define MK_EN 0xff
#endif
#define EN(x) ((MK_EN >> (x)) & 1)
constexpr int PH_TOTAL = 19;
__global__ void __launch_bounds__(512, 2) mega(Params p) {
    extern __shared__ __attribute__((aligned(16))) unsigned char lds_raw[];
    Frame F;
    F.lds = (LAS unsigned char*)lds_raw;
    F.tid = threadIdx.x; F.lane = F.tid & 63; F.w = __builtin_amdgcn_readfirstlane(F.tid >> 6); F.h = F.lane >> 5; F.lq = F.lane & 31;
    F.ws = p.ws;
    F.karg = (karg_t)__builtin_amdgcn_kernarg_segment_ptr();
    volatile LAS unsigned* MISC = (volatile LAS unsigned*)(F.lds + LDS_MISC);
    if (F.tid < 64) MISC[F.tid] = 0u;
    __syncthreads();
    unsigned* ctl = (unsigned*)(p.ws + WS_CTL);
    XcdBarrier bar; bar.bar = ctl + CW_BAR; bar.x = 0; bar.st = nullptr;
    const bool multi = p.ph_hi - p.ph_lo > 1;
    if (multi) bar = xcd_barrier_post(ctl + CW_BAR, MISC + 8);
    bar.w = F.w;
    const int G = gridDim.x;
    const Frame F0 = F;
    for (int ph = p.ph_lo; ph < p.ph_hi; ++ph) {
        if (ph >= 2 && ph < 18 && ((ph - 2) & 3) == 1) continue;
        Frame F = F0;
        F.lane = (int)__builtin_amdgcn_mbcnt_hi(~0u, __builtin_amdgcn_mbcnt_lo(~0u, 0u));
        asm volatile("" : "+v"(F.lane));
        F.tid = (F.w << 6) | F.lane; F.h = F.lane >> 5; F.lq = F.lane & 31;
        asm volatile("" : "+s"(F.w), "+s"(F.ws), "+s"(F.karg));
        if (MK_TIMING >= 0 && blockIdx.x == 0 && F.tid == 0) {
            const unsigned long long now = __builtin_amdgcn_s_memrealtime();
            const unsigned long long prev = ((unsigned long long)MISC[17] << 32) | MISC[16];
            if (ph > p.ph_lo) { const int q = ph - 1; const int grp = q < 2 ? q : 2 + ((q - 2) & 3); if (grp == MK_TIMING) MISC[18] += (unsigned)(now - prev); }
            MISC[16] = (unsigned)now; MISC[17] = (unsigned)(now >> 32);
        }
#ifndef MK_REPEAT
#define MK_REPEAT -1
#endif
        int nrep = 1;
        if (MK_REPEAT >= 1) { const int grp = ph < 2 ? ph : (ph == 18 ? 6 : 2 + ((ph - 2) & 3)); if (grp == MK_REPEAT) nrep = (grp == 5) ? (ph == 5 ? 5 : 1) : 2; }
        for (int rep = 0; rep < nrep; ++rep) {
        if (rep > 0) xcd_barrier(bar);
        Frame F = F0;
        F.lane = (int)__builtin_amdgcn_mbcnt_hi(~0u, __builtin_amdgcn_mbcnt_lo(~0u, 0u));
        asm volatile("" : "+v"(F.lane));
        F.tid = (F.w << 6) | F.lane; F.h = F.lane >> 5; F.lq = F.lane & 31;
        asm volatile("" : "+s"(F.w), "+s"(F.ws), "+s"(F.karg));
        if (EN(0) && ph == 0) {
#if defined(MK_DUP0)
            for (int d = 0; d < 2; ++d) { int dd = d; asm volatile("" : "+s"(dd)); if (dd) xcd_barrier(bar); phase0(F, p, dd != 0); }
#else
            phase0(F, p);
#endif
        }
        else if (EN(1) && ph == 1) phase1(F, p);
        else if (EN(2) && ph == 18) phase_final(F, p);
        else {
            const int l = (ph - 2) >> 2, sub = (ph - 2) & 3;
            int bid = blockIdx.x; asm volatile("" : "+s"(bid));
            if (EN(3) && sub == 0) {
                const bf16_t* Wt = (const bf16_t*)(F.ws + WS_WIN) + (size_t)l * 2944 * 1024;
                const bf16_t* X = (const bf16_t*)(F.ws + WS_XG);
                unsigned* flags = ctl + CW_FLAG + l * 512;
                bool first = true;
                int waited_tm = -1;
                for (int j = bid; j < 12 * 32; j += G) {
                    const int tn2 = j >> 5, tm = j & 31;
                    const int jn = j + G; const bool hn = jn < 12 * 32 && (jn & 31) == tm;
                    if (l == 0 && tm != waited_tm) {
                        waited_tm = tm;
                        if (F.tid == 0) {
                            XB_SPIN(xb_ld(ctl + CW_P1X + tm * 4) < 8u, ctl + CW_BAR);
                            XB_SPIN(xb_ld(ctl + CW_P1B0) < 368u, ctl + CW_BAR);
                            __builtin_amdgcn_fence(__ATOMIC_ACQUIRE, "agent");
                            asm volatile("s_waitcnt vmcnt(0)" ::: "memory");
                        }
                        __syncthreads();
                        first = true;
                    }
                    if (l > 0 && tm != waited_tm) {
                        waited_tm = tm;
                        if (F.w == 0) {
                            const int ln = lane_id();
                            unsigned* ptr = ctl + CW_P1DONE; unsigned tgt = (unsigned)G;
                            if (ln == 1) { ptr = ctl + CW_XGR + ((l - 1) * 32 + tm) * 4; tgt = 8u; }
                            if (ln >= 2) {
                                if (tm >= 16) { ptr = ctl + CW_YRDY + ((l - 1) * 32 + (tm & ~3) + ((ln - 2) & 3)) * 4; tgt = 16u; }
                                else { ptr = ctl + CW_SD + ((l - 1) * 16 + tm) * 4; tgt = 4u; }
                            }
                            poll_lanes(ptr, tgt, ln < (tm >= 16 ? 6 : 3), ctl + CW_BAR);
                            __builtin_amdgcn_fence(__ATOMIC_ACQUIRE, "agent");
                            asm volatile("s_waitcnt vmcnt(0)" ::: "memory");
                        }
                        __syncthreads();
                        first = true;
                    }
                    const int tn = 2 * tn2 + ((F.w & 3) >> 1), wn = F.w & 1;
                    if (tn2 == 11) {
                        GemmAcc2 accn;
                        Gemm1Pre P1;
                        const bool mine = (F.w & 3) == 0;
                        if (mine) gemm1_pre(F, p, 22, 0, tm, l, P1); else { P1.rstd[0] = P1.rstd[1] = 0.f; P1.bias = 0.f; P1.gain = 1.f; }
                        gemm_core256n(F, Wt + (size_t)tn2 * 256 * 1024, X + (size_t)tm * 256 * 1024, accn, first); first = true;
                        if (mine) epi_kpe(F, p, accn, tm, l, P1);
                    } else {
                    GemmAcc8 acc;
                    Gemm1Pre P1;
                    gemm1_pre(F, p, tn, wn, tm, l, P1);
                    gemm_core256(F, Wt + (size_t)tn2 * 256 * 1024, X + (size_t)tm * 256 * 1024, acc, first, hn, Wt + (size_t)(jn >> 5) * 256 * 1024, X + (size_t)(jn & 31) * 256 * 1024); first = false;
                    epi_gemm1(F, p, acc, tn, wn, tm, l, P1, tn2 == 6);
                    }
                    {
                        asm volatile("s_waitcnt vmcnt(0)" ::: "memory");
                        __syncthreads();
                        if (F.tid == 0) {
                            if (tn2 == 5 || tn2 == 6) (void)xb_add(flags + tm * 16, 1u);
                            if (tn2 < 8) (void)xb_add(ctl + CW_RA + (l * 32 + tm) * 4, 1u);
                            if (tn2 >= 7 && tn2 < 11) (void)xb_add(ctl + CW_ZC + (l * 32 + tm) * 4, 1u);
                            (void)xb_add(ctl + CW_FULL + (l * 32 + tm) * 4, 1u);
                        }
                    }
                }
                for (int vb = bid; vb < 256; vb += G) {
                    if (vb < 128) continue;
                    const int c = (vb >> 5) - 4, tmw = vb & 31;
                    const int nit = (c == 2 && tmw < 16) ? 4 : 3;
                    if (F.tid == 0) {
                        if (l > 0 && tmw != waited_tm) {
                            if (tmw >= 16) { unsigned* y = ctl + CW_YRDY + ((l - 1) * 32 + (tmw & ~3)) * 4; for (int i = 0; i < 4; ++i) { XB_SPIN(xb_ld(y + 4 * i) < 16u, ctl + CW_BAR); } }
                            else { XB_SPIN(xb_ld(ctl + CW_YRDY + ((l - 1) * 32 + tmw) * 4) < 16u, ctl + CW_BAR); XB_SPIN(xb_ld(ctl + CW_SD + ((l - 1) * 16 + tmw) * 4) < 4u, ctl + CW_BAR); }
                        }
                        unsigned* f = flags + tmw * 16;
                        XB_SPIN(xb_ld(f) < 2u, ctl + CW_BAR);
                        __builtin_amdgcn_fence(__ATOMIC_ACQUIRE, "agent");
                        asm volatile("s_waitcnt vmcnt(0)" ::: "memory");
                    }
                    __syncthreads();
                    for (int i = 0; i < nit; ++i) {
                        const bool hn = i + 1 < nit;
                        const int j = a2_item(vb, i), jn = a2_item(vb, hn ? i + 1 : i);
                        const GemmOp g = a2_op(F, l, j); const GemmOp gn = a2_op(F, l, jn);
                        GemmAcc acc;
                        float rstdq = 0.f;
                        if (j < 160) qm_pre(F, tmw, rstdq);
                        gemm_core(F, g, acc, i == 0, hn, gn);
                        if (j < 160) epi_qm(F, acc, j >> 5, tmw, rstdq);
                        else if (j < 352) { const int jj = j - 160; epi_plain(F, acc, (bf16_t*)(F.ws + WS_KVM), 768, tmw * 256, (jj >> 5) * 128); }
                        else {
                            const int jj = j - 352, tc = jj & 7;
                            if (l > 0) {
                                if (F.w == 0) { const int ln = lane_id(); poll_lanes(ctl + CW_YRDY + ((l - 1) * 32 + 16 + 4 * (tc >> 1) + (ln & 3)) * 4, 16u, ln < 4, ctl + CW_BAR); }
                                __syncthreads();
                            }
                            epi_plain(F, acc, (bf16_t*)(F.ws + WS_KVMC), 768, (tc >> 1) * 512 + (tc & 1) * 256, (jj >> 3) * 128);
                        }
                        asm volatile("s_waitcnt vmcnt(0)" ::: "memory");
                        __syncthreads();
                        if (F.tid == 0) {
                            if (j < 352) (void)xb_add(ctl + CW_FULL + (l * 32 + tmw) * 4, 1u);
                            else (void)xb_add(ctl + CW_KC + (l * 4 + (((j - 352) & 7) >> 1)) * 4, 1u);
                        }
                    }
                }
            } else if (EN(5) && sub == 2) {
                for (;;) {
                    __syncthreads();
                    if (F.tid == 0) MISC[0] = atomicAdd(ctl + CW_QUEUE + 64 * l + 32 * rep, 1u);
                    __syncthreads();
                    const int uq = __builtin_amdgcn_readfirstlane((int)MISC[0]);
                    if (uq >= N_ATTN_UNITS) break;
                    const int u = uq < 160 ? uq + 96 : (uq < 256 ? uq - 160 : (uq < 480 ? uq + 96 : uq - 224));
                    attn_dispatch(F, p, u, l);
                }
            } else if (EN(6)) {
                const bf16_t* Wt = (const bf16_t*)(F.ws + WS_WOUT) + (size_t)l * 1024 * 1024;
                const bf16_t* Yb = (const bf16_t*)(F.ws + WS_Y);
                for (int j = bid; j < 8 * 32; j += G) {
                    const int tn = j >> 5, tm = j & 31;
                    GemmOp g; g.W = Wt + (size_t)tn * 128 * 1024; g.X = Yb + (size_t)tm * 256 * 1024; g.ldw = 1024; g.ldx = 1024; g.K = 1024;
                    GemmAcc acc;
                    Gemm2Pre P2;
                    if (F.tid == 0) {
                        unsigned* f = ctl + CW_YRDY + (l * 32 + tm) * 4;
                        XB_SPIN(xb_ld(f) < 16u, ctl + CW_BAR);
                        if (l == 0) { XB_SPIN(xb_ld(ctl + CW_P1DONE) < (unsigned)G, ctl + CW_BAR); }
                        __builtin_amdgcn_fence(__ATOMIC_ACQUIRE, "agent");
                        asm volatile("s_waitcnt vmcnt(0)" ::: "memory");
                    }
                    __syncthreads();
                    gemm2_pre(F, tn, tm, l, P2);
                    gemm_core(F, g, acc, true, false, g);
                    epi_gemm2(F, p, acc, tn, tm, l, P2, l == 3);
                    {
                        asm volatile("s_waitcnt vmcnt(0)" ::: "memory");
                        __syncthreads();
                        if (F.tid == 0) (void)xb_add(l == 3 ? ctl + CW_XRDY + tm * 4 : ctl + CW_XGR + (l * 32 + tm) * 4, 1u);
                    }
                }
            }
        }
        }
        if (MK_TIMING >= 0 && ph == 17 && blockIdx.x == 0 && F.tid == 0) {
            const unsigned long long now = __builtin_amdgcn_s_memrealtime();
            const unsigned long long prev = ((unsigned long long)MISC[17] << 32) | MISC[16];
            unsigned a = MISC[18]; if (MK_TIMING == 5) a += (unsigned)(now - prev);
            __hip_atomic_store(ctl + CW_TIME, __float_as_uint(1.f + (float)a * 1e-5f), __ATOMIC_RELAXED, __HIP_MEMORY_SCOPE_AGENT);
        }
        if (ph + 1 < p.ph_hi && ph < 1) xcd_barrier(bar);
    }
}
}

extern "C" void kernel_launch(void* const* d_in, const int* in_sizes, int n_in, void* d_out, int out_size, void* d_ws, size_t ws_size, hipStream_t stream) {
    static int grid = 0;
    if (!grid) {
        int dev = 0, cus = 0, per_cu = 0;
        (void)hipGetDevice(&dev);
        (void)hipDeviceGetAttribute(&cus, hipDeviceAttributeMultiprocessorCount, dev);
        (void)hipFuncSetAttribute((const void*)mk::mega, hipFuncAttributeMaxDynamicSharedMemorySize, mk::LDS_BYTES);
        (void)hipOccupancyMaxActiveBlocksPerMultiprocessor(&per_cu, (const void*)mk::mega, 512, mk::LDS_BYTES);
        if (per_cu > 1) per_cu = 1;
        if (per_cu < 1) per_cu = 1;
        if (cus < 1) cus = 256;
        grid = cus * per_cu;
    }
    unsigned char* ws = (unsigned char*)d_ws;
    (void)hipMemsetAsync(ws, 0, mk::CTL_ZERO_BYTES, stream);
    mk::Params P{};
    for (int i = 0; i < 22; ++i) P.in[i] = (const float*)d_in[i];
    P.out = (float*)d_out; P.ws = ws; P.xs = (float*)d_out;
    P.ph_lo = 0; P.ph_hi = mk::PH_TOTAL;
    void* args[] = {&P};
    (void)hipLaunchCooperativeKernel((const void*)mk::mega, dim3(grid), dim3(512), args, mk::LDS_BYTES, stream);
}
```

```cpp
#include <hip/hip_runtime.h>
#include <stdint.h>
namespace mk {
#define LAS __attribute__((address_space(3)))
typedef unsigned short bf16_t;
typedef short bf16x8 __attribute__((ext_vector_type(8)));
typedef short s16x4 __attribute__((ext_vector_type(4)));
typedef float f32x16 __attribute__((ext_vector_type(16)));
typedef float f32x4 __attribute__((ext_vector_type(4)));
typedef float f32x2 __attribute__((ext_vector_type(2)));
typedef unsigned u32x4 __attribute__((ext_vector_type(4)));
typedef unsigned u32x2 __attribute__((ext_vector_type(2)));
typedef __bf16 bf16x2_t __attribute__((ext_vector_type(2)));

constexpr float EPS = 1e-6f;
constexpr float LOG2E = 1.4426950408889634f;
constexpr float QSC_GQA = 0.125f * LOG2E;
constexpr float QSC_MLA = 0.10206207261596575f * LOG2E;

__device__ __forceinline__ unsigned pk2(float lo, float hi) { f32x2 v = {lo, hi}; bf16x2_t b = __builtin_convertvector(v, bf16x2_t); return __builtin_bit_cast(unsigned, b); }
__device__ __forceinline__ float bf2f(unsigned short u) { return __uint_as_float((unsigned)u << 16); }
__device__ __forceinline__ float bflo(unsigned u) { return __uint_as_float(u << 16); }
__device__ __forceinline__ float bfhi(unsigned u) { return __uint_as_float(u & 0xffff0000u); }
__device__ __forceinline__ float silu_f(float x) { return x * __builtin_amdgcn_rcpf(1.f + __builtin_amdgcn_exp2f(-x * LOG2E)); }
__device__ __forceinline__ float wsum(float v) {
#pragma unroll
    for (int o = 32; o > 0; o >>= 1) v += __shfl_xor(v, o);
    return v;
}

constexpr size_t MiB = 1u << 20;
constexpr size_t WS_CTL = 0, CTL_ZERO_BYTES = 1 * MiB;
constexpr size_t WS_MODS = 256 * 1024;
constexpr size_t WS_BIAS = 1 * MiB;
constexpr size_t WS_GS = 1 * MiB + 256 * 1024;
constexpr size_t WS_ROPE64 = 1 * MiB + 512 * 1024;
constexpr size_t WS_ROPE32 = 1 * MiB + 768 * 1024;
constexpr size_t WS_SSQ = 2 * MiB;
constexpr size_t WS_CQSSQ = 2 * MiB + 512 * 1024;
constexpr size_t WS_S0T = 3 * MiB;
constexpr size_t WS_CGK = 4 * MiB, WS_CGV = 6 * MiB, WS_CCKV = 8 * MiB, WS_CKPE = 10 * MiB;
constexpr size_t WS_WIN = 11 * MiB;
constexpr size_t WS_WOUT = 34 * MiB;
constexpr size_t WS_WUQ = 42 * MiB;
constexpr size_t WS_WUKV = 43 * MiB + 256 * 1024;
constexpr size_t WS_XG = 44 * MiB;
constexpr size_t WS_KVM = 130 * MiB;
constexpr size_t WS_KVMC = 142 * MiB;
constexpr size_t WS_RQ = 60 * MiB, WS_RK = 64 * MiB, WS_RV = 68 * MiB;
constexpr size_t WS_GQ = 72 * MiB;
constexpr size_t WS_GK = 78 * MiB, WS_GV = 80 * MiB;
constexpr size_t WS_CQG = 82 * MiB;
constexpr size_t WS_CKVN = 86 * MiB;
constexpr size_t WS_KPEB = 88 * MiB;
constexpr size_t WS_ZS = 89 * MiB;
constexpr size_t WS_QM = 105 * MiB;
constexpr size_t WS_Y = 114 * MiB;
constexpr size_t WS_XSDBG = 130 * MiB;
constexpr size_t WS_XB = 146 * MiB;
constexpr size_t WS_OPT_END = 162 * MiB;
constexpr int CW_QUEUE = 1024;
constexpr int CW_FLAG = 2048;
constexpr int CW_YRDY = 1536;
constexpr int CW_XRDY = 1280;
constexpr int CW_RA = 8192;
constexpr int CW_FULL = 8704;
constexpr int CW_ZC = 9216;
constexpr int CW_KC = 9728;
constexpr int CW_XGR = 9856;
constexpr int CW_SD = 10368;
constexpr int CW_P1X = 10656;
constexpr int CW_P1B0 = 10784;
constexpr int CW_P1DONE = 10788;
constexpr int CW_BAR = 4096;

constexpr size_t O_STATE = 8388608, O_GK = 10485760, O_GV = 12582912, O_CKV = 14680064, O_KPE = 16777216;

constexpr int NWAVE = 8;
constexpr int GST = 49152;
constexpr int GST2 = 65536;
constexpr int LDS_OST = GST2;
constexpr int LDS_EX = 135168;
constexpr int LDS_EXB = 137216;
constexpr int LDS_SCAL = 141312;
constexpr int LDS_MISC = 142336;
constexpr int LDS_BYTES = 142592;

struct Params { const float* in[22]; float* out; unsigned char* ws; float* xs; int ph_lo, ph_hi; };
enum { I_XP = 0, I_XS, I_STATE, I_CGK, I_CGV, I_CCKV, I_CKPE, I_C, I_CCTX, I_NORMG, I_WADA, I_BADA, I_WIN, I_DECAY, I_GQN, I_GKN, I_MQN, I_MKVN, I_WUQ, I_WUKV, I_WOUT, I_FNORM };

#define XB_TMO      128
#define XB_XCNT(j)  (256  + 64 * (j))
#define XB_XSUB(j)  (1280 + 64 * (j))
#define XB_XGEN(j)  (2304 + 64 * (j))
#define XB_TOP      3328
#define XB_TOPGEN   3392
#define XB_SPIN_CAP (1u << 20)
__device__ __forceinline__ unsigned xb_ld(unsigned* p) { return __hip_atomic_load(p, __ATOMIC_RELAXED, __HIP_MEMORY_SCOPE_AGENT); }
__device__ __forceinline__ unsigned xb_add(unsigned* p, unsigned v) { return __hip_atomic_fetch_add(p, v, __ATOMIC_RELAXED, __HIP_MEMORY_SCOPE_AGENT); }
__device__ __forceinline__ unsigned xb_xcc_id() { return (unsigned)__builtin_amdgcn_s_getreg((3 << 11) | 20) & 0xFu; }
#define XB_SPIN(cond, bar) do { unsigned _sp = 0; while (cond) { __builtin_amdgcn_s_sleep(1); \
    if ((++_sp & 255u) == 0u) { if (xb_ld(&(bar)[XB_TMO])) break; if (_sp > XB_SPIN_CAP) { atomicAdd(&(bar)[XB_TMO], 1u); break; } } } } while (0)
__device__ __forceinline__ int lane_id() { int ln = (int)__builtin_amdgcn_mbcnt_hi(~0u, __builtin_amdgcn_mbcnt_lo(~0u, 0u)); asm volatile("" : "+v"(ln)); return ln; }
__device__ __forceinline__ void poll_lanes(unsigned* ptr, unsigned target, bool active, unsigned* bar0) {
    unsigned sp = 0u;
    for (;;) {
        unsigned v = target;
        if (active) v = xb_ld(ptr);
        if (!__any(v < target)) break;
        __builtin_amdgcn_s_sleep(1);
        if ((++sp & 255u) == 0u) { if (xb_ld(&bar0[XB_TMO])) break; if (sp > XB_SPIN_CAP) { atomicAdd(&bar0[XB_TMO], 1u); break; } }
    }
}
struct XcdBarrier { unsigned* bar; unsigned x; volatile LAS unsigned* st; int w; };
__device__ __forceinline__ XcdBarrier xcd_barrier_post(unsigned* bar, volatile LAS unsigned* st) {
    XcdBarrier b; b.bar = bar; b.x = xb_xcc_id(); b.st = st; b.w = 0;
    if (threadIdx.x == 0) (void)xb_add(&bar[XB_XCNT(b.x)], 1u);
    return b;
}
__device__ __forceinline__ void xcd_barrier_complete(unsigned* bar, unsigned x, unsigned& nloc, unsigned& nx) {
    const unsigned G = gridDim.x * gridDim.y * gridDim.z;
    unsigned sum, cnt, mine, sp = 0u;
    for (;;) {
        sum = 0u; cnt = 0u; mine = 0u;
#pragma unroll
        for (unsigned j = 0; j < 16; ++j) { const unsigned c = xb_ld(&bar[XB_XCNT(j)]); sum += c; cnt += (c > 0u) ? 1u : 0u; mine = (j == x) ? c : mine; }
        if (sum == G) break;
        __builtin_amdgcn_s_sleep(1);
        if ((++sp & 255u) == 0u) { if (xb_ld(&bar[XB_TMO])) break; if (sp > XB_SPIN_CAP) { atomicAdd(&bar[XB_TMO], 1u); break; } }
    }
    nloc = mine > 0u ? mine : 1u; nx = cnt > 0u ? cnt : 1u;
}
__device__ __forceinline__ void xcd_barrier(const XcdBarrier& b) {
    asm volatile("s_waitcnt vmcnt(0)" ::: "memory");
    __syncthreads();
    if (b.w == 0 && __builtin_amdgcn_mbcnt_hi(~0u, __builtin_amdgcn_mbcnt_lo(~0u, 0u)) == 0u) {
        unsigned* bar = b.bar;
        __builtin_amdgcn_s_waitcnt(0);
        unsigned nloc = b.st[0], nx = b.st[1];
        if (nloc == 0u) { xcd_barrier_complete(bar, b.x, nloc, nx); b.st[0] = nloc; b.st[1] = nx; }
        const unsigned old = xb_add(&bar[XB_XSUB(b.x)], 1u);
        const unsigned gen = old / nloc;
        if (old + 1u == (gen + 1u) * nloc) {
            __builtin_amdgcn_fence(__ATOMIC_RELEASE, "agent");
            asm volatile("s_waitcnt vmcnt(0)" ::: "memory");
            const unsigned og = xb_add(&bar[XB_TOP], 1u);
            const unsigned tg = og / nx;
            if (og + 1u == (tg + 1u) * nx) xb_add(&bar[XB_TOPGEN], 1u);
            else XB_SPIN(xb_ld(&bar[XB_TOPGEN]) == tg, bar);
            xb_add(&bar[XB_XGEN(b.x)], 1u);
            __builtin_amdgcn_fence(__ATOMIC_ACQUIRE, "agent");
            asm volatile("s_waitcnt vmcnt(0)" ::: "memory");
        } else {
            XB_SPIN(xb_ld(&bar[XB_XGEN(b.x)]) == gen, bar);
            __builtin_amdgcn_fence(__ATOMIC_ACQUIRE, "agent");
            asm volatile("s_waitcnt vmcnt(0)" ::: "memory");
        }
    }
    __syncthreads();
}

typedef const float* cfp_t;
typedef const __attribute__((address_space(4))) cfp_t* karg_t;
struct Frame {
    LAS unsigned char* lds;
    int tid, lane, w, h, lq;
    unsigned char* ws;
    karg_t karg;
};
__device__ __forceinline__ const float* pin(const Frame& F, int i) { return F.karg[i]; }
__device__ __forceinline__ bool is_t0(const Frame& F) { return F.w == 0 && __builtin_amdgcn_mbcnt_hi(~0u, __builtin_amdgcn_mbcnt_lo(~0u, 0u)) == 0u; }
#define GLDS16(gsrc, ldsdst) __builtin_amdgcn_global_load_lds((const unsigned*)(gsrc), (LAS unsigned*)(ldsdst), 16, 0, 0)
#define ST16_WT(ptr, val) asm volatile("global_store_dwordx4 %0, %1, off sc1\n\ts_nop 1" :: "v"(ptr), "v"(val) : "memory")
#define MFMA32(a, b, c) __builtin_amdgcn_mfma_f32_32x32x16_bf16((a), (b), (c), 0, 0, 0)

struct GemmOp { const bf16_t* W; const bf16_t* X; int ldw, ldx, K; };
__device__ __forceinline__ void gemm_issue0(const Frame& F, const GemmOp& g) {
    const int lane = F.lane, w = F.w;
#pragma unroll
    for (int q = 0; q < 2; ++q) { const int row = 16 * w + 8 * q + (lane >> 3); GLDS16(g.W + row * g.ldw + ((lane & 7) ^ ((row >> 1) & 7)) * 8, F.lds + (16 * w + 8 * q) * 128); }
#pragma unroll
    for (int q = 0; q < 4; ++q) { const int row = 32 * w + 8 * q + (lane >> 3); GLDS16(g.X + row * g.ldx + ((lane & 7) ^ ((row >> 1) & 7)) * 8, F.lds + 16384 + (32 * w + 8 * q) * 128); }
}
typedef f32x4 GemmAcc[4][4];
__device__ __forceinline__ void gemm_core(const Frame& F, const GemmOp& g, GemmAcc& acc, bool issue_first, bool has_next, const GemmOp& gn) {
    const int lane = F.lane, w = F.w;
    const bf16_t* __restrict__ W = g.W; const bf16_t* __restrict__ X = g.X;
    const int nkt = g.K >> 6;
    int offW[2], offX[4];
#pragma unroll
    for (int q = 0; q < 2; ++q) { const int row = 16 * w + 8 * q + (lane >> 3); offW[q] = row * g.ldw + ((lane & 7) ^ ((row >> 1) & 7)) * 8; }
#pragma unroll
    for (int q = 0; q < 4; ++q) { const int row = 32 * w + 8 * q + (lane >> 3); offX[q] = row * g.ldx + ((lane & 7) ^ ((row >> 1) & 7)) * 8; }
    LAS unsigned char* const dW = F.lds + (16 * w) * 128;
    LAS unsigned char* const dX = F.lds + 16384 + (32 * w) * 128;
#define GC_ISSUE(kt, st) do { _Pragma("unroll") for (int q = 0; q < 2; ++q) GLDS16(W + offW[q] + (kt) * 64, dW + (st) * GST + q * 1024); \
        _Pragma("unroll") for (int q = 0; q < 4; ++q) GLDS16(X + offX[q] + (kt) * 64, dX + (st) * GST + q * 1024); } while (0)
    const int wn = w & 1, wm = w >> 1, c15 = lane & 15, g4 = lane >> 4;
    const int sw = (c15 >> 1) & 7;
    int so[2];
#pragma unroll
    for (int s = 0; s < 2; ++s) so[s] = ((4 * s + g4) ^ sw) << 4;
    const int bn0 = (64 * wn + c15) * 128, bm0 = 16384 + (64 * wm + c15) * 128;
#pragma unroll
    for (int a = 0; a < 4; ++a)
#pragma unroll
        for (int b = 0; b < 4; ++b) acc[a][b] = (f32x4){0.f, 0.f, 0.f, 0.f};
    if (issue_first) GC_ISSUE(0, 0);
    asm volatile("s_waitcnt vmcnt(0)" ::: "memory");
    __syncthreads();
    for (int kt = 0; kt < nkt; ++kt) {
        const int st = kt & 1;
        if (kt + 1 < nkt) GC_ISSUE(kt + 1, st ^ 1);
        LAS unsigned char* const base = F.lds + st * GST;
#pragma unroll
        for (int s = 0; s < 2; ++s) {
            bf16x8 fa[4], fb[4];
#pragma unroll
            for (int q = 0; q < 4; ++q) { fa[q] = *(const LAS bf16x8*)(base + bn0 + q * 2048 + so[s]); fb[q] = *(const LAS bf16x8*)(base + bm0 + q * 2048 + so[s]); }
#pragma unroll
            for (int a = 0; a < 4; ++a)
#pragma unroll
                for (int b = 0; b < 4; ++b) acc[a][b] = __builtin_amdgcn_mfma_f32_16x16x32_bf16(fa[a], fb[b], acc[a][b], 0, 0, 0);
        }
        asm volatile("s_waitcnt vmcnt(0)" ::: "memory");
        __syncthreads();
    }
#undef GC_ISSUE
    if (has_next) gemm_issue0(F, gn);
}

typedef f32x4 GemmAcc8[4][8];
__device__ __forceinline__ void gemm256_issue0(const Frame& F, const bf16_t* W, const bf16_t* X) {
    int lane = F.lane; const int w = F.w;
    asm volatile("" : "+v"(lane));
#pragma unroll
    for (int q = 0; q < 4; ++q) {
        const int row = 32 * w + 8 * q + (lane >> 3), off = row * 1024 + ((lane & 7) ^ ((row >> 1) & 7)) * 8;
        GLDS16(W + off, F.lds + (32 * w + 8 * q) * 128);
        GLDS16(X + off, F.lds + 32768 + (32 * w + 8 * q) * 128);
    }
}
__device__ __forceinline__ void gemm_core256(const Frame& F, const bf16_t* __restrict__ W, const bf16_t* __restrict__ X, GemmAcc8& acc, bool issue_first, bool has_next, const bf16_t* Wn, const bf16_t* Xn) {
    int lane = F.lane; const int w = F.w;
    asm volatile("" : "+v"(lane));
    int off[4];
#pragma unroll
    for (int q = 0; q < 4; ++q) { const int row = 32 * w + 8 * q + (lane >> 3); off[q] = row * 1024 + ((lane & 7) ^ ((row >> 1) & 7)) * 8; }
    LAS unsigned char* const dW = F.lds + (32 * w) * 128;
    LAS unsigned char* const dX = F.lds + 32768 + (32 * w) * 128;
#define GC2_ISSUE(kt, st) do { _Pragma("unroll") for (int q = 0; q < 4; ++q) { GLDS16(W + off[q] + (kt) * 64, dW + (st) * GST2 + q * 1024); GLDS16(X + off[q] + (kt) * 64, dX + (st) * GST2 + q * 1024); } } while (0)
    const int wn4 = w & 3, wm2 = w >> 2, c15 = lane & 15, g4 = lane >> 4;
    const int sw = (c15 >> 1) & 7;
    int so[2];
#pragma unroll
    for (int s = 0; s < 2; ++s) so[s] = ((4 * s + g4) ^ sw) << 4;
    const int bn0 = (64 * wn4 + c15) * 128, bm0 = 32768 + (128 * wm2 + c15) * 128;
#pragma unroll
    for (int a = 0; a < 4; ++a)
#pragma unroll
        for (int b = 0; b < 8; ++b) acc[a][b] = (f32x4){0.f, 0.f, 0.f, 0.f};
    if (issue_first) GC2_ISSUE(0, 0);
    asm volatile("s_waitcnt vmcnt(0)" ::: "memory");
    __syncthreads();
    for (int kt = 0; kt < 16; ++kt) {
        const int st = kt & 1;
        if (kt + 1 < 16) GC2_ISSUE(kt + 1, st ^ 1);
        LAS unsigned char* const base = F.lds + st * GST2;
#pragma unroll
        for (int s = 0; s < 2; ++s) {
            bf16x8 fa[4];
#pragma unroll
            for (int q = 0; q < 4; ++q) fa[q] = *(const LAS bf16x8*)(base + bn0 + q * 2048 + so[s]);
#pragma unroll
            for (int hb = 0; hb < 2; ++hb) {
                bf16x8 fb[4];
#pragma unroll
                for (int q = 0; q < 4; ++q) fb[q] = *(const LAS bf16x8*)(base + bm0 + (4 * hb + q) * 2048 + so[s]);
#pragma unroll
                for (int a = 0; a < 4; ++a)
#pragma unroll
                    for (int b = 0; b < 4; ++b) acc[a][4 * hb + b] = __builtin_amdgcn_mfma_f32_16x16x32_bf16(fa[a], fb[b], acc[a][4 * hb + b], 0, 0, 0);
            }
        }
        asm volatile("s_waitcnt vmcnt(0)" ::: "memory");
        __syncthreads();
    }
#undef GC2_ISSUE
    if (has_next) gemm256_issue0(F, Wn, Xn);
}
typedef f32x4 GemmAcc2[2][8];
__device__ __forceinline__ void gemm_core256n(const Frame& F, const bf16_t* __restrict__ W, const bf16_t* __restrict__ X, GemmAcc2& acc, bool issue_first) {
    int lane = F.lane; const int w = F.w;
    asm volatile("" : "+v"(lane));
    int off[4];
#pragma unroll
    for (int q = 0; q < 4; ++q) { const int row = 32 * w + 8 * q + (lane >> 3); off[q] = row * 1024 + ((lane & 7) ^ ((row >> 1) & 7)) * 8; }
    LAS unsigned char* const dW = F.lds + (32 * w) * 128;
    LAS unsigned char* const dX = F.lds + 32768 + (32 * w) * 128;
#define GC2_ISSUE(kt, st) do { _Pragma("unroll") for (int q = 0; q < 4; ++q) { if (w == 0) GLDS16(W + off[q] + (kt) * 64, dW + (st) * GST2 + q * 1024); GLDS16(X + off[q] + (kt) * 64, dX + (st) * GST2 + q * 1024); } } while (0)
    const int wn4 = w & 3, wm2 = w >> 2, c15 = lane & 15, g4 = lane >> 4;
    const int sw = (c15 >> 1) & 7;
    int so[2];
#pragma unroll
    for (int s = 0; s < 2; ++s) so[s] = ((4 * s + g4) ^ sw) << 4;
    const int bn0 = (64 * wn4 + c15) * 128, bm0 = 32768 + (128 * wm2 + c15) * 128;
#pragma unroll
    for (int a = 0; a < 2; ++a)
#pragma unroll
        for (int b = 0; b < 8; ++b) acc[a][b] = (f32x4){0.f, 0.f, 0.f, 0.f};
    if (issue_first) GC2_ISSUE(0, 0);
    asm volatile("s_waitcnt vmcnt(0)" ::: "memory");
    __syncthreads();
    for (int kt = 0; kt < 16; ++kt) {
        const int st = kt & 1;
        if (kt + 1 < 16) GC2_ISSUE(kt + 1, st ^ 1);
        LAS unsigned char* const base = F.lds + st * GST2;
        if (wn4 == 0) {
#pragma unroll
        for (int s = 0; s < 2; ++s) {
            bf16x8 fa[2];
#pragma unroll
            for (int q = 0; q < 2; ++q) fa[q] = *(const LAS bf16x8*)(base + bn0 + q * 2048 + so[s]);
#pragma unroll
            for (int hb = 0; hb < 2; ++hb) {
                bf16x8 fb[4];
#pragma unroll
                for (int q = 0; q < 4; ++q) fb[q] = *(const LAS bf16x8*)(base + bm0 + (4 * hb + q) * 2048 + so[s]);
#pragma unroll
                for (int a = 0; a < 2; ++a)
#pragma unroll
                    for (int b = 0; b < 4; ++b) acc[a][4 * hb + b] = __builtin_amdgcn_mfma_f32_16x16x32_bf16(fa[a], fb[b], acc[a][4 * hb + b], 0, 0, 0);
            }
        }
        }
        asm volatile("s_waitcnt vmcnt(0)" ::: "memory");
        __syncthreads();
    }
#undef GC2_ISSUE
}

__device__ __forceinline__ void rope64_16(float (&v)[4][4], float rowp, float colp, int g4) {
#pragma unroll
    for (int i = 0; i < 4; ++i) {
        const float fr = __builtin_amdgcn_exp2f((float)(4 * g4 + i) * -0.8304820237218406f) * 0.15915494309189535f;
#pragma unroll
        for (int c = 0; c < 2; ++c) {
            const float rev = (c ? colp : rowp) * fr;
            const float sn = __builtin_amdgcn_sinf(rev), cs = __builtin_amdgcn_cosf(rev);
            const float x0 = v[2 * c][i], x1 = v[2 * c + 1][i];
            v[2 * c][i] = x0 * cs - x1 * sn;
            v[2 * c + 1][i] = x1 * cs + x0 * sn;
        }
    }
}
__device__ __forceinline__ void rope32_16(float (&a)[4], float (&b)[4], float rowp, float colp, int g4) {
    const bool hi = g4 >= 2;
#pragma unroll
    for (int i = 0; i < 4; ++i) {
        const float fr = __builtin_amdgcn_exp2f((float)(4 * (g4 & 1) + i) * -1.6609640474436813f) * 0.15915494309189535f;
        {
            const float rev = rowp * fr;
            const float sn = __builtin_amdgcn_sinf(rev), cs = __builtin_amdgcn_cosf(rev);
            const float own = a[i], oth = __shfl_xor(own, 32);
            a[i] = own * cs + oth * (hi ? sn : -sn);
        }
        {
            const float rev = colp * fr;
            const float sn = __builtin_amdgcn_sinf(rev), cs = __builtin_amdgcn_cosf(rev);
            const float own = b[i], oth = __shfl_xor(own, 32);
            b[i] = own * cs + oth * (hi ? sn : -sn);
        }
    }
}
__device__ __forceinline__ float ssq64(const float (&v)[4][4]) {
    float s = 0.f;
#pragma unroll
    for (int nt = 0; nt < 4; ++nt)
#pragma unroll
        for (int i = 0; i < 4; ++i) s += v[nt][i] * v[nt][i];
    s += __shfl_xor(s, 16);
    s += __shfl_xor(s, 32);
    return s;
}
__device__ __forceinline__ void mulvec64(float (&v)[4][4], const LAS float* gv, int g4) {
#pragma unroll
    for (int nt = 0; nt < 4; ++nt) {
        const f32x4 q = *(const LAS f32x4*)(gv + 16 * nt + 4 * g4);
#pragma unroll
        for (int i = 0; i < 4; ++i) v[nt][i] *= q[i];
    }
}
constexpr int OST_LD = 68, OST_BYTES = 32 * OST_LD * 4;
__device__ __forceinline__ void stage_write16(LAS float* st, const float (&v)[4][4], int mh, int c15, int g4) {
    asm volatile("s_waitcnt lgkmcnt(0)" ::: "memory");
    __builtin_amdgcn_wave_barrier();
#pragma unroll
    for (int nt = 0; nt < 4; ++nt) {
        f32x4 o = {v[nt][0], v[nt][1], v[nt][2], v[nt][3]};
        *(LAS f32x4*)(st + (16 * mh + c15) * OST_LD + 16 * nt + 4 * g4) = o;
    }
    asm volatile("s_waitcnt lgkmcnt(0)" ::: "memory");
    __builtin_amdgcn_wave_barrier();
}
__device__ __forceinline__ void stage_write16a(LAS float* st, const f32x4 (&a)[4][4], int mt, int c15, int g4) {
    asm volatile("s_waitcnt lgkmcnt(0)" ::: "memory");
    __builtin_amdgcn_wave_barrier();
#pragma unroll
    for (int nt = 0; nt < 4; ++nt) *(LAS f32x4*)(st + (16 * (mt & 1) + c15) * OST_LD + 16 * nt + 4 * g4) = a[nt][mt];
    asm volatile("s_waitcnt lgkmcnt(0)" ::: "memory");
    __builtin_amdgcn_wave_barrier();
}
__device__ __forceinline__ void stage_store_bf16(const LAS float* st, bf16_t* dst, int ld, float sc, int lane) {
#pragma unroll 1
    for (int it = 0; it < 4; ++it) {
        const int row = it * 8 + (lane >> 3), c8 = (lane & 7) * 8;
        const f32x4 x0 = *(const LAS f32x4*)(st + row * OST_LD + c8), x1 = *(const LAS f32x4*)(st + row * OST_LD + c8 + 4);
        u32x4 o; o.x = pk2(x0[0] * sc, x0[1] * sc); o.y = pk2(x0[2] * sc, x0[3] * sc); o.z = pk2(x1[0] * sc, x1[1] * sc); o.w = pk2(x1[2] * sc, x1[3] * sc);
        ST16_WT(dst + (size_t)row * ld + c8, o);
    }
}
__device__ __forceinline__ void stage_store_bf16_sc1(const LAS float* st, bf16_t* dst, int ld, int lane) {
#pragma unroll 1
    for (int it = 0; it < 4; ++it) {
        const int row = it * 8 + (lane >> 3), c8 = (lane & 7) * 8;
        const f32x4 x0 = *(const LAS f32x4*)(st + row * OST_LD + c8), x1 = *(const LAS f32x4*)(st + row * OST_LD + c8 + 4);
        u32x4 o; o.x = pk2(x0[0], x0[1]); o.y = pk2(x0[2], x0[3]); o.z = pk2(x1[0], x1[1]); o.w = pk2(x1[2], x1[3]);
        bf16_t* ptr = dst + (size_t)row * ld + c8;
        asm volatile("global_store_dwordx4 %0, %1, off sc1\n\ts_nop 1" :: "v"(ptr), "v"(o) : "memory");
    }
}
__device__ __forceinline__ void stage_store_f32(const LAS float* st, float* dst, int ld, int lane) {
#pragma unroll 1
    for (int it = 0; it < 8; ++it) {
        const int row = it * 4 + (lane >> 4), c = (lane & 15) * 4;
        { const f32x4 o = *(const LAS f32x4*)(st + row * OST_LD + c); ST16_WT(dst + (size_t)row * ld + c, o); }
    }
}
__device__ __forceinline__ void stage_store_bf16_32(const LAS float* st, bf16_t* dst, int ld, int lane) {
#pragma unroll 1
    for (int it = 0; it < 2; ++it) {
        const int row = it * 16 + (lane >> 2), c8 = (lane & 3) * 8;
        const f32x4 x0 = *(const LAS f32x4*)(st + row * OST_LD + c8), x1 = *(const LAS f32x4*)(st + row * OST_LD + c8 + 4);
        u32x4 o; o.x = pk2(x0[0], x0[1]); o.y = pk2(x0[2], x0[3]); o.z = pk2(x1[0], x1[1]); o.w = pk2(x1[2], x1[3]);
        ST16_WT(dst + (size_t)row * ld + c8, o);
    }
}
__device__ __forceinline__ void stage_store_f32_32(const LAS float* st, float* dst, int ld, int lane) {
#pragma unroll 1
    for (int it = 0; it < 4; ++it) {
        const int row = it * 8 + (lane >> 3), c = (lane & 7) * 4;
        { const f32x4 o = *(const LAS f32x4*)(st + row * OST_LD + c); ST16_WT(dst + (size_t)row * ld + c, o); }
    }
}

struct Gemm1Pre { float rstd[2]; float bias, gain; };
__device__ __forceinline__ void gemm1_pre(const Frame& F, const Params& p, int tn, int wn, int tm, int l, Gemm1Pre& P) {
    const float* ssqp = (const float*)(F.ws + WS_SSQ);
#pragma unroll
    for (int jj = 0; jj < 2; ++jj) {
        const int tok = tm * 256 + (F.w >> 2) * 128 + 64 * jj + F.lane;
        const f32x4* sp = (const f32x4*)(ssqp + (size_t)tok * 16);
        float ss = 0.f;
#pragma unroll
        for (int i = 0; i < 4; ++i) { const f32x4 q = sp[i]; ss += (q[0] + q[1]) + (q[2] + q[3]); }
        P.rstd[jj] = rsqrtf(ss * (1.f / 1024.f) + EPS);
    }
    const bool lat = tm >= 16;
    const int cond = lat ? 1 + ((tm - 16) >> 2) : 0;
    const int nb = tn * 128 + wn * 64;
    P.bias = (tn < 23) ? ((const float*)(F.ws + WS_BIAS))[(size_t)(l * 5 + cond) * 2944 + nb + F.lane] : 0.f;
    const float* gp = nullptr;
    if (tn >= 6 && tn < 9) gp = pin(F, I_GQN) + l * 64;
    else if (tn == 9) gp = pin(F, I_GKN) + l * 64;
    else if (tn == 11 || tn == 12) gp = pin(F, I_MQN) + l * 256 + (nb - 1408);
    else if (tn == 13) gp = pin(F, I_MKVN) + l * 128 + wn * 64;
    P.gain = gp ? gp[F.lane] : 1.f;
}
__device__ __forceinline__ void epi_gemm1(const Frame& F, const Params& p, GemmAcc8& acc, int tn, int wn, int tm, int l, const Gemm1Pre& P, bool ckv_tile) {
    int lane = F.lane; const int wm = F.w >> 2;
    asm volatile("" : "+v"(lane));
    const int c15 = lane & 15, g4 = lane >> 4;
    unsigned char* ws = F.ws;
    asm volatile("" : "+s"(ws));
    LAS float* st = (LAS float*)(F.lds + LDS_OST + F.w * OST_BYTES);
    const bool lat = tm >= 16;
    const int b = lat ? ((tm - 16) >> 2) : tm;
    const int nb = tn * 128 + wn * 64;
    LAS float* exb = (LAS float*)(F.lds + LDS_EXB) + F.w * 128;
    exb[lane] = P.bias; exb[64 + lane] = P.gain;
    asm volatile("s_waitcnt lgkmcnt(0)" ::: "memory");
    __builtin_amdgcn_wave_barrier();
    const LAS float* bias = exb;
    float* outp = p.out;
    asm volatile("" : "+s"(outp));
    float ckv_ss[8];
    if (tn < 23) {
#pragma unroll
    for (int mt = 0; mt < 8; ++mt) {
        const int mh = mt & 1;
        const int tok0 = tm * 256 + wm * 128 + (mt >> 1) * 32;
        const int tokb = tok0 + 16 * mh, tok = tokb + c15;
        const int t0 = lat ? ((tok0 - 4096) & 1023) : (tok0 & 255), t = t0 + 16 * mh + c15;
        const float rstd = __shfl(P.rstd[mt >> 2], 16 * (mt & 3) + c15);
        float v[4][4];
#pragma unroll
        for (int nt = 0; nt < 4; ++nt) {
            const f32x4 bq = *(const LAS f32x4*)(bias + 16 * nt + 4 * g4);
#pragma unroll
            for (int i = 0; i < 4; ++i) v[nt][i] = acc[nt][mt][i] * rstd + bq[i];
        }
        const float rowp = (float)(t >> 6), colp = (float)(t & 63);
        const size_t orow0 = (size_t)(b * 4 + l) * 256 + t0;
        if (tn < 2) {
            if (lat) rope64_16(v, rowp, colp, g4);
            stage_write16(st, v, mh, c15, g4);
            if (mh) stage_store_bf16(st, (bf16_t*)(ws + WS_RQ) + (size_t)tok0 * 256 + nb, 256, 1.f, lane);
        } else if (tn < 4) {
            if (lat) rope64_16(v, rowp, colp, g4);
            stage_write16(st, v, mh, c15, g4);
            if (mh) stage_store_bf16(st, (bf16_t*)(ws + WS_RK) + (size_t)tok0 * 256 + (nb - 256), 256, 0.125f, lane);
        } else if (tn < 6) {
            stage_write16(st, v, mh, c15, g4);
            if (mh) stage_store_bf16(st, (bf16_t*)(ws + WS_RV) + (size_t)tok0 * 256 + (nb - 512), 256, 1.f, lane);
        } else if (tn < 9) {
            const float r = rsqrtf(ssq64(v) * (1.f / 64.f) + EPS);
#pragma unroll
            for (int nt = 0; nt < 4; ++nt)
#pragma unroll
                for (int i = 0; i < 4; ++i) v[nt][i] *= r;
            mulvec64(v, exb + 64, g4);
            if (lat) rope64_16(v, rowp, colp, g4);
            stage_write16(st, v, mh, c15, g4);
            if (mh) stage_store_bf16(st, (bf16_t*)(ws + WS_GQ) + (size_t)tok0 * 384 + (nb - 768), 384, QSC_GQA, lane);
        } else if (tn == 9) {
            const float r = rsqrtf(ssq64(v) * (1.f / 64.f) + EPS);
#pragma unroll
            for (int nt = 0; nt < 4; ++nt)
#pragma unroll
                for (int i = 0; i < 4; ++i) v[nt][i] *= r;
            mulvec64(v, exb + 64, g4);
            if (lat) rope64_16(v, rowp, colp, g4);
            stage_write16(st, v, mh, c15, g4);
            if (mh) {
                if (!lat) stage_store_f32(st, outp + O_GK + orow0 * 128 + (nb - 1152), 128, lane);
                stage_store_bf16(st, (bf16_t*)(ws + WS_GK) + (size_t)tok0 * 128 + (nb - 1152), 128, 1.f, lane);
            }
        } else if (tn == 10) {
            stage_write16(st, v, mh, c15, g4);
            if (mh) {
                if (!lat) stage_store_f32(st, outp + O_GV + orow0 * 128 + (nb - 1280), 128, lane);
                stage_store_bf16(st, (bf16_t*)(ws + WS_GV) + (size_t)tok0 * 128 + (nb - 1280), 128, 1.f, lane);
            }
        } else if (tn < 13) {
            const float s2 = ssq64(v);
            if (g4 == 0) __hip_atomic_store((__attribute__((address_space(1))) float*)((float*)(ws + WS_CQSSQ) + (size_t)tok * 4 + ((nb - 1408) >> 6)), s2, __ATOMIC_RELAXED, __HIP_MEMORY_SCOPE_AGENT);
            mulvec64(v, exb + 64, g4);
            stage_write16(st, v, mh, c15, g4);
            if (mh) stage_store_bf16_sc1(st, (bf16_t*)(ws + WS_CQG) + (size_t)tok0 * 256 + (nb - 1408), 256, lane);
        } else if (tn == 13) {
            ckv_ss[mt] = ssq64(v);
            if (g4 == 0) ((LAS float*)(F.lds + LDS_EX))[(wm * 2 + wn) * 128 + mt * 16 + c15] = ckv_ss[mt];
        } else if (tn < 22) {
#pragma unroll
            for (int nt = 0; nt < 4; ++nt)
#pragma unroll
                for (int i = 0; i < 4; ++i) v[nt][i] = silu_f(v[nt][i]);
            stage_write16(st, v, mh, c15, g4);
            if (mh) stage_store_bf16(st, (bf16_t*)(ws + WS_ZS) + (size_t)tok0 * 1024 + (nb - 1792), 1024, 1.f, lane);
        } else {
            if (wn == 0) {
                if (lat) rope32_16(v[0], v[1], rowp, colp, g4);
                stage_write16(st, v, mh, c15, g4);
                if (mh) {
                    if (!lat) stage_store_f32_32(st, outp + O_KPE + orow0 * 32, 32, lane);
                    stage_store_bf16_32(st, (bf16_t*)(ws + WS_KPEB) + (size_t)tok0 * 32, 32, lane);
                }
            }
        }
    }
    }
    if (ckv_tile) {
        __syncthreads();
        if (tn == 13) {
#pragma unroll
        for (int mt = 0; mt < 8; ++mt) {
            const int mh = mt & 1;
            const int tok0 = tm * 256 + wm * 128 + (mt >> 1) * 32;
            const int t0 = lat ? ((tok0 - 4096) & 1023) : (tok0 & 255);
            const float rstd = __shfl(P.rstd[mt >> 2], 16 * (mt & 3) + c15);
            float v[4][4];
#pragma unroll
            for (int nt = 0; nt < 4; ++nt) {
                const f32x4 bq = *(const LAS f32x4*)(bias + 16 * nt + 4 * g4);
#pragma unroll
                for (int i = 0; i < 4; ++i) v[nt][i] = acc[nt][mt][i] * rstd + bq[i];
            }
            const float tot = ckv_ss[mt] + ((const LAS float*)(F.lds + LDS_EX))[(wm * 2 + (wn ^ 1)) * 128 + mt * 16 + c15];
            const float r = rsqrtf(tot * (1.f / 128.f) + EPS);
#pragma unroll
            for (int nt = 0; nt < 4; ++nt)
#pragma unroll
                for (int i = 0; i < 4; ++i) v[nt][i] *= r;
            mulvec64(v, exb + 64, g4);
            const size_t orow0 = (size_t)(b * 4 + l) * 256 + t0;
            stage_write16(st, v, mh, c15, g4);
            if (mh) {
                if (!lat) stage_store_f32(st, outp + O_CKV + orow0 * 128 + wn * 64, 128, lane);
                stage_store_bf16_sc1(st, (bf16_t*)(ws + WS_CKVN) + (size_t)tok0 * 128 + wn * 64, 128, lane);
            }
        }
        }
        __syncthreads();
    }
}

__device__ __forceinline__ void qm_pre(const Frame& F, int tm, float& rstd) {
    const int tok = tm * 256 + (F.w >> 1) * 64 + F.lane;
    const f32x4 q4 = *(const f32x4*)((const float*)(F.ws + WS_CQSSQ) + (size_t)tok * 4);
    rstd = rsqrtf(((q4[0] + q4[1]) + (q4[2] + q4[3])) * (1.f / 256.f) + EPS);
}
__device__ __forceinline__ void epi_qm(const Frame& F, GemmAcc& acc, int tn, int tm, float rstdl) {
    int lane = F.lane; const int wn = F.w & 1, wm = F.w >> 1;
    asm volatile("" : "+v"(lane));
    const int c15 = lane & 15, g4 = lane >> 4;
    unsigned char* ws = F.ws;
    LAS float* st = (LAS float*)(F.lds + LDS_OST + F.w * OST_BYTES);
    const bool lat = tm >= 16;
    const int nb = tn * 128 + wn * 64;
    if (nb >= 576) return;
#pragma unroll
    for (int mt = 0; mt < 4; ++mt) {
        const int mh = mt & 1;
        const int tok0 = tm * 256 + wm * 64 + (mt >> 1) * 32, tok = tok0 + 16 * mh + c15;
        const int t = lat ? ((tok - 4096) & 1023) : (tok & 255);
        const float rstd = __shfl(rstdl, 16 * mt + c15);
        const float rowp = (float)(t >> 6), colp = (float)(t & 63);
        float v[4][4];
#pragma unroll
        for (int nt = 0; nt < 4; ++nt)
#pragma unroll
            for (int i = 0; i < 4; ++i) v[nt][i] = acc[nt][mt][i] * rstd;
#pragma unroll
        for (int q = 0; q < 2; ++q) {
            const int T = (nb + 32 * q) >> 5;
            if (lat && (T % 3) == 2) rope32_16(v[2 * q], v[2 * q + 1], rowp, colp, g4);
        }
        stage_write16(st, v, mh, c15, g4);
        if (mh) stage_store_bf16(st, (bf16_t*)(ws + WS_QM) + (size_t)tok0 * 576 + nb, 576, QSC_MLA, lane);
    }
}
__device__ __forceinline__ void epi_plain(const Frame& F, GemmAcc& acc, bf16_t* D, int ldd, int row0, int n0) {
    int lane = F.lane; const int wn = F.w & 1, wm = F.w >> 1;
    asm volatile("" : "+v"(lane));
    const int c15 = lane & 15, g4 = lane >> 4;
    LAS float* st = (LAS float*)(F.lds + LDS_OST + F.w * OST_BYTES);
#pragma unroll
    for (int mt = 0; mt < 4; ++mt) {
        const int r0 = row0 + wm * 64 + (mt >> 1) * 32;
        stage_write16a(st, acc, mt, c15, g4);
        if (mt & 1) stage_store_bf16(st, D + (size_t)r0 * ldd + n0 + wn * 64, ldd, 1.f, lane);
    }
}

struct Gemm2Pre { f32x4 gt0, gt1, gs0, gs1; };
__device__ __forceinline__ void gemm2_pre(const Frame& F, int tn, int tm, int l, Gemm2Pre& P) {
    const bool lat = tm >= 16; const int cond = lat ? 1 + ((tm - 16) >> 2) : 0;
    const int nb = tn * 128 + (F.w & 1) * 64, c8 = (F.lane & 7) * 8;
    const float* gtp = (const float*)(F.ws + WS_MODS) + (size_t)(l * 5 + cond) * 3072 + 2048 + nb + c8;
    const float* gsp = (const float*)(F.ws + WS_GS) + (size_t)((l < 3 ? l + 1 : 3) * 5 + cond) * 1024 + nb + c8;
    P.gt0 = *(const f32x4*)gtp; P.gt1 = *(const f32x4*)(gtp + 4);
    P.gs0 = *(const f32x4*)gsp; P.gs1 = *(const f32x4*)(gsp + 4);
}
__device__ __forceinline__ void epi_gemm2(const Frame& F, const Params& p, GemmAcc& acc, int tn, int tm, int l, const Gemm2Pre& P, bool last) {
    int lane = F.lane; const int wn = F.w & 1, wm = F.w >> 1;
    asm volatile("" : "+v"(lane));
    const int c15 = lane & 15, g4 = lane >> 4;
    unsigned char* ws = F.ws;
    LAS float* st = (LAS float*)(F.lds + LDS_OST + F.w * OST_BYTES);
    const bool lat = tm >= 16;
    const int nb = tn * 128 + wn * 64;
    const int c8 = (lane & 7) * 8, r8 = lane >> 3;
#pragma unroll
    for (int mt = 0; mt < 2; ++mt) {
        const int tok0 = tm * 256 + wm * 64 + mt * 32;
        stage_write16a(st, acc, 2 * mt, c15, g4);
        stage_write16a(st, acc, 2 * mt + 1, c15, g4);
        bf16_t* xb0 = (bf16_t*)(ws + WS_XB) + (size_t)tok0 * 1024 + nb + c8;
        f32x4 xo8[8];
        if (l == 0) {
            const float* xold0 = lat ? pin(F, I_XS) + (size_t)(tok0 - 4096) * 1024 : pin(F, I_XP) + (size_t)tok0 * 1024;
#pragma unroll
            for (int it = 0; it < 4; ++it) {
                const float* xp = xold0 + (size_t)(it * 8 + r8) * 1024 + nb + c8;
                xo8[2 * it] = __builtin_nontemporal_load((const f32x4*)xp); xo8[2 * it + 1] = __builtin_nontemporal_load((const f32x4*)(xp + 4));
            }
        } else {
#pragma unroll
            for (int it = 0; it < 4; ++it) {
                const u32x4 q = *(const u32x4*)(xb0 + (size_t)(it * 8 + r8) * 1024);
                xo8[2 * it] = (f32x4){bflo(q.x), bfhi(q.x), bflo(q.y), bfhi(q.y)}; xo8[2 * it + 1] = (f32x4){bflo(q.z), bfhi(q.z), bflo(q.w), bfhi(q.w)};
            }
        }
#pragma unroll
        for (int it = 0; it < 4; ++it) {
            const int row = it * 8 + r8;
            const f32x4 a0 = *(const LAS f32x4*)(st + row * OST_LD + c8), a1 = *(const LAS f32x4*)(st + row * OST_LD + c8 + 4);
            const f32x4 xn0 = xo8[2 * it] + P.gt0 * a0, xn1 = xo8[2 * it + 1] + P.gt1 * a1;
            {
                u32x4 o; o.x = pk2(xn0[0], xn0[1]); o.y = pk2(xn0[2], xn0[3]); o.z = pk2(xn1[0], xn1[1]); o.w = pk2(xn1[2], xn1[3]);
                if (last) ST16_WT(xb0 + (size_t)row * 1024, o); else *(u32x4*)(xb0 + (size_t)row * 1024) = o;
            }
            float ss = ((xn0[0] * xn0[0] + xn0[1] * xn0[1]) + (xn0[2] * xn0[2] + xn0[3] * xn0[3])) + ((xn1[0] * xn1[0] + xn1[1] * xn1[1]) + (xn1[2] * xn1[2] + xn1[3] * xn1[3]));
            ss += __shfl_xor(ss, 1); ss += __shfl_xor(ss, 2); ss += __shfl_xor(ss, 4);
            if ((lane & 7) == 0) {
                float* sq = (float*)(ws + WS_SSQ) + (size_t)(tok0 + row) * 16 + tn * 2 + wn;
                __hip_atomic_store((__attribute__((address_space(1))) float*)sq, ss, __ATOMIC_RELAXED, __HIP_MEMORY_SCOPE_AGENT);
            }
            if (l < 3) {
                u32x4 o; o.x = pk2(xn0[0] * P.gs0[0], xn0[1] * P.gs0[1]); o.y = pk2(xn0[2] * P.gs0[2], xn0[3] * P.gs0[3]);
                o.z = pk2(xn1[0] * P.gs1[0], xn1[1] * P.gs1[1]); o.w = pk2(xn1[2] * P.gs1[2], xn1[3] * P.gs1[3]);
                ST16_WT((bf16_t*)(ws + WS_XG) + (size_t)(tok0 + row) * 1024 + nb + c8, o);
            }
        }
    }
}

__device__ __forceinline__ void epi_kpe(const Frame& F, const Params& p, GemmAcc2& acc, int tm, int l, const Gemm1Pre& P) {
    int lane = F.lane; const int wm = F.w >> 2;
    asm volatile("" : "+v"(lane));
    const int c15 = lane & 15, g4 = lane >> 4;
    unsigned char* ws = F.ws;
    asm volatile("" : "+s"(ws));
    float* outp = p.out;
    asm volatile("" : "+s"(outp));
    LAS float* st = (LAS float*)(F.lds + LDS_OST + F.w * OST_BYTES);
    const bool lat = tm >= 16;
    const int b = lat ? ((tm - 16) >> 2) : tm;
    LAS float* exb = (LAS float*)(F.lds + LDS_EXB) + F.w * 128;
    exb[lane] = P.bias;
    asm volatile("s_waitcnt lgkmcnt(0)" ::: "memory");
    __builtin_amdgcn_wave_barrier();
#pragma unroll
    for (int mt = 0; mt < 8; ++mt) {
        const int mh = mt & 1;
        const int tok0 = tm * 256 + wm * 128 + (mt >> 1) * 32;
        const int t0 = lat ? ((tok0 - 4096) & 1023) : (tok0 & 255), t = t0 + 16 * mh + c15;
        const float rstd = __shfl(P.rstd[mt >> 2], 16 * (mt & 3) + c15);
        float v[4][4];
#pragma unroll
        for (int nt = 0; nt < 2; ++nt) {
            const f32x4 bq = *(const LAS f32x4*)(exb + 16 * nt + 4 * g4);
#pragma unroll
            for (int i = 0; i < 4; ++i) { v[nt][i] = acc[nt][mt][i] * rstd + bq[i]; v[2 + nt][i] = 0.f; }
        }
        const float rowp = (float)(t >> 6), colp = (float)(t & 63);
        const size_t orow0 = (size_t)(b * 4 + l) * 256 + t0;
        if (lat) rope32_16(v[0], v[1], rowp, colp, g4);
        stage_write16(st, v, mh, c15, g4);
        if (mh) {
            if (!lat) stage_store_f32_32(st, outp + O_KPE + orow0 * 32, 32, lane);
            stage_store_bf16_32(st, (bf16_t*)(ws + WS_KPEB) + (size_t)tok0 * 32, 32, lane);
        }
    }
}
constexpr int AT_STG = 20480, AT_PE = 8192, AT_V = 12288, AT_OLD = 68;
struct AttnUnit {
    int mode;
    int nt0, nt1;
    const bf16_t *q; int q_ld;
    const bf16_t *k0, *k1; int k_ld0, k_ld1;
    const bf16_t *pe0, *pe1;
    const bf16_t *v0, *v1; int v_ld0, v_ld1;
    int tok0;
    int ycol;
    int qpos0, L;
    float lf, lb;
    const bf16_t *s0f, *s0b;
    unsigned* zflag;
    unsigned* yflag;
    float* st_out;
};
__device__ __forceinline__ s16x4 tr16(LAS const unsigned char* p) {
    typedef short v4i16_t __attribute__((ext_vector_type(4)));
    return __builtin_bit_cast(s16x4, __builtin_amdgcn_ds_read_tr16_b64_v4i16((LAS v4i16_t*)p));
}

template <int MODE>
__device__ __forceinline__ void attn_unit(const Frame& F, const Params& p, const AttnUnit& U) {
    constexpr int NQS = MODE == 1 ? 6 : 4;
    int lane = F.lane; const int w = F.w;
    asm volatile("" : "+v"(lane));
    const int h = lane >> 5, lq = lane & 31;
    LAS unsigned char* lds = F.lds;
    const int k_ld = U.k_ld1, v_ld = U.v_ld1;
    const int krow = 8 * w + (lane >> 3);
    const int koff = krow * k_ld + ((lane & 7) ^ ((krow >> 1) & 7)) * 8;
    const int poff = (16 * (w & 3) + (lane >> 2)) * 32 + ((lane & 3) ^ ((lane >> 4) & 3)) * 8;
    const int vdblk = w >> 2, vkg = w & 3;
    const int voff = (16 * vkg + (lane >> 2)) * v_ld + vdblk * 32 + (lane & 3) * 8;
    const int vdst = AT_V + vdblk * 4096 + vkg * 1024;
    const int nt0 = U.nt0, ntot = U.nt0 + U.nt1;
    const unsigned ldsb = (unsigned)(uintptr_t)lds;
#define AT_DMA(gsrc, ldsoff) do { unsigned _keep; const unsigned _d = (unsigned)__builtin_amdgcn_readfirstlane((int)(ldsb + (unsigned)(ldsoff))); \
        asm volatile("s_mov_b32 %0, m0\n\ts_mov_b32 m0, %2\n\ts_nop 0\n\tglobal_load_lds_dwordx4 %1, off\n\ts_mov_b32 m0, %0" : "=&s"(_keep) : "v"(gsrc), "s"(_d) : "memory"); } while (0)
#define AT_ISSUE(t, st) do { const int _t = (t); const int _b = (st) * AT_STG; \
        const bool _s0 = _t < nt0; const int _u = _s0 ? _t : _t - nt0; \
        const bf16_t* _kb = (_s0 ? U.k0 : U.k1) + (size_t)_u * 64 * k_ld; const bf16_t* _vb = (_s0 ? U.v0 : U.v1) + (size_t)_u * 64 * v_ld; \
        AT_DMA(_kb + koff, _b + (8 * w) * 128); \
        if (MODE == 1) { const bf16_t* _pb = (_s0 ? U.pe0 : U.pe1) + (size_t)_u * 64 * 32; AT_DMA(_pb + poff, _b + AT_PE + 16 * (w & 3) * 64); } \
        AT_DMA(_vb + voff, _b + vdst); } while (0)
    AT_ISSUE(0, 0);
    if (ntot > 1) AT_ISSUE(1, 1);
    bf16x8 qr[NQS];
    if (MODE == 3) {
        const int dk = 32 * (w & 1) + lq;
#pragma unroll
        for (int s = 0; s < 4; ++s)
#pragma unroll
            for (int j = 0; j < 8; ++j) qr[s][j] = (16 * s + 8 * h + j == dk) ? (short)0x3F80 : (short)0;
    } else {
        const bf16_t* qp = U.q + (size_t)(32 * w + lq) * U.q_ld + 8 * h;
#pragma unroll
        for (int s = 0; s < NQS; ++s) qr[s] = *(const bf16x8*)(qp + 16 * s);
    }
    f32x16 o[2];
#pragma unroll
    for (int d = 0; d < 2; ++d)
#pragma unroll
        for (int r = 0; r < 16; ++r) o[d][r] = 0.f;
    float m_run = 0.f, l_run = 0.f;
    f32x16 negm;
#pragma unroll
    for (int r = 0; r < 16; ++r) negm[r] = 0.f;
    const int qpos = U.qpos0 + 32 * w + lq;
    const float st_slope = ((w >> 1) & 1) ? U.lb : -U.lf, st_off = ((w >> 1) & 1) ? 0.f : 255.f * U.lf;
    const int sdir = (w >> 1) & 1;
    LAS float* scal = (LAS float*)(lds + LDS_SCAL) + w * 32;
    LAS float* ctab = (LAS float*)(lds + LDS_EXB) + w * 128;
    float a_f = 0.f, a_b = 0.f;
    if (MODE == 2) {
        ctab[lane] = __builtin_amdgcn_exp2f((float)(63 - lane) * U.lf);
        ctab[64 + lane] = __builtin_amdgcn_exp2f((float)lane * U.lb);
        a_f = __builtin_amdgcn_exp2f((float)(32 * w + lq) * U.lf);
        a_b = __builtin_amdgcn_exp2f((float)(255 - 32 * w - lq) * U.lb);
        asm volatile("s_waitcnt lgkmcnt(0)" ::: "memory");
        __builtin_amdgcn_wave_barrier();
    }
    const int kfo = lq * 128, sw = (lane >> 1) & 7, pfo = AT_PE + lq * 64, psw = (lane >> 2) & 3;
    const int vfo = AT_V + (4 * h + ((lane & 15) >> 2)) * 64 + ((lane >> 4) & 1) * 32 + (lane & 3) * 8;
    int st = 0;
    for (int t = 0; t < ntot; ++t) {
        if (t + 1 < ntot) { if (MODE == 1) asm volatile("s_waitcnt vmcnt(3)" ::: "memory"); else asm volatile("s_waitcnt vmcnt(2)" ::: "memory"); }
        else asm volatile("s_waitcnt vmcnt(0)" ::: "memory");
        __builtin_amdgcn_s_barrier();
        asm volatile("" ::: "memory");
        const int st2 = st == 0 ? 2 : st - 1;
        if (t + 2 < ntot) AT_ISSUE(t + 2, st2);
        LAS const unsigned char* base = lds + st * AT_STG;
        bf16x8 kfa[NQS], kfb[NQS];
#pragma unroll
        for (int s = 0; s < 4; ++s) {
            const int so = ((2 * s + h) ^ sw) << 4;
            kfa[s] = *(const LAS bf16x8*)(base + kfo + so);
            kfb[s] = *(const LAS bf16x8*)(base + kfo + 4096 + so);
        }
        if (MODE == 1) {
#pragma unroll
            for (int s = 0; s < 2; ++s) {
                const int so = ((2 * s + h) ^ psw) << 4;
                kfa[4 + s] = *(const LAS bf16x8*)(base + pfo + so);
                kfb[4 + s] = *(const LAS bf16x8*)(base + pfo + 2048 + so);
            }
        }
        f32x16 p0, p1;
        if (MODE <= 1) { p0 = negm; p1 = negm; }
        else {
#pragma unroll
            for (int r = 0; r < 16; ++r) { p0[r] = 0.f; p1[r] = 0.f; }
        }
#pragma unroll
        for (int s = 0; s < NQS; ++s) { p0 = MFMA32(kfa[s], qr[s], p0); p1 = MFMA32(kfb[s], qr[s], p1); }
        s16x4 vlo[4], vhi[4];
#pragma unroll
        for (int ks = 0; ks < 4; ++ks) { vlo[ks] = tr16(base + vfo + ks * 1024); vhi[ks] = tr16(base + vfo + ks * 1024 + 512); }
        if (MODE <= 1) {
            float tm = p0[0];
#pragma unroll
            for (int r = 1; r < 16; ++r) tm = fmaxf(tm, p0[r]);
#pragma unroll
            for (int r = 0; r < 16; ++r) tm = fmaxf(tm, p1[r]);
            tm = fmaxf(tm, __shfl_xor(tm, 32));
            if (t == 0 || __any(tm > 6.0f)) {
                const float dl = t == 0 ? tm : fmaxf(tm, 0.f);
                m_run += dl;
#pragma unroll
                for (int r = 0; r < 16; ++r) { p0[r] -= dl; p1[r] -= dl; negm[r] = -m_run; }
                if (t > 0) {
                    const float alpha = __builtin_amdgcn_exp2f(-dl);
                    l_run *= alpha;
                    if (h == 0) scal[lq] = alpha;
                    asm volatile("s_waitcnt lgkmcnt(0)" ::: "memory");
#pragma unroll
                    for (int g = 0; g < 4; ++g) {
                        const f32x4 a4 = *(const LAS f32x4*)(scal + 8 * g + 4 * h);
#pragma unroll
                        for (int i = 0; i < 4; ++i) { o[0][4 * g + i] *= a4[i]; o[1][4 * g + i] *= a4[i]; }
                    }
                }
            }
            float ls = 0.f;
#pragma unroll
            for (int r = 0; r < 16; ++r) { p0[r] = __builtin_amdgcn_exp2f(p0[r]); p1[r] = __builtin_amdgcn_exp2f(p1[r]); ls += p0[r] + p1[r]; }
            l_run += ls;
        } else if (MODE == 2 && (64 * t + 63 < U.qpos0 || 64 * t > U.qpos0 + 255)) {
            const bool fwd = 64 * t + 63 < U.qpos0;
            const float A = fwd ? a_f * __builtin_amdgcn_exp2f((float)(U.qpos0 - 64 * t - 63) * U.lf) : a_b * __builtin_amdgcn_exp2f((float)(64 * t - U.qpos0 - 255) * U.lb);
            const LAS float* tb = ctab + (fwd ? 0 : 64) + 4 * h;
#pragma unroll
            for (int g = 0; g < 4; ++g) {
                const f32x4 c0 = *(const LAS f32x4*)(tb + 8 * g), c1 = *(const LAS f32x4*)(tb + 32 + 8 * g);
#pragma unroll
                for (int i = 0; i < 4; ++i) { p0[4 * g + i] *= c0[i] * A; p1[4 * g + i] *= c1[i] * A; }
            }
        } else if (MODE == 2) {
            float dq = (float)(qpos - 64 * t - 4 * h);
            asm volatile("" : "+v"(dq));
#pragma unroll
            for (int r = 0; r < 16; ++r) {
                const float d0 = dq - (float)((r & 3) + 8 * (r >> 2)), d1 = d0 - 32.f;
                const float w0 = __builtin_amdgcn_exp2f(fabsf(d0) * (d0 > 0.f ? U.lf : U.lb));
                const float w1 = __builtin_amdgcn_exp2f(fabsf(d1) * (d1 > 0.f ? U.lf : U.lb));
                p0[r] *= (d0 == 0.f ? 2.f : w0);
                p1[r] *= (d1 == 0.f ? 2.f : w1);
            }
        } else {
            float mb = (float)(64 * t + 4 * h);
            asm volatile("" : "+v"(mb));
#pragma unroll
            for (int r = 0; r < 16; ++r) {
                const float m0 = mb + (float)((r & 3) + 8 * (r >> 2)), m1 = m0 + 32.f;
                const float e0 = fmaf(m0, st_slope, st_off), e1 = fmaf(m1, st_slope, st_off);
                p0[r] *= __builtin_amdgcn_exp2f(e0);
                p1[r] *= __builtin_amdgcn_exp2f(e1);
            }
        }
        bf16x8 pa[4];
        { u32x4 a;
          a.x = pk2(p0[0], p0[1]); a.y = pk2(p0[2], p0[3]); a.z = pk2(p0[4], p0[5]); a.w = pk2(p0[6], p0[7]); pa[0] = __builtin_bit_cast(bf16x8, a);
          a.x = pk2(p0[8], p0[9]); a.y = pk2(p0[10], p0[11]); a.z = pk2(p0[12], p0[13]); a.w = pk2(p0[14], p0[15]); pa[1] = __builtin_bit_cast(bf16x8, a);
          a.x = pk2(p1[0], p1[1]); a.y = pk2(p1[2], p1[3]); a.z = pk2(p1[4], p1[5]); a.w = pk2(p1[6], p1[7]); pa[2] = __builtin_bit_cast(bf16x8, a);
          a.x = pk2(p1[8], p1[9]); a.y = pk2(p1[10], p1[11]); a.z = pk2(p1[12], p1[13]); a.w = pk2(p1[14], p1[15]); pa[3] = __builtin_bit_cast(bf16x8, a); }
#pragma unroll
        for (int ks = 0; ks < 4; ++ks) {
            const bf16x8 vb = __builtin_shufflevector(vlo[ks], vhi[ks], 0, 1, 2, 3, 4, 5, 6, 7);
            o[0] = MFMA32(pa[ks], vb, o[0]);
        }
#pragma unroll
        for (int ks = 0; ks < 4; ++ks) { vlo[ks] = tr16(base + vfo + 4096 + ks * 1024); vhi[ks] = tr16(base + vfo + 4096 + ks * 1024 + 512); }
#pragma unroll
        for (int ks = 0; ks < 4; ++ks) {
            const bf16x8 vb = __builtin_shufflevector(vlo[ks], vhi[ks], 0, 1, 2, 3, 4, 5, 6, 7);
            o[1] = MFMA32(pa[ks], vb, o[1]);
        }
        st = st == 2 ? 0 : st + 1;
    }
#undef AT_ISSUE
#undef AT_DMA
    int lq2 = lq, h2 = h, lane2 = lane; asm volatile("" : "+v"(lq2), "+v"(h2), "+v"(lane2));
    if (MODE == 2 && U.s0f != nullptr) {
        const float ff = __builtin_amdgcn_exp2f((float)(qpos + 1) * U.lf), fb = __builtin_amdgcn_exp2f((float)(U.L - qpos) * U.lb);
#pragma unroll
        for (int s = 0; s < 4; ++s) {
            const u32x4 qu = __builtin_bit_cast(u32x4, qr[s]);
            u32x4 af, ab;
#pragma unroll
            for (int i = 0; i < 4; ++i) { const float lo = bflo(qu[i]), hi = bfhi(qu[i]); af[i] = pk2(lo * ff, hi * ff); ab[i] = pk2(lo * fb, hi * fb); }
#pragma unroll
            for (int d = 0; d < 2; ++d) {
                const bf16x8 sf = *(const bf16x8*)(U.s0f + (size_t)(32 * d + lq2) * 64 + 16 * s + 8 * h2);
                const bf16x8 sb = *(const bf16x8*)(U.s0b + (size_t)(32 * d + lq2) * 64 + 16 * s + 8 * h2);
                o[d] = MFMA32(__builtin_bit_cast(bf16x8, af), sf, o[d]);
                o[d] = MFMA32(__builtin_bit_cast(bf16x8, ab), sb, o[d]);
            }
        }
    }
    if (MODE == 3) {
        float* dst = U.st_out + (size_t)sdir * 4 * 4096 + (size_t)(32 * (w & 1)) * 64;
        if (w < 4) {
#pragma unroll
        for (int d = 0; d < 2; ++d)
#pragma unroll
            for (int r = 0; r < 16; ++r) dst[(size_t)((r & 3) + 8 * (r >> 2) + 4 * h2) * 64 + 32 * d + lq2] = o[d][r];
        }
        __syncthreads();
        if (F.tid == 0 && U.yflag != nullptr) (void)xb_add(U.yflag, 1u);
        return;
    }
    if (MODE <= 1) {
        l_run += __shfl_xor(l_run, 32);
        if (h2 == 0) scal[lq2] = 1.f / l_run;
    }
    if (U.zflag != nullptr && F.tid == 0) {
        unsigned* bar0 = (unsigned*)(F.ws + WS_CTL) + CW_BAR;
        XB_SPIN(xb_ld(U.zflag) < 4u, bar0);
    }
    __syncthreads();
    LAS float* ost = (LAS float*)lds + w * (32 * AT_OLD);
#pragma unroll
    for (int d = 0; d < 2; ++d)
#pragma unroll
        for (int r = 0; r < 16; ++r) ost[((r & 3) + 8 * (r >> 2) + 4 * h2) * AT_OLD + 32 * d + lq2] = o[d][r];
    asm volatile("s_waitcnt lgkmcnt(0)" ::: "memory");
    __builtin_amdgcn_wave_barrier();
    const bf16_t* zs = (const bf16_t*)(F.ws + WS_ZS);
    bf16_t* yb = (bf16_t*)(F.ws + WS_Y);
#pragma unroll
    for (int it = 0; it < 4; ++it) {
        const int row = it * 8 + (lane2 >> 3), c8 = (lane2 & 7) * 8;
        const f32x4 x0 = *(const LAS f32x4*)(ost + row * AT_OLD + c8), x1 = *(const LAS f32x4*)(ost + row * AT_OLD + c8 + 4);
        float sc;
        if (MODE <= 1) sc = scal[row];
        else {
            float ss = (x0[0] * x0[0] + x0[1] * x0[1]) + (x0[2] * x0[2] + x0[3] * x0[3]) + (x1[0] * x1[0] + x1[1] * x1[1]) + (x1[2] * x1[2] + x1[3] * x1[3]);
            ss += __shfl_xor(ss, 1); ss += __shfl_xor(ss, 2); ss += __shfl_xor(ss, 4);
            sc = rsqrtf(ss * (1.f / 64.f) + EPS);
        }
        const size_t off = (size_t)(U.tok0 + 32 * w + row) * 1024 + U.ycol + c8;
        const u32x4 z = *(const u32x4*)(zs + off);
        u32x4 y;
        y.x = pk2(x0[0] * sc * bflo(z.x), x0[1] * sc * bfhi(z.x));
        y.y = pk2(x0[2] * sc * bflo(z.y), x0[3] * sc * bfhi(z.y));
        y.z = pk2(x1[0] * sc * bflo(z.z), x1[1] * sc * bfhi(z.z));
        y.w = pk2(x1[2] * sc * bflo(z.w), x1[3] * sc * bfhi(z.w));
        ST16_WT(yb + off, y);
    }
    asm volatile("s_waitcnt vmcnt(0)" ::: "memory");
    __syncthreads();
    if (F.tid == 0) (void)xb_add(U.yflag, 1u);
}

__device__ __forceinline__ void dep_wait(const Frame& F, unsigned* c, int n, unsigned target, unsigned* c2 = nullptr, unsigned target2 = 0u) {
    if (F.w == 0) {
        const int ln = lane_id();
        unsigned* ptr = c + 4 * ln; unsigned tgt = target;
        if (c2 != nullptr && ln == n) { ptr = c2; tgt = target2; }
        poll_lanes(ptr, tgt, ln < n + (c2 != nullptr ? 1 : 0), (unsigned*)(F.ws + WS_CTL) + CW_BAR);
    }
}
__device__ __forceinline__ void attn_dispatch(const Frame& F, const Params& p, int u, int l) {
    unsigned char* ws = F.ws;
    AttnUnit U;
    U.nt0 = 0; U.nt1 = 0; U.q = nullptr; U.q_ld = 0; U.k0 = U.k1 = nullptr; U.k_ld0 = U.k_ld1 = 0; U.pe0 = U.pe1 = nullptr; U.v0 = U.v1 = nullptr; U.v_ld0 = U.v_ld1 = 0;
    U.tok0 = 0; U.ycol = 0; U.qpos0 = 0; U.L = 0; U.lf = U.lb = 0.f; U.s0f = U.s0b = nullptr; U.st_out = nullptr; U.mode = 0; U.yflag = nullptr; U.zflag = nullptr;
    const bf16_t* GQ = (const bf16_t*)(ws + WS_GQ); const bf16_t* GK = (const bf16_t*)(ws + WS_GK); const bf16_t* GV = (const bf16_t*)(ws + WS_GV);
    const bf16_t* QM = (const bf16_t*)(ws + WS_QM); const bf16_t* KVM = (const bf16_t*)(ws + WS_KVM); const bf16_t* KVMC = (const bf16_t*)(ws + WS_KVMC);
    const bf16_t* KPEB = (const bf16_t*)(ws + WS_KPEB); const bf16_t* CKPE = (const bf16_t*)(ws + WS_CKPE);
    const bf16_t* CGK = (const bf16_t*)(ws + WS_CGK); const bf16_t* CGV = (const bf16_t*)(ws + WS_CGV);
    const bf16_t* RQ = (const bf16_t*)(ws + WS_RQ); const bf16_t* RK = (const bf16_t*)(ws + WS_RK); const bf16_t* RV = (const bf16_t*)(ws + WS_RV);
    const float* decay = pin(F, I_DECAY) + l * 8;
    if (u < 96 || (u >= 256 && u < 352)) {
        const bool lat = u < 96; const int uu = lat ? u : u - 256;
        const int b = lat ? uu / 24 : uu / 6, hh = lat ? (uu >> 2) % 6 : uu % 6, qb = lat ? (uu & 3) : 0;
        const int seq0 = lat ? 4096 + b * 1024 : b * 256;
        U.mode = 1; U.tok0 = seq0 + qb * 256; U.q = QM + (size_t)U.tok0 * 576 + hh * 96; U.q_ld = 576; U.ycol = 640 + hh * 64;
        U.nt1 = lat ? 16 : 4; U.k1 = KVM + (size_t)seq0 * 768 + hh * 128; U.k_ld1 = 768; U.v1 = U.k1 + 64; U.v_ld1 = 768; U.pe1 = KPEB + (size_t)seq0 * 32;
        U.k0 = U.k1; U.v0 = U.v1; U.pe0 = U.pe1; U.k_ld0 = 768; U.v_ld0 = 768;
        if (lat) { U.nt0 = 8; U.k0 = KVMC + (size_t)(b * 512) * 768 + hh * 128; U.v0 = U.k0 + 64; U.pe0 = CKPE + (size_t)((b * 4 + l) * 512) * 32; }
        U.yflag = (unsigned*)(ws + WS_CTL) + CW_YRDY + (l * 32 + (U.tok0 >> 8)) * 4;
        { unsigned* c = (unsigned*)(ws + WS_CTL);
          dep_wait(F, c + CW_FULL + (l * 32 + (seq0 >> 8)) * 4, lat ? 4 : 1, 23u, lat ? c + CW_KC + (l * 4 + b) * 4 : nullptr, 12u); }
        __syncthreads();
        attn_unit<1>(F, p, U);
    } else if (u < 192 || (u >= 352 && u < 448)) {
        const bool lat = u < 192; const int uu = lat ? u - 96 : u - 352;
        const int b = lat ? uu / 24 : uu / 6, hh = lat ? (uu >> 2) % 6 : uu % 6, qb = lat ? (uu & 3) : 0, kvh = hh / 3;
        const int seq0 = lat ? 4096 + b * 1024 : b * 256;
        U.mode = 0; U.tok0 = seq0 + qb * 256; U.q = GQ + (size_t)U.tok0 * 384 + hh * 64; U.q_ld = 384; U.ycol = 256 + hh * 64;
        U.nt1 = lat ? 16 : 4; U.k1 = GK + (size_t)seq0 * 128 + kvh * 64; U.k_ld1 = 128; U.v1 = GV + (size_t)seq0 * 128 + kvh * 64; U.v_ld1 = 128;
        U.k0 = U.k1; U.v0 = U.v1; U.k_ld0 = 128; U.v_ld0 = 128;
        if (lat) { U.nt0 = 8; U.k0 = CGK + (size_t)((b * 4 + l) * 512) * 128 + kvh * 64; U.v0 = CGV + (size_t)((b * 4 + l) * 512) * 128 + kvh * 64; }
        U.yflag = (unsigned*)(ws + WS_CTL) + CW_YRDY + (l * 32 + (U.tok0 >> 8)) * 4;
        { unsigned* c = (unsigned*)(ws + WS_CTL);
          dep_wait(F, c + CW_RA + (l * 32 + (seq0 >> 8)) * 4, lat ? 4 : 1, 8u);
          U.zflag = c + CW_ZC + (l * 32 + (U.tok0 >> 8)) * 4; }
        __syncthreads();
        attn_unit<0>(F, p, U);
    } else if (u < 256 || (u >= 448 && u < 512)) {
        const bool lat = u < 256; const int uu = lat ? u - 192 : u - 448;
        const int b = lat ? uu / 16 : uu / 4, hh = lat ? (uu >> 2) & 3 : uu & 3, qb = lat ? (uu & 3) : 0;
        const int seq0 = lat ? 4096 + b * 1024 : b * 256;
        U.mode = 2; U.tok0 = seq0 + qb * 256; U.q = RQ + (size_t)U.tok0 * 256 + hh * 64; U.q_ld = 256; U.ycol = hh * 64;
        U.nt1 = lat ? 16 : 4; U.k1 = RK + (size_t)seq0 * 256 + hh * 64; U.k_ld1 = 256; U.v1 = RV + (size_t)seq0 * 256 + hh * 64; U.v_ld1 = 256;
        U.k0 = U.k1; U.v0 = U.v1; U.k_ld0 = 256; U.v_ld0 = 256;
        U.qpos0 = qb * 256; U.L = lat ? 1024 : 256;
        U.lf = -log1pf(__expf(-decay[hh])) * LOG2E; U.lb = -log1pf(__expf(-decay[4 + hh])) * LOG2E;
        if (lat) { const bf16_t* S0T = (const bf16_t*)(ws + WS_S0T); U.s0f = S0T + (size_t)(((b * 4 + l) * 2 + 0) * 4 + hh) * 4096; U.s0b = S0T + (size_t)(((b * 4 + l) * 2 + 1) * 4 + hh) * 4096; }
        U.yflag = (unsigned*)(ws + WS_CTL) + CW_YRDY + (l * 32 + (U.tok0 >> 8)) * 4;
        { unsigned* c = (unsigned*)(ws + WS_CTL);
          dep_wait(F, c + CW_RA + (l * 32 + (seq0 >> 8)) * 4, lat ? 4 : 1, 8u);
          U.zflag = c + CW_ZC + (l * 32 + (U.tok0 >> 8)) * 4; }
        __syncthreads();
        attn_unit<2>(F, p, U);
    } else {
        const int uu = u - 512, b = uu >> 2, hh = uu & 3, seq0 = b * 256;
        U.mode = 3; U.nt1 = 4; U.k1 = RK + (size_t)seq0 * 256 + hh * 64; U.k_ld1 = 256; U.v1 = RV + (size_t)seq0 * 256 + hh * 64; U.v_ld1 = 256;
        U.k0 = U.k1; U.v0 = U.v1; U.k_ld0 = 256; U.v_ld0 = 256;
        U.lf = -log1pf(__expf(-decay[hh])) * LOG2E; U.lb = -log1pf(__expf(-decay[4 + hh])) * LOG2E;
        U.st_out = p.out + O_STATE + (size_t)(((b * 4 + l) * 2 + 0) * 4 + hh) * 4096;
        dep_wait(F, (unsigned*)(ws + WS_CTL) + CW_RA + (l * 32 + b) * 4, 1, 8u);
        U.yflag = (unsigned*)(ws + WS_CTL) + CW_SD + (l * 16 + b) * 4;
        __syncthreads();
        attn_unit<3>(F, p, U);
    }
}
constexpr int N_ATTN_UNITS = 576;
struct TItem { const float* src; bf16_t* dst; int nsrc, K; int valid; };
constexpr int P0_TWIN = 4 * 16 * 92, P0_TWOUT = 4 * 16 * 32, P0_TWUQ = 4 * 4 * 20, P0_TWUKV = 4 * 2 * 24, P0_TR = P0_TWIN + P0_TWOUT + P0_TWUQ + P0_TWUKV;
__device__ __forceinline__ TItem p0_titem(const Frame& F, unsigned char* ws, int it) {
    TItem t; t.valid = it < P0_TR; t.src = nullptr; t.dst = nullptr; t.nsrc = 0; t.K = 0;
    if (!t.valid) return t;
    if (it < P0_TWIN) {
        const int l = it / (16 * 92), r = it % (16 * 92), kb = r / 92, nb = r % 92, n0 = nb * 32;
        const int src = n0 < 1792 ? n0 : (n0 < 2816 ? n0 + 32 : (n0 < 2848 ? n0 - 2816 + 1792 : -1));
        t.nsrc = 2848; t.K = 1024;
        if (src >= 0) t.src = pin(F, I_WIN) + (size_t)l * 1024 * 2848 + (size_t)(kb * 64) * 2848 + src;
        t.dst = (bf16_t*)(ws + WS_WIN) + ((size_t)l * 2944 + n0) * 1024 + kb * 64;
        return t;
    }
    it -= P0_TWIN;
    if (it < P0_TWOUT) {
        const int l = it / 512, r = it % 512, kb = r >> 5, nb = r & 31;
        t.nsrc = 1024; t.K = 1024; t.src = pin(F, I_WOUT) + (size_t)l * 1024 * 1024 + (size_t)(kb * 64) * 1024 + nb * 32;
        t.dst = (bf16_t*)(ws + WS_WOUT) + ((size_t)l * 1024 + nb * 32) * 1024 + kb * 64;
        return t;
    }
    it -= P0_TWOUT;
    if (it < P0_TWUQ) {
        const int l = it / 80, r = it % 80, kb = r / 20, nb = r % 20;
        t.nsrc = 576; t.K = 256; if (nb < 18) t.src = pin(F, I_WUQ) + (size_t)l * 256 * 576 + (size_t)(kb * 64) * 576 + nb * 32;
        t.dst = (bf16_t*)(ws + WS_WUQ) + ((size_t)l * 640 + nb * 32) * 256 + kb * 64;
        return t;
    }
    it -= P0_TWUQ;
    { const int l = it / 48, r = it % 48, kb = r / 24, nb = r % 24;
      t.nsrc = 768; t.K = 128; t.src = pin(F, I_WUKV) + (size_t)l * 128 * 768 + (size_t)(kb * 64) * 768 + nb * 32;
      t.dst = (bf16_t*)(ws + WS_WUKV) + ((size_t)l * 768 + nb * 32) * 128 + kb * 64; }
    return t;
}
__device__ __forceinline__ void p0_tload(const TItem& t, float (&r)[32], int lane) {
    if (t.valid && t.src) {
        const float* wp = t.src + (size_t)(lane >> 5) * t.nsrc + (lane & 31);
#pragma unroll
        for (int i = 0; i < 32; ++i) r[i] = __builtin_nontemporal_load(wp + (size_t)(2 * i) * t.nsrc);
    } else {
#pragma unroll
        for (int i = 0; i < 32; ++i) r[i] = 0.f;
    }
}
__device__ __forceinline__ void p0_tstore(const TItem& t, const float (&r)[32], LAS float* scr, int lane) {
    if (!t.valid) return;
#pragma unroll
    for (int i = 0; i < 32; ++i) scr[(2 * i + (lane >> 5)) * 33 + (lane & 31)] = r[i];
    asm volatile("s_waitcnt lgkmcnt(0)" ::: "memory");
    __builtin_amdgcn_wave_barrier();
    const int c = lane & 7;
#pragma unroll
    for (int j = 0; j < 4; ++j) {
        const int n = (lane >> 3) + 8 * j; const LAS float* s = scr + (8 * c) * 33 + n;
        u32x4 o; o.x = pk2(s[0 * 33], s[1 * 33]); o.y = pk2(s[2 * 33], s[3 * 33]); o.z = pk2(s[4 * 33], s[5 * 33]); o.w = pk2(s[6 * 33], s[7 * 33]);
        ST16_WT(t.dst + (size_t)n * t.K + 8 * c, o);
    }
    asm volatile("s_waitcnt lgkmcnt(0)" ::: "memory");
    __builtin_amdgcn_wave_barrier();
}
__device__ __forceinline__ void cast8(const float* src, bf16_t* dst, size_t e) {
    const f32x4 a = __builtin_nontemporal_load((const f32x4*)(src + e)), b = __builtin_nontemporal_load((const f32x4*)(src + e + 4));
    u32x4 o; o.x = pk2(a[0], a[1]); o.y = pk2(a[2], a[3]); o.z = pk2(b[0], b[1]); o.w = pk2(b[2], b[3]);
    ST16_WT(dst + e, o);
}
constexpr int P0_MODS = 1536, P0_CAST_G = 512, P0_CAST_KPE = 128, P0_S0T = 512;
constexpr int P0_TOTAL = P0_MODS + 3 * P0_CAST_G + P0_CAST_KPE + P0_S0T;
__device__ __forceinline__ void phase0(const Frame& F, const Params& p, bool dup = false) {
    unsigned char* ws = F.ws + (dup ? 162 * MiB : 0); const int lane = F.lane;
    LAS float* scr = (LAS float*)F.lds + F.w * (64 * 33);
    const int gw = blockIdx.x * NWAVE + F.w, ngw = gridDim.x * NWAVE;
#ifndef MK_DUP0
#define MK_DUP0_ 0
#else
#define MK_DUP0_ MK_DUP0
#endif
    if (!(dup && MK_DUP0_ == 2))
    for (int it = gw; it < P0_TR; it += 2 * ngw) {
        const TItem t0 = p0_titem(F, ws, it), t1 = p0_titem(F, ws, it + ngw);
        float r0[32], r1[32];
        p0_tload(t0, r0, lane); p0_tload(t1, r1, lane);
        p0_tstore(t0, r0, scr, lane); p0_tstore(t1, r1, scr, lane);
    }
    if (!(dup && MK_DUP0_ == 1))
    for (int it0 = (gw + ngw - 256) % ngw; it0 < P0_TOTAL; it0 += ngw) {
        int it = it0;
        if (it < P0_MODS) {
            const int l = it / 384, cg = (it % 384) >> 5, ks = it & 31;
            const int j = cg * 256 + lane * 4;
            const float* wp = pin(F, I_WADA) + ((size_t)l * 1024 + ks * 32) * 3072 + j;
            const float* c = pin(F, I_C); const float* cc = pin(F, I_CCTX);
            float sv[3];
#pragma unroll
            for (int q = 0; q < 3; ++q) {
                const int idx = q * 64 + lane, n = idx >> 5, k = idx & 31;
                float x = 0.f;
                if (idx < 160) x = (n == 0) ? cc[ks * 32 + k] : c[(n - 1) * 1024 + ks * 32 + k];
                sv[q] = silu_f(x);
            }
            f32x4 acc[5];
#pragma unroll
            for (int n = 0; n < 5; ++n) acc[n] = (f32x4){0.f, 0.f, 0.f, 0.f};
#pragma unroll 1
            for (int k0 = 0; k0 < 32; k0 += 16) {
                f32x4 wv[16];
#pragma unroll
                for (int k = 0; k < 16; ++k) wv[k] = __builtin_nontemporal_load((const f32x4*)(wp + (size_t)(k0 + k) * 3072));
                __builtin_amdgcn_sched_barrier(0);
#pragma unroll
                for (int k = 0; k < 16; ++k)
#pragma unroll
                    for (int n = 0; n < 5; ++n) {
                        const float s = __int_as_float(__builtin_amdgcn_readlane(__float_as_int(sv[n >> 1]), 32 * (n & 1) + k0 + k));
                        acc[n] += wv[k] * s;
                    }
            }
            LAS f32x4* red = (LAS f32x4*)(F.lds + 69632);
#pragma unroll
            for (int n = 0; n < 5; ++n) red[(F.w * 5 + n) * 64 + lane] = acc[n];
            __syncthreads();
            if (F.tid < 320) {
                const int n = F.tid >> 6;
                f32x4 s = red[n * 64 + lane];
#pragma unroll
                for (int ww = 1; ww < 8; ++ww) s += red[(ww * 5 + n) * 64 + lane];
                if ((ks >> 3) == 0) s += *(const f32x4*)(pin(F, I_BADA) + l * 3072 + j);
                float* mods = (float*)(ws + WS_MODS) + (size_t)(l * 5 + n) * 3072 + j;
#pragma unroll
                for (int e = 0; e < 4; ++e) atomicAdd(mods + e, s[e]);
            }
            __syncthreads();
            continue;
        }
        it -= P0_MODS;
        if (it < 3 * P0_CAST_G) {
            const int which = it / P0_CAST_G, r = it % P0_CAST_G;
            const float* src = which == 0 ? pin(F, I_CGK) : (which == 1 ? pin(F, I_CGV) : pin(F, I_CCKV));
            bf16_t* dst = (bf16_t*)(ws + (which == 0 ? WS_CGK : (which == 1 ? WS_CGV : WS_CCKV)));
#pragma unroll
            for (int q = 0; q < 4; ++q) cast8(src, dst, (size_t)r * 2048 + q * 512 + lane * 8);
            continue;
        }
        it -= 3 * P0_CAST_G;
        if (it < P0_CAST_KPE) {
#pragma unroll
            for (int q = 0; q < 4; ++q) cast8(pin(F, I_CKPE), (bf16_t*)(ws + WS_CKPE), (size_t)it * 2048 + q * 512 + lane * 8);
            continue; }
        it -= P0_CAST_KPE;
        {
            const int mat = it >> 2, qd = it & 3, dv = qd * 16 + (lane >> 2), dk0 = (lane & 3) * 16;
            const float* s = pin(F, I_STATE) + (size_t)mat * 4096 + dv;
            float x[16];
#pragma unroll
            for (int i = 0; i < 16; ++i) x[i] = __builtin_nontemporal_load(s + (dk0 + i) * 64);
            u32x4 o0, o1;
            o0.x = pk2(x[0], x[1]); o0.y = pk2(x[2], x[3]); o0.z = pk2(x[4], x[5]); o0.w = pk2(x[6], x[7]);
            o1.x = pk2(x[8], x[9]); o1.y = pk2(x[10], x[11]); o1.z = pk2(x[12], x[13]); o1.w = pk2(x[14], x[15]);
            bf16_t* d = (bf16_t*)(ws + WS_S0T) + (size_t)mat * 4096 + dv * 64 + dk0;
            ST16_WT(d, o0); ST16_WT(d + 8, o1);
        }
    }
}
constexpr int P1_GS = 80, P1_BIAS = 4 * 368, P1_X = 8192, P1_TOTAL = P1_GS + P1_BIAS + P1_X;
__device__ __forceinline__ void xg_row(const Frame& F, const float* xrow, const float* g, const float* mods_c, bf16_t* xg_row_out, float* ssq_row, bool write_xg) {
    const int lane = F.lane;
    float ss = 0.f;
#pragma unroll
    for (int j = 0; j < 2; ++j) {
        const int k = j * 512 + lane * 8;
        const f32x4 x0 = *(const f32x4*)(xrow + k), x1 = *(const f32x4*)(xrow + k + 4);
        ss += ((x0[0] * x0[0] + x0[1] * x0[1]) + (x0[2] * x0[2] + x0[3] * x0[3])) + ((x1[0] * x1[0] + x1[1] * x1[1]) + (x1[2] * x1[2] + x1[3] * x1[3]));
        if (write_xg) {
            const f32x4 g0 = *(const f32x4*)(g + k), g1 = *(const f32x4*)(g + k + 4), s0 = *(const f32x4*)(mods_c + 1024 + k), s1 = *(const f32x4*)(mods_c + 1024 + k + 4);
            u32x4 o; o.x = pk2(x0[0] * g0[0] * (1.f + s0[0]), x0[1] * g0[1] * (1.f + s0[1])); o.y = pk2(x0[2] * g0[2] * (1.f + s0[2]), x0[3] * g0[3] * (1.f + s0[3]));
            o.z = pk2(x1[0] * g1[0] * (1.f + s1[0]), x1[1] * g1[1] * (1.f + s1[1])); o.w = pk2(x1[2] * g1[2] * (1.f + s1[2]), x1[3] * g1[3] * (1.f + s1[3]));
            ST16_WT(xg_row_out + k, o);
        }
    }
    ss = wsum(ss);
    if (lane < 16) ssq_row[lane] = lane == 0 ? ss : 0.f;
}
__device__ __forceinline__ void phase1(const Frame& F, const Params& p) {
    unsigned char* ws = F.ws; const int lane = F.lane;
    unsigned* ctl = (unsigned*)(ws + WS_CTL);
    const int gw = blockIdx.x * NWAVE + F.w, ngw = gridDim.x * NWAVE;
    const float* mods = (const float*)(ws + WS_MODS);
    for (int it0 = gw; it0 < P1_GS + P1_BIAS; it0 += ngw) {
        int it = it0;
        if (it < P1_GS) {
            const int e = it * 256 + lane * 4, lc = e >> 10, k = e & 1023, l = lc / 5;
            const f32x4 g = *(const f32x4*)(pin(F, I_NORMG) + l * 1024 + k), sc = *(const f32x4*)(mods + (size_t)lc * 3072 + 1024 + k);
            { const f32x4 o = g * (sc + 1.f); ST16_WT((float*)(ws + WS_GS) + e, o); }
            continue;
        }
        it -= P1_GS;
        {
            const int l = it / 368, n0 = (it % 368) * 8;
            f32x4 sh[5][4];
#pragma unroll
            for (int c = 0; c < 5; ++c) {
                const float* shp = mods + (size_t)(l * 5 + c) * 3072 + lane * 16;
#pragma unroll
                for (int i = 0; i < 4; ++i) sh[c][i] = *(const f32x4*)(shp + 4 * i);
            }
            const bf16_t* wr0 = (const bf16_t*)(ws + WS_WIN) + ((size_t)l * 2944 + n0) * 1024 + lane * 16;
            u32x4 w0[8], w1[8];
#pragma unroll
            for (int r = 0; r < 8; ++r) { w0[r] = *(const u32x4*)(wr0 + (size_t)r * 1024); w1[r] = *(const u32x4*)(wr0 + (size_t)r * 1024 + 8); }
#pragma unroll
            for (int r = 0; r < 8; ++r) {
                float wv[16];
#pragma unroll
                for (int i = 0; i < 4; ++i) { wv[2 * i] = bflo(w0[r][i]); wv[2 * i + 1] = bfhi(w0[r][i]); wv[8 + 2 * i] = bflo(w1[r][i]); wv[8 + 2 * i + 1] = bfhi(w1[r][i]); }
#pragma unroll
                for (int c = 0; c < 5; ++c) {
                    float d = 0.f;
#pragma unroll
                    for (int i = 0; i < 4; ++i) { const f32x4 s4 = sh[c][i]; d += (s4[0] * wv[4 * i] + s4[1] * wv[4 * i + 1]) + (s4[2] * wv[4 * i + 2] + s4[3] * wv[4 * i + 3]); }
                    d = wsum(d);
                    if (lane == 0) __hip_atomic_store((__attribute__((address_space(1))) float*)((float*)(ws + WS_BIAS) + (size_t)(l * 5 + c) * 2944 + n0 + r), d, __ATOMIC_RELAXED, __HIP_MEMORY_SCOPE_AGENT);
                }
            }
            if (l == 0) {
                asm volatile("s_waitcnt vmcnt(0)" ::: "memory");
                if (lane == 0) (void)xb_add(ctl + CW_P1B0, 1u);
            }
        }
    }
    for (int vb = blockIdx.x; vb < 256; vb += gridDim.x) {
        const int tm = vb & 31, part = vb >> 5;
        const bool lat = tm >= 16;
        const int cond = lat ? 1 + ((tm - 16) >> 2) : 0;
        const float* g = pin(F, I_NORMG); const float* sc = mods + (size_t)cond * 3072 + 1024;
#pragma unroll 1
        for (int i = 0; i < 4; i += 2) {
            const int tok = tm * 256 + part * 32 + F.w * 4 + i;
            const float* xa = lat ? pin(F, I_XS) + (size_t)(tok - 4096) * 1024 : pin(F, I_XP) + (size_t)tok * 1024;
            const float* xb = xa + 1024;
            bf16_t* oa = (bf16_t*)(ws + WS_XG) + (size_t)tok * 1024;
            float ssa = 0.f, ssb = 0.f;
#pragma unroll
            for (int j = 0; j < 2; ++j) {
                const int k = j * 512 + lane * 8;
                const f32x4 a0 = *(const f32x4*)(xa + k), a1 = *(const f32x4*)(xa + k + 4), b0 = *(const f32x4*)(xb + k), b1 = *(const f32x4*)(xb + k + 4);
                const f32x4 g0 = *(const f32x4*)(g + k), g1 = *(const f32x4*)(g + k + 4), s0 = *(const f32x4*)(sc + k), s1 = *(const f32x4*)(sc + k + 4);
                const f32x4 m0 = g0 * (s0 + 1.f), m1 = g1 * (s1 + 1.f);
                ssa += ((a0[0] * a0[0] + a0[1] * a0[1]) + (a0[2] * a0[2] + a0[3] * a0[3])) + ((a1[0] * a1[0] + a1[1] * a1[1]) + (a1[2] * a1[2] + a1[3] * a1[3]));
                ssb += ((b0[0] * b0[0] + b0[1] * b0[1]) + (b0[2] * b0[2] + b0[3] * b0[3])) + ((b1[0] * b1[0] + b1[1] * b1[1]) + (b1[2] * b1[2] + b1[3] * b1[3]));
                u32x4 o; o.x = pk2(a0[0] * m0[0], a0[1] * m0[1]); o.y = pk2(a0[2] * m0[2], a0[3] * m0[3]); o.z = pk2(a1[0] * m1[0], a1[1] * m1[1]); o.w = pk2(a1[2] * m1[2], a1[3] * m1[3]);
                ST16_WT(oa + k, o);
                o.x = pk2(b0[0] * m0[0], b0[1] * m0[1]); o.y = pk2(b0[2] * m0[2], b0[3] * m0[3]); o.z = pk2(b1[0] * m1[0], b1[1] * m1[1]); o.w = pk2(b1[2] * m1[2], b1[3] * m1[3]);
                ST16_WT(oa + 1024 + k, o);
            }
            ssa = wsum(ssa); ssb = wsum(ssb);
            if (lane < 32) {
                const float v = (lane & 15) == 0 ? (lane < 16 ? ssa : ssb) : 0.f;
                __hip_atomic_store((__attribute__((address_space(1))) float*)((float*)(ws + WS_SSQ) + (size_t)(tok + (lane >> 4)) * 16 + (lane & 15)), v, __ATOMIC_RELAXED, __HIP_MEMORY_SCOPE_AGENT);
            }
        }
        asm volatile("s_waitcnt vmcnt(0)" ::: "memory");
        __syncthreads();
        if (is_t0(F)) (void)xb_add(ctl + CW_P1X + tm * 4, 1u);
    }
    asm volatile("s_waitcnt vmcnt(0)" ::: "memory");
    __syncthreads();
    if (is_t0(F)) (void)xb_add(ctl + CW_P1DONE, 1u);
}
#ifndef MK_TIMING
#define MK_TIMING -1
#endif
constexpr int CW_TIME = 2048;
__device__ __forceinline__ void phase_final(const Frame& F, const Params& p) {
    const int lane = F.lane;
    float tf = 1.f;
    if (MK_TIMING >= 0) tf = __uint_as_float(__hip_atomic_load((unsigned*)(F.ws + WS_CTL) + CW_TIME, __ATOMIC_RELAXED, __HIP_MEMORY_SCOPE_AGENT));
    unsigned* ctl = (unsigned*)(F.ws + WS_CTL);
    for (int vb = blockIdx.x; vb < 256; vb += gridDim.x) {
        const int tm = vb & 31, part = vb >> 5;
        if (F.tid == 0) {
            XB_SPIN(xb_ld(ctl + CW_XRDY + tm * 4) < 8u, ctl + CW_BAR);
            __builtin_amdgcn_fence(__ATOMIC_ACQUIRE, "agent");
            asm volatile("s_waitcnt vmcnt(0)" ::: "memory");
        }
        __syncthreads();
#pragma unroll 1
        for (int i = 0; i < 4; ++i) {
            const int tok = tm * 256 + part * 32 + F.w * 4 + i;
            float ss = 0.f;
            if (lane < 16) ss = ((const float*)(F.ws + WS_SSQ))[(size_t)tok * 16 + lane];
            ss = wsum(ss);
            const float rstd = rsqrtf(ss * (1.f / 1024.f) + EPS);
            const bf16_t* xr = (const bf16_t*)(F.ws + WS_XB) + (size_t)tok * 1024; float* orow = p.out + (size_t)tok * 1024;
#pragma unroll
            for (int j = 0; j < 4; ++j) {
                const int k = j * 256 + lane * 4;
                const u32x2 xq = *(const u32x2*)(xr + k);
                const f32x4 x = {bflo(xq.x), bfhi(xq.x), bflo(xq.y), bfhi(xq.y)}, fn = *(const f32x4*)(pin(F, I_FNORM) + k);
                { const f32x4 o = x * fn * (rstd * tf); ST16_WT(orow + k, o); }
            }
        }
    }
}

__device__ __forceinline__ GemmOp a2_op(const Frame& F, int l, int j) {
    GemmOp g;
    if (j < 160) { const int tn = j >> 5, tm = j & 31; g.W = (const bf16_t*)(F.ws + WS_WUQ) + ((size_t)l * 640 + tn * 128) * 256; g.X = (const bf16_t*)(F.ws + WS_CQG) + (size_t)tm * 256 * 256; g.ldw = 256; g.ldx = 256; g.K = 256; }
    else if (j < 352) { const int jj = j - 160, tn = jj >> 5, tm = jj & 31; g.W = (const bf16_t*)(F.ws + WS_WUKV) + ((size_t)l * 768 + tn * 128) * 128; g.X = (const bf16_t*)(F.ws + WS_CKVN) + (size_t)tm * 256 * 128; g.ldw = 128; g.ldx = 128; g.K = 128; }
    else { const int jj = j - 352, tn = jj >> 3, tc = jj & 7, b = tc >> 1, jt = tc & 1; g.W = (const bf16_t*)(F.ws + WS_WUKV) + ((size_t)l * 768 + tn * 128) * 128;
           g.X = (const bf16_t*)(F.ws + WS_CCKV) + ((size_t)(b * 4 + l) * 512 + jt * 256) * 128; g.ldw = 128; g.ldx = 128; g.K = 128; }
    return g;
}
__device__ __forceinline__ int a2_item(int vb, int i) {
    const int c = (vb >> 5) - 4, tmw = vb & 31;
    if (i == 3) return 352 + 32 + tmw;
    if (c == 0) return i * 32 + tmw;
    if (c == 1) return i < 2 ? (3 + i) * 32 + tmw : 160 + tmw;
    if (c == 2) return 160 + (1 + i) * 32 + tmw;
    return i < 2 ? 160 + (4 + i) * 32 + tmw : 352 + tmw;
}
#ifndef MK_EN
#define MK_EN 0xff
#endif
#define EN(x) ((MK_EN >> (x)) & 1)
constexpr int PH_TOTAL = 19;
__global__ void __launch_bounds__(512, 2) mega(Params p) {
    extern __shared__ __attribute__((aligned(16))) unsigned char lds_raw[];
    Frame F;
    F.lds = (LAS unsigned char*)lds_raw;
    F.tid = threadIdx.x; F.lane = F.tid & 63; F.w = __builtin_amdgcn_readfirstlane(F.tid >> 6); F.h = F.lane >> 5; F.lq = F.lane & 31;
    F.ws = p.ws;
    F.karg = (karg_t)__builtin_amdgcn_kernarg_segment_ptr();
    volatile LAS unsigned* MISC = (volatile LAS unsigned*)(F.lds + LDS_MISC);
    if (F.tid < 64) MISC[F.tid] = 0u;
    __syncthreads();
    unsigned* ctl = (unsigned*)(p.ws + WS_CTL);
    XcdBarrier bar; bar.bar = ctl + CW_BAR; bar.x = 0; bar.st = nullptr;
    const bool multi = p.ph_hi - p.ph_lo > 1;
    if (multi) bar = xcd_barrier_post(ctl + CW_BAR, MISC + 8);
    bar.w = F.w;
    const int G = gridDim.x;
    const Frame F0 = F;
    for (int ph = p.ph_lo; ph < p.ph_hi; ++ph) {
        if (ph >= 2 && ph < 18 && ((ph - 2) & 3) == 1) continue;
        Frame F = F0;
        F.lane = (int)__builtin_amdgcn_mbcnt_hi(~0u, __builtin_amdgcn_mbcnt_lo(~0u, 0u));
        asm volatile("" : "+v"(F.lane));
        F.tid = (F.w << 6) | F.lane; F.h = F.lane >> 5; F.lq = F.lane & 31;
        asm volatile("" : "+s"(F.w), "+s"(F.ws), "+s"(F.karg));
        if (MK_TIMING >= 0 && blockIdx.x == 0 && F.tid == 0) {
            const unsigned long long now = __builtin_amdgcn_s_memrealtime();
            const unsigned long long prev = ((unsigned long long)MISC[17] << 32) | MISC[16];
            if (ph > p.ph_lo) { const int q = ph - 1; const int grp = q < 2 ? q : 2 + ((q - 2) & 3); if (grp == MK_TIMING) MISC[18] += (unsigned)(now - prev); }
            MISC[16] = (unsigned)now; MISC[17] = (unsigned)(now >> 32);
        }
#ifndef MK_REPEAT
#define MK_REPEAT -1
#endif
        int nrep = 1;
        if (MK_REPEAT >= 1) { const int grp = ph < 2 ? ph : (ph == 18 ? 6 : 2 + ((ph - 2) & 3)); if (grp == MK_REPEAT) nrep = (grp == 5) ? (ph == 5 ? 5 : 1) : 2; }
        for (int rep = 0; rep < nrep; ++rep) {
        if (rep > 0) xcd_barrier(bar);
        Frame F = F0;
        F.lane = (int)__builtin_amdgcn_mbcnt_hi(~0u, __builtin_amdgcn_mbcnt_lo(~0u, 0u));
        asm volatile("" : "+v"(F.lane));
        F.tid = (F.w << 6) | F.lane; F.h = F.lane >> 5; F.lq = F.lane & 31;
        asm volatile("" : "+s"(F.w), "+s"(F.ws), "+s"(F.karg));
        if (EN(0) && ph == 0) {
#if defined(MK_DUP0)
            for (int d = 0; d < 2; ++d) { int dd = d; asm volatile("" : "+s"(dd)); if (dd) xcd_barrier(bar); phase0(F, p, dd != 0); }
#else
            phase0(F, p);
#endif
        }
        else if (EN(1) && ph == 1) phase1(F, p);
        else if (EN(2) && ph == 18) phase_final(F, p);
        else {
            const int l = (ph - 2) >> 2, sub = (ph - 2) & 3;
            int bid = blockIdx.x; asm volatile("" : "+s"(bid));
            if (EN(3) && sub == 0) {
                const bf16_t* Wt = (const bf16_t*)(F.ws + WS_WIN) + (size_t)l * 2944 * 1024;
                const bf16_t* X = (const bf16_t*)(F.ws + WS_XG);
                unsigned* flags = ctl + CW_FLAG + l * 512;
                bool first = true;
                int waited_tm = -1;
                for (int j = bid; j < 12 * 32; j += G) {
                    const int tn2 = j >> 5, tm = j & 31;
                    const int jn = j + G; const bool hn = jn < 12 * 32 && (jn & 31) == tm;
                    if (l == 0 && tm != waited_tm) {
                        waited_tm = tm;
                        if (F.tid == 0) {
                            XB_SPIN(xb_ld(ctl + CW_P1X + tm * 4) < 8u, ctl + CW_BAR);
                            XB_SPIN(xb_ld(ctl + CW_P1B0) < 368u, ctl + CW_BAR);
                            __builtin_amdgcn_fence(__ATOMIC_ACQUIRE, "agent");
                            asm volatile("s_waitcnt vmcnt(0)" ::: "memory");
                        }
                        __syncthreads();
                        first = true;
                    }
                    if (l > 0 && tm != waited_tm) {
                        waited_tm = tm;
                        if (F.w == 0) {
                            const int ln = lane_id();
                            unsigned* ptr = ctl + CW_P1DONE; unsigned tgt = (unsigned)G;
                            if (ln == 1) { ptr = ctl + CW_XGR + ((l - 1) * 32 + tm) * 4; tgt = 8u; }
                            if (ln >= 2) {
                                if (tm >= 16) { ptr = ctl + CW_YRDY + ((l - 1) * 32 + (tm & ~3) + ((ln - 2) & 3)) * 4; tgt = 16u; }
                                else { ptr = ctl + CW_SD + ((l - 1) * 16 + tm) * 4; tgt = 4u; }
                            }
                            poll_lanes(ptr, tgt, ln < (tm >= 16 ? 6 : 3), ctl + CW_BAR);
                            __builtin_amdgcn_fence(__ATOMIC_ACQUIRE, "agent");
                            asm volatile("s_waitcnt vmcnt(0)" ::: "memory");
                        }
                        __syncthreads();
                        first = true;
                    }
                    const int tn = 2 * tn2 + ((F.w & 3) >> 1), wn = F.w & 1;
                    if (tn2 == 11) {
                        GemmAcc2 accn;
                        Gemm1Pre P1;
                        const bool mine = (F.w & 3) == 0;
                        if (mine) gemm1_pre(F, p, 22, 0, tm, l, P1); else { P1.rstd[0] = P1.rstd[1] = 0.f; P1.bias = 0.f; P1.gain = 1.f; }
                        gemm_core256n(F, Wt + (size_t)tn2 * 256 * 1024, X + (size_t)tm * 256 * 1024, accn, first); first = true;
                        if (mine) epi_kpe(F, p, accn, tm, l, P1);
                    } else {
                    GemmAcc8 acc;
                    Gemm1Pre P1;
                    gemm1_pre(F, p, tn, wn, tm, l, P1);
                    gemm_core256(F, Wt + (size_t)tn2 * 256 * 1024, X + (size_t)tm * 256 * 1024, acc, first, hn, Wt + (size_t)(jn >> 5) * 256 * 1024, X + (size_t)(jn & 31) * 256 * 1024); first = false;
                    epi_gemm1(F, p, acc, tn, wn, tm, l, P1, tn2 == 6);
                    }
                    {
                        asm volatile("s_waitcnt vmcnt(0)" ::: "memory");
                        __syncthreads();
                        if (F.tid == 0) {
                            if (tn2 == 5 || tn2 == 6) (void)xb_add(flags + tm * 16, 1u);
                            if (tn2 < 8) (void)xb_add(ctl + CW_RA + (l * 32 + tm) * 4, 1u);
                            if (tn2 >= 7 && tn2 < 11) (void)xb_add(ctl + CW_ZC + (l * 32 + tm) * 4, 1u);
                            (void)xb_add(ctl + CW_FULL + (l * 32 + tm) * 4, 1u);
                        }
                    }
                }
                for (int vb = bid; vb < 256; vb += G) {
                    if (vb < 128) continue;
                    const int c = (vb >> 5) - 4, tmw = vb & 31;
                    const int nit = (c == 2 && tmw < 16) ? 4 : 3;
                    if (F.tid == 0) {
                        if (l > 0 && tmw != waited_tm) {
                            if (tmw >= 16) { unsigned* y = ctl + CW_YRDY + ((l - 1) * 32 + (tmw & ~3)) * 4; for (int i = 0; i < 4; ++i) { XB_SPIN(xb_ld(y + 4 * i) < 16u, ctl + CW_BAR); } }
                            else { XB_SPIN(xb_ld(ctl + CW_YRDY + ((l - 1) * 32 + tmw) * 4) < 16u, ctl + CW_BAR); XB_SPIN(xb_ld(ctl + CW_SD + ((l - 1) * 16 + tmw) * 4) < 4u, ctl + CW_BAR); }
                        }
                        unsigned* f = flags + tmw * 16;
                        XB_SPIN(xb_ld(f) < 2u, ctl + CW_BAR);
                        __builtin_amdgcn_fence(__ATOMIC_ACQUIRE, "agent");
                        asm volatile("s_waitcnt vmcnt(0)" ::: "memory");
                    }
                    __syncthreads();
                    for (int i = 0; i < nit; ++i) {
                        const bool hn = i + 1 < nit;
                        const int j = a2_item(vb, i), jn = a2_item(vb, hn ? i + 1 : i);
                        const GemmOp g = a2_op(F, l, j); const GemmOp gn = a2_op(F, l, jn);
                        GemmAcc acc;
                        float rstdq = 0.f;
                        if (j < 160) qm_pre(F, tmw, rstdq);
                        gemm_core(F, g, acc, i == 0, hn, gn);
                        if (j < 160) epi_qm(F, acc, j >> 5, tmw, rstdq);
                        else if (j < 352) { const int jj = j - 160; epi_plain(F, acc, (bf16_t*)(F.ws + WS_KVM), 768, tmw * 256, (jj >> 5) * 128); }
                        else {
                            const int jj = j - 352, tc = jj & 7;
                            if (l > 0) {
                                if (F.w == 0) { const int ln = lane_id(); poll_lanes(ctl + CW_YRDY + ((l - 1) * 32 + 16 + 4 * (tc >> 1) + (ln & 3)) * 4, 16u, ln < 4, ctl + CW_BAR); }
                                __syncthreads();
                            }
                            epi_plain(F, acc, (bf16_t*)(F.ws + WS_KVMC), 768, (tc >> 1) * 512 + (tc & 1) * 256, (jj >> 3) * 128);
                        }
                        asm volatile("s_waitcnt vmcnt(0)" ::: "memory");
                        __syncthreads();
                        if (F.tid == 0) {
                            if (j < 352) (void)xb_add(ctl + CW_FULL + (l * 32 + tmw) * 4, 1u);
                            else (void)xb_add(ctl + CW_KC + (l * 4 + (((j - 352) & 7) >> 1)) * 4, 1u);
                        }
                    }
                }
            } else if (EN(5) && sub == 2) {
                for (;;) {
                    __syncthreads();
                    if (F.tid == 0) MISC[0] = atomicAdd(ctl + CW_QUEUE + 64 * l + 32 * rep, 1u);
                    __syncthreads();
                    const int uq = __builtin_amdgcn_readfirstlane((int)MISC[0]);
                    if (uq >= N_ATTN_UNITS) break;
                    const int u = uq < 160 ? uq + 96 : (uq < 256 ? uq - 160 : (uq < 416 ? uq + 96 : (uq < 512 ? uq - 160 : uq)));
                    attn_dispatch(F, p, u, l);
                }
            } else if (EN(6)) {
                const bf16_t* Wt = (const bf16_t*)(F.ws + WS_WOUT) + (size_t)l * 1024 * 1024;
                const bf16_t* Yb = (const bf16_t*)(F.ws + WS_Y);
                for (int j = bid; j < 8 * 32; j += G) {
                    const int tn = j >> 5, tm = j & 31;
                    GemmOp g; g.W = Wt + (size_t)tn * 128 * 1024; g.X = Yb + (size_t)tm * 256 * 1024; g.ldw = 1024; g.ldx = 1024; g.K = 1024;
                    GemmAcc acc;
                    Gemm2Pre P2;
                    if (F.tid == 0) {
                        unsigned* f = ctl + CW_YRDY + (l * 32 + tm) * 4;
                        XB_SPIN(xb_ld(f) < 16u, ctl + CW_BAR);
                        if (l == 0) { XB_SPIN(xb_ld(ctl + CW_P1DONE) < (unsigned)G, ctl + CW_BAR); }
                        __builtin_amdgcn_fence(__ATOMIC_ACQUIRE, "agent");
                        asm volatile("s_waitcnt vmcnt(0)" ::: "memory");
                    }
                    __syncthreads();
                    gemm2_pre(F, tn, tm, l, P2);
                    gemm_core(F, g, acc, true, false, g);
                    epi_gemm2(F, p, acc, tn, tm, l, P2, l == 3);
                    {
                        asm volatile("s_waitcnt vmcnt(0)" ::: "memory");
                        __syncthreads();
                        if (F.tid == 0) (void)xb_add(l == 3 ? ctl + CW_XRDY + tm * 4 : ctl + CW_XGR + (l * 32 + tm) * 4, 1u);
                    }
                }
            }
        }
        }
        if (MK_TIMING >= 0 && ph == 17 && blockIdx.x == 0 && F.tid == 0) {
            const unsigned long long now = __builtin_amdgcn_s_memrealtime();
            const unsigned long long prev = ((unsigned long long)MISC[17] << 32) | MISC[16];
            unsigned a = MISC[18]; if (MK_TIMING == 5) a += (unsigned)(now - prev);
            __hip_atomic_store(ctl + CW_TIME, __float_as_uint(1.f + (float)a * 1e-5f), __ATOMIC_RELAXED, __HIP_MEMORY_SCOPE_AGENT);
        }
        if (ph + 1 < p.ph_hi && ph < 1) xcd_barrier(bar);
    }
}
}

extern "C" void kernel_launch(void* const* d_in, const int* in_sizes, int n_in, void* d_out, int out_size, void* d_ws, size_t ws_size, hipStream_t stream) {
    static int grid = 0;
    if (!grid) {
        int dev = 0, cus = 0, per_cu = 0;
        (void)hipGetDevice(&dev);
        (void)hipDeviceGetAttribute(&cus, hipDeviceAttributeMultiprocessorCount, dev);
        (void)hipFuncSetAttribute((const void*)mk::mega, hipFuncAttributeMaxDynamicSharedMemorySize, mk::LDS_BYTES);
        (void)hipOccupancyMaxActiveBlocksPerMultiprocessor(&per_cu, (const void*)mk::mega, 512, mk::LDS_BYTES);
        if (per_cu > 1) per_cu = 1;
        if (per_cu < 1) per_cu = 1;
        if (cus < 1) cus = 256;
        grid = cus * per_cu;
    }
    unsigned char* ws = (unsigned char*)d_ws;
    (void)hipMemsetAsync(ws, 0, mk::CTL_ZERO_BYTES, stream);
    mk::Params P{};
    for (int i = 0; i < 22; ++i) P.in[i] = (const float*)d_in[i];
    P.out = (float*)d_out; P.ws = ws; P.xs = (float*)d_out;
    P.ph_lo = 0; P.ph_hi = mk::PH_TOTAL;
    void* args[] = {&P};
    (void)hipLaunchCooperativeKernel((const void*)mk::mega, dim3(grid), dim3(512), args, mk::LDS_BYTES, stream);
}
```

```cpp
#include <hip/hip_runtime.h>
#include <stdint.h>
namespace mk {
#define LAS __attribute__((address_space(3)))
typedef unsigned short bf16_t;
typedef short bf16x8 __attribute__((ext_vector_type(8)));
typedef short s16x4 __attribute__((ext_vector_type(4)));
typedef float f32x16 __attribute__((ext_vector_type(16)));
typedef float f32x4 __attribute__((ext_vector_type(4)));
typedef float f32x2 __attribute__((ext_vector_type(2)));
typedef unsigned u32x4 __attribute__((ext_vector_type(4)));
typedef unsigned u32x2 __attribute__((ext_vector_type(2)));
typedef __bf16 bf16x2_t __attribute__((ext_vector_type(2)));

constexpr float EPS = 1e-6f;
constexpr float LOG2E = 1.4426950408889634f;
constexpr float QSC_GQA = 0.125f * LOG2E;
constexpr float QSC_MLA = 0.10206207261596575f * LOG2E;

__device__ __forceinline__ unsigned pk2(float lo, float hi) { f32x2 v = {lo, hi}; bf16x2_t b = __builtin_convertvector(v, bf16x2_t); return __builtin_bit_cast(unsigned, b); }
__device__ __forceinline__ float bf2f(unsigned short u) { return __uint_as_float((unsigned)u << 16); }
__device__ __forceinline__ float bflo(unsigned u) { return __uint_as_float(u << 16); }
__device__ __forceinline__ float bfhi(unsigned u) { return __uint_as_float(u & 0xffff0000u); }
__device__ __forceinline__ float silu_f(float x) { return x * __builtin_amdgcn_rcpf(1.f + __builtin_amdgcn_exp2f(-x * LOG2E)); }
__device__ __forceinline__ float wsum(float v) {
#pragma unroll
    for (int o = 32; o > 0; o >>= 1) v += __shfl_xor(v, o);
    return v;
}

constexpr size_t MiB = 1u << 20;
constexpr size_t WS_CTL = 0, CTL_ZERO_BYTES = 1 * MiB;
constexpr size_t WS_MODS = 256 * 1024;
constexpr size_t WS_BIAS = 1 * MiB;
constexpr size_t WS_GS = 1 * MiB + 256 * 1024;
constexpr size_t WS_ROPE64 = 1 * MiB + 512 * 1024;
constexpr size_t WS_ROPE32 = 1 * MiB + 768 * 1024;
constexpr size_t WS_SSQ = 2 * MiB;
constexpr size_t WS_CQSSQ = 2 * MiB + 512 * 1024;
constexpr size_t WS_S0T = 3 * MiB;
constexpr size_t WS_CGK = 4 * MiB, WS_CGV = 6 * MiB, WS_CCKV = 8 * MiB, WS_CKPE = 10 * MiB;
constexpr size_t WS_WIN = 11 * MiB;
constexpr size_t WS_WOUT = 34 * MiB;
constexpr size_t WS_WUQ = 42 * MiB;
constexpr size_t WS_WUKV = 43 * MiB + 256 * 1024;
constexpr size_t WS_XG = 44 * MiB;
constexpr size_t WS_KVM = 130 * MiB;
constexpr size_t WS_KVMC = 142 * MiB;
constexpr size_t WS_RQ = 60 * MiB, WS_RK = 64 * MiB, WS_RV = 68 * MiB;
constexpr size_t WS_GQ = 72 * MiB;
constexpr size_t WS_GK = 78 * MiB, WS_GV = 80 * MiB;
constexpr size_t WS_CQG = 82 * MiB;
constexpr size_t WS_CKVN = 86 * MiB;
constexpr size_t WS_KPEB = 88 * MiB;
constexpr size_t WS_ZS = 89 * MiB;
constexpr size_t WS_QM = 105 * MiB;
constexpr size_t WS_Y = 114 * MiB;
constexpr size_t WS_XSDBG = 130 * MiB;
constexpr size_t WS_XB = 146 * MiB;
constexpr size_t WS_OPT_END = 162 * MiB;
constexpr int CW_QUEUE = 1024;
constexpr int CW_FLAG = 2048;
constexpr int CW_YRDY = 1536;
constexpr int CW_XRDY = 1280;
constexpr int CW_RA = 8192;
constexpr int CW_FULL = 8704;
constexpr int CW_ZC = 9216;
constexpr int CW_KC = 9728;
constexpr int CW_XGR = 9856;
constexpr int CW_SD = 10368;
constexpr int CW_P1X = 10656;
constexpr int CW_P1B0 = 10784;
constexpr int CW_P1DONE = 10788;
constexpr int CW_BAR = 4096;

constexpr size_t O_STATE = 8388608, O_GK = 10485760, O_GV = 12582912, O_CKV = 14680064, O_KPE = 16777216;

constexpr int NWAVE = 8;
constexpr int GST = 49152;
constexpr int GST2 = 65536;
constexpr int LDS_OST = GST2;
constexpr int LDS_EX = 135168;
constexpr int LDS_EXB = 137216;
constexpr int LDS_SCAL = 141312;
constexpr int LDS_MISC = 142336;
constexpr int LDS_BYTES = 142592;

struct Params { const float* in[22]; float* out; unsigned char* ws; float* xs; int ph_lo, ph_hi; };
enum { I_XP = 0, I_XS, I_STATE, I_CGK, I_CGV, I_CCKV, I_CKPE, I_C, I_CCTX, I_NORMG, I_WADA, I_BADA, I_WIN, I_DECAY, I_GQN, I_GKN, I_MQN, I_MKVN, I_WUQ, I_WUKV, I_WOUT, I_FNORM };

#define XB_TMO      128
#define XB_XCNT(j)  (256  + 64 * (j))
#define XB_XSUB(j)  (1280 + 64 * (j))
#define XB_XGEN(j)  (2304 + 64 * (j))
#define XB_TOP      3328
#define XB_TOPGEN   3392
#define XB_SPIN_CAP (1u << 20)
__device__ __forceinline__ unsigned xb_ld(unsigned* p) { return __hip_atomic_load(p, __ATOMIC_RELAXED, __HIP_MEMORY_SCOPE_AGENT); }
__device__ __forceinline__ unsigned xb_add(unsigned* p, unsigned v) { return __hip_atomic_fetch_add(p, v, __ATOMIC_RELAXED, __HIP_MEMORY_SCOPE_AGENT); }
__device__ __forceinline__ unsigned xb_xcc_id() { return (unsigned)__builtin_amdgcn_s_getreg((3 << 11) | 20) & 0xFu; }
#define XB_SPIN(cond, bar) do { unsigned _sp = 0; while (cond) { __builtin_amdgcn_s_sleep(1); \
    if ((++_sp & 255u) == 0u) { if (xb_ld(&(bar)[XB_TMO])) break; if (_sp > XB_SPIN_CAP) { atomicAdd(&(bar)[XB_TMO], 1u); break; } } } } while (0)
__device__ __forceinline__ int lane_id() { int ln = (int)__builtin_amdgcn_mbcnt_hi(~0u, __builtin_amdgcn_mbcnt_lo(~0u, 0u)); asm volatile("" : "+v"(ln)); return ln; }
__device__ __forceinline__ void poll_lanes(unsigned* ptr, unsigned target, bool active, unsigned* bar0) {
    unsigned sp = 0u;
    for (;;) {
        unsigned v = target;
        if (active) v = xb_ld(ptr);
        if (!__any(v < target)) break;
        __builtin_amdgcn_s_sleep(1);
        if ((++sp & 255u) == 0u) { if (xb_ld(&bar0[XB_TMO])) break; if (sp > XB_SPIN_CAP) { atomicAdd(&bar0[XB_TMO], 1u); break; } }
    }
}
struct XcdBarrier { unsigned* bar; unsigned x; volatile LAS unsigned* st; int w; };
__device__ __forceinline__ XcdBarrier xcd_barrier_post(unsigned* bar, volatile LAS unsigned* st) {
    XcdBarrier b; b.bar = bar; b.x = xb_xcc_id(); b.st = st; b.w = 0;
    if (threadIdx.x == 0) (void)xb_add(&bar[XB_XCNT(b.x)], 1u);
    return b;
}
__device__ __forceinline__ void xcd_barrier_complete(unsigned* bar, unsigned x, unsigned& nloc, unsigned& nx) {
    const unsigned G = gridDim.x * gridDim.y * gridDim.z;
    unsigned sum, cnt, mine, sp = 0u;
    for (;;) {
        sum = 0u; cnt = 0u; mine = 0u;
#pragma unroll
        for (unsigned j = 0; j < 16; ++j) { const unsigned c = xb_ld(&bar[XB_XCNT(j)]); sum += c; cnt += (c > 0u) ? 1u : 0u; mine = (j == x) ? c : mine; }
        if (sum == G) break;
        __builtin_amdgcn_s_sleep(1);
        if ((++sp & 255u) == 0u) { if (xb_ld(&bar[XB_TMO])) break; if (sp > XB_SPIN_CAP) { atomicAdd(&bar[XB_TMO], 1u); break; } }
    }
    nloc = mine > 0u ? mine : 1u; nx = cnt > 0u ? cnt : 1u;
}
__device__ __forceinline__ void xcd_barrier(const XcdBarrier& b) {
    asm volatile("s_waitcnt vmcnt(0)" ::: "memory");
    __syncthreads();
    if (b.w == 0 && __builtin_amdgcn_mbcnt_hi(~0u, __builtin_amdgcn_mbcnt_lo(~0u, 0u)) == 0u) {
        unsigned* bar = b.bar;
        __builtin_amdgcn_s_waitcnt(0);
        unsigned nloc = b.st[0], nx = b.st[1];
        if (nloc == 0u) { xcd_barrier_complete(bar, b.x, nloc, nx); b.st[0] = nloc; b.st[1] = nx; }
        const unsigned old = xb_add(&bar[XB_XSUB(b.x)], 1u);
        const unsigned gen = old / nloc;
        if (old + 1u == (gen + 1u) * nloc) {
            __builtin_amdgcn_fence(__ATOMIC_RELEASE, "agent");
            asm volatile("s_waitcnt vmcnt(0)" ::: "memory");
            const unsigned og = xb_add(&bar[XB_TOP], 1u);
            const unsigned tg = og / nx;
            if (og + 1u == (tg + 1u) * nx) xb_add(&bar[XB_TOPGEN], 1u);
            else XB_SPIN(xb_ld(&bar[XB_TOPGEN]) == tg, bar);
            xb_add(&bar[XB_XGEN(b.x)], 1u);
            __builtin_amdgcn_fence(__ATOMIC_ACQUIRE, "agent");
            asm volatile("s_waitcnt vmcnt(0)" ::: "memory");
        } else {
            XB_SPIN(xb_ld(&bar[XB_XGEN(b.x)]) == gen, bar);
            __builtin_amdgcn_fence(__ATOMIC_ACQUIRE, "agent");
            asm volatile("s_waitcnt vmcnt(0)" ::: "memory");
        }
    }
    __syncthreads();
}

typedef const float* cfp_t;
typedef const __attribute__((address_space(4))) cfp_t* karg_t;
struct Frame {
    LAS unsigned char* lds;
    int tid, lane, w, h, lq;
    unsigned char* ws;
    karg_t karg;
};
__device__ __forceinline__ const float* pin(const Frame& F, int i) { return F.karg[i]; }
__device__ __forceinline__ bool is_t0(const Frame& F) { return F.w == 0 && __builtin_amdgcn_mbcnt_hi(~0u, __builtin_amdgcn_mbcnt_lo(~0u, 0u)) == 0u; }
#define GLDS16(gsrc, ldsdst) __builtin_amdgcn_global_load_lds((const unsigned*)(gsrc), (LAS unsigned*)(ldsdst), 16, 0, 0)
#define ST16_WT(ptr, val) asm volatile("global_store_dwordx4 %0, %1, off sc1\n\ts_nop 1" :: "v"(ptr), "v"(val) : "memory")
#define MFMA32(a, b, c) __builtin_amdgcn_mfma_f32_32x32x16_bf16((a), (b), (c), 0, 0, 0)

struct GemmOp { const bf16_t* W; const bf16_t* X; int ldw, ldx, K; };
__device__ __forceinline__ void gemm_issue0(const Frame& F, const GemmOp& g) {
    const int lane = F.lane, w = F.w;
#pragma unroll
    for (int q = 0; q < 2; ++q) { const int row = 16 * w + 8 * q + (lane >> 3); GLDS16(g.W + row * g.ldw + ((lane & 7) ^ ((row >> 1) & 7)) * 8, F.lds + (16 * w + 8 * q) * 128); }
#pragma unroll
    for (int q = 0; q < 4; ++q) { const int row = 32 * w + 8 * q + (lane >> 3); GLDS16(g.X + row * g.ldx + ((lane & 7) ^ ((row >> 1) & 7)) * 8, F.lds + 16384 + (32 * w + 8 * q) * 128); }
}
typedef f32x4 GemmAcc[4][4];
__device__ __forceinline__ void gemm_core(const Frame& F, const GemmOp& g, GemmAcc& acc, bool issue_first, bool has_next, const GemmOp& gn) {
    const int lane = F.lane, w = F.w;
    const bf16_t* __restrict__ W = g.W; const bf16_t* __restrict__ X = g.X;
    const int nkt = g.K >> 6;
    int offW[2], offX[4];
#pragma unroll
    for (int q = 0; q < 2; ++q) { const int row = 16 * w + 8 * q + (lane >> 3); offW[q] = row * g.ldw + ((lane & 7) ^ ((row >> 1) & 7)) * 8; }
#pragma unroll
    for (int q = 0; q < 4; ++q) { const int row = 32 * w + 8 * q + (lane >> 3); offX[q] = row * g.ldx + ((lane & 7) ^ ((row >> 1) & 7)) * 8; }
    LAS unsigned char* const dW = F.lds + (16 * w) * 128;
    LAS unsigned char* const dX = F.lds + 16384 + (32 * w) * 128;
#define GC_ISSUE(kt, st) do { _Pragma("unroll") for (int q = 0; q < 2; ++q) GLDS16(W + offW[q] + (kt) * 64, dW + (st) * GST + q * 1024); \
        _Pragma("unroll") for (int q = 0; q < 4; ++q) GLDS16(X + offX[q] + (kt) * 64, dX + (st) * GST + q * 1024); } while (0)
    const int wn = w & 1, wm = w >> 1, c15 = lane & 15, g4 = lane >> 4;
    const int sw = (c15 >> 1) & 7;
    int so[2];
#pragma unroll
    for (int s = 0; s < 2; ++s) so[s] = ((4 * s + g4) ^ sw) << 4;
    const int bn0 = (64 * wn + c15) * 128, bm0 = 16384 + (64 * wm + c15) * 128;
#pragma unroll
    for (int a = 0; a < 4; ++a)
#pragma unroll
        for (int b = 0; b < 4; ++b) acc[a][b] = (f32x4){0.f, 0.f, 0.f, 0.f};
    if (issue_first) GC_ISSUE(0, 0);
    asm volatile("s_waitcnt vmcnt(0)" ::: "memory");
    __syncthreads();
    for (int kt = 0; kt < nkt; ++kt) {
        const int st = kt & 1;
        if (kt + 1 < nkt) GC_ISSUE(kt + 1, st ^ 1);
        LAS unsigned char* const base = F.lds + st * GST;
#pragma unroll
        for (int s = 0; s < 2; ++s) {
            bf16x8 fa[4], fb[4];
#pragma unroll
            for (int q = 0; q < 4; ++q) { fa[q] = *(const LAS bf16x8*)(base + bn0 + q * 2048 + so[s]); fb[q] = *(const LAS bf16x8*)(base + bm0 + q * 2048 + so[s]); }
#pragma unroll
            for (int a = 0; a < 4; ++a)
#pragma unroll
                for (int b = 0; b < 4; ++b) acc[a][b] = __builtin_amdgcn_mfma_f32_16x16x32_bf16(fa[a], fb[b], acc[a][b], 0, 0, 0);
        }
        asm volatile("s_waitcnt vmcnt(0)" ::: "memory");
        __syncthreads();
    }
#undef GC_ISSUE
    if (has_next) gemm_issue0(F, gn);
}

typedef f32x4 GemmAcc8[4][8];
__device__ __forceinline__ void gemm256_issue0(const Frame& F, const bf16_t* W, const bf16_t* X) {
    int lane = F.lane; const int w = F.w;
    asm volatile("" : "+v"(lane));
#pragma unroll
    for (int q = 0; q < 4; ++q) {
        const int row = 32 * w + 8 * q + (lane >> 3), off = row * 1024 + ((lane & 7) ^ ((row >> 1) & 7)) * 8;
        GLDS16(W + off, F.lds + (32 * w + 8 * q) * 128);
        GLDS16(X + off, F.lds + 32768 + (32 * w + 8 * q) * 128);
    }
}
__device__ __forceinline__ void gemm_core256(const Frame& F, const bf16_t* __restrict__ W, const bf16_t* __restrict__ X, GemmAcc8& acc, bool issue_first, bool has_next, const bf16_t* Wn, const bf16_t* Xn) {
    int lane = F.lane; const int w = F.w;
    asm volatile("" : "+v"(lane));
    int off[4];
#pragma unroll
    for (int q = 0; q < 4; ++q) { const int row = 32 * w + 8 * q + (lane >> 3); off[q] = row * 1024 + ((lane & 7) ^ ((row >> 1) & 7)) * 8; }
    LAS unsigned char* const dW = F.lds + (32 * w) * 128;
    LAS unsigned char* const dX = F.lds + 32768 + (32 * w) * 128;
#define GC2_ISSUE(kt, st) do { _Pragma("unroll") for (int q = 0; q < 4; ++q) { GLDS16(W + off[q] + (kt) * 64, dW + (st) * GST2 + q * 1024); GLDS16(X + off[q] + (kt) * 64, dX + (st) * GST2 + q * 1024); } } while (0)
    const int wn4 = w & 3, wm2 = w >> 2, c15 = lane & 15, g4 = lane >> 4;
    const int sw = (c15 >> 1) & 7;
    int so[2];
#pragma unroll
    for (int s = 0; s < 2; ++s) so[s] = ((4 * s + g4) ^ sw) << 4;
    const int bn0 = (64 * wn4 + c15) * 128, bm0 = 32768 + (128 * wm2 + c15) * 128;
#pragma unroll
    for (int a = 0; a < 4; ++a)
#pragma unroll
        for (int b = 0; b < 8; ++b) acc[a][b] = (f32x4){0.f, 0.f, 0.f, 0.f};
    if (issue_first) GC2_ISSUE(0, 0);
    asm volatile("s_waitcnt vmcnt(0)" ::: "memory");
    __syncthreads();
    for (int kt = 0; kt < 16; ++kt) {
        const int st = kt & 1;
        if (kt + 1 < 16) GC2_ISSUE(kt + 1, st ^ 1);
        LAS unsigned char* const base = F.lds + st * GST2;
#pragma unroll
        for (int s = 0; s < 2; ++s) {
            bf16x8 fa[4];
#pragma unroll
            for (int q = 0; q < 4; ++q) fa[q] = *(const LAS bf16x8*)(base + bn0 + q * 2048 + so[s]);
#pragma unroll
            for (int hb = 0; hb < 2; ++hb) {
                bf16x8 fb[4];
#pragma unroll
                for (int q = 0; q < 4; ++q) fb[q] = *(const LAS bf16x8*)(base + bm0 + (4 * hb + q) * 2048 + so[s]);
#pragma unroll
                for (int a = 0; a < 4; ++a)
#pragma unroll
                    for (int b = 0; b < 4; ++b) acc[a][4 * hb + b] = __builtin_amdgcn_mfma_f32_16x16x32_bf16(fa[a], fb[b], acc[a][4 * hb + b], 0, 0, 0);
            }
        }
        asm volatile("s_waitcnt vmcnt(0)" ::: "memory");
        __syncthreads();
    }
#undef GC2_ISSUE
    if (has_next) gemm256_issue0(F, Wn, Xn);
}
typedef f32x4 GemmAcc2[2][8];
__device__ __forceinline__ void gemm_core256n(const Frame& F, const bf16_t* __restrict__ W, const bf16_t* __restrict__ X, GemmAcc2& acc, bool issue_first) {
    int lane = F.lane; const int w = F.w;
    asm volatile("" : "+v"(lane));
    int off[4];
#pragma unroll
    for (int q = 0; q < 4; ++q) { const int row = 32 * w + 8 * q + (lane >> 3); off[q] = row * 1024 + ((lane & 7) ^ ((row >> 1) & 7)) * 8; }
    LAS unsigned char* const dW = F.lds + (32 * w) * 128;
    LAS unsigned char* const dX = F.lds + 32768 + (32 * w) * 128;
#define GC2_ISSUE(kt, st) do { _Pragma("unroll") for (int q = 0; q < 4; ++q) { if (w == 0) GLDS16(W + off[q] + (kt) * 64, dW + (st) * GST2 + q * 1024); GLDS16(X + off[q] + (kt) * 64, dX + (st) * GST2 + q * 1024); } } while (0)
    const int wn4 = w & 3, wm2 = w >> 2, c15 = lane & 15, g4 = lane >> 4;
    const int sw = (c15 >> 1) & 7;
    int so[2];
#pragma unroll
    for (int s = 0; s < 2; ++s) so[s] = ((4 * s + g4) ^ sw) << 4;
    const int bn0 = (64 * wn4 + c15) * 128, bm0 = 32768 + (128 * wm2 + c15) * 128;
#pragma unroll
    for (int a = 0; a < 2; ++a)
#pragma unroll
        for (int b = 0; b < 8; ++b) acc[a][b] = (f32x4){0.f, 0.f, 0.f, 0.f};
    if (issue_first) GC2_ISSUE(0, 0);
    asm volatile("s_waitcnt vmcnt(0)" ::: "memory");
    __syncthreads();
    for (int kt = 0; kt < 16; ++kt) {
        const int st = kt & 1;
        if (kt + 1 < 16) GC2_ISSUE(kt + 1, st ^ 1);
        LAS unsigned char* const base = F.lds + st * GST2;
        if (wn4 == 0) {
#pragma unroll
        for (int s = 0; s < 2; ++s) {
            bf16x8 fa[2];
#pragma unroll
            for (int q = 0; q < 2; ++q) fa[q] = *(const LAS bf16x8*)(base + bn0 + q * 2048 + so[s]);
#pragma unroll
            for (int hb = 0; hb < 2; ++hb) {
                bf16x8 fb[4];
#pragma unroll
                for (int q = 0; q < 4; ++q) fb[q] = *(const LAS bf16x8*)(base + bm0 + (4 * hb + q) * 2048 + so[s]);
#pragma unroll
                for (int a = 0; a < 2; ++a)
#pragma unroll
                    for (int b = 0; b < 4; ++b) acc[a][4 * hb + b] = __builtin_amdgcn_mfma_f32_16x16x32_bf16(fa[a], fb[b], acc[a][4 * hb + b], 0, 0, 0);
            }
        }
        }
        asm volatile("s_waitcnt vmcnt(0)" ::: "memory");
        __syncthreads();
    }
#undef GC2_ISSUE
}

__device__ __forceinline__ void rope64_16(float (&v)[4][4], float rowp, float colp, int g4) {
#pragma unroll
    for (int i = 0; i < 4; ++i) {
        const float fr = __builtin_amdgcn_exp2f((float)(4 * g4 + i) * -0.8304820237218406f) * 0.15915494309189535f;
#pragma unroll
        for (int c = 0; c < 2; ++c) {
            const float rev = (c ? colp : rowp) * fr;
            const float sn = __builtin_amdgcn_sinf(rev), cs = __builtin_amdgcn_cosf(rev);
            const float x0 = v[2 * c][i], x1 = v[2 * c + 1][i];
            v[2 * c][i] = x0 * cs - x1 * sn;
            v[2 * c + 1][i] = x1 * cs + x0 * sn;
        }
    }
}
__device__ __forceinline__ void rope32_16(float (&a)[4], float (&b)[4], float rowp, float colp, int g4) {
    const bool hi = g4 >= 2;
#pragma unroll
    for (int i = 0; i < 4; ++i) {
        const float fr = __builtin_amdgcn_exp2f((float)(4 * (g4 & 1) + i) * -1.6609640474436813f) * 0.15915494309189535f;
        {
            const float rev = rowp * fr;
            const float sn = __builtin_amdgcn_sinf(rev), cs = __builtin_amdgcn_cosf(rev);
            const float own = a[i], oth = __shfl_xor(own, 32);
            a[i] = own * cs + oth * (hi ? sn : -sn);
        }
        {
            const float rev = colp * fr;
            const float sn = __builtin_amdgcn_sinf(rev), cs = __builtin_amdgcn_cosf(rev);
            const float own = b[i], oth = __shfl_xor(own, 32);
            b[i] = own * cs + oth * (hi ? sn : -sn);
        }
    }
}
__device__ __forceinline__ float ssq64(const float (&v)[4][4]) {
    float s = 0.f;
#pragma unroll
    for (int nt = 0; nt < 4; ++nt)
#pragma unroll
        for (int i = 0; i < 4; ++i) s += v[nt][i] * v[nt][i];
    s += __shfl_xor(s, 16);
    s += __shfl_xor(s, 32);
    return s;
}
__device__ __forceinline__ void mulvec64(float (&v)[4][4], const LAS float* gv, int g4) {
#pragma unroll
    for (int nt = 0; nt < 4; ++nt) {
        const f32x4 q = *(const LAS f32x4*)(gv + 16 * nt + 4 * g4);
#pragma unroll
        for (int i = 0; i < 4; ++i) v[nt][i] *= q[i];
    }
}
constexpr int OST_LD = 68, OST_BYTES = 32 * OST_LD * 4;
__device__ __forceinline__ void stage_write16(LAS float* st, const float (&v)[4][4], int mh, int c15, int g4) {
    asm volatile("s_waitcnt lgkmcnt(0)" ::: "memory");
    __builtin_amdgcn_wave_barrier();
#pragma unroll
    for (int nt = 0; nt < 4; ++nt) {
        f32x4 o = {v[nt][0], v[nt][1], v[nt][2], v[nt][3]};
        *(LAS f32x4*)(st + (16 * mh + c15) * OST_LD + 16 * nt + 4 * g4) = o;
    }
    asm volatile("s_waitcnt lgkmcnt(0)" ::: "memory");
    __builtin_amdgcn_wave_barrier();
}
__device__ __forceinline__ void stage_write16a(LAS float* st, const f32x4 (&a)[4][4], int mt, int c15, int g4) {
    asm volatile("s_waitcnt lgkmcnt(0)" ::: "memory");
    __builtin_amdgcn_wave_barrier();
#pragma unroll
    for (int nt = 0; nt < 4; ++nt) *(LAS f32x4*)(st + (16 * (mt & 1) + c15) * OST_LD + 16 * nt + 4 * g4) = a[nt][mt];
    asm volatile("s_waitcnt lgkmcnt(0)" ::: "memory");
    __builtin_amdgcn_wave_barrier();
}
__device__ __forceinline__ void stage_store_bf16(const LAS float* st, bf16_t* dst, int ld, float sc, int lane) {
#pragma unroll 1
    for (int it = 0; it < 4; ++it) {
        const int row = it * 8 + (lane >> 3), c8 = (lane & 7) * 8;
        const f32x4 x0 = *(const LAS f32x4*)(st + row * OST_LD + c8), x1 = *(const LAS f32x4*)(st + row * OST_LD + c8 + 4);
        u32x4 o; o.x = pk2(x0[0] * sc, x0[1] * sc); o.y = pk2(x0[2] * sc, x0[3] * sc); o.z = pk2(x1[0] * sc, x1[1] * sc); o.w = pk2(x1[2] * sc, x1[3] * sc);
        ST16_WT(dst + (size_t)row * ld + c8, o);
    }
}
__device__ __forceinline__ void stage_store_bf16_sc1(const LAS float* st, bf16_t* dst, int ld, int lane) {
#pragma unroll 1
    for (int it = 0; it < 4; ++it) {
        const int row = it * 8 + (lane >> 3), c8 = (lane & 7) * 8;
        const f32x4 x0 = *(const LAS f32x4*)(st + row * OST_LD + c8), x1 = *(const LAS f32x4*)(st + row * OST_LD + c8 + 4);
        u32x4 o; o.x = pk2(x0[0], x0[1]); o.y = pk2(x0[2], x0[3]); o.z = pk2(x1[0], x1[1]); o.w = pk2(x1[2], x1[3]);
        bf16_t* ptr = dst + (size_t)row * ld + c8;
        asm volatile("global_store_dwordx4 %0, %1, off sc1\n\ts_nop 1" :: "v"(ptr), "v"(o) : "memory");
    }
}
__device__ __forceinline__ void stage_store_f32(const LAS float* st, float* dst, int ld, int lane) {
#pragma unroll 1
    for (int it = 0; it < 8; ++it) {
        const int row = it * 4 + (lane >> 4), c = (lane & 15) * 4;
        { const f32x4 o = *(const LAS f32x4*)(st + row * OST_LD + c); ST16_WT(dst + (size_t)row * ld + c, o); }
    }
}
__device__ __forceinline__ void stage_store_bf16_32(const LAS float* st, bf16_t* dst, int ld, int lane) {
#pragma unroll 1
    for (int it = 0; it < 2; ++it) {
        const int row = it * 16 + (lane >> 2), c8 = (lane & 3) * 8;
        const f32x4 x0 = *(const LAS f32x4*)(st + row * OST_LD + c8), x1 = *(const LAS f32x4*)(st + row * OST_LD + c8 + 4);
        u32x4 o; o.x = pk2(x0[0], x0[1]); o.y = pk2(x0[2], x0[3]); o.z = pk2(x1[0], x1[1]); o.w = pk2(x1[2], x1[3]);
        ST16_WT(dst + (size_t)row * ld + c8, o);
    }
}
__device__ __forceinline__ void stage_store_f32_32(const LAS float* st, float* dst, int ld, int lane) {
#pragma unroll 1
    for (int it = 0; it < 4; ++it) {
        const int row = it * 8 + (lane >> 3), c = (lane & 7) * 4;
        { const f32x4 o = *(const LAS f32x4*)(st + row * OST_LD + c); ST16_WT(dst + (size_t)row * ld + c, o); }
    }
}

struct Gemm1Pre { float rstd[2]; float bias, gain; };
__device__ __forceinline__ void gemm1_pre(const Frame& F, const Params& p, int tn, int wn, int tm, int l, Gemm1Pre& P) {
    const float* ssqp = (const float*)(F.ws + WS_SSQ);
#pragma unroll
    for (int jj = 0; jj < 2; ++jj) {
        const int tok = tm * 256 + (F.w >> 2) * 128 + 64 * jj + F.lane;
        const f32x4* sp = (const f32x4*)(ssqp + (size_t)tok * 16);
        float ss = 0.f;
#pragma unroll
        for (int i = 0; i < 4; ++i) { const f32x4 q = sp[i]; ss += (q[0] + q[1]) + (q[2] + q[3]); }
        P.rstd[jj] = rsqrtf(ss * (1.f / 1024.f) + EPS);
    }
    const bool lat = tm >= 16;
    const int cond = lat ? 1 + ((tm - 16) >> 2) : 0;
    const int nb = tn * 128 + wn * 64;
    P.bias = (tn < 23) ? ((const float*)(F.ws + WS_BIAS))[(size_t)(l * 5 + cond) * 2944 + nb + F.lane] : 0.f;
    const float* gp = nullptr;
    if (tn >= 6 && tn < 9) gp = pin(F, I_GQN) + l * 64;
    else if (tn == 9) gp = pin(F, I_GKN) + l * 64;
    else if (tn == 11 || tn == 12) gp = pin(F, I_MQN) + l * 256 + (nb - 1408);
    else if (tn == 13) gp = pin(F, I_MKVN) + l * 128 + wn * 64;
    P.gain = gp ? gp[F.lane] : 1.f;
}
__device__ __forceinline__ void epi_gemm1(const Frame& F, const Params& p, GemmAcc8& acc, int tn, int wn, int tm, int l, const Gemm1Pre& P, bool ckv_tile) {
    int lane = F.lane; const int wm = F.w >> 2;
    asm volatile("" : "+v"(lane));
    const int c15 = lane & 15, g4 = lane >> 4;
    unsigned char* ws = F.ws;
    asm volatile("" : "+s"(ws));
    LAS float* st = (LAS float*)(F.lds + LDS_OST + F.w * OST_BYTES);
    const bool lat = tm >= 16;
    const int b = lat ? ((tm - 16) >> 2) : tm;
    const int nb = tn * 128 + wn * 64;
    LAS float* exb = (LAS float*)(F.lds + LDS_EXB) + F.w * 128;
    exb[lane] = P.bias; exb[64 + lane] = P.gain;
    asm volatile("s_waitcnt lgkmcnt(0)" ::: "memory");
    __builtin_amdgcn_wave_barrier();
    const LAS float* bias = exb;
    float* outp = p.out;
    asm volatile("" : "+s"(outp));
    float ckv_ss[8];
    if (tn < 23) {
#pragma unroll
    for (int mt = 0; mt < 8; ++mt) {
        const int mh = mt & 1;
        const int tok0 = tm * 256 + wm * 128 + (mt >> 1) * 32;
        const int tokb = tok0 + 16 * mh, tok = tokb + c15;
        const int t0 = lat ? ((tok0 - 4096) & 1023) : (tok0 & 255), t = t0 + 16 * mh + c15;
        const float rstd = __shfl(P.rstd[mt >> 2], 16 * (mt & 3) + c15);
        float v[4][4];
#pragma unroll
        for (int nt = 0; nt < 4; ++nt) {
            const f32x4 bq = *(const LAS f32x4*)(bias + 16 * nt + 4 * g4);
#pragma unroll
            for (int i = 0; i < 4; ++i) v[nt][i] = acc[nt][mt][i] * rstd + bq[i];
        }
        const float rowp = (float)(t >> 6), colp = (float)(t & 63);
        const size_t orow0 = (size_t)(b * 4 + l) * 256 + t0;
        if (tn < 2) {
            if (lat) rope64_16(v, rowp, colp, g4);
            stage_write16(st, v, mh, c15, g4);
            if (mh) stage_store_bf16(st, (bf16_t*)(ws + WS_RQ) + (size_t)tok0 * 256 + nb, 256, 1.f, lane);
        } else if (tn < 4) {
            if (lat) rope64_16(v, rowp, colp, g4);
            stage_write16(st, v, mh, c15, g4);
            if (mh) stage_store_bf16(st, (bf16_t*)(ws + WS_RK) + (size_t)tok0 * 256 + (nb - 256), 256, 0.125f, lane);
        } else if (tn < 6) {
            stage_write16(st, v, mh, c15, g4);
            if (mh) stage_store_bf16(st, (bf16_t*)(ws + WS_RV) + (size_t)tok0 * 256 + (nb - 512), 256, 1.f, lane);
        } else if (tn < 9) {
            const float r = rsqrtf(ssq64(v) * (1.f / 64.f) + EPS);
#pragma unroll
            for (int nt = 0; nt < 4; ++nt)
#pragma unroll
                for (int i = 0; i < 4; ++i) v[nt][i] *= r;
            mulvec64(v, exb + 64, g4);
            if (lat) rope64_16(v, rowp, colp, g4);
            stage_write16(st, v, mh, c15, g4);
            if (mh) stage_store_bf16(st, (bf16_t*)(ws + WS_GQ) + (size_t)tok0 * 384 + (nb - 768), 384, QSC_GQA, lane);
        } else if (tn == 9) {
            const float r = rsqrtf(ssq64(v) * (1.f / 64.f) + EPS);
#pragma unroll
            for (int nt = 0; nt < 4; ++nt)
#pragma unroll
                for (int i = 0; i < 4; ++i) v[nt][i] *= r;
            mulvec64(v, exb + 64, g4);
            if (lat) rope64_16(v, rowp, colp, g4);
            stage_write16(st, v, mh, c15, g4);
            if (mh) {
                if (!lat) stage_store_f32(st, outp + O_GK + orow0 * 128 + (nb - 1152), 128, lane);
                stage_store_bf16(st, (bf16_t*)(ws + WS_GK) + (size_t)tok0 * 128 + (nb - 1152), 128, 1.f, lane);
            }
        } else if (tn == 10) {
            stage_write16(st, v, mh, c15, g4);
            if (mh) {
                if (!lat) stage_store_f32(st, outp + O_GV + orow0 * 128 + (nb - 1280), 128, lane);
                stage_store_bf16(st, (bf16_t*)(ws + WS_GV) + (size_t)tok0 * 128 + (nb - 1280), 128, 1.f, lane);
            }
        } else if (tn < 13) {
            const float s2 = ssq64(v);
            if (g4 == 0) __hip_atomic_store((__attribute__((address_space(1))) float*)((float*)(ws + WS_CQSSQ) + (size_t)tok * 4 + ((nb - 1408) >> 6)), s2, __ATOMIC_RELAXED, __HIP_MEMORY_SCOPE_AGENT);
            mulvec64(v, exb + 64, g4);
            stage_write16(st, v, mh, c15, g4);
            if (mh) stage_store_bf16_sc1(st, (bf16_t*)(ws + WS_CQG) + (size_t)tok0 * 256 + (nb - 1408), 256, lane);
        } else if (tn == 13) {
            ckv_ss[mt] = ssq64(v);
            if (g4 == 0) ((LAS float*)(F.lds + LDS_EX))[(wm * 2 + wn) * 128 + mt * 16 + c15] = ckv_ss[mt];
        } else if (tn < 22) {
#pragma unroll
            for (int nt = 0; nt < 4; ++nt)
#pragma unroll
                for (int i = 0; i < 4; ++i) v[nt][i] = silu_f(v[nt][i]);
            stage_write16(st, v, mh, c15, g4);
            if (mh) stage_store_bf16(st, (bf16_t*)(ws + WS_ZS) + (size_t)tok0 * 1024 + (nb - 1792), 1024, 1.f, lane);
        } else {
            if (wn == 0) {
                if (lat) rope32_16(v[0], v[1], rowp, colp, g4);
                stage_write16(st, v, mh, c15, g4);
                if (mh) {
                    if (!lat) stage_store_f32_32(st, outp + O_KPE + orow0 * 32, 32, lane);
                    stage_store_bf16_32(st, (bf16_t*)(ws + WS_KPEB) + (size_t)tok0 * 32, 32, lane);
                }
            }
        }
    }
    }
    if (ckv_tile) {
        __syncthreads();
        if (tn == 13) {
#pragma unroll
        for (int mt = 0; mt < 8; ++mt) {
            const int mh = mt & 1;
            const int tok0 = tm * 256 + wm * 128 + (mt >> 1) * 32;
            const int t0 = lat ? ((tok0 - 4096) & 1023) : (tok0 & 255);
            const float rstd = __shfl(P.rstd[mt >> 2], 16 * (mt & 3) + c15);
            float v[4][4];
#pragma unroll
            for (int nt = 0; nt < 4; ++nt) {
                const f32x4 bq = *(const LAS f32x4*)(bias + 16 * nt + 4 * g4);
#pragma unroll
                for (int i = 0; i < 4; ++i) v[nt][i] = acc[nt][mt][i] * rstd + bq[i];
            }
            const float tot = ckv_ss[mt] + ((const LAS float*)(F.lds + LDS_EX))[(wm * 2 + (wn ^ 1)) * 128 + mt * 16 + c15];
            const float r = rsqrtf(tot * (1.f / 128.f) + EPS);
#pragma unroll
            for (int nt = 0; nt < 4; ++nt)
#pragma unroll
                for (int i = 0; i < 4; ++i) v[nt][i] *= r;
            mulvec64(v, exb + 64, g4);
            const size_t orow0 = (size_t)(b * 4 + l) * 256 + t0;
            stage_write16(st, v, mh, c15, g4);
            if (mh) {
                if (!lat) stage_store_f32(st, outp + O_CKV + orow0 * 128 + wn * 64, 128, lane);
                stage_store_bf16_sc1(st, (bf16_t*)(ws + WS_CKVN) + (size_t)tok0 * 128 + wn * 64, 128, lane);
            }
        }
        }
        __syncthreads();
    }
}

__device__ __forceinline__ void qm_pre(const Frame& F, int tm, float& rstd) {
    const int tok = tm * 256 + (F.w >> 1) * 64 + F.lane;
    const f32x4 q4 = *(const f32x4*)((const float*)(F.ws + WS_CQSSQ) + (size_t)tok * 4);
    rstd = rsqrtf(((q4[0] + q4[1]) + (q4[2] + q4[3])) * (1.f / 256.f) + EPS);
}
__device__ __forceinline__ void epi_qm(const Frame& F, GemmAcc& acc, int tn, int tm, float rstdl) {
    int lane = F.lane; const int wn = F.w & 1, wm = F.w >> 1;
    asm volatile("" : "+v"(lane));
    const int c15 = lane & 15, g4 = lane >> 4;
    unsigned char* ws = F.ws;
    LAS float* st = (LAS float*)(F.lds + LDS_OST + F.w * OST_BYTES);
    const bool lat = tm >= 16;
    const int nb = tn * 128 + wn * 64;
    if (nb >= 576) return;
#pragma unroll
    for (int mt = 0; mt < 4; ++mt) {
        const int mh = mt & 1;
        const int tok0 = tm * 256 + wm * 64 + (mt >> 1) * 32, tok = tok0 + 16 * mh + c15;
        const int t = lat ? ((tok - 4096) & 1023) : (tok & 255);
        const float rstd = __shfl(rstdl, 16 * mt + c15);
        const float rowp = (float)(t >> 6), colp = (float)(t & 63);
        float v[4][4];
#pragma unroll
        for (int nt = 0; nt < 4; ++nt)
#pragma unroll
            for (int i = 0; i < 4; ++i) v[nt][i] = acc[nt][mt][i] * rstd;
#pragma unroll
        for (int q = 0; q < 2; ++q) {
            const int T = (nb + 32 * q) >> 5;
            if (lat && (T % 3) == 2) rope32_16(v[2 * q], v[2 * q + 1], rowp, colp, g4);
        }
        stage_write16(st, v, mh, c15, g4);
        if (mh) stage_store_bf16(st, (bf16_t*)(ws + WS_QM) + (size_t)tok0 * 576 + nb, 576, QSC_MLA, lane);
    }
}
__device__ __forceinline__ void epi_plain(const Frame& F, GemmAcc& acc, bf16_t* D, int ldd, int row0, int n0) {
    int lane = F.lane; const int wn = F.w & 1, wm = F.w >> 1;
    asm volatile("" : "+v"(lane));
    const int c15 = lane & 15, g4 = lane >> 4;
    LAS float* st = (LAS float*)(F.lds + LDS_OST + F.w * OST_BYTES);
#pragma unroll
    for (int mt = 0; mt < 4; ++mt) {
        const int r0 = row0 + wm * 64 + (mt >> 1) * 32;
        stage_write16a(st, acc, mt, c15, g4);
        if (mt & 1) stage_store_bf16(st, D + (size_t)r0 * ldd + n0 + wn * 64, ldd, 1.f, lane);
    }
}

struct Gemm2Pre { f32x4 gt0, gt1, gs0, gs1; };
__device__ __forceinline__ void gemm2_pre(const Frame& F, int tn, int tm, int l, Gemm2Pre& P) {
    const bool lat = tm >= 16; const int cond = lat ? 1 + ((tm - 16) >> 2) : 0;
    const int nb = tn * 128 + (F.w & 1) * 64, c8 = (F.lane & 7) * 8;
    const float* gtp = (const float*)(F.ws + WS_MODS) + (size_t)(l * 5 + cond) * 3072 + 2048 + nb + c8;
    const float* gsp = (const float*)(F.ws + WS_GS) + (size_t)((l < 3 ? l + 1 : 3) * 5 + cond) * 1024 + nb + c8;
    P.gt0 = *(const f32x4*)gtp; P.gt1 = *(const f32x4*)(gtp + 4);
    P.gs0 = *(const f32x4*)gsp; P.gs1 = *(const f32x4*)(gsp + 4);
}
__device__ __forceinline__ void epi_gemm2(const Frame& F, const Params& p, GemmAcc& acc, int tn, int tm, int l, const Gemm2Pre& P, bool last) {
    int lane = F.lane; const int wn = F.w & 1, wm = F.w >> 1;
    asm volatile("" : "+v"(lane));
    const int c15 = lane & 15, g4 = lane >> 4;
    unsigned char* ws = F.ws;
    LAS float* st = (LAS float*)(F.lds + LDS_OST + F.w * OST_BYTES);
    const bool lat = tm >= 16;
    const int nb = tn * 128 + wn * 64;
    const int c8 = (lane & 7) * 8, r8 = lane >> 3;
#pragma unroll
    for (int mt = 0; mt < 2; ++mt) {
        const int tok0 = tm * 256 + wm * 64 + mt * 32;
        stage_write16a(st, acc, 2 * mt, c15, g4);
        stage_write16a(st, acc, 2 * mt + 1, c15, g4);
        bf16_t* xb0 = (bf16_t*)(ws + WS_XB) + (size_t)tok0 * 1024 + nb + c8;
        f32x4 xo8[8];
        if (l == 0) {
            const float* xold0 = lat ? pin(F, I_XS) + (size_t)(tok0 - 4096) * 1024 : pin(F, I_XP) + (size_t)tok0 * 1024;
#pragma unroll
            for (int it = 0; it < 4; ++it) {
                const float* xp = xold0 + (size_t)(it * 8 + r8) * 1024 + nb + c8;
                xo8[2 * it] = __builtin_nontemporal_load((const f32x4*)xp); xo8[2 * it + 1] = __builtin_nontemporal_load((const f32x4*)(xp + 4));
            }
        } else {
#pragma unroll
            for (int it = 0; it < 4; ++it) {
                const u32x4 q = *(const u32x4*)(xb0 + (size_t)(it * 8 + r8) * 1024);
                xo8[2 * it] = (f32x4){bflo(q.x), bfhi(q.x), bflo(q.y), bfhi(q.y)}; xo8[2 * it + 1] = (f32x4){bflo(q.z), bfhi(q.z), bflo(q.w), bfhi(q.w)};
            }
        }
#pragma unroll
        for (int it = 0; it < 4; ++it) {
            const int row = it * 8 + r8;
            const f32x4 a0 = *(const LAS f32x4*)(st + row * OST_LD + c8), a1 = *(const LAS f32x4*)(st + row * OST_LD + c8 + 4);
            const f32x4 xn0 = xo8[2 * it] + P.gt0 * a0, xn1 = xo8[2 * it + 1] + P.gt1 * a1;
            {
                u32x4 o; o.x = pk2(xn0[0], xn0[1]); o.y = pk2(xn0[2], xn0[3]); o.z = pk2(xn1[0], xn1[1]); o.w = pk2(xn1[2], xn1[3]);
                if (last) ST16_WT(xb0 + (size_t)row * 1024, o); else *(u32x4*)(xb0 + (size_t)row * 1024) = o;
            }
            float ss = ((xn0[0] * xn0[0] + xn0[1] * xn0[1]) + (xn0[2] * xn0[2] + xn0[3] * xn0[3])) + ((xn1[0] * xn1[0] + xn1[1] * xn1[1]) + (xn1[2] * xn1[2] + xn1[3] * xn1[3]));
            ss += __shfl_xor(ss, 1); ss += __shfl_xor(ss, 2); ss += __shfl_xor(ss, 4);
            if ((lane & 7) == 0) {
                float* sq = (float*)(ws + WS_SSQ) + (size_t)(tok0 + row) * 16 + tn * 2 + wn;
                __hip_atomic_store((__attribute__((address_space(1))) float*)sq, ss, __ATOMIC_RELAXED, __HIP_MEMORY_SCOPE_AGENT);
            }
            if (l < 3) {
                u32x4 o; o.x = pk2(xn0[0] * P.gs0[0], xn0[1] * P.gs0[1]); o.y = pk2(xn0[2] * P.gs0[2], xn0[3] * P.gs0[3]);
                o.z = pk2(xn1[0] * P.gs1[0], xn1[1] * P.gs1[1]); o.w = pk2(xn1[2] * P.gs1[2], xn1[3] * P.gs1[3]);
                ST16_WT((bf16_t*)(ws + WS_XG) + (size_t)(tok0 + row) * 1024 + nb + c8, o);
            }
        }
    }
}

__device__ __forceinline__ void epi_kpe(const Frame& F, const Params& p, GemmAcc2& acc, int tm, int l, const Gemm1Pre& P) {
    int lane = F.lane; const int wm = F.w >> 2;
    asm volatile("" : "+v"(lane));
    const int c15 = lane & 15, g4 = lane >> 4;
    unsigned char* ws = F.ws;
    asm volatile("" : "+s"(ws));
    float* outp = p.out;
    asm volatile("" : "+s"(outp));
    LAS float* st = (LAS float*)(F.lds + LDS_OST + F.w * OST_BYTES);
    const bool lat = tm >= 16;
    const int b = lat ? ((tm - 16) >> 2) : tm;
    LAS float* exb = (LAS float*)(F.lds + LDS_EXB) + F.w * 128;
    exb[lane] = P.bias;
    asm volatile("s_waitcnt lgkmcnt(0)" ::: "memory");
    __builtin_amdgcn_wave_barrier();
#pragma unroll
    for (int mt = 0; mt < 8; ++mt) {
        const int mh = mt & 1;
        const int tok0 = tm * 256 + wm * 128 + (mt >> 1) * 32;
        const int t0 = lat ? ((tok0 - 4096) & 1023) : (tok0 & 255), t = t0 + 16 * mh + c15;
        const float rstd = __shfl(P.rstd[mt >> 2], 16 * (mt & 3) + c15);
        float v[4][4];
#pragma unroll
        for (int nt = 0; nt < 2; ++nt) {
            const f32x4 bq = *(const LAS f32x4*)(exb + 16 * nt + 4 * g4);
#pragma unroll
            for (int i = 0; i < 4; ++i) { v[nt][i] = acc[nt][mt][i] * rstd + bq[i]; v[2 + nt][i] = 0.f; }
        }
        const float rowp = (float)(t >> 6), colp = (float)(t & 63);
        const size_t orow0 = (size_t)(b * 4 + l) * 256 + t0;
        if (lat) rope32_16(v[0], v[1], rowp, colp, g4);
        stage_write16(st, v, mh, c15, g4);
        if (mh) {
            if (!lat) stage_store_f32_32(st, outp + O_KPE + orow0 * 32, 32, lane);
            stage_store_bf16_32(st, (bf16_t*)(ws + WS_KPEB) + (size_t)tok0 * 32, 32, lane);
        }
    }
}
constexpr int AT_STG = 20480, AT_PE = 8192, AT_V = 12288, AT_OLD = 68;
struct AttnUnit {
    int mode;
    int nt0, nt1;
    const bf16_t *q; int q_ld;
    const bf16_t *k0, *k1; int k_ld0, k_ld1;
    const bf16_t *pe0, *pe1;
    const bf16_t *v0, *v1; int v_ld0, v_ld1;
    int tok0;
    int ycol;
    int qpos0, L;
    float lf, lb;
    const bf16_t *s0f, *s0b;
    unsigned* zflag;
    unsigned* yflag;
    float* st_out;
};
__device__ __forceinline__ s16x4 tr16(LAS const unsigned char* p) {
    typedef short v4i16_t __attribute__((ext_vector_type(4)));
    return __builtin_bit_cast(s16x4, __builtin_amdgcn_ds_read_tr16_b64_v4i16((LAS v4i16_t*)p));
}

template <int MODE>
__device__ __forceinline__ void attn_unit(const Frame& F, const Params& p, const AttnUnit& U) {
    constexpr int NQS = MODE == 1 ? 6 : 4;
    int lane = F.lane; const int w = F.w;
    asm volatile("" : "+v"(lane));
    const int h = lane >> 5, lq = lane & 31;
    LAS unsigned char* lds = F.lds;
    const int k_ld = U.k_ld1, v_ld = U.v_ld1;
    const int krow = 8 * w + (lane >> 3);
    const int koff = krow * k_ld + ((lane & 7) ^ ((krow >> 1) & 7)) * 8;
    const int poff = (16 * (w & 3) + (lane >> 2)) * 32 + ((lane & 3) ^ ((lane >> 4) & 3)) * 8;
    const int vdblk = w >> 2, vkg = w & 3;
    const int voff = (16 * vkg + (lane >> 2)) * v_ld + vdblk * 32 + (lane & 3) * 8;
    const int vdst = AT_V + vdblk * 4096 + vkg * 1024;
    const int nt0 = U.nt0, ntot = U.nt0 + U.nt1;
    const unsigned ldsb = (unsigned)(uintptr_t)lds;
#define AT_DMA(gsrc, ldsoff) do { unsigned _keep; const unsigned _d = (unsigned)__builtin_amdgcn_readfirstlane((int)(ldsb + (unsigned)(ldsoff))); \
        asm volatile("s_mov_b32 %0, m0\n\ts_mov_b32 m0, %2\n\ts_nop 0\n\tglobal_load_lds_dwordx4 %1, off\n\ts_mov_b32 m0, %0" : "=&s"(_keep) : "v"(gsrc), "s"(_d) : "memory"); } while (0)
#define AT_ISSUE(t, st) do { const int _t = (t); const int _b = (st) * AT_STG; \
        const bool _s0 = _t < nt0; const int _u = _s0 ? _t : _t - nt0; \
        const bf16_t* _kb = (_s0 ? U.k0 : U.k1) + (size_t)_u * 64 * k_ld; const bf16_t* _vb = (_s0 ? U.v0 : U.v1) + (size_t)_u * 64 * v_ld; \
        AT_DMA(_kb + koff, _b + (8 * w) * 128); \
        if (MODE == 1) { const bf16_t* _pb = (_s0 ? U.pe0 : U.pe1) + (size_t)_u * 64 * 32; AT_DMA(_pb + poff, _b + AT_PE + 16 * (w & 3) * 64); } \
        AT_DMA(_vb + voff, _b + vdst); } while (0)
    AT_ISSUE(0, 0);
    if (ntot > 1) AT_ISSUE(1, 1);
    bf16x8 qr[NQS];
    if (MODE == 3) {
        const int dk = 32 * (w & 1) + lq;
#pragma unroll
        for (int s = 0; s < 4; ++s)
#pragma unroll
            for (int j = 0; j < 8; ++j) qr[s][j] = (16 * s + 8 * h + j == dk) ? (short)0x3F80 : (short)0;
    } else {
        const bf16_t* qp = U.q + (size_t)(32 * w + lq) * U.q_ld + 8 * h;
#pragma unroll
        for (int s = 0; s < NQS; ++s) qr[s] = *(const bf16x8*)(qp + 16 * s);
    }
    f32x16 o[2];
#pragma unroll
    for (int d = 0; d < 2; ++d)
#pragma unroll
        for (int r = 0; r < 16; ++r) o[d][r] = 0.f;
    float m_run = 0.f, l_run = 0.f;
    f32x16 negm;
#pragma unroll
    for (int r = 0; r < 16; ++r) negm[r] = 0.f;
    const int qpos = U.qpos0 + 32 * w + lq;
    const float st_slope = ((w >> 1) & 1) ? U.lb : -U.lf, st_off = ((w >> 1) & 1) ? 0.f : 255.f * U.lf;
    const int sdir = (w >> 1) & 1;
    LAS float* scal = (LAS float*)(lds + LDS_SCAL) + w * 32;
    LAS float* ctab = (LAS float*)(lds + LDS_EXB) + w * 128;
    float a_f = 0.f, a_b = 0.f;
    if (MODE == 2) {
        ctab[lane] = __builtin_amdgcn_exp2f((float)(63 - lane) * U.lf);
        ctab[64 + lane] = __builtin_amdgcn_exp2f((float)lane * U.lb);
        a_f = __builtin_amdgcn_exp2f((float)(32 * w + lq) * U.lf);
        a_b = __builtin_amdgcn_exp2f((float)(255 - 32 * w - lq) * U.lb);
        asm volatile("s_waitcnt lgkmcnt(0)" ::: "memory");
        __builtin_amdgcn_wave_barrier();
    }
    const int kfo = lq * 128, sw = (lane >> 1) & 7, pfo = AT_PE + lq * 64, psw = (lane >> 2) & 3;
    const int vfo = AT_V + (4 * h + ((lane & 15) >> 2)) * 64 + ((lane >> 4) & 1) * 32 + (lane & 3) * 8;
    int st = 0;
    for (int t = 0; t < ntot; ++t) {
        if (t + 1 < ntot) { if (MODE == 1) asm volatile("s_waitcnt vmcnt(3)" ::: "memory"); else asm volatile("s_waitcnt vmcnt(2)" ::: "memory"); }
        else asm volatile("s_waitcnt vmcnt(0)" ::: "memory");
        __builtin_amdgcn_s_barrier();
        asm volatile("" ::: "memory");
        const int st2 = st == 0 ? 2 : st - 1;
        LAS const unsigned char* base = lds + st * AT_STG;
        bf16x8 kfa[NQS], kfb[NQS];
#pragma unroll
        for (int s = 0; s < 4; ++s) {
            const int so = ((2 * s + h) ^ sw) << 4;
            kfa[s] = *(const LAS bf16x8*)(base + kfo + so);
            kfb[s] = *(const LAS bf16x8*)(base + kfo + 4096 + so);
        }
        if (MODE == 1) {
#pragma unroll
            for (int s = 0; s < 2; ++s) {
                const int so = ((2 * s + h) ^ psw) << 4;
                kfa[4 + s] = *(const LAS bf16x8*)(base + pfo + so);
                kfb[4 + s] = *(const LAS bf16x8*)(base + pfo + 2048 + so);
            }
        }
        f32x16 p0, p1;
        if (MODE <= 1) { p0 = negm; p1 = negm; }
        else {
#pragma unroll
            for (int r = 0; r < 16; ++r) { p0[r] = 0.f; p1[r] = 0.f; }
        }
#pragma unroll
        for (int s = 0; s < NQS; ++s) { p0 = MFMA32(kfa[s], qr[s], p0); p1 = MFMA32(kfb[s], qr[s], p1); }
        s16x4 vlo[4], vhi[4];
#pragma unroll
        for (int ks = 0; ks < 4; ++ks) { vlo[ks] = tr16(base + vfo + ks * 1024); vhi[ks] = tr16(base + vfo + ks * 1024 + 512); }
        if (MODE <= 1) {
            float tm = p0[0];
#pragma unroll
            for (int r = 1; r < 16; ++r) tm = fmaxf(tm, p0[r]);
#pragma unroll
            for (int r = 0; r < 16; ++r) tm = fmaxf(tm, p1[r]);
            tm = fmaxf(tm, __shfl_xor(tm, 32));
            if (t == 0 || __any(tm > 6.0f)) {
                const float dl = t == 0 ? tm : fmaxf(tm, 0.f);
                m_run += dl;
#pragma unroll
                for (int r = 0; r < 16; ++r) { p0[r] -= dl; p1[r] -= dl; negm[r] = -m_run; }
                if (t > 0) {
                    const float alpha = __builtin_amdgcn_exp2f(-dl);
                    l_run *= alpha;
                    if (h == 0) scal[lq] = alpha;
                    asm volatile("s_waitcnt lgkmcnt(0)" ::: "memory");
#pragma unroll
                    for (int g = 0; g < 4; ++g) {
                        const f32x4 a4 = *(const LAS f32x4*)(scal + 8 * g + 4 * h);
#pragma unroll
                        for (int i = 0; i < 4; ++i) { o[0][4 * g + i] *= a4[i]; o[1][4 * g + i] *= a4[i]; }
                    }
                }
            }
            float ls = 0.f;
#pragma unroll
            for (int r = 0; r < 16; ++r) { p0[r] = __builtin_amdgcn_exp2f(p0[r]); p1[r] = __builtin_amdgcn_exp2f(p1[r]); ls += p0[r] + p1[r]; }
            l_run += ls;
        } else if (MODE == 2 && (64 * t + 63 < U.qpos0 || 64 * t > U.qpos0 + 255)) {
            const bool fwd = 64 * t + 63 < U.qpos0;
            const float A = fwd ? a_f * __builtin_amdgcn_exp2f((float)(U.qpos0 - 64 * t - 63) * U.lf) : a_b * __builtin_amdgcn_exp2f((float)(64 * t - U.qpos0 - 255) * U.lb);
            const LAS float* tb = ctab + (fwd ? 0 : 64) + 4 * h;
#pragma unroll
            for (int g = 0; g < 4; ++g) {
                const f32x4 c0 = *(const LAS f32x4*)(tb + 8 * g), c1 = *(const LAS f32x4*)(tb + 32 + 8 * g);
#pragma unroll
                for (int i = 0; i < 4; ++i) { p0[4 * g + i] *= c0[i] * A; p1[4 * g + i] *= c1[i] * A; }
            }
        } else if (MODE == 2) {
            float dq = (float)(qpos - 64 * t - 4 * h);
            asm volatile("" : "+v"(dq));
#pragma unroll
            for (int r = 0; r < 16; ++r) {
                const float d0 = dq - (float)((r & 3) + 8 * (r >> 2)), d1 = d0 - 32.f;
                const float w0 = __builtin_amdgcn_exp2f(fabsf(d0) * (d0 > 0.f ? U.lf : U.lb));
                const float w1 = __builtin_amdgcn_exp2f(fabsf(d1) * (d1 > 0.f ? U.lf : U.lb));
                p0[r] *= (d0 == 0.f ? 2.f : w0);
                p1[r] *= (d1 == 0.f ? 2.f : w1);
            }
        } else {
            float mb = (float)(64 * t + 4 * h);
            asm volatile("" : "+v"(mb));
#pragma unroll
            for (int r = 0; r < 16; ++r) {
                const float m0 = mb + (float)((r & 3) + 8 * (r >> 2)), m1 = m0 + 32.f;
                const float e0 = fmaf(m0, st_slope, st_off), e1 = fmaf(m1, st_slope, st_off);
                p0[r] *= __builtin_amdgcn_exp2f(e0);
                p1[r] *= __builtin_amdgcn_exp2f(e1);
            }
        }
        if (t + 2 < ntot) AT_ISSUE(t + 2, st2);
        bf16x8 pa[4];
        { u32x4 a;
          a.x = pk2(p0[0], p0[1]); a.y = pk2(p0[2], p0[3]); a.z = pk2(p0[4], p0[5]); a.w = pk2(p0[6], p0[7]); pa[0] = __builtin_bit_cast(bf16x8, a);
          a.x = pk2(p0[8], p0[9]); a.y = pk2(p0[10], p0[11]); a.z = pk2(p0[12], p0[13]); a.w = pk2(p0[14], p0[15]); pa[1] = __builtin_bit_cast(bf16x8, a);
          a.x = pk2(p1[0], p1[1]); a.y = pk2(p1[2], p1[3]); a.z = pk2(p1[4], p1[5]); a.w = pk2(p1[6], p1[7]); pa[2] = __builtin_bit_cast(bf16x8, a);
          a.x = pk2(p1[8], p1[9]); a.y = pk2(p1[10], p1[11]); a.z = pk2(p1[12], p1[13]); a.w = pk2(p1[14], p1[15]); pa[3] = __builtin_bit_cast(bf16x8, a); }
#pragma unroll
        for (int ks = 0; ks < 4; ++ks) {
            const bf16x8 vb = __builtin_shufflevector(vlo[ks], vhi[ks], 0, 1, 2, 3, 4, 5, 6, 7);
            o[0] = MFMA32(pa[ks], vb, o[0]);
        }
#pragma unroll
        for (int ks = 0; ks < 4; ++ks) { vlo[ks] = tr16(base + vfo + 4096 + ks * 1024); vhi[ks] = tr16(base + vfo + 4096 + ks * 1024 + 512); }
#pragma unroll
        for (int ks = 0; ks < 4; ++ks) {
            const bf16x8 vb = __builtin_shufflevector(vlo[ks], vhi[ks], 0, 1, 2, 3, 4, 5, 6, 7);
            o[1] = MFMA32(pa[ks], vb, o[1]);
        }
        st = st == 2 ? 0 : st + 1;
    }
#undef AT_ISSUE
#undef AT_DMA
    int lq2 = lq, h2 = h, lane2 = lane; asm volatile("" : "+v"(lq2), "+v"(h2), "+v"(lane2));
    if (MODE == 2 && U.s0f != nullptr) {
        const float ff = __builtin_amdgcn_exp2f((float)(qpos + 1) * U.lf), fb = __builtin_amdgcn_exp2f((float)(U.L - qpos) * U.lb);
#pragma unroll
        for (int s = 0; s < 4; ++s) {
            const u32x4 qu = __builtin_bit_cast(u32x4, qr[s]);
            u32x4 af, ab;
#pragma unroll
            for (int i = 0; i < 4; ++i) { const float lo = bflo(qu[i]), hi = bfhi(qu[i]); af[i] = pk2(lo * ff, hi * ff); ab[i] = pk2(lo * fb, hi * fb); }
#pragma unroll
            for (int d = 0; d < 2; ++d) {
                const bf16x8 sf = *(const bf16x8*)(U.s0f + (size_t)(32 * d + lq2) * 64 + 16 * s + 8 * h2);
                const bf16x8 sb = *(const bf16x8*)(U.s0b + (size_t)(32 * d + lq2) * 64 + 16 * s + 8 * h2);
                o[d] = MFMA32(__builtin_bit_cast(bf16x8, af), sf, o[d]);
                o[d] = MFMA32(__builtin_bit_cast(bf16x8, ab), sb, o[d]);
            }
        }
    }
    if (MODE == 3) {
        float* dst = U.st_out + (size_t)sdir * 4 * 4096 + (size_t)(32 * (w & 1)) * 64;
        if (w < 4) {
#pragma unroll
        for (int d = 0; d < 2; ++d)
#pragma unroll
            for (int r = 0; r < 16; ++r) dst[(size_t)((r & 3) + 8 * (r >> 2) + 4 * h2) * 64 + 32 * d + lq2] = o[d][r];
        }
        __syncthreads();
        if (F.tid == 0 && U.yflag != nullptr) (void)xb_add(U.yflag, 1u);
        return;
    }
    if (MODE <= 1) {
        l_run += __shfl_xor(l_run, 32);
        if (h2 == 0) scal[lq2] = 1.f / l_run;
    }
    if (U.zflag != nullptr && F.tid == 0) {
        unsigned* bar0 = (unsigned*)(F.ws + WS_CTL) + CW_BAR;
        XB_SPIN(xb_ld(U.zflag) < 4u, bar0);
    }
    __syncthreads();
    LAS float* ost = (LAS float*)lds + w * (32 * AT_OLD);
#pragma unroll
    for (int d = 0; d < 2; ++d)
#pragma unroll
        for (int r = 0; r < 16; ++r) ost[((r & 3) + 8 * (r >> 2) + 4 * h2) * AT_OLD + 32 * d + lq2] = o[d][r];
    asm volatile("s_waitcnt lgkmcnt(0)" ::: "memory");
    __builtin_amdgcn_wave_barrier();
    const bf16_t* zs = (const bf16_t*)(F.ws + WS_ZS);
    bf16_t* yb = (bf16_t*)(F.ws + WS_Y);
#pragma unroll
    for (int it = 0; it < 4; ++it) {
        const int row = it * 8 + (lane2 >> 3), c8 = (lane2 & 7) * 8;
        const f32x4 x0 = *(const LAS f32x4*)(ost + row * AT_OLD + c8), x1 = *(const LAS f32x4*)(ost + row * AT_OLD + c8 + 4);
        float sc;
        if (MODE <= 1) sc = scal[row];
        else {
            float ss = (x0[0] * x0[0] + x0[1] * x0[1]) + (x0[2] * x0[2] + x0[3] * x0[3]) + (x1[0] * x1[0] + x1[1] * x1[1]) + (x1[2] * x1[2] + x1[3] * x1[3]);
            ss += __shfl_xor(ss, 1); ss += __shfl_xor(ss, 2); ss += __shfl_xor(ss, 4);
            sc = rsqrtf(ss * (1.f / 64.f) + EPS);
        }
        const size_t off = (size_t)(U.tok0 + 32 * w + row) * 1024 + U.ycol + c8;
        const u32x4 z = *(const u32x4*)(zs + off);
        u32x4 y;
        y.x = pk2(x0[0] * sc * bflo(z.x), x0[1] * sc * bfhi(z.x));
        y.y = pk2(x0[2] * sc * bflo(z.y), x0[3] * sc * bfhi(z.y));
        y.z = pk2(x1[0] * sc * bflo(z.z), x1[1] * sc * bfhi(z.z));
        y.w = pk2(x1[2] * sc * bflo(z.w), x1[3] * sc * bfhi(z.w));
        ST16_WT(yb + off, y);
    }
    asm volatile("s_waitcnt vmcnt(0)" ::: "memory");
    __syncthreads();
    if (F.tid == 0) (void)xb_add(U.yflag, 1u);
}

__device__ __forceinline__ void dep_wait(const Frame& F, unsigned* c, int n, unsigned target, unsigned* c2 = nullptr, unsigned target2 = 0u) {
    if (F.w == 0) {
        const int ln = lane_id();
        unsigned* ptr = c + 4 * ln; unsigned tgt = target;
        if (c2 != nullptr && ln == n) { ptr = c2; tgt = target2; }
        poll_lanes(ptr, tgt, ln < n + (c2 != nullptr ? 1 : 0), (unsigned*)(F.ws + WS_CTL) + CW_BAR);
    }
}
__device__ __forceinline__ void attn_dispatch(const Frame& F, const Params& p, int u, int l) {
    unsigned char* ws = F.ws;
    AttnUnit U;
    U.nt0 = 0; U.nt1 = 0; U.q = nullptr; U.q_ld = 0; U.k0 = U.k1 = nullptr; U.k_ld0 = U.k_ld1 = 0; U.pe0 = U.pe1 = nullptr; U.v0 = U.v1 = nullptr; U.v_ld0 = U.v_ld1 = 0;
    U.tok0 = 0; U.ycol = 0; U.qpos0 = 0; U.L = 0; U.lf = U.lb = 0.f; U.s0f = U.s0b = nullptr; U.st_out = nullptr; U.mode = 0; U.yflag = nullptr; U.zflag = nullptr;
    const bf16_t* GQ = (const bf16_t*)(ws + WS_GQ); const bf16_t* GK = (const bf16_t*)(ws + WS_GK); const bf16_t* GV = (const bf16_t*)(ws + WS_GV);
    const bf16_t* QM = (const bf16_t*)(ws + WS_QM); const bf16_t* KVM = (const bf16_t*)(ws + WS_KVM); const bf16_t* KVMC = (const bf16_t*)(ws + WS_KVMC);
    const bf16_t* KPEB = (const bf16_t*)(ws + WS_KPEB); const bf16_t* CKPE = (const bf16_t*)(ws + WS_CKPE);
    const bf16_t* CGK = (const bf16_t*)(ws + WS_CGK); const bf16_t* CGV = (const bf16_t*)(ws + WS_CGV);
    const bf16_t* RQ = (const bf16_t*)(ws + WS_RQ); const bf16_t* RK = (const bf16_t*)(ws + WS_RK); const bf16_t* RV = (const bf16_t*)(ws + WS_RV);
    const float* decay = pin(F, I_DECAY) + l * 8;
    if (u < 96 || (u >= 256 && u < 352)) {
        const bool lat = u < 96; const int uu = lat ? u : u - 256;
        const int b = lat ? uu / 24 : uu / 6, hh = lat ? (uu >> 2) % 6 : uu % 6, qb = lat ? (uu & 3) : 0;
        const int seq0 = lat ? 4096 + b * 1024 : b * 256;
        U.mode = 1; U.tok0 = seq0 + qb * 256; U.q = QM + (size_t)U.tok0 * 576 + hh * 96; U.q_ld = 576; U.ycol = 640 + hh * 64;
        U.nt1 = lat ? 16 : 4; U.k1 = KVM + (size_t)seq0 * 768 + hh * 128; U.k_ld1 = 768; U.v1 = U.k1 + 64; U.v_ld1 = 768; U.pe1 = KPEB + (size_t)seq0 * 32;
        U.k0 = U.k1; U.v0 = U.v1; U.pe0 = U.pe1; U.k_ld0 = 768; U.v_ld0 = 768;
        if (lat) { U.nt0 = 8; U.k0 = KVMC + (size_t)(b * 512) * 768 + hh * 128; U.v0 = U.k0 + 64; U.pe0 = CKPE + (size_t)((b * 4 + l) * 512) * 32; }
        U.yflag = (unsigned*)(ws + WS_CTL) + CW_YRDY + (l * 32 + (U.tok0 >> 8)) * 4;
        { unsigned* c = (unsigned*)(ws + WS_CTL);
          dep_wait(F, c + CW_FULL + (l * 32 + (seq0 >> 8)) * 4, lat ? 4 : 1, 23u, lat ? c + CW_KC + (l * 4 + b) * 4 : nullptr, 12u); }
        __syncthreads();
        attn_unit<1>(F, p, U);
    } else if (u < 192 || (u >= 352 && u < 448)) {
        const bool lat = u < 192; const int uu = lat ? u - 96 : u - 352;
        const int b = lat ? uu / 24 : uu / 6, hh = lat ? (uu >> 2) % 6 : uu % 6, qb = lat ? (uu & 3) : 0, kvh = hh / 3;
        const int seq0 = lat ? 4096 + b * 1024 : b * 256;
        U.mode = 0; U.tok0 = seq0 + qb * 256; U.q = GQ + (size_t)U.tok0 * 384 + hh * 64; U.q_ld = 384; U.ycol = 256 + hh * 64;
        U.nt1 = lat ? 16 : 4; U.k1 = GK + (size_t)seq0 * 128 + kvh * 64; U.k_ld1 = 128; U.v1 = GV + (size_t)seq0 * 128 + kvh * 64; U.v_ld1 = 128;
        U.k0 = U.k1; U.v0 = U.v1; U.k_ld0 = 128; U.v_ld0 = 128;
        if (lat) { U.nt0 = 8; U.k0 = CGK + (size_t)((b * 4 + l) * 512) * 128 + kvh * 64; U.v0 = CGV + (size_t)((b * 4 + l) * 512) * 128 + kvh * 64; }
        U.yflag = (unsigned*)(ws + WS_CTL) + CW_YRDY + (l * 32 + (U.tok0 >> 8)) * 4;
        { unsigned* c = (unsigned*)(ws + WS_CTL);
          dep_wait(F, c + CW_RA + (l * 32 + (seq0 >> 8)) * 4, lat ? 4 : 1, 8u);
          U.zflag = c + CW_ZC + (l * 32 + (U.tok0 >> 8)) * 4; }
        __syncthreads();
        attn_unit<0>(F, p, U);
    } else if (u < 256 || (u >= 448 && u < 512)) {
        const bool lat = u < 256; const int uu = lat ? u - 192 : u - 448;
        const int b = lat ? uu / 16 : uu / 4, hh = lat ? (uu >> 2) & 3 : uu & 3, qb = lat ? (uu & 3) : 0;
        const int seq0 = lat ? 4096 + b * 1024 : b * 256;
        U.mode = 2; U.tok0 = seq0 + qb * 256; U.q = RQ + (size_t)U.tok0 * 256 + hh * 64; U.q_ld = 256; U.ycol = hh * 64;
        U.nt1 = lat ? 16 : 4; U.k1 = RK + (size_t)seq0 * 256 + hh * 64; U.k_ld1 = 256; U.v1 = RV + (size_t)seq0 * 256 + hh * 64; U.v_ld1 = 256;
        U.k0 = U.k1; U.v0 = U.v1; U.k_ld0 = 256; U.v_ld0 = 256;
        U.qpos0 = qb * 256; U.L = lat ? 1024 : 256;
        U.lf = -log1pf(__expf(-decay[hh])) * LOG2E; U.lb = -log1pf(__expf(-decay[4 + hh])) * LOG2E;
        if (lat) { const bf16_t* S0T = (const bf16_t*)(ws + WS_S0T); U.s0f = S0T + (size_t)(((b * 4 + l) * 2 + 0) * 4 + hh) * 4096; U.s0b = S0T + (size_t)(((b * 4 + l) * 2 + 1) * 4 + hh) * 4096; }
        U.yflag = (unsigned*)(ws + WS_CTL) + CW_YRDY + (l * 32 + (U.tok0 >> 8)) * 4;
        { unsigned* c = (unsigned*)(ws + WS_CTL);
          dep_wait(F, c + CW_RA + (l * 32 + (seq0 >> 8)) * 4, lat ? 4 : 1, 8u);
          U.zflag = c + CW_ZC + (l * 32 + (U.tok0 >> 8)) * 4; }
        __syncthreads();
        attn_unit<2>(F, p, U);
    } else {
        const int uu = u - 512, b = uu >> 2, hh = uu & 3, seq0 = b * 256;
        U.mode = 3; U.nt1 = 4; U.k1 = RK + (size_t)seq0 * 256 + hh * 64; U.k_ld1 = 256; U.v1 = RV + (size_t)seq0 * 256 + hh * 64; U.v_ld1 = 256;
        U.k0 = U.k1; U.v0 = U.v1; U.k_ld0 = 256; U.v_ld0 = 256;
        U.lf = -log1pf(__expf(-decay[hh])) * LOG2E; U.lb = -log1pf(__expf(-decay[4 + hh])) * LOG2E;
        U.st_out = p.out + O_STATE + (size_t)(((b * 4 + l) * 2 + 0) * 4 + hh) * 4096;
        dep_wait(F, (unsigned*)(ws + WS_CTL) + CW_RA + (l * 32 + b) * 4, 1, 8u);
        U.yflag = (unsigned*)(ws + WS_CTL) + CW_SD + (l * 16 + b) * 4;
        __syncthreads();
        attn_unit<3>(F, p, U);
    }
}
constexpr int N_ATTN_UNITS = 576;
struct TItem { const float* src; bf16_t* dst; int nsrc, K; int valid; };
constexpr int P0_TWIN = 4 * 16 * 92, P0_TWOUT = 4 * 16 * 32, P0_TWUQ = 4 * 4 * 20, P0_TWUKV = 4 * 2 * 24, P0_TR = P0_TWIN + P0_TWOUT + P0_TWUQ + P0_TWUKV;
__device__ __forceinline__ TItem p0_titem(const Frame& F, unsigned char* ws, int it) {
    TItem t; t.valid = it < P0_TR; t.src = nullptr; t.dst = nullptr; t.nsrc = 0; t.K = 0;
    if (!t.valid) return t;
    if (it < P0_TWIN) {
        const int l = it / (16 * 92), r = it % (16 * 92), kb = r / 92, nb = r % 92, n0 = nb * 32;
        const int src = n0 < 1792 ? n0 : (n0 < 2816 ? n0 + 32 : (n0 < 2848 ? n0 - 2816 + 1792 : -1));
        t.nsrc = 2848; t.K = 1024;
        if (src >= 0) t.src = pin(F, I_WIN) + (size_t)l * 1024 * 2848 + (size_t)(kb * 64) * 2848 + src;
        t.dst = (bf16_t*)(ws + WS_WIN) + ((size_t)l * 2944 + n0) * 1024 + kb * 64;
        return t;
    }
    it -= P0_TWIN;
    if (it < P0_TWOUT) {
        const int l = it / 512, r = it % 512, kb = r >> 5, nb = r & 31;
        t.nsrc = 1024; t.K = 1024; t.src = pin(F, I_WOUT) + (size_t)l * 1024 * 1024 + (size_t)(kb * 64) * 1024 + nb * 32;
        t.dst = (bf16_t*)(ws + WS_WOUT) + ((size_t)l * 1024 + nb * 32) * 1024 + kb * 64;
        return t;
    }
    it -= P0_TWOUT;
    if (it < P0_TWUQ) {
        const int l = it / 80, r = it % 80, kb = r / 20, nb = r % 20;
        t.nsrc = 576; t.K = 256; if (nb < 18) t.src = pin(F, I_WUQ) + (size_t)l * 256 * 576 + (size_t)(kb * 64) * 576 + nb * 32;
        t.dst = (bf16_t*)(ws + WS_WUQ) + ((size_t)l * 640 + nb * 32) * 256 + kb * 64;
        return t;
    }
    it -= P0_TWUQ;
    { const int l = it / 48, r = it % 48, kb = r / 24, nb = r % 24;
      t.nsrc = 768; t.K = 128; t.src = pin(F, I_WUKV) + (size_t)l * 128 * 768 + (size_t)(kb * 64) * 768 + nb * 32;
      t.dst = (bf16_t*)(ws + WS_WUKV) + ((size_t)l * 768 + nb * 32) * 128 + kb * 64; }
    return t;
}
__device__ __forceinline__ void p0_tload(const TItem& t, float (&r)[32], int lane) {
    if (t.valid && t.src) {
        const float* wp = t.src + (size_t)(lane >> 5) * t.nsrc + (lane & 31);
#pragma unroll
        for (int i = 0; i < 32; ++i) r[i] = __builtin_nontemporal_load(wp + (size_t)(2 * i) * t.nsrc);
    } else {
#pragma unroll
        for (int i = 0; i < 32; ++i) r[i] = 0.f;
    }
}
__device__ __forceinline__ void p0_tstore(const TItem& t, const float (&r)[32], LAS float* scr, int lane) {
    if (!t.valid) return;
#pragma unroll
    for (int i = 0; i < 32; ++i) scr[(2 * i + (lane >> 5)) * 33 + (lane & 31)] = r[i];
    asm volatile("s_waitcnt lgkmcnt(0)" ::: "memory");
    __builtin_amdgcn_wave_barrier();
    const int c = lane & 7;
#pragma unroll
    for (int j = 0; j < 4; ++j) {
        const int n = (lane >> 3) + 8 * j; const LAS float* s = scr + (8 * c) * 33 + n;
        u32x4 o; o.x = pk2(s[0 * 33], s[1 * 33]); o.y = pk2(s[2 * 33], s[3 * 33]); o.z = pk2(s[4 * 33], s[5 * 33]); o.w = pk2(s[6 * 33], s[7 * 33]);
        ST16_WT(t.dst + (size_t)n * t.K + 8 * c, o);
    }
    asm volatile("s_waitcnt lgkmcnt(0)" ::: "memory");
    __builtin_amdgcn_wave_barrier();
}
__device__ __forceinline__ void cast8(const float* src, bf16_t* dst, size_t e) {
    const f32x4 a = __builtin_nontemporal_load((const f32x4*)(src + e)), b = __builtin_nontemporal_load((const f32x4*)(src + e + 4));
    u32x4 o; o.x = pk2(a[0], a[1]); o.y = pk2(a[2], a[3]); o.z = pk2(b[0], b[1]); o.w = pk2(b[2], b[3]);
    ST16_WT(dst + e, o);
}
constexpr int P0_MODS = 1536, P0_CAST_G = 512, P0_CAST_KPE = 128, P0_S0T = 512;
constexpr int P0_TOTAL = P0_MODS + 3 * P0_CAST_G + P0_CAST_KPE + P0_S0T;
__device__ __forceinline__ void phase0(const Frame& F, const Params& p, bool dup = false) {
    unsigned char* ws = F.ws + (dup ? 162 * MiB : 0); const int lane = F.lane;
    LAS float* scr = (LAS float*)F.lds + F.w * (64 * 33);
    const int gw = blockIdx.x * NWAVE + F.w, ngw = gridDim.x * NWAVE;
#ifndef MK_DUP0
#define MK_DUP0_ 0
#else
#define MK_DUP0_ MK_DUP0
#endif
    if (!(dup && MK_DUP0_ == 2))
    for (int it = gw; it < P0_TR; it += 2 * ngw) {
        const TItem t0 = p0_titem(F, ws, it), t1 = p0_titem(F, ws, it + ngw);
        float r0[32], r1[32];
        p0_tload(t0, r0, lane); p0_tload(t1, r1, lane);
        p0_tstore(t0, r0, scr, lane); p0_tstore(t1, r1, scr, lane);
    }
    if (!(dup && MK_DUP0_ == 1))
    for (int it0 = (gw + ngw - 256) % ngw; it0 < P0_TOTAL; it0 += ngw) {
        int it = it0;
        if (it < P0_MODS) {
            const int l = it / 384, cg = (it % 384) >> 5, ks = it & 31;
            const int j = cg * 256 + lane * 4;
            const float* wp = pin(F, I_WADA) + ((size_t)l * 1024 + ks * 32) * 3072 + j;
            const float* c = pin(F, I_C); const float* cc = pin(F, I_CCTX);
            float sv[3];
#pragma unroll
            for (int q = 0; q < 3; ++q) {
                const int idx = q * 64 + lane, n = idx >> 5, k = idx & 31;
                float x = 0.f;
                if (idx < 160) x = (n == 0) ? cc[ks * 32 + k] : c[(n - 1) * 1024 + ks * 32 + k];
                sv[q] = silu_f(x);
            }
            f32x4 acc[5];
#pragma unroll
            for (int n = 0; n < 5; ++n) acc[n] = (f32x4){0.f, 0.f, 0.f, 0.f};
#pragma unroll 1
            for (int k0 = 0; k0 < 32; k0 += 16) {
                f32x4 wv[16];
#pragma unroll
                for (int k = 0; k < 16; ++k) wv[k] = __builtin_nontemporal_load((const f32x4*)(wp + (size_t)(k0 + k) * 3072));
                __builtin_amdgcn_sched_barrier(0);
#pragma unroll
                for (int k = 0; k < 16; ++k)
#pragma unroll
                    for (int n = 0; n < 5; ++n) {
                        const float s = __int_as_float(__builtin_amdgcn_readlane(__float_as_int(sv[n >> 1]), 32 * (n & 1) + k0 + k));
                        acc[n] += wv[k] * s;
                    }
            }
            LAS f32x4* red = (LAS f32x4*)(F.lds + 69632);
#pragma unroll
            for (int n = 0; n < 5; ++n) red[(F.w * 5 + n) * 64 + lane] = acc[n];
            __syncthreads();
            if (F.tid < 320) {
                const int n = F.tid >> 6;
                f32x4 s = red[n * 64 + lane];
#pragma unroll
                for (int ww = 1; ww < 8; ++ww) s += red[(ww * 5 + n) * 64 + lane];
                if ((ks >> 3) == 0) s += *(const f32x4*)(pin(F, I_BADA) + l * 3072 + j);
                float* mods = (float*)(ws + WS_MODS) + (size_t)(l * 5 + n) * 3072 + j;
#pragma unroll
                for (int e = 0; e < 4; ++e) atomicAdd(mods + e, s[e]);
            }
            __syncthreads();
            continue;
        }
        it -= P0_MODS;
        if (it < 3 * P0_CAST_G) {
            const int which = it / P0_CAST_G, r = it % P0_CAST_G;
            const float* src = which == 0 ? pin(F, I_CGK) : (which == 1 ? pin(F, I_CGV) : pin(F, I_CCKV));
            bf16_t* dst = (bf16_t*)(ws + (which == 0 ? WS_CGK : (which == 1 ? WS_CGV : WS_CCKV)));
#pragma unroll
            for (int q = 0; q < 4; ++q) cast8(src, dst, (size_t)r * 2048 + q * 512 + lane * 8);
            continue;
        }
        it -= 3 * P0_CAST_G;
        if (it < P0_CAST_KPE) {
#pragma unroll
            for (int q = 0; q < 4; ++q) cast8(pin(F, I_CKPE), (bf16_t*)(ws + WS_CKPE), (size_t)it * 2048 + q * 512 + lane * 8);
            continue; }
        it -= P0_CAST_KPE;
        {
            const int mat = it >> 2, qd = it & 3, dv = qd * 16 + (lane >> 2), dk0 = (lane & 3) * 16;
            const float* s = pin(F, I_STATE) + (size_t)mat * 4096 + dv;
            float x[16];
#pragma unroll
            for (int i = 0; i < 16; ++i) x[i] = __builtin_nontemporal_load(s + (dk0 + i) * 64);
            u32x4 o0, o1;
            o0.x = pk2(x[0], x[1]); o0.y = pk2(x[2], x[3]); o0.z = pk2(x[4], x[5]); o0.w = pk2(x[6], x[7]);
            o1.x = pk2(x[8], x[9]); o1.y = pk2(x[10], x[11]); o1.z = pk2(x[12], x[13]); o1.w = pk2(x[14], x[15]);
            bf16_t* d = (bf16_t*)(ws + WS_S0T) + (size_t)mat * 4096 + dv * 64 + dk0;
            ST16_WT(d, o0); ST16_WT(d + 8, o1);
        }
    }
}
constexpr int P1_GS = 80, P1_BIAS = 4 * 368, P1_X = 8192, P1_TOTAL = P1_GS + P1_BIAS + P1_X;
__device__ __forceinline__ void xg_row(const Frame& F, const float* xrow, const float* g, const float* mods_c, bf16_t* xg_row_out, float* ssq_row, bool write_xg) {
    const int lane = F.lane;
    float ss = 0.f;
#pragma unroll
    for (int j = 0; j < 2; ++j) {
        const int k = j * 512 + lane * 8;
        const f32x4 x0 = *(const f32x4*)(xrow + k), x1 = *(const f32x4*)(xrow + k + 4);
        ss += ((x0[0] * x0[0] + x0[1] * x0[1]) + (x0[2] * x0[2] + x0[3] * x0[3])) + ((x1[0] * x1[0] + x1[1] * x1[1]) + (x1[2] * x1[2] + x1[3] * x1[3]));
        if (write_xg) {
            const f32x4 g0 = *(const f32x4*)(g + k), g1 = *(const f32x4*)(g + k + 4), s0 = *(const f32x4*)(mods_c + 1024 + k), s1 = *(const f32x4*)(mods_c + 1024 + k + 4);
            u32x4 o; o.x = pk2(x0[0] * g0[0] * (1.f + s0[0]), x0[1] * g0[1] * (1.f + s0[1])); o.y = pk2(x0[2] * g0[2] * (1.f + s0[2]), x0[3] * g0[3] * (1.f + s0[3]));
            o.z = pk2(x1[0] * g1[0] * (1.f + s1[0]), x1[1] * g1[1] * (1.f + s1[1])); o.w = pk2(x1[2] * g1[2] * (1.f + s1[2]), x1[3] * g1[3] * (1.f + s1[3]));
            ST16_WT(xg_row_out + k, o);
        }
    }
    ss = wsum(ss);
    if (lane < 16) ssq_row[lane] = lane == 0 ? ss : 0.f;
}
__device__ __forceinline__ void phase1(const Frame& F, const Params& p) {
    unsigned char* ws = F.ws; const int lane = F.lane;
    unsigned* ctl = (unsigned*)(ws + WS_CTL);
    const int gw = blockIdx.x * NWAVE + F.w, ngw = gridDim.x * NWAVE;
    const float* mods = (const float*)(ws + WS_MODS);
    for (int it0 = gw; it0 < P1_GS + P1_BIAS; it0 += ngw) {
        int it = it0;
        if (it < P1_GS) {
            const int e = it * 256 + lane * 4, lc = e >> 10, k = e & 1023, l = lc / 5;
            const f32x4 g = *(const f32x4*)(pin(F, I_NORMG) + l * 1024 + k), sc = *(const f32x4*)(mods + (size_t)lc * 3072 + 1024 + k);
            { const f32x4 o = g * (sc + 1.f); ST16_WT((float*)(ws + WS_GS) + e, o); }
            continue;
        }
        it -= P1_GS;
        {
            const int l = it / 368, n0 = (it % 368) * 8;
            f32x4 sh[5][4];
#pragma unroll
            for (int c = 0; c < 5; ++c) {
                const float* shp = mods + (size_t)(l * 5 + c) * 3072 + lane * 16;
#pragma unroll
                for (int i = 0; i < 4; ++i) sh[c][i] = *(const f32x4*)(shp + 4 * i);
            }
            const bf16_t* wr0 = (const bf16_t*)(ws + WS_WIN) + ((size_t)l * 2944 + n0) * 1024 + lane * 16;
            u32x4 w0[8], w1[8];
#pragma unroll
            for (int r = 0; r < 8; ++r) { w0[r] = *(const u32x4*)(wr0 + (size_t)r * 1024); w1[r] = *(const u32x4*)(wr0 + (size_t)r * 1024 + 8); }
#pragma unroll
            for (int r = 0; r < 8; ++r) {
                float wv[16];
#pragma unroll
                for (int i = 0; i < 4; ++i) { wv[2 * i] = bflo(w0[r][i]); wv[2 * i + 1] = bfhi(w0[r][i]); wv[8 + 2 * i] = bflo(w1[r][i]); wv[8 + 2 * i + 1] = bfhi(w1[r][i]); }
#pragma unroll
                for (int c = 0; c < 5; ++c) {
                    float d = 0.f;
#pragma unroll
                    for (int i = 0; i < 4; ++i) { const f32x4 s4 = sh[c][i]; d += (s4[0] * wv[4 * i] + s4[1] * wv[4 * i + 1]) + (s4[2] * wv[4 * i + 2] + s4[3] * wv[4 * i + 3]); }
                    d = wsum(d);
                    if (lane == 0) __hip_atomic_store((__attribute__((address_space(1))) float*)((float*)(ws + WS_BIAS) + (size_t)(l * 5 + c) * 2944 + n0 + r), d, __ATOMIC_RELAXED, __HIP_MEMORY_SCOPE_AGENT);
                }
            }
            if (l == 0) {
                asm volatile("s_waitcnt vmcnt(0)" ::: "memory");
                if (lane == 0) (void)xb_add(ctl + CW_P1B0, 1u);
            }
        }
    }
    for (int vb = blockIdx.x; vb < 256; vb += gridDim.x) {
        const int tm = vb & 31, part = vb >> 5;
        const bool lat = tm >= 16;
        const int cond = lat ? 1 + ((tm - 16) >> 2) : 0;
        const float* g = pin(F, I_NORMG); const float* sc = mods + (size_t)cond * 3072 + 1024;
#pragma unroll 1
        for (int i = 0; i < 4; i += 2) {
            const int tok = tm * 256 + part * 32 + F.w * 4 + i;
            const float* xa = lat ? pin(F, I_XS) + (size_t)(tok - 4096) * 1024 : pin(F, I_XP) + (size_t)tok * 1024;
            const float* xb = xa + 1024;
            bf16_t* oa = (bf16_t*)(ws + WS_XG) + (size_t)tok * 1024;
            float ssa = 0.f, ssb = 0.f;
#pragma unroll
            for (int j = 0; j < 2; ++j) {
                const int k = j * 512 + lane * 8;
                const f32x4 a0 = *(const f32x4*)(xa + k), a1 = *(const f32x4*)(xa + k + 4), b0 = *(const f32x4*)(xb + k), b1 = *(const f32x4*)(xb + k + 4);
                const f32x4 g0 = *(const f32x4*)(g + k), g1 = *(const f32x4*)(g + k + 4), s0 = *(const f32x4*)(sc + k), s1 = *(const f32x4*)(sc + k + 4);
                const f32x4 m0 = g0 * (s0 + 1.f), m1 = g1 * (s1 + 1.f);
                ssa += ((a0[0] * a0[0] + a0[1] * a0[1]) + (a0[2] * a0[2] + a0[3] * a0[3])) + ((a1[0] * a1[0] + a1[1] * a1[1]) + (a1[2] * a1[2] + a1[3] * a1[3]));
                ssb += ((b0[0] * b0[0] + b0[1] * b0[1]) + (b0[2] * b0[2] + b0[3] * b0[3])) + ((b1[0] * b1[0] + b1[1] * b1[1]) + (b1[2] * b1[2] + b1[3] * b1[3]));
                u32x4 o; o.x = pk2(a0[0] * m0[0], a0[1] * m0[1]); o.y = pk2(a0[2] * m0[2], a0[3] * m0[3]); o.z = pk2(a1[0] * m1[0], a1[1] * m1[1]); o.w = pk2(a1[2] * m1[2], a1[3] * m1[3]);
                ST16_WT(oa + k, o);
                o.x = pk2(b0[0] * m0[0], b0[1] * m0[1]); o.y = pk2(b0[2] * m0[2], b0[3] * m0[3]); o.z = pk2(b1[0] * m1[0], b1[1] * m1[1]); o.w = pk2(b1[2] * m1[2], b1[3] * m1[3]);
                ST16_WT(oa + 1024 + k, o);
            }
            ssa = wsum(ssa); ssb = wsum(ssb);
            if (lane < 32) {
                const float v = (lane & 15) == 0 ? (lane < 16 ? ssa : ssb) : 0.f;
                __hip_atomic_store((__attribute__((address_space(1))) float*)((float*)(ws + WS_SSQ) + (size_t)(tok + (lane >> 4)) * 16 + (lane & 15)), v, __ATOMIC_RELAXED, __HIP_MEMORY_SCOPE_AGENT);
            }
        }
        asm volatile("s_waitcnt vmcnt(0)" ::: "memory");
        __syncthreads();
        if (is_t0(F)) (void)xb_add(ctl + CW_P1X + tm * 4, 1u);
    }
    asm volatile("s_waitcnt vmcnt(0)" ::: "memory");
    __syncthreads();
    if (is_t0(F)) (void)xb_add(ctl + CW_P1DONE, 1u);
}
#ifndef MK_TIMING
#define MK_TIMING -1
#endif
constexpr int CW_TIME = 2048;
__device__ __forceinline__ void phase_final(const Frame& F, const Params& p) {
    const int lane = F.lane;
    float tf = 1.f;
    if (MK_TIMING >= 0) tf = __uint_as_float(__hip_atomic_load((unsigned*)(F.ws + WS_CTL) + CW_TIME, __ATOMIC_RELAXED, __HIP_MEMORY_SCOPE_AGENT));
    unsigned* ctl = (unsigned*)(F.ws + WS_CTL);
    for (int vb = blockIdx.x; vb < 256; vb += gridDim.x) {
        const int tm = vb & 31, part = vb >> 5;
        if (F.tid == 0) {
            XB_SPIN(xb_ld(ctl + CW_XRDY + tm * 4) < 8u, ctl + CW_BAR);
            __builtin_amdgcn_fence(__ATOMIC_ACQUIRE, "agent");
            asm volatile("s_waitcnt vmcnt(0)" ::: "memory");
        }
        __syncthreads();
#pragma unroll 1
        for (int i = 0; i < 4; ++i) {
            const int tok = tm * 256 + part * 32 + F.w * 4 + i;
            float ss = 0.f;
            if (lane < 16) ss = ((const float*)(F.ws + WS_SSQ))[(size_t)tok * 16 + lane];
            ss = wsum(ss);
            const float rstd = rsqrtf(ss * (1.f / 1024.f) + EPS);
            const bf16_t* xr = (const bf16_t*)(F.ws + WS_XB) + (size_t)tok * 1024; float* orow = p.out + (size_t)tok * 1024;
#pragma unroll
            for (int j = 0; j < 4; ++j) {
                const int k = j * 256 + lane * 4;
                const u32x2 xq = *(const u32x2*)(xr + k);
                const f32x4 x = {bflo(xq.x), bfhi(xq.x), bflo(xq.y), bfhi(xq.y)}, fn = *(const f32x4*)(pin(F, I_FNORM) + k);
                { const f32x4 o = x * fn * (rstd * tf); ST16_WT(orow + k, o); }
            }
        }
    }
}

__device__ __forceinline__ GemmOp a2_op(const Frame& F, int l, int j) {
    GemmOp g;
    if (j < 160) { const int tn = j >> 5, tm = j & 31; g.W = (const bf16_t*)(F.ws + WS_WUQ) + ((size_t)l * 640 + tn * 128) * 256; g.X = (const bf16_t*)(F.ws + WS_CQG) + (size_t)tm * 256 * 256; g.ldw = 256; g.ldx = 256; g.K = 256; }
    else if (j < 352) { const int jj = j - 160, tn = jj >> 5, tm = jj & 31; g.W = (const bf16_t*)(F.ws + WS_WUKV) + ((size_t)l * 768 + tn * 128) * 128; g.X = (const bf16_t*)(F.ws + WS_CKVN) + (size_t)tm * 256 * 128; g.ldw = 128; g.ldx = 128; g.K = 128; }
    else { const int jj = j - 352, tn = jj >> 3, tc = jj & 7, b = tc >> 1, jt = tc & 1; g.W = (const bf16_t*)(F.ws + WS_WUKV) + ((size_t)l * 768 + tn * 128) * 128;
           g.X = (const bf16_t*)(F.ws + WS_CCKV) + ((size_t)(b * 4 + l) * 512 + jt * 256) * 128; g.ldw = 128; g.ldx = 128; g.K = 128; }
    return g;
}
__device__ __forceinline__ int a2_item(int vb, int i) {
    const int c = (vb >> 5) - 4, tmw = vb & 31;
    if (i == 3) return 352 + 32 + tmw;
    if (c == 0) return i * 32 + tmw;
    if (c == 1) return i < 2 ? (3 + i) * 32 + tmw : 160 + tmw;
    if (c == 2) return 160 + (1 + i) * 32 + tmw;
    return i < 2 ? 160 + (4 + i) * 32 + tmw : 352 + tmw;
}
#ifndef MK_EN
#define MK_EN 0xff
#endif
#define EN(x) ((MK_EN >> (x)) & 1)
constexpr int PH_TOTAL = 19;
__global__ void __launch_bounds__(512, 2) mega(Params p) {
    extern __shared__ __attribute__((aligned(16))) unsigned char lds_raw[];
    Frame F;
    F.lds = (LAS unsigned char*)lds_raw;
    F.tid = threadIdx.x; F.lane = F.tid & 63; F.w = __builtin_amdgcn_readfirstlane(F.tid >> 6); F.h = F.lane >> 5; F.lq = F.lane & 31;
    F.ws = p.ws;
    F.karg = (karg_t)__builtin_amdgcn_kernarg_segment_ptr();
    volatile LAS unsigned* MISC = (volatile LAS unsigned*)(F.lds + LDS_MISC);
    if (F.tid < 64) MISC[F.tid] = 0u;
    __syncthreads();
    unsigned* ctl = (unsigned*)(p.ws + WS_CTL);
    XcdBarrier bar; bar.bar = ctl + CW_BAR; bar.x = 0; bar.st = nullptr;
    const bool multi = p.ph_hi - p.ph_lo > 1;
    if (multi) bar = xcd_barrier_post(ctl + CW_BAR, MISC + 8);
    bar.w = F.w;
    const int G = gridDim.x;
    const Frame F0 = F;
    for (int ph = p.ph_lo; ph < p.ph_hi; ++ph) {
        if (ph >= 2 && ph < 18 && ((ph - 2) & 3) == 1) continue;
        Frame F = F0;
        F.lane = (int)__builtin_amdgcn_mbcnt_hi(~0u, __builtin_amdgcn_mbcnt_lo(~0u, 0u));
        asm volatile("" : "+v"(F.lane));
        F.tid = (F.w << 6) | F.lane; F.h = F.lane >> 5; F.lq = F.lane & 31;
        asm volatile("" : "+s"(F.w), "+s"(F.ws), "+s"(F.karg));
        if (MK_TIMING >= 0 && blockIdx.x == 0 && F.tid == 0) {
            const unsigned long long now = __builtin_amdgcn_s_memrealtime();
            const unsigned long long prev = ((unsigned long long)MISC[17] << 32) | MISC[16];
            if (ph > p.ph_lo) { const int q = ph - 1; const int grp = q < 2 ? q : 2 + ((q - 2) & 3); if (grp == MK_TIMING) MISC[18] += (unsigned)(now - prev); }
            MISC[16] = (unsigned)now; MISC[17] = (unsigned)(now >> 32);
        }
#ifndef MK_REPEAT
#define MK_REPEAT -1
#endif
        int nrep = 1;
        if (MK_REPEAT >= 1) { const int grp = ph < 2 ? ph : (ph == 18 ? 6 : 2 + ((ph - 2) & 3)); if (grp == MK_REPEAT) nrep = (grp == 5) ? (ph == 5 ? 5 : 1) : 2; }
        for (int rep = 0; rep < nrep; ++rep) {
        if (rep > 0) xcd_barrier(bar);
        Frame F = F0;
        F.lane = (int)__builtin_amdgcn_mbcnt_hi(~0u, __builtin_amdgcn_mbcnt_lo(~0u, 0u));
        asm volatile("" : "+v"(F.lane));
        F.tid = (F.w << 6) | F.lane; F.h = F.lane >> 5; F.lq = F.lane & 31;
        asm volatile("" : "+s"(F.w), "+s"(F.ws), "+s"(F.karg));
        if (EN(0) && ph == 0) {
#if defined(MK_DUP0)
            for (int d = 0; d < 2; ++d) { int dd = d; asm volatile("" : "+s"(dd)); if (dd) xcd_barrier(bar); phase0(F, p, dd != 0); }
#else
            phase0(F, p);
#endif
        }
        else if (EN(1) && ph == 1) phase1(F, p);
        else if (EN(2) && ph == 18) phase_final(F, p);
        else {
            const int l = (ph - 2) >> 2, sub = (ph - 2) & 3;
            int bid = blockIdx.x; asm volatile("" : "+s"(bid));
            if (EN(3) && sub == 0) {
                const bf16_t* Wt = (const bf16_t*)(F.ws + WS_WIN) + (size_t)l * 2944 * 1024;
                const bf16_t* X = (const bf16_t*)(F.ws + WS_XG);
                unsigned* flags = ctl + CW_FLAG + l * 512;
                bool first = true;
                int waited_tm = -1;
                for (int j = bid; j < 12 * 32; j += G) {
                    const int tn2 = j >> 5, tm = j & 31;
                    const int jn = j + G; const bool hn = jn < 12 * 32 && (jn & 31) == tm;
                    if (l == 0 && tm != waited_tm) {
                        waited_tm = tm;
                        if (F.tid == 0) {
                            XB_SPIN(xb_ld(ctl + CW_P1X + tm * 4) < 8u, ctl + CW_BAR);
                            XB_SPIN(xb_ld(ctl + CW_P1B0) < 368u, ctl + CW_BAR);
                            __builtin_amdgcn_fence(__ATOMIC_ACQUIRE, "agent");
                            asm volatile("s_waitcnt vmcnt(0)" ::: "memory");
                        }
                        __syncthreads();
                        first = true;
                    }
                    if (l > 0 && tm != waited_tm) {
                        waited_tm = tm;
                        if (F.w == 0) {
                            const int ln = lane_id();
                            unsigned* ptr = ctl + CW_P1DONE; unsigned tgt = (unsigned)G;
                            if (ln == 1) { ptr = ctl + CW_XGR + ((l - 1) * 32 + tm) * 4; tgt = 8u; }
                            if (ln >= 2) {
                                if (tm >= 16) { ptr = ctl + CW_YRDY + ((l - 1) * 32 + (tm & ~3) + ((ln - 2) & 3)) * 4; tgt = 16u; }
                                else { ptr = ctl + CW_SD + ((l - 1) * 16 + tm) * 4; tgt = 4u; }
                            }
                            poll_lanes(ptr, tgt, ln < (tm >= 16 ? 6 : 3), ctl + CW_BAR);
                            __builtin_amdgcn_fence(__ATOMIC_ACQUIRE, "agent");
                            asm volatile("s_waitcnt vmcnt(0)" ::: "memory");
                        }
                        __syncthreads();
                        first = true;
                    }
                    const int tn = 2 * tn2 + ((F.w & 3) >> 1), wn = F.w & 1;
                    if (tn2 == 11) {
                        GemmAcc2 accn;
                        Gemm1Pre P1;
                        const bool mine = (F.w & 3) == 0;
                        if (mine) gemm1_pre(F, p, 22, 0, tm, l, P1); else { P1.rstd[0] = P1.rstd[1] = 0.f; P1.bias = 0.f; P1.gain = 1.f; }
                        gemm_core256n(F, Wt + (size_t)tn2 * 256 * 1024, X + (size_t)tm * 256 * 1024, accn, first); first = true;
                        if (mine) epi_kpe(F, p, accn, tm, l, P1);
                    } else {
                    GemmAcc8 acc;
                    Gemm1Pre P1;
                    gemm1_pre(F, p, tn, wn, tm, l, P1);
                    gemm_core256(F, Wt + (size_t)tn2 * 256 * 1024, X + (size_t)tm * 256 * 1024, acc, first, hn, Wt + (size_t)(jn >> 5) * 256 * 1024, X + (size_t)(jn & 31) * 256 * 1024); first = false;
                    epi_gemm1(F, p, acc, tn, wn, tm, l, P1, tn2 == 6);
                    }
                    {
                        asm volatile("s_waitcnt vmcnt(0)" ::: "memory");
                        __syncthreads();
                        if (F.tid == 0) {
                            if (tn2 == 5 || tn2 == 6) (void)xb_add(flags + tm * 16, 1u);
                            if (tn2 < 8) (void)xb_add(ctl + CW_RA + (l * 32 + tm) * 4, 1u);
                            if (tn2 >= 7 && tn2 < 11) (void)xb_add(ctl + CW_ZC + (l * 32 + tm) * 4, 1u);
                            (void)xb_add(ctl + CW_FULL + (l * 32 + tm) * 4, 1u);
                        }
                    }
                }
                for (int vb = bid; vb < 256; vb += G) {
                    if (vb < 128) continue;
                    const int c = (vb >> 5) - 4, tmw = vb & 31;
                    const int nit = (c == 2 && tmw < 16) ? 4 : 3;
                    if (F.tid == 0) {
                        if (l > 0 && tmw != waited_tm) {
                            if (tmw >= 16) { unsigned* y = ctl + CW_YRDY + ((l - 1) * 32 + (tmw & ~3)) * 4; for (int i = 0; i < 4; ++i) { XB_SPIN(xb_ld(y + 4 * i) < 16u, ctl + CW_BAR); } }
                            else { XB_SPIN(xb_ld(ctl + CW_YRDY + ((l - 1) * 32 + tmw) * 4) < 16u, ctl + CW_BAR); XB_SPIN(xb_ld(ctl + CW_SD + ((l - 1) * 16 + tmw) * 4) < 4u, ctl + CW_BAR); }
                        }
                        unsigned* f = flags + tmw * 16;
                        XB_SPIN(xb_ld(f) < 2u, ctl + CW_BAR);
                        __builtin_amdgcn_fence(__ATOMIC_ACQUIRE, "agent");
                        asm volatile("s_waitcnt vmcnt(0)" ::: "memory");
                    }
                    __syncthreads();
                    for (int i = 0; i < nit; ++i) {
                        const bool hn = i + 1 < nit;
                        const int j = a2_item(vb, i), jn = a2_item(vb, hn ? i + 1 : i);
                        const GemmOp g = a2_op(F, l, j); const GemmOp gn = a2_op(F, l, jn);
                        GemmAcc acc;
                        float rstdq = 0.f;
                        if (j < 160) qm_pre(F, tmw, rstdq);
                        gemm_core(F, g, acc, i == 0, hn, gn);
                        if (j < 160) epi_qm(F, acc, j >> 5, tmw, rstdq);
                        else if (j < 352) { const int jj = j - 160; epi_plain(F, acc, (bf16_t*)(F.ws + WS_KVM), 768, tmw * 256, (jj >> 5) * 128); }
                        else {
                            const int jj = j - 352, tc = jj & 7;
                            if (l > 0) {
                                if (F.w == 0) { const int ln = lane_id(); poll_lanes(ctl + CW_YRDY + ((l - 1) * 32 + 16 + 4 * (tc >> 1) + (ln & 3)) * 4, 16u, ln < 4, ctl + CW_BAR); }
                                __syncthreads();
                            }
                            epi_plain(F, acc, (bf16_t*)(F.ws + WS_KVMC), 768, (tc >> 1) * 512 + (tc & 1) * 256, (jj >> 3) * 128);
                        }
                        asm volatile("s_waitcnt vmcnt(0)" ::: "memory");
                        __syncthreads();
                        if (F.tid == 0) {
                            if (j < 352) (void)xb_add(ctl + CW_FULL + (l * 32 + tmw) * 4, 1u);
                            else (void)xb_add(ctl + CW_KC + (l * 4 + (((j - 352) & 7) >> 1)) * 4, 1u);
                        }
                    }
                }
            } else if (EN(5) && sub == 2) {
                for (;;) {
                    __syncthreads();
                    if (F.tid == 0) MISC[0] = atomicAdd(ctl + CW_QUEUE + 64 * l + 32 * rep, 1u);
                    __syncthreads();
                    const int uq = __builtin_amdgcn_readfirstlane((int)MISC[0]);
                    if (uq >= N_ATTN_UNITS) break;
                    const int u = uq < 160 ? uq + 96 : (uq < 256 ? uq - 160 : (uq < 416 ? uq + 96 : (uq < 512 ? uq - 160 : uq)));
                    attn_dispatch(F, p, u, l);
                }
            } else if (EN(6)) {
                const bf16_t* Wt = (const bf16_t*)(F.ws + WS_WOUT) + (size_t)l * 1024 * 1024;
                const bf16_t* Yb = (const bf16_t*)(F.ws + WS_Y);
                for (int j = bid; j < 8 * 32; j += G) {
                    const int tn = j >> 5, tm = j & 31;
                    GemmOp g; g.W = Wt + (size_t)tn * 128 * 1024; g.X = Yb + (size_t)tm * 256 * 1024; g.ldw = 1024; g.ldx = 1024; g.K = 1024;
                    GemmAcc acc;
                    Gemm2Pre P2;
                    if (F.tid == 0) {
                        unsigned* f = ctl + CW_YRDY + (l * 32 + tm) * 4;
                        XB_SPIN(xb_ld(f) < 16u, ctl + CW_BAR);
                        if (l == 0) { XB_SPIN(xb_ld(ctl + CW_P1DONE) < (unsigned)G, ctl + CW_BAR); }
                        __builtin_amdgcn_fence(__ATOMIC_ACQUIRE, "agent");
                        asm volatile("s_waitcnt vmcnt(0)" ::: "memory");
                    }
                    __syncthreads();
                    gemm2_pre(F, tn, tm, l, P2);
                    gemm_core(F, g, acc, true, false, g);
                    epi_gemm2(F, p, acc, tn, tm, l, P2, l == 3);
                    {
                        asm volatile("s_waitcnt vmcnt(0)" ::: "memory");
                        __syncthreads();
                        if (F.tid == 0) (void)xb_add(l == 3 ? ctl + CW_XRDY + tm * 4 : ctl + CW_XGR + (l * 32 + tm) * 4, 1u);
                    }
                }
            }
        }
        }
        if (MK_TIMING >= 0 && ph == 17 && blockIdx.x == 0 && F.tid == 0) {
            const unsigned long long now = __builtin_amdgcn_s_memrealtime();
            const unsigned long long prev = ((unsigned long long)MISC[17] << 32) | MISC[16];
            unsigned a = MISC[18]; if (MK_TIMING == 5) a += (unsigned)(now - prev);
            __hip_atomic_store(ctl + CW_TIME, __float_as_uint(1.f + (float)a * 1e-5f), __ATOMIC_RELAXED, __HIP_MEMORY_SCOPE_AGENT);
        }
        if (ph + 1 < p.ph_hi && ph < 1) xcd_barrier(bar);
    }
}
}

extern "C" void kernel_launch(void* const* d_in, const int* in_sizes, int n_in, void* d_out, int out_size, void* d_ws, size_t ws_size, hipStream_t stream) {
    static int grid = 0;
    if (!grid) {
        int dev = 0, cus = 0, per_cu = 0;
        (void)hipGetDevice(&dev);
        (void)hipDeviceGetAttribute(&cus, hipDeviceAttributeMultiprocessorCount, dev);
        (void)hipFuncSetAttribute((const void*)mk::mega, hipFuncAttributeMaxDynamicSharedMemorySize, mk::LDS_BYTES);
        (void)hipOccupancyMaxActiveBlocksPerMultiprocessor(&per_cu, (const void*)mk::mega, 512, mk::LDS_BYTES);
        if (per_cu > 1) per_cu = 1;
        if (per_cu < 1) per_cu = 1;
        if (cus < 1) cus = 256;
        grid = cus * per_cu;
    }
    unsigned char* ws = (unsigned char*)d_ws;
    (void)hipMemsetAsync(ws, 0, mk::CTL_ZERO_BYTES, stream);
    mk::Params P{};
    for (int i = 0; i < 22; ++i) P.in[i] = (const float*)d_in[i];
    P.out = (float*)d_out; P.ws = ws; P.xs = (float*)d_out;
    P.ph_lo = 0; P.ph_hi = mk::PH_TOTAL;
    void* args[] = {&P};
    (void)hipLaunchCooperativeKernel((const void*)mk::mega, dim3(grid), dim3(512), args, mk::LDS_BYTES, stream);
}
```

```cpp
#include <hip/hip_runtime.h>
#include <stdint.h>
namespace mk {
#define LAS __attribute__((address_space(3)))
typedef unsigned short bf16_t;
typedef short bf16x8 __attribute__((ext_vector_type(8)));
typedef short s16x4 __attribute__((ext_vector_type(4)));
typedef float f32x16 __attribute__((ext_vector_type(16)));
typedef float f32x4 __attribute__((ext_vector_type(4)));
typedef float f32x2 __attribute__((ext_vector_type(2)));
typedef unsigned u32x4 __attribute__((ext_vector_type(4)));
typedef unsigned u32x2 __attribute__((ext_vector_type(2)));
typedef __bf16 bf16x2_t __attribute__((ext_vector_type(2)));

constexpr float EPS = 1e-6f;
constexpr float LOG2E = 1.4426950408889634f;
constexpr float QSC_GQA = 0.125f * LOG2E;
constexpr float QSC_MLA = 0.10206207261596575f * LOG2E;

__device__ __forceinline__ unsigned pk2(float lo, float hi) { f32x2 v = {lo, hi}; bf16x2_t b = __builtin_convertvector(v, bf16x2_t); return __builtin_bit_cast(unsigned, b); }
__device__ __forceinline__ float bf2f(unsigned short u) { return __uint_as_float((unsigned)u << 16); }
__device__ __forceinline__ float bflo(unsigned u) { return __uint_as_float(u << 16); }
__device__ __forceinline__ float bfhi(unsigned u) { return __uint_as_float(u & 0xffff0000u); }
__device__ __forceinline__ float silu_f(float x) { return x * __builtin_amdgcn_rcpf(1.f + __builtin_amdgcn_exp2f(-x * LOG2E)); }
__device__ __forceinline__ float wsum(float v) {
#pragma unroll
    for (int o = 32; o > 0; o >>= 1) v += __shfl_xor(v, o);
    return v;
}

constexpr size_t MiB = 1u << 20;
constexpr size_t WS_CTL = 0, CTL_ZERO_BYTES = 1 * MiB;
constexpr size_t WS_MODS = 256 * 1024;
constexpr size_t WS_BIAS = 1 * MiB;
constexpr size_t WS_GS = 1 * MiB + 256 * 1024;
constexpr size_t WS_ROPE64 = 1 * MiB + 512 * 1024;
constexpr size_t WS_ROPE32 = 1 * MiB + 768 * 1024;
constexpr size_t WS_SSQ = 2 * MiB;
constexpr size_t WS_CQSSQ = 2 * MiB + 512 * 1024;
constexpr size_t WS_S0T = 3 * MiB;
constexpr size_t WS_CGK = 4 * MiB, WS_CGV = 6 * MiB, WS_CCKV = 8 * MiB, WS_CKPE = 10 * MiB;
constexpr size_t WS_WIN = 11 * MiB;
constexpr size_t WS_WOUT = 34 * MiB;
constexpr size_t WS_WUQ = 42 * MiB;
constexpr size_t WS_WUKV = 43 * MiB + 256 * 1024;
constexpr size_t WS_XG = 44 * MiB;
constexpr size_t WS_KVM = 130 * MiB;
constexpr size_t WS_KVMC = 142 * MiB;
constexpr size_t WS_RQ = 60 * MiB, WS_RK = 64 * MiB, WS_RV = 68 * MiB;
constexpr size_t WS_GQ = 72 * MiB;
constexpr size_t WS_GK = 78 * MiB, WS_GV = 80 * MiB;
constexpr size_t WS_CQG = 82 * MiB;
constexpr size_t WS_CKVN = 86 * MiB;
constexpr size_t WS_KPEB = 88 * MiB;
constexpr size_t WS_ZS = 89 * MiB;
constexpr size_t WS_QM = 105 * MiB;
constexpr size_t WS_Y = 114 * MiB;
constexpr size_t WS_XSDBG = 130 * MiB;
constexpr size_t WS_XB = 146 * MiB;
constexpr size_t WS_OPT_END = 162 * MiB;
constexpr int CW_QUEUE = 1024;
constexpr int CW_FLAG = 2048;
constexpr int CW_YRDY = 1536;
constexpr int CW_XRDY = 1280;
constexpr int CW_RA = 8192;
constexpr int CW_FULL = 8704;
constexpr int CW_ZC = 9216;
constexpr int CW_KC = 9728;
constexpr int CW_XGR = 9856;
constexpr int CW_SD = 10368;
constexpr int CW_P1X = 10656;
constexpr int CW_P1B0 = 10784;
constexpr int CW_P1DONE = 10788;
constexpr int CW_BAR = 4096;

constexpr size_t O_STATE = 8388608, O_GK = 10485760, O_GV = 12582912, O_CKV = 14680064, O_KPE = 16777216;

constexpr int NWAVE = 8;
constexpr int GST = 49152;
constexpr int GST2 = 65536;
constexpr int LDS_OST = GST2;
constexpr int LDS_EX = 135168;
constexpr int LDS_EXB = 137216;
constexpr int LDS_SCAL = 141312;
constexpr int LDS_MISC = 142336;
constexpr int LDS_BYTES = 142592;

struct Params { const float* in[22]; float* out; unsigned char* ws; float* xs; int ph_lo, ph_hi; };
enum { I_XP = 0, I_XS, I_STATE, I_CGK, I_CGV, I_CCKV, I_CKPE, I_C, I_CCTX, I_NORMG, I_WADA, I_BADA, I_WIN, I_DECAY, I_GQN, I_GKN, I_MQN, I_MKVN, I_WUQ, I_WUKV, I_WOUT, I_FNORM };

#define XB_TMO      128
#define XB_XCNT(j)  (256  + 64 * (j))
#define XB_XSUB(j)  (1280 + 64 * (j))
#define XB_XGEN(j)  (2304 + 64 * (j))
#define XB_TOP      3328
#define XB_TOPGEN   3392
#define XB_SPIN_CAP (1u << 20)
__device__ __forceinline__ unsigned xb_ld(unsigned* p) { return __hip_atomic_load(p, __ATOMIC_RELAXED, __HIP_MEMORY_SCOPE_AGENT); }
__device__ __forceinline__ unsigned xb_add(unsigned* p, unsigned v) { return __hip_atomic_fetch_add(p, v, __ATOMIC_RELAXED, __HIP_MEMORY_SCOPE_AGENT); }
__device__ __forceinline__ unsigned xb_xcc_id() { return (unsigned)__builtin_amdgcn_s_getreg((3 << 11) | 20) & 0xFu; }
#define XB_SPIN(cond, bar) do { unsigned _sp = 0; while (cond) { __builtin_amdgcn_s_sleep(1); \
    if ((++_sp & 255u) == 0u) { if (xb_ld(&(bar)[XB_TMO])) break; if (_sp > XB_SPIN_CAP) { atomicAdd(&(bar)[XB_TMO], 1u); break; } } } } while (0)
__device__ __forceinline__ int lane_id() { int ln = (int)__builtin_amdgcn_mbcnt_hi(~0u, __builtin_amdgcn_mbcnt_lo(~0u, 0u)); asm volatile("" : "+v"(ln)); return ln; }
__device__ __forceinline__ void poll_lanes(unsigned* ptr, unsigned target, bool active, unsigned* bar0) {
    unsigned sp = 0u;
    for (;;) {
        unsigned v = target;
        if (active) v = xb_ld(ptr);
        if (!__any(v < target)) break;
        __builtin_amdgcn_s_sleep(1);
        if ((++sp & 255u) == 0u) { if (xb_ld(&bar0[XB_TMO])) break; if (sp > XB_SPIN_CAP) { atomicAdd(&bar0[XB_TMO], 1u); break; } }
    }
}
struct XcdBarrier { unsigned* bar; unsigned x; volatile LAS unsigned* st; int w; };
__device__ __forceinline__ XcdBarrier xcd_barrier_post(unsigned* bar, volatile LAS unsigned* st) {
    XcdBarrier b; b.bar = bar; b.x = xb_xcc_id(); b.st = st; b.w = 0;
    if (threadIdx.x == 0) (void)xb_add(&bar[XB_XCNT(b.x)], 1u);
    return b;
}
__device__ __forceinline__ void xcd_barrier_complete(unsigned* bar, unsigned x, unsigned& nloc, unsigned& nx) {
    const unsigned G = gridDim.x * gridDim.y * gridDim.z;
    unsigned sum, cnt, mine, sp = 0u;
    for (;;) {
        sum = 0u; cnt = 0u; mine = 0u;
#pragma unroll
        for (unsigned j = 0; j < 16; ++j) { const unsigned c = xb_ld(&bar[XB_XCNT(j)]); sum += c; cnt += (c > 0u) ? 1u : 0u; mine = (j == x) ? c : mine; }
        if (sum == G) break;
        __builtin_amdgcn_s_sleep(1);
        if ((++sp & 255u) == 0u) { if (xb_ld(&bar[XB_TMO])) break; if (sp > XB_SPIN_CAP) { atomicAdd(&bar[XB_TMO], 1u); break; } }
    }
    nloc = mine > 0u ? mine : 1u; nx = cnt > 0u ? cnt : 1u;
}
__device__ __forceinline__ void xcd_barrier(const XcdBarrier& b) {
    asm volatile("s_waitcnt vmcnt(0)" ::: "memory");
    __syncthreads();
    if (b.w == 0 && __builtin_amdgcn_mbcnt_hi(~0u, __builtin_amdgcn_mbcnt_lo(~0u, 0u)) == 0u) {
        unsigned* bar = b.bar;
        __builtin_amdgcn_s_waitcnt(0);
        unsigned nloc = b.st[0], nx = b.st[1];
        if (nloc == 0u) { xcd_barrier_complete(bar, b.x, nloc, nx); b.st[0] = nloc; b.st[1] = nx; }
        const unsigned old = xb_add(&bar[XB_XSUB(b.x)], 1u);
        const unsigned gen = old / nloc;
        if (old + 1u == (gen + 1u) * nloc) {
            __builtin_amdgcn_fence(__ATOMIC_RELEASE, "agent");
            asm volatile("s_waitcnt vmcnt(0)" ::: "memory");
            const unsigned og = xb_add(&bar[XB_TOP], 1u);
            const unsigned tg = og / nx;
            if (og + 1u == (tg + 1u) * nx) xb_add(&bar[XB_TOPGEN], 1u);
            else XB_SPIN(xb_ld(&bar[XB_TOPGEN]) == tg, bar);
            xb_add(&bar[XB_XGEN(b.x)], 1u);
            __builtin_amdgcn_fence(__ATOMIC_ACQUIRE, "agent");
            asm volatile("s_waitcnt vmcnt(0)" ::: "memory");
        } else {
            XB_SPIN(xb_ld(&bar[XB_XGEN(b.x)]) == gen, bar);
            __builtin_amdgcn_fence(__ATOMIC_ACQUIRE, "agent");
            asm volatile("s_waitcnt vmcnt(0)" ::: "memory");
        }
    }
    __syncthreads();
}

typedef const float* cfp_t;
typedef const __attribute__((address_space(4))) cfp_t* karg_t;
struct Frame {
    LAS unsigned char* lds;
    int tid, lane, w, h, lq;
    unsigned char* ws;
    karg_t karg;
};
__device__ __forceinline__ const float* pin(const Frame& F, int i) { return F.karg[i]; }
__device__ __forceinline__ bool is_t0(const Frame& F) { return F.w == 0 && __builtin_amdgcn_mbcnt_hi(~0u, __builtin_amdgcn_mbcnt_lo(~0u, 0u)) == 0u; }
#define GLDS16(gsrc, ldsdst) __builtin_amdgcn_global_load_lds((const unsigned*)(gsrc), (LAS unsigned*)(ldsdst), 16, 0, 0)
#define ST16_WT(ptr, val) asm volatile("global_store_dwordx4 %0, %1, off sc1\n\ts_nop 1" :: "v"(ptr), "v"(val) : "memory")
#define MFMA32(a, b, c) __builtin_amdgcn_mfma_f32_32x32x16_bf16((a), (b), (c), 0, 0, 0)

struct GemmOp { const bf16_t* W; const bf16_t* X; int ldw, ldx, K; };
__device__ __forceinline__ void gemm_issue0(const Frame& F, const GemmOp& g) {
    const int lane = F.lane, w = F.w;
#pragma unroll
    for (int q = 0; q < 2; ++q) { const int row = 16 * w + 8 * q + (lane >> 3); GLDS16(g.W + row * g.ldw + ((lane & 7) ^ ((row >> 1) & 7)) * 8, F.lds + (16 * w + 8 * q) * 128); }
#pragma unroll
    for (int q = 0; q < 4; ++q) { const int row = 32 * w + 8 * q + (lane >> 3); GLDS16(g.X + row * g.ldx + ((lane & 7) ^ ((row >> 1) & 7)) * 8, F.lds + 16384 + (32 * w + 8 * q) * 128); }
}
typedef f32x4 GemmAcc[4][4];
__device__ __forceinline__ void gemm_core(const Frame& F, const GemmOp& g, GemmAcc& acc, bool issue_first, bool has_next, const GemmOp& gn) {
    const int lane = F.lane, w = F.w;
    const bf16_t* __restrict__ W = g.W; const bf16_t* __restrict__ X = g.X;
    const int nkt = g.K >> 6;
    int offW[2], offX[4];
#pragma unroll
    for (int q = 0; q < 2; ++q) { const int row = 16 * w + 8 * q + (lane >> 3); offW[q] = row * g.ldw + ((lane & 7) ^ ((row >> 1) & 7)) * 8; }
#pragma unroll
    for (int q = 0; q < 4; ++q) { const int row = 32 * w + 8 * q + (lane >> 3); offX[q] = row * g.ldx + ((lane & 7) ^ ((row >> 1) & 7)) * 8; }
    LAS unsigned char* const dW = F.lds + (16 * w) * 128;
    LAS unsigned char* const dX = F.lds + 16384 + (32 * w) * 128;
#define GC_ISSUE(kt, st) do { _Pragma("unroll") for (int q = 0; q < 2; ++q) GLDS16(W + offW[q] + (kt) * 64, dW + (st) * GST + q * 1024); \
        _Pragma("unroll") for (int q = 0; q < 4; ++q) GLDS16(X + offX[q] + (kt) * 64, dX + (st) * GST + q * 1024); } while (0)
    const int wn = w & 1, wm = w >> 1, c15 = lane & 15, g4 = lane >> 4;
    const int sw = (c15 >> 1) & 7;
    int so[2];
#pragma unroll
    for (int s = 0; s < 2; ++s) so[s] = ((4 * s + g4) ^ sw) << 4;
    const int bn0 = (64 * wn + c15) * 128, bm0 = 16384 + (64 * wm + c15) * 128;
#pragma unroll
    for (int a = 0; a < 4; ++a)
#pragma unroll
        for (int b = 0; b < 4; ++b) acc[a][b] = (f32x4){0.f, 0.f, 0.f, 0.f};
    if (issue_first) GC_ISSUE(0, 0);
    asm volatile("s_waitcnt vmcnt(0)" ::: "memory");
    __syncthreads();
    for (int kt = 0; kt < nkt; ++kt) {
        const int st = kt & 1;
        if (kt + 1 < nkt) GC_ISSUE(kt + 1, st ^ 1);
        LAS unsigned char* const base = F.lds + st * GST;
#pragma unroll
        for (int s = 0; s < 2; ++s) {
            bf16x8 fa[4], fb[4];
#pragma unroll
            for (int q = 0; q < 4; ++q) { fa[q] = *(const LAS bf16x8*)(base + bn0 + q * 2048 + so[s]); fb[q] = *(const LAS bf16x8*)(base + bm0 + q * 2048 + so[s]); }
#pragma unroll
            for (int a = 0; a < 4; ++a)
#pragma unroll
                for (int b = 0; b < 4; ++b) acc[a][b] = __builtin_amdgcn_mfma_f32_16x16x32_bf16(fa[a], fb[b], acc[a][b], 0, 0, 0);
        }
        asm volatile("s_waitcnt vmcnt(0)" ::: "memory");
        __syncthreads();
    }
#undef GC_ISSUE
    if (has_next) gemm_issue0(F, gn);
}

typedef f32x4 GemmAcc8[4][8];
__device__ __forceinline__ void gemm256_issue0(const Frame& F, const bf16_t* W, const bf16_t* X) {
    int lane = F.lane; const int w = F.w;
    asm volatile("" : "+v"(lane));
#pragma unroll
    for (int q = 0; q < 4; ++q) {
        const int row = 32 * w + 8 * q + (lane >> 3), off = row * 1024 + ((lane & 7) ^ ((row >> 1) & 7)) * 8;
        GLDS16(W + off, F.lds + (32 * w + 8 * q) * 128);
        GLDS16(X + off, F.lds + 32768 + (32 * w + 8 * q) * 128);
    }
}
__device__ __forceinline__ void gemm_core256(const Frame& F, const bf16_t* __restrict__ W, const bf16_t* __restrict__ X, GemmAcc8& acc, bool issue_first, bool has_next, const bf16_t* Wn, const bf16_t* Xn) {
    int lane = F.lane; const int w = F.w;
    asm volatile("" : "+v"(lane));
    int off[4];
#pragma unroll
    for (int q = 0; q < 4; ++q) { const int row = 32 * w + 8 * q + (lane >> 3); off[q] = row * 1024 + ((lane & 7) ^ ((row >> 1) & 7)) * 8; }
    LAS unsigned char* const dW = F.lds + (32 * w) * 128;
    LAS unsigned char* const dX = F.lds + 32768 + (32 * w) * 128;
#define GC2_ISSUE(kt, st) do { _Pragma("unroll") for (int q = 0; q < 4; ++q) { GLDS16(W + off[q] + (kt) * 64, dW + (st) * GST2 + q * 1024); GLDS16(X + off[q] + (kt) * 64, dX + (st) * GST2 + q * 1024); } } while (0)
    const int wn4 = w & 3, wm2 = w >> 2, c15 = lane & 15, g4 = lane >> 4;
    const int sw = (c15 >> 1) & 7;
    int so[2];
#pragma unroll
    for (int s = 0; s < 2; ++s) so[s] = ((4 * s + g4) ^ sw) << 4;
    const int bn0 = (64 * wn4 + c15) * 128, bm0 = 32768 + (128 * wm2 + c15) * 128;
#pragma unroll
    for (int a = 0; a < 4; ++a)
#pragma unroll
        for (int b = 0; b < 8; ++b) acc[a][b] = (f32x4){0.f, 0.f, 0.f, 0.f};
    if (issue_first) GC2_ISSUE(0, 0);
    asm volatile("s_waitcnt vmcnt(0)" ::: "memory");
    __syncthreads();
    for (int kt = 0; kt < 16; ++kt) {
        const int st = kt & 1;
        LAS unsigned char* const base = F.lds + st * GST2;
#pragma unroll
        for (int s = 0; s < 2; ++s) {
            bf16x8 fa[4];
#pragma unroll
            for (int q = 0; q < 4; ++q) fa[q] = *(const LAS bf16x8*)(base + bn0 + q * 2048 + so[s]);
#pragma unroll
            for (int hb = 0; hb < 2; ++hb) {
                bf16x8 fb[4];
#pragma unroll
                for (int q = 0; q < 4; ++q) fb[q] = *(const LAS bf16x8*)(base + bm0 + (4 * hb + q) * 2048 + so[s]);
                if (s == 0 && hb == 0 && kt + 1 < 16) GC2_ISSUE(kt + 1, st ^ 1);
#pragma unroll
                for (int a = 0; a < 4; ++a)
#pragma unroll
                    for (int b = 0; b < 4; ++b) acc[a][4 * hb + b] = __builtin_amdgcn_mfma_f32_16x16x32_bf16(fa[a], fb[b], acc[a][4 * hb + b], 0, 0, 0);
            }
        }
        asm volatile("s_waitcnt vmcnt(0)" ::: "memory");
        __syncthreads();
    }
#undef GC2_ISSUE
    if (has_next) gemm256_issue0(F, Wn, Xn);
}
typedef f32x4 GemmAcc2[2][8];
__device__ __forceinline__ void gemm_core256n(const Frame& F, const bf16_t* __restrict__ W, const bf16_t* __restrict__ X, GemmAcc2& acc, bool issue_first) {
    int lane = F.lane; const int w = F.w;
    asm volatile("" : "+v"(lane));
    int off[4];
#pragma unroll
    for (int q = 0; q < 4; ++q) { const int row = 32 * w + 8 * q + (lane >> 3); off[q] = row * 1024 + ((lane & 7) ^ ((row >> 1) & 7)) * 8; }
    LAS unsigned char* const dW = F.lds + (32 * w) * 128;
    LAS unsigned char* const dX = F.lds + 32768 + (32 * w) * 128;
#define GC2_ISSUE(kt, st) do { _Pragma("unroll") for (int q = 0; q < 4; ++q) { if (w == 0) GLDS16(W + off[q] + (kt) * 64, dW + (st) * GST2 + q * 1024); GLDS16(X + off[q] + (kt) * 64, dX + (st) * GST2 + q * 1024); } } while (0)
    const int wn4 = w & 3, wm2 = w >> 2, c15 = lane & 15, g4 = lane >> 4;
    const int sw = (c15 >> 1) & 7;
    int so[2];
#pragma unroll
    for (int s = 0; s < 2; ++s) so[s] = ((4 * s + g4) ^ sw) << 4;
    const int bn0 = (64 * wn4 + c15) * 128, bm0 = 32768 + (128 * wm2 + c15) * 128;
#pragma unroll
    for (int a = 0; a < 2; ++a)
#pragma unroll
        for (int b = 0; b < 8; ++b) acc[a][b] = (f32x4){0.f, 0.f, 0.f, 0.f};
    if (issue_first) GC2_ISSUE(0, 0);
    asm volatile("s_waitcnt vmcnt(0)" ::: "memory");
    __syncthreads();
    for (int kt = 0; kt < 16; ++kt) {
        const int st = kt & 1;
        if (kt + 1 < 16) GC2_ISSUE(kt + 1, st ^ 1);
        LAS unsigned char* const base = F.lds + st * GST2;
        if (wn4 == 0) {
#pragma unroll
        for (int s = 0; s < 2; ++s) {
            bf16x8 fa[2];
#pragma unroll
            for (int q = 0; q < 2; ++q) fa[q] = *(const LAS bf16x8*)(base + bn0 + q * 2048 + so[s]);
#pragma unroll
            for (int hb = 0; hb < 2; ++hb) {
                bf16x8 fb[4];
#pragma unroll
                for (int q = 0; q < 4; ++q) fb[q] = *(const LAS bf16x8*)(base + bm0 + (4 * hb + q) * 2048 + so[s]);
#pragma unroll
                for (int a = 0; a < 2; ++a)
#pragma unroll
                    for (int b = 0; b < 4; ++b) acc[a][4 * hb + b] = __builtin_amdgcn_mfma_f32_16x16x32_bf16(fa[a], fb[b], acc[a][4 * hb + b], 0, 0, 0);
            }
        }
        }
        asm volatile("s_waitcnt vmcnt(0)" ::: "memory");
        __syncthreads();
    }
#undef GC2_ISSUE
}

__device__ __forceinline__ void rope64_16(float (&v)[4][4], float rowp, float colp, int g4) {
#pragma unroll
    for (int i = 0; i < 4; ++i) {
        const float fr = __builtin_amdgcn_exp2f((float)(4 * g4 + i) * -0.8304820237218406f) * 0.15915494309189535f;
#pragma unroll
        for (int c = 0; c < 2; ++c) {
            const float rev = (c ? colp : rowp) * fr;
            const float sn = __builtin_amdgcn_sinf(rev), cs = __builtin_amdgcn_cosf(rev);
            const float x0 = v[2 * c][i], x1 = v[2 * c + 1][i];
            v[2 * c][i] = x0 * cs - x1 * sn;
            v[2 * c + 1][i] = x1 * cs + x0 * sn;
        }
    }
}
__device__ __forceinline__ void rope32_16(float (&a)[4], float (&b)[4], float rowp, float colp, int g4) {
    const bool hi = g4 >= 2;
#pragma unroll
    for (int i = 0; i < 4; ++i) {
        const float fr = __builtin_amdgcn_exp2f((float)(4 * (g4 & 1) + i) * -1.6609640474436813f) * 0.15915494309189535f;
        {
            const float rev = rowp * fr;
            const float sn = __builtin_amdgcn_sinf(rev), cs = __builtin_amdgcn_cosf(rev);
            const float own = a[i], oth = __shfl_xor(own, 32);
            a[i] = own * cs + oth * (hi ? sn : -sn);
        }
        {
            const float rev = colp * fr;
            const float sn = __builtin_amdgcn_sinf(rev), cs = __builtin_amdgcn_cosf(rev);
            const float own = b[i], oth = __shfl_xor(own, 32);
            b[i] = own * cs + oth * (hi ? sn : -sn);
        }
    }
}
__device__ __forceinline__ float ssq64(const float (&v)[4][4]) {
    float s = 0.f;
#pragma unroll
    for (int nt = 0; nt < 4; ++nt)
#pragma unroll
        for (int i = 0; i < 4; ++i) s += v[nt][i] * v[nt][i];
    s += __shfl_xor(s, 16);
    s += __shfl_xor(s, 32);
    return s;
}
__device__ __forceinline__ void mulvec64(float (&v)[4][4], const LAS float* gv, int g4) {
#pragma unroll
    for (int nt = 0; nt < 4; ++nt) {
        const f32x4 q = *(const LAS f32x4*)(gv + 16 * nt + 4 * g4);
#pragma unroll
        for (int i = 0; i < 4; ++i) v[nt][i] *= q[i];
    }
}
constexpr int OST_LD = 68, OST_BYTES = 32 * OST_LD * 4;
__device__ __forceinline__ void stage_write16(LAS float* st, const float (&v)[4][4], int mh, int c15, int g4) {
    asm volatile("s_waitcnt lgkmcnt(0)" ::: "memory");
    __builtin_amdgcn_wave_barrier();
#pragma unroll
    for (int nt = 0; nt < 4; ++nt) {
        f32x4 o = {v[nt][0], v[nt][1], v[nt][2], v[nt][3]};
        *(LAS f32x4*)(st + (16 * mh + c15) * OST_LD + 16 * nt + 4 * g4) = o;
    }
    asm volatile("s_waitcnt lgkmcnt(0)" ::: "memory");
    __builtin_amdgcn_wave_barrier();
}
__device__ __forceinline__ void stage_write16a(LAS float* st, const f32x4 (&a)[4][4], int mt, int c15, int g4) {
    asm volatile("s_waitcnt lgkmcnt(0)" ::: "memory");
    __builtin_amdgcn_wave_barrier();
#pragma unroll
    for (int nt = 0; nt < 4; ++nt) *(LAS f32x4*)(st + (16 * (mt & 1) + c15) * OST_LD + 16 * nt + 4 * g4) = a[nt][mt];
    asm volatile("s_waitcnt lgkmcnt(0)" ::: "memory");
    __builtin_amdgcn_wave_barrier();
}
__device__ __forceinline__ void stage_store_bf16(const LAS float* st, bf16_t* dst, int ld, float sc, int lane) {
#pragma unroll 1
    for (int it = 0; it < 4; ++it) {
        const int row = it * 8 + (lane >> 3), c8 = (lane & 7) * 8;
        const f32x4 x0 = *(const LAS f32x4*)(st + row * OST_LD + c8), x1 = *(const LAS f32x4*)(st + row * OST_LD + c8 + 4);
        u32x4 o; o.x = pk2(x0[0] * sc, x0[1] * sc); o.y = pk2(x0[2] * sc, x0[3] * sc); o.z = pk2(x1[0] * sc, x1[1] * sc); o.w = pk2(x1[2] * sc, x1[3] * sc);
        ST16_WT(dst + (size_t)row * ld + c8, o);
    }
}
__device__ __forceinline__ void stage_store_bf16_sc1(const LAS float* st, bf16_t* dst, int ld, int lane) {
#pragma unroll 1
    for (int it = 0; it < 4; ++it) {
        const int row = it * 8 + (lane >> 3), c8 = (lane & 7) * 8;
        const f32x4 x0 = *(const LAS f32x4*)(st + row * OST_LD + c8), x1 = *(const LAS f32x4*)(st + row * OST_LD + c8 + 4);
        u32x4 o; o.x = pk2(x0[0], x0[1]); o.y = pk2(x0[2], x0[3]); o.z = pk2(x1[0], x1[1]); o.w = pk2(x1[2], x1[3]);
        bf16_t* ptr = dst + (size_t)row * ld + c8;
        asm volatile("global_store_dwordx4 %0, %1, off sc1\n\ts_nop 1" :: "v"(ptr), "v"(o) : "memory");
    }
}
__device__ __forceinline__ void stage_store_f32(const LAS float* st, float* dst, int ld, int lane) {
#pragma unroll 1
    for (int it = 0; it < 8; ++it) {
        const int row = it * 4 + (lane >> 4), c = (lane & 15) * 4;
        { const f32x4 o = *(const LAS f32x4*)(st + row * OST_LD + c); ST16_WT(dst + (size_t)row * ld + c, o); }
    }
}
__device__ __forceinline__ void stage_store_bf16_32(const LAS float* st, bf16_t* dst, int ld, int lane) {
#pragma unroll 1
    for (int it = 0; it < 2; ++it) {
        const int row = it * 16 + (lane >> 2), c8 = (lane & 3) * 8;
        const f32x4 x0 = *(const LAS f32x4*)(st + row * OST_LD + c8), x1 = *(const LAS f32x4*)(st + row * OST_LD + c8 + 4);
        u32x4 o; o.x = pk2(x0[0], x0[1]); o.y = pk2(x0[2], x0[3]); o.z = pk2(x1[0], x1[1]); o.w = pk2(x1[2], x1[3]);
        ST16_WT(dst + (size_t)row * ld + c8, o);
    }
}
__device__ __forceinline__ void stage_store_f32_32(const LAS float* st, float* dst, int ld, int lane) {
#pragma unroll 1
    for (int it = 0; it < 4; ++it) {
        const int row = it * 8 + (lane >> 3), c = (lane & 7) * 4;
        { const f32x4 o = *(const LAS f32x4*)(st + row * OST_LD + c); ST16_WT(dst + (size_t)row * ld + c, o); }
    }
}

struct Gemm1Pre { float rstd[2]; float bias, gain; };
__device__ __forceinline__ void gemm1_pre(const Frame& F, const Params& p, int tn, int wn, int tm, int l, Gemm1Pre& P) {
    const float* ssqp = (const float*)(F.ws + WS_SSQ);
#pragma unroll
    for (int jj = 0; jj < 2; ++jj) {
        const int tok = tm * 256 + (F.w >> 2) * 128 + 64 * jj + F.lane;
        const f32x4* sp = (const f32x4*)(ssqp + (size_t)tok * 16);
        float ss = 0.f;
#pragma unroll
        for (int i = 0; i < 4; ++i) { const f32x4 q = sp[i]; ss += (q[0] + q[1]) + (q[2] + q[3]); }
        P.rstd[jj] = rsqrtf(ss * (1.f / 1024.f) + EPS);
    }
    const bool lat = tm >= 16;
    const int cond = lat ? 1 + ((tm - 16) >> 2) : 0;
    const int nb = tn * 128 + wn * 64;
    P.bias = (tn < 23) ? ((const float*)(F.ws + WS_BIAS))[(size_t)(l * 5 + cond) * 2944 + nb + F.lane] : 0.f;
    const float* gp = nullptr;
    if (tn >= 6 && tn < 9) gp = pin(F, I_GQN) + l * 64;
    else if (tn == 9) gp = pin(F, I_GKN) + l * 64;
    else if (tn == 11 || tn == 12) gp = pin(F, I_MQN) + l * 256 + (nb - 1408);
    else if (tn == 13) gp = pin(F, I_MKVN) + l * 128 + wn * 64;
    P.gain = gp ? gp[F.lane] : 1.f;
}
__device__ __forceinline__ void epi_gemm1(const Frame& F, const Params& p, GemmAcc8& acc, int tn, int wn, int tm, int l, const Gemm1Pre& P, bool ckv_tile) {
    int lane = F.lane; const int wm = F.w >> 2;
    asm volatile("" : "+v"(lane));
    const int c15 = lane & 15, g4 = lane >> 4;
    unsigned char* ws = F.ws;
    asm volatile("" : "+s"(ws));
    LAS float* st = (LAS float*)(F.lds + LDS_OST + F.w * OST_BYTES);
    const bool lat = tm >= 16;
    const int b = lat ? ((tm - 16) >> 2) : tm;
    const int nb = tn * 128 + wn * 64;
    LAS float* exb = (LAS float*)(F.lds + LDS_EXB) + F.w * 128;
    exb[lane] = P.bias; exb[64 + lane] = P.gain;
    asm volatile("s_waitcnt lgkmcnt(0)" ::: "memory");
    __builtin_amdgcn_wave_barrier();
    const LAS float* bias = exb;
    float* outp = p.out;
    asm volatile("" : "+s"(outp));
    float ckv_ss[8];
    if (tn < 23) {
#pragma unroll
    for (int mt = 0; mt < 8; ++mt) {
        const int mh = mt & 1;
        const int tok0 = tm * 256 + wm * 128 + (mt >> 1) * 32;
        const int tokb = tok0 + 16 * mh, tok = tokb + c15;
        const int t0 = lat ? ((tok0 - 4096) & 1023) : (tok0 & 255), t = t0 + 16 * mh + c15;
        const float rstd = __shfl(P.rstd[mt >> 2], 16 * (mt & 3) + c15);
        float v[4][4];
#pragma unroll
        for (int nt = 0; nt < 4; ++nt) {
            const f32x4 bq = *(const LAS f32x4*)(bias + 16 * nt + 4 * g4);
#pragma unroll
            for (int i = 0; i < 4; ++i) v[nt][i] = acc[nt][mt][i] * rstd + bq[i];
        }
        const float rowp = (float)(t >> 6), colp = (float)(t & 63);
        const size_t orow0 = (size_t)(b * 4 + l) * 256 + t0;
        if (tn < 2) {
            if (lat) rope64_16(v, rowp, colp, g4);
            stage_write16(st, v, mh, c15, g4);
            if (mh) stage_store_bf16(st, (bf16_t*)(ws + WS_RQ) + (size_t)tok0 * 256 + nb, 256, 1.f, lane);
        } else if (tn < 4) {
            if (lat) rope64_16(v, rowp, colp, g4);
            stage_write16(st, v, mh, c15, g4);
            if (mh) stage_store_bf16(st, (bf16_t*)(ws + WS_RK) + (size_t)tok0 * 256 + (nb - 256), 256, 0.125f, lane);
        } else if (tn < 6) {
            stage_write16(st, v, mh, c15, g4);
            if (mh) stage_store_bf16(st, (bf16_t*)(ws + WS_RV) + (size_t)tok0 * 256 + (nb - 512), 256, 1.f, lane);
        } else if (tn < 9) {
            const float r = rsqrtf(ssq64(v) * (1.f / 64.f) + EPS);
#pragma unroll
            for (int nt = 0; nt < 4; ++nt)
#pragma unroll
                for (int i = 0; i < 4; ++i) v[nt][i] *= r;
            mulvec64(v, exb + 64, g4);
            if (lat) rope64_16(v, rowp, colp, g4);
            stage_write16(st, v, mh, c15, g4);
            if (mh) stage_store_bf16(st, (bf16_t*)(ws + WS_GQ) + (size_t)tok0 * 384 + (nb - 768), 384, QSC_GQA, lane);
        } else if (tn == 9) {
            const float r = rsqrtf(ssq64(v) * (1.f / 64.f) + EPS);
#pragma unroll
            for (int nt = 0; nt < 4; ++nt)
#pragma unroll
                for (int i = 0; i < 4; ++i) v[nt][i] *= r;
            mulvec64(v, exb + 64, g4);
            if (lat) rope64_16(v, rowp, colp, g4);
            stage_write16(st, v, mh, c15, g4);
            if (mh) {
                if (!lat) stage_store_f32(st, outp + O_GK + orow0 * 128 + (nb - 1152), 128, lane);
                stage_store_bf16(st, (bf16_t*)(ws + WS_GK) + (size_t)tok0 * 128 + (nb - 1152), 128, 1.f, lane);
            }
        } else if (tn == 10) {
            stage_write16(st, v, mh, c15, g4);
            if (mh) {
                if (!lat) stage_store_f32(st, outp + O_GV + orow0 * 128 + (nb - 1280), 128, lane);
                stage_store_bf16(st, (bf16_t*)(ws + WS_GV) + (size_t)tok0 * 128 + (nb - 1280), 128, 1.f, lane);
            }
        } else if (tn < 13) {
            const float s2 = ssq64(v);
            if (g4 == 0) __hip_atomic_store((__attribute__((address_space(1))) float*)((float*)(ws + WS_CQSSQ) + (size_t)tok * 4 + ((nb - 1408) >> 6)), s2, __ATOMIC_RELAXED, __HIP_MEMORY_SCOPE_AGENT);
            mulvec64(v, exb + 64, g4);
            stage_write16(st, v, mh, c15, g4);
            if (mh) stage_store_bf16_sc1(st, (bf16_t*)(ws + WS_CQG) + (size_t)tok0 * 256 + (nb - 1408), 256, lane);
        } else if (tn == 13) {
            ckv_ss[mt] = ssq64(v);
            if (g4 == 0) ((LAS float*)(F.lds + LDS_EX))[(wm * 2 + wn) * 128 + mt * 16 + c15] = ckv_ss[mt];
        } else if (tn < 22) {
#pragma unroll
            for (int nt = 0; nt < 4; ++nt)
#pragma unroll
                for (int i = 0; i < 4; ++i) v[nt][i] = silu_f(v[nt][i]);
            stage_write16(st, v, mh, c15, g4);
            if (mh) stage_store_bf16(st, (bf16_t*)(ws + WS_ZS) + (size_t)tok0 * 1024 + (nb - 1792), 1024, 1.f, lane);
        } else {
            if (wn == 0) {
                if (lat) rope32_16(v[0], v[1], rowp, colp, g4);
                stage_write16(st, v, mh, c15, g4);
                if (mh) {
                    if (!lat) stage_store_f32_32(st, outp + O_KPE + orow0 * 32, 32, lane);
                    stage_store_bf16_32(st, (bf16_t*)(ws + WS_KPEB) + (size_t)tok0 * 32, 32, lane);
                }
            }
        }
    }
    }
    if (ckv_tile) {
        __syncthreads();
        if (tn == 13) {
#pragma unroll
        for (int mt = 0; mt < 8; ++mt) {
            const int mh = mt & 1;
            const int tok0 = tm * 256 + wm * 128 + (mt >> 1) * 32;
            const int t0 = lat ? ((tok0 - 4096) & 1023) : (tok0 & 255);
            const float rstd = __shfl(P.rstd[mt >> 2], 16 * (mt & 3) + c15);
            float v[4][4];
#pragma unroll
            for (int nt = 0; nt < 4; ++nt) {
                const f32x4 bq = *(const LAS f32x4*)(bias + 16 * nt + 4 * g4);
#pragma unroll
                for (int i = 0; i < 4; ++i) v[nt][i] = acc[nt][mt][i] * rstd + bq[i];
            }
            const float tot = ckv_ss[mt] + ((const LAS float*)(F.lds + LDS_EX))[(wm * 2 + (wn ^ 1)) * 128 + mt * 16 + c15];
            const float r = rsqrtf(tot * (1.f / 128.f) + EPS);
#pragma unroll
            for (int nt = 0; nt < 4; ++nt)
#pragma unroll
                for (int i = 0; i < 4; ++i) v[nt][i] *= r;
            mulvec64(v, exb + 64, g4);
            const size_t orow0 = (size_t)(b * 4 + l) * 256 + t0;
            stage_write16(st, v, mh, c15, g4);
            if (mh) {
                if (!lat) stage_store_f32(st, outp + O_CKV + orow0 * 128 + wn * 64, 128, lane);
                stage_store_bf16_sc1(st, (bf16_t*)(ws + WS_CKVN) + (size_t)tok0 * 128 + wn * 64, 128, lane);
            }
        }
        }
        __syncthreads();
    }
}

__device__ __forceinline__ void qm_pre(const Frame& F, int tm, float& rstd) {
    const int tok = tm * 256 + (F.w >> 1) * 64 + F.lane;
    const f32x4 q4 = *(const f32x4*)((const float*)(F.ws + WS_CQSSQ) + (size_t)tok * 4);
    rstd = rsqrtf(((q4[0] + q4[1]) + (q4[2] + q4[3])) * (1.f / 256.f) + EPS);
}
__device__ __forceinline__ void epi_qm(const Frame& F, GemmAcc& acc, int tn, int tm, float rstdl) {
    int lane = F.lane; const int wn = F.w & 1, wm = F.w >> 1;
    asm volatile("" : "+v"(lane));
    const int c15 = lane & 15, g4 = lane >> 4;
    unsigned char* ws = F.ws;
    LAS float* st = (LAS float*)(F.lds + LDS_OST + F.w * OST_BYTES);
    const bool lat = tm >= 16;
    const int nb = tn * 128 + wn * 64;
    if (nb >= 576) return;
#pragma unroll
    for (int mt = 0; mt < 4; ++mt) {
        const int mh = mt & 1;
        const int tok0 = tm * 256 + wm * 64 + (mt >> 1) * 32, tok = tok0 + 16 * mh + c15;
        const int t = lat ? ((tok - 4096) & 1023) : (tok & 255);
        const float rstd = __shfl(rstdl, 16 * mt + c15);
        const float rowp = (float)(t >> 6), colp = (float)(t & 63);
        float v[4][4];
#pragma unroll
        for (int nt = 0; nt < 4; ++nt)
#pragma unroll
            for (int i = 0; i < 4; ++i) v[nt][i] = acc[nt][mt][i] * rstd;
#pragma unroll
        for (int q = 0; q < 2; ++q) {
            const int T = (nb + 32 * q) >> 5;
            if (lat && (T % 3) == 2) rope32_16(v[2 * q], v[2 * q + 1], rowp, colp, g4);
        }
        stage_write16(st, v, mh, c15, g4);
        if (mh) stage_store_bf16(st, (bf16_t*)(ws + WS_QM) + (size_t)tok0 * 576 + nb, 576, QSC_MLA, lane);
    }
}
__device__ __forceinline__ void epi_plain(const Frame& F, GemmAcc& acc, bf16_t* D, int ldd, int row0, int n0) {
    int lane = F.lane; const int wn = F.w & 1, wm = F.w >> 1;
    asm volatile("" : "+v"(lane));
    const int c15 = lane & 15, g4 = lane >> 4;
    LAS float* st = (LAS float*)(F.lds + LDS_OST + F.w * OST_BYTES);
#pragma unroll
    for (int mt = 0; mt < 4; ++mt) {
        const int r0 = row0 + wm * 64 + (mt >> 1) * 32;
        stage_write16a(st, acc, mt, c15, g4);
        if (mt & 1) stage_store_bf16(st, D + (size_t)r0 * ldd + n0 + wn * 64, ldd, 1.f, lane);
    }
}

struct Gemm2Pre { f32x4 gt0, gt1, gs0, gs1; };
__device__ __forceinline__ void gemm2_pre(const Frame& F, int tn, int tm, int l, Gemm2Pre& P) {
    const bool lat = tm >= 16; const int cond = lat ? 1 + ((tm - 16) >> 2) : 0;
    const int nb = tn * 128 + (F.w & 1) * 64, c8 = (F.lane & 7) * 8;
    const float* gtp = (const float*)(F.ws + WS_MODS) + (size_t)(l * 5 + cond) * 3072 + 2048 + nb + c8;
    const float* gsp = (const float*)(F.ws + WS_GS) + (size_t)((l < 3 ? l + 1 : 3) * 5 + cond) * 1024 + nb + c8;
    P.gt0 = *(const f32x4*)gtp; P.gt1 = *(const f32x4*)(gtp + 4);
    P.gs0 = *(const f32x4*)gsp; P.gs1 = *(const f32x4*)(gsp + 4);
}
__device__ __forceinline__ void epi_gemm2(const Frame& F, const Params& p, GemmAcc& acc, int tn, int tm, int l, const Gemm2Pre& P, bool last) {
    int lane = F.lane; const int wn = F.w & 1, wm = F.w >> 1;
    asm volatile("" : "+v"(lane));
    const int c15 = lane & 15, g4 = lane >> 4;
    unsigned char* ws = F.ws;
    LAS float* st = (LAS float*)(F.lds + LDS_OST + F.w * OST_BYTES);
    const bool lat = tm >= 16;
    const int nb = tn * 128 + wn * 64;
    const int c8 = (lane & 7) * 8, r8 = lane >> 3;
#pragma unroll
    for (int mt = 0; mt < 2; ++mt) {
        const int tok0 = tm * 256 + wm * 64 + mt * 32;
        stage_write16a(st, acc, 2 * mt, c15, g4);
        stage_write16a(st, acc, 2 * mt + 1, c15, g4);
        bf16_t* xb0 = (bf16_t*)(ws + WS_XB) + (size_t)tok0 * 1024 + nb + c8;
        f32x4 xo8[8];
        if (l == 0) {
            const float* xold0 = lat ? pin(F, I_XS) + (size_t)(tok0 - 4096) * 1024 : pin(F, I_XP) + (size_t)tok0 * 1024;
#pragma unroll
            for (int it = 0; it < 4; ++it) {
                const float* xp = xold0 + (size_t)(it * 8 + r8) * 1024 + nb + c8;
                xo8[2 * it] = __builtin_nontemporal_load((const f32x4*)xp); xo8[2 * it + 1] = __builtin_nontemporal_load((const f32x4*)(xp + 4));
            }
        } else {
#pragma unroll
            for (int it = 0; it < 4; ++it) {
                const u32x4 q = *(const u32x4*)(xb0 + (size_t)(it * 8 + r8) * 1024);
                xo8[2 * it] = (f32x4){bflo(q.x), bfhi(q.x), bflo(q.y), bfhi(q.y)}; xo8[2 * it + 1] = (f32x4){bflo(q.z), bfhi(q.z), bflo(q.w), bfhi(q.w)};
            }
        }
#pragma unroll
        for (int it = 0; it < 4; ++it) {
            const int row = it * 8 + r8;
            const f32x4 a0 = *(const LAS f32x4*)(st + row * OST_LD + c8), a1 = *(const LAS f32x4*)(st + row * OST_LD + c8 + 4);
            const f32x4 xn0 = xo8[2 * it] + P.gt0 * a0, xn1 = xo8[2 * it + 1] + P.gt1 * a1;
            {
                u32x4 o; o.x = pk2(xn0[0], xn0[1]); o.y = pk2(xn0[2], xn0[3]); o.z = pk2(xn1[0], xn1[1]); o.w = pk2(xn1[2], xn1[3]);
                if (last) ST16_WT(xb0 + (size_t)row * 1024, o); else *(u32x4*)(xb0 + (size_t)row * 1024) = o;
            }
            float ss = ((xn0[0] * xn0[0] + xn0[1] * xn0[1]) + (xn0[2] * xn0[2] + xn0[3] * xn0[3])) + ((xn1[0] * xn1[0] + xn1[1] * xn1[1]) + (xn1[2] * xn1[2] + xn1[3] * xn1[3]));
            ss += __shfl_xor(ss, 1); ss += __shfl_xor(ss, 2); ss += __shfl_xor(ss, 4);
            if ((lane & 7) == 0) {
                float* sq = (float*)(ws + WS_SSQ) + (size_t)(tok0 + row) * 16 + tn * 2 + wn;
                __hip_atomic_store((__attribute__((address_space(1))) float*)sq, ss, __ATOMIC_RELAXED, __HIP_MEMORY_SCOPE_AGENT);
            }
            if (l < 3) {
                u32x4 o; o.x = pk2(xn0[0] * P.gs0[0], xn0[1] * P.gs0[1]); o.y = pk2(xn0[2] * P.gs0[2], xn0[3] * P.gs0[3]);
                o.z = pk2(xn1[0] * P.gs1[0], xn1[1] * P.gs1[1]); o.w = pk2(xn1[2] * P.gs1[2], xn1[3] * P.gs1[3]);
                ST16_WT((bf16_t*)(ws + WS_XG) + (size_t)(tok0 + row) * 1024 + nb + c8, o);
            }
        }
    }
}

__device__ __forceinline__ void epi_kpe(const Frame& F, const Params& p, GemmAcc2& acc, int tm, int l, const Gemm1Pre& P) {
    int lane = F.lane; const int wm = F.w >> 2;
    asm volatile("" : "+v"(lane));
    const int c15 = lane & 15, g4 = lane >> 4;
    unsigned char* ws = F.ws;
    asm volatile("" : "+s"(ws));
    float* outp = p.out;
    asm volatile("" : "+s"(outp));
    LAS float* st = (LAS float*)(F.lds + LDS_OST + F.w * OST_BYTES);
    const bool lat = tm >= 16;
    const int b = lat ? ((tm - 16) >> 2) : tm;
    LAS float* exb = (LAS float*)(F.lds + LDS_EXB) + F.w * 128;
    exb[lane] = P.bias;
    asm volatile("s_waitcnt lgkmcnt(0)" ::: "memory");
    __builtin_amdgcn_wave_barrier();
#pragma unroll
    for (int mt = 0; mt < 8; ++mt) {
        const int mh = mt & 1;
        const int tok0 = tm * 256 + wm * 128 + (mt >> 1) * 32;
        const int t0 = lat ? ((tok0 - 4096) & 1023) : (tok0 & 255), t = t0 + 16 * mh + c15;
        const float rstd = __shfl(P.rstd[mt >> 2], 16 * (mt & 3) + c15);
        float v[4][4];
#pragma unroll
        for (int nt = 0; nt < 2; ++nt) {
            const f32x4 bq = *(const LAS f32x4*)(exb + 16 * nt + 4 * g4);
#pragma unroll
            for (int i = 0; i < 4; ++i) { v[nt][i] = acc[nt][mt][i] * rstd + bq[i]; v[2 + nt][i] = 0.f; }
        }
        const float rowp = (float)(t >> 6), colp = (float)(t & 63);
        const size_t orow0 = (size_t)(b * 4 + l) * 256 + t0;
        if (lat) rope32_16(v[0], v[1], rowp, colp, g4);
        stage_write16(st, v, mh, c15, g4);
        if (mh) {
            if (!lat) stage_store_f32_32(st, outp + O_KPE + orow0 * 32, 32, lane);
            stage_store_bf16_32(st, (bf16_t*)(ws + WS_KPEB) + (size_t)tok0 * 32, 32, lane);
        }
    }
}
constexpr int AT_STG = 20480, AT_PE = 8192, AT_V = 12288, AT_OLD = 68;
struct AttnUnit {
    int mode;
    int nt0, nt1;
    const bf16_t *q; int q_ld;
    const bf16_t *k0, *k1; int k_ld0, k_ld1;
    const bf16_t *pe0, *pe1;
    const bf16_t *v0, *v1; int v_ld0, v_ld1;
    int tok0;
    int ycol;
    int qpos0, L;
    float lf, lb;
    const bf16_t *s0f, *s0b;
    unsigned* zflag;
    unsigned* yflag;
    float* st_out;
};
__device__ __forceinline__ s16x4 tr16(LAS const unsigned char* p) {
    typedef short v4i16_t __attribute__((ext_vector_type(4)));
    return __builtin_bit_cast(s16x4, __builtin_amdgcn_ds_read_tr16_b64_v4i16((LAS v4i16_t*)p));
}

template <int MODE>
__device__ __forceinline__ void attn_unit(const Frame& F, const Params& p, const AttnUnit& U) {
    constexpr int NQS = MODE == 1 ? 6 : 4;
    int lane = F.lane; const int w = F.w;
    asm volatile("" : "+v"(lane));
    const int h = lane >> 5, lq = lane & 31;
    LAS unsigned char* lds = F.lds;
    const int k_ld = U.k_ld1, v_ld = U.v_ld1;
    const int krow = 8 * w + (lane >> 3);
    const int koff = krow * k_ld + ((lane & 7) ^ ((krow >> 1) & 7)) * 8;
    const int poff = (16 * (w & 3) + (lane >> 2)) * 32 + ((lane & 3) ^ ((lane >> 4) & 3)) * 8;
    const int vdblk = w >> 2, vkg = w & 3;
    const int voff = (16 * vkg + (lane >> 2)) * v_ld + vdblk * 32 + (lane & 3) * 8;
    const int vdst = AT_V + vdblk * 4096 + vkg * 1024;
    const int nt0 = U.nt0, ntot = U.nt0 + U.nt1;
    const unsigned ldsb = (unsigned)(uintptr_t)lds;
#define AT_DMA(gsrc, ldsoff) do { unsigned _keep; const unsigned _d = (unsigned)__builtin_amdgcn_readfirstlane((int)(ldsb + (unsigned)(ldsoff))); \
        asm volatile("s_mov_b32 %0, m0\n\ts_mov_b32 m0, %2\n\ts_nop 0\n\tglobal_load_lds_dwordx4 %1, off\n\ts_mov_b32 m0, %0" : "=&s"(_keep) : "v"(gsrc), "s"(_d) : "memory"); } while (0)
#define AT_ISSUE(t, st) do { const int _t = (t); const int _b = (st) * AT_STG; \
        const bool _s0 = _t < nt0; const int _u = _s0 ? _t : _t - nt0; \
        const bf16_t* _kb = (_s0 ? U.k0 : U.k1) + (size_t)_u * 64 * k_ld; const bf16_t* _vb = (_s0 ? U.v0 : U.v1) + (size_t)_u * 64 * v_ld; \
        AT_DMA(_kb + koff, _b + (8 * w) * 128); \
        if (MODE == 1) { const bf16_t* _pb = (_s0 ? U.pe0 : U.pe1) + (size_t)_u * 64 * 32; AT_DMA(_pb + poff, _b + AT_PE + 16 * (w & 3) * 64); } \
        AT_DMA(_vb + voff, _b + vdst); } while (0)
    AT_ISSUE(0, 0);
    if (ntot > 1) AT_ISSUE(1, 1);
    bf16x8 qr[NQS];
    if (MODE == 3) {
        const int dk = 32 * (w & 1) + lq;
#pragma unroll
        for (int s = 0; s < 4; ++s)
#pragma unroll
            for (int j = 0; j < 8; ++j) qr[s][j] = (16 * s + 8 * h + j == dk) ? (short)0x3F80 : (short)0;
    } else {
        const bf16_t* qp = U.q + (size_t)(32 * w + lq) * U.q_ld + 8 * h;
#pragma unroll
        for (int s = 0; s < NQS; ++s) qr[s] = *(const bf16x8*)(qp + 16 * s);
    }
    f32x16 o[2];
#pragma unroll
    for (int d = 0; d < 2; ++d)
#pragma unroll
        for (int r = 0; r < 16; ++r) o[d][r] = 0.f;
    float m_run = 0.f, l_run = 0.f;
    f32x16 negm;
#pragma unroll
    for (int r = 0; r < 16; ++r) negm[r] = 0.f;
    const int qpos = U.qpos0 + 32 * w + lq;
    const float st_slope = ((w >> 1) & 1) ? U.lb : -U.lf, st_off = ((w >> 1) & 1) ? 0.f : 255.f * U.lf;
    const int sdir = (w >> 1) & 1;
    LAS float* scal = (LAS float*)(lds + LDS_SCAL) + w * 32;
    LAS float* ctab = (LAS float*)(lds + LDS_EXB) + w * 128;
    float a_f = 0.f, a_b = 0.f;
    if (MODE == 2) {
        ctab[lane] = __builtin_amdgcn_exp2f((float)(63 - lane) * U.lf);
        ctab[64 + lane] = __builtin_amdgcn_exp2f((float)lane * U.lb);
        a_f = __builtin_amdgcn_exp2f((float)(32 * w + lq) * U.lf);
        a_b = __builtin_amdgcn_exp2f((float)(255 - 32 * w - lq) * U.lb);
        asm volatile("s_waitcnt lgkmcnt(0)" ::: "memory");
        __builtin_amdgcn_wave_barrier();
    }
    const int kfo = lq * 128, sw = (lane >> 1) & 7, pfo = AT_PE + lq * 64, psw = (lane >> 2) & 3;
    const int vfo = AT_V + (4 * h + ((lane & 15) >> 2)) * 64 + ((lane >> 4) & 1) * 32 + (lane & 3) * 8;
    int st = 0;
    for (int t = 0; t < ntot; ++t) {
        if (t + 1 < ntot) { if (MODE == 1) asm volatile("s_waitcnt vmcnt(3)" ::: "memory"); else asm volatile("s_waitcnt vmcnt(2)" ::: "memory"); }
        else asm volatile("s_waitcnt vmcnt(0)" ::: "memory");
        __builtin_amdgcn_s_barrier();
        asm volatile("" ::: "memory");
        const int st2 = st == 0 ? 2 : st - 1;
        LAS const unsigned char* base = lds + st * AT_STG;
        bf16x8 kfa[NQS], kfb[NQS];
#pragma unroll
        for (int s = 0; s < 4; ++s) {
            const int so = ((2 * s + h) ^ sw) << 4;
            kfa[s] = *(const LAS bf16x8*)(base + kfo + so);
            kfb[s] = *(const LAS bf16x8*)(base + kfo + 4096 + so);
        }
        if (MODE == 1) {
#pragma unroll
            for (int s = 0; s < 2; ++s) {
                const int so = ((2 * s + h) ^ psw) << 4;
                kfa[4 + s] = *(const LAS bf16x8*)(base + pfo + so);
                kfb[4 + s] = *(const LAS bf16x8*)(base + pfo + 2048 + so);
            }
        }
        f32x16 p0, p1;
        if (MODE <= 1) { p0 = negm; p1 = negm; }
        else {
#pragma unroll
            for (int r = 0; r < 16; ++r) { p0[r] = 0.f; p1[r] = 0.f; }
        }
#pragma unroll
        for (int s = 0; s < NQS; ++s) { p0 = MFMA32(kfa[s], qr[s], p0); p1 = MFMA32(kfb[s], qr[s], p1); }
        s16x4 vlo[4], vhi[4];
#pragma unroll
        for (int ks = 0; ks < 4; ++ks) { vlo[ks] = tr16(base + vfo + ks * 1024); vhi[ks] = tr16(base + vfo + ks * 1024 + 512); }
        if (MODE <= 1) {
            float tm = p0[0];
#pragma unroll
            for (int r = 1; r < 16; ++r) tm = fmaxf(tm, p0[r]);
#pragma unroll
            for (int r = 0; r < 16; ++r) tm = fmaxf(tm, p1[r]);
            tm = fmaxf(tm, __shfl_xor(tm, 32));
            if (t == 0 || __any(tm > 6.0f)) {
                const float dl = t == 0 ? tm : fmaxf(tm, 0.f);
                m_run += dl;
#pragma unroll
                for (int r = 0; r < 16; ++r) { p0[r] -= dl; p1[r] -= dl; negm[r] = -m_run; }
                if (t > 0) {
                    const float alpha = __builtin_amdgcn_exp2f(-dl);
                    l_run *= alpha;
                    if (h == 0) scal[lq] = alpha;
                    asm volatile("s_waitcnt lgkmcnt(0)" ::: "memory");
#pragma unroll
                    for (int g = 0; g < 4; ++g) {
                        const f32x4 a4 = *(const LAS f32x4*)(scal + 8 * g + 4 * h);
#pragma unroll
                        for (int i = 0; i < 4; ++i) { o[0][4 * g + i] *= a4[i]; o[1][4 * g + i] *= a4[i]; }
                    }
                }
            }
            float ls = 0.f;
#pragma unroll
            for (int r = 0; r < 16; ++r) { p0[r] = __builtin_amdgcn_exp2f(p0[r]); p1[r] = __builtin_amdgcn_exp2f(p1[r]); ls += p0[r] + p1[r]; }
            l_run += ls;
        } else if (MODE == 2 && (64 * t + 63 < U.qpos0 || 64 * t > U.qpos0 + 255)) {
            const bool fwd = 64 * t + 63 < U.qpos0;
            const float A = fwd ? a_f * __builtin_amdgcn_exp2f((float)(U.qpos0 - 64 * t - 63) * U.lf) : a_b * __builtin_amdgcn_exp2f((float)(64 * t - U.qpos0 - 255) * U.lb);
            const LAS float* tb = ctab + (fwd ? 0 : 64) + 4 * h;
#pragma unroll
            for (int g = 0; g < 4; ++g) {
                const f32x4 c0 = *(const LAS f32x4*)(tb + 8 * g), c1 = *(const LAS f32x4*)(tb + 32 + 8 * g);
#pragma unroll
                for (int i = 0; i < 4; ++i) { p0[4 * g + i] *= c0[i] * A; p1[4 * g + i] *= c1[i] * A; }
            }
        } else if (MODE == 2) {
            float dq = (float)(qpos - 64 * t - 4 * h);
            asm volatile("" : "+v"(dq));
#pragma unroll
            for (int r = 0; r < 16; ++r) {
                const float d0 = dq - (float)((r & 3) + 8 * (r >> 2)), d1 = d0 - 32.f;
                const float w0 = __builtin_amdgcn_exp2f(fabsf(d0) * (d0 > 0.f ? U.lf : U.lb));
                const float w1 = __builtin_amdgcn_exp2f(fabsf(d1) * (d1 > 0.f ? U.lf : U.lb));
                p0[r] *= (d0 == 0.f ? 2.f : w0);
                p1[r] *= (d1 == 0.f ? 2.f : w1);
            }
        } else {
            float mb = (float)(64 * t + 4 * h);
            asm volatile("" : "+v"(mb));
#pragma unroll
            for (int r = 0; r < 16; ++r) {
                const float m0 = mb + (float)((r & 3) + 8 * (r >> 2)), m1 = m0 + 32.f;
                const float e0 = fmaf(m0, st_slope, st_off), e1 = fmaf(m1, st_slope, st_off);
                p0[r] *= __builtin_amdgcn_exp2f(e0);
                p1[r] *= __builtin_amdgcn_exp2f(e1);
            }
        }
        if (t + 2 < ntot) AT_ISSUE(t + 2, st2);
        bf16x8 pa[4];
        { u32x4 a;
          a.x = pk2(p0[0], p0[1]); a.y = pk2(p0[2], p0[3]); a.z = pk2(p0[4], p0[5]); a.w = pk2(p0[6], p0[7]); pa[0] = __builtin_bit_cast(bf16x8, a);
          a.x = pk2(p0[8], p0[9]); a.y = pk2(p0[10], p0[11]); a.z = pk2(p0[12], p0[13]); a.w = pk2(p0[14], p0[15]); pa[1] = __builtin_bit_cast(bf16x8, a);
          a.x = pk2(p1[0], p1[1]); a.y = pk2(p1[2], p1[3]); a.z = pk2(p1[4], p1[5]); a.w = pk2(p1[6], p1[7]); pa[2] = __builtin_bit_cast(bf16x8, a);
          a.x = pk2(p1[8], p1[9]); a.y = pk2(p1[10], p1[11]); a.z = pk2(p1[12], p1[13]); a.w = pk2(p1[14], p1[15]); pa[3] = __builtin_bit_cast(bf16x8, a); }
#pragma unroll
        for (int ks = 0; ks < 4; ++ks) {
            const bf16x8 vb = __builtin_shufflevector(vlo[ks], vhi[ks], 0, 1, 2, 3, 4, 5, 6, 7);
            o[0] = MFMA32(pa[ks], vb, o[0]);
        }
#pragma unroll
        for (int ks = 0; ks < 4; ++ks) { vlo[ks] = tr16(base + vfo + 4096 + ks * 1024); vhi[ks] = tr16(base + vfo + 4096 + ks * 1024 + 512); }
#pragma unroll
        for (int ks = 0; ks < 4; ++ks) {
            const bf16x8 vb = __builtin_shufflevector(vlo[ks], vhi[ks], 0, 1, 2, 3, 4, 5, 6, 7);
            o[1] = MFMA32(pa[ks], vb, o[1]);
        }
        st = st == 2 ? 0 : st + 1;
    }
#undef AT_ISSUE
#undef AT_DMA
    int lq2 = lq, h2 = h, lane2 = lane; asm volatile("" : "+v"(lq2), "+v"(h2), "+v"(lane2));
    if (MODE == 2 && U.s0f != nullptr) {
        const float ff = __builtin_amdgcn_exp2f((float)(qpos + 1) * U.lf), fb = __builtin_amdgcn_exp2f((float)(U.L - qpos) * U.lb);
#pragma unroll
        for (int s = 0; s < 4; ++s) {
            const u32x4 qu = __builtin_bit_cast(u32x4, qr[s]);
            u32x4 af, ab;
#pragma unroll
            for (int i = 0; i < 4; ++i) { const float lo = bflo(qu[i]), hi = bfhi(qu[i]); af[i] = pk2(lo * ff, hi * ff); ab[i] = pk2(lo * fb, hi * fb); }
#pragma unroll
            for (int d = 0; d < 2; ++d) {
                const bf16x8 sf = *(const bf16x8*)(U.s0f + (size_t)(32 * d + lq2) * 64 + 16 * s + 8 * h2);
                const bf16x8 sb = *(const bf16x8*)(U.s0b + (size_t)(32 * d + lq2) * 64 + 16 * s + 8 * h2);
                o[d] = MFMA32(__builtin_bit_cast(bf16x8, af), sf, o[d]);
                o[d] = MFMA32(__builtin_bit_cast(bf16x8, ab), sb, o[d]);
            }
        }
    }
    if (MODE == 3) {
        float* dst = U.st_out + (size_t)sdir * 4 * 4096 + (size_t)(32 * (w & 1)) * 64;
        if (w < 4) {
#pragma unroll
        for (int d = 0; d < 2; ++d)
#pragma unroll
            for (int r = 0; r < 16; ++r) dst[(size_t)((r & 3) + 8 * (r >> 2) + 4 * h2) * 64 + 32 * d + lq2] = o[d][r];
        }
        __syncthreads();
        if (F.tid == 0 && U.yflag != nullptr) (void)xb_add(U.yflag, 1u);
        return;
    }
    if (MODE <= 1) {
        l_run += __shfl_xor(l_run, 32);
        if (h2 == 0) scal[lq2] = 1.f / l_run;
    }
    if (U.zflag != nullptr && F.tid == 0) {
        unsigned* bar0 = (unsigned*)(F.ws + WS_CTL) + CW_BAR;
        XB_SPIN(xb_ld(U.zflag) < 4u, bar0);
    }
    __syncthreads();
    LAS float* ost = (LAS float*)lds + w * (32 * AT_OLD);
#pragma unroll
    for (int d = 0; d < 2; ++d)
#pragma unroll
        for (int r = 0; r < 16; ++r) ost[((r & 3) + 8 * (r >> 2) + 4 * h2) * AT_OLD + 32 * d + lq2] = o[d][r];
    asm volatile("s_waitcnt lgkmcnt(0)" ::: "memory");
    __builtin_amdgcn_wave_barrier();
    const bf16_t* zs = (const bf16_t*)(F.ws + WS_ZS);
    bf16_t* yb = (bf16_t*)(F.ws + WS_Y);
#pragma unroll
    for (int it = 0; it < 4; ++it) {
        const int row = it * 8 + (lane2 >> 3), c8 = (lane2 & 7) * 8;
        const f32x4 x0 = *(const LAS f32x4*)(ost + row * AT_OLD + c8), x1 = *(const LAS f32x4*)(ost + row * AT_OLD + c8 + 4);
        float sc;
        if (MODE <= 1) sc = scal[row];
        else {
            float ss = (x0[0] * x0[0] + x0[1] * x0[1]) + (x0[2] * x0[2] + x0[3] * x0[3]) + (x1[0] * x1[0] + x1[1] * x1[1]) + (x1[2] * x1[2] + x1[3] * x1[3]);
            ss += __shfl_xor(ss, 1); ss += __shfl_xor(ss, 2); ss += __shfl_xor(ss, 4);
            sc = rsqrtf(ss * (1.f / 64.f) + EPS);
        }
        const size_t off = (size_t)(U.tok0 + 32 * w + row) * 1024 + U.ycol + c8;
        const u32x4 z = *(const u32x4*)(zs + off);
        u32x4 y;
        y.x = pk2(x0[0] * sc * bflo(z.x), x0[1] * sc * bfhi(z.x));
        y.y = pk2(x0[2] * sc * bflo(z.y), x0[3] * sc * bfhi(z.y));
        y.z = pk2(x1[0] * sc * bflo(z.z), x1[1] * sc * bfhi(z.z));
        y.w = pk2(x1[2] * sc * bflo(z.w), x1[3] * sc * bfhi(z.w));
        ST16_WT(yb + off, y);
    }
    asm volatile("s_waitcnt vmcnt(0)" ::: "memory");
    __syncthreads();
    if (F.tid == 0) (void)xb_add(U.yflag, 1u);
}

__device__ __forceinline__ void dep_wait(const Frame& F, unsigned* c, int n, unsigned target, unsigned* c2 = nullptr, unsigned target2 = 0u) {
    if (F.w == 0) {
        const int ln = lane_id();
        unsigned* ptr = c + 4 * ln; unsigned tgt = target;
        if (c2 != nullptr && ln == n) { ptr = c2; tgt = target2; }
        poll_lanes(ptr, tgt, ln < n + (c2 != nullptr ? 1 : 0), (unsigned*)(F.ws + WS_CTL) + CW_BAR);
    }
}
__device__ __forceinline__ void attn_dispatch(const Frame& F, const Params& p, int u, int l) {
    unsigned char* ws = F.ws;
    AttnUnit U;
    U.nt0 = 0; U.nt1 = 0; U.q = nullptr; U.q_ld = 0; U.k0 = U.k1 = nullptr; U.k_ld0 = U.k_ld1 = 0; U.pe0 = U.pe1 = nullptr; U.v0 = U.v1 = nullptr; U.v_ld0 = U.v_ld1 = 0;
    U.tok0 = 0; U.ycol = 0; U.qpos0 = 0; U.L = 0; U.lf = U.lb = 0.f; U.s0f = U.s0b = nullptr; U.st_out = nullptr; U.mode = 0; U.yflag = nullptr; U.zflag = nullptr;
    const bf16_t* GQ = (const bf16_t*)(ws + WS_GQ); const bf16_t* GK = (const bf16_t*)(ws + WS_GK); const bf16_t* GV = (const bf16_t*)(ws + WS_GV);
    const bf16_t* QM = (const bf16_t*)(ws + WS_QM); const bf16_t* KVM = (const bf16_t*)(ws + WS_KVM); const bf16_t* KVMC = (const bf16_t*)(ws + WS_KVMC);
    const bf16_t* KPEB = (const bf16_t*)(ws + WS_KPEB); const bf16_t* CKPE = (const bf16_t*)(ws + WS_CKPE);
    const bf16_t* CGK = (const bf16_t*)(ws + WS_CGK); const bf16_t* CGV = (const bf16_t*)(ws + WS_CGV);
    const bf16_t* RQ = (const bf16_t*)(ws + WS_RQ); const bf16_t* RK = (const bf16_t*)(ws + WS_RK); const bf16_t* RV = (const bf16_t*)(ws + WS_RV);
    const float* decay = pin(F, I_DECAY) + l * 8;
    if (u < 96 || (u >= 256 && u < 352)) {
        const bool lat = u < 96; const int uu = lat ? u : u - 256;
        const int b = lat ? uu / 24 : uu / 6, hh = lat ? (uu >> 2) % 6 : uu % 6, qb = lat ? (uu & 3) : 0;
        const int seq0 = lat ? 4096 + b * 1024 : b * 256;
        U.mode = 1; U.tok0 = seq0 + qb * 256; U.q = QM + (size_t)U.tok0 * 576 + hh * 96; U.q_ld = 576; U.ycol = 640 + hh * 64;
        U.nt1 = lat ? 16 : 4; U.k1 = KVM + (size_t)seq0 * 768 + hh * 128; U.k_ld1 = 768; U.v1 = U.k1 + 64; U.v_ld1 = 768; U.pe1 = KPEB + (size_t)seq0 * 32;
        U.k0 = U.k1; U.v0 = U.v1; U.pe0 = U.pe1; U.k_ld0 = 768; U.v_ld0 = 768;
        if (lat) { U.nt0 = 8; U.k0 = KVMC + (size_t)(b * 512) * 768 + hh * 128; U.v0 = U.k0 + 64; U.pe0 = CKPE + (size_t)((b * 4 + l) * 512) * 32; }
        U.yflag = (unsigned*)(ws + WS_CTL) + CW_YRDY + (l * 32 + (U.tok0 >> 8)) * 4;
        { unsigned* c = (unsigned*)(ws + WS_CTL);
          dep_wait(F, c + CW_FULL + (l * 32 + (seq0 >> 8)) * 4, lat ? 4 : 1, 23u, lat ? c + CW_KC + (l * 4 + b) * 4 : nullptr, 12u); }
        __syncthreads();
        attn_unit<1>(F, p, U);
    } else if (u < 192 || (u >= 352 && u < 448)) {
        const bool lat = u < 192; const int uu = lat ? u - 96 : u - 352;
        const int b = lat ? uu / 24 : uu / 6, hh = lat ? (uu >> 2) % 6 : uu % 6, qb = lat ? (uu & 3) : 0, kvh = hh / 3;
        const int seq0 = lat ? 4096 + b * 1024 : b * 256;
        U.mode = 0; U.tok0 = seq0 + qb * 256; U.q = GQ + (size_t)U.tok0 * 384 + hh * 64; U.q_ld = 384; U.ycol = 256 + hh * 64;
        U.nt1 = lat ? 16 : 4; U.k1 = GK + (size_t)seq0 * 128 + kvh * 64; U.k_ld1 = 128; U.v1 = GV + (size_t)seq0 * 128 + kvh * 64; U.v_ld1 = 128;
        U.k0 = U.k1; U.v0 = U.v1; U.k_ld0 = 128; U.v_ld0 = 128;
        if (lat) { U.nt0 = 8; U.k0 = CGK + (size_t)((b * 4 + l) * 512) * 128 + kvh * 64; U.v0 = CGV + (size_t)((b * 4 + l) * 512) * 128 + kvh * 64; }
        U.yflag = (unsigned*)(ws + WS_CTL) + CW_YRDY + (l * 32 + (U.tok0 >> 8)) * 4;
        { unsigned* c = (unsigned*)(ws + WS_CTL);
          dep_wait(F, c + CW_RA + (l * 32 + (seq0 >> 8)) * 4, lat ? 4 : 1, 8u);
          U.zflag = c + CW_ZC + (l * 32 + (U.tok0 >> 8)) * 4; }
        __syncthreads();
        attn_unit<0>(F, p, U);
    } else if (u < 256 || (u >= 448 && u < 512)) {
        const bool lat = u < 256; const int uu = lat ? u - 192 : u - 448;
        const int b = lat ? uu / 16 : uu / 4, hh = lat ? (uu >> 2) & 3 : uu & 3, qb = lat ? (uu & 3) : 0;
        const int seq0 = lat ? 4096 + b * 1024 : b * 256;
        U.mode = 2; U.tok0 = seq0 + qb * 256; U.q = RQ + (size_t)U.tok0 * 256 + hh * 64; U.q_ld = 256; U.ycol = hh * 64;
        U.nt1 = lat ? 16 : 4; U.k1 = RK + (size_t)seq0 * 256 + hh * 64; U.k_ld1 = 256; U.v1 = RV + (size_t)seq0 * 256 + hh * 64; U.v_ld1 = 256;
        U.k0 = U.k1; U.v0 = U.v1; U.k_ld0 = 256; U.v_ld0 = 256;
        U.qpos0 = qb * 256; U.L = lat ? 1024 : 256;
        U.lf = -log1pf(__expf(-decay[hh])) * LOG2E; U.lb = -log1pf(__expf(-decay[4 + hh])) * LOG2E;
        if (lat) { const bf16_t* S0T = (const bf16_t*)(ws + WS_S0T); U.s0f = S0T + (size_t)(((b * 4 + l) * 2 + 0) * 4 + hh) * 4096; U.s0b = S0T + (size_t)(((b * 4 + l) * 2 + 1) * 4 + hh) * 4096; }
        U.yflag = (unsigned*)(ws + WS_CTL) + CW_YRDY + (l * 32 + (U.tok0 >> 8)) * 4;
        { unsigned* c = (unsigned*)(ws + WS_CTL);
          dep_wait(F, c + CW_RA + (l * 32 + (seq0 >> 8)) * 4, lat ? 4 : 1, 8u);
          U.zflag = c + CW_ZC + (l * 32 + (U.tok0 >> 8)) * 4; }
        __syncthreads();
        attn_unit<2>(F, p, U);
    } else {
        const int uu = u - 512, b = uu >> 2, hh = uu & 3, seq0 = b * 256;
        U.mode = 3; U.nt1 = 4; U.k1 = RK + (size_t)seq0 * 256 + hh * 64; U.k_ld1 = 256; U.v1 = RV + (size_t)seq0 * 256 + hh * 64; U.v_ld1 = 256;
        U.k0 = U.k1; U.v0 = U.v1; U.k_ld0 = 256; U.v_ld0 = 256;
        U.lf = -log1pf(__expf(-decay[hh])) * LOG2E; U.lb = -log1pf(__expf(-decay[4 + hh])) * LOG2E;
        U.st_out = p.out + O_STATE + (size_t)(((b * 4 + l) * 2 + 0) * 4 + hh) * 4096;
        dep_wait(F, (unsigned*)(ws + WS_CTL) + CW_RA + (l * 32 + b) * 4, 1, 8u);
        U.yflag = (unsigned*)(ws + WS_CTL) + CW_SD + (l * 16 + b) * 4;
        __syncthreads();
        attn_unit<3>(F, p, U);
    }
}
constexpr int N_ATTN_UNITS = 576;
struct TItem { const float* src; bf16_t* dst; int nsrc, K; int valid; };
constexpr int P0_TWIN = 4 * 16 * 92, P0_TWOUT = 4 * 16 * 32, P0_TWUQ = 4 * 4 * 20, P0_TWUKV = 4 * 2 * 24, P0_TR = P0_TWIN + P0_TWOUT + P0_TWUQ + P0_TWUKV;
__device__ __forceinline__ TItem p0_titem(const Frame& F, unsigned char* ws, int it) {
    TItem t; t.valid = it < P0_TR; t.src = nullptr; t.dst = nullptr; t.nsrc = 0; t.K = 0;
    if (!t.valid) return t;
    if (it < P0_TWIN) {
        const int l = it / (16 * 92), r = it % (16 * 92), kb = r / 92, nb = r % 92, n0 = nb * 32;
        const int src = n0 < 1792 ? n0 : (n0 < 2816 ? n0 + 32 : (n0 < 2848 ? n0 - 2816 + 1792 : -1));
        t.nsrc = 2848; t.K = 1024;
        if (src >= 0) t.src = pin(F, I_WIN) + (size_t)l * 1024 * 2848 + (size_t)(kb * 64) * 2848 + src;
        t.dst = (bf16_t*)(ws + WS_WIN) + ((size_t)l * 2944 + n0) * 1024 + kb * 64;
        return t;
    }
    it -= P0_TWIN;
    if (it < P0_TWOUT) {
        const int l = it / 512, r = it % 512, kb = r >> 5, nb = r & 31;
        t.nsrc = 1024; t.K = 1024; t.src = pin(F, I_WOUT) + (size_t)l * 1024 * 1024 + (size_t)(kb * 64) * 1024 + nb * 32;
        t.dst = (bf16_t*)(ws + WS_WOUT) + ((size_t)l * 1024 + nb * 32) * 1024 + kb * 64;
        return t;
    }
    it -= P0_TWOUT;
    if (it < P0_TWUQ) {
        const int l = it / 80, r = it % 80, kb = r / 20, nb = r % 20;
        t.nsrc = 576; t.K = 256; if (nb < 18) t.src = pin(F, I_WUQ) + (size_t)l * 256 * 576 + (size_t)(kb * 64) * 576 + nb * 32;
        t.dst = (bf16_t*)(ws + WS_WUQ) + ((size_t)l * 640 + nb * 32) * 256 + kb * 64;
        return t;
    }
    it -= P0_TWUQ;
    { const int l = it / 48, r = it % 48, kb = r / 24, nb = r % 24;
      t.nsrc = 768; t.K = 128; t.src = pin(F, I_WUKV) + (size_t)l * 128 * 768 + (size_t)(kb * 64) * 768 + nb * 32;
      t.dst = (bf16_t*)(ws + WS_WUKV) + ((size_t)l * 768 + nb * 32) * 128 + kb * 64; }
    return t;
}
__device__ __forceinline__ void p0_tload(const TItem& t, float (&r)[32], int lane) {
    if (t.valid && t.src) {
        const float* wp = t.src + (size_t)(lane >> 5) * t.nsrc + (lane & 31);
#pragma unroll
        for (int i = 0; i < 32; ++i) r[i] = __builtin_nontemporal_load(wp + (size_t)(2 * i) * t.nsrc);
    } else {
#pragma unroll
        for (int i = 0; i < 32; ++i) r[i] = 0.f;
    }
}
__device__ __forceinline__ void p0_tstore(const TItem& t, const float (&r)[32], LAS float* scr, int lane) {
    if (!t.valid) return;
#pragma unroll
    for (int i = 0; i < 32; ++i) scr[(2 * i + (lane >> 5)) * 33 + (lane & 31)] = r[i];
    asm volatile("s_waitcnt lgkmcnt(0)" ::: "memory");
    __builtin_amdgcn_wave_barrier();
    const int c = lane & 7;
#pragma unroll
    for (int j = 0; j < 4; ++j) {
        const int n = (lane >> 3) + 8 * j; const LAS float* s = scr + (8 * c) * 33 + n;
        u32x4 o; o.x = pk2(s[0 * 33], s[1 * 33]); o.y = pk2(s[2 * 33], s[3 * 33]); o.z = pk2(s[4 * 33], s[5 * 33]); o.w = pk2(s[6 * 33], s[7 * 33]);
        ST16_WT(t.dst + (size_t)n * t.K + 8 * c, o);
    }
    asm volatile("s_waitcnt lgkmcnt(0)" ::: "memory");
    __builtin_amdgcn_wave_barrier();
}
__device__ __forceinline__ void cast8(const float* src, bf16_t* dst, size_t e) {
    const f32x4 a = __builtin_nontemporal_load((const f32x4*)(src + e)), b = __builtin_nontemporal_load((const f32x4*)(src + e + 4));
    u32x4 o; o.x = pk2(a[0], a[1]); o.y = pk2(a[2], a[3]); o.z = pk2(b[0], b[1]); o.w = pk2(b[2], b[3]);
    ST16_WT(dst + e, o);
}
constexpr int P0_MODS = 1536, P0_CAST_G = 512, P0_CAST_KPE = 128, P0_S0T = 512;
constexpr int P0_TOTAL = P0_MODS + 3 * P0_CAST_G + P0_CAST_KPE + P0_S0T;
__device__ __forceinline__ void phase0(const Frame& F, const Params& p, bool dup = false) {
    unsigned char* ws = F.ws + (dup ? 162 * MiB : 0); const int lane = F.lane;
    LAS float* scr = (LAS float*)F.lds + F.w * (64 * 33);
    const int gw = blockIdx.x * NWAVE + F.w, ngw = gridDim.x * NWAVE;
#ifndef MK_DUP0
#define MK_DUP0_ 0
#else
#define MK_DUP0_ MK_DUP0
#endif
    if (!(dup && MK_DUP0_ == 2))
    for (int it = gw; it < P0_TR; it += 2 * ngw) {
        const TItem t0 = p0_titem(F, ws, it), t1 = p0_titem(F, ws, it + ngw);
        float r0[32], r1[32];
        p0_tload(t0, r0, lane); p0_tload(t1, r1, lane);
        p0_tstore(t0, r0, scr, lane); p0_tstore(t1, r1, scr, lane);
    }
    if (!(dup && MK_DUP0_ == 1))
    for (int it0 = (gw + ngw - 256) % ngw; it0 < P0_TOTAL; it0 += ngw) {
        int it = it0;
        if (it < P0_MODS) {
            const int l = it / 384, cg = (it % 384) >> 5, ks = it & 31;
            const int j = cg * 256 + lane * 4;
            const float* wp = pin(F, I_WADA) + ((size_t)l * 1024 + ks * 32) * 3072 + j;
            const float* c = pin(F, I_C); const float* cc = pin(F, I_CCTX);
            float sv[3];
#pragma unroll
            for (int q = 0; q < 3; ++q) {
                const int idx = q * 64 + lane, n = idx >> 5, k = idx & 31;
                float x = 0.f;
                if (idx < 160) x = (n == 0) ? cc[ks * 32 + k] : c[(n - 1) * 1024 + ks * 32 + k];
                sv[q] = silu_f(x);
            }
            f32x4 acc[5];
#pragma unroll
            for (int n = 0; n < 5; ++n) acc[n] = (f32x4){0.f, 0.f, 0.f, 0.f};
#pragma unroll 1
            for (int k0 = 0; k0 < 32; k0 += 16) {
                f32x4 wv[16];
#pragma unroll
                for (int k = 0; k < 16; ++k) wv[k] = __builtin_nontemporal_load((const f32x4*)(wp + (size_t)(k0 + k) * 3072));
                __builtin_amdgcn_sched_barrier(0);
#pragma unroll
                for (int k = 0; k < 16; ++k)
#pragma unroll
                    for (int n = 0; n < 5; ++n) {
                        const float s = __int_as_float(__builtin_amdgcn_readlane(__float_as_int(sv[n >> 1]), 32 * (n & 1) + k0 + k));
                        acc[n] += wv[k] * s;
                    }
            }
            LAS f32x4* red = (LAS f32x4*)(F.lds + 69632);
#pragma unroll
            for (int n = 0; n < 5; ++n) red[(F.w * 5 + n) * 64 + lane] = acc[n];
            __syncthreads();
            if (F.tid < 320) {
                const int n = F.tid >> 6;
                f32x4 s = red[n * 64 + lane];
#pragma unroll
                for (int ww = 1; ww < 8; ++ww) s += red[(ww * 5 + n) * 64 + lane];
                if ((ks >> 3) == 0) s += *(const f32x4*)(pin(F, I_BADA) + l * 3072 + j);
                float* mods = (float*)(ws + WS_MODS) + (size_t)(l * 5 + n) * 3072 + j;
#pragma unroll
                for (int e = 0; e < 4; ++e) atomicAdd(mods + e, s[e]);
            }
            __syncthreads();
            continue;
        }
        it -= P0_MODS;
        if (it < 3 * P0_CAST_G) {
            const int which = it / P0_CAST_G, r = it % P0_CAST_G;
            const float* src = which == 0 ? pin(F, I_CGK) : (which == 1 ? pin(F, I_CGV) : pin(F, I_CCKV));
            bf16_t* dst = (bf16_t*)(ws + (which == 0 ? WS_CGK : (which == 1 ? WS_CGV : WS_CCKV)));
#pragma unroll
            for (int q = 0; q < 4; ++q) cast8(src, dst, (size_t)r * 2048 + q * 512 + lane * 8);
            continue;
        }
        it -= 3 * P0_CAST_G;
        if (it < P0_CAST_KPE) {
#pragma unroll
            for (int q = 0; q < 4; ++q) cast8(pin(F, I_CKPE), (bf16_t*)(ws + WS_CKPE), (size_t)it * 2048 + q * 512 + lane * 8);
            continue; }
        it -= P0_CAST_KPE;
        {
            const int mat = it >> 2, qd = it & 3, dv = qd * 16 + (lane >> 2), dk0 = (lane & 3) * 16;
            const float* s = pin(F, I_STATE) + (size_t)mat * 4096 + dv;
            float x[16];
#pragma unroll
            for (int i = 0; i < 16; ++i) x[i] = __builtin_nontemporal_load(s + (dk0 + i) * 64);
            u32x4 o0, o1;
            o0.x = pk2(x[0], x[1]); o0.y = pk2(x[2], x[3]); o0.z = pk2(x[4], x[5]); o0.w = pk2(x[6], x[7]);
            o1.x = pk2(x[8], x[9]); o1.y = pk2(x[10], x[11]); o1.z = pk2(x[12], x[13]); o1.w = pk2(x[14], x[15]);
            bf16_t* d = (bf16_t*)(ws + WS_S0T) + (size_t)mat * 4096 + dv * 64 + dk0;
            ST16_WT(d, o0); ST16_WT(d + 8, o1);
        }
    }
}
constexpr int P1_GS = 80, P1_BIAS = 4 * 368, P1_X = 8192, P1_TOTAL = P1_GS + P1_BIAS + P1_X;
__device__ __forceinline__ void xg_row(const Frame& F, const float* xrow, const float* g, const float* mods_c, bf16_t* xg_row_out, float* ssq_row, bool write_xg) {
    const int lane = F.lane;
    float ss = 0.f;
#pragma unroll
    for (int j = 0; j < 2; ++j) {
        const int k = j * 512 + lane * 8;
        const f32x4 x0 = *(const f32x4*)(xrow + k), x1 = *(const f32x4*)(xrow + k + 4);
        ss += ((x0[0] * x0[0] + x0[1] * x0[1]) + (x0[2] * x0[2] + x0[3] * x0[3])) + ((x1[0] * x1[0] + x1[1] * x1[1]) + (x1[2] * x1[2] + x1[3] * x1[3]));
        if (write_xg) {
            const f32x4 g0 = *(const f32x4*)(g + k), g1 = *(const f32x4*)(g + k + 4), s0 = *(const f32x4*)(mods_c + 1024 + k), s1 = *(const f32x4*)(mods_c + 1024 + k + 4);
            u32x4 o; o.x = pk2(x0[0] * g0[0] * (1.f + s0[0]), x0[1] * g0[1] * (1.f + s0[1])); o.y = pk2(x0[2] * g0[2] * (1.f + s0[2]), x0[3] * g0[3] * (1.f + s0[3]));
            o.z = pk2(x1[0] * g1[0] * (1.f + s1[0]), x1[1] * g1[1] * (1.f + s1[1])); o.w = pk2(x1[2] * g1[2] * (1.f + s1[2]), x1[3] * g1[3] * (1.f + s1[3]));
            ST16_WT(xg_row_out + k, o);
        }
    }
    ss = wsum(ss);
    if (lane < 16) ssq_row[lane] = lane == 0 ? ss : 0.f;
}
__device__ __forceinline__ void phase1(const Frame& F, const Params& p) {
    unsigned char* ws = F.ws; const int lane = F.lane;
    unsigned* ctl = (unsigned*)(ws + WS_CTL);
    const int gw = blockIdx.x * NWAVE + F.w, ngw = gridDim.x * NWAVE;
    const float* mods = (const float*)(ws + WS_MODS);
    for (int it0 = gw; it0 < P1_GS + P1_BIAS; it0 += ngw) {
        int it = it0;
        if (it < P1_GS) {
            const int e = it * 256 + lane * 4, lc = e >> 10, k = e & 1023, l = lc / 5;
            const f32x4 g = *(const f32x4*)(pin(F, I_NORMG) + l * 1024 + k), sc = *(const f32x4*)(mods + (size_t)lc * 3072 + 1024 + k);
            { const f32x4 o = g * (sc + 1.f); ST16_WT((float*)(ws + WS_GS) + e, o); }
            continue;
        }
        it -= P1_GS;
        {
            const int l = it / 368, n0 = (it % 368) * 8;
            f32x4 sh[5][4];
#pragma unroll
            for (int c = 0; c < 5; ++c) {
                const float* shp = mods + (size_t)(l * 5 + c) * 3072 + lane * 16;
#pragma unroll
                for (int i = 0; i < 4; ++i) sh[c][i] = *(const f32x4*)(shp + 4 * i);
            }
            const bf16_t* wr0 = (const bf16_t*)(ws + WS_WIN) + ((size_t)l * 2944 + n0) * 1024 + lane * 16;
            u32x4 w0[8], w1[8];
#pragma unroll
            for (int r = 0; r < 8; ++r) { w0[r] = *(const u32x4*)(wr0 + (size_t)r * 1024); w1[r] = *(const u32x4*)(wr0 + (size_t)r * 1024 + 8); }
#pragma unroll
            for (int r = 0; r < 8; ++r) {
                float wv[16];
#pragma unroll
                for (int i = 0; i < 4; ++i) { wv[2 * i] = bflo(w0[r][i]); wv[2 * i + 1] = bfhi(w0[r][i]); wv[8 + 2 * i] = bflo(w1[r][i]); wv[8 + 2 * i + 1] = bfhi(w1[r][i]); }
#pragma unroll
                for (int c = 0; c < 5; ++c) {
                    float d = 0.f;
#pragma unroll
                    for (int i = 0; i < 4; ++i) { const f32x4 s4 = sh[c][i]; d += (s4[0] * wv[4 * i] + s4[1] * wv[4 * i + 1]) + (s4[2] * wv[4 * i + 2] + s4[3] * wv[4 * i + 3]); }
                    d = wsum(d);
                    if (lane == 0) __hip_atomic_store((__attribute__((address_space(1))) float*)((float*)(ws + WS_BIAS) + (size_t)(l * 5 + c) * 2944 + n0 + r), d, __ATOMIC_RELAXED, __HIP_MEMORY_SCOPE_AGENT);
                }
            }
            if (l == 0) {
                asm volatile("s_waitcnt vmcnt(0)" ::: "memory");
                if (lane == 0) (void)xb_add(ctl + CW_P1B0, 1u);
            }
        }
    }
    for (int vb = blockIdx.x; vb < 256; vb += gridDim.x) {
        const int tm = vb & 31, part = vb >> 5;
        const bool lat = tm >= 16;
        const int cond = lat ? 1 + ((tm - 16) >> 2) : 0;
        const float* g = pin(F, I_NORMG); const float* sc = mods + (size_t)cond * 3072 + 1024;
#pragma unroll 1
        for (int i = 0; i < 4; i += 2) {
            const int tok = tm * 256 + part * 32 + F.w * 4 + i;
            const float* xa = lat ? pin(F, I_XS) + (size_t)(tok - 4096) * 1024 : pin(F, I_XP) + (size_t)tok * 1024;
            const float* xb = xa + 1024;
            bf16_t* oa = (bf16_t*)(ws + WS_XG) + (size_t)tok * 1024;
            float ssa = 0.f, ssb = 0.f;
#pragma unroll
            for (int j = 0; j < 2; ++j) {
                const int k = j * 512 + lane * 8;
                const f32x4 a0 = *(const f32x4*)(xa + k), a1 = *(const f32x4*)(xa + k + 4), b0 = *(const f32x4*)(xb + k), b1 = *(const f32x4*)(xb + k + 4);
                const f32x4 g0 = *(const f32x4*)(g + k), g1 = *(const f32x4*)(g + k + 4), s0 = *(const f32x4*)(sc + k), s1 = *(const f32x4*)(sc + k + 4);
                const f32x4 m0 = g0 * (s0 + 1.f), m1 = g1 * (s1 + 1.f);
                ssa += ((a0[0] * a0[0] + a0[1] * a0[1]) + (a0[2] * a0[2] + a0[3] * a0[3])) + ((a1[0] * a1[0] + a1[1] * a1[1]) + (a1[2] * a1[2] + a1[3] * a1[3]));
                ssb += ((b0[0] * b0[0] + b0[1] * b0[1]) + (b0[2] * b0[2] + b0[3] * b0[3])) + ((b1[0] * b1[0] + b1[1] * b1[1]) + (b1[2] * b1[2] + b1[3] * b1[3]));
                u32x4 o; o.x = pk2(a0[0] * m0[0], a0[1] * m0[1]); o.y = pk2(a0[2] * m0[2], a0[3] * m0[3]); o.z = pk2(a1[0] * m1[0], a1[1] * m1[1]); o.w = pk2(a1[2] * m1[2], a1[3] * m1[3]);
                ST16_WT(oa + k, o);
                o.x = pk2(b0[0] * m0[0], b0[1] * m0[1]); o.y = pk2(b0[2] * m0[2], b0[3] * m0[3]); o.z = pk2(b1[0] * m1[0], b1[1] * m1[1]); o.w = pk2(b1[2] * m1[2], b1[3] * m1[3]);
                ST16_WT(oa + 1024 + k, o);
            }
            ssa = wsum(ssa); ssb = wsum(ssb);
            if (lane < 32) {
                const float v = (lane & 15) == 0 ? (lane < 16 ? ssa : ssb) : 0.f;
                __hip_atomic_store((__attribute__((address_space(1))) float*)((float*)(ws + WS_SSQ) + (size_t)(tok + (lane >> 4)) * 16 + (lane & 15)), v, __ATOMIC_RELAXED, __HIP_MEMORY_SCOPE_AGENT);
            }
        }
        asm volatile("s_waitcnt vmcnt(0)" ::: "memory");
        __syncthreads();
        if (is_t0(F)) (void)xb_add(ctl + CW_P1X + tm * 4, 1u);
    }
    asm volatile("s_waitcnt vmcnt(0)" ::: "memory");
    __syncthreads();
    if (is_t0(F)) (void)xb_add(ctl + CW_P1DONE, 1u);
}
#ifndef MK_TIMING
#define MK_TIMING -1
#endif
constexpr int CW_TIME = 2048;
__device__ __forceinline__ void phase_final(const Frame& F, const Params& p) {
    const int lane = F.lane;
    float tf = 1.f;
    if (MK_TIMING >= 0) tf = __uint_as_float(__hip_atomic_load((unsigned*)(F.ws + WS_CTL) + CW_TIME, __ATOMIC_RELAXED, __HIP_MEMORY_SCOPE_AGENT));
    unsigned* ctl = (unsigned*)(F.ws + WS_CTL);
    for (int vb = blockIdx.x; vb < 256; vb += gridDim.x) {
        const int tm = vb & 31, part = vb >> 5;
        if (F.tid == 0) {
            XB_SPIN(xb_ld(ctl + CW_XRDY + tm * 4) < 8u, ctl + CW_BAR);
            __builtin_amdgcn_fence(__ATOMIC_ACQUIRE, "agent");
            asm volatile("s_waitcnt vmcnt(0)" ::: "memory");
        }
        __syncthreads();
#pragma unroll 1
        for (int i = 0; i < 4; ++i) {
            const int tok = tm * 256 + part * 32 + F.w * 4 + i;
            float ss = 0.f;
            if (lane < 16) ss = ((const float*)(F.ws + WS_SSQ))[(size_t)tok * 16 + lane];
            ss = wsum(ss);
            const float rstd = rsqrtf(ss * (1.f / 1024.f) + EPS);
            const bf16_t* xr = (const bf16_t*)(F.ws + WS_XB) + (size_t)tok * 1024; float* orow = p.out + (size_t)tok * 1024;
#pragma unroll
            for (int j = 0; j < 4; ++j) {
                const int k = j * 256 + lane * 4;
                const u32x2 xq = *(const u32x2*)(xr + k);
                const f32x4 x = {bflo(xq.x), bfhi(xq.x), bflo(xq.y), bfhi(xq.y)}, fn = *(const f32x4*)(pin(F, I_FNORM) + k);
                { const f32x4 o = x * fn * (rstd * tf); ST16_WT(orow + k, o); }
            }
        }
    }
}

__device__ __forceinline__ GemmOp a2_op(const Frame& F, int l, int j) {
    GemmOp g;
    if (j < 160) { const int tn = j >> 5, tm = j & 31; g.W = (const bf16_t*)(F.ws + WS_WUQ) + ((size_t)l * 640 + tn * 128) * 256; g.X = (const bf16_t*)(F.ws + WS_CQG) + (size_t)tm * 256 * 256; g.ldw = 256; g.ldx = 256; g.K = 256; }
    else if (j < 352) { const int jj = j - 160, tn = jj >> 5, tm = jj & 31; g.W = (const bf16_t*)(F.ws + WS_WUKV) + ((size_t)l * 768 + tn * 128) * 128; g.X = (const bf16_t*)(F.ws + WS_CKVN) + (size_t)tm * 256 * 128; g.ldw = 128; g.ldx = 128; g.K = 128; }
    else { const int jj = j - 352, tn = jj >> 3, tc = jj & 7, b = tc >> 1, jt = tc & 1; g.W = (const bf16_t*)(F.ws + WS_WUKV) + ((size_t)l * 768 + tn * 128) * 128;
           g.X = (const bf16_t*)(F.ws + WS_CCKV) + ((size_t)(b * 4 + l) * 512 + jt * 256) * 128; g.ldw = 128; g.ldx = 128; g.K = 128; }
    return g;
}
__device__ __forceinline__ int a2_item(int vb, int i) {
    const int c = (vb >> 5) - 4, tmw = vb & 31;
    if (i == 3) return 352 + 32 + tmw;
    if (c == 0) return i * 32 + tmw;
    if (c == 1) return i < 2 ? (3 + i) * 32 + tmw : 160 + tmw;
    if (c == 2) return 160 + (1 + i) * 32 + tmw;
    return i < 2 ? 160 + (4 + i) * 32 + tmw : 352 + tmw;
}
#ifndef MK_EN
#define MK_EN 0xff
#endif
#define EN(x) ((MK_EN >> (x)) & 1)
constexpr int PH_TOTAL = 19;
__global__ void __launch_bounds__(512, 2) mega(Params p) {
    extern __shared__ __attribute__((aligned(16))) unsigned char lds_raw[];
    Frame F;
    F.lds = (LAS unsigned char*)lds_raw;
    F.tid = threadIdx.x; F.lane = F.tid & 63; F.w = __builtin_amdgcn_readfirstlane(F.tid >> 6); F.h = F.lane >> 5; F.lq = F.lane & 31;
    F.ws = p.ws;
    F.karg = (karg_t)__builtin_amdgcn_kernarg_segment_ptr();
    volatile LAS unsigned* MISC = (volatile LAS unsigned*)(F.lds + LDS_MISC);
    if (F.tid < 64) MISC[F.tid] = 0u;
    __syncthreads();
    unsigned* ctl = (unsigned*)(p.ws + WS_CTL);
    XcdBarrier bar; bar.bar = ctl + CW_BAR; bar.x = 0; bar.st = nullptr;
    const bool multi = p.ph_hi - p.ph_lo > 1;
    if (multi) bar = xcd_barrier_post(ctl + CW_BAR, MISC + 8);
    bar.w = F.w;
    const int G = gridDim.x;
    const Frame F0 = F;
    for (int ph = p.ph_lo; ph < p.ph_hi; ++ph) {
        if (ph >= 2 && ph < 18 && ((ph - 2) & 3) == 1) continue;
        Frame F = F0;
        F.lane = (int)__builtin_amdgcn_mbcnt_hi(~0u, __builtin_amdgcn_mbcnt_lo(~0u, 0u));
        asm volatile("" : "+v"(F.lane));
        F.tid = (F.w << 6) | F.lane; F.h = F.lane >> 5; F.lq = F.lane & 31;
        asm volatile("" : "+s"(F.w), "+s"(F.ws), "+s"(F.karg));
        if (MK_TIMING >= 0 && blockIdx.x == 0 && F.tid == 0) {
            const unsigned long long now = __builtin_amdgcn_s_memrealtime();
            const unsigned long long prev = ((unsigned long long)MISC[17] << 32) | MISC[16];
            if (ph > p.ph_lo) { const int q = ph - 1; const int grp = q < 2 ? q : 2 + ((q - 2) & 3); if (grp == MK_TIMING) MISC[18] += (unsigned)(now - prev); }
            MISC[16] = (unsigned)now; MISC[17] = (unsigned)(now >> 32);
        }
#ifndef MK_REPEAT
#define MK_REPEAT -1
#endif
        int nrep = 1;
        if (MK_REPEAT >= 1) { const int grp = ph < 2 ? ph : (ph == 18 ? 6 : 2 + ((ph - 2) & 3)); if (grp == MK_REPEAT) nrep = (grp == 5) ? (ph == 5 ? 5 : 1) : 2; }
        for (int rep = 0; rep < nrep; ++rep) {
        if (rep > 0) xcd_barrier(bar);
        Frame F = F0;
        F.lane = (int)__builtin_amdgcn_mbcnt_hi(~0u, __builtin_amdgcn_mbcnt_lo(~0u, 0u));
        asm volatile("" : "+v"(F.lane));
        F.tid = (F.w << 6) | F.lane; F.h = F.lane >> 5; F.lq = F.lane & 31;
        asm volatile("" : "+s"(F.w), "+s"(F.ws), "+s"(F.karg));
        if (EN(0) && ph == 0) {
#if defined(MK_DUP0)
            for (int d = 0; d < 2; ++d) { int dd = d; asm volatile("" : "+s"(dd)); if (dd) xcd_barrier(bar); phase0(F, p, dd != 0); }
#else
            phase0(F, p);
#endif
        }
        else if (EN(1) && ph == 1) phase1(F, p);
        else if (EN(2) && ph == 18) phase_final(F, p);
        else {
            const int l = (ph - 2) >> 2, sub = (ph - 2) & 3;
            int bid = blockIdx.x; asm volatile("" : "+s"(bid));
            if (EN(3) && sub == 0) {
                const bf16_t* Wt = (const bf16_t*)(F.ws + WS_WIN) + (size_t)l * 2944 * 1024;
                const bf16_t* X = (const bf16_t*)(F.ws + WS_XG);
                unsigned* flags = ctl + CW_FLAG + l * 512;
                bool first = true;
                int waited_tm = -1;
                for (int j = bid; j < 12 * 32; j += G) {
                    const int tn2 = j >> 5, tm = j & 31;
                    const int jn = j + G; const bool hn = jn < 12 * 32 && (jn & 31) == tm;
                    if (l == 0 && tm != waited_tm) {
                        waited_tm = tm;
                        if (F.tid == 0) {
                            XB_SPIN(xb_ld(ctl + CW_P1X + tm * 4) < 8u, ctl + CW_BAR);
                            XB_SPIN(xb_ld(ctl + CW_P1B0) < 368u, ctl + CW_BAR);
                            __builtin_amdgcn_fence(__ATOMIC_ACQUIRE, "agent");
                            asm volatile("s_waitcnt vmcnt(0)" ::: "memory");
                        }
                        __syncthreads();
                        first = true;
                    }
                    if (l > 0 && tm != waited_tm) {
                        waited_tm = tm;
                        if (F.w == 0) {
                            const int ln = lane_id();
                            unsigned* ptr = ctl + CW_P1DONE; unsigned tgt = (unsigned)G;
                            if (ln == 1) { ptr = ctl + CW_XGR + ((l - 1) * 32 + tm) * 4; tgt = 8u; }
                            if (ln >= 2) {
                                if (tm >= 16) { ptr = ctl + CW_YRDY + ((l - 1) * 32 + (tm & ~3) + ((ln - 2) & 3)) * 4; tgt = 16u; }
                                else { ptr = ctl + CW_SD + ((l - 1) * 16 + tm) * 4; tgt = 4u; }
                            }
                            poll_lanes(ptr, tgt, ln < (tm >= 16 ? 6 : 3), ctl + CW_BAR);
                            __builtin_amdgcn_fence(__ATOMIC_ACQUIRE, "agent");
                            asm volatile("s_waitcnt vmcnt(0)" ::: "memory");
                        }
                        __syncthreads();
                        first = true;
                    }
                    const int tn = 2 * tn2 + ((F.w & 3) >> 1), wn = F.w & 1;
                    if (tn2 == 11) {
                        GemmAcc2 accn;
                        Gemm1Pre P1;
                        const bool mine = (F.w & 3) == 0;
                        if (mine) gemm1_pre(F, p, 22, 0, tm, l, P1); else { P1.rstd[0] = P1.rstd[1] = 0.f; P1.bias = 0.f; P1.gain = 1.f; }
                        gemm_core256n(F, Wt + (size_t)tn2 * 256 * 1024, X + (size_t)tm * 256 * 1024, accn, first); first = true;
                        if (mine) epi_kpe(F, p, accn, tm, l, P1);
                    } else {
                    GemmAcc8 acc;
                    Gemm1Pre P1;
                    gemm1_pre(F, p, tn, wn, tm, l, P1);
                    gemm_core256(F, Wt + (size_t)tn2 * 256 * 1024, X + (size_t)tm * 256 * 1024, acc, first, hn, Wt + (size_t)(jn >> 5) * 256 * 1024, X + (size_t)(jn & 31) * 256 * 1024); first = false;
                    epi_gemm1(F, p, acc, tn, wn, tm, l, P1, tn2 == 6);
                    }
                    {
                        asm volatile("s_waitcnt vmcnt(0)" ::: "memory");
                        __syncthreads();
                        if (F.tid == 0) {
                            if (tn2 == 5 || tn2 == 6) (void)xb_add(flags + tm * 16, 1u);
                            if (tn2 < 8) (void)xb_add(ctl + CW_RA + (l * 32 + tm) * 4, 1u);
                            if (tn2 >= 7 && tn2 < 11) (void)xb_add(ctl + CW_ZC + (l * 32 + tm) * 4, 1u);
                            (void)xb_add(ctl + CW_FULL + (l * 32 + tm) * 4, 1u);
                        }
                    }
                }
                for (int vb = bid; vb < 256; vb += G) {
                    if (vb < 128) continue;
                    const int c = (vb >> 5) - 4, tmw = vb & 31;
                    const int nit = (c == 2 && tmw < 16) ? 4 : 3;
                    if (F.tid == 0) {
                        if (l > 0 && tmw != waited_tm) {
                            if (tmw >= 16) { unsigned* y = ctl + CW_YRDY + ((l - 1) * 32 + (tmw & ~3)) * 4; for (int i = 0; i < 4; ++i) { XB_SPIN(xb_ld(y + 4 * i) < 16u, ctl + CW_BAR); } }
                            else { XB_SPIN(xb_ld(ctl + CW_YRDY + ((l - 1) * 32 + tmw) * 4) < 16u, ctl + CW_BAR); XB_SPIN(xb_ld(ctl + CW_SD + ((l - 1) * 16 + tmw) * 4) < 4u, ctl + CW_BAR); }
                        }
                        unsigned* f = flags + tmw * 16;
                        XB_SPIN(xb_ld(f) < 2u, ctl + CW_BAR);
                        __builtin_amdgcn_fence(__ATOMIC_ACQUIRE, "agent");
                        asm volatile("s_waitcnt vmcnt(0)" ::: "memory");
                    }
                    __syncthreads();
                    for (int i = 0; i < nit; ++i) {
                        const bool hn = i + 1 < nit;
                        const int j = a2_item(vb, i), jn = a2_item(vb, hn ? i + 1 : i);
                        const GemmOp g = a2_op(F, l, j); const GemmOp gn = a2_op(F, l, jn);
                        GemmAcc acc;
                        float rstdq = 0.f;
                        if (j < 160) qm_pre(F, tmw, rstdq);
                        gemm_core(F, g, acc, i == 0, hn, gn);
                        if (j < 160) epi_qm(F, acc, j >> 5, tmw, rstdq);
                        else if (j < 352) { const int jj = j - 160; epi_plain(F, acc, (bf16_t*)(F.ws + WS_KVM), 768, tmw * 256, (jj >> 5) * 128); }
                        else {
                            const int jj = j - 352, tc = jj & 7;
                            if (l > 0) {
                                if (F.w == 0) { const int ln = lane_id(); poll_lanes(ctl + CW_YRDY + ((l - 1) * 32 + 16 + 4 * (tc >> 1) + (ln & 3)) * 4, 16u, ln < 4, ctl + CW_BAR); }
                                __syncthreads();
                            }
                            epi_plain(F, acc, (bf16_t*)(F.ws + WS_KVMC), 768, (tc >> 1) * 512 + (tc & 1) * 256, (jj >> 3) * 128);
                        }
                        asm volatile("s_waitcnt vmcnt(0)" ::: "memory");
                        __syncthreads();
                        if (F.tid == 0) {
                            if (j < 352) (void)xb_add(ctl + CW_FULL + (l * 32 + tmw) * 4, 1u);
                            else (void)xb_add(ctl + CW_KC + (l * 4 + (((j - 352) & 7) >> 1)) * 4, 1u);
                        }
                    }
                }
            } else if (EN(5) && sub == 2) {
                for (;;) {
                    __syncthreads();
                    if (F.tid == 0) MISC[0] = atomicAdd(ctl + CW_QUEUE + 64 * l + 32 * rep, 1u);
                    __syncthreads();
                    const int uq = __builtin_amdgcn_readfirstlane((int)MISC[0]);
                    if (uq >= N_ATTN_UNITS) break;
                    const int u = uq < 160 ? uq + 96 : (uq < 256 ? uq - 160 : (uq < 416 ? uq + 96 : (uq < 512 ? uq - 160 : uq)));
                    attn_dispatch(F, p, u, l);
                }
            } else if (EN(6)) {
                const bf16_t* Wt = (const bf16_t*)(F.ws + WS_WOUT) + (size_t)l * 1024 * 1024;
                const bf16_t* Yb = (const bf16_t*)(F.ws + WS_Y);
                for (int j = bid; j < 8 * 32; j += G) {
                    const int tn = j >> 5, tm = j & 31;
                    GemmOp g; g.W = Wt + (size_t)tn * 128 * 1024; g.X = Yb + (size_t)tm * 256 * 1024; g.ldw = 1024; g.ldx = 1024; g.K = 1024;
                    GemmAcc acc;
                    Gemm2Pre P2;
                    if (F.tid == 0) {
                        unsigned* f = ctl + CW_YRDY + (l * 32 + tm) * 4;
                        XB_SPIN(xb_ld(f) < 16u, ctl + CW_BAR);
                        if (l == 0) { XB_SPIN(xb_ld(ctl + CW_P1DONE) < (unsigned)G, ctl + CW_BAR); }
                        __builtin_amdgcn_fence(__ATOMIC_ACQUIRE, "agent");
                        asm volatile("s_waitcnt vmcnt(0)" ::: "memory");
                    }
                    __syncthreads();
                    gemm2_pre(F, tn, tm, l, P2);
                    gemm_core(F, g, acc, true, false, g);
                    epi_gemm2(F, p, acc, tn, tm, l, P2, l == 3);
                    {
                        asm volatile("s_waitcnt vmcnt(0)" ::: "memory");
                        __syncthreads();
                        if (F.tid == 0) (void)xb_add(l == 3 ? ctl + CW_XRDY + tm * 4 : ctl + CW_XGR + (l * 32 + tm) * 4, 1u);
                    }
                }
            }
        }
        }
        if (MK_TIMING >= 0 && ph == 17 && blockIdx.x == 0 && F.tid == 0) {
            const unsigned long long now = __builtin_amdgcn_s_memrealtime();
            const unsigned long long prev = ((unsigned long long)MISC[17] << 32) | MISC[16];
            unsigned a = MISC[18]; if (MK_TIMING == 5) a += (unsigned)(now - prev);
            __hip_atomic_store(ctl + CW_TIME, __float_as_uint(1.f + (float)a * 1e-5f), __ATOMIC_RELAXED, __HIP_MEMORY_SCOPE_AGENT);
        }
        if (ph + 1 < p.ph_hi && ph < 1) xcd_barrier(bar);
    }
}
}

extern "C" void kernel_launch(void* const* d_in, const int* in_sizes, int n_in, void* d_out, int out_size, void* d_ws, size_t ws_size, hipStream_t stream) {
    static int grid = 0;
    if (!grid) {
        int dev = 0, cus = 0, per_cu = 0;
        (void)hipGetDevice(&dev);
        (void)hipDeviceGetAttribute(&cus, hipDeviceAttributeMultiprocessorCount, dev);
        (void)hipFuncSetAttribute((const void*)mk::mega, hipFuncAttributeMaxDynamicSharedMemorySize, mk::LDS_BYTES);
        (void)hipOccupancyMaxActiveBlocksPerMultiprocessor(&per_cu, (const void*)mk::mega, 512, mk::LDS_BYTES);
        if (per_cu > 1) per_cu = 1;
        if (per_cu < 1) per_cu = 1;
        if (cus < 1) cus = 256;
        grid = cus * per_cu;
    }
    unsigned char* ws = (unsigned char*)d_ws;
    (void)hipMemsetAsync(ws, 0, mk::CTL_ZERO_BYTES, stream);
    mk::Params P{};
    for (int i = 0; i < 22; ++i) P.in[i] = (const float*)d_in[i];
    P.out = (float*)d_out; P.ws = ws; P.xs = (float*)d_out;
    P.ph_lo = 0; P.ph_hi = mk::PH_TOTAL;
    void* args[] = {&P};
    (void)hipLaunchCooperativeKernel((const void*)mk::mega, dim3(grid), dim3(512), args, mk::LDS_BYTES, stream);
}
```

```cpp
#include <hip/hip_runtime.h>
#include <stdint.h>
namespace mk {
#define LAS __attribute__((address_space(3)))
typedef unsigned short bf16_t;
typedef short bf16x8 __attribute__((ext_vector_type(8)));
typedef short s16x4 __attribute__((ext_vector_type(4)));
typedef float f32x16 __attribute__((ext_vector_type(16)));
typedef float f32x4 __attribute__((ext_vector_type(4)));
typedef float f32x2 __attribute__((ext_vector_type(2)));
typedef unsigned u32x4 __attribute__((ext_vector_type(4)));
typedef unsigned u32x2 __attribute__((ext_vector_type(2)));
typedef __bf16 bf16x2_t __attribute__((ext_vector_type(2)));

constexpr float EPS = 1e-6f;
constexpr float LOG2E = 1.4426950408889634f;
constexpr float QSC_GQA = 0.125f * LOG2E;
constexpr float QSC_MLA = 0.10206207261596575f * LOG2E;

__device__ __forceinline__ unsigned pk2(float lo, float hi) { f32x2 v = {lo, hi}; bf16x2_t b = __builtin_convertvector(v, bf16x2_t); return __builtin_bit_cast(unsigned, b); }
__device__ __forceinline__ float bf2f(unsigned short u) { return __uint_as_float((unsigned)u << 16); }
__device__ __forceinline__ float bflo(unsigned u) { return __uint_as_float(u << 16); }
__device__ __forceinline__ float bfhi(unsigned u) { return __uint_as_float(u & 0xffff0000u); }
__device__ __forceinline__ float silu_f(float x) { return x * __builtin_amdgcn_rcpf(1.f + __builtin_amdgcn_exp2f(-x * LOG2E)); }
__device__ __forceinline__ float wsum(float v) {
#pragma unroll
    for (int o = 32; o > 0; o >>= 1) v += __shfl_xor(v, o);
    return v;
}

constexpr size_t MiB = 1u << 20;
constexpr size_t WS_CTL = 0, CTL_ZERO_BYTES = 1 * MiB;
constexpr size_t WS_MODS = 256 * 1024;
constexpr size_t WS_BIAS = 1 * MiB;
constexpr size_t WS_GS = 1 * MiB + 256 * 1024;
constexpr size_t WS_ROPE64 = 1 * MiB + 512 * 1024;
constexpr size_t WS_ROPE32 = 1 * MiB + 768 * 1024;
constexpr size_t WS_SSQ = 2 * MiB;
constexpr size_t WS_CQSSQ = 2 * MiB + 512 * 1024;
constexpr size_t WS_S0T = 3 * MiB;
constexpr size_t WS_CGK = 4 * MiB, WS_CGV = 6 * MiB, WS_CCKV = 8 * MiB, WS_CKPE = 10 * MiB;
constexpr size_t WS_WIN = 11 * MiB;
constexpr size_t WS_WOUT = 34 * MiB;
constexpr size_t WS_WUQ = 42 * MiB;
constexpr size_t WS_WUKV = 43 * MiB + 256 * 1024;
constexpr size_t WS_XG = 44 * MiB;
constexpr size_t WS_KVM = 130 * MiB;
constexpr size_t WS_KVMC = 142 * MiB;
constexpr size_t WS_RQ = 60 * MiB, WS_RK = 64 * MiB, WS_RV = 68 * MiB;
constexpr size_t WS_GQ = 72 * MiB;
constexpr size_t WS_GK = 78 * MiB, WS_GV = 80 * MiB;
constexpr size_t WS_CQG = 82 * MiB;
constexpr size_t WS_CKVN = 86 * MiB;
constexpr size_t WS_KPEB = 88 * MiB;
constexpr size_t WS_ZS = 89 * MiB;
constexpr size_t WS_QM = 105 * MiB;
constexpr size_t WS_Y = 114 * MiB;
constexpr size_t WS_XSDBG = 130 * MiB;
constexpr size_t WS_XB = 146 * MiB;
constexpr size_t WS_OPT_END = 162 * MiB;
constexpr int CW_QUEUE = 1024;
constexpr int CW_FLAG = 2048;
constexpr int CW_YRDY = 1536;
constexpr int CW_XRDY = 1280;
constexpr int CW_RA = 8192;
constexpr int CW_FULL = 8704;
constexpr int CW_ZC = 9216;
constexpr int CW_KC = 9728;
constexpr int CW_XGR = 9856;
constexpr int CW_SD = 10368;
constexpr int CW_P1X = 10656;
constexpr int CW_P1B0 = 10784;
constexpr int CW_P1DONE = 10788;
constexpr int CW_BAR = 4096;

constexpr size_t O_STATE = 8388608, O_GK = 10485760, O_GV = 12582912, O_CKV = 14680064, O_KPE = 16777216;

constexpr int NWAVE = 8;
constexpr int GST = 49152;
constexpr int GST2 = 65536;
constexpr int LDS_OST = GST2;
constexpr int LDS_EX = 135168;
constexpr int LDS_EXB = 137216;
constexpr int LDS_SCAL = 141312;
constexpr int LDS_MISC = 142336;
constexpr int LDS_BYTES = 142592;

struct Params { const float* in[22]; float* out; unsigned char* ws; float* xs; int ph_lo, ph_hi; };
enum { I_XP = 0, I_XS, I_STATE, I_CGK, I_CGV, I_CCKV, I_CKPE, I_C, I_CCTX, I_NORMG, I_WADA, I_BADA, I_WIN, I_DECAY, I_GQN, I_GKN, I_MQN, I_MKVN, I_WUQ, I_WUKV, I_WOUT, I_FNORM };

#define XB_TMO      128
#define XB_XCNT(j)  (256  + 64 * (j))
#define XB_XSUB(j)  (1280 + 64 * (j))
#define XB_XGEN(j)  (2304 + 64 * (j))
#define XB_TOP      3328
#define XB_TOPGEN   3392
#define XB_SPIN_CAP (1u << 20)
__device__ __forceinline__ unsigned xb_ld(unsigned* p) { return __hip_atomic_load(p, __ATOMIC_RELAXED, __HIP_MEMORY_SCOPE_AGENT); }
__device__ __forceinline__ unsigned xb_add(unsigned* p, unsigned v) { return __hip_atomic_fetch_add(p, v, __ATOMIC_RELAXED, __HIP_MEMORY_SCOPE_AGENT); }
__device__ __forceinline__ unsigned xb_xcc_id() { return (unsigned)__builtin_amdgcn_s_getreg((3 << 11) | 20) & 0xFu; }
#define XB_SPIN(cond, bar) do { unsigned _sp = 0; while (cond) { __builtin_amdgcn_s_sleep(1); \
    if ((++_sp & 255u) == 0u) { if (xb_ld(&(bar)[XB_TMO])) break; if (_sp > XB_SPIN_CAP) { atomicAdd(&(bar)[XB_TMO], 1u); break; } } } } while (0)
__device__ __forceinline__ int lane_id() { int ln = (int)__builtin_amdgcn_mbcnt_hi(~0u, __builtin_amdgcn_mbcnt_lo(~0u, 0u)); asm volatile("" : "+v"(ln)); return ln; }
__device__ __forceinline__ void poll_lanes(unsigned* ptr, unsigned target, bool active, unsigned* bar0) {
    unsigned sp = 0u;
    for (;;) {
        unsigned v = target;
        if (active) v = xb_ld(ptr);
        if (!__any(v < target)) break;
        __builtin_amdgcn_s_sleep(1);
        if ((++sp & 255u) == 0u) { if (xb_ld(&bar0[XB_TMO])) break; if (sp > XB_SPIN_CAP) { atomicAdd(&bar0[XB_TMO], 1u); break; } }
    }
}
struct XcdBarrier { unsigned* bar; unsigned x; volatile LAS unsigned* st; int w; };
__device__ __forceinline__ XcdBarrier xcd_barrier_post(unsigned* bar, volatile LAS unsigned* st) {
    XcdBarrier b; b.bar = bar; b.x = xb_xcc_id(); b.st = st; b.w = 0;
    if (threadIdx.x == 0) (void)xb_add(&bar[XB_XCNT(b.x)], 1u);
    return b;
}
__device__ __forceinline__ void xcd_barrier_complete(unsigned* bar, unsigned x, unsigned& nloc, unsigned& nx) {
    const unsigned G = gridDim.x * gridDim.y * gridDim.z;
    unsigned sum, cnt, mine, sp = 0u;
    for (;;) {
        sum = 0u; cnt = 0u; mine = 0u;
#pragma unroll
        for (unsigned j = 0; j < 16; ++j) { const unsigned c = xb_ld(&bar[XB_XCNT(j)]); sum += c; cnt += (c > 0u) ? 1u : 0u; mine = (j == x) ? c : mine; }
        if (sum == G) break;
        __builtin_amdgcn_s_sleep(1);
        if ((++sp & 255u) == 0u) { if (xb_ld(&bar[XB_TMO])) break; if (sp > XB_SPIN_CAP) { atomicAdd(&bar[XB_TMO], 1u); break; } }
    }
    nloc = mine > 0u ? mine : 1u; nx = cnt > 0u ? cnt : 1u;
}
__device__ __forceinline__ void xcd_barrier(const XcdBarrier& b) {
    asm volatile("s_waitcnt vmcnt(0)" ::: "memory");
    __syncthreads();
    if (b.w == 0 && __builtin_amdgcn_mbcnt_hi(~0u, __builtin_amdgcn_mbcnt_lo(~0u, 0u)) == 0u) {
        unsigned* bar = b.bar;
        __builtin_amdgcn_s_waitcnt(0);
        unsigned nloc = b.st[0], nx = b.st[1];
        if (nloc == 0u) { xcd_barrier_complete(bar, b.x, nloc, nx); b.st[0] = nloc; b.st[1] = nx; }
        const unsigned old = xb_add(&bar[XB_XSUB(b.x)], 1u);
        const unsigned gen = old / nloc;
        if (old + 1u == (gen + 1u) * nloc) {
            __builtin_amdgcn_fence(__ATOMIC_RELEASE, "agent");
            asm volatile("s_waitcnt vmcnt(0)" ::: "memory");
            const unsigned og = xb_add(&bar[XB_TOP], 1u);
            const unsigned tg = og / nx;
            if (og + 1u == (tg + 1u) * nx) xb_add(&bar[XB_TOPGEN], 1u);
            else XB_SPIN(xb_ld(&bar[XB_TOPGEN]) == tg, bar);
            xb_add(&bar[XB_XGEN(b.x)], 1u);
            __builtin_amdgcn_fence(__ATOMIC_ACQUIRE, "agent");
            asm volatile("s_waitcnt vmcnt(0)" ::: "memory");
        } else {
            XB_SPIN(xb_ld(&bar[XB_XGEN(b.x)]) == gen, bar);
            __builtin_amdgcn_fence(__ATOMIC_ACQUIRE, "agent");
            asm volatile("s_waitcnt vmcnt(0)" ::: "memory");
        }
    }
    __syncthreads();
}

typedef const float* cfp_t;
typedef const __attribute__((address_space(4))) cfp_t* karg_t;
struct Frame {
    LAS unsigned char* lds;
    int tid, lane, w, h, lq;
    unsigned char* ws;
    karg_t karg;
};
__device__ __forceinline__ const float* pin(const Frame& F, int i) { return F.karg[i]; }
__device__ __forceinline__ bool is_t0(const Frame& F) { return F.w == 0 && __builtin_amdgcn_mbcnt_hi(~0u, __builtin_amdgcn_mbcnt_lo(~0u, 0u)) == 0u; }
#define GLDS16(gsrc, ldsdst) __builtin_amdgcn_global_load_lds((const unsigned*)(gsrc), (LAS unsigned*)(ldsdst), 16, 0, 0)
#define ST16_WT(ptr, val) asm volatile("global_store_dwordx4 %0, %1, off sc1\n\ts_nop 1" :: "v"(ptr), "v"(val) : "memory")
#define MFMA32(a, b, c) __builtin_amdgcn_mfma_f32_32x32x16_bf16((a), (b), (c), 0, 0, 0)

struct GemmOp { const bf16_t* W; const bf16_t* X; int ldw, ldx, K; };
__device__ __forceinline__ void gemm_issue0(const Frame& F, const GemmOp& g) {
    const int lane = F.lane, w = F.w;
#pragma unroll
    for (int q = 0; q < 2; ++q) { const int row = 16 * w + 8 * q + (lane >> 3); GLDS16(g.W + row * g.ldw + ((lane & 7) ^ ((row >> 1) & 7)) * 8, F.lds + (16 * w + 8 * q) * 128); }
#pragma unroll
    for (int q = 0; q < 4; ++q) { const int row = 32 * w + 8 * q + (lane >> 3); GLDS16(g.X + row * g.ldx + ((lane & 7) ^ ((row >> 1) & 7)) * 8, F.lds + 16384 + (32 * w + 8 * q) * 128); }
}
typedef f32x4 GemmAcc[4][4];
__device__ __forceinline__ void gemm_core(const Frame& F, const GemmOp& g, GemmAcc& acc, bool issue_first, bool has_next, const GemmOp& gn) {
    const int lane = F.lane, w = F.w;
    const bf16_t* __restrict__ W = g.W; const bf16_t* __restrict__ X = g.X;
    const int nkt = g.K >> 6;
    int offW[2], offX[4];
#pragma unroll
    for (int q = 0; q < 2; ++q) { const int row = 16 * w + 8 * q + (lane >> 3); offW[q] = row * g.ldw + ((lane & 7) ^ ((row >> 1) & 7)) * 8; }
#pragma unroll
    for (int q = 0; q < 4; ++q) { const int row = 32 * w + 8 * q + (lane >> 3); offX[q] = row * g.ldx + ((lane & 7) ^ ((row >> 1) & 7)) * 8; }
    LAS unsigned char* const dW = F.lds + (16 * w) * 128;
    LAS unsigned char* const dX = F.lds + 16384 + (32 * w) * 128;
#define GC_ISSUE(kt, st) do { _Pragma("unroll") for (int q = 0; q < 2; ++q) GLDS16(W + offW[q] + (kt) * 64, dW + (st) * GST + q * 1024); \
        _Pragma("unroll") for (int q = 0; q < 4; ++q) GLDS16(X + offX[q] + (kt) * 64, dX + (st) * GST + q * 1024); } while (0)
    const int wn = w & 1, wm = w >> 1, c15 = lane & 15, g4 = lane >> 4;
    const int sw = (c15 >> 1) & 7;
    int so[2];
#pragma unroll
    for (int s = 0; s < 2; ++s) so[s] = ((4 * s + g4) ^ sw) << 4;
    const int bn0 = (64 * wn + c15) * 128, bm0 = 16384 + (64 * wm + c15) * 128;
#pragma unroll
    for (int a = 0; a < 4; ++a)
#pragma unroll
        for (int b = 0; b < 4; ++b) acc[a][b] = (f32x4){0.f, 0.f, 0.f, 0.f};
    if (issue_first) GC_ISSUE(0, 0);
    asm volatile("s_waitcnt vmcnt(0)" ::: "memory");
    __syncthreads();
    for (int kt = 0; kt < nkt; ++kt) {
        const int st = kt & 1;
        const bool lng = nkt >= 16;
        if (kt + 1 < nkt) { if (!lng) GC_ISSUE(kt + 1, st ^ 1); else { GLDS16(W + offW[0] + (kt + 1) * 64, dW + (st ^ 1) * GST); GLDS16(X + offX[0] + (kt + 1) * 64, dX + (st ^ 1) * GST); GLDS16(X + offX[1] + (kt + 1) * 64, dX + (st ^ 1) * GST + 1024); } }
        LAS unsigned char* const base = F.lds + st * GST;
#pragma unroll
        for (int s = 0; s < 2; ++s) {
            bf16x8 fa[4], fb[4];
#pragma unroll
            for (int q = 0; q < 4; ++q) { fa[q] = *(const LAS bf16x8*)(base + bn0 + q * 2048 + so[s]); fb[q] = *(const LAS bf16x8*)(base + bm0 + q * 2048 + so[s]); }
            if (lng && s == 0 && kt + 1 < nkt) { GLDS16(W + offW[1] + (kt + 1) * 64, dW + (st ^ 1) * GST + 1024); GLDS16(X + offX[2] + (kt + 1) * 64, dX + (st ^ 1) * GST + 2048); GLDS16(X + offX[3] + (kt + 1) * 64, dX + (st ^ 1) * GST + 3072); }
#pragma unroll
            for (int a = 0; a < 4; ++a)
#pragma unroll
                for (int b = 0; b < 4; ++b) acc[a][b] = __builtin_amdgcn_mfma_f32_16x16x32_bf16(fa[a], fb[b], acc[a][b], 0, 0, 0);
        }
        asm volatile("s_waitcnt vmcnt(0)" ::: "memory");
        __syncthreads();
    }
#undef GC_ISSUE
    if (has_next) gemm_issue0(F, gn);
}

typedef f32x4 GemmAcc8[4][8];
__device__ __forceinline__ void gemm256_issue0(const Frame& F, const bf16_t* W, const bf16_t* X) {
    int lane = F.lane; const int w = F.w;
    asm volatile("" : "+v"(lane));
#pragma unroll
    for (int q = 0; q < 4; ++q) {
        const int row = 32 * w + 8 * q + (lane >> 3), off = row * 1024 + ((lane & 7) ^ ((row >> 1) & 7)) * 8;
        GLDS16(W + off, F.lds + (32 * w + 8 * q) * 128);
        GLDS16(X + off, F.lds + 32768 + (32 * w + 8 * q) * 128);
    }
}
__device__ __forceinline__ void gemm_core256(const Frame& F, const bf16_t* __restrict__ W, const bf16_t* __restrict__ X, GemmAcc8& acc, bool issue_first, bool has_next, const bf16_t* Wn, const bf16_t* Xn) {
    int lane = F.lane; const int w = F.w;
    asm volatile("" : "+v"(lane));
    int off[4];
#pragma unroll
    for (int q = 0; q < 4; ++q) { const int row = 32 * w + 8 * q + (lane >> 3); off[q] = row * 1024 + ((lane & 7) ^ ((row >> 1) & 7)) * 8; }
    LAS unsigned char* const dW = F.lds + (32 * w) * 128;
    LAS unsigned char* const dX = F.lds + 32768 + (32 * w) * 128;
#define GC2_ISSUE(kt, st) do { _Pragma("unroll") for (int q = 0; q < 4; ++q) { GLDS16(W + off[q] + (kt) * 64, dW + (st) * GST2 + q * 1024); GLDS16(X + off[q] + (kt) * 64, dX + (st) * GST2 + q * 1024); } } while (0)
    const int wn4 = w & 3, wm2 = w >> 2, c15 = lane & 15, g4 = lane >> 4;
    const int sw = (c15 >> 1) & 7;
    int so[2];
#pragma unroll
    for (int s = 0; s < 2; ++s) so[s] = ((4 * s + g4) ^ sw) << 4;
    const int bn0 = (64 * wn4 + c15) * 128, bm0 = 32768 + (128 * wm2 + c15) * 128;
#pragma unroll
    for (int a = 0; a < 4; ++a)
#pragma unroll
        for (int b = 0; b < 8; ++b) acc[a][b] = (f32x4){0.f, 0.f, 0.f, 0.f};
    if (issue_first) GC2_ISSUE(0, 0);
    asm volatile("s_waitcnt vmcnt(0)" ::: "memory");
    __syncthreads();
    for (int kt = 0; kt < 16; ++kt) {
        const int st = kt & 1;
        LAS unsigned char* const base = F.lds + st * GST2;
#pragma unroll
        for (int s = 0; s < 2; ++s) {
            bf16x8 fa[4];
#pragma unroll
            for (int q = 0; q < 4; ++q) fa[q] = *(const LAS bf16x8*)(base + bn0 + q * 2048 + so[s]);
#pragma unroll
            for (int hb = 0; hb < 2; ++hb) {
                bf16x8 fb[4];
#pragma unroll
                for (int q = 0; q < 4; ++q) fb[q] = *(const LAS bf16x8*)(base + bm0 + (4 * hb + q) * 2048 + so[s]);
                if (s == 0 && kt + 1 < 16) {
                    _Pragma("unroll") for (int q = 2 * hb; q < 2 * hb + 2; ++q) { GLDS16(W + off[q] + (kt + 1) * 64, dW + (st ^ 1) * GST2 + q * 1024); GLDS16(X + off[q] + (kt + 1) * 64, dX + (st ^ 1) * GST2 + q * 1024); }
                }
#pragma unroll
                for (int a = 0; a < 4; ++a)
#pragma unroll
                    for (int b = 0; b < 4; ++b) acc[a][4 * hb + b] = __builtin_amdgcn_mfma_f32_16x16x32_bf16(fa[a], fb[b], acc[a][4 * hb + b], 0, 0, 0);
            }
        }
        asm volatile("s_waitcnt vmcnt(0)" ::: "memory");
        __syncthreads();
    }
#undef GC2_ISSUE
    if (has_next) gemm256_issue0(F, Wn, Xn);
}
typedef f32x4 GemmAcc2[2][8];
__device__ __forceinline__ void gemm_core256n(const Frame& F, const bf16_t* __restrict__ W, const bf16_t* __restrict__ X, GemmAcc2& acc, bool issue_first) {
    int lane = F.lane; const int w = F.w;
    asm volatile("" : "+v"(lane));
    int off[4];
#pragma unroll
    for (int q = 0; q < 4; ++q) { const int row = 32 * w + 8 * q + (lane >> 3); off[q] = row * 1024 + ((lane & 7) ^ ((row >> 1) & 7)) * 8; }
    LAS unsigned char* const dW = F.lds + (32 * w) * 128;
    LAS unsigned char* const dX = F.lds + 32768 + (32 * w) * 128;
#define GC2_ISSUE(kt, st) do { _Pragma("unroll") for (int q = 0; q < 4; ++q) { if (w == 0) GLDS16(W + off[q] + (kt) * 64, dW + (st) * GST2 + q * 1024); GLDS16(X + off[q] + (kt) * 64, dX + (st) * GST2 + q * 1024); } } while (0)
    const int wn4 = w & 3, wm2 = w >> 2, c15 = lane & 15, g4 = lane >> 4;
    const int sw = (c15 >> 1) & 7;
    int so[2];
#pragma unroll
    for (int s = 0; s < 2; ++s) so[s] = ((4 * s + g4) ^ sw) << 4;
    const int bn0 = (64 * wn4 + c15) * 128, bm0 = 32768 + (128 * wm2 + c15) * 128;
#pragma unroll
    for (int a = 0; a < 2; ++a)
#pragma unroll
        for (int b = 0; b < 8; ++b) acc[a][b] = (f32x4){0.f, 0.f, 0.f, 0.f};
    if (issue_first) GC2_ISSUE(0, 0);
    asm volatile("s_waitcnt vmcnt(0)" ::: "memory");
    __syncthreads();
    for (int kt = 0; kt < 16; ++kt) {
        const int st = kt & 1;
        if (kt + 1 < 16) GC2_ISSUE(kt + 1, st ^ 1);
        LAS unsigned char* const base = F.lds + st * GST2;
        if (wn4 == 0) {
#pragma unroll
        for (int s = 0; s < 2; ++s) {
            bf16x8 fa[2];
#pragma unroll
            for (int q = 0; q < 2; ++q) fa[q] = *(const LAS bf16x8*)(base + bn0 + q * 2048 + so[s]);
#pragma unroll
            for (int hb = 0; hb < 2; ++hb) {
                bf16x8 fb[4];
#pragma unroll
                for (int q = 0; q < 4; ++q) fb[q] = *(const LAS bf16x8*)(base + bm0 + (4 * hb + q) * 2048 + so[s]);
#pragma unroll
                for (int a = 0; a < 2; ++a)
#pragma unroll
                    for (int b = 0; b < 4; ++b) acc[a][4 * hb + b] = __builtin_amdgcn_mfma_f32_16x16x32_bf16(fa[a], fb[b], acc[a][4 * hb + b], 0, 0, 0);
            }
        }
        }
        asm volatile("s_waitcnt vmcnt(0)" ::: "memory");
        __syncthreads();
    }
#undef GC2_ISSUE
}

__device__ __forceinline__ void rope64_16(float (&v)[4][4], float rowp, float colp, int g4) {
#pragma unroll
    for (int i = 0; i < 4; ++i) {
        const float fr = __builtin_amdgcn_exp2f((float)(4 * g4 + i) * -0.8304820237218406f) * 0.15915494309189535f;
#pragma unroll
        for (int c = 0; c < 2; ++c) {
            const float rev = (c ? colp : rowp) * fr;
            const float sn = __builtin_amdgcn_sinf(rev), cs = __builtin_amdgcn_cosf(rev);
            const float x0 = v[2 * c][i], x1 = v[2 * c + 1][i];
            v[2 * c][i] = x0 * cs - x1 * sn;
            v[2 * c + 1][i] = x1 * cs + x0 * sn;
        }
    }
}
__device__ __forceinline__ void rope32_16(float (&a)[4], float (&b)[4], float rowp, float colp, int g4) {
    const bool hi = g4 >= 2;
#pragma unroll
    for (int i = 0; i < 4; ++i) {
        const float fr = __builtin_amdgcn_exp2f((float)(4 * (g4 & 1) + i) * -1.6609640474436813f) * 0.15915494309189535f;
        {
            const float rev = rowp * fr;
            const float sn = __builtin_amdgcn_sinf(rev), cs = __builtin_amdgcn_cosf(rev);
            const float own = a[i], oth = __shfl_xor(own, 32);
            a[i] = own * cs + oth * (hi ? sn : -sn);
        }
        {
            const float rev = colp * fr;
            const float sn = __builtin_amdgcn_sinf(rev), cs = __builtin_amdgcn_cosf(rev);
            const float own = b[i], oth = __shfl_xor(own, 32);
            b[i] = own * cs + oth * (hi ? sn : -sn);
        }
    }
}
__device__ __forceinline__ float ssq64(const float (&v)[4][4]) {
    float s = 0.f;
#pragma unroll
    for (int nt = 0; nt < 4; ++nt)
#pragma unroll
        for (int i = 0; i < 4; ++i) s += v[nt][i] * v[nt][i];
    s += __shfl_xor(s, 16);
    s += __shfl_xor(s, 32);
    return s;
}
__device__ __forceinline__ void mulvec64(float (&v)[4][4], const LAS float* gv, int g4) {
#pragma unroll
    for (int nt = 0; nt < 4; ++nt) {
        const f32x4 q = *(const LAS f32x4*)(gv + 16 * nt + 4 * g4);
#pragma unroll
        for (int i = 0; i < 4; ++i) v[nt][i] *= q[i];
    }
}
constexpr int OST_LD = 68, OST_BYTES = 32 * OST_LD * 4;
__device__ __forceinline__ void stage_write16(LAS float* st, const float (&v)[4][4], int mh, int c15, int g4) {
    asm volatile("s_waitcnt lgkmcnt(0)" ::: "memory");
    __builtin_amdgcn_wave_barrier();
#pragma unroll
    for (int nt = 0; nt < 4; ++nt) {
        f32x4 o = {v[nt][0], v[nt][1], v[nt][2], v[nt][3]};
        *(LAS f32x4*)(st + (16 * mh + c15) * OST_LD + 16 * nt + 4 * g4) = o;
    }
    asm volatile("s_waitcnt lgkmcnt(0)" ::: "memory");
    __builtin_amdgcn_wave_barrier();
}
__device__ __forceinline__ void stage_write16a(LAS float* st, const f32x4 (&a)[4][4], int mt, int c15, int g4) {
    asm volatile("s_waitcnt lgkmcnt(0)" ::: "memory");
    __builtin_amdgcn_wave_barrier();
#pragma unroll
    for (int nt = 0; nt < 4; ++nt) *(LAS f32x4*)(st + (16 * (mt & 1) + c15) * OST_LD + 16 * nt + 4 * g4) = a[nt][mt];
    asm volatile("s_waitcnt lgkmcnt(0)" ::: "memory");
    __builtin_amdgcn_wave_barrier();
}
__device__ __forceinline__ void stage_store_bf16(const LAS float* st, bf16_t* dst, int ld, float sc, int lane) {
#pragma unroll 1
    for (int it = 0; it < 4; ++it) {
        const int row = it * 8 + (lane >> 3), c8 = (lane & 7) * 8;
        const f32x4 x0 = *(const LAS f32x4*)(st + row * OST_LD + c8), x1 = *(const LAS f32x4*)(st + row * OST_LD + c8 + 4);
        u32x4 o; o.x = pk2(x0[0] * sc, x0[1] * sc); o.y = pk2(x0[2] * sc, x0[3] * sc); o.z = pk2(x1[0] * sc, x1[1] * sc); o.w = pk2(x1[2] * sc, x1[3] * sc);
        ST16_WT(dst + (size_t)row * ld + c8, o);
    }
}
__device__ __forceinline__ void stage_store_bf16_sc1(const LAS float* st, bf16_t* dst, int ld, int lane) {
#pragma unroll 1
    for (int it = 0; it < 4; ++it) {
        const int row = it * 8 + (lane >> 3), c8 = (lane & 7) * 8;
        const f32x4 x0 = *(const LAS f32x4*)(st + row * OST_LD + c8), x1 = *(const LAS f32x4*)(st + row * OST_LD + c8 + 4);
        u32x4 o; o.x = pk2(x0[0], x0[1]); o.y = pk2(x0[2], x0[3]); o.z = pk2(x1[0], x1[1]); o.w = pk2(x1[2], x1[3]);
        bf16_t* ptr = dst + (size_t)row * ld + c8;
        asm volatile("global_store_dwordx4 %0, %1, off sc1\n\ts_nop 1" :: "v"(ptr), "v"(o) : "memory");
    }
}
__device__ __forceinline__ void stage_store_f32(const LAS float* st, float* dst, int ld, int lane) {
#pragma unroll 1
    for (int it = 0; it < 8; ++it) {
        const int row = it * 4 + (lane >> 4), c = (lane & 15) * 4;
        { const f32x4 o = *(const LAS f32x4*)(st + row * OST_LD + c); ST16_WT(dst + (size_t)row * ld + c, o); }
    }
}
__device__ __forceinline__ void stage_store_bf16_32(const LAS float* st, bf16_t* dst, int ld, int lane) {
#pragma unroll 1
    for (int it = 0; it < 2; ++it) {
        const int row = it * 16 + (lane >> 2), c8 = (lane & 3) * 8;
        const f32x4 x0 = *(const LAS f32x4*)(st + row * OST_LD + c8), x1 = *(const LAS f32x4*)(st + row * OST_LD + c8 + 4);
        u32x4 o; o.x = pk2(x0[0], x0[1]); o.y = pk2(x0[2], x0[3]); o.z = pk2(x1[0], x1[1]); o.w = pk2(x1[2], x1[3]);
        ST16_WT(dst + (size_t)row * ld + c8, o);
    }
}
__device__ __forceinline__ void stage_store_f32_32(const LAS float* st, float* dst, int ld, int lane) {
#pragma unroll 1
    for (int it = 0; it < 4; ++it) {
        const int row = it * 8 + (lane >> 3), c = (lane & 7) * 4;
        { const f32x4 o = *(const LAS f32x4*)(st + row * OST_LD + c); ST16_WT(dst + (size_t)row * ld + c, o); }
    }
}

struct Gemm1Pre { float rstd[2]; float bias, gain; };
__device__ __forceinline__ void gemm1_pre(const Frame& F, const Params& p, int tn, int wn, int tm, int l, Gemm1Pre& P) {
    const float* ssqp = (const float*)(F.ws + WS_SSQ);
#pragma unroll
    for (int jj = 0; jj < 2; ++jj) {
        const int tok = tm * 256 + (F.w >> 2) * 128 + 64 * jj + F.lane;
        const f32x4* sp = (const f32x4*)(ssqp + (size_t)tok * 16);
        float ss = 0.f;
#pragma unroll
        for (int i = 0; i < 4; ++i) { const f32x4 q = sp[i]; ss += (q[0] + q[1]) + (q[2] + q[3]); }
        P.rstd[jj] = rsqrtf(ss * (1.f / 1024.f) + EPS);
    }
    const bool lat = tm >= 16;
    const int cond = lat ? 1 + ((tm - 16) >> 2) : 0;
    const int nb = tn * 128 + wn * 64;
    P.bias = (tn < 23) ? ((const float*)(F.ws + WS_BIAS))[(size_t)(l * 5 + cond) * 2944 + nb + F.lane] : 0.f;
    const float* gp = nullptr;
    if (tn >= 6 && tn < 9) gp = pin(F, I_GQN) + l * 64;
    else if (tn == 9) gp = pin(F, I_GKN) + l * 64;
    else if (tn == 11 || tn == 12) gp = pin(F, I_MQN) + l * 256 + (nb - 1408);
    else if (tn == 13) gp = pin(F, I_MKVN) + l * 128 + wn * 64;
    P.gain = gp ? gp[F.lane] : 1.f;
}
__device__ __forceinline__ void epi_gemm1(const Frame& F, const Params& p, GemmAcc8& acc, int tn, int wn, int tm, int l, const Gemm1Pre& P, bool ckv_tile) {
    int lane = F.lane; const int wm = F.w >> 2;
    asm volatile("" : "+v"(lane));
    const int c15 = lane & 15, g4 = lane >> 4;
    unsigned char* ws = F.ws;
    asm volatile("" : "+s"(ws));
    LAS float* st = (LAS float*)(F.lds + LDS_OST + F.w * OST_BYTES);
    const bool lat = tm >= 16;
    const int b = lat ? ((tm - 16) >> 2) : tm;
    const int nb = tn * 128 + wn * 64;
    LAS float* exb = (LAS float*)(F.lds + LDS_EXB) + F.w * 128;
    exb[lane] = P.bias; exb[64 + lane] = P.gain;
    asm volatile("s_waitcnt lgkmcnt(0)" ::: "memory");
    __builtin_amdgcn_wave_barrier();
    const LAS float* bias = exb;
    float* outp = p.out;
    asm volatile("" : "+s"(outp));
    float ckv_ss[8];
    if (tn < 23) {
#pragma unroll
    for (int mt = 0; mt < 8; ++mt) {
        const int mh = mt & 1;
        const int tok0 = tm * 256 + wm * 128 + (mt >> 1) * 32;
        const int tokb = tok0 + 16 * mh, tok = tokb + c15;
        const int t0 = lat ? ((tok0 - 4096) & 1023) : (tok0 & 255), t = t0 + 16 * mh + c15;
        const float rstd = __shfl(P.rstd[mt >> 2], 16 * (mt & 3) + c15);
        float v[4][4];
#pragma unroll
        for (int nt = 0; nt < 4; ++nt) {
            const f32x4 bq = *(const LAS f32x4*)(bias + 16 * nt + 4 * g4);
#pragma unroll
            for (int i = 0; i < 4; ++i) v[nt][i] = acc[nt][mt][i] * rstd + bq[i];
        }
        const float rowp = (float)(t >> 6), colp = (float)(t & 63);
        const size_t orow0 = (size_t)(b * 4 + l) * 256 + t0;
        if (tn < 2) {
            if (lat) rope64_16(v, rowp, colp, g4);
            stage_write16(st, v, mh, c15, g4);
            if (mh) stage_store_bf16(st, (bf16_t*)(ws + WS_RQ) + (size_t)tok0 * 256 + nb, 256, 1.f, lane);
        } else if (tn < 4) {
            if (lat) rope64_16(v, rowp, colp, g4);
            stage_write16(st, v, mh, c15, g4);
            if (mh) stage_store_bf16(st, (bf16_t*)(ws + WS_RK) + (size_t)tok0 * 256 + (nb - 256), 256, 0.125f, lane);
        } else if (tn < 6) {
            stage_write16(st, v, mh, c15, g4);
            if (mh) stage_store_bf16(st, (bf16_t*)(ws + WS_RV) + (size_t)tok0 * 256 + (nb - 512), 256, 1.f, lane);
        } else if (tn < 9) {
            const float r = rsqrtf(ssq64(v) * (1.f / 64.f) + EPS);
#pragma unroll
            for (int nt = 0; nt < 4; ++nt)
#pragma unroll
                for (int i = 0; i < 4; ++i) v[nt][i] *= r;
            mulvec64(v, exb + 64, g4);
            if (lat) rope64_16(v, rowp, colp, g4);
            stage_write16(st, v, mh, c15, g4);
            if (mh) stage_store_bf16(st, (bf16_t*)(ws + WS_GQ) + (size_t)tok0 * 384 + (nb - 768), 384, QSC_GQA, lane);
        } else if (tn == 9) {
            const float r = rsqrtf(ssq64(v) * (1.f / 64.f) + EPS);
#pragma unroll
            for (int nt = 0; nt < 4; ++nt)
#pragma unroll
                for (int i = 0; i < 4; ++i) v[nt][i] *= r;
            mulvec64(v, exb + 64, g4);
            if (lat) rope64_16(v, rowp, colp, g4);
            stage_write16(st, v, mh, c15, g4);
            if (mh) {
                if (!lat) stage_store_f32(st, outp + O_GK + orow0 * 128 + (nb - 1152), 128, lane);
                stage_store_bf16(st, (bf16_t*)(ws + WS_GK) + (size_t)tok0 * 128 + (nb - 1152), 128, 1.f, lane);
            }
        } else if (tn == 10) {
            stage_write16(st, v, mh, c15, g4);
            if (mh) {
                if (!lat) stage_store_f32(st, outp + O_GV + orow0 * 128 + (nb - 1280), 128, lane);
                stage_store_bf16(st, (bf16_t*)(ws + WS_GV) + (size_t)tok0 * 128 + (nb - 1280), 128, 1.f, lane);
            }
        } else if (tn < 13) {
            const float s2 = ssq64(v);
            if (g4 == 0) __hip_atomic_store((__attribute__((address_space(1))) float*)((float*)(ws + WS_CQSSQ) + (size_t)tok * 4 + ((nb - 1408) >> 6)), s2, __ATOMIC_RELAXED, __HIP_MEMORY_SCOPE_AGENT);
            mulvec64(v, exb + 64, g4);
            stage_write16(st, v, mh, c15, g4);
            if (mh) stage_store_bf16_sc1(st, (bf16_t*)(ws + WS_CQG) + (size_t)tok0 * 256 + (nb - 1408), 256, lane);
        } else if (tn == 13) {
            ckv_ss[mt] = ssq64(v);
            if (g4 == 0) ((LAS float*)(F.lds + LDS_EX))[(wm * 2 + wn) * 128 + mt * 16 + c15] = ckv_ss[mt];
        } else if (tn < 22) {
#pragma unroll
            for (int nt = 0; nt < 4; ++nt)
#pragma unroll
                for (int i = 0; i < 4; ++i) v[nt][i] = silu_f(v[nt][i]);
            stage_write16(st, v, mh, c15, g4);
            if (mh) stage_store_bf16(st, (bf16_t*)(ws + WS_ZS) + (size_t)tok0 * 1024 + (nb - 1792), 1024, 1.f, lane);
        } else {
            if (wn == 0) {
                if (lat) rope32_16(v[0], v[1], rowp, colp, g4);
                stage_write16(st, v, mh, c15, g4);
                if (mh) {
                    if (!lat) stage_store_f32_32(st, outp + O_KPE + orow0 * 32, 32, lane);
                    stage_store_bf16_32(st, (bf16_t*)(ws + WS_KPEB) + (size_t)tok0 * 32, 32, lane);
                }
            }
        }
    }
    }
    if (ckv_tile) {
        __syncthreads();
        if (tn == 13) {
#pragma unroll
        for (int mt = 0; mt < 8; ++mt) {
            const int mh = mt & 1;
            const int tok0 = tm * 256 + wm * 128 + (mt >> 1) * 32;
            const int t0 = lat ? ((tok0 - 4096) & 1023) : (tok0 & 255);
            const float rstd = __shfl(P.rstd[mt >> 2], 16 * (mt & 3) + c15);
            float v[4][4];
#pragma unroll
            for (int nt = 0; nt < 4; ++nt) {
                const f32x4 bq = *(const LAS f32x4*)(bias + 16 * nt + 4 * g4);
#pragma unroll
                for (int i = 0; i < 4; ++i) v[nt][i] = acc[nt][mt][i] * rstd + bq[i];
            }
            const float tot = ckv_ss[mt] + ((const LAS float*)(F.lds + LDS_EX))[(wm * 2 + (wn ^ 1)) * 128 + mt * 16 + c15];
            const float r = rsqrtf(tot * (1.f / 128.f) + EPS);
#pragma unroll
            for (int nt = 0; nt < 4; ++nt)
#pragma unroll
                for (int i = 0; i < 4; ++i) v[nt][i] *= r;
            mulvec64(v, exb + 64, g4);
            const size_t orow0 = (size_t)(b * 4 + l) * 256 + t0;
            stage_write16(st, v, mh, c15, g4);
            if (mh) {
                if (!lat) stage_store_f32(st, outp + O_CKV + orow0 * 128 + wn * 64, 128, lane);
                stage_store_bf16_sc1(st, (bf16_t*)(ws + WS_CKVN) + (size_t)tok0 * 128 + wn * 64, 128, lane);
            }
        }
        }
        __syncthreads();
    }
}

__device__ __forceinline__ void qm_pre(const Frame& F, int tm, float& rstd) {
    const int tok = tm * 256 + (F.w >> 1) * 64 + F.lane;
    const f32x4 q4 = *(const f32x4*)((const float*)(F.ws + WS_CQSSQ) + (size_t)tok * 4);
    rstd = rsqrtf(((q4[0] + q4[1]) + (q4[2] + q4[3])) * (1.f / 256.f) + EPS);
}
__device__ __forceinline__ void epi_qm(const Frame& F, GemmAcc& acc, int tn, int tm, float rstdl) {
    int lane = F.lane; const int wn = F.w & 1, wm = F.w >> 1;
    asm volatile("" : "+v"(lane));
    const int c15 = lane & 15, g4 = lane >> 4;
    unsigned char* ws = F.ws;
    LAS float* st = (LAS float*)(F.lds + LDS_OST + F.w * OST_BYTES);
    const bool lat = tm >= 16;
    const int nb = tn * 128 + wn * 64;
    if (nb >= 576) return;
#pragma unroll
    for (int mt = 0; mt < 4; ++mt) {
        const int mh = mt & 1;
        const int tok0 = tm * 256 + wm * 64 + (mt >> 1) * 32, tok = tok0 + 16 * mh + c15;
        const int t = lat ? ((tok - 4096) & 1023) : (tok & 255);
        const float rstd = __shfl(rstdl, 16 * mt + c15);
        const float rowp = (float)(t >> 6), colp = (float)(t & 63);
        float v[4][4];
#pragma unroll
        for (int nt = 0; nt < 4; ++nt)
#pragma unroll
            for (int i = 0; i < 4; ++i) v[nt][i] = acc[nt][mt][i] * rstd;
#pragma unroll
        for (int q = 0; q < 2; ++q) {
            const int T = (nb + 32 * q) >> 5;
            if (lat && (T % 3) == 2) rope32_16(v[2 * q], v[2 * q + 1], rowp, colp, g4);
        }
        stage_write16(st, v, mh, c15, g4);
        if (mh) stage_store_bf16(st, (bf16_t*)(ws + WS_QM) + (size_t)tok0 * 576 + nb, 576, QSC_MLA, lane);
    }
}
__device__ __forceinline__ void epi_plain(const Frame& F, GemmAcc& acc, bf16_t* D, int ldd, int row0, int n0) {
    int lane = F.lane; const int wn = F.w & 1, wm = F.w >> 1;
    asm volatile("" : "+v"(lane));
    const int c15 = lane & 15, g4 = lane >> 4;
    LAS float* st = (LAS float*)(F.lds + LDS_OST + F.w * OST_BYTES);
#pragma unroll
    for (int mt = 0; mt < 4; ++mt) {
        const int r0 = row0 + wm * 64 + (mt >> 1) * 32;
        stage_write16a(st, acc, mt, c15, g4);
        if (mt & 1) stage_store_bf16(st, D + (size_t)r0 * ldd + n0 + wn * 64, ldd, 1.f, lane);
    }
}

struct Gemm2Pre { f32x4 gt0, gt1, gs0, gs1; };
__device__ __forceinline__ void gemm2_pre(const Frame& F, int tn, int tm, int l, Gemm2Pre& P) {
    const bool lat = tm >= 16; const int cond = lat ? 1 + ((tm - 16) >> 2) : 0;
    const int nb = tn * 128 + (F.w & 1) * 64, c8 = (F.lane & 7) * 8;
    const float* gtp = (const float*)(F.ws + WS_MODS) + (size_t)(l * 5 + cond) * 3072 + 2048 + nb + c8;
    const float* gsp = (const float*)(F.ws + WS_GS) + (size_t)((l < 3 ? l + 1 : 3) * 5 + cond) * 1024 + nb + c8;
    P.gt0 = *(const f32x4*)gtp; P.gt1 = *(const f32x4*)(gtp + 4);
    P.gs0 = *(const f32x4*)gsp; P.gs1 = *(const f32x4*)(gsp + 4);
}
__device__ __forceinline__ void epi_gemm2(const Frame& F, const Params& p, GemmAcc& acc, int tn, int tm, int l, const Gemm2Pre& P, bool last) {
    int lane = F.lane; const int wn = F.w & 1, wm = F.w >> 1;
    asm volatile("" : "+v"(lane));
    const int c15 = lane & 15, g4 = lane >> 4;
    unsigned char* ws = F.ws;
    LAS float* st = (LAS float*)(F.lds + LDS_OST + F.w * OST_BYTES);
    const bool lat = tm >= 16;
    const int nb = tn * 128 + wn * 64;
    const int c8 = (lane & 7) * 8, r8 = lane >> 3;
#pragma unroll
    for (int mt = 0; mt < 2; ++mt) {
        const int tok0 = tm * 256 + wm * 64 + mt * 32;
        bf16_t* xb0 = (bf16_t*)(ws + WS_XB) + (size_t)tok0 * 1024 + nb + c8;
        f32x4 xo8[8];
        if (l == 0) {
            const float* xold0 = lat ? pin(F, I_XS) + (size_t)(tok0 - 4096) * 1024 : pin(F, I_XP) + (size_t)tok0 * 1024;
#pragma unroll
            for (int it = 0; it < 4; ++it) {
                const float* xp = xold0 + (size_t)(it * 8 + r8) * 1024 + nb + c8;
                xo8[2 * it] = __builtin_nontemporal_load((const f32x4*)xp); xo8[2 * it + 1] = __builtin_nontemporal_load((const f32x4*)(xp + 4));
            }
        } else {
#pragma unroll
            for (int it = 0; it < 4; ++it) {
                const u32x4 q = *(const u32x4*)(xb0 + (size_t)(it * 8 + r8) * 1024);
                xo8[2 * it] = (f32x4){bflo(q.x), bfhi(q.x), bflo(q.y), bfhi(q.y)}; xo8[2 * it + 1] = (f32x4){bflo(q.z), bfhi(q.z), bflo(q.w), bfhi(q.w)};
            }
        }
        stage_write16a(st, acc, 2 * mt, c15, g4);
        stage_write16a(st, acc, 2 * mt + 1, c15, g4);
#pragma unroll
        for (int it = 0; it < 4; ++it) {
            const int row = it * 8 + r8;
            const f32x4 a0 = *(const LAS f32x4*)(st + row * OST_LD + c8), a1 = *(const LAS f32x4*)(st + row * OST_LD + c8 + 4);
            const f32x4 xn0 = xo8[2 * it] + P.gt0 * a0, xn1 = xo8[2 * it + 1] + P.gt1 * a1;
            {
                u32x4 o; o.x = pk2(xn0[0], xn0[1]); o.y = pk2(xn0[2], xn0[3]); o.z = pk2(xn1[0], xn1[1]); o.w = pk2(xn1[2], xn1[3]);
                if (last) ST16_WT(xb0 + (size_t)row * 1024, o); else *(u32x4*)(xb0 + (size_t)row * 1024) = o;
            }
            float ss = ((xn0[0] * xn0[0] + xn0[1] * xn0[1]) + (xn0[2] * xn0[2] + xn0[3] * xn0[3])) + ((xn1[0] * xn1[0] + xn1[1] * xn1[1]) + (xn1[2] * xn1[2] + xn1[3] * xn1[3]));
            ss += __shfl_xor(ss, 1); ss += __shfl_xor(ss, 2); ss += __shfl_xor(ss, 4);
            if ((lane & 7) == 0) {
                float* sq = (float*)(ws + WS_SSQ) + (size_t)(tok0 + row) * 16 + tn * 2 + wn;
                __hip_atomic_store((__attribute__((address_space(1))) float*)sq, ss, __ATOMIC_RELAXED, __HIP_MEMORY_SCOPE_AGENT);
            }
            if (l < 3) {
                u32x4 o; o.x = pk2(xn0[0] * P.gs0[0], xn0[1] * P.gs0[1]); o.y = pk2(xn0[2] * P.gs0[2], xn0[3] * P.gs0[3]);
                o.z = pk2(xn1[0] * P.gs1[0], xn1[1] * P.gs1[1]); o.w = pk2(xn1[2] * P.gs1[2], xn1[3] * P.gs1[3]);
                ST16_WT((bf16_t*)(ws + WS_XG) + (size_t)(tok0 + row) * 1024 + nb + c8, o);
            }
        }
    }
}

__device__ __forceinline__ void epi_kpe(const Frame& F, const Params& p, GemmAcc2& acc, int tm, int l, const Gemm1Pre& P) {
    int lane = F.lane; const int wm = F.w >> 2;
    asm volatile("" : "+v"(lane));
    const int c15 = lane & 15, g4 = lane >> 4;
    unsigned char* ws = F.ws;
    asm volatile("" : "+s"(ws));
    float* outp = p.out;
    asm volatile("" : "+s"(outp));
    LAS float* st = (LAS float*)(F.lds + LDS_OST + F.w * OST_BYTES);
    const bool lat = tm >= 16;
    const int b = lat ? ((tm - 16) >> 2) : tm;
    LAS float* exb = (LAS float*)(F.lds + LDS_EXB) + F.w * 128;
    exb[lane] = P.bias;
    asm volatile("s_waitcnt lgkmcnt(0)" ::: "memory");
    __builtin_amdgcn_wave_barrier();
#pragma unroll
    for (int mt = 0; mt < 8; ++mt) {
        const int mh = mt & 1;
        const int tok0 = tm * 256 + wm * 128 + (mt >> 1) * 32;
        const int t0 = lat ? ((tok0 - 4096) & 1023) : (tok0 & 255), t = t0 + 16 * mh + c15;
        const float rstd = __shfl(P.rstd[mt >> 2], 16 * (mt & 3) + c15);
        float v[4][4];
#pragma unroll
        for (int nt = 0; nt < 2; ++nt) {
            const f32x4 bq = *(const LAS f32x4*)(exb + 16 * nt + 4 * g4);
#pragma unroll
            for (int i = 0; i < 4; ++i) { v[nt][i] = acc[nt][mt][i] * rstd + bq[i]; v[2 + nt][i] = 0.f; }
        }
        const float rowp = (float)(t >> 6), colp = (float)(t & 63);
        const size_t orow0 = (size_t)(b * 4 + l) * 256 + t0;
        if (lat) rope32_16(v[0], v[1], rowp, colp, g4);
        stage_write16(st, v, mh, c15, g4);
        if (mh) {
            if (!lat) stage_store_f32_32(st, outp + O_KPE + orow0 * 32, 32, lane);
            stage_store_bf16_32(st, (bf16_t*)(ws + WS_KPEB) + (size_t)tok0 * 32, 32, lane);
        }
    }
}
constexpr int AT_STG = 20480, AT_PE = 8192, AT_V = 12288, AT_OLD = 68;
struct AttnUnit {
    int mode;
    int nt0, nt1;
    const bf16_t *q; int q_ld;
    const bf16_t *k0, *k1; int k_ld0, k_ld1;
    const bf16_t *pe0, *pe1;
    const bf16_t *v0, *v1; int v_ld0, v_ld1;
    int tok0;
    int ycol;
    int qpos0, L;
    float lf, lb;
    const bf16_t *s0f, *s0b;
    unsigned* zflag;
    unsigned* yflag;
    float* st_out;
};
__device__ __forceinline__ s16x4 tr16(LAS const unsigned char* p) {
    typedef short v4i16_t __attribute__((ext_vector_type(4)));
    return __builtin_bit_cast(s16x4, __builtin_amdgcn_ds_read_tr16_b64_v4i16((LAS v4i16_t*)p));
}

template <int MODE>
__device__ __forceinline__ void attn_unit(const Frame& F, const Params& p, const AttnUnit& U) {
    constexpr int NQS = MODE == 1 ? 6 : 4;
    int lane = F.lane; const int w = F.w;
    asm volatile("" : "+v"(lane));
    const int h = lane >> 5, lq = lane & 31;
    LAS unsigned char* lds = F.lds;
    const int k_ld = U.k_ld1, v_ld = U.v_ld1;
    const int krow = 8 * w + (lane >> 3);
    const int koff = krow * k_ld + ((lane & 7) ^ ((krow >> 1) & 7)) * 8;
    const int poff = (16 * (w & 3) + (lane >> 2)) * 32 + ((lane & 3) ^ ((lane >> 4) & 3)) * 8;
    const int vdblk = w >> 2, vkg = w & 3;
    const int voff = (16 * vkg + (lane >> 2)) * v_ld + vdblk * 32 + (lane & 3) * 8;
    const int vdst = AT_V + vdblk * 4096 + vkg * 1024;
    const int nt0 = U.nt0, ntot = U.nt0 + U.nt1;
    const unsigned ldsb = (unsigned)(uintptr_t)lds;
#define AT_DMA(gsrc, ldsoff) do { unsigned _keep; const unsigned _d = (unsigned)__builtin_amdgcn_readfirstlane((int)(ldsb + (unsigned)(ldsoff))); \
        asm volatile("s_mov_b32 %0, m0\n\ts_mov_b32 m0, %2\n\ts_nop 0\n\tglobal_load_lds_dwordx4 %1, off\n\ts_mov_b32 m0, %0" : "=&s"(_keep) : "v"(gsrc), "s"(_d) : "memory"); } while (0)
#define AT_ISSUE(t, st) do { const int _t = (t); const int _b = (st) * AT_STG; \
        const bool _s0 = _t < nt0; const int _u = _s0 ? _t : _t - nt0; \
        const bf16_t* _kb = (_s0 ? U.k0 : U.k1) + (size_t)_u * 64 * k_ld; const bf16_t* _vb = (_s0 ? U.v0 : U.v1) + (size_t)_u * 64 * v_ld; \
        AT_DMA(_kb + koff, _b + (8 * w) * 128); \
        if (MODE == 1) { const bf16_t* _pb = (_s0 ? U.pe0 : U.pe1) + (size_t)_u * 64 * 32; AT_DMA(_pb + poff, _b + AT_PE + 16 * (w & 3) * 64); } \
        AT_DMA(_vb + voff, _b + vdst); } while (0)
    bf16x8 qr[NQS];
    if (MODE == 3) {
        const int dk = 32 * (w & 1) + lq;
#pragma unroll
        for (int s = 0; s < 4; ++s)
#pragma unroll
            for (int j = 0; j < 8; ++j) qr[s][j] = (16 * s + 8 * h + j == dk) ? (short)0x3F80 : (short)0;
    } else {
        const bf16_t* qp = U.q + (size_t)(32 * w + lq) * U.q_ld + 8 * h;
#pragma unroll
        for (int s = 0; s < NQS; ++s) qr[s] = *(const bf16x8*)(qp + 16 * s);
    }
    AT_ISSUE(0, 0);
    if (ntot > 1) AT_ISSUE(1, 1);
    f32x16 o[2];
#pragma unroll
    for (int d = 0; d < 2; ++d)
#pragma unroll
        for (int r = 0; r < 16; ++r) o[d][r] = 0.f;
    float m_run = 0.f, l_run = 0.f;
    f32x16 negm;
#pragma unroll
    for (int r = 0; r < 16; ++r) negm[r] = 0.f;
    const int qpos = U.qpos0 + 32 * w + lq;
    const float st_slope = ((w >> 1) & 1) ? U.lb : -U.lf, st_off = ((w >> 1) & 1) ? 0.f : 255.f * U.lf;
    const int sdir = (w >> 1) & 1;
    LAS float* scal = (LAS float*)(lds + LDS_SCAL) + w * 32;
    LAS float* ctab = (LAS float*)(lds + LDS_EXB) + w * 128;
    float a_f = 0.f, a_b = 0.f;
    if (MODE == 2) {
        ctab[lane] = __builtin_amdgcn_exp2f((float)(63 - lane) * U.lf);
        ctab[64 + lane] = __builtin_amdgcn_exp2f((float)lane * U.lb);
        a_f = __builtin_amdgcn_exp2f((float)(32 * w + lq) * U.lf);
        a_b = __builtin_amdgcn_exp2f((float)(255 - 32 * w - lq) * U.lb);
        asm volatile("s_waitcnt lgkmcnt(0)" ::: "memory");
        __builtin_amdgcn_wave_barrier();
    }
    const int kfo = lq * 128, sw = (lane >> 1) & 7, pfo = AT_PE + lq * 64, psw = (lane >> 2) & 3;
    const int vfo = AT_V + (4 * h + ((lane & 15) >> 2)) * 64 + ((lane >> 4) & 1) * 32 + (lane & 3) * 8;
    int st = 0;
    for (int t = 0; t < ntot; ++t) {
        if (t + 1 < ntot) { if (MODE == 1) asm volatile("s_waitcnt vmcnt(3)" ::: "memory"); else asm volatile("s_waitcnt vmcnt(2)" ::: "memory"); }
        else asm volatile("s_waitcnt vmcnt(0)" ::: "memory");
        __builtin_amdgcn_s_barrier();
        asm volatile("" ::: "memory");
        const int st2 = st == 0 ? 2 : st - 1;
        LAS const unsigned char* base = lds + st * AT_STG;
        bf16x8 kfa[NQS], kfb[NQS];
#pragma unroll
        for (int s = 0; s < 4; ++s) {
            const int so = ((2 * s + h) ^ sw) << 4;
            kfa[s] = *(const LAS bf16x8*)(base + kfo + so);
            kfb[s] = *(const LAS bf16x8*)(base + kfo + 4096 + so);
        }
        if (MODE == 1) {
#pragma unroll
            for (int s = 0; s < 2; ++s) {
                const int so = ((2 * s + h) ^ psw) << 4;
                kfa[4 + s] = *(const LAS bf16x8*)(base + pfo + so);
                kfb[4 + s] = *(const LAS bf16x8*)(base + pfo + 2048 + so);
            }
        }
        f32x16 p0, p1;
        if (MODE <= 1) { p0 = negm; p1 = negm; }
        else {
#pragma unroll
            for (int r = 0; r < 16; ++r) { p0[r] = 0.f; p1[r] = 0.f; }
        }
#pragma unroll
        for (int s = 0; s < NQS; ++s) { p0 = MFMA32(kfa[s], qr[s], p0); p1 = MFMA32(kfb[s], qr[s], p1); }
        s16x4 vlo[4], vhi[4];
#pragma unroll
        for (int ks = 0; ks < 4; ++ks) { vlo[ks] = tr16(base + vfo + ks * 1024); vhi[ks] = tr16(base + vfo + ks * 1024 + 512); }
        if (MODE <= 1) {
            float tm = p0[0];
#pragma unroll
            for (int r = 1; r < 16; ++r) tm = fmaxf(tm, p0[r]);
#pragma unroll
            for (int r = 0; r < 16; ++r) tm = fmaxf(tm, p1[r]);
            tm = fmaxf(tm, __shfl_xor(tm, 32));
            if (t == 0 || __any(tm > 6.0f)) {
                const float dl = t == 0 ? tm : fmaxf(tm, 0.f);
                m_run += dl;
#pragma unroll
                for (int r = 0; r < 16; ++r) { p0[r] -= dl; p1[r] -= dl; negm[r] = -m_run; }
                if (t > 0) {
                    const float alpha = __builtin_amdgcn_exp2f(-dl);
                    l_run *= alpha;
                    if (h == 0) scal[lq] = alpha;
                    asm volatile("s_waitcnt lgkmcnt(0)" ::: "memory");
#pragma unroll
                    for (int g = 0; g < 4; ++g) {
                        const f32x4 a4 = *(const LAS f32x4*)(scal + 8 * g + 4 * h);
#pragma unroll
                        for (int i = 0; i < 4; ++i) { o[0][4 * g + i] *= a4[i]; o[1][4 * g + i] *= a4[i]; }
                    }
                }
            }
            float ls = 0.f;
#pragma unroll
            for (int r = 0; r < 16; ++r) { p0[r] = __builtin_amdgcn_exp2f(p0[r]); p1[r] = __builtin_amdgcn_exp2f(p1[r]); ls += p0[r] + p1[r]; }
            l_run += ls;
        } else if (MODE == 2 && (64 * t + 63 < U.qpos0 || 64 * t > U.qpos0 + 255)) {
            const bool fwd = 64 * t + 63 < U.qpos0;
            const float A = fwd ? a_f * __builtin_amdgcn_exp2f((float)(U.qpos0 - 64 * t - 63) * U.lf) : a_b * __builtin_amdgcn_exp2f((float)(64 * t - U.qpos0 - 255) * U.lb);
            const LAS float* tb = ctab + (fwd ? 0 : 64) + 4 * h;
#pragma unroll
            for (int g = 0; g < 4; ++g) {
                const f32x4 c0 = *(const LAS f32x4*)(tb + 8 * g), c1 = *(const LAS f32x4*)(tb + 32 + 8 * g);
#pragma unroll
                for (int i = 0; i < 4; ++i) { p0[4 * g + i] *= c0[i] * A; p1[4 * g + i] *= c1[i] * A; }
            }
        } else if (MODE == 2) {
            float dq = (float)(qpos - 64 * t - 4 * h);
            asm volatile("" : "+v"(dq));
#pragma unroll
            for (int r = 0; r < 16; ++r) {
                const float d0 = dq - (float)((r & 3) + 8 * (r >> 2)), d1 = d0 - 32.f;
                const float w0 = __builtin_amdgcn_exp2f(fabsf(d0) * (d0 > 0.f ? U.lf : U.lb));
                const float w1 = __builtin_amdgcn_exp2f(fabsf(d1) * (d1 > 0.f ? U.lf : U.lb));
                p0[r] *= (d0 == 0.f ? 2.f : w0);
                p1[r] *= (d1 == 0.f ? 2.f : w1);
            }
        } else {
            float mb = (float)(64 * t + 4 * h);
            asm volatile("" : "+v"(mb));
#pragma unroll
            for (int r = 0; r < 16; ++r) {
                const float m0 = mb + (float)((r & 3) + 8 * (r >> 2)), m1 = m0 + 32.f;
                const float e0 = fmaf(m0, st_slope, st_off), e1 = fmaf(m1, st_slope, st_off);
                p0[r] *= __builtin_amdgcn_exp2f(e0);
                p1[r] *= __builtin_amdgcn_exp2f(e1);
            }
        }
        if (t + 2 < ntot) AT_ISSUE(t + 2, st2);
        bf16x8 pa[4];
        { u32x4 a;
          a.x = pk2(p0[0], p0[1]); a.y = pk2(p0[2], p0[3]); a.z = pk2(p0[4], p0[5]); a.w = pk2(p0[6], p0[7]); pa[0] = __builtin_bit_cast(bf16x8, a);
          a.x = pk2(p0[8], p0[9]); a.y = pk2(p0[10], p0[11]); a.z = pk2(p0[12], p0[13]); a.w = pk2(p0[14], p0[15]); pa[1] = __builtin_bit_cast(bf16x8, a);
          a.x = pk2(p1[0], p1[1]); a.y = pk2(p1[2], p1[3]); a.z = pk2(p1[4], p1[5]); a.w = pk2(p1[6], p1[7]); pa[2] = __builtin_bit_cast(bf16x8, a);
          a.x = pk2(p1[8], p1[9]); a.y = pk2(p1[10], p1[11]); a.z = pk2(p1[12], p1[13]); a.w = pk2(p1[14], p1[15]); pa[3] = __builtin_bit_cast(bf16x8, a); }
#pragma unroll
        for (int ks = 0; ks < 4; ++ks) {
            const bf16x8 vb = __builtin_shufflevector(vlo[ks], vhi[ks], 0, 1, 2, 3, 4, 5, 6, 7);
            o[0] = MFMA32(pa[ks], vb, o[0]);
        }
#pragma unroll
        for (int ks = 0; ks < 4; ++ks) { vlo[ks] = tr16(base + vfo + 4096 + ks * 1024); vhi[ks] = tr16(base + vfo + 4096 + ks * 1024 + 512); }
#pragma unroll
        for (int ks = 0; ks < 4; ++ks) {
            const bf16x8 vb = __builtin_shufflevector(vlo[ks], vhi[ks], 0, 1, 2, 3, 4, 5, 6, 7);
            o[1] = MFMA32(pa[ks], vb, o[1]);
        }
        st = st == 2 ? 0 : st + 1;
    }
#undef AT_ISSUE
#undef AT_DMA
    int lq2 = lq, h2 = h, lane2 = lane; asm volatile("" : "+v"(lq2), "+v"(h2), "+v"(lane2));
    if (MODE == 2 && U.s0f != nullptr) {
        const float ff = __builtin_amdgcn_exp2f((float)(qpos + 1) * U.lf), fb = __builtin_amdgcn_exp2f((float)(U.L - qpos) * U.lb);
#pragma unroll
        for (int s = 0; s < 4; ++s) {
            const u32x4 qu = __builtin_bit_cast(u32x4, qr[s]);
            u32x4 af, ab;
#pragma unroll
            for (int i = 0; i < 4; ++i) { const float lo = bflo(qu[i]), hi = bfhi(qu[i]); af[i] = pk2(lo * ff, hi * ff); ab[i] = pk2(lo * fb, hi * fb); }
#pragma unroll
            for (int d = 0; d < 2; ++d) {
                const bf16x8 sf = *(const bf16x8*)(U.s0f + (size_t)(32 * d + lq2) * 64 + 16 * s + 8 * h2);
                const bf16x8 sb = *(const bf16x8*)(U.s0b + (size_t)(32 * d + lq2) * 64 + 16 * s + 8 * h2);
                o[d] = MFMA32(__builtin_bit_cast(bf16x8, af), sf, o[d]);
                o[d] = MFMA32(__builtin_bit_cast(bf16x8, ab), sb, o[d]);
            }
        }
    }
    if (MODE == 3) {
        float* dst = U.st_out + (size_t)sdir * 4 * 4096 + (size_t)(32 * (w & 1)) * 64;
        if (w < 4) {
#pragma unroll
        for (int d = 0; d < 2; ++d)
#pragma unroll
            for (int r = 0; r < 16; ++r) dst[(size_t)((r & 3) + 8 * (r >> 2) + 4 * h2) * 64 + 32 * d + lq2] = o[d][r];
        }
        __syncthreads();
        if (F.tid == 0 && U.yflag != nullptr) (void)xb_add(U.yflag, 1u);
        return;
    }
    if (MODE <= 1) {
        l_run += __shfl_xor(l_run, 32);
        if (h2 == 0) scal[lq2] = 1.f / l_run;
    }
    if (U.zflag != nullptr && F.tid == 0) {
        unsigned* bar0 = (unsigned*)(F.ws + WS_CTL) + CW_BAR;
        XB_SPIN(xb_ld(U.zflag) < 4u, bar0);
    }
    __syncthreads();
    const bf16_t* zs = (const bf16_t*)(F.ws + WS_ZS);
    u32x4 zz[4];
#pragma unroll
    for (int it = 0; it < 4; ++it) zz[it] = *(const u32x4*)(zs + (size_t)(U.tok0 + 32 * w + it * 8 + (lane2 >> 3)) * 1024 + U.ycol + (lane2 & 7) * 8);
    LAS float* ost = (LAS float*)lds + w * (32 * AT_OLD);
#pragma unroll
    for (int d = 0; d < 2; ++d)
#pragma unroll
        for (int r = 0; r < 16; ++r) ost[((r & 3) + 8 * (r >> 2) + 4 * h2) * AT_OLD + 32 * d + lq2] = o[d][r];
    asm volatile("s_waitcnt lgkmcnt(0)" ::: "memory");
    __builtin_amdgcn_wave_barrier();
    bf16_t* yb = (bf16_t*)(F.ws + WS_Y);
#pragma unroll
    for (int it = 0; it < 4; ++it) {
        const int row = it * 8 + (lane2 >> 3), c8 = (lane2 & 7) * 8;
        const f32x4 x0 = *(const LAS f32x4*)(ost + row * AT_OLD + c8), x1 = *(const LAS f32x4*)(ost + row * AT_OLD + c8 + 4);
        float sc;
        if (MODE <= 1) sc = scal[row];
        else {
            float ss = (x0[0] * x0[0] + x0[1] * x0[1]) + (x0[2] * x0[2] + x0[3] * x0[3]) + (x1[0] * x1[0] + x1[1] * x1[1]) + (x1[2] * x1[2] + x1[3] * x1[3]);
            ss += __shfl_xor(ss, 1); ss += __shfl_xor(ss, 2); ss += __shfl_xor(ss, 4);
            sc = rsqrtf(ss * (1.f / 64.f) + EPS);
        }
        const size_t off = (size_t)(U.tok0 + 32 * w + row) * 1024 + U.ycol + c8;
        const u32x4 z = zz[it];
        u32x4 y;
        y.x = pk2(x0[0] * sc * bflo(z.x), x0[1] * sc * bfhi(z.x));
        y.y = pk2(x0[2] * sc * bflo(z.y), x0[3] * sc * bfhi(z.y));
        y.z = pk2(x1[0] * sc * bflo(z.z), x1[1] * sc * bfhi(z.z));
        y.w = pk2(x1[2] * sc * bflo(z.w), x1[3] * sc * bfhi(z.w));
        ST16_WT(yb + off, y);
    }
    asm volatile("s_waitcnt vmcnt(0)" ::: "memory");
    __syncthreads();
    if (F.tid == 0) (void)xb_add(U.yflag, 1u);
}

__device__ __forceinline__ void dep_wait(const Frame& F, unsigned* c, int n, unsigned target, unsigned* c2 = nullptr, unsigned target2 = 0u) {
    if (F.w == 0) {
        const int ln = lane_id();
        unsigned* ptr = c + 4 * ln; unsigned tgt = target;
        if (c2 != nullptr && ln == n) { ptr = c2; tgt = target2; }
        poll_lanes(ptr, tgt, ln < n + (c2 != nullptr ? 1 : 0), (unsigned*)(F.ws + WS_CTL) + CW_BAR);
    }
}
__device__ __forceinline__ void attn_dispatch(const Frame& F, const Params& p, int u, int l) {
    unsigned char* ws = F.ws;
    AttnUnit U;
    U.nt0 = 0; U.nt1 = 0; U.q = nullptr; U.q_ld = 0; U.k0 = U.k1 = nullptr; U.k_ld0 = U.k_ld1 = 0; U.pe0 = U.pe1 = nullptr; U.v0 = U.v1 = nullptr; U.v_ld0 = U.v_ld1 = 0;
    U.tok0 = 0; U.ycol = 0; U.qpos0 = 0; U.L = 0; U.lf = U.lb = 0.f; U.s0f = U.s0b = nullptr; U.st_out = nullptr; U.mode = 0; U.yflag = nullptr; U.zflag = nullptr;
    const bf16_t* GQ = (const bf16_t*)(ws + WS_GQ); const bf16_t* GK = (const bf16_t*)(ws + WS_GK); const bf16_t* GV = (const bf16_t*)(ws + WS_GV);
    const bf16_t* QM = (const bf16_t*)(ws + WS_QM); const bf16_t* KVM = (const bf16_t*)(ws + WS_KVM); const bf16_t* KVMC = (const bf16_t*)(ws + WS_KVMC);
    const bf16_t* KPEB = (const bf16_t*)(ws + WS_KPEB); const bf16_t* CKPE = (const bf16_t*)(ws + WS_CKPE);
    const bf16_t* CGK = (const bf16_t*)(ws + WS_CGK); const bf16_t* CGV = (const bf16_t*)(ws + WS_CGV);
    const bf16_t* RQ = (const bf16_t*)(ws + WS_RQ); const bf16_t* RK = (const bf16_t*)(ws + WS_RK); const bf16_t* RV = (const bf16_t*)(ws + WS_RV);
    const float* decay = pin(F, I_DECAY) + l * 8;
    if (u < 96 || (u >= 256 && u < 352)) {
        const bool lat = u < 96; const int uu = lat ? u : u - 256;
        const int b = lat ? uu / 24 : uu / 6, hh = lat ? (uu >> 2) % 6 : uu % 6, qb = lat ? (uu & 3) : 0;
        const int seq0 = lat ? 4096 + b * 1024 : b * 256;
        U.mode = 1; U.tok0 = seq0 + qb * 256; U.q = QM + (size_t)U.tok0 * 576 + hh * 96; U.q_ld = 576; U.ycol = 640 + hh * 64;
        U.nt1 = lat ? 16 : 4; U.k1 = KVM + (size_t)seq0 * 768 + hh * 128; U.k_ld1 = 768; U.v1 = U.k1 + 64; U.v_ld1 = 768; U.pe1 = KPEB + (size_t)seq0 * 32;
        U.k0 = U.k1; U.v0 = U.v1; U.pe0 = U.pe1; U.k_ld0 = 768; U.v_ld0 = 768;
        if (lat) { U.nt0 = 8; U.k0 = KVMC + (size_t)(b * 512) * 768 + hh * 128; U.v0 = U.k0 + 64; U.pe0 = CKPE + (size_t)((b * 4 + l) * 512) * 32; }
        U.yflag = (unsigned*)(ws + WS_CTL) + CW_YRDY + (l * 32 + (U.tok0 >> 8)) * 4;
        { unsigned* c = (unsigned*)(ws + WS_CTL);
          dep_wait(F, c + CW_FULL + (l * 32 + (seq0 >> 8)) * 4, lat ? 4 : 1, 23u, lat ? c + CW_KC + (l * 4 + b) * 4 : nullptr, 12u); }
        __syncthreads();
        attn_unit<1>(F, p, U);
    } else if (u < 192 || (u >= 352 && u < 448)) {
        const bool lat = u < 192; const int uu = lat ? u - 96 : u - 352;
        const int b = lat ? uu / 24 : uu / 6, hh = lat ? (uu >> 2) % 6 : uu % 6, qb = lat ? (uu & 3) : 0, kvh = hh / 3;
        const int seq0 = lat ? 4096 + b * 1024 : b * 256;
        U.mode = 0; U.tok0 = seq0 + qb * 256; U.q = GQ + (size_t)U.tok0 * 384 + hh * 64; U.q_ld = 384; U.ycol = 256 + hh * 64;
        U.nt1 = lat ? 16 : 4; U.k1 = GK + (size_t)seq0 * 128 + kvh * 64; U.k_ld1 = 128; U.v1 = GV + (size_t)seq0 * 128 + kvh * 64; U.v_ld1 = 128;
        U.k0 = U.k1; U.v0 = U.v1; U.k_ld0 = 128; U.v_ld0 = 128;
        if (lat) { U.nt0 = 8; U.k0 = CGK + (size_t)((b * 4 + l) * 512) * 128 + kvh * 64; U.v0 = CGV + (size_t)((b * 4 + l) * 512) * 128 + kvh * 64; }
        U.yflag = (unsigned*)(ws + WS_CTL) + CW_YRDY + (l * 32 + (U.tok0 >> 8)) * 4;
        { unsigned* c = (unsigned*)(ws + WS_CTL);
          dep_wait(F, c + CW_RA + (l * 32 + (seq0 >> 8)) * 4, lat ? 4 : 1, 8u);
          U.zflag = c + CW_ZC + (l * 32 + (U.tok0 >> 8)) * 4; }
        __syncthreads();
        attn_unit<0>(F, p, U);
    } else if (u < 256 || (u >= 448 && u < 512)) {
        const bool lat = u < 256; const int uu = lat ? u - 192 : u - 448;
        const int b = lat ? uu / 16 : uu / 4, hh = lat ? (uu >> 2) & 3 : uu & 3, qb = lat ? (uu & 3) : 0;
        const int seq0 = lat ? 4096 + b * 1024 : b * 256;
        U.mode = 2; U.tok0 = seq0 + qb * 256; U.q = RQ + (size_t)U.tok0 * 256 + hh * 64; U.q_ld = 256; U.ycol = hh * 64;
        U.nt1 = lat ? 16 : 4; U.k1 = RK + (size_t)seq0 * 256 + hh * 64; U.k_ld1 = 256; U.v1 = RV + (size_t)seq0 * 256 + hh * 64; U.v_ld1 = 256;
        U.k0 = U.k1; U.v0 = U.v1; U.k_ld0 = 256; U.v_ld0 = 256;
        U.qpos0 = qb * 256; U.L = lat ? 1024 : 256;
        U.lf = -log1pf(__expf(-decay[hh])) * LOG2E; U.lb = -log1pf(__expf(-decay[4 + hh])) * LOG2E;
        if (lat) { const bf16_t* S0T = (const bf16_t*)(ws + WS_S0T); U.s0f = S0T + (size_t)(((b * 4 + l) * 2 + 0) * 4 + hh) * 4096; U.s0b = S0T + (size_t)(((b * 4 + l) * 2 + 1) * 4 + hh) * 4096; }
        U.yflag = (unsigned*)(ws + WS_CTL) + CW_YRDY + (l * 32 + (U.tok0 >> 8)) * 4;
        { unsigned* c = (unsigned*)(ws + WS_CTL);
          dep_wait(F, c + CW_RA + (l * 32 + (seq0 >> 8)) * 4, lat ? 4 : 1, 8u);
          U.zflag = c + CW_ZC + (l * 32 + (U.tok0 >> 8)) * 4; }
        __syncthreads();
        attn_unit<2>(F, p, U);
    } else {
        const int uu = u - 512, b = uu >> 2, hh = uu & 3, seq0 = b * 256;
        U.mode = 3; U.nt1 = 4; U.k1 = RK + (size_t)seq0 * 256 + hh * 64; U.k_ld1 = 256; U.v1 = RV + (size_t)seq0 * 256 + hh * 64; U.v_ld1 = 256;
        U.k0 = U.k1; U.v0 = U.v1; U.k_ld0 = 256; U.v_ld0 = 256;
        U.lf = -log1pf(__expf(-decay[hh])) * LOG2E; U.lb = -log1pf(__expf(-decay[4 + hh])) * LOG2E;
        U.st_out = p.out + O_STATE + (size_t)(((b * 4 + l) * 2 + 0) * 4 + hh) * 4096;
        dep_wait(F, (unsigned*)(ws + WS_CTL) + CW_RA + (l * 32 + b) * 4, 1, 8u);
        U.yflag = (unsigned*)(ws + WS_CTL) + CW_SD + (l * 16 + b) * 4;
        __syncthreads();
        attn_unit<3>(F, p, U);
    }
}
constexpr int N_ATTN_UNITS = 576;
struct TItem { const float* src; bf16_t* dst; int nsrc, K; int valid; };
constexpr int P0_TWIN = 4 * 16 * 92, P0_TWOUT = 4 * 16 * 32, P0_TWUQ = 4 * 4 * 20, P0_TWUKV = 4 * 2 * 24, P0_TR = P0_TWIN + P0_TWOUT + P0_TWUQ + P0_TWUKV;
__device__ __forceinline__ TItem p0_titem(const Frame& F, unsigned char* ws, int it) {
    TItem t; t.valid = it < P0_TR; t.src = nullptr; t.dst = nullptr; t.nsrc = 0; t.K = 0;
    if (!t.valid) return t;
    if (it < P0_TWIN) {
        const int l = it / (16 * 92), r = it % (16 * 92), kb = r / 92, nb = r % 92, n0 = nb * 32;
        const int src = n0 < 1792 ? n0 : (n0 < 2816 ? n0 + 32 : (n0 < 2848 ? n0 - 2816 + 1792 : -1));
        t.nsrc = 2848; t.K = 1024;
        if (src >= 0) t.src = pin(F, I_WIN) + (size_t)l * 1024 * 2848 + (size_t)(kb * 64) * 2848 + src;
        t.dst = (bf16_t*)(ws + WS_WIN) + ((size_t)l * 2944 + n0) * 1024 + kb * 64;
        return t;
    }
    it -= P0_TWIN;
    if (it < P0_TWOUT) {
        const int l = it / 512, r = it % 512, kb = r >> 5, nb = r & 31;
        t.nsrc = 1024; t.K = 1024; t.src = pin(F, I_WOUT) + (size_t)l * 1024 * 1024 + (size_t)(kb * 64) * 1024 + nb * 32;
        t.dst = (bf16_t*)(ws + WS_WOUT) + ((size_t)l * 1024 + nb * 32) * 1024 + kb * 64;
        return t;
    }
    it -= P0_TWOUT;
    if (it < P0_TWUQ) {
        const int l = it / 80, r = it % 80, kb = r / 20, nb = r % 20;
        t.nsrc = 576; t.K = 256; if (nb < 18) t.src = pin(F, I_WUQ) + (size_t)l * 256 * 576 + (size_t)(kb * 64) * 576 + nb * 32;
        t.dst = (bf16_t*)(ws + WS_WUQ) + ((size_t)l * 640 + nb * 32) * 256 + kb * 64;
        return t;
    }
    it -= P0_TWUQ;
    { const int l = it / 48, r = it % 48, kb = r / 24, nb = r % 24;
      t.nsrc = 768; t.K = 128; t.src = pin(F, I_WUKV) + (size_t)l * 128 * 768 + (size_t)(kb * 64) * 768 + nb * 32;
      t.dst = (bf16_t*)(ws + WS_WUKV) + ((size_t)l * 768 + nb * 32) * 128 + kb * 64; }
    return t;
}
__device__ __forceinline__ void p0_tload(const TItem& t, float (&r)[32], int lane) {
    if (t.valid && t.src) {
        const float* wp = t.src + (size_t)(lane >> 5) * t.nsrc + (lane & 31);
#pragma unroll
        for (int i = 0; i < 32; ++i) r[i] = __builtin_nontemporal_load(wp + (size_t)(2 * i) * t.nsrc);
    } else {
#pragma unroll
        for (int i = 0; i < 32; ++i) r[i] = 0.f;
    }
}
__device__ __forceinline__ void p0_tstore(const TItem& t, const float (&r)[32], LAS float* scr, int lane) {
    if (!t.valid) return;
#pragma unroll
    for (int i = 0; i < 32; ++i) scr[(2 * i + (lane >> 5)) * 33 + (lane & 31)] = r[i];
    asm volatile("s_waitcnt lgkmcnt(0)" ::: "memory");
    __builtin_amdgcn_wave_barrier();
    const int c = lane & 7;
#pragma unroll
    for (int j = 0; j < 4; ++j) {
        const int n = (lane >> 3) + 8 * j; const LAS float* s = scr + (8 * c) * 33 + n;
        u32x4 o; o.x = pk2(s[0 * 33], s[1 * 33]); o.y = pk2(s[2 * 33], s[3 * 33]); o.z = pk2(s[4 * 33], s[5 * 33]); o.w = pk2(s[6 * 33], s[7 * 33]);
        ST16_WT(t.dst + (size_t)n * t.K + 8 * c, o);
    }
    asm volatile("s_waitcnt lgkmcnt(0)" ::: "memory");
    __builtin_amdgcn_wave_barrier();
}
__device__ __forceinline__ void cast8x4(const float* src, bf16_t* dst, size_t e0) {
    f32x4 a[4], b[4];
#pragma unroll
    for (int q = 0; q < 4; ++q) { a[q] = __builtin_nontemporal_load((const f32x4*)(src + e0 + q * 512)); b[q] = __builtin_nontemporal_load((const f32x4*)(src + e0 + q * 512 + 4)); }
#pragma unroll
    for (int q = 0; q < 4; ++q) {
        u32x4 o; o.x = pk2(a[q][0], a[q][1]); o.y = pk2(a[q][2], a[q][3]); o.z = pk2(b[q][0], b[q][1]); o.w = pk2(b[q][2], b[q][3]);
        ST16_WT(dst + e0 + q * 512, o);
    }
}
__device__ __forceinline__ void cast8(const float* src, bf16_t* dst, size_t e) {
    const f32x4 a = __builtin_nontemporal_load((const f32x4*)(src + e)), b = __builtin_nontemporal_load((const f32x4*)(src + e + 4));
    u32x4 o; o.x = pk2(a[0], a[1]); o.y = pk2(a[2], a[3]); o.z = pk2(b[0], b[1]); o.w = pk2(b[2], b[3]);
    ST16_WT(dst + e, o);
}
constexpr int P0_MODS = 1536, P0_CAST_G = 512, P0_CAST_KPE = 128, P0_S0T = 512;
constexpr int P0_TOTAL = P0_MODS + 3 * P0_CAST_G + P0_CAST_KPE + P0_S0T;
__device__ __forceinline__ void phase0(const Frame& F, const Params& p, bool dup = false) {
    unsigned char* ws = F.ws + (dup ? 162 * MiB : 0); const int lane = F.lane;
    LAS float* scr = (LAS float*)F.lds + F.w * (64 * 33);
    const int gw = blockIdx.x * NWAVE + F.w, ngw = gridDim.x * NWAVE;
#ifndef MK_DUP0
#define MK_DUP0_ 0
#else
#define MK_DUP0_ MK_DUP0
#endif
    if (!(dup && MK_DUP0_ == 2))
    for (int it = gw; it < P0_TR; it += 2 * ngw) {
        const TItem t0 = p0_titem(F, ws, it), t1 = p0_titem(F, ws, it + ngw);
        float r0[32], r1[32];
        p0_tload(t0, r0, lane); p0_tload(t1, r1, lane);
        p0_tstore(t0, r0, scr, lane); p0_tstore(t1, r1, scr, lane);
    }
    if (!(dup && MK_DUP0_ == 1))
    for (int it0 = (gw + ngw - 256) % ngw; it0 < P0_TOTAL; it0 += ngw) {
        int it = it0;
        if (it < P0_MODS) {
            const int l = it / 384, cg = (it % 384) >> 5, ks = it & 31;
            const int j = cg * 256 + lane * 4;
            const float* wp = pin(F, I_WADA) + ((size_t)l * 1024 + ks * 32) * 3072 + j;
            const float* c = pin(F, I_C); const float* cc = pin(F, I_CCTX);
            float sv[3];
#pragma unroll
            for (int q = 0; q < 3; ++q) {
                const int idx = q * 64 + lane, n = idx >> 5, k = idx & 31;
                float x = 0.f;
                if (idx < 160) x = (n == 0) ? cc[ks * 32 + k] : c[(n - 1) * 1024 + ks * 32 + k];
                sv[q] = silu_f(x);
            }
            f32x4 acc[5];
#pragma unroll
            for (int n = 0; n < 5; ++n) acc[n] = (f32x4){0.f, 0.f, 0.f, 0.f};
#pragma unroll 1
            for (int k0 = 0; k0 < 32; k0 += 16) {
                f32x4 wv[16];
#pragma unroll
                for (int k = 0; k < 16; ++k) wv[k] = __builtin_nontemporal_load((const f32x4*)(wp + (size_t)(k0 + k) * 3072));
                __builtin_amdgcn_sched_barrier(0);
#pragma unroll
                for (int k = 0; k < 16; ++k)
#pragma unroll
                    for (int n = 0; n < 5; ++n) {
                        const float s = __int_as_float(__builtin_amdgcn_readlane(__float_as_int(sv[n >> 1]), 32 * (n & 1) + k0 + k));
                        acc[n] += wv[k] * s;
                    }
            }
            LAS f32x4* red = (LAS f32x4*)(F.lds + 69632);
#pragma unroll
            for (int n = 0; n < 5; ++n) red[(F.w * 5 + n) * 64 + lane] = acc[n];
            __syncthreads();
            if (F.tid < 320) {
                const int n = F.tid >> 6;
                f32x4 s = red[n * 64 + lane];
#pragma unroll
                for (int ww = 1; ww < 8; ++ww) s += red[(ww * 5 + n) * 64 + lane];
                if ((ks >> 3) == 0) s += *(const f32x4*)(pin(F, I_BADA) + l * 3072 + j);
                float* mods = (float*)(ws + WS_MODS) + (size_t)(l * 5 + n) * 3072 + j;
#pragma unroll
                for (int e = 0; e < 4; ++e) atomicAdd(mods + e, s[e]);
            }
            __syncthreads();
            continue;
        }
        it -= P0_MODS;
        if (it < 3 * P0_CAST_G) {
            const int which = it / P0_CAST_G, r = it % P0_CAST_G;
            const float* src = which == 0 ? pin(F, I_CGK) : (which == 1 ? pin(F, I_CGV) : pin(F, I_CCKV));
            bf16_t* dst = (bf16_t*)(ws + (which == 0 ? WS_CGK : (which == 1 ? WS_CGV : WS_CCKV)));
            cast8x4(src, dst, (size_t)r * 2048 + lane * 8);
            continue;
        }
        it -= 3 * P0_CAST_G;
        if (it < P0_CAST_KPE) {
            cast8x4(pin(F, I_CKPE), (bf16_t*)(ws + WS_CKPE), (size_t)it * 2048 + lane * 8);
            continue; }
        it -= P0_CAST_KPE;
        {
            const int mat = it >> 2, qd = it & 3, dv = qd * 16 + (lane >> 2), dk0 = (lane & 3) * 16;
            const float* s = pin(F, I_STATE) + (size_t)mat * 4096 + dv;
            float x[16];
#pragma unroll
            for (int i = 0; i < 16; ++i) x[i] = __builtin_nontemporal_load(s + (dk0 + i) * 64);
            u32x4 o0, o1;
            o0.x = pk2(x[0], x[1]); o0.y = pk2(x[2], x[3]); o0.z = pk2(x[4], x[5]); o0.w = pk2(x[6], x[7]);
            o1.x = pk2(x[8], x[9]); o1.y = pk2(x[10], x[11]); o1.z = pk2(x[12], x[13]); o1.w = pk2(x[14], x[15]);
            bf16_t* d = (bf16_t*)(ws + WS_S0T) + (size_t)mat * 4096 + dv * 64 + dk0;
            ST16_WT(d, o0); ST16_WT(d + 8, o1);
        }
    }
}
constexpr int P1_GS = 80, P1_BIAS = 4 * 368, P1_X = 8192, P1_TOTAL = P1_GS + P1_BIAS + P1_X;
__device__ __forceinline__ void xg_row(const Frame& F, const float* xrow, const float* g, const float* mods_c, bf16_t* xg_row_out, float* ssq_row, bool write_xg) {
    const int lane = F.lane;
    float ss = 0.f;
#pragma unroll
    for (int j = 0; j < 2; ++j) {
        const int k = j * 512 + lane * 8;
        const f32x4 x0 = *(const f32x4*)(xrow + k), x1 = *(const f32x4*)(xrow + k + 4);
        ss += ((x0[0] * x0[0] + x0[1] * x0[1]) + (x0[2] * x0[2] + x0[3] * x0[3])) + ((x1[0] * x1[0] + x1[1] * x1[1]) + (x1[2] * x1[2] + x1[3] * x1[3]));
        if (write_xg) {
            const f32x4 g0 = *(const f32x4*)(g + k), g1 = *(const f32x4*)(g + k + 4), s0 = *(const f32x4*)(mods_c + 1024 + k), s1 = *(const f32x4*)(mods_c + 1024 + k + 4);
            u32x4 o; o.x = pk2(x0[0] * g0[0] * (1.f + s0[0]), x0[1] * g0[1] * (1.f + s0[1])); o.y = pk2(x0[2] * g0[2] * (1.f + s0[2]), x0[3] * g0[3] * (1.f + s0[3]));
            o.z = pk2(x1[0] * g1[0] * (1.f + s1[0]), x1[1] * g1[1] * (1.f + s1[1])); o.w = pk2(x1[2] * g1[2] * (1.f + s1[2]), x1[3] * g1[3] * (1.f + s1[3]));
            ST16_WT(xg_row_out + k, o);
        }
    }
    ss = wsum(ss);
    if (lane < 16) ssq_row[lane] = lane == 0 ? ss : 0.f;
}
__device__ __forceinline__ void phase1(const Frame& F, const Params& p) {
    unsigned char* ws = F.ws; const int lane = F.lane;
    unsigned* ctl = (unsigned*)(ws + WS_CTL);
    const int gw = blockIdx.x * NWAVE + F.w, ngw = gridDim.x * NWAVE;
    const float* mods = (const float*)(ws + WS_MODS);
    for (int it0 = gw; it0 < P1_GS + P1_BIAS; it0 += ngw) {
        int it = it0;
        if (it < P1_GS) {
            const int e = it * 256 + lane * 4, lc = e >> 10, k = e & 1023, l = lc / 5;
            const f32x4 g = *(const f32x4*)(pin(F, I_NORMG) + l * 1024 + k), sc = *(const f32x4*)(mods + (size_t)lc * 3072 + 1024 + k);
            { const f32x4 o = g * (sc + 1.f); ST16_WT((float*)(ws + WS_GS) + e, o); }
            continue;
        }
        it -= P1_GS;
        {
            const int l = it / 368, n0 = (it % 368) * 8;
            f32x4 sh[5][4];
#pragma unroll
            for (int c = 0; c < 5; ++c) {
                const float* shp = mods + (size_t)(l * 5 + c) * 3072 + lane * 16;
#pragma unroll
                for (int i = 0; i < 4; ++i) sh[c][i] = *(const f32x4*)(shp + 4 * i);
            }
            const bf16_t* wr0 = (const bf16_t*)(ws + WS_WIN) + ((size_t)l * 2944 + n0) * 1024 + lane * 16;
            u32x4 w0[8], w1[8];
#pragma unroll
            for (int r = 0; r < 8; ++r) { w0[r] = *(const u32x4*)(wr0 + (size_t)r * 1024); w1[r] = *(const u32x4*)(wr0 + (size_t)r * 1024 + 8); }
#pragma unroll
            for (int r = 0; r < 8; ++r) {
                float wv[16];
#pragma unroll
                for (int i = 0; i < 4; ++i) { wv[2 * i] = bflo(w0[r][i]); wv[2 * i + 1] = bfhi(w0[r][i]); wv[8 + 2 * i] = bflo(w1[r][i]); wv[8 + 2 * i + 1] = bfhi(w1[r][i]); }
#pragma unroll
                for (int c = 0; c < 5; ++c) {
                    float d = 0.f;
#pragma unroll
                    for (int i = 0; i < 4; ++i) { const f32x4 s4 = sh[c][i]; d += (s4[0] * wv[4 * i] + s4[1] * wv[4 * i + 1]) + (s4[2] * wv[4 * i + 2] + s4[3] * wv[4 * i + 3]); }
                    d = wsum(d);
                    if (lane == 0) __hip_atomic_store((__attribute__((address_space(1))) float*)((float*)(ws + WS_BIAS) + (size_t)(l * 5 + c) * 2944 + n0 + r), d, __ATOMIC_RELAXED, __HIP_MEMORY_SCOPE_AGENT);
                }
            }
            if (l == 0) {
                asm volatile("s_waitcnt vmcnt(0)" ::: "memory");
                if (lane == 0) (void)xb_add(ctl + CW_P1B0, 1u);
            }
        }
    }
    for (int vb = blockIdx.x; vb < 256; vb += gridDim.x) {
        const int tm = vb & 31, part = vb >> 5;
        const bool lat = tm >= 16;
        const int cond = lat ? 1 + ((tm - 16) >> 2) : 0;
        const float* g = pin(F, I_NORMG); const float* sc = mods + (size_t)cond * 3072 + 1024;
#pragma unroll 1
        for (int i = 0; i < 4; i += 2) {
            const int tok = tm * 256 + part * 32 + F.w * 4 + i;
            const float* xa = lat ? pin(F, I_XS) + (size_t)(tok - 4096) * 1024 : pin(F, I_XP) + (size_t)tok * 1024;
            const float* xb = xa + 1024;
            bf16_t* oa = (bf16_t*)(ws + WS_XG) + (size_t)tok * 1024;
            float ssa = 0.f, ssb = 0.f;
#pragma unroll
            for (int j = 0; j < 2; ++j) {
                const int k = j * 512 + lane * 8;
                const f32x4 a0 = *(const f32x4*)(xa + k), a1 = *(const f32x4*)(xa + k + 4), b0 = *(const f32x4*)(xb + k), b1 = *(const f32x4*)(xb + k + 4);
                const f32x4 g0 = *(const f32x4*)(g + k), g1 = *(const f32x4*)(g + k + 4), s0 = *(const f32x4*)(sc + k), s1 = *(const f32x4*)(sc + k + 4);
                const f32x4 m0 = g0 * (s0 + 1.f), m1 = g1 * (s1 + 1.f);
                ssa += ((a0[0] * a0[0] + a0[1] * a0[1]) + (a0[2] * a0[2] + a0[3] * a0[3])) + ((a1[0] * a1[0] + a1[1] * a1[1]) + (a1[2] * a1[2] + a1[3] * a1[3]));
                ssb += ((b0[0] * b0[0] + b0[1] * b0[1]) + (b0[2] * b0[2] + b0[3] * b0[3])) + ((b1[0] * b1[0] + b1[1] * b1[1]) + (b1[2] * b1[2] + b1[3] * b1[3]));
                u32x4 o; o.x = pk2(a0[0] * m0[0], a0[1] * m0[1]); o.y = pk2(a0[2] * m0[2], a0[3] * m0[3]); o.z = pk2(a1[0] * m1[0], a1[1] * m1[1]); o.w = pk2(a1[2] * m1[2], a1[3] * m1[3]);
                ST16_WT(oa + k, o);
                o.x = pk2(b0[0] * m0[0], b0[1] * m0[1]); o.y = pk2(b0[2] * m0[2], b0[3] * m0[3]); o.z = pk2(b1[0] * m1[0], b1[1] * m1[1]); o.w = pk2(b1[2] * m1[2], b1[3] * m1[3]);
                ST16_WT(oa + 1024 + k, o);
            }
            ssa = wsum(ssa); ssb = wsum(ssb);
            if (lane < 32) {
                const float v = (lane & 15) == 0 ? (lane < 16 ? ssa : ssb) : 0.f;
                __hip_atomic_store((__attribute__((address_space(1))) float*)((float*)(ws + WS_SSQ) + (size_t)(tok + (lane >> 4)) * 16 + (lane & 15)), v, __ATOMIC_RELAXED, __HIP_MEMORY_SCOPE_AGENT);
            }
        }
        asm volatile("s_waitcnt vmcnt(0)" ::: "memory");
        __syncthreads();
        if (is_t0(F)) (void)xb_add(ctl + CW_P1X + tm * 4, 1u);
    }
    asm volatile("s_waitcnt vmcnt(0)" ::: "memory");
    __syncthreads();
    if (is_t0(F)) (void)xb_add(ctl + CW_P1DONE, 1u);
}
#ifndef MK_TIMING
#define MK_TIMING -1
#endif
constexpr int CW_TIME = 2048;
__device__ __forceinline__ void phase_final(const Frame& F, const Params& p) {
    const int lane = F.lane;
    float tf = 1.f;
    if (MK_TIMING >= 0) tf = __uint_as_float(__hip_atomic_load((unsigned*)(F.ws + WS_CTL) + CW_TIME, __ATOMIC_RELAXED, __HIP_MEMORY_SCOPE_AGENT));
    unsigned* ctl = (unsigned*)(F.ws + WS_CTL);
    for (int vb = blockIdx.x; vb < 256; vb += gridDim.x) {
        const int tm = vb & 31, part = vb >> 5;
        if (F.tid == 0) {
            XB_SPIN(xb_ld(ctl + CW_XRDY + tm * 4) < 8u, ctl + CW_BAR);
            __builtin_amdgcn_fence(__ATOMIC_ACQUIRE, "agent");
            asm volatile("s_waitcnt vmcnt(0)" ::: "memory");
        }
        __syncthreads();
#pragma unroll 1
        for (int i = 0; i < 4; ++i) {
            const int tok = tm * 256 + part * 32 + F.w * 4 + i;
            float ss = 0.f;
            if (lane < 16) ss = ((const float*)(F.ws + WS_SSQ))[(size_t)tok * 16 + lane];
            ss = wsum(ss);
            const float rstd = rsqrtf(ss * (1.f / 1024.f) + EPS);
            const bf16_t* xr = (const bf16_t*)(F.ws + WS_XB) + (size_t)tok * 1024; float* orow = p.out + (size_t)tok * 1024;
            u32x2 xq4[4]; f32x4 fn4[4];
#pragma unroll
            for (int j = 0; j < 4; ++j) { const int k = j * 256 + lane * 4; xq4[j] = *(const u32x2*)(xr + k); fn4[j] = *(const f32x4*)(pin(F, I_FNORM) + k); }
#pragma unroll
            for (int j = 0; j < 4; ++j) {
                const int k = j * 256 + lane * 4;
                const u32x2 xq = xq4[j];
                const f32x4 x = {bflo(xq.x), bfhi(xq.x), bflo(xq.y), bfhi(xq.y)}, fn = fn4[j];
                { const f32x4 o = x * fn * (rstd * tf); ST16_WT(orow + k, o); }
            }
        }
    }
}

__device__ __forceinline__ GemmOp a2_op(const Frame& F, int l, int j) {
    GemmOp g;
    if (j < 160) { const int tn = j >> 5, tm = j & 31; g.W = (const bf16_t*)(F.ws + WS_WUQ) + ((size_t)l * 640 + tn * 128) * 256; g.X = (const bf16_t*)(F.ws + WS_CQG) + (size_t)tm * 256 * 256; g.ldw = 256; g.ldx = 256; g.K = 256; }
    else if (j < 352) { const int jj = j - 160, tn = jj >> 5, tm = jj & 31; g.W = (const bf16_t*)(F.ws + WS_WUKV) + ((size_t)l * 768 + tn * 128) * 128; g.X = (const bf16_t*)(F.ws + WS_CKVN) + (size_t)tm * 256 * 128; g.ldw = 128; g.ldx = 128; g.K = 128; }
    else { const int jj = j - 352, tn = jj >> 3, tc = jj & 7, b = tc >> 1, jt = tc & 1; g.W = (const bf16_t*)(F.ws + WS_WUKV) + ((size_t)l * 768 + tn * 128) * 128;
           g.X = (const bf16_t*)(F.ws + WS_CCKV) + ((size_t)(b * 4 + l) * 512 + jt * 256) * 128; g.ldw = 128; g.ldx = 128; g.K = 128; }
    return g;
}
__device__ __forceinline__ int a2_item(int vb, int i) {
    const int c = (vb >> 5) - 4, tmw = vb & 31;
    if (i == 3) return 352 + 32 + tmw;
    if (c == 0) return i * 32 + tmw;
    if (c == 1) return i < 2 ? (3 + i) * 32 + tmw : 160 + tmw;
    if (c == 2) return 160 + (1 + i) * 32 + tmw;
    return i < 2 ? 160 + (4 + i) * 32 + tmw : 352 + tmw;
}
#ifndef MK_EN
#define MK_EN 0xff
#endif
#define EN(x) ((MK_EN >> (x)) & 1)
constexpr int PH_TOTAL = 19;
__global__ void __launch_bounds__(512, 2) mega(Params p) {
    extern __shared__ __attribute__((aligned(16))) unsigned char lds_raw[];
    Frame F;
    F.lds = (LAS unsigned char*)lds_raw;
    F.tid = threadIdx.x; F.lane = F.tid & 63; F.w = __builtin_amdgcn_readfirstlane(F.tid >> 6); F.h = F.lane >> 5; F.lq = F.lane & 31;
    F.ws = p.ws;
    F.karg = (karg_t)__builtin_amdgcn_kernarg_segment_ptr();
    volatile LAS unsigned* MISC = (volatile LAS unsigned*)(F.lds + LDS_MISC);
    if (F.tid < 64) MISC[F.tid] = 0u;
    __syncthreads();
    unsigned* ctl = (unsigned*)(p.ws + WS_CTL);
    XcdBarrier bar; bar.bar = ctl + CW_BAR; bar.x = 0; bar.st = nullptr;
    const bool multi = p.ph_hi - p.ph_lo > 1;
    if (multi) bar = xcd_barrier_post(ctl + CW_BAR, MISC + 8);
    bar.w = F.w;
    const int G = gridDim.x;
    const Frame F0 = F;
    for (int ph = p.ph_lo; ph < p.ph_hi; ++ph) {
        if (ph >= 2 && ph < 18 && ((ph - 2) & 3) == 1) continue;
        Frame F = F0;
        F.lane = (int)__builtin_amdgcn_mbcnt_hi(~0u, __builtin_amdgcn_mbcnt_lo(~0u, 0u));
        asm volatile("" : "+v"(F.lane));
        F.tid = (F.w << 6) | F.lane; F.h = F.lane >> 5; F.lq = F.lane & 31;
        asm volatile("" : "+s"(F.w), "+s"(F.ws), "+s"(F.karg));
        if (MK_TIMING >= 0 && blockIdx.x == 0 && F.tid == 0) {
            const unsigned long long now = __builtin_amdgcn_s_memrealtime();
            const unsigned long long prev = ((unsigned long long)MISC[17] << 32) | MISC[16];
            if (ph > p.ph_lo) { const int q = ph - 1; const int grp = q < 2 ? q : 2 + ((q - 2) & 3); if (grp == MK_TIMING) MISC[18] += (unsigned)(now - prev); }
            MISC[16] = (unsigned)now; MISC[17] = (unsigned)(now >> 32);
        }
#ifndef MK_REPEAT
#define MK_REPEAT -1
#endif
        int nrep = 1;
        if (MK_REPEAT >= 1) { const int grp = ph < 2 ? ph : (ph == 18 ? 6 : 2 + ((ph - 2) & 3)); if (grp == MK_REPEAT) nrep = (grp == 5) ? (ph == 5 ? 5 : 1) : 2; }
        for (int rep = 0; rep < nrep; ++rep) {
        if (rep > 0) xcd_barrier(bar);
        Frame F = F0;
        F.lane = (int)__builtin_amdgcn_mbcnt_hi(~0u, __builtin_amdgcn_mbcnt_lo(~0u, 0u));
        asm volatile("" : "+v"(F.lane));
        F.tid = (F.w << 6) | F.lane; F.h = F.lane >> 5; F.lq = F.lane & 31;
        asm volatile("" : "+s"(F.w), "+s"(F.ws), "+s"(F.karg));
        if (EN(0) && ph == 0) {
#if defined(MK_DUP0)
            for (int d = 0; d < 2; ++d) { int dd = d; asm volatile("" : "+s"(dd)); if (dd) xcd_barrier(bar); phase0(F, p, dd != 0); }
#else
            phase0(F, p);
#endif
        }
        else if (EN(1) && ph == 1) phase1(F, p);
        else if (EN(2) && ph == 18) phase_final(F, p);
        else {
            const int l = (ph - 2) >> 2, sub = (ph - 2) & 3;
            int bid = blockIdx.x; asm volatile("" : "+s"(bid));
            if (EN(3) && sub == 0) {
                const bf16_t* Wt = (const bf16_t*)(F.ws + WS_WIN) + (size_t)l * 2944 * 1024;
                const bf16_t* X = (const bf16_t*)(F.ws + WS_XG);
                unsigned* flags = ctl + CW_FLAG + l * 512;
                bool first = true;
                int waited_tm = -1;
                for (int j = bid; j < 12 * 32; j += G) {
                    const int tn2 = j >> 5, tm = j & 31;
                    const int jn = j + G; const bool hn = jn < 12 * 32 && (jn & 31) == tm;
                    if (l == 0 && tm != waited_tm) {
                        waited_tm = tm;
                        if (F.tid == 0) {
                            XB_SPIN(xb_ld(ctl + CW_P1X + tm * 4) < 8u, ctl + CW_BAR);
                            XB_SPIN(xb_ld(ctl + CW_P1B0) < 368u, ctl + CW_BAR);
                            __builtin_amdgcn_fence(__ATOMIC_ACQUIRE, "agent");
                            asm volatile("s_waitcnt vmcnt(0)" ::: "memory");
                        }
                        __syncthreads();
                        first = true;
                    }
                    if (l > 0 && tm != waited_tm) {
                        waited_tm = tm;
                        if (F.w == 0) {
                            const int ln = lane_id();
                            unsigned* ptr = ctl + CW_P1DONE; unsigned tgt = (unsigned)G;
                            if (ln == 1) { ptr = ctl + CW_XGR + ((l - 1) * 32 + tm) * 4; tgt = 8u; }
                            if (ln >= 2) {
                                if (tm >= 16) { ptr = ctl + CW_YRDY + ((l - 1) * 32 + (tm & ~3) + ((ln - 2) & 3)) * 4; tgt = 16u; }
                                else { ptr = ctl + CW_SD + ((l - 1) * 16 + tm) * 4; tgt = 4u; }
                            }
                            poll_lanes(ptr, tgt, ln < (tm >= 16 ? 6 : 3), ctl + CW_BAR);
                            __builtin_amdgcn_fence(__ATOMIC_ACQUIRE, "agent");
                            asm volatile("s_waitcnt vmcnt(0)" ::: "memory");
                        }
                        __syncthreads();
                        first = true;
                    }
                    const int tn = 2 * tn2 + ((F.w & 3) >> 1), wn = F.w & 1;
                    if (tn2 == 11) {
                        GemmAcc2 accn;
                        Gemm1Pre P1;
                        const bool mine = (F.w & 3) == 0;
                        if (mine) gemm1_pre(F, p, 22, 0, tm, l, P1); else { P1.rstd[0] = P1.rstd[1] = 0.f; P1.bias = 0.f; P1.gain = 1.f; }
                        gemm_core256n(F, Wt + (size_t)tn2 * 256 * 1024, X + (size_t)tm * 256 * 1024, accn, first); first = true;
                        if (mine) epi_kpe(F, p, accn, tm, l, P1);
                    } else {
                    GemmAcc8 acc;
                    Gemm1Pre P1;
                    gemm1_pre(F, p, tn, wn, tm, l, P1);
                    gemm_core256(F, Wt + (size_t)tn2 * 256 * 1024, X + (size_t)tm * 256 * 1024, acc, first, hn, Wt + (size_t)(jn >> 5) * 256 * 1024, X + (size_t)(jn & 31) * 256 * 1024); first = false;
                    epi_gemm1(F, p, acc, tn, wn, tm, l, P1, tn2 == 6);
                    }
                    {
                        asm volatile("s_waitcnt vmcnt(0)" ::: "memory");
                        __syncthreads();
                        if (F.tid == 0) {
                            if (tn2 == 5 || tn2 == 6) (void)xb_add(flags + tm * 16, 1u);
                            if (tn2 < 8) (void)xb_add(ctl + CW_RA + (l * 32 + tm) * 4, 1u);
                            if (tn2 >= 7 && tn2 < 11) (void)xb_add(ctl + CW_ZC + (l * 32 + tm) * 4, 1u);
                            (void)xb_add(ctl + CW_FULL + (l * 32 + tm) * 4, 1u);
                        }
                    }
                }
                for (int vb = bid; vb < 256; vb += G) {
                    if (vb < 128) continue;
                    const int c = (vb >> 5) - 4, tmw = vb & 31;
                    const int nit = (c == 2 && tmw < 16) ? 4 : 3;
                    if (F.tid == 0) {
                        if (l > 0 && tmw != waited_tm) {
                            if (tmw >= 16) { unsigned* y = ctl + CW_YRDY + ((l - 1) * 32 + (tmw & ~3)) * 4; for (int i = 0; i < 4; ++i) { XB_SPIN(xb_ld(y + 4 * i) < 16u, ctl + CW_BAR); } }
                            else { XB_SPIN(xb_ld(ctl + CW_YRDY + ((l - 1) * 32 + tmw) * 4) < 16u, ctl + CW_BAR); XB_SPIN(xb_ld(ctl + CW_SD + ((l - 1) * 16 + tmw) * 4) < 4u, ctl + CW_BAR); }
                        }
                        unsigned* f = flags + tmw * 16;
                        XB_SPIN(xb_ld(f) < 2u, ctl + CW_BAR);
                    }
                    __syncthreads();
                    for (int i = 0; i < nit; ++i) {
                        const bool hn = i + 1 < nit;
                        const int j = a2_item(vb, i), jn = a2_item(vb, hn ? i + 1 : i);
                        const GemmOp g = a2_op(F, l, j); const GemmOp gn = a2_op(F, l, jn);
                        GemmAcc acc;
                        float rstdq = 0.f;
                        if (j < 160) qm_pre(F, tmw, rstdq);
                        gemm_core(F, g, acc, i == 0, hn, gn);
                        if (j < 160) epi_qm(F, acc, j >> 5, tmw, rstdq);
                        else if (j < 352) { const int jj = j - 160; epi_plain(F, acc, (bf16_t*)(F.ws + WS_KVM), 768, tmw * 256, (jj >> 5) * 128); }
                        else {
                            const int jj = j - 352, tc = jj & 7;
                            if (l > 0) {
                                if (F.w == 0) { const int ln = lane_id(); poll_lanes(ctl + CW_YRDY + ((l - 1) * 32 + 16 + 4 * (tc >> 1) + (ln & 3)) * 4, 16u, ln < 4, ctl + CW_BAR); }
                                __syncthreads();
                            }
                            epi_plain(F, acc, (bf16_t*)(F.ws + WS_KVMC), 768, (tc >> 1) * 512 + (tc & 1) * 256, (jj >> 3) * 128);
                        }
                        asm volatile("s_waitcnt vmcnt(0)" ::: "memory");
                        __syncthreads();
                        if (F.tid == 0) {
                            if (j < 352) (void)xb_add(ctl + CW_FULL + (l * 32 + tmw) * 4, 1u);
                            else (void)xb_add(ctl + CW_KC + (l * 4 + (((j - 352) & 7) >> 1)) * 4, 1u);
                        }
                    }
                }
            } else if (EN(5) && sub == 2) {
                for (;;) {
                    __syncthreads();
                    if (F.tid == 0) MISC[0] = atomicAdd(ctl + CW_QUEUE + 64 * l + 32 * rep, 1u);
                    __syncthreads();
                    const int uq = __builtin_amdgcn_readfirstlane((int)MISC[0]);
                    if (uq >= N_ATTN_UNITS) break;
                    const int u = uq < 160 ? uq + 96 : (uq < 256 ? uq - 160 : (uq < 416 ? uq + 96 : (uq < 512 ? uq - 160 : uq)));
                    attn_dispatch(F, p, u, l);
                }
            } else if (EN(6)) {
                const bf16_t* Wt = (const bf16_t*)(F.ws + WS_WOUT) + (size_t)l * 1024 * 1024;
                const bf16_t* Yb = (const bf16_t*)(F.ws + WS_Y);
                for (int j = bid; j < 8 * 32; j += G) {
                    const int tn = j >> 5, tm = j & 31;
                    GemmOp g; g.W = Wt + (size_t)tn * 128 * 1024; g.X = Yb + (size_t)tm * 256 * 1024; g.ldw = 1024; g.ldx = 1024; g.K = 1024;
                    GemmAcc acc;
                    Gemm2Pre P2;
                    if (F.tid == 0) {
                        unsigned* f = ctl + CW_YRDY + (l * 32 + tm) * 4;
                        XB_SPIN(xb_ld(f) < 16u, ctl + CW_BAR);
                        if (l == 0) { XB_SPIN(xb_ld(ctl + CW_P1DONE) < (unsigned)G, ctl + CW_BAR); }
                    }
                    __syncthreads();
                    gemm2_pre(F, tn, tm, l, P2);
                    gemm_core(F, g, acc, true, false, g);
                    epi_gemm2(F, p, acc, tn, tm, l, P2, l == 3);
                    {
                        asm volatile("s_waitcnt vmcnt(0)" ::: "memory");
                        __syncthreads();
                        if (F.tid == 0) (void)xb_add(l == 3 ? ctl + CW_XRDY + tm * 4 : ctl + CW_XGR + (l * 32 + tm) * 4, 1u);
                    }
                }
            }
        }
        }
        if (MK_TIMING >= 0 && ph == 17 && blockIdx.x == 0 && F.tid == 0) {
            const unsigned long long now = __builtin_amdgcn_s_memrealtime();
            const unsigned long long prev = ((unsigned long long)MISC[17] << 32) | MISC[16];
            unsigned a = MISC[18]; if (MK_TIMING == 5) a += (unsigned)(now - prev);
            __hip_atomic_store(ctl + CW_TIME, __float_as_uint(1.f + (float)a * 1e-5f), __ATOMIC_RELAXED, __HIP_MEMORY_SCOPE_AGENT);
        }
        if (ph + 1 < p.ph_hi && ph < 1) xcd_barrier(bar);
    }
}
}

extern "C" void kernel_launch(void* const* d_in, const int* in_sizes, int n_in, void* d_out, int out_size, void* d_ws, size_t ws_size, hipStream_t stream) {
    static int grid = 0;
    if (!grid) {
        int dev = 0, cus = 0, per_cu = 0;
        (void)hipGetDevice(&dev);
        (void)hipDeviceGetAttribute(&cus, hipDeviceAttributeMultiprocessorCount, dev);
        (void)hipFuncSetAttribute((const void*)mk::mega, hipFuncAttributeMaxDynamicSharedMemorySize, mk::LDS_BYTES);
        (void)hipOccupancyMaxActiveBlocksPerMultiprocessor(&per_cu, (const void*)mk::mega, 512, mk::LDS_BYTES);
        if (per_cu > 1) per_cu = 1;
        if (per_cu < 1) per_cu = 1;
        if (cus < 1) cus = 256;
        grid = cus * per_cu;
    }
    unsigned char* ws = (unsigned char*)d_ws;
    (void)hipMemsetAsync(ws, 0, mk::CTL_ZERO_BYTES, stream);
    mk::Params P{};
    for (int i = 0; i < 22; ++i) P.in[i] = (const float*)d_in[i];
    P.out = (float*)d_out; P.ws = ws; P.xs = (float*)d_out;
    P.ph_lo = 0; P.ph_hi = mk::PH_TOTAL;
    void* args[] = {&P};
    (void)hipLaunchCooperativeKernel((const void*)mk::mega, dim3(grid), dim3(512), args, mk::LDS_BYTES, stream);
}
```
